# Optimizing an MI355X kernel written in HIP

```python
import math
import jax
import jax.numpy as jnp
from jax import lax
import numpy as np

D_MODEL = 1024
BATCH = 8
SEQ = 2048
DEPTH = 2

CTX_LEN = 256
GRID_W = 64
N_BRANCH = 4
BRANCH_W = D_MODEL // N_BRANCH

MLA_HEADS = BRANCH_W // 64
MLA_NOPE = 64
MLA_ROPE = 32
MLA_V = BRANCH_W // MLA_HEADS
MLA_Q_RANK = D_MODEL // 4
MLA_KV_RANK = D_MODEL // 8

NA_HEADS = BRANCH_W // 64
NA_DH = BRANCH_W // NA_HEADS
NA_WIN_R = 8
NA_WIN_C = 16

S5_GROUP = 16
S5_GROUPS = BRANCH_W // S5_GROUP
S5_STATE = 64

M2_HEADS = BRANCH_W // 64
M2_HEADDIM = BRANCH_W // M2_HEADS
M2_STATE = 128
M2_GROUPS = 2
M2_CONV = 4
M2_CHUNK = 128
M2_CONV_CH = BRANCH_W + 2 * M2_GROUPS * M2_STATE

N_EXPERTS = 16
EXPERT_FF = D_MODEL
CAPACITY_FACTOR = 2

Q_BLOCK = 128
ROPE_THETA = 10000.0
EPS = 1e-6

IN_SPLITS = (MLA_Q_RANK, MLA_KV_RANK, MLA_ROPE, 3 * BRANCH_W, BRANCH_W, BRANCH_W, M2_CONV_CH, 2 * M2_HEADS, N_BRANCH * D_MODEL)
N_IN = sum(IN_SPLITS)

kernel_name = 'hybrid_mla_na_s5_ssd_ecmoe_dit'


def rmsnorm(x, g):
    x32 = x.astype(jnp.float32)
    y = x32 * lax.rsqrt(jnp.mean(x32 * x32, axis=-1, keepdims=True) + EPS)
    return (y * g.astype(jnp.float32)).astype(x.dtype)


def modulate(h, shift, scale):
    return h * (1.0 + scale) + shift


def split_cols(p, sizes):
    return jnp.split(p, np.cumsum(sizes)[:-1].tolist(), axis=-1)


def rope_1d(x, pos):
    d = x.shape[-1]
    inv_freq = 1.0 / (ROPE_THETA ** (jnp.arange(0, d, 2, dtype=jnp.float32) / d))
    ang = pos.astype(jnp.float32)[:, None] * inv_freq[None, :]
    cos = jnp.concatenate([jnp.cos(ang), jnp.cos(ang)], axis=-1)
    sin = jnp.concatenate([jnp.sin(ang), jnp.sin(ang)], axis=-1)
    x32 = x.astype(jnp.float32)
    x1, x2 = jnp.split(x32, 2, axis=-1)
    rot = jnp.concatenate([-x2, x1], axis=-1)
    return (x32 * cos + rot * sin).astype(x.dtype)


def rope_2d(x, row, col):
    half = x.shape[-1] // 2
    return jnp.concatenate([rope_1d(x[..., :half], row), rope_1d(x[..., half:], col)], axis=-1)


def split_heads(t, n_heads):
    b, s, _ = t.shape
    return t.reshape(b, s, n_heads, -1).transpose(0, 2, 1, 3)


def merge_heads(t):
    b, h, s, d = t.shape
    return t.transpose(0, 2, 1, 3).reshape(b, s, h * d)


def block_attention(q, k, v, scale):
    b, h, t, d = q.shape
    nb = t // Q_BLOCK
    q_blocks = q.reshape(b, h, nb, Q_BLOCK, d).transpose(2, 0, 1, 3, 4)

    def one_block(qb):
        s = jnp.einsum('bhqd,bhkd->bhqk', qb, k).astype(jnp.float32) * scale
        p = jax.nn.softmax(s, axis=-1).astype(v.dtype)
        return jnp.einsum('bhqk,bhkd->bhqd', p, v)

    o = lax.map(one_block, q_blocks)
    return o.transpose(1, 2, 0, 3, 4).reshape(b, h, t, v.shape[-1])


def mla_mixer(cq_lat, ckv_lat, kr_lat, cq_ctx, ckv_ctx, kr_ctx, g_cq, g_ckv, w_uq, w_ukv, row, col, ctx_out):
    def keys_values(ckv, kr):
        b, t, _ = ckv.shape
        kvh = (rmsnorm(ckv, g_ckv) @ w_ukv).reshape(b, t, MLA_HEADS, MLA_NOPE + MLA_V)
        k_rope = jnp.broadcast_to(kr[:, :, None, :], (b, t, MLA_HEADS, MLA_ROPE))
        k = jnp.concatenate([kvh[..., :MLA_NOPE], k_rope], axis=-1)
        return k.transpose(0, 2, 1, 3), kvh[..., MLA_NOPE:].transpose(0, 2, 1, 3)

    def queries(cq):
        return split_heads(rmsnorm(cq, g_cq) @ w_uq, MLA_HEADS)

    scale = (MLA_NOPE + MLA_ROPE) ** -0.5
    k_lat, v_lat = keys_values(ckv_lat, rope_2d(kr_lat, row, col))
    k_ctx, v_ctx = keys_values(ckv_ctx, kr_ctx)
    q_lat = queries(cq_lat)
    q_lat = jnp.concatenate([q_lat[..., :MLA_NOPE], rope_2d(q_lat[..., MLA_NOPE:], row, col)], axis=-1)
    o_lat = block_attention(q_lat, jnp.concatenate([k_lat, k_ctx], axis=2),
                            jnp.concatenate([v_lat, v_ctx], axis=2), scale)
    o_ctx = merge_heads(block_attention(queries(cq_ctx), k_ctx, v_ctx, scale)) if ctx_out else None
    return merge_heads(o_lat), o_ctx


def na_mixer(qkv_lat, qkv_ctx, rpb, ctx_out):
    b, s, _ = qkv_lat.shape
    rows = s // GRID_W
    wr = min(NA_WIN_R, rows)
    scale = NA_DH ** -0.5
    q, k, v = [split_heads(t, NA_HEADS) for t in jnp.split(qkv_lat, 3, axis=-1)]
    qc, kc, vc = [split_heads(t, NA_HEADS) for t in jnp.split(qkv_ctx, 3, axis=-1)]

    def to_grid(t):
        return t.reshape(b, NA_HEADS, rows, GRID_W, NA_DH)

    kg, vg = to_grid(k), to_grid(v)
    q_rows = to_grid(q).transpose(2, 0, 1, 3, 4)
    row_start = jnp.clip(jnp.arange(rows) - wr // 2, 0, rows - wr)
    qcol = jnp.arange(GRID_W)
    col_idx = jnp.clip(qcol - NA_WIN_C // 2, 0, GRID_W - NA_WIN_C)[:, None] + jnp.arange(NA_WIN_C)[None, :]
    col_off = col_idx - qcol[:, None] + (NA_WIN_C - 1)
    rpb32 = rpb.astype(jnp.float32)
    n_win = wr * NA_WIN_C

    def one_row(args):
        r, qr = args
        rs = row_start[r]
        kw = lax.dynamic_slice_in_dim(kg, rs, wr, axis=2)[:, :, :, col_idx]
        vw = lax.dynamic_slice_in_dim(vg, rs, wr, axis=2)[:, :, :, col_idx]
        row_off = rs + jnp.arange(wr) - r + (NA_WIN_R - 1)
        bias = rpb32[:, row_off[None, :, None], col_off[:, None, :]]
        s_win = jnp.einsum('bhqd,bhrqcd->bhqrc', qr, kw).astype(jnp.float32) * scale + bias[None]
        s_ctx = jnp.einsum('bhqd,bhkd->bhqk', qr, kc).astype(jnp.float32) * scale
        s_all = jnp.concatenate([s_win.reshape(b, NA_HEADS, GRID_W, n_win), s_ctx], axis=-1)
        p = jax.nn.softmax(s_all, axis=-1).astype(vg.dtype)
        p_win = p[..., :n_win].reshape(b, NA_HEADS, GRID_W, wr, NA_WIN_C)
        return (jnp.einsum('bhqrc,bhrqcd->bhqd', p_win, vw)
                + jnp.einsum('bhqk,bhkd->bhqd', p[..., n_win:], vc))

    o = lax.map(one_row, (jnp.arange(rows), q_rows))
    o_lat = o.transpose(1, 0, 3, 2, 4).reshape(b, s, NA_HEADS * NA_DH)
    o_ctx = merge_heads(block_attention(qc, kc, vc, scale)) if ctx_out else None
    return o_lat, o_ctx


def _linear_combine(e1, e2):
    a1, b1 = e1
    a2, b2 = e2
    return a1 * a2, a2 * b1 + b2


def s5_scan(abar, bbar, u, h0, reverse):
    bu = jnp.einsum('gpc,btgc->btgp', bbar, u.astype(jnp.complex64))
    a = jnp.broadcast_to(abar, bu.shape)
    a_cum, h = lax.associative_scan(_linear_combine, (a, bu), reverse=reverse, axis=1)
    return h + a_cum * h0[:, None]


def s5_mixer(u_lat, u_ctx, a_re, a_im, log_step, b_re, b_im, c_re, c_im, d_skip, w_glu, b_glu, ctx_out):
    f32 = jnp.float32

    def groups(u):
        return u.reshape(u.shape[0], u.shape[1], S5_GROUPS, S5_GROUP)

    def readout(cm, h):
        y = jnp.real(jnp.einsum('gcp,btgp->btgc', cm, h))
        return y.reshape(h.shape[0], h.shape[1], BRANCH_W)

    def glu(y):
        z = jax.nn.gelu(y)
        return z * jax.nn.sigmoid(z @ w_glu + b_glu)

    ul, uc = groups(u_lat), groups(u_ctx)
    d32 = d_skip.astype(f32)
    y_lat = d32 * u_lat.astype(f32)
    y_ctx = d32 * u_ctx.astype(f32) if ctx_out else None
    h_zero = jnp.zeros((u_ctx.shape[0], S5_GROUPS, S5_STATE), jnp.complex64)
    for d, rev in ((0, False), (1, True)):
        a = lax.complex(a_re[d].astype(f32), a_im[d].astype(f32))
        abar = jnp.exp(jnp.exp(log_step[d].astype(f32))[:, None] * a)
        bbar = ((abar - 1.0) / a)[:, :, None] * lax.complex(b_re[d].astype(f32), b_im[d].astype(f32))
        cm = lax.complex(c_re[d].astype(f32), c_im[d].astype(f32))
        h_ctx = s5_scan(abar, bbar, uc, h_zero, rev)
        h_lat = s5_scan(abar, bbar, ul, h_ctx[:, 0] if rev else h_ctx[:, -1], rev)
        y_lat = y_lat + readout(cm, h_lat)
        if ctx_out:
            y_ctx = y_ctx + readout(cm, h_ctx)
    o_ctx = glu(y_ctx).astype(u_ctx.dtype) if ctx_out else None
    return glu(y_lat).astype(u_lat.dtype), o_ctx


def dw_conv_centred(x, w, b):
    k = w.shape[0]
    y = lax.conv_general_dilated(x, w[:, None, :].astype(x.dtype), window_strides=(1,),
                                 padding=[(k // 2, k - 1 - k // 2)],
                                 dimension_numbers=('NWC', 'WIO', 'NWC'),
                                 feature_group_count=x.shape[-1])
    return y + b


def ssd_chunked(x, dt, a, bm, cm, h0):
    b, t, h, p = x.shape
    nc = t // M2_CHUNK
    rep = h // bm.shape[2]
    bh = jnp.repeat(bm, rep, axis=2).reshape(b, nc, M2_CHUNK, h, -1)
    ch = jnp.repeat(cm, rep, axis=2).reshape(b, nc, M2_CHUNK, h, -1)
    xdt = (x * dt[..., None]).reshape(b, nc, M2_CHUNK, h, p)
    a_cum = jnp.cumsum((dt * a).reshape(b, nc, M2_CHUNK, h), axis=2)
    causal = jnp.tril(jnp.ones((M2_CHUNK, M2_CHUNK), dtype=bool))[None, None, :, :, None]
    seg = a_cum[:, :, :, None, :] - a_cum[:, :, None, :, :]
    decay = jnp.exp(jnp.where(causal, seg, -jnp.inf))
    y_diag = jnp.einsum('bclsh,bcshp->bclhp', jnp.einsum('bclhn,bcshn->bclsh', ch, bh) * decay, xdt)
    states = jnp.einsum('bcsh,bcshn,bcshp->bchpn', jnp.exp(a_cum[:, :, -1:, :] - a_cum), bh, xdt)
    chunk_decay = jnp.exp(a_cum[:, :, -1, :])

    def step(state, inp):
        s_c, d_c = inp
        return state * d_c[:, :, None, None] + s_c, state

    h_last, h_in = lax.scan(step, h0, (jnp.moveaxis(states, 1, 0), jnp.moveaxis(chunk_decay, 1, 0)))
    y_off = jnp.einsum('bclhn,cbhpn,bclh->bclhp', ch, h_in, jnp.exp(a_cum))
    return (y_diag + y_off).reshape(b, t, h, p), h_last


def ssd_final_state(x, dt, a, bm):
    rep = x.shape[2] // bm.shape[2]
    a_cum = jnp.cumsum(dt * a, axis=1)
    w = jnp.exp(a_cum[:, -1:, :] - a_cum) * dt
    return jnp.einsum('bth,bthn,bthp->bhpn', w, jnp.repeat(bm, rep, axis=2), x)


def _flip(t, rev):
    return jnp.flip(t, axis=1) if rev else t


def m2_mixer(z_lat, xbc_lat, dt_lat, z_ctx, xbc_ctx, dt_ctx, conv_w, conv_b, a_log, dt_bias, d_skip, g_norm, ctx_out):
    f32 = jnp.float32

    def prep(xbc, dt_raw):
        b, t, _ = xbc.shape
        xbc = jax.nn.silu(dw_conv_centred(xbc, conv_w, conv_b)).astype(f32)
        xs, bm, cm = split_cols(xbc, (BRANCH_W, M2_GROUPS * M2_STATE, M2_GROUPS * M2_STATE))
        dt = jax.nn.softplus(dt_raw.astype(f32).reshape(b, t, 2, M2_HEADS) + dt_bias.astype(f32))
        return (xs.reshape(b, t, M2_HEADS, M2_HEADDIM), bm.reshape(b, t, M2_GROUPS, M2_STATE),
                cm.reshape(b, t, M2_GROUPS, M2_STATE), dt)

    def gated_norm(y, z):
        b, t = z.shape[:2]
        return rmsnorm(y.reshape(b, t, BRANCH_W) * jax.nn.silu(z.astype(f32)), g_norm).astype(z.dtype)

    xl, bl, cl, dtl = prep(xbc_lat, dt_lat)
    xc, bc, cc, dtc = prep(xbc_ctx, dt_ctx)
    d32 = d_skip.astype(f32)[:, None]
    y_lat = d32 * xl
    y_ctx = d32 * xc if ctx_out else None
    h_zero = jnp.zeros((xc.shape[0], M2_HEADS, M2_HEADDIM, M2_STATE), f32)
    for d in (0, 1):
        rev = d == 1
        a = -jnp.exp(a_log[d].astype(f32))
        if ctx_out:
            yc, h_ctx = ssd_chunked(_flip(xc, rev), _flip(dtc[:, :, d], rev), a, _flip(bc, rev), _flip(cc, rev), h_zero)
            y_ctx = y_ctx + _flip(yc, rev)
        else:
            h_ctx = ssd_final_state(_flip(xc, rev), _flip(dtc[:, :, d], rev), a, _flip(bc, rev))
        yl, _ = ssd_chunked(_flip(xl, rev), _flip(dtl[:, :, d], rev), a, _flip(bl, rev), _flip(cl, rev), h_ctx)
        y_lat = y_lat + _flip(yl, rev)
    o_ctx = gated_norm(y_ctx, z_ctx) if ctx_out else None
    return gated_norm(y_lat, z_lat), o_ctx


def token_mixer(h_lat, h_ctx, w_in, mla_g_cq, mla_g_ckv, mla_w_uq, mla_w_ukv, na_rpb,
                s5_a_re, s5_a_im, s5_log_step, s5_b_re, s5_b_im, s5_c_re, s5_c_im, s5_d, s5_w_glu, s5_b_glu,
                m2_conv_w, m2_conv_b, m2_a_log, m2_dt_bias, m2_d, m2_g_norm, w_branch, w_out, ctx_out):
    s = h_lat.shape[1]
    pos = jnp.arange(s)
    row, col = pos // GRID_W, pos % GRID_W
    pl = split_cols(h_lat @ w_in, IN_SPLITS)
    if ctx_out:
        pc = split_cols(h_ctx @ w_in, IN_SPLITS)
    else:
        pc = split_cols(h_ctx @ w_in[:, :N_IN - N_BRANCH * D_MODEL], IN_SPLITS[:-1])
    o_mla, oc_mla = mla_mixer(pl[0], pl[1], pl[2], pc[0], pc[1], pc[2], mla_g_cq, mla_g_ckv,
                              mla_w_uq, mla_w_ukv, row, col, ctx_out)
    o_na, oc_na = na_mixer(pl[3], pc[3], na_rpb, ctx_out)
    o_s5, oc_s5 = s5_mixer(pl[4], pc[4], s5_a_re, s5_a_im, s5_log_step, s5_b_re, s5_b_im,
                           s5_c_re, s5_c_im, s5_d, s5_w_glu, s5_b_glu, ctx_out)
    o_m2, oc_m2 = m2_mixer(pl[5], pl[6], pl[7], pc[5], pc[6], pc[7], m2_conv_w, m2_conv_b,
                           m2_a_log, m2_dt_bias, m2_d, m2_g_norm, ctx_out)

    def merge(outs, gate_logits):
        gl = gate_logits.reshape(gate_logits.shape[:-1] + (N_BRANCH, D_MODEL))
        y = jax.nn.sigmoid(gl[..., 0, :]) * (outs[0] @ w_branch[0])
        for j in range(1, N_BRANCH):
            y = y + jax.nn.sigmoid(gl[..., j, :]) * (outs[j] @ w_branch[j])
        return y @ w_out

    y_lat = merge((o_mla, o_na, o_s5, o_m2), pl[8])
    y_ctx = merge((oc_mla, oc_na, oc_s5, oc_m2), pc[8]) if ctx_out else None
    return y_lat, y_ctx


def expert_choice_ffn(h, w_router, w_gate, w_up, w_down):
    b, t, _ = h.shape
    cap = CAPACITY_FACTOR * t // N_EXPERTS
    aff = jax.nn.softmax(jnp.einsum('btd,de->bte', h, w_router).astype(jnp.float32), axis=-1)
    g, idx = lax.top_k(jnp.swapaxes(aff, 1, 2), cap)
    bidx = jnp.arange(b)[:, None, None]
    xs = h[bidx, idx]
    act = jax.nn.silu(jnp.einsum('becd,edf->becf', xs, w_gate)) * jnp.einsum('becd,edf->becf', xs, w_up)
    ys = jnp.einsum('becf,efd->becd', act, w_down) * g[..., None].astype(h.dtype)
    return jnp.zeros_like(h).at[bidx, idx].add(ys)


def setup_inputs(seed: int = 0) -> dict:
    key = jax.random.key(seed)
    keys = iter(jax.random.split(key, 48))

    def normal(shape, std):
        return jax.random.normal(next(keys), shape, jnp.float32) * std

    def gain(shape):
        return 1.0 + normal(shape, 0.02)

    def log_uniform(shape, lo, hi):
        return jax.random.uniform(next(keys), shape, jnp.float32, minval=math.log(lo), maxval=math.log(hi))

    L = DEPTH
    W = BRANCH_W
    dt0 = jnp.exp(log_uniform((L, 2, M2_HEADS), 1e-3, 1e-1))
    return {
        'x': normal((BATCH, SEQ, D_MODEL), 1.0),
        'c': normal((BATCH, D_MODEL), 1.0),
        'ctx': normal((BATCH, CTX_LEN, D_MODEL), 1.0),
        'c_ctx': normal((D_MODEL,), 1.0),
        'w_ada': normal((L, D_MODEL, 6 * D_MODEL), 0.2 * D_MODEL ** -0.5),
        'b_ada': normal((L, 6 * D_MODEL), 0.02),
        'g_pre_mix': gain((L, D_MODEL)),
        'g_post_mix': gain((L, D_MODEL)),
        'g_pre_ffn': gain((L, D_MODEL)),
        'g_post_ffn': gain((L, D_MODEL)),
        'w_in': normal((L, D_MODEL, N_IN), D_MODEL ** -0.5),
        'mla_g_cq': gain((L, MLA_Q_RANK)),
        'mla_g_ckv': gain((L, MLA_KV_RANK)),
        'mla_w_uq': normal((L, MLA_Q_RANK, MLA_HEADS * (MLA_NOPE + MLA_ROPE)), MLA_Q_RANK ** -0.5),
        'mla_w_ukv': normal((L, MLA_KV_RANK, MLA_HEADS * (MLA_NOPE + MLA_V)), MLA_KV_RANK ** -0.5),
        'na_rpb': normal((L, NA_HEADS, 2 * NA_WIN_R - 1, 2 * NA_WIN_C - 1), 0.1),
        's5_a_re': -0.5 + normal((L, 2, S5_GROUPS, S5_STATE), 0.01),
        's5_a_im': jnp.pi * jnp.arange(S5_STATE, dtype=jnp.float32) + normal((L, 2, S5_GROUPS, S5_STATE), 0.01),
        's5_log_step': log_uniform((L, 2, S5_GROUPS), 1e-3, 1e-1),
        's5_b_re': normal((L, 2, S5_GROUPS, S5_STATE, S5_GROUP), (2 * S5_GROUP) ** -0.5),
        's5_b_im': normal((L, 2, S5_GROUPS, S5_STATE, S5_GROUP), (2 * S5_GROUP) ** -0.5),
        's5_c_re': normal((L, 2, S5_GROUPS, S5_GROUP, S5_STATE), (2 * S5_STATE) ** -0.5),
        's5_c_im': normal((L, 2, S5_GROUPS, S5_GROUP, S5_STATE), (2 * S5_STATE) ** -0.5),
        's5_d': normal((L, W), 1.0),
        's5_w_glu': normal((L, W, W), W ** -0.5),
        's5_b_glu': normal((L, W), 0.02),
        'm2_conv_w': normal((L, M2_CONV, M2_CONV_CH), M2_CONV ** -0.5),
        'm2_conv_b': normal((L, M2_CONV_CH), 0.02),
        'm2_a_log': jnp.log(jax.random.uniform(next(keys), (L, 2, M2_HEADS), jnp.float32, 1.0, 16.0)),
        'm2_dt_bias': dt0 + jnp.log(-jnp.expm1(-dt0)),
        'm2_d': 1.0 + normal((L, M2_HEADS), 0.1),
        'm2_g_norm': gain((L, W)),
        'w_branch': normal((L, N_BRANCH, W, D_MODEL), W ** -0.5),
        'w_out': normal((L, D_MODEL, D_MODEL), D_MODEL ** -0.5),
        'w_router': normal((L, D_MODEL, N_EXPERTS), D_MODEL ** -0.5),
        'w_gate': normal((L, N_EXPERTS, D_MODEL, EXPERT_FF), D_MODEL ** -0.5),
        'w_up': normal((L, N_EXPERTS, D_MODEL, EXPERT_FF), D_MODEL ** -0.5),
        'w_down': normal((L, N_EXPERTS, EXPERT_FF, D_MODEL), EXPERT_FF ** -0.5),
    }


def reference(x, c, ctx, c_ctx, w_ada, b_ada, g_pre_mix, g_post_mix, g_pre_ffn, g_post_ffn, w_in,
              mla_g_cq, mla_g_ckv, mla_w_uq, mla_w_ukv, na_rpb,
              s5_a_re, s5_a_im, s5_log_step, s5_b_re, s5_b_im, s5_c_re, s5_c_im, s5_d, s5_w_glu, s5_b_glu,
              m2_conv_w, m2_conv_b, m2_a_log, m2_dt_bias, m2_d, m2_g_norm,
              w_branch, w_out, w_router, w_gate, w_up, w_down):
    xc = ctx
    silu_c = jax.nn.silu(c)
    silu_cc = jax.nn.silu(c_ctx)
    for l in range(DEPTH):
        ctx_out = l < DEPTH - 1
        mod = jnp.split(silu_c @ w_ada[l] + b_ada[l], 6, axis=-1)
        shift1, scale1, gate1, shift2, scale2, gate2 = [m[:, None, :] for m in mod]
        cshift1, cscale1, cgate1, cshift2, cscale2, cgate2 = jnp.split(silu_cc @ w_ada[l] + b_ada[l], 6)

        h = modulate(rmsnorm(x, g_pre_mix[l]), shift1, scale1)
        hc = modulate(rmsnorm(xc, g_pre_mix[l]), cshift1, cscale1)
        y, yc = token_mixer(h, hc, w_in[l], mla_g_cq[l], mla_g_ckv[l], mla_w_uq[l], mla_w_ukv[l], na_rpb[l],
                            s5_a_re[l], s5_a_im[l], s5_log_step[l], s5_b_re[l], s5_b_im[l], s5_c_re[l],
                            s5_c_im[l], s5_d[l], s5_w_glu[l], s5_b_glu[l], m2_conv_w[l], m2_conv_b[l],
                            m2_a_log[l], m2_dt_bias[l], m2_d[l], m2_g_norm[l], w_branch[l], w_out[l], ctx_out)
        x = x + gate1 * rmsnorm(y, g_post_mix[l])
        h = modulate(rmsnorm(x, g_pre_ffn[l]), shift2, scale2)
        x = x + gate2 * rmsnorm(expert_choice_ffn(h, w_router[l], w_gate[l], w_up[l], w_down[l]), g_post_ffn[l])

        if ctx_out:
            xc = xc + cgate1 * rmsnorm(yc, g_post_mix[l])
            hc = modulate(rmsnorm(xc, g_pre_ffn[l]), cshift2, cscale2)
            xc = xc + cgate2 * rmsnorm(expert_choice_ffn(hc, w_router[l], w_gate[l], w_up[l], w_down[l]), g_post_ffn[l])
    return x
```

```cpp
#ifdef EMU
#include "emu.h"
#else
#include <hip/hip_runtime.h>
#include <hip/hip_cooperative_groups.h>
#include <cstdio>
namespace cg = cooperative_groups;
using bf16x8 = __attribute__((ext_vector_type(8))) short;
using f32x4 = __attribute__((ext_vector_type(4))) float;
using f32x16 = __attribute__((ext_vector_type(16))) float;
#endif
using u32x4 = __attribute__((ext_vector_type(4))) unsigned;
#ifndef MK_MULTI
#define MK_MULTI 1
#endif

#define DI __device__ __forceinline__
typedef unsigned short bf16;

#ifdef EMU_SMALL
constexpr int BATCH = 2, SEQ = 512, CTXL = 64, GRID_W = 32;
#else
constexpr int BATCH = 8, SEQ = 2048, CTXL = 256, GRID_W = 64;
#endif
constexpr int D = 1024, DEPTH = 2;
constexpr int TOK = CTXL + SEQ, NTOK = BATCH * TOK;
constexpr int ROWS = SEQ / GRID_W;
constexpr int WIN_R = (ROWS < 8 ? ROWS : 8), WIN_C = 16;
constexpr int N_IN = 6568, N_INP = 6656;
constexpr int C_CQ = 0, C_CKV = 256, C_KR = 384, C_NA = 416, C_S5 = 1184, C_Z = 1440, C_XBC = 1696, C_DT = 2464, C_GATE = 2472;
constexpr int P1W = 2480;
constexpr int NCH = TOK / 16, NCC = CTXL / 16, MCH = BATCH * NCH;
constexpr int NE = 16;
constexpr int CAP_L = 2 * SEQ / NE, CAP_C = 2 * CTXL / NE;
constexpr int ESLOTS = BATCH * (CAP_L + CAP_C), ESLOTS_L = BATCH * CAP_L;
constexpr int NB1 = BATCH + 1;
constexpr float EPS = 1e-6f;
constexpr int SMEM_BYTES = 49152;
constexpr int NTHREADS = 256;

enum { I_X = 0, I_C, I_CTX, I_CCTX, I_WADA, I_BADA, I_GPREMIX, I_GPOSTMIX, I_GPREFFN, I_GPOSTFFN, I_WIN, I_GCQ, I_GCKV, I_WUQ, I_WUKV, I_RPB,
       I_S5ARE, I_S5AIM, I_S5LOGSTEP, I_S5BRE, I_S5BIM, I_S5CRE, I_S5CIM, I_S5D, I_S5WGLU, I_S5BGLU, I_M2CONVW, I_M2CONVB, I_M2ALOG, I_M2DTBIAS,
       I_M2D, I_M2GNORM, I_WBRANCH, I_WOUT, I_WROUTER, I_WGATE, I_WUP, I_WDOWN, N_INPUTS };

constexpr size_t al256(size_t x) { return (x + 255) & ~(size_t)255; }
constexpr size_t SZ_X = (size_t)NTOK * D * 4;
constexpr size_t SZ_ROWBF = (size_t)NTOK * D * 2;
constexpr size_t OFF_X = 0;
constexpr size_t OFF_MOD = OFF_X + al256(SZ_X);
constexpr size_t OFF_HA = OFF_MOD + al256((size_t)DEPTH * NB1 * 6144 * 4);
constexpr size_t OFF_O = OFF_HA + al256(SZ_ROWBF);
constexpr size_t OFF_P1 = OFF_O + al256(SZ_ROWBF);
constexpr size_t SZ_P1 = (size_t)NTOK * P1W * 2;
constexpr size_t OFF_PG = OFF_P1 + al256(SZ_P1);
constexpr size_t SZ_PG = (size_t)NTOK * 4096 * 2;
constexpr size_t OFF_DT = OFF_PG + al256(SZ_PG);
constexpr size_t OFF_AFF = OFF_DT + al256((size_t)NTOK * 8 * 4);
constexpr size_t OFF_SEL = OFF_AFF + al256((size_t)NTOK * 16 * 4);
constexpr size_t OFF_IDX = OFF_SEL + al256((size_t)NTOK * 16 * 4);
constexpr size_t OFF_GW = OFF_IDX + al256((size_t)NE * ESLOTS * 4);
constexpr size_t OFF_ROPE = OFF_GW + al256((size_t)NE * ESLOTS * 4);
constexpr size_t OFF_WEARLY = OFF_ROPE + al256(64 * 8 * 2 * 4);
constexpr size_t WE_WIN = 0;
constexpr size_t WE_UQ = WE_WIN + (size_t)N_INP * 1024 * 2;
constexpr size_t WE_UKV = WE_UQ + (size_t)384 * 256 * 2;
constexpr size_t WE_GLU = WE_UKV + (size_t)512 * 128 * 2;
constexpr size_t WE_WB = WE_GLU + (size_t)256 * 256 * 2;
constexpr size_t WE_WOUT = WE_WB + (size_t)4 * 1024 * 256 * 2;
constexpr size_t WE_SIZE = al256(WE_WOUT + (size_t)1024 * 1024 * 2);
constexpr size_t OFF_S5TAB = OFF_WEARLY + DEPTH * WE_SIZE;
constexpr size_t S5_LAMPOW = 0;
constexpr size_t S5_BBAR = S5_LAMPOW + (size_t)2 * 16 * 17 * 64 * 2 * 4;
constexpr size_t S5_KT = S5_BBAR + (size_t)2 * 16 * 64 * 16 * 2 * 4;
constexpr size_t S5_WA = S5_KT + (size_t)2 * 16 * 16 * 256 * 4;
constexpr size_t S5_W2 = S5_WA + (size_t)16 * 256 * 256 * 2;
constexpr size_t S5_SIZE = al256(S5_W2 + (size_t)16 * 256 * 512 * 2);
constexpr size_t OFF_MIX = OFF_S5TAB + DEPTH * S5_SIZE;
constexpr size_t MX_Q = 0;
constexpr size_t MX_K = MX_Q + al256((size_t)BATCH * 4 * TOK * 96 * 2);
constexpr size_t MX_VTM = MX_K + al256((size_t)BATCH * 4 * TOK * 96 * 2);
constexpr size_t MX_VTN = MX_VTM + al256((size_t)BATCH * 4 * 64 * TOK * 2);
constexpr size_t MX_XBC = MX_VTN + al256((size_t)BATCH * 4 * 64 * TOK * 2);
constexpr size_t MX_US5 = MX_XBC + al256((size_t)NTOK * 768 * 2);
constexpr size_t MX_HEND = MX_US5 + al256((size_t)NTOK * 256 * 2);
constexpr size_t MX_HIN = MX_HEND + al256((size_t)16 * MCH * 256 * 4);
constexpr size_t MX_Z = MX_HIN + al256((size_t)16 * MCH * 256 * 2);
constexpr size_t MX_SIZE = MX_Z + al256((size_t)NTOK * 256 * 2);
constexpr size_t WX_GU = 0;
constexpr size_t WX_DN = WX_GU + (size_t)NE * 2048 * 1024 * 2;
constexpr size_t WX_SIZE = WX_DN + (size_t)NE * 1024 * 1024 * 2;
constexpr size_t MIXREG = (MX_SIZE > WX_SIZE ? MX_SIZE : WX_SIZE);
constexpr size_t WS_TOTAL = OFF_MIX + al256(MIXREG);

struct Params {
  const float* in[N_INPUTS];
  float* out;
  char* ws;
  int phase_lo, phase_hi;
};

DI int tid_() {
#ifdef EMU
  return (int)threadIdx.x;
#else
  int t = (int)threadIdx.x; asm volatile("" : "+v"(t)); return t;
#endif
}
DI float bf2f(bf16 h) { return __uint_as_float(((unsigned)h) << 16); }
DI bf16 f2bf(float f) { unsigned u = __float_as_uint(f); u += 0x7fffu + ((u >> 16) & 1u); return (bf16)(u >> 16); }
DI unsigned pack2(float a, float b) { return (unsigned)f2bf(a) | ((unsigned)f2bf(b) << 16); }
DI float sigmoidf_(float x) { return 1.0f / (1.0f + __expf(-x)); }
DI float siluf_(float x) { return x / (1.0f + __expf(-x)); }
DI float softplusf_(float x) { return x > 20.f ? x : log1pf(expf(x)); }
DI float geluf_(float x) { float u = 0.7978845608028654f * (x + 0.044715f * x * x * x); return 0.5f * x * (1.0f + tanhf(u)); }
DI float wave_sum(float v) {
  v += __shfl_xor(v, 32); v += __shfl_xor(v, 16); v += __shfl_xor(v, 8); v += __shfl_xor(v, 4); v += __shfl_xor(v, 2); v += __shfl_xor(v, 1);
  return v;
}
DI void grid_sync_() {
#ifdef EMU
  emu_grid_sync();
#else
  cg::this_grid().sync();
#endif
}

struct GA {
  const bf16* A; const bf16* A2; int lda, lda2, ksplit;
  const int* ridx; int mvalid;
  const bf16* Bt; int ldb; int K;
};
DI GA make_ga(const bf16* A, int lda, const bf16* Bt, int ldb, int K, int mvalid) {
  GA g; g.A = A; g.A2 = A; g.lda = lda; g.lda2 = lda; g.ksplit = K; g.ridx = nullptr; g.mvalid = mvalid; g.Bt = Bt; g.ldb = ldb; g.K = K; return g;
}

template <int NT>
DI void gemm_main(const GA& g, int m0, int n0, char* smem, f32x4 (&acc)[4][NT]) {
  bf16* sA = (bf16*)smem;
  bf16* sB = sA + 2 * 4096;
  const int tid = tid_(), lane = tid & 63, wid = tid >> 6, wr = wid >> 1, wc = wid & 1, fr = lane & 15, fq = lane >> 4;
  const int lrow = tid >> 2, kc = tid & 3;
  constexpr int NBL = NT / 2;
  long aoff[2], aoff2[2], boff[NBL];
  int soff[2];
#pragma unroll
  for (int i = 0; i < 2; ++i) {
    int row = lrow + i * 64;
    int gm = m0 + row; if (gm > g.mvalid - 1) gm = g.mvalid - 1;
    int ar = g.ridx ? g.ridx[gm] : gm;
    aoff[i] = (long)ar * g.lda + kc * 8;
    aoff2[i] = (long)ar * g.lda2 + kc * 8;
    if (i < NBL) boff[i] = (long)(n0 + row) * g.ldb + kc * 8;
    soff[i] = row * 32 + ((kc ^ ((row >> 2) & 3)) << 3);
  }
#pragma unroll
  for (int m = 0; m < 4; ++m)
#pragma unroll
    for (int n = 0; n < NT; ++n) acc[m][n] = f32x4{0.f, 0.f, 0.f, 0.f};
  const int T = g.K / 32;
  u32x4 ra0, ra1, rb0, rb1;
  rb1 = u32x4{0u, 0u, 0u, 0u};
#define GEMM_GLOAD(t_) { const int k0_ = (t_) * 32; \
    const bf16* ap0_ = (k0_ < g.ksplit) ? (g.A + aoff[0] + k0_) : (g.A2 + aoff2[0] + (k0_ - g.ksplit)); \
    const bf16* ap1_ = (k0_ < g.ksplit) ? (g.A + aoff[1] + k0_) : (g.A2 + aoff2[1] + (k0_ - g.ksplit)); \
    ra0 = *(const u32x4*)ap0_; ra1 = *(const u32x4*)ap1_; \
    rb0 = *(const u32x4*)(g.Bt + boff[0] + k0_); \
    if (NBL > 1) rb1 = *(const u32x4*)(g.Bt + boff[NBL - 1] + k0_); }
#define GEMM_SSTORE(buf_) { \
    *(u32x4*)(sA + (buf_) * 4096 + soff[0]) = ra0; *(u32x4*)(sA + (buf_) * 4096 + soff[1]) = ra1; \
    *(u32x4*)(sB + (buf_) * 4096 + soff[0]) = rb0; \
    if (NBL > 1) *(u32x4*)(sB + (buf_) * 4096 + soff[1]) = rb1; }
  __syncthreads();
  GEMM_GLOAD(0) GEMM_SSTORE(0)
  __syncthreads();
#pragma unroll 1
  for (int t = 0; t < T; ++t) {
    const int buf = t & 1;
    if (t + 1 < T) GEMM_GLOAD(t + 1)
    bf16x8 af[4], bfr[NT];
#pragma unroll
    for (int m = 0; m < 4; ++m) {
      int row = wr * 64 + m * 16 + fr;
      af[m] = *(const bf16x8*)(sA + buf * 4096 + row * 32 + ((fq ^ ((row >> 2) & 3)) << 3));
    }
#pragma unroll
    for (int n = 0; n < NT; ++n) {
      int row = wc * (16 * NT) + n * 16 + fr;
      bfr[n] = *(const bf16x8*)(sB + buf * 4096 + row * 32 + ((fq ^ ((row >> 2) & 3)) << 3));
    }
#pragma unroll
    for (int m = 0; m < 4; ++m)
#pragma unroll
      for (int n = 0; n < NT; ++n) acc[m][n] = __builtin_amdgcn_mfma_f32_16x16x32_bf16(af[m], bfr[n], acc[m][n], 0, 0, 0);
    if (t + 1 < T) GEMM_SSTORE(buf ^ 1)
    __syncthreads();
  }
}
constexpr int EST = 68;
constexpr int SRS_OFF = 36864;
DI void wave_sync_() {
#ifdef EMU
  bool last; unsigned g = emu_wave_arrive(last); emu_wave_wait(g, last);
#else
  __builtin_amdgcn_wave_barrier();
#endif
}
template <int NT, int HALF>
DI void epi_stage(const f32x4 (&acc)[4][NT], float* wb) {
  const int lane = tid_() & 63, fr = lane & 15, fq = lane >> 4;
  wave_sync_();
#pragma unroll
  for (int mm = 0; mm < 2; ++mm)
#pragma unroll
    for (int n = 0; n < NT; ++n)
#pragma unroll
      for (int j = 0; j < 4; ++j) wb[(mm * 16 + fq * 4 + j) * EST + n * 16 + fr] = acc[HALF * 2 + mm][n][j];
  wave_sync_();
}
DI void ld8f(const float* p, float (&v)[8]) {
  float4 a = *(const float4*)p, b = *(const float4*)(p + 4);
  v[0] = a.x; v[1] = a.y; v[2] = a.z; v[3] = a.w; v[4] = b.x; v[5] = b.y; v[6] = b.z; v[7] = b.w;
}
DI void ld8bf(const bf16* p, float (&v)[8]) {
  uint4 w = *(const uint4*)p;
  v[0] = __uint_as_float(w.x << 16); v[1] = __uint_as_float(w.x & 0xffff0000u); v[2] = __uint_as_float(w.y << 16); v[3] = __uint_as_float(w.y & 0xffff0000u);
  v[4] = __uint_as_float(w.z << 16); v[5] = __uint_as_float(w.z & 0xffff0000u); v[6] = __uint_as_float(w.w << 16); v[7] = __uint_as_float(w.w & 0xffff0000u);
}
DI void st8bf(bf16* p, const float (&v)[8]) { *(uint4*)p = make_uint4(pack2(v[0], v[1]), pack2(v[2], v[3]), pack2(v[4], v[5]), pack2(v[6], v[7])); }
DI void st8f(float* p, const float (&v)[8]) { *(float4*)p = make_float4(v[0], v[1], v[2], v[3]); *(float4*)(p + 4) = make_float4(v[4], v[5], v[6], v[7]); }
#define EPI_BEGIN_NT(NT_, acc_, m0_, n0_) { float* _wb = (float*)smem + (tid_() >> 6) * (32 * EST); \
  const int _lane = tid_() & 63, _w = tid_() >> 6, _wr = _w >> 1, _wc = _w & 1; \
  _Pragma("unroll") for (int _half = 0; _half < 2; ++_half) { \
    if (_half == 0) epi_stage<NT_, 0>(acc_, _wb); else epi_stage<NT_, 1>(acc_, _wb); \
    _Pragma("unroll") for (int _it = 0; _it < (NT_); ++_it) { \
      const int _g = _it * 64 + _lane, _r = _g / (2 * (NT_)), _cg = _g % (2 * (NT_)); \
      const int row = (m0_) + _wr * 64 + _half * 32 + _r, col = (n0_) + _wc * (16 * (NT_)) + _cg * 8; (void)row; (void)col; \
      float v[8]; ld8f(_wb + _r * EST + _cg * 8, v);
#define EPI_BEGIN(acc_, m0_, n0_) EPI_BEGIN_NT(4, acc_, m0_, n0_)
#define EPI_END }}}

DI int mtile_row0(int mt, bool latonly) {
  if (!latonly) return mt * 128;
  int b = mt / (SEQ / 128), r = mt % (SEQ / 128);
  return b * TOK + CTXL + r * 128;
}
DI int mtiles(bool latonly) { return latonly ? BATCH * (SEQ / 128) : NTOK / 128; }

struct LP {
  int l; bool last;
  const float* mod;
  char* we;
  char* s5;
};
DI LP make_lp(const Params& p, int l) {
  LP q; q.l = l; q.last = (l == DEPTH - 1);
  q.mod = (const float*)(p.ws + OFF_MOD) + (size_t)l * NB1 * 6144;
  q.we = p.ws + OFF_WEARLY + (size_t)l * WE_SIZE;
  q.s5 = p.ws + OFF_S5TAB + (size_t)l * S5_SIZE;
  return q;
}

template <class RowMap>
DI void conv_tile(const float* src, int lds, int nsrc, const float* kscale, bf16* dst, int K, int k0, int n0, char* smem, RowMap rowmap) {
  float* t = (float*)smem;
  const int tid = tid_();
  __syncthreads();
#pragma unroll 4
  for (int i = 0; i < 16; ++i) {
    int k = i * 4 + (tid >> 6), n = tid & 63;
    float v = (n0 + n < nsrc) ? src[(size_t)(k0 + k) * lds + n0 + n] : 0.f;
    if (kscale) v *= kscale[k0 + k];
    t[k * 65 + n] = v;
  }
  __syncthreads();
  const int n = tid >> 2, kq = (tid & 3) * 16;
  unsigned w[8];
#pragma unroll
  for (int i = 0; i < 8; ++i) w[i] = pack2(t[(kq + 2 * i) * 65 + n], t[(kq + 2 * i + 1) * 65 + n]);
  bf16* d = dst + (size_t)rowmap(n0 + n) * K + k0 + kq;
  *(uint4*)d = make_uint4(w[0], w[1], w[2], w[3]);
  *(uint4*)(d + 8) = make_uint4(w[4], w[5], w[6], w[7]);
}
struct RowId { DI int operator()(int n) const { return n; } };
struct RowGU { int half; DI int operator()(int f) const { return (f >> 6) * 128 + ((f >> 5) & 1) * 64 + half * 32 + (f & 31); } };

constexpr int CT_WIN = 16 * (N_INP / 64), CT_UQ = 4 * 6, CT_UKV = 2 * 8, CT_GLU = 16, CT_WB = 4 * 64, CT_WOUT = 256;
constexpr int CT_EARLY = CT_WIN + CT_UQ + CT_UKV + CT_GLU + CT_WB + CT_WOUT;
constexpr int CT_EXP = NE * 3 * 256;

DI void conv_early_item(const Params& p, int l, int it, char* smem) {
  char* we = p.ws + OFF_WEARLY + (size_t)l * WE_SIZE;
  if (it < CT_WIN) {
    int kt = it % 16, nt = it / 16;
    conv_tile(p.in[I_WIN] + (size_t)l * 1024 * N_IN, N_IN, N_IN, nullptr, (bf16*)(we + WE_WIN), 1024, kt * 64, nt * 64, smem, RowId());
    return;
  }
  it -= CT_WIN;
  if (it < CT_UQ) {
    int kt = it % 4, nt = it / 4;
    conv_tile(p.in[I_WUQ] + (size_t)l * 256 * 384, 384, 384, p.in[I_GCQ] + l * 256, (bf16*)(we + WE_UQ), 256, kt * 64, nt * 64, smem, RowId());
    return;
  }
  it -= CT_UQ;
  if (it < CT_UKV) {
    int kt = it % 2, nt = it / 2;
    conv_tile(p.in[I_WUKV] + (size_t)l * 128 * 512, 512, 512, p.in[I_GCKV] + l * 128, (bf16*)(we + WE_UKV), 128, kt * 64, nt * 64, smem, RowId());
    return;
  }
  it -= CT_UKV;
  if (it < CT_GLU) {
    int kt = it % 4, nt = it / 4;
    conv_tile(p.in[I_S5WGLU] + (size_t)l * 256 * 256, 256, 256, nullptr, (bf16*)(we + WE_GLU), 256, kt * 64, nt * 64, smem, RowId());
    return;
  }
  it -= CT_GLU;
  if (it < CT_WB) {
    int j = it / 64, r = it % 64, kt = r % 4, nt = r / 4;
    conv_tile(p.in[I_WBRANCH] + ((size_t)l * 4 + j) * 256 * 1024, 1024, 1024, nullptr, (bf16*)(we + WE_WB) + (size_t)j * 1024 * 256, 256, kt * 64, nt * 64, smem, RowId());
    return;
  }
  it -= CT_WB;
  {
    int kt = it % 16, nt = it / 16;
    conv_tile(p.in[I_WOUT] + (size_t)l * 1024 * 1024, 1024, 1024, nullptr, (bf16*)(we + WE_WOUT), 1024, kt * 64, nt * 64, smem, RowId());
  }
}
DI void conv_expert_item(const Params& p, int l, int it, char* smem) {
  char* wx = p.ws + OFF_MIX;
  int e = it / 768, r = it % 768, which = r / 256, t = r % 256, kt = t % 16, nt = t / 16;
  size_t eoff = ((size_t)l * NE + e) * 1024 * 1024;
  if (which == 0) { RowGU rm; rm.half = 0; conv_tile(p.in[I_WGATE] + eoff, 1024, 1024, nullptr, (bf16*)(wx + WX_GU) + (size_t)e * 2048 * 1024, 1024, kt * 64, nt * 64, smem, rm); }
  else if (which == 1) { RowGU rm; rm.half = 1; conv_tile(p.in[I_WUP] + eoff, 1024, 1024, nullptr, (bf16*)(wx + WX_GU) + (size_t)e * 2048 * 1024, 1024, kt * 64, nt * 64, smem, rm); }
  else conv_tile(p.in[I_WDOWN] + eoff, 1024, 1024, nullptr, (bf16*)(wx + WX_DN) + (size_t)e * 1024 * 1024, 1024, kt * 64, nt * 64, smem, RowId());
}

DI void mod_item(const Params& p, int it, char* smem) {
  const int l = it / 96, cg0 = (it % 96) * 64;
  float* sc = (float*)smem;
  float* red = sc + NB1 * 1024;
  const int tid = tid_();
  __syncthreads();
  for (int i = tid; i < NB1 * 1024; i += NTHREADS) {
    int r = i >> 10, k = i & 1023;
    float c = (r < BATCH) ? p.in[I_C][r * 1024 + k] : p.in[I_CCTX][k];
    sc[i] = siluf_(c);
  }
  __syncthreads();
  const int cl = tid & 63, kg = tid >> 6;
  float acc[NB1];
#pragma unroll
  for (int r = 0; r < NB1; ++r) acc[r] = 0.f;
  const float* w = p.in[I_WADA] + (size_t)l * 1024 * 6144 + cg0 + cl;
  for (int k = kg * 256; k < kg * 256 + 256; ++k) {
    float wv = w[(size_t)k * 6144];
#pragma unroll
    for (int r = 0; r < NB1; ++r) acc[r] += sc[r * 1024 + k] * wv;
  }
#pragma unroll
  for (int r = 0; r < NB1; ++r) red[(kg * NB1 + r) * 64 + cl] = acc[r];
  __syncthreads();
  for (int i = tid; i < NB1 * 64; i += NTHREADS) {
    int r = i >> 6, c = i & 63;
    float s = red[(0 * NB1 + r) * 64 + c] + red[(1 * NB1 + r) * 64 + c] + red[(2 * NB1 + r) * 64 + c] + red[(3 * NB1 + r) * 64 + c];
    s += p.in[I_BADA][l * 6144 + cg0 + c];
    ((float*)(p.ws + OFF_MOD))[((size_t)l * NB1 + r) * 6144 + cg0 + c] = s;
  }
}

DI void s5_tab_item(const Params& p, int it, char* smem) {
  const int l = it / 32, d = (it / 16) & 1, g = it & 15;
  char* s5 = p.ws + OFF_S5TAB + (size_t)l * S5_SIZE;
  float* lampow = (float*)(s5 + S5_LAMPOW) + (size_t)(d * 16 + g) * 17 * 64 * 2;
  float* bbar = (float*)(s5 + S5_BBAR) + (size_t)(d * 16 + g) * 64 * 16 * 2;
  float* kt = (float*)(s5 + S5_KT) + (size_t)(d * 16 + g) * 16 * 256;
  float* slam = (float*)smem;
  float* sbb = slam + 17 * 64 * 2;
  const int tid = tid_();
  const size_t pg = ((size_t)(l * 2 + d) * 16 + g);
  const float step = expf(p.in[I_S5LOGSTEP][pg]);
  __syncthreads();
  for (int i = tid; i < 17 * 64; i += NTHREADS) {
    int j = i >> 6, pp = i & 63;
    float are = p.in[I_S5ARE][pg * 64 + pp], aim = p.in[I_S5AIM][pg * 64 + pp];
    float mag = expf((float)j * step * are), ang = (float)j * step * aim;
    float re = mag * cosf(ang), im = mag * sinf(ang);
    slam[i * 2] = re; slam[i * 2 + 1] = im; lampow[i * 2] = re; lampow[i * 2 + 1] = im;
  }
  __syncthreads();
  for (int i = tid; i < 64 * 16; i += NTHREADS) {
    int pp = i >> 4;
    float are = p.in[I_S5ARE][pg * 64 + pp], aim = p.in[I_S5AIM][pg * 64 + pp];
    float x = slam[(64 + pp) * 2] - 1.0f, y = slam[(64 + pp) * 2 + 1];
    float den = are * are + aim * aim;
    float qre = (x * are + y * aim) / den, qim = (y * are - x * aim) / den;
    float bre = p.in[I_S5BRE][pg * 1024 + i], bim = p.in[I_S5BIM][pg * 1024 + i];
    float re = qre * bre - qim * bim, im = qre * bim + qim * bre;
    sbb[i * 2] = re; sbb[i * 2 + 1] = im; bbar[i * 2] = re; bbar[i * 2 + 1] = im;
  }
  __syncthreads();
  for (int i = tid; i < 16 * 256; i += NTHREADS) {
    int j = i >> 8, c = (i >> 4) & 15, c2 = i & 15;
    float s = 0.f;
    for (int pp = 0; pp < 64; ++pp) {
      float cre = p.in[I_S5CRE][pg * 1024 + c * 64 + pp], cim = p.in[I_S5CIM][pg * 1024 + c * 64 + pp];
      float lre = slam[(j * 64 + pp) * 2], lim = slam[(j * 64 + pp) * 2 + 1];
      float tre = cre * lre - cim * lim, tim = cre * lim + cim * lre;
      float bre = sbb[(pp * 16 + c2) * 2], bim = sbb[(pp * 16 + c2) * 2 + 1];
      s += tre * bre - tim * bim;
    }
    kt[i] = s;
  }
}
DI void s5_mat_item(const Params& p, int it) {
  const int l = it / 64, g = (it / 4) & 15, q = it & 3;
  char* s5 = p.ws + OFF_S5TAB + (size_t)l * S5_SIZE;
  const float* lampow = (const float*)(s5 + S5_LAMPOW);
  const float* bbar = (const float*)(s5 + S5_BBAR);
  const float* ktab = (const float*)(s5 + S5_KT);
  bf16* WA = (bf16*)(s5 + S5_WA) + (size_t)g * 256 * 256;
  bf16* W2 = (bf16*)(s5 + S5_W2) + (size_t)g * 256 * 512;
  const int tid = tid_();
  for (int i = tid; i < 64 * 256; i += NTHREADS) {
    int n = q * 64 + (i >> 8), k = i & 255;
    int d = n >> 7, ri = (n >> 6) & 1, pp = n & 63, s = k >> 4, c2 = k & 15;
    int e = (d == 0) ? (15 - s) : s;
    const float* lp = lampow + ((size_t)((d * 16 + g) * 17 + e) * 64 + pp) * 2;
    const float* bp = bbar + ((size_t)((d * 16 + g) * 64 + pp) * 16 + c2) * 2;
    float re = lp[0] * bp[0] - lp[1] * bp[1], im = lp[0] * bp[1] + lp[1] * bp[0];
    WA[(size_t)n * 256 + k] = f2bf(ri == 0 ? re : im);
  }
  for (int i = tid; i < 64 * 512; i += NTHREADS) {
    int n = q * 64 + (i >> 9), k = i & 511;
    int lq = n >> 4, c = n & 15;
    float v;
    if (k < 256) {
      int s = k >> 4, c2 = k & 15;
      v = 0.f;
      if (s <= lq) v += ktab[((size_t)(0 * 16 + g) * 16 + (lq - s)) * 256 + c * 16 + c2];
      if (s >= lq) v += ktab[((size_t)(1 * 16 + g) * 16 + (s - lq)) * 256 + c * 16 + c2];
      if (s == lq && c == c2) v += p.in[I_S5D][l * 256 + g * 16 + c];
    } else {
      int kk = k - 256, d = kk >> 7, ri = (kk >> 6) & 1, pp = kk & 63;
      int e = (d == 0) ? (lq + 1) : (16 - lq);
      size_t pg = ((size_t)(l * 2 + d) * 16 + g);
      float cre = p.in[I_S5CRE][pg * 1024 + c * 64 + pp], cim = p.in[I_S5CIM][pg * 1024 + c * 64 + pp];
      const float* lp = lampow + ((size_t)((d * 16 + g) * 17 + e) * 64 + pp) * 2;
      float re = cre * lp[0] - cim * lp[1], im = cre * lp[1] + cim * lp[0];
      v = (ri == 0) ? re : -im;
    }
    W2[(size_t)n * 512 + k] = f2bf(v);
  }
}

DI int tok_b(int tok) { return tok / TOK; }
DI int tok_j(int tok) { return tok % TOK; }
DI int tok_modrow(int tok) { return (tok_j(tok) < CTXL) ? BATCH : tok_b(tok); }

DI void normmod_row(const float (&xv)[16], const float* g, const float* shift, const float* scale, bf16* dst, float (&hout)[16]) {
  const int lane = tid_() & 63;
  float ss = 0.f;
#pragma unroll
  for (int i = 0; i < 16; ++i) ss += xv[i] * xv[i];
  ss = wave_sum(ss);
  const float rs = rsqrtf(ss * (1.0f / 1024.f) + EPS);
#pragma unroll
  for (int i = 0; i < 4; ++i) {
    int c = lane * 4 + i * 256;
    float4 gv = *(const float4*)(g + c), sh = *(const float4*)(shift + c), sc = *(const float4*)(scale + c);
    float h0 = xv[i * 4 + 0] * rs * gv.x * (1.f + sc.x) + sh.x;
    float h1 = xv[i * 4 + 1] * rs * gv.y * (1.f + sc.y) + sh.y;
    float h2 = xv[i * 4 + 2] * rs * gv.z * (1.f + sc.z) + sh.z;
    float h3 = xv[i * 4 + 3] * rs * gv.w * (1.f + sc.w) + sh.w;
    hout[i * 4 + 0] = h0; hout[i * 4 + 1] = h1; hout[i * 4 + 2] = h2; hout[i * 4 + 3] = h3;
    *(uint2*)(dst + c) = make_uint2(pack2(h0, h1), pack2(h2, h3));
  }
}

DI void prep_row_item(const Params& p, int it) {
  const int tok = it * 4 + (tid_() >> 6), lane = tid_() & 63;
  const int b = tok_b(tok), j = tok_j(tok);
  const float* src = (j < CTXL) ? p.in[I_CTX] + ((size_t)b * CTXL + j) * 1024 : p.in[I_X] + ((size_t)b * SEQ + (j - CTXL)) * 1024;
  float* X = (float*)(p.ws + OFF_X) + (size_t)tok * 1024;
  float xv[16], h[16];
#pragma unroll
  for (int i = 0; i < 4; ++i) {
    float4 v = *(const float4*)(src + lane * 4 + i * 256);
    *(float4*)(X + lane * 4 + i * 256) = v;
    xv[i * 4] = v.x; xv[i * 4 + 1] = v.y; xv[i * 4 + 2] = v.z; xv[i * 4 + 3] = v.w;
  }
  const float* mod = (const float*)(p.ws + OFF_MOD) + (size_t)tok_modrow(tok) * 6144;
  normmod_row(xv, p.in[I_GPREMIX], mod + 0, mod + 1024, (bf16*)(p.ws + OFF_HA) + (size_t)tok * 1024, h);
}

DI void inproj_tile(const Params& p, const LP& L, int t, char* smem) {
  const int MT = NTOK / 128;
  const int mt = t % MT, nt = t / MT;
  const int m0 = mt * 128, n0 = nt * 128;
  GA g = make_ga((const bf16*)(p.ws + OFF_HA), 1024, (const bf16*)(L.we + WE_WIN), 1024, 1024, NTOK);
  f32x4 acc[4][4];
  gemm_main<4>(g, m0, n0, smem, acc);
  bf16* P1 = (bf16*)(p.ws + OFF_P1);
  bf16* PG = (bf16*)(p.ws + OFF_PG);
  bf16* US5 = (bf16*)(p.ws + OFF_MIX + MX_US5);
  float* DT = (float*)(p.ws + OFF_DT);
  const float* dtb = p.in[I_M2DTBIAS] + L.l * 8;
  EPI_BEGIN(acc, m0, n0)
    if (col < C_S5 || (col >= C_Z && col < C_DT)) st8bf(P1 + (size_t)row * P1W + col, v);
    else if (col < C_Z) st8bf(US5 + ((size_t)((col - C_S5) >> 4) * NTOK + row) * 16 + (col & 15), v);
    else if (col < C_GATE) {
#pragma unroll
      for (int k = 0; k < 8; ++k) v[k] = softplusf_(v[k] + dtb[k]);
      st8f(DT + (size_t)row * 8, v);
    } else if (col < N_IN) {
#pragma unroll
      for (int k = 0; k < 8; ++k) v[k] = sigmoidf_(v[k]);
      st8bf(PG + (size_t)row * 4096 + (col - C_GATE), v);
    }
  EPI_END
}

DI void rowscale_128(const bf16* P1, int m0, int c0, int width, float* srs) {
  const int tid = tid_(), r = tid >> 1, half = tid & 1;
  const bf16* src = P1 + (size_t)(m0 + r) * P1W + c0 + half * (width / 2);
  float ss = 0.f;
  for (int i = 0; i < width / 2; i += 8) {
    uint4 v = *(const uint4*)(src + i);
    unsigned w[4] = {v.x, v.y, v.z, v.w};
#pragma unroll
    for (int q = 0; q < 4; ++q) { float a = __uint_as_float(w[q] << 16), b = __uint_as_float(w[q] & 0xffff0000u); ss += a * a + b * b; }
  }
  ss += __shfl_xor(ss, 1);
  if (half == 0) srs[r] = rsqrtf(ss / (float)width + EPS);
}
DI void rope_tab_item(const Params& p) {
  float* tab = (float*)(p.ws + OFF_ROPE);
  for (int i = tid_(); i < 64 * 8; i += NTHREADS) {
    int pos = i >> 3, k = i & 7;
    float f = expf(-(float)k * (9.210340371976184f / 8.0f));
    float a = (float)pos * f;
    tab[i * 2] = cosf(a); tab[i * 2 + 1] = sinf(a);
  }
}
DI void rope_cs(const float* tab, int pos, int i, float& c, float& s) { c = tab[(pos * 8 + i) * 2]; s = tab[(pos * 8 + i) * 2 + 1]; }

DI void mlaq_tile(const Params& p, const LP& L, int t, char* smem) {
  const int MT = NTOK / 128;
  const int mt = t % MT, nt = t / MT, m0 = mt * 128, n0 = nt * 128;
  const bf16* P1 = (const bf16*)(p.ws + OFF_P1);
  float* srs = (float*)(smem + SRS_OFF);
  GA g = make_ga(P1 + C_CQ, P1W, (const bf16*)(L.we + WE_UQ), 256, 256, NTOK);
  f32x4 acc[4][4];
  gemm_main<4>(g, m0, n0, smem, acc);
  rowscale_128(P1, m0, C_CQ, 256, srs);
  __syncthreads();
  bf16* Q = (bf16*)(p.ws + OFF_MIX + MX_Q);
  const float* ropetab = (const float*)(p.ws + OFF_ROPE);
  EPI_BEGIN(acc, m0, n0)
    const float rsc = srs[row - m0];
    const int h = col / 96, dd = col % 96;
    const int b = tok_b(row), j = tok_j(row);
    if (dd >= 64 && j >= CTXL) {
      float vp[8]; ld8f(_wb + _r * EST + (_cg ^ 1) * 8, vp);
      const int tl = j - CTXL, pos = ((dd - 64) < 16) ? (tl / GRID_W) : (tl % GRID_W);
      const bool lo = ((dd & 8) == 0);
#pragma unroll
      for (int k = 0; k < 8; ++k) {
        float c, sn; rope_cs(ropetab, pos, k, c, sn);
        v[k] = lo ? (v[k] * c - vp[k] * sn) : (v[k] * c + vp[k] * sn);
      }
    }
#pragma unroll
    for (int k = 0; k < 8; ++k) v[k] *= rsc;
    st8bf(Q + (((size_t)b * 4 + h) * TOK + j) * 96 + dd, v);
  EPI_END
}
DI void mlakv_tile(const Params& p, const LP& L, int t, char* smem) {
  const int MT = NTOK / 128;
  const int mt = t % MT, h = t / MT, m0 = mt * 128, n0 = h * 128;
  const bf16* P1 = (const bf16*)(p.ws + OFF_P1);
  float* srs = (float*)(smem + SRS_OFF);
  GA g = make_ga(P1 + C_CKV, P1W, (const bf16*)(L.we + WE_UKV), 128, 128, NTOK);
  f32x4 acc[4][4];
  gemm_main<4>(g, m0, n0, smem, acc);
  rowscale_128(P1, m0, C_CKV, 128, srs);
  __syncthreads();
  bf16* K = (bf16*)(p.ws + OFF_MIX + MX_K);
  bf16* VT = (bf16*)(p.ws + OFF_MIX + MX_VTM);
  const float* ropetab = (const float*)(p.ws + OFF_ROPE);
  {
    float* wb = (float*)smem + (tid_() >> 6) * (32 * EST);
    const int lane = tid_() & 63, w = tid_() >> 6, wr = w >> 1, wc = w & 1;
#pragma unroll
    for (int half = 0; half < 2; ++half) {
      if (half == 0) epi_stage<4, 0>(acc, wb); else epi_stage<4, 1>(acc, wb);
      if (wc == 0) {
#pragma unroll
        for (int it = 0; it < 4; ++it) {
          const int gI = it * 64 + lane, r = gI >> 3, cgp = gI & 7;
          const int row = m0 + wr * 64 + half * 32 + r;
          float v[8]; ld8f(wb + r * EST + cgp * 8, v);
          const float rsc = srs[row - m0];
#pragma unroll
          for (int k = 0; k < 8; ++k) v[k] *= rsc;
          st8bf(K + (((size_t)tok_b(row) * 4 + h) * TOK + tok_j(row)) * 96 + cgp * 8, v);
        }
      } else {
#pragma unroll
        for (int it = 0; it < 4; ++it) {
          const int r0 = it * 8, row0 = m0 + wr * 64 + half * 32 + r0;
          float v[8];
#pragma unroll
          for (int k = 0; k < 8; ++k) v[k] = wb[(r0 + k) * EST + lane] * srs[row0 + k - m0];
          st8bf(VT + (((size_t)tok_b(row0) * 4 + h) * 64 + lane) * TOK + tok_j(row0), v);
        }
      }
    }
  }
  for (int i = tid_(); i < 128 * 16; i += NTHREADS) {
    int r = i >> 4, q = i & 15;
    int row = m0 + r, b = tok_b(row), j = tok_j(row);
    int blk = q >> 3, i8 = q & 7;
    float x1 = bf2f(P1[(size_t)row * P1W + C_KR + blk * 16 + i8]), x2 = bf2f(P1[(size_t)row * P1W + C_KR + blk * 16 + i8 + 8]);
    float o1 = x1, o2 = x2;
    if (j >= CTXL) {
      int tl = j - CTXL, pos = blk == 0 ? (tl / GRID_W) : (tl % GRID_W);
      float c, s; rope_cs(ropetab, pos, i8, c, s);
      o1 = x1 * c - x2 * s; o2 = x2 * c + x1 * s;
    }
    bf16* kd = K + (((size_t)b * 4 + h) * TOK + j) * 96 + 64 + blk * 16 + i8;
    kd[0] = f2bf(o1); kd[8] = f2bf(o2);
  }
}
DI void navt_item(const Params& p, int it, char* smem) {
  bf16* s = (bf16*)smem;
  const bf16* P1 = (const bf16*)(p.ws + OFF_P1);
  bf16* VT = (bf16*)(p.ws + OFF_MIX + MX_VTN);
  const int tok0 = it * 64, tid = tid_();
  const int b = tok_b(tok0), j0 = tok_j(tok0);
  __syncthreads();
  for (int i = tid; i < 64 * 32; i += NTHREADS) {
    int r = i >> 5, c8 = i & 31;
    *(uint4*)(s + r * 264 + c8 * 8) = *(const uint4*)(P1 + (size_t)(tok0 + r) * P1W + C_NA + 512 + c8 * 8);
  }
  __syncthreads();
  for (int i = tid; i < 256 * 8; i += NTHREADS) {
    int ch = i >> 3, t8 = i & 7;
    unsigned w[4];
#pragma unroll
    for (int q = 0; q < 4; ++q) w[q] = (unsigned)s[(t8 * 8 + 2 * q) * 264 + ch] | ((unsigned)s[(t8 * 8 + 2 * q + 1) * 264 + ch] << 16);
    *(uint4*)(VT + ((size_t)b * 256 + ch) * TOK + j0 + t8 * 8) = make_uint4(w[0], w[1], w[2], w[3]);
  }
}
DI void m2conv_item(const Params& p, const LP& L, int it) {
  const bf16* P1 = (const bf16*)(p.ws + OFF_P1);
  bf16* XB = (bf16*)(p.ws + OFF_MIX + MX_XBC);
  const int tok0 = it * 32, j0 = tok_j(tok0);
  const int slo = (j0 < CTXL) ? 0 : CTXL, shi = (j0 < CTXL) ? CTXL : TOK;
  const int base = tok0 - j0;
  for (int c = tid_(); c < 768; c += NTHREADS) {
    const float w0 = p.in[I_M2CONVW][(L.l * 4 + 0) * 768 + c], w1 = p.in[I_M2CONVW][(L.l * 4 + 1) * 768 + c];
    const float w2 = p.in[I_M2CONVW][(L.l * 4 + 2) * 768 + c], w3 = p.in[I_M2CONVW][(L.l * 4 + 3) * 768 + c];
    const float bb = p.in[I_M2CONVB][L.l * 768 + c];
    auto ld = [&](int j) -> float { return (j >= slo && j < shi) ? bf2f(P1[(size_t)(base + j) * P1W + C_XBC + c]) : 0.f; };
    float xm2 = ld(j0 - 2), xm1 = ld(j0 - 1), x0 = ld(j0);
    for (int i = 0; i < 32; ++i) {
      float xp1 = ld(j0 + i + 1);
      float y = bb + w0 * xm2 + w1 * xm1 + w2 * x0 + w3 * xp1;
      XB[(size_t)(tok0 + i) * 768 + c] = f2bf(siluf_(y));
      xm2 = xm1; xm1 = x0; x0 = xp1;
    }
  }
}
constexpr int S5_MT = (MCH + 127) / 128;
DI void s5a_tile(const Params& p, const LP& L, int t, char* smem) {
  const int g = t / (S5_MT * 2), r = t % (S5_MT * 2), mt = r / 2, nt = r % 2;
  const int m0 = mt * 128, n0 = nt * 128;
  GA ga = make_ga((const bf16*)(p.ws + OFF_MIX + MX_US5) + (size_t)g * NTOK * 16, 256, (const bf16*)(L.s5 + S5_WA) + (size_t)g * 65536, 256, 256, MCH);
  f32x4 acc[4][4];
  gemm_main<4>(ga, m0, n0, smem, acc);
  float* HE = (float*)(p.ws + OFF_MIX + MX_HEND) + (size_t)g * MCH * 256;
  EPI_BEGIN(acc, m0, n0)
    if (row < MCH) st8f(HE + (size_t)row * 256 + col, v);
  EPI_END
}
DI void s5carry_item(const Params& p, const LP& L, int it) {
  const int w = it * 4 + (tid_() >> 6), lane = tid_() & 63;
  const int d = w / (16 * BATCH), g = (w / BATCH) & 15, b = w % BATCH;
  const float* lp = (const float*)(L.s5 + S5_LAMPOW) + ((size_t)((d * 16 + g) * 17 + 16) * 64 + lane) * 2;
  const float lre = lp[0], lim = lp[1];
  const float* HE = (const float*)(p.ws + OFF_MIX + MX_HEND) + ((size_t)g * MCH + (size_t)b * NCH) * 256 + d * 128;
  bf16* HI = (bf16*)(p.ws + OFF_MIX + MX_HIN) + ((size_t)g * MCH + (size_t)b * NCH) * 256 + d * 128;
  float cre = 0.f, cim = 0.f;
  for (int i = 0; i < NCH; ++i) {
    int ch = (d == 0) ? i : (i < NCC ? (NCC - 1 - i) : (NCH - 1 - (i - NCC)));
    HI[(size_t)ch * 256 + lane] = f2bf(cre); HI[(size_t)ch * 256 + 64 + lane] = f2bf(cim);
    float hre = HE[(size_t)ch * 256 + lane], him = HE[(size_t)ch * 256 + 64 + lane];
    float nre = lre * cre - lim * cim + hre, nim = lre * cim + lim * cre + him;
    cre = nre; cim = nim;
  }
}
DI void s5c_tile(const Params& p, const LP& L, int t, char* smem) {
  const int g = t / (S5_MT * 2), r = t % (S5_MT * 2), mt = r / 2, nt = r % 2;
  const int m0 = mt * 128, n0 = nt * 128;
  GA ga = make_ga((const bf16*)(p.ws + OFF_MIX + MX_US5) + (size_t)g * NTOK * 16, 256, (const bf16*)(L.s5 + S5_W2) + (size_t)g * 256 * 512, 512, 512, MCH);
  ga.A2 = (const bf16*)(p.ws + OFF_MIX + MX_HIN) + (size_t)g * MCH * 256; ga.lda2 = 256; ga.ksplit = 256;
  f32x4 acc[4][4];
  gemm_main<4>(ga, m0, n0, smem, acc);
  bf16* Z = (bf16*)(p.ws + OFF_MIX + MX_Z);
  EPI_BEGIN(acc, m0, n0)
#pragma unroll
    for (int k = 0; k < 8; ++k) v[k] = geluf_(v[k]);
    if (row < MCH) st8bf(Z + ((size_t)row * 16 + (col >> 4)) * 256 + g * 16 + (col & 15), v);
  EPI_END
}

DI float fmax_(float a, float b) { return a > b ? a : b; }
template <int DK>
struct AttnState {
  bf16x8 qf[DK / 16];
  f32x16 o0, o1;
  float m, l;
};
template <int DK>
DI void attn_init(AttnState<DK>& st, const bf16* qrow) {
  const int h = (tid_() & 63) >> 5;
#pragma unroll
  for (int ks = 0; ks < DK / 16; ++ks) st.qf[ks] = *(const bf16x8*)(qrow + ks * 16 + 8 * h);
#pragma unroll
  for (int i = 0; i < 16; ++i) { st.o0[i] = 0.f; st.o1[i] = 0.f; }
  st.m = -1e30f; st.l = 0.f;
}
template <int DK, class BiasF>
DI void attn_tile(AttnState<DK>& st, const bf16* krow, const bf16* vt, int vstride, float scale, BiasF biasf) {
  const int lane = tid_() & 63, h = lane >> 5, r = lane & 31;
  f32x16 s;
#pragma unroll
  for (int i = 0; i < 16; ++i) s[i] = 0.f;
#pragma unroll
  for (int ks = 0; ks < DK / 16; ++ks) {
    bf16x8 a = *(const bf16x8*)(krow + ks * 16 + 8 * h);
    s = __builtin_amdgcn_mfma_f32_32x32x16_bf16(a, st.qf[ks], s, 0, 0, 0);
  }
  float mx = -INFINITY;
#pragma unroll
  for (int i = 0; i < 16; ++i) {
    int kk = (i & 3) + 8 * (i >> 2) + 4 * h;
    float v = s[i] * scale + biasf(kk);
    s[i] = v; mx = fmax_(mx, v);
  }
  mx = fmax_(mx, __shfl_xor(mx, 32));
  const float mn = fmax_(st.m, mx);
  const float alpha = __expf(st.m - mn);
  st.m = mn;
  float ps = 0.f;
#pragma unroll
  for (int i = 0; i < 16; ++i) { float pv = __expf(s[i] - mn); s[i] = pv; ps += pv; }
  st.l = st.l * alpha + ps;
#pragma unroll
  for (int i = 0; i < 16; ++i) { st.o0[i] *= alpha; st.o1[i] *= alpha; }
#pragma unroll
  for (int sI = 0; sI < 2; ++sI) {
    bf16x8 pf;
#pragma unroll
    for (int j = 0; j < 8; ++j) pf[j] = (short)f2bf(s[8 * sI + j]);
    const bf16* v0 = vt + (size_t)r * vstride + 16 * sI + 4 * h;
    const bf16* v1 = vt + (size_t)(r + 32) * vstride + 16 * sI + 4 * h;
    uint2 a0 = *(const uint2*)v0, a1 = *(const uint2*)(v0 + 8);
    uint2 b0 = *(const uint2*)v1, b1 = *(const uint2*)(v1 + 8);
    bf16x8 va, vb;
    { unsigned w[4] = {a0.x, a0.y, a1.x, a1.y};
#pragma unroll
      for (int q = 0; q < 4; ++q) { va[2 * q] = (short)(w[q] & 0xffff); va[2 * q + 1] = (short)(w[q] >> 16); } }
    { unsigned w[4] = {b0.x, b0.y, b1.x, b1.y};
#pragma unroll
      for (int q = 0; q < 4; ++q) { vb[2 * q] = (short)(w[q] & 0xffff); vb[2 * q + 1] = (short)(w[q] >> 16); } }
    st.o0 = __builtin_amdgcn_mfma_f32_32x32x16_bf16(va, pf, st.o0, 0, 0, 0);
    st.o1 = __builtin_amdgcn_mfma_f32_32x32x16_bf16(vb, pf, st.o1, 0, 0, 0);
  }
}
template <int DK>
DI void attn_finish(AttnState<DK>& st, bf16* orow) {
  const int h = (tid_() & 63) >> 5;
  float lt = st.l + __shfl_xor(st.l, 32);
  float inv = 1.0f / lt;
#pragma unroll
  for (int gI = 0; gI < 4; ++gI) {
    int d0 = 8 * gI + 4 * h;
    *(uint2*)(orow + d0) = make_uint2(pack2(st.o0[4 * gI] * inv, st.o0[4 * gI + 1] * inv), pack2(st.o0[4 * gI + 2] * inv, st.o0[4 * gI + 3] * inv));
    *(uint2*)(orow + 32 + d0) = make_uint2(pack2(st.o1[4 * gI] * inv, st.o1[4 * gI + 1] * inv), pack2(st.o1[4 * gI + 2] * inv, st.o1[4 * gI + 3] * inv));
  }
}
struct NoBias { DI float operator()(int) const { return 0.f; } };
struct NaBias { const float* rpb_row; int qc, kc0, cs; DI float operator()(int kk) const { int kc = kc0 + kk; return (kc >= cs && kc < cs + WIN_C) ? rpb_row[kc - qc + (WIN_C - 1)] : -INFINITY; } };

DI void mla_attn_item(const Params& p, int it, bool ctxq) {
  const int nqb = ctxq ? (CTXL + 127) / 128 : SEQ / 128;
  const int b = it / (4 * nqb), h = (it / nqb) & 3, qb = it % nqb;
  const int lane = tid_() & 63, wid = tid_() >> 6;
  const int nq = ctxq ? CTXL : SEQ, q0 = qb * 128 + wid * 32;
  if (q0 >= nq) return;
  const int jq = (ctxq ? 0 : CTXL) + q0 + (lane & 31);
  const bf16* Q = (const bf16*)(p.ws + OFF_MIX + MX_Q) + ((size_t)b * 4 + h) * TOK * 96;
  const bf16* K = (const bf16*)(p.ws + OFF_MIX + MX_K) + ((size_t)b * 4 + h) * TOK * 96;
  const bf16* VT = (const bf16*)(p.ws + OFF_MIX + MX_VTM) + ((size_t)b * 4 + h) * 64 * TOK;
  AttnState<96> st;
  attn_init<96>(st, Q + (size_t)jq * 96);
  const float scale = 0.10206207261596577f;
  const int nk = ctxq ? CTXL : TOK;
  for (int k0 = 0; k0 < nk; k0 += 32)
    attn_tile<96>(st, K + (size_t)(k0 + (lane & 31)) * 96, VT + k0, TOK, scale, NoBias());
  bf16* O = (bf16*)(p.ws + OFF_O) + ((size_t)b * TOK + jq) * 1024 + 0 * 256 + h * 64;
  attn_finish<96>(st, O);
}
DI void na_attn_item(const Params& p, const LP& L, int it, bool ctxq) {
  const int nqb = ctxq ? (CTXL + 127) / 128 : SEQ / 128;
  const int b = it / (4 * nqb), h = (it / nqb) & 3, qb = it % nqb;
  const int lane = tid_() & 63, wid = tid_() >> 6;
  const int nq = ctxq ? CTXL : SEQ, q0 = qb * 128 + wid * 32;
  if (q0 >= nq) return;
  const int jq = (ctxq ? 0 : CTXL) + q0 + (lane & 31);
  const bf16* P1 = (const bf16*)(p.ws + OFF_P1) + (size_t)b * TOK * P1W;
  const bf16* VT = (const bf16*)(p.ws + OFF_MIX + MX_VTN) + ((size_t)b * 4 + h) * 64 * TOK;
  AttnState<64> st;
  attn_init<64>(st, P1 + (size_t)jq * P1W + C_NA + h * 64);
  const float scale = 0.125f;
  const bf16* Kb = P1 + C_NA + 256 + h * 64;
  if (!ctxq) {
    const int tl = q0 + (lane & 31), r = tl / GRID_W, qc = tl % GRID_W;
    int rs = r - WIN_R / 2; rs = rs < 0 ? 0 : (rs > ROWS - WIN_R ? ROWS - WIN_R : rs);
    int cs = qc - WIN_C / 2; cs = cs < 0 ? 0 : (cs > GRID_W - WIN_C ? GRID_W - WIN_C : cs);
    const float* rpb = p.in[I_RPB] + ((size_t)L.l * 4 + h) * 15 * 31;
    for (int wr = 0; wr < WIN_R; ++wr) {
      const int kr = rs + wr;
      for (int ct = 0; ct < GRID_W / 32; ++ct) {
        const int k0 = CTXL + kr * GRID_W + ct * 32;
        NaBias bf; bf.rpb_row = rpb + (kr - r + 7) * 31; bf.qc = qc; bf.kc0 = ct * 32; bf.cs = cs;
        attn_tile<64>(st, Kb + (size_t)(k0 + (lane & 31)) * P1W, VT + k0, TOK, scale, bf);
      }
    }
  }
  for (int k0 = 0; k0 < CTXL; k0 += 32)
    attn_tile<64>(st, Kb + (size_t)(k0 + (lane & 31)) * P1W, VT + k0, TOK, scale, NoBias());
  bf16* O = (bf16*)(p.ws + OFF_O) + ((size_t)b * TOK + jq) * 1024 + 1 * 256 + h * 64;
  attn_finish<64>(st, O);
}

DI void m2scan_item(const Params& p, const LP& L, int it, char* smem) {
  const int b = it / 8, hd = (it >> 1) & 3, dir = it & 1, grp = hd >> 1;
  const int tid = tid_(), pp = tid >> 2, nq = tid & 3;
  float* sB = (float*)smem;
  float* sC = sB + 32 * 128;
  float* sX = sC + 32 * 128;
  float* sD = sX + 32 * 64;
  const bf16* XB = (const bf16*)(p.ws + OFF_MIX + MX_XBC) + (size_t)b * TOK * 768;
  const float* DT = (const float*)(p.ws + OFF_DT) + (size_t)b * TOK * 8;
  float* YM = (float*)(p.ws + OFF_HA) + ((size_t)dir * NTOK + (size_t)b * TOK) * 256;
  const float a = -expf(p.in[I_M2ALOG][(L.l * 2 + dir) * 4 + hd]);
  float hst[32];
#pragma unroll
  for (int n = 0; n < 32; ++n) hst[n] = 0.f;
  for (int c0 = 0; c0 < TOK; c0 += 32) {
    __syncthreads();
    for (int i = tid; i < 32 * 128; i += NTHREADS) {
      int s = i >> 7, n = i & 127, sq = c0 + s;
      int j = (dir == 0) ? sq : (sq < CTXL ? (CTXL - 1 - sq) : (TOK - 1 - (sq - CTXL)));
      sB[i] = bf2f(XB[(size_t)j * 768 + 256 + grp * 128 + n]);
      sC[i] = bf2f(XB[(size_t)j * 768 + 512 + grp * 128 + n]);
    }
    for (int i = tid; i < 32 * 64; i += NTHREADS) {
      int s = i >> 6, q = i & 63, sq = c0 + s;
      int j = (dir == 0) ? sq : (sq < CTXL ? (CTXL - 1 - sq) : (TOK - 1 - (sq - CTXL)));
      sX[i] = bf2f(XB[(size_t)j * 768 + hd * 64 + q]);
    }
    if (tid < 32) {
      int sq = c0 + tid;
      int j = (dir == 0) ? sq : (sq < CTXL ? (CTXL - 1 - sq) : (TOK - 1 - (sq - CTXL)));
      sD[tid] = DT[(size_t)j * 8 + dir * 4 + hd];
    }
    __syncthreads();
    for (int s = 0; s < 32; ++s) {
      const float dt = sD[s], dec = __expf(dt * a), coef = dt * sX[s * 64 + pp];
      const float* bp = sB + s * 128 + nq * 32;
      const float* cp = sC + s * 128 + nq * 32;
      float y = 0.f;
#pragma unroll
      for (int n = 0; n < 32; n += 4) {
        float4 bv = *(const float4*)(bp + n), cv = *(const float4*)(cp + n);
        hst[n] = hst[n] * dec + coef * bv.x; y += cv.x * hst[n];
        hst[n + 1] = hst[n + 1] * dec + coef * bv.y; y += cv.y * hst[n + 1];
        hst[n + 2] = hst[n + 2] * dec + coef * bv.z; y += cv.z * hst[n + 2];
        hst[n + 3] = hst[n + 3] * dec + coef * bv.w; y += cv.w * hst[n + 3];
      }
      y += __shfl_xor(y, 1); y += __shfl_xor(y, 2);
      if (nq == 0) {
        int sq = c0 + s;
        int j = (dir == 0) ? sq : (sq < CTXL ? (CTXL - 1 - sq) : (TOK - 1 - (sq - CTXL)));
        YM[(size_t)j * 256 + hd * 64 + pp] = y;
      }
    }
  }
}
DI void m2gate_item(const Params& p, const LP& L, int it) {
  const int tok = it * 4 + (tid_() >> 6), lane = tid_() & 63;
  const float* Y0 = (const float*)(p.ws + OFF_HA) + (size_t)tok * 256;
  const float* Y1 = Y0 + (size_t)NTOK * 256;
  const bf16* XB = (const bf16*)(p.ws + OFF_MIX + MX_XBC) + (size_t)tok * 768;
  const bf16* P1 = (const bf16*)(p.ws + OFF_P1) + (size_t)tok * P1W + C_Z;
  const int c = lane * 4, hd = c >> 6;
  const float dsk = p.in[I_M2D][L.l * 4 + hd];
  float4 y0 = *(const float4*)(Y0 + c), y1 = *(const float4*)(Y1 + c);
  uint2 xw = *(const uint2*)(XB + c), zw = *(const uint2*)(P1 + c);
  float xs[4] = {__uint_as_float(xw.x << 16), __uint_as_float(xw.x & 0xffff0000u), __uint_as_float(xw.y << 16), __uint_as_float(xw.y & 0xffff0000u)};
  float zs[4] = {__uint_as_float(zw.x << 16), __uint_as_float(zw.x & 0xffff0000u), __uint_as_float(zw.y << 16), __uint_as_float(zw.y & 0xffff0000u)};
  float ys[4] = {y0.x + y1.x, y0.y + y1.y, y0.z + y1.z, y0.w + y1.w};
  float v[4], ss = 0.f;
#pragma unroll
  for (int i = 0; i < 4; ++i) { v[i] = (ys[i] + dsk * xs[i]) * siluf_(zs[i]); ss += v[i] * v[i]; }
  ss = wave_sum(ss);
  const float rs = rsqrtf(ss * (1.f / 256.f) + EPS);
  float4 gn = *(const float4*)(p.in[I_M2GNORM] + L.l * 256 + c);
  bf16* O = (bf16*)(p.ws + OFF_O) + (size_t)tok * 1024 + 768 + c;
  *(uint2*)O = make_uint2(pack2(v[0] * rs * gn.x, v[1] * rs * gn.y), pack2(v[2] * rs * gn.z, v[3] * rs * gn.w));
}
DI void glu_tile(const Params& p, const LP& L, int t, char* smem) {
  const int MT = NTOK / 128;
  const int mt = t % MT, nt = t / MT, m0 = mt * 128, n0 = nt * 128;
  const bf16* Z = (const bf16*)(p.ws + OFF_MIX + MX_Z);
  GA g = make_ga(Z, 256, (const bf16*)(L.we + WE_GLU), 256, 256, NTOK);
  f32x4 acc[4][4];
  gemm_main<4>(g, m0, n0, smem, acc);
  bf16* O = (bf16*)(p.ws + OFF_O);
  const float* bg = p.in[I_S5BGLU] + L.l * 256;
  EPI_BEGIN(acc, m0, n0)
    float z[8]; ld8bf(Z + (size_t)row * 256 + col, z);
#pragma unroll
    for (int k = 0; k < 8; ++k) v[k] = z[k] * sigmoidf_(v[k] + bg[col + k]);
    st8bf(O + (size_t)row * 1024 + 512 + col, v);
  EPI_END
}
DI void merge_tile(const Params& p, const LP& L, int t, char* smem) {
  const int MT = mtiles(L.last);
  const int mt = t % MT, nt = t / MT, m0 = mtile_row0(mt, L.last), n0 = nt * 64;
  const bf16* O = (const bf16*)(p.ws + OFF_O);
  const bf16* PG = (const bf16*)(p.ws + OFF_PG);
  float tot[2][2][8];
#pragma unroll
  for (int a = 0; a < 2; ++a)
#pragma unroll
    for (int b = 0; b < 2; ++b)
#pragma unroll
      for (int k = 0; k < 8; ++k) tot[a][b][k] = 0.f;
  for (int j = 0; j < 4; ++j) {
    GA g = make_ga(O + j * 256, 1024, (const bf16*)(L.we + WE_WB) + (size_t)j * 1024 * 256, 256, 256, NTOK);
    f32x4 acc[4][2];
    gemm_main<2>(g, m0, n0, smem, acc);
    EPI_BEGIN_NT(2, acc, m0, n0)
      float gt[8]; ld8bf(PG + (size_t)row * 4096 + j * 1024 + col, gt);
#pragma unroll
      for (int k = 0; k < 8; ++k) tot[_half][_it][k] += gt[k] * v[k];
    EPI_END
  }
  bf16* Y = (bf16*)(p.ws + OFF_P1);
  {
    const int lane = tid_() & 63, w = tid_() >> 6, wr = w >> 1, wc = w & 1;
#pragma unroll
    for (int half = 0; half < 2; ++half)
#pragma unroll
      for (int it = 0; it < 2; ++it) {
        const int gI = it * 64 + lane, r = gI >> 2, cgp = gI & 3;
        const int row = m0 + wr * 64 + half * 32 + r, col = n0 + wc * 32 + cgp * 8;
        st8bf(Y + (size_t)row * 1024 + col, tot[half][it]);
      }
  }
}
DI void outproj_tile(const Params& p, const LP& L, int t, char* smem) {
  const int MT = mtiles(L.last);
  const int mt = t % MT, nt = t / MT, m0 = mtile_row0(mt, L.last), n0 = nt * 128;
  GA g = make_ga((const bf16*)(p.ws + OFF_P1), 1024, (const bf16*)(L.we + WE_WOUT), 1024, 1024, NTOK);
  f32x4 acc[4][4];
  gemm_main<4>(g, m0, n0, smem, acc);
  float* Y2 = (float*)(p.ws + OFF_HA);
  EPI_BEGIN(acc, m0, n0)
    st8f(Y2 + (size_t)row * 1024 + col, v);
  EPI_END
}
DI int post_ntok(bool latonly) { return latonly ? BATCH * SEQ : NTOK; }
DI int post_tok(int i, bool latonly) { return latonly ? ((i / SEQ) * TOK + CTXL + (i % SEQ)) : i; }

DI void post_item(const Params& p, const LP& L, int it) {
  const int tok = post_tok(it * 4 + (tid_() >> 6), L.last), lane = tid_() & 63;
  float* X = (float*)(p.ws + OFF_X) + (size_t)tok * 1024;
  const float* Y2 = (const float*)(p.ws + OFF_HA) + (size_t)tok * 1024;
  const float* mod = L.mod + (size_t)tok_modrow(tok) * 6144;
  float yv[16], xv[16], h[16];
  float ss = 0.f;
#pragma unroll
  for (int i = 0; i < 4; ++i) {
    float4 v = *(const float4*)(Y2 + lane * 4 + i * 256);
    yv[i * 4] = v.x; yv[i * 4 + 1] = v.y; yv[i * 4 + 2] = v.z; yv[i * 4 + 3] = v.w;
    ss += v.x * v.x + v.y * v.y + v.z * v.z + v.w * v.w;
  }
  ss = wave_sum(ss);
  const float rs = rsqrtf(ss * (1.f / 1024.f) + EPS);
  const float* gpm = p.in[I_GPOSTMIX] + L.l * 1024;
#pragma unroll
  for (int i = 0; i < 4; ++i) {
    int c = lane * 4 + i * 256;
    float4 xo = *(const float4*)(X + c), gv = *(const float4*)(gpm + c), gt = *(const float4*)(mod + 2048 + c);
    xo.x += gt.x * yv[i * 4] * rs * gv.x; xo.y += gt.y * yv[i * 4 + 1] * rs * gv.y; xo.z += gt.z * yv[i * 4 + 2] * rs * gv.z; xo.w += gt.w * yv[i * 4 + 3] * rs * gv.w;
    *(float4*)(X + c) = xo;
    xv[i * 4] = xo.x; xv[i * 4 + 1] = xo.y; xv[i * 4 + 2] = xo.z; xv[i * 4 + 3] = xo.w;
  }
  bf16* H2 = (bf16*)(p.ws + OFF_P1) + (size_t)NTOK * 1024 + (size_t)tok * 1024;
  normmod_row(xv, p.in[I_GPREFFN] + L.l * 1024, mod + 3072, mod + 4096, H2, h);
  const float* wr = p.in[I_WROUTER] + (size_t)L.l * 1024 * 16;
  float lg[16];
#pragma unroll
  for (int e = 0; e < 16; ++e) lg[e] = 0.f;
#pragma unroll
  for (int i = 0; i < 16; ++i) {
    int k = lane * 4 + (i >> 2) * 256 + (i & 3);
    const float4* w4 = (const float4*)(wr + (size_t)k * 16);
    float4 a = w4[0], b4 = w4[1], c4 = w4[2], d4 = w4[3];
    float hv = h[i];
    lg[0] += hv * a.x; lg[1] += hv * a.y; lg[2] += hv * a.z; lg[3] += hv * a.w;
    lg[4] += hv * b4.x; lg[5] += hv * b4.y; lg[6] += hv * b4.z; lg[7] += hv * b4.w;
    lg[8] += hv * c4.x; lg[9] += hv * c4.y; lg[10] += hv * c4.z; lg[11] += hv * c4.w;
    lg[12] += hv * d4.x; lg[13] += hv * d4.y; lg[14] += hv * d4.z; lg[15] += hv * d4.w;
  }
  float mx = -INFINITY;
#pragma unroll
  for (int e = 0; e < 16; ++e) { lg[e] = wave_sum(lg[e]); mx = fmax_(mx, lg[e]); }
  float se = 0.f;
#pragma unroll
  for (int e = 0; e < 16; ++e) { lg[e] = expf(lg[e] - mx); se += lg[e]; }
  if (lane < 16) {
    float v = 0.f;
#pragma unroll
    for (int e = 0; e < 16; ++e) if (e == lane) v = lg[e];
    ((float*)(p.ws + OFF_AFF))[(size_t)tok * 16 + lane] = v / se;
  }
}
DI void route_item(const Params& p, const LP& L, int it, char* smem) {
  const int nstream = L.last ? 1 : 2;
  const int b = it / (16 * nstream), e = (it / nstream) & 15, ctxs = (nstream == 2) ? (it & 1) : 0;
  const int T = ctxs ? CTXL : SEQ, cap = ctxs ? CAP_C : CAP_L;
  const int tok0 = b * TOK + (ctxs ? 0 : CTXL);
  const int slot0 = ctxs ? (BATCH * CAP_L + b * CAP_C) : (b * CAP_L);
  float* sa = (float*)smem;
  const float* AFF = (const float*)(p.ws + OFF_AFF);
  int* SEL = (int*)(p.ws + OFF_SEL);
  int* IDX = (int*)(p.ws + OFF_IDX) + (size_t)e * ESLOTS;
  float* GW = (float*)(p.ws + OFF_GW) + (size_t)e * ESLOTS;
  const int tid = tid_();
  __syncthreads();
  for (int i = tid; i < T; i += NTHREADS) sa[i] = AFF[(size_t)(tok0 + i) * 16 + e];
  __syncthreads();
  for (int i = tid; i < T; i += NTHREADS) {
    const float a = sa[i];
    int rank = 0;
    for (int j = 0; j < T; ++j) { float v = sa[j]; rank += (v > a || (v == a && j < i)) ? 1 : 0; }
    if (rank < cap) { IDX[slot0 + rank] = tok0 + i; GW[slot0 + rank] = a; SEL[(size_t)(tok0 + i) * 16 + e] = slot0 + rank; }
    else SEL[(size_t)(tok0 + i) * 16 + e] = -1;
  }
}
DI void moe1_tile(const Params& p, const LP& L, int t, char* smem) {
  const int nslots = L.last ? ESLOTS_L : ESLOTS;
  const int MT = (nslots + 127) / 128;
  const int e = t / (MT * 16), r = t % (MT * 16), mt = r % MT, nt = r / MT;
  const int m0 = mt * 128, n0 = nt * 128;
  GA g = make_ga((const bf16*)(p.ws + OFF_P1) + (size_t)NTOK * 1024, 1024, (const bf16*)(p.ws + OFF_MIX + WX_GU) + (size_t)e * 2048 * 1024, 1024, 1024, nslots);
  g.ridx = (const int*)(p.ws + OFF_IDX) + (size_t)e * ESLOTS;
  f32x4 acc[4][4];
  gemm_main<4>(g, m0, n0, smem, acc);
  bf16* ACT = (bf16*)(p.ws + OFF_PG) + (size_t)e * ESLOTS * 1024;
  {
    float* wb = (float*)smem + (tid_() >> 6) * (32 * EST);
    const int lane = tid_() & 63, w = tid_() >> 6, wr = w >> 1, wc = w & 1;
#pragma unroll
    for (int half = 0; half < 2; ++half) {
      if (half == 0) epi_stage<4, 0>(acc, wb); else epi_stage<4, 1>(acc, wb);
#pragma unroll
      for (int it = 0; it < 2; ++it) {
        const int gI = it * 64 + lane, r = gI >> 2, cgp = gI & 3;
        const int row = m0 + wr * 64 + half * 32 + r;
        float gt[8], up[8];
        ld8f(wb + r * EST + cgp * 8, gt); ld8f(wb + r * EST + 32 + cgp * 8, up);
#pragma unroll
        for (int k = 0; k < 8; ++k) gt[k] = siluf_(gt[k]) * up[k];
        if (row < nslots) st8bf(ACT + (size_t)row * 1024 + nt * 64 + wc * 32 + cgp * 8, gt);
      }
    }
  }
}
DI void moe2_tile(const Params& p, const LP& L, int t, char* smem) {
  const int nslots = L.last ? ESLOTS_L : ESLOTS;
  const int MT = (nslots + 127) / 128;
  const int e = t / (MT * 8), r = t % (MT * 8), mt = r % MT, nt = r / MT;
  const int m0 = mt * 128, n0 = nt * 128;
  GA g = make_ga((const bf16*)(p.ws + OFF_PG) + (size_t)e * ESLOTS * 1024, 1024, (const bf16*)(p.ws + OFF_MIX + WX_DN) + (size_t)e * 1024 * 1024, 1024, 1024, nslots);
  f32x4 acc[4][4];
  gemm_main<4>(g, m0, n0, smem, acc);
  bf16* YS = (bf16*)(p.ws + OFF_PG) + (size_t)NE * ESLOTS * 1024 + (size_t)e * ESLOTS * 1024;
  const float* GW = (const float*)(p.ws + OFF_GW) + (size_t)e * ESLOTS;
  EPI_BEGIN(acc, m0, n0)
    const float gw = (row < nslots) ? GW[row] : 0.f;
#pragma unroll
    for (int k = 0; k < 8; ++k) v[k] *= gw;
    if (row < nslots) st8bf(YS + (size_t)row * 1024 + col, v);
  EPI_END
}
DI void comb_item(const Params& p, const LP& L, int it) {
  const int tok = post_tok(it * 4 + (tid_() >> 6), L.last), lane = tid_() & 63;
  float* X = (float*)(p.ws + OFF_X) + (size_t)tok * 1024;
  const int* SEL = (const int*)(p.ws + OFF_SEL) + (size_t)tok * 16;
  const bf16* YS = (const bf16*)(p.ws + OFF_PG) + (size_t)NE * ESLOTS * 1024;
  const float* mod = L.mod + (size_t)tok_modrow(tok) * 6144;
  float s[16];
#pragma unroll
  for (int i = 0; i < 16; ++i) s[i] = 0.f;
  for (int e = 0; e < 16; ++e) {
    int sl = SEL[e];
    if (sl >= 0) {
      const bf16* yr = YS + ((size_t)e * ESLOTS + sl) * 1024;
#pragma unroll
      for (int i = 0; i < 4; ++i) {
        uint2 w = *(const uint2*)(yr + lane * 4 + i * 256);
        s[i * 4] += __uint_as_float(w.x << 16); s[i * 4 + 1] += __uint_as_float(w.x & 0xffff0000u);
        s[i * 4 + 2] += __uint_as_float(w.y << 16); s[i * 4 + 3] += __uint_as_float(w.y & 0xffff0000u);
      }
    }
  }
  float ss = 0.f;
#pragma unroll
  for (int i = 0; i < 16; ++i) ss += s[i] * s[i];
  ss = wave_sum(ss);
  const float rs = rsqrtf(ss * (1.f / 1024.f) + EPS);
  const float* gpf = p.in[I_GPOSTFFN] + L.l * 1024;
  float xv[16], h[16];
  float* dst = X;
  if (L.last) { const int b = tok_b(tok), j = tok_j(tok); dst = p.out + ((size_t)b * SEQ + (j - CTXL)) * 1024; }
#pragma unroll
  for (int i = 0; i < 4; ++i) {
    int c = lane * 4 + i * 256;
    float4 xo = *(const float4*)(X + c), gv = *(const float4*)(gpf + c), gt = *(const float4*)(mod + 5120 + c);
    xo.x += gt.x * s[i * 4] * rs * gv.x; xo.y += gt.y * s[i * 4 + 1] * rs * gv.y; xo.z += gt.z * s[i * 4 + 2] * rs * gv.z; xo.w += gt.w * s[i * 4 + 3] * rs * gv.w;
    *(float4*)(dst + c) = xo;
    xv[i * 4] = xo.x; xv[i * 4 + 1] = xo.y; xv[i * 4 + 2] = xo.z; xv[i * 4 + 3] = xo.w;
  }
  if (!L.last) {
    const float* mod1 = (const float*)(p.ws + OFF_MOD) + ((size_t)(L.l + 1) * NB1 + tok_modrow(tok)) * 6144;
    normmod_row(xv, p.in[I_GPREMIX] + (L.l + 1) * 1024, mod1, mod1 + 1024, (bf16*)(p.ws + OFF_HA) + (size_t)tok * 1024, h);
  }
}

enum { PH_PREP0 = 0, PH_PREP1, PH_L0 };
enum { LP_INPROJ = 0, LP_TOKPREP, LP_MIX1, LP_MIX2, LP_GLU, LP_MERGE, LP_OUT, LP_POST, LP_ROUTE, LP_MOE1, LP_MOE2, LP_COMB, LP_COUNT };
constexpr int NPHASES = PH_L0 + DEPTH * LP_COUNT;


DI void run_phase(const Params& p, int ph, char* smem) {
  const int G = gridDim.x;
  int start = blockIdx.x;
  auto seg = [&](int n, auto&& fn) {
    for (; start < n; start += G) fn(start);
    start -= n;
  };
#ifdef ONLY_PREP
  if (ph >= PH_L0) return;
#endif
  if (ph == PH_PREP0) {
    seg(DEPTH * 96, [&](int it) { mod_item(p, it, smem); });
    seg(DEPTH * 32, [&](int it) { s5_tab_item(p, it, smem); });
    seg(1, [&](int) { rope_tab_item(p); });
    seg(DEPTH * CT_EARLY, [&](int it) { conv_early_item(p, it / CT_EARLY, it % CT_EARLY, smem); });
    return;
  }
  if (ph == PH_PREP1) {
    seg(DEPTH * 64, [&](int it) { s5_mat_item(p, it); });
    seg(NTOK / 4, [&](int it) { prep_row_item(p, it); });
    return;
  }
#ifdef ONLY_LPH
  if (ph < PH_L0) return;
#endif
  const int l = (ph - PH_L0) / LP_COUNT;
#ifdef ONLY_LPH
  const int lph = ONLY_LPH;
#else
  const int lph = (ph - PH_L0) % LP_COUNT;
#endif
  const LP L = make_lp(p, l);
  switch (lph) {
    case LP_INPROJ:
      seg((NTOK / 128) * (N_INP / 128), [&](int it) { inproj_tile(p, L, it, smem); });
      break;
    case LP_TOKPREP:
      seg(16 * S5_MT * 2, [&](int it) { s5a_tile(p, L, it, smem); });
      seg((NTOK / 128) * 3, [&](int it) { mlaq_tile(p, L, it, smem); });
      seg((NTOK / 128) * 4, [&](int it) { mlakv_tile(p, L, it, smem); });
      seg(NTOK / 64, [&](int it) { navt_item(p, it, smem); });
      seg(NTOK / 32, [&](int it) { m2conv_item(p, L, it); });
      break;
    case LP_MIX1:
      seg(BATCH * 8, [&](int it) { m2scan_item(p, L, it, smem); });
      seg(2 * 16 * BATCH / 4, [&](int it) { s5carry_item(p, L, it); });
      seg(BATCH * 4 * (SEQ / 128), [&](int it) { mla_attn_item(p, it, false); });
      seg(BATCH * 4 * (SEQ / 128), [&](int it) { na_attn_item(p, L, it, false); });
      if (!L.last) {
        seg(BATCH * 4 * ((CTXL + 127) / 128), [&](int it) { mla_attn_item(p, it, true); });
        seg(BATCH * 4 * ((CTXL + 127) / 128), [&](int it) { na_attn_item(p, L, it, true); });
      }
      break;
    case LP_MIX2:
      seg(16 * S5_MT * 2, [&](int it) { s5c_tile(p, L, it, smem); });
      seg(NTOK / 4, [&](int it) { m2gate_item(p, L, it); });
      break;
    case LP_GLU:
      seg((NTOK / 128) * 2, [&](int it) { glu_tile(p, L, it, smem); });
      break;
    case LP_MERGE:
      seg(mtiles(L.last) * 16, [&](int it) { merge_tile(p, L, it, smem); });
      break;
    case LP_OUT:
      seg(mtiles(L.last) * 8, [&](int it) { outproj_tile(p, L, it, smem); });
      break;
    case LP_POST:
      seg(CT_EXP, [&](int it) { conv_expert_item(p, l, it, smem); });
      seg(post_ntok(L.last) / 4, [&](int it) { post_item(p, L, it); });
      break;
    case LP_ROUTE:
      seg(BATCH * 16 * (L.last ? 1 : 2), [&](int it) { route_item(p, L, it, smem); });
      break;
    case LP_MOE1:
      seg(NE * (((L.last ? ESLOTS_L : ESLOTS) + 127) / 128) * 16, [&](int it) { moe1_tile(p, L, it, smem); });
      break;
    case LP_MOE2:
      seg(NE * (((L.last ? ESLOTS_L : ESLOTS) + 127) / 128) * 8, [&](int it) { moe2_tile(p, L, it, smem); });
      break;
    case LP_COMB:
      seg(post_ntok(L.last) / 4, [&](int it) { comb_item(p, L, it); });
      break;
  }
}

__global__ void __launch_bounds__(NTHREADS, 2) mega_kernel(Params p) {
#ifdef EMU
  char* smem = emu_cur_f->blk->smem;
#else
  __shared__ __attribute__((aligned(16))) char smem[SMEM_BYTES];
#endif
  for (int ph = p.phase_lo; ph < p.phase_hi; ++ph) {
    run_phase(p, ph, smem);
    if (ph + 1 < p.phase_hi) grid_sync_();
  }
}

#ifndef EMU
extern "C" void kernel_launch(void* const* d_in, const int* in_sizes, int n_in, void* d_out, int out_size, void* d_ws, size_t ws_size,
                              hipStream_t stream) {
  static int grid_blocks = 0;
  if (!grid_blocks) {
    int dev = 0, cus = 0, per_cu = 0;
    hipGetDevice(&dev);
    hipDeviceGetAttribute(&cus, hipDeviceAttributeMultiprocessorCount, dev);
    hipOccupancyMaxActiveBlocksPerMultiprocessor(&per_cu, mega_kernel, NTHREADS, 0);
    if (per_cu > 2) per_cu = 2;
    if (per_cu < 1) per_cu = 1;
    grid_blocks = cus * per_cu;
    if (ws_size < WS_TOTAL) fprintf(stderr, "workspace too small: %zu < %zu\n", ws_size, (size_t)WS_TOTAL);
  }
  Params p{};
  for (int i = 0; i < N_INPUTS; ++i) p.in[i] = (const float*)d_in[i];
  p.out = (float*)d_out;
  p.ws = (char*)d_ws;
#if MK_MULTI
  for (int ph = 0; ph < NPHASES; ++ph) {
    p.phase_lo = ph; p.phase_hi = ph + 1;
    hipLaunchKernelGGL(mega_kernel, dim3(grid_blocks), dim3(NTHREADS), 0, stream, p);
  }
#else
  p.phase_lo = 0; p.phase_hi = NPHASES;
  void* args[] = {&p};
  hipError_t e = hipLaunchCooperativeKernel((void*)mega_kernel, dim3(grid_blocks), dim3(NTHREADS), args, 0, stream);
  if (e != hipSuccess) fprintf(stderr, "cooperative launch failed: %s (grid %d)\n", hipGetErrorString(e), grid_blocks);
#endif
}
#endif
```

```cpp
#ifdef EMU
#include "emu.h"
#else
#include <hip/hip_runtime.h>
#include <hip/hip_cooperative_groups.h>
#include <cstdio>
namespace cg = cooperative_groups;
using bf16x8 = __attribute__((ext_vector_type(8))) short;
using f32x4 = __attribute__((ext_vector_type(4))) float;
using f32x16 = __attribute__((ext_vector_type(16))) float;
#endif
using u32x4 = __attribute__((ext_vector_type(4))) unsigned;
#ifndef MK_MULTI
#define MK_MULTI 0
#endif

#define DI __device__ __forceinline__
typedef unsigned short bf16;

#ifdef EMU_SMALL
constexpr int BATCH = 2, SEQ = 512, CTXL = 64, GRID_W = 32;
#else
constexpr int BATCH = 8, SEQ = 2048, CTXL = 256, GRID_W = 64;
#endif
constexpr int D = 1024, DEPTH = 2;
constexpr int TOK = CTXL + SEQ, NTOK = BATCH * TOK;
constexpr int ROWS = SEQ / GRID_W;
constexpr int WIN_R = (ROWS < 8 ? ROWS : 8), WIN_C = 16;
constexpr int N_IN = 6568, N_INP = 6656;
constexpr int C_CQ = 0, C_CKV = 256, C_KR = 384, C_NA = 416, C_S5 = 1184, C_Z = 1440, C_XBC = 1696, C_DT = 2464, C_GATE = 2472;
constexpr int P1W = 2480;
constexpr int NCH = TOK / 16, NCC = CTXL / 16, MCH = BATCH * NCH;
constexpr int NE = 16;
constexpr int CAP_L = 2 * SEQ / NE, CAP_C = 2 * CTXL / NE;
constexpr int ESLOTS = BATCH * (CAP_L + CAP_C), ESLOTS_L = BATCH * CAP_L;
constexpr int NB1 = BATCH + 1;
constexpr float EPS = 1e-6f;
constexpr int SMEM_BYTES = 49152;
constexpr int NTHREADS = 256;

enum { I_X = 0, I_C, I_CTX, I_CCTX, I_WADA, I_BADA, I_GPREMIX, I_GPOSTMIX, I_GPREFFN, I_GPOSTFFN, I_WIN, I_GCQ, I_GCKV, I_WUQ, I_WUKV, I_RPB,
       I_S5ARE, I_S5AIM, I_S5LOGSTEP, I_S5BRE, I_S5BIM, I_S5CRE, I_S5CIM, I_S5D, I_S5WGLU, I_S5BGLU, I_M2CONVW, I_M2CONVB, I_M2ALOG, I_M2DTBIAS,
       I_M2D, I_M2GNORM, I_WBRANCH, I_WOUT, I_WROUTER, I_WGATE, I_WUP, I_WDOWN, N_INPUTS };

constexpr size_t al256(size_t x) { return (x + 255) & ~(size_t)255; }
constexpr size_t SZ_X = (size_t)NTOK * D * 4;
constexpr size_t SZ_ROWBF = (size_t)NTOK * D * 2;
constexpr size_t OFF_X = 0;
constexpr size_t OFF_MOD = OFF_X + al256(SZ_X);
constexpr size_t OFF_HA = OFF_MOD + al256((size_t)DEPTH * NB1 * 6144 * 4);
constexpr size_t OFF_O = OFF_HA + al256(SZ_ROWBF);
constexpr size_t OFF_P1 = OFF_O + al256(SZ_ROWBF);
constexpr size_t SZ_P1 = (size_t)NTOK * P1W * 2;
constexpr size_t OFF_PG = OFF_P1 + al256(SZ_P1);
constexpr size_t SZ_PG = (size_t)NTOK * 4096 * 2;
constexpr size_t OFF_DT = OFF_PG + al256(SZ_PG);
constexpr size_t OFF_AFF = OFF_DT + al256((size_t)NTOK * 8 * 4);
constexpr size_t OFF_SEL = OFF_AFF + al256((size_t)NTOK * 16 * 4);
constexpr size_t OFF_IDX = OFF_SEL + al256((size_t)NTOK * 16 * 4);
constexpr size_t OFF_GW = OFF_IDX + al256((size_t)NE * ESLOTS * 4);
constexpr size_t OFF_ROPE = OFF_GW + al256((size_t)NE * ESLOTS * 4);
constexpr size_t OFF_WEARLY = OFF_ROPE + al256(64 * 8 * 2 * 4);
constexpr size_t WE_WIN = 0;
constexpr size_t WE_UQ = WE_WIN + (size_t)N_INP * 1024 * 2;
constexpr size_t WE_UKV = WE_UQ + (size_t)384 * 256 * 2;
constexpr size_t WE_GLU = WE_UKV + (size_t)512 * 128 * 2;
constexpr size_t WE_WB = WE_GLU + (size_t)256 * 256 * 2;
constexpr size_t WE_WOUT = WE_WB + (size_t)4 * 1024 * 256 * 2;
constexpr size_t WE_SIZE = al256(WE_WOUT + (size_t)1024 * 1024 * 2);
constexpr size_t OFF_S5TAB = OFF_WEARLY + DEPTH * WE_SIZE;
constexpr size_t S5_LAMPOW = 0;
constexpr size_t S5_BBAR = S5_LAMPOW + (size_t)2 * 16 * 17 * 64 * 2 * 4;
constexpr size_t S5_KT = S5_BBAR + (size_t)2 * 16 * 64 * 16 * 2 * 4;
constexpr size_t S5_WA = S5_KT + (size_t)2 * 16 * 16 * 256 * 4;
constexpr size_t S5_W2 = S5_WA + (size_t)16 * 256 * 256 * 2;
constexpr size_t S5_SIZE = al256(S5_W2 + (size_t)16 * 256 * 512 * 2);
constexpr size_t OFF_MIX = OFF_S5TAB + DEPTH * S5_SIZE;
constexpr size_t MX_Q = 0;
constexpr size_t MX_K = MX_Q + al256((size_t)BATCH * 4 * TOK * 96 * 2);
constexpr size_t MX_VTM = MX_K + al256((size_t)BATCH * 4 * TOK * 96 * 2);
constexpr size_t MX_VTN = MX_VTM + al256((size_t)BATCH * 4 * 64 * TOK * 2);
constexpr size_t MX_XBC = MX_VTN + al256((size_t)BATCH * 4 * 64 * TOK * 2);
constexpr size_t MX_US5 = MX_XBC + al256((size_t)NTOK * 768 * 2);
constexpr size_t MX_HEND = MX_US5 + al256((size_t)NTOK * 256 * 2);
constexpr size_t MX_HIN = MX_HEND + al256((size_t)16 * MCH * 256 * 4);
constexpr size_t MX_Z = MX_HIN + al256((size_t)16 * MCH * 256 * 2);
constexpr size_t MX_SIZE = MX_Z + al256((size_t)NTOK * 256 * 2);
constexpr size_t WX_GU = 0;
constexpr size_t WX_DN = WX_GU + (size_t)NE * 2048 * 1024 * 2;
constexpr size_t WX_SIZE = WX_DN + (size_t)NE * 1024 * 1024 * 2;
constexpr size_t MIXREG = (MX_SIZE > WX_SIZE ? MX_SIZE : WX_SIZE);
constexpr size_t WS_TOTAL = OFF_MIX + al256(MIXREG);

struct Params {
  const float* in[N_INPUTS];
  float* out;
  char* ws;
  int phase_lo, phase_hi;
};

DI int tid_() {
#ifdef EMU
  return (int)threadIdx.x;
#else
  int t = (int)threadIdx.x; asm volatile("" : "+v"(t)); return t;
#endif
}
DI float bf2f(bf16 h) { return __uint_as_float(((unsigned)h) << 16); }
DI bf16 f2bf(float f) { unsigned u = __float_as_uint(f); u += 0x7fffu + ((u >> 16) & 1u); return (bf16)(u >> 16); }
DI unsigned pack2(float a, float b) { return (unsigned)f2bf(a) | ((unsigned)f2bf(b) << 16); }
DI float sigmoidf_(float x) { return 1.0f / (1.0f + __expf(-x)); }
DI float siluf_(float x) { return x / (1.0f + __expf(-x)); }
DI float softplusf_(float x) { return x > 20.f ? x : log1pf(expf(x)); }
DI float geluf_(float x) { float u = 0.7978845608028654f * (x + 0.044715f * x * x * x); return 0.5f * x * (1.0f + tanhf(u)); }
DI float wave_sum(float v) {
  v += __shfl_xor(v, 32); v += __shfl_xor(v, 16); v += __shfl_xor(v, 8); v += __shfl_xor(v, 4); v += __shfl_xor(v, 2); v += __shfl_xor(v, 1);
  return v;
}
DI void grid_sync_() {
#ifdef EMU
  emu_grid_sync();
#else
  cg::this_grid().sync();
#endif
}

struct GA {
  const bf16* A; const bf16* A2; int lda, lda2, ksplit;
  const int* ridx; int mvalid;
  const bf16* Bt; int ldb; int K;
};
DI GA make_ga(const bf16* A, int lda, const bf16* Bt, int ldb, int K, int mvalid) {
  GA g; g.A = A; g.A2 = A; g.lda = lda; g.lda2 = lda; g.ksplit = K; g.ridx = nullptr; g.mvalid = mvalid; g.Bt = Bt; g.ldb = ldb; g.K = K; return g;
}

template <int NT>
DI void gemm_main(const GA& g, int m0, int n0, char* smem, f32x4 (&acc)[4][NT]) {
  bf16* sA = (bf16*)smem;
  bf16* sB = sA + 2 * 4096;
  const int tid = tid_(), lane = tid & 63, wid = tid >> 6, wr = wid >> 1, wc = wid & 1, fr = lane & 15, fq = lane >> 4;
  const int lrow = tid >> 2, kc = tid & 3;
  constexpr int NBL = NT / 2;
  long aoff[2], aoff2[2], boff[NBL];
  int soff[2];
#pragma unroll
  for (int i = 0; i < 2; ++i) {
    int row = lrow + i * 64;
    int gm = m0 + row; if (gm > g.mvalid - 1) gm = g.mvalid - 1;
    int ar = g.ridx ? g.ridx[gm] : gm;
    aoff[i] = (long)ar * g.lda + kc * 8;
    aoff2[i] = (long)ar * g.lda2 + kc * 8;
    if (i < NBL) boff[i] = (long)(n0 + row) * g.ldb + kc * 8;
    soff[i] = row * 32 + ((kc ^ ((row >> 2) & 3)) << 3);
  }
#pragma unroll
  for (int m = 0; m < 4; ++m)
#pragma unroll
    for (int n = 0; n < NT; ++n) acc[m][n] = f32x4{0.f, 0.f, 0.f, 0.f};
  const int T = g.K / 32;
  u32x4 ra0, ra1, rb0, rb1;
  rb1 = u32x4{0u, 0u, 0u, 0u};
#define GEMM_GLOAD(t_) { const int k0_ = (t_) * 32; \
    const bf16* ap0_ = (k0_ < g.ksplit) ? (g.A + aoff[0] + k0_) : (g.A2 + aoff2[0] + (k0_ - g.ksplit)); \
    const bf16* ap1_ = (k0_ < g.ksplit) ? (g.A + aoff[1] + k0_) : (g.A2 + aoff2[1] + (k0_ - g.ksplit)); \
    ra0 = *(const u32x4*)ap0_; ra1 = *(const u32x4*)ap1_; \
    rb0 = *(const u32x4*)(g.Bt + boff[0] + k0_); \
    if (NBL > 1) rb1 = *(const u32x4*)(g.Bt + boff[NBL - 1] + k0_); }
#define GEMM_SSTORE(buf_) { \
    *(u32x4*)(sA + (buf_) * 4096 + soff[0]) = ra0; *(u32x4*)(sA + (buf_) * 4096 + soff[1]) = ra1; \
    *(u32x4*)(sB + (buf_) * 4096 + soff[0]) = rb0; \
    if (NBL > 1) *(u32x4*)(sB + (buf_) * 4096 + soff[1]) = rb1; }
  __syncthreads();
  GEMM_GLOAD(0) GEMM_SSTORE(0)
  __syncthreads();
#pragma unroll 1
  for (int t = 0; t < T; ++t) {
    const int buf = t & 1;
    if (t + 1 < T) GEMM_GLOAD(t + 1)
    bf16x8 af[4], bfr[NT];
#pragma unroll
    for (int m = 0; m < 4; ++m) {
      int row = wr * 64 + m * 16 + fr;
      af[m] = *(const bf16x8*)(sA + buf * 4096 + row * 32 + ((fq ^ ((row >> 2) & 3)) << 3));
    }
#pragma unroll
    for (int n = 0; n < NT; ++n) {
      int row = wc * (16 * NT) + n * 16 + fr;
      bfr[n] = *(const bf16x8*)(sB + buf * 4096 + row * 32 + ((fq ^ ((row >> 2) & 3)) << 3));
    }
#pragma unroll
    for (int m = 0; m < 4; ++m)
#pragma unroll
      for (int n = 0; n < NT; ++n) acc[m][n] = __builtin_amdgcn_mfma_f32_16x16x32_bf16(af[m], bfr[n], acc[m][n], 0, 0, 0);
    if (t + 1 < T) GEMM_SSTORE(buf ^ 1)
    __syncthreads();
  }
}
constexpr int EST = 68;
constexpr int SRS_OFF = 36864;
DI void wave_sync_() {
#ifdef EMU
  bool last; unsigned g = emu_wave_arrive(last); emu_wave_wait(g, last);
#else
  __builtin_amdgcn_wave_barrier();
#endif
}
template <int NT, int HALF>
DI void epi_stage(const f32x4 (&acc)[4][NT], float* wb) {
  const int lane = tid_() & 63, fr = lane & 15, fq = lane >> 4;
  wave_sync_();
#pragma unroll
  for (int mm = 0; mm < 2; ++mm)
#pragma unroll
    for (int n = 0; n < NT; ++n)
#pragma unroll
      for (int j = 0; j < 4; ++j) wb[(mm * 16 + fq * 4 + j) * EST + n * 16 + fr] = acc[HALF * 2 + mm][n][j];
  wave_sync_();
}
DI void ld8f(const float* p, float (&v)[8]) {
  float4 a = *(const float4*)p, b = *(const float4*)(p + 4);
  v[0] = a.x; v[1] = a.y; v[2] = a.z; v[3] = a.w; v[4] = b.x; v[5] = b.y; v[6] = b.z; v[7] = b.w;
}
DI void ld8bf(const bf16* p, float (&v)[8]) {
  uint4 w = *(const uint4*)p;
  v[0] = __uint_as_float(w.x << 16); v[1] = __uint_as_float(w.x & 0xffff0000u); v[2] = __uint_as_float(w.y << 16); v[3] = __uint_as_float(w.y & 0xffff0000u);
  v[4] = __uint_as_float(w.z << 16); v[5] = __uint_as_float(w.z & 0xffff0000u); v[6] = __uint_as_float(w.w << 16); v[7] = __uint_as_float(w.w & 0xffff0000u);
}
DI void st8bf(bf16* p, const float (&v)[8]) { *(uint4*)p = make_uint4(pack2(v[0], v[1]), pack2(v[2], v[3]), pack2(v[4], v[5]), pack2(v[6], v[7])); }
DI void st8f(float* p, const float (&v)[8]) { *(float4*)p = make_float4(v[0], v[1], v[2], v[3]); *(float4*)(p + 4) = make_float4(v[4], v[5], v[6], v[7]); }
#define EPI_BEGIN_NT(NT_, acc_, m0_, n0_) { float* _wb = (float*)smem + (tid_() >> 6) * (32 * EST); \
  const int _lane = tid_() & 63, _w = tid_() >> 6, _wr = _w >> 1, _wc = _w & 1; \
  _Pragma("unroll") for (int _half = 0; _half < 2; ++_half) { \
    if (_half == 0) epi_stage<NT_, 0>(acc_, _wb); else epi_stage<NT_, 1>(acc_, _wb); \
    _Pragma("unroll") for (int _it = 0; _it < (NT_); ++_it) { \
      const int _g = _it * 64 + _lane, _r = _g / (2 * (NT_)), _cg = _g % (2 * (NT_)); \
      const int row = (m0_) + _wr * 64 + _half * 32 + _r, col = (n0_) + _wc * (16 * (NT_)) + _cg * 8; (void)row; (void)col; \
      float v[8]; ld8f(_wb + _r * EST + _cg * 8, v);
#define EPI_BEGIN(acc_, m0_, n0_) EPI_BEGIN_NT(4, acc_, m0_, n0_)
#define EPI_END }}}

DI int mtile_row0(int mt, bool latonly) {
  if (!latonly) return mt * 128;
  int b = mt / (SEQ / 128), r = mt % (SEQ / 128);
  return b * TOK + CTXL + r * 128;
}
DI int mtiles(bool latonly) { return latonly ? BATCH * (SEQ / 128) : NTOK / 128; }

struct LP {
  int l; bool last;
  const float* mod;
  char* we;
  char* s5;
};
DI LP make_lp(const Params& p, int l) {
  LP q; q.l = l; q.last = (l == DEPTH - 1);
  q.mod = (const float*)(p.ws + OFF_MOD) + (size_t)l * NB1 * 6144;
  q.we = p.ws + OFF_WEARLY + (size_t)l * WE_SIZE;
  q.s5 = p.ws + OFF_S5TAB + (size_t)l * S5_SIZE;
  return q;
}

template <class RowMap>
DI void conv_tile(const float* src, int lds, int nsrc, const float* kscale, bf16* dst, int K, int k0, int n0, char* smem, RowMap rowmap) {
  float* t = (float*)smem;
  const int tid = tid_();
  __syncthreads();
#pragma unroll 4
  for (int i = 0; i < 16; ++i) {
    int k = i * 4 + (tid >> 6), n = tid & 63;
    float v = (n0 + n < nsrc) ? src[(size_t)(k0 + k) * lds + n0 + n] : 0.f;
    if (kscale) v *= kscale[k0 + k];
    t[k * 65 + n] = v;
  }
  __syncthreads();
  const int n = tid >> 2, kq = (tid & 3) * 16;
  unsigned w[8];
#pragma unroll
  for (int i = 0; i < 8; ++i) w[i] = pack2(t[(kq + 2 * i) * 65 + n], t[(kq + 2 * i + 1) * 65 + n]);
  bf16* d = dst + (size_t)rowmap(n0 + n) * K + k0 + kq;
  *(uint4*)d = make_uint4(w[0], w[1], w[2], w[3]);
  *(uint4*)(d + 8) = make_uint4(w[4], w[5], w[6], w[7]);
}
struct RowId { DI int operator()(int n) const { return n; } };
struct RowGU { int half; DI int operator()(int f) const { return (f >> 6) * 128 + ((f >> 5) & 1) * 64 + half * 32 + (f & 31); } };

constexpr int CT_WIN = 16 * (N_INP / 64), CT_UQ = 4 * 6, CT_UKV = 2 * 8, CT_GLU = 16, CT_WB = 4 * 64, CT_WOUT = 256;
constexpr int CT_EARLY = CT_WIN + CT_UQ + CT_UKV + CT_GLU + CT_WB + CT_WOUT;
constexpr int CT_EXP = NE * 3 * 256;

DI void conv_early_item(const Params& p, int l, int it, char* smem) {
  char* we = p.ws + OFF_WEARLY + (size_t)l * WE_SIZE;
  if (it < CT_WIN) {
    int kt = it % 16, nt = it / 16;
    conv_tile(p.in[I_WIN] + (size_t)l * 1024 * N_IN, N_IN, N_IN, nullptr, (bf16*)(we + WE_WIN), 1024, kt * 64, nt * 64, smem, RowId());
    return;
  }
  it -= CT_WIN;
  if (it < CT_UQ) {
    int kt = it % 4, nt = it / 4;
    conv_tile(p.in[I_WUQ] + (size_t)l * 256 * 384, 384, 384, p.in[I_GCQ] + l * 256, (bf16*)(we + WE_UQ), 256, kt * 64, nt * 64, smem, RowId());
    return;
  }
  it -= CT_UQ;
  if (it < CT_UKV) {
    int kt = it % 2, nt = it / 2;
    conv_tile(p.in[I_WUKV] + (size_t)l * 128 * 512, 512, 512, p.in[I_GCKV] + l * 128, (bf16*)(we + WE_UKV), 128, kt * 64, nt * 64, smem, RowId());
    return;
  }
  it -= CT_UKV;
  if (it < CT_GLU) {
    int kt = it % 4, nt = it / 4;
    conv_tile(p.in[I_S5WGLU] + (size_t)l * 256 * 256, 256, 256, nullptr, (bf16*)(we + WE_GLU), 256, kt * 64, nt * 64, smem, RowId());
    return;
  }
  it -= CT_GLU;
  if (it < CT_WB) {
    int j = it / 64, r = it % 64, kt = r % 4, nt = r / 4;
    conv_tile(p.in[I_WBRANCH] + ((size_t)l * 4 + j) * 256 * 1024, 1024, 1024, nullptr, (bf16*)(we + WE_WB) + (size_t)j * 1024 * 256, 256, kt * 64, nt * 64, smem, RowId());
    return;
  }
  it -= CT_WB;
  {
    int kt = it % 16, nt = it / 16;
    conv_tile(p.in[I_WOUT] + (size_t)l * 1024 * 1024, 1024, 1024, nullptr, (bf16*)(we + WE_WOUT), 1024, kt * 64, nt * 64, smem, RowId());
  }
}
DI void conv_expert_item(const Params& p, int l, int it, char* smem) {
  char* wx = p.ws + OFF_MIX;
  int e = it / 768, r = it % 768, which = r / 256, t = r % 256, kt = t % 16, nt = t / 16;
  size_t eoff = ((size_t)l * NE + e) * 1024 * 1024;
  if (which == 0) { RowGU rm; rm.half = 0; conv_tile(p.in[I_WGATE] + eoff, 1024, 1024, nullptr, (bf16*)(wx + WX_GU) + (size_t)e * 2048 * 1024, 1024, kt * 64, nt * 64, smem, rm); }
  else if (which == 1) { RowGU rm; rm.half = 1; conv_tile(p.in[I_WUP] + eoff, 1024, 1024, nullptr, (bf16*)(wx + WX_GU) + (size_t)e * 2048 * 1024, 1024, kt * 64, nt * 64, smem, rm); }
  else conv_tile(p.in[I_WDOWN] + eoff, 1024, 1024, nullptr, (bf16*)(wx + WX_DN) + (size_t)e * 1024 * 1024, 1024, kt * 64, nt * 64, smem, RowId());
}

DI void mod_item(const Params& p, int it, char* smem) {
  const int l = it / 96, cg0 = (it % 96) * 64;
  float* sc = (float*)smem;
  float* red = sc + NB1 * 1024;
  const int tid = tid_();
  __syncthreads();
  for (int i = tid; i < NB1 * 1024; i += NTHREADS) {
    int r = i >> 10, k = i & 1023;
    float c = (r < BATCH) ? p.in[I_C][r * 1024 + k] : p.in[I_CCTX][k];
    sc[i] = siluf_(c);
  }
  __syncthreads();
  const int cl = tid & 63, kg = tid >> 6;
  float acc[NB1];
#pragma unroll
  for (int r = 0; r < NB1; ++r) acc[r] = 0.f;
  const float* w = p.in[I_WADA] + (size_t)l * 1024 * 6144 + cg0 + cl;
  for (int k = kg * 256; k < kg * 256 + 256; ++k) {
    float wv = w[(size_t)k * 6144];
#pragma unroll
    for (int r = 0; r < NB1; ++r) acc[r] += sc[r * 1024 + k] * wv;
  }
#pragma unroll
  for (int r = 0; r < NB1; ++r) red[(kg * NB1 + r) * 64 + cl] = acc[r];
  __syncthreads();
  for (int i = tid; i < NB1 * 64; i += NTHREADS) {
    int r = i >> 6, c = i & 63;
    float s = red[(0 * NB1 + r) * 64 + c] + red[(1 * NB1 + r) * 64 + c] + red[(2 * NB1 + r) * 64 + c] + red[(3 * NB1 + r) * 64 + c];
    s += p.in[I_BADA][l * 6144 + cg0 + c];
    ((float*)(p.ws + OFF_MOD))[((size_t)l * NB1 + r) * 6144 + cg0 + c] = s;
  }
}

DI void s5_tab_item(const Params& p, int it, char* smem) {
  const int l = it / 32, d = (it / 16) & 1, g = it & 15;
  char* s5 = p.ws + OFF_S5TAB + (size_t)l * S5_SIZE;
  float* lampow = (float*)(s5 + S5_LAMPOW) + (size_t)(d * 16 + g) * 17 * 64 * 2;
  float* bbar = (float*)(s5 + S5_BBAR) + (size_t)(d * 16 + g) * 64 * 16 * 2;
  float* kt = (float*)(s5 + S5_KT) + (size_t)(d * 16 + g) * 16 * 256;
  float* slam = (float*)smem;
  float* sbb = slam + 17 * 64 * 2;
  const int tid = tid_();
  const size_t pg = ((size_t)(l * 2 + d) * 16 + g);
  const float step = expf(p.in[I_S5LOGSTEP][pg]);
  __syncthreads();
  for (int i = tid; i < 17 * 64; i += NTHREADS) {
    int j = i >> 6, pp = i & 63;
    float are = p.in[I_S5ARE][pg * 64 + pp], aim = p.in[I_S5AIM][pg * 64 + pp];
    float mag = expf((float)j * step * are), ang = (float)j * step * aim;
    float re = mag * cosf(ang), im = mag * sinf(ang);
    slam[i * 2] = re; slam[i * 2 + 1] = im; lampow[i * 2] = re; lampow[i * 2 + 1] = im;
  }
  __syncthreads();
  for (int i = tid; i < 64 * 16; i += NTHREADS) {
    int pp = i >> 4;
    float are = p.in[I_S5ARE][pg * 64 + pp], aim = p.in[I_S5AIM][pg * 64 + pp];
    float x = slam[(64 + pp) * 2] - 1.0f, y = slam[(64 + pp) * 2 + 1];
    float den = are * are + aim * aim;
    float qre = (x * are + y * aim) / den, qim = (y * are - x * aim) / den;
    float bre = p.in[I_S5BRE][pg * 1024 + i], bim = p.in[I_S5BIM][pg * 1024 + i];
    float re = qre * bre - qim * bim, im = qre * bim + qim * bre;
    sbb[i * 2] = re; sbb[i * 2 + 1] = im; bbar[i * 2] = re; bbar[i * 2 + 1] = im;
  }
  __syncthreads();
  for (int i = tid; i < 16 * 256; i += NTHREADS) {
    int j = i >> 8, c = (i >> 4) & 15, c2 = i & 15;
    float s = 0.f;
    for (int pp = 0; pp < 64; ++pp) {
      float cre = p.in[I_S5CRE][pg * 1024 + c * 64 + pp], cim = p.in[I_S5CIM][pg * 1024 + c * 64 + pp];
      float lre = slam[(j * 64 + pp) * 2], lim = slam[(j * 64 + pp) * 2 + 1];
      float tre = cre * lre - cim * lim, tim = cre * lim + cim * lre;
      float bre = sbb[(pp * 16 + c2) * 2], bim = sbb[(pp * 16 + c2) * 2 + 1];
      s += tre * bre - tim * bim;
    }
    kt[i] = s;
  }
}
DI void s5_mat_item(const Params& p, int it) {
  const int l = it / 64, g = (it / 4) & 15, q = it & 3;
  char* s5 = p.ws + OFF_S5TAB + (size_t)l * S5_SIZE;
  const float* lampow = (const float*)(s5 + S5_LAMPOW);
  const float* bbar = (const float*)(s5 + S5_BBAR);
  const float* ktab = (const float*)(s5 + S5_KT);
  bf16* WA = (bf16*)(s5 + S5_WA) + (size_t)g * 256 * 256;
  bf16* W2 = (bf16*)(s5 + S5_W2) + (size_t)g * 256 * 512;
  const int tid = tid_();
  for (int i = tid; i < 64 * 256; i += NTHREADS) {
    int n = q * 64 + (i >> 8), k = i & 255;
    int d = n >> 7, ri = (n >> 6) & 1, pp = n & 63, s = k >> 4, c2 = k & 15;
    int e = (d == 0) ? (15 - s) : s;
    const float* lp = lampow + ((size_t)((d * 16 + g) * 17 + e) * 64 + pp) * 2;
    const float* bp = bbar + ((size_t)((d * 16 + g) * 64 + pp) * 16 + c2) * 2;
    float re = lp[0] * bp[0] - lp[1] * bp[1], im = lp[0] * bp[1] + lp[1] * bp[0];
    WA[(size_t)n * 256 + k] = f2bf(ri == 0 ? re : im);
  }
  for (int i = tid; i < 64 * 512; i += NTHREADS) {
    int n = q * 64 + (i >> 9), k = i & 511;
    int lq = n >> 4, c = n & 15;
    float v;
    if (k < 256) {
      int s = k >> 4, c2 = k & 15;
      v = 0.f;
      if (s <= lq) v += ktab[((size_t)(0 * 16 + g) * 16 + (lq - s)) * 256 + c * 16 + c2];
      if (s >= lq) v += ktab[((size_t)(1 * 16 + g) * 16 + (s - lq)) * 256 + c * 16 + c2];
      if (s == lq && c == c2) v += p.in[I_S5D][l * 256 + g * 16 + c];
    } else {
      int kk = k - 256, d = kk >> 7, ri = (kk >> 6) & 1, pp = kk & 63;
      int e = (d == 0) ? (lq + 1) : (16 - lq);
      size_t pg = ((size_t)(l * 2 + d) * 16 + g);
      float cre = p.in[I_S5CRE][pg * 1024 + c * 64 + pp], cim = p.in[I_S5CIM][pg * 1024 + c * 64 + pp];
      const float* lp = lampow + ((size_t)((d * 16 + g) * 17 + e) * 64 + pp) * 2;
      float re = cre * lp[0] - cim * lp[1], im = cre * lp[1] + cim * lp[0];
      v = (ri == 0) ? re : -im;
    }
    W2[(size_t)n * 512 + k] = f2bf(v);
  }
}

DI int tok_b(int tok) { return tok / TOK; }
DI int tok_j(int tok) { return tok % TOK; }
DI int tok_modrow(int tok) { return (tok_j(tok) < CTXL) ? BATCH : tok_b(tok); }

DI void normmod_row(const float (&xv)[16], const float* g, const float* shift, const float* scale, bf16* dst, float (&hout)[16]) {
  const int lane = tid_() & 63;
  float ss = 0.f;
#pragma unroll
  for (int i = 0; i < 16; ++i) ss += xv[i] * xv[i];
  ss = wave_sum(ss);
  const float rs = rsqrtf(ss * (1.0f / 1024.f) + EPS);
#pragma unroll
  for (int i = 0; i < 4; ++i) {
    int c = lane * 4 + i * 256;
    float4 gv = *(const float4*)(g + c), sh = *(const float4*)(shift + c), sc = *(const float4*)(scale + c);
    float h0 = xv[i * 4 + 0] * rs * gv.x * (1.f + sc.x) + sh.x;
    float h1 = xv[i * 4 + 1] * rs * gv.y * (1.f + sc.y) + sh.y;
    float h2 = xv[i * 4 + 2] * rs * gv.z * (1.f + sc.z) + sh.z;
    float h3 = xv[i * 4 + 3] * rs * gv.w * (1.f + sc.w) + sh.w;
    hout[i * 4 + 0] = h0; hout[i * 4 + 1] = h1; hout[i * 4 + 2] = h2; hout[i * 4 + 3] = h3;
    *(uint2*)(dst + c) = make_uint2(pack2(h0, h1), pack2(h2, h3));
  }
}

DI void prep_row_item(const Params& p, int it) {
  const int tok = it * 4 + (tid_() >> 6), lane = tid_() & 63;
  const int b = tok_b(tok), j = tok_j(tok);
  const float* src = (j < CTXL) ? p.in[I_CTX] + ((size_t)b * CTXL + j) * 1024 : p.in[I_X] + ((size_t)b * SEQ + (j - CTXL)) * 1024;
  float* X = (float*)(p.ws + OFF_X) + (size_t)tok * 1024;
  float xv[16], h[16];
#pragma unroll
  for (int i = 0; i < 4; ++i) {
    float4 v = *(const float4*)(src + lane * 4 + i * 256);
    *(float4*)(X + lane * 4 + i * 256) = v;
    xv[i * 4] = v.x; xv[i * 4 + 1] = v.y; xv[i * 4 + 2] = v.z; xv[i * 4 + 3] = v.w;
  }
  const float* mod = (const float*)(p.ws + OFF_MOD) + (size_t)tok_modrow(tok) * 6144;
  normmod_row(xv, p.in[I_GPREMIX], mod + 0, mod + 1024, (bf16*)(p.ws + OFF_HA) + (size_t)tok * 1024, h);
}

DI void inproj_tile(const Params& p, const LP& L, int t, char* smem) {
  const int MT = NTOK / 128;
  const int mt = t % MT, nt = t / MT;
  const int m0 = mt * 128, n0 = nt * 128;
  GA g = make_ga((const bf16*)(p.ws + OFF_HA), 1024, (const bf16*)(L.we + WE_WIN), 1024, 1024, NTOK);
  f32x4 acc[4][4];
  gemm_main<4>(g, m0, n0, smem, acc);
  bf16* P1 = (bf16*)(p.ws + OFF_P1);
  bf16* PG = (bf16*)(p.ws + OFF_PG);
  bf16* US5 = (bf16*)(p.ws + OFF_MIX + MX_US5);
  float* DT = (float*)(p.ws + OFF_DT);
  const float* dtb = p.in[I_M2DTBIAS] + L.l * 8;
  EPI_BEGIN(acc, m0, n0)
    if (col < C_S5 || (col >= C_Z && col < C_DT)) st8bf(P1 + (size_t)row * P1W + col, v);
    else if (col < C_Z) st8bf(US5 + ((size_t)((col - C_S5) >> 4) * NTOK + row) * 16 + (col & 15), v);
    else if (col < C_GATE) {
#pragma unroll
      for (int k = 0; k < 8; ++k) v[k] = softplusf_(v[k] + dtb[k]);
      st8f(DT + (size_t)row * 8, v);
    } else if (col < N_IN) {
#pragma unroll
      for (int k = 0; k < 8; ++k) v[k] = sigmoidf_(v[k]);
      st8bf(PG + (size_t)row * 4096 + (col - C_GATE), v);
    }
  EPI_END
}

DI void rowscale_128(const bf16* P1, int m0, int c0, int width, float* srs) {
  const int tid = tid_(), r = tid >> 1, half = tid & 1;
  const bf16* src = P1 + (size_t)(m0 + r) * P1W + c0 + half * (width / 2);
  float ss = 0.f;
  for (int i = 0; i < width / 2; i += 8) {
    uint4 v = *(const uint4*)(src + i);
    unsigned w[4] = {v.x, v.y, v.z, v.w};
#pragma unroll
    for (int q = 0; q < 4; ++q) { float a = __uint_as_float(w[q] << 16), b = __uint_as_float(w[q] & 0xffff0000u); ss += a * a + b * b; }
  }
  ss += __shfl_xor(ss, 1);
  if (half == 0) srs[r] = rsqrtf(ss / (float)width + EPS);
}
DI void rope_tab_item(const Params& p) {
  float* tab = (float*)(p.ws + OFF_ROPE);
  for (int i = tid_(); i < 64 * 8; i += NTHREADS) {
    int pos = i >> 3, k = i & 7;
    float f = expf(-(float)k * (9.210340371976184f / 8.0f));
    float a = (float)pos * f;
    tab[i * 2] = cosf(a); tab[i * 2 + 1] = sinf(a);
  }
}
DI void rope_cs(const float* tab, int pos, int i, float& c, float& s) { c = tab[(pos * 8 + i) * 2]; s = tab[(pos * 8 + i) * 2 + 1]; }

DI void mlaq_tile(const Params& p, const LP& L, int t, char* smem) {
  const int MT = NTOK / 128;
  const int mt = t % MT, nt = t / MT, m0 = mt * 128, n0 = nt * 128;
  const bf16* P1 = (const bf16*)(p.ws + OFF_P1);
  float* srs = (float*)(smem + SRS_OFF);
  GA g = make_ga(P1 + C_CQ, P1W, (const bf16*)(L.we + WE_UQ), 256, 256, NTOK);
  f32x4 acc[4][4];
  gemm_main<4>(g, m0, n0, smem, acc);
  rowscale_128(P1, m0, C_CQ, 256, srs);
  __syncthreads();
  bf16* Q = (bf16*)(p.ws + OFF_MIX + MX_Q);
  const float* ropetab = (const float*)(p.ws + OFF_ROPE);
  EPI_BEGIN(acc, m0, n0)
    const float rsc = srs[row - m0];
    const int h = col / 96, dd = col % 96;
    const int b = tok_b(row), j = tok_j(row);
    if (dd >= 64 && j >= CTXL) {
      float vp[8]; ld8f(_wb + _r * EST + (_cg ^ 1) * 8, vp);
      const int tl = j - CTXL, pos = ((dd - 64) < 16) ? (tl / GRID_W) : (tl % GRID_W);
      const bool lo = ((dd & 8) == 0);
#pragma unroll
      for (int k = 0; k < 8; ++k) {
        float c, sn; rope_cs(ropetab, pos, k, c, sn);
        v[k] = lo ? (v[k] * c - vp[k] * sn) : (v[k] * c + vp[k] * sn);
      }
    }
#pragma unroll
    for (int k = 0; k < 8; ++k) v[k] *= rsc;
    st8bf(Q + (((size_t)b * 4 + h) * TOK + j) * 96 + dd, v);
  EPI_END
}
DI void mlakv_tile(const Params& p, const LP& L, int t, char* smem) {
  const int MT = NTOK / 128;
  const int mt = t % MT, h = t / MT, m0 = mt * 128, n0 = h * 128;
  const bf16* P1 = (const bf16*)(p.ws + OFF_P1);
  float* srs = (float*)(smem + SRS_OFF);
  GA g = make_ga(P1 + C_CKV, P1W, (const bf16*)(L.we + WE_UKV), 128, 128, NTOK);
  f32x4 acc[4][4];
  gemm_main<4>(g, m0, n0, smem, acc);
  rowscale_128(P1, m0, C_CKV, 128, srs);
  __syncthreads();
  bf16* K = (bf16*)(p.ws + OFF_MIX + MX_K);
  bf16* VT = (bf16*)(p.ws + OFF_MIX + MX_VTM);
  const float* ropetab = (const float*)(p.ws + OFF_ROPE);
  {
    float* wb = (float*)smem + (tid_() >> 6) * (32 * EST);
    const int lane = tid_() & 63, w = tid_() >> 6, wr = w >> 1, wc = w & 1;
#pragma unroll
    for (int half = 0; half < 2; ++half) {
      if (half == 0) epi_stage<4, 0>(acc, wb); else epi_stage<4, 1>(acc, wb);
      if (wc == 0) {
#pragma unroll
        for (int it = 0; it < 4; ++it) {
          const int gI = it * 64 + lane, r = gI >> 3, cgp = gI & 7;
          const int row = m0 + wr * 64 + half * 32 + r;
          float v[8]; ld8f(wb + r * EST + cgp * 8, v);
          const float rsc = srs[row - m0];
#pragma unroll
          for (int k = 0; k < 8; ++k) v[k] *= rsc;
          st8bf(K + (((size_t)tok_b(row) * 4 + h) * TOK + tok_j(row)) * 96 + cgp * 8, v);
        }
      } else {
#pragma unroll
        for (int it = 0; it < 4; ++it) {
          const int r0 = it * 8, row0 = m0 + wr * 64 + half * 32 + r0;
          float v[8];
#pragma unroll
          for (int k = 0; k < 8; ++k) v[k] = wb[(r0 + k) * EST + lane] * srs[row0 + k - m0];
          st8bf(VT + (((size_t)tok_b(row0) * 4 + h) * 64 + lane) * TOK + tok_j(row0), v);
        }
      }
    }
  }
  for (int i = tid_(); i < 128 * 16; i += NTHREADS) {
    int r = i >> 4, q = i & 15;
    int row = m0 + r, b = tok_b(row), j = tok_j(row);
    int blk = q >> 3, i8 = q & 7;
    float x1 = bf2f(P1[(size_t)row * P1W + C_KR + blk * 16 + i8]), x2 = bf2f(P1[(size_t)row * P1W + C_KR + blk * 16 + i8 + 8]);
    float o1 = x1, o2 = x2;
    if (j >= CTXL) {
      int tl = j - CTXL, pos = blk == 0 ? (tl / GRID_W) : (tl % GRID_W);
      float c, s; rope_cs(ropetab, pos, i8, c, s);
      o1 = x1 * c - x2 * s; o2 = x2 * c + x1 * s;
    }
    bf16* kd = K + (((size_t)b * 4 + h) * TOK + j) * 96 + 64 + blk * 16 + i8;
    kd[0] = f2bf(o1); kd[8] = f2bf(o2);
  }
}
DI void navt_item(const Params& p, int it, char* smem) {
  bf16* s = (bf16*)smem;
  const bf16* P1 = (const bf16*)(p.ws + OFF_P1);
  bf16* VT = (bf16*)(p.ws + OFF_MIX + MX_VTN);
  const int tok0 = it * 64, tid = tid_();
  const int b = tok_b(tok0), j0 = tok_j(tok0);
  __syncthreads();
  for (int i = tid; i < 64 * 32; i += NTHREADS) {
    int r = i >> 5, c8 = i & 31;
    *(uint4*)(s + r * 264 + c8 * 8) = *(const uint4*)(P1 + (size_t)(tok0 + r) * P1W + C_NA + 512 + c8 * 8);
  }
  __syncthreads();
  for (int i = tid; i < 256 * 8; i += NTHREADS) {
    int ch = i >> 3, t8 = i & 7;
    unsigned w[4];
#pragma unroll
    for (int q = 0; q < 4; ++q) w[q] = (unsigned)s[(t8 * 8 + 2 * q) * 264 + ch] | ((unsigned)s[(t8 * 8 + 2 * q + 1) * 264 + ch] << 16);
    *(uint4*)(VT + ((size_t)b * 256 + ch) * TOK + j0 + t8 * 8) = make_uint4(w[0], w[1], w[2], w[3]);
  }
}
DI void m2conv_item(const Params& p, const LP& L, int it) {
  const bf16* P1 = (const bf16*)(p.ws + OFF_P1);
  bf16* XB = (bf16*)(p.ws + OFF_MIX + MX_XBC);
  const int tok0 = it * 32, j0 = tok_j(tok0);
  const int slo = (j0 < CTXL) ? 0 : CTXL, shi = (j0 < CTXL) ? CTXL : TOK;
  const int base = tok0 - j0;
  for (int c = tid_(); c < 768; c += NTHREADS) {
    const float w0 = p.in[I_M2CONVW][(L.l * 4 + 0) * 768 + c], w1 = p.in[I_M2CONVW][(L.l * 4 + 1) * 768 + c];
    const float w2 = p.in[I_M2CONVW][(L.l * 4 + 2) * 768 + c], w3 = p.in[I_M2CONVW][(L.l * 4 + 3) * 768 + c];
    const float bb = p.in[I_M2CONVB][L.l * 768 + c];
    auto ld = [&](int j) -> float { return (j >= slo && j < shi) ? bf2f(P1[(size_t)(base + j) * P1W + C_XBC + c]) : 0.f; };
    float xm2 = ld(j0 - 2), xm1 = ld(j0 - 1), x0 = ld(j0);
    for (int i = 0; i < 32; ++i) {
      float xp1 = ld(j0 + i + 1);
      float y = bb + w0 * xm2 + w1 * xm1 + w2 * x0 + w3 * xp1;
      XB[(size_t)(tok0 + i) * 768 + c] = f2bf(siluf_(y));
      xm2 = xm1; xm1 = x0; x0 = xp1;
    }
  }
}
constexpr int S5_MT = (MCH + 127) / 128;
DI void s5a_tile(const Params& p, const LP& L, int t, char* smem) {
  const int g = t / (S5_MT * 2), r = t % (S5_MT * 2), mt = r / 2, nt = r % 2;
  const int m0 = mt * 128, n0 = nt * 128;
  GA ga = make_ga((const bf16*)(p.ws + OFF_MIX + MX_US5) + (size_t)g * NTOK * 16, 256, (const bf16*)(L.s5 + S5_WA) + (size_t)g * 65536, 256, 256, MCH);
  f32x4 acc[4][4];
  gemm_main<4>(ga, m0, n0, smem, acc);
  float* HE = (float*)(p.ws + OFF_MIX + MX_HEND) + (size_t)g * MCH * 256;
  EPI_BEGIN(acc, m0, n0)
    if (row < MCH) st8f(HE + (size_t)row * 256 + col, v);
  EPI_END
}
DI void s5carry_item(const Params& p, const LP& L, int it) {
  const int w = it * 4 + (tid_() >> 6), lane = tid_() & 63;
  const int d = w / (16 * BATCH), g = (w / BATCH) & 15, b = w % BATCH;
  const float* lp = (const float*)(L.s5 + S5_LAMPOW) + ((size_t)((d * 16 + g) * 17 + 16) * 64 + lane) * 2;
  const float lre = lp[0], lim = lp[1];
  const float* HE = (const float*)(p.ws + OFF_MIX + MX_HEND) + ((size_t)g * MCH + (size_t)b * NCH) * 256 + d * 128;
  bf16* HI = (bf16*)(p.ws + OFF_MIX + MX_HIN) + ((size_t)g * MCH + (size_t)b * NCH) * 256 + d * 128;
  float cre = 0.f, cim = 0.f;
  for (int i = 0; i < NCH; ++i) {
    int ch = (d == 0) ? i : (i < NCC ? (NCC - 1 - i) : (NCH - 1 - (i - NCC)));
    HI[(size_t)ch * 256 + lane] = f2bf(cre); HI[(size_t)ch * 256 + 64 + lane] = f2bf(cim);
    float hre = HE[(size_t)ch * 256 + lane], him = HE[(size_t)ch * 256 + 64 + lane];
    float nre = lre * cre - lim * cim + hre, nim = lre * cim + lim * cre + him;
    cre = nre; cim = nim;
  }
}
DI void s5c_tile(const Params& p, const LP& L, int t, char* smem) {
  const int g = t / (S5_MT * 2), r = t % (S5_MT * 2), mt = r / 2, nt = r % 2;
  const int m0 = mt * 128, n0 = nt * 128;
  GA ga = make_ga((const bf16*)(p.ws + OFF_MIX + MX_US5) + (size_t)g * NTOK * 16, 256, (const bf16*)(L.s5 + S5_W2) + (size_t)g * 256 * 512, 512, 512, MCH);
  ga.A2 = (const bf16*)(p.ws + OFF_MIX + MX_HIN) + (size_t)g * MCH * 256; ga.lda2 = 256; ga.ksplit = 256;
  f32x4 acc[4][4];
  gemm_main<4>(ga, m0, n0, smem, acc);
  bf16* Z = (bf16*)(p.ws + OFF_MIX + MX_Z);
  EPI_BEGIN(acc, m0, n0)
#pragma unroll
    for (int k = 0; k < 8; ++k) v[k] = geluf_(v[k]);
    if (row < MCH) st8bf(Z + ((size_t)row * 16 + (col >> 4)) * 256 + g * 16 + (col & 15), v);
  EPI_END
}

DI float fmax_(float a, float b) { return a > b ? a : b; }
template <int DK>
struct AttnState {
  bf16x8 qf[DK / 16];
  f32x16 o0, o1;
  float m, l;
};
template <int DK>
DI void attn_init(AttnState<DK>& st, const bf16* qrow) {
  const int h = (tid_() & 63) >> 5;
#pragma unroll
  for (int ks = 0; ks < DK / 16; ++ks) st.qf[ks] = *(const bf16x8*)(qrow + ks * 16 + 8 * h);
#pragma unroll
  for (int i = 0; i < 16; ++i) { st.o0[i] = 0.f; st.o1[i] = 0.f; }
  st.m = -1e30f; st.l = 0.f;
}
template <int DK, class BiasF>
DI void attn_tile(AttnState<DK>& st, const bf16* krow, const bf16* vt, int vstride, float scale, BiasF biasf) {
  const int lane = tid_() & 63, h = lane >> 5, r = lane & 31;
  f32x16 s;
#pragma unroll
  for (int i = 0; i < 16; ++i) s[i] = 0.f;
#pragma unroll
  for (int ks = 0; ks < DK / 16; ++ks) {
    bf16x8 a = *(const bf16x8*)(krow + ks * 16 + 8 * h);
    s = __builtin_amdgcn_mfma_f32_32x32x16_bf16(a, st.qf[ks], s, 0, 0, 0);
  }
  float mx = -INFINITY;
#pragma unroll
  for (int i = 0; i < 16; ++i) {
    int kk = (i & 3) + 8 * (i >> 2) + 4 * h;
    float v = s[i] * scale + biasf(kk);
    s[i] = v; mx = fmax_(mx, v);
  }
  mx = fmax_(mx, __shfl_xor(mx, 32));
  const float mn = fmax_(st.m, mx);
  const float alpha = __expf(st.m - mn);
  st.m = mn;
  float ps = 0.f;
#pragma unroll
  for (int i = 0; i < 16; ++i) { float pv = __expf(s[i] - mn); s[i] = pv; ps += pv; }
  st.l = st.l * alpha + ps;
#pragma unroll
  for (int i = 0; i < 16; ++i) { st.o0[i] *= alpha; st.o1[i] *= alpha; }
#pragma unroll
  for (int sI = 0; sI < 2; ++sI) {
    bf16x8 pf;
#pragma unroll
    for (int j = 0; j < 8; ++j) pf[j] = (short)f2bf(s[8 * sI + j]);
    const bf16* v0 = vt + (size_t)r * vstride + 16 * sI + 4 * h;
    const bf16* v1 = vt + (size_t)(r + 32) * vstride + 16 * sI + 4 * h;
    uint2 a0 = *(const uint2*)v0, a1 = *(const uint2*)(v0 + 8);
    uint2 b0 = *(const uint2*)v1, b1 = *(const uint2*)(v1 + 8);
    bf16x8 va, vb;
    { unsigned w[4] = {a0.x, a0.y, a1.x, a1.y};
#pragma unroll
      for (int q = 0; q < 4; ++q) { va[2 * q] = (short)(w[q] & 0xffff); va[2 * q + 1] = (short)(w[q] >> 16); } }
    { unsigned w[4] = {b0.x, b0.y, b1.x, b1.y};
#pragma unroll
      for (int q = 0; q < 4; ++q) { vb[2 * q] = (short)(w[q] & 0xffff); vb[2 * q + 1] = (short)(w[q] >> 16); } }
    st.o0 = __builtin_amdgcn_mfma_f32_32x32x16_bf16(va, pf, st.o0, 0, 0, 0);
    st.o1 = __builtin_amdgcn_mfma_f32_32x32x16_bf16(vb, pf, st.o1, 0, 0, 0);
  }
}
template <int DK>
DI void attn_finish(AttnState<DK>& st, bf16* orow) {
  const int h = (tid_() & 63) >> 5;
  float lt = st.l + __shfl_xor(st.l, 32);
  float inv = 1.0f / lt;
#pragma unroll
  for (int gI = 0; gI < 4; ++gI) {
    int d0 = 8 * gI + 4 * h;
    *(uint2*)(orow + d0) = make_uint2(pack2(st.o0[4 * gI] * inv, st.o0[4 * gI + 1] * inv), pack2(st.o0[4 * gI + 2] * inv, st.o0[4 * gI + 3] * inv));
    *(uint2*)(orow + 32 + d0) = make_uint2(pack2(st.o1[4 * gI] * inv, st.o1[4 * gI + 1] * inv), pack2(st.o1[4 * gI + 2] * inv, st.o1[4 * gI + 3] * inv));
  }
}
struct NoBias { DI float operator()(int) const { return 0.f; } };
struct NaBias { const float* rpb_row; int qc, kc0, cs; DI float operator()(int kk) const { int kc = kc0 + kk; return (kc >= cs && kc < cs + WIN_C) ? rpb_row[kc - qc + (WIN_C - 1)] : -INFINITY; } };

DI void mla_attn_item(const Params& p, int it, bool ctxq) {
  const int nqb = ctxq ? (CTXL + 127) / 128 : SEQ / 128;
  const int b = it / (4 * nqb), h = (it / nqb) & 3, qb = it % nqb;
  const int lane = tid_() & 63, wid = tid_() >> 6;
  const int nq = ctxq ? CTXL : SEQ, q0 = qb * 128 + wid * 32;
  if (q0 >= nq) return;
  const int jq = (ctxq ? 0 : CTXL) + q0 + (lane & 31);
  const bf16* Q = (const bf16*)(p.ws + OFF_MIX + MX_Q) + ((size_t)b * 4 + h) * TOK * 96;
  const bf16* K = (const bf16*)(p.ws + OFF_MIX + MX_K) + ((size_t)b * 4 + h) * TOK * 96;
  const bf16* VT = (const bf16*)(p.ws + OFF_MIX + MX_VTM) + ((size_t)b * 4 + h) * 64 * TOK;
  AttnState<96> st;
  attn_init<96>(st, Q + (size_t)jq * 96);
  const float scale = 0.10206207261596577f;
  const int nk = ctxq ? CTXL : TOK;
  for (int k0 = 0; k0 < nk; k0 += 32)
    attn_tile<96>(st, K + (size_t)(k0 + (lane & 31)) * 96, VT + k0, TOK, scale, NoBias());
  bf16* O = (bf16*)(p.ws + OFF_O) + ((size_t)b * TOK + jq) * 1024 + 0 * 256 + h * 64;
  attn_finish<96>(st, O);
}
DI void na_attn_item(const Params& p, const LP& L, int it, bool ctxq) {
  const int nqb = ctxq ? (CTXL + 127) / 128 : SEQ / 128;
  const int b = it / (4 * nqb), h = (it / nqb) & 3, qb = it % nqb;
  const int lane = tid_() & 63, wid = tid_() >> 6;
  const int nq = ctxq ? CTXL : SEQ, q0 = qb * 128 + wid * 32;
  if (q0 >= nq) return;
  const int jq = (ctxq ? 0 : CTXL) + q0 + (lane & 31);
  const bf16* P1 = (const bf16*)(p.ws + OFF_P1) + (size_t)b * TOK * P1W;
  const bf16* VT = (const bf16*)(p.ws + OFF_MIX + MX_VTN) + ((size_t)b * 4 + h) * 64 * TOK;
  AttnState<64> st;
  attn_init<64>(st, P1 + (size_t)jq * P1W + C_NA + h * 64);
  const float scale = 0.125f;
  const bf16* Kb = P1 + C_NA + 256 + h * 64;
  if (!ctxq) {
    const int tl = q0 + (lane & 31), r = tl / GRID_W, qc = tl % GRID_W;
    int rs = r - WIN_R / 2; rs = rs < 0 ? 0 : (rs > ROWS - WIN_R ? ROWS - WIN_R : rs);
    int cs = qc - WIN_C / 2; cs = cs < 0 ? 0 : (cs > GRID_W - WIN_C ? GRID_W - WIN_C : cs);
    const float* rpb = p.in[I_RPB] + ((size_t)L.l * 4 + h) * 15 * 31;
    for (int wr = 0; wr < WIN_R; ++wr) {
      const int kr = rs + wr;
      for (int ct = 0; ct < GRID_W / 32; ++ct) {
        const int k0 = CTXL + kr * GRID_W + ct * 32;
        NaBias bf; bf.rpb_row = rpb + (kr - r + 7) * 31; bf.qc = qc; bf.kc0 = ct * 32; bf.cs = cs;
        attn_tile<64>(st, Kb + (size_t)(k0 + (lane & 31)) * P1W, VT + k0, TOK, scale, bf);
      }
    }
  }
  for (int k0 = 0; k0 < CTXL; k0 += 32)
    attn_tile<64>(st, Kb + (size_t)(k0 + (lane & 31)) * P1W, VT + k0, TOK, scale, NoBias());
  bf16* O = (bf16*)(p.ws + OFF_O) + ((size_t)b * TOK + jq) * 1024 + 1 * 256 + h * 64;
  attn_finish<64>(st, O);
}

DI void m2scan_item(const Params& p, const LP& L, int it, char* smem) {
  const int b = it / 8, hd = (it >> 1) & 3, dir = it & 1, grp = hd >> 1;
  const int tid = tid_(), pp = tid >> 2, nq = tid & 3;
  float* sB = (float*)smem;
  float* sC = sB + 32 * 128;
  float* sX = sC + 32 * 128;
  float* sD = sX + 32 * 64;
  const bf16* XB = (const bf16*)(p.ws + OFF_MIX + MX_XBC) + (size_t)b * TOK * 768;
  const float* DT = (const float*)(p.ws + OFF_DT) + (size_t)b * TOK * 8;
  float* YM = (float*)(p.ws + OFF_HA) + ((size_t)dir * NTOK + (size_t)b * TOK) * 256;
  const float a = -expf(p.in[I_M2ALOG][(L.l * 2 + dir) * 4 + hd]);
  float hst[32];
#pragma unroll
  for (int n = 0; n < 32; ++n) hst[n] = 0.f;
  for (int c0 = 0; c0 < TOK; c0 += 32) {
    __syncthreads();
    for (int i = tid; i < 32 * 128; i += NTHREADS) {
      int s = i >> 7, n = i & 127, sq = c0 + s;
      int j = (dir == 0) ? sq : (sq < CTXL ? (CTXL - 1 - sq) : (TOK - 1 - (sq - CTXL)));
      sB[i] = bf2f(XB[(size_t)j * 768 + 256 + grp * 128 + n]);
      sC[i] = bf2f(XB[(size_t)j * 768 + 512 + grp * 128 + n]);
    }
    for (int i = tid; i < 32 * 64; i += NTHREADS) {
      int s = i >> 6, q = i & 63, sq = c0 + s;
      int j = (dir == 0) ? sq : (sq < CTXL ? (CTXL - 1 - sq) : (TOK - 1 - (sq - CTXL)));
      sX[i] = bf2f(XB[(size_t)j * 768 + hd * 64 + q]);
    }
    if (tid < 32) {
      int sq = c0 + tid;
      int j = (dir == 0) ? sq : (sq < CTXL ? (CTXL - 1 - sq) : (TOK - 1 - (sq - CTXL)));
      sD[tid] = DT[(size_t)j * 8 + dir * 4 + hd];
    }
    __syncthreads();
    for (int s = 0; s < 32; ++s) {
      const float dt = sD[s], dec = __expf(dt * a), coef = dt * sX[s * 64 + pp];
      const float* bp = sB + s * 128 + nq * 32;
      const float* cp = sC + s * 128 + nq * 32;
      float y = 0.f;
#pragma unroll
      for (int n = 0; n < 32; n += 4) {
        float4 bv = *(const float4*)(bp + n), cv = *(const float4*)(cp + n);
        hst[n] = hst[n] * dec + coef * bv.x; y += cv.x * hst[n];
        hst[n + 1] = hst[n + 1] * dec + coef * bv.y; y += cv.y * hst[n + 1];
        hst[n + 2] = hst[n + 2] * dec + coef * bv.z; y += cv.z * hst[n + 2];
        hst[n + 3] = hst[n + 3] * dec + coef * bv.w; y += cv.w * hst[n + 3];
      }
      y += __shfl_xor(y, 1); y += __shfl_xor(y, 2);
      if (nq == 0) {
        int sq = c0 + s;
        int j = (dir == 0) ? sq : (sq < CTXL ? (CTXL - 1 - sq) : (TOK - 1 - (sq - CTXL)));
        YM[(size_t)j * 256 + hd * 64 + pp] = y;
      }
    }
  }
}
DI void m2gate_item(const Params& p, const LP& L, int it) {
  const int tok = it * 4 + (tid_() >> 6), lane = tid_() & 63;
  const float* Y0 = (const float*)(p.ws + OFF_HA) + (size_t)tok * 256;
  const float* Y1 = Y0 + (size_t)NTOK * 256;
  const bf16* XB = (const bf16*)(p.ws + OFF_MIX + MX_XBC) + (size_t)tok * 768;
  const bf16* P1 = (const bf16*)(p.ws + OFF_P1) + (size_t)tok * P1W + C_Z;
  const int c = lane * 4, hd = c >> 6;
  const float dsk = p.in[I_M2D][L.l * 4 + hd];
  float4 y0 = *(const float4*)(Y0 + c), y1 = *(const float4*)(Y1 + c);
  uint2 xw = *(const uint2*)(XB + c), zw = *(const uint2*)(P1 + c);
  float xs[4] = {__uint_as_float(xw.x << 16), __uint_as_float(xw.x & 0xffff0000u), __uint_as_float(xw.y << 16), __uint_as_float(xw.y & 0xffff0000u)};
  float zs[4] = {__uint_as_float(zw.x << 16), __uint_as_float(zw.x & 0xffff0000u), __uint_as_float(zw.y << 16), __uint_as_float(zw.y & 0xffff0000u)};
  float ys[4] = {y0.x + y1.x, y0.y + y1.y, y0.z + y1.z, y0.w + y1.w};
  float v[4], ss = 0.f;
#pragma unroll
  for (int i = 0; i < 4; ++i) { v[i] = (ys[i] + dsk * xs[i]) * siluf_(zs[i]); ss += v[i] * v[i]; }
  ss = wave_sum(ss);
  const float rs = rsqrtf(ss * (1.f / 256.f) + EPS);
  float4 gn = *(const float4*)(p.in[I_M2GNORM] + L.l * 256 + c);
  bf16* O = (bf16*)(p.ws + OFF_O) + (size_t)tok * 1024 + 768 + c;
  *(uint2*)O = make_uint2(pack2(v[0] * rs * gn.x, v[1] * rs * gn.y), pack2(v[2] * rs * gn.z, v[3] * rs * gn.w));
}
DI void glu_tile(const Params& p, const LP& L, int t, char* smem) {
  const int MT = NTOK / 128;
  const int mt = t % MT, nt = t / MT, m0 = mt * 128, n0 = nt * 128;
  const bf16* Z = (const bf16*)(p.ws + OFF_MIX + MX_Z);
  GA g = make_ga(Z, 256, (const bf16*)(L.we + WE_GLU), 256, 256, NTOK);
  f32x4 acc[4][4];
  gemm_main<4>(g, m0, n0, smem, acc);
  bf16* O = (bf16*)(p.ws + OFF_O);
  const float* bg = p.in[I_S5BGLU] + L.l * 256;
  EPI_BEGIN(acc, m0, n0)
    float z[8]; ld8bf(Z + (size_t)row * 256 + col, z);
#pragma unroll
    for (int k = 0; k < 8; ++k) v[k] = z[k] * sigmoidf_(v[k] + bg[col + k]);
    st8bf(O + (size_t)row * 1024 + 512 + col, v);
  EPI_END
}
DI void merge_tile(const Params& p, const LP& L, int t, char* smem) {
  const int MT = mtiles(L.last);
  const int mt = t % MT, nt = t / MT, m0 = mtile_row0(mt, L.last), n0 = nt * 64;
  const bf16* O = (const bf16*)(p.ws + OFF_O);
  const bf16* PG = (const bf16*)(p.ws + OFF_PG);
  float tot[2][2][8];
#pragma unroll
  for (int a = 0; a < 2; ++a)
#pragma unroll
    for (int b = 0; b < 2; ++b)
#pragma unroll
      for (int k = 0; k < 8; ++k) tot[a][b][k] = 0.f;
  for (int j = 0; j < 4; ++j) {
    GA g = make_ga(O + j * 256, 1024, (const bf16*)(L.we + WE_WB) + (size_t)j * 1024 * 256, 256, 256, NTOK);
    f32x4 acc[4][2];
    gemm_main<2>(g, m0, n0, smem, acc);
    EPI_BEGIN_NT(2, acc, m0, n0)
      float gt[8]; ld8bf(PG + (size_t)row * 4096 + j * 1024 + col, gt);
#pragma unroll
      for (int k = 0; k < 8; ++k) tot[_half][_it][k] += gt[k] * v[k];
    EPI_END
  }
  bf16* Y = (bf16*)(p.ws + OFF_P1);
  {
    const int lane = tid_() & 63, w = tid_() >> 6, wr = w >> 1, wc = w & 1;
#pragma unroll
    for (int half = 0; half < 2; ++half)
#pragma unroll
      for (int it = 0; it < 2; ++it) {
        const int gI = it * 64 + lane, r = gI >> 2, cgp = gI & 3;
        const int row = m0 + wr * 64 + half * 32 + r, col = n0 + wc * 32 + cgp * 8;
        st8bf(Y + (size_t)row * 1024 + col, tot[half][it]);
      }
  }
}
DI void outproj_tile(const Params& p, const LP& L, int t, char* smem) {
  const int MT = mtiles(L.last);
  const int mt = t % MT, nt = t / MT, m0 = mtile_row0(mt, L.last), n0 = nt * 128;
  GA g = make_ga((const bf16*)(p.ws + OFF_P1), 1024, (const bf16*)(L.we + WE_WOUT), 1024, 1024, NTOK);
  f32x4 acc[4][4];
  gemm_main<4>(g, m0, n0, smem, acc);
  float* Y2 = (float*)(p.ws + OFF_HA);
  EPI_BEGIN(acc, m0, n0)
    st8f(Y2 + (size_t)row * 1024 + col, v);
  EPI_END
}
DI int post_ntok(bool latonly) { return latonly ? BATCH * SEQ : NTOK; }
DI int post_tok(int i, bool latonly) { return latonly ? ((i / SEQ) * TOK + CTXL + (i % SEQ)) : i; }

DI void post_item(const Params& p, const LP& L, int it) {
  const int tok = post_tok(it * 4 + (tid_() >> 6), L.last), lane = tid_() & 63;
  float* X = (float*)(p.ws + OFF_X) + (size_t)tok * 1024;
  const float* Y2 = (const float*)(p.ws + OFF_HA) + (size_t)tok * 1024;
  const float* mod = L.mod + (size_t)tok_modrow(tok) * 6144;
  float yv[16], xv[16], h[16];
  float ss = 0.f;
#pragma unroll
  for (int i = 0; i < 4; ++i) {
    float4 v = *(const float4*)(Y2 + lane * 4 + i * 256);
    yv[i * 4] = v.x; yv[i * 4 + 1] = v.y; yv[i * 4 + 2] = v.z; yv[i * 4 + 3] = v.w;
    ss += v.x * v.x + v.y * v.y + v.z * v.z + v.w * v.w;
  }
  ss = wave_sum(ss);
  const float rs = rsqrtf(ss * (1.f / 1024.f) + EPS);
  const float* gpm = p.in[I_GPOSTMIX] + L.l * 1024;
#pragma unroll
  for (int i = 0; i < 4; ++i) {
    int c = lane * 4 + i * 256;
    float4 xo = *(const float4*)(X + c), gv = *(const float4*)(gpm + c), gt = *(const float4*)(mod + 2048 + c);
    xo.x += gt.x * yv[i * 4] * rs * gv.x; xo.y += gt.y * yv[i * 4 + 1] * rs * gv.y; xo.z += gt.z * yv[i * 4 + 2] * rs * gv.z; xo.w += gt.w * yv[i * 4 + 3] * rs * gv.w;
    *(float4*)(X + c) = xo;
    xv[i * 4] = xo.x; xv[i * 4 + 1] = xo.y; xv[i * 4 + 2] = xo.z; xv[i * 4 + 3] = xo.w;
  }
  bf16* H2 = (bf16*)(p.ws + OFF_P1) + (size_t)NTOK * 1024 + (size_t)tok * 1024;
  normmod_row(xv, p.in[I_GPREFFN] + L.l * 1024, mod + 3072, mod + 4096, H2, h);
  const float* wr = p.in[I_WROUTER] + (size_t)L.l * 1024 * 16;
  float lg[16];
#pragma unroll
  for (int e = 0; e < 16; ++e) lg[e] = 0.f;
#pragma unroll
  for (int i = 0; i < 16; ++i) {
    int k = lane * 4 + (i >> 2) * 256 + (i & 3);
    const float4* w4 = (const float4*)(wr + (size_t)k * 16);
    float4 a = w4[0], b4 = w4[1], c4 = w4[2], d4 = w4[3];
    float hv = h[i];
    lg[0] += hv * a.x; lg[1] += hv * a.y; lg[2] += hv * a.z; lg[3] += hv * a.w;
    lg[4] += hv * b4.x; lg[5] += hv * b4.y; lg[6] += hv * b4.z; lg[7] += hv * b4.w;
    lg[8] += hv * c4.x; lg[9] += hv * c4.y; lg[10] += hv * c4.z; lg[11] += hv * c4.w;
    lg[12] += hv * d4.x; lg[13] += hv * d4.y; lg[14] += hv * d4.z; lg[15] += hv * d4.w;
  }
  float mx = -INFINITY;
#pragma unroll
  for (int e = 0; e < 16; ++e) { lg[e] = wave_sum(lg[e]); mx = fmax_(mx, lg[e]); }
  float se = 0.f;
#pragma unroll
  for (int e = 0; e < 16; ++e) { lg[e] = expf(lg[e] - mx); se += lg[e]; }
  if (lane < 16) {
    float v = 0.f;
#pragma unroll
    for (int e = 0; e < 16; ++e) if (e == lane) v = lg[e];
    ((float*)(p.ws + OFF_AFF))[(size_t)tok * 16 + lane] = v / se;
  }
}
DI void route_item(const Params& p, const LP& L, int it, char* smem) {
  const int nstream = L.last ? 1 : 2;
  const int b = it / (16 * nstream), e = (it / nstream) & 15, ctxs = (nstream == 2) ? (it & 1) : 0;
  const int T = ctxs ? CTXL : SEQ, cap = ctxs ? CAP_C : CAP_L;
  const int tok0 = b * TOK + (ctxs ? 0 : CTXL);
  const int slot0 = ctxs ? (BATCH * CAP_L + b * CAP_C) : (b * CAP_L);
  float* sa = (float*)smem;
  const float* AFF = (const float*)(p.ws + OFF_AFF);
  int* SEL = (int*)(p.ws + OFF_SEL);
  int* IDX = (int*)(p.ws + OFF_IDX) + (size_t)e * ESLOTS;
  float* GW = (float*)(p.ws + OFF_GW) + (size_t)e * ESLOTS;
  const int tid = tid_();
  __syncthreads();
  for (int i = tid; i < T; i += NTHREADS) sa[i] = AFF[(size_t)(tok0 + i) * 16 + e];
  __syncthreads();
  for (int i = tid; i < T; i += NTHREADS) {
    const float a = sa[i];
    int rank = 0;
    for (int j = 0; j < T; ++j) { float v = sa[j]; rank += (v > a || (v == a && j < i)) ? 1 : 0; }
    if (rank < cap) { IDX[slot0 + rank] = tok0 + i; GW[slot0 + rank] = a; SEL[(size_t)(tok0 + i) * 16 + e] = slot0 + rank; }
    else SEL[(size_t)(tok0 + i) * 16 + e] = -1;
  }
}
DI void moe1_tile(const Params& p, const LP& L, int t, char* smem) {
  const int nslots = L.last ? ESLOTS_L : ESLOTS;
  const int MT = (nslots + 127) / 128;
  const int e = t / (MT * 16), r = t % (MT * 16), mt = r % MT, nt = r / MT;
  const int m0 = mt * 128, n0 = nt * 128;
  GA g = make_ga((const bf16*)(p.ws + OFF_P1) + (size_t)NTOK * 1024, 1024, (const bf16*)(p.ws + OFF_MIX + WX_GU) + (size_t)e * 2048 * 1024, 1024, 1024, nslots);
  g.ridx = (const int*)(p.ws + OFF_IDX) + (size_t)e * ESLOTS;
  f32x4 acc[4][4];
  gemm_main<4>(g, m0, n0, smem, acc);
  bf16* ACT = (bf16*)(p.ws + OFF_PG) + (size_t)e * ESLOTS * 1024;
  {
    float* wb = (float*)smem + (tid_() >> 6) * (32 * EST);
    const int lane = tid_() & 63, w = tid_() >> 6, wr = w >> 1, wc = w & 1;
#pragma unroll
    for (int half = 0; half < 2; ++half) {
      if (half == 0) epi_stage<4, 0>(acc, wb); else epi_stage<4, 1>(acc, wb);
#pragma unroll
      for (int it = 0; it < 2; ++it) {
        const int gI = it * 64 + lane, r = gI >> 2, cgp = gI & 3;
        const int row = m0 + wr * 64 + half * 32 + r;
        float gt[8], up[8];
        ld8f(wb + r * EST + cgp * 8, gt); ld8f(wb + r * EST + 32 + cgp * 8, up);
#pragma unroll
        for (int k = 0; k < 8; ++k) gt[k] = siluf_(gt[k]) * up[k];
        if (row < nslots) st8bf(ACT + (size_t)row * 1024 + nt * 64 + wc * 32 + cgp * 8, gt);
      }
    }
  }
}
DI void moe2_tile(const Params& p, const LP& L, int t, char* smem) {
  const int nslots = L.last ? ESLOTS_L : ESLOTS;
  const int MT = (nslots + 127) / 128;
  const int e = t / (MT * 8), r = t % (MT * 8), mt = r % MT, nt = r / MT;
  const int m0 = mt * 128, n0 = nt * 128;
  GA g = make_ga((const bf16*)(p.ws + OFF_PG) + (size_t)e * ESLOTS * 1024, 1024, (const bf16*)(p.ws + OFF_MIX + WX_DN) + (size_t)e * 1024 * 1024, 1024, 1024, nslots);
  f32x4 acc[4][4];
  gemm_main<4>(g, m0, n0, smem, acc);
  bf16* YS = (bf16*)(p.ws + OFF_PG) + (size_t)NE * ESLOTS * 1024 + (size_t)e * ESLOTS * 1024;
  const float* GW = (const float*)(p.ws + OFF_GW) + (size_t)e * ESLOTS;
  EPI_BEGIN(acc, m0, n0)
    const float gw = (row < nslots) ? GW[row] : 0.f;
#pragma unroll
    for (int k = 0; k < 8; ++k) v[k] *= gw;
    if (row < nslots) st8bf(YS + (size_t)row * 1024 + col, v);
  EPI_END
}
DI void comb_item(const Params& p, const LP& L, int it) {
  const int tok = post_tok(it * 4 + (tid_() >> 6), L.last), lane = tid_() & 63;
  float* X = (float*)(p.ws + OFF_X) + (size_t)tok * 1024;
  const int* SEL = (const int*)(p.ws + OFF_SEL) + (size_t)tok * 16;
  const bf16* YS = (const bf16*)(p.ws + OFF_PG) + (size_t)NE * ESLOTS * 1024;
  const float* mod = L.mod + (size_t)tok_modrow(tok) * 6144;
  float s[16];
#pragma unroll
  for (int i = 0; i < 16; ++i) s[i] = 0.f;
  for (int e = 0; e < 16; ++e) {
    int sl = SEL[e];
    if (sl >= 0) {
      const bf16* yr = YS + ((size_t)e * ESLOTS + sl) * 1024;
#pragma unroll
      for (int i = 0; i < 4; ++i) {
        uint2 w = *(const uint2*)(yr + lane * 4 + i * 256);
        s[i * 4] += __uint_as_float(w.x << 16); s[i * 4 + 1] += __uint_as_float(w.x & 0xffff0000u);
        s[i * 4 + 2] += __uint_as_float(w.y << 16); s[i * 4 + 3] += __uint_as_float(w.y & 0xffff0000u);
      }
    }
  }
  float ss = 0.f;
#pragma unroll
  for (int i = 0; i < 16; ++i) ss += s[i] * s[i];
  ss = wave_sum(ss);
  const float rs = rsqrtf(ss * (1.f / 1024.f) + EPS);
  const float* gpf = p.in[I_GPOSTFFN] + L.l * 1024;
  float xv[16], h[16];
  float* dst = X;
  if (L.last) { const int b = tok_b(tok), j = tok_j(tok); dst = p.out + ((size_t)b * SEQ + (j - CTXL)) * 1024; }
#pragma unroll
  for (int i = 0; i < 4; ++i) {
    int c = lane * 4 + i * 256;
    float4 xo = *(const float4*)(X + c), gv = *(const float4*)(gpf + c), gt = *(const float4*)(mod + 5120 + c);
    xo.x += gt.x * s[i * 4] * rs * gv.x; xo.y += gt.y * s[i * 4 + 1] * rs * gv.y; xo.z += gt.z * s[i * 4 + 2] * rs * gv.z; xo.w += gt.w * s[i * 4 + 3] * rs * gv.w;
    *(float4*)(dst + c) = xo;
    xv[i * 4] = xo.x; xv[i * 4 + 1] = xo.y; xv[i * 4 + 2] = xo.z; xv[i * 4 + 3] = xo.w;
  }
  if (!L.last) {
    const float* mod1 = (const float*)(p.ws + OFF_MOD) + ((size_t)(L.l + 1) * NB1 + tok_modrow(tok)) * 6144;
    normmod_row(xv, p.in[I_GPREMIX] + (L.l + 1) * 1024, mod1, mod1 + 1024, (bf16*)(p.ws + OFF_HA) + (size_t)tok * 1024, h);
  }
}

enum { PH_PREP0 = 0, PH_PREP1, PH_L0 };
enum { LP_INPROJ = 0, LP_TOKPREP, LP_MIX1, LP_MIX2, LP_GLU, LP_MERGE, LP_OUT, LP_POST, LP_ROUTE, LP_MOE1, LP_MOE2, LP_COMB, LP_COUNT };
constexpr int NPHASES = PH_L0 + DEPTH * LP_COUNT;


DI void run_phase(const Params& p, int ph, char* smem) {
  const int G = gridDim.x;
  int start = blockIdx.x;
  auto seg = [&](int n, auto&& fn) {
    for (; start < n; start += G) fn(start);
    start -= n;
  };
#ifdef ONLY_PREP
  if (ph >= PH_L0) return;
#endif
  if (ph == PH_PREP0) {
    seg(DEPTH * 96, [&](int it) { mod_item(p, it, smem); });
    seg(DEPTH * 32, [&](int it) { s5_tab_item(p, it, smem); });
    seg(1, [&](int) { rope_tab_item(p); });
    seg(DEPTH * CT_EARLY, [&](int it) { conv_early_item(p, it / CT_EARLY, it % CT_EARLY, smem); });
    return;
  }
  if (ph == PH_PREP1) {
    seg(DEPTH * 64, [&](int it) { s5_mat_item(p, it); });
    seg(NTOK / 4, [&](int it) { prep_row_item(p, it); });
    return;
  }
#ifdef ONLY_LPH
  if (ph < PH_L0) return;
#endif
  const int l = (ph - PH_L0) / LP_COUNT;
#ifdef ONLY_LPH
  const int lph = ONLY_LPH;
#else
  const int lph = (ph - PH_L0) % LP_COUNT;
#endif
  const LP L = make_lp(p, l);
  switch (lph) {
    case LP_INPROJ:
      seg((NTOK / 128) * (N_INP / 128), [&](int it) { inproj_tile(p, L, it, smem); });
      break;
    case LP_TOKPREP:
      seg(16 * S5_MT * 2, [&](int it) { s5a_tile(p, L, it, smem); });
      seg((NTOK / 128) * 3, [&](int it) { mlaq_tile(p, L, it, smem); });
      seg((NTOK / 128) * 4, [&](int it) { mlakv_tile(p, L, it, smem); });
      seg(NTOK / 64, [&](int it) { navt_item(p, it, smem); });
      seg(NTOK / 32, [&](int it) { m2conv_item(p, L, it); });
      break;
    case LP_MIX1:
      seg(BATCH * 8, [&](int it) { m2scan_item(p, L, it, smem); });
      seg(2 * 16 * BATCH / 4, [&](int it) { s5carry_item(p, L, it); });
      seg(BATCH * 4 * (SEQ / 128), [&](int it) { mla_attn_item(p, it, false); });
      seg(BATCH * 4 * (SEQ / 128), [&](int it) { na_attn_item(p, L, it, false); });
      if (!L.last) {
        seg(BATCH * 4 * ((CTXL + 127) / 128), [&](int it) { mla_attn_item(p, it, true); });
        seg(BATCH * 4 * ((CTXL + 127) / 128), [&](int it) { na_attn_item(p, L, it, true); });
      }
      break;
    case LP_MIX2:
      seg(16 * S5_MT * 2, [&](int it) { s5c_tile(p, L, it, smem); });
      seg(NTOK / 4, [&](int it) { m2gate_item(p, L, it); });
      break;
    case LP_GLU:
      seg((NTOK / 128) * 2, [&](int it) { glu_tile(p, L, it, smem); });
      break;
    case LP_MERGE:
      seg(mtiles(L.last) * 16, [&](int it) { merge_tile(p, L, it, smem); });
      break;
    case LP_OUT:
      seg(mtiles(L.last) * 8, [&](int it) { outproj_tile(p, L, it, smem); });
      break;
    case LP_POST:
      seg(CT_EXP, [&](int it) { conv_expert_item(p, l, it, smem); });
      seg(post_ntok(L.last) / 4, [&](int it) { post_item(p, L, it); });
      break;
    case LP_ROUTE:
      seg(BATCH * 16 * (L.last ? 1 : 2), [&](int it) { route_item(p, L, it, smem); });
      break;
    case LP_MOE1:
      seg(NE * (((L.last ? ESLOTS_L : ESLOTS) + 127) / 128) * 16, [&](int it) { moe1_tile(p, L, it, smem); });
      break;
    case LP_MOE2:
      seg(NE * (((L.last ? ESLOTS_L : ESLOTS) + 127) / 128) * 8, [&](int it) { moe2_tile(p, L, it, smem); });
      break;
    case LP_COMB:
      seg(post_ntok(L.last) / 4, [&](int it) { comb_item(p, L, it); });
      break;
  }
}

__global__ void __launch_bounds__(NTHREADS, 2) mega_kernel(Params p) {
#ifdef EMU
  char* smem = emu_cur_f->blk->smem;
#else
  __shared__ __attribute__((aligned(16))) char smem[SMEM_BYTES];
#endif
  for (int ph = p.phase_lo; ph < p.phase_hi; ++ph) {
    run_phase(p, ph, smem);
    if (ph + 1 < p.phase_hi) grid_sync_();
  }
}

#ifndef EMU
extern "C" void kernel_launch(void* const* d_in, const int* in_sizes, int n_in, void* d_out, int out_size, void* d_ws, size_t ws_size,
                              hipStream_t stream) {
  static int grid_blocks = 0;
  if (!grid_blocks) {
    int dev = 0, cus = 0, per_cu = 0;
    hipGetDevice(&dev);
    hipDeviceGetAttribute(&cus, hipDeviceAttributeMultiprocessorCount, dev);
    hipOccupancyMaxActiveBlocksPerMultiprocessor(&per_cu, mega_kernel, NTHREADS, 0);
    if (per_cu > 2) per_cu = 2;
    if (per_cu < 1) per_cu = 1;
    grid_blocks = cus * per_cu;
    if (ws_size < WS_TOTAL) fprintf(stderr, "workspace too small: %zu < %zu\n", ws_size, (size_t)WS_TOTAL);
  }
  Params p{};
  for (int i = 0; i < N_INPUTS; ++i) p.in[i] = (const float*)d_in[i];
  p.out = (float*)d_out;
  p.ws = (char*)d_ws;
#if MK_MULTI
  for (int ph = 0; ph < NPHASES; ++ph) {
    p.phase_lo = ph; p.phase_hi = ph + 1;
    hipLaunchKernelGGL(mega_kernel, dim3(grid_blocks), dim3(NTHREADS), 0, stream, p);
  }
#else
  p.phase_lo = 0; p.phase_hi = NPHASES;
  void* args[] = {&p};
  hipError_t e = hipLaunchCooperativeKernel((void*)mega_kernel, dim3(grid_blocks), dim3(NTHREADS), args, 0, stream);
  if (e != hipSuccess) fprintf(stderr, "cooperative launch failed: %s (grid %d)\n", hipGetErrorString(e), grid_blocks);
#endif
}
#endif
```

```cpp
#ifdef EMU
#include "emu.h"
#else
#include <hip/hip_runtime.h>
#include <hip/hip_cooperative_groups.h>
#include <cstdio>
namespace cg = cooperative_groups;
using bf16x8 = __attribute__((ext_vector_type(8))) short;
using f32x4 = __attribute__((ext_vector_type(4))) float;
using f32x16 = __attribute__((ext_vector_type(16))) float;
#endif
using u32x4 = __attribute__((ext_vector_type(4))) unsigned;
#ifndef MK_MULTI
#define MK_MULTI 0
#endif

#define DI __device__ __forceinline__
typedef unsigned short bf16;

#ifdef EMU_SMALL
constexpr int BATCH = 2, SEQ = 512, CTXL = 64, GRID_W = 32;
#else
constexpr int BATCH = 8, SEQ = 2048, CTXL = 256, GRID_W = 64;
#endif
constexpr int D = 1024, DEPTH = 2;
constexpr int TOK = CTXL + SEQ, NTOK = BATCH * TOK;
constexpr int ROWS = SEQ / GRID_W;
constexpr int WIN_R = (ROWS < 8 ? ROWS : 8), WIN_C = 16;
constexpr int N_IN = 6568, N_INP = 6656;
constexpr int C_CQ = 0, C_CKV = 256, C_KR = 384, C_NA = 416, C_S5 = 1184, C_Z = 1440, C_XBC = 1696, C_DT = 2464, C_GATE = 2472;
constexpr int P1W = 2480;
constexpr int NCH = TOK / 16, NCC = CTXL / 16, MCH = BATCH * NCH;
constexpr int NE = 16;
constexpr int CAP_L = 2 * SEQ / NE, CAP_C = 2 * CTXL / NE;
constexpr int ESLOTS = BATCH * (CAP_L + CAP_C), ESLOTS_L = BATCH * CAP_L;
constexpr int NB1 = BATCH + 1;
constexpr float EPS = 1e-6f;
constexpr int SMEM_BYTES = 131072;
constexpr int NTHREADS = 512, NWAVES = NTHREADS / 64;

enum { I_X = 0, I_C, I_CTX, I_CCTX, I_WADA, I_BADA, I_GPREMIX, I_GPOSTMIX, I_GPREFFN, I_GPOSTFFN, I_WIN, I_GCQ, I_GCKV, I_WUQ, I_WUKV, I_RPB,
       I_S5ARE, I_S5AIM, I_S5LOGSTEP, I_S5BRE, I_S5BIM, I_S5CRE, I_S5CIM, I_S5D, I_S5WGLU, I_S5BGLU, I_M2CONVW, I_M2CONVB, I_M2ALOG, I_M2DTBIAS,
       I_M2D, I_M2GNORM, I_WBRANCH, I_WOUT, I_WROUTER, I_WGATE, I_WUP, I_WDOWN, N_INPUTS };

constexpr size_t al256(size_t x) { return (x + 255) & ~(size_t)255; }
constexpr size_t SZ_X = (size_t)NTOK * D * 4;
constexpr size_t SZ_ROWBF = (size_t)NTOK * D * 2;
constexpr size_t OFF_X = 0;
constexpr size_t OFF_MOD = OFF_X + al256(SZ_X);
constexpr size_t OFF_HA = OFF_MOD + al256((size_t)DEPTH * NB1 * 6144 * 4);
constexpr size_t OFF_O = OFF_HA + al256(SZ_ROWBF);
constexpr size_t OFF_P1 = OFF_O + al256(SZ_ROWBF);
constexpr size_t SZ_P1 = (size_t)NTOK * P1W * 2;
constexpr size_t OFF_PG = OFF_P1 + al256(SZ_P1);
constexpr size_t SZ_PG = (size_t)NTOK * 4096 * 2;
constexpr size_t OFF_DT = OFF_PG + al256(SZ_PG);
constexpr size_t OFF_AFF = OFF_DT + al256((size_t)NTOK * 8 * 4);
constexpr size_t OFF_SEL = OFF_AFF + al256((size_t)NTOK * 16 * 4);
constexpr size_t OFF_IDX = OFF_SEL + al256((size_t)NTOK * 16 * 4);
constexpr size_t OFF_GW = OFF_IDX + al256((size_t)NE * ESLOTS * 4);
constexpr size_t OFF_BAR = OFF_GW + al256((size_t)NE * ESLOTS * 4);
constexpr size_t BAR_BYTES = (3456 + 64 * 4) * 4;
constexpr int Q_WORD0 = 3456;
constexpr size_t OFF_ROPE = OFF_BAR + al256(BAR_BYTES);
constexpr size_t OFF_WEARLY = OFF_ROPE + al256(64 * 8 * 2 * 4);
constexpr size_t WE_WIN = 0;
constexpr size_t WE_UQ = WE_WIN + (size_t)N_INP * 1024 * 2;
constexpr size_t WE_UKV = WE_UQ + (size_t)384 * 256 * 2;
constexpr size_t WE_GLU = WE_UKV + (size_t)512 * 128 * 2;
constexpr size_t WE_WB = WE_GLU + (size_t)256 * 256 * 2;
constexpr size_t WE_WOUT = WE_WB + (size_t)4 * 1024 * 256 * 2;
constexpr size_t WE_SIZE = al256(WE_WOUT + (size_t)1024 * 1024 * 2);
constexpr size_t OFF_S5TAB = OFF_WEARLY + DEPTH * WE_SIZE;
constexpr size_t S5_LAMPOW = 0;
constexpr size_t S5_BBAR = S5_LAMPOW + (size_t)2 * 16 * 17 * 64 * 2 * 4;
constexpr size_t S5_KT = S5_BBAR + (size_t)2 * 16 * 64 * 16 * 2 * 4;
constexpr size_t S5_WA = S5_KT + (size_t)2 * 16 * 16 * 256 * 4;
constexpr size_t S5_W2 = S5_WA + (size_t)16 * 256 * 256 * 2;
constexpr size_t S5_SIZE = al256(S5_W2 + (size_t)16 * 256 * 512 * 2);
constexpr size_t OFF_MIX = OFF_S5TAB + DEPTH * S5_SIZE;
constexpr size_t MX_Q = 0;
constexpr size_t MX_K = MX_Q + al256((size_t)BATCH * 4 * TOK * 96 * 2);
constexpr size_t MX_VTM = MX_K + al256((size_t)BATCH * 4 * TOK * 96 * 2);
constexpr size_t MX_VTN = MX_VTM + al256((size_t)BATCH * 4 * 64 * TOK * 2);
constexpr size_t MX_XBC = MX_VTN + al256((size_t)BATCH * 4 * 64 * TOK * 2);
constexpr size_t MX_US5 = MX_XBC + al256((size_t)NTOK * 768 * 2);
constexpr size_t MX_HEND = MX_US5 + al256((size_t)NTOK * 256 * 2);
constexpr size_t MX_HIN = MX_HEND + al256((size_t)16 * MCH * 256 * 4);
constexpr size_t MX_Z = MX_HIN + al256((size_t)16 * MCH * 256 * 2);
constexpr size_t MX_SIZE = MX_Z + al256((size_t)NTOK * 256 * 2);
constexpr size_t WX_GU = 0;
constexpr size_t WX_DN = WX_GU + (size_t)NE * 2048 * 1024 * 2;
constexpr size_t WX_SIZE = WX_DN + (size_t)NE * 1024 * 1024 * 2;
constexpr size_t MIXREG = (MX_SIZE > WX_SIZE ? MX_SIZE : WX_SIZE);
constexpr size_t WS_TOTAL = OFF_MIX + al256(MIXREG);

struct Params {
  const float* in[N_INPUTS];
  float* out;
  char* ws;
  int phase_lo, phase_hi;
};

DI int tid_() {
#ifdef EMU
  return (int)threadIdx.x;
#else
  int t = (int)threadIdx.x; asm volatile("" : "+v"(t)); return t;
#endif
}
#ifdef EMU
template <class T> DI T shfl_xor_(T v, int m) { return __shfl_xor(v, m); }
template <class T> DI T shfl_up_(T v, int d) { return __shfl_up(v, d); }
template <class T> DI T shfl_(T v, int src) { return __shfl(v, src); }
#else
template <class T> DI T shfl_xor_(T v, int m) {
  const int idx = ((tid_() & 63) ^ m) << 2;
  return __builtin_bit_cast(T, __builtin_amdgcn_ds_bpermute(idx, __builtin_bit_cast(int, v)));
}
template <class T> DI T shfl_up_(T v, int d) {
  const int l = tid_() & 63; const int idx = (l >= d ? l - d : l) << 2;
  return __builtin_bit_cast(T, __builtin_amdgcn_ds_bpermute(idx, __builtin_bit_cast(int, v)));
}
template <class T> DI T shfl_(T v, int src) {
  int idx = src << 2; asm volatile("" : "+v"(idx));
  return __builtin_bit_cast(T, __builtin_amdgcn_ds_bpermute(idx, __builtin_bit_cast(int, v)));
}
#endif
DI float bf2f(bf16 h) { return __uint_as_float(((unsigned)h) << 16); }
DI bf16 f2bf(float f) { unsigned u = __float_as_uint(f); u += 0x7fffu + ((u >> 16) & 1u); return (bf16)(u >> 16); }
DI unsigned pack2(float a, float b) { return (unsigned)f2bf(a) | ((unsigned)f2bf(b) << 16); }
DI float sigmoidf_(float x) { return 1.0f / (1.0f + __expf(-x)); }
DI float siluf_(float x) { return x / (1.0f + __expf(-x)); }
DI float softplusf_(float x) { const float ax = x < 0.f ? -x : x; return (x > 0.f ? x : 0.f) + __logf(1.0f + __expf(-ax)); }
DI float geluf_(float x) { const float u2 = 1.5957691216057308f * (x + 0.044715f * x * x * x); return x / (1.0f + __expf(-u2)); }
DI float wave_sum(float v) {
  v += shfl_xor_(v, 32); v += shfl_xor_(v, 16); v += shfl_xor_(v, 8); v += shfl_xor_(v, 4); v += shfl_xor_(v, 2); v += shfl_xor_(v, 1);
  return v;
}
#ifndef EMU
#define XB_TMO      128
#define XB_XCNT(j)  (256  + 64 * (j))
#define XB_XSUB(j)  (1280 + 64 * (j))
#define XB_XGEN(j)  (2304 + 64 * (j))
#define XB_TOP      3328
#define XB_TOPGEN   3392
#define XB_SPIN_CAP (1u << 24)
#define LAS __attribute__((address_space(3)))
DI unsigned xb_ld(unsigned* p) { return __hip_atomic_load(p, __ATOMIC_RELAXED, __HIP_MEMORY_SCOPE_AGENT); }
DI unsigned xb_add(unsigned* p, unsigned v) { return __hip_atomic_fetch_add(p, v, __ATOMIC_RELAXED, __HIP_MEMORY_SCOPE_AGENT); }
DI unsigned xb_xcc_id() { return (unsigned)__builtin_amdgcn_s_getreg((3 << 11) | 20) & 0xFu; }
#define XB_SPIN(cond, bar) do { unsigned _sp = 0; while (cond) { __builtin_amdgcn_s_sleep(1); \
    if ((++_sp & 255u) == 0u) { if (xb_ld(&(bar)[XB_TMO])) break; if (_sp > XB_SPIN_CAP) { atomicAdd(&(bar)[XB_TMO], 1u); break; } } } } while (0)
struct XcdBarrier { unsigned* bar; unsigned x; volatile LAS unsigned* st; };
DI XcdBarrier xcd_barrier_post(unsigned* bar, volatile LAS unsigned* st) {
  XcdBarrier b; b.bar = bar; b.x = xb_xcc_id(); b.st = st;
  if (threadIdx.x == 0) (void)xb_add(&bar[XB_XCNT(b.x)], 1u);
  return b;
}
DI void xcd_barrier_complete(unsigned* bar, unsigned x, unsigned& nloc, unsigned& nx) {
  const unsigned G = gridDim.x * gridDim.y * gridDim.z;
  unsigned sum, cnt, mine, sp = 0u;
  for (;;) {
    sum = 0u; cnt = 0u; mine = 0u;
#pragma unroll
    for (unsigned j = 0; j < 16; ++j) { const unsigned c = xb_ld(&bar[XB_XCNT(j)]); sum += c; cnt += (c > 0u) ? 1u : 0u; mine = (j == x) ? c : mine; }
    if (sum == G) break;
    __builtin_amdgcn_s_sleep(1);
    if ((++sp & 255u) == 0u) { if (xb_ld(&bar[XB_TMO])) break; if (sp > XB_SPIN_CAP) { atomicAdd(&bar[XB_TMO], 1u); break; } }
  }
  nloc = mine > 0u ? mine : 1u; nx = cnt > 0u ? cnt : 1u;
}
DI void xcd_barrier(const XcdBarrier& b) {
  asm volatile("s_waitcnt vmcnt(0)" ::: "memory");
  __syncthreads();
  if (threadIdx.x == 0) {
    unsigned* bar = b.bar;
    __builtin_amdgcn_s_waitcnt(0);
    unsigned nloc = b.st[0], nx = b.st[1];
    if (nloc == 0u) { xcd_barrier_complete(bar, b.x, nloc, nx); b.st[0] = nloc; b.st[1] = nx; }
    const unsigned old = xb_add(&bar[XB_XSUB(b.x)], 1u);
    const unsigned gen = old / nloc;
    if (old + 1u == (gen + 1u) * nloc) {
      __builtin_amdgcn_fence(__ATOMIC_RELEASE, "agent");
      asm volatile("s_waitcnt vmcnt(0)" ::: "memory");
      const unsigned og = xb_add(&bar[XB_TOP], 1u);
      const unsigned tg = og / nx;
      if (og + 1u == (tg + 1u) * nx) xb_add(&bar[XB_TOPGEN], 1u);
      else XB_SPIN(xb_ld(&bar[XB_TOPGEN]) == tg, bar);
      __builtin_amdgcn_fence(__ATOMIC_ACQUIRE, "agent");
      xb_add(&bar[XB_XGEN(b.x)], 1u);
      asm volatile("s_waitcnt vmcnt(0)" ::: "memory");
    } else {
      XB_SPIN(xb_ld(&bar[XB_XGEN(b.x)]) == gen, bar);
      __builtin_amdgcn_fence(__ATOMIC_ACQUIRE, "agent");
      asm volatile("s_waitcnt vmcnt(0)" ::: "memory");
    }
  }
  __syncthreads();
}
#endif

struct GA {
  const bf16* A; const bf16* A2; int lda, lda2, ksplit;
  const int* ridx; int mvalid;
  const bf16* Bt; int ldb; int K;
  int kfix;
};
DI GA make_ga(const bf16* A, int lda, const bf16* Bt, int ldb, int K, int mvalid) {
  GA g; g.A = A; g.A2 = A; g.lda = lda; g.lda2 = lda; g.ksplit = K; g.ridx = nullptr; g.mvalid = mvalid; g.Bt = Bt; g.ldb = ldb; g.K = K; g.kfix = 0; return g;
}

#ifdef EMU
#define GLDS16(gptr_, lptr_) memcpy((void*)(lptr_), (const void*)(gptr_), 16)
#define BGLDS16(rsrc_, base_, voff_, soff_, lptr_) memcpy((void*)(lptr_), (const char*)(base_) + (voff_) + (soff_), 16)
#define GEMM_WAIT(N_)
#define RAW_BARRIER() __syncthreads()
#else
#define LASV __attribute__((address_space(3))) void
#define GLDS16(gptr_, lptr_) __builtin_amdgcn_global_load_lds((const void*)(gptr_), (LASV*)(lptr_), 16, 0, 0)
#define BGLDS16(rsrc_, base_, voff_, soff_, lptr_) __builtin_amdgcn_raw_ptr_buffer_load_lds(rsrc_, (LASV*)(lptr_), 16, (int)(voff_), (int)(soff_), 0, 0)
#define GEMM_WAIT(N_) asm volatile("s_waitcnt vmcnt(%0)" :: "n"(N_) : "memory")
#define RAW_BARRIER() { asm volatile("" ::: "memory"); __builtin_amdgcn_s_barrier(); asm volatile("" ::: "memory"); }
#endif
DI int perm32(int rho) { const int n = rho >> 4, i = rho & 15; return 8 * (i >> 2) + 4 * n + (i & 3); }
constexpr int SRS_OFF = 73728;
template <int NT>
DI void gemm_s(const GA& g, int m0, int n0, char* smem, f32x4 (&acc)[4][NT]) {
  constexpr int A_ELEMS = 256 * 32, B_ELEMS = 32 * NT * 32, STAGE = A_ELEMS + B_ELEMS;
  bf16* st = (bf16*)smem;
  const int tid = tid_(), lane = tid & 63, wid = tid >> 6, wr = wid >> 1, wc = wid & 1, fr = lane & 15, fq = lane >> 4;
  const int lrow = tid >> 2, pch = tid & 3;
  long aoff[2], aoff2[2], boff;
#pragma unroll
  for (int i = 0; i < 2; ++i) {
    const int row = lrow + 128 * i;
    const int lch = pch ^ ((-(row >> 2)) & 3);
    int gm = m0 + row; if (gm > g.mvalid - 1) gm = g.mvalid - 1;
    const int ar = g.ridx ? g.ridx[gm] : gm;
    aoff[i] = (long)ar * g.lda + lch * 8;
    aoff2[i] = (long)ar * g.lda2 + lch * 8;
  }
  const int cb = (NT == 4) ? tid : (tid & 255);
  {
    const int row = cb >> 2;
    const int lch = pch ^ ((-(row >> 2)) & 3);
    const int src = n0 + (row & ~31) + perm32(row & 31);
    boff = (long)src * g.ldb + lch * 8;
  }
#pragma unroll
  for (int m = 0; m < 4; ++m)
#pragma unroll
    for (int n = 0; n < NT; ++n) acc[m][n] = f32x4{0.f, 0.f, 0.f, 0.f};
  const int T = g.K / 32;
#define GEMM_DMA(t_, stg_) { const int k0_ = (t_) * 32; const bool seg2_ = (k0_ >= g.ksplit); bf16* sa_ = st + (stg_) * STAGE; \
    _Pragma("unroll") for (int i_ = 0; i_ < 2; ++i_) { \
      const bf16* ap_ = seg2_ ? (g.A2 + aoff2[i_] + (k0_ - g.ksplit)) : (g.A + aoff[i_] + k0_); \
      GLDS16(ap_, sa_ + (tid + i_ * 512) * 8); } \
    GLDS16(g.Bt + boff + k0_, sa_ + A_ELEMS + cb * 8); }
  __syncthreads();
  GEMM_DMA(0, 0)
  if (T > 1) GEMM_DMA(1, 1)
  int s_cur = 0, s_nxt = 2;
#pragma unroll 1
  for (int t = 0; t < T; ++t) {
    if (t + 1 < T) { GEMM_WAIT(3); } else { GEMM_WAIT(0); }
    RAW_BARRIER();
    if (t + 2 < T) GEMM_DMA(t + 2, s_nxt)
    const bf16* sa = st + s_cur * STAGE;
    const bf16* sb = sa + A_ELEMS;
    bf16x8 af[4], bfr[NT];
#pragma unroll
    for (int n = 0; n < NT; ++n) {
      const int row = wc * (16 * NT) + n * 16 + fr;
      bfr[n] = *(const bf16x8*)(sb + row * 32 + ((fq ^ ((-(row >> 2)) & 3)) << 3));
    }
#pragma unroll
    for (int m = 0; m < 4; ++m) {
      const int row = wr * 64 + m * 16 + fr;
      af[m] = *(const bf16x8*)(sa + row * 32 + ((fq ^ ((-(row >> 2)) & 3)) << 3));
    }
#pragma unroll
    for (int m = 0; m < 4; ++m)
#pragma unroll
      for (int n = 0; n < NT; ++n) acc[m][n] = __builtin_amdgcn_mfma_f32_16x16x32_bf16(bfr[n], af[m], acc[m][n], 0, 0, 0);
    s_cur = (s_cur == 2) ? 0 : s_cur + 1;
    s_nxt = (s_nxt == 2) ? 0 : s_nxt + 1;
  }
}
constexpr int BG_HT = 128 * 64;
DI int lds_byte(int r, int c) { const int stt = (r >> 4) * 2 + (c >> 5), rr = r & 15, cc = c & 31, ob = rr * 64 + cc * 2; return stt * 1024 + (ob ^ (((ob >> 9) & 1) << 5)); }
DI void stage_rc(int b, int& R, int& C) { const int stt = b / 1024, sb = b % 1024, swz = sb ^ (((sb >> 9) & 1) << 5); R = (stt >> 1) * 16 + swz / 64; C = (stt & 1) * 32 + (swz % 64) / 2; }
#ifdef EMU
#define BG_WAIT_V(n)
#define BG_WAIT_L(n)
#define BG_BAR __syncthreads()
#define BG_SCHED
#define BG_PRIO(x)
#else
#define BG_WAIT_V(n) asm volatile("s_waitcnt vmcnt(" #n ")" ::: "memory")
#define BG_WAIT_L(n) asm volatile("s_waitcnt lgkmcnt(" #n ")" ::: "memory")
#define BG_BAR __builtin_amdgcn_s_barrier()
#define BG_SCHED __builtin_amdgcn_sched_barrier(0)
#define BG_PRIO(x) __builtin_amdgcn_s_setprio(x)
#endif
DI void gemm_big(const GA& g, int m0, int n0, char* smem, f32x4 (&acc)[2][2][4][2]) {
  bf16* shm = (bf16*)smem;
  const int tid = tid_(), wid = tid >> 6, lane = tid & 63, wr = wid >> 2, wc = wid & 3, fr = lane & 15, fq = lane >> 4;
  unsigned aof[2][2], bof[2][2];
#ifndef EMU
  const __amdgpu_buffer_rsrc_t rsA = __builtin_amdgcn_make_buffer_rsrc((void*)g.A, 0, 0x7fffffff, 0x00020000);
  const __amdgpu_buffer_rsrc_t rsB = __builtin_amdgcn_make_buffer_rsrc((void*)g.Bt, 0, 0x7fffffff, 0x00020000);
#endif
#pragma unroll
  for (int i = 0; i < 2; ++i) {
    int R, C; stage_rc(tid * 16 + i * 8192, R, C);
#pragma unroll
    for (int h = 0; h < 2; ++h) {
      int gm = m0 + h * 128 + R; if (gm > g.mvalid - 1) gm = g.mvalid - 1;
      const int ar = g.ridx ? g.ridx[gm] : gm;
      aof[h][i] = (unsigned)(ar * g.lda + C) * 2u;
      bof[h][i] = (unsigned)((n0 + h * 128 + (R & ~31) + perm32(R & 31)) * g.ldb + C) * 2u;
    }
  }
#define BG_SA(b, h) (shm + ((b) * 2 + (h)) * BG_HT)
#define BG_SB(b, h) (shm + (4 + (b) * 2 + (h)) * BG_HT)
#define BG_STAGE_A(P, h, kt) { \
    _Pragma("unroll") for (int i_ = 0; i_ < 2; ++i_) BGLDS16(rsA, g.A, aof[h][i_], (kt) * 128, (char*)(P) + tid * 16 + i_ * 8192); }
#define BG_STAGE_B(P, h, kt) { \
    _Pragma("unroll") for (int i_ = 0; i_ < 2; ++i_) BGLDS16(rsB, g.Bt, bof[h][i_], (kt) * 128, (char*)(P) + tid * 16 + i_ * 8192); }
#define BG_LDA(dst, b, h) _Pragma("unroll") for (int m_ = 0; m_ < 4; ++m_) _Pragma("unroll") for (int k_ = 0; k_ < 2; ++k_) \
    dst[m_][k_] = *(const bf16x8*)((const char*)BG_SA(b, h) + lds_byte(wr * 64 + m_ * 16 + fr, k_ * 32 + fq * 8))
#define BG_LDB(dst, b, h) _Pragma("unroll") for (int n_ = 0; n_ < 2; ++n_) _Pragma("unroll") for (int k_ = 0; k_ < 2; ++k_) \
    dst[n_][k_] = *(const bf16x8*)((const char*)BG_SB(b, h) + lds_byte(wc * 32 + n_ * 16 + fr, k_ * 32 + fq * 8))
#define BG_MMA(ai, bj, At_, Bt_) { BG_PRIO(1); \
    _Pragma("unroll") for (int m_ = 0; m_ < 4; ++m_) _Pragma("unroll") for (int n_ = 0; n_ < 2; ++n_) _Pragma("unroll") for (int k_ = 0; k_ < 2; ++k_) \
      acc[ai][bj][m_][n_] = __builtin_amdgcn_mfma_f32_16x16x32_bf16(Bt_[n_][k_], At_[m_][k_], acc[ai][bj][m_][n_], 0, 0, 0); \
    BG_PRIO(0); }
#pragma unroll
  for (int a_ = 0; a_ < 2; ++a_)
#pragma unroll
    for (int b_ = 0; b_ < 2; ++b_)
#pragma unroll
      for (int m_ = 0; m_ < 4; ++m_)
#pragma unroll
        for (int n_ = 0; n_ < 2; ++n_) acc[a_][b_][m_][n_] = f32x4{0.f, 0.f, 0.f, 0.f};
  bf16x8 At[4][2], B0[2][2], B1[2][2];
  const int nt = g.K / 64;
  __syncthreads();
  BG_STAGE_B(BG_SB(0, 0), 0, 0) BG_STAGE_A(BG_SA(0, 0), 0, 0)
  BG_STAGE_B(BG_SB(0, 1), 1, 0) BG_STAGE_A(BG_SA(0, 1), 1, 0)
  if (wr == 1) BG_BAR;
  BG_WAIT_V(4); BG_BAR;
  BG_STAGE_B(BG_SB(1, 0), 0, 1) BG_STAGE_A(BG_SA(1, 0), 0, 1) BG_STAGE_B(BG_SB(1, 1), 1, 1)
  BG_WAIT_V(6); BG_BAR;
#pragma unroll 1
  for (int t = 0; t < nt - 2; t += 2) {
    BG_LDB(B0, 0, 0); BG_SCHED; BG_LDA(At, 0, 0); BG_STAGE_A(BG_SA(1, 1), 1, t + 1)
    BG_WAIT_L(8); BG_BAR; BG_WAIT_L(0); BG_MMA(0, 0, At, B0) BG_BAR; BG_SCHED;
    BG_LDB(B1, 0, 1); BG_STAGE_B(BG_SB(0, 0), 0, t + 2)
    BG_BAR; BG_WAIT_L(0); BG_MMA(0, 1, At, B1) BG_BAR;
    BG_LDA(At, 0, 1); BG_STAGE_A(BG_SA(0, 0), 0, t + 2)
    BG_BAR; BG_WAIT_L(0); BG_MMA(1, 0, At, B0) BG_BAR; BG_SCHED;
    BG_STAGE_B(BG_SB(0, 1), 1, t + 2)
    BG_WAIT_V(6); BG_BAR; BG_MMA(1, 1, At, B1) BG_BAR;
    BG_LDB(B0, 1, 0); BG_SCHED; BG_LDA(At, 1, 0); BG_STAGE_A(BG_SA(0, 1), 1, t + 2)
    BG_WAIT_L(8); BG_BAR; BG_WAIT_L(0); BG_MMA(0, 0, At, B0) BG_BAR; BG_SCHED;
    BG_LDB(B1, 1, 1); BG_STAGE_B(BG_SB(1, 0), 0, t + 3)
    BG_BAR; BG_WAIT_L(0); BG_MMA(0, 1, At, B1) BG_BAR;
    BG_LDA(At, 1, 1); BG_STAGE_A(BG_SA(1, 0), 0, t + 3)
    BG_BAR; BG_WAIT_L(0); BG_MMA(1, 0, At, B0) BG_BAR; BG_SCHED;
    BG_STAGE_B(BG_SB(1, 1), 1, t + 3)
    BG_WAIT_V(6); BG_BAR; BG_MMA(1, 1, At, B1) BG_BAR;
  }
  { BG_LDB(B0, 0, 0); BG_LDA(At, 0, 0); BG_STAGE_A(BG_SA(1, 1), 1, nt - 1)
    BG_BAR; BG_WAIT_L(0); BG_MMA(0, 0, At, B0) BG_BAR;
    BG_LDB(B1, 0, 1); BG_BAR; BG_WAIT_L(0); BG_MMA(0, 1, At, B1) BG_BAR;
    BG_LDA(At, 0, 1); BG_WAIT_V(4); BG_BAR; BG_WAIT_L(0); BG_MMA(1, 0, At, B0) BG_MMA(1, 1, At, B1) BG_BAR; }
  { BG_LDB(B0, 1, 0); BG_LDA(At, 1, 0); BG_WAIT_V(2); BG_BAR; BG_WAIT_L(0); BG_MMA(0, 0, At, B0) BG_BAR;
    BG_LDB(B1, 1, 1); BG_WAIT_V(0); BG_BAR; BG_WAIT_L(0); BG_MMA(0, 1, At, B1) BG_BAR;
    BG_LDA(At, 1, 1); BG_BAR; BG_WAIT_L(0); BG_MMA(1, 0, At, B0) BG_MMA(1, 1, At, B1) BG_BAR; }
  if (wr == 0) BG_BAR;
}
#define EPIB_BEGIN(acc_, m0_, n0_, mvalid_) { const int _l = tid_() & 63, _w = tid_() >> 6, _wr = _w >> 2, _wc = _w & 3, _fr = _l & 15, _fq = _l >> 4; \
  _Pragma("unroll") for (int _ai = 0; _ai < 2; ++_ai) _Pragma("unroll") for (int _m = 0; _m < 4; ++_m) { const int row = (m0_) + _ai * 128 + _wr * 64 + _m * 16 + _fr; \
  _Pragma("unroll") for (int _bj = 0; _bj < 2; ++_bj) { const int col = (n0_) + _bj * 128 + _wc * 32 + 8 * _fq; (void)col; \
    float v[8] = {acc_[_ai][_bj][_m][0][0], acc_[_ai][_bj][_m][0][1], acc_[_ai][_bj][_m][0][2], acc_[_ai][_bj][_m][0][3], \
                  acc_[_ai][_bj][_m][1][0], acc_[_ai][_bj][_m][1][1], acc_[_ai][_bj][_m][1][2], acc_[_ai][_bj][_m][1][3]}; \
    if (row < (mvalid_)) {
#define EPIB_END }}}}

DI void ld8bf(const bf16* p, float (&v)[8]) {
  uint4 w = *(const uint4*)p;
  v[0] = __uint_as_float(w.x << 16); v[1] = __uint_as_float(w.x & 0xffff0000u); v[2] = __uint_as_float(w.y << 16); v[3] = __uint_as_float(w.y & 0xffff0000u);
  v[4] = __uint_as_float(w.z << 16); v[5] = __uint_as_float(w.z & 0xffff0000u); v[6] = __uint_as_float(w.w << 16); v[7] = __uint_as_float(w.w & 0xffff0000u);
}
DI void st8bf(bf16* p, const float (&v)[8]) { *(uint4*)p = make_uint4(pack2(v[0], v[1]), pack2(v[2], v[3]), pack2(v[4], v[5]), pack2(v[6], v[7])); }
DI void st8f(float* p, const float (&v)[8]) { *(float4*)p = make_float4(v[0], v[1], v[2], v[3]); *(float4*)(p + 4) = make_float4(v[4], v[5], v[6], v[7]); }
#define EPI_BEGIN(NT_, acc_, m0_, n0_, mvalid_) { const int _l = tid_() & 63, _w = tid_() >> 6, _wr = _w >> 1, _wc = _w & 1, _fr = _l & 15, _fq = _l >> 4; \
  _Pragma("unroll") for (int _m = 0; _m < 4; ++_m) { const int row = (m0_) + _wr * 64 + _m * 16 + _fr; \
  _Pragma("unroll") for (int _q = 0; _q < (NT_) / 2; ++_q) { const int col = (n0_) + _wc * (16 * (NT_)) + _q * 32 + 8 * _fq; (void)col; \
    float v[8] = {acc_[_m][2 * _q][0], acc_[_m][2 * _q][1], acc_[_m][2 * _q][2], acc_[_m][2 * _q][3], \
                  acc_[_m][2 * _q + 1][0], acc_[_m][2 * _q + 1][1], acc_[_m][2 * _q + 1][2], acc_[_m][2 * _q + 1][3]}; \
    if (row < (mvalid_)) {
#define EPI_END }}}}

DI int mtile_row0(int mt, bool latonly, int TH) {
  if (!latonly) return mt * TH;
  const int per = SEQ / TH, b = mt / per, r = mt % per;
  return b * TOK + CTXL + r * TH;
}
DI int mtiles(bool latonly, int TH) { return latonly ? BATCH * (SEQ / TH) : (NTOK + TH - 1) / TH; }

struct LP {
  int l; bool last;
  const float* mod;
  char* we;
  char* s5;
};
DI LP make_lp(const Params& p, int l) {
  LP q; q.l = l; q.last = (l == DEPTH - 1);
  q.mod = (const float*)(p.ws + OFF_MOD) + (size_t)l * NB1 * 6144;
  q.we = p.ws + OFF_WEARLY + (size_t)l * WE_SIZE;
  q.s5 = p.ws + OFF_S5TAB + (size_t)l * S5_SIZE;
  return q;
}

template <class RowMap>
DI void conv_tile(const float* src, int lds, int nsrc, const float* kscale, bf16* dst, int K, int k0, int n0, char* smem, RowMap rowmap) {
  float* t = (float*)smem;
  const int tid = tid_();
  __syncthreads();
#pragma unroll 4
  for (int i = 0; i < 8; ++i) {
    int k = i * 8 + (tid >> 6), n = tid & 63;
    float v = (n0 + n < nsrc) ? src[(size_t)(k0 + k) * lds + n0 + n] : 0.f;
    if (kscale) v *= kscale[k0 + k];
    t[k * 65 + n] = v;
  }
  __syncthreads();
  const int n = tid >> 3, kq = (tid & 7) * 8;
  unsigned w[4];
#pragma unroll
  for (int i = 0; i < 4; ++i) w[i] = pack2(t[(kq + 2 * i) * 65 + n], t[(kq + 2 * i + 1) * 65 + n]);
  bf16* d = dst + (size_t)rowmap(n0 + n) * K + k0 + kq;
  *(uint4*)d = make_uint4(w[0], w[1], w[2], w[3]);
}
struct RowId { DI int operator()(int n) const { return n; } };
struct RowGU { int half; DI int operator()(int f) const { return (f >> 7) * 256 + half * 128 + (f & 127); } };

constexpr int CT_WIN = 16 * (N_INP / 64), CT_UQ = 4 * 6, CT_UKV = 2 * 8, CT_GLU = 16, CT_WB = 4 * 64, CT_WOUT = 256;
constexpr int CT_EARLY = CT_WIN + CT_UQ + CT_UKV + CT_GLU + CT_WB + CT_WOUT;
constexpr int CT_EXP = NE * 3 * 256;

DI void conv_early_item(const Params& p, int l, int it, char* smem) {
  char* we = p.ws + OFF_WEARLY + (size_t)l * WE_SIZE;
  if (it < CT_WIN) {
    int kt = it % 16, nt = it / 16;
    conv_tile(p.in[I_WIN] + (size_t)l * 1024 * N_IN, N_IN, N_IN, nullptr, (bf16*)(we + WE_WIN), 1024, kt * 64, nt * 64, smem, RowId());
    return;
  }
  it -= CT_WIN;
  if (it < CT_UQ) {
    int kt = it % 4, nt = it / 4;
    conv_tile(p.in[I_WUQ] + (size_t)l * 256 * 384, 384, 384, p.in[I_GCQ] + l * 256, (bf16*)(we + WE_UQ), 256, kt * 64, nt * 64, smem, RowId());
    return;
  }
  it -= CT_UQ;
  if (it < CT_UKV) {
    int kt = it % 2, nt = it / 2;
    conv_tile(p.in[I_WUKV] + (size_t)l * 128 * 512, 512, 512, p.in[I_GCKV] + l * 128, (bf16*)(we + WE_UKV), 128, kt * 64, nt * 64, smem, RowId());
    return;
  }
  it -= CT_UKV;
  if (it < CT_GLU) {
    int kt = it % 4, nt = it / 4;
    conv_tile(p.in[I_S5WGLU] + (size_t)l * 256 * 256, 256, 256, nullptr, (bf16*)(we + WE_GLU), 256, kt * 64, nt * 64, smem, RowId());
    return;
  }
  it -= CT_GLU;
  if (it < CT_WB) {
    int j = it / 64, r = it % 64, kt = r % 4, nt = r / 4;
    conv_tile(p.in[I_WBRANCH] + ((size_t)l * 4 + j) * 256 * 1024, 1024, 1024, nullptr, (bf16*)(we + WE_WB) + (size_t)j * 1024 * 256, 256, kt * 64, nt * 64, smem, RowId());
    return;
  }
  it -= CT_WB;
  {
    int kt = it % 16, nt = it / 16;
    conv_tile(p.in[I_WOUT] + (size_t)l * 1024 * 1024, 1024, 1024, nullptr, (bf16*)(we + WE_WOUT), 1024, kt * 64, nt * 64, smem, RowId());
  }
}
DI void conv_expert_item(const Params& p, int l, int it, char* smem) {
  char* wx = p.ws + OFF_MIX;
  int e = it / 768, r = it % 768, which = r / 256, t = r % 256, kt = t % 16, nt = t / 16;
  size_t eoff = ((size_t)l * NE + e) * 1024 * 1024;
  if (which == 0) { RowGU rm; rm.half = 0; conv_tile(p.in[I_WGATE] + eoff, 1024, 1024, nullptr, (bf16*)(wx + WX_GU) + (size_t)e * 2048 * 1024, 1024, kt * 64, nt * 64, smem, rm); }
  else if (which == 1) { RowGU rm; rm.half = 1; conv_tile(p.in[I_WUP] + eoff, 1024, 1024, nullptr, (bf16*)(wx + WX_GU) + (size_t)e * 2048 * 1024, 1024, kt * 64, nt * 64, smem, rm); }
  else conv_tile(p.in[I_WDOWN] + eoff, 1024, 1024, nullptr, (bf16*)(wx + WX_DN) + (size_t)e * 1024 * 1024, 1024, kt * 64, nt * 64, smem, RowId());
}

DI void mod_item(const Params& p, int it, char* smem) {
  const int l = it / 96, cg0 = (it % 96) * 64;
  float* sc = (float*)smem;
  float* red = sc + NB1 * 1024;
  const int tid = tid_();
  __syncthreads();
  for (int i = tid; i < NB1 * 1024; i += NTHREADS) {
    int r = i >> 10, k = i & 1023;
    float c = (r < BATCH) ? p.in[I_C][r * 1024 + k] : p.in[I_CCTX][k];
    sc[i] = siluf_(c);
  }
  __syncthreads();
  const int cl = tid & 63, kg = tid >> 6;
  float acc[NB1];
#pragma unroll
  for (int r = 0; r < NB1; ++r) acc[r] = 0.f;
  const float* w = p.in[I_WADA] + (size_t)l * 1024 * 6144 + cg0 + cl;
  for (int k = kg * (1024 / NWAVES); k < (kg + 1) * (1024 / NWAVES); ++k) {
    float wv = w[(size_t)k * 6144];
#pragma unroll
    for (int r = 0; r < NB1; ++r) acc[r] += sc[r * 1024 + k] * wv;
  }
#pragma unroll
  for (int r = 0; r < NB1; ++r) red[(kg * NB1 + r) * 64 + cl] = acc[r];
  __syncthreads();
  for (int i = tid; i < NB1 * 64; i += NTHREADS) {
    int r = i >> 6, c = i & 63;
    float s = 0.f;
#pragma unroll
    for (int q = 0; q < NWAVES; ++q) s += red[(q * NB1 + r) * 64 + c];
    s += p.in[I_BADA][l * 6144 + cg0 + c];
    ((float*)(p.ws + OFF_MOD))[((size_t)l * NB1 + r) * 6144 + cg0 + c] = s;
  }
}

DI void s5_tab_item(const Params& p, int it, char* smem) {
  const int l = it / 32, d = (it / 16) & 1, g = it & 15;
  char* s5 = p.ws + OFF_S5TAB + (size_t)l * S5_SIZE;
  float* lampow = (float*)(s5 + S5_LAMPOW) + (size_t)(d * 16 + g) * 17 * 64 * 2;
  float* bbar = (float*)(s5 + S5_BBAR) + (size_t)(d * 16 + g) * 64 * 16 * 2;
  float* kt = (float*)(s5 + S5_KT) + (size_t)(d * 16 + g) * 16 * 256;
  float* slam = (float*)smem;
  float* sbb = slam + 17 * 64 * 2;
  const int tid = tid_();
  const size_t pg = ((size_t)(l * 2 + d) * 16 + g);
  const float step = expf(p.in[I_S5LOGSTEP][pg]);
  __syncthreads();
  for (int i = tid; i < 17 * 64; i += NTHREADS) {
    int j = i >> 6, pp = i & 63;
    float are = p.in[I_S5ARE][pg * 64 + pp], aim = p.in[I_S5AIM][pg * 64 + pp];
    float mag = expf((float)j * step * are), ang = (float)j * step * aim;
    float re = mag * cosf(ang), im = mag * sinf(ang);
    slam[i * 2] = re; slam[i * 2 + 1] = im; lampow[i * 2] = re; lampow[i * 2 + 1] = im;
  }
  __syncthreads();
  for (int i = tid; i < 64 * 16; i += NTHREADS) {
    int pp = i >> 4;
    float are = p.in[I_S5ARE][pg * 64 + pp], aim = p.in[I_S5AIM][pg * 64 + pp];
    float x = slam[(64 + pp) * 2] - 1.0f, y = slam[(64 + pp) * 2 + 1];
    float den = are * are + aim * aim;
    float qre = (x * are + y * aim) / den, qim = (y * are - x * aim) / den;
    float bre = p.in[I_S5BRE][pg * 1024 + i], bim = p.in[I_S5BIM][pg * 1024 + i];
    float re = qre * bre - qim * bim, im = qre * bim + qim * bre;
    sbb[i * 2] = re; sbb[i * 2 + 1] = im; bbar[i * 2] = re; bbar[i * 2 + 1] = im;
  }
  __syncthreads();
  for (int i = tid; i < 16 * 256; i += NTHREADS) {
    int j = i >> 8, c = (i >> 4) & 15, c2 = i & 15;
    float s = 0.f;
    for (int pp = 0; pp < 64; ++pp) {
      float cre = p.in[I_S5CRE][pg * 1024 + c * 64 + pp], cim = p.in[I_S5CIM][pg * 1024 + c * 64 + pp];
      float lre = slam[(j * 64 + pp) * 2], lim = slam[(j * 64 + pp) * 2 + 1];
      float tre = cre * lre - cim * lim, tim = cre * lim + cim * lre;
      float bre = sbb[(pp * 16 + c2) * 2], bim = sbb[(pp * 16 + c2) * 2 + 1];
      s += tre * bre - tim * bim;
    }
    kt[i] = s;
  }
}
DI void s5_mat_item(const Params& p, int it) {
  const int l = it / 64, g = (it / 4) & 15, q = it & 3;
  char* s5 = p.ws + OFF_S5TAB + (size_t)l * S5_SIZE;
  const float* lampow = (const float*)(s5 + S5_LAMPOW);
  const float* bbar = (const float*)(s5 + S5_BBAR);
  const float* ktab = (const float*)(s5 + S5_KT);
  bf16* WA = (bf16*)(s5 + S5_WA) + (size_t)g * 256 * 256;
  bf16* W2 = (bf16*)(s5 + S5_W2) + (size_t)g * 256 * 512;
  const int tid = tid_();
  for (int i = tid; i < 64 * 256; i += NTHREADS) {
    int n = q * 64 + (i >> 8), k = i & 255;
    int d = n >> 7, ri = (n >> 6) & 1, pp = n & 63, s = k >> 4, c2 = k & 15;
    int e = (d == 0) ? (15 - s) : s;
    const float* lp = lampow + ((size_t)((d * 16 + g) * 17 + e) * 64 + pp) * 2;
    const float* bp = bbar + ((size_t)((d * 16 + g) * 64 + pp) * 16 + c2) * 2;
    float re = lp[0] * bp[0] - lp[1] * bp[1], im = lp[0] * bp[1] + lp[1] * bp[0];
    WA[(size_t)n * 256 + k] = f2bf(ri == 0 ? re : im);
  }
  for (int i = tid; i < 64 * 512; i += NTHREADS) {
    int n = q * 64 + (i >> 9), k = i & 511;
    int lq = n >> 4, c = n & 15;
    float v;
    if (k < 256) {
      int s = k >> 4, c2 = k & 15;
      v = 0.f;
      if (s <= lq) v += ktab[((size_t)(0 * 16 + g) * 16 + (lq - s)) * 256 + c * 16 + c2];
      if (s >= lq) v += ktab[((size_t)(1 * 16 + g) * 16 + (s - lq)) * 256 + c * 16 + c2];
      if (s == lq && c == c2) v += p.in[I_S5D][l * 256 + g * 16 + c];
    } else {
      int kk = k - 256, d = kk >> 7, ri = (kk >> 6) & 1, pp = kk & 63;
      int e = (d == 0) ? (lq + 1) : (16 - lq);
      size_t pg = ((size_t)(l * 2 + d) * 16 + g);
      float cre = p.in[I_S5CRE][pg * 1024 + c * 64 + pp], cim = p.in[I_S5CIM][pg * 1024 + c * 64 + pp];
      const float* lp = lampow + ((size_t)((d * 16 + g) * 17 + e) * 64 + pp) * 2;
      float re = cre * lp[0] - cim * lp[1], im = cre * lp[1] + cim * lp[0];
      v = (ri == 0) ? re : -im;
    }
    W2[(size_t)n * 512 + k] = f2bf(v);
  }
}

DI int tok_b(int tok) { return tok / TOK; }
DI int tok_j(int tok) { return tok % TOK; }
DI int tok_modrow(int tok) { return (tok_j(tok) < CTXL) ? BATCH : tok_b(tok); }

DI void normmod_row(const float (&xv)[16], const float* g, const float* shift, const float* scale, bf16* dst, float (&hout)[16]) {
  const int lane = tid_() & 63;
  float ss = 0.f;
#pragma unroll
  for (int i = 0; i < 16; ++i) ss += xv[i] * xv[i];
  ss = wave_sum(ss);
  const float rs = rsqrtf(ss * (1.0f / 1024.f) + EPS);
#pragma unroll
  for (int i = 0; i < 4; ++i) {
    int c = lane * 4 + i * 256;
    float4 gv = *(const float4*)(g + c), sh = *(const float4*)(shift + c), sc = *(const float4*)(scale + c);
    float h0 = xv[i * 4 + 0] * rs * gv.x * (1.f + sc.x) + sh.x;
    float h1 = xv[i * 4 + 1] * rs * gv.y * (1.f + sc.y) + sh.y;
    float h2 = xv[i * 4 + 2] * rs * gv.z * (1.f + sc.z) + sh.z;
    float h3 = xv[i * 4 + 3] * rs * gv.w * (1.f + sc.w) + sh.w;
    hout[i * 4 + 0] = h0; hout[i * 4 + 1] = h1; hout[i * 4 + 2] = h2; hout[i * 4 + 3] = h3;
    *(uint2*)(dst + c) = make_uint2(pack2(h0, h1), pack2(h2, h3));
  }
}

DI void prep_row_item(const Params& p, int it) {
  const int tok = it * NWAVES + (tid_() >> 6), lane = tid_() & 63;
  const int b = tok_b(tok), j = tok_j(tok);
  const float* src = (j < CTXL) ? p.in[I_CTX] + ((size_t)b * CTXL + j) * 1024 : p.in[I_X] + ((size_t)b * SEQ + (j - CTXL)) * 1024;
  float* X = (float*)(p.ws + OFF_X) + (size_t)tok * 1024;
  float xv[16], h[16];
#pragma unroll
  for (int i = 0; i < 4; ++i) {
    float4 v = *(const float4*)(src + lane * 4 + i * 256);
    *(float4*)(X + lane * 4 + i * 256) = v;
    xv[i * 4] = v.x; xv[i * 4 + 1] = v.y; xv[i * 4 + 2] = v.z; xv[i * 4 + 3] = v.w;
  }
  const float* mod = (const float*)(p.ws + OFF_MOD) + (size_t)tok_modrow(tok) * 6144;
  normmod_row(xv, p.in[I_GPREMIX], mod + 0, mod + 1024, (bf16*)(p.ws + OFF_HA) + (size_t)tok * 1024, h);
}

constexpr int IP_MT = (NTOK + 255) / 256, IP_NT = N_INP / 256, IP_RR = (IP_MT + 7) / 8, IP_RC = (IP_NT + 1) / 2;
constexpr int IP_SLOTS = ((IP_RR * IP_RC + 15) / 16) * 256;
DI void inproj_tile(const Params& p, const LP& L, int t, char* smem) {
  const int vb = t % 256, vround = t / 256, x = vb % 8, j = vb / 8;
  const int R = vround * 16 + x * 2 + (j >> 4), jj = j & 15, rm = R % IP_RR, rn = R / IP_RR;
  const int mt = rm * 8 + (jj & 7), nt = rn * 2 + (jj >> 3);
  if (mt >= IP_MT || nt >= IP_NT) return;
  const int m0 = mt * 256, n0 = nt * 256;
  GA g = make_ga((const bf16*)(p.ws + OFF_HA), 1024, (const bf16*)(L.we + WE_WIN), 1024, 1024, NTOK);
  f32x4 acc[2][2][4][2];
  gemm_big(g, m0, n0, smem, acc);
  bf16* P1 = (bf16*)(p.ws + OFF_P1);
  bf16* PG = (bf16*)(p.ws + OFF_PG);
  bf16* US5 = (bf16*)(p.ws + OFF_MIX + MX_US5);
  float* DT = (float*)(p.ws + OFF_DT);
  const float* dtb = p.in[I_M2DTBIAS] + L.l * 8;
  EPIB_BEGIN(acc, m0, n0, NTOK)
    if (col < C_S5 || (col >= C_Z && col < C_DT)) st8bf(P1 + (size_t)row * P1W + col, v);
    else if (col < C_Z) st8bf(US5 + ((size_t)((col - C_S5) >> 4) * NTOK + row) * 16 + (col & 15), v);
    else if (col < C_GATE) {
#pragma unroll
      for (int k = 0; k < 8; ++k) v[k] = softplusf_(v[k] + dtb[k]);
      st8f(DT + (size_t)row * 8, v);
    } else if (col < N_IN) {
#pragma unroll
      for (int k = 0; k < 8; ++k) v[k] = sigmoidf_(v[k]);
      st8bf(PG + (size_t)row * 4096 + (col - C_GATE), v);
    }
  EPIB_END
}

DI void rowscale_256(const bf16* P1, int m0, int c0, int width, float* srs) {
  const int r = tid_() >> 1, hf = tid_() & 1;
  int gr = m0 + r; if (gr > NTOK - 1) gr = NTOK - 1;
  const bf16* src = P1 + (size_t)gr * P1W + c0 + hf * (width / 2);
  float ss = 0.f;
  for (int i = 0; i < width / 2; i += 8) {
    float v[8]; ld8bf(src + i, v);
#pragma unroll
    for (int k = 0; k < 8; ++k) ss += v[k] * v[k];
  }
  ss += shfl_xor_(ss, 1);
  if (hf == 0) srs[r] = rsqrtf(ss / (float)width + EPS);
}
DI void rope_tab_item(const Params& p) {
  float* tab = (float*)(p.ws + OFF_ROPE);
  for (int i = tid_(); i < 64 * 8; i += NTHREADS) {
    int pos = i >> 3, k = i & 7;
    float f = expf(-(float)k * (9.210340371976184f / 8.0f));
    float a = (float)pos * f;
    tab[i * 2] = cosf(a); tab[i * 2 + 1] = sinf(a);
  }
}
DI void rope_cs(const float* tab, int pos, int i, float& c, float& s) { c = tab[(pos * 8 + i) * 2]; s = tab[(pos * 8 + i) * 2 + 1]; }

constexpr int TP_MT = (NTOK + 255) / 256;
DI void mlaq_tile(const Params& p, const LP& L, int t, char* smem) {
  const int mt = t % TP_MT, nt = t / TP_MT, m0 = mt * 256, n0 = nt * 128;
  const bf16* P1 = (const bf16*)(p.ws + OFF_P1);
  float* srs = (float*)(smem + SRS_OFF);
  GA g = make_ga(P1 + C_CQ, P1W, (const bf16*)(L.we + WE_UQ), 256, 256, NTOK);
  f32x4 acc[4][4];
  gemm_s<4>(g, m0, n0, smem, acc);
  rowscale_256(P1, m0, C_CQ, 256, srs);
  __syncthreads();
  bf16* Q = (bf16*)(p.ws + OFF_MIX + MX_Q);
  const float* ropetab = (const float*)(p.ws + OFF_ROPE);
  {
    const int l = tid_() & 63, w = tid_() >> 6, wr = w >> 1, wc = w & 1, fr = l & 15, fq = l >> 4;
#pragma unroll
    for (int m = 0; m < 4; ++m) {
      const int row = m0 + wr * 64 + m * 16 + fr;
      const int rowc = row < NTOK ? row : NTOK - 1;
      const float rsc = srs[rowc - m0];
      const int b = tok_b(rowc), j = tok_j(rowc);
#pragma unroll
      for (int q = 0; q < 2; ++q) {
        const int col = n0 + wc * 64 + q * 32 + 8 * fq;
        const int h = col / 96, dd = col % 96;
        float v[8] = {acc[m][2 * q][0], acc[m][2 * q][1], acc[m][2 * q][2], acc[m][2 * q][3], acc[m][2 * q + 1][0], acc[m][2 * q + 1][1], acc[m][2 * q + 1][2], acc[m][2 * q + 1][3]};
        float vp[8];
#pragma unroll
        for (int k = 0; k < 8; ++k) vp[k] = shfl_xor_(v[k], 16);
        if (dd >= 64 && j >= CTXL) {
          const int tl = j - CTXL, pos = ((dd - 64) < 16) ? (tl / GRID_W) : (tl % GRID_W);
          const bool lo = ((dd & 8) == 0);
#pragma unroll
          for (int k = 0; k < 8; ++k) {
            float c, sn; rope_cs(ropetab, pos, k, c, sn);
            v[k] = lo ? (v[k] * c - vp[k] * sn) : (v[k] * c + vp[k] * sn);
          }
        }
#pragma unroll
        for (int k = 0; k < 8; ++k) v[k] *= rsc;
        if (row < NTOK) st8bf(Q + (((size_t)b * 4 + h) * TOK + j) * 96 + dd, v);
      }
    }
  }
}
DI void mlakv_tile(const Params& p, const LP& L, int t, char* smem) {
  const int mt = t % TP_MT, h = t / TP_MT, m0 = mt * 256, n0 = h * 128;
  const bf16* P1 = (const bf16*)(p.ws + OFF_P1);
  float* srs = (float*)(smem + SRS_OFF);
  GA g = make_ga(P1 + C_CKV, P1W, (const bf16*)(L.we + WE_UKV), 128, 128, NTOK);
  f32x4 acc[4][4];
  gemm_s<4>(g, m0, n0, smem, acc);
  rowscale_256(P1, m0, C_CKV, 128, srs);
  __syncthreads();
  bf16* K = (bf16*)(p.ws + OFF_MIX + MX_K);
  bf16* VT = (bf16*)(p.ws + OFF_MIX + MX_VTM);
  const float* ropetab = (const float*)(p.ws + OFF_ROPE);
  EPI_BEGIN(4, acc, m0, n0, NTOK)
    const float rsc = srs[row - m0];
    const int b = tok_b(row), j = tok_j(row), dd = col - n0;
#pragma unroll
    for (int k = 0; k < 8; ++k) v[k] *= rsc;
    if (dd < 64) st8bf(K + (((size_t)b * 4 + h) * TOK + j) * 96 + dd, v);
    else {
#pragma unroll
      for (int k = 0; k < 8; ++k) VT[(((size_t)b * 4 + h) * 64 + (dd - 64 + k)) * TOK + j] = f2bf(v[k]);
    }
  EPI_END
  for (int i = tid_(); i < 256 * 16; i += NTHREADS) {
    int r = i >> 4, q = i & 15;
    int row = m0 + r;
    if (row < NTOK) {
      int b = tok_b(row), j = tok_j(row);
      int blk = q >> 3, i8 = q & 7;
      float x1 = bf2f(P1[(size_t)row * P1W + C_KR + blk * 16 + i8]), x2 = bf2f(P1[(size_t)row * P1W + C_KR + blk * 16 + i8 + 8]);
      float o1 = x1, o2 = x2;
      if (j >= CTXL) {
        int tl = j - CTXL, pos = blk == 0 ? (tl / GRID_W) : (tl % GRID_W);
        float c, sn; rope_cs(ropetab, pos, i8, c, sn);
        o1 = x1 * c - x2 * sn; o2 = x2 * c + x1 * sn;
      }
      bf16* kd = K + (((size_t)b * 4 + h) * TOK + j) * 96 + 64 + blk * 16 + i8;
      kd[0] = f2bf(o1); kd[8] = f2bf(o2);
    }
  }
}
DI void navt_item(const Params& p, int it, char* smem) {
  bf16* s = (bf16*)smem;
  const bf16* P1 = (const bf16*)(p.ws + OFF_P1);
  bf16* VT = (bf16*)(p.ws + OFF_MIX + MX_VTN);
  const int tok0 = it * 64, tid = tid_();
  const int b = tok_b(tok0), j0 = tok_j(tok0);
  __syncthreads();
  for (int i = tid; i < 64 * 32; i += NTHREADS) {
    int r = i >> 5, c8 = i & 31;
    *(uint4*)(s + r * 264 + c8 * 8) = *(const uint4*)(P1 + (size_t)(tok0 + r) * P1W + C_NA + 512 + c8 * 8);
  }
  __syncthreads();
  for (int i = tid; i < 256 * 8; i += NTHREADS) {
    int ch = i >> 3, t8 = i & 7;
    unsigned w[4];
#pragma unroll
    for (int q = 0; q < 4; ++q) w[q] = (unsigned)s[(t8 * 8 + 2 * q) * 264 + ch] | ((unsigned)s[(t8 * 8 + 2 * q + 1) * 264 + ch] << 16);
    *(uint4*)(VT + ((size_t)b * 256 + ch) * TOK + j0 + t8 * 8) = make_uint4(w[0], w[1], w[2], w[3]);
  }
}
DI void m2conv_item(const Params& p, const LP& L, int it) {
  const bf16* P1 = (const bf16*)(p.ws + OFF_P1);
  bf16* XB = (bf16*)(p.ws + OFF_MIX + MX_XBC);
  const int tok0 = it * 32, j0 = tok_j(tok0);
  const int slo = (j0 < CTXL) ? 0 : CTXL, shi = (j0 < CTXL) ? CTXL : TOK;
  const int base = tok0 - j0;
  for (int c = tid_(); c < 768; c += NTHREADS) {
    const float w0 = p.in[I_M2CONVW][(L.l * 4 + 0) * 768 + c], w1 = p.in[I_M2CONVW][(L.l * 4 + 1) * 768 + c];
    const float w2 = p.in[I_M2CONVW][(L.l * 4 + 2) * 768 + c], w3 = p.in[I_M2CONVW][(L.l * 4 + 3) * 768 + c];
    const float bb = p.in[I_M2CONVB][L.l * 768 + c];
    auto ld = [&](int j) -> float { return (j >= slo && j < shi) ? bf2f(P1[(size_t)(base + j) * P1W + C_XBC + c]) : 0.f; };
    float xm2 = ld(j0 - 2), xm1 = ld(j0 - 1), x0 = ld(j0);
    for (int i = 0; i < 32; ++i) {
      float xp1 = ld(j0 + i + 1);
      float y = bb + w0 * xm2 + w1 * xm1 + w2 * x0 + w3 * xp1;
      XB[(size_t)(tok0 + i) * 768 + c] = f2bf(siluf_(y));
      xm2 = xm1; xm1 = x0; x0 = xp1;
    }
  }
}
constexpr int S5_MT = (MCH + 255) / 256;
DI void s5a_tile(const Params& p, const LP& L, int t, char* smem) {
  const int g = t / (S5_MT * 2), r = t % (S5_MT * 2), mt = r / 2, nt = r % 2;
  const int m0 = mt * 256, n0 = nt * 128;
  GA ga = make_ga((const bf16*)(p.ws + OFF_MIX + MX_US5) + (size_t)g * NTOK * 16, 256, (const bf16*)(L.s5 + S5_WA) + (size_t)g * 65536, 256, 256, MCH);
  f32x4 acc[4][4];
  gemm_s<4>(ga, m0, n0, smem, acc);
  float* HE = (float*)(p.ws + OFF_MIX + MX_HEND) + (size_t)g * MCH * 256;
  EPI_BEGIN(4, acc, m0, n0, MCH)
    st8f(HE + (size_t)row * 256 + col, v);
  EPI_END
}
DI int s5_chunk_of(int i, int d) { return (d == 0) ? i : (i < NCC ? (NCC - 1 - i) : (NCH - 1 - (i - NCC))); }
DI void s5carry_item(const Params& p, const LP& L, int it) {
  const int w = it * NWAVES + (tid_() >> 6), lane = tid_() & 63;
  const int d = w / (16 * BATCH), g = (w / BATCH) & 15, b = w % BATCH;
  const float* lp = (const float*)(L.s5 + S5_LAMPOW) + ((size_t)((d * 16 + g) * 17 + 16) * 64 + lane) * 2;
  const float lre = lp[0], lim = lp[1];
  const float* HE = (const float*)(p.ws + OFF_MIX + MX_HEND) + ((size_t)g * MCH + (size_t)b * NCH) * 256 + d * 128;
  bf16* HI = (bf16*)(p.ws + OFF_MIX + MX_HIN) + ((size_t)g * MCH + (size_t)b * NCH) * 256 + d * 128;
  float cre = 0.f, cim = 0.f;
  static_assert(NCH % 4 == 0, "chunk count");
  for (int i0 = 0; i0 < NCH; i0 += 4) {
    float hre[4], him[4];
#pragma unroll
    for (int k = 0; k < 4; ++k) { const int ch = s5_chunk_of(i0 + k, d); hre[k] = HE[(size_t)ch * 256 + lane]; him[k] = HE[(size_t)ch * 256 + 64 + lane]; }
#pragma unroll
    for (int k = 0; k < 4; ++k) {
      const int ch = s5_chunk_of(i0 + k, d);
      HI[(size_t)ch * 256 + lane] = f2bf(cre); HI[(size_t)ch * 256 + 64 + lane] = f2bf(cim);
      const float nre = lre * cre - lim * cim + hre[k], nim = lre * cim + lim * cre + him[k];
      cre = nre; cim = nim;
    }
  }
}
DI void s5c_tile(const Params& p, const LP& L, int t, char* smem) {
  const int g = t / (S5_MT * 2), r = t % (S5_MT * 2), mt = r / 2, nt = r % 2;
  const int m0 = mt * 256, n0 = nt * 128;
  GA ga = make_ga((const bf16*)(p.ws + OFF_MIX + MX_US5) + (size_t)g * NTOK * 16, 256, (const bf16*)(L.s5 + S5_W2) + (size_t)g * 256 * 512, 512, 512, MCH);
  ga.A2 = (const bf16*)(p.ws + OFF_MIX + MX_HIN) + (size_t)g * MCH * 256; ga.lda2 = 256; ga.ksplit = 256;
  f32x4 acc[4][4];
  gemm_s<4>(ga, m0, n0, smem, acc);
  bf16* Z = (bf16*)(p.ws + OFF_MIX + MX_Z);
  EPI_BEGIN(4, acc, m0, n0, MCH)
#pragma unroll
    for (int k = 0; k < 8; ++k) v[k] = geluf_(v[k]);
    st8bf(Z + ((size_t)row * 16 + (col >> 4)) * 256 + g * 16 + (col & 15), v);
  EPI_END
}

DI float fmax_(float a, float b) { return a > b ? a : b; }
constexpr int AT_LDV = 76;
struct NaInfo { int r, qc, rs, cs; };
template <int DK, bool NA>
DI void attn_block(const bf16* qrow, bool active, const bf16* Kp, int kstride, const bf16* Vt,
                   int ka0, int ntile_a, int arow0, int kb0, int ntile_b,
                   const float* srpb, NaInfo ni, float scale, bf16* orow, char* smem) {
  constexpr int LDK = DK + 8, KCH = DK / 8;
  constexpr int KT_BYTES = 64 * LDK * 2, VT_BYTES = 64 * AT_LDV * 2;
  constexpr int NKL = (64 * KCH + NTHREADS - 1) / NTHREADS;
  const int tid = tid_(), lane = tid & 63, half = lane >> 5, r = lane & 31;
  bf16* sK = (bf16*)smem;
  bf16* sV = (bf16*)(smem + 2 * KT_BYTES);
  bf16x8 qf[DK / 16];
  f32x16 o0, o1;
  float m = -1e30f, l = 0.f;
#pragma unroll
  for (int ks = 0; ks < DK / 16; ++ks) qf[ks] = active ? *(const bf16x8*)(qrow + ks * 16 + 8 * half) : bf16x8{0, 0, 0, 0, 0, 0, 0, 0};
#pragma unroll
  for (int i = 0; i < 16; ++i) { o0[i] = 0.f; o1[i] = 0.f; }
  const int NTL = ntile_a + ntile_b;
  u32x4 rk[NKL], rv[1];
#pragma unroll
  for (int i = 0; i < NKL; ++i) rk[i] = u32x4{0u, 0u, 0u, 0u};
  auto key0_of = [&](int t) { return t < ntile_a ? ka0 + 64 * t : kb0 + 64 * (t - ntile_a); };
#define AT_GLOAD(t_) { const int k0_ = key0_of(t_); \
    _Pragma("unroll") for (int i_ = 0; i_ < NKL; ++i_) { const int c_ = tid + i_ * NTHREADS; const int key_ = c_ / KCH, ch_ = c_ % KCH; \
      if (c_ < 64 * KCH) rk[i_] = *(const u32x4*)(Kp + (size_t)(k0_ + key_) * kstride + ch_ * 8); } \
    { const int d_ = tid >> 3, ch_ = tid & 7; rv[0] = *(const u32x4*)(Vt + (size_t)d_ * TOK + k0_ + ch_ * 8); } }
#define AT_SSTORE(buf_) { \
    _Pragma("unroll") for (int i_ = 0; i_ < NKL; ++i_) { const int c_ = tid + i_ * NTHREADS; const int key_ = c_ / KCH, ch_ = c_ % KCH; \
      if (c_ < 64 * KCH) *(u32x4*)(sK + (buf_) * (64 * LDK) + key_ * LDK + ch_ * 8) = rk[i_]; } \
    { const int d_ = tid >> 3, ch_ = tid & 7; \
      bf16* dst_ = sV + (buf_) * (64 * AT_LDV) + d_ * AT_LDV + ch_ * 8; \
      *(uint2*)dst_ = make_uint2(rv[0][0], rv[0][1]); *(uint2*)(dst_ + 4) = make_uint2(rv[0][2], rv[0][3]); } }
  __syncthreads();
  AT_GLOAD(0) AT_SSTORE(0)
  __syncthreads();
#pragma unroll 1
  for (int t = 0; t < NTL; ++t) {
    const int buf = t & 1;
    if (t + 1 < NTL) AT_GLOAD(t + 1)
    bool doit = active;
    int trow0 = 0;
    if (NA && t < ntile_a) {
      trow0 = arow0 + t * (64 / GRID_W);
      doit = active && (trow0 + (64 / GRID_W) > ni.rs) && (trow0 < ni.rs + WIN_R);
    }
    if (doit) {
      const bf16* kb = sK + buf * (64 * LDK);
      const bf16* vb = sV + buf * (64 * AT_LDV);
      f32x16 s0, s1;
#pragma unroll
      for (int i = 0; i < 16; ++i) { s0[i] = 0.f; s1[i] = 0.f; }
#pragma unroll
      for (int ks = 0; ks < DK / 16; ++ks) {
        bf16x8 a0 = *(const bf16x8*)(kb + r * LDK + ks * 16 + 8 * half);
        bf16x8 a1 = *(const bf16x8*)(kb + (32 + r) * LDK + ks * 16 + 8 * half);
        s0 = __builtin_amdgcn_mfma_f32_32x32x16_bf16(a0, qf[ks], s0, 0, 0, 0);
        s1 = __builtin_amdgcn_mfma_f32_32x32x16_bf16(a1, qf[ks], s1, 0, 0, 0);
      }
      float mx = -INFINITY;
      if (NA && t < ntile_a) {
#pragma unroll
        for (int i = 0; i < 16; ++i) {
          const int kk = (i & 3) + 8 * (i >> 2) + 4 * half;
#pragma unroll
          for (int hb = 0; hb < 2; ++hb) {
            const int kq = kk + 32 * hb;
            const int kr = trow0 + kq / GRID_W, kc = kq % GRID_W;
            const bool ok = (kr >= ni.rs) && (kr < ni.rs + WIN_R) && (kc >= ni.cs) && (kc < ni.cs + WIN_C);
            const float bias = ok ? srpb[(kr - ni.r + 7) * 31 + (kc - ni.qc + 15)] : -INFINITY;
            if (hb == 0) { s0[i] = s0[i] * scale + bias; mx = fmax_(mx, s0[i]); }
            else { s1[i] = s1[i] * scale + bias; mx = fmax_(mx, s1[i]); }
          }
        }
      } else {
#pragma unroll
        for (int i = 0; i < 16; ++i) { s0[i] *= scale; s1[i] *= scale; mx = fmax_(mx, fmax_(s0[i], s1[i])); }
      }
      mx = fmax_(mx, shfl_xor_(mx, 32));
      const float mn = fmax_(m, mx);
      const float alpha = __expf(m - mn);
      m = mn;
      float ps = 0.f;
#pragma unroll
      for (int i = 0; i < 16; ++i) { s0[i] = __expf(s0[i] - mn); s1[i] = __expf(s1[i] - mn); ps += s0[i] + s1[i]; }
      l = l * alpha + ps;
#pragma unroll
      for (int i = 0; i < 16; ++i) { o0[i] *= alpha; o1[i] *= alpha; }
#pragma unroll
      for (int kq = 0; kq < 4; ++kq) {
        bf16x8 pf;
#pragma unroll
        for (int j = 0; j < 8; ++j) pf[j] = (short)f2bf((kq < 2) ? s0[8 * (kq & 1) + j] : s1[8 * (kq & 1) + j]);
        const bf16* v0 = vb + r * AT_LDV + 16 * kq + 4 * half;
        const bf16* v1 = vb + (r + 32) * AT_LDV + 16 * kq + 4 * half;
        uint2 a0 = *(const uint2*)v0, a1 = *(const uint2*)(v0 + 8), b0 = *(const uint2*)v1, b1 = *(const uint2*)(v1 + 8);
        bf16x8 va, vbb;
        va[0] = (short)(a0.x & 0xffff); va[1] = (short)(a0.x >> 16); va[2] = (short)(a0.y & 0xffff); va[3] = (short)(a0.y >> 16);
        va[4] = (short)(a1.x & 0xffff); va[5] = (short)(a1.x >> 16); va[6] = (short)(a1.y & 0xffff); va[7] = (short)(a1.y >> 16);
        vbb[0] = (short)(b0.x & 0xffff); vbb[1] = (short)(b0.x >> 16); vbb[2] = (short)(b0.y & 0xffff); vbb[3] = (short)(b0.y >> 16);
        vbb[4] = (short)(b1.x & 0xffff); vbb[5] = (short)(b1.x >> 16); vbb[6] = (short)(b1.y & 0xffff); vbb[7] = (short)(b1.y >> 16);
        o0 = __builtin_amdgcn_mfma_f32_32x32x16_bf16(va, pf, o0, 0, 0, 0);
        o1 = __builtin_amdgcn_mfma_f32_32x32x16_bf16(vbb, pf, o1, 0, 0, 0);
      }
    }
    if (t + 1 < NTL) AT_SSTORE(buf ^ 1)
    __syncthreads();
  }
  if (active) {
    const float lt = l + shfl_xor_(l, 32);
    const float inv = 1.0f / lt;
#pragma unroll
    for (int gI = 0; gI < 4; ++gI) {
      const int d0 = 8 * gI + 4 * half;
      *(uint2*)(orow + d0) = make_uint2(pack2(o0[4 * gI] * inv, o0[4 * gI + 1] * inv), pack2(o0[4 * gI + 2] * inv, o0[4 * gI + 3] * inv));
      *(uint2*)(orow + 32 + d0) = make_uint2(pack2(o1[4 * gI] * inv, o1[4 * gI + 1] * inv), pack2(o1[4 * gI + 2] * inv, o1[4 * gI + 3] * inv));
    }
  }
}
DI void mla_attn_item(const Params& p, int it, bool ctxq, char* smem) {
  const int nqb = ctxq ? (CTXL + 255) / 256 : SEQ / 256;
  const int b = it / (4 * nqb), h = (it / nqb) & 3, qb = it % nqb;
  const int lane = tid_() & 63, wid = tid_() >> 6;
  const int nq = ctxq ? CTXL : SEQ, q0 = qb * 256 + wid * 32;
  const bool active = q0 < nq;
  const int jq = (ctxq ? 0 : CTXL) + (active ? q0 : 0) + (lane & 31);
  const bf16* Q = (const bf16*)(p.ws + OFF_MIX + MX_Q) + ((size_t)b * 4 + h) * TOK * 96;
  const bf16* K = (const bf16*)(p.ws + OFF_MIX + MX_K) + ((size_t)b * 4 + h) * TOK * 96;
  const bf16* VT = (const bf16*)(p.ws + OFF_MIX + MX_VTM) + ((size_t)b * 4 + h) * 64 * TOK;
  bf16* O = (bf16*)(p.ws + OFF_O) + ((size_t)b * TOK + jq) * 1024 + 0 * 256 + h * 64;
  NaInfo ni; ni.r = 0; ni.qc = 0; ni.rs = 0; ni.cs = 0;
  attn_block<96, false>(Q + (size_t)jq * 96, active, K, 96, VT, 0, 0, 0, 0, (ctxq ? CTXL : TOK) / 64, nullptr, ni, 0.10206207261596577f, O, smem);
}
DI void na_attn_item(const Params& p, const LP& L, int it, bool ctxq, char* smem) {
  const int nqb = ctxq ? (CTXL + 255) / 256 : SEQ / 256;
  const int b = it / (4 * nqb), h = (it / nqb) & 3, qb = it % nqb;
  const int tid = tid_(), lane = tid & 63, wid = tid >> 6;
  const int nq = ctxq ? CTXL : SEQ, q0 = qb * 256 + wid * 32;
  const bool active = q0 < nq;
  const int jq = (ctxq ? 0 : CTXL) + (active ? q0 : 0) + (lane & 31);
  const bf16* P1 = (const bf16*)(p.ws + OFF_P1) + (size_t)b * TOK * P1W;
  const bf16* VT = (const bf16*)(p.ws + OFF_MIX + MX_VTN) + ((size_t)b * 4 + h) * 64 * TOK;
  const bf16* Kb = P1 + C_NA + 256 + h * 64;
  bf16* O = (bf16*)(p.ws + OFF_O) + ((size_t)b * TOK + jq) * 1024 + 1 * 256 + h * 64;
  constexpr int AT_END64 = 2 * (64 * 72 * 2) + 2 * (64 * AT_LDV * 2);
  float* srpb = (float*)(smem + AT_END64);
  NaInfo ni; ni.r = 0; ni.qc = 0; ni.rs = 0; ni.cs = 0;
  int ka0 = 0, nta = 0, arow0 = 0;
  if (!ctxq) {
    __syncthreads();
    const float* rpb = p.in[I_RPB] + ((size_t)L.l * 4 + h) * 15 * 31;
    for (int i = tid; i < 15 * 31; i += NTHREADS) srpb[i] = rpb[i];
    const int tl = q0 + (lane & 31);
    ni.r = tl / GRID_W; ni.qc = tl % GRID_W;
    int rs = ni.r - WIN_R / 2; rs = rs < 0 ? 0 : (rs > ROWS - WIN_R ? ROWS - WIN_R : rs);
    int cs = ni.qc - WIN_C / 2; cs = cs < 0 ? 0 : (cs > GRID_W - WIN_C ? GRID_W - WIN_C : cs);
    ni.rs = rs; ni.cs = cs;
    constexpr int RPT = 64 / GRID_W;
    const int rfirst = (qb * 256) / GRID_W, rlast = (qb * 256 + 255) / GRID_W;
    int rs_f = rfirst - WIN_R / 2; rs_f = rs_f < 0 ? 0 : (rs_f > ROWS - WIN_R ? ROWS - WIN_R : rs_f);
    int rs_l = rlast - WIN_R / 2; rs_l = rs_l < 0 ? 0 : (rs_l > ROWS - WIN_R ? ROWS - WIN_R : rs_l);
    arow0 = (rs_f / RPT) * RPT;
    const int row_hi = rs_l + WIN_R;
    nta = (row_hi - arow0 + RPT - 1) / RPT;
    ka0 = CTXL + arow0 * GRID_W;
  }
  attn_block<64, true>(P1 + (size_t)jq * P1W + C_NA + h * 64, active, Kb, P1W, VT, ka0, nta, arow0, 0, CTXL / 64, srpb, ni, 0.125f, O, smem);
}

constexpr int M2_LDB = 136, M2_LDX = 72;
constexpr int M2_OFF_B = 0;
constexpr int M2_OFF_C = M2_OFF_B + 64 * M2_LDB * 2;
constexpr int M2_OFF_HD = M2_OFF_C + 64 * M2_LDB * 2;
constexpr int M2H_H = 0;
constexpr int M2H_XT = M2H_H + 64 * M2_LDB * 2;
constexpr int M2H_BT = M2H_XT + 64 * M2_LDX * 2;
constexpr int M2H_S = M2H_BT + 128 * M2_LDX * 2;
constexpr int M2H_SIZE = M2H_S + 3 * 64 * 4;
constexpr int M2_SMEM = M2_OFF_HD + 2 * M2H_SIZE;
static_assert(M2_SMEM <= SMEM_BYTES, "m2 smem");
DI int m2_seq2tok(int sq, int dir) { return (dir == 0) ? sq : (sq < CTXL ? (CTXL - 1 - sq) : (TOK - 1 - (sq - CTXL))); }
DI void m2scan_item(const Params& p, const LP& L, int it, char* smem) {
  const int b = it / 4, grp = (it >> 1) & 1, dir = it & 1;
  const int tid = tid_(), lane = tid & 63, wid = tid >> 6, half = lane >> 5, r = lane & 31;
  const int hsel = wid >> 2, wl = wid & 3, hd = grp * 2 + hsel;
  bf16* sB = (bf16*)(smem + M2_OFF_B);
  bf16* sC = (bf16*)(smem + M2_OFF_C);
  char* hb = smem + M2_OFF_HD + hsel * M2H_SIZE;
  bf16* sH = (bf16*)(hb + M2H_H);
  bf16* sXT = (bf16*)(hb + M2H_XT);
  bf16* sBT = (bf16*)(hb + M2H_BT);
  float* sS = (float*)(hb + M2H_S);
  float* sDt = sS + 64;
  float* sW = sS + 128;
  const bf16* XB = (const bf16*)(p.ws + OFF_MIX + MX_XBC) + (size_t)b * TOK * 768;
  const float* DT = (const float*)(p.ws + OFF_DT) + (size_t)b * TOK * 8;
  float* YM = (float*)(p.ws + OFF_HA) + ((size_t)dir * NTOK + (size_t)b * TOK) * 256;
  const float a = -expf(p.in[I_M2ALOG][(L.l * 2 + dir) * 4 + hd]);
  const int pb = wl & 1, tb = wl >> 1, nb0 = 2 * (wl >> 1);
  f32x16 hst[2];
#pragma unroll
  for (int i = 0; i < 16; ++i) { hst[0][i] = 0.f; hst[1][i] = 0.f; }
  __syncthreads();
  for (int i = tid; i < 2 * M2H_SIZE / 4; i += NTHREADS) ((unsigned*)(smem + M2_OFF_HD))[i] = 0u;
  __syncthreads();
  u32x4 rx[2], rb[2], rc[2];
  float rdt = 0.f;
#define M2_GLOAD(c0_) { \
    _Pragma("unroll") for (int q_ = 0; q_ < 2; ++q_) { const int i_ = tid + q_ * NTHREADS; const int h2_ = i_ >> 9, t_ = (i_ >> 3) & 63, p8_ = (i_ & 7) * 8; \
      rx[q_] = *(const u32x4*)(XB + (size_t)m2_seq2tok((c0_) + t_, dir) * 768 + (grp * 2 + h2_) * 64 + p8_); } \
    _Pragma("unroll") for (int q_ = 0; q_ < 2; ++q_) { const int i_ = tid + q_ * NTHREADS; const int t_ = i_ >> 4, n8_ = (i_ & 15) * 8; \
      const bf16* src_ = XB + (size_t)m2_seq2tok((c0_) + t_, dir) * 768 + grp * 128 + n8_; \
      rb[q_] = *(const u32x4*)(src_ + 256); rc[q_] = *(const u32x4*)(src_ + 512); } \
    if (wl == 0) rdt = DT[(size_t)m2_seq2tok((c0_) + lane, dir) * 8 + dir * 4 + hd]; }
  M2_GLOAD(0)
  for (int c0 = 0; c0 < TOK; c0 += 64) {
    if (wl == 0) {
      const float dt = rdt;
      float cs = dt * a;
#pragma unroll
      for (int d = 1; d < 64; d <<= 1) { float o = shfl_up_(cs, d); if (lane >= d) cs += o; }
      const float sl = shfl_(cs, 63);
      sS[lane] = cs; sDt[lane] = dt; sW[lane] = dt * __expf(sl - cs);
    }
    __syncthreads();
#pragma unroll
    for (int q2 = 0; q2 < 2; ++q2) {
      const int i = tid + q2 * NTHREADS; const int h2 = i >> 9, t = (i >> 3) & 63, p8 = (i & 7) * 8;
      bf16* xt = (bf16*)(smem + M2_OFF_HD + h2 * M2H_SIZE + M2H_XT);
#pragma unroll
      for (int q = 0; q < 4; ++q) { xt[(p8 + 2 * q) * M2_LDX + t] = (bf16)(rx[q2][q] & 0xffff); xt[(p8 + 2 * q + 1) * M2_LDX + t] = (bf16)(rx[q2][q] >> 16); }
    }
#pragma unroll
    for (int q4 = 0; q4 < 2; ++q4) {
      const int i = tid + q4 * NTHREADS; const int t = i >> 4, n8 = (i & 15) * 8;
      *(u32x4*)(sB + t * M2_LDB + n8) = rb[q4];
      *(u32x4*)(sC + t * M2_LDB + n8) = rc[q4];
#pragma unroll
      for (int h2 = 0; h2 < 2; ++h2) {
        bf16* bt = (bf16*)(smem + M2_OFF_HD + h2 * M2H_SIZE + M2H_BT);
        const float w = ((const float*)(smem + M2_OFF_HD + h2 * M2H_SIZE + M2H_S))[128 + t];
#pragma unroll
        for (int q = 0; q < 4; ++q) {
          bt[(n8 + 2 * q) * M2_LDX + t] = f2bf(__uint_as_float(rb[q4][q] << 16) * w);
          bt[(n8 + 2 * q + 1) * M2_LDX + t] = f2bf(__uint_as_float(rb[q4][q] & 0xffff0000u) * w);
        }
      }
    }
    __syncthreads();
    if (c0 + 64 < TOK) M2_GLOAD(c0 + 64)
    {
      f32x16 yT, y2;
#pragma unroll
      for (int i = 0; i < 16; ++i) { yT[i] = 0.f; y2[i] = 0.f; }
      const int tv = 32 * tb + r;
      const float St = sS[tv];
      for (int sb = 0; sb <= tb; ++sb) {
        f32x16 gT;
#pragma unroll
        for (int i = 0; i < 16; ++i) gT[i] = 0.f;
#pragma unroll
        for (int ks = 0; ks < 8; ++ks) {
          bf16x8 av = *(const bf16x8*)(sB + (32 * sb + r) * M2_LDB + 16 * ks + 8 * half);
          bf16x8 bv = *(const bf16x8*)(sC + tv * M2_LDB + 16 * ks + 8 * half);
          gT = __builtin_amdgcn_mfma_f32_32x32x16_bf16(av, bv, gT, 0, 0, 0);
        }
#pragma unroll
        for (int i = 0; i < 16; ++i) {
          const int sv = 32 * sb + (i & 3) + 8 * (i >> 2) + 4 * half;
          const float m = (sv <= tv) ? gT[i] * sDt[sv] * __expf(St - sS[sv]) : 0.f;
          gT[i] = m;
        }
#pragma unroll
        for (int kq = 0; kq < 2; ++kq) {
          bf16x8 pf;
#pragma unroll
          for (int j = 0; j < 8; ++j) pf[j] = (short)f2bf(gT[8 * kq + j]);
          const bf16* xr = sXT + (32 * pb + r) * M2_LDX + 32 * sb + 16 * kq + 4 * half;
          uint2 x0 = *(const uint2*)xr, x1 = *(const uint2*)(xr + 8);
          bf16x8 xa;
          xa[0] = (short)(x0.x & 0xffff); xa[1] = (short)(x0.x >> 16); xa[2] = (short)(x0.y & 0xffff); xa[3] = (short)(x0.y >> 16);
          xa[4] = (short)(x1.x & 0xffff); xa[5] = (short)(x1.x >> 16); xa[6] = (short)(x1.y & 0xffff); xa[7] = (short)(x1.y >> 16);
          yT = __builtin_amdgcn_mfma_f32_32x32x16_bf16(xa, pf, yT, 0, 0, 0);
        }
      }
#pragma unroll
      for (int ks = 0; ks < 8; ++ks) {
        bf16x8 av = *(const bf16x8*)(sH + (32 * pb + r) * M2_LDB + 16 * ks + 8 * half);
        bf16x8 bv = *(const bf16x8*)(sC + tv * M2_LDB + 16 * ks + 8 * half);
        y2 = __builtin_amdgcn_mfma_f32_32x32x16_bf16(av, bv, y2, 0, 0, 0);
      }
      const float eS = __expf(St);
      const int j = m2_seq2tok(c0 + tv, dir);
      float* yo = YM + (size_t)j * 256 + hd * 64 + 32 * pb + 4 * half;
#pragma unroll
      for (int gI = 0; gI < 4; ++gI)
        *(float4*)(yo + 8 * gI) = make_float4(yT[4 * gI] + eS * y2[4 * gI], yT[4 * gI + 1] + eS * y2[4 * gI + 1], yT[4 * gI + 2] + eS * y2[4 * gI + 2], yT[4 * gI + 3] + eS * y2[4 * gI + 3]);
    }
    __syncthreads();
    {
      const float eL = __expf(sS[63]);
#pragma unroll
      for (int q = 0; q < 2; ++q) {
#pragma unroll
        for (int i = 0; i < 16; ++i) hst[q][i] *= eL;
#pragma unroll
        for (int ks = 0; ks < 4; ++ks) {
          bf16x8 av = *(const bf16x8*)(sXT + (32 * pb + r) * M2_LDX + 16 * ks + 8 * half);
          bf16x8 bv = *(const bf16x8*)(sBT + (32 * (nb0 + q) + r) * M2_LDX + 16 * ks + 8 * half);
          hst[q] = __builtin_amdgcn_mfma_f32_32x32x16_bf16(av, bv, hst[q], 0, 0, 0);
        }
#pragma unroll
        for (int i = 0; i < 16; ++i) {
          const int pv = 32 * pb + (i & 3) + 8 * (i >> 2) + 4 * half;
          sH[pv * M2_LDB + 32 * (nb0 + q) + r] = f2bf(hst[q][i]);
        }
      }
    }
    __syncthreads();
  }
}
DI void m2gate_item(const Params& p, const LP& L, int it) {
  const int tok = it * NWAVES + (tid_() >> 6), lane = tid_() & 63;
  const float* Y0 = (const float*)(p.ws + OFF_HA) + (size_t)tok * 256;
  const float* Y1 = Y0 + (size_t)NTOK * 256;
  const bf16* XB = (const bf16*)(p.ws + OFF_MIX + MX_XBC) + (size_t)tok * 768;
  const bf16* P1 = (const bf16*)(p.ws + OFF_P1) + (size_t)tok * P1W + C_Z;
  const int c = lane * 4, hd = c >> 6;
  const float dsk = p.in[I_M2D][L.l * 4 + hd];
  float4 y0 = *(const float4*)(Y0 + c), y1 = *(const float4*)(Y1 + c);
  uint2 xw = *(const uint2*)(XB + c), zw = *(const uint2*)(P1 + c);
  float xs[4] = {__uint_as_float(xw.x << 16), __uint_as_float(xw.x & 0xffff0000u), __uint_as_float(xw.y << 16), __uint_as_float(xw.y & 0xffff0000u)};
  float zs[4] = {__uint_as_float(zw.x << 16), __uint_as_float(zw.x & 0xffff0000u), __uint_as_float(zw.y << 16), __uint_as_float(zw.y & 0xffff0000u)};
  float ys[4] = {y0.x + y1.x, y0.y + y1.y, y0.z + y1.z, y0.w + y1.w};
  float v[4], ss = 0.f;
#pragma unroll
  for (int i = 0; i < 4; ++i) { v[i] = (ys[i] + dsk * xs[i]) * siluf_(zs[i]); ss += v[i] * v[i]; }
  ss = wave_sum(ss);
  const float rs = rsqrtf(ss * (1.f / 256.f) + EPS);
  float4 gn = *(const float4*)(p.in[I_M2GNORM] + L.l * 256 + c);
  bf16* O = (bf16*)(p.ws + OFF_O) + (size_t)tok * 1024 + 768 + c;
  *(uint2*)O = make_uint2(pack2(v[0] * rs * gn.x, v[1] * rs * gn.y), pack2(v[2] * rs * gn.z, v[3] * rs * gn.w));
}
constexpr int GLU_MT = (NTOK + 255) / 256;
DI void glu_tile(const Params& p, const LP& L, int t, char* smem) {
  const int mt = t % GLU_MT, nt = t / GLU_MT, m0 = mt * 256, n0 = nt * 128;
  const bf16* Z = (const bf16*)(p.ws + OFF_MIX + MX_Z);
  GA g = make_ga(Z, 256, (const bf16*)(L.we + WE_GLU), 256, 256, NTOK);
  f32x4 acc[4][4];
  gemm_s<4>(g, m0, n0, smem, acc);
  bf16* O = (bf16*)(p.ws + OFF_O);
  const float* bg = p.in[I_S5BGLU] + L.l * 256;
  EPI_BEGIN(4, acc, m0, n0, NTOK)
    float z[8]; ld8bf(Z + (size_t)row * 256 + col, z);
#pragma unroll
    for (int k = 0; k < 8; ++k) v[k] = z[k] * sigmoidf_(v[k] + bg[col + k]);
    st8bf(O + (size_t)row * 1024 + 512 + col, v);
  EPI_END
}
DI void merge_tile(const Params& p, const LP& L, int t, char* smem) {
  constexpr int MT_L = BATCH * (SEQ / 256), MT_A = (NTOK + 255) / 256;
  const int mt = L.last ? t % MT_L : t % MT_A, nt = L.last ? t / MT_L : t / MT_A, m0 = mtile_row0(mt, L.last, 256), n0 = nt * 64;
  const bf16* O = (const bf16*)(p.ws + OFF_O);
  const bf16* PG = (const bf16*)(p.ws + OFF_PG);
  float tot[4][8];
#pragma unroll
  for (int a = 0; a < 4; ++a)
#pragma unroll
    for (int k = 0; k < 8; ++k) tot[a][k] = 0.f;
  for (int j = 0; j < 4; ++j) {
    GA g = make_ga(O + j * 256, 1024, (const bf16*)(L.we + WE_WB) + (size_t)j * 1024 * 256, 256, 256, NTOK);
    f32x4 acc[4][2];
    gemm_s<2>(g, m0, n0, smem, acc);
    EPI_BEGIN(2, acc, m0, n0, NTOK)
      float gt[8]; ld8bf(PG + (size_t)row * 4096 + j * 1024 + col, gt);
#pragma unroll
      for (int k = 0; k < 8; ++k) tot[_m][k] += gt[k] * v[k];
    EPI_END
  }
  bf16* Y = (bf16*)(p.ws + OFF_P1);
  {
    const int l = tid_() & 63, w = tid_() >> 6, wr = w >> 1, wc = w & 1, fr = l & 15, fq = l >> 4;
#pragma unroll
    for (int m = 0; m < 4; ++m) {
      const int row = m0 + wr * 64 + m * 16 + fr, col = n0 + wc * 32 + 8 * fq;
      if (row < NTOK) st8bf(Y + (size_t)row * 1024 + col, tot[m]);
    }
  }
}
DI void outproj_tile(const Params& p, const LP& L, int t, char* smem) {
  float* Y2 = (float*)(p.ws + OFF_HA);
  constexpr int MT_L = BATCH * (SEQ / 256), MT_A = (NTOK + 255) / 256;
  const int mt = L.last ? t % MT_L : t % MT_A, nt = L.last ? t / MT_L : t / MT_A, m0 = mtile_row0(mt, L.last, 256), n0 = nt * 256;
  GA g = make_ga((const bf16*)(p.ws + OFF_P1), 1024, (const bf16*)(L.we + WE_WOUT), 1024, 1024, NTOK);
  f32x4 acc[2][2][4][2];
  gemm_big(g, m0, n0, smem, acc);
  EPIB_BEGIN(acc, m0, n0, NTOK)
    st8f(Y2 + (size_t)row * 1024 + col, v);
  EPIB_END
}
DI int post_ntok(bool latonly) { return latonly ? BATCH * SEQ : NTOK; }
DI int post_tok(int i, bool latonly) { return latonly ? ((i / SEQ) * TOK + CTXL + (i % SEQ)) : i; }

DI void post_item(const Params& p, const LP& L, int it) {
  const int tok = post_tok(it * NWAVES + (tid_() >> 6), L.last), lane = tid_() & 63;
  float* X = (float*)(p.ws + OFF_X) + (size_t)tok * 1024;
  const float* Y2 = (const float*)(p.ws + OFF_HA) + (size_t)tok * 1024;
  const float* mod = L.mod + (size_t)tok_modrow(tok) * 6144;
  float yv[16], xv[16], h[16];
  float ss = 0.f;
#pragma unroll
  for (int i = 0; i < 4; ++i) {
    float4 v = *(const float4*)(Y2 + lane * 4 + i * 256);
    yv[i * 4] = v.x; yv[i * 4 + 1] = v.y; yv[i * 4 + 2] = v.z; yv[i * 4 + 3] = v.w;
    ss += v.x * v.x + v.y * v.y + v.z * v.z + v.w * v.w;
  }
  ss = wave_sum(ss);
  const float rs = rsqrtf(ss * (1.f / 1024.f) + EPS);
  const float* gpm = p.in[I_GPOSTMIX] + L.l * 1024;
#pragma unroll
  for (int i = 0; i < 4; ++i) {
    int c = lane * 4 + i * 256;
    float4 xo = *(const float4*)(X + c), gv = *(const float4*)(gpm + c), gt = *(const float4*)(mod + 2048 + c);
    xo.x += gt.x * yv[i * 4] * rs * gv.x; xo.y += gt.y * yv[i * 4 + 1] * rs * gv.y; xo.z += gt.z * yv[i * 4 + 2] * rs * gv.z; xo.w += gt.w * yv[i * 4 + 3] * rs * gv.w;
    *(float4*)(X + c) = xo;
    xv[i * 4] = xo.x; xv[i * 4 + 1] = xo.y; xv[i * 4 + 2] = xo.z; xv[i * 4 + 3] = xo.w;
  }
  bf16* H2 = (bf16*)(p.ws + OFF_P1) + (size_t)NTOK * 1024 + (size_t)tok * 1024;
  normmod_row(xv, p.in[I_GPREFFN] + L.l * 1024, mod + 3072, mod + 4096, H2, h);
  const float* wr = p.in[I_WROUTER] + (size_t)L.l * 1024 * 16;
  float lg[16];
#pragma unroll
  for (int e = 0; e < 16; ++e) lg[e] = 0.f;
#pragma unroll
  for (int i = 0; i < 16; ++i) {
    int k = lane * 4 + (i >> 2) * 256 + (i & 3);
    const float4* w4 = (const float4*)(wr + (size_t)k * 16);
    float4 a = w4[0], b4 = w4[1], c4 = w4[2], d4 = w4[3];
    float hv = h[i];
    lg[0] += hv * a.x; lg[1] += hv * a.y; lg[2] += hv * a.z; lg[3] += hv * a.w;
    lg[4] += hv * b4.x; lg[5] += hv * b4.y; lg[6] += hv * b4.z; lg[7] += hv * b4.w;
    lg[8] += hv * c4.x; lg[9] += hv * c4.y; lg[10] += hv * c4.z; lg[11] += hv * c4.w;
    lg[12] += hv * d4.x; lg[13] += hv * d4.y; lg[14] += hv * d4.z; lg[15] += hv * d4.w;
  }
  float mx = -INFINITY;
#pragma unroll
  for (int e = 0; e < 16; ++e) { lg[e] = wave_sum(lg[e]); mx = fmax_(mx, lg[e]); }
  float se = 0.f;
#pragma unroll
  for (int e = 0; e < 16; ++e) { lg[e] = expf(lg[e] - mx); se += lg[e]; }
  if (lane < 16) {
    float v = 0.f;
#pragma unroll
    for (int e = 0; e < 16; ++e) if (e == lane) v = lg[e];
    ((float*)(p.ws + OFF_AFF))[(size_t)lane * NTOK + tok] = v / se;
  }
}
DI int block_sum_(int v, int* sred, int round) {
  const int tid = tid_(), lane = tid & 63, wid = tid >> 6;
  v += shfl_xor_(v, 32); v += shfl_xor_(v, 16); v += shfl_xor_(v, 8); v += shfl_xor_(v, 4); v += shfl_xor_(v, 2); v += shfl_xor_(v, 1);
  int* r = sred + (round & 1) * NWAVES;
  if (lane == 0) r[wid] = v;
  __syncthreads();
  int tsum = 0;
#pragma unroll
  for (int q = 0; q < NWAVES; ++q) tsum += r[q];
  return tsum;
}
DI void route_item(const Params& p, const LP& L, int it, char* smem) {
  const int nstream = L.last ? 1 : 2;
  const int b = it / (16 * nstream), e = (it / nstream) & 15, ctxs = (nstream == 2) ? (it & 1) : 0;
  const int T = ctxs ? CTXL : SEQ, cap = ctxs ? CAP_C : CAP_L;
  const int tok0 = b * TOK + (ctxs ? 0 : CTXL);
  const int slot0 = ctxs ? (BATCH * CAP_L + b * CAP_C) : (b * CAP_L);
  int* sred = (int*)smem;
  const float* AFF = (const float*)(p.ws + OFF_AFF) + (size_t)e * NTOK + tok0;
  int* SEL = (int*)(p.ws + OFF_SEL);
  int* IDX = (int*)(p.ws + OFF_IDX) + (size_t)e * ESLOTS;
  float* GW = (float*)(p.ws + OFF_GW) + (size_t)e * ESLOTS;
  const int tid = tid_(), lane = tid & 63, wid = tid >> 6;
  constexpr int MAXPER = (SEQ + NTHREADS - 1) / NTHREADS;
  const int per = (T + NTHREADS - 1) / NTHREADS;
  unsigned key[MAXPER];
  __syncthreads();
#pragma unroll
  for (int k = 0; k < MAXPER; ++k) {
    int i = tid * per + k;
    key[k] = (k < per && i < T) ? (__float_as_uint(AFF[i]) + 1u) : 0u;
  }
  unsigned thr = 0u;
  int round = 0;
  for (int bit = 30; bit >= 0; --bit) {
    const unsigned cand = thr | (1u << bit);
    int c = 0;
#pragma unroll
    for (int k = 0; k < MAXPER; ++k) c += (key[k] >= cand) ? 1 : 0;
    c = block_sum_(c, sred, round++);
    if (c >= cap) thr = cand;
  }
  int cg = 0, ce = 0;
#pragma unroll
  for (int k = 0; k < MAXPER; ++k) { cg += (key[k] > thr) ? 1 : 0; ce += (key[k] == thr) ? 1 : 0; }
  const int tot_gt = block_sum_(cg, sred, round++);
  const int need_eq = cap - tot_gt;
  int v = cg | (ce << 16), inc = v;
#pragma unroll
  for (int d = 1; d < 64; d <<= 1) { int o = shfl_up_(inc, d); if (lane >= d) inc += o; }
  int* soff = sred + 2 * NWAVES;
  __syncthreads();
  if (lane == 63) soff[wid] = inc;
  __syncthreads();
  int base = 0;
  for (int w = 0; w < wid; ++w) base += soff[w];
  int excl = base + inc - v;
  int gt_before = excl & 0xffff, eq_before = excl >> 16;
#pragma unroll
  for (int k = 0; k < MAXPER; ++k) {
    int i = tid * per + k;
    if (k < per && i < T) {
      const bool isgt = key[k] > thr, iseq = key[k] == thr;
      const bool sel = isgt || (iseq && eq_before < need_eq);
      const int slot = slot0 + gt_before + (eq_before < need_eq ? eq_before : need_eq);
      if (sel) { IDX[slot] = tok0 + i; GW[slot] = __uint_as_float(key[k] - 1u); SEL[(size_t)(tok0 + i) * 16 + e] = slot; }
      else SEL[(size_t)(tok0 + i) * 16 + e] = -1;
      gt_before += isgt ? 1 : 0; eq_before += iseq ? 1 : 0;
    }
  }
}
DI void moe1_tile(const Params& p, const LP& L, int t, char* smem) {
  const int nslots = L.last ? ESLOTS_L : ESLOTS;
  constexpr int MT_L = (ESLOTS_L + 255) / 256, MT_A = (ESLOTS + 255) / 256;
  const int e = L.last ? t / (MT_L * 8) : t / (MT_A * 8), r = L.last ? t % (MT_L * 8) : t % (MT_A * 8), mt = L.last ? r % MT_L : r % MT_A, nt = L.last ? r / MT_L : r / MT_A;
  const int m0 = mt * 256, n0 = nt * 256;
  GA g = make_ga((const bf16*)(p.ws + OFF_P1) + (size_t)NTOK * 1024, 1024, (const bf16*)(p.ws + OFF_MIX + WX_GU) + (size_t)e * 2048 * 1024, 1024, 1024, nslots);
  g.ridx = (const int*)(p.ws + OFF_IDX) + (size_t)e * ESLOTS;
  f32x4 acc[2][2][4][2];
  gemm_big(g, m0, n0, smem, acc);
  bf16* ACT = (bf16*)(p.ws + OFF_PG) + (size_t)e * ESLOTS * 1024;
  {
    const int l = tid_() & 63, w = tid_() >> 6, wr = w >> 2, wc = w & 3, fr = l & 15, fq = l >> 4;
#pragma unroll
    for (int ai = 0; ai < 2; ++ai)
#pragma unroll
      for (int m = 0; m < 4; ++m) {
        const int row = m0 + ai * 128 + wr * 64 + m * 16 + fr;
        float a[8];
#pragma unroll
        for (int k = 0; k < 4; ++k) { a[k] = siluf_(acc[ai][0][m][0][k]) * acc[ai][1][m][0][k]; a[4 + k] = siluf_(acc[ai][0][m][1][k]) * acc[ai][1][m][1][k]; }
        if (row < nslots) st8bf(ACT + (size_t)row * 1024 + nt * 128 + wc * 32 + 8 * fq, a);
      }
  }
}
DI void moe2_tile(const Params& p, const LP& L, int t, char* smem) {
  const int nslots = L.last ? ESLOTS_L : ESLOTS;
  constexpr int MT_L = (ESLOTS_L + 255) / 256, MT_A = (ESLOTS + 255) / 256;
  const int e = L.last ? t / (MT_L * 4) : t / (MT_A * 4), r = L.last ? t % (MT_L * 4) : t % (MT_A * 4), mt = L.last ? r % MT_L : r % MT_A, nt = L.last ? r / MT_L : r / MT_A;
  const int m0 = mt * 256, n0 = nt * 256;
  GA g = make_ga((const bf16*)(p.ws + OFF_PG) + (size_t)e * ESLOTS * 1024, 1024, (const bf16*)(p.ws + OFF_MIX + WX_DN) + (size_t)e * 1024 * 1024, 1024, 1024, nslots);
  f32x4 acc[2][2][4][2];
  gemm_big(g, m0, n0, smem, acc);
  bf16* YS = (bf16*)(p.ws + OFF_PG) + (size_t)NE * ESLOTS * 1024 + (size_t)e * ESLOTS * 1024;
  const float* GW = (const float*)(p.ws + OFF_GW) + (size_t)e * ESLOTS;
  EPIB_BEGIN(acc, m0, n0, nslots)
    const float gw = GW[row];
#pragma unroll
    for (int k = 0; k < 8; ++k) v[k] *= gw;
    st8bf(YS + (size_t)row * 1024 + col, v);
  EPIB_END
}
DI void comb_item(const Params& p, const LP& L, int it) {
  const int tok = post_tok(it * NWAVES + (tid_() >> 6), L.last), lane = tid_() & 63;
  float* X = (float*)(p.ws + OFF_X) + (size_t)tok * 1024;
  const int* SEL = (const int*)(p.ws + OFF_SEL) + (size_t)tok * 16;
  const bf16* YS = (const bf16*)(p.ws + OFF_PG) + (size_t)NE * ESLOTS * 1024;
  const float* mod = L.mod + (size_t)tok_modrow(tok) * 6144;
  float s[16];
#pragma unroll
  for (int i = 0; i < 16; ++i) s[i] = 0.f;
  for (int e = 0; e < 16; ++e) {
    int sl = SEL[e];
    if (sl >= 0) {
      const bf16* yr = YS + ((size_t)e * ESLOTS + sl) * 1024;
#pragma unroll
      for (int i = 0; i < 4; ++i) {
        uint2 w = *(const uint2*)(yr + lane * 4 + i * 256);
        s[i * 4] += __uint_as_float(w.x << 16); s[i * 4 + 1] += __uint_as_float(w.x & 0xffff0000u);
        s[i * 4 + 2] += __uint_as_float(w.y << 16); s[i * 4 + 3] += __uint_as_float(w.y & 0xffff0000u);
      }
    }
  }
  float ss = 0.f;
#pragma unroll
  for (int i = 0; i < 16; ++i) ss += s[i] * s[i];
  ss = wave_sum(ss);
  const float rs = rsqrtf(ss * (1.f / 1024.f) + EPS);
  const float* gpf = p.in[I_GPOSTFFN] + L.l * 1024;
  float xv[16], h[16];
  float* dst = X;
  if (L.last) { const int b = tok_b(tok), j = tok_j(tok); dst = p.out + ((size_t)b * SEQ + (j - CTXL)) * 1024; }
#pragma unroll
  for (int i = 0; i < 4; ++i) {
    int c = lane * 4 + i * 256;
    float4 xo = *(const float4*)(X + c), gv = *(const float4*)(gpf + c), gt = *(const float4*)(mod + 5120 + c);
    xo.x += gt.x * s[i * 4] * rs * gv.x; xo.y += gt.y * s[i * 4 + 1] * rs * gv.y; xo.z += gt.z * s[i * 4 + 2] * rs * gv.z; xo.w += gt.w * s[i * 4 + 3] * rs * gv.w;
    *(float4*)(dst + c) = xo;
    xv[i * 4] = xo.x; xv[i * 4 + 1] = xo.y; xv[i * 4 + 2] = xo.z; xv[i * 4 + 3] = xo.w;
  }
  if (!L.last) {
    const float* mod1 = (const float*)(p.ws + OFF_MOD) + ((size_t)(L.l + 1) * NB1 + tok_modrow(tok)) * 6144;
    normmod_row(xv, p.in[I_GPREMIX] + (L.l + 1) * 1024, mod1, mod1 + 1024, (bf16*)(p.ws + OFF_HA) + (size_t)tok * 1024, h);
  }
}

enum { PH_PREP0 = 0, PH_PREP1, PH_L0 };
enum { LP_INPROJ = 0, LP_TOKPREP, LP_MIX1, LP_MIX2, LP_GLU, LP_MERGE, LP_OUT, LP_POST, LP_ROUTE, LP_MOE1, LP_MOE2, LP_COMB, LP_COUNT };
constexpr int NPHASES = PH_L0 + DEPTH * LP_COUNT;


DI void run_phase(const Params& p, int ph, char* smem) {
  const int G = gridDim.x;
  int start = blockIdx.x;
  auto seg = [&](int n, auto&& fn) {
    for (; start < n; start += G) fn(start);
    start -= n;
  };
#ifdef ONLY_PREP
  if (ph >= PH_L0) return;
#endif
  if (ph == PH_PREP0) {
    seg(DEPTH * 96, [&](int it) { mod_item(p, it, smem); });
    seg(DEPTH * 32, [&](int it) { s5_tab_item(p, it, smem); });
    seg(1, [&](int) { rope_tab_item(p); });
    seg(DEPTH * CT_EARLY, [&](int it) { conv_early_item(p, it / CT_EARLY, it % CT_EARLY, smem); });
    return;
  }
  if (ph == PH_PREP1) {
    seg(DEPTH * 64, [&](int it) { s5_mat_item(p, it); });
    seg(NTOK / NWAVES, [&](int it) { prep_row_item(p, it); });
    return;
  }
#ifdef ONLY_LPH
  if (ph < PH_L0) return;
#endif
  const int l = (ph - PH_L0) / LP_COUNT;
#ifdef ONLY_LPH
  const int lph = ONLY_LPH;
#else
  const int lph = (ph - PH_L0) % LP_COUNT;
#endif
  const LP L = make_lp(p, l);
  switch (lph) {
    case LP_INPROJ:
      seg(IP_SLOTS, [&](int it) { inproj_tile(p, L, it, smem); });
      break;
    case LP_TOKPREP:
      seg(16 * S5_MT * 2, [&](int it) { s5a_tile(p, L, it, smem); });
      seg(TP_MT * 3, [&](int it) { mlaq_tile(p, L, it, smem); });
      seg(TP_MT * 4, [&](int it) { mlakv_tile(p, L, it, smem); });
      seg(NTOK / 64, [&](int it) { navt_item(p, it, smem); });
      seg(NTOK / 32, [&](int it) { m2conv_item(p, L, it); });
      break;
    case LP_MIX1: {
      const int n0 = BATCH * 4, n1 = n0 + 2 * 16 * BATCH / NWAVES, n2 = n1 + BATCH * 4 * (SEQ / 256), n3 = n2 + BATCH * 4 * (SEQ / 256);
      const int n4 = n3 + (L.last ? 0 : BATCH * 4 * ((CTXL + 255) / 256)), n5 = n4 + (L.last ? 0 : BATCH * 4 * ((CTXL + 255) / 256));
      int* qhead = (int*)(p.ws + OFF_BAR) + Q_WORD0 + 64 * l;
#ifdef EMU
      volatile int* bc = (volatile int*)(smem + SMEM_BYTES + 8);
#else
      volatile LAS int* bc = (volatile LAS int*)(smem + SMEM_BYTES + 8);
#endif
      for (;;) {
        __syncthreads();
        if (tid_() == 0) {
#ifdef EMU
          *bc = atomicAdd(qhead, 1);
#else
          *bc = __hip_atomic_fetch_add(qhead, 1, __ATOMIC_RELAXED, __HIP_MEMORY_SCOPE_AGENT);
#endif
        }
        __syncthreads();
        const int it = *bc;
        if (it >= n5) break;
        if (it < n0) m2scan_item(p, L, it, smem);
        else if (it < n1) s5carry_item(p, L, it - n0);
        else if (it < n2) mla_attn_item(p, it - n1, false, smem);
        else if (it < n3) na_attn_item(p, L, it - n2, false, smem);
        else if (it < n4) mla_attn_item(p, it - n3, true, smem);
        else na_attn_item(p, L, it - n4, true, smem);
      }
    } break;
    case LP_MIX2:
      seg(16 * S5_MT * 2, [&](int it) { s5c_tile(p, L, it, smem); });
      seg(NTOK / NWAVES, [&](int it) { m2gate_item(p, L, it); });
      break;
    case LP_GLU:
      seg(GLU_MT * 2, [&](int it) { glu_tile(p, L, it, smem); });
      break;
    case LP_MERGE:
      seg(mtiles(L.last, 256) * 16, [&](int it) { merge_tile(p, L, it, smem); });
      break;
    case LP_OUT:
      seg(mtiles(L.last, 256) * 4, [&](int it) { outproj_tile(p, L, it, smem); });
      break;
    case LP_POST:
      seg(CT_EXP, [&](int it) { conv_expert_item(p, l, it, smem); });
      seg(post_ntok(L.last) / NWAVES, [&](int it) { post_item(p, L, it); });
      break;
    case LP_ROUTE:
      seg(BATCH * 16 * (L.last ? 1 : 2), [&](int it) { route_item(p, L, it, smem); });
      break;
    case LP_MOE1:
      seg(NE * (((L.last ? ESLOTS_L : ESLOTS) + 255) / 256) * 8, [&](int it) { moe1_tile(p, L, it, smem); });
      break;
    case LP_MOE2:
      seg(NE * (((L.last ? ESLOTS_L : ESLOTS) + 255) / 256) * 4, [&](int it) { moe2_tile(p, L, it, smem); });
      break;
    case LP_COMB:
      seg(post_ntok(L.last) / NWAVES, [&](int it) { comb_item(p, L, it); });
      break;
  }
}

__global__ void __launch_bounds__(NTHREADS, 2) mega_kernel(Params p) {
#ifdef EMU
  char* smem = emu_cur_f->blk->smem;
  for (int ph = p.phase_lo; ph < p.phase_hi; ++ph) {
    run_phase(p, ph, smem);
    if (ph + 1 < p.phase_hi) emu_grid_sync();
  }
#else
  __shared__ __attribute__((aligned(16))) char smem[SMEM_BYTES + 16];
  if (p.phase_hi - p.phase_lo > 1) {
    if (threadIdx.x == 0) *(uint4*)(smem + SMEM_BYTES) = make_uint4(0u, 0u, 0u, 0u);
    __syncthreads();
    XcdBarrier xb = xcd_barrier_post((unsigned*)(p.ws + OFF_BAR), (volatile LAS unsigned*)(smem + SMEM_BYTES));
    for (int ph = p.phase_lo; ph < p.phase_hi; ++ph) {
      run_phase(p, ph, smem);
#ifdef PROBE_PHASE
      if (ph == PROBE_PHASE || ph == PROBE_PHASE2) { for (int rep = 0; rep < PROBE_REP; ++rep) { xcd_barrier(xb); run_phase(p, ph, smem); } }
#endif

      if (ph + 1 < p.phase_hi) {
        if (ph == p.phase_lo) cg::this_grid().sync();
        else xcd_barrier(xb);
      }
    }
  } else {
    run_phase(p, p.phase_lo, smem);
  }
#endif
}

#ifndef EMU
extern "C" void kernel_launch(void* const* d_in, const int* in_sizes, int n_in, void* d_out, int out_size, void* d_ws, size_t ws_size,
                              hipStream_t stream) {
  static int grid_blocks = 0;
  if (!grid_blocks) {
    int dev = 0, cus = 0, per_cu = 0;
    hipGetDevice(&dev);
    hipDeviceGetAttribute(&cus, hipDeviceAttributeMultiprocessorCount, dev);
    hipOccupancyMaxActiveBlocksPerMultiprocessor(&per_cu, mega_kernel, NTHREADS, 0);
    if (per_cu > 1) per_cu = 1;
    if (per_cu < 1) per_cu = 1;
    grid_blocks = cus * per_cu;
    if (ws_size < WS_TOTAL) fprintf(stderr, "workspace too small: %zu < %zu\n", ws_size, (size_t)WS_TOTAL);
  }
  Params p{};
  for (int i = 0; i < N_INPUTS; ++i) p.in[i] = (const float*)d_in[i];
  p.out = (float*)d_out;
  p.ws = (char*)d_ws;
#if MK_MULTI
  for (int ph = 0; ph < NPHASES; ++ph) {
    p.phase_lo = ph; p.phase_hi = ph + 1;
    hipLaunchKernelGGL(mega_kernel, dim3(grid_blocks), dim3(NTHREADS), 0, stream, p);
  }
#else
  p.phase_lo = 0; p.phase_hi = NPHASES;
  hipMemsetAsync((char*)d_ws + OFF_BAR, 0, BAR_BYTES, stream);
  void* args[] = {&p};
  hipError_t e = hipLaunchCooperativeKernel((void*)mega_kernel, dim3(grid_blocks), dim3(NTHREADS), args, 0, stream);
  if (e != hipSuccess) fprintf(stderr, "cooperative launch failed: %s (grid %d)\n", hipGetErrorString(e), grid_blocks);
#endif
}
#endif
```

```cpp
#ifdef EMU
#include "emu.h"
#else
#include <hip/hip_runtime.h>
#include <hip/hip_cooperative_groups.h>
#include <cstdio>
namespace cg = cooperative_groups;
using bf16x8 = __attribute__((ext_vector_type(8))) short;
using f32x4 = __attribute__((ext_vector_type(4))) float;
using f32x16 = __attribute__((ext_vector_type(16))) float;
#endif
using u32x4 = __attribute__((ext_vector_type(4))) unsigned;
#ifndef MK_MULTI
#define MK_MULTI 0
#endif

#define DI __device__ __forceinline__
typedef unsigned short bf16;

#ifdef EMU_SMALL
constexpr int BATCH = 2, SEQ = 512, CTXL = 64, GRID_W = 32;
#else
constexpr int BATCH = 8, SEQ = 2048, CTXL = 256, GRID_W = 64;
#endif
constexpr int D = 1024, DEPTH = 2;
constexpr int TOK = CTXL + SEQ, NTOK = BATCH * TOK;
constexpr int ROWS = SEQ / GRID_W;
constexpr int WIN_R = (ROWS < 8 ? ROWS : 8), WIN_C = 16;
constexpr int N_IN = 6568, N_INP = 6656;
constexpr int C_CQ = 0, C_CKV = 256, C_KR = 384, C_NA = 416, C_S5 = 1184, C_Z = 1440, C_XBC = 1696, C_DT = 2464, C_GATE = 2472;
constexpr int P1W = 2480;
constexpr int NCH = TOK / 16, NCC = CTXL / 16, MCH = BATCH * NCH;
constexpr int NE = 16;
constexpr int CAP_L = 2 * SEQ / NE, CAP_C = 2 * CTXL / NE;
constexpr int ESLOTS = BATCH * (CAP_L + CAP_C), ESLOTS_L = BATCH * CAP_L;
constexpr int NB1 = BATCH + 1;
constexpr float EPS = 1e-6f;
constexpr int SMEM_BYTES = 147456;
constexpr int NTHREADS = 512, NWAVES = NTHREADS / 64;

enum { I_X = 0, I_C, I_CTX, I_CCTX, I_WADA, I_BADA, I_GPREMIX, I_GPOSTMIX, I_GPREFFN, I_GPOSTFFN, I_WIN, I_GCQ, I_GCKV, I_WUQ, I_WUKV, I_RPB,
       I_S5ARE, I_S5AIM, I_S5LOGSTEP, I_S5BRE, I_S5BIM, I_S5CRE, I_S5CIM, I_S5D, I_S5WGLU, I_S5BGLU, I_M2CONVW, I_M2CONVB, I_M2ALOG, I_M2DTBIAS,
       I_M2D, I_M2GNORM, I_WBRANCH, I_WOUT, I_WROUTER, I_WGATE, I_WUP, I_WDOWN, N_INPUTS };

constexpr size_t al256(size_t x) { return (x + 255) & ~(size_t)255; }
constexpr size_t SZ_X = (size_t)NTOK * D * 4;
constexpr size_t SZ_ROWBF = (size_t)NTOK * D * 2;
constexpr size_t OFF_X = 0;
constexpr size_t OFF_MOD = OFF_X + al256(SZ_X);
constexpr size_t OFF_HA = OFF_MOD + al256((size_t)DEPTH * NB1 * 6144 * 4);
constexpr size_t OFF_O = OFF_HA + al256(SZ_ROWBF);
constexpr size_t OFF_P1 = OFF_O + al256(SZ_ROWBF);
constexpr size_t SZ_P1 = (size_t)NTOK * P1W * 2;
constexpr size_t OFF_PG = OFF_P1 + al256(SZ_P1);
constexpr size_t SZ_PG = (size_t)NTOK * 4096 * 2;
constexpr size_t OFF_DT = OFF_PG + al256(SZ_PG);
constexpr size_t OFF_AFF = OFF_DT + al256((size_t)NTOK * 8 * 4);
constexpr size_t OFF_SEL = OFF_AFF + al256((size_t)NTOK * 16 * 4);
constexpr size_t OFF_IDX = OFF_SEL + al256((size_t)NTOK * 16 * 4);
constexpr size_t OFF_GW = OFF_IDX + al256((size_t)NE * ESLOTS * 4);
constexpr size_t OFF_BAR = OFF_GW + al256((size_t)NE * ESLOTS * 4);
constexpr size_t BAR_BYTES = (3456 + 64 * 4) * 4;
constexpr int Q_WORD0 = 3456;
constexpr size_t OFF_ROPE = OFF_BAR + al256(BAR_BYTES);
constexpr size_t OFF_WEARLY = OFF_ROPE + al256(64 * 8 * 2 * 4);
constexpr size_t WE_WIN = 0;
constexpr size_t WE_UQ = WE_WIN + (size_t)N_INP * 1024 * 2;
constexpr size_t WE_UKV = WE_UQ + (size_t)384 * 256 * 2;
constexpr size_t WE_GLU = WE_UKV + (size_t)512 * 128 * 2;
constexpr size_t WE_WB = WE_GLU + (size_t)256 * 256 * 2;
constexpr size_t WE_WOUT = WE_WB + (size_t)4 * 1024 * 256 * 2;
constexpr size_t WE_SIZE = al256(WE_WOUT + (size_t)1024 * 1024 * 2);
constexpr size_t OFF_S5TAB = OFF_WEARLY + DEPTH * WE_SIZE;
constexpr size_t S5_LAMPOW = 0;
constexpr size_t S5_BBAR = S5_LAMPOW + (size_t)2 * 16 * 17 * 64 * 2 * 4;
constexpr size_t S5_KT = S5_BBAR + (size_t)2 * 16 * 64 * 16 * 2 * 4;
constexpr size_t S5_WA = S5_KT + (size_t)2 * 16 * 16 * 256 * 4;
constexpr size_t S5_W2 = S5_WA + (size_t)16 * 256 * 256 * 2;
constexpr size_t S5_SIZE = al256(S5_W2 + (size_t)16 * 256 * 512 * 2);
constexpr size_t OFF_MIX = OFF_S5TAB + DEPTH * S5_SIZE;
constexpr size_t MX_Q = 0;
constexpr size_t MX_K = MX_Q + al256((size_t)BATCH * 4 * TOK * 96 * 2);
constexpr size_t MX_VTM = MX_K + al256((size_t)BATCH * 4 * TOK * 96 * 2);
constexpr size_t MX_VTN = MX_VTM + al256((size_t)BATCH * 4 * 64 * TOK * 2);
constexpr size_t MX_XBC = MX_VTN + al256((size_t)BATCH * 4 * 64 * TOK * 2);
constexpr size_t MX_US5 = MX_XBC + al256((size_t)NTOK * 768 * 2);
constexpr size_t MX_HEND = MX_US5 + al256((size_t)NTOK * 256 * 2);
constexpr size_t MX_HIN = MX_HEND + al256((size_t)16 * MCH * 256 * 4);
constexpr size_t MX_Z = MX_HIN + al256((size_t)16 * MCH * 256 * 2);
constexpr size_t MX_XBT = MX_Z + al256((size_t)NTOK * 256 * 2);
constexpr size_t MX_M2S = MX_XBT + al256((size_t)NTOK * 512 * 2);
constexpr size_t MX_SIZE = MX_M2S + al256((size_t)BATCH * 8 * TOK * 4 * 4);
constexpr size_t WX_GU = 0;
constexpr size_t WX_DN = WX_GU + (size_t)NE * 2048 * 1024 * 2;
constexpr size_t WX_SIZE = WX_DN + (size_t)NE * 1024 * 1024 * 2;
constexpr size_t MIXREG = (MX_SIZE > WX_SIZE ? MX_SIZE : WX_SIZE);
constexpr size_t WS_TOTAL = OFF_MIX + al256(MIXREG);

struct Params {
  const float* in[N_INPUTS];
  float* out;
  char* ws;
  int phase_lo, phase_hi;
  int probe_rep, pad_;
};

DI int tid_() {
#ifdef EMU
  return (int)threadIdx.x;
#else
  int t = (int)threadIdx.x; asm volatile("" : "+v"(t)); return t;
#endif
}
#ifdef EMU
template <class T> DI T shfl_xor_(T v, int m) { return __shfl_xor(v, m); }
template <class T> DI T shfl_up_(T v, int d) { return __shfl_up(v, d); }
template <class T> DI T shfl_(T v, int src) { return __shfl(v, src); }
#else
template <class T> DI T shfl_xor_(T v, int m) {
  const int idx = ((tid_() & 63) ^ m) << 2;
  return __builtin_bit_cast(T, __builtin_amdgcn_ds_bpermute(idx, __builtin_bit_cast(int, v)));
}
template <class T> DI T shfl_up_(T v, int d) {
  const int l = tid_() & 63; const int idx = (l >= d ? l - d : l) << 2;
  return __builtin_bit_cast(T, __builtin_amdgcn_ds_bpermute(idx, __builtin_bit_cast(int, v)));
}
template <class T> DI T shfl_(T v, int src) {
  int idx = src << 2; asm volatile("" : "+v"(idx));
  return __builtin_bit_cast(T, __builtin_amdgcn_ds_bpermute(idx, __builtin_bit_cast(int, v)));
}
#endif
DI float bf2f(bf16 h) { return __uint_as_float(((unsigned)h) << 16); }
DI bf16 f2bf(float f) { unsigned u = __float_as_uint(f); u += 0x7fffu + ((u >> 16) & 1u); return (bf16)(u >> 16); }
#ifdef EMU
DI unsigned pack2(float a, float b) { return (unsigned)f2bf(a) | ((unsigned)f2bf(b) << 16); }
DI float exp2f_(float x) { return exp2f(x); }
#else
typedef float f32x2_t_ __attribute__((ext_vector_type(2)));
typedef __bf16 bf16x2_t_ __attribute__((ext_vector_type(2)));
DI unsigned pack2(float a, float b) { const f32x2_t_ v = {a, b}; return __builtin_bit_cast(unsigned, __builtin_convertvector(v, bf16x2_t_)); }
DI float exp2f_(float x) { return __builtin_amdgcn_exp2f(x); }
#endif
DI float sigmoidf_(float x) { return 1.0f / (1.0f + __expf(-x)); }
DI float siluf_(float x) { return x / (1.0f + __expf(-x)); }
DI float softplusf_(float x) { const float ax = x < 0.f ? -x : x; return (x > 0.f ? x : 0.f) + __logf(1.0f + __expf(-ax)); }
DI float geluf_(float x) { const float u2 = 1.5957691216057308f * (x + 0.044715f * x * x * x); return x / (1.0f + __expf(-u2)); }
DI float wave_sum(float v) {
  v += shfl_xor_(v, 32); v += shfl_xor_(v, 16); v += shfl_xor_(v, 8); v += shfl_xor_(v, 4); v += shfl_xor_(v, 2); v += shfl_xor_(v, 1);
  return v;
}
#ifndef EMU
#define XB_TMO      128
#define XB_XCNT(j)  (256  + 64 * (j))
#define XB_XSUB(j)  (1280 + 64 * (j))
#define XB_XGEN(j)  (2304 + 64 * (j))
#define XB_TOP      3328
#define XB_TOPGEN   3392
#define XB_SPIN_CAP (1u << 24)
#define LAS __attribute__((address_space(3)))
DI unsigned xb_ld(unsigned* p) { return __hip_atomic_load(p, __ATOMIC_RELAXED, __HIP_MEMORY_SCOPE_AGENT); }
DI unsigned xb_add(unsigned* p, unsigned v) { return __hip_atomic_fetch_add(p, v, __ATOMIC_RELAXED, __HIP_MEMORY_SCOPE_AGENT); }
DI unsigned xb_xcc_id() { return (unsigned)__builtin_amdgcn_s_getreg((3 << 11) | 20) & 0xFu; }
#define XB_SPIN(cond, bar) do { unsigned _sp = 0; while (cond) { __builtin_amdgcn_s_sleep(1); \
    if ((++_sp & 255u) == 0u) { if (xb_ld(&(bar)[XB_TMO])) break; if (_sp > XB_SPIN_CAP) { atomicAdd(&(bar)[XB_TMO], 1u); break; } } } } while (0)
struct XcdBarrier { unsigned* bar; unsigned x; volatile LAS unsigned* st; };
DI XcdBarrier xcd_barrier_post(unsigned* bar, volatile LAS unsigned* st) {
  XcdBarrier b; b.bar = bar; b.x = xb_xcc_id(); b.st = st;
  if (threadIdx.x == 0) (void)xb_add(&bar[XB_XCNT(b.x)], 1u);
  return b;
}
DI void xcd_barrier_complete(unsigned* bar, unsigned x, unsigned& nloc, unsigned& nx) {
  const unsigned G = gridDim.x * gridDim.y * gridDim.z;
  unsigned sum, cnt, mine, sp = 0u;
  for (;;) {
    sum = 0u; cnt = 0u; mine = 0u;
#pragma unroll
    for (unsigned j = 0; j < 16; ++j) { const unsigned c = xb_ld(&bar[XB_XCNT(j)]); sum += c; cnt += (c > 0u) ? 1u : 0u; mine = (j == x) ? c : mine; }
    if (sum == G) break;
    __builtin_amdgcn_s_sleep(1);
    if ((++sp & 255u) == 0u) { if (xb_ld(&bar[XB_TMO])) break; if (sp > XB_SPIN_CAP) { atomicAdd(&bar[XB_TMO], 1u); break; } }
  }
  nloc = mine > 0u ? mine : 1u; nx = cnt > 0u ? cnt : 1u;
}
DI void xcd_barrier(const XcdBarrier& b) {
  asm volatile("s_waitcnt vmcnt(0)" ::: "memory");
  __syncthreads();
  if (threadIdx.x == 0) {
    unsigned* bar = b.bar;
    __builtin_amdgcn_s_waitcnt(0);
    unsigned nloc = b.st[0], nx = b.st[1];
    if (nloc == 0u) { xcd_barrier_complete(bar, b.x, nloc, nx); b.st[0] = nloc; b.st[1] = nx; }
    const unsigned old = xb_add(&bar[XB_XSUB(b.x)], 1u);
    const unsigned gen = old / nloc;
    if (old + 1u == (gen + 1u) * nloc) {
      __builtin_amdgcn_fence(__ATOMIC_RELEASE, "agent");
      asm volatile("s_waitcnt vmcnt(0)" ::: "memory");
      const unsigned og = xb_add(&bar[XB_TOP], 1u);
      const unsigned tg = og / nx;
      if (og + 1u == (tg + 1u) * nx) xb_add(&bar[XB_TOPGEN], 1u);
      else XB_SPIN(xb_ld(&bar[XB_TOPGEN]) == tg, bar);
      __builtin_amdgcn_fence(__ATOMIC_ACQUIRE, "agent");
      xb_add(&bar[XB_XGEN(b.x)], 1u);
      asm volatile("s_waitcnt vmcnt(0)" ::: "memory");
    } else {
      XB_SPIN(xb_ld(&bar[XB_XGEN(b.x)]) == gen, bar);
      __builtin_amdgcn_fence(__ATOMIC_ACQUIRE, "agent");
      asm volatile("s_waitcnt vmcnt(0)" ::: "memory");
    }
  }
  __syncthreads();
}
#endif

struct GA {
  const bf16* A; const bf16* A2; int lda, lda2, ksplit;
  const int* ridx; int mvalid;
  const bf16* Bt; int ldb; int K;
  int kfix;
};
DI GA make_ga(const bf16* A, int lda, const bf16* Bt, int ldb, int K, int mvalid) {
  GA g; g.A = A; g.A2 = A; g.lda = lda; g.lda2 = lda; g.ksplit = K; g.ridx = nullptr; g.mvalid = mvalid; g.Bt = Bt; g.ldb = ldb; g.K = K; g.kfix = 0; return g;
}

#ifdef EMU
#define GLDS16(gptr_, lptr_) memcpy((void*)(lptr_), (const void*)(gptr_), 16)
#define BGLDS16(rsrc_, base_, voff_, soff_, lptr_) memcpy((void*)(lptr_), (const char*)(base_) + (voff_) + (soff_), 16)
#define GEMM_WAIT(N_)
#define RAW_BARRIER() __syncthreads()
#else
#define LASV __attribute__((address_space(3))) void
#define GLDS16(gptr_, lptr_) __builtin_amdgcn_global_load_lds((const void*)(gptr_), (LASV*)(lptr_), 16, 0, 0)
#define BGLDS16(rsrc_, base_, voff_, soff_, lptr_) __builtin_amdgcn_raw_ptr_buffer_load_lds(rsrc_, (LASV*)(lptr_), 16, (int)(voff_), (int)(soff_), 0, 0)
#define GEMM_WAIT(N_) asm volatile("s_waitcnt vmcnt(%0)" :: "n"(N_) : "memory")
#define RAW_BARRIER() { asm volatile("" ::: "memory"); __builtin_amdgcn_s_barrier(); asm volatile("" ::: "memory"); }
#endif
DI int perm32(int rho) { const int n = rho >> 4, i = rho & 15; return 8 * (i >> 2) + 4 * n + (i & 3); }
constexpr int SRS_OFF = 73728;
template <int NT>
DI void gemm_s(const GA& g, int m0, int n0, char* smem, f32x4 (&acc)[4][NT]) {
  constexpr int A_ELEMS = 256 * 32, B_ELEMS = 32 * NT * 32, STAGE = A_ELEMS + B_ELEMS;
  bf16* st = (bf16*)smem;
  const int tid = tid_(), lane = tid & 63, wid = tid >> 6, wr = wid >> 1, wc = wid & 1, fr = lane & 15, fq = lane >> 4;
  const int lrow = tid >> 2, pch = tid & 3;
  long aoff[2], aoff2[2], boff;
#pragma unroll
  for (int i = 0; i < 2; ++i) {
    const int row = lrow + 128 * i;
    const int lch = pch ^ ((-(row >> 2)) & 3);
    int gm = m0 + row; if (gm > g.mvalid - 1) gm = g.mvalid - 1;
    const int ar = g.ridx ? g.ridx[gm] : gm;
    aoff[i] = (long)ar * g.lda + lch * 8;
    aoff2[i] = (long)ar * g.lda2 + lch * 8;
  }
  const int cb = (NT == 4) ? tid : (tid & 255);
  {
    const int row = cb >> 2;
    const int lch = pch ^ ((-(row >> 2)) & 3);
    const int src = n0 + (row & ~31) + perm32(row & 31);
    boff = (long)src * g.ldb + lch * 8;
  }
#pragma unroll
  for (int m = 0; m < 4; ++m)
#pragma unroll
    for (int n = 0; n < NT; ++n) acc[m][n] = f32x4{0.f, 0.f, 0.f, 0.f};
  const int T = g.K / 32;
#define GEMM_DMA(t_, stg_) { const int k0_ = (t_) * 32; const bool seg2_ = (k0_ >= g.ksplit); bf16* sa_ = st + (stg_) * STAGE; \
    _Pragma("unroll") for (int i_ = 0; i_ < 2; ++i_) { \
      const bf16* ap_ = seg2_ ? (g.A2 + aoff2[i_] + (k0_ - g.ksplit)) : (g.A + aoff[i_] + k0_); \
      GLDS16(ap_, sa_ + (tid + i_ * 512) * 8); } \
    GLDS16(g.Bt + boff + k0_, sa_ + A_ELEMS + cb * 8); }
  __syncthreads();
  GEMM_DMA(0, 0)
  if (T > 1) GEMM_DMA(1, 1)
  int s_cur = 0, s_nxt = 2;
#pragma unroll 1
  for (int t = 0; t < T; ++t) {
    if (t + 1 < T) { GEMM_WAIT(3); } else { GEMM_WAIT(0); }
    RAW_BARRIER();
    if (t + 2 < T) GEMM_DMA(t + 2, s_nxt)
    const bf16* sa = st + s_cur * STAGE;
    const bf16* sb = sa + A_ELEMS;
    bf16x8 af[4], bfr[NT];
#pragma unroll
    for (int n = 0; n < NT; ++n) {
      const int row = wc * (16 * NT) + n * 16 + fr;
      bfr[n] = *(const bf16x8*)(sb + row * 32 + ((fq ^ ((-(row >> 2)) & 3)) << 3));
    }
#pragma unroll
    for (int m = 0; m < 4; ++m) {
      const int row = wr * 64 + m * 16 + fr;
      af[m] = *(const bf16x8*)(sa + row * 32 + ((fq ^ ((-(row >> 2)) & 3)) << 3));
    }
#pragma unroll
    for (int m = 0; m < 4; ++m)
#pragma unroll
      for (int n = 0; n < NT; ++n) acc[m][n] = __builtin_amdgcn_mfma_f32_16x16x32_bf16(bfr[n], af[m], acc[m][n], 0, 0, 0);
    s_cur = (s_cur == 2) ? 0 : s_cur + 1;
    s_nxt = (s_nxt == 2) ? 0 : s_nxt + 1;
  }
}
constexpr int BG_HT = 128 * 64;
DI int lds_byte(int r, int c) { const int stt = (r >> 4) * 2 + (c >> 5), rr = r & 15, cc = c & 31, ob = rr * 64 + cc * 2; return stt * 1024 + (ob ^ (((ob >> 9) & 1) << 5)); }
DI void stage_rc(int b, int& R, int& C) { const int stt = b / 1024, sb = b % 1024, swz = sb ^ (((sb >> 9) & 1) << 5); R = (stt >> 1) * 16 + swz / 64; C = (stt & 1) * 32 + (swz % 64) / 2; }
#ifdef EMU
#define BG_WAIT_V(n)
#define BG_WAIT_L(n)
#define BG_BAR __syncthreads()
#define BG_SCHED
#define BG_PRIO(x)
#else
#define BG_WAIT_V(n) asm volatile("s_waitcnt vmcnt(" #n ")" ::: "memory")
#define BG_WAIT_L(n) asm volatile("s_waitcnt lgkmcnt(" #n ")" ::: "memory")
#define BG_BAR __builtin_amdgcn_s_barrier()
#define BG_SCHED __builtin_amdgcn_sched_barrier(0)
#define BG_PRIO(x) __builtin_amdgcn_s_setprio(x)
#endif
DI void gemm_big(const GA& g, int m0, int n0, char* smem, f32x4 (&acc)[2][2][4][2]) {
  bf16* shm = (bf16*)smem;
  const int tid = tid_(), wid = tid >> 6, lane = tid & 63, wr = wid >> 2, wc = wid & 3, fr = lane & 15, fq = lane >> 4;
  unsigned aof[2][2], bof[2][2];
#ifndef EMU
  const __amdgpu_buffer_rsrc_t rsA = __builtin_amdgcn_make_buffer_rsrc((void*)g.A, 0, 0x7fffffff, 0x00020000);
  const __amdgpu_buffer_rsrc_t rsB = __builtin_amdgcn_make_buffer_rsrc((void*)g.Bt, 0, 0x7fffffff, 0x00020000);
#endif
#pragma unroll
  for (int i = 0; i < 2; ++i) {
    int R, C; stage_rc(tid * 16 + i * 8192, R, C);
#pragma unroll
    for (int h = 0; h < 2; ++h) {
      int gm = m0 + h * 128 + R; if (gm > g.mvalid - 1) gm = g.mvalid - 1;
      const int ar = g.ridx ? g.ridx[gm] : gm;
      aof[h][i] = (unsigned)(ar * g.lda + C) * 2u;
      bof[h][i] = (unsigned)((n0 + h * 128 + (R & ~31) + perm32(R & 31)) * g.ldb + C) * 2u;
    }
  }
#define BG_SA(b, h) (shm + ((b) * 2 + (h)) * BG_HT)
#define BG_SB(b, h) (shm + (4 + (b) * 2 + (h)) * BG_HT)
#define BG_STAGE_A(P, h, kt) { \
    _Pragma("unroll") for (int i_ = 0; i_ < 2; ++i_) BGLDS16(rsA, g.A, aof[h][i_], (kt) * 128, (char*)(P) + tid * 16 + i_ * 8192); }
#define BG_STAGE_B(P, h, kt) { \
    _Pragma("unroll") for (int i_ = 0; i_ < 2; ++i_) BGLDS16(rsB, g.Bt, bof[h][i_], (kt) * 128, (char*)(P) + tid * 16 + i_ * 8192); }
#define BG_LDA(dst, b, h) _Pragma("unroll") for (int m_ = 0; m_ < 4; ++m_) _Pragma("unroll") for (int k_ = 0; k_ < 2; ++k_) \
    dst[m_][k_] = *(const bf16x8*)((const char*)BG_SA(b, h) + lds_byte(wr * 64 + m_ * 16 + fr, k_ * 32 + fq * 8))
#define BG_LDB(dst, b, h) _Pragma("unroll") for (int n_ = 0; n_ < 2; ++n_) _Pragma("unroll") for (int k_ = 0; k_ < 2; ++k_) \
    dst[n_][k_] = *(const bf16x8*)((const char*)BG_SB(b, h) + lds_byte(wc * 32 + n_ * 16 + fr, k_ * 32 + fq * 8))
#define BG_MMA(ai, bj, At_, Bt_) { BG_PRIO(1); \
    _Pragma("unroll") for (int m_ = 0; m_ < 4; ++m_) _Pragma("unroll") for (int n_ = 0; n_ < 2; ++n_) _Pragma("unroll") for (int k_ = 0; k_ < 2; ++k_) \
      acc[ai][bj][m_][n_] = __builtin_amdgcn_mfma_f32_16x16x32_bf16(Bt_[n_][k_], At_[m_][k_], acc[ai][bj][m_][n_], 0, 0, 0); \
    BG_PRIO(0); }
#pragma unroll
  for (int a_ = 0; a_ < 2; ++a_)
#pragma unroll
    for (int b_ = 0; b_ < 2; ++b_)
#pragma unroll
      for (int m_ = 0; m_ < 4; ++m_)
#pragma unroll
        for (int n_ = 0; n_ < 2; ++n_) acc[a_][b_][m_][n_] = f32x4{0.f, 0.f, 0.f, 0.f};
  bf16x8 At[4][2], B0[2][2], B1[2][2];
  const int nt = g.K / 64;
  __syncthreads();
  BG_STAGE_B(BG_SB(0, 0), 0, 0) BG_STAGE_A(BG_SA(0, 0), 0, 0)
  BG_STAGE_B(BG_SB(0, 1), 1, 0) BG_STAGE_A(BG_SA(0, 1), 1, 0)
  if (wr == 1) BG_BAR;
  BG_WAIT_V(4); BG_BAR;
  BG_STAGE_B(BG_SB(1, 0), 0, 1) BG_STAGE_A(BG_SA(1, 0), 0, 1) BG_STAGE_B(BG_SB(1, 1), 1, 1)
  BG_WAIT_V(6); BG_BAR;
#pragma unroll 1
  for (int t = 0; t < nt - 2; t += 2) {
    BG_LDB(B0, 0, 0); BG_SCHED; BG_LDA(At, 0, 0); BG_STAGE_A(BG_SA(1, 1), 1, t + 1)
    BG_WAIT_L(8); BG_BAR; BG_WAIT_L(0); BG_MMA(0, 0, At, B0) BG_BAR; BG_SCHED;
    BG_LDB(B1, 0, 1); BG_STAGE_B(BG_SB(0, 0), 0, t + 2)
    BG_BAR; BG_WAIT_L(0); BG_MMA(0, 1, At, B1) BG_BAR;
    BG_LDA(At, 0, 1); BG_STAGE_A(BG_SA(0, 0), 0, t + 2)
    BG_BAR; BG_WAIT_L(0); BG_MMA(1, 0, At, B0) BG_BAR; BG_SCHED;
    BG_STAGE_B(BG_SB(0, 1), 1, t + 2)
    BG_WAIT_V(6); BG_BAR; BG_MMA(1, 1, At, B1) BG_BAR;
    BG_LDB(B0, 1, 0); BG_SCHED; BG_LDA(At, 1, 0); BG_STAGE_A(BG_SA(0, 1), 1, t + 2)
    BG_WAIT_L(8); BG_BAR; BG_WAIT_L(0); BG_MMA(0, 0, At, B0) BG_BAR; BG_SCHED;
    BG_LDB(B1, 1, 1); BG_STAGE_B(BG_SB(1, 0), 0, t + 3)
    BG_BAR; BG_WAIT_L(0); BG_MMA(0, 1, At, B1) BG_BAR;
    BG_LDA(At, 1, 1); BG_STAGE_A(BG_SA(1, 0), 0, t + 3)
    BG_BAR; BG_WAIT_L(0); BG_MMA(1, 0, At, B0) BG_BAR; BG_SCHED;
    BG_STAGE_B(BG_SB(1, 1), 1, t + 3)
    BG_WAIT_V(6); BG_BAR; BG_MMA(1, 1, At, B1) BG_BAR;
  }
  { BG_LDB(B0, 0, 0); BG_LDA(At, 0, 0); BG_STAGE_A(BG_SA(1, 1), 1, nt - 1)
    BG_BAR; BG_WAIT_L(0); BG_MMA(0, 0, At, B0) BG_BAR;
    BG_LDB(B1, 0, 1); BG_BAR; BG_WAIT_L(0); BG_MMA(0, 1, At, B1) BG_BAR;
    BG_LDA(At, 0, 1); BG_WAIT_V(4); BG_BAR; BG_WAIT_L(0); BG_MMA(1, 0, At, B0) BG_MMA(1, 1, At, B1) BG_BAR; }
  { BG_LDB(B0, 1, 0); BG_LDA(At, 1, 0); BG_WAIT_V(2); BG_BAR; BG_WAIT_L(0); BG_MMA(0, 0, At, B0) BG_BAR;
    BG_LDB(B1, 1, 1); BG_WAIT_V(0); BG_BAR; BG_WAIT_L(0); BG_MMA(0, 1, At, B1) BG_BAR;
    BG_LDA(At, 1, 1); BG_BAR; BG_WAIT_L(0); BG_MMA(1, 0, At, B0) BG_MMA(1, 1, At, B1) BG_BAR; }
  if (wr == 0) BG_BAR;
}
#define EPIB_BEGIN(acc_, m0_, n0_, mvalid_) { const int _l = tid_() & 63, _w = tid_() >> 6, _wr = _w >> 2, _wc = _w & 3, _fr = _l & 15, _fq = _l >> 4; \
  _Pragma("unroll") for (int _ai = 0; _ai < 2; ++_ai) _Pragma("unroll") for (int _m = 0; _m < 4; ++_m) { const int row = (m0_) + _ai * 128 + _wr * 64 + _m * 16 + _fr; \
  _Pragma("unroll") for (int _bj = 0; _bj < 2; ++_bj) { const int col = (n0_) + _bj * 128 + _wc * 32 + 8 * _fq; (void)col; \
    float v[8] = {acc_[_ai][_bj][_m][0][0], acc_[_ai][_bj][_m][0][1], acc_[_ai][_bj][_m][0][2], acc_[_ai][_bj][_m][0][3], \
                  acc_[_ai][_bj][_m][1][0], acc_[_ai][_bj][_m][1][1], acc_[_ai][_bj][_m][1][2], acc_[_ai][_bj][_m][1][3]}; \
    if (row < (mvalid_)) {
#define EPIB_END }}}}

DI void ld8bf(const bf16* p, float (&v)[8]) {
  uint4 w = *(const uint4*)p;
  v[0] = __uint_as_float(w.x << 16); v[1] = __uint_as_float(w.x & 0xffff0000u); v[2] = __uint_as_float(w.y << 16); v[3] = __uint_as_float(w.y & 0xffff0000u);
  v[4] = __uint_as_float(w.z << 16); v[5] = __uint_as_float(w.z & 0xffff0000u); v[6] = __uint_as_float(w.w << 16); v[7] = __uint_as_float(w.w & 0xffff0000u);
}
DI void st8bf(bf16* p, const float (&v)[8]) { *(uint4*)p = make_uint4(pack2(v[0], v[1]), pack2(v[2], v[3]), pack2(v[4], v[5]), pack2(v[6], v[7])); }
DI void st8f(float* p, const float (&v)[8]) { *(float4*)p = make_float4(v[0], v[1], v[2], v[3]); *(float4*)(p + 4) = make_float4(v[4], v[5], v[6], v[7]); }
#define EPI_BEGIN(NT_, acc_, m0_, n0_, mvalid_) { const int _l = tid_() & 63, _w = tid_() >> 6, _wr = _w >> 1, _wc = _w & 1, _fr = _l & 15, _fq = _l >> 4; \
  _Pragma("unroll") for (int _m = 0; _m < 4; ++_m) { const int row = (m0_) + _wr * 64 + _m * 16 + _fr; \
  _Pragma("unroll") for (int _q = 0; _q < (NT_) / 2; ++_q) { const int col = (n0_) + _wc * (16 * (NT_)) + _q * 32 + 8 * _fq; (void)col; \
    float v[8] = {acc_[_m][2 * _q][0], acc_[_m][2 * _q][1], acc_[_m][2 * _q][2], acc_[_m][2 * _q][3], \
                  acc_[_m][2 * _q + 1][0], acc_[_m][2 * _q + 1][1], acc_[_m][2 * _q + 1][2], acc_[_m][2 * _q + 1][3]}; \
    if (row < (mvalid_)) {
#define EPI_END }}}}

DI int mtile_row0(int mt, bool latonly, int TH) {
  if (!latonly) return mt * TH;
  const int per = SEQ / TH, b = mt / per, r = mt % per;
  return b * TOK + CTXL + r * TH;
}
DI int mtiles(bool latonly, int TH) { return latonly ? BATCH * (SEQ / TH) : (NTOK + TH - 1) / TH; }

struct LP {
  int l; bool last;
  const float* mod;
  char* we;
  char* s5;
};
DI LP make_lp(const Params& p, int l) {
  LP q; q.l = l; q.last = (l == DEPTH - 1);
  q.mod = (const float*)(p.ws + OFF_MOD) + (size_t)l * NB1 * 6144;
  q.we = p.ws + OFF_WEARLY + (size_t)l * WE_SIZE;
  q.s5 = p.ws + OFF_S5TAB + (size_t)l * S5_SIZE;
  return q;
}

template <class RowMap>
DI void conv_tile(const float* src, int lds, int nsrc, const float* kscale, bf16* dst, int K, int k0, int n0, char* smem, RowMap rowmap) {
  float* t = (float*)smem;
  const int tid = tid_();
  __syncthreads();
#pragma unroll 4
  for (int i = 0; i < 8; ++i) {
    int k = i * 8 + (tid >> 6), n = tid & 63;
    float v = (n0 + n < nsrc) ? src[(size_t)(k0 + k) * lds + n0 + n] : 0.f;
    if (kscale) v *= kscale[k0 + k];
    t[k * 65 + n] = v;
  }
  __syncthreads();
  const int n = tid >> 3, kq = (tid & 7) * 8;
  unsigned w[4];
#pragma unroll
  for (int i = 0; i < 4; ++i) w[i] = pack2(t[(kq + 2 * i) * 65 + n], t[(kq + 2 * i + 1) * 65 + n]);
  bf16* d = dst + (size_t)rowmap(n0 + n) * K + k0 + kq;
  *(uint4*)d = make_uint4(w[0], w[1], w[2], w[3]);
}
struct RowId { DI int operator()(int n) const { return n; } };
struct RowGU { int half; DI int operator()(int f) const { return (f >> 7) * 256 + half * 128 + (f & 127); } };

constexpr int CT_WIN = 16 * (N_INP / 64), CT_UQ = 4 * 6, CT_UKV = 2 * 8, CT_GLU = 16, CT_WB = 4 * 64, CT_WOUT = 256;
constexpr int CT_EARLY = CT_WIN + CT_UQ + CT_UKV + CT_GLU + CT_WB + CT_WOUT;
constexpr int CT_EXP = NE * 3 * 256;

DI void conv_early_item(const Params& p, int l, int it, char* smem) {
  char* we = p.ws + OFF_WEARLY + (size_t)l * WE_SIZE;
  if (it < CT_WIN) {
    int kt = it % 16, nt = it / 16;
    conv_tile(p.in[I_WIN] + (size_t)l * 1024 * N_IN, N_IN, N_IN, nullptr, (bf16*)(we + WE_WIN), 1024, kt * 64, nt * 64, smem, RowId());
    return;
  }
  it -= CT_WIN;
  if (it < CT_UQ) {
    int kt = it % 4, nt = it / 4;
    conv_tile(p.in[I_WUQ] + (size_t)l * 256 * 384, 384, 384, p.in[I_GCQ] + l * 256, (bf16*)(we + WE_UQ), 256, kt * 64, nt * 64, smem, RowId());
    return;
  }
  it -= CT_UQ;
  if (it < CT_UKV) {
    int kt = it % 2, nt = it / 2;
    conv_tile(p.in[I_WUKV] + (size_t)l * 128 * 512, 512, 512, p.in[I_GCKV] + l * 128, (bf16*)(we + WE_UKV), 128, kt * 64, nt * 64, smem, RowId());
    return;
  }
  it -= CT_UKV;
  if (it < CT_GLU) {
    int kt = it % 4, nt = it / 4;
    conv_tile(p.in[I_S5WGLU] + (size_t)l * 256 * 256, 256, 256, nullptr, (bf16*)(we + WE_GLU), 256, kt * 64, nt * 64, smem, RowId());
    return;
  }
  it -= CT_GLU;
  if (it < CT_WB) {
    int j = it / 64, r = it % 64, kt = r % 4, nt = r / 4;
    conv_tile(p.in[I_WBRANCH] + ((size_t)l * 4 + j) * 256 * 1024, 1024, 1024, nullptr, (bf16*)(we + WE_WB) + (size_t)j * 1024 * 256, 256, kt * 64, nt * 64, smem, RowId());
    return;
  }
  it -= CT_WB;
  {
    int kt = it % 16, nt = it / 16;
    conv_tile(p.in[I_WOUT] + (size_t)l * 1024 * 1024, 1024, 1024, nullptr, (bf16*)(we + WE_WOUT), 1024, kt * 64, nt * 64, smem, RowId());
  }
}
DI void conv_expert_item(const Params& p, int l, int it, char* smem) {
  char* wx = p.ws + OFF_MIX;
  int e = it / 768, r = it % 768, which = r / 256, t = r % 256, kt = t % 16, nt = t / 16;
  size_t eoff = ((size_t)l * NE + e) * 1024 * 1024;
  if (which == 0) { RowGU rm; rm.half = 0; conv_tile(p.in[I_WGATE] + eoff, 1024, 1024, nullptr, (bf16*)(wx + WX_GU) + (size_t)e * 2048 * 1024, 1024, kt * 64, nt * 64, smem, rm); }
  else if (which == 1) { RowGU rm; rm.half = 1; conv_tile(p.in[I_WUP] + eoff, 1024, 1024, nullptr, (bf16*)(wx + WX_GU) + (size_t)e * 2048 * 1024, 1024, kt * 64, nt * 64, smem, rm); }
  else conv_tile(p.in[I_WDOWN] + eoff, 1024, 1024, nullptr, (bf16*)(wx + WX_DN) + (size_t)e * 1024 * 1024, 1024, kt * 64, nt * 64, smem, RowId());
}

DI void mod_item(const Params& p, int it, char* smem) {
  const int l = it / 96, cg0 = (it % 96) * 64;
  float* sc = (float*)smem;
  float* red = sc + NB1 * 1024;
  const int tid = tid_();
  __syncthreads();
  for (int i = tid; i < NB1 * 1024; i += NTHREADS) {
    int r = i >> 10, k = i & 1023;
    float c = (r < BATCH) ? p.in[I_C][r * 1024 + k] : p.in[I_CCTX][k];
    sc[i] = siluf_(c);
  }
  __syncthreads();
  const int cl = tid & 63, kg = tid >> 6;
  float acc[NB1];
#pragma unroll
  for (int r = 0; r < NB1; ++r) acc[r] = 0.f;
  const float* w = p.in[I_WADA] + (size_t)l * 1024 * 6144 + cg0 + cl;
  for (int k = kg * (1024 / NWAVES); k < (kg + 1) * (1024 / NWAVES); ++k) {
    float wv = w[(size_t)k * 6144];
#pragma unroll
    for (int r = 0; r < NB1; ++r) acc[r] += sc[r * 1024 + k] * wv;
  }
#pragma unroll
  for (int r = 0; r < NB1; ++r) red[(kg * NB1 + r) * 64 + cl] = acc[r];
  __syncthreads();
  for (int i = tid; i < NB1 * 64; i += NTHREADS) {
    int r = i >> 6, c = i & 63;
    float s = 0.f;
#pragma unroll
    for (int q = 0; q < NWAVES; ++q) s += red[(q * NB1 + r) * 64 + c];
    s += p.in[I_BADA][l * 6144 + cg0 + c];
    ((float*)(p.ws + OFF_MOD))[((size_t)l * NB1 + r) * 6144 + cg0 + c] = s;
  }
}

DI void s5_tab_item(const Params& p, int it, char* smem) {
  const int l = it / 32, d = (it / 16) & 1, g = it & 15;
  char* s5 = p.ws + OFF_S5TAB + (size_t)l * S5_SIZE;
  float* lampow = (float*)(s5 + S5_LAMPOW) + (size_t)(d * 16 + g) * 17 * 64 * 2;
  float* bbar = (float*)(s5 + S5_BBAR) + (size_t)(d * 16 + g) * 64 * 16 * 2;
  float* kt = (float*)(s5 + S5_KT) + (size_t)(d * 16 + g) * 16 * 256;
  float* slam = (float*)smem;
  float* sbb = slam + 17 * 64 * 2;
  const int tid = tid_();
  const size_t pg = ((size_t)(l * 2 + d) * 16 + g);
  const float step = expf(p.in[I_S5LOGSTEP][pg]);
  __syncthreads();
  for (int i = tid; i < 17 * 64; i += NTHREADS) {
    int j = i >> 6, pp = i & 63;
    float are = p.in[I_S5ARE][pg * 64 + pp], aim = p.in[I_S5AIM][pg * 64 + pp];
    float mag = expf((float)j * step * are), ang = (float)j * step * aim;
    float re = mag * cosf(ang), im = mag * sinf(ang);
    slam[i * 2] = re; slam[i * 2 + 1] = im; lampow[i * 2] = re; lampow[i * 2 + 1] = im;
  }
  __syncthreads();
  for (int i = tid; i < 64 * 16; i += NTHREADS) {
    int pp = i >> 4;
    float are = p.in[I_S5ARE][pg * 64 + pp], aim = p.in[I_S5AIM][pg * 64 + pp];
    float x = slam[(64 + pp) * 2] - 1.0f, y = slam[(64 + pp) * 2 + 1];
    float den = are * are + aim * aim;
    float qre = (x * are + y * aim) / den, qim = (y * are - x * aim) / den;
    float bre = p.in[I_S5BRE][pg * 1024 + i], bim = p.in[I_S5BIM][pg * 1024 + i];
    float re = qre * bre - qim * bim, im = qre * bim + qim * bre;
    sbb[i * 2] = re; sbb[i * 2 + 1] = im; bbar[i * 2] = re; bbar[i * 2 + 1] = im;
  }
  __syncthreads();
  for (int i = tid; i < 16 * 256; i += NTHREADS) {
    int j = i >> 8, c = (i >> 4) & 15, c2 = i & 15;
    float s = 0.f;
    for (int pp = 0; pp < 64; ++pp) {
      float cre = p.in[I_S5CRE][pg * 1024 + c * 64 + pp], cim = p.in[I_S5CIM][pg * 1024 + c * 64 + pp];
      float lre = slam[(j * 64 + pp) * 2], lim = slam[(j * 64 + pp) * 2 + 1];
      float tre = cre * lre - cim * lim, tim = cre * lim + cim * lre;
      float bre = sbb[(pp * 16 + c2) * 2], bim = sbb[(pp * 16 + c2) * 2 + 1];
      s += tre * bre - tim * bim;
    }
    kt[i] = s;
  }
}
DI void s5_mat_item(const Params& p, int it) {
  const int l = it / 64, g = (it / 4) & 15, q = it & 3;
  char* s5 = p.ws + OFF_S5TAB + (size_t)l * S5_SIZE;
  const float* lampow = (const float*)(s5 + S5_LAMPOW);
  const float* bbar = (const float*)(s5 + S5_BBAR);
  const float* ktab = (const float*)(s5 + S5_KT);
  bf16* WA = (bf16*)(s5 + S5_WA) + (size_t)g * 256 * 256;
  bf16* W2 = (bf16*)(s5 + S5_W2) + (size_t)g * 256 * 512;
  const int tid = tid_();
  for (int i = tid; i < 64 * 256; i += NTHREADS) {
    int n = q * 64 + (i >> 8), k = i & 255;
    int d = n >> 7, ri = (n >> 6) & 1, pp = n & 63, s = k >> 4, c2 = k & 15;
    int e = (d == 0) ? (15 - s) : s;
    const float* lp = lampow + ((size_t)((d * 16 + g) * 17 + e) * 64 + pp) * 2;
    const float* bp = bbar + ((size_t)((d * 16 + g) * 64 + pp) * 16 + c2) * 2;
    float re = lp[0] * bp[0] - lp[1] * bp[1], im = lp[0] * bp[1] + lp[1] * bp[0];
    WA[(size_t)n * 256 + k] = f2bf(ri == 0 ? re : im);
  }
  for (int i = tid; i < 64 * 512; i += NTHREADS) {
    int n = q * 64 + (i >> 9), k = i & 511;
    int lq = n >> 4, c = n & 15;
    float v;
    if (k < 256) {
      int s = k >> 4, c2 = k & 15;
      v = 0.f;
      if (s <= lq) v += ktab[((size_t)(0 * 16 + g) * 16 + (lq - s)) * 256 + c * 16 + c2];
      if (s >= lq) v += ktab[((size_t)(1 * 16 + g) * 16 + (s - lq)) * 256 + c * 16 + c2];
      if (s == lq && c == c2) v += p.in[I_S5D][l * 256 + g * 16 + c];
    } else {
      int kk = k - 256, d = kk >> 7, ri = (kk >> 6) & 1, pp = kk & 63;
      int e = (d == 0) ? (lq + 1) : (16 - lq);
      size_t pg = ((size_t)(l * 2 + d) * 16 + g);
      float cre = p.in[I_S5CRE][pg * 1024 + c * 64 + pp], cim = p.in[I_S5CIM][pg * 1024 + c * 64 + pp];
      const float* lp = lampow + ((size_t)((d * 16 + g) * 17 + e) * 64 + pp) * 2;
      float re = cre * lp[0] - cim * lp[1], im = cre * lp[1] + cim * lp[0];
      v = (ri == 0) ? re : -im;
    }
    W2[(size_t)n * 512 + k] = f2bf(v);
  }
}

DI int tok_b(int tok) { return tok / TOK; }
DI int tok_j(int tok) { return tok % TOK; }
DI int tok_modrow(int tok) { return (tok_j(tok) < CTXL) ? BATCH : tok_b(tok); }

DI void normmod_row(const float (&xv)[16], const float* g, const float* shift, const float* scale, bf16* dst, float (&hout)[16]) {
  const int lane = tid_() & 63;
  float ss = 0.f;
#pragma unroll
  for (int i = 0; i < 16; ++i) ss += xv[i] * xv[i];
  ss = wave_sum(ss);
  const float rs = rsqrtf(ss * (1.0f / 1024.f) + EPS);
#pragma unroll
  for (int i = 0; i < 4; ++i) {
    int c = lane * 4 + i * 256;
    float4 gv = *(const float4*)(g + c), sh = *(const float4*)(shift + c), sc = *(const float4*)(scale + c);
    float h0 = xv[i * 4 + 0] * rs * gv.x * (1.f + sc.x) + sh.x;
    float h1 = xv[i * 4 + 1] * rs * gv.y * (1.f + sc.y) + sh.y;
    float h2 = xv[i * 4 + 2] * rs * gv.z * (1.f + sc.z) + sh.z;
    float h3 = xv[i * 4 + 3] * rs * gv.w * (1.f + sc.w) + sh.w;
    hout[i * 4 + 0] = h0; hout[i * 4 + 1] = h1; hout[i * 4 + 2] = h2; hout[i * 4 + 3] = h3;
    *(uint2*)(dst + c) = make_uint2(pack2(h0, h1), pack2(h2, h3));
  }
}

DI void prep_row_item(const Params& p, int it) {
  const int tok = it * NWAVES + (tid_() >> 6), lane = tid_() & 63;
  const int b = tok_b(tok), j = tok_j(tok);
  const float* src = (j < CTXL) ? p.in[I_CTX] + ((size_t)b * CTXL + j) * 1024 : p.in[I_X] + ((size_t)b * SEQ + (j - CTXL)) * 1024;
  float* X = (float*)(p.ws + OFF_X) + (size_t)tok * 1024;
  float xv[16], h[16];
#pragma unroll
  for (int i = 0; i < 4; ++i) {
    float4 v = *(const float4*)(src + lane * 4 + i * 256);
    *(float4*)(X + lane * 4 + i * 256) = v;
    xv[i * 4] = v.x; xv[i * 4 + 1] = v.y; xv[i * 4 + 2] = v.z; xv[i * 4 + 3] = v.w;
  }
  const float* mod = (const float*)(p.ws + OFF_MOD) + (size_t)tok_modrow(tok) * 6144;
  normmod_row(xv, p.in[I_GPREMIX], mod + 0, mod + 1024, (bf16*)(p.ws + OFF_HA) + (size_t)tok * 1024, h);
}

constexpr int IP_MT = (NTOK + 255) / 256, IP_NT = N_INP / 256, IP_RR = (IP_MT + 7) / 8, IP_RC = (IP_NT + 1) / 2;
constexpr int IP_SLOTS = ((IP_RR * IP_RC + 15) / 16) * 256;
DI void inproj_tile(const Params& p, const LP& L, int t, char* smem) {
  const int vb = t % 256, vround = t / 256, x = vb % 8, j = vb / 8;
  const int R = vround * 16 + x * 2 + (j >> 4), jj = j & 15, rm = R % IP_RR, rn = R / IP_RR;
  const int mt = rm * 8 + (jj & 7), nt = rn * 2 + (jj >> 3);
  if (mt >= IP_MT || nt >= IP_NT) return;
  const int m0 = mt * 256, n0 = nt * 256;
  GA g = make_ga((const bf16*)(p.ws + OFF_HA), 1024, (const bf16*)(L.we + WE_WIN), 1024, 1024, NTOK);
  f32x4 acc[2][2][4][2];
  gemm_big(g, m0, n0, smem, acc);
  bf16* P1 = (bf16*)(p.ws + OFF_P1);
  bf16* PG = (bf16*)(p.ws + OFF_PG);
  bf16* US5 = (bf16*)(p.ws + OFF_MIX + MX_US5);
  float* DT = (float*)(p.ws + OFF_DT);
  const float* dtb = p.in[I_M2DTBIAS] + L.l * 8;
  EPIB_BEGIN(acc, m0, n0, NTOK)
    if (col < C_S5 || (col >= C_Z && col < C_DT)) st8bf(P1 + (size_t)row * P1W + col, v);
    else if (col < C_Z) st8bf(US5 + ((size_t)((col - C_S5) >> 4) * NTOK + row) * 16 + (col & 15), v);
    else if (col < C_GATE) {
#pragma unroll
      for (int k = 0; k < 8; ++k) v[k] = softplusf_(v[k] + dtb[k]);
      st8f(DT + (size_t)row * 8, v);
    } else if (col < N_IN) {
#pragma unroll
      for (int k = 0; k < 8; ++k) v[k] = sigmoidf_(v[k]);
      st8bf(PG + (size_t)row * 4096 + (col - C_GATE), v);
    }
  EPIB_END
}

DI void rowscale_256(const bf16* P1, int m0, int c0, int width, float* srs) {
  const int r = tid_() >> 1, hf = tid_() & 1;
  int gr = m0 + r; if (gr > NTOK - 1) gr = NTOK - 1;
  const bf16* src = P1 + (size_t)gr * P1W + c0 + hf * (width / 2);
  float ss = 0.f;
  for (int i = 0; i < width / 2; i += 8) {
    float v[8]; ld8bf(src + i, v);
#pragma unroll
    for (int k = 0; k < 8; ++k) ss += v[k] * v[k];
  }
  ss += shfl_xor_(ss, 1);
  if (hf == 0) srs[r] = rsqrtf(ss / (float)width + EPS);
}
DI void rope_tab_item(const Params& p) {
  float* tab = (float*)(p.ws + OFF_ROPE);
  for (int i = tid_(); i < 64 * 8; i += NTHREADS) {
    int pos = i >> 3, k = i & 7;
    float f = expf(-(float)k * (9.210340371976184f / 8.0f));
    float a = (float)pos * f;
    tab[i * 2] = cosf(a); tab[i * 2 + 1] = sinf(a);
  }
}
DI void rope_cs(const float* tab, int pos, int i, float& c, float& s) { c = tab[(pos * 8 + i) * 2]; s = tab[(pos * 8 + i) * 2 + 1]; }

constexpr int TP_MT = (NTOK + 255) / 256;
DI void mlaq_tile(const Params& p, const LP& L, int t, char* smem) {
  const int mt = t % TP_MT, nt = t / TP_MT, m0 = mt * 256, n0 = nt * 128;
  const bf16* P1 = (const bf16*)(p.ws + OFF_P1);
  float* srs = (float*)(smem + SRS_OFF);
  GA g = make_ga(P1 + C_CQ, P1W, (const bf16*)(L.we + WE_UQ), 256, 256, NTOK);
  f32x4 acc[4][4];
  gemm_s<4>(g, m0, n0, smem, acc);
  rowscale_256(P1, m0, C_CQ, 256, srs);
  __syncthreads();
  bf16* Q = (bf16*)(p.ws + OFF_MIX + MX_Q);
  const float* ropetab = (const float*)(p.ws + OFF_ROPE);
  {
    const int l = tid_() & 63, w = tid_() >> 6, wr = w >> 1, wc = w & 1, fr = l & 15, fq = l >> 4;
#pragma unroll
    for (int m = 0; m < 4; ++m) {
      const int row = m0 + wr * 64 + m * 16 + fr;
      const int rowc = row < NTOK ? row : NTOK - 1;
      const float rsc = srs[rowc - m0];
      const int b = tok_b(rowc), j = tok_j(rowc);
#pragma unroll
      for (int q = 0; q < 2; ++q) {
        const int col = n0 + wc * 64 + q * 32 + 8 * fq;
        const int h = col / 96, dd = col % 96;
        float v[8] = {acc[m][2 * q][0], acc[m][2 * q][1], acc[m][2 * q][2], acc[m][2 * q][3], acc[m][2 * q + 1][0], acc[m][2 * q + 1][1], acc[m][2 * q + 1][2], acc[m][2 * q + 1][3]};
        float vp[8];
#pragma unroll
        for (int k = 0; k < 8; ++k) vp[k] = shfl_xor_(v[k], 16);
        if (dd >= 64 && j >= CTXL) {
          const int tl = j - CTXL, pos = ((dd - 64) < 16) ? (tl / GRID_W) : (tl % GRID_W);
          const bool lo = ((dd & 8) == 0);
#pragma unroll
          for (int k = 0; k < 8; ++k) {
            float c, sn; rope_cs(ropetab, pos, k, c, sn);
            v[k] = lo ? (v[k] * c - vp[k] * sn) : (v[k] * c + vp[k] * sn);
          }
        }
#pragma unroll
        for (int k = 0; k < 8; ++k) v[k] *= rsc;
        if (row < NTOK) st8bf(Q + (((size_t)b * 4 + h) * TOK + j) * 96 + dd, v);
      }
    }
  }
}
DI void mlakv_tile(const Params& p, const LP& L, int t, char* smem) {
  const int mt = t % TP_MT, h = t / TP_MT, m0 = mt * 256, n0 = h * 128;
  const bf16* P1 = (const bf16*)(p.ws + OFF_P1);
  float* srs = (float*)(smem + SRS_OFF);
  GA g = make_ga(P1 + C_CKV, P1W, (const bf16*)(L.we + WE_UKV), 128, 128, NTOK);
  f32x4 acc[4][4];
  gemm_s<4>(g, m0, n0, smem, acc);
  rowscale_256(P1, m0, C_CKV, 128, srs);
  __syncthreads();
  bf16* K = (bf16*)(p.ws + OFF_MIX + MX_K);
  bf16* VT = (bf16*)(p.ws + OFF_MIX + MX_VTM);
  const float* ropetab = (const float*)(p.ws + OFF_ROPE);
  EPI_BEGIN(4, acc, m0, n0, NTOK)
    const float rsc = srs[row - m0];
    const int b = tok_b(row), j = tok_j(row), dd = col - n0;
#pragma unroll
    for (int k = 0; k < 8; ++k) v[k] *= rsc;
    if (dd < 64) st8bf(K + (((size_t)b * 4 + h) * TOK + j) * 96 + dd, v);
    else {
#pragma unroll
      for (int k = 0; k < 8; ++k) VT[(((size_t)b * 4 + h) * 64 + (dd - 64 + k)) * TOK + j] = f2bf(v[k]);
    }
  EPI_END
  for (int i = tid_(); i < 256 * 16; i += NTHREADS) {
    int r = i >> 4, q = i & 15;
    int row = m0 + r;
    if (row < NTOK) {
      int b = tok_b(row), j = tok_j(row);
      int blk = q >> 3, i8 = q & 7;
      float x1 = bf2f(P1[(size_t)row * P1W + C_KR + blk * 16 + i8]), x2 = bf2f(P1[(size_t)row * P1W + C_KR + blk * 16 + i8 + 8]);
      float o1 = x1, o2 = x2;
      if (j >= CTXL) {
        int tl = j - CTXL, pos = blk == 0 ? (tl / GRID_W) : (tl % GRID_W);
        float c, sn; rope_cs(ropetab, pos, i8, c, sn);
        o1 = x1 * c - x2 * sn; o2 = x2 * c + x1 * sn;
      }
      bf16* kd = K + (((size_t)b * 4 + h) * TOK + j) * 96 + 64 + blk * 16 + i8;
      kd[0] = f2bf(o1); kd[8] = f2bf(o2);
    }
  }
}
DI void navt_item(const Params& p, int it, char* smem) {
  bf16* s = (bf16*)smem;
  const bf16* P1 = (const bf16*)(p.ws + OFF_P1);
  bf16* VT = (bf16*)(p.ws + OFF_MIX + MX_VTN);
  const int tok0 = it * 64, tid = tid_();
  const int b = tok_b(tok0), j0 = tok_j(tok0);
  __syncthreads();
  for (int i = tid; i < 64 * 32; i += NTHREADS) {
    int r = i >> 5, c8 = i & 31;
    *(uint4*)(s + r * 264 + c8 * 8) = *(const uint4*)(P1 + (size_t)(tok0 + r) * P1W + C_NA + 512 + c8 * 8);
  }
  __syncthreads();
  for (int i = tid; i < 256 * 8; i += NTHREADS) {
    int ch = i >> 3, t8 = i & 7;
    unsigned w[4];
#pragma unroll
    for (int q = 0; q < 4; ++q) w[q] = (unsigned)s[(t8 * 8 + 2 * q) * 264 + ch] | ((unsigned)s[(t8 * 8 + 2 * q + 1) * 264 + ch] << 16);
    *(uint4*)(VT + ((size_t)b * 256 + ch) * TOK + j0 + t8 * 8) = make_uint4(w[0], w[1], w[2], w[3]);
  }
}
DI void m2conv_item(const Params& p, const LP& L, int it) {
  const bf16* P1 = (const bf16*)(p.ws + OFF_P1);
  bf16* XB = (bf16*)(p.ws + OFF_MIX + MX_XBC);
  const int tok0 = it * 32, j0 = tok_j(tok0);
  const int slo = (j0 < CTXL) ? 0 : CTXL, shi = (j0 < CTXL) ? CTXL : TOK;
  const int base = tok0 - j0;
  for (int c = tid_(); c < 768; c += NTHREADS) {
    const float w0 = p.in[I_M2CONVW][(L.l * 4 + 0) * 768 + c], w1 = p.in[I_M2CONVW][(L.l * 4 + 1) * 768 + c];
    const float w2 = p.in[I_M2CONVW][(L.l * 4 + 2) * 768 + c], w3 = p.in[I_M2CONVW][(L.l * 4 + 3) * 768 + c];
    const float bb = p.in[I_M2CONVB][L.l * 768 + c];
    auto ld = [&](int j) -> float { return (j >= slo && j < shi) ? bf2f(P1[(size_t)(base + j) * P1W + C_XBC + c]) : 0.f; };
    float xm2 = ld(j0 - 2), xm1 = ld(j0 - 1), x0 = ld(j0);
    bf16* XT = (bf16*)(p.ws + OFF_MIX + MX_XBT) + ((size_t)(base / TOK) * 512 + c) * TOK + j0;
    for (int i8 = 0; i8 < 32; i8 += 8) {
      float yv[8];
#pragma unroll
      for (int k = 0; k < 8; ++k) {
        float xp1 = ld(j0 + i8 + k + 1);
        float y = siluf_(bb + w0 * xm2 + w1 * xm1 + w2 * x0 + w3 * xp1);
        XB[(size_t)(tok0 + i8 + k) * 768 + c] = f2bf(y);
        yv[k] = y;
        xm2 = xm1; xm1 = x0; x0 = xp1;
      }
      if (c < 512) st8bf(XT + i8, yv);
    }
  }
}
DI int m2_seq2tok(int sq, int dir) { return (dir == 0) ? sq : (sq < CTXL ? (CTXL - 1 - sq) : (TOK - 1 - (sq - CTXL))); }
constexpr int M2S_ITEMS = BATCH * 8 * (TOK / 64) / NWAVES;
DI void m2scal_item(const Params& p, const LP& L, int it) {
  const int w = it * NWAVES + (tid_() >> 6), lane = tid_() & 63;
  const int ch = w % (TOK / 64), r = w / (TOK / 64), hd = r & 3, dir = (r >> 2) & 1, b = r >> 3;
  const float a = -expf(p.in[I_M2ALOG][(L.l * 2 + dir) * 4 + hd]);
  const int sq = ch * 64 + lane, j = m2_seq2tok(sq, dir);
  const float dt = ((const float*)(p.ws + OFF_DT))[((size_t)b * TOK + j) * 8 + dir * 4 + hd];
  float cs = dt * a;
#pragma unroll
  for (int d = 1; d < 64; d <<= 1) { float o = shfl_up_(cs, d); if (lane >= d) cs += o; }
  const float sl = shfl_(cs, 63);
  float* o = (float*)(p.ws + OFF_MIX + MX_M2S) + ((size_t)((b * 2 + dir) * 4 + hd) * TOK + sq) * 4;
  *(float4*)o = make_float4(cs, dt, dt * __expf(sl - cs), cs * 1.4426950408889634f - log2f(dt));
}
constexpr int S5_MT = (MCH + 255) / 256;
DI void s5a_tile(const Params& p, const LP& L, int t, char* smem) {
  const int g = t / (S5_MT * 2), r = t % (S5_MT * 2), mt = r / 2, nt = r % 2;
  const int m0 = mt * 256, n0 = nt * 128;
  GA ga = make_ga((const bf16*)(p.ws + OFF_MIX + MX_US5) + (size_t)g * NTOK * 16, 256, (const bf16*)(L.s5 + S5_WA) + (size_t)g * 65536, 256, 256, MCH);
  f32x4 acc[4][4];
  gemm_s<4>(ga, m0, n0, smem, acc);
  float* HE = (float*)(p.ws + OFF_MIX + MX_HEND) + (size_t)g * MCH * 256;
  EPI_BEGIN(4, acc, m0, n0, MCH)
    st8f(HE + (size_t)row * 256 + col, v);
  EPI_END
}
DI int s5_chunk_of(int i, int d) { return (d == 0) ? i : (i < NCC ? (NCC - 1 - i) : (NCH - 1 - (i - NCC))); }
DI void s5carry_item(const Params& p, const LP& L, int it) {
  const int w = it * NWAVES + (tid_() >> 6), lane = tid_() & 63;
  const int d = w / (16 * BATCH), g = (w / BATCH) & 15, b = w % BATCH;
  const float* lp = (const float*)(L.s5 + S5_LAMPOW) + ((size_t)((d * 16 + g) * 17 + 16) * 64 + lane) * 2;
  const float lre = lp[0], lim = lp[1];
  const float* HE = (const float*)(p.ws + OFF_MIX + MX_HEND) + ((size_t)g * MCH + (size_t)b * NCH) * 256 + d * 128;
  bf16* HI = (bf16*)(p.ws + OFF_MIX + MX_HIN) + ((size_t)g * MCH + (size_t)b * NCH) * 256 + d * 128;
  float cre = 0.f, cim = 0.f;
  static_assert(NCH % 4 == 0, "chunk count");
  for (int i0 = 0; i0 < NCH; i0 += 4) {
    float hre[4], him[4];
#pragma unroll
    for (int k = 0; k < 4; ++k) { const int ch = s5_chunk_of(i0 + k, d); hre[k] = HE[(size_t)ch * 256 + lane]; him[k] = HE[(size_t)ch * 256 + 64 + lane]; }
#pragma unroll
    for (int k = 0; k < 4; ++k) {
      const int ch = s5_chunk_of(i0 + k, d);
      HI[(size_t)ch * 256 + lane] = f2bf(cre); HI[(size_t)ch * 256 + 64 + lane] = f2bf(cim);
      const float nre = lre * cre - lim * cim + hre[k], nim = lre * cim + lim * cre + him[k];
      cre = nre; cim = nim;
    }
  }
}
DI void s5c_tile(const Params& p, const LP& L, int t, char* smem) {
  const int g = t / (S5_MT * 2), r = t % (S5_MT * 2), mt = r / 2, nt = r % 2;
  const int m0 = mt * 256, n0 = nt * 128;
  GA ga = make_ga((const bf16*)(p.ws + OFF_MIX + MX_US5) + (size_t)g * NTOK * 16, 256, (const bf16*)(L.s5 + S5_W2) + (size_t)g * 256 * 512, 512, 512, MCH);
  ga.A2 = (const bf16*)(p.ws + OFF_MIX + MX_HIN) + (size_t)g * MCH * 256; ga.lda2 = 256; ga.ksplit = 256;
  f32x4 acc[4][4];
  gemm_s<4>(ga, m0, n0, smem, acc);
  bf16* Z = (bf16*)(p.ws + OFF_MIX + MX_Z);
  EPI_BEGIN(4, acc, m0, n0, MCH)
#pragma unroll
    for (int k = 0; k < 8; ++k) v[k] = geluf_(v[k]);
    st8bf(Z + ((size_t)row * 16 + (col >> 4)) * 256 + g * 16 + (col & 15), v);
  EPI_END
}

DI float fmax_(float a, float b) { return a > b ? a : b; }
constexpr int AT_LDV = 76;
struct NaInfo { int r, qc, rs, cs; };
template <int DK, bool NA>
DI void attn_block(const bf16* qrow, bool active, const bf16* Kp, int kstride, const bf16* Vt,
                   int ka0, int ntile_a, int arow0, int kb0, int ntile_b,
                   const float* srpb, NaInfo ni, float scale, bf16* orow, char* smem) {
  constexpr int LDK = DK + 8, KCH = DK / 8;
  constexpr int KT_BYTES = 64 * LDK * 2, VT_BYTES = 64 * AT_LDV * 2;
  constexpr int NKL = (64 * KCH + NTHREADS - 1) / NTHREADS;
  const int tid = tid_(), lane = tid & 63, half = lane >> 5, r = lane & 31;
  bf16* sK = (bf16*)smem;
  bf16* sV = (bf16*)(smem + 2 * KT_BYTES);
  bf16x8 qf[DK / 16];
  f32x16 o0, o1;
  float m = -1e30f, l = 0.f;
#pragma unroll
  for (int ks = 0; ks < DK / 16; ++ks) qf[ks] = active ? *(const bf16x8*)(qrow + ks * 16 + 8 * half) : bf16x8{0, 0, 0, 0, 0, 0, 0, 0};
#pragma unroll
  for (int i = 0; i < 16; ++i) { o0[i] = 0.f; o1[i] = 0.f; }
  const int NTL = ntile_a + ntile_b;
  u32x4 rk[NKL], rv[1];
#pragma unroll
  for (int i = 0; i < NKL; ++i) rk[i] = u32x4{0u, 0u, 0u, 0u};
  auto key0_of = [&](int t) { return t < ntile_a ? ka0 + 64 * t : kb0 + 64 * (t - ntile_a); };
#define AT_GLOAD(t_) { const int k0_ = key0_of(t_); \
    _Pragma("unroll") for (int i_ = 0; i_ < NKL; ++i_) { const int c_ = tid + i_ * NTHREADS; const int key_ = c_ / KCH, ch_ = c_ % KCH; \
      if (c_ < 64 * KCH) rk[i_] = *(const u32x4*)(Kp + (size_t)(k0_ + key_) * kstride + ch_ * 8); } \
    { const int d_ = tid >> 3, ch_ = tid & 7; rv[0] = *(const u32x4*)(Vt + (size_t)d_ * TOK + k0_ + ch_ * 8); } }
#define AT_SSTORE(buf_) { \
    _Pragma("unroll") for (int i_ = 0; i_ < NKL; ++i_) { const int c_ = tid + i_ * NTHREADS; const int key_ = c_ / KCH, ch_ = c_ % KCH; \
      if (c_ < 64 * KCH) *(u32x4*)(sK + (buf_) * (64 * LDK) + key_ * LDK + ch_ * 8) = rk[i_]; } \
    { const int d_ = tid >> 3, ch_ = tid & 7; \
      bf16* dst_ = sV + (buf_) * (64 * AT_LDV) + d_ * AT_LDV + ch_ * 8; \
      *(uint2*)dst_ = make_uint2(rv[0][0], rv[0][1]); *(uint2*)(dst_ + 4) = make_uint2(rv[0][2], rv[0][3]); } }
  __syncthreads();
  AT_GLOAD(0) AT_SSTORE(0)
  __syncthreads();
#pragma unroll 1
  for (int t = 0; t < NTL; ++t) {
    const int buf = t & 1;
    if (t + 1 < NTL) AT_GLOAD(t + 1)
    bool doit = active;
    int trow0 = 0;
    if (NA && t < ntile_a) {
      trow0 = arow0 + t * (64 / GRID_W);
      doit = active && (trow0 + (64 / GRID_W) > ni.rs) && (trow0 < ni.rs + WIN_R);
    }
    if (doit) {
      const bf16* kb = sK + buf * (64 * LDK);
      const bf16* vb = sV + buf * (64 * AT_LDV);
      f32x16 s0, s1;
#pragma unroll
      for (int i = 0; i < 16; ++i) { s0[i] = 0.f; s1[i] = 0.f; }
#pragma unroll
      for (int ks = 0; ks < DK / 16; ++ks) {
        bf16x8 a0 = *(const bf16x8*)(kb + r * LDK + ks * 16 + 8 * half);
        bf16x8 a1 = *(const bf16x8*)(kb + (32 + r) * LDK + ks * 16 + 8 * half);
        s0 = __builtin_amdgcn_mfma_f32_32x32x16_bf16(a0, qf[ks], s0, 0, 0, 0);
        s1 = __builtin_amdgcn_mfma_f32_32x32x16_bf16(a1, qf[ks], s1, 0, 0, 0);
      }
      float mx = -INFINITY;
      if (NA && t < ntile_a) {
#pragma unroll
        for (int i = 0; i < 16; ++i) {
          const int kk = (i & 3) + 8 * (i >> 2) + 4 * half;
#pragma unroll
          for (int hb = 0; hb < 2; ++hb) {
            const int kq = kk + 32 * hb;
            const int kr = trow0 + kq / GRID_W, kc = kq % GRID_W;
            const bool ok = (kr >= ni.rs) && (kr < ni.rs + WIN_R) && (kc >= ni.cs) && (kc < ni.cs + WIN_C);
            const float bias = ok ? srpb[(kr - ni.r + 7) * 31 + (kc - ni.qc + 15)] : -INFINITY;
            if (hb == 0) { s0[i] = s0[i] * scale + bias; mx = fmax_(mx, s0[i]); }
            else { s1[i] = s1[i] * scale + bias; mx = fmax_(mx, s1[i]); }
          }
        }
      } else {
#pragma unroll
        for (int i = 0; i < 16; ++i) { s0[i] *= scale; s1[i] *= scale; mx = fmax_(mx, fmax_(s0[i], s1[i])); }
      }
      mx = fmax_(mx, shfl_xor_(mx, 32));
      const float mn = fmax_(m, mx);
      const float alpha = __expf(m - mn);
      m = mn;
      float ps = 0.f;
#pragma unroll
      for (int i = 0; i < 16; ++i) { s0[i] = __expf(s0[i] - mn); s1[i] = __expf(s1[i] - mn); ps += s0[i] + s1[i]; }
      l = l * alpha + ps;
#pragma unroll
      for (int i = 0; i < 16; ++i) { o0[i] *= alpha; o1[i] *= alpha; }
#pragma unroll
      for (int kq = 0; kq < 4; ++kq) {
        u32x4 pw;
#pragma unroll
        for (int j = 0; j < 4; ++j) pw[j] = (kq < 2) ? pack2(s0[8 * (kq & 1) + 2 * j], s0[8 * (kq & 1) + 2 * j + 1]) : pack2(s1[8 * (kq & 1) + 2 * j], s1[8 * (kq & 1) + 2 * j + 1]);
        const bf16x8 pf = __builtin_bit_cast(bf16x8, pw);
        const bf16* v0 = vb + r * AT_LDV + 16 * kq + 4 * half;
        const bf16* v1 = vb + (r + 32) * AT_LDV + 16 * kq + 4 * half;
        uint2 a0 = *(const uint2*)v0, a1 = *(const uint2*)(v0 + 8), b0 = *(const uint2*)v1, b1 = *(const uint2*)(v1 + 8);
        bf16x8 va, vbb;
        va[0] = (short)(a0.x & 0xffff); va[1] = (short)(a0.x >> 16); va[2] = (short)(a0.y & 0xffff); va[3] = (short)(a0.y >> 16);
        va[4] = (short)(a1.x & 0xffff); va[5] = (short)(a1.x >> 16); va[6] = (short)(a1.y & 0xffff); va[7] = (short)(a1.y >> 16);
        vbb[0] = (short)(b0.x & 0xffff); vbb[1] = (short)(b0.x >> 16); vbb[2] = (short)(b0.y & 0xffff); vbb[3] = (short)(b0.y >> 16);
        vbb[4] = (short)(b1.x & 0xffff); vbb[5] = (short)(b1.x >> 16); vbb[6] = (short)(b1.y & 0xffff); vbb[7] = (short)(b1.y >> 16);
        o0 = __builtin_amdgcn_mfma_f32_32x32x16_bf16(va, pf, o0, 0, 0, 0);
        o1 = __builtin_amdgcn_mfma_f32_32x32x16_bf16(vbb, pf, o1, 0, 0, 0);
      }
    }
    if (t + 1 < NTL) AT_SSTORE(buf ^ 1)
    __syncthreads();
  }
  if (active) {
    const float lt = l + shfl_xor_(l, 32);
    const float inv = 1.0f / lt;
#pragma unroll
    for (int gI = 0; gI < 4; ++gI) {
      const int d0 = 8 * gI + 4 * half;
      *(uint2*)(orow + d0) = make_uint2(pack2(o0[4 * gI] * inv, o0[4 * gI + 1] * inv), pack2(o0[4 * gI + 2] * inv, o0[4 * gI + 3] * inv));
      *(uint2*)(orow + 32 + d0) = make_uint2(pack2(o1[4 * gI] * inv, o1[4 * gI + 1] * inv), pack2(o1[4 * gI + 2] * inv, o1[4 * gI + 3] * inv));
    }
  }
}
DI void mla_attn_item(const Params& p, int it, bool ctxq, char* smem) {
  const int nqb = ctxq ? (CTXL + 255) / 256 : SEQ / 256;
  const int b = it / (4 * nqb), h = (it / nqb) & 3, qb = it % nqb;
  const int lane = tid_() & 63, wid = tid_() >> 6;
  const int nq = ctxq ? CTXL : SEQ, q0 = qb * 256 + wid * 32;
  const bool active = q0 < nq;
  const int jq = (ctxq ? 0 : CTXL) + (active ? q0 : 0) + (lane & 31);
  const bf16* Q = (const bf16*)(p.ws + OFF_MIX + MX_Q) + ((size_t)b * 4 + h) * TOK * 96;
  const bf16* K = (const bf16*)(p.ws + OFF_MIX + MX_K) + ((size_t)b * 4 + h) * TOK * 96;
  const bf16* VT = (const bf16*)(p.ws + OFF_MIX + MX_VTM) + ((size_t)b * 4 + h) * 64 * TOK;
  bf16* O = (bf16*)(p.ws + OFF_O) + ((size_t)b * TOK + jq) * 1024 + 0 * 256 + h * 64;
  NaInfo ni; ni.r = 0; ni.qc = 0; ni.rs = 0; ni.cs = 0;
  attn_block<96, false>(Q + (size_t)jq * 96, active, K, 96, VT, 0, 0, 0, 0, (ctxq ? CTXL : TOK) / 64, nullptr, ni, 0.10206207261596577f, O, smem);
}
DI void na_attn_item(const Params& p, const LP& L, int it, bool ctxq, char* smem) {
  const int nqb = ctxq ? (CTXL + 255) / 256 : SEQ / 256;
  const int b = it / (4 * nqb), h = (it / nqb) & 3, qb = it % nqb;
  const int tid = tid_(), lane = tid & 63, wid = tid >> 6;
  const int nq = ctxq ? CTXL : SEQ, q0 = qb * 256 + wid * 32;
  const bool active = q0 < nq;
  const int jq = (ctxq ? 0 : CTXL) + (active ? q0 : 0) + (lane & 31);
  const bf16* P1 = (const bf16*)(p.ws + OFF_P1) + (size_t)b * TOK * P1W;
  const bf16* VT = (const bf16*)(p.ws + OFF_MIX + MX_VTN) + ((size_t)b * 4 + h) * 64 * TOK;
  const bf16* Kb = P1 + C_NA + 256 + h * 64;
  bf16* O = (bf16*)(p.ws + OFF_O) + ((size_t)b * TOK + jq) * 1024 + 1 * 256 + h * 64;
  constexpr int AT_END64 = 2 * (64 * 72 * 2) + 2 * (64 * AT_LDV * 2);
  float* srpb = (float*)(smem + AT_END64);
  NaInfo ni; ni.r = 0; ni.qc = 0; ni.rs = 0; ni.cs = 0;
  int ka0 = 0, nta = 0, arow0 = 0;
  if (!ctxq) {
    __syncthreads();
    const float* rpb = p.in[I_RPB] + ((size_t)L.l * 4 + h) * 15 * 31;
    for (int i = tid; i < 15 * 31; i += NTHREADS) srpb[i] = rpb[i];
    const int tl = q0 + (lane & 31);
    ni.r = tl / GRID_W; ni.qc = tl % GRID_W;
    int rs = ni.r - WIN_R / 2; rs = rs < 0 ? 0 : (rs > ROWS - WIN_R ? ROWS - WIN_R : rs);
    int cs = ni.qc - WIN_C / 2; cs = cs < 0 ? 0 : (cs > GRID_W - WIN_C ? GRID_W - WIN_C : cs);
    ni.rs = rs; ni.cs = cs;
    constexpr int RPT = 64 / GRID_W;
    const int rfirst = (qb * 256) / GRID_W, rlast = (qb * 256 + 255) / GRID_W;
    int rs_f = rfirst - WIN_R / 2; rs_f = rs_f < 0 ? 0 : (rs_f > ROWS - WIN_R ? ROWS - WIN_R : rs_f);
    int rs_l = rlast - WIN_R / 2; rs_l = rs_l < 0 ? 0 : (rs_l > ROWS - WIN_R ? ROWS - WIN_R : rs_l);
    arow0 = (rs_f / RPT) * RPT;
    const int row_hi = rs_l + WIN_R;
    nta = (row_hi - arow0 + RPT - 1) / RPT;
    ka0 = CTXL + arow0 * GRID_W;
  }
  attn_block<64, true>(P1 + (size_t)jq * P1W + C_NA + h * 64, active, Kb, P1W, VT, ka0, nta, arow0, 0, CTXL / 64, srpb, ni, 0.125f, O, smem);
}

constexpr int M2_LDB = 136, M2_LDX = 72;
constexpr int M2_OFF_B = 0;
constexpr int M2_OFF_C = M2_OFF_B + 64 * M2_LDB * 2;
constexpr int M2_OFF_HD = M2_OFF_C + 64 * M2_LDB * 2;
constexpr int M2H_H = 0;
constexpr int M2H_XT = M2H_H + 64 * M2_LDB * 2;
constexpr int M2H_BT = M2H_XT + 64 * M2_LDX * 2;
constexpr int M2H_S = M2H_BT + 128 * M2_LDX * 2;
constexpr int M2H_X = M2H_S + 3 * 64 * 4;
constexpr int M2H_SIZE = M2H_X + 64 * M2_LDX * 2;
constexpr int M2_SMEM = M2_OFF_HD + 2 * M2H_SIZE;
static_assert(M2_SMEM <= SMEM_BYTES, "m2 smem");
DI u32x4 rev8_(u32x4 v) {
  return u32x4{(v[3] >> 16) | (v[3] << 16), (v[2] >> 16) | (v[2] << 16), (v[1] >> 16) | (v[1] << 16), (v[0] >> 16) | (v[0] << 16)};
}
DI void m2scan_item(const Params& p, const LP& L, int it, char* smem) {
  const int b = it / 4, grp = (it >> 1) & 1, dir = it & 1;
  const int tid = tid_(), lane = tid & 63, wid = tid >> 6, half = lane >> 5, r = lane & 31;
  const int hsel = wid >> 2, wl = wid & 3, hd = grp * 2 + hsel;
  bf16* sB = (bf16*)(smem + M2_OFF_B);
  bf16* sC = (bf16*)(smem + M2_OFF_C);
  char* hb = smem + M2_OFF_HD + hsel * M2H_SIZE;
  bf16* sH = (bf16*)(hb + M2H_H);
  bf16* sXT = (bf16*)(hb + M2H_XT);
  bf16* sBT = (bf16*)(hb + M2H_BT);
  float* sS = (float*)(hb + M2H_S);
  float* sDt = sS + 64;
  float* sW = sS + 128;
  const bf16* XB = (const bf16*)(p.ws + OFF_MIX + MX_XBC) + (size_t)b * TOK * 768;
  const bf16* XT = (const bf16*)(p.ws + OFF_MIX + MX_XBT) + (size_t)b * 512 * TOK;
  const float* SC = (const float*)(p.ws + OFF_MIX + MX_M2S) + (size_t)((b * 2 + dir) * 4 + hd) * TOK * 4;
  float* YM = (float*)(p.ws + OFF_HA) + ((size_t)dir * NTOK + (size_t)b * TOK) * 256;
  const int pb = wl & 1, tb = wl >> 1, nb0 = 2 * (wl >> 1);
  f32x16 hst[2];
#pragma unroll
  for (int i = 0; i < 16; ++i) { hst[0][i] = 0.f; hst[1][i] = 0.f; }
  __syncthreads();
  for (int i = tid; i < 2 * M2H_SIZE / 4; i += NTHREADS) ((unsigned*)(smem + M2_OFF_HD))[i] = 0u;
  __syncthreads();
  u32x4 rxt[2], rbt[2], rb[2], rc[2];
  float4 rsc = make_float4(0.f, 0.f, 0.f, 0.f);
#define M2_TLOAD(rowptr_, sq0_) (*(const u32x4*)((rowptr_) + ((dir == 0) ? (sq0_) : m2_seq2tok((sq0_) + 7, 1))))
#define M2_GLOAD(c0_) { \
    _Pragma("unroll") for (int q_ = 0; q_ < 2; ++q_) { const int i_ = tid + q_ * NTHREADS; const int h2_ = i_ >> 9, t8_ = ((i_ >> 6) & 7) * 8, pp_ = i_ & 63; \
      rxt[q_] = M2_TLOAD(XT + (size_t)((grp * 2 + h2_) * 64 + pp_) * TOK, (c0_) + t8_); } \
    _Pragma("unroll") for (int q_ = 0; q_ < 2; ++q_) { const int i_ = tid + q_ * NTHREADS; const int t8_ = (i_ >> 7) * 8, nn_ = i_ & 127; \
      rbt[q_] = M2_TLOAD(XT + (size_t)(256 + grp * 128 + nn_) * TOK, (c0_) + t8_); } \
    _Pragma("unroll") for (int q_ = 0; q_ < 2; ++q_) { const int i_ = tid + q_ * NTHREADS; const int t_ = i_ >> 4, n8_ = (i_ & 15) * 8; \
      const bf16* src_ = XB + (size_t)m2_seq2tok((c0_) + t_, dir) * 768 + grp * 128 + n8_; \
      rb[q_] = *(const u32x4*)(src_ + 256); rc[q_] = *(const u32x4*)(src_ + 512); } \
    if (wl == 0) rsc = *(const float4*)(SC + (size_t)((c0_) + lane) * 4); }
  M2_GLOAD(0)
  for (int c0 = 0; c0 < TOK; c0 += 64) {
    if (wl == 0) { sS[lane] = rsc.x; sDt[lane] = rsc.w; sW[lane] = rsc.z; }
    __syncthreads();
#pragma unroll
    for (int q2 = 0; q2 < 2; ++q2) {
      const int i = tid + q2 * NTHREADS; const int h2 = i >> 9, t8 = ((i >> 6) & 7) * 8, pp = i & 63;
      *(u32x4*)((bf16*)(smem + M2_OFF_HD + h2 * M2H_SIZE + M2H_XT) + pp * M2_LDX + t8) = dir ? rev8_(rxt[q2]) : rxt[q2];
    }
#pragma unroll
    for (int q4 = 0; q4 < 2; ++q4) {
      const int i = tid + q4 * NTHREADS; const int t = i >> 4, n8 = (i & 15) * 8;
      *(u32x4*)(sB + t * M2_LDB + n8) = rb[q4];
      *(u32x4*)(sC + t * M2_LDB + n8) = rc[q4];
    }
#pragma unroll
    for (int q4 = 0; q4 < 2; ++q4) {
      const int i = tid + q4 * NTHREADS; const int t8 = (i >> 7) * 8, nn = i & 127;
      float bv[8];
      if (dir) rbt[q4] = rev8_(rbt[q4]);
      bv[0] = __uint_as_float(rbt[q4][0] << 16); bv[1] = __uint_as_float(rbt[q4][0] & 0xffff0000u);
      bv[2] = __uint_as_float(rbt[q4][1] << 16); bv[3] = __uint_as_float(rbt[q4][1] & 0xffff0000u);
      bv[4] = __uint_as_float(rbt[q4][2] << 16); bv[5] = __uint_as_float(rbt[q4][2] & 0xffff0000u);
      bv[6] = __uint_as_float(rbt[q4][3] << 16); bv[7] = __uint_as_float(rbt[q4][3] & 0xffff0000u);
#pragma unroll
      for (int h2 = 0; h2 < 2; ++h2) {
        const float* wv = (const float*)(smem + M2_OFF_HD + h2 * M2H_SIZE + M2H_S) + 128 + t8;
        float sv[8];
#pragma unroll
        for (int k = 0; k < 8; ++k) sv[k] = bv[k] * wv[k];
        st8bf((bf16*)(smem + M2_OFF_HD + h2 * M2H_SIZE + M2H_BT) + nn * M2_LDX + t8, sv);
      }
    }
    __syncthreads();
    if (c0 + 64 < TOK) M2_GLOAD(c0 + 64)
    {
      f32x16 yT, y2;
#pragma unroll
      for (int i = 0; i < 16; ++i) { yT[i] = 0.f; y2[i] = 0.f; }
      const int tv = 32 * tb + r;
      const float St = sS[tv];
      for (int sb = 0; sb <= tb; ++sb) {
        f32x16 gT;
#pragma unroll
        for (int i = 0; i < 16; ++i) gT[i] = 0.f;
#pragma unroll
        for (int ks = 0; ks < 8; ++ks) {
          bf16x8 av = *(const bf16x8*)(sB + (32 * sb + r) * M2_LDB + 16 * ks + 8 * half);
          bf16x8 bv = *(const bf16x8*)(sC + tv * M2_LDB + 16 * ks + 8 * half);
          gT = __builtin_amdgcn_mfma_f32_32x32x16_bf16(av, bv, gT, 0, 0, 0);
        }
        const float St2 = St * 1.4426950408889634f;
        if (sb == tb) {
#pragma unroll
          for (int i = 0; i < 16; ++i) {
            const int sv = 32 * sb + (i & 3) + 8 * (i >> 2) + 4 * half;
            gT[i] = (sv <= tv) ? gT[i] * exp2f_(St2 - sDt[sv]) : 0.f;
          }
        } else {
#pragma unroll
          for (int i = 0; i < 16; ++i) {
            const int sv = 32 * sb + (i & 3) + 8 * (i >> 2) + 4 * half;
            gT[i] *= exp2f_(St2 - sDt[sv]);
          }
        }
#pragma unroll
        for (int kq = 0; kq < 2; ++kq) {
          const u32x4 pw = u32x4{pack2(gT[8 * kq], gT[8 * kq + 1]), pack2(gT[8 * kq + 2], gT[8 * kq + 3]), pack2(gT[8 * kq + 4], gT[8 * kq + 5]), pack2(gT[8 * kq + 6], gT[8 * kq + 7])};
          const bf16x8 pf = __builtin_bit_cast(bf16x8, pw);
          const bf16* xr = sXT + (32 * pb + r) * M2_LDX + 32 * sb + 16 * kq + 4 * half;
          uint2 x0 = *(const uint2*)xr, x1 = *(const uint2*)(xr + 8);
          bf16x8 xa;
          xa[0] = (short)(x0.x & 0xffff); xa[1] = (short)(x0.x >> 16); xa[2] = (short)(x0.y & 0xffff); xa[3] = (short)(x0.y >> 16);
          xa[4] = (short)(x1.x & 0xffff); xa[5] = (short)(x1.x >> 16); xa[6] = (short)(x1.y & 0xffff); xa[7] = (short)(x1.y >> 16);
          yT = __builtin_amdgcn_mfma_f32_32x32x16_bf16(xa, pf, yT, 0, 0, 0);
        }
      }
#pragma unroll
      for (int ks = 0; ks < 8; ++ks) {
        bf16x8 av = *(const bf16x8*)(sH + (32 * pb + r) * M2_LDB + 16 * ks + 8 * half);
        bf16x8 bv = *(const bf16x8*)(sC + tv * M2_LDB + 16 * ks + 8 * half);
        y2 = __builtin_amdgcn_mfma_f32_32x32x16_bf16(av, bv, y2, 0, 0, 0);
      }
      const float eS = __expf(St);
      const int j = m2_seq2tok(c0 + tv, dir);
      float* yo = YM + (size_t)j * 256 + hd * 64 + 32 * pb + 4 * half;
#pragma unroll
      for (int gI = 0; gI < 4; ++gI)
        *(float4*)(yo + 8 * gI) = make_float4(yT[4 * gI] + eS * y2[4 * gI], yT[4 * gI + 1] + eS * y2[4 * gI + 1], yT[4 * gI + 2] + eS * y2[4 * gI + 2], yT[4 * gI + 3] + eS * y2[4 * gI + 3]);
    }
    __syncthreads();
    {
      const float eL = __expf(sS[63]);
#pragma unroll
      for (int q = 0; q < 2; ++q) {
#pragma unroll
        for (int i = 0; i < 16; ++i) hst[q][i] *= eL;
#pragma unroll
        for (int ks = 0; ks < 4; ++ks) {
          bf16x8 av = *(const bf16x8*)(sXT + (32 * pb + r) * M2_LDX + 16 * ks + 8 * half);
          bf16x8 bv = *(const bf16x8*)(sBT + (32 * (nb0 + q) + r) * M2_LDX + 16 * ks + 8 * half);
          hst[q] = __builtin_amdgcn_mfma_f32_32x32x16_bf16(av, bv, hst[q], 0, 0, 0);
        }
#pragma unroll
        for (int i = 0; i < 16; ++i) {
          const int pv = 32 * pb + (i & 3) + 8 * (i >> 2) + 4 * half;
          sH[pv * M2_LDB + 32 * (nb0 + q) + r] = f2bf(hst[q][i]);
        }
      }
    }
    __syncthreads();
  }
}
DI void m2gate_item(const Params& p, const LP& L, int it) {
  const int tok = it * NWAVES + (tid_() >> 6), lane = tid_() & 63;
  const float* Y0 = (const float*)(p.ws + OFF_HA) + (size_t)tok * 256;
  const float* Y1 = Y0 + (size_t)NTOK * 256;
  const bf16* XB = (const bf16*)(p.ws + OFF_MIX + MX_XBC) + (size_t)tok * 768;
  const bf16* P1 = (const bf16*)(p.ws + OFF_P1) + (size_t)tok * P1W + C_Z;
  const int c = lane * 4, hd = c >> 6;
  const float dsk = p.in[I_M2D][L.l * 4 + hd];
  float4 y0 = *(const float4*)(Y0 + c), y1 = *(const float4*)(Y1 + c);
  uint2 xw = *(const uint2*)(XB + c), zw = *(const uint2*)(P1 + c);
  float xs[4] = {__uint_as_float(xw.x << 16), __uint_as_float(xw.x & 0xffff0000u), __uint_as_float(xw.y << 16), __uint_as_float(xw.y & 0xffff0000u)};
  float zs[4] = {__uint_as_float(zw.x << 16), __uint_as_float(zw.x & 0xffff0000u), __uint_as_float(zw.y << 16), __uint_as_float(zw.y & 0xffff0000u)};
  float ys[4] = {y0.x + y1.x, y0.y + y1.y, y0.z + y1.z, y0.w + y1.w};
  float v[4], ss = 0.f;
#pragma unroll
  for (int i = 0; i < 4; ++i) { v[i] = (ys[i] + dsk * xs[i]) * siluf_(zs[i]); ss += v[i] * v[i]; }
  ss = wave_sum(ss);
  const float rs = rsqrtf(ss * (1.f / 256.f) + EPS);
  float4 gn = *(const float4*)(p.in[I_M2GNORM] + L.l * 256 + c);
  bf16* O = (bf16*)(p.ws + OFF_O) + (size_t)tok * 1024 + 768 + c;
  *(uint2*)O = make_uint2(pack2(v[0] * rs * gn.x, v[1] * rs * gn.y), pack2(v[2] * rs * gn.z, v[3] * rs * gn.w));
}
constexpr int GLU_MT = (NTOK + 255) / 256;
DI void glu_tile(const Params& p, const LP& L, int t, char* smem) {
  const int mt = t % GLU_MT, nt = t / GLU_MT, m0 = mt * 256, n0 = nt * 128;
  const bf16* Z = (const bf16*)(p.ws + OFF_MIX + MX_Z);
  GA g = make_ga(Z, 256, (const bf16*)(L.we + WE_GLU), 256, 256, NTOK);
  f32x4 acc[4][4];
  gemm_s<4>(g, m0, n0, smem, acc);
  bf16* O = (bf16*)(p.ws + OFF_O);
  const float* bg = p.in[I_S5BGLU] + L.l * 256;
  EPI_BEGIN(4, acc, m0, n0, NTOK)
    float z[8]; ld8bf(Z + (size_t)row * 256 + col, z);
#pragma unroll
    for (int k = 0; k < 8; ++k) v[k] = z[k] * sigmoidf_(v[k] + bg[col + k]);
    st8bf(O + (size_t)row * 1024 + 512 + col, v);
  EPI_END
}
DI void merge_tile(const Params& p, const LP& L, int t, char* smem) {
  constexpr int MT_L = BATCH * (SEQ / 256), MT_A = (NTOK + 255) / 256;
  const int mt = L.last ? t % MT_L : t % MT_A, nt = L.last ? t / MT_L : t / MT_A, m0 = mtile_row0(mt, L.last, 256), n0 = nt * 64;
  const bf16* O = (const bf16*)(p.ws + OFF_O);
  const bf16* PG = (const bf16*)(p.ws + OFF_PG);
  float tot[4][8];
#pragma unroll
  for (int a = 0; a < 4; ++a)
#pragma unroll
    for (int k = 0; k < 8; ++k) tot[a][k] = 0.f;
  for (int j = 0; j < 4; ++j) {
    GA g = make_ga(O + j * 256, 1024, (const bf16*)(L.we + WE_WB) + (size_t)j * 1024 * 256, 256, 256, NTOK);
    f32x4 acc[4][2];
    gemm_s<2>(g, m0, n0, smem, acc);
    EPI_BEGIN(2, acc, m0, n0, NTOK)
      float gt[8]; ld8bf(PG + (size_t)row * 4096 + j * 1024 + col, gt);
#pragma unroll
      for (int k = 0; k < 8; ++k) tot[_m][k] += gt[k] * v[k];
    EPI_END
  }
  bf16* Y = (bf16*)(p.ws + OFF_P1);
  {
    const int l = tid_() & 63, w = tid_() >> 6, wr = w >> 1, wc = w & 1, fr = l & 15, fq = l >> 4;
#pragma unroll
    for (int m = 0; m < 4; ++m) {
      const int row = m0 + wr * 64 + m * 16 + fr, col = n0 + wc * 32 + 8 * fq;
      if (row < NTOK) st8bf(Y + (size_t)row * 1024 + col, tot[m]);
    }
  }
}
DI void outproj_tile(const Params& p, const LP& L, int t, char* smem) {
  float* Y2 = (float*)(p.ws + OFF_HA);
  constexpr int MT_L = BATCH * (SEQ / 256), MT_A = (NTOK + 255) / 256;
  const int mt = L.last ? t % MT_L : t % MT_A, nt = L.last ? t / MT_L : t / MT_A, m0 = mtile_row0(mt, L.last, 256), n0 = nt * 256;
  GA g = make_ga((const bf16*)(p.ws + OFF_P1), 1024, (const bf16*)(L.we + WE_WOUT), 1024, 1024, NTOK);
  f32x4 acc[2][2][4][2];
  gemm_big(g, m0, n0, smem, acc);
  EPIB_BEGIN(acc, m0, n0, NTOK)
    st8f(Y2 + (size_t)row * 1024 + col, v);
  EPIB_END
}
DI int post_ntok(bool latonly) { return latonly ? BATCH * SEQ : NTOK; }
DI int post_tok(int i, bool latonly) { return latonly ? ((i / SEQ) * TOK + CTXL + (i % SEQ)) : i; }

DI void post_item(const Params& p, const LP& L, int it) {
  const int tok = post_tok(it * NWAVES + (tid_() >> 6), L.last), lane = tid_() & 63;
  float* X = (float*)(p.ws + OFF_X) + (size_t)tok * 1024;
  const float* Y2 = (const float*)(p.ws + OFF_HA) + (size_t)tok * 1024;
  const float* mod = L.mod + (size_t)tok_modrow(tok) * 6144;
  float yv[16], xv[16], h[16];
  float ss = 0.f;
#pragma unroll
  for (int i = 0; i < 4; ++i) {
    float4 v = *(const float4*)(Y2 + lane * 4 + i * 256);
    yv[i * 4] = v.x; yv[i * 4 + 1] = v.y; yv[i * 4 + 2] = v.z; yv[i * 4 + 3] = v.w;
    ss += v.x * v.x + v.y * v.y + v.z * v.z + v.w * v.w;
  }
  ss = wave_sum(ss);
  const float rs = rsqrtf(ss * (1.f / 1024.f) + EPS);
  const float* gpm = p.in[I_GPOSTMIX] + L.l * 1024;
#pragma unroll
  for (int i = 0; i < 4; ++i) {
    int c = lane * 4 + i * 256;
    float4 xo = *(const float4*)(X + c), gv = *(const float4*)(gpm + c), gt = *(const float4*)(mod + 2048 + c);
    xo.x += gt.x * yv[i * 4] * rs * gv.x; xo.y += gt.y * yv[i * 4 + 1] * rs * gv.y; xo.z += gt.z * yv[i * 4 + 2] * rs * gv.z; xo.w += gt.w * yv[i * 4 + 3] * rs * gv.w;
    *(float4*)(X + c) = xo;
    xv[i * 4] = xo.x; xv[i * 4 + 1] = xo.y; xv[i * 4 + 2] = xo.z; xv[i * 4 + 3] = xo.w;
  }
  bf16* H2 = (bf16*)(p.ws + OFF_P1) + (size_t)NTOK * 1024 + (size_t)tok * 1024;
  normmod_row(xv, p.in[I_GPREFFN] + L.l * 1024, mod + 3072, mod + 4096, H2, h);
  const float* wr = p.in[I_WROUTER] + (size_t)L.l * 1024 * 16;
  float lg[16];
#pragma unroll
  for (int e = 0; e < 16; ++e) lg[e] = 0.f;
#pragma unroll
  for (int i = 0; i < 16; ++i) {
    int k = lane * 4 + (i >> 2) * 256 + (i & 3);
    const float4* w4 = (const float4*)(wr + (size_t)k * 16);
    float4 a = w4[0], b4 = w4[1], c4 = w4[2], d4 = w4[3];
    float hv = h[i];
    lg[0] += hv * a.x; lg[1] += hv * a.y; lg[2] += hv * a.z; lg[3] += hv * a.w;
    lg[4] += hv * b4.x; lg[5] += hv * b4.y; lg[6] += hv * b4.z; lg[7] += hv * b4.w;
    lg[8] += hv * c4.x; lg[9] += hv * c4.y; lg[10] += hv * c4.z; lg[11] += hv * c4.w;
    lg[12] += hv * d4.x; lg[13] += hv * d4.y; lg[14] += hv * d4.z; lg[15] += hv * d4.w;
  }
  float mx = -INFINITY;
#pragma unroll
  for (int e = 0; e < 16; ++e) { lg[e] = wave_sum(lg[e]); mx = fmax_(mx, lg[e]); }
  float se = 0.f;
#pragma unroll
  for (int e = 0; e < 16; ++e) { lg[e] = expf(lg[e] - mx); se += lg[e]; }
  if (lane < 16) {
    float v = 0.f;
#pragma unroll
    for (int e = 0; e < 16; ++e) if (e == lane) v = lg[e];
    ((float*)(p.ws + OFF_AFF))[(size_t)lane * NTOK + tok] = v / se;
  }
}
DI int block_sum_(int v, int* sred, int round) {
  const int tid = tid_(), lane = tid & 63, wid = tid >> 6;
  v += shfl_xor_(v, 32); v += shfl_xor_(v, 16); v += shfl_xor_(v, 8); v += shfl_xor_(v, 4); v += shfl_xor_(v, 2); v += shfl_xor_(v, 1);
  int* r = sred + (round & 1) * NWAVES;
  if (lane == 0) r[wid] = v;
  __syncthreads();
  int tsum = 0;
#pragma unroll
  for (int q = 0; q < NWAVES; ++q) tsum += r[q];
  return tsum;
}
DI void route_item(const Params& p, const LP& L, int it, char* smem) {
  const int nstream = L.last ? 1 : 2;
  const int b = it / (16 * nstream), e = (it / nstream) & 15, ctxs = (nstream == 2) ? (it & 1) : 0;
  const int T = ctxs ? CTXL : SEQ, cap = ctxs ? CAP_C : CAP_L;
  const int tok0 = b * TOK + (ctxs ? 0 : CTXL);
  const int slot0 = ctxs ? (BATCH * CAP_L + b * CAP_C) : (b * CAP_L);
  int* sred = (int*)smem;
  const float* AFF = (const float*)(p.ws + OFF_AFF) + (size_t)e * NTOK + tok0;
  int* SEL = (int*)(p.ws + OFF_SEL);
  int* IDX = (int*)(p.ws + OFF_IDX) + (size_t)e * ESLOTS;
  float* GW = (float*)(p.ws + OFF_GW) + (size_t)e * ESLOTS;
  const int tid = tid_(), lane = tid & 63, wid = tid >> 6;
  constexpr int MAXPER = (SEQ + NTHREADS - 1) / NTHREADS;
  const int per = (T + NTHREADS - 1) / NTHREADS;
  unsigned key[MAXPER];
  __syncthreads();
#pragma unroll
  for (int k = 0; k < MAXPER; ++k) {
    int i = tid * per + k;
    key[k] = (k < per && i < T) ? (__float_as_uint(AFF[i]) + 1u) : 0u;
  }
  unsigned thr = 0u;
  int round = 0;
  for (int bit = 30; bit >= 0; --bit) {
    const unsigned cand = thr | (1u << bit);
    int c = 0;
#pragma unroll
    for (int k = 0; k < MAXPER; ++k) c += (key[k] >= cand) ? 1 : 0;
    c = block_sum_(c, sred, round++);
    if (c >= cap) thr = cand;
  }
  int cg = 0, ce = 0;
#pragma unroll
  for (int k = 0; k < MAXPER; ++k) { cg += (key[k] > thr) ? 1 : 0; ce += (key[k] == thr) ? 1 : 0; }
  const int tot_gt = block_sum_(cg, sred, round++);
  const int need_eq = cap - tot_gt;
  int v = cg | (ce << 16), inc = v;
#pragma unroll
  for (int d = 1; d < 64; d <<= 1) { int o = shfl_up_(inc, d); if (lane >= d) inc += o; }
  int* soff = sred + 2 * NWAVES;
  __syncthreads();
  if (lane == 63) soff[wid] = inc;
  __syncthreads();
  int base = 0;
  for (int w = 0; w < wid; ++w) base += soff[w];
  int excl = base + inc - v;
  int gt_before = excl & 0xffff, eq_before = excl >> 16;
#pragma unroll
  for (int k = 0; k < MAXPER; ++k) {
    int i = tid * per + k;
    if (k < per && i < T) {
      const bool isgt = key[k] > thr, iseq = key[k] == thr;
      const bool sel = isgt || (iseq && eq_before < need_eq);
      const int slot = slot0 + gt_before + (eq_before < need_eq ? eq_before : need_eq);
      if (sel) { IDX[slot] = tok0 + i; GW[slot] = __uint_as_float(key[k] - 1u); SEL[(size_t)(tok0 + i) * 16 + e] = slot; }
      else SEL[(size_t)(tok0 + i) * 16 + e] = -1;
      gt_before += isgt ? 1 : 0; eq_before += iseq ? 1 : 0;
    }
  }
}
DI void moe1_tile(const Params& p, const LP& L, int t, char* smem) {
  const int nslots = L.last ? ESLOTS_L : ESLOTS;
  constexpr int MT_L = (ESLOTS_L + 255) / 256, MT_A = (ESLOTS + 255) / 256;
  const int nt = t & 7, sq = t >> 3;
  const int e = L.last ? sq / MT_L : sq / MT_A, mt = L.last ? sq % MT_L : sq % MT_A;
  const int m0 = mt * 256, n0 = nt * 256;
  GA g = make_ga((const bf16*)(p.ws + OFF_P1) + (size_t)NTOK * 1024, 1024, (const bf16*)(p.ws + OFF_MIX + WX_GU) + (size_t)e * 2048 * 1024, 1024, 1024, nslots);
  g.ridx = (const int*)(p.ws + OFF_IDX) + (size_t)e * ESLOTS;
  f32x4 acc[2][2][4][2];
  gemm_big(g, m0, n0, smem, acc);
  bf16* ACT = (bf16*)(p.ws + OFF_PG) + (size_t)e * ESLOTS * 1024;
  {
    const int l = tid_() & 63, w = tid_() >> 6, wr = w >> 2, wc = w & 3, fr = l & 15, fq = l >> 4;
#pragma unroll
    for (int ai = 0; ai < 2; ++ai)
#pragma unroll
      for (int m = 0; m < 4; ++m) {
        const int row = m0 + ai * 128 + wr * 64 + m * 16 + fr;
        float a[8];
#pragma unroll
        for (int k = 0; k < 4; ++k) { a[k] = siluf_(acc[ai][0][m][0][k]) * acc[ai][1][m][0][k]; a[4 + k] = siluf_(acc[ai][0][m][1][k]) * acc[ai][1][m][1][k]; }
        if (row < nslots) st8bf(ACT + (size_t)row * 1024 + nt * 128 + wc * 32 + 8 * fq, a);
      }
  }
}
DI void moe2_tile(const Params& p, const LP& L, int t, char* smem) {
  const int nslots = L.last ? ESLOTS_L : ESLOTS;
  constexpr int MT_L = (ESLOTS_L + 255) / 256, MT_A = (ESLOTS + 255) / 256;
  const int e = L.last ? t / (MT_L * 4) : t / (MT_A * 4), r = L.last ? t % (MT_L * 4) : t % (MT_A * 4), mt = L.last ? r % MT_L : r % MT_A, nt = L.last ? r / MT_L : r / MT_A;
  const int m0 = mt * 256, n0 = nt * 256;
  GA g = make_ga((const bf16*)(p.ws + OFF_PG) + (size_t)e * ESLOTS * 1024, 1024, (const bf16*)(p.ws + OFF_MIX + WX_DN) + (size_t)e * 1024 * 1024, 1024, 1024, nslots);
  f32x4 acc[2][2][4][2];
  gemm_big(g, m0, n0, smem, acc);
  bf16* YS = (bf16*)(p.ws + OFF_PG) + (size_t)NE * ESLOTS * 1024 + (size_t)e * ESLOTS * 1024;
  const float* GW = (const float*)(p.ws + OFF_GW) + (size_t)e * ESLOTS;
  EPIB_BEGIN(acc, m0, n0, nslots)
    const float gw = GW[row];
#pragma unroll
    for (int k = 0; k < 8; ++k) v[k] *= gw;
    st8bf(YS + (size_t)row * 1024 + col, v);
  EPIB_END
}
DI void comb_item(const Params& p, const LP& L, int it) {
  const int tok = post_tok(it * NWAVES + (tid_() >> 6), L.last), lane = tid_() & 63;
  float* X = (float*)(p.ws + OFF_X) + (size_t)tok * 1024;
  const int* SEL = (const int*)(p.ws + OFF_SEL) + (size_t)tok * 16;
  const bf16* YS = (const bf16*)(p.ws + OFF_PG) + (size_t)NE * ESLOTS * 1024;
  const float* mod = L.mod + (size_t)tok_modrow(tok) * 6144;
  float s[16];
#pragma unroll
  for (int i = 0; i < 16; ++i) s[i] = 0.f;
  for (int e = 0; e < 16; ++e) {
    int sl = SEL[e];
    if (sl >= 0) {
      const bf16* yr = YS + ((size_t)e * ESLOTS + sl) * 1024;
#pragma unroll
      for (int i = 0; i < 4; ++i) {
        uint2 w = *(const uint2*)(yr + lane * 4 + i * 256);
        s[i * 4] += __uint_as_float(w.x << 16); s[i * 4 + 1] += __uint_as_float(w.x & 0xffff0000u);
        s[i * 4 + 2] += __uint_as_float(w.y << 16); s[i * 4 + 3] += __uint_as_float(w.y & 0xffff0000u);
      }
    }
  }
  float ss = 0.f;
#pragma unroll
  for (int i = 0; i < 16; ++i) ss += s[i] * s[i];
  ss = wave_sum(ss);
  const float rs = rsqrtf(ss * (1.f / 1024.f) + EPS);
  const float* gpf = p.in[I_GPOSTFFN] + L.l * 1024;
  float xv[16], h[16];
  float* dst = X;
  if (L.last) { const int b = tok_b(tok), j = tok_j(tok); dst = p.out + ((size_t)b * SEQ + (j - CTXL)) * 1024; }
#pragma unroll
  for (int i = 0; i < 4; ++i) {
    int c = lane * 4 + i * 256;
    float4 xo = *(const float4*)(X + c), gv = *(const float4*)(gpf + c), gt = *(const float4*)(mod + 5120 + c);
    xo.x += gt.x * s[i * 4] * rs * gv.x; xo.y += gt.y * s[i * 4 + 1] * rs * gv.y; xo.z += gt.z * s[i * 4 + 2] * rs * gv.z; xo.w += gt.w * s[i * 4 + 3] * rs * gv.w;
    *(float4*)(dst + c) = xo;
    xv[i * 4] = xo.x; xv[i * 4 + 1] = xo.y; xv[i * 4 + 2] = xo.z; xv[i * 4 + 3] = xo.w;
  }
  if (!L.last) {
    const float* mod1 = (const float*)(p.ws + OFF_MOD) + ((size_t)(L.l + 1) * NB1 + tok_modrow(tok)) * 6144;
    normmod_row(xv, p.in[I_GPREMIX] + (L.l + 1) * 1024, mod1, mod1 + 1024, (bf16*)(p.ws + OFF_HA) + (size_t)tok * 1024, h);
  }
}

enum { PH_PREP0 = 0, PH_PREP1, PH_L0 };
enum { LP_INPROJ = 0, LP_TOKPREP, LP_MIX1, LP_MIX2, LP_GLU, LP_MERGE, LP_OUT, LP_POST, LP_ROUTE, LP_MOE1, LP_MOE2, LP_COMB, LP_COUNT };
constexpr int NPHASES = PH_L0 + DEPTH * LP_COUNT;


DI void run_phase(const Params& p, int ph, char* smem) {
  const int G = gridDim.x;
  int start = blockIdx.x;
  auto seg = [&](int n, auto&& fn) {
    for (; start < n; start += G) fn(start);
    start -= n;
  };
#ifdef ONLY_PREP
  if (ph >= PH_L0) return;
#endif
  if (ph == PH_PREP0) {
    seg(DEPTH * 96, [&](int it) { mod_item(p, it, smem); });
    seg(DEPTH * 32, [&](int it) { s5_tab_item(p, it, smem); });
    seg(1, [&](int) { rope_tab_item(p); });
    seg(DEPTH * CT_EARLY, [&](int it) { conv_early_item(p, it / CT_EARLY, it % CT_EARLY, smem); });
    return;
  }
  if (ph == PH_PREP1) {
    seg(DEPTH * 64, [&](int it) { s5_mat_item(p, it); });
    seg(NTOK / NWAVES, [&](int it) { prep_row_item(p, it); });
    return;
  }
#ifdef ONLY_LPH
  if (ph < PH_L0) return;
#endif
  const int l = (ph - PH_L0) / LP_COUNT;
#ifdef ONLY_LPH
  const int lph = ONLY_LPH;
#else
  const int lph = (ph - PH_L0) % LP_COUNT;
#endif
  const LP L = make_lp(p, l);
  switch (lph) {
    case LP_INPROJ:
      seg(IP_SLOTS, [&](int it) { inproj_tile(p, L, it, smem); });
      break;
    case LP_TOKPREP:
      seg(16 * S5_MT * 2, [&](int it) { s5a_tile(p, L, it, smem); });
      seg(TP_MT * 3, [&](int it) { mlaq_tile(p, L, it, smem); });
      seg(TP_MT * 4, [&](int it) { mlakv_tile(p, L, it, smem); });
      seg(NTOK / 64, [&](int it) { navt_item(p, it, smem); });
      seg(NTOK / 32, [&](int it) { m2conv_item(p, L, it); });
      seg(M2S_ITEMS, [&](int it) { m2scal_item(p, L, it); });
      break;
    case LP_MIX1: {
      const int n0 = BATCH * 4, n1 = n0 + 2 * 16 * BATCH / NWAVES, n2 = n1 + BATCH * 4 * (SEQ / 256), n3 = n2 + BATCH * 4 * (SEQ / 256);
      const int n4 = n3 + (L.last ? 0 : BATCH * 4 * ((CTXL + 255) / 256)), n5 = n4 + (L.last ? 0 : BATCH * 4 * ((CTXL + 255) / 256));
      int* qhead = (int*)(p.ws + OFF_BAR) + Q_WORD0 + 64 * (l + 2 * p.probe_rep);
#ifdef EMU
      volatile int* bc = (volatile int*)(smem + SMEM_BYTES + 8);
#else
      volatile LAS int* bc = (volatile LAS int*)(smem + SMEM_BYTES + 8);
#endif
      for (;;) {
        __syncthreads();
        if (tid_() == 0) {
#ifdef EMU
          *bc = atomicAdd(qhead, 1);
#else
          *bc = __hip_atomic_fetch_add(qhead, 1, __ATOMIC_RELAXED, __HIP_MEMORY_SCOPE_AGENT);
#endif
        }
        __syncthreads();
        const int it = *bc;
        if (it >= n5) break;
        if (it < n0) m2scan_item(p, L, it, smem);
        else if (it < n1) s5carry_item(p, L, it - n0);
        else if (it < n2) mla_attn_item(p, it - n1, false, smem);
        else if (it < n3) na_attn_item(p, L, it - n2, false, smem);
        else if (it < n4) mla_attn_item(p, it - n3, true, smem);
        else na_attn_item(p, L, it - n4, true, smem);
      }
    } break;
    case LP_MIX2:
      seg(16 * S5_MT * 2, [&](int it) { s5c_tile(p, L, it, smem); });
      seg(NTOK / NWAVES, [&](int it) { m2gate_item(p, L, it); });
      break;
    case LP_GLU:
      seg(GLU_MT * 2, [&](int it) { glu_tile(p, L, it, smem); });
      break;
    case LP_MERGE:
      seg(mtiles(L.last, 256) * 16, [&](int it) { merge_tile(p, L, it, smem); });
      break;
    case LP_OUT:
      seg(mtiles(L.last, 256) * 4, [&](int it) { outproj_tile(p, L, it, smem); });
      break;
    case LP_POST:
      seg(CT_EXP, [&](int it) { conv_expert_item(p, l, it, smem); });
      seg(post_ntok(L.last) / NWAVES, [&](int it) { post_item(p, L, it); });
      break;
    case LP_ROUTE:
      seg(BATCH * 16 * (L.last ? 1 : 2), [&](int it) { route_item(p, L, it, smem); });
      break;
    case LP_MOE1:
      seg(NE * (((L.last ? ESLOTS_L : ESLOTS) + 255) / 256) * 8, [&](int it) { moe1_tile(p, L, it, smem); });
      break;
    case LP_MOE2:
      seg(NE * (((L.last ? ESLOTS_L : ESLOTS) + 255) / 256) * 4, [&](int it) { moe2_tile(p, L, it, smem); });
      break;
    case LP_COMB:
      seg(post_ntok(L.last) / NWAVES, [&](int it) { comb_item(p, L, it); });
      break;
  }
}

__global__ void __launch_bounds__(NTHREADS, 2) mega_kernel(Params p) {
#ifdef EMU
  char* smem = emu_cur_f->blk->smem;
  for (int ph = p.phase_lo; ph < p.phase_hi; ++ph) {
    run_phase(p, ph, smem);
    if (ph + 1 < p.phase_hi) emu_grid_sync();
  }
#else
  __shared__ __attribute__((aligned(16))) char smem[SMEM_BYTES + 16];
  if (p.phase_hi - p.phase_lo > 1) {
    if (threadIdx.x == 0) *(uint4*)(smem + SMEM_BYTES) = make_uint4(0u, 0u, 0u, 0u);
    __syncthreads();
    XcdBarrier xb = xcd_barrier_post((unsigned*)(p.ws + OFF_BAR), (volatile LAS unsigned*)(smem + SMEM_BYTES));
    for (int ph = p.phase_lo; ph < p.phase_hi; ++ph) {
      int reps = 1;
#ifdef PROBE_PHASE
      if (ph == PROBE_PHASE || ph == PROBE_PHASE2) reps = 1 + PROBE_REP;
#endif
      for (int rep = 0; rep < reps; ++rep) {
        p.probe_rep = rep;
        run_phase(p, ph, smem);
        if (ph + 1 < p.phase_hi || rep + 1 < reps) {
          if (ph == p.phase_lo && rep == 0) cg::this_grid().sync();
          else xcd_barrier(xb);
        }
      }
    }
  } else {
    run_phase(p, p.phase_lo, smem);
  }
#endif
}

#ifndef EMU
extern "C" void kernel_launch(void* const* d_in, const int* in_sizes, int n_in, void* d_out, int out_size, void* d_ws, size_t ws_size,
                              hipStream_t stream) {
  static int grid_blocks = 0;
  if (!grid_blocks) {
    int dev = 0, cus = 0, per_cu = 0;
    hipGetDevice(&dev);
    hipDeviceGetAttribute(&cus, hipDeviceAttributeMultiprocessorCount, dev);
    hipOccupancyMaxActiveBlocksPerMultiprocessor(&per_cu, mega_kernel, NTHREADS, 0);
    if (per_cu > 1) per_cu = 1;
    if (per_cu < 1) per_cu = 1;
    grid_blocks = cus * per_cu;
    if (ws_size < WS_TOTAL) fprintf(stderr, "workspace too small: %zu < %zu\n", ws_size, (size_t)WS_TOTAL);
  }
  Params p{};
  for (int i = 0; i < N_INPUTS; ++i) p.in[i] = (const float*)d_in[i];
  p.out = (float*)d_out;
  p.ws = (char*)d_ws;
#if MK_MULTI
  for (int ph = 0; ph < NPHASES; ++ph) {
    p.phase_lo = ph; p.phase_hi = ph + 1;
    hipLaunchKernelGGL(mega_kernel, dim3(grid_blocks), dim3(NTHREADS), 0, stream, p);
  }
#else
  p.phase_lo = 0; p.phase_hi = NPHASES;
  hipMemsetAsync((char*)d_ws + OFF_BAR, 0, BAR_BYTES, stream);
  void* args[] = {&p};
  hipError_t e = hipLaunchCooperativeKernel((void*)mega_kernel, dim3(grid_blocks), dim3(NTHREADS), args, 0, stream);
  if (e != hipSuccess) fprintf(stderr, "cooperative launch failed: %s (grid %d)\n", hipGetErrorString(e), grid_blocks);
#endif
}
#endif
```

```cpp
#ifdef EMU
#include "emu.h"
#else
#include <hip/hip_runtime.h>
#include <hip/hip_cooperative_groups.h>
#include <cstdio>
namespace cg = cooperative_groups;
using bf16x8 = __attribute__((ext_vector_type(8))) short;
using f32x4 = __attribute__((ext_vector_type(4))) float;
using f32x16 = __attribute__((ext_vector_type(16))) float;
#endif
using u32x4 = __attribute__((ext_vector_type(4))) unsigned;
#ifndef MK_MULTI
#define MK_MULTI 0
#endif

#define DI __device__ __forceinline__
typedef unsigned short bf16;

#ifdef EMU_SMALL2
constexpr int BATCH = 2, SEQ = 1024, CTXL = 64, GRID_W = 32;
#elif defined(EMU_SMALL)
constexpr int BATCH = 2, SEQ = 512, CTXL = 64, GRID_W = 32;
#else
constexpr int BATCH = 8, SEQ = 2048, CTXL = 256, GRID_W = 64;
#endif
constexpr int D = 1024, DEPTH = 2;
constexpr int TOK = CTXL + SEQ, NTOK = BATCH * TOK;
constexpr int ROWS = SEQ / GRID_W;
constexpr int WIN_R = (ROWS < 8 ? ROWS : 8), WIN_C = 16;
constexpr int N_IN = 6568, N_INP = 6656;
constexpr int C_CQ = 0, C_CKV = 256, C_KR = 384, C_NA = 416, C_S5 = 1184, C_Z = 1440, C_XBC = 1696, C_DT = 2464, C_GATE = 2472;
constexpr int P1W = 2480;
constexpr int NCH = TOK / 16, NCC = CTXL / 16, MCH = BATCH * NCH;
constexpr int NE = 16;
constexpr int CAP_L = 2 * SEQ / NE, CAP_C = 2 * CTXL / NE;
constexpr int ESLOTS = BATCH * (CAP_L + CAP_C), ESLOTS_L = BATCH * CAP_L;
constexpr int NB1 = BATCH + 1;
constexpr float EPS = 1e-6f;
constexpr int SMEM_BYTES = 147456;
constexpr int NTHREADS = 512, NWAVES = NTHREADS / 64;

enum { I_X = 0, I_C, I_CTX, I_CCTX, I_WADA, I_BADA, I_GPREMIX, I_GPOSTMIX, I_GPREFFN, I_GPOSTFFN, I_WIN, I_GCQ, I_GCKV, I_WUQ, I_WUKV, I_RPB,
       I_S5ARE, I_S5AIM, I_S5LOGSTEP, I_S5BRE, I_S5BIM, I_S5CRE, I_S5CIM, I_S5D, I_S5WGLU, I_S5BGLU, I_M2CONVW, I_M2CONVB, I_M2ALOG, I_M2DTBIAS,
       I_M2D, I_M2GNORM, I_WBRANCH, I_WOUT, I_WROUTER, I_WGATE, I_WUP, I_WDOWN, N_INPUTS };

constexpr size_t al256(size_t x) { return (x + 255) & ~(size_t)255; }
constexpr size_t SZ_X = (size_t)NTOK * D * 4;
constexpr size_t SZ_ROWBF = (size_t)NTOK * D * 2;
constexpr size_t OFF_X = 0;
constexpr size_t OFF_MOD = OFF_X + al256(SZ_X);
constexpr size_t OFF_HA = OFF_MOD + al256((size_t)DEPTH * NB1 * 6144 * 4);
constexpr size_t OFF_O = OFF_HA + al256(SZ_ROWBF);
constexpr size_t OFF_P1 = OFF_O + al256(SZ_ROWBF);
constexpr size_t SZ_P1 = (size_t)NTOK * P1W * 2;
constexpr size_t OFF_PG = OFF_P1 + al256(SZ_P1);
constexpr size_t SZ_PG = (size_t)NTOK * 4096 * 2;
constexpr size_t OFF_DT = OFF_PG + al256(SZ_PG);
constexpr size_t OFF_AFF = OFF_DT + al256((size_t)NTOK * 8 * 4);
constexpr size_t OFF_SEL = OFF_AFF + al256((size_t)NTOK * 16 * 4);
constexpr size_t OFF_IDX = OFF_SEL + al256((size_t)NTOK * 16 * 4);
constexpr size_t OFF_GW = OFF_IDX + al256((size_t)NE * ESLOTS * 4);
constexpr size_t OFF_BAR = OFF_GW + al256((size_t)NE * ESLOTS * 4);
constexpr size_t BAR_BYTES = (3456 + 64 * 4) * 4;
constexpr int Q_WORD0 = 3456;
constexpr size_t OFF_ROPE = OFF_BAR + al256(BAR_BYTES);
constexpr size_t OFF_WEARLY = OFF_ROPE + al256(64 * 8 * 2 * 4);
constexpr size_t WE_WIN = 0;
constexpr size_t WE_UQ = WE_WIN + (size_t)N_INP * 1024 * 2;
constexpr size_t WE_UKV = WE_UQ + (size_t)384 * 256 * 2;
constexpr size_t WE_GLU = WE_UKV + (size_t)512 * 128 * 2;
constexpr size_t WE_WB = WE_GLU + (size_t)256 * 256 * 2;
constexpr size_t WE_WOUT = WE_WB + (size_t)4 * 1024 * 256 * 2;
constexpr size_t WE_SIZE = al256(WE_WOUT + (size_t)1024 * 1024 * 2);
constexpr size_t OFF_S5TAB = OFF_WEARLY + DEPTH * WE_SIZE;
constexpr size_t S5_LAMPOW = 0;
constexpr size_t S5_BBAR = S5_LAMPOW + (size_t)2 * 16 * 17 * 64 * 2 * 4;
constexpr size_t S5_KT = S5_BBAR + (size_t)2 * 16 * 64 * 16 * 2 * 4;
constexpr size_t S5_WA = S5_KT + (size_t)2 * 16 * 16 * 256 * 4;
constexpr size_t S5_W2 = S5_WA + (size_t)16 * 256 * 256 * 2;
constexpr size_t S5_SIZE = al256(S5_W2 + (size_t)16 * 256 * 512 * 2);
constexpr size_t OFF_MIX = OFF_S5TAB + DEPTH * S5_SIZE;
constexpr size_t MX_Q = 0;
constexpr size_t MX_K = MX_Q + al256((size_t)BATCH * 4 * TOK * 96 * 2);
constexpr size_t MX_VTM = MX_K + al256((size_t)BATCH * 4 * TOK * 96 * 2);
constexpr size_t MX_VTN = MX_VTM + al256((size_t)BATCH * 4 * 64 * TOK * 2);
constexpr size_t MX_XBC = MX_VTN + al256((size_t)BATCH * 4 * 64 * TOK * 2);
constexpr size_t MX_US5 = MX_XBC + al256((size_t)NTOK * 768 * 2);
constexpr size_t MX_HEND = MX_US5 + al256((size_t)NTOK * 256 * 2);
constexpr size_t MX_HIN = MX_HEND + al256((size_t)16 * MCH * 256 * 4);
constexpr size_t MX_Z = MX_HIN + al256((size_t)16 * MCH * 256 * 2);
constexpr size_t MX_XBT = MX_Z + al256((size_t)NTOK * 256 * 2);
constexpr size_t MX_M2S = MX_XBT + al256((size_t)NTOK * 512 * 2);
constexpr size_t MX_SIZE = MX_M2S + al256((size_t)BATCH * 8 * TOK * 4 * 4);
constexpr size_t WX_GU = 0;
constexpr size_t WX_DN = WX_GU + (size_t)NE * 2048 * 1024 * 2;
constexpr size_t WX_SIZE = WX_DN + (size_t)NE * 1024 * 1024 * 2;
constexpr size_t MIXREG = (MX_SIZE > WX_SIZE ? MX_SIZE : WX_SIZE);
constexpr size_t WS_TOTAL = OFF_MIX + al256(MIXREG);

struct Params {
  const float* in[N_INPUTS];
  float* out;
  char* ws;
  int phase_lo, phase_hi;
  int probe_rep, pad_;
};

constexpr int WAVE_TAB_OFF = SMEM_BYTES + 16;
DI int tid_() {
#ifdef EMU
  return (int)threadIdx.x;
#else
  const unsigned hw = (unsigned)__builtin_amdgcn_s_getreg((5 << 11) | 4) & 0x3fu;
  const int wave = *(volatile __attribute__((address_space(3))) int*)(unsigned long)(WAVE_TAB_OFF + hw * 4u);
  int lane;
  asm volatile("v_mbcnt_lo_u32_b32 %0, -1, 0\n\tv_mbcnt_hi_u32_b32 %0, -1, %0" : "=v"(lane));
  return wave * 64 + lane;
#endif
}
#ifdef EMU
template <class T> DI T shfl_xor_(T v, int m) { return __shfl_xor(v, m); }
template <class T> DI T shfl_up_(T v, int d) { return __shfl_up(v, d); }
template <class T> DI T shfl_(T v, int src) { return __shfl(v, src); }
#else
template <class T> DI T shfl_xor_(T v, int m) {
  const int idx = ((tid_() & 63) ^ m) << 2;
  return __builtin_bit_cast(T, __builtin_amdgcn_ds_bpermute(idx, __builtin_bit_cast(int, v)));
}
template <class T> DI T shfl_up_(T v, int d) {
  const int l = tid_() & 63; const int idx = (l >= d ? l - d : l) << 2;
  return __builtin_bit_cast(T, __builtin_amdgcn_ds_bpermute(idx, __builtin_bit_cast(int, v)));
}
template <class T> DI T shfl_(T v, int src) {
  int idx = src << 2; asm volatile("" : "+v"(idx));
  return __builtin_bit_cast(T, __builtin_amdgcn_ds_bpermute(idx, __builtin_bit_cast(int, v)));
}
#endif
DI float bf2f(bf16 h) { return __uint_as_float(((unsigned)h) << 16); }
DI bf16 f2bf(float f) { unsigned u = __float_as_uint(f); u += 0x7fffu + ((u >> 16) & 1u); return (bf16)(u >> 16); }
#ifdef EMU
DI unsigned pack2(float a, float b) { return (unsigned)f2bf(a) | ((unsigned)f2bf(b) << 16); }
DI float exp2f_(float x) { return exp2f(x); }
#else
typedef float f32x2_t_ __attribute__((ext_vector_type(2)));
typedef __bf16 bf16x2_t_ __attribute__((ext_vector_type(2)));
DI unsigned pack2(float a, float b) { const f32x2_t_ v = {a, b}; return __builtin_bit_cast(unsigned, __builtin_convertvector(v, bf16x2_t_)); }
DI float exp2f_(float x) { return __builtin_amdgcn_exp2f(x); }
#endif
DI float sigmoidf_(float x) { return 1.0f / (1.0f + __expf(-x)); }
DI float siluf_(float x) { return x / (1.0f + __expf(-x)); }
DI float softplusf_(float x) { const float ax = x < 0.f ? -x : x; return (x > 0.f ? x : 0.f) + __logf(1.0f + __expf(-ax)); }
DI float geluf_(float x) { const float u2 = 1.5957691216057308f * (x + 0.044715f * x * x * x); return x / (1.0f + __expf(-u2)); }
DI bool wave_all_(bool c) {
#ifdef EMU
  int v = c ? 0 : 1;
  v += shfl_xor_(v, 32); v += shfl_xor_(v, 16); v += shfl_xor_(v, 8); v += shfl_xor_(v, 4); v += shfl_xor_(v, 2); v += shfl_xor_(v, 1);
  return v == 0;
#else
  return __builtin_amdgcn_ballot_w64(!c) == 0ull;
#endif
}
DI float wave_sum(float v) {
#ifdef EMU
  v += shfl_xor_(v, 32); v += shfl_xor_(v, 16); v += shfl_xor_(v, 8); v += shfl_xor_(v, 4); v += shfl_xor_(v, 2); v += shfl_xor_(v, 1);
  return v;
#else
  int x = __float_as_int(v);
  x = __float_as_int(__int_as_float(x) + __int_as_float(__builtin_amdgcn_update_dpp(0, x, 0xB1, 0xF, 0xF, true)));
  x = __float_as_int(__int_as_float(x) + __int_as_float(__builtin_amdgcn_update_dpp(0, x, 0x4E, 0xF, 0xF, true)));
  x = __float_as_int(__int_as_float(x) + __int_as_float(__builtin_amdgcn_update_dpp(0, x, 0x141, 0xF, 0xF, true)));
  x = __float_as_int(__int_as_float(x) + __int_as_float(__builtin_amdgcn_update_dpp(0, x, 0x140, 0xF, 0xF, true)));
  const float r0 = __int_as_float(__builtin_amdgcn_readlane(x, 0)), r1 = __int_as_float(__builtin_amdgcn_readlane(x, 16));
  const float r2 = __int_as_float(__builtin_amdgcn_readlane(x, 32)), r3 = __int_as_float(__builtin_amdgcn_readlane(x, 48));
  return (r0 + r1) + (r2 + r3);
#endif
}
#ifndef EMU
#define XB_TMO      128
#define XB_XCNT(j)  (256  + 64 * (j))
#define XB_XSUB(j)  (1280 + 64 * (j))
#define XB_XGEN(j)  (2304 + 64 * (j))
#define XB_TOP      3328
#define XB_TOPGEN   3392
#define XB_SPIN_CAP (1u << 24)
#define LAS __attribute__((address_space(3)))
DI unsigned xb_ld(unsigned* p) { return __hip_atomic_load(p, __ATOMIC_RELAXED, __HIP_MEMORY_SCOPE_AGENT); }
DI unsigned xb_add(unsigned* p, unsigned v) { return __hip_atomic_fetch_add(p, v, __ATOMIC_RELAXED, __HIP_MEMORY_SCOPE_AGENT); }
DI unsigned xb_xcc_id() { return (unsigned)__builtin_amdgcn_s_getreg((3 << 11) | 20) & 0xFu; }
#define XB_SPIN(cond, bar) do { unsigned _sp = 0; while (cond) { __builtin_amdgcn_s_sleep(1); \
    if ((++_sp & 255u) == 0u) { if (xb_ld(&(bar)[XB_TMO])) break; if (_sp > XB_SPIN_CAP) { atomicAdd(&(bar)[XB_TMO], 1u); break; } } } } while (0)
struct XcdBarrier { unsigned* bar; unsigned x; volatile LAS unsigned* st; };
DI XcdBarrier xcd_barrier_post(unsigned* bar, volatile LAS unsigned* st) {
  XcdBarrier b; b.bar = bar; b.x = xb_xcc_id(); b.st = st;
  if (threadIdx.x == 0) (void)xb_add(&bar[XB_XCNT(b.x)], 1u);
  return b;
}
DI void xcd_barrier_complete(unsigned* bar, unsigned x, unsigned& nloc, unsigned& nx) {
  const unsigned G = gridDim.x * gridDim.y * gridDim.z;
  unsigned sum, cnt, mine, sp = 0u;
  for (;;) {
    sum = 0u; cnt = 0u; mine = 0u;
#pragma unroll
    for (unsigned j = 0; j < 16; ++j) { const unsigned c = xb_ld(&bar[XB_XCNT(j)]); sum += c; cnt += (c > 0u) ? 1u : 0u; mine = (j == x) ? c : mine; }
    if (sum == G) break;
    __builtin_amdgcn_s_sleep(1);
    if ((++sp & 255u) == 0u) { if (xb_ld(&bar[XB_TMO])) break; if (sp > XB_SPIN_CAP) { atomicAdd(&bar[XB_TMO], 1u); break; } }
  }
  nloc = mine > 0u ? mine : 1u; nx = cnt > 0u ? cnt : 1u;
}
DI void xcd_barrier(const XcdBarrier& b) {
  asm volatile("s_waitcnt vmcnt(0)" ::: "memory");
  __syncthreads();
  if (threadIdx.x == 0) {
    unsigned* bar = b.bar;
    __builtin_amdgcn_s_waitcnt(0);
    unsigned nloc = b.st[0], nx = b.st[1];
    if (nloc == 0u) { xcd_barrier_complete(bar, b.x, nloc, nx); b.st[0] = nloc; b.st[1] = nx; }
    const unsigned old = xb_add(&bar[XB_XSUB(b.x)], 1u);
    const unsigned gen = old / nloc;
    if (old + 1u == (gen + 1u) * nloc) {
      __builtin_amdgcn_fence(__ATOMIC_RELEASE, "agent");
      asm volatile("s_waitcnt vmcnt(0)" ::: "memory");
      const unsigned og = xb_add(&bar[XB_TOP], 1u);
      const unsigned tg = og / nx;
      if (og + 1u == (tg + 1u) * nx) xb_add(&bar[XB_TOPGEN], 1u);
      else XB_SPIN(xb_ld(&bar[XB_TOPGEN]) == tg, bar);
      __builtin_amdgcn_fence(__ATOMIC_ACQUIRE, "agent");
      xb_add(&bar[XB_XGEN(b.x)], 1u);
      asm volatile("s_waitcnt vmcnt(0)" ::: "memory");
    } else {
      XB_SPIN(xb_ld(&bar[XB_XGEN(b.x)]) == gen, bar);
      __builtin_amdgcn_fence(__ATOMIC_ACQUIRE, "agent");
      asm volatile("s_waitcnt vmcnt(0)" ::: "memory");
    }
  }
  __syncthreads();
}
#endif

struct GA {
  const bf16* A; const bf16* A2; int lda, lda2, ksplit;
  const int* ridx; int mvalid;
  const bf16* Bt; int ldb; int K;
  int kfix;
};
DI GA make_ga(const bf16* A, int lda, const bf16* Bt, int ldb, int K, int mvalid) {
  GA g; g.A = A; g.A2 = A; g.lda = lda; g.lda2 = lda; g.ksplit = K; g.ridx = nullptr; g.mvalid = mvalid; g.Bt = Bt; g.ldb = ldb; g.K = K; g.kfix = 0; return g;
}

#ifdef EMU
#define GLDS16(gptr_, lptr_) memcpy((void*)(lptr_), (const void*)(gptr_), 16)
#define BGLDS16(rsrc_, base_, voff_, soff_, lptr_) memcpy((void*)(lptr_), (const char*)(base_) + (voff_) + (soff_), 16)
#define GEMM_WAIT(N_)
#define RAW_BARRIER() __syncthreads()
#else
#define LASV __attribute__((address_space(3))) void
#define GLDS16(gptr_, lptr_) __builtin_amdgcn_global_load_lds((const void*)(gptr_), (LASV*)(lptr_), 16, 0, 0)
#define BGLDS16(rsrc_, base_, voff_, soff_, lptr_) __builtin_amdgcn_raw_ptr_buffer_load_lds(rsrc_, (LASV*)(lptr_), 16, (int)(voff_), (int)(soff_), 0, 0)
#define GEMM_WAIT(N_) asm volatile("s_waitcnt vmcnt(%0)" :: "n"(N_) : "memory")
#define RAW_BARRIER() { asm volatile("" ::: "memory"); __builtin_amdgcn_s_barrier(); asm volatile("" ::: "memory"); }
#endif
DI int perm32(int rho) { const int n = rho >> 4, i = rho & 15; return 8 * (i >> 2) + 4 * n + (i & 3); }
constexpr int SRS_OFF = 73728;
template <int NT>
DI void gemm_s(const GA& g, int m0, int n0, char* smem, f32x4 (&acc)[4][NT]) {
  constexpr int A_ELEMS = 256 * 32, B_ELEMS = 32 * NT * 32, STAGE = A_ELEMS + B_ELEMS;
  bf16* st = (bf16*)smem;
  const int tid = tid_(), lane = tid & 63, wid = tid >> 6, wr = wid >> 1, wc = wid & 1, fr = lane & 15, fq = lane >> 4;
  const int lrow = tid >> 2, pch = tid & 3;
  long aoff[2], aoff2[2], boff;
#pragma unroll
  for (int i = 0; i < 2; ++i) {
    const int row = lrow + 128 * i;
    const int lch = pch ^ ((-(row >> 2)) & 3);
    int gm = m0 + row; if (gm > g.mvalid - 1) gm = g.mvalid - 1;
    const int ar = g.ridx ? g.ridx[gm] : gm;
    aoff[i] = (long)ar * g.lda + lch * 8;
    aoff2[i] = (long)ar * g.lda2 + lch * 8;
  }
  const int cb = (NT == 4) ? tid : (tid & 255);
  {
    const int row = cb >> 2;
    const int lch = pch ^ ((-(row >> 2)) & 3);
    const int src = n0 + (row & ~31) + perm32(row & 31);
    boff = (long)src * g.ldb + lch * 8;
  }
#pragma unroll
  for (int m = 0; m < 4; ++m)
#pragma unroll
    for (int n = 0; n < NT; ++n) acc[m][n] = f32x4{0.f, 0.f, 0.f, 0.f};
  const int T = g.K / 32;
#define GEMM_DMA(t_, stg_) { const int k0_ = (t_) * 32; const bool seg2_ = (k0_ >= g.ksplit); bf16* sa_ = st + (stg_) * STAGE; \
    _Pragma("unroll") for (int i_ = 0; i_ < 2; ++i_) { \
      const bf16* ap_ = seg2_ ? (g.A2 + aoff2[i_] + (k0_ - g.ksplit)) : (g.A + aoff[i_] + k0_); \
      GLDS16(ap_, sa_ + (tid + i_ * 512) * 8); } \
    GLDS16(g.Bt + boff + k0_, sa_ + A_ELEMS + cb * 8); }
  __syncthreads();
  GEMM_DMA(0, 0)
  if (T > 1) GEMM_DMA(1, 1)
  int s_cur = 0, s_nxt = 2;
#pragma unroll 1
  for (int t = 0; t < T; ++t) {
    if (t + 1 < T) { GEMM_WAIT(3); } else { GEMM_WAIT(0); }
    RAW_BARRIER();
    if (t + 2 < T) GEMM_DMA(t + 2, s_nxt)
    const bf16* sa = st + s_cur * STAGE;
    const bf16* sb = sa + A_ELEMS;
    bf16x8 af[4], bfr[NT];
#pragma unroll
    for (int n = 0; n < NT; ++n) {
      const int row = wc * (16 * NT) + n * 16 + fr;
      bfr[n] = *(const bf16x8*)(sb + row * 32 + ((fq ^ ((-(row >> 2)) & 3)) << 3));
    }
#pragma unroll
    for (int m = 0; m < 4; ++m) {
      const int row = wr * 64 + m * 16 + fr;
      af[m] = *(const bf16x8*)(sa + row * 32 + ((fq ^ ((-(row >> 2)) & 3)) << 3));
    }
#pragma unroll
    for (int m = 0; m < 4; ++m)
#pragma unroll
      for (int n = 0; n < NT; ++n) acc[m][n] = __builtin_amdgcn_mfma_f32_16x16x32_bf16(bfr[n], af[m], acc[m][n], 0, 0, 0);
    s_cur = (s_cur == 2) ? 0 : s_cur + 1;
    s_nxt = (s_nxt == 2) ? 0 : s_nxt + 1;
  }
}
constexpr int BG_HT = 128 * 64;
DI int lds_byte(int r, int c) { const int stt = (r >> 4) * 2 + (c >> 5), rr = r & 15, cc = c & 31, ob = rr * 64 + cc * 2; return stt * 1024 + (ob ^ (((ob >> 9) & 1) << 5)); }
DI void stage_rc(int b, int& R, int& C) { const int stt = b / 1024, sb = b % 1024, swz = sb ^ (((sb >> 9) & 1) << 5); R = (stt >> 1) * 16 + swz / 64; C = (stt & 1) * 32 + (swz % 64) / 2; }
#ifdef EMU
#define BG_WAIT_V(n)
#define BG_WAIT_L(n)
#define BG_BAR __syncthreads()
#define BG_SCHED
#define BG_PRIO(x)
#else
#define BG_WAIT_V(n) asm volatile("s_waitcnt vmcnt(" #n ")" ::: "memory")
#define BG_WAIT_L(n) asm volatile("s_waitcnt lgkmcnt(" #n ")" ::: "memory")
#define BG_BAR __builtin_amdgcn_s_barrier()
#define BG_SCHED __builtin_amdgcn_sched_barrier(0)
#define BG_PRIO(x) __builtin_amdgcn_s_setprio(x)
#endif
DI void gemm_big(const GA& g, int m0, int n0, char* smem, f32x4 (&acc)[2][2][4][2]) {
  bf16* shm = (bf16*)smem;
  const int tid = tid_(), wid = tid >> 6, lane = tid & 63, wr = wid >> 2, wc = wid & 3, fr = lane & 15, fq = lane >> 4;
  unsigned aof[2][2], bof[2];
#ifndef EMU
  const __amdgpu_buffer_rsrc_t rsA = __builtin_amdgcn_make_buffer_rsrc((void*)g.A, 0, 0x7fffffff, 0x00020000);
  const __amdgpu_buffer_rsrc_t rsB = __builtin_amdgcn_make_buffer_rsrc((void*)g.Bt, 0, 0x7fffffff, 0x00020000);
#endif
#pragma unroll
  for (int i = 0; i < 2; ++i) {
    int R, C; stage_rc(tid * 16 + i * 8192, R, C);
    bof[i] = (unsigned)((n0 + (R & ~31) + perm32(R & 31)) * g.ldb + C) * 2u;
#pragma unroll
    for (int h = 0; h < 2; ++h) {
      int gm = m0 + h * 128 + R; if (gm > g.mvalid - 1) gm = g.mvalid - 1;
      const int ar = g.ridx ? g.ridx[gm] : gm;
      aof[h][i] = (unsigned)(ar * g.lda + C) * 2u;
    }
  }
#define BG_SA(b, h) (shm + ((b) * 2 + (h)) * BG_HT)
#define BG_SB(b, h) (shm + (4 + (b) * 2 + (h)) * BG_HT)
#define BG_STAGE_A(P, h, kt) { \
    _Pragma("unroll") for (int i_ = 0; i_ < 2; ++i_) BGLDS16(rsA, g.A, aof[h][i_], (kt) * 128, (char*)(P) + tid * 16 + i_ * 8192); }
#define BG_STAGE_B(P, h, kt) { \
    _Pragma("unroll") for (int i_ = 0; i_ < 2; ++i_) BGLDS16(rsB, g.Bt, bof[i_], (kt) * 128 + (h) * 256 * g.ldb, (char*)(P) + tid * 16 + i_ * 8192); }
#define BG_LDA(dst, b, h) _Pragma("unroll") for (int m_ = 0; m_ < 4; ++m_) _Pragma("unroll") for (int k_ = 0; k_ < 2; ++k_) \
    dst[m_][k_] = *(const bf16x8*)((const char*)BG_SA(b, h) + lds_byte(wr * 64 + m_ * 16 + fr, k_ * 32 + fq * 8))
#define BG_LDB(dst, b, h) _Pragma("unroll") for (int n_ = 0; n_ < 2; ++n_) _Pragma("unroll") for (int k_ = 0; k_ < 2; ++k_) \
    dst[n_][k_] = *(const bf16x8*)((const char*)BG_SB(b, h) + lds_byte(wc * 32 + n_ * 16 + fr, k_ * 32 + fq * 8))
#define BG_MMA(ai, bj, At_, Bt_) { BG_PRIO(1); \
    _Pragma("unroll") for (int m_ = 0; m_ < 4; ++m_) _Pragma("unroll") for (int n_ = 0; n_ < 2; ++n_) _Pragma("unroll") for (int k_ = 0; k_ < 2; ++k_) \
      acc[ai][bj][m_][n_] = __builtin_amdgcn_mfma_f32_16x16x32_bf16(Bt_[n_][k_], At_[m_][k_], acc[ai][bj][m_][n_], 0, 0, 0); \
    BG_PRIO(0); }
#pragma unroll
  for (int a_ = 0; a_ < 2; ++a_)
#pragma unroll
    for (int b_ = 0; b_ < 2; ++b_)
#pragma unroll
      for (int m_ = 0; m_ < 4; ++m_)
#pragma unroll
        for (int n_ = 0; n_ < 2; ++n_) acc[a_][b_][m_][n_] = f32x4{0.f, 0.f, 0.f, 0.f};
  bf16x8 At[4][2], B0[2][2], B1[2][2];
  const int nt = g.K / 64;
  __syncthreads();
  BG_STAGE_B(BG_SB(0, 0), 0, 0) BG_STAGE_A(BG_SA(0, 0), 0, 0)
  BG_STAGE_B(BG_SB(0, 1), 1, 0) BG_STAGE_A(BG_SA(0, 1), 1, 0)
  if (wr == 1) BG_BAR;
  BG_WAIT_V(4); BG_BAR;
  BG_STAGE_B(BG_SB(1, 0), 0, 1) BG_STAGE_A(BG_SA(1, 0), 0, 1) BG_STAGE_B(BG_SB(1, 1), 1, 1)
  BG_WAIT_V(6); BG_BAR;
#pragma unroll 1
  for (int t = 0; t < nt - 2; t += 2) {
    BG_LDB(B0, 0, 0); BG_SCHED; BG_LDA(At, 0, 0); BG_STAGE_A(BG_SA(1, 1), 1, t + 1)
    BG_WAIT_L(8); BG_BAR; BG_WAIT_L(0); BG_MMA(0, 0, At, B0) BG_BAR; BG_SCHED;
    BG_LDB(B1, 0, 1); BG_STAGE_B(BG_SB(0, 0), 0, t + 2)
    BG_BAR; BG_WAIT_L(0); BG_MMA(0, 1, At, B1) BG_BAR;
    BG_LDA(At, 0, 1); BG_STAGE_A(BG_SA(0, 0), 0, t + 2)
    BG_BAR; BG_WAIT_L(0); BG_MMA(1, 0, At, B0) BG_BAR; BG_SCHED;
    BG_STAGE_B(BG_SB(0, 1), 1, t + 2)
    BG_WAIT_V(6); BG_BAR; BG_MMA(1, 1, At, B1) BG_BAR;
    BG_LDB(B0, 1, 0); BG_SCHED; BG_LDA(At, 1, 0); BG_STAGE_A(BG_SA(0, 1), 1, t + 2)
    BG_WAIT_L(8); BG_BAR; BG_WAIT_L(0); BG_MMA(0, 0, At, B0) BG_BAR; BG_SCHED;
    BG_LDB(B1, 1, 1); BG_STAGE_B(BG_SB(1, 0), 0, t + 3)
    BG_BAR; BG_WAIT_L(0); BG_MMA(0, 1, At, B1) BG_BAR;
    BG_LDA(At, 1, 1); BG_STAGE_A(BG_SA(1, 0), 0, t + 3)
    BG_BAR; BG_WAIT_L(0); BG_MMA(1, 0, At, B0) BG_BAR; BG_SCHED;
    BG_STAGE_B(BG_SB(1, 1), 1, t + 3)
    BG_WAIT_V(6); BG_BAR; BG_MMA(1, 1, At, B1) BG_BAR;
  }
  { BG_LDB(B0, 0, 0); BG_LDA(At, 0, 0); BG_STAGE_A(BG_SA(1, 1), 1, nt - 1)
    BG_BAR; BG_WAIT_L(0); BG_MMA(0, 0, At, B0) BG_BAR;
    BG_LDB(B1, 0, 1); BG_BAR; BG_WAIT_L(0); BG_MMA(0, 1, At, B1) BG_BAR;
    BG_LDA(At, 0, 1); BG_WAIT_V(4); BG_BAR; BG_WAIT_L(0); BG_MMA(1, 0, At, B0) BG_MMA(1, 1, At, B1) BG_BAR; }
  { BG_LDB(B0, 1, 0); BG_LDA(At, 1, 0); BG_WAIT_V(2); BG_BAR; BG_WAIT_L(0); BG_MMA(0, 0, At, B0) BG_BAR;
    BG_LDB(B1, 1, 1); BG_WAIT_V(0); BG_BAR; BG_WAIT_L(0); BG_MMA(0, 1, At, B1) BG_BAR;
    BG_LDA(At, 1, 1); BG_BAR; BG_WAIT_L(0); BG_MMA(1, 0, At, B0) BG_MMA(1, 1, At, B1) BG_BAR; }
  if (wr == 0) BG_BAR;
}
#define EPIB_BEGIN(acc_, m0_, n0_, mvalid_) { const int _l = tid_() & 63, _w = tid_() >> 6, _wr = _w >> 2, _wc = _w & 3, _fr = _l & 15, _fq = _l >> 4; \
  _Pragma("unroll") for (int _ai = 0; _ai < 2; ++_ai) _Pragma("unroll") for (int _m = 0; _m < 4; ++_m) { const int row = (m0_) + _ai * 128 + _wr * 64 + _m * 16 + _fr; \
  _Pragma("unroll") for (int _bj = 0; _bj < 2; ++_bj) { const int col = (n0_) + _bj * 128 + _wc * 32 + 8 * _fq; (void)col; \
    float v[8] = {acc_[_ai][_bj][_m][0][0], acc_[_ai][_bj][_m][0][1], acc_[_ai][_bj][_m][0][2], acc_[_ai][_bj][_m][0][3], \
                  acc_[_ai][_bj][_m][1][0], acc_[_ai][_bj][_m][1][1], acc_[_ai][_bj][_m][1][2], acc_[_ai][_bj][_m][1][3]}; \
    if (row < (mvalid_)) {
#define EPIB_END }}}}

DI void ld8bf(const bf16* p, float (&v)[8]) {
  uint4 w = *(const uint4*)p;
  v[0] = __uint_as_float(w.x << 16); v[1] = __uint_as_float(w.x & 0xffff0000u); v[2] = __uint_as_float(w.y << 16); v[3] = __uint_as_float(w.y & 0xffff0000u);
  v[4] = __uint_as_float(w.z << 16); v[5] = __uint_as_float(w.z & 0xffff0000u); v[6] = __uint_as_float(w.w << 16); v[7] = __uint_as_float(w.w & 0xffff0000u);
}
DI void st8bf(bf16* p, const float (&v)[8]) { *(uint4*)p = make_uint4(pack2(v[0], v[1]), pack2(v[2], v[3]), pack2(v[4], v[5]), pack2(v[6], v[7])); }
DI void st8f(float* p, const float (&v)[8]) { *(float4*)p = make_float4(v[0], v[1], v[2], v[3]); *(float4*)(p + 4) = make_float4(v[4], v[5], v[6], v[7]); }
#define EPI_BEGIN(NT_, acc_, m0_, n0_, mvalid_) { const int _l = tid_() & 63, _w = tid_() >> 6, _wr = _w >> 1, _wc = _w & 1, _fr = _l & 15, _fq = _l >> 4; \
  _Pragma("unroll") for (int _m = 0; _m < 4; ++_m) { const int row = (m0_) + _wr * 64 + _m * 16 + _fr; \
  _Pragma("unroll") for (int _q = 0; _q < (NT_) / 2; ++_q) { const int col = (n0_) + _wc * (16 * (NT_)) + _q * 32 + 8 * _fq; (void)col; \
    float v[8] = {acc_[_m][2 * _q][0], acc_[_m][2 * _q][1], acc_[_m][2 * _q][2], acc_[_m][2 * _q][3], \
                  acc_[_m][2 * _q + 1][0], acc_[_m][2 * _q + 1][1], acc_[_m][2 * _q + 1][2], acc_[_m][2 * _q + 1][3]}; \
    if (row < (mvalid_)) {
#define EPI_END }}}}

DI int mtile_row0(int mt, bool latonly, int TH) {
  if (!latonly) return mt * TH;
  const int per = SEQ / TH, b = mt / per, r = mt % per;
  return b * TOK + CTXL + r * TH;
}
DI int mtiles(bool latonly, int TH) { return latonly ? BATCH * (SEQ / TH) : (NTOK + TH - 1) / TH; }

struct LP {
  int l; bool last;
  const float* mod;
  char* we;
  char* s5;
};
DI LP make_lp(const Params& p, int l) {
  LP q; q.l = l; q.last = (l == DEPTH - 1);
  q.mod = (const float*)(p.ws + OFF_MOD) + (size_t)l * NB1 * 6144;
  q.we = p.ws + OFF_WEARLY + (size_t)l * WE_SIZE;
  q.s5 = p.ws + OFF_S5TAB + (size_t)l * S5_SIZE;
  return q;
}

template <int KS, class RowMap>
DI void conv_tile(const float* src, int lds, int nsrc, const float* kscale, bf16* dst, int K, int k0, int n0, char* smem, RowMap rowmap) {
  (void)smem;
  const int tid = tid_(), n = tid & 63, k8 = (tid >> 6) * 8;
  float v[KS][8];
  const bool ok = (n0 + n < nsrc);
  const float* sp = src + (size_t)(k0 + k8) * lds + n0 + n;
#pragma unroll
  for (int sgm = 0; sgm < KS; ++sgm)
#pragma unroll
    for (int k = 0; k < 8; ++k) v[sgm][k] = ok ? sp[(size_t)(sgm * 64 + k) * lds] : 0.f;
  bf16* dp = dst + (size_t)rowmap(n0 + n) * K + k0 + k8;
#pragma unroll
  for (int sgm = 0; sgm < KS; ++sgm) {
    if (kscale) {
#pragma unroll
      for (int k = 0; k < 8; ++k) v[sgm][k] *= kscale[k0 + sgm * 64 + k8 + k];
    }
    st8bf(dp + sgm * 64, v[sgm]);
  }
}
struct RowId { DI int operator()(int n) const { return n; } };
struct RowGU { int half; DI int operator()(int f) const { return (f >> 7) * 256 + half * 128 + (f & 127); } };

constexpr int CT_WIN = 4 * (N_INP / 64), CT_UQ = 6, CT_UKV = 2 * 8, CT_GLU = 4, CT_WB = 4 * 16, CT_WOUT = 64;
constexpr int CT_EARLY = CT_WIN + CT_UQ + CT_UKV + CT_GLU + CT_WB + CT_WOUT;
constexpr int CT_EXP = NE * 3 * 64;

DI void conv_early_item(const Params& p, int l, int it, char* smem) {
  char* we = p.ws + OFF_WEARLY + (size_t)l * WE_SIZE;
  if (it < CT_WIN) {
    int kt = it % 4, nt = it / 4;
    conv_tile<4>(p.in[I_WIN] + (size_t)l * 1024 * N_IN, N_IN, N_IN, nullptr, (bf16*)(we + WE_WIN), 1024, kt * 256, nt * 64, smem, RowId());
    return;
  }
  it -= CT_WIN;
  if (it < CT_UQ) {
    int nt = it;
    conv_tile<4>(p.in[I_WUQ] + (size_t)l * 256 * 384, 384, 384, p.in[I_GCQ] + l * 256, (bf16*)(we + WE_UQ), 256, 0, nt * 64, smem, RowId());
    return;
  }
  it -= CT_UQ;
  if (it < CT_UKV) {
    int kt = it % 2, nt = it / 2;
    conv_tile<1>(p.in[I_WUKV] + (size_t)l * 128 * 512, 512, 512, p.in[I_GCKV] + l * 128, (bf16*)(we + WE_UKV), 128, kt * 64, nt * 64, smem, RowId());
    return;
  }
  it -= CT_UKV;
  if (it < CT_GLU) {
    int nt = it;
    conv_tile<4>(p.in[I_S5WGLU] + (size_t)l * 256 * 256, 256, 256, nullptr, (bf16*)(we + WE_GLU), 256, 0, nt * 64, smem, RowId());
    return;
  }
  it -= CT_GLU;
  if (it < CT_WB) {
    int j = it / 16, nt = it % 16;
    conv_tile<4>(p.in[I_WBRANCH] + ((size_t)l * 4 + j) * 256 * 1024, 1024, 1024, nullptr, (bf16*)(we + WE_WB) + (size_t)j * 1024 * 256, 256, 0, nt * 64, smem, RowId());
    return;
  }
  it -= CT_WB;
  {
    int kt = it % 4, nt = it / 4;
    conv_tile<4>(p.in[I_WOUT] + (size_t)l * 1024 * 1024, 1024, 1024, nullptr, (bf16*)(we + WE_WOUT), 1024, kt * 256, nt * 64, smem, RowId());
  }
}
DI void conv_expert_item(const Params& p, int l, int it, char* smem) {
  char* wx = p.ws + OFF_MIX;
  int e = it / 192, r = it % 192, which = r / 64, t = r % 64, kt = t % 4, nt = t / 4;
  size_t eoff = ((size_t)l * NE + e) * 1024 * 1024;
  if (which == 0) { RowGU rm; rm.half = 0; conv_tile<4>(p.in[I_WGATE] + eoff, 1024, 1024, nullptr, (bf16*)(wx + WX_GU) + (size_t)e * 2048 * 1024, 1024, kt * 256, nt * 64, smem, rm); }
  else if (which == 1) { RowGU rm; rm.half = 1; conv_tile<4>(p.in[I_WUP] + eoff, 1024, 1024, nullptr, (bf16*)(wx + WX_GU) + (size_t)e * 2048 * 1024, 1024, kt * 256, nt * 64, smem, rm); }
  else conv_tile<4>(p.in[I_WDOWN] + eoff, 1024, 1024, nullptr, (bf16*)(wx + WX_DN) + (size_t)e * 1024 * 1024, 1024, kt * 256, nt * 64, smem, RowId());
}

DI void mod_item(const Params& p, int it, char* smem) {
  const int l = it / 96, cg0 = (it % 96) * 64;
  float* sc = (float*)smem;
  float* red = sc + NB1 * 1024;
  const int tid = tid_();
  __syncthreads();
  for (int i = tid; i < NB1 * 1024; i += NTHREADS) {
    int r = i >> 10, k = i & 1023;
    float c = (r < BATCH) ? p.in[I_C][r * 1024 + k] : p.in[I_CCTX][k];
    sc[i] = siluf_(c);
  }
  __syncthreads();
  const int cl = tid & 63, kg = tid >> 6;
  float acc[NB1];
#pragma unroll
  for (int r = 0; r < NB1; ++r) acc[r] = 0.f;
  const float* w = p.in[I_WADA] + (size_t)l * 1024 * 6144 + cg0 + cl;
  for (int k = kg * (1024 / NWAVES); k < (kg + 1) * (1024 / NWAVES); ++k) {
    float wv = w[(size_t)k * 6144];
#pragma unroll
    for (int r = 0; r < NB1; ++r) acc[r] += sc[r * 1024 + k] * wv;
  }
#pragma unroll
  for (int r = 0; r < NB1; ++r) red[(kg * NB1 + r) * 64 + cl] = acc[r];
  __syncthreads();
  for (int i = tid; i < NB1 * 64; i += NTHREADS) {
    int r = i >> 6, c = i & 63;
    float s = 0.f;
#pragma unroll
    for (int q = 0; q < NWAVES; ++q) s += red[(q * NB1 + r) * 64 + c];
    s += p.in[I_BADA][l * 6144 + cg0 + c];
    ((float*)(p.ws + OFF_MOD))[((size_t)l * NB1 + r) * 6144 + cg0 + c] = s;
  }
}

DI void s5_tab_item(const Params& p, int it, char* smem) {
  const int l = it / 32, d = (it / 16) & 1, g = it & 15;
  char* s5 = p.ws + OFF_S5TAB + (size_t)l * S5_SIZE;
  float* lampow = (float*)(s5 + S5_LAMPOW) + (size_t)(d * 16 + g) * 17 * 64 * 2;
  float* bbar = (float*)(s5 + S5_BBAR) + (size_t)(d * 16 + g) * 64 * 16 * 2;
  float* kt = (float*)(s5 + S5_KT) + (size_t)(d * 16 + g) * 16 * 256;
  float* slam = (float*)smem;
  float* sbb = slam + 17 * 64 * 2;
  const int tid = tid_();
  const size_t pg = ((size_t)(l * 2 + d) * 16 + g);
  const float step = expf(p.in[I_S5LOGSTEP][pg]);
  __syncthreads();
  for (int i = tid; i < 17 * 64; i += NTHREADS) {
    int j = i >> 6, pp = i & 63;
    float are = p.in[I_S5ARE][pg * 64 + pp], aim = p.in[I_S5AIM][pg * 64 + pp];
    float mag = expf((float)j * step * are), ang = (float)j * step * aim;
    float re = mag * cosf(ang), im = mag * sinf(ang);
    slam[i * 2] = re; slam[i * 2 + 1] = im; lampow[i * 2] = re; lampow[i * 2 + 1] = im;
  }
  __syncthreads();
  for (int i = tid; i < 64 * 16; i += NTHREADS) {
    int pp = i >> 4;
    float are = p.in[I_S5ARE][pg * 64 + pp], aim = p.in[I_S5AIM][pg * 64 + pp];
    float x = slam[(64 + pp) * 2] - 1.0f, y = slam[(64 + pp) * 2 + 1];
    float den = are * are + aim * aim;
    float qre = (x * are + y * aim) / den, qim = (y * are - x * aim) / den;
    float bre = p.in[I_S5BRE][pg * 1024 + i], bim = p.in[I_S5BIM][pg * 1024 + i];
    float re = qre * bre - qim * bim, im = qre * bim + qim * bre;
    sbb[i * 2] = re; sbb[i * 2 + 1] = im; bbar[i * 2] = re; bbar[i * 2 + 1] = im;
  }
  __syncthreads();
  for (int i = tid; i < 16 * 256; i += NTHREADS) {
    int j = i >> 8, c = (i >> 4) & 15, c2 = i & 15;
    float s = 0.f;
    for (int pp = 0; pp < 64; ++pp) {
      float cre = p.in[I_S5CRE][pg * 1024 + c * 64 + pp], cim = p.in[I_S5CIM][pg * 1024 + c * 64 + pp];
      float lre = slam[(j * 64 + pp) * 2], lim = slam[(j * 64 + pp) * 2 + 1];
      float tre = cre * lre - cim * lim, tim = cre * lim + cim * lre;
      float bre = sbb[(pp * 16 + c2) * 2], bim = sbb[(pp * 16 + c2) * 2 + 1];
      s += tre * bre - tim * bim;
    }
    kt[i] = s;
  }
}
DI void s5_mat_item(const Params& p, int it) {
  const int l = it / 64, g = (it / 4) & 15, q = it & 3;
  char* s5 = p.ws + OFF_S5TAB + (size_t)l * S5_SIZE;
  const float* lampow = (const float*)(s5 + S5_LAMPOW);
  const float* bbar = (const float*)(s5 + S5_BBAR);
  const float* ktab = (const float*)(s5 + S5_KT);
  bf16* WA = (bf16*)(s5 + S5_WA) + (size_t)g * 256 * 256;
  bf16* W2 = (bf16*)(s5 + S5_W2) + (size_t)g * 256 * 512;
  const int tid = tid_();
  for (int i = tid; i < 64 * 256; i += NTHREADS) {
    int n = q * 64 + (i >> 8), k = i & 255;
    int d = n >> 7, ri = (n >> 6) & 1, pp = n & 63, s = k >> 4, c2 = k & 15;
    int e = (d == 0) ? (15 - s) : s;
    const float* lp = lampow + ((size_t)((d * 16 + g) * 17 + e) * 64 + pp) * 2;
    const float* bp = bbar + ((size_t)((d * 16 + g) * 64 + pp) * 16 + c2) * 2;
    float re = lp[0] * bp[0] - lp[1] * bp[1], im = lp[0] * bp[1] + lp[1] * bp[0];
    WA[(size_t)n * 256 + k] = f2bf(ri == 0 ? re : im);
  }
  for (int i = tid; i < 64 * 512; i += NTHREADS) {
    int n = q * 64 + (i >> 9), k = i & 511;
    int lq = n >> 4, c = n & 15;
    float v;
    if (k < 256) {
      int s = k >> 4, c2 = k & 15;
      v = 0.f;
      if (s <= lq) v += ktab[((size_t)(0 * 16 + g) * 16 + (lq - s)) * 256 + c * 16 + c2];
      if (s >= lq) v += ktab[((size_t)(1 * 16 + g) * 16 + (s - lq)) * 256 + c * 16 + c2];
      if (s == lq && c == c2) v += p.in[I_S5D][l * 256 + g * 16 + c];
    } else {
      int kk = k - 256, d = kk >> 7, ri = (kk >> 6) & 1, pp = kk & 63;
      int e = (d == 0) ? (lq + 1) : (16 - lq);
      size_t pg = ((size_t)(l * 2 + d) * 16 + g);
      float cre = p.in[I_S5CRE][pg * 1024 + c * 64 + pp], cim = p.in[I_S5CIM][pg * 1024 + c * 64 + pp];
      const float* lp = lampow + ((size_t)((d * 16 + g) * 17 + e) * 64 + pp) * 2;
      float re = cre * lp[0] - cim * lp[1], im = cre * lp[1] + cim * lp[0];
      v = (ri == 0) ? re : -im;
    }
    W2[(size_t)n * 512 + k] = f2bf(v);
  }
}

DI int tok_b(int tok) { return tok / TOK; }
DI int tok_j(int tok) { return tok % TOK; }
DI int tok_modrow(int tok) { return (tok_j(tok) < CTXL) ? BATCH : tok_b(tok); }

DI void normmod_row(const float (&xv)[16], const float* g, const float* shift, const float* scale, bf16* dst, float (&hout)[16]) {
  const int lane = tid_() & 63;
  float ss = 0.f;
#pragma unroll
  for (int i = 0; i < 16; ++i) ss += xv[i] * xv[i];
  ss = wave_sum(ss);
  const float rs = rsqrtf(ss * (1.0f / 1024.f) + EPS);
#pragma unroll
  for (int i = 0; i < 4; ++i) {
    int c = lane * 4 + i * 256;
    float4 gv = *(const float4*)(g + c), sh = *(const float4*)(shift + c), sc = *(const float4*)(scale + c);
    float h0 = xv[i * 4 + 0] * rs * gv.x * (1.f + sc.x) + sh.x;
    float h1 = xv[i * 4 + 1] * rs * gv.y * (1.f + sc.y) + sh.y;
    float h2 = xv[i * 4 + 2] * rs * gv.z * (1.f + sc.z) + sh.z;
    float h3 = xv[i * 4 + 3] * rs * gv.w * (1.f + sc.w) + sh.w;
    hout[i * 4 + 0] = h0; hout[i * 4 + 1] = h1; hout[i * 4 + 2] = h2; hout[i * 4 + 3] = h3;
    *(uint2*)(dst + c) = make_uint2(pack2(h0, h1), pack2(h2, h3));
  }
}

DI void prep_row_item(const Params& p, int it) {
  const int tok = it * NWAVES + (tid_() >> 6), lane = tid_() & 63;
  const int b = tok_b(tok), j = tok_j(tok);
  const float* src = (j < CTXL) ? p.in[I_CTX] + ((size_t)b * CTXL + j) * 1024 : p.in[I_X] + ((size_t)b * SEQ + (j - CTXL)) * 1024;
  float* X = (float*)(p.ws + OFF_X) + (size_t)tok * 1024;
  float xv[16], h[16];
#pragma unroll
  for (int i = 0; i < 4; ++i) {
    float4 v = *(const float4*)(src + lane * 4 + i * 256);
    *(float4*)(X + lane * 4 + i * 256) = v;
    xv[i * 4] = v.x; xv[i * 4 + 1] = v.y; xv[i * 4 + 2] = v.z; xv[i * 4 + 3] = v.w;
  }
  const float* mod = (const float*)(p.ws + OFF_MOD) + (size_t)tok_modrow(tok) * 6144;
  normmod_row(xv, p.in[I_GPREMIX], mod + 0, mod + 1024, (bf16*)(p.ws + OFF_HA) + (size_t)tok * 1024, h);
}

constexpr int IP_LT = BATCH * (SEQ / 256), IP_CT = BATCH * ((CTXL + 255) / 256), IP_MT = IP_LT + IP_CT, IP_NT = N_INP / 256;
constexpr int IP_RR = (IP_MT + 7) / 8, IP_RC = (IP_NT + 1) / 2;
constexpr int IP_RC_NOGATE = (((C_GATE + 255) / 256) + 1) / 2;
constexpr int IP_RR_LAT = IP_LT / 8;
constexpr bool IP_COMPACT = (IP_LT % 8 == 0);
constexpr int IP_RECTS_ALL = IP_RR * IP_RC, IP_RECTS_LAST = IP_COMPACT ? (IP_RR * IP_RC_NOGATE + IP_RR_LAT * (IP_RC - IP_RC_NOGATE)) : IP_RECTS_ALL;
constexpr int IP_SLOTS_ALL = ((IP_RECTS_ALL + 15) / 16) * 256, IP_SLOTS_LAST = ((IP_RECTS_LAST + 15) / 16) * 256;
DI void inproj_tile(const Params& p, const LP& L, int t, char* smem) {
  const int vb = t % 256, vround = t / 256, x = vb % 8, j = vb / 8;
  const int Rc = vround * 16 + x * 2 + (j >> 4), jj = j & 15;
  int rm, rn;
  if (!L.last || !IP_COMPACT || Rc < IP_RR * IP_RC_NOGATE) { rm = Rc % IP_RR; rn = Rc / IP_RR; }
  else { const int q = Rc - IP_RR * IP_RC_NOGATE; rm = q % IP_RR_LAT; rn = IP_RC_NOGATE + q / IP_RR_LAT; }
  const int mt = rm * 8 + (jj & 7), nt = rn * 2 + (jj >> 3);
  if (mt >= IP_MT || nt >= IP_NT || rn >= IP_RC) return;
  int m0;
  if (mt < IP_LT) m0 = (mt / (SEQ / 256)) * TOK + CTXL + (mt % (SEQ / 256)) * 256;
  else { const int c = mt - IP_LT; m0 = (c / ((CTXL + 255) / 256)) * TOK + (c % ((CTXL + 255) / 256)) * 256; }
  const int n0 = nt * 256;
  const int mv = (mt < IP_LT) ? NTOK : (m0 - (m0 % TOK) + CTXL);
  if (L.last && mt >= IP_LT && n0 >= ((C_GATE + 255) / 256) * 256) return;
  GA g = make_ga((const bf16*)(p.ws + OFF_HA), 1024, (const bf16*)(L.we + WE_WIN), 1024, 1024, mv);
  f32x4 acc[2][2][4][2];
  gemm_big(g, m0, n0, smem, acc);
  bf16* P1 = (bf16*)(p.ws + OFF_P1);
  bf16* PG = (bf16*)(p.ws + OFF_PG);
  bf16* US5 = (bf16*)(p.ws + OFF_MIX + MX_US5);
  float* DT = (float*)(p.ws + OFF_DT);
  const float* dtb = p.in[I_M2DTBIAS] + L.l * 8;
  EPIB_BEGIN(acc, m0, n0, mv)
    if (col < C_S5 || (col >= C_Z && col < C_DT)) st8bf(P1 + (size_t)row * P1W + col, v);
    else if (col < C_Z) st8bf(US5 + ((size_t)((col - C_S5) >> 4) * NTOK + row) * 16 + (col & 15), v);
    else if (col < C_GATE) {
#pragma unroll
      for (int k = 0; k < 8; ++k) v[k] = softplusf_(v[k] + dtb[k]);
      st8f(DT + (size_t)row * 8, v);
    } else if (col < N_IN) {
#pragma unroll
      for (int k = 0; k < 8; ++k) v[k] = sigmoidf_(v[k]);
      st8bf(PG + (size_t)row * 4096 + (col - C_GATE), v);
    }
  EPIB_END
}

DI void rowscale_256(const bf16* P1, int m0, int c0, int width, float* srs) {
  const int r = tid_() >> 1, hf = tid_() & 1;
  int gr = m0 + r; if (gr > NTOK - 1) gr = NTOK - 1;
  const bf16* src = P1 + (size_t)gr * P1W + c0 + hf * (width / 2);
  float ss = 0.f;
  for (int i = 0; i < width / 2; i += 8) {
    float v[8]; ld8bf(src + i, v);
#pragma unroll
    for (int k = 0; k < 8; ++k) ss += v[k] * v[k];
  }
  ss += shfl_xor_(ss, 1);
  if (hf == 0) srs[r] = rsqrtf(ss / (float)width + EPS);
}
DI void rope_tab_item(const Params& p) {
  float* tab = (float*)(p.ws + OFF_ROPE);
  for (int i = tid_(); i < 64 * 8; i += NTHREADS) {
    int pos = i >> 3, k = i & 7;
    float f = expf(-(float)k * (9.210340371976184f / 8.0f));
    float a = (float)pos * f;
    tab[i * 2] = cosf(a); tab[i * 2 + 1] = sinf(a);
  }
}
DI void rope_cs(const float* tab, int pos, int i, float& c, float& s) { c = tab[(pos * 8 + i) * 2]; s = tab[(pos * 8 + i) * 2 + 1]; }

constexpr int TP_MT = (NTOK + 255) / 256;
DI void mlaq_tile(const Params& p, const LP& L, int t, char* smem) {
  const int mt = t % TP_MT, nt = t / TP_MT, m0 = mt * 256, n0 = nt * 128;
  const bf16* P1 = (const bf16*)(p.ws + OFF_P1);
  float* srs = (float*)(smem + SRS_OFF);
  GA g = make_ga(P1 + C_CQ, P1W, (const bf16*)(L.we + WE_UQ), 256, 256, NTOK);
  f32x4 acc[4][4];
  gemm_s<4>(g, m0, n0, smem, acc);
  rowscale_256(P1, m0, C_CQ, 256, srs);
  __syncthreads();
  bf16* Q = (bf16*)(p.ws + OFF_MIX + MX_Q);
  const float* ropetab = (const float*)(p.ws + OFF_ROPE);
  {
    const int l = tid_() & 63, w = tid_() >> 6, wr = w >> 1, wc = w & 1, fr = l & 15, fq = l >> 4;
#pragma unroll
    for (int m = 0; m < 4; ++m) {
      const int row = m0 + wr * 64 + m * 16 + fr;
      const int rowc = row < NTOK ? row : NTOK - 1;
      const float rsc = srs[rowc - m0];
      const int b = tok_b(rowc), j = tok_j(rowc);
#pragma unroll
      for (int q = 0; q < 2; ++q) {
        const int col = n0 + wc * 64 + q * 32 + 8 * fq;
        const int h = col / 96, dd = col % 96;
        float v[8] = {acc[m][2 * q][0], acc[m][2 * q][1], acc[m][2 * q][2], acc[m][2 * q][3], acc[m][2 * q + 1][0], acc[m][2 * q + 1][1], acc[m][2 * q + 1][2], acc[m][2 * q + 1][3]};
        float vp[8];
#pragma unroll
        for (int k = 0; k < 8; ++k) vp[k] = shfl_xor_(v[k], 16);
        if (dd >= 64 && j >= CTXL) {
          const int tl = j - CTXL, pos = ((dd - 64) < 16) ? (tl / GRID_W) : (tl % GRID_W);
          const bool lo = ((dd & 8) == 0);
#pragma unroll
          for (int k = 0; k < 8; ++k) {
            float c, sn; rope_cs(ropetab, pos, k, c, sn);
            v[k] = lo ? (v[k] * c - vp[k] * sn) : (v[k] * c + vp[k] * sn);
          }
        }
#pragma unroll
        for (int k = 0; k < 8; ++k) v[k] *= rsc;
        if (row < NTOK) st8bf(Q + (((size_t)b * 4 + h) * TOK + j) * 96 + dd, v);
      }
    }
  }
}
DI void mlakv_tile(const Params& p, const LP& L, int t, char* smem) {
  const int mt = t % TP_MT, h = t / TP_MT, m0 = mt * 256, n0 = h * 128;
  const bf16* P1 = (const bf16*)(p.ws + OFF_P1);
  float* srs = (float*)(smem + SRS_OFF);
  GA g = make_ga(P1 + C_CKV, P1W, (const bf16*)(L.we + WE_UKV), 128, 128, NTOK);
  f32x4 acc[4][4];
  gemm_s<4>(g, m0, n0, smem, acc);
  rowscale_256(P1, m0, C_CKV, 128, srs);
  __syncthreads();
  bf16* K = (bf16*)(p.ws + OFF_MIX + MX_K);
  bf16* VT = (bf16*)(p.ws + OFF_MIX + MX_VTM);
  const float* ropetab = (const float*)(p.ws + OFF_ROPE);
  EPI_BEGIN(4, acc, m0, n0, NTOK)
    const float rsc = srs[row - m0];
    const int b = tok_b(row), j = tok_j(row), dd = col - n0;
#pragma unroll
    for (int k = 0; k < 8; ++k) v[k] *= rsc;
    if (dd < 64) st8bf(K + (((size_t)b * 4 + h) * TOK + j) * 96 + dd, v);
    else {
#pragma unroll
      for (int k = 0; k < 8; ++k) VT[(((size_t)b * 4 + h) * 64 + (dd - 64 + k)) * TOK + j] = f2bf(v[k]);
    }
  EPI_END
  for (int i = tid_(); i < 256 * 16; i += NTHREADS) {
    int r = i >> 4, q = i & 15;
    int row = m0 + r;
    if (row < NTOK) {
      int b = tok_b(row), j = tok_j(row);
      int blk = q >> 3, i8 = q & 7;
      float x1 = bf2f(P1[(size_t)row * P1W + C_KR + blk * 16 + i8]), x2 = bf2f(P1[(size_t)row * P1W + C_KR + blk * 16 + i8 + 8]);
      float o1 = x1, o2 = x2;
      if (j >= CTXL) {
        int tl = j - CTXL, pos = blk == 0 ? (tl / GRID_W) : (tl % GRID_W);
        float c, sn; rope_cs(ropetab, pos, i8, c, sn);
        o1 = x1 * c - x2 * sn; o2 = x2 * c + x1 * sn;
      }
      bf16* kd = K + (((size_t)b * 4 + h) * TOK + j) * 96 + 64 + blk * 16 + i8;
      kd[0] = f2bf(o1); kd[8] = f2bf(o2);
    }
  }
}
DI void navt_item(const Params& p, int it, char* smem) {
  bf16* s = (bf16*)smem;
  const bf16* P1 = (const bf16*)(p.ws + OFF_P1);
  bf16* VT = (bf16*)(p.ws + OFF_MIX + MX_VTN);
  const int tok0 = it * 64, tid = tid_();
  const int b = tok_b(tok0), j0 = tok_j(tok0);
  __syncthreads();
  for (int i = tid; i < 64 * 32; i += NTHREADS) {
    int r = i >> 5, c8 = i & 31;
    *(uint4*)(s + r * 264 + c8 * 8) = *(const uint4*)(P1 + (size_t)(tok0 + r) * P1W + C_NA + 512 + c8 * 8);
  }
  __syncthreads();
  for (int i = tid; i < 256 * 8; i += NTHREADS) {
    int ch = i >> 3, t8 = i & 7;
    unsigned w[4];
#pragma unroll
    for (int q = 0; q < 4; ++q) w[q] = (unsigned)s[(t8 * 8 + 2 * q) * 264 + ch] | ((unsigned)s[(t8 * 8 + 2 * q + 1) * 264 + ch] << 16);
    *(uint4*)(VT + ((size_t)b * 256 + ch) * TOK + j0 + t8 * 8) = make_uint4(w[0], w[1], w[2], w[3]);
  }
}
DI void m2conv_item(const Params& p, const LP& L, int it) {
  const bf16* P1 = (const bf16*)(p.ws + OFF_P1);
  bf16* XB = (bf16*)(p.ws + OFF_MIX + MX_XBC);
  const int tok0 = it * 32, j0 = tok_j(tok0);
  const int slo = (j0 < CTXL) ? 0 : CTXL, shi = (j0 < CTXL) ? CTXL : TOK;
  const int base = tok0 - j0;
  for (int c = tid_(); c < 768; c += NTHREADS) {
    const float w0 = p.in[I_M2CONVW][(L.l * 4 + 0) * 768 + c], w1 = p.in[I_M2CONVW][(L.l * 4 + 1) * 768 + c];
    const float w2 = p.in[I_M2CONVW][(L.l * 4 + 2) * 768 + c], w3 = p.in[I_M2CONVW][(L.l * 4 + 3) * 768 + c];
    const float bb = p.in[I_M2CONVB][L.l * 768 + c];
    auto ld = [&](int j) -> float { return (j >= slo && j < shi) ? bf2f(P1[(size_t)(base + j) * P1W + C_XBC + c]) : 0.f; };
    float xm2 = ld(j0 - 2), xm1 = ld(j0 - 1), x0 = ld(j0);
    bf16* XT = (bf16*)(p.ws + OFF_MIX + MX_XBT) + ((size_t)(base / TOK) * 512 + c) * TOK + j0;
    for (int i8 = 0; i8 < 32; i8 += 8) {
      float yv[8];
#pragma unroll
      for (int k = 0; k < 8; ++k) {
        float xp1 = ld(j0 + i8 + k + 1);
        float y = siluf_(bb + w0 * xm2 + w1 * xm1 + w2 * x0 + w3 * xp1);
        XB[(size_t)(tok0 + i8 + k) * 768 + c] = f2bf(y);
        yv[k] = y;
        xm2 = xm1; xm1 = x0; x0 = xp1;
      }
      if (c < 512) st8bf(XT + i8, yv);
    }
  }
}
DI int m2_seq2tok(int sq, int dir) { return (dir == 0) ? sq : (sq < CTXL ? (CTXL - 1 - sq) : (TOK - 1 - (sq - CTXL))); }
constexpr int M2S_ITEMS = BATCH * 8 * (TOK / 64) / NWAVES;
DI void m2scal_item(const Params& p, const LP& L, int it) {
  const int w = it * NWAVES + (tid_() >> 6), lane = tid_() & 63;
  const int ch = w % (TOK / 64), r = w / (TOK / 64), hd = r & 3, dir = (r >> 2) & 1, b = r >> 3;
  const float a = -expf(p.in[I_M2ALOG][(L.l * 2 + dir) * 4 + hd]);
  const int sq = ch * 64 + lane, j = m2_seq2tok(sq, dir);
  const float dt = ((const float*)(p.ws + OFF_DT))[((size_t)b * TOK + j) * 8 + dir * 4 + hd];
  float cs = dt * a;
#pragma unroll
  for (int d = 1; d < 64; d <<= 1) { float o = shfl_up_(cs, d); if (lane >= d) cs += o; }
  const float sl = shfl_(cs, 63);
  float* o = (float*)(p.ws + OFF_MIX + MX_M2S) + ((size_t)((b * 2 + dir) * 4 + hd) * TOK + sq) * 4;
  *(float4*)o = make_float4(cs, dt, dt * __expf(sl - cs), cs * 1.4426950408889634f - log2f(dt));
}
constexpr int S5_MT = (MCH + 255) / 256;
DI void s5a_tile(const Params& p, const LP& L, int t, char* smem) {
  const int g = t / (S5_MT * 2), r = t % (S5_MT * 2), mt = r / 2, nt = r % 2;
  const int m0 = mt * 256, n0 = nt * 128;
  GA ga = make_ga((const bf16*)(p.ws + OFF_MIX + MX_US5) + (size_t)g * NTOK * 16, 256, (const bf16*)(L.s5 + S5_WA) + (size_t)g * 65536, 256, 256, MCH);
  f32x4 acc[4][4];
  gemm_s<4>(ga, m0, n0, smem, acc);
  float* HE = (float*)(p.ws + OFF_MIX + MX_HEND) + (size_t)g * MCH * 256;
  EPI_BEGIN(4, acc, m0, n0, MCH)
    st8f(HE + (size_t)row * 256 + col, v);
  EPI_END
}
DI int s5_chunk_of(int i, int d) { return (d == 0) ? i : (i < NCC ? (NCC - 1 - i) : (NCH - 1 - (i - NCC))); }
DI void s5carry_item(const Params& p, const LP& L, int it) {
  const int w = it * NWAVES + (tid_() >> 6), lane = tid_() & 63;
  const int d = w / (16 * BATCH), g = (w / BATCH) & 15, b = w % BATCH;
  const float* lp = (const float*)(L.s5 + S5_LAMPOW) + ((size_t)((d * 16 + g) * 17 + 16) * 64 + lane) * 2;
  const float lre = lp[0], lim = lp[1];
  const float* HE = (const float*)(p.ws + OFF_MIX + MX_HEND) + ((size_t)g * MCH + (size_t)b * NCH) * 256 + d * 128;
  bf16* HI = (bf16*)(p.ws + OFF_MIX + MX_HIN) + ((size_t)g * MCH + (size_t)b * NCH) * 256 + d * 128;
  float cre = 0.f, cim = 0.f;
  static_assert(NCH % 4 == 0, "chunk count");
  for (int i0 = 0; i0 < NCH; i0 += 4) {
    float hre[4], him[4];
#pragma unroll
    for (int k = 0; k < 4; ++k) { const int ch = s5_chunk_of(i0 + k, d); hre[k] = HE[(size_t)ch * 256 + lane]; him[k] = HE[(size_t)ch * 256 + 64 + lane]; }
#pragma unroll
    for (int k = 0; k < 4; ++k) {
      const int ch = s5_chunk_of(i0 + k, d);
      HI[(size_t)ch * 256 + lane] = f2bf(cre); HI[(size_t)ch * 256 + 64 + lane] = f2bf(cim);
      const float nre = lre * cre - lim * cim + hre[k], nim = lre * cim + lim * cre + him[k];
      cre = nre; cim = nim;
    }
  }
}
DI void s5c_tile(const Params& p, const LP& L, int t, char* smem) {
  const int g = t / (S5_MT * 2), r = t % (S5_MT * 2), mt = r / 2, nt = r % 2;
  const int m0 = mt * 256, n0 = nt * 128;
  GA ga = make_ga((const bf16*)(p.ws + OFF_MIX + MX_US5) + (size_t)g * NTOK * 16, 256, (const bf16*)(L.s5 + S5_W2) + (size_t)g * 256 * 512, 512, 512, MCH);
  ga.A2 = (const bf16*)(p.ws + OFF_MIX + MX_HIN) + (size_t)g * MCH * 256; ga.lda2 = 256; ga.ksplit = 256;
  f32x4 acc[4][4];
  gemm_s<4>(ga, m0, n0, smem, acc);
  bf16* Z = (bf16*)(p.ws + OFF_MIX + MX_Z);
  EPI_BEGIN(4, acc, m0, n0, MCH)
#pragma unroll
    for (int k = 0; k < 8; ++k) v[k] = geluf_(v[k]);
    st8bf(Z + ((size_t)row * 16 + (col >> 4)) * 256 + g * 16 + (col & 15), v);
  EPI_END
}

DI float fmax_(float a, float b) { return a > b ? a : b; }
constexpr int AT_LDV = 76;
struct NaInfo { int r, qc, rs, cs; };
template <int DK, bool NA>
DI void attn_block(const bf16* qrow, bool active, const bf16* Kp, int kstride, const bf16* Vt,
                   int ka0, int ntile_a, int arow0, int kb0, int ntile_b,
                   const float* srpb, NaInfo ni, float scale, bf16* orow, char* smem) {
  constexpr int LDK = DK + 8, KCH = DK / 8;
  constexpr int KT_BYTES = 64 * LDK * 2, VT_BYTES = 64 * AT_LDV * 2;
  constexpr int NKL = (64 * KCH + NTHREADS - 1) / NTHREADS;
  const int tid = tid_(), lane = tid & 63, half = lane >> 5, r = lane & 31;
  bf16* sK = (bf16*)smem;
  bf16* sV = (bf16*)(smem + 2 * KT_BYTES);
  bf16x8 qf[DK / 16];
  f32x16 o0, o1;
  float m = -1e30f, l = 0.f;
  const float scale2 = scale * 1.4426950408889634f;
#pragma unroll
  for (int ks = 0; ks < DK / 16; ++ks) qf[ks] = active ? *(const bf16x8*)(qrow + ks * 16 + 8 * half) : bf16x8{0, 0, 0, 0, 0, 0, 0, 0};
#pragma unroll
  for (int i = 0; i < 16; ++i) { o0[i] = 0.f; o1[i] = 0.f; }
  const int NTL = ntile_a + ntile_b;
  u32x4 rk[NKL], rv[1];
#pragma unroll
  for (int i = 0; i < NKL; ++i) rk[i] = u32x4{0u, 0u, 0u, 0u};
  auto key0_of = [&](int t) { return t < ntile_a ? ka0 + 64 * t : kb0 + 64 * (t - ntile_a); };
#define AT_GLOAD(t_) { const int k0_ = key0_of(t_); \
    _Pragma("unroll") for (int i_ = 0; i_ < NKL; ++i_) { const int c_ = tid + i_ * NTHREADS; const int key_ = c_ / KCH, ch_ = c_ % KCH; \
      if (c_ < 64 * KCH) rk[i_] = *(const u32x4*)(Kp + (size_t)(k0_ + key_) * kstride + ch_ * 8); } \
    { const int d_ = tid >> 3, ch_ = tid & 7; rv[0] = *(const u32x4*)(Vt + (size_t)d_ * TOK + k0_ + ch_ * 8); } }
#define AT_SSTORE(buf_) { \
    _Pragma("unroll") for (int i_ = 0; i_ < NKL; ++i_) { const int c_ = tid + i_ * NTHREADS; const int key_ = c_ / KCH, ch_ = c_ % KCH; \
      if (c_ < 64 * KCH) *(u32x4*)(sK + (buf_) * (64 * LDK) + key_ * LDK + ch_ * 8) = rk[i_]; } \
    { const int d_ = tid >> 3, ch_ = tid & 7; \
      bf16* dst_ = sV + (buf_) * (64 * AT_LDV) + d_ * AT_LDV + ch_ * 8; \
      *(uint2*)dst_ = make_uint2(rv[0][0], rv[0][1]); *(uint2*)(dst_ + 4) = make_uint2(rv[0][2], rv[0][3]); } }
  __syncthreads();
  AT_GLOAD(0) AT_SSTORE(0)
  __syncthreads();
#pragma unroll 1
  for (int t = 0; t < NTL; ++t) {
    const int buf = t & 1;
    if (t + 1 < NTL) AT_GLOAD(t + 1)
    bool doit = active;
    int trow0 = 0;
    if (NA && t < ntile_a) {
      trow0 = arow0 + t * (64 / GRID_W);
      doit = active && (trow0 + (64 / GRID_W) > ni.rs) && (trow0 < ni.rs + WIN_R);
    }
    if (doit) {
      const bf16* kb = sK + buf * (64 * LDK);
      const bf16* vb = sV + buf * (64 * AT_LDV);
      f32x16 s0, s1;
#pragma unroll
      for (int i = 0; i < 16; ++i) { s0[i] = 0.f; s1[i] = 0.f; }
#pragma unroll
      for (int ks = 0; ks < DK / 16; ++ks) {
        bf16x8 a0 = *(const bf16x8*)(kb + r * LDK + ks * 16 + 8 * half);
        bf16x8 a1 = *(const bf16x8*)(kb + (32 + r) * LDK + ks * 16 + 8 * half);
        s0 = __builtin_amdgcn_mfma_f32_32x32x16_bf16(a0, qf[ks], s0, 0, 0, 0);
        s1 = __builtin_amdgcn_mfma_f32_32x32x16_bf16(a1, qf[ks], s1, 0, 0, 0);
      }
      float mx = -INFINITY;
      if (NA && t < ntile_a) {
#pragma unroll
        for (int i = 0; i < 16; ++i) {
          const int kk = (i & 3) + 8 * (i >> 2) + 4 * half;
#pragma unroll
          for (int hb = 0; hb < 2; ++hb) {
            const int kq = kk + 32 * hb;
            const int kr = trow0 + kq / GRID_W, kc = kq % GRID_W;
            const bool ok = (kr >= ni.rs) && (kr < ni.rs + WIN_R) && (kc >= ni.cs) && (kc < ni.cs + WIN_C);
            const float bias = ok ? srpb[(kr - ni.r + 7) * 31 + (kc - ni.qc + 15)] * 1.4426950408889634f : -INFINITY;
            if (hb == 0) { s0[i] = s0[i] * scale2 + bias; mx = fmax_(mx, s0[i]); }
            else { s1[i] = s1[i] * scale2 + bias; mx = fmax_(mx, s1[i]); }
          }
        }
      } else {
#pragma unroll
        for (int i = 0; i < 16; ++i) { s0[i] *= scale2; s1[i] *= scale2; mx = fmax_(mx, fmax_(s0[i], s1[i])); }
      }
      mx = fmax_(mx, shfl_xor_(mx, 32));
      const float mn = fmax_(m, mx);
      const float alpha = exp2f_(m - mn);
      const bool same = (mn == m);
      m = mn;
      float ps = 0.f;
#pragma unroll
      for (int i = 0; i < 16; ++i) { s0[i] = exp2f_(s0[i] - mn); s1[i] = exp2f_(s1[i] - mn); ps += s0[i] + s1[i]; }
      l = l * alpha + ps;
      if (!wave_all_(same)) {
#pragma unroll
        for (int i = 0; i < 16; ++i) { o0[i] *= alpha; o1[i] *= alpha; }
      }
#pragma unroll
      for (int kq = 0; kq < 4; ++kq) {
        u32x4 pw;
#pragma unroll
        for (int j = 0; j < 4; ++j) pw[j] = (kq < 2) ? pack2(s0[8 * (kq & 1) + 2 * j], s0[8 * (kq & 1) + 2 * j + 1]) : pack2(s1[8 * (kq & 1) + 2 * j], s1[8 * (kq & 1) + 2 * j + 1]);
        const bf16x8 pf = __builtin_bit_cast(bf16x8, pw);
        const bf16* v0 = vb + r * AT_LDV + 16 * kq + 4 * half;
        const bf16* v1 = vb + (r + 32) * AT_LDV + 16 * kq + 4 * half;
        uint2 a0 = *(const uint2*)v0, a1 = *(const uint2*)(v0 + 8), b0 = *(const uint2*)v1, b1 = *(const uint2*)(v1 + 8);
        bf16x8 va, vbb;
        va[0] = (short)(a0.x & 0xffff); va[1] = (short)(a0.x >> 16); va[2] = (short)(a0.y & 0xffff); va[3] = (short)(a0.y >> 16);
        va[4] = (short)(a1.x & 0xffff); va[5] = (short)(a1.x >> 16); va[6] = (short)(a1.y & 0xffff); va[7] = (short)(a1.y >> 16);
        vbb[0] = (short)(b0.x & 0xffff); vbb[1] = (short)(b0.x >> 16); vbb[2] = (short)(b0.y & 0xffff); vbb[3] = (short)(b0.y >> 16);
        vbb[4] = (short)(b1.x & 0xffff); vbb[5] = (short)(b1.x >> 16); vbb[6] = (short)(b1.y & 0xffff); vbb[7] = (short)(b1.y >> 16);
        o0 = __builtin_amdgcn_mfma_f32_32x32x16_bf16(va, pf, o0, 0, 0, 0);
        o1 = __builtin_amdgcn_mfma_f32_32x32x16_bf16(vbb, pf, o1, 0, 0, 0);
      }
    }
    if (t + 1 < NTL) AT_SSTORE(buf ^ 1)
    __syncthreads();
  }
  if (active) {
    const float lt = l + shfl_xor_(l, 32);
    const float inv = 1.0f / lt;
#pragma unroll
    for (int gI = 0; gI < 4; ++gI) {
      const int d0 = 8 * gI + 4 * half;
      *(uint2*)(orow + d0) = make_uint2(pack2(o0[4 * gI] * inv, o0[4 * gI + 1] * inv), pack2(o0[4 * gI + 2] * inv, o0[4 * gI + 3] * inv));
      *(uint2*)(orow + 32 + d0) = make_uint2(pack2(o1[4 * gI] * inv, o1[4 * gI + 1] * inv), pack2(o1[4 * gI + 2] * inv, o1[4 * gI + 3] * inv));
    }
  }
}
DI void mla_attn_item(const Params& p, int it, bool ctxq, char* smem) {
  const int nqb = ctxq ? (CTXL + 255) / 256 : SEQ / 256;
  const int b = it / (4 * nqb), h = (it / nqb) & 3, qb = it % nqb;
  const int lane = tid_() & 63, wid = tid_() >> 6;
  const int nq = ctxq ? CTXL : SEQ, q0 = qb * 256 + wid * 32;
  const bool active = q0 < nq;
  const int jq = (ctxq ? 0 : CTXL) + (active ? q0 : 0) + (lane & 31);
  const bf16* Q = (const bf16*)(p.ws + OFF_MIX + MX_Q) + ((size_t)b * 4 + h) * TOK * 96;
  const bf16* K = (const bf16*)(p.ws + OFF_MIX + MX_K) + ((size_t)b * 4 + h) * TOK * 96;
  const bf16* VT = (const bf16*)(p.ws + OFF_MIX + MX_VTM) + ((size_t)b * 4 + h) * 64 * TOK;
  bf16* O = (bf16*)(p.ws + OFF_O) + ((size_t)b * TOK + jq) * 1024 + 0 * 256 + h * 64;
  NaInfo ni; ni.r = 0; ni.qc = 0; ni.rs = 0; ni.cs = 0;
  attn_block<96, false>(Q + (size_t)jq * 96, active, K, 96, VT, 0, 0, 0, 0, (ctxq ? CTXL : TOK) / 64, nullptr, ni, 0.10206207261596577f, O, smem);
}
DI void na_attn_item(const Params& p, const LP& L, int it, bool ctxq, char* smem) {
  const int nqb = ctxq ? (CTXL + 255) / 256 : SEQ / 256;
  const int b = it / (4 * nqb), h = (it / nqb) & 3, qb = it % nqb;
  const int tid = tid_(), lane = tid & 63, wid = tid >> 6;
  const int nq = ctxq ? CTXL : SEQ, q0 = qb * 256 + wid * 32;
  const bool active = q0 < nq;
  const int jq = (ctxq ? 0 : CTXL) + (active ? q0 : 0) + (lane & 31);
  const bf16* P1 = (const bf16*)(p.ws + OFF_P1) + (size_t)b * TOK * P1W;
  const bf16* VT = (const bf16*)(p.ws + OFF_MIX + MX_VTN) + ((size_t)b * 4 + h) * 64 * TOK;
  const bf16* Kb = P1 + C_NA + 256 + h * 64;
  bf16* O = (bf16*)(p.ws + OFF_O) + ((size_t)b * TOK + jq) * 1024 + 1 * 256 + h * 64;
  constexpr int AT_END64 = 2 * (64 * 72 * 2) + 2 * (64 * AT_LDV * 2);
  float* srpb = (float*)(smem + AT_END64);
  NaInfo ni; ni.r = 0; ni.qc = 0; ni.rs = 0; ni.cs = 0;
  int ka0 = 0, nta = 0, arow0 = 0;
  if (!ctxq) {
    __syncthreads();
    const float* rpb = p.in[I_RPB] + ((size_t)L.l * 4 + h) * 15 * 31;
    for (int i = tid; i < 15 * 31; i += NTHREADS) srpb[i] = rpb[i];
    const int tl = q0 + (lane & 31);
    ni.r = tl / GRID_W; ni.qc = tl % GRID_W;
    int rs = ni.r - WIN_R / 2; rs = rs < 0 ? 0 : (rs > ROWS - WIN_R ? ROWS - WIN_R : rs);
    int cs = ni.qc - WIN_C / 2; cs = cs < 0 ? 0 : (cs > GRID_W - WIN_C ? GRID_W - WIN_C : cs);
    ni.rs = rs; ni.cs = cs;
    constexpr int RPT = 64 / GRID_W;
    const int rfirst = (qb * 256) / GRID_W, rlast = (qb * 256 + 255) / GRID_W;
    int rs_f = rfirst - WIN_R / 2; rs_f = rs_f < 0 ? 0 : (rs_f > ROWS - WIN_R ? ROWS - WIN_R : rs_f);
    int rs_l = rlast - WIN_R / 2; rs_l = rs_l < 0 ? 0 : (rs_l > ROWS - WIN_R ? ROWS - WIN_R : rs_l);
    arow0 = (rs_f / RPT) * RPT;
    const int row_hi = rs_l + WIN_R;
    nta = (row_hi - arow0 + RPT - 1) / RPT;
    ka0 = CTXL + arow0 * GRID_W;
  }
  attn_block<64, true>(P1 + (size_t)jq * P1W + C_NA + h * 64, active, Kb, P1W, VT, ka0, nta, arow0, 0, CTXL / 64, srpb, ni, 0.125f, O, smem);
}

constexpr int M2_LDB = 136, M2_LDX = 72;
constexpr int M2_OFF_B = 0;
constexpr int M2_OFF_C = M2_OFF_B + 64 * M2_LDB * 2;
constexpr int M2_OFF_HD = M2_OFF_C + 64 * M2_LDB * 2;
constexpr int M2H_H = 0;
constexpr int M2H_XT = M2H_H + 64 * M2_LDB * 2;
constexpr int M2H_BT = M2H_XT + 64 * M2_LDX * 2;
constexpr int M2H_S = M2H_BT + 128 * M2_LDX * 2;
constexpr int M2H_X = M2H_S + 3 * 64 * 4;
constexpr int M2H_SIZE = M2H_X + 64 * M2_LDX * 2;
constexpr int M2_SMEM = M2_OFF_HD + 2 * M2H_SIZE;
static_assert(M2_SMEM <= SMEM_BYTES, "m2 smem");
DI u32x4 rev8_(u32x4 v) {
  return u32x4{(v[3] >> 16) | (v[3] << 16), (v[2] >> 16) | (v[2] << 16), (v[1] >> 16) | (v[1] << 16), (v[0] >> 16) | (v[0] << 16)};
}
DI void m2scan_item(const Params& p, const LP& L, int it, char* smem) {
  const int b = it / 4, grp = (it >> 1) & 1, dir = it & 1;
  const int tid = tid_(), lane = tid & 63, wid = tid >> 6, half = lane >> 5, r = lane & 31;
  const int hsel = wid >> 2, wl = wid & 3, hd = grp * 2 + hsel;
  bf16* sB = (bf16*)(smem + M2_OFF_B);
  bf16* sC = (bf16*)(smem + M2_OFF_C);
  char* hb = smem + M2_OFF_HD + hsel * M2H_SIZE;
  bf16* sH = (bf16*)(hb + M2H_H);
  bf16* sXT = (bf16*)(hb + M2H_XT);
  bf16* sBT = (bf16*)(hb + M2H_BT);
  float* sS = (float*)(hb + M2H_S);
  float* sDt = sS + 64;
  float* sW = sS + 128;
  const bf16* XB = (const bf16*)(p.ws + OFF_MIX + MX_XBC) + (size_t)b * TOK * 768;
  const bf16* XT = (const bf16*)(p.ws + OFF_MIX + MX_XBT) + (size_t)b * 512 * TOK;
  const float* SC = (const float*)(p.ws + OFF_MIX + MX_M2S) + (size_t)((b * 2 + dir) * 4 + hd) * TOK * 4;
  float* YM = (float*)(p.ws + OFF_HA) + ((size_t)dir * NTOK + (size_t)b * TOK) * 256;
  const int pb = wl & 1, tb = wl >> 1, nb0 = 2 * (wl >> 1);
  f32x16 hst[2];
#pragma unroll
  for (int i = 0; i < 16; ++i) { hst[0][i] = 0.f; hst[1][i] = 0.f; }
  __syncthreads();
  for (int i = tid; i < 2 * M2H_SIZE / 4; i += NTHREADS) ((unsigned*)(smem + M2_OFF_HD))[i] = 0u;
  __syncthreads();
  u32x4 rxt[2], rbt[2], rb[2], rc[2];
  float4 rsc = make_float4(0.f, 0.f, 0.f, 0.f);
#define M2_TLOAD(rowptr_, sq0_) (*(const u32x4*)((rowptr_) + ((dir == 0) ? (sq0_) : m2_seq2tok((sq0_) + 7, 1))))
#define M2_GLOAD(c0_) { \
    _Pragma("unroll") for (int q_ = 0; q_ < 2; ++q_) { const int i_ = tid + q_ * NTHREADS; const int h2_ = i_ >> 9, t8_ = ((i_ >> 6) & 7) * 8, pp_ = i_ & 63; \
      rxt[q_] = M2_TLOAD(XT + (size_t)((grp * 2 + h2_) * 64 + pp_) * TOK, (c0_) + t8_); } \
    _Pragma("unroll") for (int q_ = 0; q_ < 2; ++q_) { const int i_ = tid + q_ * NTHREADS; const int t8_ = (i_ >> 7) * 8, nn_ = i_ & 127; \
      rbt[q_] = M2_TLOAD(XT + (size_t)(256 + grp * 128 + nn_) * TOK, (c0_) + t8_); } \
    _Pragma("unroll") for (int q_ = 0; q_ < 2; ++q_) { const int i_ = tid + q_ * NTHREADS; const int t_ = i_ >> 4, n8_ = (i_ & 15) * 8; \
      const bf16* src_ = XB + (size_t)m2_seq2tok((c0_) + t_, dir) * 768 + grp * 128 + n8_; \
      rb[q_] = *(const u32x4*)(src_ + 256); rc[q_] = *(const u32x4*)(src_ + 512); } \
    if (wl == 0) rsc = *(const float4*)(SC + (size_t)((c0_) + lane) * 4); }
  M2_GLOAD(0)
  for (int c0 = 0; c0 < TOK; c0 += 64) {
    if (wl == 0) { sS[lane] = rsc.x; sDt[lane] = rsc.w; sW[lane] = rsc.z; }
    __syncthreads();
#pragma unroll
    for (int q2 = 0; q2 < 2; ++q2) {
      const int i = tid + q2 * NTHREADS; const int h2 = i >> 9, t8 = ((i >> 6) & 7) * 8, pp = i & 63;
      *(u32x4*)((bf16*)(smem + M2_OFF_HD + h2 * M2H_SIZE + M2H_XT) + pp * M2_LDX + t8) = dir ? rev8_(rxt[q2]) : rxt[q2];
    }
#pragma unroll
    for (int q4 = 0; q4 < 2; ++q4) {
      const int i = tid + q4 * NTHREADS; const int t = i >> 4, n8 = (i & 15) * 8;
      *(u32x4*)(sB + t * M2_LDB + n8) = rb[q4];
      *(u32x4*)(sC + t * M2_LDB + n8) = rc[q4];
    }
#pragma unroll
    for (int q4 = 0; q4 < 2; ++q4) {
      const int i = tid + q4 * NTHREADS; const int t8 = (i >> 7) * 8, nn = i & 127;
      float bv[8];
      if (dir) rbt[q4] = rev8_(rbt[q4]);
      bv[0] = __uint_as_float(rbt[q4][0] << 16); bv[1] = __uint_as_float(rbt[q4][0] & 0xffff0000u);
      bv[2] = __uint_as_float(rbt[q4][1] << 16); bv[3] = __uint_as_float(rbt[q4][1] & 0xffff0000u);
      bv[4] = __uint_as_float(rbt[q4][2] << 16); bv[5] = __uint_as_float(rbt[q4][2] & 0xffff0000u);
      bv[6] = __uint_as_float(rbt[q4][3] << 16); bv[7] = __uint_as_float(rbt[q4][3] & 0xffff0000u);
#pragma unroll
      for (int h2 = 0; h2 < 2; ++h2) {
        const float* wv = (const float*)(smem + M2_OFF_HD + h2 * M2H_SIZE + M2H_S) + 128 + t8;
        float sv[8];
#pragma unroll
        for (int k = 0; k < 8; ++k) sv[k] = bv[k] * wv[k];
        st8bf((bf16*)(smem + M2_OFF_HD + h2 * M2H_SIZE + M2H_BT) + nn * M2_LDX + t8, sv);
      }
    }
    __syncthreads();
    if (c0 + 64 < TOK) M2_GLOAD(c0 + 64)
    {
      f32x16 yT, y2;
#pragma unroll
      for (int i = 0; i < 16; ++i) { yT[i] = 0.f; y2[i] = 0.f; }
      const int tv = 32 * tb + r;
      const float St = sS[tv];
      for (int sb = 0; sb <= tb; ++sb) {
        f32x16 gT;
#pragma unroll
        for (int i = 0; i < 16; ++i) gT[i] = 0.f;
#pragma unroll
        for (int ks = 0; ks < 8; ++ks) {
          bf16x8 av = *(const bf16x8*)(sB + (32 * sb + r) * M2_LDB + 16 * ks + 8 * half);
          bf16x8 bv = *(const bf16x8*)(sC + tv * M2_LDB + 16 * ks + 8 * half);
          gT = __builtin_amdgcn_mfma_f32_32x32x16_bf16(av, bv, gT, 0, 0, 0);
        }
        const float St2 = St * 1.4426950408889634f;
        if (sb == tb) {
#pragma unroll
          for (int i = 0; i < 16; ++i) {
            const int sv = 32 * sb + (i & 3) + 8 * (i >> 2) + 4 * half;
            gT[i] = (sv <= tv) ? gT[i] * exp2f_(St2 - sDt[sv]) : 0.f;
          }
        } else {
#pragma unroll
          for (int i = 0; i < 16; ++i) {
            const int sv = 32 * sb + (i & 3) + 8 * (i >> 2) + 4 * half;
            gT[i] *= exp2f_(St2 - sDt[sv]);
          }
        }
#pragma unroll
        for (int kq = 0; kq < 2; ++kq) {
          const u32x4 pw = u32x4{pack2(gT[8 * kq], gT[8 * kq + 1]), pack2(gT[8 * kq + 2], gT[8 * kq + 3]), pack2(gT[8 * kq + 4], gT[8 * kq + 5]), pack2(gT[8 * kq + 6], gT[8 * kq + 7])};
          const bf16x8 pf = __builtin_bit_cast(bf16x8, pw);
          const bf16* xr = sXT + (32 * pb + r) * M2_LDX + 32 * sb + 16 * kq + 4 * half;
          uint2 x0 = *(const uint2*)xr, x1 = *(const uint2*)(xr + 8);
          bf16x8 xa;
          xa[0] = (short)(x0.x & 0xffff); xa[1] = (short)(x0.x >> 16); xa[2] = (short)(x0.y & 0xffff); xa[3] = (short)(x0.y >> 16);
          xa[4] = (short)(x1.x & 0xffff); xa[5] = (short)(x1.x >> 16); xa[6] = (short)(x1.y & 0xffff); xa[7] = (short)(x1.y >> 16);
          yT = __builtin_amdgcn_mfma_f32_32x32x16_bf16(xa, pf, yT, 0, 0, 0);
        }
      }
#pragma unroll
      for (int ks = 0; ks < 8; ++ks) {
        bf16x8 av = *(const bf16x8*)(sH + (32 * pb + r) * M2_LDB + 16 * ks + 8 * half);
        bf16x8 bv = *(const bf16x8*)(sC + tv * M2_LDB + 16 * ks + 8 * half);
        y2 = __builtin_amdgcn_mfma_f32_32x32x16_bf16(av, bv, y2, 0, 0, 0);
      }
      const float eS = __expf(St);
      const int j = m2_seq2tok(c0 + tv, dir);
      float* yo = YM + (size_t)j * 256 + hd * 64 + 32 * pb + 4 * half;
#pragma unroll
      for (int gI = 0; gI < 4; ++gI)
        *(float4*)(yo + 8 * gI) = make_float4(yT[4 * gI] + eS * y2[4 * gI], yT[4 * gI + 1] + eS * y2[4 * gI + 1], yT[4 * gI + 2] + eS * y2[4 * gI + 2], yT[4 * gI + 3] + eS * y2[4 * gI + 3]);
    }
    __syncthreads();
    {
      const float eL = __expf(sS[63]);
#pragma unroll
      for (int q = 0; q < 2; ++q) {
#pragma unroll
        for (int i = 0; i < 16; ++i) hst[q][i] *= eL;
#pragma unroll
        for (int ks = 0; ks < 4; ++ks) {
          bf16x8 av = *(const bf16x8*)(sXT + (32 * pb + r) * M2_LDX + 16 * ks + 8 * half);
          bf16x8 bv = *(const bf16x8*)(sBT + (32 * (nb0 + q) + r) * M2_LDX + 16 * ks + 8 * half);
          hst[q] = __builtin_amdgcn_mfma_f32_32x32x16_bf16(av, bv, hst[q], 0, 0, 0);
        }
#pragma unroll
        for (int i = 0; i < 16; ++i) {
          const int pv = 32 * pb + (i & 3) + 8 * (i >> 2) + 4 * half;
          sH[pv * M2_LDB + 32 * (nb0 + q) + r] = f2bf(hst[q][i]);
        }
      }
    }
    __syncthreads();
  }
}
DI void m2gate_item(const Params& p, const LP& L, int it) {
  const int tok = it * NWAVES + (tid_() >> 6), lane = tid_() & 63;
  const float* Y0 = (const float*)(p.ws + OFF_HA) + (size_t)tok * 256;
  const float* Y1 = Y0 + (size_t)NTOK * 256;
  const bf16* XB = (const bf16*)(p.ws + OFF_MIX + MX_XBC) + (size_t)tok * 768;
  const bf16* P1 = (const bf16*)(p.ws + OFF_P1) + (size_t)tok * P1W + C_Z;
  const int c = lane * 4, hd = c >> 6;
  const float dsk = p.in[I_M2D][L.l * 4 + hd];
  float4 y0 = *(const float4*)(Y0 + c), y1 = *(const float4*)(Y1 + c);
  uint2 xw = *(const uint2*)(XB + c), zw = *(const uint2*)(P1 + c);
  float xs[4] = {__uint_as_float(xw.x << 16), __uint_as_float(xw.x & 0xffff0000u), __uint_as_float(xw.y << 16), __uint_as_float(xw.y & 0xffff0000u)};
  float zs[4] = {__uint_as_float(zw.x << 16), __uint_as_float(zw.x & 0xffff0000u), __uint_as_float(zw.y << 16), __uint_as_float(zw.y & 0xffff0000u)};
  float ys[4] = {y0.x + y1.x, y0.y + y1.y, y0.z + y1.z, y0.w + y1.w};
  float v[4], ss = 0.f;
#pragma unroll
  for (int i = 0; i < 4; ++i) { v[i] = (ys[i] + dsk * xs[i]) * siluf_(zs[i]); ss += v[i] * v[i]; }
  ss = wave_sum(ss);
  const float rs = rsqrtf(ss * (1.f / 256.f) + EPS);
  float4 gn = *(const float4*)(p.in[I_M2GNORM] + L.l * 256 + c);
  bf16* O = (bf16*)(p.ws + OFF_O) + (size_t)tok * 1024 + 768 + c;
  *(uint2*)O = make_uint2(pack2(v[0] * rs * gn.x, v[1] * rs * gn.y), pack2(v[2] * rs * gn.z, v[3] * rs * gn.w));
}
constexpr int GLU_MT = (NTOK + 255) / 256;
DI void glu_tile(const Params& p, const LP& L, int t, char* smem) {
  const int mt = t % GLU_MT, nt = t / GLU_MT, m0 = mt * 256, n0 = nt * 128;
  const bf16* Z = (const bf16*)(p.ws + OFF_MIX + MX_Z);
  GA g = make_ga(Z, 256, (const bf16*)(L.we + WE_GLU), 256, 256, NTOK);
  f32x4 acc[4][4];
  gemm_s<4>(g, m0, n0, smem, acc);
  bf16* O = (bf16*)(p.ws + OFF_O);
  const float* bg = p.in[I_S5BGLU] + L.l * 256;
  EPI_BEGIN(4, acc, m0, n0, NTOK)
    float z[8]; ld8bf(Z + (size_t)row * 256 + col, z);
#pragma unroll
    for (int k = 0; k < 8; ++k) v[k] = z[k] * sigmoidf_(v[k] + bg[col + k]);
    st8bf(O + (size_t)row * 1024 + 512 + col, v);
  EPI_END
}
DI void merge_tile(const Params& p, const LP& L, int t, char* smem) {
  constexpr int MT_L = BATCH * (SEQ / 256), MT_A = (NTOK + 255) / 256;
  const int mt = L.last ? t % MT_L : t % MT_A, nt = L.last ? t / MT_L : t / MT_A, m0 = mtile_row0(mt, L.last, 256), n0 = nt * 64;
  const bf16* O = (const bf16*)(p.ws + OFF_O);
  const bf16* PG = (const bf16*)(p.ws + OFF_PG);
  float tot[4][8];
#pragma unroll
  for (int a = 0; a < 4; ++a)
#pragma unroll
    for (int k = 0; k < 8; ++k) tot[a][k] = 0.f;
  for (int j = 0; j < 4; ++j) {
    GA g = make_ga(O + j * 256, 1024, (const bf16*)(L.we + WE_WB) + (size_t)j * 1024 * 256, 256, 256, NTOK);
    f32x4 acc[4][2];
    gemm_s<2>(g, m0, n0, smem, acc);
    EPI_BEGIN(2, acc, m0, n0, NTOK)
      float gt[8]; ld8bf(PG + (size_t)row * 4096 + j * 1024 + col, gt);
#pragma unroll
      for (int k = 0; k < 8; ++k) tot[_m][k] += gt[k] * v[k];
    EPI_END
  }
  bf16* Y = (bf16*)(p.ws + OFF_P1);
  {
    const int l = tid_() & 63, w = tid_() >> 6, wr = w >> 1, wc = w & 1, fr = l & 15, fq = l >> 4;
#pragma unroll
    for (int m = 0; m < 4; ++m) {
      const int row = m0 + wr * 64 + m * 16 + fr, col = n0 + wc * 32 + 8 * fq;
      if (row < NTOK) st8bf(Y + (size_t)row * 1024 + col, tot[m]);
    }
  }
}
DI void outproj_tile(const Params& p, const LP& L, int t, char* smem) {
  float* Y2 = (float*)(p.ws + OFF_HA);
  constexpr int MT_L = BATCH * (SEQ / 256), MT_A = (NTOK + 255) / 256;
  const int mt = L.last ? t % MT_L : t % MT_A, nt = L.last ? t / MT_L : t / MT_A, m0 = mtile_row0(mt, L.last, 256), n0 = nt * 256;
  GA g = make_ga((const bf16*)(p.ws + OFF_P1), 1024, (const bf16*)(L.we + WE_WOUT), 1024, 1024, NTOK);
  f32x4 acc[2][2][4][2];
  gemm_big(g, m0, n0, smem, acc);
  EPIB_BEGIN(acc, m0, n0, NTOK)
    st8f(Y2 + (size_t)row * 1024 + col, v);
  EPIB_END
}
DI int post_ntok(bool latonly) { return latonly ? BATCH * SEQ : NTOK; }
DI int post_tok(int i, bool latonly) { return latonly ? ((i / SEQ) * TOK + CTXL + (i % SEQ)) : i; }

DI void post_stage_router(const Params& p, const LP& L, char* smem) {
  const float* wr = p.in[I_WROUTER] + (size_t)L.l * 1024 * 16;
  float4* wl = (float4*)smem;
  __syncthreads();
  for (int i = tid_(); i < 4096; i += NTHREADS) {
    const int k = i >> 2, q = i & 3;
    const int pos = ((k >> 8) * 4 + (k & 3)) * 64 + ((k >> 2) & 63);
    wl[q * 1024 + pos] = *(const float4*)(wr + (size_t)k * 16 + q * 4);
  }
  __syncthreads();
}
DI void post_item(const Params& p, const LP& L, int it, char* smem) {
  const int tok = post_tok(it * NWAVES + (tid_() >> 6), L.last), lane = tid_() & 63;
  float* X = (float*)(p.ws + OFF_X) + (size_t)tok * 1024;
  const float* Y2 = (const float*)(p.ws + OFF_HA) + (size_t)tok * 1024;
  const float* mod = L.mod + (size_t)tok_modrow(tok) * 6144;
  float yv[16], xv[16], h[16];
  float ss = 0.f;
#pragma unroll
  for (int i = 0; i < 4; ++i) {
    float4 v = *(const float4*)(Y2 + lane * 4 + i * 256);
    yv[i * 4] = v.x; yv[i * 4 + 1] = v.y; yv[i * 4 + 2] = v.z; yv[i * 4 + 3] = v.w;
    ss += v.x * v.x + v.y * v.y + v.z * v.z + v.w * v.w;
  }
  ss = wave_sum(ss);
  const float rs = rsqrtf(ss * (1.f / 1024.f) + EPS);
  const float* gpm = p.in[I_GPOSTMIX] + L.l * 1024;
#pragma unroll
  for (int i = 0; i < 4; ++i) {
    int c = lane * 4 + i * 256;
    float4 xo = *(const float4*)(X + c), gv = *(const float4*)(gpm + c), gt = *(const float4*)(mod + 2048 + c);
    xo.x += gt.x * yv[i * 4] * rs * gv.x; xo.y += gt.y * yv[i * 4 + 1] * rs * gv.y; xo.z += gt.z * yv[i * 4 + 2] * rs * gv.z; xo.w += gt.w * yv[i * 4 + 3] * rs * gv.w;
    *(float4*)(X + c) = xo;
    xv[i * 4] = xo.x; xv[i * 4 + 1] = xo.y; xv[i * 4 + 2] = xo.z; xv[i * 4 + 3] = xo.w;
  }
  bf16* H2 = (bf16*)(p.ws + OFF_P1) + (size_t)NTOK * 1024 + (size_t)tok * 1024;
  normmod_row(xv, p.in[I_GPREFFN] + L.l * 1024, mod + 3072, mod + 4096, H2, h);
  const float4* wl = (const float4*)smem;
  float lg[16];
#pragma unroll
  for (int e = 0; e < 16; ++e) lg[e] = 0.f;
#pragma unroll
  for (int i = 0; i < 16; ++i) {
    const int pos = ((i >> 2) * 4 + (i & 3)) * 64 + lane;
    float4 a = wl[pos], b4 = wl[1024 + pos], c4 = wl[2048 + pos], d4 = wl[3072 + pos];
    float hv = h[i];
    lg[0] += hv * a.x; lg[1] += hv * a.y; lg[2] += hv * a.z; lg[3] += hv * a.w;
    lg[4] += hv * b4.x; lg[5] += hv * b4.y; lg[6] += hv * b4.z; lg[7] += hv * b4.w;
    lg[8] += hv * c4.x; lg[9] += hv * c4.y; lg[10] += hv * c4.z; lg[11] += hv * c4.w;
    lg[12] += hv * d4.x; lg[13] += hv * d4.y; lg[14] += hv * d4.z; lg[15] += hv * d4.w;
  }
  float mx = -INFINITY;
#pragma unroll
  for (int e = 0; e < 16; ++e) { lg[e] = wave_sum(lg[e]); mx = fmax_(mx, lg[e]); }
  float se = 0.f;
#pragma unroll
  for (int e = 0; e < 16; ++e) { lg[e] = expf(lg[e] - mx); se += lg[e]; }
  if (lane < 16) {
    float v = 0.f;
#pragma unroll
    for (int e = 0; e < 16; ++e) if (e == lane) v = lg[e];
    ((float*)(p.ws + OFF_AFF))[(size_t)lane * NTOK + tok] = v / se;
  }
}
DI int block_sum_(int v, int* sred, int round) {
  const int tid = tid_(), lane = tid & 63, wid = tid >> 6;
  v += shfl_xor_(v, 32); v += shfl_xor_(v, 16); v += shfl_xor_(v, 8); v += shfl_xor_(v, 4); v += shfl_xor_(v, 2); v += shfl_xor_(v, 1);
  int* r = sred + (round & 1) * NWAVES;
  if (lane == 0) r[wid] = v;
  __syncthreads();
  int tsum = 0;
#pragma unroll
  for (int q = 0; q < NWAVES; ++q) tsum += r[q];
  return tsum;
}
DI void route_item(const Params& p, const LP& L, int it, char* smem) {
  const int nstream = L.last ? 1 : 2;
  const int b = it / (16 * nstream), e = (it / nstream) & 15, ctxs = (nstream == 2) ? (it & 1) : 0;
  const int T = ctxs ? CTXL : SEQ, cap = ctxs ? CAP_C : CAP_L;
  const int tok0 = b * TOK + (ctxs ? 0 : CTXL);
  const int slot0 = ctxs ? (BATCH * CAP_L + b * CAP_C) : (b * CAP_L);
  int* sred = (int*)smem;
  const float* AFF = (const float*)(p.ws + OFF_AFF) + (size_t)e * NTOK + tok0;
  int* SEL = (int*)(p.ws + OFF_SEL);
  int* IDX = (int*)(p.ws + OFF_IDX) + (size_t)e * ESLOTS;
  float* GW = (float*)(p.ws + OFF_GW) + (size_t)e * ESLOTS;
  const int tid = tid_(), lane = tid & 63, wid = tid >> 6;
  constexpr int MAXPER = (SEQ + NTHREADS - 1) / NTHREADS;
  const int per = (T + NTHREADS - 1) / NTHREADS;
  unsigned key[MAXPER];
  __syncthreads();
#pragma unroll
  for (int k = 0; k < MAXPER; ++k) {
    int i = tid * per + k;
    key[k] = (k < per && i < T) ? (__float_as_uint(AFF[i]) + 1u) : 0u;
  }
  unsigned thr = 0u;
  int round = 0;
  for (int bit = 30; bit >= 0; --bit) {
    const unsigned cand = thr | (1u << bit);
    int c = 0;
#pragma unroll
    for (int k = 0; k < MAXPER; ++k) c += (key[k] >= cand) ? 1 : 0;
    c = block_sum_(c, sred, round++);
    if (c >= cap) thr = cand;
  }
  int cg = 0, ce = 0;
#pragma unroll
  for (int k = 0; k < MAXPER; ++k) { cg += (key[k] > thr) ? 1 : 0; ce += (key[k] == thr) ? 1 : 0; }
  const int tot_gt = block_sum_(cg, sred, round++);
  const int need_eq = cap - tot_gt;
  int v = cg | (ce << 16), inc = v;
#pragma unroll
  for (int d = 1; d < 64; d <<= 1) { int o = shfl_up_(inc, d); if (lane >= d) inc += o; }
  int* soff = sred + 2 * NWAVES;
  __syncthreads();
  if (lane == 63) soff[wid] = inc;
  __syncthreads();
  int base = 0;
  for (int w = 0; w < wid; ++w) base += soff[w];
  int excl = base + inc - v;
  int gt_before = excl & 0xffff, eq_before = excl >> 16;
#pragma unroll
  for (int k = 0; k < MAXPER; ++k) {
    int i = tid * per + k;
    if (k < per && i < T) {
      const bool isgt = key[k] > thr, iseq = key[k] == thr;
      const bool sel = isgt || (iseq && eq_before < need_eq);
      const int slot = slot0 + gt_before + (eq_before < need_eq ? eq_before : need_eq);
      if (sel) { IDX[slot] = tok0 + i; GW[slot] = __uint_as_float(key[k] - 1u); SEL[(size_t)(tok0 + i) * 16 + e] = slot; }
      else SEL[(size_t)(tok0 + i) * 16 + e] = -1;
      gt_before += isgt ? 1 : 0; eq_before += iseq ? 1 : 0;
    }
  }
}
DI void moe1_tile(const Params& p, const LP& L, int t, char* smem) {
  const int nslots = L.last ? ESLOTS_L : ESLOTS;
  constexpr int MT_L = (ESLOTS_L + 255) / 256, MT_A = (ESLOTS + 255) / 256;
  const int nt = t & 7, sq = t >> 3;
  const int e = L.last ? sq / MT_L : sq / MT_A, mt = L.last ? sq % MT_L : sq % MT_A;
  const int m0 = mt * 256, n0 = nt * 256;
  GA g = make_ga((const bf16*)(p.ws + OFF_P1) + (size_t)NTOK * 1024, 1024, (const bf16*)(p.ws + OFF_MIX + WX_GU) + (size_t)e * 2048 * 1024, 1024, 1024, nslots);
  g.ridx = (const int*)(p.ws + OFF_IDX) + (size_t)e * ESLOTS;
  f32x4 acc[2][2][4][2];
  gemm_big(g, m0, n0, smem, acc);
  bf16* ACT = (bf16*)(p.ws + OFF_PG) + (size_t)e * ESLOTS * 1024;
  {
    const int l = tid_() & 63, w = tid_() >> 6, wr = w >> 2, wc = w & 3, fr = l & 15, fq = l >> 4;
#pragma unroll
    for (int ai = 0; ai < 2; ++ai)
#pragma unroll
      for (int m = 0; m < 4; ++m) {
        const int row = m0 + ai * 128 + wr * 64 + m * 16 + fr;
        float a[8];
#pragma unroll
        for (int k = 0; k < 4; ++k) { a[k] = siluf_(acc[ai][0][m][0][k]) * acc[ai][1][m][0][k]; a[4 + k] = siluf_(acc[ai][0][m][1][k]) * acc[ai][1][m][1][k]; }
        if (row < nslots) st8bf(ACT + (size_t)row * 1024 + nt * 128 + wc * 32 + 8 * fq, a);
      }
  }
}
DI void moe2_tile(const Params& p, const LP& L, int t, char* smem) {
  const int nslots = L.last ? ESLOTS_L : ESLOTS;
  constexpr int MT_L = (ESLOTS_L + 255) / 256, MT_A = (ESLOTS + 255) / 256;
  const int e = L.last ? t / (MT_L * 4) : t / (MT_A * 4), r = L.last ? t % (MT_L * 4) : t % (MT_A * 4), mt = L.last ? r % MT_L : r % MT_A, nt = L.last ? r / MT_L : r / MT_A;
  const int m0 = mt * 256, n0 = nt * 256;
  GA g = make_ga((const bf16*)(p.ws + OFF_PG) + (size_t)e * ESLOTS * 1024, 1024, (const bf16*)(p.ws + OFF_MIX + WX_DN) + (size_t)e * 1024 * 1024, 1024, 1024, nslots);
  f32x4 acc[2][2][4][2];
  gemm_big(g, m0, n0, smem, acc);
  bf16* YS = (bf16*)(p.ws + OFF_PG) + (size_t)NE * ESLOTS * 1024 + (size_t)e * ESLOTS * 1024;
  const float* GW = (const float*)(p.ws + OFF_GW) + (size_t)e * ESLOTS;
  EPIB_BEGIN(acc, m0, n0, nslots)
    const float gw = GW[row];
#pragma unroll
    for (int k = 0; k < 8; ++k) v[k] *= gw;
    st8bf(YS + (size_t)row * 1024 + col, v);
  EPIB_END
}
DI void comb_item(const Params& p, const LP& L, int it) {
  const int tok = post_tok(it * NWAVES + (tid_() >> 6), L.last), lane = tid_() & 63;
  float* X = (float*)(p.ws + OFF_X) + (size_t)tok * 1024;
  const int* SEL = (const int*)(p.ws + OFF_SEL) + (size_t)tok * 16;
  const bf16* YS = (const bf16*)(p.ws + OFF_PG) + (size_t)NE * ESLOTS * 1024;
  const float* mod = L.mod + (size_t)tok_modrow(tok) * 6144;
  float s[16];
#pragma unroll
  for (int i = 0; i < 16; ++i) s[i] = 0.f;
  for (int e = 0; e < 16; ++e) {
    int sl = SEL[e];
    if (sl >= 0) {
      const bf16* yr = YS + ((size_t)e * ESLOTS + sl) * 1024;
#pragma unroll
      for (int i = 0; i < 4; ++i) {
        uint2 w = *(const uint2*)(yr + lane * 4 + i * 256);
        s[i * 4] += __uint_as_float(w.x << 16); s[i * 4 + 1] += __uint_as_float(w.x & 0xffff0000u);
        s[i * 4 + 2] += __uint_as_float(w.y << 16); s[i * 4 + 3] += __uint_as_float(w.y & 0xffff0000u);
      }
    }
  }
  float ss = 0.f;
#pragma unroll
  for (int i = 0; i < 16; ++i) ss += s[i] * s[i];
  ss = wave_sum(ss);
  const float rs = rsqrtf(ss * (1.f / 1024.f) + EPS);
  const float* gpf = p.in[I_GPOSTFFN] + L.l * 1024;
  float xv[16], h[16];
  float* dst = X;
  if (L.last) { const int b = tok_b(tok), j = tok_j(tok); dst = p.out + ((size_t)b * SEQ + (j - CTXL)) * 1024; }
#pragma unroll
  for (int i = 0; i < 4; ++i) {
    int c = lane * 4 + i * 256;
    float4 xo = *(const float4*)(X + c), gv = *(const float4*)(gpf + c), gt = *(const float4*)(mod + 5120 + c);
    xo.x += gt.x * s[i * 4] * rs * gv.x; xo.y += gt.y * s[i * 4 + 1] * rs * gv.y; xo.z += gt.z * s[i * 4 + 2] * rs * gv.z; xo.w += gt.w * s[i * 4 + 3] * rs * gv.w;
    *(float4*)(dst + c) = xo;
    xv[i * 4] = xo.x; xv[i * 4 + 1] = xo.y; xv[i * 4 + 2] = xo.z; xv[i * 4 + 3] = xo.w;
  }
  if (!L.last) {
    const float* mod1 = (const float*)(p.ws + OFF_MOD) + ((size_t)(L.l + 1) * NB1 + tok_modrow(tok)) * 6144;
    normmod_row(xv, p.in[I_GPREMIX] + (L.l + 1) * 1024, mod1, mod1 + 1024, (bf16*)(p.ws + OFF_HA) + (size_t)tok * 1024, h);
  }
}

enum { PH_PREP0 = 0, PH_PREP1, PH_L0 };
enum { LP_INPROJ = 0, LP_TOKPREP, LP_MIX1, LP_MIX2, LP_GLU, LP_MERGE, LP_OUT, LP_POST, LP_ROUTE, LP_MOE1, LP_MOE2, LP_COMB, LP_COUNT };
constexpr int NPHASES = PH_L0 + DEPTH * LP_COUNT;


DI void run_phase(const Params& p, int ph, char* smem) {
  const int G = gridDim.x;
  int start = blockIdx.x;
  auto seg = [&](int n, auto&& fn) {
    for (; start < n; start += G) fn(start);
    start -= n;
  };
#ifdef ONLY_PREP
  if (ph >= PH_L0) return;
#endif
  if (ph == PH_PREP0) {
    seg(DEPTH * 96, [&](int it) { mod_item(p, it, smem); });
    seg(DEPTH * 32, [&](int it) { s5_tab_item(p, it, smem); });
    seg(1, [&](int) { rope_tab_item(p); });
    seg(DEPTH * CT_EARLY, [&](int it) { conv_early_item(p, it / CT_EARLY, it % CT_EARLY, smem); });
    return;
  }
  if (ph == PH_PREP1) {
    seg(DEPTH * 64, [&](int it) { s5_mat_item(p, it); });
    seg(NTOK / NWAVES, [&](int it) { prep_row_item(p, it); });
    return;
  }
#ifdef ONLY_LPH
  if (ph < PH_L0) return;
#endif
  const int l = (ph - PH_L0) / LP_COUNT;
#ifdef ONLY_LPH
  const int lph = ONLY_LPH;
#else
  const int lph = (ph - PH_L0) % LP_COUNT;
#endif
  const LP L = make_lp(p, l);
  switch (lph) {
    case LP_INPROJ:
      seg(L.last ? IP_SLOTS_LAST : IP_SLOTS_ALL, [&](int it) { inproj_tile(p, L, it, smem); });
      break;
    case LP_TOKPREP:
      seg(16 * S5_MT * 2, [&](int it) { s5a_tile(p, L, it, smem); });
      seg(TP_MT * 3, [&](int it) { mlaq_tile(p, L, it, smem); });
      seg(TP_MT * 4, [&](int it) { mlakv_tile(p, L, it, smem); });
      seg(NTOK / 64, [&](int it) { navt_item(p, it, smem); });
      seg(NTOK / 32, [&](int it) { m2conv_item(p, L, it); });
      seg(M2S_ITEMS, [&](int it) { m2scal_item(p, L, it); });
      break;
    case LP_MIX1: {
      const int n0 = BATCH * 4, n1 = n0 + 2 * 16 * BATCH / NWAVES, n2 = n1 + BATCH * 4 * (SEQ / 256), n3 = n2 + BATCH * 4 * (SEQ / 256);
      const int n4 = n3 + (L.last ? 0 : BATCH * 4 * ((CTXL + 255) / 256)), n5 = n4 + (L.last ? 0 : BATCH * 4 * ((CTXL + 255) / 256));
      int* qhead = (int*)(p.ws + OFF_BAR) + Q_WORD0 + 64 * (l + 2 * p.probe_rep);
#ifdef EMU
      volatile int* bc = (volatile int*)(smem + SMEM_BYTES + 8);
#else
      volatile LAS int* bc = (volatile LAS int*)(smem + SMEM_BYTES + 8);
#endif
      for (;;) {
        __syncthreads();
        if (tid_() == 0) {
#ifdef EMU
          *bc = atomicAdd(qhead, 1);
#else
          *bc = __hip_atomic_fetch_add(qhead, 1, __ATOMIC_RELAXED, __HIP_MEMORY_SCOPE_AGENT);
#endif
        }
        __syncthreads();
        const int it = *bc;
        if (it >= n5) break;
        if (it < n0) m2scan_item(p, L, it, smem);
        else if (it < n1) s5carry_item(p, L, it - n0);
        else if (it < n2) mla_attn_item(p, it - n1, false, smem);
        else if (it < n3) na_attn_item(p, L, it - n2, false, smem);
        else if (it < n4) mla_attn_item(p, it - n3, true, smem);
        else na_attn_item(p, L, it - n4, true, smem);
      }
    } break;
    case LP_MIX2:
      seg(16 * S5_MT * 2, [&](int it) { s5c_tile(p, L, it, smem); });
      seg(NTOK / NWAVES, [&](int it) { m2gate_item(p, L, it); });
      break;
    case LP_GLU:
      seg(GLU_MT * 2, [&](int it) { glu_tile(p, L, it, smem); });
      break;
    case LP_MERGE:
      seg(mtiles(L.last, 256) * 16, [&](int it) { merge_tile(p, L, it, smem); });
      break;
    case LP_OUT:
      seg(mtiles(L.last, 256) * 4, [&](int it) { outproj_tile(p, L, it, smem); });
      break;
    case LP_POST:
      seg(CT_EXP, [&](int it) { conv_expert_item(p, l, it, smem); });
      post_stage_router(p, L, smem);
      seg(post_ntok(L.last) / NWAVES, [&](int it) { post_item(p, L, it, smem); });
      break;
    case LP_ROUTE:
      seg(BATCH * 16 * (L.last ? 1 : 2), [&](int it) { route_item(p, L, it, smem); });
      break;
    case LP_MOE1:
      seg(NE * (((L.last ? ESLOTS_L : ESLOTS) + 255) / 256) * 8, [&](int it) { moe1_tile(p, L, it, smem); });
      break;
    case LP_MOE2:
      seg(NE * (((L.last ? ESLOTS_L : ESLOTS) + 255) / 256) * 4, [&](int it) { moe2_tile(p, L, it, smem); });
      break;
    case LP_COMB:
      seg(post_ntok(L.last) / NWAVES, [&](int it) { comb_item(p, L, it); });
      break;
  }
}

__global__ void __launch_bounds__(NTHREADS, 2) mega_kernel(Params p) {
#ifdef EMU
  char* smem = emu_cur_f->blk->smem;
  for (int ph = p.phase_lo; ph < p.phase_hi; ++ph) {
    run_phase(p, ph, smem);
    if (ph + 1 < p.phase_hi) emu_grid_sync();
  }
#else
  __shared__ __attribute__((aligned(16))) char smem[SMEM_BYTES + 16 + 256];
  {
    const unsigned hw = (unsigned)__builtin_amdgcn_s_getreg((5 << 11) | 4) & 0x3fu;
    if ((threadIdx.x & 63) == 0) *(volatile int*)(smem + WAVE_TAB_OFF + hw * 4u) = (int)(threadIdx.x >> 6);
    __syncthreads();
  }
  if (p.phase_hi - p.phase_lo > 1) {
    if (threadIdx.x == 0) *(uint4*)(smem + SMEM_BYTES) = make_uint4(0u, 0u, 0u, 0u);
    __syncthreads();
    XcdBarrier xb = xcd_barrier_post((unsigned*)(p.ws + OFF_BAR), (volatile LAS unsigned*)(smem + SMEM_BYTES));
    for (int ph = p.phase_lo; ph < p.phase_hi; ++ph) {
      int reps = 1;
#ifdef PROBE_PHASE
      if (ph == PROBE_PHASE || ph == PROBE_PHASE2) reps = 1 + PROBE_REP;
#endif
      for (int rep = 0; rep < reps; ++rep) {
        p.probe_rep = rep;
        run_phase(p, ph, smem);
        if (ph + 1 < p.phase_hi || rep + 1 < reps) {
          if (ph == p.phase_lo && rep == 0) cg::this_grid().sync();
          else xcd_barrier(xb);
        }
      }
    }
  } else {
    run_phase(p, p.phase_lo, smem);
  }
#endif
}

#ifndef EMU
extern "C" void kernel_launch(void* const* d_in, const int* in_sizes, int n_in, void* d_out, int out_size, void* d_ws, size_t ws_size,
                              hipStream_t stream) {
  static int grid_blocks = 0;
  if (!grid_blocks) {
    int dev = 0, cus = 0, per_cu = 0;
    hipGetDevice(&dev);
    hipDeviceGetAttribute(&cus, hipDeviceAttributeMultiprocessorCount, dev);
    hipOccupancyMaxActiveBlocksPerMultiprocessor(&per_cu, mega_kernel, NTHREADS, 0);
    if (per_cu > 1) per_cu = 1;
    if (per_cu < 1) per_cu = 1;
    grid_blocks = cus * per_cu;
    if (ws_size < WS_TOTAL) fprintf(stderr, "workspace too small: %zu < %zu\n", ws_size, (size_t)WS_TOTAL);
  }
  Params p{};
  for (int i = 0; i < N_INPUTS; ++i) p.in[i] = (const float*)d_in[i];
  p.out = (float*)d_out;
  p.ws = (char*)d_ws;
#if MK_MULTI
  for (int ph = 0; ph < NPHASES; ++ph) {
    p.phase_lo = ph; p.phase_hi = ph + 1;
    hipLaunchKernelGGL(mega_kernel, dim3(grid_blocks), dim3(NTHREADS), 0, stream, p);
  }
#else
  p.phase_lo = 0; p.phase_hi = NPHASES;
  hipMemsetAsync((char*)d_ws + OFF_BAR, 0, BAR_BYTES, stream);
  void* args[] = {&p};
  hipError_t e = hipLaunchCooperativeKernel((void*)mega_kernel, dim3(grid_blocks), dim3(NTHREADS), args, 0, stream);
  if (e != hipSuccess) fprintf(stderr, "cooperative launch failed: %s (grid %d)\n", hipGetErrorString(e), grid_blocks);
#endif
}
#endif
```

```cpp
#ifdef EMU
#include "emu.h"
#else
#include <hip/hip_runtime.h>
#include <hip/hip_cooperative_groups.h>
#include <cstdio>
namespace cg = cooperative_groups;
using bf16x8 = __attribute__((ext_vector_type(8))) short;
using f32x4 = __attribute__((ext_vector_type(4))) float;
using f32x16 = __attribute__((ext_vector_type(16))) float;
#endif
using u32x4 = __attribute__((ext_vector_type(4))) unsigned;
#ifndef MK_MULTI
#define MK_MULTI 0
#endif

#define DI __device__ __forceinline__
typedef unsigned short bf16;

#ifdef EMU_SMALL2
constexpr int BATCH = 2, SEQ = 1024, CTXL = 64, GRID_W = 32;
#elif defined(EMU_SMALL)
constexpr int BATCH = 2, SEQ = 512, CTXL = 64, GRID_W = 32;
#else
constexpr int BATCH = 8, SEQ = 2048, CTXL = 256, GRID_W = 64;
#endif
constexpr int D = 1024, DEPTH = 2;
constexpr int TOK = CTXL + SEQ, NTOK = BATCH * TOK;
constexpr int ROWS = SEQ / GRID_W;
constexpr int WIN_R = (ROWS < 8 ? ROWS : 8), WIN_C = 16;
constexpr int N_IN = 6568, N_INP = 6656;
constexpr int C_CQ = 0, C_CKV = 256, C_KR = 384, C_NA = 416, C_S5 = 1184, C_Z = 1440, C_XBC = 1696, C_DT = 2464, C_GATE = 2472;
constexpr int P1W = 2480;
constexpr int NCH = TOK / 16, NCC = CTXL / 16, MCH = BATCH * NCH;
constexpr int NE = 16;
constexpr int CAP_L = 2 * SEQ / NE, CAP_C = 2 * CTXL / NE;
constexpr int ESLOTS = BATCH * (CAP_L + CAP_C), ESLOTS_L = BATCH * CAP_L;
constexpr int NB1 = BATCH + 1;
constexpr float EPS = 1e-6f;
constexpr int SMEM_BYTES = 147456;
constexpr int NTHREADS = 512, NWAVES = NTHREADS / 64;

enum { I_X = 0, I_C, I_CTX, I_CCTX, I_WADA, I_BADA, I_GPREMIX, I_GPOSTMIX, I_GPREFFN, I_GPOSTFFN, I_WIN, I_GCQ, I_GCKV, I_WUQ, I_WUKV, I_RPB,
       I_S5ARE, I_S5AIM, I_S5LOGSTEP, I_S5BRE, I_S5BIM, I_S5CRE, I_S5CIM, I_S5D, I_S5WGLU, I_S5BGLU, I_M2CONVW, I_M2CONVB, I_M2ALOG, I_M2DTBIAS,
       I_M2D, I_M2GNORM, I_WBRANCH, I_WOUT, I_WROUTER, I_WGATE, I_WUP, I_WDOWN, N_INPUTS };

constexpr size_t al256(size_t x) { return (x + 255) & ~(size_t)255; }
constexpr size_t SZ_X = (size_t)NTOK * D * 4;
constexpr size_t SZ_ROWBF = (size_t)NTOK * D * 2;
constexpr size_t OFF_X = 0;
constexpr size_t OFF_MOD = OFF_X + al256(SZ_X);
constexpr size_t OFF_HA = OFF_MOD + al256((size_t)DEPTH * NB1 * 6144 * 4);
constexpr size_t OFF_O = OFF_HA + al256(SZ_ROWBF);
constexpr size_t OFF_P1 = OFF_O + al256(SZ_ROWBF);
constexpr size_t SZ_P1 = (size_t)NTOK * P1W * 2;
constexpr size_t OFF_PG = OFF_P1 + al256(SZ_P1);
constexpr size_t SZ_PG = (size_t)NTOK * 4096 * 2;
constexpr size_t OFF_DT = OFF_PG + al256(SZ_PG);
constexpr size_t OFF_AFF = OFF_DT + al256((size_t)NTOK * 8 * 4);
constexpr size_t OFF_SEL = OFF_AFF + al256((size_t)NTOK * 16 * 4);
constexpr size_t OFF_IDX = OFF_SEL + al256((size_t)NTOK * 16 * 4);
constexpr size_t OFF_GW = OFF_IDX + al256((size_t)NE * ESLOTS * 4);
constexpr size_t OFF_BAR = OFF_GW + al256((size_t)NE * ESLOTS * 4);
constexpr size_t BAR_BYTES = (3456 + 64 * 4) * 4;
constexpr int Q_WORD0 = 3456;
constexpr size_t OFF_ROPE = OFF_BAR + al256(BAR_BYTES);
constexpr size_t OFF_WEARLY = OFF_ROPE + al256(64 * 8 * 2 * 4);
constexpr size_t WE_WIN = 0;
constexpr size_t WE_UQ = WE_WIN + (size_t)N_INP * 1024 * 2;
constexpr size_t WE_UKV = WE_UQ + (size_t)384 * 256 * 2;
constexpr size_t WE_GLU = WE_UKV + (size_t)512 * 128 * 2;
constexpr size_t WE_WB = WE_GLU + (size_t)256 * 256 * 2;
constexpr size_t WE_WOUT = WE_WB + (size_t)4 * 1024 * 256 * 2;
constexpr size_t WE_SIZE = al256(WE_WOUT + (size_t)1024 * 1024 * 2);
constexpr size_t OFF_S5TAB = OFF_WEARLY + DEPTH * WE_SIZE;
constexpr size_t S5_LAMPOW = 0;
constexpr size_t S5_BBAR = S5_LAMPOW + (size_t)2 * 16 * 17 * 64 * 2 * 4;
constexpr size_t S5_KT = S5_BBAR + (size_t)2 * 16 * 64 * 16 * 2 * 4;
constexpr size_t S5_WA = S5_KT + (size_t)2 * 16 * 16 * 256 * 4;
constexpr size_t S5_W2 = S5_WA + (size_t)16 * 256 * 256 * 2;
constexpr size_t S5_SIZE = al256(S5_W2 + (size_t)16 * 256 * 512 * 2);
constexpr size_t OFF_MIX = OFF_S5TAB + DEPTH * S5_SIZE;
constexpr size_t MX_Q = 0;
constexpr size_t MX_K = MX_Q + al256((size_t)BATCH * 4 * TOK * 96 * 2);
constexpr size_t MX_VTM = MX_K + al256((size_t)BATCH * 4 * TOK * 96 * 2);
constexpr size_t MX_VTN = MX_VTM + al256((size_t)BATCH * 4 * 64 * TOK * 2);
constexpr size_t MX_XBC = MX_VTN + al256((size_t)BATCH * 4 * 64 * TOK * 2);
constexpr size_t MX_US5 = MX_XBC + al256((size_t)NTOK * 768 * 2);
constexpr size_t MX_HEND = MX_US5 + al256((size_t)NTOK * 256 * 2);
constexpr size_t MX_HIN = MX_HEND + al256((size_t)16 * MCH * 256 * 4);
constexpr size_t MX_Z = MX_HIN + al256((size_t)16 * MCH * 256 * 2);
constexpr size_t MX_XBT = MX_Z + al256((size_t)NTOK * 256 * 2);
constexpr size_t MX_M2S = MX_XBT + al256((size_t)NTOK * 512 * 2);
constexpr size_t MX_SIZE = MX_M2S + al256((size_t)BATCH * 8 * TOK * 4 * 4);
constexpr size_t WX_GU = 0;
constexpr size_t WX_DN = WX_GU + (size_t)NE * 2048 * 1024 * 2;
constexpr size_t WX_SIZE = WX_DN + (size_t)NE * 1024 * 1024 * 2;
constexpr size_t MIXREG = (MX_SIZE > WX_SIZE ? MX_SIZE : WX_SIZE);
constexpr size_t WS_TOTAL = OFF_MIX + al256(MIXREG);

struct Params {
  const float* in[N_INPUTS];
  float* out;
  char* ws;
  int phase_lo, phase_hi;
  int probe_rep, pad_;
};

constexpr int WAVE_TAB_OFF = SMEM_BYTES + 16;
DI int tid_() {
#ifdef EMU
  return (int)threadIdx.x;
#else
  const unsigned hw = (unsigned)__builtin_amdgcn_s_getreg((5 << 11) | 4) & 0x3fu;
  const int wave = *(volatile __attribute__((address_space(3))) int*)(unsigned long)(WAVE_TAB_OFF + hw * 4u);
  int lane;
  asm volatile("v_mbcnt_lo_u32_b32 %0, -1, 0\n\tv_mbcnt_hi_u32_b32 %0, -1, %0" : "=v"(lane));
  return wave * 64 + lane;
#endif
}
#ifdef EMU
template <class T> DI T shfl_xor_(T v, int m) { return __shfl_xor(v, m); }
template <class T> DI T shfl_up_(T v, int d) { return __shfl_up(v, d); }
template <class T> DI T shfl_(T v, int src) { return __shfl(v, src); }
#else
template <class T> DI T shfl_xor_(T v, int m) {
  const int idx = ((tid_() & 63) ^ m) << 2;
  return __builtin_bit_cast(T, __builtin_amdgcn_ds_bpermute(idx, __builtin_bit_cast(int, v)));
}
template <class T> DI T shfl_up_(T v, int d) {
  const int l = tid_() & 63; const int idx = (l >= d ? l - d : l) << 2;
  return __builtin_bit_cast(T, __builtin_amdgcn_ds_bpermute(idx, __builtin_bit_cast(int, v)));
}
template <class T> DI T shfl_(T v, int src) {
  int idx = src << 2; asm volatile("" : "+v"(idx));
  return __builtin_bit_cast(T, __builtin_amdgcn_ds_bpermute(idx, __builtin_bit_cast(int, v)));
}
#endif
DI float bf2f(bf16 h) { return __uint_as_float(((unsigned)h) << 16); }
DI bf16 f2bf(float f) { unsigned u = __float_as_uint(f); u += 0x7fffu + ((u >> 16) & 1u); return (bf16)(u >> 16); }
#ifdef EMU
DI unsigned pack2(float a, float b) { return (unsigned)f2bf(a) | ((unsigned)f2bf(b) << 16); }
DI float exp2f_(float x) { return exp2f(x); }
#else
typedef float f32x2_t_ __attribute__((ext_vector_type(2)));
typedef __bf16 bf16x2_t_ __attribute__((ext_vector_type(2)));
DI unsigned pack2(float a, float b) { const f32x2_t_ v = {a, b}; return __builtin_bit_cast(unsigned, __builtin_convertvector(v, bf16x2_t_)); }
DI float exp2f_(float x) { return __builtin_amdgcn_exp2f(x); }
#endif
DI float sigmoidf_(float x) { return 1.0f / (1.0f + __expf(-x)); }
DI float siluf_(float x) { return x / (1.0f + __expf(-x)); }
DI float softplusf_(float x) { const float ax = x < 0.f ? -x : x; return (x > 0.f ? x : 0.f) + __logf(1.0f + __expf(-ax)); }
DI float geluf_(float x) { const float u2 = 1.5957691216057308f * (x + 0.044715f * x * x * x); return x / (1.0f + __expf(-u2)); }
DI bool wave_all_(bool c) {
#ifdef EMU
  int v = c ? 0 : 1;
  v += shfl_xor_(v, 32); v += shfl_xor_(v, 16); v += shfl_xor_(v, 8); v += shfl_xor_(v, 4); v += shfl_xor_(v, 2); v += shfl_xor_(v, 1);
  return v == 0;
#else
  return __builtin_amdgcn_ballot_w64(!c) == 0ull;
#endif
}
DI float wave_sum(float v) {
#ifdef EMU
  v += shfl_xor_(v, 32); v += shfl_xor_(v, 16); v += shfl_xor_(v, 8); v += shfl_xor_(v, 4); v += shfl_xor_(v, 2); v += shfl_xor_(v, 1);
  return v;
#else
  int x = __float_as_int(v);
  x = __float_as_int(__int_as_float(x) + __int_as_float(__builtin_amdgcn_update_dpp(0, x, 0xB1, 0xF, 0xF, true)));
  x = __float_as_int(__int_as_float(x) + __int_as_float(__builtin_amdgcn_update_dpp(0, x, 0x4E, 0xF, 0xF, true)));
  x = __float_as_int(__int_as_float(x) + __int_as_float(__builtin_amdgcn_update_dpp(0, x, 0x141, 0xF, 0xF, true)));
  x = __float_as_int(__int_as_float(x) + __int_as_float(__builtin_amdgcn_update_dpp(0, x, 0x140, 0xF, 0xF, true)));
  const float r0 = __int_as_float(__builtin_amdgcn_readlane(x, 0)), r1 = __int_as_float(__builtin_amdgcn_readlane(x, 16));
  const float r2 = __int_as_float(__builtin_amdgcn_readlane(x, 32)), r3 = __int_as_float(__builtin_amdgcn_readlane(x, 48));
  return (r0 + r1) + (r2 + r3);
#endif
}
#ifndef EMU
#define XB_TMO      128
#define XB_XCNT(j)  (256  + 64 * (j))
#define XB_XSUB(j)  (1280 + 64 * (j))
#define XB_XGEN(j)  (2304 + 64 * (j))
#define XB_TOP      3328
#define XB_TOPGEN   3392
#define XB_SPIN_CAP (1u << 24)
#define LAS __attribute__((address_space(3)))
DI unsigned xb_ld(unsigned* p) { return __hip_atomic_load(p, __ATOMIC_RELAXED, __HIP_MEMORY_SCOPE_AGENT); }
DI unsigned xb_add(unsigned* p, unsigned v) { return __hip_atomic_fetch_add(p, v, __ATOMIC_RELAXED, __HIP_MEMORY_SCOPE_AGENT); }
DI unsigned xb_xcc_id() { return (unsigned)__builtin_amdgcn_s_getreg((3 << 11) | 20) & 0xFu; }
#define XB_SPIN(cond, bar) do { unsigned _sp = 0; while (cond) { __builtin_amdgcn_s_sleep(1); \
    if ((++_sp & 255u) == 0u) { if (xb_ld(&(bar)[XB_TMO])) break; if (_sp > XB_SPIN_CAP) { atomicAdd(&(bar)[XB_TMO], 1u); break; } } } } while (0)
struct XcdBarrier { unsigned* bar; unsigned x; volatile LAS unsigned* st; };
DI XcdBarrier xcd_barrier_post(unsigned* bar, volatile LAS unsigned* st) {
  XcdBarrier b; b.bar = bar; b.x = xb_xcc_id(); b.st = st;
  if (threadIdx.x == 0) (void)xb_add(&bar[XB_XCNT(b.x)], 1u);
  return b;
}
DI void xcd_barrier_complete(unsigned* bar, unsigned x, unsigned& nloc, unsigned& nx) {
  const unsigned G = gridDim.x * gridDim.y * gridDim.z;
  unsigned sum, cnt, mine, sp = 0u;
  for (;;) {
    sum = 0u; cnt = 0u; mine = 0u;
#pragma unroll
    for (unsigned j = 0; j < 16; ++j) { const unsigned c = xb_ld(&bar[XB_XCNT(j)]); sum += c; cnt += (c > 0u) ? 1u : 0u; mine = (j == x) ? c : mine; }
    if (sum == G) break;
    __builtin_amdgcn_s_sleep(1);
    if ((++sp & 255u) == 0u) { if (xb_ld(&bar[XB_TMO])) break; if (sp > XB_SPIN_CAP) { atomicAdd(&bar[XB_TMO], 1u); break; } }
  }
  nloc = mine > 0u ? mine : 1u; nx = cnt > 0u ? cnt : 1u;
}
DI void xcd_barrier(const XcdBarrier& b) {
  asm volatile("s_waitcnt vmcnt(0)" ::: "memory");
  __syncthreads();
  if (threadIdx.x == 0) {
    unsigned* bar = b.bar;
    __builtin_amdgcn_s_waitcnt(0);
    unsigned nloc = b.st[0], nx = b.st[1];
    if (nloc == 0u) { xcd_barrier_complete(bar, b.x, nloc, nx); b.st[0] = nloc; b.st[1] = nx; }
    const unsigned old = xb_add(&bar[XB_XSUB(b.x)], 1u);
    const unsigned gen = old / nloc;
    if (old + 1u == (gen + 1u) * nloc) {
      __builtin_amdgcn_fence(__ATOMIC_RELEASE, "agent");
      asm volatile("s_waitcnt vmcnt(0)" ::: "memory");
      const unsigned og = xb_add(&bar[XB_TOP], 1u);
      const unsigned tg = og / nx;
      if (og + 1u == (tg + 1u) * nx) xb_add(&bar[XB_TOPGEN], 1u);
      else XB_SPIN(xb_ld(&bar[XB_TOPGEN]) == tg, bar);
      __builtin_amdgcn_fence(__ATOMIC_ACQUIRE, "agent");
      xb_add(&bar[XB_XGEN(b.x)], 1u);
      asm volatile("s_waitcnt vmcnt(0)" ::: "memory");
    } else {
      XB_SPIN(xb_ld(&bar[XB_XGEN(b.x)]) == gen, bar);
      __builtin_amdgcn_fence(__ATOMIC_ACQUIRE, "agent");
      asm volatile("s_waitcnt vmcnt(0)" ::: "memory");
    }
  }
  __syncthreads();
}
#endif

struct GA {
  const bf16* A; const bf16* A2; int lda, lda2, ksplit;
  const int* ridx; int mvalid;
  const bf16* Bt; int ldb; int K;
  int kfix;
};
DI GA make_ga(const bf16* A, int lda, const bf16* Bt, int ldb, int K, int mvalid) {
  GA g; g.A = A; g.A2 = A; g.lda = lda; g.lda2 = lda; g.ksplit = K; g.ridx = nullptr; g.mvalid = mvalid; g.Bt = Bt; g.ldb = ldb; g.K = K; g.kfix = 0; return g;
}

#ifdef EMU
#define GLDS16(gptr_, lptr_) memcpy((void*)(lptr_), (const void*)(gptr_), 16)
#define BGLDS16(rsrc_, base_, voff_, soff_, lptr_) memcpy((void*)(lptr_), (const char*)(base_) + (voff_) + (soff_), 16)
#define GEMM_WAIT(N_)
#define RAW_BARRIER() __syncthreads()
#else
#define LASV __attribute__((address_space(3))) void
#define GLDS16(gptr_, lptr_) __builtin_amdgcn_global_load_lds((const void*)(gptr_), (LASV*)(lptr_), 16, 0, 0)
#define BGLDS16(rsrc_, base_, voff_, soff_, lptr_) __builtin_amdgcn_raw_ptr_buffer_load_lds(rsrc_, (LASV*)(lptr_), 16, (int)(voff_), (int)(soff_), 0, 0)
#define GEMM_WAIT(N_) asm volatile("s_waitcnt vmcnt(%0)" :: "n"(N_) : "memory")
#define RAW_BARRIER() { asm volatile("" ::: "memory"); __builtin_amdgcn_s_barrier(); asm volatile("" ::: "memory"); }
#endif
DI int perm32(int rho) { const int n = rho >> 4, i = rho & 15; return 8 * (i >> 2) + 4 * n + (i & 3); }
constexpr int SRS_OFF = 73728;
template <int NT>
DI void gemm_s(const GA& g, int m0, int n0, char* smem, f32x4 (&acc)[4][NT]) {
  constexpr int A_ELEMS = 256 * 32, B_ELEMS = 32 * NT * 32, STAGE = A_ELEMS + B_ELEMS;
  bf16* st = (bf16*)smem;
  const int tid = tid_(), lane = tid & 63, wid = tid >> 6, wr = wid >> 1, wc = wid & 1, fr = lane & 15, fq = lane >> 4;
  const int lrow = tid >> 2, pch = tid & 3;
  long aoff[2], aoff2[2], boff;
#pragma unroll
  for (int i = 0; i < 2; ++i) {
    const int row = lrow + 128 * i;
    const int lch = pch ^ ((-(row >> 2)) & 3);
    int gm = m0 + row; if (gm > g.mvalid - 1) gm = g.mvalid - 1;
    const int ar = g.ridx ? g.ridx[gm] : gm;
    aoff[i] = (long)ar * g.lda + lch * 8;
    aoff2[i] = (long)ar * g.lda2 + lch * 8;
  }
  const int cb = (NT == 4) ? tid : (tid & 255);
  {
    const int row = cb >> 2;
    const int lch = pch ^ ((-(row >> 2)) & 3);
    const int src = n0 + (row & ~31) + perm32(row & 31);
    boff = (long)src * g.ldb + lch * 8;
  }
#pragma unroll
  for (int m = 0; m < 4; ++m)
#pragma unroll
    for (int n = 0; n < NT; ++n) acc[m][n] = f32x4{0.f, 0.f, 0.f, 0.f};
  const int T = g.K / 32;
#define GEMM_DMA(t_, stg_) { const int k0_ = (t_) * 32; const bool seg2_ = (k0_ >= g.ksplit); bf16* sa_ = st + (stg_) * STAGE; \
    _Pragma("unroll") for (int i_ = 0; i_ < 2; ++i_) { \
      const bf16* ap_ = seg2_ ? (g.A2 + aoff2[i_] + (k0_ - g.ksplit)) : (g.A + aoff[i_] + k0_); \
      GLDS16(ap_, sa_ + (tid + i_ * 512) * 8); } \
    GLDS16(g.Bt + boff + k0_, sa_ + A_ELEMS + cb * 8); }
  __syncthreads();
  GEMM_DMA(0, 0)
  if (T > 1) GEMM_DMA(1, 1)
  int s_cur = 0, s_nxt = 2;
#pragma unroll 1
  for (int t = 0; t < T; ++t) {
    if (t + 1 < T) { GEMM_WAIT(3); } else { GEMM_WAIT(0); }
    RAW_BARRIER();
    if (t + 2 < T) GEMM_DMA(t + 2, s_nxt)
    const bf16* sa = st + s_cur * STAGE;
    const bf16* sb = sa + A_ELEMS;
    bf16x8 af[4], bfr[NT];
#pragma unroll
    for (int n = 0; n < NT; ++n) {
      const int row = wc * (16 * NT) + n * 16 + fr;
      bfr[n] = *(const bf16x8*)(sb + row * 32 + ((fq ^ ((-(row >> 2)) & 3)) << 3));
    }
#pragma unroll
    for (int m = 0; m < 4; ++m) {
      const int row = wr * 64 + m * 16 + fr;
      af[m] = *(const bf16x8*)(sa + row * 32 + ((fq ^ ((-(row >> 2)) & 3)) << 3));
    }
#pragma unroll
    for (int m = 0; m < 4; ++m)
#pragma unroll
      for (int n = 0; n < NT; ++n) acc[m][n] = __builtin_amdgcn_mfma_f32_16x16x32_bf16(bfr[n], af[m], acc[m][n], 0, 0, 0);
    s_cur = (s_cur == 2) ? 0 : s_cur + 1;
    s_nxt = (s_nxt == 2) ? 0 : s_nxt + 1;
  }
}
constexpr int BG_HT = 128 * 64;
DI int lds_byte(int r, int c) { const int stt = (r >> 4) * 2 + (c >> 5), rr = r & 15, cc = c & 31, ob = rr * 64 + cc * 2; return stt * 1024 + (ob ^ (((ob >> 9) & 1) << 5)); }
DI void stage_rc(int b, int& R, int& C) { const int stt = b / 1024, sb = b % 1024, swz = sb ^ (((sb >> 9) & 1) << 5); R = (stt >> 1) * 16 + swz / 64; C = (stt & 1) * 32 + (swz % 64) / 2; }
#ifdef EMU
#define BG_WAIT_V(n)
#define BG_WAIT_L(n)
#define BG_BAR __syncthreads()
#define BG_SCHED
#define BG_PRIO(x)
#else
#define BG_WAIT_V(n) asm volatile("s_waitcnt vmcnt(" #n ")" ::: "memory")
#define BG_WAIT_L(n) asm volatile("s_waitcnt lgkmcnt(" #n ")" ::: "memory")
#define BG_BAR __builtin_amdgcn_s_barrier()
#define BG_SCHED __builtin_amdgcn_sched_barrier(0)
#define BG_PRIO(x) __builtin_amdgcn_s_setprio(x)
#endif
DI void gemm_big(const GA& g, int m0, int n0, char* smem, f32x4 (&acc)[2][2][4][2]) {
  bf16* shm = (bf16*)smem;
  const int tid = tid_(), wid = tid >> 6, lane = tid & 63, wr = wid >> 2, wc = wid & 3, fr = lane & 15, fq = lane >> 4;
  unsigned aof[2][2], bof[2];
#ifdef EMU
  const int dma_lds = tid * 16;
#else
  const int dma_lds = __builtin_amdgcn_readfirstlane(tid >> 6) * 1024;
#endif
#ifndef EMU
  const __amdgpu_buffer_rsrc_t rsA = __builtin_amdgcn_make_buffer_rsrc((void*)g.A, 0, 0x7fffffff, 0x00020000);
  const __amdgpu_buffer_rsrc_t rsB = __builtin_amdgcn_make_buffer_rsrc((void*)g.Bt, 0, 0x7fffffff, 0x00020000);
#endif
#pragma unroll
  for (int i = 0; i < 2; ++i) {
    int R, C; stage_rc(tid * 16 + i * 8192, R, C);
    bof[i] = (unsigned)((n0 + (R & ~31) + perm32(R & 31)) * g.ldb + C) * 2u;
#pragma unroll
    for (int h = 0; h < 2; ++h) {
      int gm = m0 + h * 128 + R; if (gm > g.mvalid - 1) gm = g.mvalid - 1;
      const int ar = g.ridx ? g.ridx[gm] : gm;
      aof[h][i] = (unsigned)(ar * g.lda + C) * 2u;
    }
  }
#define BG_SA(b, h) (shm + ((b) * 2 + (h)) * BG_HT)
#define BG_SB(b, h) (shm + (4 + (b) * 2 + (h)) * BG_HT)
#define BG_STAGE_A(P, h, kt) { \
    _Pragma("unroll") for (int i_ = 0; i_ < 2; ++i_) BGLDS16(rsA, g.A, aof[h][i_], (kt) * 128, (char*)(P) + dma_lds + i_ * 8192); }
#define BG_STAGE_B(P, h, kt) { \
    _Pragma("unroll") for (int i_ = 0; i_ < 2; ++i_) BGLDS16(rsB, g.Bt, bof[i_], (kt) * 128 + (h) * 256 * g.ldb, (char*)(P) + dma_lds + i_ * 8192); }
#define BG_LDA(dst, b, h) _Pragma("unroll") for (int m_ = 0; m_ < 4; ++m_) _Pragma("unroll") for (int k_ = 0; k_ < 2; ++k_) \
    dst[m_][k_] = *(const bf16x8*)((const char*)BG_SA(b, h) + lds_byte(wr * 64 + m_ * 16 + fr, k_ * 32 + fq * 8))
#define BG_LDB(dst, b, h) _Pragma("unroll") for (int n_ = 0; n_ < 2; ++n_) _Pragma("unroll") for (int k_ = 0; k_ < 2; ++k_) \
    dst[n_][k_] = *(const bf16x8*)((const char*)BG_SB(b, h) + lds_byte(wc * 32 + n_ * 16 + fr, k_ * 32 + fq * 8))
#define BG_MMA(ai, bj, At_, Bt_) { BG_PRIO(1); \
    _Pragma("unroll") for (int m_ = 0; m_ < 4; ++m_) _Pragma("unroll") for (int n_ = 0; n_ < 2; ++n_) _Pragma("unroll") for (int k_ = 0; k_ < 2; ++k_) \
      acc[ai][bj][m_][n_] = __builtin_amdgcn_mfma_f32_16x16x32_bf16(Bt_[n_][k_], At_[m_][k_], acc[ai][bj][m_][n_], 0, 0, 0); \
    BG_PRIO(0); }
#pragma unroll
  for (int a_ = 0; a_ < 2; ++a_)
#pragma unroll
    for (int b_ = 0; b_ < 2; ++b_)
#pragma unroll
      for (int m_ = 0; m_ < 4; ++m_)
#pragma unroll
        for (int n_ = 0; n_ < 2; ++n_) acc[a_][b_][m_][n_] = f32x4{0.f, 0.f, 0.f, 0.f};
  bf16x8 At[4][2], B0[2][2], B1[2][2];
  const int nt = g.K / 64;
  __syncthreads();
  BG_STAGE_B(BG_SB(0, 0), 0, 0) BG_STAGE_A(BG_SA(0, 0), 0, 0)
  BG_STAGE_B(BG_SB(0, 1), 1, 0) BG_STAGE_A(BG_SA(0, 1), 1, 0)
  if (wr == 1) BG_BAR;
  BG_WAIT_V(4); BG_BAR;
  BG_STAGE_B(BG_SB(1, 0), 0, 1) BG_STAGE_A(BG_SA(1, 0), 0, 1) BG_STAGE_B(BG_SB(1, 1), 1, 1)
  BG_WAIT_V(6); BG_BAR;
#pragma unroll 1
  for (int t = 0; t < nt - 2; t += 2) {
    BG_LDB(B0, 0, 0); BG_SCHED; BG_LDA(At, 0, 0); BG_STAGE_A(BG_SA(1, 1), 1, t + 1)
    BG_WAIT_L(8); BG_BAR; BG_WAIT_L(0); BG_MMA(0, 0, At, B0) BG_BAR; BG_SCHED;
    BG_LDB(B1, 0, 1); BG_STAGE_B(BG_SB(0, 0), 0, t + 2)
    BG_BAR; BG_WAIT_L(0); BG_MMA(0, 1, At, B1) BG_BAR;
    BG_LDA(At, 0, 1); BG_STAGE_A(BG_SA(0, 0), 0, t + 2)
    BG_BAR; BG_WAIT_L(0); BG_MMA(1, 0, At, B0) BG_BAR; BG_SCHED;
    BG_STAGE_B(BG_SB(0, 1), 1, t + 2)
    BG_WAIT_V(6); BG_BAR; BG_MMA(1, 1, At, B1) BG_BAR;
    BG_LDB(B0, 1, 0); BG_SCHED; BG_LDA(At, 1, 0); BG_STAGE_A(BG_SA(0, 1), 1, t + 2)
    BG_WAIT_L(8); BG_BAR; BG_WAIT_L(0); BG_MMA(0, 0, At, B0) BG_BAR; BG_SCHED;
    BG_LDB(B1, 1, 1); BG_STAGE_B(BG_SB(1, 0), 0, t + 3)
    BG_BAR; BG_WAIT_L(0); BG_MMA(0, 1, At, B1) BG_BAR;
    BG_LDA(At, 1, 1); BG_STAGE_A(BG_SA(1, 0), 0, t + 3)
    BG_BAR; BG_WAIT_L(0); BG_MMA(1, 0, At, B0) BG_BAR; BG_SCHED;
    BG_STAGE_B(BG_SB(1, 1), 1, t + 3)
    BG_WAIT_V(6); BG_BAR; BG_MMA(1, 1, At, B1) BG_BAR;
  }
  { BG_LDB(B0, 0, 0); BG_LDA(At, 0, 0); BG_STAGE_A(BG_SA(1, 1), 1, nt - 1)
    BG_BAR; BG_WAIT_L(0); BG_MMA(0, 0, At, B0) BG_BAR;
    BG_LDB(B1, 0, 1); BG_BAR; BG_WAIT_L(0); BG_MMA(0, 1, At, B1) BG_BAR;
    BG_LDA(At, 0, 1); BG_WAIT_V(4); BG_BAR; BG_WAIT_L(0); BG_MMA(1, 0, At, B0) BG_MMA(1, 1, At, B1) BG_BAR; }
  { BG_LDB(B0, 1, 0); BG_LDA(At, 1, 0); BG_WAIT_V(2); BG_BAR; BG_WAIT_L(0); BG_MMA(0, 0, At, B0) BG_BAR;
    BG_LDB(B1, 1, 1); BG_WAIT_V(0); BG_BAR; BG_WAIT_L(0); BG_MMA(0, 1, At, B1) BG_BAR;
    BG_LDA(At, 1, 1); BG_BAR; BG_WAIT_L(0); BG_MMA(1, 0, At, B0) BG_MMA(1, 1, At, B1) BG_BAR; }
  if (wr == 0) BG_BAR;
}
#define EPIB_BEGIN(acc_, m0_, n0_, mvalid_) { const int _l = tid_() & 63, _w = tid_() >> 6, _wr = _w >> 2, _wc = _w & 3, _fr = _l & 15, _fq = _l >> 4; \
  _Pragma("unroll") for (int _ai = 0; _ai < 2; ++_ai) _Pragma("unroll") for (int _m = 0; _m < 4; ++_m) { const int row = (m0_) + _ai * 128 + _wr * 64 + _m * 16 + _fr; \
  _Pragma("unroll") for (int _bj = 0; _bj < 2; ++_bj) { const int col = (n0_) + _bj * 128 + _wc * 32 + 8 * _fq; (void)col; \
    float v[8] = {acc_[_ai][_bj][_m][0][0], acc_[_ai][_bj][_m][0][1], acc_[_ai][_bj][_m][0][2], acc_[_ai][_bj][_m][0][3], \
                  acc_[_ai][_bj][_m][1][0], acc_[_ai][_bj][_m][1][1], acc_[_ai][_bj][_m][1][2], acc_[_ai][_bj][_m][1][3]}; \
    if (row < (mvalid_)) {
#define EPIB_END }}}}

DI void ld8bf(const bf16* p, float (&v)[8]) {
  uint4 w = *(const uint4*)p;
  v[0] = __uint_as_float(w.x << 16); v[1] = __uint_as_float(w.x & 0xffff0000u); v[2] = __uint_as_float(w.y << 16); v[3] = __uint_as_float(w.y & 0xffff0000u);
  v[4] = __uint_as_float(w.z << 16); v[5] = __uint_as_float(w.z & 0xffff0000u); v[6] = __uint_as_float(w.w << 16); v[7] = __uint_as_float(w.w & 0xffff0000u);
}
DI void st8bf(bf16* p, const float (&v)[8]) { *(uint4*)p = make_uint4(pack2(v[0], v[1]), pack2(v[2], v[3]), pack2(v[4], v[5]), pack2(v[6], v[7])); }
DI void st8f(float* p, const float (&v)[8]) { *(float4*)p = make_float4(v[0], v[1], v[2], v[3]); *(float4*)(p + 4) = make_float4(v[4], v[5], v[6], v[7]); }
#define EPI_BEGIN(NT_, acc_, m0_, n0_, mvalid_) { const int _l = tid_() & 63, _w = tid_() >> 6, _wr = _w >> 1, _wc = _w & 1, _fr = _l & 15, _fq = _l >> 4; \
  _Pragma("unroll") for (int _m = 0; _m < 4; ++_m) { const int row = (m0_) + _wr * 64 + _m * 16 + _fr; \
  _Pragma("unroll") for (int _q = 0; _q < (NT_) / 2; ++_q) { const int col = (n0_) + _wc * (16 * (NT_)) + _q * 32 + 8 * _fq; (void)col; \
    float v[8] = {acc_[_m][2 * _q][0], acc_[_m][2 * _q][1], acc_[_m][2 * _q][2], acc_[_m][2 * _q][3], \
                  acc_[_m][2 * _q + 1][0], acc_[_m][2 * _q + 1][1], acc_[_m][2 * _q + 1][2], acc_[_m][2 * _q + 1][3]}; \
    if (row < (mvalid_)) {
#define EPI_END }}}}

DI int mtile_row0(int mt, bool latonly, int TH) {
  if (!latonly) return mt * TH;
  const int per = SEQ / TH, b = mt / per, r = mt % per;
  return b * TOK + CTXL + r * TH;
}
DI int mtiles(bool latonly, int TH) { return latonly ? BATCH * (SEQ / TH) : (NTOK + TH - 1) / TH; }

struct LP {
  int l; bool last;
  const float* mod;
  char* we;
  char* s5;
};
DI LP make_lp(const Params& p, int l) {
  LP q; q.l = l; q.last = (l == DEPTH - 1);
  q.mod = (const float*)(p.ws + OFF_MOD) + (size_t)l * NB1 * 6144;
  q.we = p.ws + OFF_WEARLY + (size_t)l * WE_SIZE;
  q.s5 = p.ws + OFF_S5TAB + (size_t)l * S5_SIZE;
  return q;
}

template <class RowMap>
DI void conv_tile(const float* src, int lds, int nsrc, const float* kscale, bf16* dst, int K, int k0, int n0, char* smem, RowMap rowmap, int ndst = 1 << 30) {
  (void)smem;
  const int tid = tid_(), n4 = (tid & 63) * 4, k8 = (tid >> 6) * 8;
  float4 v[8];
  const bool ok = (n0 + n4 < nsrc);
  const float* sp = src + (size_t)(k0 + k8) * lds + n0 + n4;
#pragma unroll
  for (int k = 0; k < 8; ++k) v[k] = ok ? *(const float4*)(sp + (size_t)k * lds) : make_float4(0.f, 0.f, 0.f, 0.f);
  if (kscale) {
#pragma unroll
    for (int k = 0; k < 8; ++k) { const float sc = kscale[k0 + k8 + k]; v[k].x *= sc; v[k].y *= sc; v[k].z *= sc; v[k].w *= sc; }
  }
  float o[8];
#pragma unroll
  for (int k = 0; k < 8; ++k) o[k] = v[k].x;
  if (n0 + n4 + 0 < ndst) st8bf(dst + (size_t)rowmap(n0 + n4 + 0) * K + k0 + k8, o);
#pragma unroll
  for (int k = 0; k < 8; ++k) o[k] = v[k].y;
  if (n0 + n4 + 1 < ndst) st8bf(dst + (size_t)rowmap(n0 + n4 + 1) * K + k0 + k8, o);
#pragma unroll
  for (int k = 0; k < 8; ++k) o[k] = v[k].z;
  if (n0 + n4 + 2 < ndst) st8bf(dst + (size_t)rowmap(n0 + n4 + 2) * K + k0 + k8, o);
#pragma unroll
  for (int k = 0; k < 8; ++k) o[k] = v[k].w;
  if (n0 + n4 + 3 < ndst) st8bf(dst + (size_t)rowmap(n0 + n4 + 3) * K + k0 + k8, o);
}
struct RowId { DI int operator()(int n) const { return n; } };
struct RowGU { int half; DI int operator()(int f) const { return (f >> 7) * 256 + half * 128 + (f & 127); } };

constexpr int CT_WIN = 16 * (N_INP / 256), CT_UQ = 4 * 2, CT_UKV = 2 * 2, CT_GLU = 4, CT_WB = 4 * 16, CT_WOUT = 64;
constexpr int CT_EARLY = CT_WIN + CT_UQ + CT_UKV + CT_GLU + CT_WB + CT_WOUT;
constexpr int CT_EXP = NE * 3 * 64;

DI void conv_early_item(const Params& p, int l, int it, char* smem) {
  char* we = p.ws + OFF_WEARLY + (size_t)l * WE_SIZE;
  if (it < CT_WIN) {
    int kt = it % 16, nt = it / 16;
    conv_tile(p.in[I_WIN] + (size_t)l * 1024 * N_IN, N_IN, N_IN, nullptr, (bf16*)(we + WE_WIN), 1024, kt * 64, nt * 256, smem, RowId());
    return;
  }
  it -= CT_WIN;
  if (it < CT_UQ) {
    int kt = it % 4, nt = it / 4;
    conv_tile(p.in[I_WUQ] + (size_t)l * 256 * 384, 384, 384, p.in[I_GCQ] + l * 256, (bf16*)(we + WE_UQ), 256, kt * 64, nt * 256, smem, RowId(), 384);
    return;
  }
  it -= CT_UQ;
  if (it < CT_UKV) {
    int kt = it % 2, nt = it / 2;
    conv_tile(p.in[I_WUKV] + (size_t)l * 128 * 512, 512, 512, p.in[I_GCKV] + l * 128, (bf16*)(we + WE_UKV), 128, kt * 64, nt * 256, smem, RowId());
    return;
  }
  it -= CT_UKV;
  if (it < CT_GLU) {
    int kt = it;
    conv_tile(p.in[I_S5WGLU] + (size_t)l * 256 * 256, 256, 256, nullptr, (bf16*)(we + WE_GLU), 256, kt * 64, 0, smem, RowId());
    return;
  }
  it -= CT_GLU;
  if (it < CT_WB) {
    int j = it / 16, r = it % 16, kt = r % 4, nt = r / 4;
    conv_tile(p.in[I_WBRANCH] + ((size_t)l * 4 + j) * 256 * 1024, 1024, 1024, nullptr, (bf16*)(we + WE_WB) + (size_t)j * 1024 * 256, 256, kt * 64, nt * 256, smem, RowId());
    return;
  }
  it -= CT_WB;
  {
    int kt = it % 16, nt = it / 16;
    conv_tile(p.in[I_WOUT] + (size_t)l * 1024 * 1024, 1024, 1024, nullptr, (bf16*)(we + WE_WOUT), 1024, kt * 64, nt * 256, smem, RowId());
  }
}
DI void conv_expert_item(const Params& p, int l, int it, char* smem) {
  char* wx = p.ws + OFF_MIX;
  int e = it / 192, r = it % 192, which = r / 64, t = r % 64, kt = t % 16, nt = t / 16;
  size_t eoff = ((size_t)l * NE + e) * 1024 * 1024;
  if (which == 0) { RowGU rm; rm.half = 0; conv_tile(p.in[I_WGATE] + eoff, 1024, 1024, nullptr, (bf16*)(wx + WX_GU) + (size_t)e * 2048 * 1024, 1024, kt * 64, nt * 256, smem, rm); }
  else if (which == 1) { RowGU rm; rm.half = 1; conv_tile(p.in[I_WUP] + eoff, 1024, 1024, nullptr, (bf16*)(wx + WX_GU) + (size_t)e * 2048 * 1024, 1024, kt * 64, nt * 256, smem, rm); }
  else conv_tile(p.in[I_WDOWN] + eoff, 1024, 1024, nullptr, (bf16*)(wx + WX_DN) + (size_t)e * 1024 * 1024, 1024, kt * 64, nt * 256, smem, RowId());
}

DI void mod_item(const Params& p, int it, char* smem) {
  const int l = it / 96, cg0 = (it % 96) * 64;
  float* sc = (float*)smem;
  float* red = sc + NB1 * 1024;
  const int tid = tid_();
  __syncthreads();
  for (int i = tid; i < NB1 * 1024; i += NTHREADS) {
    int r = i >> 10, k = i & 1023;
    float c = (r < BATCH) ? p.in[I_C][r * 1024 + k] : p.in[I_CCTX][k];
    sc[i] = siluf_(c);
  }
  __syncthreads();
  const int cl = tid & 63, kg = tid >> 6;
  float acc[NB1];
#pragma unroll
  for (int r = 0; r < NB1; ++r) acc[r] = 0.f;
  const float* w = p.in[I_WADA] + (size_t)l * 1024 * 6144 + cg0 + cl;
  for (int k = kg * (1024 / NWAVES); k < (kg + 1) * (1024 / NWAVES); ++k) {
    float wv = w[(size_t)k * 6144];
#pragma unroll
    for (int r = 0; r < NB1; ++r) acc[r] += sc[r * 1024 + k] * wv;
  }
#pragma unroll
  for (int r = 0; r < NB1; ++r) red[(kg * NB1 + r) * 64 + cl] = acc[r];
  __syncthreads();
  for (int i = tid; i < NB1 * 64; i += NTHREADS) {
    int r = i >> 6, c = i & 63;
    float s = 0.f;
#pragma unroll
    for (int q = 0; q < NWAVES; ++q) s += red[(q * NB1 + r) * 64 + c];
    s += p.in[I_BADA][l * 6144 + cg0 + c];
    ((float*)(p.ws + OFF_MOD))[((size_t)l * NB1 + r) * 6144 + cg0 + c] = s;
  }
}

DI void s5_tab_item(const Params& p, int it, char* smem) {
  const int l = it / 32, d = (it / 16) & 1, g = it & 15;
  char* s5 = p.ws + OFF_S5TAB + (size_t)l * S5_SIZE;
  float* lampow = (float*)(s5 + S5_LAMPOW) + (size_t)(d * 16 + g) * 17 * 64 * 2;
  float* bbar = (float*)(s5 + S5_BBAR) + (size_t)(d * 16 + g) * 64 * 16 * 2;
  float* kt = (float*)(s5 + S5_KT) + (size_t)(d * 16 + g) * 16 * 256;
  float* slam = (float*)smem;
  float* sbb = slam + 17 * 64 * 2;
  const int tid = tid_();
  const size_t pg = ((size_t)(l * 2 + d) * 16 + g);
  const float step = expf(p.in[I_S5LOGSTEP][pg]);
  __syncthreads();
  for (int i = tid; i < 17 * 64; i += NTHREADS) {
    int j = i >> 6, pp = i & 63;
    float are = p.in[I_S5ARE][pg * 64 + pp], aim = p.in[I_S5AIM][pg * 64 + pp];
    float mag = expf((float)j * step * are), ang = (float)j * step * aim;
    float re = mag * cosf(ang), im = mag * sinf(ang);
    slam[i * 2] = re; slam[i * 2 + 1] = im; lampow[i * 2] = re; lampow[i * 2 + 1] = im;
  }
  __syncthreads();
  for (int i = tid; i < 64 * 16; i += NTHREADS) {
    int pp = i >> 4;
    float are = p.in[I_S5ARE][pg * 64 + pp], aim = p.in[I_S5AIM][pg * 64 + pp];
    float x = slam[(64 + pp) * 2] - 1.0f, y = slam[(64 + pp) * 2 + 1];
    float den = are * are + aim * aim;
    float qre = (x * are + y * aim) / den, qim = (y * are - x * aim) / den;
    float bre = p.in[I_S5BRE][pg * 1024 + i], bim = p.in[I_S5BIM][pg * 1024 + i];
    float re = qre * bre - qim * bim, im = qre * bim + qim * bre;
    sbb[i * 2] = re; sbb[i * 2 + 1] = im; bbar[i * 2] = re; bbar[i * 2 + 1] = im;
  }
  __syncthreads();
  for (int i = tid; i < 16 * 256; i += NTHREADS) {
    int j = i >> 8, c = (i >> 4) & 15, c2 = i & 15;
    float s = 0.f;
    for (int pp = 0; pp < 64; ++pp) {
      float cre = p.in[I_S5CRE][pg * 1024 + c * 64 + pp], cim = p.in[I_S5CIM][pg * 1024 + c * 64 + pp];
      float lre = slam[(j * 64 + pp) * 2], lim = slam[(j * 64 + pp) * 2 + 1];
      float tre = cre * lre - cim * lim, tim = cre * lim + cim * lre;
      float bre = sbb[(pp * 16 + c2) * 2], bim = sbb[(pp * 16 + c2) * 2 + 1];
      s += tre * bre - tim * bim;
    }
    kt[i] = s;
  }
}
DI void s5_mat_item(const Params& p, int it) {
  const int l = it / 64, g = (it / 4) & 15, q = it & 3;
  char* s5 = p.ws + OFF_S5TAB + (size_t)l * S5_SIZE;
  const float* lampow = (const float*)(s5 + S5_LAMPOW);
  const float* bbar = (const float*)(s5 + S5_BBAR);
  const float* ktab = (const float*)(s5 + S5_KT);
  bf16* WA = (bf16*)(s5 + S5_WA) + (size_t)g * 256 * 256;
  bf16* W2 = (bf16*)(s5 + S5_W2) + (size_t)g * 256 * 512;
  const int tid = tid_();
  for (int i = tid; i < 64 * 256; i += NTHREADS) {
    int n = q * 64 + (i >> 8), k = i & 255;
    int d = n >> 7, ri = (n >> 6) & 1, pp = n & 63, s = k >> 4, c2 = k & 15;
    int e = (d == 0) ? (15 - s) : s;
    const float* lp = lampow + ((size_t)((d * 16 + g) * 17 + e) * 64 + pp) * 2;
    const float* bp = bbar + ((size_t)((d * 16 + g) * 64 + pp) * 16 + c2) * 2;
    float re = lp[0] * bp[0] - lp[1] * bp[1], im = lp[0] * bp[1] + lp[1] * bp[0];
    WA[(size_t)n * 256 + k] = f2bf(ri == 0 ? re : im);
  }
  for (int i = tid; i < 64 * 512; i += NTHREADS) {
    int n = q * 64 + (i >> 9), k = i & 511;
    int lq = n >> 4, c = n & 15;
    float v;
    if (k < 256) {
      int s = k >> 4, c2 = k & 15;
      v = 0.f;
      if (s <= lq) v += ktab[((size_t)(0 * 16 + g) * 16 + (lq - s)) * 256 + c * 16 + c2];
      if (s >= lq) v += ktab[((size_t)(1 * 16 + g) * 16 + (s - lq)) * 256 + c * 16 + c2];
      if (s == lq && c == c2) v += p.in[I_S5D][l * 256 + g * 16 + c];
    } else {
      int kk = k - 256, d = kk >> 7, ri = (kk >> 6) & 1, pp = kk & 63;
      int e = (d == 0) ? (lq + 1) : (16 - lq);
      size_t pg = ((size_t)(l * 2 + d) * 16 + g);
      float cre = p.in[I_S5CRE][pg * 1024 + c * 64 + pp], cim = p.in[I_S5CIM][pg * 1024 + c * 64 + pp];
      const float* lp = lampow + ((size_t)((d * 16 + g) * 17 + e) * 64 + pp) * 2;
      float re = cre * lp[0] - cim * lp[1], im = cre * lp[1] + cim * lp[0];
      v = (ri == 0) ? re : -im;
    }
    W2[(size_t)n * 512 + k] = f2bf(v);
  }
}

DI int tok_b(int tok) { return tok / TOK; }
DI int tok_j(int tok) { return tok % TOK; }
DI int tok_modrow(int tok) { return (tok_j(tok) < CTXL) ? BATCH : tok_b(tok); }

DI void normmod_row(const float (&xv)[16], const float* g, const float* shift, const float* scale, bf16* dst, float (&hout)[16]) {
  const int lane = tid_() & 63;
  float ss = 0.f;
#pragma unroll
  for (int i = 0; i < 16; ++i) ss += xv[i] * xv[i];
  ss = wave_sum(ss);
  const float rs = rsqrtf(ss * (1.0f / 1024.f) + EPS);
#pragma unroll
  for (int i = 0; i < 4; ++i) {
    int c = lane * 4 + i * 256;
    float4 gv = *(const float4*)(g + c), sh = *(const float4*)(shift + c), sc = *(const float4*)(scale + c);
    float h0 = xv[i * 4 + 0] * rs * gv.x * (1.f + sc.x) + sh.x;
    float h1 = xv[i * 4 + 1] * rs * gv.y * (1.f + sc.y) + sh.y;
    float h2 = xv[i * 4 + 2] * rs * gv.z * (1.f + sc.z) + sh.z;
    float h3 = xv[i * 4 + 3] * rs * gv.w * (1.f + sc.w) + sh.w;
    hout[i * 4 + 0] = h0; hout[i * 4 + 1] = h1; hout[i * 4 + 2] = h2; hout[i * 4 + 3] = h3;
    *(uint2*)(dst + c) = make_uint2(pack2(h0, h1), pack2(h2, h3));
  }
}

DI void prep_row_item(const Params& p, int it) {
  const int tok = it * NWAVES + (tid_() >> 6), lane = tid_() & 63;
  const int b = tok_b(tok), j = tok_j(tok);
  const float* src = (j < CTXL) ? p.in[I_CTX] + ((size_t)b * CTXL + j) * 1024 : p.in[I_X] + ((size_t)b * SEQ + (j - CTXL)) * 1024;
  float* X = (float*)(p.ws + OFF_X) + (size_t)tok * 1024;
  float xv[16], h[16];
#pragma unroll
  for (int i = 0; i < 4; ++i) {
    float4 v = *(const float4*)(src + lane * 4 + i * 256);
    *(float4*)(X + lane * 4 + i * 256) = v;
    xv[i * 4] = v.x; xv[i * 4 + 1] = v.y; xv[i * 4 + 2] = v.z; xv[i * 4 + 3] = v.w;
  }
  const float* mod = (const float*)(p.ws + OFF_MOD) + (size_t)tok_modrow(tok) * 6144;
  normmod_row(xv, p.in[I_GPREMIX], mod + 0, mod + 1024, (bf16*)(p.ws + OFF_HA) + (size_t)tok * 1024, h);
}

constexpr int IP_LT = BATCH * (SEQ / 256), IP_CT = BATCH * ((CTXL + 255) / 256), IP_MT = IP_LT + IP_CT, IP_NT = N_INP / 256;
constexpr int IP_RR = (IP_MT + 7) / 8, IP_RC = (IP_NT + 1) / 2;
constexpr int IP_RC_NOGATE = (((C_GATE + 255) / 256) + 1) / 2;
constexpr int IP_RR_LAT = IP_LT / 8;
constexpr bool IP_COMPACT = (IP_LT % 8 == 0);
constexpr int IP_RECTS_ALL = IP_RR * IP_RC, IP_RECTS_LAST = IP_COMPACT ? (IP_RR * IP_RC_NOGATE + IP_RR_LAT * (IP_RC - IP_RC_NOGATE)) : IP_RECTS_ALL;
constexpr int IP_SLOTS_ALL = ((IP_RECTS_ALL + 15) / 16) * 256, IP_SLOTS_LAST = ((IP_RECTS_LAST + 15) / 16) * 256;
DI void inproj_tile(const Params& p, const LP& L, int t, char* smem) {
  const int vb = t % 256, vround = t / 256, x = vb % 8, j = vb / 8;
  const int Rc = vround * 16 + x * 2 + (j >> 4), jj = j & 15;
  int rm, rn;
  if (!L.last || !IP_COMPACT || Rc < IP_RR * IP_RC_NOGATE) { rm = Rc % IP_RR; rn = Rc / IP_RR; }
  else { const int q = Rc - IP_RR * IP_RC_NOGATE; rm = q % IP_RR_LAT; rn = IP_RC_NOGATE + q / IP_RR_LAT; }
  const int mt = rm * 8 + (jj & 7), nt = rn * 2 + (jj >> 3);
  if (mt >= IP_MT || nt >= IP_NT || rn >= IP_RC) return;
  int m0;
  if (mt < IP_LT) m0 = (mt / (SEQ / 256)) * TOK + CTXL + (mt % (SEQ / 256)) * 256;
  else { const int c = mt - IP_LT; m0 = (c / ((CTXL + 255) / 256)) * TOK + (c % ((CTXL + 255) / 256)) * 256; }
  const int n0 = nt * 256;
  const int mv = (mt < IP_LT) ? NTOK : (m0 - (m0 % TOK) + CTXL);
  if (L.last && mt >= IP_LT && n0 >= ((C_GATE + 255) / 256) * 256) return;
  GA g = make_ga((const bf16*)(p.ws + OFF_HA), 1024, (const bf16*)(L.we + WE_WIN), 1024, 1024, mv);
  f32x4 acc[2][2][4][2];
  gemm_big(g, m0, n0, smem, acc);
  bf16* P1 = (bf16*)(p.ws + OFF_P1);
  bf16* PG = (bf16*)(p.ws + OFF_PG);
  bf16* US5 = (bf16*)(p.ws + OFF_MIX + MX_US5);
  float* DT = (float*)(p.ws + OFF_DT);
  const float* dtb = p.in[I_M2DTBIAS] + L.l * 8;
  EPIB_BEGIN(acc, m0, n0, mv)
    if (col < C_S5 || (col >= C_Z && col < C_DT)) st8bf(P1 + (size_t)row * P1W + col, v);
    else if (col < C_Z) st8bf(US5 + ((size_t)((col - C_S5) >> 4) * NTOK + row) * 16 + (col & 15), v);
    else if (col < C_GATE) {
#pragma unroll
      for (int k = 0; k < 8; ++k) v[k] = softplusf_(v[k] + dtb[k]);
      st8f(DT + (size_t)row * 8, v);
    } else if (col < N_IN) {
#pragma unroll
      for (int k = 0; k < 8; ++k) v[k] = sigmoidf_(v[k]);
      st8bf(PG + (size_t)row * 4096 + (col - C_GATE), v);
    }
  EPIB_END
}

DI void rowscale_256(const bf16* P1, int m0, int c0, int width, float* srs) {
  const int r = tid_() >> 1, hf = tid_() & 1;
  int gr = m0 + r; if (gr > NTOK - 1) gr = NTOK - 1;
  const bf16* src = P1 + (size_t)gr * P1W + c0 + hf * (width / 2);
  float ss = 0.f;
  for (int i = 0; i < width / 2; i += 8) {
    float v[8]; ld8bf(src + i, v);
#pragma unroll
    for (int k = 0; k < 8; ++k) ss += v[k] * v[k];
  }
  ss += shfl_xor_(ss, 1);
  if (hf == 0) srs[r] = rsqrtf(ss / (float)width + EPS);
}
DI void rope_tab_item(const Params& p) {
  float* tab = (float*)(p.ws + OFF_ROPE);
  for (int i = tid_(); i < 64 * 8; i += NTHREADS) {
    int pos = i >> 3, k = i & 7;
    float f = expf(-(float)k * (9.210340371976184f / 8.0f));
    float a = (float)pos * f;
    tab[i * 2] = cosf(a); tab[i * 2 + 1] = sinf(a);
  }
}
DI void rope_cs(const float* tab, int pos, int i, float& c, float& s) { c = tab[(pos * 8 + i) * 2]; s = tab[(pos * 8 + i) * 2 + 1]; }

constexpr int TP_MT = (NTOK + 255) / 256;
DI void mlaq_tile(const Params& p, const LP& L, int t, char* smem) {
  const int mt = t % TP_MT, nt = t / TP_MT, m0 = mt * 256, n0 = nt * 128;
  const bf16* P1 = (const bf16*)(p.ws + OFF_P1);
  float* srs = (float*)(smem + SRS_OFF);
  GA g = make_ga(P1 + C_CQ, P1W, (const bf16*)(L.we + WE_UQ), 256, 256, NTOK);
  f32x4 acc[4][4];
  gemm_s<4>(g, m0, n0, smem, acc);
  rowscale_256(P1, m0, C_CQ, 256, srs);
  __syncthreads();
  bf16* Q = (bf16*)(p.ws + OFF_MIX + MX_Q);
  const float* ropetab = (const float*)(p.ws + OFF_ROPE);
  {
    const int l = tid_() & 63, w = tid_() >> 6, wr = w >> 1, wc = w & 1, fr = l & 15, fq = l >> 4;
#pragma unroll
    for (int m = 0; m < 4; ++m) {
      const int row = m0 + wr * 64 + m * 16 + fr;
      const int rowc = row < NTOK ? row : NTOK - 1;
      const float rsc = srs[rowc - m0];
      const int b = tok_b(rowc), j = tok_j(rowc);
#pragma unroll
      for (int q = 0; q < 2; ++q) {
        const int col = n0 + wc * 64 + q * 32 + 8 * fq;
        const int h = col / 96, dd = col % 96;
        float v[8] = {acc[m][2 * q][0], acc[m][2 * q][1], acc[m][2 * q][2], acc[m][2 * q][3], acc[m][2 * q + 1][0], acc[m][2 * q + 1][1], acc[m][2 * q + 1][2], acc[m][2 * q + 1][3]};
        float vp[8];
#pragma unroll
        for (int k = 0; k < 8; ++k) vp[k] = shfl_xor_(v[k], 16);
        if (dd >= 64 && j >= CTXL) {
          const int tl = j - CTXL, pos = ((dd - 64) < 16) ? (tl / GRID_W) : (tl % GRID_W);
          const bool lo = ((dd & 8) == 0);
#pragma unroll
          for (int k = 0; k < 8; ++k) {
            float c, sn; rope_cs(ropetab, pos, k, c, sn);
            v[k] = lo ? (v[k] * c - vp[k] * sn) : (v[k] * c + vp[k] * sn);
          }
        }
#pragma unroll
        for (int k = 0; k < 8; ++k) v[k] *= rsc;
        if (row < NTOK) st8bf(Q + (((size_t)b * 4 + h) * TOK + j) * 96 + dd, v);
      }
    }
  }
}
DI void mlakv_tile(const Params& p, const LP& L, int t, char* smem) {
  const int mt = t % TP_MT, h = t / TP_MT, m0 = mt * 256, n0 = h * 128;
  const bf16* P1 = (const bf16*)(p.ws + OFF_P1);
  float* srs = (float*)(smem + SRS_OFF);
  GA g = make_ga(P1 + C_CKV, P1W, (const bf16*)(L.we + WE_UKV), 128, 128, NTOK);
  f32x4 acc[4][4];
  gemm_s<4>(g, m0, n0, smem, acc);
  rowscale_256(P1, m0, C_CKV, 128, srs);
  __syncthreads();
  bf16* K = (bf16*)(p.ws + OFF_MIX + MX_K);
  bf16* VT = (bf16*)(p.ws + OFF_MIX + MX_VTM);
  const float* ropetab = (const float*)(p.ws + OFF_ROPE);
  EPI_BEGIN(4, acc, m0, n0, NTOK)
    const float rsc = srs[row - m0];
    const int b = tok_b(row), j = tok_j(row), dd = col - n0;
#pragma unroll
    for (int k = 0; k < 8; ++k) v[k] *= rsc;
    if (dd < 64) st8bf(K + (((size_t)b * 4 + h) * TOK + j) * 96 + dd, v);
    else {
#pragma unroll
      for (int k = 0; k < 8; ++k) VT[(((size_t)b * 4 + h) * 64 + (dd - 64 + k)) * TOK + j] = f2bf(v[k]);
    }
  EPI_END
  for (int i = tid_(); i < 256 * 16; i += NTHREADS) {
    int r = i >> 4, q = i & 15;
    int row = m0 + r;
    if (row < NTOK) {
      int b = tok_b(row), j = tok_j(row);
      int blk = q >> 3, i8 = q & 7;
      float x1 = bf2f(P1[(size_t)row * P1W + C_KR + blk * 16 + i8]), x2 = bf2f(P1[(size_t)row * P1W + C_KR + blk * 16 + i8 + 8]);
      float o1 = x1, o2 = x2;
      if (j >= CTXL) {
        int tl = j - CTXL, pos = blk == 0 ? (tl / GRID_W) : (tl % GRID_W);
        float c, sn; rope_cs(ropetab, pos, i8, c, sn);
        o1 = x1 * c - x2 * sn; o2 = x2 * c + x1 * sn;
      }
      bf16* kd = K + (((size_t)b * 4 + h) * TOK + j) * 96 + 64 + blk * 16 + i8;
      kd[0] = f2bf(o1); kd[8] = f2bf(o2);
    }
  }
}
DI void navt_item(const Params& p, int it, char* smem) {
  bf16* s = (bf16*)smem;
  const bf16* P1 = (const bf16*)(p.ws + OFF_P1);
  bf16* VT = (bf16*)(p.ws + OFF_MIX + MX_VTN);
  const int tok0 = it * 64, tid = tid_();
  const int b = tok_b(tok0), j0 = tok_j(tok0);
  __syncthreads();
  for (int i = tid; i < 64 * 32; i += NTHREADS) {
    int r = i >> 5, c8 = i & 31;
    *(uint4*)(s + r * 264 + c8 * 8) = *(const uint4*)(P1 + (size_t)(tok0 + r) * P1W + C_NA + 512 + c8 * 8);
  }
  __syncthreads();
  for (int i = tid; i < 256 * 8; i += NTHREADS) {
    int ch = i >> 3, t8 = i & 7;
    unsigned w[4];
#pragma unroll
    for (int q = 0; q < 4; ++q) w[q] = (unsigned)s[(t8 * 8 + 2 * q) * 264 + ch] | ((unsigned)s[(t8 * 8 + 2 * q + 1) * 264 + ch] << 16);
    *(uint4*)(VT + ((size_t)b * 256 + ch) * TOK + j0 + t8 * 8) = make_uint4(w[0], w[1], w[2], w[3]);
  }
}
constexpr int M2C_TOK = 128, M2C_ITEMS = NTOK / M2C_TOK;
DI void m2conv_item(const Params& p, const LP& L, int it) {
  const bf16* P1 = (const bf16*)(p.ws + OFF_P1);
  bf16* XB = (bf16*)(p.ws + OFF_MIX + MX_XBC);
  const int tok0 = it * M2C_TOK;
  const float* cw = p.in[I_M2CONVW] + (size_t)L.l * 4 * 768;
  const float* cb = p.in[I_M2CONVB] + (size_t)L.l * 768;
  for (int task = tid_(); task < 96 * (M2C_TOK / 8); task += NTHREADS) {
    const int cg = task % 96, tb = task / 96, c0 = cg * 8;
    const int tokb = tok0 + tb * 8, jt = tok_j(tokb), base = tokb - jt;
    const int slo = (jt < CTXL) ? 0 : CTXL, shi = (jt < CTXL) ? CTXL : TOK;
    float w[4][8], bias[8];
#pragma unroll
    for (int k = 0; k < 4; ++k) { float4 a = *(const float4*)(cw + k * 768 + c0), b4 = *(const float4*)(cw + k * 768 + c0 + 4);
      w[k][0] = a.x; w[k][1] = a.y; w[k][2] = a.z; w[k][3] = a.w; w[k][4] = b4.x; w[k][5] = b4.y; w[k][6] = b4.z; w[k][7] = b4.w; }
    { float4 a = *(const float4*)(cb + c0), b4 = *(const float4*)(cb + c0 + 4);
      bias[0] = a.x; bias[1] = a.y; bias[2] = a.z; bias[3] = a.w; bias[4] = b4.x; bias[5] = b4.y; bias[6] = b4.z; bias[7] = b4.w; }
    float xin[11][8];
#pragma unroll
    for (int r = 0; r < 11; ++r) {
      const int j = jt - 2 + r;
      if (j >= slo && j < shi) ld8bf(P1 + (size_t)(base + j) * P1W + C_XBC + c0, xin[r]);
      else {
#pragma unroll
        for (int c = 0; c < 8; ++c) xin[r][c] = 0.f;
      }
    }
    float y[8][8];
#pragma unroll
    for (int t = 0; t < 8; ++t) {
#pragma unroll
      for (int c = 0; c < 8; ++c) y[t][c] = siluf_(bias[c] + w[0][c] * xin[t][c] + w[1][c] * xin[t + 1][c] + w[2][c] * xin[t + 2][c] + w[3][c] * xin[t + 3][c]);
      st8bf(XB + (size_t)(base + jt + t) * 768 + c0, y[t]);
    }
    if (c0 < 512) {
      bf16* XT = (bf16*)(p.ws + OFF_MIX + MX_XBT) + ((size_t)(base / TOK) * 512 + c0) * TOK + jt;
#pragma unroll
      for (int c = 0; c < 8; ++c) {
        float col[8];
#pragma unroll
        for (int t = 0; t < 8; ++t) col[t] = y[t][c];
        st8bf(XT + (size_t)c * TOK, col);
      }
    }
  }
}
DI int m2_seq2tok(int sq, int dir) { return (dir == 0) ? sq : (sq < CTXL ? (CTXL - 1 - sq) : (TOK - 1 - (sq - CTXL))); }
constexpr int M2S_ITEMS = BATCH * 8 * (TOK / 64) / NWAVES;
DI void m2scal_item(const Params& p, const LP& L, int it) {
  const int w = it * NWAVES + (tid_() >> 6), lane = tid_() & 63;
  const int ch = w % (TOK / 64), r = w / (TOK / 64), hd = r & 3, dir = (r >> 2) & 1, b = r >> 3;
  const float a = -expf(p.in[I_M2ALOG][(L.l * 2 + dir) * 4 + hd]);
  const int sq = ch * 64 + lane, j = m2_seq2tok(sq, dir);
  const float dt = ((const float*)(p.ws + OFF_DT))[((size_t)b * TOK + j) * 8 + dir * 4 + hd];
  float cs = dt * a;
#pragma unroll
  for (int d = 1; d < 64; d <<= 1) { float o = shfl_up_(cs, d); if (lane >= d) cs += o; }
  const float sl = shfl_(cs, 63);
  float* o = (float*)(p.ws + OFF_MIX + MX_M2S) + ((size_t)((b * 2 + dir) * 4 + hd) * TOK + sq) * 4;
  *(float4*)o = make_float4(cs, dt, dt * __expf(sl - cs), cs * 1.4426950408889634f - log2f(dt));
}
constexpr int S5_MT = (MCH + 255) / 256;
DI void s5a_tile(const Params& p, const LP& L, int t, char* smem) {
  const int g = t / (S5_MT * 2), r = t % (S5_MT * 2), mt = r / 2, nt = r % 2;
  const int m0 = mt * 256, n0 = nt * 128;
  GA ga = make_ga((const bf16*)(p.ws + OFF_MIX + MX_US5) + (size_t)g * NTOK * 16, 256, (const bf16*)(L.s5 + S5_WA) + (size_t)g * 65536, 256, 256, MCH);
  f32x4 acc[4][4];
  gemm_s<4>(ga, m0, n0, smem, acc);
  float* HE = (float*)(p.ws + OFF_MIX + MX_HEND) + (size_t)g * MCH * 256;
  EPI_BEGIN(4, acc, m0, n0, MCH)
    st8f(HE + (size_t)row * 256 + col, v);
  EPI_END
}
DI int s5_chunk_of(int i, int d) { return (d == 0) ? i : (i < NCC ? (NCC - 1 - i) : (NCH - 1 - (i - NCC))); }
DI void s5carry_item(const Params& p, const LP& L, int it) {
  const int w = it * NWAVES + (tid_() >> 6), lane = tid_() & 63;
  const int d = w / (16 * BATCH), g = (w / BATCH) & 15, b = w % BATCH;
  const float* lp = (const float*)(L.s5 + S5_LAMPOW) + ((size_t)((d * 16 + g) * 17 + 16) * 64 + lane) * 2;
  const float lre = lp[0], lim = lp[1];
  const float* HE = (const float*)(p.ws + OFF_MIX + MX_HEND) + ((size_t)g * MCH + (size_t)b * NCH) * 256 + d * 128;
  bf16* HI = (bf16*)(p.ws + OFF_MIX + MX_HIN) + ((size_t)g * MCH + (size_t)b * NCH) * 256 + d * 128;
  float cre = 0.f, cim = 0.f;
  static_assert(NCH % 4 == 0, "chunk count");
  for (int i0 = 0; i0 < NCH; i0 += 4) {
    float hre[4], him[4];
#pragma unroll
    for (int k = 0; k < 4; ++k) { const int ch = s5_chunk_of(i0 + k, d); hre[k] = HE[(size_t)ch * 256 + lane]; him[k] = HE[(size_t)ch * 256 + 64 + lane]; }
#pragma unroll
    for (int k = 0; k < 4; ++k) {
      const int ch = s5_chunk_of(i0 + k, d);
      HI[(size_t)ch * 256 + lane] = f2bf(cre); HI[(size_t)ch * 256 + 64 + lane] = f2bf(cim);
      const float nre = lre * cre - lim * cim + hre[k], nim = lre * cim + lim * cre + him[k];
      cre = nre; cim = nim;
    }
  }
}
DI void s5c_tile(const Params& p, const LP& L, int t, char* smem) {
  const int g = t / (S5_MT * 2), r = t % (S5_MT * 2), mt = r / 2, nt = r % 2;
  const int m0 = mt * 256, n0 = nt * 128;
  GA ga = make_ga((const bf16*)(p.ws + OFF_MIX + MX_US5) + (size_t)g * NTOK * 16, 256, (const bf16*)(L.s5 + S5_W2) + (size_t)g * 256 * 512, 512, 512, MCH);
  ga.A2 = (const bf16*)(p.ws + OFF_MIX + MX_HIN) + (size_t)g * MCH * 256; ga.lda2 = 256; ga.ksplit = 256;
  f32x4 acc[4][4];
  gemm_s<4>(ga, m0, n0, smem, acc);
  bf16* Z = (bf16*)(p.ws + OFF_MIX + MX_Z);
  EPI_BEGIN(4, acc, m0, n0, MCH)
#pragma unroll
    for (int k = 0; k < 8; ++k) v[k] = geluf_(v[k]);
    st8bf(Z + ((size_t)row * 16 + (col >> 4)) * 256 + g * 16 + (col & 15), v);
  EPI_END
}

DI float fmax_(float a, float b) { return a > b ? a : b; }
constexpr int AT_LDV = 76;
struct NaInfo { int r, qc, rs, cs; };
template <int DK, bool NA>
DI void attn_block(const bf16* qrow, bool active, const bf16* Kp, int kstride, const bf16* Vt,
                   int ka0, int ntile_a, int arow0, int kb0, int ntile_b,
                   const float* srpb, NaInfo ni, float scale, bf16* orow, char* smem) {
  constexpr int LDK = DK + 8, KCH = DK / 8;
  constexpr int KT_BYTES = 64 * LDK * 2, VT_BYTES = 64 * AT_LDV * 2;
  constexpr int NKL = (64 * KCH + NTHREADS - 1) / NTHREADS;
  const int tid = tid_(), lane = tid & 63, half = lane >> 5, r = lane & 31;
  bf16* sK = (bf16*)smem;
  bf16* sV = (bf16*)(smem + 2 * KT_BYTES);
  bf16x8 qf[DK / 16];
  f32x16 o0, o1;
  float m = -1e30f, l = 0.f;
  const float scale2 = scale * 1.4426950408889634f;
#pragma unroll
  for (int ks = 0; ks < DK / 16; ++ks) qf[ks] = active ? *(const bf16x8*)(qrow + ks * 16 + 8 * half) : bf16x8{0, 0, 0, 0, 0, 0, 0, 0};
#pragma unroll
  for (int i = 0; i < 16; ++i) { o0[i] = 0.f; o1[i] = 0.f; }
  const int NTL = ntile_a + ntile_b;
  u32x4 rk[NKL], rv[1];
#pragma unroll
  for (int i = 0; i < NKL; ++i) rk[i] = u32x4{0u, 0u, 0u, 0u};
  auto key0_of = [&](int t) { return t < ntile_a ? ka0 + 64 * t : kb0 + 64 * (t - ntile_a); };
#define AT_GLOAD(t_) { const int k0_ = key0_of(t_); \
    _Pragma("unroll") for (int i_ = 0; i_ < NKL; ++i_) { const int c_ = tid + i_ * NTHREADS; const int key_ = c_ / KCH, ch_ = c_ % KCH; \
      if (c_ < 64 * KCH) rk[i_] = *(const u32x4*)(Kp + (size_t)(k0_ + key_) * kstride + ch_ * 8); } \
    { const int d_ = tid >> 3, ch_ = tid & 7; rv[0] = *(const u32x4*)(Vt + (size_t)d_ * TOK + k0_ + ch_ * 8); } }
#define AT_SSTORE(buf_) { \
    _Pragma("unroll") for (int i_ = 0; i_ < NKL; ++i_) { const int c_ = tid + i_ * NTHREADS; const int key_ = c_ / KCH, ch_ = c_ % KCH; \
      if (c_ < 64 * KCH) *(u32x4*)(sK + (buf_) * (64 * LDK) + key_ * LDK + ch_ * 8) = rk[i_]; } \
    { const int d_ = tid >> 3, ch_ = tid & 7; \
      bf16* dst_ = sV + (buf_) * (64 * AT_LDV) + d_ * AT_LDV + ch_ * 8; \
      *(uint2*)dst_ = make_uint2(rv[0][0], rv[0][1]); *(uint2*)(dst_ + 4) = make_uint2(rv[0][2], rv[0][3]); } }
  __syncthreads();
  AT_GLOAD(0) AT_SSTORE(0)
  __syncthreads();
#pragma unroll 1
  for (int t = 0; t < NTL; ++t) {
    const int buf = t & 1;
    if (t + 1 < NTL) AT_GLOAD(t + 1)
    bool doit = active;
    int trow0 = 0;
    if (NA && t < ntile_a) {
      trow0 = arow0 + t * (64 / GRID_W);
      doit = active && (trow0 + (64 / GRID_W) > ni.rs) && (trow0 < ni.rs + WIN_R);
    }
    if (doit) {
      const bf16* kb = sK + buf * (64 * LDK);
      const bf16* vb = sV + buf * (64 * AT_LDV);
      f32x16 s0, s1;
#pragma unroll
      for (int i = 0; i < 16; ++i) { s0[i] = 0.f; s1[i] = 0.f; }
#pragma unroll
      for (int ks = 0; ks < DK / 16; ++ks) {
        bf16x8 a0 = *(const bf16x8*)(kb + r * LDK + ks * 16 + 8 * half);
        bf16x8 a1 = *(const bf16x8*)(kb + (32 + r) * LDK + ks * 16 + 8 * half);
        s0 = __builtin_amdgcn_mfma_f32_32x32x16_bf16(a0, qf[ks], s0, 0, 0, 0);
        s1 = __builtin_amdgcn_mfma_f32_32x32x16_bf16(a1, qf[ks], s1, 0, 0, 0);
      }
      float mx = -INFINITY;
      if (NA && t < ntile_a) {
#pragma unroll
        for (int i = 0; i < 16; ++i) {
          const int kk = (i & 3) + 8 * (i >> 2) + 4 * half;
#pragma unroll
          for (int hb = 0; hb < 2; ++hb) {
            const int kq = kk + 32 * hb;
            const int kr = trow0 + kq / GRID_W, kc = kq % GRID_W;
            const bool ok = (kr >= ni.rs) && (kr < ni.rs + WIN_R) && (kc >= ni.cs) && (kc < ni.cs + WIN_C);
            const float bias = ok ? srpb[(kr - ni.r + 7) * 31 + (kc - ni.qc + 15)] * 1.4426950408889634f : -INFINITY;
            if (hb == 0) { s0[i] = s0[i] * scale2 + bias; mx = fmax_(mx, s0[i]); }
            else { s1[i] = s1[i] * scale2 + bias; mx = fmax_(mx, s1[i]); }
          }
        }
      } else {
#pragma unroll
        for (int i = 0; i < 16; ++i) { s0[i] *= scale2; s1[i] *= scale2; mx = fmax_(mx, fmax_(s0[i], s1[i])); }
      }
      mx = fmax_(mx, shfl_xor_(mx, 32));
      const float mn = fmax_(m, mx);
      const float alpha = exp2f_(m - mn);
      const bool same = (mn == m);
      m = mn;
      float ps = 0.f;
#pragma unroll
      for (int i = 0; i < 16; ++i) { s0[i] = exp2f_(s0[i] - mn); s1[i] = exp2f_(s1[i] - mn); ps += s0[i] + s1[i]; }
      l = l * alpha + ps;
      if (!wave_all_(same)) {
#pragma unroll
        for (int i = 0; i < 16; ++i) { o0[i] *= alpha; o1[i] *= alpha; }
      }
#pragma unroll
      for (int kq = 0; kq < 4; ++kq) {
        u32x4 pw;
#pragma unroll
        for (int j = 0; j < 4; ++j) pw[j] = (kq < 2) ? pack2(s0[8 * (kq & 1) + 2 * j], s0[8 * (kq & 1) + 2 * j + 1]) : pack2(s1[8 * (kq & 1) + 2 * j], s1[8 * (kq & 1) + 2 * j + 1]);
        const bf16x8 pf = __builtin_bit_cast(bf16x8, pw);
        const bf16* v0 = vb + r * AT_LDV + 16 * kq + 4 * half;
        const bf16* v1 = vb + (r + 32) * AT_LDV + 16 * kq + 4 * half;
        uint2 a0 = *(const uint2*)v0, a1 = *(const uint2*)(v0 + 8), b0 = *(const uint2*)v1, b1 = *(const uint2*)(v1 + 8);
        bf16x8 va, vbb;
        va[0] = (short)(a0.x & 0xffff); va[1] = (short)(a0.x >> 16); va[2] = (short)(a0.y & 0xffff); va[3] = (short)(a0.y >> 16);
        va[4] = (short)(a1.x & 0xffff); va[5] = (short)(a1.x >> 16); va[6] = (short)(a1.y & 0xffff); va[7] = (short)(a1.y >> 16);
        vbb[0] = (short)(b0.x & 0xffff); vbb[1] = (short)(b0.x >> 16); vbb[2] = (short)(b0.y & 0xffff); vbb[3] = (short)(b0.y >> 16);
        vbb[4] = (short)(b1.x & 0xffff); vbb[5] = (short)(b1.x >> 16); vbb[6] = (short)(b1.y & 0xffff); vbb[7] = (short)(b1.y >> 16);
        o0 = __builtin_amdgcn_mfma_f32_32x32x16_bf16(va, pf, o0, 0, 0, 0);
        o1 = __builtin_amdgcn_mfma_f32_32x32x16_bf16(vbb, pf, o1, 0, 0, 0);
      }
    }
    if (t + 1 < NTL) AT_SSTORE(buf ^ 1)
    __syncthreads();
  }
  if (active) {
    const float lt = l + shfl_xor_(l, 32);
    const float inv = 1.0f / lt;
#pragma unroll
    for (int gI = 0; gI < 4; ++gI) {
      const int d0 = 8 * gI + 4 * half;
      *(uint2*)(orow + d0) = make_uint2(pack2(o0[4 * gI] * inv, o0[4 * gI + 1] * inv), pack2(o0[4 * gI + 2] * inv, o0[4 * gI + 3] * inv));
      *(uint2*)(orow + 32 + d0) = make_uint2(pack2(o1[4 * gI] * inv, o1[4 * gI + 1] * inv), pack2(o1[4 * gI + 2] * inv, o1[4 * gI + 3] * inv));
    }
  }
}
DI void mla_attn_item(const Params& p, int it, bool ctxq, char* smem) {
  const int nqb = ctxq ? (CTXL + 255) / 256 : SEQ / 256;
  const int b = it / (4 * nqb), h = (it / nqb) & 3, qb = it % nqb;
  const int lane = tid_() & 63, wid = tid_() >> 6;
  const int nq = ctxq ? CTXL : SEQ, q0 = qb * 256 + wid * 32;
  const bool active = q0 < nq;
  const int jq = (ctxq ? 0 : CTXL) + (active ? q0 : 0) + (lane & 31);
  const bf16* Q = (const bf16*)(p.ws + OFF_MIX + MX_Q) + ((size_t)b * 4 + h) * TOK * 96;
  const bf16* K = (const bf16*)(p.ws + OFF_MIX + MX_K) + ((size_t)b * 4 + h) * TOK * 96;
  const bf16* VT = (const bf16*)(p.ws + OFF_MIX + MX_VTM) + ((size_t)b * 4 + h) * 64 * TOK;
  bf16* O = (bf16*)(p.ws + OFF_O) + ((size_t)b * TOK + jq) * 1024 + 0 * 256 + h * 64;
  NaInfo ni; ni.r = 0; ni.qc = 0; ni.rs = 0; ni.cs = 0;
  attn_block<96, false>(Q + (size_t)jq * 96, active, K, 96, VT, 0, 0, 0, 0, (ctxq ? CTXL : TOK) / 64, nullptr, ni, 0.10206207261596577f, O, smem);
}
DI void na_attn_item(const Params& p, const LP& L, int it, bool ctxq, char* smem) {
  const int nqb = ctxq ? (CTXL + 255) / 256 : SEQ / 256;
  const int b = it / (4 * nqb), h = (it / nqb) & 3, qb = it % nqb;
  const int tid = tid_(), lane = tid & 63, wid = tid >> 6;
  const int nq = ctxq ? CTXL : SEQ, q0 = qb * 256 + wid * 32;
  const bool active = q0 < nq;
  const int jq = (ctxq ? 0 : CTXL) + (active ? q0 : 0) + (lane & 31);
  const bf16* P1 = (const bf16*)(p.ws + OFF_P1) + (size_t)b * TOK * P1W;
  const bf16* VT = (const bf16*)(p.ws + OFF_MIX + MX_VTN) + ((size_t)b * 4 + h) * 64 * TOK;
  const bf16* Kb = P1 + C_NA + 256 + h * 64;
  bf16* O = (bf16*)(p.ws + OFF_O) + ((size_t)b * TOK + jq) * 1024 + 1 * 256 + h * 64;
  constexpr int AT_END64 = 2 * (64 * 72 * 2) + 2 * (64 * AT_LDV * 2);
  float* srpb = (float*)(smem + AT_END64);
  NaInfo ni; ni.r = 0; ni.qc = 0; ni.rs = 0; ni.cs = 0;
  int ka0 = 0, nta = 0, arow0 = 0;
  if (!ctxq) {
    __syncthreads();
    const float* rpb = p.in[I_RPB] + ((size_t)L.l * 4 + h) * 15 * 31;
    for (int i = tid; i < 15 * 31; i += NTHREADS) srpb[i] = rpb[i];
    const int tl = q0 + (lane & 31);
    ni.r = tl / GRID_W; ni.qc = tl % GRID_W;
    int rs = ni.r - WIN_R / 2; rs = rs < 0 ? 0 : (rs > ROWS - WIN_R ? ROWS - WIN_R : rs);
    int cs = ni.qc - WIN_C / 2; cs = cs < 0 ? 0 : (cs > GRID_W - WIN_C ? GRID_W - WIN_C : cs);
    ni.rs = rs; ni.cs = cs;
    constexpr int RPT = 64 / GRID_W;
    const int rfirst = (qb * 256) / GRID_W, rlast = (qb * 256 + 255) / GRID_W;
    int rs_f = rfirst - WIN_R / 2; rs_f = rs_f < 0 ? 0 : (rs_f > ROWS - WIN_R ? ROWS - WIN_R : rs_f);
    int rs_l = rlast - WIN_R / 2; rs_l = rs_l < 0 ? 0 : (rs_l > ROWS - WIN_R ? ROWS - WIN_R : rs_l);
    arow0 = (rs_f / RPT) * RPT;
    const int row_hi = rs_l + WIN_R;
    nta = (row_hi - arow0 + RPT - 1) / RPT;
    ka0 = CTXL + arow0 * GRID_W;
  }
  attn_block<64, true>(P1 + (size_t)jq * P1W + C_NA + h * 64, active, Kb, P1W, VT, ka0, nta, arow0, 0, CTXL / 64, srpb, ni, 0.125f, O, smem);
}

constexpr int M2_LDB = 136, M2_LDX = 72;
constexpr int M2_OFF_B = 0;
constexpr int M2_OFF_C = M2_OFF_B + 64 * M2_LDB * 2;
constexpr int M2_OFF_HD = M2_OFF_C + 64 * M2_LDB * 2;
constexpr int M2H_H = 0;
constexpr int M2H_XT = M2H_H + 64 * M2_LDB * 2;
constexpr int M2H_BT = M2H_XT + 64 * M2_LDX * 2;
constexpr int M2H_S = M2H_BT + 128 * M2_LDX * 2;
constexpr int M2H_X = M2H_S + 3 * 64 * 4;
constexpr int M2H_SIZE = M2H_X + 64 * M2_LDX * 2;
constexpr int M2_SMEM = M2_OFF_HD + 2 * M2H_SIZE;
static_assert(M2_SMEM <= SMEM_BYTES, "m2 smem");
DI u32x4 rev8_(u32x4 v) {
  return u32x4{(v[3] >> 16) | (v[3] << 16), (v[2] >> 16) | (v[2] << 16), (v[1] >> 16) | (v[1] << 16), (v[0] >> 16) | (v[0] << 16)};
}
DI void m2scan_item(const Params& p, const LP& L, int it, char* smem) {
  const int b = it / 4, grp = (it >> 1) & 1, dir = it & 1;
  const int tid = tid_(), lane = tid & 63, wid = tid >> 6, half = lane >> 5, r = lane & 31;
  const int hsel = wid >> 2, wl = wid & 3, hd = grp * 2 + hsel;
  bf16* sB = (bf16*)(smem + M2_OFF_B);
  bf16* sC = (bf16*)(smem + M2_OFF_C);
  char* hb = smem + M2_OFF_HD + hsel * M2H_SIZE;
  bf16* sH = (bf16*)(hb + M2H_H);
  bf16* sXT = (bf16*)(hb + M2H_XT);
  bf16* sBT = (bf16*)(hb + M2H_BT);
  float* sS = (float*)(hb + M2H_S);
  float* sDt = sS + 64;
  float* sW = sS + 128;
  const bf16* XB = (const bf16*)(p.ws + OFF_MIX + MX_XBC) + (size_t)b * TOK * 768;
  const bf16* XT = (const bf16*)(p.ws + OFF_MIX + MX_XBT) + (size_t)b * 512 * TOK;
  const float* SC = (const float*)(p.ws + OFF_MIX + MX_M2S) + (size_t)((b * 2 + dir) * 4 + hd) * TOK * 4;
  float* YM = (float*)(p.ws + OFF_HA) + ((size_t)dir * NTOK + (size_t)b * TOK) * 256;
  const int pb = wl & 1, tb = wl >> 1, nb0 = 2 * (wl >> 1);
  f32x16 hst[2];
#pragma unroll
  for (int i = 0; i < 16; ++i) { hst[0][i] = 0.f; hst[1][i] = 0.f; }
  __syncthreads();
  for (int i = tid; i < 2 * M2H_SIZE / 4; i += NTHREADS) ((unsigned*)(smem + M2_OFF_HD))[i] = 0u;
  __syncthreads();
  u32x4 rxt[2], rbt[2], rb[2], rc[2];
  float4 rsc = make_float4(0.f, 0.f, 0.f, 0.f);
#define M2_TLOAD(rowptr_, sq0_) (*(const u32x4*)((rowptr_) + ((dir == 0) ? (sq0_) : m2_seq2tok((sq0_) + 7, 1))))
#define M2_GLOAD(c0_) { \
    _Pragma("unroll") for (int q_ = 0; q_ < 2; ++q_) { const int i_ = tid + q_ * NTHREADS; const int h2_ = i_ >> 9, t8_ = ((i_ >> 6) & 7) * 8, pp_ = i_ & 63; \
      rxt[q_] = M2_TLOAD(XT + (size_t)((grp * 2 + h2_) * 64 + pp_) * TOK, (c0_) + t8_); } \
    _Pragma("unroll") for (int q_ = 0; q_ < 2; ++q_) { const int i_ = tid + q_ * NTHREADS; const int t8_ = (i_ >> 7) * 8, nn_ = i_ & 127; \
      rbt[q_] = M2_TLOAD(XT + (size_t)(256 + grp * 128 + nn_) * TOK, (c0_) + t8_); } \
    _Pragma("unroll") for (int q_ = 0; q_ < 2; ++q_) { const int i_ = tid + q_ * NTHREADS; const int t_ = i_ >> 4, n8_ = (i_ & 15) * 8; \
      const bf16* src_ = XB + (size_t)m2_seq2tok((c0_) + t_, dir) * 768 + grp * 128 + n8_; \
      rb[q_] = *(const u32x4*)(src_ + 256); rc[q_] = *(const u32x4*)(src_ + 512); } \
    if (wl == 0) rsc = *(const float4*)(SC + (size_t)((c0_) + lane) * 4); }
  M2_GLOAD(0)
  for (int c0 = 0; c0 < TOK; c0 += 64) {
    if (wl == 0) { sS[lane] = rsc.x; sDt[lane] = rsc.w; sW[lane] = rsc.z; }
    __syncthreads();
#pragma unroll
    for (int q2 = 0; q2 < 2; ++q2) {
      const int i = tid + q2 * NTHREADS; const int h2 = i >> 9, t8 = ((i >> 6) & 7) * 8, pp = i & 63;
      *(u32x4*)((bf16*)(smem + M2_OFF_HD + h2 * M2H_SIZE + M2H_XT) + pp * M2_LDX + t8) = dir ? rev8_(rxt[q2]) : rxt[q2];
    }
#pragma unroll
    for (int q4 = 0; q4 < 2; ++q4) {
      const int i = tid + q4 * NTHREADS; const int t = i >> 4, n8 = (i & 15) * 8;
      *(u32x4*)(sB + t * M2_LDB + n8) = rb[q4];
      *(u32x4*)(sC + t * M2_LDB + n8) = rc[q4];
    }
#pragma unroll
    for (int q4 = 0; q4 < 2; ++q4) {
      const int i = tid + q4 * NTHREADS; const int t8 = (i >> 7) * 8, nn = i & 127;
      float bv[8];
      if (dir) rbt[q4] = rev8_(rbt[q4]);
      bv[0] = __uint_as_float(rbt[q4][0] << 16); bv[1] = __uint_as_float(rbt[q4][0] & 0xffff0000u);
      bv[2] = __uint_as_float(rbt[q4][1] << 16); bv[3] = __uint_as_float(rbt[q4][1] & 0xffff0000u);
      bv[4] = __uint_as_float(rbt[q4][2] << 16); bv[5] = __uint_as_float(rbt[q4][2] & 0xffff0000u);
      bv[6] = __uint_as_float(rbt[q4][3] << 16); bv[7] = __uint_as_float(rbt[q4][3] & 0xffff0000u);
#pragma unroll
      for (int h2 = 0; h2 < 2; ++h2) {
        const float* wv = (const float*)(smem + M2_OFF_HD + h2 * M2H_SIZE + M2H_S) + 128 + t8;
        float sv[8];
#pragma unroll
        for (int k = 0; k < 8; ++k) sv[k] = bv[k] * wv[k];
        st8bf((bf16*)(smem + M2_OFF_HD + h2 * M2H_SIZE + M2H_BT) + nn * M2_LDX + t8, sv);
      }
    }
    __syncthreads();
    if (c0 + 64 < TOK) M2_GLOAD(c0 + 64)
    {
      f32x16 yT, y2;
#pragma unroll
      for (int i = 0; i < 16; ++i) { yT[i] = 0.f; y2[i] = 0.f; }
      const int tv = 32 * tb + r;
      const float St = sS[tv];
      for (int sb = 0; sb <= tb; ++sb) {
        f32x16 gT;
#pragma unroll
        for (int i = 0; i < 16; ++i) gT[i] = 0.f;
#pragma unroll
        for (int ks = 0; ks < 8; ++ks) {
          bf16x8 av = *(const bf16x8*)(sB + (32 * sb + r) * M2_LDB + 16 * ks + 8 * half);
          bf16x8 bv = *(const bf16x8*)(sC + tv * M2_LDB + 16 * ks + 8 * half);
          gT = __builtin_amdgcn_mfma_f32_32x32x16_bf16(av, bv, gT, 0, 0, 0);
        }
        const float St2 = St * 1.4426950408889634f;
        if (sb == tb) {
#pragma unroll
          for (int i = 0; i < 16; ++i) {
            const int sv = 32 * sb + (i & 3) + 8 * (i >> 2) + 4 * half;
            gT[i] = (sv <= tv) ? gT[i] * exp2f_(St2 - sDt[sv]) : 0.f;
          }
        } else {
#pragma unroll
          for (int i = 0; i < 16; ++i) {
            const int sv = 32 * sb + (i & 3) + 8 * (i >> 2) + 4 * half;
            gT[i] *= exp2f_(St2 - sDt[sv]);
          }
        }
#pragma unroll
        for (int kq = 0; kq < 2; ++kq) {
          const u32x4 pw = u32x4{pack2(gT[8 * kq], gT[8 * kq + 1]), pack2(gT[8 * kq + 2], gT[8 * kq + 3]), pack2(gT[8 * kq + 4], gT[8 * kq + 5]), pack2(gT[8 * kq + 6], gT[8 * kq + 7])};
          const bf16x8 pf = __builtin_bit_cast(bf16x8, pw);
          const bf16* xr = sXT + (32 * pb + r) * M2_LDX + 32 * sb + 16 * kq + 4 * half;
          uint2 x0 = *(const uint2*)xr, x1 = *(const uint2*)(xr + 8);
          bf16x8 xa;
          xa[0] = (short)(x0.x & 0xffff); xa[1] = (short)(x0.x >> 16); xa[2] = (short)(x0.y & 0xffff); xa[3] = (short)(x0.y >> 16);
          xa[4] = (short)(x1.x & 0xffff); xa[5] = (short)(x1.x >> 16); xa[6] = (short)(x1.y & 0xffff); xa[7] = (short)(x1.y >> 16);
          yT = __builtin_amdgcn_mfma_f32_32x32x16_bf16(xa, pf, yT, 0, 0, 0);
        }
      }
#pragma unroll
      for (int ks = 0; ks < 8; ++ks) {
        bf16x8 av = *(const bf16x8*)(sH + (32 * pb + r) * M2_LDB + 16 * ks + 8 * half);
        bf16x8 bv = *(const bf16x8*)(sC + tv * M2_LDB + 16 * ks + 8 * half);
        y2 = __builtin_amdgcn_mfma_f32_32x32x16_bf16(av, bv, y2, 0, 0, 0);
      }
      const float eS = __expf(St);
      const int j = m2_seq2tok(c0 + tv, dir);
      float* yo = YM + (size_t)j * 256 + hd * 64 + 32 * pb + 4 * half;
#pragma unroll
      for (int gI = 0; gI < 4; ++gI)
        *(float4*)(yo + 8 * gI) = make_float4(yT[4 * gI] + eS * y2[4 * gI], yT[4 * gI + 1] + eS * y2[4 * gI + 1], yT[4 * gI + 2] + eS * y2[4 * gI + 2], yT[4 * gI + 3] + eS * y2[4 * gI + 3]);
    }
    __syncthreads();
    {
      const float eL = __expf(sS[63]);
#pragma unroll
      for (int q = 0; q < 2; ++q) {
#pragma unroll
        for (int i = 0; i < 16; ++i) hst[q][i] *= eL;
#pragma unroll
        for (int ks = 0; ks < 4; ++ks) {
          bf16x8 av = *(const bf16x8*)(sXT + (32 * pb + r) * M2_LDX + 16 * ks + 8 * half);
          bf16x8 bv = *(const bf16x8*)(sBT + (32 * (nb0 + q) + r) * M2_LDX + 16 * ks + 8 * half);
          hst[q] = __builtin_amdgcn_mfma_f32_32x32x16_bf16(av, bv, hst[q], 0, 0, 0);
        }
#pragma unroll
        for (int i = 0; i < 16; ++i) {
          const int pv = 32 * pb + (i & 3) + 8 * (i >> 2) + 4 * half;
          sH[pv * M2_LDB + 32 * (nb0 + q) + r] = f2bf(hst[q][i]);
        }
      }
    }
    __syncthreads();
  }
}
DI void m2gate_item(const Params& p, const LP& L, int it) {
  const int tok = it * NWAVES + (tid_() >> 6), lane = tid_() & 63;
  const float* Y0 = (const float*)(p.ws + OFF_HA) + (size_t)tok * 256;
  const float* Y1 = Y0 + (size_t)NTOK * 256;
  const bf16* XB = (const bf16*)(p.ws + OFF_MIX + MX_XBC) + (size_t)tok * 768;
  const bf16* P1 = (const bf16*)(p.ws + OFF_P1) + (size_t)tok * P1W + C_Z;
  const int c = lane * 4, hd = c >> 6;
  const float dsk = p.in[I_M2D][L.l * 4 + hd];
  float4 y0 = *(const float4*)(Y0 + c), y1 = *(const float4*)(Y1 + c);
  uint2 xw = *(const uint2*)(XB + c), zw = *(const uint2*)(P1 + c);
  float xs[4] = {__uint_as_float(xw.x << 16), __uint_as_float(xw.x & 0xffff0000u), __uint_as_float(xw.y << 16), __uint_as_float(xw.y & 0xffff0000u)};
  float zs[4] = {__uint_as_float(zw.x << 16), __uint_as_float(zw.x & 0xffff0000u), __uint_as_float(zw.y << 16), __uint_as_float(zw.y & 0xffff0000u)};
  float ys[4] = {y0.x + y1.x, y0.y + y1.y, y0.z + y1.z, y0.w + y1.w};
  float v[4], ss = 0.f;
#pragma unroll
  for (int i = 0; i < 4; ++i) { v[i] = (ys[i] + dsk * xs[i]) * siluf_(zs[i]); ss += v[i] * v[i]; }
  ss = wave_sum(ss);
  const float rs = rsqrtf(ss * (1.f / 256.f) + EPS);
  float4 gn = *(const float4*)(p.in[I_M2GNORM] + L.l * 256 + c);
  bf16* O = (bf16*)(p.ws + OFF_O) + (size_t)tok * 1024 + 768 + c;
  *(uint2*)O = make_uint2(pack2(v[0] * rs * gn.x, v[1] * rs * gn.y), pack2(v[2] * rs * gn.z, v[3] * rs * gn.w));
}
constexpr int GLU_MT = (NTOK + 255) / 256;
DI void glu_tile(const Params& p, const LP& L, int t, char* smem) {
  const int mt = t % GLU_MT, nt = t / GLU_MT, m0 = mt * 256, n0 = nt * 128;
  const bf16* Z = (const bf16*)(p.ws + OFF_MIX + MX_Z);
  GA g = make_ga(Z, 256, (const bf16*)(L.we + WE_GLU), 256, 256, NTOK);
  f32x4 acc[4][4];
  gemm_s<4>(g, m0, n0, smem, acc);
  bf16* O = (bf16*)(p.ws + OFF_O);
  const float* bg = p.in[I_S5BGLU] + L.l * 256;
  EPI_BEGIN(4, acc, m0, n0, NTOK)
    float z[8]; ld8bf(Z + (size_t)row * 256 + col, z);
#pragma unroll
    for (int k = 0; k < 8; ++k) v[k] = z[k] * sigmoidf_(v[k] + bg[col + k]);
    st8bf(O + (size_t)row * 1024 + 512 + col, v);
  EPI_END
}
DI void merge_tile(const Params& p, const LP& L, int t, char* smem) {
  constexpr int MT_L = BATCH * (SEQ / 256), MT_A = (NTOK + 255) / 256;
  const int mt = L.last ? t % MT_L : t % MT_A, nt = L.last ? t / MT_L : t / MT_A, m0 = mtile_row0(mt, L.last, 256), n0 = nt * 128;
  const bf16* O = (const bf16*)(p.ws + OFF_O);
  const bf16* PG = (const bf16*)(p.ws + OFF_PG);
  float tot[4][2][8];
#pragma unroll
  for (int a = 0; a < 4; ++a)
#pragma unroll
    for (int q = 0; q < 2; ++q)
#pragma unroll
      for (int k = 0; k < 8; ++k) tot[a][q][k] = 0.f;
  for (int j = 0; j < 4; ++j) {
    GA g = make_ga(O + j * 256, 1024, (const bf16*)(L.we + WE_WB) + (size_t)j * 1024 * 256, 256, 256, NTOK);
    f32x4 acc[4][4];
    gemm_s<4>(g, m0, n0, smem, acc);
    EPI_BEGIN(4, acc, m0, n0, NTOK)
      float gt[8]; ld8bf(PG + (size_t)row * 4096 + j * 1024 + col, gt);
#pragma unroll
      for (int k = 0; k < 8; ++k) tot[_m][_q][k] += gt[k] * v[k];
    EPI_END
  }
  bf16* Y = (bf16*)(p.ws + OFF_P1);
  {
    const int l = tid_() & 63, w = tid_() >> 6, wr = w >> 1, wc = w & 1, fr = l & 15, fq = l >> 4;
#pragma unroll
    for (int m = 0; m < 4; ++m)
#pragma unroll
      for (int q = 0; q < 2; ++q) {
        const int row = m0 + wr * 64 + m * 16 + fr, col = n0 + wc * 64 + q * 32 + 8 * fq;
        if (row < NTOK) st8bf(Y + (size_t)row * 1024 + col, tot[m][q]);
      }
  }
}
DI void outproj_tile(const Params& p, const LP& L, int t, char* smem) {
  float* Y2 = (float*)(p.ws + OFF_HA);
  constexpr int MT_L = BATCH * (SEQ / 256), MT_A = (NTOK + 255) / 256;
  const int mt = L.last ? t % MT_L : t % MT_A, nt = L.last ? t / MT_L : t / MT_A, m0 = mtile_row0(mt, L.last, 256), n0 = nt * 256;
  GA g = make_ga((const bf16*)(p.ws + OFF_P1), 1024, (const bf16*)(L.we + WE_WOUT), 1024, 1024, NTOK);
  f32x4 acc[2][2][4][2];
  gemm_big(g, m0, n0, smem, acc);
  EPIB_BEGIN(acc, m0, n0, NTOK)
    st8f(Y2 + (size_t)row * 1024 + col, v);
  EPIB_END
}
DI int post_ntok(bool latonly) { return latonly ? BATCH * SEQ : NTOK; }
DI int post_tok(int i, bool latonly) { return latonly ? ((i / SEQ) * TOK + CTXL + (i % SEQ)) : i; }

DI void post_stage_router(const Params& p, const LP& L, char* smem) {
  const float* wr = p.in[I_WROUTER] + (size_t)L.l * 1024 * 16;
  float4* wl = (float4*)smem;
  __syncthreads();
  for (int i = tid_(); i < 4096; i += NTHREADS) {
    const int k = i >> 2, q = i & 3;
    const int pos = ((k >> 8) * 4 + (k & 3)) * 64 + ((k >> 2) & 63);
    wl[q * 1024 + pos] = *(const float4*)(wr + (size_t)k * 16 + q * 4);
  }
  __syncthreads();
}
DI void post_item(const Params& p, const LP& L, int it, char* smem) {
  const int tok = post_tok(it * NWAVES + (tid_() >> 6), L.last), lane = tid_() & 63;
  float* X = (float*)(p.ws + OFF_X) + (size_t)tok * 1024;
  const float* Y2 = (const float*)(p.ws + OFF_HA) + (size_t)tok * 1024;
  const float* mod = L.mod + (size_t)tok_modrow(tok) * 6144;
  float yv[16], xv[16], h[16];
  float ss = 0.f;
#pragma unroll
  for (int i = 0; i < 4; ++i) {
    float4 v = *(const float4*)(Y2 + lane * 4 + i * 256);
    yv[i * 4] = v.x; yv[i * 4 + 1] = v.y; yv[i * 4 + 2] = v.z; yv[i * 4 + 3] = v.w;
    ss += v.x * v.x + v.y * v.y + v.z * v.z + v.w * v.w;
  }
  ss = wave_sum(ss);
  const float rs = rsqrtf(ss * (1.f / 1024.f) + EPS);
  const float* gpm = p.in[I_GPOSTMIX] + L.l * 1024;
#pragma unroll
  for (int i = 0; i < 4; ++i) {
    int c = lane * 4 + i * 256;
    float4 xo = *(const float4*)(X + c), gv = *(const float4*)(gpm + c), gt = *(const float4*)(mod + 2048 + c);
    xo.x += gt.x * yv[i * 4] * rs * gv.x; xo.y += gt.y * yv[i * 4 + 1] * rs * gv.y; xo.z += gt.z * yv[i * 4 + 2] * rs * gv.z; xo.w += gt.w * yv[i * 4 + 3] * rs * gv.w;
    *(float4*)(X + c) = xo;
    xv[i * 4] = xo.x; xv[i * 4 + 1] = xo.y; xv[i * 4 + 2] = xo.z; xv[i * 4 + 3] = xo.w;
  }
  bf16* H2 = (bf16*)(p.ws + OFF_P1) + (size_t)NTOK * 1024 + (size_t)tok * 1024;
  normmod_row(xv, p.in[I_GPREFFN] + L.l * 1024, mod + 3072, mod + 4096, H2, h);
  const float4* wl = (const float4*)smem;
  float lg[16];
#pragma unroll
  for (int e = 0; e < 16; ++e) lg[e] = 0.f;
#pragma unroll
  for (int i = 0; i < 16; ++i) {
    const int pos = ((i >> 2) * 4 + (i & 3)) * 64 + lane;
    float4 a = wl[pos], b4 = wl[1024 + pos], c4 = wl[2048 + pos], d4 = wl[3072 + pos];
    float hv = h[i];
    lg[0] += hv * a.x; lg[1] += hv * a.y; lg[2] += hv * a.z; lg[3] += hv * a.w;
    lg[4] += hv * b4.x; lg[5] += hv * b4.y; lg[6] += hv * b4.z; lg[7] += hv * b4.w;
    lg[8] += hv * c4.x; lg[9] += hv * c4.y; lg[10] += hv * c4.z; lg[11] += hv * c4.w;
    lg[12] += hv * d4.x; lg[13] += hv * d4.y; lg[14] += hv * d4.z; lg[15] += hv * d4.w;
  }
  float mx = -INFINITY;
#pragma unroll
  for (int e = 0; e < 16; ++e) { lg[e] = wave_sum(lg[e]); mx = fmax_(mx, lg[e]); }
  float se = 0.f;
#pragma unroll
  for (int e = 0; e < 16; ++e) { lg[e] = expf(lg[e] - mx); se += lg[e]; }
  if (lane < 16) {
    float v = 0.f;
#pragma unroll
    for (int e = 0; e < 16; ++e) if (e == lane) v = lg[e];
    ((float*)(p.ws + OFF_AFF))[(size_t)lane * NTOK + tok] = v / se;
  }
}
DI int block_sum_(int v, int* sred, int round) {
  const int tid = tid_(), lane = tid & 63, wid = tid >> 6;
  v += shfl_xor_(v, 32); v += shfl_xor_(v, 16); v += shfl_xor_(v, 8); v += shfl_xor_(v, 4); v += shfl_xor_(v, 2); v += shfl_xor_(v, 1);
  int* r = sred + (round & 1) * NWAVES;
  if (lane == 0) r[wid] = v;
  __syncthreads();
  int tsum = 0;
#pragma unroll
  for (int q = 0; q < NWAVES; ++q) tsum += r[q];
  return tsum;
}
DI void route_item(const Params& p, const LP& L, int it, char* smem) {
  const int nstream = L.last ? 1 : 2;
  const int b = it / (16 * nstream), e = (it / nstream) & 15, ctxs = (nstream == 2) ? (it & 1) : 0;
  const int T = ctxs ? CTXL : SEQ, cap = ctxs ? CAP_C : CAP_L;
  const int tok0 = b * TOK + (ctxs ? 0 : CTXL);
  const int slot0 = ctxs ? (BATCH * CAP_L + b * CAP_C) : (b * CAP_L);
  int* sred = (int*)smem;
  const float* AFF = (const float*)(p.ws + OFF_AFF) + (size_t)e * NTOK + tok0;
  int* SEL = (int*)(p.ws + OFF_SEL);
  int* IDX = (int*)(p.ws + OFF_IDX) + (size_t)e * ESLOTS;
  float* GW = (float*)(p.ws + OFF_GW) + (size_t)e * ESLOTS;
  const int tid = tid_(), lane = tid & 63, wid = tid >> 6;
  constexpr int MAXPER = (SEQ + NTHREADS - 1) / NTHREADS;
  const int per = (T + NTHREADS - 1) / NTHREADS;
  unsigned key[MAXPER];
  __syncthreads();
#pragma unroll
  for (int k = 0; k < MAXPER; ++k) {
    int i = tid * per + k;
    key[k] = (k < per && i < T) ? (__float_as_uint(AFF[i]) + 1u) : 0u;
  }
  unsigned thr = 0u;
  int round = 0;
  for (int bit = 30; bit >= 0; --bit) {
    const unsigned cand = thr | (1u << bit);
    int c = 0;
#pragma unroll
    for (int k = 0; k < MAXPER; ++k) c += (key[k] >= cand) ? 1 : 0;
    c = block_sum_(c, sred, round++);
    if (c >= cap) thr = cand;
  }
  int cg = 0, ce = 0;
#pragma unroll
  for (int k = 0; k < MAXPER; ++k) { cg += (key[k] > thr) ? 1 : 0; ce += (key[k] == thr) ? 1 : 0; }
  const int tot_gt = block_sum_(cg, sred, round++);
  const int need_eq = cap - tot_gt;
  int v = cg | (ce << 16), inc = v;
#pragma unroll
  for (int d = 1; d < 64; d <<= 1) { int o = shfl_up_(inc, d); if (lane >= d) inc += o; }
  int* soff = sred + 2 * NWAVES;
  __syncthreads();
  if (lane == 63) soff[wid] = inc;
  __syncthreads();
  int base = 0;
  for (int w = 0; w < wid; ++w) base += soff[w];
  int excl = base + inc - v;
  int gt_before = excl & 0xffff, eq_before = excl >> 16;
#pragma unroll
  for (int k = 0; k < MAXPER; ++k) {
    int i = tid * per + k;
    if (k < per && i < T) {
      const bool isgt = key[k] > thr, iseq = key[k] == thr;
      const bool sel = isgt || (iseq && eq_before < need_eq);
      const int slot = slot0 + gt_before + (eq_before < need_eq ? eq_before : need_eq);
      if (sel) { IDX[slot] = tok0 + i; GW[slot] = __uint_as_float(key[k] - 1u); SEL[(size_t)(tok0 + i) * 16 + e] = slot; }
      else SEL[(size_t)(tok0 + i) * 16 + e] = -1;
      gt_before += isgt ? 1 : 0; eq_before += iseq ? 1 : 0;
    }
  }
}
DI void moe1_tile(const Params& p, const LP& L, int t, char* smem) {
  const int nslots = L.last ? ESLOTS_L : ESLOTS;
  constexpr int MT_L = (ESLOTS_L + 255) / 256, MT_A = (ESLOTS + 255) / 256;
  const int nt = t & 7, sq = t >> 3;
  const int e = L.last ? sq / MT_L : sq / MT_A, mt = L.last ? sq % MT_L : sq % MT_A;
  const int m0 = mt * 256, n0 = nt * 256;
  GA g = make_ga((const bf16*)(p.ws + OFF_P1) + (size_t)NTOK * 1024, 1024, (const bf16*)(p.ws + OFF_MIX + WX_GU) + (size_t)e * 2048 * 1024, 1024, 1024, nslots);
  g.ridx = (const int*)(p.ws + OFF_IDX) + (size_t)e * ESLOTS;
  f32x4 acc[2][2][4][2];
  gemm_big(g, m0, n0, smem, acc);
  bf16* ACT = (bf16*)(p.ws + OFF_PG) + (size_t)e * ESLOTS * 1024;
  {
    const int l = tid_() & 63, w = tid_() >> 6, wr = w >> 2, wc = w & 3, fr = l & 15, fq = l >> 4;
#pragma unroll
    for (int ai = 0; ai < 2; ++ai)
#pragma unroll
      for (int m = 0; m < 4; ++m) {
        const int row = m0 + ai * 128 + wr * 64 + m * 16 + fr;
        float a[8];
#pragma unroll
        for (int k = 0; k < 4; ++k) { a[k] = siluf_(acc[ai][0][m][0][k]) * acc[ai][1][m][0][k]; a[4 + k] = siluf_(acc[ai][0][m][1][k]) * acc[ai][1][m][1][k]; }
        if (row < nslots) st8bf(ACT + (size_t)row * 1024 + nt * 128 + wc * 32 + 8 * fq, a);
      }
  }
}
DI void moe2_tile(const Params& p, const LP& L, int t, char* smem) {
  const int nslots = L.last ? ESLOTS_L : ESLOTS;
  constexpr int MT_L = (ESLOTS_L + 255) / 256, MT_A = (ESLOTS + 255) / 256;
  const int e = L.last ? t / (MT_L * 4) : t / (MT_A * 4), r = L.last ? t % (MT_L * 4) : t % (MT_A * 4), mt = L.last ? r % MT_L : r % MT_A, nt = L.last ? r / MT_L : r / MT_A;
  const int m0 = mt * 256, n0 = nt * 256;
  GA g = make_ga((const bf16*)(p.ws + OFF_PG) + (size_t)e * ESLOTS * 1024, 1024, (const bf16*)(p.ws + OFF_MIX + WX_DN) + (size_t)e * 1024 * 1024, 1024, 1024, nslots);
  f32x4 acc[2][2][4][2];
  gemm_big(g, m0, n0, smem, acc);
  bf16* YS = (bf16*)(p.ws + OFF_PG) + (size_t)NE * ESLOTS * 1024 + (size_t)e * ESLOTS * 1024;
  const float* GW = (const float*)(p.ws + OFF_GW) + (size_t)e * ESLOTS;
  EPIB_BEGIN(acc, m0, n0, nslots)
    const float gw = GW[row];
#pragma unroll
    for (int k = 0; k < 8; ++k) v[k] *= gw;
    st8bf(YS + (size_t)row * 1024 + col, v);
  EPIB_END
}
DI void comb_item(const Params& p, const LP& L, int it) {
  const int tok = post_tok(it * NWAVES + (tid_() >> 6), L.last), lane = tid_() & 63;
  float* X = (float*)(p.ws + OFF_X) + (size_t)tok * 1024;
  const int* SEL = (const int*)(p.ws + OFF_SEL) + (size_t)tok * 16;
  const bf16* YS = (const bf16*)(p.ws + OFF_PG) + (size_t)NE * ESLOTS * 1024;
  const float* mod = L.mod + (size_t)tok_modrow(tok) * 6144;
  float s[16];
#pragma unroll
  for (int i = 0; i < 16; ++i) s[i] = 0.f;
  for (int e = 0; e < 16; ++e) {
    int sl = SEL[e];
    if (sl >= 0) {
      const bf16* yr = YS + ((size_t)e * ESLOTS + sl) * 1024;
#pragma unroll
      for (int i = 0; i < 4; ++i) {
        uint2 w = *(const uint2*)(yr + lane * 4 + i * 256);
        s[i * 4] += __uint_as_float(w.x << 16); s[i * 4 + 1] += __uint_as_float(w.x & 0xffff0000u);
        s[i * 4 + 2] += __uint_as_float(w.y << 16); s[i * 4 + 3] += __uint_as_float(w.y & 0xffff0000u);
      }
    }
  }
  float ss = 0.f;
#pragma unroll
  for (int i = 0; i < 16; ++i) ss += s[i] * s[i];
  ss = wave_sum(ss);
  const float rs = rsqrtf(ss * (1.f / 1024.f) + EPS);
  const float* gpf = p.in[I_GPOSTFFN] + L.l * 1024;
  float xv[16], h[16];
  float* dst = X;
  if (L.last) { const int b = tok_b(tok), j = tok_j(tok); dst = p.out + ((size_t)b * SEQ + (j - CTXL)) * 1024; }
#pragma unroll
  for (int i = 0; i < 4; ++i) {
    int c = lane * 4 + i * 256;
    float4 xo = *(const float4*)(X + c), gv = *(const float4*)(gpf + c), gt = *(const float4*)(mod + 5120 + c);
    xo.x += gt.x * s[i * 4] * rs * gv.x; xo.y += gt.y * s[i * 4 + 1] * rs * gv.y; xo.z += gt.z * s[i * 4 + 2] * rs * gv.z; xo.w += gt.w * s[i * 4 + 3] * rs * gv.w;
    *(float4*)(dst + c) = xo;
    xv[i * 4] = xo.x; xv[i * 4 + 1] = xo.y; xv[i * 4 + 2] = xo.z; xv[i * 4 + 3] = xo.w;
  }
  if (!L.last) {
    const float* mod1 = (const float*)(p.ws + OFF_MOD) + ((size_t)(L.l + 1) * NB1 + tok_modrow(tok)) * 6144;
    normmod_row(xv, p.in[I_GPREMIX] + (L.l + 1) * 1024, mod1, mod1 + 1024, (bf16*)(p.ws + OFF_HA) + (size_t)tok * 1024, h);
  }
}

enum { PH_PREP0 = 0, PH_PREP1, PH_L0 };
enum { LP_INPROJ = 0, LP_TOKPREP, LP_MIX1, LP_MIX2, LP_GLU, LP_MERGE, LP_OUT, LP_POST, LP_ROUTE, LP_MOE1, LP_MOE2, LP_COMB, LP_COUNT };
constexpr int NPHASES = PH_L0 + DEPTH * LP_COUNT;


DI void run_phase(const Params& p, int ph, char* smem) {
  const int G = gridDim.x;
  int start = blockIdx.x;
  auto seg = [&](int n, auto&& fn) {
    for (; start < n; start += G) fn(start);
    start -= n;
  };
#ifdef ONLY_PREP
  if (ph >= PH_L0) return;
#endif
  if (ph == PH_PREP0) {
    seg(DEPTH * 96, [&](int it) { mod_item(p, it, smem); });
    seg(DEPTH * 32, [&](int it) { s5_tab_item(p, it, smem); });
    seg(1, [&](int) { rope_tab_item(p); });
    seg(DEPTH * CT_EARLY, [&](int it) { conv_early_item(p, it / CT_EARLY, it % CT_EARLY, smem); });
    return;
  }
  if (ph == PH_PREP1) {
    seg(DEPTH * 64, [&](int it) { s5_mat_item(p, it); });
    seg(NTOK / NWAVES, [&](int it) { prep_row_item(p, it); });
    return;
  }
#ifdef ONLY_LPH
  if (ph < PH_L0) return;
#endif
  const int l = (ph - PH_L0) / LP_COUNT;
#ifdef ONLY_LPH
  const int lph = ONLY_LPH;
#else
  const int lph = (ph - PH_L0) % LP_COUNT;
#endif
  const LP L = make_lp(p, l);
  switch (lph) {
    case LP_INPROJ:
      seg(L.last ? IP_SLOTS_LAST : IP_SLOTS_ALL, [&](int it) { inproj_tile(p, L, it, smem); });
      break;
    case LP_TOKPREP:
      seg(16 * S5_MT * 2, [&](int it) { s5a_tile(p, L, it, smem); });
      seg(TP_MT * 3, [&](int it) { mlaq_tile(p, L, it, smem); });
      seg(TP_MT * 4, [&](int it) { mlakv_tile(p, L, it, smem); });
      seg(NTOK / 64, [&](int it) { navt_item(p, it, smem); });
      seg(M2C_ITEMS, [&](int it) { m2conv_item(p, L, it); });
      seg(M2S_ITEMS, [&](int it) { m2scal_item(p, L, it); });
      break;
    case LP_MIX1: {
      const int n0 = BATCH * 4, n1 = n0 + 2 * 16 * BATCH / NWAVES, n2 = n1 + BATCH * 4 * (SEQ / 256), n3 = n2 + BATCH * 4 * (SEQ / 256);
      const int n4 = n3 + (L.last ? 0 : BATCH * 4 * ((CTXL + 255) / 256)), n5 = n4 + (L.last ? 0 : BATCH * 4 * ((CTXL + 255) / 256));
      int* qhead = (int*)(p.ws + OFF_BAR) + Q_WORD0 + 64 * (l + 2 * p.probe_rep);
#ifdef EMU
      volatile int* bc = (volatile int*)(smem + SMEM_BYTES + 8);
#else
      volatile LAS int* bc = (volatile LAS int*)(smem + SMEM_BYTES + 8);
#endif
      for (;;) {
        __syncthreads();
        if (tid_() == 0) {
#ifdef EMU
          *bc = atomicAdd(qhead, 1);
#else
          *bc = __hip_atomic_fetch_add(qhead, 1, __ATOMIC_RELAXED, __HIP_MEMORY_SCOPE_AGENT);
#endif
        }
        __syncthreads();
        const int it = *bc;
        if (it >= n5) break;
        if (it < n0) m2scan_item(p, L, it, smem);
        else if (it < n1) s5carry_item(p, L, it - n0);
        else if (it < n2) mla_attn_item(p, it - n1, false, smem);
        else if (it < n3) na_attn_item(p, L, it - n2, false, smem);
        else if (it < n4) mla_attn_item(p, it - n3, true, smem);
        else na_attn_item(p, L, it - n4, true, smem);
      }
    } break;
    case LP_MIX2:
      seg(16 * S5_MT * 2, [&](int it) { s5c_tile(p, L, it, smem); });
      seg(NTOK / NWAVES, [&](int it) { m2gate_item(p, L, it); });
      break;
    case LP_GLU:
      seg(GLU_MT * 2, [&](int it) { glu_tile(p, L, it, smem); });
      break;
    case LP_MERGE:
      seg(mtiles(L.last, 256) * 8, [&](int it) { merge_tile(p, L, it, smem); });
      break;
    case LP_OUT:
      seg(mtiles(L.last, 256) * 4, [&](int it) { outproj_tile(p, L, it, smem); });
      break;
    case LP_POST:
      seg(CT_EXP, [&](int it) { conv_expert_item(p, l, it, smem); });
      post_stage_router(p, L, smem);
      seg(post_ntok(L.last) / NWAVES, [&](int it) { post_item(p, L, it, smem); });
      break;
    case LP_ROUTE:
      seg(BATCH * 16 * (L.last ? 1 : 2), [&](int it) { route_item(p, L, it, smem); });
      break;
    case LP_MOE1:
      seg(NE * (((L.last ? ESLOTS_L : ESLOTS) + 255) / 256) * 8, [&](int it) { moe1_tile(p, L, it, smem); });
      break;
    case LP_MOE2:
      seg(NE * (((L.last ? ESLOTS_L : ESLOTS) + 255) / 256) * 4, [&](int it) { moe2_tile(p, L, it, smem); });
      break;
    case LP_COMB:
      seg(post_ntok(L.last) / NWAVES, [&](int it) { comb_item(p, L, it); });
      break;
  }
}

__global__ void __launch_bounds__(NTHREADS, 2) mega_kernel(Params p) {
#ifdef EMU
  char* smem = emu_cur_f->blk->smem;
  for (int ph = p.phase_lo; ph < p.phase_hi; ++ph) {
    run_phase(p, ph, smem);
    if (ph + 1 < p.phase_hi) emu_grid_sync();
  }
#else
  __shared__ __attribute__((aligned(16))) char smem[SMEM_BYTES + 16 + 256];
  {
    const unsigned hw = (unsigned)__builtin_amdgcn_s_getreg((5 << 11) | 4) & 0x3fu;
    if ((threadIdx.x & 63) == 0) *(volatile int*)(smem + WAVE_TAB_OFF + hw * 4u) = (int)(threadIdx.x >> 6);
    __syncthreads();
  }
  if (p.phase_hi - p.phase_lo > 1) {
    if (threadIdx.x == 0) *(uint4*)(smem + SMEM_BYTES) = make_uint4(0u, 0u, 0u, 0u);
    __syncthreads();
    XcdBarrier xb = xcd_barrier_post((unsigned*)(p.ws + OFF_BAR), (volatile LAS unsigned*)(smem + SMEM_BYTES));
    for (int ph = p.phase_lo; ph < p.phase_hi; ++ph) {
      int reps = 1;
#ifdef PROBE_PHASE
      if (ph == PROBE_PHASE || ph == PROBE_PHASE2) reps = 1 + PROBE_REP;
#endif
      for (int rep = 0; rep < reps; ++rep) {
        p.probe_rep = rep;
        run_phase(p, ph, smem);
        if (ph + 1 < p.phase_hi || rep + 1 < reps) {
          if (ph == p.phase_lo && rep == 0) cg::this_grid().sync();
          else xcd_barrier(xb);
        }
      }
    }
  } else {
    run_phase(p, p.phase_lo, smem);
  }
#endif
}

#ifndef EMU
extern "C" void kernel_launch(void* const* d_in, const int* in_sizes, int n_in, void* d_out, int out_size, void* d_ws, size_t ws_size,
                              hipStream_t stream) {
  static int grid_blocks = 0;
  if (!grid_blocks) {
    int dev = 0, cus = 0, per_cu = 0;
    hipGetDevice(&dev);
    hipDeviceGetAttribute(&cus, hipDeviceAttributeMultiprocessorCount, dev);
    hipOccupancyMaxActiveBlocksPerMultiprocessor(&per_cu, mega_kernel, NTHREADS, 0);
    if (per_cu > 1) per_cu = 1;
    if (per_cu < 1) per_cu = 1;
    grid_blocks = cus * per_cu;
    if (ws_size < WS_TOTAL) fprintf(stderr, "workspace too small: %zu < %zu\n", ws_size, (size_t)WS_TOTAL);
  }
  Params p{};
  for (int i = 0; i < N_INPUTS; ++i) p.in[i] = (const float*)d_in[i];
  p.out = (float*)d_out;
  p.ws = (char*)d_ws;
#if MK_MULTI
  for (int ph = 0; ph < NPHASES; ++ph) {
    p.phase_lo = ph; p.phase_hi = ph + 1;
    hipLaunchKernelGGL(mega_kernel, dim3(grid_blocks), dim3(NTHREADS), 0, stream, p);
  }
#else
  p.phase_lo = 0; p.phase_hi = NPHASES;
  hipMemsetAsync((char*)d_ws + OFF_BAR, 0, BAR_BYTES, stream);
  void* args[] = {&p};
  hipError_t e = hipLaunchCooperativeKernel((void*)mega_kernel, dim3(grid_blocks), dim3(NTHREADS), args, 0, stream);
  if (e != hipSuccess) fprintf(stderr, "cooperative launch failed: %s (grid %d)\n", hipGetErrorString(e), grid_blocks);
#endif
}
#endif
```

```cpp
#ifdef EMU
#include "emu.h"
#else
#include <hip/hip_runtime.h>
#include <hip/hip_cooperative_groups.h>
#include <cstdio>
namespace cg = cooperative_groups;
using bf16x8 = __attribute__((ext_vector_type(8))) short;
using f32x4 = __attribute__((ext_vector_type(4))) float;
using f32x16 = __attribute__((ext_vector_type(16))) float;
#endif
using u32x4 = __attribute__((ext_vector_type(4))) unsigned;
#ifndef MK_MULTI
#define MK_MULTI 0
#endif

#define DI __device__ __forceinline__
typedef unsigned short bf16;

#ifdef EMU_SMALL2
constexpr int BATCH = 2, SEQ = 1024, CTXL = 64, GRID_W = 32;
#elif defined(EMU_SMALL)
constexpr int BATCH = 2, SEQ = 512, CTXL = 64, GRID_W = 32;
#else
constexpr int BATCH = 8, SEQ = 2048, CTXL = 256, GRID_W = 64;
#endif
constexpr int D = 1024, DEPTH = 2;
constexpr int TOK = CTXL + SEQ, NTOK = BATCH * TOK;
constexpr int ROWS = SEQ / GRID_W;
constexpr int WIN_R = (ROWS < 8 ? ROWS : 8), WIN_C = 16;
constexpr int N_IN = 6568, N_INP = 6656;
constexpr int C_CQ = 0, C_CKV = 256, C_KR = 384, C_NA = 416, C_S5 = 1184, C_Z = 1440, C_XBC = 1696, C_DT = 2464, C_GATE = 2472;
constexpr int P1W = 2480;
constexpr int NCH = TOK / 16, NCC = CTXL / 16, MCH = BATCH * NCH;
constexpr int NE = 16;
constexpr int CAP_L = 2 * SEQ / NE, CAP_C = 2 * CTXL / NE;
constexpr int ESLOTS = BATCH * (CAP_L + CAP_C), ESLOTS_L = BATCH * CAP_L;
constexpr int NB1 = BATCH + 1;
constexpr float EPS = 1e-6f;
constexpr int SMEM_BYTES = 147456;
constexpr int NTHREADS = 512, NWAVES = NTHREADS / 64;

enum { I_X = 0, I_C, I_CTX, I_CCTX, I_WADA, I_BADA, I_GPREMIX, I_GPOSTMIX, I_GPREFFN, I_GPOSTFFN, I_WIN, I_GCQ, I_GCKV, I_WUQ, I_WUKV, I_RPB,
       I_S5ARE, I_S5AIM, I_S5LOGSTEP, I_S5BRE, I_S5BIM, I_S5CRE, I_S5CIM, I_S5D, I_S5WGLU, I_S5BGLU, I_M2CONVW, I_M2CONVB, I_M2ALOG, I_M2DTBIAS,
       I_M2D, I_M2GNORM, I_WBRANCH, I_WOUT, I_WROUTER, I_WGATE, I_WUP, I_WDOWN, N_INPUTS };

constexpr size_t al256(size_t x) { return (x + 255) & ~(size_t)255; }
constexpr size_t SZ_X = (size_t)NTOK * D * 4;
constexpr size_t SZ_ROWBF = (size_t)NTOK * D * 2;
constexpr size_t OFF_X = 0;
constexpr size_t OFF_MOD = OFF_X + al256(SZ_X);
constexpr size_t OFF_HA = OFF_MOD + al256((size_t)DEPTH * NB1 * 6144 * 4);
constexpr size_t OFF_O = OFF_HA + al256(SZ_ROWBF);
constexpr size_t OFF_P1 = OFF_O + al256(SZ_ROWBF);
constexpr size_t SZ_P1 = (size_t)NTOK * P1W * 2;
constexpr size_t OFF_PG = OFF_P1 + al256(SZ_P1);
constexpr size_t SZ_PG = (size_t)NTOK * 4096 * 2;
constexpr size_t OFF_DT = OFF_PG + al256(SZ_PG);
constexpr size_t OFF_AFF = OFF_DT + al256((size_t)NTOK * 8 * 4);
constexpr size_t OFF_SEL = OFF_AFF + al256((size_t)NTOK * 16 * 4);
constexpr size_t OFF_IDX = OFF_SEL + al256((size_t)NTOK * 16 * 4);
constexpr size_t OFF_GW = OFF_IDX + al256((size_t)NE * ESLOTS * 4);
constexpr size_t OFF_BAR = OFF_GW + al256((size_t)NE * ESLOTS * 4);
constexpr size_t BAR_BYTES = (3456 + 64 * 4) * 4;
constexpr int Q_WORD0 = 3456;
constexpr size_t OFF_ROPE = OFF_BAR + al256(BAR_BYTES);
constexpr size_t OFF_WEARLY = OFF_ROPE + al256(64 * 8 * 2 * 4);
constexpr size_t WE_WIN = 0;
constexpr size_t WE_UQ = WE_WIN + (size_t)N_INP * 1024 * 2;
constexpr size_t WE_UKV = WE_UQ + (size_t)384 * 256 * 2;
constexpr size_t WE_GLU = WE_UKV + (size_t)512 * 128 * 2;
constexpr size_t WE_WB = WE_GLU + (size_t)256 * 256 * 2;
constexpr size_t WE_WOUT = WE_WB + (size_t)4 * 1024 * 256 * 2;
constexpr size_t WE_SIZE = al256(WE_WOUT + (size_t)1024 * 1024 * 2);
constexpr size_t OFF_S5TAB = OFF_WEARLY + DEPTH * WE_SIZE;
constexpr size_t S5_LAMPOW = 0;
constexpr size_t S5_BBAR = S5_LAMPOW + (size_t)2 * 16 * 17 * 64 * 2 * 4;
constexpr size_t S5_KT = S5_BBAR + (size_t)2 * 16 * 64 * 16 * 2 * 4;
constexpr size_t S5_WA = S5_KT + (size_t)2 * 16 * 16 * 256 * 4;
constexpr size_t S5_W2 = S5_WA + (size_t)16 * 256 * 256 * 2;
constexpr size_t S5_SIZE = al256(S5_W2 + (size_t)16 * 256 * 512 * 2);
constexpr size_t OFF_MIX = OFF_S5TAB + DEPTH * S5_SIZE;
constexpr size_t MX_Q = 0;
constexpr size_t MX_K = MX_Q + al256((size_t)BATCH * 4 * TOK * 96 * 2);
constexpr size_t MX_VTM = MX_K + al256((size_t)BATCH * 4 * TOK * 96 * 2);
constexpr size_t MX_VTN = MX_VTM + al256((size_t)BATCH * 4 * 64 * TOK * 2);
constexpr size_t MX_XBC = MX_VTN + al256((size_t)BATCH * 4 * 64 * TOK * 2);
constexpr size_t MX_US5 = MX_XBC + al256((size_t)NTOK * 768 * 2);
constexpr size_t MX_HEND = MX_US5 + al256((size_t)NTOK * 256 * 2);
constexpr size_t MX_HIN = MX_HEND + al256((size_t)16 * MCH * 256 * 4);
constexpr size_t MX_Z = MX_HIN + al256((size_t)16 * MCH * 256 * 2);
constexpr size_t MX_XBT = MX_Z + al256((size_t)NTOK * 256 * 2);
constexpr size_t MX_M2S = MX_XBT + al256((size_t)NTOK * 512 * 2);
constexpr size_t MX_SIZE = MX_M2S + al256((size_t)BATCH * 8 * TOK * 4 * 4);
constexpr size_t WX_GU = 0;
constexpr size_t WX_DN = WX_GU + (size_t)NE * 2048 * 1024 * 2;
constexpr size_t WX_SIZE = WX_DN + (size_t)NE * 1024 * 1024 * 2;
constexpr size_t MIXREG = (MX_SIZE > WX_SIZE ? MX_SIZE : WX_SIZE);
constexpr size_t WS_TOTAL = OFF_MIX + al256(MIXREG);

struct Params {
  const float* in[N_INPUTS];
  float* out;
  char* ws;
  int phase_lo, phase_hi;
  int probe_rep, pad_;
};

constexpr int WAVE_TAB_OFF = SMEM_BYTES + 16;
DI int tid_() {
#ifdef EMU
  return (int)threadIdx.x;
#else
  const unsigned hw = (unsigned)__builtin_amdgcn_s_getreg((5 << 11) | 4) & 0x3fu;
  const int wave = *(volatile __attribute__((address_space(3))) int*)(unsigned long)(WAVE_TAB_OFF + hw * 4u);
  int lane;
  asm volatile("v_mbcnt_lo_u32_b32 %0, -1, 0\n\tv_mbcnt_hi_u32_b32 %0, -1, %0" : "=v"(lane));
  return wave * 64 + lane;
#endif
}
#ifdef EMU
template <class T> DI T shfl_xor_(T v, int m) { return __shfl_xor(v, m); }
template <class T> DI T shfl_up_(T v, int d) { return __shfl_up(v, d); }
template <class T> DI T shfl_(T v, int src) { return __shfl(v, src); }
#else
template <class T> DI T shfl_xor_(T v, int m) {
  const int idx = ((tid_() & 63) ^ m) << 2;
  return __builtin_bit_cast(T, __builtin_amdgcn_ds_bpermute(idx, __builtin_bit_cast(int, v)));
}
template <class T> DI T shfl_up_(T v, int d) {
  const int l = tid_() & 63; const int idx = (l >= d ? l - d : l) << 2;
  return __builtin_bit_cast(T, __builtin_amdgcn_ds_bpermute(idx, __builtin_bit_cast(int, v)));
}
template <class T> DI T shfl_(T v, int src) {
  int idx = src << 2; asm volatile("" : "+v"(idx));
  return __builtin_bit_cast(T, __builtin_amdgcn_ds_bpermute(idx, __builtin_bit_cast(int, v)));
}
#endif
DI float bf2f(bf16 h) { return __uint_as_float(((unsigned)h) << 16); }
DI bf16 f2bf(float f) { unsigned u = __float_as_uint(f); u += 0x7fffu + ((u >> 16) & 1u); return (bf16)(u >> 16); }
#ifdef EMU
DI unsigned pack2(float a, float b) { return (unsigned)f2bf(a) | ((unsigned)f2bf(b) << 16); }
DI float exp2f_(float x) { return exp2f(x); }
#else
typedef float f32x2_t_ __attribute__((ext_vector_type(2)));
typedef __bf16 bf16x2_t_ __attribute__((ext_vector_type(2)));
DI unsigned pack2(float a, float b) { const f32x2_t_ v = {a, b}; return __builtin_bit_cast(unsigned, __builtin_convertvector(v, bf16x2_t_)); }
DI float exp2f_(float x) { return __builtin_amdgcn_exp2f(x); }
#endif
DI float sigmoidf_(float x) { return 1.0f / (1.0f + __expf(-x)); }
DI float siluf_(float x) { return x / (1.0f + __expf(-x)); }
DI float softplusf_(float x) { const float ax = x < 0.f ? -x : x; return (x > 0.f ? x : 0.f) + __logf(1.0f + __expf(-ax)); }
DI float geluf_(float x) { const float u2 = 1.5957691216057308f * (x + 0.044715f * x * x * x); return x / (1.0f + __expf(-u2)); }
DI bool wave_all_(bool c) {
#ifdef EMU
  int v = c ? 0 : 1;
  v += shfl_xor_(v, 32); v += shfl_xor_(v, 16); v += shfl_xor_(v, 8); v += shfl_xor_(v, 4); v += shfl_xor_(v, 2); v += shfl_xor_(v, 1);
  return v == 0;
#else
  return __builtin_amdgcn_ballot_w64(!c) == 0ull;
#endif
}
DI float wave_sum(float v) {
#ifdef EMU
  v += shfl_xor_(v, 32); v += shfl_xor_(v, 16); v += shfl_xor_(v, 8); v += shfl_xor_(v, 4); v += shfl_xor_(v, 2); v += shfl_xor_(v, 1);
  return v;
#else
  int x = __float_as_int(v);
  x = __float_as_int(__int_as_float(x) + __int_as_float(__builtin_amdgcn_update_dpp(0, x, 0xB1, 0xF, 0xF, true)));
  x = __float_as_int(__int_as_float(x) + __int_as_float(__builtin_amdgcn_update_dpp(0, x, 0x4E, 0xF, 0xF, true)));
  x = __float_as_int(__int_as_float(x) + __int_as_float(__builtin_amdgcn_update_dpp(0, x, 0x141, 0xF, 0xF, true)));
  x = __float_as_int(__int_as_float(x) + __int_as_float(__builtin_amdgcn_update_dpp(0, x, 0x140, 0xF, 0xF, true)));
  const float r0 = __int_as_float(__builtin_amdgcn_readlane(x, 0)), r1 = __int_as_float(__builtin_amdgcn_readlane(x, 16));
  const float r2 = __int_as_float(__builtin_amdgcn_readlane(x, 32)), r3 = __int_as_float(__builtin_amdgcn_readlane(x, 48));
  return (r0 + r1) + (r2 + r3);
#endif
}
#ifndef EMU
#define XB_TMO      128
#define XB_XCNT(j)  (256  + 64 * (j))
#define XB_XSUB(j)  (1280 + 64 * (j))
#define XB_XGEN(j)  (2304 + 64 * (j))
#define XB_TOP      3328
#define XB_TOPGEN   3392
#define XB_SPIN_CAP (1u << 24)
#define LAS __attribute__((address_space(3)))
DI unsigned xb_ld(unsigned* p) { return __hip_atomic_load(p, __ATOMIC_RELAXED, __HIP_MEMORY_SCOPE_AGENT); }
DI unsigned xb_add(unsigned* p, unsigned v) { return __hip_atomic_fetch_add(p, v, __ATOMIC_RELAXED, __HIP_MEMORY_SCOPE_AGENT); }
DI unsigned xb_xcc_id() { return (unsigned)__builtin_amdgcn_s_getreg((3 << 11) | 20) & 0xFu; }
#define XB_SPIN(cond, bar) do { unsigned _sp = 0; while (cond) { __builtin_amdgcn_s_sleep(1); \
    if ((++_sp & 255u) == 0u) { if (xb_ld(&(bar)[XB_TMO])) break; if (_sp > XB_SPIN_CAP) { atomicAdd(&(bar)[XB_TMO], 1u); break; } } } } while (0)
struct XcdBarrier { unsigned* bar; unsigned x; volatile LAS unsigned* st; };
DI XcdBarrier xcd_barrier_post(unsigned* bar, volatile LAS unsigned* st) {
  XcdBarrier b; b.bar = bar; b.x = xb_xcc_id(); b.st = st;
  if (threadIdx.x == 0) (void)xb_add(&bar[XB_XCNT(b.x)], 1u);
  return b;
}
DI void xcd_barrier_complete(unsigned* bar, unsigned x, unsigned& nloc, unsigned& nx) {
  const unsigned G = gridDim.x * gridDim.y * gridDim.z;
  unsigned sum, cnt, mine, sp = 0u;
  for (;;) {
    sum = 0u; cnt = 0u; mine = 0u;
#pragma unroll
    for (unsigned j = 0; j < 16; ++j) { const unsigned c = xb_ld(&bar[XB_XCNT(j)]); sum += c; cnt += (c > 0u) ? 1u : 0u; mine = (j == x) ? c : mine; }
    if (sum == G) break;
    __builtin_amdgcn_s_sleep(1);
    if ((++sp & 255u) == 0u) { if (xb_ld(&bar[XB_TMO])) break; if (sp > XB_SPIN_CAP) { atomicAdd(&bar[XB_TMO], 1u); break; } }
  }
  nloc = mine > 0u ? mine : 1u; nx = cnt > 0u ? cnt : 1u;
}
DI void xcd_barrier(const XcdBarrier& b) {
  asm volatile("s_waitcnt vmcnt(0)" ::: "memory");
  __syncthreads();
  if (threadIdx.x == 0) {
    unsigned* bar = b.bar;
    __builtin_amdgcn_s_waitcnt(0);
    unsigned nloc = b.st[0], nx = b.st[1];
    if (nloc == 0u) { xcd_barrier_complete(bar, b.x, nloc, nx); b.st[0] = nloc; b.st[1] = nx; }
    const unsigned old = xb_add(&bar[XB_XSUB(b.x)], 1u);
    const unsigned gen = old / nloc;
    if (old + 1u == (gen + 1u) * nloc) {
      __builtin_amdgcn_fence(__ATOMIC_RELEASE, "agent");
      asm volatile("s_waitcnt vmcnt(0)" ::: "memory");
      const unsigned og = xb_add(&bar[XB_TOP], 1u);
      const unsigned tg = og / nx;
      if (og + 1u == (tg + 1u) * nx) xb_add(&bar[XB_TOPGEN], 1u);
      else XB_SPIN(xb_ld(&bar[XB_TOPGEN]) == tg, bar);
      __builtin_amdgcn_fence(__ATOMIC_ACQUIRE, "agent");
      xb_add(&bar[XB_XGEN(b.x)], 1u);
      asm volatile("s_waitcnt vmcnt(0)" ::: "memory");
    } else {
      XB_SPIN(xb_ld(&bar[XB_XGEN(b.x)]) == gen, bar);
      __builtin_amdgcn_fence(__ATOMIC_ACQUIRE, "agent");
      asm volatile("s_waitcnt vmcnt(0)" ::: "memory");
    }
  }
  __syncthreads();
}
#endif

struct GA {
  const bf16* A; const bf16* A2; int lda, lda2, ksplit;
  const int* ridx; int mvalid;
  const bf16* Bt; int ldb; int K;
  int kfix;
};
DI GA make_ga(const bf16* A, int lda, const bf16* Bt, int ldb, int K, int mvalid) {
  GA g; g.A = A; g.A2 = A; g.lda = lda; g.lda2 = lda; g.ksplit = K; g.ridx = nullptr; g.mvalid = mvalid; g.Bt = Bt; g.ldb = ldb; g.K = K; g.kfix = 0; return g;
}

#ifdef EMU
#define GLDS16(gptr_, lptr_) memcpy((void*)(lptr_), (const void*)(gptr_), 16)
#define BGLDS16(rsrc_, base_, voff_, soff_, lptr_) memcpy((void*)(lptr_), (const char*)(base_) + (voff_) + (soff_), 16)
#define GEMM_WAIT(N_)
#define RAW_BARRIER() __syncthreads()
#else
#define LASV __attribute__((address_space(3))) void
#define GLDS16(gptr_, lptr_) __builtin_amdgcn_global_load_lds((const void*)(gptr_), (LASV*)(lptr_), 16, 0, 0)
#define BGLDS16(rsrc_, base_, voff_, soff_, lptr_) __builtin_amdgcn_raw_ptr_buffer_load_lds(rsrc_, (LASV*)(lptr_), 16, (int)(voff_), (int)(soff_), 0, 0)
#define GEMM_WAIT(N_) asm volatile("s_waitcnt vmcnt(%0)" :: "n"(N_) : "memory")
#define RAW_BARRIER() { asm volatile("" ::: "memory"); __builtin_amdgcn_s_barrier(); asm volatile("" ::: "memory"); }
#endif
DI int perm32(int rho) { const int n = rho >> 4, i = rho & 15; return 8 * (i >> 2) + 4 * n + (i & 3); }
constexpr int SRS_OFF = 73728;
template <int NT>
DI void gemm_s(const GA& g, int m0, int n0, char* smem, f32x4 (&acc)[4][NT]) {
  constexpr int A_ELEMS = 256 * 32, B_ELEMS = 32 * NT * 32, STAGE = A_ELEMS + B_ELEMS;
  bf16* st = (bf16*)smem;
  const int tid = tid_(), lane = tid & 63, wid = tid >> 6, wr = wid >> 1, wc = wid & 1, fr = lane & 15, fq = lane >> 4;
  const int lrow = tid >> 2, pch = tid & 3;
  long aoff[2], aoff2[2], boff;
#pragma unroll
  for (int i = 0; i < 2; ++i) {
    const int row = lrow + 128 * i;
    const int lch = pch ^ ((-(row >> 2)) & 3);
    int gm = m0 + row; if (gm > g.mvalid - 1) gm = g.mvalid - 1;
    const int ar = g.ridx ? g.ridx[gm] : gm;
    aoff[i] = (long)ar * g.lda + lch * 8;
    aoff2[i] = (long)ar * g.lda2 + lch * 8;
  }
  const int cb = (NT == 4) ? tid : (tid & 255);
  {
    const int row = cb >> 2;
    const int lch = pch ^ ((-(row >> 2)) & 3);
    const int src = n0 + (row & ~31) + perm32(row & 31);
    boff = (long)src * g.ldb + lch * 8;
  }
#pragma unroll
  for (int m = 0; m < 4; ++m)
#pragma unroll
    for (int n = 0; n < NT; ++n) acc[m][n] = f32x4{0.f, 0.f, 0.f, 0.f};
  const int T = g.K / 32;
#define GEMM_DMA(t_, stg_) { const int k0_ = (t_) * 32; const bool seg2_ = (k0_ >= g.ksplit); bf16* sa_ = st + (stg_) * STAGE; \
    _Pragma("unroll") for (int i_ = 0; i_ < 2; ++i_) { \
      const bf16* ap_ = seg2_ ? (g.A2 + aoff2[i_] + (k0_ - g.ksplit)) : (g.A + aoff[i_] + k0_); \
      GLDS16(ap_, sa_ + (tid + i_ * 512) * 8); } \
    GLDS16(g.Bt + boff + k0_, sa_ + A_ELEMS + cb * 8); }
  __syncthreads();
  GEMM_DMA(0, 0)
  if (T > 1) GEMM_DMA(1, 1)
  int s_cur = 0, s_nxt = 2;
#pragma unroll 1
  for (int t = 0; t < T; ++t) {
    if (t + 1 < T) { GEMM_WAIT(3); } else { GEMM_WAIT(0); }
    RAW_BARRIER();
    if (t + 2 < T) GEMM_DMA(t + 2, s_nxt)
    const bf16* sa = st + s_cur * STAGE;
    const bf16* sb = sa + A_ELEMS;
    bf16x8 af[4], bfr[NT];
#pragma unroll
    for (int n = 0; n < NT; ++n) {
      const int row = wc * (16 * NT) + n * 16 + fr;
      bfr[n] = *(const bf16x8*)(sb + row * 32 + ((fq ^ ((-(row >> 2)) & 3)) << 3));
    }
#pragma unroll
    for (int m = 0; m < 4; ++m) {
      const int row = wr * 64 + m * 16 + fr;
      af[m] = *(const bf16x8*)(sa + row * 32 + ((fq ^ ((-(row >> 2)) & 3)) << 3));
    }
#pragma unroll
    for (int m = 0; m < 4; ++m)
#pragma unroll
      for (int n = 0; n < NT; ++n) acc[m][n] = __builtin_amdgcn_mfma_f32_16x16x32_bf16(bfr[n], af[m], acc[m][n], 0, 0, 0);
    s_cur = (s_cur == 2) ? 0 : s_cur + 1;
    s_nxt = (s_nxt == 2) ? 0 : s_nxt + 1;
  }
}
constexpr int BG_HT = 128 * 64;
DI int lds_byte(int r, int c) { const int stt = (r >> 4) * 2 + (c >> 5), rr = r & 15, cc = c & 31, ob = rr * 64 + cc * 2; return stt * 1024 + (ob ^ (((ob >> 9) & 1) << 5)); }
DI void stage_rc(int b, int& R, int& C) { const int stt = b / 1024, sb = b % 1024, swz = sb ^ (((sb >> 9) & 1) << 5); R = (stt >> 1) * 16 + swz / 64; C = (stt & 1) * 32 + (swz % 64) / 2; }
#ifdef EMU
#define BG_WAIT_V(n)
#define BG_WAIT_L(n)
#define BG_BAR __syncthreads()
#define BG_SCHED
#define BG_PRIO(x)
#else
#define BG_WAIT_V(n) asm volatile("s_waitcnt vmcnt(" #n ")" ::: "memory")
#define BG_WAIT_L(n) asm volatile("s_waitcnt lgkmcnt(" #n ")" ::: "memory")
#define BG_BAR __builtin_amdgcn_s_barrier()
#define BG_SCHED __builtin_amdgcn_sched_barrier(0)
#define BG_PRIO(x) __builtin_amdgcn_s_setprio(x)
#endif
DI void gemm_big(const GA& g, int m0, int n0, char* smem, f32x4 (&acc)[2][2][4][2]) {
  bf16* shm = (bf16*)smem;
  const int tid = tid_(), wid = tid >> 6, lane = tid & 63, wr = wid >> 2, wc = wid & 3, fr = lane & 15, fq = lane >> 4;
  unsigned aof[2][2], bof[2];
#ifdef EMU
  const int dma_lds = tid * 16;
#else
  const int dma_lds = __builtin_amdgcn_readfirstlane(tid >> 6) * 1024;
#endif
#ifndef EMU
  const __amdgpu_buffer_rsrc_t rsA = __builtin_amdgcn_make_buffer_rsrc((void*)g.A, 0, 0x7fffffff, 0x00020000);
  const __amdgpu_buffer_rsrc_t rsB = __builtin_amdgcn_make_buffer_rsrc((void*)g.Bt, 0, 0x7fffffff, 0x00020000);
#endif
#pragma unroll
  for (int i = 0; i < 2; ++i) {
    int R, C; stage_rc(tid * 16 + i * 8192, R, C);
    bof[i] = (unsigned)((n0 + (R & ~31) + perm32(R & 31)) * g.ldb + C) * 2u;
#pragma unroll
    for (int h = 0; h < 2; ++h) {
      int gm = m0 + h * 128 + R; if (gm > g.mvalid - 1) gm = g.mvalid - 1;
      const int ar = g.ridx ? g.ridx[gm] : gm;
      aof[h][i] = (unsigned)(ar * g.lda + C) * 2u;
    }
  }
#define BG_SA(b, h) (shm + ((b) * 2 + (h)) * BG_HT)
#define BG_SB(b, h) (shm + (4 + (b) * 2 + (h)) * BG_HT)
#define BG_STAGE_A(P, h, kt) { \
    _Pragma("unroll") for (int i_ = 0; i_ < 2; ++i_) BGLDS16(rsA, g.A, aof[h][i_], (kt) * 128, (char*)(P) + dma_lds + i_ * 8192); }
#define BG_STAGE_B(P, h, kt) { \
    _Pragma("unroll") for (int i_ = 0; i_ < 2; ++i_) BGLDS16(rsB, g.Bt, bof[i_], (kt) * 128 + (h) * 256 * g.ldb, (char*)(P) + dma_lds + i_ * 8192); }
#define BG_LDA(dst, b, h) _Pragma("unroll") for (int m_ = 0; m_ < 4; ++m_) _Pragma("unroll") for (int k_ = 0; k_ < 2; ++k_) \
    dst[m_][k_] = *(const bf16x8*)((const char*)BG_SA(b, h) + lds_byte(wr * 64 + m_ * 16 + fr, k_ * 32 + fq * 8))
#define BG_LDB(dst, b, h) _Pragma("unroll") for (int n_ = 0; n_ < 2; ++n_) _Pragma("unroll") for (int k_ = 0; k_ < 2; ++k_) \
    dst[n_][k_] = *(const bf16x8*)((const char*)BG_SB(b, h) + lds_byte(wc * 32 + n_ * 16 + fr, k_ * 32 + fq * 8))
#define BG_MMA(ai, bj, At_, Bt_) { BG_PRIO(1); \
    _Pragma("unroll") for (int m_ = 0; m_ < 4; ++m_) _Pragma("unroll") for (int n_ = 0; n_ < 2; ++n_) _Pragma("unroll") for (int k_ = 0; k_ < 2; ++k_) \
      acc[ai][bj][m_][n_] = __builtin_amdgcn_mfma_f32_16x16x32_bf16(Bt_[n_][k_], At_[m_][k_], acc[ai][bj][m_][n_], 0, 0, 0); \
    BG_PRIO(0); }
#pragma unroll
  for (int a_ = 0; a_ < 2; ++a_)
#pragma unroll
    for (int b_ = 0; b_ < 2; ++b_)
#pragma unroll
      for (int m_ = 0; m_ < 4; ++m_)
#pragma unroll
        for (int n_ = 0; n_ < 2; ++n_) acc[a_][b_][m_][n_] = f32x4{0.f, 0.f, 0.f, 0.f};
  bf16x8 At[4][2], B0[2][2], B1[2][2];
  const int nt = g.K / 64;
  __syncthreads();
  BG_STAGE_B(BG_SB(0, 0), 0, 0) BG_STAGE_A(BG_SA(0, 0), 0, 0)
  BG_STAGE_B(BG_SB(0, 1), 1, 0) BG_STAGE_A(BG_SA(0, 1), 1, 0)
  if (wr == 1) BG_BAR;
  BG_WAIT_V(4); BG_BAR;
  BG_STAGE_B(BG_SB(1, 0), 0, 1) BG_STAGE_A(BG_SA(1, 0), 0, 1) BG_STAGE_B(BG_SB(1, 1), 1, 1)
  BG_WAIT_V(6); BG_BAR;
#pragma unroll 1
  for (int t = 0; t < nt - 2; t += 2) {
    BG_LDB(B0, 0, 0); BG_SCHED; BG_LDA(At, 0, 0); BG_STAGE_A(BG_SA(1, 1), 1, t + 1)
    BG_WAIT_L(8); BG_BAR; BG_WAIT_L(0); BG_MMA(0, 0, At, B0) BG_BAR; BG_SCHED;
    BG_LDB(B1, 0, 1); BG_STAGE_B(BG_SB(0, 0), 0, t + 2)
    BG_BAR; BG_WAIT_L(0); BG_MMA(0, 1, At, B1) BG_BAR;
    BG_LDA(At, 0, 1); BG_STAGE_A(BG_SA(0, 0), 0, t + 2)
    BG_BAR; BG_WAIT_L(0); BG_MMA(1, 0, At, B0) BG_BAR; BG_SCHED;
    BG_STAGE_B(BG_SB(0, 1), 1, t + 2)
    BG_WAIT_V(6); BG_BAR; BG_MMA(1, 1, At, B1) BG_BAR;
    BG_LDB(B0, 1, 0); BG_SCHED; BG_LDA(At, 1, 0); BG_STAGE_A(BG_SA(0, 1), 1, t + 2)
    BG_WAIT_L(8); BG_BAR; BG_WAIT_L(0); BG_MMA(0, 0, At, B0) BG_BAR; BG_SCHED;
    BG_LDB(B1, 1, 1); BG_STAGE_B(BG_SB(1, 0), 0, t + 3)
    BG_BAR; BG_WAIT_L(0); BG_MMA(0, 1, At, B1) BG_BAR;
    BG_LDA(At, 1, 1); BG_STAGE_A(BG_SA(1, 0), 0, t + 3)
    BG_BAR; BG_WAIT_L(0); BG_MMA(1, 0, At, B0) BG_BAR; BG_SCHED;
    BG_STAGE_B(BG_SB(1, 1), 1, t + 3)
    BG_WAIT_V(6); BG_BAR; BG_MMA(1, 1, At, B1) BG_BAR;
  }
  { BG_LDB(B0, 0, 0); BG_LDA(At, 0, 0); BG_STAGE_A(BG_SA(1, 1), 1, nt - 1)
    BG_BAR; BG_WAIT_L(0); BG_MMA(0, 0, At, B0) BG_BAR;
    BG_LDB(B1, 0, 1); BG_BAR; BG_WAIT_L(0); BG_MMA(0, 1, At, B1) BG_BAR;
    BG_LDA(At, 0, 1); BG_WAIT_V(4); BG_BAR; BG_WAIT_L(0); BG_MMA(1, 0, At, B0) BG_MMA(1, 1, At, B1) BG_BAR; }
  { BG_LDB(B0, 1, 0); BG_LDA(At, 1, 0); BG_WAIT_V(2); BG_BAR; BG_WAIT_L(0); BG_MMA(0, 0, At, B0) BG_BAR;
    BG_LDB(B1, 1, 1); BG_WAIT_V(0); BG_BAR; BG_WAIT_L(0); BG_MMA(0, 1, At, B1) BG_BAR;
    BG_LDA(At, 1, 1); BG_BAR; BG_WAIT_L(0); BG_MMA(1, 0, At, B0) BG_MMA(1, 1, At, B1) BG_BAR; }
  if (wr == 0) BG_BAR;
}
#define EPIB_BEGIN(acc_, m0_, n0_, mvalid_) { const int _l = tid_() & 63, _w = tid_() >> 6, _wr = _w >> 2, _wc = _w & 3, _fr = _l & 15, _fq = _l >> 4; \
  _Pragma("unroll") for (int _ai = 0; _ai < 2; ++_ai) _Pragma("unroll") for (int _m = 0; _m < 4; ++_m) { const int row = (m0_) + _ai * 128 + _wr * 64 + _m * 16 + _fr; \
  _Pragma("unroll") for (int _bj = 0; _bj < 2; ++_bj) { const int col = (n0_) + _bj * 128 + _wc * 32 + 8 * _fq; (void)col; \
    float v[8] = {acc_[_ai][_bj][_m][0][0], acc_[_ai][_bj][_m][0][1], acc_[_ai][_bj][_m][0][2], acc_[_ai][_bj][_m][0][3], \
                  acc_[_ai][_bj][_m][1][0], acc_[_ai][_bj][_m][1][1], acc_[_ai][_bj][_m][1][2], acc_[_ai][_bj][_m][1][3]}; \
    if (row < (mvalid_)) {
#define EPIB_END }}}}

DI void ld8bf(const bf16* p, float (&v)[8]) {
  uint4 w = *(const uint4*)p;
  v[0] = __uint_as_float(w.x << 16); v[1] = __uint_as_float(w.x & 0xffff0000u); v[2] = __uint_as_float(w.y << 16); v[3] = __uint_as_float(w.y & 0xffff0000u);
  v[4] = __uint_as_float(w.z << 16); v[5] = __uint_as_float(w.z & 0xffff0000u); v[6] = __uint_as_float(w.w << 16); v[7] = __uint_as_float(w.w & 0xffff0000u);
}
DI void st8bf(bf16* p, const float (&v)[8]) { *(uint4*)p = make_uint4(pack2(v[0], v[1]), pack2(v[2], v[3]), pack2(v[4], v[5]), pack2(v[6], v[7])); }
DI void st8f(float* p, const float (&v)[8]) { *(float4*)p = make_float4(v[0], v[1], v[2], v[3]); *(float4*)(p + 4) = make_float4(v[4], v[5], v[6], v[7]); }
#define EPI_BEGIN(NT_, acc_, m0_, n0_, mvalid_) { const int _l = tid_() & 63, _w = tid_() >> 6, _wr = _w >> 1, _wc = _w & 1, _fr = _l & 15, _fq = _l >> 4; \
  _Pragma("unroll") for (int _m = 0; _m < 4; ++_m) { const int row = (m0_) + _wr * 64 + _m * 16 + _fr; \
  _Pragma("unroll") for (int _q = 0; _q < (NT_) / 2; ++_q) { const int col = (n0_) + _wc * (16 * (NT_)) + _q * 32 + 8 * _fq; (void)col; \
    float v[8] = {acc_[_m][2 * _q][0], acc_[_m][2 * _q][1], acc_[_m][2 * _q][2], acc_[_m][2 * _q][3], \
                  acc_[_m][2 * _q + 1][0], acc_[_m][2 * _q + 1][1], acc_[_m][2 * _q + 1][2], acc_[_m][2 * _q + 1][3]}; \
    if (row < (mvalid_)) {
#define EPI_END }}}}

DI int mtile_row0(int mt, bool latonly, int TH) {
  if (!latonly) return mt * TH;
  const int per = SEQ / TH, b = mt / per, r = mt % per;
  return b * TOK + CTXL + r * TH;
}
DI int mtiles(bool latonly, int TH) { return latonly ? BATCH * (SEQ / TH) : (NTOK + TH - 1) / TH; }

struct LP {
  int l; bool last;
  const float* mod;
  char* we;
  char* s5;
};
DI LP make_lp(const Params& p, int l) {
  LP q; q.l = l; q.last = (l == DEPTH - 1);
  q.mod = (const float*)(p.ws + OFF_MOD) + (size_t)l * NB1 * 6144;
  q.we = p.ws + OFF_WEARLY + (size_t)l * WE_SIZE;
  q.s5 = p.ws + OFF_S5TAB + (size_t)l * S5_SIZE;
  return q;
}

template <class RowMap>
DI void conv_tile(const float* src, int lds, int nsrc, const float* kscale, bf16* dst, int K, int k0, int n0, char* smem, RowMap rowmap, int ndst = 1 << 30) {
  (void)smem;
  const int tid = tid_(), n4 = (tid & 63) * 4, k8 = (tid >> 6) * 8;
  float4 v[8];
  const bool ok = (n0 + n4 < nsrc);
  const float* sp = src + (size_t)(k0 + k8) * lds + n0 + n4;
#pragma unroll
  for (int k = 0; k < 8; ++k) v[k] = ok ? *(const float4*)(sp + (size_t)k * lds) : make_float4(0.f, 0.f, 0.f, 0.f);
  if (kscale) {
#pragma unroll
    for (int k = 0; k < 8; ++k) { const float sc = kscale[k0 + k8 + k]; v[k].x *= sc; v[k].y *= sc; v[k].z *= sc; v[k].w *= sc; }
  }
  float o[8];
#pragma unroll
  for (int k = 0; k < 8; ++k) o[k] = v[k].x;
  if (n0 + n4 + 0 < ndst) st8bf(dst + (size_t)rowmap(n0 + n4 + 0) * K + k0 + k8, o);
#pragma unroll
  for (int k = 0; k < 8; ++k) o[k] = v[k].y;
  if (n0 + n4 + 1 < ndst) st8bf(dst + (size_t)rowmap(n0 + n4 + 1) * K + k0 + k8, o);
#pragma unroll
  for (int k = 0; k < 8; ++k) o[k] = v[k].z;
  if (n0 + n4 + 2 < ndst) st8bf(dst + (size_t)rowmap(n0 + n4 + 2) * K + k0 + k8, o);
#pragma unroll
  for (int k = 0; k < 8; ++k) o[k] = v[k].w;
  if (n0 + n4 + 3 < ndst) st8bf(dst + (size_t)rowmap(n0 + n4 + 3) * K + k0 + k8, o);
}
struct RowId { DI int operator()(int n) const { return n; } };
struct RowGU { int half; DI int operator()(int f) const { return (f >> 7) * 256 + half * 128 + (f & 127); } };

constexpr int CT_WIN = 16 * (N_INP / 256), CT_UQ = 4 * 2, CT_UKV = 2 * 2, CT_GLU = 4, CT_WB = 4 * 16, CT_WOUT = 64;
constexpr int CT_EARLY = CT_WIN + CT_UQ + CT_UKV + CT_GLU + CT_WB + CT_WOUT;
constexpr int CT_EXP = NE * 3 * 64;

DI void conv_early_item(const Params& p, int l, int it, char* smem) {
  char* we = p.ws + OFF_WEARLY + (size_t)l * WE_SIZE;
  if (it < CT_WIN) {
    int kt = it % 16, nt = it / 16;
    conv_tile(p.in[I_WIN] + (size_t)l * 1024 * N_IN, N_IN, N_IN, nullptr, (bf16*)(we + WE_WIN), 1024, kt * 64, nt * 256, smem, RowId());
    return;
  }
  it -= CT_WIN;
  if (it < CT_UQ) {
    int kt = it % 4, nt = it / 4;
    conv_tile(p.in[I_WUQ] + (size_t)l * 256 * 384, 384, 384, p.in[I_GCQ] + l * 256, (bf16*)(we + WE_UQ), 256, kt * 64, nt * 256, smem, RowId(), 384);
    return;
  }
  it -= CT_UQ;
  if (it < CT_UKV) {
    int kt = it % 2, nt = it / 2;
    conv_tile(p.in[I_WUKV] + (size_t)l * 128 * 512, 512, 512, p.in[I_GCKV] + l * 128, (bf16*)(we + WE_UKV), 128, kt * 64, nt * 256, smem, RowId());
    return;
  }
  it -= CT_UKV;
  if (it < CT_GLU) {
    int kt = it;
    conv_tile(p.in[I_S5WGLU] + (size_t)l * 256 * 256, 256, 256, nullptr, (bf16*)(we + WE_GLU), 256, kt * 64, 0, smem, RowId());
    return;
  }
  it -= CT_GLU;
  if (it < CT_WB) {
    int j = it / 16, r = it % 16, kt = r % 4, nt = r / 4;
    conv_tile(p.in[I_WBRANCH] + ((size_t)l * 4 + j) * 256 * 1024, 1024, 1024, nullptr, (bf16*)(we + WE_WB) + (size_t)j * 1024 * 256, 256, kt * 64, nt * 256, smem, RowId());
    return;
  }
  it -= CT_WB;
  {
    int kt = it % 16, nt = it / 16;
    conv_tile(p.in[I_WOUT] + (size_t)l * 1024 * 1024, 1024, 1024, nullptr, (bf16*)(we + WE_WOUT), 1024, kt * 64, nt * 256, smem, RowId());
  }
}
DI void conv_expert_item(const Params& p, int l, int it, char* smem) {
  char* wx = p.ws + OFF_MIX;
  int e = it / 192, r = it % 192, which = r / 64, t = r % 64, kt = t % 16, nt = t / 16;
  size_t eoff = ((size_t)l * NE + e) * 1024 * 1024;
  if (which == 0) { RowGU rm; rm.half = 0; conv_tile(p.in[I_WGATE] + eoff, 1024, 1024, nullptr, (bf16*)(wx + WX_GU) + (size_t)e * 2048 * 1024, 1024, kt * 64, nt * 256, smem, rm); }
  else if (which == 1) { RowGU rm; rm.half = 1; conv_tile(p.in[I_WUP] + eoff, 1024, 1024, nullptr, (bf16*)(wx + WX_GU) + (size_t)e * 2048 * 1024, 1024, kt * 64, nt * 256, smem, rm); }
  else conv_tile(p.in[I_WDOWN] + eoff, 1024, 1024, nullptr, (bf16*)(wx + WX_DN) + (size_t)e * 1024 * 1024, 1024, kt * 64, nt * 256, smem, RowId());
}

DI void mod_item(const Params& p, int it, char* smem) {
  const int l = it / 96, cg0 = (it % 96) * 64;
  float* sc = (float*)smem;
  float* red = sc + NB1 * 1024;
  const int tid = tid_();
  __syncthreads();
  for (int i = tid; i < NB1 * 1024; i += NTHREADS) {
    int r = i >> 10, k = i & 1023;
    float c = (r < BATCH) ? p.in[I_C][r * 1024 + k] : p.in[I_CCTX][k];
    sc[i] = siluf_(c);
  }
  __syncthreads();
  const int cl = tid & 63, kg = tid >> 6;
  float acc[NB1];
#pragma unroll
  for (int r = 0; r < NB1; ++r) acc[r] = 0.f;
  const float* w = p.in[I_WADA] + (size_t)l * 1024 * 6144 + cg0 + cl;
  for (int k = kg * (1024 / NWAVES); k < (kg + 1) * (1024 / NWAVES); ++k) {
    float wv = w[(size_t)k * 6144];
#pragma unroll
    for (int r = 0; r < NB1; ++r) acc[r] += sc[r * 1024 + k] * wv;
  }
#pragma unroll
  for (int r = 0; r < NB1; ++r) red[(kg * NB1 + r) * 64 + cl] = acc[r];
  __syncthreads();
  for (int i = tid; i < NB1 * 64; i += NTHREADS) {
    int r = i >> 6, c = i & 63;
    float s = 0.f;
#pragma unroll
    for (int q = 0; q < NWAVES; ++q) s += red[(q * NB1 + r) * 64 + c];
    s += p.in[I_BADA][l * 6144 + cg0 + c];
    ((float*)(p.ws + OFF_MOD))[((size_t)l * NB1 + r) * 6144 + cg0 + c] = s;
  }
}

DI void s5_tab_item(const Params& p, int it, char* smem) {
  const int l = it / 32, d = (it / 16) & 1, g = it & 15;
  char* s5 = p.ws + OFF_S5TAB + (size_t)l * S5_SIZE;
  float* lampow = (float*)(s5 + S5_LAMPOW) + (size_t)(d * 16 + g) * 17 * 64 * 2;
  float* bbar = (float*)(s5 + S5_BBAR) + (size_t)(d * 16 + g) * 64 * 16 * 2;
  float* kt = (float*)(s5 + S5_KT) + (size_t)(d * 16 + g) * 16 * 256;
  float* slam = (float*)smem;
  float* sbb = slam + 17 * 64 * 2;
  const int tid = tid_();
  const size_t pg = ((size_t)(l * 2 + d) * 16 + g);
  const float step = expf(p.in[I_S5LOGSTEP][pg]);
  __syncthreads();
  for (int i = tid; i < 17 * 64; i += NTHREADS) {
    int j = i >> 6, pp = i & 63;
    float are = p.in[I_S5ARE][pg * 64 + pp], aim = p.in[I_S5AIM][pg * 64 + pp];
    float mag = expf((float)j * step * are), ang = (float)j * step * aim;
    float re = mag * cosf(ang), im = mag * sinf(ang);
    slam[i * 2] = re; slam[i * 2 + 1] = im; lampow[i * 2] = re; lampow[i * 2 + 1] = im;
  }
  __syncthreads();
  for (int i = tid; i < 64 * 16; i += NTHREADS) {
    int pp = i >> 4;
    float are = p.in[I_S5ARE][pg * 64 + pp], aim = p.in[I_S5AIM][pg * 64 + pp];
    float x = slam[(64 + pp) * 2] - 1.0f, y = slam[(64 + pp) * 2 + 1];
    float den = are * are + aim * aim;
    float qre = (x * are + y * aim) / den, qim = (y * are - x * aim) / den;
    float bre = p.in[I_S5BRE][pg * 1024 + i], bim = p.in[I_S5BIM][pg * 1024 + i];
    float re = qre * bre - qim * bim, im = qre * bim + qim * bre;
    sbb[i * 2] = re; sbb[i * 2 + 1] = im; bbar[i * 2] = re; bbar[i * 2 + 1] = im;
  }
  __syncthreads();
  for (int i = tid; i < 16 * 256; i += NTHREADS) {
    int j = i >> 8, c = (i >> 4) & 15, c2 = i & 15;
    float s = 0.f;
    for (int pp = 0; pp < 64; ++pp) {
      float cre = p.in[I_S5CRE][pg * 1024 + c * 64 + pp], cim = p.in[I_S5CIM][pg * 1024 + c * 64 + pp];
      float lre = slam[(j * 64 + pp) * 2], lim = slam[(j * 64 + pp) * 2 + 1];
      float tre = cre * lre - cim * lim, tim = cre * lim + cim * lre;
      float bre = sbb[(pp * 16 + c2) * 2], bim = sbb[(pp * 16 + c2) * 2 + 1];
      s += tre * bre - tim * bim;
    }
    kt[i] = s;
  }
}
DI void s5_mat_item(const Params& p, int it) {
  const int l = it / 64, g = (it / 4) & 15, q = it & 3;
  char* s5 = p.ws + OFF_S5TAB + (size_t)l * S5_SIZE;
  const float* lampow = (const float*)(s5 + S5_LAMPOW);
  const float* bbar = (const float*)(s5 + S5_BBAR);
  const float* ktab = (const float*)(s5 + S5_KT);
  bf16* WA = (bf16*)(s5 + S5_WA) + (size_t)g * 256 * 256;
  bf16* W2 = (bf16*)(s5 + S5_W2) + (size_t)g * 256 * 512;
  const int tid = tid_();
  for (int i = tid; i < 64 * 256; i += NTHREADS) {
    int n = q * 64 + (i >> 8), k = i & 255;
    int d = n >> 7, ri = (n >> 6) & 1, pp = n & 63, s = k >> 4, c2 = k & 15;
    int e = (d == 0) ? (15 - s) : s;
    const float* lp = lampow + ((size_t)((d * 16 + g) * 17 + e) * 64 + pp) * 2;
    const float* bp = bbar + ((size_t)((d * 16 + g) * 64 + pp) * 16 + c2) * 2;
    float re = lp[0] * bp[0] - lp[1] * bp[1], im = lp[0] * bp[1] + lp[1] * bp[0];
    WA[(size_t)n * 256 + k] = f2bf(ri == 0 ? re : im);
  }
  for (int i = tid; i < 64 * 512; i += NTHREADS) {
    int n = q * 64 + (i >> 9), k = i & 511;
    int lq = n >> 4, c = n & 15;
    float v;
    if (k < 256) {
      int s = k >> 4, c2 = k & 15;
      v = 0.f;
      if (s <= lq) v += ktab[((size_t)(0 * 16 + g) * 16 + (lq - s)) * 256 + c * 16 + c2];
      if (s >= lq) v += ktab[((size_t)(1 * 16 + g) * 16 + (s - lq)) * 256 + c * 16 + c2];
      if (s == lq && c == c2) v += p.in[I_S5D][l * 256 + g * 16 + c];
    } else {
      int kk = k - 256, d = kk >> 7, ri = (kk >> 6) & 1, pp = kk & 63;
      int e = (d == 0) ? (lq + 1) : (16 - lq);
      size_t pg = ((size_t)(l * 2 + d) * 16 + g);
      float cre = p.in[I_S5CRE][pg * 1024 + c * 64 + pp], cim = p.in[I_S5CIM][pg * 1024 + c * 64 + pp];
      const float* lp = lampow + ((size_t)((d * 16 + g) * 17 + e) * 64 + pp) * 2;
      float re = cre * lp[0] - cim * lp[1], im = cre * lp[1] + cim * lp[0];
      v = (ri == 0) ? re : -im;
    }
    W2[(size_t)n * 512 + k] = f2bf(v);
  }
}

DI int tok_b(int tok) { return tok / TOK; }
DI int tok_j(int tok) { return tok % TOK; }
DI int tok_modrow(int tok) { return (tok_j(tok) < CTXL) ? BATCH : tok_b(tok); }

DI void normmod_row(const float (&xv)[16], const float* g, const float* shift, const float* scale, bf16* dst, float (&hout)[16]) {
  const int lane = tid_() & 63;
  float ss = 0.f;
#pragma unroll
  for (int i = 0; i < 16; ++i) ss += xv[i] * xv[i];
  ss = wave_sum(ss);
  const float rs = rsqrtf(ss * (1.0f / 1024.f) + EPS);
#pragma unroll
  for (int i = 0; i < 4; ++i) {
    int c = lane * 4 + i * 256;
    float4 gv = *(const float4*)(g + c), sh = *(const float4*)(shift + c), sc = *(const float4*)(scale + c);
    float h0 = xv[i * 4 + 0] * rs * gv.x * (1.f + sc.x) + sh.x;
    float h1 = xv[i * 4 + 1] * rs * gv.y * (1.f + sc.y) + sh.y;
    float h2 = xv[i * 4 + 2] * rs * gv.z * (1.f + sc.z) + sh.z;
    float h3 = xv[i * 4 + 3] * rs * gv.w * (1.f + sc.w) + sh.w;
    hout[i * 4 + 0] = h0; hout[i * 4 + 1] = h1; hout[i * 4 + 2] = h2; hout[i * 4 + 3] = h3;
    *(uint2*)(dst + c) = make_uint2(pack2(h0, h1), pack2(h2, h3));
  }
}

DI void prep_row_item(const Params& p, int it) {
  const int tok = it * NWAVES + (tid_() >> 6), lane = tid_() & 63;
  const int b = tok_b(tok), j = tok_j(tok);
  const float* src = (j < CTXL) ? p.in[I_CTX] + ((size_t)b * CTXL + j) * 1024 : p.in[I_X] + ((size_t)b * SEQ + (j - CTXL)) * 1024;
  float* X = (float*)(p.ws + OFF_X) + (size_t)tok * 1024;
  float xv[16], h[16];
#pragma unroll
  for (int i = 0; i < 4; ++i) {
    float4 v = *(const float4*)(src + lane * 4 + i * 256);
    *(float4*)(X + lane * 4 + i * 256) = v;
    xv[i * 4] = v.x; xv[i * 4 + 1] = v.y; xv[i * 4 + 2] = v.z; xv[i * 4 + 3] = v.w;
  }
  const float* mod = (const float*)(p.ws + OFF_MOD) + (size_t)tok_modrow(tok) * 6144;
  normmod_row(xv, p.in[I_GPREMIX], mod + 0, mod + 1024, (bf16*)(p.ws + OFF_HA) + (size_t)tok * 1024, h);
}

constexpr int IP_LT = BATCH * (SEQ / 256), IP_CT = BATCH * ((CTXL + 255) / 256), IP_MT = IP_LT + IP_CT, IP_NT = N_INP / 256;
constexpr int IP_RR = (IP_MT + 7) / 8, IP_RC = (IP_NT + 1) / 2;
constexpr int IP_RC_NOGATE = (((C_GATE + 255) / 256) + 1) / 2;
constexpr int IP_RR_LAT = IP_LT / 8;
constexpr bool IP_COMPACT = (IP_LT % 8 == 0);
constexpr int IP_RECTS_ALL = IP_RR * IP_RC, IP_RECTS_LAST = IP_COMPACT ? (IP_RR * IP_RC_NOGATE + IP_RR_LAT * (IP_RC - IP_RC_NOGATE)) : IP_RECTS_ALL;
constexpr int IP_SLOTS_ALL = ((IP_RECTS_ALL + 15) / 16) * 256, IP_SLOTS_LAST = ((IP_RECTS_LAST + 15) / 16) * 256;
DI void inproj_tile(const Params& p, const LP& L, int t, char* smem) {
  const int vb = t % 256, vround = t / 256, x = vb % 8, j = vb / 8;
  const int Rc = vround * 16 + x * 2 + (j >> 4), jj = j & 15;
  int rm, rn;
  if (!L.last || !IP_COMPACT || Rc < IP_RR * IP_RC_NOGATE) { rm = Rc % IP_RR; rn = Rc / IP_RR; }
  else { const int q = Rc - IP_RR * IP_RC_NOGATE; rm = q % IP_RR_LAT; rn = IP_RC_NOGATE + q / IP_RR_LAT; }
  const int mt = rm * 8 + (jj & 7), nt = rn * 2 + (jj >> 3);
  if (mt >= IP_MT || nt >= IP_NT || rn >= IP_RC) return;
  int m0;
  if (mt < IP_LT) m0 = (mt / (SEQ / 256)) * TOK + CTXL + (mt % (SEQ / 256)) * 256;
  else { const int c = mt - IP_LT; m0 = (c / ((CTXL + 255) / 256)) * TOK + (c % ((CTXL + 255) / 256)) * 256; }
  const int n0 = nt * 256;
  const int mv = (mt < IP_LT) ? NTOK : (m0 - (m0 % TOK) + CTXL);
  if (L.last && mt >= IP_LT && n0 >= ((C_GATE + 255) / 256) * 256) return;
  GA g = make_ga((const bf16*)(p.ws + OFF_HA), 1024, (const bf16*)(L.we + WE_WIN), 1024, 1024, mv);
  f32x4 acc[2][2][4][2];
  gemm_big(g, m0, n0, smem, acc);
  bf16* P1 = (bf16*)(p.ws + OFF_P1);
  bf16* PG = (bf16*)(p.ws + OFF_PG);
  bf16* US5 = (bf16*)(p.ws + OFF_MIX + MX_US5);
  float* DT = (float*)(p.ws + OFF_DT);
  const float* dtb = p.in[I_M2DTBIAS] + L.l * 8;
  EPIB_BEGIN(acc, m0, n0, mv)
    if (col < C_S5 || (col >= C_Z && col < C_DT)) st8bf(P1 + (size_t)row * P1W + col, v);
    else if (col < C_Z) st8bf(US5 + ((size_t)((col - C_S5) >> 4) * NTOK + row) * 16 + (col & 15), v);
    else if (col < C_GATE) {
#pragma unroll
      for (int k = 0; k < 8; ++k) v[k] = softplusf_(v[k] + dtb[k]);
      st8f(DT + (size_t)row * 8, v);
    } else if (col < N_IN) {
#pragma unroll
      for (int k = 0; k < 8; ++k) v[k] = sigmoidf_(v[k]);
      st8bf(PG + (size_t)row * 4096 + (col - C_GATE), v);
    }
  EPIB_END
}

DI void rowscale_256(const bf16* P1, int m0, int c0, int width, float* srs) {
  const int r = tid_() >> 1, hf = tid_() & 1;
  int gr = m0 + r; if (gr > NTOK - 1) gr = NTOK - 1;
  const bf16* src = P1 + (size_t)gr * P1W + c0 + hf * (width / 2);
  float ss = 0.f;
  for (int i = 0; i < width / 2; i += 8) {
    float v[8]; ld8bf(src + i, v);
#pragma unroll
    for (int k = 0; k < 8; ++k) ss += v[k] * v[k];
  }
  ss += shfl_xor_(ss, 1);
  if (hf == 0) srs[r] = rsqrtf(ss / (float)width + EPS);
}
DI void rope_tab_item(const Params& p) {
  float* tab = (float*)(p.ws + OFF_ROPE);
  for (int i = tid_(); i < 64 * 8; i += NTHREADS) {
    int pos = i >> 3, k = i & 7;
    float f = expf(-(float)k * (9.210340371976184f / 8.0f));
    float a = (float)pos * f;
    tab[i * 2] = cosf(a); tab[i * 2 + 1] = sinf(a);
  }
}
DI void rope_cs(const float* tab, int pos, int i, float& c, float& s) { c = tab[(pos * 8 + i) * 2]; s = tab[(pos * 8 + i) * 2 + 1]; }

constexpr int TP_MT = (NTOK + 255) / 256;
DI void mlaq_tile(const Params& p, const LP& L, int t, char* smem) {
  const int mt = t % TP_MT, nt = t / TP_MT, m0 = mt * 256, n0 = nt * 128;
  const bf16* P1 = (const bf16*)(p.ws + OFF_P1);
  float* srs = (float*)(smem + SRS_OFF);
  GA g = make_ga(P1 + C_CQ, P1W, (const bf16*)(L.we + WE_UQ), 256, 256, NTOK);
  f32x4 acc[4][4];
  gemm_s<4>(g, m0, n0, smem, acc);
  rowscale_256(P1, m0, C_CQ, 256, srs);
  __syncthreads();
  bf16* Q = (bf16*)(p.ws + OFF_MIX + MX_Q);
  const float* ropetab = (const float*)(p.ws + OFF_ROPE);
  {
    const int l = tid_() & 63, w = tid_() >> 6, wr = w >> 1, wc = w & 1, fr = l & 15, fq = l >> 4;
#pragma unroll
    for (int m = 0; m < 4; ++m) {
      const int row = m0 + wr * 64 + m * 16 + fr;
      const int rowc = row < NTOK ? row : NTOK - 1;
      const float rsc = srs[rowc - m0];
      const int b = tok_b(rowc), j = tok_j(rowc);
#pragma unroll
      for (int q = 0; q < 2; ++q) {
        const int col = n0 + wc * 64 + q * 32 + 8 * fq;
        const int h = col / 96, dd = col % 96;
        float v[8] = {acc[m][2 * q][0], acc[m][2 * q][1], acc[m][2 * q][2], acc[m][2 * q][3], acc[m][2 * q + 1][0], acc[m][2 * q + 1][1], acc[m][2 * q + 1][2], acc[m][2 * q + 1][3]};
        float vp[8];
#pragma unroll
        for (int k = 0; k < 8; ++k) vp[k] = shfl_xor_(v[k], 16);
        if (dd >= 64 && j >= CTXL) {
          const int tl = j - CTXL, pos = ((dd - 64) < 16) ? (tl / GRID_W) : (tl % GRID_W);
          const bool lo = ((dd & 8) == 0);
#pragma unroll
          for (int k = 0; k < 8; ++k) {
            float c, sn; rope_cs(ropetab, pos, k, c, sn);
            v[k] = lo ? (v[k] * c - vp[k] * sn) : (v[k] * c + vp[k] * sn);
          }
        }
#pragma unroll
        for (int k = 0; k < 8; ++k) v[k] *= rsc;
        if (row < NTOK) st8bf(Q + (((size_t)b * 4 + h) * TOK + j) * 96 + dd, v);
      }
    }
  }
}
DI void mlakv_tile(const Params& p, const LP& L, int t, char* smem) {
  const int mt = t % TP_MT, h = t / TP_MT, m0 = mt * 256, n0 = h * 128;
  const bf16* P1 = (const bf16*)(p.ws + OFF_P1);
  float* srs = (float*)(smem + SRS_OFF);
  GA g = make_ga(P1 + C_CKV, P1W, (const bf16*)(L.we + WE_UKV), 128, 128, NTOK);
  f32x4 acc[4][4];
  gemm_s<4>(g, m0, n0, smem, acc);
  rowscale_256(P1, m0, C_CKV, 128, srs);
  __syncthreads();
  bf16* K = (bf16*)(p.ws + OFF_MIX + MX_K);
  bf16* VT = (bf16*)(p.ws + OFF_MIX + MX_VTM);
  const float* ropetab = (const float*)(p.ws + OFF_ROPE);
  EPI_BEGIN(4, acc, m0, n0, NTOK)
    const float rsc = srs[row - m0];
    const int b = tok_b(row), j = tok_j(row), dd = col - n0;
#pragma unroll
    for (int k = 0; k < 8; ++k) v[k] *= rsc;
    if (dd < 64) st8bf(K + (((size_t)b * 4 + h) * TOK + j) * 96 + dd, v);
    else {
#pragma unroll
      for (int k = 0; k < 8; ++k) VT[(((size_t)b * 4 + h) * 64 + (dd - 64 + k)) * TOK + j] = f2bf(v[k]);
    }
  EPI_END
  for (int i = tid_(); i < 256 * 16; i += NTHREADS) {
    int r = i >> 4, q = i & 15;
    int row = m0 + r;
    if (row < NTOK) {
      int b = tok_b(row), j = tok_j(row);
      int blk = q >> 3, i8 = q & 7;
      float x1 = bf2f(P1[(size_t)row * P1W + C_KR + blk * 16 + i8]), x2 = bf2f(P1[(size_t)row * P1W + C_KR + blk * 16 + i8 + 8]);
      float o1 = x1, o2 = x2;
      if (j >= CTXL) {
        int tl = j - CTXL, pos = blk == 0 ? (tl / GRID_W) : (tl % GRID_W);
        float c, sn; rope_cs(ropetab, pos, i8, c, sn);
        o1 = x1 * c - x2 * sn; o2 = x2 * c + x1 * sn;
      }
      bf16* kd = K + (((size_t)b * 4 + h) * TOK + j) * 96 + 64 + blk * 16 + i8;
      kd[0] = f2bf(o1); kd[8] = f2bf(o2);
    }
  }
}
DI void navt_item(const Params& p, int it, char* smem) {
  bf16* s = (bf16*)smem;
  const bf16* P1 = (const bf16*)(p.ws + OFF_P1);
  bf16* VT = (bf16*)(p.ws + OFF_MIX + MX_VTN);
  const int tok0 = it * 64, tid = tid_();
  const int b = tok_b(tok0), j0 = tok_j(tok0);
  __syncthreads();
  for (int i = tid; i < 64 * 32; i += NTHREADS) {
    int r = i >> 5, c8 = i & 31;
    *(uint4*)(s + r * 264 + c8 * 8) = *(const uint4*)(P1 + (size_t)(tok0 + r) * P1W + C_NA + 512 + c8 * 8);
  }
  __syncthreads();
  for (int i = tid; i < 256 * 8; i += NTHREADS) {
    int ch = i >> 3, t8 = i & 7;
    unsigned w[4];
#pragma unroll
    for (int q = 0; q < 4; ++q) w[q] = (unsigned)s[(t8 * 8 + 2 * q) * 264 + ch] | ((unsigned)s[(t8 * 8 + 2 * q + 1) * 264 + ch] << 16);
    *(uint4*)(VT + ((size_t)b * 256 + ch) * TOK + j0 + t8 * 8) = make_uint4(w[0], w[1], w[2], w[3]);
  }
}
constexpr int M2C_TOK = 128, M2C_ITEMS = NTOK / M2C_TOK;
DI void m2conv_item(const Params& p, const LP& L, int it) {
  const bf16* P1 = (const bf16*)(p.ws + OFF_P1);
  bf16* XB = (bf16*)(p.ws + OFF_MIX + MX_XBC);
  const int tok0 = it * M2C_TOK;
  const float* cw = p.in[I_M2CONVW] + (size_t)L.l * 4 * 768;
  const float* cb = p.in[I_M2CONVB] + (size_t)L.l * 768;
  for (int task = tid_(); task < 96 * (M2C_TOK / 8); task += NTHREADS) {
    const int cg = task % 96, tb = task / 96, c0 = cg * 8;
    const int tokb = tok0 + tb * 8, jt = tok_j(tokb), base = tokb - jt;
    const int slo = (jt < CTXL) ? 0 : CTXL, shi = (jt < CTXL) ? CTXL : TOK;
    float w[4][8], bias[8];
#pragma unroll
    for (int k = 0; k < 4; ++k) { float4 a = *(const float4*)(cw + k * 768 + c0), b4 = *(const float4*)(cw + k * 768 + c0 + 4);
      w[k][0] = a.x; w[k][1] = a.y; w[k][2] = a.z; w[k][3] = a.w; w[k][4] = b4.x; w[k][5] = b4.y; w[k][6] = b4.z; w[k][7] = b4.w; }
    { float4 a = *(const float4*)(cb + c0), b4 = *(const float4*)(cb + c0 + 4);
      bias[0] = a.x; bias[1] = a.y; bias[2] = a.z; bias[3] = a.w; bias[4] = b4.x; bias[5] = b4.y; bias[6] = b4.z; bias[7] = b4.w; }
    float xin[11][8];
#pragma unroll
    for (int r = 0; r < 11; ++r) {
      const int j = jt - 2 + r;
      if (j >= slo && j < shi) ld8bf(P1 + (size_t)(base + j) * P1W + C_XBC + c0, xin[r]);
      else {
#pragma unroll
        for (int c = 0; c < 8; ++c) xin[r][c] = 0.f;
      }
    }
    float y[8][8];
#pragma unroll
    for (int t = 0; t < 8; ++t) {
#pragma unroll
      for (int c = 0; c < 8; ++c) y[t][c] = siluf_(bias[c] + w[0][c] * xin[t][c] + w[1][c] * xin[t + 1][c] + w[2][c] * xin[t + 2][c] + w[3][c] * xin[t + 3][c]);
      st8bf(XB + (size_t)(base + jt + t) * 768 + c0, y[t]);
    }
    if (c0 < 512) {
      bf16* XT = (bf16*)(p.ws + OFF_MIX + MX_XBT) + ((size_t)(base / TOK) * 512 + c0) * TOK + jt;
#pragma unroll
      for (int c = 0; c < 8; ++c) {
        float col[8];
#pragma unroll
        for (int t = 0; t < 8; ++t) col[t] = y[t][c];
        st8bf(XT + (size_t)c * TOK, col);
      }
    }
  }
}
DI int m2_seq2tok(int sq, int dir) { return (dir == 0) ? sq : (sq < CTXL ? (CTXL - 1 - sq) : (TOK - 1 - (sq - CTXL))); }
constexpr int M2S_ITEMS = BATCH * 8 * (TOK / 64) / NWAVES;
DI void m2scal_item(const Params& p, const LP& L, int it) {
  const int w = it * NWAVES + (tid_() >> 6), lane = tid_() & 63;
  const int ch = w % (TOK / 64), r = w / (TOK / 64), hd = r & 3, dir = (r >> 2) & 1, b = r >> 3;
  const float a = -expf(p.in[I_M2ALOG][(L.l * 2 + dir) * 4 + hd]);
  const int sq = ch * 64 + lane, j = m2_seq2tok(sq, dir);
  const float dt = ((const float*)(p.ws + OFF_DT))[((size_t)b * TOK + j) * 8 + dir * 4 + hd];
  float cs = dt * a;
#pragma unroll
  for (int d = 1; d < 64; d <<= 1) { float o = shfl_up_(cs, d); if (lane >= d) cs += o; }
  const float sl = shfl_(cs, 63);
  float* o = (float*)(p.ws + OFF_MIX + MX_M2S) + ((size_t)((b * 2 + dir) * 4 + hd) * TOK + sq) * 4;
  *(float4*)o = make_float4(cs, dt, dt * __expf(sl - cs), cs * 1.4426950408889634f - log2f(dt));
}
constexpr int S5_MT = (MCH + 255) / 256;
DI void s5a_tile(const Params& p, const LP& L, int t, char* smem) {
  const int g = t / (S5_MT * 2), r = t % (S5_MT * 2), mt = r / 2, nt = r % 2;
  const int m0 = mt * 256, n0 = nt * 128;
  GA ga = make_ga((const bf16*)(p.ws + OFF_MIX + MX_US5) + (size_t)g * NTOK * 16, 256, (const bf16*)(L.s5 + S5_WA) + (size_t)g * 65536, 256, 256, MCH);
  f32x4 acc[4][4];
  gemm_s<4>(ga, m0, n0, smem, acc);
  float* HE = (float*)(p.ws + OFF_MIX + MX_HEND) + (size_t)g * MCH * 256;
  EPI_BEGIN(4, acc, m0, n0, MCH)
    st8f(HE + (size_t)row * 256 + col, v);
  EPI_END
}
DI int s5_chunk_of(int i, int d) { return (d == 0) ? i : (i < NCC ? (NCC - 1 - i) : (NCH - 1 - (i - NCC))); }
DI void s5carry_item(const Params& p, const LP& L, int it) {
  const int w = it * NWAVES + (tid_() >> 6), lane = tid_() & 63;
  const int d = w / (16 * BATCH), g = (w / BATCH) & 15, b = w % BATCH;
  const float* lp = (const float*)(L.s5 + S5_LAMPOW) + ((size_t)((d * 16 + g) * 17 + 16) * 64 + lane) * 2;
  const float lre = lp[0], lim = lp[1];
  const float* HE = (const float*)(p.ws + OFF_MIX + MX_HEND) + ((size_t)g * MCH + (size_t)b * NCH) * 256 + d * 128;
  bf16* HI = (bf16*)(p.ws + OFF_MIX + MX_HIN) + ((size_t)g * MCH + (size_t)b * NCH) * 256 + d * 128;
  float cre = 0.f, cim = 0.f;
  static_assert(NCH % 4 == 0, "chunk count");
  for (int i0 = 0; i0 < NCH; i0 += 4) {
    float hre[4], him[4];
#pragma unroll
    for (int k = 0; k < 4; ++k) { const int ch = s5_chunk_of(i0 + k, d); hre[k] = HE[(size_t)ch * 256 + lane]; him[k] = HE[(size_t)ch * 256 + 64 + lane]; }
#pragma unroll
    for (int k = 0; k < 4; ++k) {
      const int ch = s5_chunk_of(i0 + k, d);
      HI[(size_t)ch * 256 + lane] = f2bf(cre); HI[(size_t)ch * 256 + 64 + lane] = f2bf(cim);
      const float nre = lre * cre - lim * cim + hre[k], nim = lre * cim + lim * cre + him[k];
      cre = nre; cim = nim;
    }
  }
}
DI void s5c_tile(const Params& p, const LP& L, int t, char* smem) {
  const int g = t / (S5_MT * 2), r = t % (S5_MT * 2), mt = r / 2, nt = r % 2;
  const int m0 = mt * 256, n0 = nt * 128;
  GA ga = make_ga((const bf16*)(p.ws + OFF_MIX + MX_US5) + (size_t)g * NTOK * 16, 256, (const bf16*)(L.s5 + S5_W2) + (size_t)g * 256 * 512, 512, 512, MCH);
  ga.A2 = (const bf16*)(p.ws + OFF_MIX + MX_HIN) + (size_t)g * MCH * 256; ga.lda2 = 256; ga.ksplit = 256;
  f32x4 acc[4][4];
  gemm_s<4>(ga, m0, n0, smem, acc);
  bf16* Z = (bf16*)(p.ws + OFF_MIX + MX_Z);
  EPI_BEGIN(4, acc, m0, n0, MCH)
#pragma unroll
    for (int k = 0; k < 8; ++k) v[k] = geluf_(v[k]);
    st8bf(Z + ((size_t)row * 16 + (col >> 4)) * 256 + g * 16 + (col & 15), v);
  EPI_END
}

DI float fmax_(float a, float b) { return a > b ? a : b; }
constexpr int AT_LDV = 76;
struct NaInfo { int r, qc, rs, cs; };
template <int DK, bool NA>
DI void attn_block(const bf16* qrow, bool active, const bf16* Kp, int kstride, const bf16* Vt,
                   int ka0, int ntile_a, int arow0, int kb0, int ntile_b,
                   const float* srpb, NaInfo ni, float scale, bf16* orow, char* smem) {
  constexpr int LDK = DK + 8, KCH = DK / 8;
  constexpr int KT_BYTES = 64 * LDK * 2, VT_BYTES = 64 * AT_LDV * 2;
  constexpr int NKL = (64 * KCH + NTHREADS - 1) / NTHREADS;
  const int tid = tid_(), lane = tid & 63, half = lane >> 5, r = lane & 31;
  bf16* sK = (bf16*)smem;
  bf16* sV = (bf16*)(smem + 2 * KT_BYTES);
  bf16x8 qf[DK / 16];
  f32x16 o0, o1;
  float m = -1e30f, l = 0.f;
  const float scale2 = scale * 1.4426950408889634f;
#pragma unroll
  for (int ks = 0; ks < DK / 16; ++ks) qf[ks] = active ? *(const bf16x8*)(qrow + ks * 16 + 8 * half) : bf16x8{0, 0, 0, 0, 0, 0, 0, 0};
#pragma unroll
  for (int i = 0; i < 16; ++i) { o0[i] = 0.f; o1[i] = 0.f; }
  const int NTL = ntile_a + ntile_b;
  u32x4 rk[NKL], rv[1];
#pragma unroll
  for (int i = 0; i < NKL; ++i) rk[i] = u32x4{0u, 0u, 0u, 0u};
  auto key0_of = [&](int t) { return t < ntile_a ? ka0 + 64 * t : kb0 + 64 * (t - ntile_a); };
#define AT_GLOAD(t_) { const int k0_ = key0_of(t_); \
    _Pragma("unroll") for (int i_ = 0; i_ < NKL; ++i_) { const int c_ = tid + i_ * NTHREADS; const int key_ = c_ / KCH, ch_ = c_ % KCH; \
      if (c_ < 64 * KCH) rk[i_] = *(const u32x4*)(Kp + (size_t)(k0_ + key_) * kstride + ch_ * 8); } \
    { const int d_ = tid >> 3, ch_ = tid & 7; rv[0] = *(const u32x4*)(Vt + (size_t)d_ * TOK + k0_ + ch_ * 8); } }
#define AT_SSTORE(buf_) { \
    _Pragma("unroll") for (int i_ = 0; i_ < NKL; ++i_) { const int c_ = tid + i_ * NTHREADS; const int key_ = c_ / KCH, ch_ = c_ % KCH; \
      if (c_ < 64 * KCH) *(u32x4*)(sK + (buf_) * (64 * LDK) + key_ * LDK + ch_ * 8) = rk[i_]; } \
    { const int d_ = tid >> 3, ch_ = tid & 7; \
      bf16* dst_ = sV + (buf_) * (64 * AT_LDV) + d_ * AT_LDV + ch_ * 8; \
      *(uint2*)dst_ = make_uint2(rv[0][0], rv[0][1]); *(uint2*)(dst_ + 4) = make_uint2(rv[0][2], rv[0][3]); } }
  __syncthreads();
  AT_GLOAD(0) AT_SSTORE(0)
  __syncthreads();
#pragma unroll 1
  for (int t = 0; t < NTL; ++t) {
    const int buf = t & 1;
    if (t + 1 < NTL) AT_GLOAD(t + 1)
    bool doit = active;
    int trow0 = 0;
    if (NA && t < ntile_a) {
      trow0 = arow0 + t * (64 / GRID_W);
      doit = active && (trow0 + (64 / GRID_W) > ni.rs) && (trow0 < ni.rs + WIN_R);
    }
    if (doit) {
      const bf16* kb = sK + buf * (64 * LDK);
      const bf16* vb = sV + buf * (64 * AT_LDV);
      f32x16 s0, s1;
#pragma unroll
      for (int i = 0; i < 16; ++i) { s0[i] = 0.f; s1[i] = 0.f; }
#pragma unroll
      for (int ks = 0; ks < DK / 16; ++ks) {
        bf16x8 a0 = *(const bf16x8*)(kb + r * LDK + ks * 16 + 8 * half);
        bf16x8 a1 = *(const bf16x8*)(kb + (32 + r) * LDK + ks * 16 + 8 * half);
        s0 = __builtin_amdgcn_mfma_f32_32x32x16_bf16(a0, qf[ks], s0, 0, 0, 0);
        s1 = __builtin_amdgcn_mfma_f32_32x32x16_bf16(a1, qf[ks], s1, 0, 0, 0);
      }
      float mx = -INFINITY;
      if (NA && t < ntile_a) {
#pragma unroll
        for (int i = 0; i < 16; ++i) {
          const int kk = (i & 3) + 8 * (i >> 2) + 4 * half;
#pragma unroll
          for (int hb = 0; hb < 2; ++hb) {
            const int kq = kk + 32 * hb;
            const int kr = trow0 + kq / GRID_W, kc = kq % GRID_W;
            const bool ok = (kr >= ni.rs) && (kr < ni.rs + WIN_R) && (kc >= ni.cs) && (kc < ni.cs + WIN_C);
            const float bias = ok ? srpb[(kr - ni.r + 7) * 31 + (kc - ni.qc + 15)] * 1.4426950408889634f : -INFINITY;
            if (hb == 0) { s0[i] = s0[i] * scale2 + bias; mx = fmax_(mx, s0[i]); }
            else { s1[i] = s1[i] * scale2 + bias; mx = fmax_(mx, s1[i]); }
          }
        }
      } else {
#pragma unroll
        for (int i = 0; i < 16; ++i) { s0[i] *= scale2; s1[i] *= scale2; mx = fmax_(mx, fmax_(s0[i], s1[i])); }
      }
      mx = fmax_(mx, shfl_xor_(mx, 32));
      const float mn = fmax_(m, mx);
      const float alpha = exp2f_(m - mn);
      const bool same = (mn == m);
      m = mn;
      float ps = 0.f;
#pragma unroll
      for (int i = 0; i < 16; ++i) { s0[i] = exp2f_(s0[i] - mn); s1[i] = exp2f_(s1[i] - mn); ps += s0[i] + s1[i]; }
      l = l * alpha + ps;
      if (!wave_all_(same)) {
#pragma unroll
        for (int i = 0; i < 16; ++i) { o0[i] *= alpha; o1[i] *= alpha; }
      }
#pragma unroll
      for (int kq = 0; kq < 4; ++kq) {
        u32x4 pw;
#pragma unroll
        for (int j = 0; j < 4; ++j) pw[j] = (kq < 2) ? pack2(s0[8 * (kq & 1) + 2 * j], s0[8 * (kq & 1) + 2 * j + 1]) : pack2(s1[8 * (kq & 1) + 2 * j], s1[8 * (kq & 1) + 2 * j + 1]);
        const bf16x8 pf = __builtin_bit_cast(bf16x8, pw);
        const bf16* v0 = vb + r * AT_LDV + 16 * kq + 4 * half;
        const bf16* v1 = vb + (r + 32) * AT_LDV + 16 * kq + 4 * half;
        uint2 a0 = *(const uint2*)v0, a1 = *(const uint2*)(v0 + 8), b0 = *(const uint2*)v1, b1 = *(const uint2*)(v1 + 8);
        bf16x8 va, vbb;
        va[0] = (short)(a0.x & 0xffff); va[1] = (short)(a0.x >> 16); va[2] = (short)(a0.y & 0xffff); va[3] = (short)(a0.y >> 16);
        va[4] = (short)(a1.x & 0xffff); va[5] = (short)(a1.x >> 16); va[6] = (short)(a1.y & 0xffff); va[7] = (short)(a1.y >> 16);
        vbb[0] = (short)(b0.x & 0xffff); vbb[1] = (short)(b0.x >> 16); vbb[2] = (short)(b0.y & 0xffff); vbb[3] = (short)(b0.y >> 16);
        vbb[4] = (short)(b1.x & 0xffff); vbb[5] = (short)(b1.x >> 16); vbb[6] = (short)(b1.y & 0xffff); vbb[7] = (short)(b1.y >> 16);
        o0 = __builtin_amdgcn_mfma_f32_32x32x16_bf16(va, pf, o0, 0, 0, 0);
        o1 = __builtin_amdgcn_mfma_f32_32x32x16_bf16(vbb, pf, o1, 0, 0, 0);
      }
    }
    if (t + 1 < NTL) AT_SSTORE(buf ^ 1)
    __syncthreads();
  }
  if (active) {
    const float lt = l + shfl_xor_(l, 32);
    const float inv = 1.0f / lt;
#pragma unroll
    for (int gI = 0; gI < 4; ++gI) {
      const int d0 = 8 * gI + 4 * half;
      *(uint2*)(orow + d0) = make_uint2(pack2(o0[4 * gI] * inv, o0[4 * gI + 1] * inv), pack2(o0[4 * gI + 2] * inv, o0[4 * gI + 3] * inv));
      *(uint2*)(orow + 32 + d0) = make_uint2(pack2(o1[4 * gI] * inv, o1[4 * gI + 1] * inv), pack2(o1[4 * gI + 2] * inv, o1[4 * gI + 3] * inv));
    }
  }
}
DI void mla_attn_item(const Params& p, int it, bool ctxq, char* smem) {
  const int nqb = ctxq ? (CTXL + 255) / 256 : SEQ / 256;
  const int b = it / (4 * nqb), h = (it / nqb) & 3, qb = it % nqb;
  const int lane = tid_() & 63, wid = tid_() >> 6;
  const int nq = ctxq ? CTXL : SEQ, q0 = qb * 256 + wid * 32;
  const bool active = q0 < nq;
  const int jq = (ctxq ? 0 : CTXL) + (active ? q0 : 0) + (lane & 31);
  const bf16* Q = (const bf16*)(p.ws + OFF_MIX + MX_Q) + ((size_t)b * 4 + h) * TOK * 96;
  const bf16* K = (const bf16*)(p.ws + OFF_MIX + MX_K) + ((size_t)b * 4 + h) * TOK * 96;
  const bf16* VT = (const bf16*)(p.ws + OFF_MIX + MX_VTM) + ((size_t)b * 4 + h) * 64 * TOK;
  bf16* O = (bf16*)(p.ws + OFF_O) + ((size_t)b * TOK + jq) * 1024 + 0 * 256 + h * 64;
  NaInfo ni; ni.r = 0; ni.qc = 0; ni.rs = 0; ni.cs = 0;
  attn_block<96, false>(Q + (size_t)jq * 96, active, K, 96, VT, 0, 0, 0, 0, (ctxq ? CTXL : TOK) / 64, nullptr, ni, 0.10206207261596577f, O, smem);
}
DI void na_attn_item(const Params& p, const LP& L, int it, bool ctxq, char* smem) {
  const int nqb = ctxq ? (CTXL + 255) / 256 : SEQ / 256;
  const int b = it / (4 * nqb), h = (it / nqb) & 3, qb = it % nqb;
  const int tid = tid_(), lane = tid & 63, wid = tid >> 6;
  const int nq = ctxq ? CTXL : SEQ, q0 = qb * 256 + wid * 32;
  const bool active = q0 < nq;
  const int jq = (ctxq ? 0 : CTXL) + (active ? q0 : 0) + (lane & 31);
  const bf16* P1 = (const bf16*)(p.ws + OFF_P1) + (size_t)b * TOK * P1W;
  const bf16* VT = (const bf16*)(p.ws + OFF_MIX + MX_VTN) + ((size_t)b * 4 + h) * 64 * TOK;
  const bf16* Kb = P1 + C_NA + 256 + h * 64;
  bf16* O = (bf16*)(p.ws + OFF_O) + ((size_t)b * TOK + jq) * 1024 + 1 * 256 + h * 64;
  constexpr int AT_END64 = 2 * (64 * 72 * 2) + 2 * (64 * AT_LDV * 2);
  float* srpb = (float*)(smem + AT_END64);
  NaInfo ni; ni.r = 0; ni.qc = 0; ni.rs = 0; ni.cs = 0;
  int ka0 = 0, nta = 0, arow0 = 0;
  if (!ctxq) {
    __syncthreads();
    const float* rpb = p.in[I_RPB] + ((size_t)L.l * 4 + h) * 15 * 31;
    for (int i = tid; i < 15 * 31; i += NTHREADS) srpb[i] = rpb[i];
    const int tl = q0 + (lane & 31);
    ni.r = tl / GRID_W; ni.qc = tl % GRID_W;
    int rs = ni.r - WIN_R / 2; rs = rs < 0 ? 0 : (rs > ROWS - WIN_R ? ROWS - WIN_R : rs);
    int cs = ni.qc - WIN_C / 2; cs = cs < 0 ? 0 : (cs > GRID_W - WIN_C ? GRID_W - WIN_C : cs);
    ni.rs = rs; ni.cs = cs;
    constexpr int RPT = 64 / GRID_W;
    const int rfirst = (qb * 256) / GRID_W, rlast = (qb * 256 + 255) / GRID_W;
    int rs_f = rfirst - WIN_R / 2; rs_f = rs_f < 0 ? 0 : (rs_f > ROWS - WIN_R ? ROWS - WIN_R : rs_f);
    int rs_l = rlast - WIN_R / 2; rs_l = rs_l < 0 ? 0 : (rs_l > ROWS - WIN_R ? ROWS - WIN_R : rs_l);
    arow0 = (rs_f / RPT) * RPT;
    const int row_hi = rs_l + WIN_R;
    nta = (row_hi - arow0 + RPT - 1) / RPT;
    ka0 = CTXL + arow0 * GRID_W;
  }
  attn_block<64, true>(P1 + (size_t)jq * P1W + C_NA + h * 64, active, Kb, P1W, VT, ka0, nta, arow0, 0, CTXL / 64, srpb, ni, 0.125f, O, smem);
}

constexpr int M2_LDB = 136, M2_LDX = 72;
constexpr int M2_OFF_B = 0;
constexpr int M2_OFF_C = M2_OFF_B + 64 * M2_LDB * 2;
constexpr int M2_OFF_HD = M2_OFF_C + 64 * M2_LDB * 2;
constexpr int M2H_H = 0;
constexpr int M2H_XT = M2H_H + 64 * M2_LDB * 2;
constexpr int M2H_BT = M2H_XT + 64 * M2_LDX * 2;
constexpr int M2H_S = M2H_BT + 128 * M2_LDX * 2;
constexpr int M2H_X = M2H_S + 3 * 64 * 4;
constexpr int M2H_SIZE = M2H_X + 64 * M2_LDX * 2;
constexpr int M2_SMEM = M2_OFF_HD + 2 * M2H_SIZE;
static_assert(M2_SMEM <= SMEM_BYTES, "m2 smem");
DI u32x4 rev8_(u32x4 v) {
  return u32x4{(v[3] >> 16) | (v[3] << 16), (v[2] >> 16) | (v[2] << 16), (v[1] >> 16) | (v[1] << 16), (v[0] >> 16) | (v[0] << 16)};
}
DI void m2scan_item(const Params& p, const LP& L, int it, char* smem) {
  const int b = it / 4, grp = (it >> 1) & 1, dir = it & 1;
  const int tid = tid_(), lane = tid & 63, wid = tid >> 6, half = lane >> 5, r = lane & 31;
  const int hsel = wid >> 2, wl = wid & 3, hd = grp * 2 + hsel;
  bf16* sB = (bf16*)(smem + M2_OFF_B);
  bf16* sC = (bf16*)(smem + M2_OFF_C);
  char* hb = smem + M2_OFF_HD + hsel * M2H_SIZE;
  bf16* sH = (bf16*)(hb + M2H_H);
  bf16* sXT = (bf16*)(hb + M2H_XT);
  bf16* sBT = (bf16*)(hb + M2H_BT);
  float* sS = (float*)(hb + M2H_S);
  float* sDt = sS + 64;
  float* sW = sS + 128;
  const bf16* XB = (const bf16*)(p.ws + OFF_MIX + MX_XBC) + (size_t)b * TOK * 768;
  const bf16* XT = (const bf16*)(p.ws + OFF_MIX + MX_XBT) + (size_t)b * 512 * TOK;
  const float* SC = (const float*)(p.ws + OFF_MIX + MX_M2S) + (size_t)((b * 2 + dir) * 4 + hd) * TOK * 4;
  float* YM = (float*)(p.ws + OFF_HA) + ((size_t)dir * NTOK + (size_t)b * TOK) * 256;
  const int pb = wl & 1, tb = wl >> 1, nb0 = 2 * (wl >> 1);
  f32x16 hst[2];
#pragma unroll
  for (int i = 0; i < 16; ++i) { hst[0][i] = 0.f; hst[1][i] = 0.f; }
  __syncthreads();
  for (int i = tid; i < 2 * M2H_SIZE / 4; i += NTHREADS) ((unsigned*)(smem + M2_OFF_HD))[i] = 0u;
  __syncthreads();
  u32x4 rxt[2], rbt[2], rb[2], rc[2];
  float4 rsc = make_float4(0.f, 0.f, 0.f, 0.f);
#define M2_TLOAD(rowptr_, sq0_) (*(const u32x4*)((rowptr_) + ((dir == 0) ? (sq0_) : m2_seq2tok((sq0_) + 7, 1))))
#define M2_GLOAD(c0_) { \
    _Pragma("unroll") for (int q_ = 0; q_ < 2; ++q_) { const int i_ = tid + q_ * NTHREADS; const int h2_ = i_ >> 9, t8_ = ((i_ >> 6) & 7) * 8, pp_ = i_ & 63; \
      rxt[q_] = M2_TLOAD(XT + (size_t)((grp * 2 + h2_) * 64 + pp_) * TOK, (c0_) + t8_); } \
    _Pragma("unroll") for (int q_ = 0; q_ < 2; ++q_) { const int i_ = tid + q_ * NTHREADS; const int t8_ = (i_ >> 7) * 8, nn_ = i_ & 127; \
      rbt[q_] = M2_TLOAD(XT + (size_t)(256 + grp * 128 + nn_) * TOK, (c0_) + t8_); } \
    _Pragma("unroll") for (int q_ = 0; q_ < 2; ++q_) { const int i_ = tid + q_ * NTHREADS; const int t_ = i_ >> 4, n8_ = (i_ & 15) * 8; \
      const bf16* src_ = XB + (size_t)m2_seq2tok((c0_) + t_, dir) * 768 + grp * 128 + n8_; \
      rb[q_] = *(const u32x4*)(src_ + 256); rc[q_] = *(const u32x4*)(src_ + 512); } \
    if (wl == 0) rsc = *(const float4*)(SC + (size_t)((c0_) + lane) * 4); }
  M2_GLOAD(0)
  for (int c0 = 0; c0 < TOK; c0 += 64) {
    if (wl == 0) { sS[lane] = rsc.x; sDt[lane] = rsc.w; sW[lane] = rsc.z; }
    __syncthreads();
#pragma unroll
    for (int q2 = 0; q2 < 2; ++q2) {
      const int i = tid + q2 * NTHREADS; const int h2 = i >> 9, t8 = ((i >> 6) & 7) * 8, pp = i & 63;
      *(u32x4*)((bf16*)(smem + M2_OFF_HD + h2 * M2H_SIZE + M2H_XT) + pp * M2_LDX + t8) = dir ? rev8_(rxt[q2]) : rxt[q2];
    }
#pragma unroll
    for (int q4 = 0; q4 < 2; ++q4) {
      const int i = tid + q4 * NTHREADS; const int t = i >> 4, n8 = (i & 15) * 8;
      *(u32x4*)(sB + t * M2_LDB + n8) = rb[q4];
      *(u32x4*)(sC + t * M2_LDB + n8) = rc[q4];
    }
#pragma unroll
    for (int q4 = 0; q4 < 2; ++q4) {
      const int i = tid + q4 * NTHREADS; const int t8 = (i >> 7) * 8, nn = i & 127;
      float bv[8];
      if (dir) rbt[q4] = rev8_(rbt[q4]);
      bv[0] = __uint_as_float(rbt[q4][0] << 16); bv[1] = __uint_as_float(rbt[q4][0] & 0xffff0000u);
      bv[2] = __uint_as_float(rbt[q4][1] << 16); bv[3] = __uint_as_float(rbt[q4][1] & 0xffff0000u);
      bv[4] = __uint_as_float(rbt[q4][2] << 16); bv[5] = __uint_as_float(rbt[q4][2] & 0xffff0000u);
      bv[6] = __uint_as_float(rbt[q4][3] << 16); bv[7] = __uint_as_float(rbt[q4][3] & 0xffff0000u);
#pragma unroll
      for (int h2 = 0; h2 < 2; ++h2) {
        const float* wv = (const float*)(smem + M2_OFF_HD + h2 * M2H_SIZE + M2H_S) + 128 + t8;
        float sv[8];
#pragma unroll
        for (int k = 0; k < 8; ++k) sv[k] = bv[k] * wv[k];
        st8bf((bf16*)(smem + M2_OFF_HD + h2 * M2H_SIZE + M2H_BT) + nn * M2_LDX + t8, sv);
      }
    }
    __syncthreads();
    if (c0 + 64 < TOK) M2_GLOAD(c0 + 64)
    {
      f32x16 yT, y2;
#pragma unroll
      for (int i = 0; i < 16; ++i) { yT[i] = 0.f; y2[i] = 0.f; }
      const int tv = 32 * tb + r;
      const float St = sS[tv];
      for (int sb = 0; sb <= tb; ++sb) {
        f32x16 gT;
#pragma unroll
        for (int i = 0; i < 16; ++i) gT[i] = 0.f;
#pragma unroll
        for (int ks = 0; ks < 8; ++ks) {
          bf16x8 av = *(const bf16x8*)(sB + (32 * sb + r) * M2_LDB + 16 * ks + 8 * half);
          bf16x8 bv = *(const bf16x8*)(sC + tv * M2_LDB + 16 * ks + 8 * half);
          gT = __builtin_amdgcn_mfma_f32_32x32x16_bf16(av, bv, gT, 0, 0, 0);
        }
        const float St2 = St * 1.4426950408889634f;
        if (sb == tb) {
#pragma unroll
          for (int i = 0; i < 16; ++i) {
            const int sv = 32 * sb + (i & 3) + 8 * (i >> 2) + 4 * half;
            gT[i] = (sv <= tv) ? gT[i] * exp2f_(St2 - sDt[sv]) : 0.f;
          }
        } else {
#pragma unroll
          for (int i = 0; i < 16; ++i) {
            const int sv = 32 * sb + (i & 3) + 8 * (i >> 2) + 4 * half;
            gT[i] *= exp2f_(St2 - sDt[sv]);
          }
        }
#pragma unroll
        for (int kq = 0; kq < 2; ++kq) {
          const u32x4 pw = u32x4{pack2(gT[8 * kq], gT[8 * kq + 1]), pack2(gT[8 * kq + 2], gT[8 * kq + 3]), pack2(gT[8 * kq + 4], gT[8 * kq + 5]), pack2(gT[8 * kq + 6], gT[8 * kq + 7])};
          const bf16x8 pf = __builtin_bit_cast(bf16x8, pw);
          const bf16* xr = sXT + (32 * pb + r) * M2_LDX + 32 * sb + 16 * kq + 4 * half;
          uint2 x0 = *(const uint2*)xr, x1 = *(const uint2*)(xr + 8);
          bf16x8 xa;
          xa[0] = (short)(x0.x & 0xffff); xa[1] = (short)(x0.x >> 16); xa[2] = (short)(x0.y & 0xffff); xa[3] = (short)(x0.y >> 16);
          xa[4] = (short)(x1.x & 0xffff); xa[5] = (short)(x1.x >> 16); xa[6] = (short)(x1.y & 0xffff); xa[7] = (short)(x1.y >> 16);
          yT = __builtin_amdgcn_mfma_f32_32x32x16_bf16(xa, pf, yT, 0, 0, 0);
        }
      }
#pragma unroll
      for (int ks = 0; ks < 8; ++ks) {
        bf16x8 av = *(const bf16x8*)(sH + (32 * pb + r) * M2_LDB + 16 * ks + 8 * half);
        bf16x8 bv = *(const bf16x8*)(sC + tv * M2_LDB + 16 * ks + 8 * half);
        y2 = __builtin_amdgcn_mfma_f32_32x32x16_bf16(av, bv, y2, 0, 0, 0);
      }
      const float eS = __expf(St);
      const int j = m2_seq2tok(c0 + tv, dir);
      float* yo = YM + (size_t)j * 256 + hd * 64 + 32 * pb + 4 * half;
#pragma unroll
      for (int gI = 0; gI < 4; ++gI)
        *(float4*)(yo + 8 * gI) = make_float4(yT[4 * gI] + eS * y2[4 * gI], yT[4 * gI + 1] + eS * y2[4 * gI + 1], yT[4 * gI + 2] + eS * y2[4 * gI + 2], yT[4 * gI + 3] + eS * y2[4 * gI + 3]);
    }
    __syncthreads();
    {
      const float eL = __expf(sS[63]);
#pragma unroll
      for (int q = 0; q < 2; ++q) {
#pragma unroll
        for (int i = 0; i < 16; ++i) hst[q][i] *= eL;
#pragma unroll
        for (int ks = 0; ks < 4; ++ks) {
          bf16x8 av = *(const bf16x8*)(sXT + (32 * pb + r) * M2_LDX + 16 * ks + 8 * half);
          bf16x8 bv = *(const bf16x8*)(sBT + (32 * (nb0 + q) + r) * M2_LDX + 16 * ks + 8 * half);
          hst[q] = __builtin_amdgcn_mfma_f32_32x32x16_bf16(av, bv, hst[q], 0, 0, 0);
        }
#pragma unroll
        for (int i = 0; i < 16; ++i) {
          const int pv = 32 * pb + (i & 3) + 8 * (i >> 2) + 4 * half;
          sH[pv * M2_LDB + 32 * (nb0 + q) + r] = f2bf(hst[q][i]);
        }
      }
    }
    __syncthreads();
  }
}
DI void m2gate_item(const Params& p, const LP& L, int it) {
  const int tok = it * NWAVES + (tid_() >> 6), lane = tid_() & 63;
  const float* Y0 = (const float*)(p.ws + OFF_HA) + (size_t)tok * 256;
  const float* Y1 = Y0 + (size_t)NTOK * 256;
  const bf16* XB = (const bf16*)(p.ws + OFF_MIX + MX_XBC) + (size_t)tok * 768;
  const bf16* P1 = (const bf16*)(p.ws + OFF_P1) + (size_t)tok * P1W + C_Z;
  const int c = lane * 4, hd = c >> 6;
  const float dsk = p.in[I_M2D][L.l * 4 + hd];
  float4 y0 = *(const float4*)(Y0 + c), y1 = *(const float4*)(Y1 + c);
  uint2 xw = *(const uint2*)(XB + c), zw = *(const uint2*)(P1 + c);
  float xs[4] = {__uint_as_float(xw.x << 16), __uint_as_float(xw.x & 0xffff0000u), __uint_as_float(xw.y << 16), __uint_as_float(xw.y & 0xffff0000u)};
  float zs[4] = {__uint_as_float(zw.x << 16), __uint_as_float(zw.x & 0xffff0000u), __uint_as_float(zw.y << 16), __uint_as_float(zw.y & 0xffff0000u)};
  float ys[4] = {y0.x + y1.x, y0.y + y1.y, y0.z + y1.z, y0.w + y1.w};
  float v[4], ss = 0.f;
#pragma unroll
  for (int i = 0; i < 4; ++i) { v[i] = (ys[i] + dsk * xs[i]) * siluf_(zs[i]); ss += v[i] * v[i]; }
  ss = wave_sum(ss);
  const float rs = rsqrtf(ss * (1.f / 256.f) + EPS);
  float4 gn = *(const float4*)(p.in[I_M2GNORM] + L.l * 256 + c);
  bf16* O = (bf16*)(p.ws + OFF_O) + (size_t)tok * 1024 + 768 + c;
  *(uint2*)O = make_uint2(pack2(v[0] * rs * gn.x, v[1] * rs * gn.y), pack2(v[2] * rs * gn.z, v[3] * rs * gn.w));
}
constexpr int GLU_MT = (NTOK + 255) / 256;
DI void glu_tile(const Params& p, const LP& L, int t, char* smem) {
  const int mt = t % GLU_MT, nt = t / GLU_MT, m0 = mt * 256, n0 = nt * 128;
  const bf16* Z = (const bf16*)(p.ws + OFF_MIX + MX_Z);
  GA g = make_ga(Z, 256, (const bf16*)(L.we + WE_GLU), 256, 256, NTOK);
  f32x4 acc[4][4];
  gemm_s<4>(g, m0, n0, smem, acc);
  bf16* O = (bf16*)(p.ws + OFF_O);
  const float* bg = p.in[I_S5BGLU] + L.l * 256;
  EPI_BEGIN(4, acc, m0, n0, NTOK)
    float z[8]; ld8bf(Z + (size_t)row * 256 + col, z);
#pragma unroll
    for (int k = 0; k < 8; ++k) v[k] = z[k] * sigmoidf_(v[k] + bg[col + k]);
    st8bf(O + (size_t)row * 1024 + 512 + col, v);
  EPI_END
}
DI void merge_tile(const Params& p, const LP& L, int t, char* smem) {
  constexpr int MT_L = BATCH * (SEQ / 256), MT_A = (NTOK + 255) / 256;
  const int mt = L.last ? t % MT_L : t % MT_A, nt = L.last ? t / MT_L : t / MT_A, m0 = mtile_row0(mt, L.last, 256), n0 = nt * 128;
  const bf16* O = (const bf16*)(p.ws + OFF_O);
  const bf16* PG = (const bf16*)(p.ws + OFF_PG);
  float tot[4][2][8];
#pragma unroll
  for (int a = 0; a < 4; ++a)
#pragma unroll
    for (int q = 0; q < 2; ++q)
#pragma unroll
      for (int k = 0; k < 8; ++k) tot[a][q][k] = 0.f;
  for (int j = 0; j < 4; ++j) {
    GA g = make_ga(O + j * 256, 1024, (const bf16*)(L.we + WE_WB) + (size_t)j * 1024 * 256, 256, 256, NTOK);
    f32x4 acc[4][4];
    gemm_s<4>(g, m0, n0, smem, acc);
    EPI_BEGIN(4, acc, m0, n0, NTOK)
      float gt[8]; ld8bf(PG + (size_t)row * 4096 + j * 1024 + col, gt);
#pragma unroll
      for (int k = 0; k < 8; ++k) tot[_m][_q][k] += gt[k] * v[k];
    EPI_END
  }
  bf16* Y = (bf16*)(p.ws + OFF_P1);
  {
    const int l = tid_() & 63, w = tid_() >> 6, wr = w >> 1, wc = w & 1, fr = l & 15, fq = l >> 4;
#pragma unroll
    for (int m = 0; m < 4; ++m)
#pragma unroll
      for (int q = 0; q < 2; ++q) {
        const int row = m0 + wr * 64 + m * 16 + fr, col = n0 + wc * 64 + q * 32 + 8 * fq;
        if (row < NTOK) st8bf(Y + (size_t)row * 1024 + col, tot[m][q]);
      }
  }
}
DI void outproj_tile(const Params& p, const LP& L, int t, char* smem) {
  float* Y2 = (float*)(p.ws + OFF_HA);
  constexpr int MT_L = BATCH * (SEQ / 256), MT_A = (NTOK + 255) / 256;
  const int mt = L.last ? t % MT_L : t % MT_A, nt = L.last ? t / MT_L : t / MT_A, m0 = mtile_row0(mt, L.last, 256), n0 = nt * 256;
  GA g = make_ga((const bf16*)(p.ws + OFF_P1), 1024, (const bf16*)(L.we + WE_WOUT), 1024, 1024, NTOK);
  f32x4 acc[2][2][4][2];
  gemm_big(g, m0, n0, smem, acc);
  EPIB_BEGIN(acc, m0, n0, NTOK)
    st8f(Y2 + (size_t)row * 1024 + col, v);
  EPIB_END
}
DI int post_ntok(bool latonly) { return latonly ? BATCH * SEQ : NTOK; }
DI int post_tok(int i, bool latonly) { return latonly ? ((i / SEQ) * TOK + CTXL + (i % SEQ)) : i; }

DI void post_stage_router(const Params& p, const LP& L, char* smem) {
  const float* wr = p.in[I_WROUTER] + (size_t)L.l * 1024 * 16;
  float4* wl = (float4*)smem;
  __syncthreads();
  for (int i = tid_(); i < 4096; i += NTHREADS) {
    const int k = i >> 2, q = i & 3;
    const int pos = ((k >> 8) * 4 + (k & 3)) * 64 + ((k >> 2) & 63);
    wl[q * 1024 + pos] = *(const float4*)(wr + (size_t)k * 16 + q * 4);
  }
  __syncthreads();
}
DI void post_phase(const Params& p, const LP& L, char* smem) {
  const int lane = tid_() & 63, gw = (int)blockIdx.x * NWAVES + (tid_() >> 6), TW = (int)gridDim.x * NWAVES;
  const int n = post_ntok(L.last);
  if (gw >= n) return;
  const float* gpm = p.in[I_GPOSTMIX] + L.l * 1024;
  const float4* wl = (const float4*)smem;
  int i = gw, tok = post_tok(i, L.last);
  float4 yr[4], xr[4];
  {
    const float* X = (const float*)(p.ws + OFF_X) + (size_t)tok * 1024;
    const float* Y2 = (const float*)(p.ws + OFF_HA) + (size_t)tok * 1024;
#pragma unroll
    for (int q = 0; q < 4; ++q) { yr[q] = *(const float4*)(Y2 + lane * 4 + q * 256); xr[q] = *(const float4*)(X + lane * 4 + q * 256); }
  }
  for (;;) {
    const int inext = i + TW; const bool has = inext < n; const int tokn = has ? post_tok(inext, L.last) : tok;
    float4 yn[4], xn[4];
    {
      const float* Xn = (const float*)(p.ws + OFF_X) + (size_t)tokn * 1024;
      const float* Yn = (const float*)(p.ws + OFF_HA) + (size_t)tokn * 1024;
#pragma unroll
      for (int q = 0; q < 4; ++q) { yn[q] = *(const float4*)(Yn + lane * 4 + q * 256); xn[q] = *(const float4*)(Xn + lane * 4 + q * 256); }
    }
    float* X = (float*)(p.ws + OFF_X) + (size_t)tok * 1024;
    const float* mod = L.mod + (size_t)tok_modrow(tok) * 6144;
    float xv[16], h[16];
    float ss = 0.f;
#pragma unroll
    for (int q = 0; q < 4; ++q) ss += yr[q].x * yr[q].x + yr[q].y * yr[q].y + yr[q].z * yr[q].z + yr[q].w * yr[q].w;
    ss = wave_sum(ss);
    const float rs = rsqrtf(ss * (1.f / 1024.f) + EPS);
#pragma unroll
    for (int q = 0; q < 4; ++q) {
      const int c = lane * 4 + q * 256;
      float4 xo = xr[q], gv = *(const float4*)(gpm + c), gt = *(const float4*)(mod + 2048 + c);
      xo.x += gt.x * yr[q].x * rs * gv.x; xo.y += gt.y * yr[q].y * rs * gv.y; xo.z += gt.z * yr[q].z * rs * gv.z; xo.w += gt.w * yr[q].w * rs * gv.w;
      *(float4*)(X + c) = xo;
      xv[q * 4] = xo.x; xv[q * 4 + 1] = xo.y; xv[q * 4 + 2] = xo.z; xv[q * 4 + 3] = xo.w;
    }
    bf16* H2 = (bf16*)(p.ws + OFF_P1) + (size_t)NTOK * 1024 + (size_t)tok * 1024;
    normmod_row(xv, p.in[I_GPREFFN] + L.l * 1024, mod + 3072, mod + 4096, H2, h);
    float lg[16];
#pragma unroll
    for (int e = 0; e < 16; ++e) lg[e] = 0.f;
#pragma unroll
    for (int q = 0; q < 16; ++q) {
      const int pos = ((q >> 2) * 4 + (q & 3)) * 64 + lane;
      float4 a = wl[pos], b4 = wl[1024 + pos], c4 = wl[2048 + pos], d4 = wl[3072 + pos];
      float hv = h[q];
      lg[0] += hv * a.x; lg[1] += hv * a.y; lg[2] += hv * a.z; lg[3] += hv * a.w;
      lg[4] += hv * b4.x; lg[5] += hv * b4.y; lg[6] += hv * b4.z; lg[7] += hv * b4.w;
      lg[8] += hv * c4.x; lg[9] += hv * c4.y; lg[10] += hv * c4.z; lg[11] += hv * c4.w;
      lg[12] += hv * d4.x; lg[13] += hv * d4.y; lg[14] += hv * d4.z; lg[15] += hv * d4.w;
    }
    float mx = -INFINITY;
#pragma unroll
    for (int e = 0; e < 16; ++e) { lg[e] = wave_sum(lg[e]); mx = fmax_(mx, lg[e]); }
    float se = 0.f;
#pragma unroll
    for (int e = 0; e < 16; ++e) { lg[e] = expf(lg[e] - mx); se += lg[e]; }
    if (lane < 16) {
      float v = 0.f;
#pragma unroll
      for (int e = 0; e < 16; ++e) if (e == lane) v = lg[e];
      ((float*)(p.ws + OFF_AFF))[(size_t)lane * NTOK + tok] = v / se;
    }
    if (!has) break;
    i = inext; tok = tokn;
#pragma unroll
    for (int q = 0; q < 4; ++q) { yr[q] = yn[q]; xr[q] = xn[q]; }
  }
}
DI int block_sum_(int v, int* sred, int round) {
  const int tid = tid_(), lane = tid & 63, wid = tid >> 6;
  v += shfl_xor_(v, 32); v += shfl_xor_(v, 16); v += shfl_xor_(v, 8); v += shfl_xor_(v, 4); v += shfl_xor_(v, 2); v += shfl_xor_(v, 1);
  int* r = sred + (round & 1) * NWAVES;
  if (lane == 0) r[wid] = v;
  __syncthreads();
  int tsum = 0;
#pragma unroll
  for (int q = 0; q < NWAVES; ++q) tsum += r[q];
  return tsum;
}
DI void route_item(const Params& p, const LP& L, int it, char* smem) {
  const int nstream = L.last ? 1 : 2;
  const int b = it / (16 * nstream), e = (it / nstream) & 15, ctxs = (nstream == 2) ? (it & 1) : 0;
  const int T = ctxs ? CTXL : SEQ, cap = ctxs ? CAP_C : CAP_L;
  const int tok0 = b * TOK + (ctxs ? 0 : CTXL);
  const int slot0 = ctxs ? (BATCH * CAP_L + b * CAP_C) : (b * CAP_L);
  int* sred = (int*)smem;
  const float* AFF = (const float*)(p.ws + OFF_AFF) + (size_t)e * NTOK + tok0;
  int* SEL = (int*)(p.ws + OFF_SEL);
  int* IDX = (int*)(p.ws + OFF_IDX) + (size_t)e * ESLOTS;
  float* GW = (float*)(p.ws + OFF_GW) + (size_t)e * ESLOTS;
  const int tid = tid_(), lane = tid & 63, wid = tid >> 6;
  constexpr int MAXPER = (SEQ + NTHREADS - 1) / NTHREADS;
  const int per = (T + NTHREADS - 1) / NTHREADS;
  unsigned key[MAXPER];
  __syncthreads();
#pragma unroll
  for (int k = 0; k < MAXPER; ++k) {
    int i = tid * per + k;
    key[k] = (k < per && i < T) ? (__float_as_uint(AFF[i]) + 1u) : 0u;
  }
  unsigned thr = 0u;
  int round = 0;
  for (int bit = 30; bit >= 0; --bit) {
    const unsigned cand = thr | (1u << bit);
    int c = 0;
#pragma unroll
    for (int k = 0; k < MAXPER; ++k) c += (key[k] >= cand) ? 1 : 0;
    c = block_sum_(c, sred, round++);
    if (c >= cap) thr = cand;
  }
  int cg = 0, ce = 0;
#pragma unroll
  for (int k = 0; k < MAXPER; ++k) { cg += (key[k] > thr) ? 1 : 0; ce += (key[k] == thr) ? 1 : 0; }
  const int tot_gt = block_sum_(cg, sred, round++);
  const int need_eq = cap - tot_gt;
  int v = cg | (ce << 16), inc = v;
#pragma unroll
  for (int d = 1; d < 64; d <<= 1) { int o = shfl_up_(inc, d); if (lane >= d) inc += o; }
  int* soff = sred + 2 * NWAVES;
  __syncthreads();
  if (lane == 63) soff[wid] = inc;
  __syncthreads();
  int base = 0;
  for (int w = 0; w < wid; ++w) base += soff[w];
  int excl = base + inc - v;
  int gt_before = excl & 0xffff, eq_before = excl >> 16;
#pragma unroll
  for (int k = 0; k < MAXPER; ++k) {
    int i = tid * per + k;
    if (k < per && i < T) {
      const bool isgt = key[k] > thr, iseq = key[k] == thr;
      const bool sel = isgt || (iseq && eq_before < need_eq);
      const int slot = slot0 + gt_before + (eq_before < need_eq ? eq_before : need_eq);
      if (sel) { IDX[slot] = tok0 + i; GW[slot] = __uint_as_float(key[k] - 1u); SEL[(size_t)(tok0 + i) * 16 + e] = slot; }
      else SEL[(size_t)(tok0 + i) * 16 + e] = -1;
      gt_before += isgt ? 1 : 0; eq_before += iseq ? 1 : 0;
    }
  }
}
DI void moe1_tile(const Params& p, const LP& L, int t, char* smem) {
  const int nslots = L.last ? ESLOTS_L : ESLOTS;
  constexpr int MT_L = (ESLOTS_L + 255) / 256, MT_A = (ESLOTS + 255) / 256;
  const int nt = t & 7, sq = t >> 3;
  const int e = L.last ? sq / MT_L : sq / MT_A, mt = L.last ? sq % MT_L : sq % MT_A;
  const int m0 = mt * 256, n0 = nt * 256;
  GA g = make_ga((const bf16*)(p.ws + OFF_P1) + (size_t)NTOK * 1024, 1024, (const bf16*)(p.ws + OFF_MIX + WX_GU) + (size_t)e * 2048 * 1024, 1024, 1024, nslots);
  g.ridx = (const int*)(p.ws + OFF_IDX) + (size_t)e * ESLOTS;
  f32x4 acc[2][2][4][2];
  gemm_big(g, m0, n0, smem, acc);
  bf16* ACT = (bf16*)(p.ws + OFF_PG) + (size_t)e * ESLOTS * 1024;
  {
    const int l = tid_() & 63, w = tid_() >> 6, wr = w >> 2, wc = w & 3, fr = l & 15, fq = l >> 4;
#pragma unroll
    for (int ai = 0; ai < 2; ++ai)
#pragma unroll
      for (int m = 0; m < 4; ++m) {
        const int row = m0 + ai * 128 + wr * 64 + m * 16 + fr;
        float a[8];
#pragma unroll
        for (int k = 0; k < 4; ++k) { a[k] = siluf_(acc[ai][0][m][0][k]) * acc[ai][1][m][0][k]; a[4 + k] = siluf_(acc[ai][0][m][1][k]) * acc[ai][1][m][1][k]; }
        if (row < nslots) st8bf(ACT + (size_t)row * 1024 + nt * 128 + wc * 32 + 8 * fq, a);
      }
  }
}
DI void moe2_tile(const Params& p, const LP& L, int t, char* smem) {
  const int nslots = L.last ? ESLOTS_L : ESLOTS;
  constexpr int MT_L = (ESLOTS_L + 255) / 256, MT_A = (ESLOTS + 255) / 256;
  const int x = t & 7, nt = x & 3, sq = (t >> 3) * 2 + (x >> 2);
  const int e = L.last ? sq / MT_L : sq / MT_A, mt = L.last ? sq % MT_L : sq % MT_A;
  if (e >= NE) return;
  const int m0 = mt * 256, n0 = nt * 256;
  GA g = make_ga((const bf16*)(p.ws + OFF_PG) + (size_t)e * ESLOTS * 1024, 1024, (const bf16*)(p.ws + OFF_MIX + WX_DN) + (size_t)e * 1024 * 1024, 1024, 1024, nslots);
  f32x4 acc[2][2][4][2];
  gemm_big(g, m0, n0, smem, acc);
  bf16* YS = (bf16*)(p.ws + OFF_PG) + (size_t)NE * ESLOTS * 1024 + (size_t)e * ESLOTS * 1024;
  const float* GW = (const float*)(p.ws + OFF_GW) + (size_t)e * ESLOTS;
  EPIB_BEGIN(acc, m0, n0, nslots)
    const float gw = GW[row];
#pragma unroll
    for (int k = 0; k < 8; ++k) v[k] *= gw;
    st8bf(YS + (size_t)row * 1024 + col, v);
  EPIB_END
}
DI int uni_(int v) {
#ifdef EMU
  return v;
#else
  return __builtin_amdgcn_readfirstlane(v);
#endif
}
DI void comb_phase(const Params& p, const LP& L) {
  const int lane = tid_() & 63, gw = (int)blockIdx.x * NWAVES + (tid_() >> 6), TW = (int)gridDim.x * NWAVES;
  const int n = post_ntok(L.last);
  if (gw >= n) return;
  const bf16* YS = (const bf16*)(p.ws + OFF_PG) + (size_t)NE * ESLOTS * 1024;
  const float* gpf = p.in[I_GPOSTFFN] + L.l * 1024;
  int i = gw, tok = post_tok(i, L.last);
  uint4 sel[4]; float4 xr[4];
  {
    const uint4* sp = (const uint4*)((const int*)(p.ws + OFF_SEL) + (size_t)tok * 16);
    const float* X = (const float*)(p.ws + OFF_X) + (size_t)tok * 1024;
#pragma unroll
    for (int q = 0; q < 4; ++q) { sel[q] = sp[q]; xr[q] = *(const float4*)(X + lane * 4 + q * 256); }
  }
  for (;;) {
    const int inext = i + TW; const bool has = inext < n; const int tokn = has ? post_tok(inext, L.last) : tok;
    float s[16];
#pragma unroll
    for (int q = 0; q < 16; ++q) s[q] = 0.f;
#pragma unroll
    for (int e = 0; e < 16; ++e) {
      const unsigned sv = (e & 3) == 0 ? sel[e >> 2].x : (e & 3) == 1 ? sel[e >> 2].y : (e & 3) == 2 ? sel[e >> 2].z : sel[e >> 2].w;
      const int sl = uni_((int)sv);
      if (sl >= 0) {
        const bf16* yr = YS + ((size_t)e * ESLOTS + sl) * 1024;
#pragma unroll
        for (int q = 0; q < 4; ++q) {
          uint2 w = *(const uint2*)(yr + lane * 4 + q * 256);
          s[q * 4] += __uint_as_float(w.x << 16); s[q * 4 + 1] += __uint_as_float(w.x & 0xffff0000u);
          s[q * 4 + 2] += __uint_as_float(w.y << 16); s[q * 4 + 3] += __uint_as_float(w.y & 0xffff0000u);
        }
      }
    }
    uint4 seln[4]; float4 xn[4];
    {
      const uint4* sp = (const uint4*)((const int*)(p.ws + OFF_SEL) + (size_t)tokn * 16);
      const float* Xn = (const float*)(p.ws + OFF_X) + (size_t)tokn * 1024;
#pragma unroll
      for (int q = 0; q < 4; ++q) { seln[q] = sp[q]; xn[q] = *(const float4*)(Xn + lane * 4 + q * 256); }
    }
    float ss = 0.f;
#pragma unroll
    for (int q = 0; q < 16; ++q) ss += s[q] * s[q];
    ss = wave_sum(ss);
    const float rs = rsqrtf(ss * (1.f / 1024.f) + EPS);
    const float* mod = L.mod + (size_t)tok_modrow(tok) * 6144;
    float* dst = (float*)(p.ws + OFF_X) + (size_t)tok * 1024;
    if (L.last) { const int b = tok_b(tok), j = tok_j(tok); dst = p.out + ((size_t)b * SEQ + (j - CTXL)) * 1024; }
    float xv[16], h[16];
#pragma unroll
    for (int q = 0; q < 4; ++q) {
      const int c = lane * 4 + q * 256;
      float4 xo = xr[q], gv = *(const float4*)(gpf + c), gt = *(const float4*)(mod + 5120 + c);
      xo.x += gt.x * s[q * 4] * rs * gv.x; xo.y += gt.y * s[q * 4 + 1] * rs * gv.y; xo.z += gt.z * s[q * 4 + 2] * rs * gv.z; xo.w += gt.w * s[q * 4 + 3] * rs * gv.w;
      *(float4*)(dst + c) = xo;
      xv[q * 4] = xo.x; xv[q * 4 + 1] = xo.y; xv[q * 4 + 2] = xo.z; xv[q * 4 + 3] = xo.w;
    }
    if (!L.last) {
      const float* mod1 = (const float*)(p.ws + OFF_MOD) + ((size_t)(L.l + 1) * NB1 + tok_modrow(tok)) * 6144;
      normmod_row(xv, p.in[I_GPREMIX] + (L.l + 1) * 1024, mod1, mod1 + 1024, (bf16*)(p.ws + OFF_HA) + (size_t)tok * 1024, h);
    }
    if (!has) break;
    i = inext; tok = tokn;
#pragma unroll
    for (int q = 0; q < 4; ++q) { sel[q] = seln[q]; xr[q] = xn[q]; }
  }
}

enum { PH_PREP0 = 0, PH_PREP1, PH_L0 };
enum { LP_INPROJ = 0, LP_TOKPREP, LP_MIX1, LP_MIX2, LP_GLU, LP_MERGE, LP_OUT, LP_POST, LP_ROUTE, LP_MOE1, LP_MOE2, LP_COMB, LP_COUNT };
constexpr int NPHASES = PH_L0 + DEPTH * LP_COUNT;


DI void run_phase(const Params& p, int ph, char* smem) {
  const int G = gridDim.x;
  int start = blockIdx.x;
  auto seg = [&](int n, auto&& fn) {
    for (; start < n; start += G) fn(start);
    start -= n;
  };
#ifdef ONLY_PREP
  if (ph >= PH_L0) return;
#endif
  if (ph == PH_PREP0) {
    seg(DEPTH * 96, [&](int it) { mod_item(p, it, smem); });
    seg(DEPTH * 32, [&](int it) { s5_tab_item(p, it, smem); });
    seg(1, [&](int) { rope_tab_item(p); });
    seg(DEPTH * CT_EARLY, [&](int it) { conv_early_item(p, it / CT_EARLY, it % CT_EARLY, smem); });
    return;
  }
  if (ph == PH_PREP1) {
    seg(DEPTH * 64, [&](int it) { s5_mat_item(p, it); });
    seg(NTOK / NWAVES, [&](int it) { prep_row_item(p, it); });
    return;
  }
#ifdef ONLY_LPH
  if (ph < PH_L0) return;
#endif
  const int l = (ph - PH_L0) / LP_COUNT;
#ifdef ONLY_LPH
  const int lph = ONLY_LPH;
#else
  const int lph = (ph - PH_L0) % LP_COUNT;
#endif
  const LP L = make_lp(p, l);
  switch (lph) {
    case LP_INPROJ:
      seg(L.last ? IP_SLOTS_LAST : IP_SLOTS_ALL, [&](int it) { inproj_tile(p, L, it, smem); });
      break;
    case LP_TOKPREP:
      seg(16 * S5_MT * 2, [&](int it) { s5a_tile(p, L, it, smem); });
      seg(TP_MT * 3, [&](int it) { mlaq_tile(p, L, it, smem); });
      seg(TP_MT * 4, [&](int it) { mlakv_tile(p, L, it, smem); });
      seg(NTOK / 64, [&](int it) { navt_item(p, it, smem); });
      seg(M2C_ITEMS, [&](int it) { m2conv_item(p, L, it); });
      seg(M2S_ITEMS, [&](int it) { m2scal_item(p, L, it); });
      break;
    case LP_MIX1: {
      const int n0 = BATCH * 4, n1 = n0 + 2 * 16 * BATCH / NWAVES, n2 = n1 + BATCH * 4 * (SEQ / 256), n3 = n2 + BATCH * 4 * (SEQ / 256);
      const int n4 = n3 + (L.last ? 0 : BATCH * 4 * ((CTXL + 255) / 256)), n5 = n4 + (L.last ? 0 : BATCH * 4 * ((CTXL + 255) / 256));
      int* qhead = (int*)(p.ws + OFF_BAR) + Q_WORD0 + 64 * (l + 2 * p.probe_rep);
#ifdef EMU
      volatile int* bc = (volatile int*)(smem + SMEM_BYTES + 8);
#else
      volatile LAS int* bc = (volatile LAS int*)(smem + SMEM_BYTES + 8);
#endif
      for (;;) {
        __syncthreads();
        if (tid_() == 0) {
#ifdef EMU
          *bc = atomicAdd(qhead, 1);
#else
          *bc = __hip_atomic_fetch_add(qhead, 1, __ATOMIC_RELAXED, __HIP_MEMORY_SCOPE_AGENT);
#endif
        }
        __syncthreads();
        const int it = *bc;
        if (it >= n5) break;
        if (it < n0) m2scan_item(p, L, it, smem);
        else if (it < n1) s5carry_item(p, L, it - n0);
        else if (it < n2) mla_attn_item(p, it - n1, false, smem);
        else if (it < n3) na_attn_item(p, L, it - n2, false, smem);
        else if (it < n4) mla_attn_item(p, it - n3, true, smem);
        else na_attn_item(p, L, it - n4, true, smem);
      }
    } break;
    case LP_MIX2:
      seg(16 * S5_MT * 2, [&](int it) { s5c_tile(p, L, it, smem); });
      seg(NTOK / NWAVES, [&](int it) { m2gate_item(p, L, it); });
      break;
    case LP_GLU:
      seg(GLU_MT * 2, [&](int it) { glu_tile(p, L, it, smem); });
      break;
    case LP_MERGE:
      seg(mtiles(L.last, 256) * 8, [&](int it) { merge_tile(p, L, it, smem); });
      break;
    case LP_OUT:
      seg(mtiles(L.last, 256) * 4, [&](int it) { outproj_tile(p, L, it, smem); });
      break;
    case LP_POST:
      seg(CT_EXP, [&](int it) { conv_expert_item(p, l, it, smem); });
      post_stage_router(p, L, smem);
      post_phase(p, L, smem);
      break;
    case LP_ROUTE:
      seg(BATCH * 16 * (L.last ? 1 : 2), [&](int it) { route_item(p, L, it, smem); });
      break;
    case LP_MOE1:
      seg(NE * (((L.last ? ESLOTS_L : ESLOTS) + 255) / 256) * 8, [&](int it) { moe1_tile(p, L, it, smem); });
      break;
    case LP_MOE2:
      seg(((NE * (((L.last ? ESLOTS_L : ESLOTS) + 255) / 256) + 1) / 2) * 8, [&](int it) { moe2_tile(p, L, it, smem); });
      break;
    case LP_COMB:
      comb_phase(p, L);
      break;
  }
}

__global__ void __launch_bounds__(NTHREADS, 2) mega_kernel(Params p) {
#ifdef EMU
  char* smem = emu_cur_f->blk->smem;
  for (int ph = p.phase_lo; ph < p.phase_hi; ++ph) {
    run_phase(p, ph, smem);
    if (ph + 1 < p.phase_hi) emu_grid_sync();
  }
#else
  __shared__ __attribute__((aligned(16))) char smem[SMEM_BYTES + 16 + 256];
  {
    const unsigned hw = (unsigned)__builtin_amdgcn_s_getreg((5 << 11) | 4) & 0x3fu;
    if ((threadIdx.x & 63) == 0) *(volatile int*)(smem + WAVE_TAB_OFF + hw * 4u) = (int)(threadIdx.x >> 6);
    __syncthreads();
  }
  if (p.phase_hi - p.phase_lo > 1) {
    if (threadIdx.x == 0) *(uint4*)(smem + SMEM_BYTES) = make_uint4(0u, 0u, 0u, 0u);
    __syncthreads();
    XcdBarrier xb = xcd_barrier_post((unsigned*)(p.ws + OFF_BAR), (volatile LAS unsigned*)(smem + SMEM_BYTES));
    for (int ph = p.phase_lo; ph < p.phase_hi; ++ph) {
      int reps = 1;
#ifdef PROBE_PHASE
      if (ph == PROBE_PHASE || ph == PROBE_PHASE2) reps = 1 + PROBE_REP;
#endif
      for (int rep = 0; rep < reps; ++rep) {
        p.probe_rep = rep;
        run_phase(p, ph, smem);
        if (ph + 1 < p.phase_hi || rep + 1 < reps) {
          if (ph == p.phase_lo && rep == 0) cg::this_grid().sync();
          else xcd_barrier(xb);
        }
      }
    }
  } else {
    run_phase(p, p.phase_lo, smem);
  }
#endif
}

#ifndef EMU
extern "C" void kernel_launch(void* const* d_in, const int* in_sizes, int n_in, void* d_out, int out_size, void* d_ws, size_t ws_size,
                              hipStream_t stream) {
  static int grid_blocks = 0;
  if (!grid_blocks) {
    int dev = 0, cus = 0, per_cu = 0;
    hipGetDevice(&dev);
    hipDeviceGetAttribute(&cus, hipDeviceAttributeMultiprocessorCount, dev);
    hipOccupancyMaxActiveBlocksPerMultiprocessor(&per_cu, mega_kernel, NTHREADS, 0);
    if (per_cu > 1) per_cu = 1;
    if (per_cu < 1) per_cu = 1;
    grid_blocks = cus * per_cu;
    if (ws_size < WS_TOTAL) fprintf(stderr, "workspace too small: %zu < %zu\n", ws_size, (size_t)WS_TOTAL);
  }
  Params p{};
  for (int i = 0; i < N_INPUTS; ++i) p.in[i] = (const float*)d_in[i];
  p.out = (float*)d_out;
  p.ws = (char*)d_ws;
#if MK_MULTI
  for (int ph = 0; ph < NPHASES; ++ph) {
    p.phase_lo = ph; p.phase_hi = ph + 1;
    hipLaunchKernelGGL(mega_kernel, dim3(grid_blocks), dim3(NTHREADS), 0, stream, p);
  }
#else
  p.phase_lo = 0; p.phase_hi = NPHASES;
  hipMemsetAsync((char*)d_ws + OFF_BAR, 0, BAR_BYTES, stream);
  void* args[] = {&p};
  hipError_t e = hipLaunchCooperativeKernel((void*)mega_kernel, dim3(grid_blocks), dim3(NTHREADS), args, 0, stream);
  if (e != hipSuccess) fprintf(stderr, "cooperative launch failed: %s (grid %d)\n", hipGetErrorString(e), grid_blocks);
#endif
}
#endif
```

```cpp
#ifdef EMU
#include "emu.h"
#else
#include <hip/hip_runtime.h>
#include <hip/hip_cooperative_groups.h>
#include <cstdio>
namespace cg = cooperative_groups;
using bf16x8 = __attribute__((ext_vector_type(8))) short;
using f32x4 = __attribute__((ext_vector_type(4))) float;
using f32x16 = __attribute__((ext_vector_type(16))) float;
#endif
using u32x4 = __attribute__((ext_vector_type(4))) unsigned;
#ifndef MK_MULTI
#define MK_MULTI 0
#endif

#define DI __device__ __forceinline__
typedef unsigned short bf16;

#ifdef EMU_SMALL2
constexpr int BATCH = 2, SEQ = 1024, CTXL = 64, GRID_W = 32;
#elif defined(EMU_SMALL)
constexpr int BATCH = 2, SEQ = 512, CTXL = 64, GRID_W = 32;
#else
constexpr int BATCH = 8, SEQ = 2048, CTXL = 256, GRID_W = 64;
#endif
constexpr int D = 1024, DEPTH = 2;
constexpr int TOK = CTXL + SEQ, NTOK = BATCH * TOK;
constexpr int ROWS = SEQ / GRID_W;
constexpr int WIN_R = (ROWS < 8 ? ROWS : 8), WIN_C = 16;
constexpr int N_IN = 6568, N_INP = 6656;
constexpr int C_CQ = 0, C_CKV = 256, C_KR = 384, C_NA = 416, C_S5 = 1184, C_Z = 1440, C_XBC = 1696, C_DT = 2464, C_GATE = 2472;
constexpr int P1W = 2480;
constexpr int NCH = TOK / 16, NCC = CTXL / 16, MCH = BATCH * NCH;
constexpr int NE = 16;
constexpr int CAP_L = 2 * SEQ / NE, CAP_C = 2 * CTXL / NE;
constexpr int ESLOTS = BATCH * (CAP_L + CAP_C), ESLOTS_L = BATCH * CAP_L;
constexpr int NB1 = BATCH + 1;
constexpr float EPS = 1e-6f;
constexpr int SMEM_BYTES = 147456;
constexpr int NTHREADS = 512, NWAVES = NTHREADS / 64;

enum { I_X = 0, I_C, I_CTX, I_CCTX, I_WADA, I_BADA, I_GPREMIX, I_GPOSTMIX, I_GPREFFN, I_GPOSTFFN, I_WIN, I_GCQ, I_GCKV, I_WUQ, I_WUKV, I_RPB,
       I_S5ARE, I_S5AIM, I_S5LOGSTEP, I_S5BRE, I_S5BIM, I_S5CRE, I_S5CIM, I_S5D, I_S5WGLU, I_S5BGLU, I_M2CONVW, I_M2CONVB, I_M2ALOG, I_M2DTBIAS,
       I_M2D, I_M2GNORM, I_WBRANCH, I_WOUT, I_WROUTER, I_WGATE, I_WUP, I_WDOWN, N_INPUTS };

constexpr size_t al256(size_t x) { return (x + 255) & ~(size_t)255; }
constexpr size_t SZ_X = (size_t)NTOK * D * 4;
constexpr size_t SZ_ROWBF = (size_t)NTOK * D * 2;
constexpr size_t OFF_X = 0;
constexpr size_t OFF_MOD = OFF_X + al256(SZ_X);
constexpr size_t OFF_HA = OFF_MOD + al256((size_t)DEPTH * NB1 * 6144 * 4);
constexpr size_t OFF_O = OFF_HA + al256(SZ_ROWBF);
constexpr size_t OFF_P1 = OFF_O + al256(SZ_ROWBF);
constexpr size_t SZ_P1 = (size_t)NTOK * P1W * 2;
constexpr size_t OFF_PG = OFF_P1 + al256(SZ_P1);
constexpr size_t SZ_PG = (size_t)NTOK * 4096 * 2;
constexpr size_t OFF_DT = OFF_PG + al256(SZ_PG);
constexpr size_t OFF_AFF = OFF_DT + al256((size_t)NTOK * 8 * 4);
constexpr size_t OFF_SEL = OFF_AFF + al256((size_t)NTOK * 16 * 4);
constexpr size_t OFF_IDX = OFF_SEL + al256((size_t)NTOK * 16 * 4);
constexpr size_t OFF_GW = OFF_IDX + al256((size_t)NE * ESLOTS * 4);
constexpr size_t OFF_BAR = OFF_GW + al256((size_t)NE * ESLOTS * 4);
constexpr size_t BAR_BYTES = (3456 + 64 * 4) * 4;
constexpr int Q_WORD0 = 3456;
constexpr size_t OFF_ROPE = OFF_BAR + al256(BAR_BYTES);
constexpr size_t OFF_WEARLY = OFF_ROPE + al256(64 * 8 * 2 * 4);
constexpr size_t WE_WIN = 0;
constexpr size_t WE_UQ = WE_WIN + (size_t)N_INP * 1024 * 2;
constexpr size_t WE_UKV = WE_UQ + (size_t)384 * 256 * 2;
constexpr size_t WE_GLU = WE_UKV + (size_t)512 * 128 * 2;
constexpr size_t WE_WB = WE_GLU + (size_t)256 * 256 * 2;
constexpr size_t WE_WOUT = WE_WB + (size_t)4 * 1024 * 256 * 2;
constexpr size_t WE_SIZE = al256(WE_WOUT + (size_t)1024 * 1024 * 2);
constexpr size_t OFF_S5TAB = OFF_WEARLY + DEPTH * WE_SIZE;
constexpr size_t S5_LAMPOW = 0;
constexpr size_t S5_BBAR = S5_LAMPOW + (size_t)2 * 16 * 17 * 64 * 2 * 4;
constexpr size_t S5_KT = S5_BBAR + (size_t)2 * 16 * 64 * 16 * 2 * 4;
constexpr size_t S5_WA = S5_KT + (size_t)2 * 16 * 16 * 256 * 4;
constexpr size_t S5_W2 = S5_WA + (size_t)16 * 256 * 256 * 2;
constexpr size_t S5_SIZE = al256(S5_W2 + (size_t)16 * 256 * 512 * 2);
constexpr size_t OFF_MIX = OFF_S5TAB + DEPTH * S5_SIZE;
constexpr size_t MX_Q = 0;
constexpr size_t MX_K = MX_Q + al256((size_t)BATCH * 4 * TOK * 96 * 2);
constexpr size_t MX_VTM = MX_K + al256((size_t)BATCH * 4 * TOK * 96 * 2);
constexpr size_t MX_VTN = MX_VTM + al256((size_t)BATCH * 4 * 64 * TOK * 2);
constexpr size_t MX_XBC = MX_VTN + al256((size_t)BATCH * 4 * 64 * TOK * 2);
constexpr size_t MX_US5 = MX_XBC + al256((size_t)NTOK * 768 * 2);
constexpr size_t MX_HEND = MX_US5 + al256((size_t)NTOK * 256 * 2);
constexpr size_t MX_HIN = MX_HEND + al256((size_t)16 * MCH * 256 * 4);
constexpr size_t MX_Z = MX_HIN + al256((size_t)16 * MCH * 256 * 2);
constexpr size_t MX_XBT = MX_Z + al256((size_t)NTOK * 256 * 2);
constexpr size_t MX_M2S = MX_XBT + al256((size_t)NTOK * 512 * 2);
constexpr size_t MX_SIZE = MX_M2S + al256((size_t)BATCH * 8 * TOK * 4 * 4);
constexpr size_t WX_GU = 0;
constexpr size_t WX_DN = WX_GU + (size_t)NE * 2048 * 1024 * 2;
constexpr size_t WX_SIZE = WX_DN + (size_t)NE * 1024 * 1024 * 2;
constexpr size_t MIXREG = (MX_SIZE > WX_SIZE ? MX_SIZE : WX_SIZE);
constexpr size_t WS_TOTAL = OFF_MIX + al256(MIXREG);

struct Params {
  const float* in[N_INPUTS];
  float* out;
  char* ws;
  int phase_lo, phase_hi;
  int probe_rep, pad_;
};

constexpr int WAVE_TAB_OFF = SMEM_BYTES + 16;
DI int tid_() {
#ifdef EMU
  return (int)threadIdx.x;
#else
  const unsigned hw = (unsigned)__builtin_amdgcn_s_getreg((5 << 11) | 4) & 0x3fu;
  const int wave = *(volatile __attribute__((address_space(3))) int*)(unsigned long)(WAVE_TAB_OFF + hw * 4u);
  int lane;
  asm volatile("v_mbcnt_lo_u32_b32 %0, -1, 0\n\tv_mbcnt_hi_u32_b32 %0, -1, %0" : "=v"(lane));
  return wave * 64 + lane;
#endif
}
#ifdef EMU
template <class T> DI T shfl_xor_(T v, int m) { return __shfl_xor(v, m); }
template <class T> DI T shfl_up_(T v, int d) { return __shfl_up(v, d); }
template <class T> DI T shfl_(T v, int src) { return __shfl(v, src); }
#else
template <class T> DI T shfl_xor_(T v, int m) {
  const int idx = ((tid_() & 63) ^ m) << 2;
  return __builtin_bit_cast(T, __builtin_amdgcn_ds_bpermute(idx, __builtin_bit_cast(int, v)));
}
template <class T> DI T shfl_up_(T v, int d) {
  const int l = tid_() & 63; const int idx = (l >= d ? l - d : l) << 2;
  return __builtin_bit_cast(T, __builtin_amdgcn_ds_bpermute(idx, __builtin_bit_cast(int, v)));
}
template <class T> DI T shfl_(T v, int src) {
  int idx = src << 2; asm volatile("" : "+v"(idx));
  return __builtin_bit_cast(T, __builtin_amdgcn_ds_bpermute(idx, __builtin_bit_cast(int, v)));
}
#endif
DI float bf2f(bf16 h) { return __uint_as_float(((unsigned)h) << 16); }
DI bf16 f2bf(float f) { unsigned u = __float_as_uint(f); u += 0x7fffu + ((u >> 16) & 1u); return (bf16)(u >> 16); }
#ifdef EMU
DI unsigned pack2(float a, float b) { return (unsigned)f2bf(a) | ((unsigned)f2bf(b) << 16); }
DI float exp2f_(float x) { return exp2f(x); }
#else
typedef float f32x2_t_ __attribute__((ext_vector_type(2)));
typedef __bf16 bf16x2_t_ __attribute__((ext_vector_type(2)));
DI unsigned pack2(float a, float b) { const f32x2_t_ v = {a, b}; return __builtin_bit_cast(unsigned, __builtin_convertvector(v, bf16x2_t_)); }
DI float exp2f_(float x) { return __builtin_amdgcn_exp2f(x); }
#endif
DI float sigmoidf_(float x) { return 1.0f / (1.0f + __expf(-x)); }
DI float siluf_(float x) { return x / (1.0f + __expf(-x)); }
DI float softplusf_(float x) { const float ax = x < 0.f ? -x : x; return (x > 0.f ? x : 0.f) + __logf(1.0f + __expf(-ax)); }
DI float geluf_(float x) { const float u2 = 1.5957691216057308f * (x + 0.044715f * x * x * x); return x / (1.0f + __expf(-u2)); }
DI bool wave_all_(bool c) {
#ifdef EMU
  int v = c ? 0 : 1;
  v += shfl_xor_(v, 32); v += shfl_xor_(v, 16); v += shfl_xor_(v, 8); v += shfl_xor_(v, 4); v += shfl_xor_(v, 2); v += shfl_xor_(v, 1);
  return v == 0;
#else
  return __builtin_amdgcn_ballot_w64(!c) == 0ull;
#endif
}
DI float wave_sum(float v) {
#ifdef EMU
  v += shfl_xor_(v, 32); v += shfl_xor_(v, 16); v += shfl_xor_(v, 8); v += shfl_xor_(v, 4); v += shfl_xor_(v, 2); v += shfl_xor_(v, 1);
  return v;
#else
  int x = __float_as_int(v);
  x = __float_as_int(__int_as_float(x) + __int_as_float(__builtin_amdgcn_update_dpp(0, x, 0xB1, 0xF, 0xF, true)));
  x = __float_as_int(__int_as_float(x) + __int_as_float(__builtin_amdgcn_update_dpp(0, x, 0x4E, 0xF, 0xF, true)));
  x = __float_as_int(__int_as_float(x) + __int_as_float(__builtin_amdgcn_update_dpp(0, x, 0x141, 0xF, 0xF, true)));
  x = __float_as_int(__int_as_float(x) + __int_as_float(__builtin_amdgcn_update_dpp(0, x, 0x140, 0xF, 0xF, true)));
  const float r0 = __int_as_float(__builtin_amdgcn_readlane(x, 0)), r1 = __int_as_float(__builtin_amdgcn_readlane(x, 16));
  const float r2 = __int_as_float(__builtin_amdgcn_readlane(x, 32)), r3 = __int_as_float(__builtin_amdgcn_readlane(x, 48));
  return (r0 + r1) + (r2 + r3);
#endif
}
#ifndef EMU
#define XB_TMO      128
#define XB_XCNT(j)  (256  + 64 * (j))
#define XB_XSUB(j)  (1280 + 64 * (j))
#define XB_XGEN(j)  (2304 + 64 * (j))
#define XB_TOP      3328
#define XB_TOPGEN   3392
#define XB_SPIN_CAP (1u << 24)
#define LAS __attribute__((address_space(3)))
DI unsigned xb_ld(unsigned* p) { return __hip_atomic_load(p, __ATOMIC_RELAXED, __HIP_MEMORY_SCOPE_AGENT); }
DI unsigned xb_add(unsigned* p, unsigned v) { return __hip_atomic_fetch_add(p, v, __ATOMIC_RELAXED, __HIP_MEMORY_SCOPE_AGENT); }
DI unsigned xb_xcc_id() { return (unsigned)__builtin_amdgcn_s_getreg((3 << 11) | 20) & 0xFu; }
#define XB_SPIN(cond, bar) do { unsigned _sp = 0; while (cond) { __builtin_amdgcn_s_sleep(1); \
    if ((++_sp & 255u) == 0u) { if (xb_ld(&(bar)[XB_TMO])) break; if (_sp > XB_SPIN_CAP) { atomicAdd(&(bar)[XB_TMO], 1u); break; } } } } while (0)
struct XcdBarrier { unsigned* bar; unsigned x; volatile LAS unsigned* st; };
DI XcdBarrier xcd_barrier_post(unsigned* bar, volatile LAS unsigned* st) {
  XcdBarrier b; b.bar = bar; b.x = xb_xcc_id(); b.st = st;
  if (threadIdx.x == 0) (void)xb_add(&bar[XB_XCNT(b.x)], 1u);
  return b;
}
DI void xcd_barrier_complete(unsigned* bar, unsigned x, unsigned& nloc, unsigned& nx) {
  const unsigned G = gridDim.x * gridDim.y * gridDim.z;
  unsigned sum, cnt, mine, sp = 0u;
  for (;;) {
    sum = 0u; cnt = 0u; mine = 0u;
#pragma unroll
    for (unsigned j = 0; j < 16; ++j) { const unsigned c = xb_ld(&bar[XB_XCNT(j)]); sum += c; cnt += (c > 0u) ? 1u : 0u; mine = (j == x) ? c : mine; }
    if (sum == G) break;
    __builtin_amdgcn_s_sleep(1);
    if ((++sp & 255u) == 0u) { if (xb_ld(&bar[XB_TMO])) break; if (sp > XB_SPIN_CAP) { atomicAdd(&bar[XB_TMO], 1u); break; } }
  }
  nloc = mine > 0u ? mine : 1u; nx = cnt > 0u ? cnt : 1u;
}
DI void xcd_barrier(const XcdBarrier& b) {
  asm volatile("s_waitcnt vmcnt(0)" ::: "memory");
  __syncthreads();
  if (threadIdx.x == 0) {
    unsigned* bar = b.bar;
    __builtin_amdgcn_s_waitcnt(0);
    unsigned nloc = b.st[0], nx = b.st[1];
    if (nloc == 0u) { xcd_barrier_complete(bar, b.x, nloc, nx); b.st[0] = nloc; b.st[1] = nx; }
    const unsigned old = xb_add(&bar[XB_XSUB(b.x)], 1u);
    const unsigned gen = old / nloc;
    if (old + 1u == (gen + 1u) * nloc) {
      __builtin_amdgcn_fence(__ATOMIC_RELEASE, "agent");
      asm volatile("s_waitcnt vmcnt(0)" ::: "memory");
      const unsigned og = xb_add(&bar[XB_TOP], 1u);
      const unsigned tg = og / nx;
      if (og + 1u == (tg + 1u) * nx) xb_add(&bar[XB_TOPGEN], 1u);
      else XB_SPIN(xb_ld(&bar[XB_TOPGEN]) == tg, bar);
      __builtin_amdgcn_fence(__ATOMIC_ACQUIRE, "agent");
      xb_add(&bar[XB_XGEN(b.x)], 1u);
      asm volatile("s_waitcnt vmcnt(0)" ::: "memory");
    } else {
      XB_SPIN(xb_ld(&bar[XB_XGEN(b.x)]) == gen, bar);
      __builtin_amdgcn_fence(__ATOMIC_ACQUIRE, "agent");
      asm volatile("s_waitcnt vmcnt(0)" ::: "memory");
    }
  }
  __syncthreads();
}
#endif

struct GA {
  const bf16* A; const bf16* A2; int lda, lda2, ksplit;
  const int* ridx; int mvalid;
  const bf16* Bt; int ldb; int K;
  int kfix;
};
DI GA make_ga(const bf16* A, int lda, const bf16* Bt, int ldb, int K, int mvalid) {
  GA g; g.A = A; g.A2 = A; g.lda = lda; g.lda2 = lda; g.ksplit = K; g.ridx = nullptr; g.mvalid = mvalid; g.Bt = Bt; g.ldb = ldb; g.K = K; g.kfix = 0; return g;
}

#ifdef EMU
#define GLDS16(gptr_, lptr_) memcpy((void*)(lptr_), (const void*)(gptr_), 16)
#define BGLDS16(rsrc_, base_, voff_, soff_, lptr_) memcpy((void*)(lptr_), (const char*)(base_) + (voff_) + (soff_), 16)
#define GEMM_WAIT(N_)
#define RAW_BARRIER() __syncthreads()
#else
#define LASV __attribute__((address_space(3))) void
#define GLDS16(gptr_, lptr_) __builtin_amdgcn_global_load_lds((const void*)(gptr_), (LASV*)(lptr_), 16, 0, 0)
#define BGLDS16(rsrc_, base_, voff_, soff_, lptr_) __builtin_amdgcn_raw_ptr_buffer_load_lds(rsrc_, (LASV*)(lptr_), 16, (int)(voff_), (int)(soff_), 0, 0)
#define GEMM_WAIT(N_) asm volatile("s_waitcnt vmcnt(%0)" :: "n"(N_) : "memory")
#define RAW_BARRIER() { asm volatile("" ::: "memory"); __builtin_amdgcn_s_barrier(); asm volatile("" ::: "memory"); }
#endif
DI int perm32(int rho) { const int n = rho >> 4, i = rho & 15; return 8 * (i >> 2) + 4 * n + (i & 3); }
constexpr int SRS_OFF = 73728;
template <int NT>
DI void gemm_s(const GA& g, int m0, int n0, char* smem, f32x4 (&acc)[4][NT]) {
  constexpr int A_ELEMS = 256 * 32, B_ELEMS = 32 * NT * 32, STAGE = A_ELEMS + B_ELEMS;
  bf16* st = (bf16*)smem;
  const int tid = tid_(), lane = tid & 63, wid = tid >> 6, wr = wid >> 1, wc = wid & 1, fr = lane & 15, fq = lane >> 4;
  const int lrow = tid >> 2, pch = tid & 3;
  long aoff[2], aoff2[2], boff;
#pragma unroll
  for (int i = 0; i < 2; ++i) {
    const int row = lrow + 128 * i;
    const int lch = pch ^ ((-(row >> 2)) & 3);
    int gm = m0 + row; if (gm > g.mvalid - 1) gm = g.mvalid - 1;
    const int ar = g.ridx ? g.ridx[gm] : gm;
    aoff[i] = (long)ar * g.lda + lch * 8;
    aoff2[i] = (long)ar * g.lda2 + lch * 8;
  }
  const int cb = (NT == 4) ? tid : (tid & 255);
  {
    const int row = cb >> 2;
    const int lch = pch ^ ((-(row >> 2)) & 3);
    const int src = n0 + (row & ~31) + perm32(row & 31);
    boff = (long)src * g.ldb + lch * 8;
  }
#pragma unroll
  for (int m = 0; m < 4; ++m)
#pragma unroll
    for (int n = 0; n < NT; ++n) acc[m][n] = f32x4{0.f, 0.f, 0.f, 0.f};
  const int T = g.K / 32;
#define GEMM_DMA(t_, stg_) { const int k0_ = (t_) * 32; const bool seg2_ = (k0_ >= g.ksplit); bf16* sa_ = st + (stg_) * STAGE; \
    _Pragma("unroll") for (int i_ = 0; i_ < 2; ++i_) { \
      const bf16* ap_ = seg2_ ? (g.A2 + aoff2[i_] + (k0_ - g.ksplit)) : (g.A + aoff[i_] + k0_); \
      GLDS16(ap_, sa_ + (tid + i_ * 512) * 8); } \
    GLDS16(g.Bt + boff + k0_, sa_ + A_ELEMS + cb * 8); }
  __syncthreads();
  GEMM_DMA(0, 0)
  if (T > 1) GEMM_DMA(1, 1)
  int s_cur = 0, s_nxt = 2;
#pragma unroll 1
  for (int t = 0; t < T; ++t) {
    if (t + 1 < T) { GEMM_WAIT(3); } else { GEMM_WAIT(0); }
    RAW_BARRIER();
    if (t + 2 < T) GEMM_DMA(t + 2, s_nxt)
    const bf16* sa = st + s_cur * STAGE;
    const bf16* sb = sa + A_ELEMS;
    bf16x8 af[4], bfr[NT];
#pragma unroll
    for (int n = 0; n < NT; ++n) {
      const int row = wc * (16 * NT) + n * 16 + fr;
      bfr[n] = *(const bf16x8*)(sb + row * 32 + ((fq ^ ((-(row >> 2)) & 3)) << 3));
    }
#pragma unroll
    for (int m = 0; m < 4; ++m) {
      const int row = wr * 64 + m * 16 + fr;
      af[m] = *(const bf16x8*)(sa + row * 32 + ((fq ^ ((-(row >> 2)) & 3)) << 3));
    }
#pragma unroll
    for (int m = 0; m < 4; ++m)
#pragma unroll
      for (int n = 0; n < NT; ++n) acc[m][n] = __builtin_amdgcn_mfma_f32_16x16x32_bf16(bfr[n], af[m], acc[m][n], 0, 0, 0);
    s_cur = (s_cur == 2) ? 0 : s_cur + 1;
    s_nxt = (s_nxt == 2) ? 0 : s_nxt + 1;
  }
}
constexpr int BG_HT = 128 * 64;
DI int lds_byte(int r, int c) { const int stt = (r >> 4) * 2 + (c >> 5), rr = r & 15, cc = c & 31, ob = rr * 64 + cc * 2; return stt * 1024 + (ob ^ (((ob >> 9) & 1) << 5)); }
DI void stage_rc(int b, int& R, int& C) { const int stt = b / 1024, sb = b % 1024, swz = sb ^ (((sb >> 9) & 1) << 5); R = (stt >> 1) * 16 + swz / 64; C = (stt & 1) * 32 + (swz % 64) / 2; }
#ifdef EMU
#define BG_WAIT_V(n)
#define BG_WAIT_L(n)
#define BG_BAR __syncthreads()
#define BG_SCHED
#define BG_PRIO(x)
#else
#define BG_WAIT_V(n) asm volatile("s_waitcnt vmcnt(" #n ")" ::: "memory")
#define BG_WAIT_L(n) asm volatile("s_waitcnt lgkmcnt(" #n ")" ::: "memory")
#define BG_BAR __builtin_amdgcn_s_barrier()
#define BG_SCHED __builtin_amdgcn_sched_barrier(0)
#define BG_PRIO(x) __builtin_amdgcn_s_setprio(x)
#endif
DI void gemm_big(const GA& g, int m0, int n0, char* smem, f32x4 (&acc)[2][2][4][2]) {
  bf16* shm = (bf16*)smem;
  const int tid = tid_(), wid = tid >> 6, lane = tid & 63, wr = wid >> 2, wc = wid & 3, fr = lane & 15, fq = lane >> 4;
  unsigned aof[2][2], bof[2];
#ifdef EMU
  const int dma_lds = tid * 16;
#else
  const int dma_lds = __builtin_amdgcn_readfirstlane(tid >> 6) * 1024;
#endif
#ifndef EMU
  const __amdgpu_buffer_rsrc_t rsA = __builtin_amdgcn_make_buffer_rsrc((void*)g.A, 0, 0x7fffffff, 0x00020000);
  const __amdgpu_buffer_rsrc_t rsB = __builtin_amdgcn_make_buffer_rsrc((void*)g.Bt, 0, 0x7fffffff, 0x00020000);
#endif
#pragma unroll
  for (int i = 0; i < 2; ++i) {
    int R, C; stage_rc(tid * 16 + i * 8192, R, C);
    bof[i] = (unsigned)((n0 + (R & ~31) + perm32(R & 31)) * g.ldb + C) * 2u;
#pragma unroll
    for (int h = 0; h < 2; ++h) {
      int gm = m0 + h * 128 + R; if (gm > g.mvalid - 1) gm = g.mvalid - 1;
      const int ar = g.ridx ? g.ridx[gm] : gm;
      aof[h][i] = (unsigned)(ar * g.lda + C) * 2u;
    }
  }
#define BG_SA(b, h) (shm + ((b) * 2 + (h)) * BG_HT)
#define BG_SB(b, h) (shm + (4 + (b) * 2 + (h)) * BG_HT)
#define BG_STAGE_A(P, h, kt) { \
    _Pragma("unroll") for (int i_ = 0; i_ < 2; ++i_) BGLDS16(rsA, g.A, aof[h][i_], (kt) * 128, (char*)(P) + dma_lds + i_ * 8192); }
#define BG_STAGE_B(P, h, kt) { \
    _Pragma("unroll") for (int i_ = 0; i_ < 2; ++i_) BGLDS16(rsB, g.Bt, bof[i_], (kt) * 128 + (h) * 256 * g.ldb, (char*)(P) + dma_lds + i_ * 8192); }
#define BG_LDA(dst, b, h) _Pragma("unroll") for (int m_ = 0; m_ < 4; ++m_) _Pragma("unroll") for (int k_ = 0; k_ < 2; ++k_) \
    dst[m_][k_] = *(const bf16x8*)((const char*)BG_SA(b, h) + lds_byte(wr * 64 + m_ * 16 + fr, k_ * 32 + fq * 8))
#define BG_LDB(dst, b, h) _Pragma("unroll") for (int n_ = 0; n_ < 2; ++n_) _Pragma("unroll") for (int k_ = 0; k_ < 2; ++k_) \
    dst[n_][k_] = *(const bf16x8*)((const char*)BG_SB(b, h) + lds_byte(wc * 32 + n_ * 16 + fr, k_ * 32 + fq * 8))
#define BG_MMA(ai, bj, At_, Bt_) { BG_PRIO(1); \
    _Pragma("unroll") for (int m_ = 0; m_ < 4; ++m_) _Pragma("unroll") for (int n_ = 0; n_ < 2; ++n_) _Pragma("unroll") for (int k_ = 0; k_ < 2; ++k_) \
      acc[ai][bj][m_][n_] = __builtin_amdgcn_mfma_f32_16x16x32_bf16(Bt_[n_][k_], At_[m_][k_], acc[ai][bj][m_][n_], 0, 0, 0); \
    BG_PRIO(0); }
#pragma unroll
  for (int a_ = 0; a_ < 2; ++a_)
#pragma unroll
    for (int b_ = 0; b_ < 2; ++b_)
#pragma unroll
      for (int m_ = 0; m_ < 4; ++m_)
#pragma unroll
        for (int n_ = 0; n_ < 2; ++n_) acc[a_][b_][m_][n_] = f32x4{0.f, 0.f, 0.f, 0.f};
  bf16x8 At[4][2], B0[2][2], B1[2][2];
  const int nt = g.K / 64;
  __syncthreads();
  BG_STAGE_B(BG_SB(0, 0), 0, 0) BG_STAGE_A(BG_SA(0, 0), 0, 0)
  BG_STAGE_B(BG_SB(0, 1), 1, 0) BG_STAGE_A(BG_SA(0, 1), 1, 0)
  if (wr == 1) BG_BAR;
  BG_WAIT_V(4); BG_BAR;
  BG_STAGE_B(BG_SB(1, 0), 0, 1) BG_STAGE_A(BG_SA(1, 0), 0, 1) BG_STAGE_B(BG_SB(1, 1), 1, 1)
  BG_WAIT_V(6); BG_BAR;
#pragma unroll 1
  for (int t = 0; t < nt - 2; t += 2) {
    BG_LDB(B0, 0, 0); BG_SCHED; BG_LDA(At, 0, 0); BG_STAGE_A(BG_SA(1, 1), 1, t + 1)
    BG_WAIT_L(8); BG_BAR; BG_WAIT_L(0); BG_MMA(0, 0, At, B0) BG_BAR; BG_SCHED;
    BG_LDB(B1, 0, 1); BG_STAGE_B(BG_SB(0, 0), 0, t + 2)
    BG_BAR; BG_WAIT_L(0); BG_MMA(0, 1, At, B1) BG_BAR;
    BG_LDA(At, 0, 1); BG_STAGE_A(BG_SA(0, 0), 0, t + 2)
    BG_BAR; BG_WAIT_L(0); BG_MMA(1, 0, At, B0) BG_BAR; BG_SCHED;
    BG_STAGE_B(BG_SB(0, 1), 1, t + 2)
    BG_WAIT_V(6); BG_BAR; BG_MMA(1, 1, At, B1) BG_BAR;
    BG_LDB(B0, 1, 0); BG_SCHED; BG_LDA(At, 1, 0); BG_STAGE_A(BG_SA(0, 1), 1, t + 2)
    BG_WAIT_L(8); BG_BAR; BG_WAIT_L(0); BG_MMA(0, 0, At, B0) BG_BAR; BG_SCHED;
    BG_LDB(B1, 1, 1); BG_STAGE_B(BG_SB(1, 0), 0, t + 3)
    BG_BAR; BG_WAIT_L(0); BG_MMA(0, 1, At, B1) BG_BAR;
    BG_LDA(At, 1, 1); BG_STAGE_A(BG_SA(1, 0), 0, t + 3)
    BG_BAR; BG_WAIT_L(0); BG_MMA(1, 0, At, B0) BG_BAR; BG_SCHED;
    BG_STAGE_B(BG_SB(1, 1), 1, t + 3)
    BG_WAIT_V(6); BG_BAR; BG_MMA(1, 1, At, B1) BG_BAR;
  }
  { BG_LDB(B0, 0, 0); BG_LDA(At, 0, 0); BG_STAGE_A(BG_SA(1, 1), 1, nt - 1)
    BG_BAR; BG_WAIT_L(0); BG_MMA(0, 0, At, B0) BG_BAR;
    BG_LDB(B1, 0, 1); BG_BAR; BG_WAIT_L(0); BG_MMA(0, 1, At, B1) BG_BAR;
    BG_LDA(At, 0, 1); BG_WAIT_V(4); BG_BAR; BG_WAIT_L(0); BG_MMA(1, 0, At, B0) BG_MMA(1, 1, At, B1) BG_BAR; }
  { BG_LDB(B0, 1, 0); BG_LDA(At, 1, 0); BG_WAIT_V(2); BG_BAR; BG_WAIT_L(0); BG_MMA(0, 0, At, B0) BG_BAR;
    BG_LDB(B1, 1, 1); BG_WAIT_V(0); BG_BAR; BG_WAIT_L(0); BG_MMA(0, 1, At, B1) BG_BAR;
    BG_LDA(At, 1, 1); BG_BAR; BG_WAIT_L(0); BG_MMA(1, 0, At, B0) BG_MMA(1, 1, At, B1) BG_BAR; }
  if (wr == 0) BG_BAR;
}
#define EPIB_BEGIN(acc_, m0_, n0_, mvalid_) { const int _l = tid_() & 63, _w = tid_() >> 6, _wr = _w >> 2, _wc = _w & 3, _fr = _l & 15, _fq = _l >> 4; \
  _Pragma("unroll") for (int _ai = 0; _ai < 2; ++_ai) _Pragma("unroll") for (int _m = 0; _m < 4; ++_m) { const int row = (m0_) + _ai * 128 + _wr * 64 + _m * 16 + _fr; \
  _Pragma("unroll") for (int _bj = 0; _bj < 2; ++_bj) { const int col = (n0_) + _bj * 128 + _wc * 32 + 8 * _fq; (void)col; \
    float v[8] = {acc_[_ai][_bj][_m][0][0], acc_[_ai][_bj][_m][0][1], acc_[_ai][_bj][_m][0][2], acc_[_ai][_bj][_m][0][3], \
                  acc_[_ai][_bj][_m][1][0], acc_[_ai][_bj][_m][1][1], acc_[_ai][_bj][_m][1][2], acc_[_ai][_bj][_m][1][3]}; \
    if (row < (mvalid_)) {
#define EPIB_END }}}}

DI void ld8bf(const bf16* p, float (&v)[8]) {
  uint4 w = *(const uint4*)p;
  v[0] = __uint_as_float(w.x << 16); v[1] = __uint_as_float(w.x & 0xffff0000u); v[2] = __uint_as_float(w.y << 16); v[3] = __uint_as_float(w.y & 0xffff0000u);
  v[4] = __uint_as_float(w.z << 16); v[5] = __uint_as_float(w.z & 0xffff0000u); v[6] = __uint_as_float(w.w << 16); v[7] = __uint_as_float(w.w & 0xffff0000u);
}
DI void st8bf(bf16* p, const float (&v)[8]) { *(uint4*)p = make_uint4(pack2(v[0], v[1]), pack2(v[2], v[3]), pack2(v[4], v[5]), pack2(v[6], v[7])); }
DI void st8f(float* p, const float (&v)[8]) { *(float4*)p = make_float4(v[0], v[1], v[2], v[3]); *(float4*)(p + 4) = make_float4(v[4], v[5], v[6], v[7]); }
#define EPI_BEGIN(NT_, acc_, m0_, n0_, mvalid_) { const int _l = tid_() & 63, _w = tid_() >> 6, _wr = _w >> 1, _wc = _w & 1, _fr = _l & 15, _fq = _l >> 4; \
  _Pragma("unroll") for (int _m = 0; _m < 4; ++_m) { const int row = (m0_) + _wr * 64 + _m * 16 + _fr; \
  _Pragma("unroll") for (int _q = 0; _q < (NT_) / 2; ++_q) { const int col = (n0_) + _wc * (16 * (NT_)) + _q * 32 + 8 * _fq; (void)col; \
    float v[8] = {acc_[_m][2 * _q][0], acc_[_m][2 * _q][1], acc_[_m][2 * _q][2], acc_[_m][2 * _q][3], \
                  acc_[_m][2 * _q + 1][0], acc_[_m][2 * _q + 1][1], acc_[_m][2 * _q + 1][2], acc_[_m][2 * _q + 1][3]}; \
    if (row < (mvalid_)) {
#define EPI_END }}}}

DI int mtile_row0(int mt, bool latonly, int TH) {
  if (!latonly) return mt * TH;
  const int per = SEQ / TH, b = mt / per, r = mt % per;
  return b * TOK + CTXL + r * TH;
}
DI int mtiles(bool latonly, int TH) { return latonly ? BATCH * (SEQ / TH) : (NTOK + TH - 1) / TH; }

struct LP {
  int l; bool last;
  const float* mod;
  char* we;
  char* s5;
};
DI LP make_lp(const Params& p, int l) {
  LP q; q.l = l; q.last = (l == DEPTH - 1);
  q.mod = (const float*)(p.ws + OFF_MOD) + (size_t)l * NB1 * 6144;
  q.we = p.ws + OFF_WEARLY + (size_t)l * WE_SIZE;
  q.s5 = p.ws + OFF_S5TAB + (size_t)l * S5_SIZE;
  return q;
}

template <class RowMap>
DI void conv_tile(const float* src, int lds, int nsrc, const float* kscale, bf16* dst, int K, int k0, int n0, char* smem, RowMap rowmap, int ndst = 1 << 30) {
  (void)smem;
  const int tid = tid_(), n4 = (tid & 63) * 4, k8 = (tid >> 6) * 8;
  float4 v[8];
  const bool ok = (n0 + n4 < nsrc);
  const float* sp = src + (size_t)(k0 + k8) * lds + n0 + n4;
#pragma unroll
  for (int k = 0; k < 8; ++k) v[k] = ok ? *(const float4*)(sp + (size_t)k * lds) : make_float4(0.f, 0.f, 0.f, 0.f);
  if (kscale) {
#pragma unroll
    for (int k = 0; k < 8; ++k) { const float sc = kscale[k0 + k8 + k]; v[k].x *= sc; v[k].y *= sc; v[k].z *= sc; v[k].w *= sc; }
  }
  float o[8];
#pragma unroll
  for (int k = 0; k < 8; ++k) o[k] = v[k].x;
  if (n0 + n4 + 0 < ndst) st8bf(dst + (size_t)rowmap(n0 + n4 + 0) * K + k0 + k8, o);
#pragma unroll
  for (int k = 0; k < 8; ++k) o[k] = v[k].y;
  if (n0 + n4 + 1 < ndst) st8bf(dst + (size_t)rowmap(n0 + n4 + 1) * K + k0 + k8, o);
#pragma unroll
  for (int k = 0; k < 8; ++k) o[k] = v[k].z;
  if (n0 + n4 + 2 < ndst) st8bf(dst + (size_t)rowmap(n0 + n4 + 2) * K + k0 + k8, o);
#pragma unroll
  for (int k = 0; k < 8; ++k) o[k] = v[k].w;
  if (n0 + n4 + 3 < ndst) st8bf(dst + (size_t)rowmap(n0 + n4 + 3) * K + k0 + k8, o);
}
struct RowId { DI int operator()(int n) const { return n; } };
struct RowGU { int half; DI int operator()(int f) const { return (f >> 7) * 256 + half * 128 + (f & 127); } };

constexpr int CT_WIN = 16 * (N_INP / 256), CT_UQ = 4 * 2, CT_UKV = 2 * 2, CT_GLU = 4, CT_WB = 4 * 16, CT_WOUT = 64;
constexpr int CT_EARLY = CT_WIN + CT_UQ + CT_UKV + CT_GLU + CT_WB + CT_WOUT;
constexpr int CT_EXP = NE * 3 * 64;

DI void conv_early_item(const Params& p, int l, int it, char* smem) {
  char* we = p.ws + OFF_WEARLY + (size_t)l * WE_SIZE;
  if (it < CT_WIN) {
    int kt = it % 16, nt = it / 16;
    conv_tile(p.in[I_WIN] + (size_t)l * 1024 * N_IN, N_IN, N_IN, nullptr, (bf16*)(we + WE_WIN), 1024, kt * 64, nt * 256, smem, RowId());
    return;
  }
  it -= CT_WIN;
  if (it < CT_UQ) {
    int kt = it % 4, nt = it / 4;
    conv_tile(p.in[I_WUQ] + (size_t)l * 256 * 384, 384, 384, p.in[I_GCQ] + l * 256, (bf16*)(we + WE_UQ), 256, kt * 64, nt * 256, smem, RowId(), 384);
    return;
  }
  it -= CT_UQ;
  if (it < CT_UKV) {
    int kt = it % 2, nt = it / 2;
    conv_tile(p.in[I_WUKV] + (size_t)l * 128 * 512, 512, 512, p.in[I_GCKV] + l * 128, (bf16*)(we + WE_UKV), 128, kt * 64, nt * 256, smem, RowId());
    return;
  }
  it -= CT_UKV;
  if (it < CT_GLU) {
    int kt = it;
    conv_tile(p.in[I_S5WGLU] + (size_t)l * 256 * 256, 256, 256, nullptr, (bf16*)(we + WE_GLU), 256, kt * 64, 0, smem, RowId());
    return;
  }
  it -= CT_GLU;
  if (it < CT_WB) {
    int j = it / 16, r = it % 16, kt = r % 4, nt = r / 4;
    conv_tile(p.in[I_WBRANCH] + ((size_t)l * 4 + j) * 256 * 1024, 1024, 1024, nullptr, (bf16*)(we + WE_WB) + (size_t)j * 1024 * 256, 256, kt * 64, nt * 256, smem, RowId());
    return;
  }
  it -= CT_WB;
  {
    int kt = it % 16, nt = it / 16;
    conv_tile(p.in[I_WOUT] + (size_t)l * 1024 * 1024, 1024, 1024, nullptr, (bf16*)(we + WE_WOUT), 1024, kt * 64, nt * 256, smem, RowId());
  }
}
DI void conv_expert_item(const Params& p, int l, int it, char* smem) {
  char* wx = p.ws + OFF_MIX;
  int e = it / 192, r = it % 192, which = r / 64, t = r % 64, kt = t % 16, nt = t / 16;
  size_t eoff = ((size_t)l * NE + e) * 1024 * 1024;
  if (which == 0) { RowGU rm; rm.half = 0; conv_tile(p.in[I_WGATE] + eoff, 1024, 1024, nullptr, (bf16*)(wx + WX_GU) + (size_t)e * 2048 * 1024, 1024, kt * 64, nt * 256, smem, rm); }
  else if (which == 1) { RowGU rm; rm.half = 1; conv_tile(p.in[I_WUP] + eoff, 1024, 1024, nullptr, (bf16*)(wx + WX_GU) + (size_t)e * 2048 * 1024, 1024, kt * 64, nt * 256, smem, rm); }
  else conv_tile(p.in[I_WDOWN] + eoff, 1024, 1024, nullptr, (bf16*)(wx + WX_DN) + (size_t)e * 1024 * 1024, 1024, kt * 64, nt * 256, smem, RowId());
}

DI void mod_item(const Params& p, int it, char* smem) {
  const int l = it / 96, cg0 = (it % 96) * 64;
  float* sc = (float*)smem;
  float* red = sc + NB1 * 1024;
  const int tid = tid_();
  __syncthreads();
  for (int i = tid; i < NB1 * 1024; i += NTHREADS) {
    int r = i >> 10, k = i & 1023;
    float c = (r < BATCH) ? p.in[I_C][r * 1024 + k] : p.in[I_CCTX][k];
    sc[i] = siluf_(c);
  }
  __syncthreads();
  const int cl = tid & 63, kg = tid >> 6;
  float acc[NB1];
#pragma unroll
  for (int r = 0; r < NB1; ++r) acc[r] = 0.f;
  const float* w = p.in[I_WADA] + (size_t)l * 1024 * 6144 + cg0 + cl;
  for (int k = kg * (1024 / NWAVES); k < (kg + 1) * (1024 / NWAVES); ++k) {
    float wv = w[(size_t)k * 6144];
#pragma unroll
    for (int r = 0; r < NB1; ++r) acc[r] += sc[r * 1024 + k] * wv;
  }
#pragma unroll
  for (int r = 0; r < NB1; ++r) red[(kg * NB1 + r) * 64 + cl] = acc[r];
  __syncthreads();
  for (int i = tid; i < NB1 * 64; i += NTHREADS) {
    int r = i >> 6, c = i & 63;
    float s = 0.f;
#pragma unroll
    for (int q = 0; q < NWAVES; ++q) s += red[(q * NB1 + r) * 64 + c];
    s += p.in[I_BADA][l * 6144 + cg0 + c];
    ((float*)(p.ws + OFF_MOD))[((size_t)l * NB1 + r) * 6144 + cg0 + c] = s;
  }
}

DI void s5_tab_item(const Params& p, int it, char* smem) {
  const int l = it / 32, d = (it / 16) & 1, g = it & 15;
  char* s5 = p.ws + OFF_S5TAB + (size_t)l * S5_SIZE;
  float* lampow = (float*)(s5 + S5_LAMPOW) + (size_t)(d * 16 + g) * 17 * 64 * 2;
  float* bbar = (float*)(s5 + S5_BBAR) + (size_t)(d * 16 + g) * 64 * 16 * 2;
  float* kt = (float*)(s5 + S5_KT) + (size_t)(d * 16 + g) * 16 * 256;
  float* slam = (float*)smem;
  float* sbb = slam + 17 * 64 * 2;
  const int tid = tid_();
  const size_t pg = ((size_t)(l * 2 + d) * 16 + g);
  const float step = expf(p.in[I_S5LOGSTEP][pg]);
  __syncthreads();
  for (int i = tid; i < 17 * 64; i += NTHREADS) {
    int j = i >> 6, pp = i & 63;
    float are = p.in[I_S5ARE][pg * 64 + pp], aim = p.in[I_S5AIM][pg * 64 + pp];
    float mag = expf((float)j * step * are), ang = (float)j * step * aim;
    float re = mag * cosf(ang), im = mag * sinf(ang);
    slam[i * 2] = re; slam[i * 2 + 1] = im; lampow[i * 2] = re; lampow[i * 2 + 1] = im;
  }
  __syncthreads();
  for (int i = tid; i < 64 * 16; i += NTHREADS) {
    int pp = i >> 4;
    float are = p.in[I_S5ARE][pg * 64 + pp], aim = p.in[I_S5AIM][pg * 64 + pp];
    float x = slam[(64 + pp) * 2] - 1.0f, y = slam[(64 + pp) * 2 + 1];
    float den = are * are + aim * aim;
    float qre = (x * are + y * aim) / den, qim = (y * are - x * aim) / den;
    float bre = p.in[I_S5BRE][pg * 1024 + i], bim = p.in[I_S5BIM][pg * 1024 + i];
    float re = qre * bre - qim * bim, im = qre * bim + qim * bre;
    sbb[i * 2] = re; sbb[i * 2 + 1] = im; bbar[i * 2] = re; bbar[i * 2 + 1] = im;
  }
  __syncthreads();
  for (int i = tid; i < 16 * 256; i += NTHREADS) {
    int j = i >> 8, c = (i >> 4) & 15, c2 = i & 15;
    float s = 0.f;
    for (int pp = 0; pp < 64; ++pp) {
      float cre = p.in[I_S5CRE][pg * 1024 + c * 64 + pp], cim = p.in[I_S5CIM][pg * 1024 + c * 64 + pp];
      float lre = slam[(j * 64 + pp) * 2], lim = slam[(j * 64 + pp) * 2 + 1];
      float tre = cre * lre - cim * lim, tim = cre * lim + cim * lre;
      float bre = sbb[(pp * 16 + c2) * 2], bim = sbb[(pp * 16 + c2) * 2 + 1];
      s += tre * bre - tim * bim;
    }
    kt[i] = s;
  }
}
DI void s5_mat_item(const Params& p, int it) {
  const int l = it / 256, g = (it / 16) & 15, q = it & 15;
  char* s5 = p.ws + OFF_S5TAB + (size_t)l * S5_SIZE;
  const float* lampow = (const float*)(s5 + S5_LAMPOW);
  const float* bbar = (const float*)(s5 + S5_BBAR);
  const float* ktab = (const float*)(s5 + S5_KT);
  bf16* WA = (bf16*)(s5 + S5_WA) + (size_t)g * 256 * 256;
  bf16* W2 = (bf16*)(s5 + S5_W2) + (size_t)g * 256 * 512;
  const int tid = tid_();
  for (int i = tid; i < 16 * 256; i += NTHREADS) {
    int n = q * 16 + (i >> 8), k = i & 255;
    int d = n >> 7, ri = (n >> 6) & 1, pp = n & 63, s = k >> 4, c2 = k & 15;
    int e = (d == 0) ? (15 - s) : s;
    const float* lp = lampow + ((size_t)((d * 16 + g) * 17 + e) * 64 + pp) * 2;
    const float* bp = bbar + ((size_t)((d * 16 + g) * 64 + pp) * 16 + c2) * 2;
    float re = lp[0] * bp[0] - lp[1] * bp[1], im = lp[0] * bp[1] + lp[1] * bp[0];
    WA[(size_t)n * 256 + k] = f2bf(ri == 0 ? re : im);
  }
  for (int i = tid; i < 16 * 512; i += NTHREADS) {
    int n = q * 16 + (i >> 9), k = i & 511;
    int lq = n >> 4, c = n & 15;
    float v;
    if (k < 256) {
      int s = k >> 4, c2 = k & 15;
      v = 0.f;
      if (s <= lq) v += ktab[((size_t)(0 * 16 + g) * 16 + (lq - s)) * 256 + c * 16 + c2];
      if (s >= lq) v += ktab[((size_t)(1 * 16 + g) * 16 + (s - lq)) * 256 + c * 16 + c2];
      if (s == lq && c == c2) v += p.in[I_S5D][l * 256 + g * 16 + c];
    } else {
      int kk = k - 256, d = kk >> 7, ri = (kk >> 6) & 1, pp = kk & 63;
      int e = (d == 0) ? (lq + 1) : (16 - lq);
      size_t pg = ((size_t)(l * 2 + d) * 16 + g);
      float cre = p.in[I_S5CRE][pg * 1024 + c * 64 + pp], cim = p.in[I_S5CIM][pg * 1024 + c * 64 + pp];
      const float* lp = lampow + ((size_t)((d * 16 + g) * 17 + e) * 64 + pp) * 2;
      float re = cre * lp[0] - cim * lp[1], im = cre * lp[1] + cim * lp[0];
      v = (ri == 0) ? re : -im;
    }
    W2[(size_t)n * 512 + k] = f2bf(v);
  }
}

DI int tok_b(int tok) { return tok / TOK; }
DI int tok_j(int tok) { return tok % TOK; }
DI int tok_modrow(int tok) { return (tok_j(tok) < CTXL) ? BATCH : tok_b(tok); }

DI void normmod_row(const float (&xv)[16], const float* g, const float* shift, const float* scale, bf16* dst, float (&hout)[16]) {
  const int lane = tid_() & 63;
  float ss = 0.f;
#pragma unroll
  for (int i = 0; i < 16; ++i) ss += xv[i] * xv[i];
  ss = wave_sum(ss);
  const float rs = rsqrtf(ss * (1.0f / 1024.f) + EPS);
#pragma unroll
  for (int i = 0; i < 4; ++i) {
    int c = lane * 4 + i * 256;
    float4 gv = *(const float4*)(g + c), sh = *(const float4*)(shift + c), sc = *(const float4*)(scale + c);
    float h0 = xv[i * 4 + 0] * rs * gv.x * (1.f + sc.x) + sh.x;
    float h1 = xv[i * 4 + 1] * rs * gv.y * (1.f + sc.y) + sh.y;
    float h2 = xv[i * 4 + 2] * rs * gv.z * (1.f + sc.z) + sh.z;
    float h3 = xv[i * 4 + 3] * rs * gv.w * (1.f + sc.w) + sh.w;
    hout[i * 4 + 0] = h0; hout[i * 4 + 1] = h1; hout[i * 4 + 2] = h2; hout[i * 4 + 3] = h3;
    *(uint2*)(dst + c) = make_uint2(pack2(h0, h1), pack2(h2, h3));
  }
}

DI void prep_row_item(const Params& p, int it) {
  const int tok = it * NWAVES + (tid_() >> 6), lane = tid_() & 63;
  const int b = tok_b(tok), j = tok_j(tok);
  const float* src = (j < CTXL) ? p.in[I_CTX] + ((size_t)b * CTXL + j) * 1024 : p.in[I_X] + ((size_t)b * SEQ + (j - CTXL)) * 1024;
  float xv[16], h[16];
#pragma unroll
  for (int i = 0; i < 4; ++i) {
    float4 v = *(const float4*)(src + lane * 4 + i * 256);
    xv[i * 4] = v.x; xv[i * 4 + 1] = v.y; xv[i * 4 + 2] = v.z; xv[i * 4 + 3] = v.w;
  }
  const float* mod = (const float*)(p.ws + OFF_MOD) + (size_t)tok_modrow(tok) * 6144;
  normmod_row(xv, p.in[I_GPREMIX], mod + 0, mod + 1024, (bf16*)(p.ws + OFF_HA) + (size_t)tok * 1024, h);
}

constexpr int IP_LT = BATCH * (SEQ / 256), IP_CT = BATCH * ((CTXL + 255) / 256), IP_MT = IP_LT + IP_CT, IP_NT = N_INP / 256;
constexpr int IP_RR = (IP_MT + 7) / 8, IP_RC = (IP_NT + 1) / 2;
constexpr int IP_RC_NOGATE = (((C_GATE + 255) / 256) + 1) / 2;
constexpr int IP_RR_LAT = IP_LT / 8;
constexpr bool IP_COMPACT = (IP_LT % 8 == 0);
constexpr int IP_RECTS_ALL = IP_RR * IP_RC, IP_RECTS_LAST = IP_COMPACT ? (IP_RR * IP_RC_NOGATE + IP_RR_LAT * (IP_RC - IP_RC_NOGATE)) : IP_RECTS_ALL;
constexpr int IP_SLOTS_ALL = ((IP_RECTS_ALL + 15) / 16) * 256, IP_SLOTS_LAST = ((IP_RECTS_LAST + 15) / 16) * 256;
DI void inproj_tile(const Params& p, const LP& L, int t, char* smem) {
  const int vb = t % 256, vround = t / 256, x = vb % 8, j = vb / 8;
  const int Rc = vround * 16 + x * 2 + (j >> 4), jj = j & 15;
  int rm, rn;
  if (!L.last || !IP_COMPACT || Rc < IP_RR * IP_RC_NOGATE) { rm = Rc % IP_RR; rn = Rc / IP_RR; }
  else { const int q = Rc - IP_RR * IP_RC_NOGATE; rm = q % IP_RR_LAT; rn = IP_RC_NOGATE + q / IP_RR_LAT; }
  const int mt = rm * 8 + (jj & 7), nt = rn * 2 + (jj >> 3);
  if (mt >= IP_MT || nt >= IP_NT || rn >= IP_RC) return;
  int m0;
  if (mt < IP_LT) m0 = (mt / (SEQ / 256)) * TOK + CTXL + (mt % (SEQ / 256)) * 256;
  else { const int c = mt - IP_LT; m0 = (c / ((CTXL + 255) / 256)) * TOK + (c % ((CTXL + 255) / 256)) * 256; }
  const int n0 = nt * 256;
  const int mv = (mt < IP_LT) ? NTOK : (m0 - (m0 % TOK) + CTXL);
  if (L.last && mt >= IP_LT && n0 >= ((C_GATE + 255) / 256) * 256) return;
  GA g = make_ga((const bf16*)(p.ws + OFF_HA), 1024, (const bf16*)(L.we + WE_WIN), 1024, 1024, mv);
  f32x4 acc[2][2][4][2];
  gemm_big(g, m0, n0, smem, acc);
  bf16* P1 = (bf16*)(p.ws + OFF_P1);
  bf16* PG = (bf16*)(p.ws + OFF_PG);
  bf16* US5 = (bf16*)(p.ws + OFF_MIX + MX_US5);
  float* DT = (float*)(p.ws + OFF_DT);
  const float* dtb = p.in[I_M2DTBIAS] + L.l * 8;
  EPIB_BEGIN(acc, m0, n0, mv)
    if (col < C_S5 || (col >= C_Z && col < C_DT)) st8bf(P1 + (size_t)row * P1W + col, v);
    else if (col < C_Z) st8bf(US5 + ((size_t)((col - C_S5) >> 4) * NTOK + row) * 16 + (col & 15), v);
    else if (col < C_GATE) {
#pragma unroll
      for (int k = 0; k < 8; ++k) v[k] = softplusf_(v[k] + dtb[k]);
      st8f(DT + (size_t)row * 8, v);
    } else if (col < N_IN) {
#pragma unroll
      for (int k = 0; k < 8; ++k) v[k] = sigmoidf_(v[k]);
      st8bf(PG + (size_t)row * 4096 + (col - C_GATE), v);
    }
  EPIB_END
}

DI void rowscale_256(const bf16* P1, int m0, int c0, int width, float* srs) {
  const int r = tid_() >> 1, hf = tid_() & 1;
  int gr = m0 + r; if (gr > NTOK - 1) gr = NTOK - 1;
  const bf16* src = P1 + (size_t)gr * P1W + c0 + hf * (width / 2);
  float ss = 0.f;
  for (int i = 0; i < width / 2; i += 8) {
    float v[8]; ld8bf(src + i, v);
#pragma unroll
    for (int k = 0; k < 8; ++k) ss += v[k] * v[k];
  }
  ss += shfl_xor_(ss, 1);
  if (hf == 0) srs[r] = rsqrtf(ss / (float)width + EPS);
}
DI void rope_tab_item(const Params& p) {
  float* tab = (float*)(p.ws + OFF_ROPE);
  for (int i = tid_(); i < 64 * 8; i += NTHREADS) {
    int pos = i >> 3, k = i & 7;
    float f = expf(-(float)k * (9.210340371976184f / 8.0f));
    float a = (float)pos * f;
    tab[i * 2] = cosf(a); tab[i * 2 + 1] = sinf(a);
  }
}
DI void rope_cs(const float* tab, int pos, int i, float& c, float& s) { c = tab[(pos * 8 + i) * 2]; s = tab[(pos * 8 + i) * 2 + 1]; }

constexpr int TP_MT = (NTOK + 255) / 256;
DI void mlaq_tile(const Params& p, const LP& L, int t, char* smem) {
  const int mt = t % TP_MT, nt = t / TP_MT, m0 = mt * 256, n0 = nt * 128;
  const bf16* P1 = (const bf16*)(p.ws + OFF_P1);
  float* srs = (float*)(smem + SRS_OFF);
  GA g = make_ga(P1 + C_CQ, P1W, (const bf16*)(L.we + WE_UQ), 256, 256, NTOK);
  f32x4 acc[4][4];
  gemm_s<4>(g, m0, n0, smem, acc);
  rowscale_256(P1, m0, C_CQ, 256, srs);
  __syncthreads();
  bf16* Q = (bf16*)(p.ws + OFF_MIX + MX_Q);
  const float* ropetab = (const float*)(p.ws + OFF_ROPE);
  {
    const int l = tid_() & 63, w = tid_() >> 6, wr = w >> 1, wc = w & 1, fr = l & 15, fq = l >> 4;
#pragma unroll
    for (int m = 0; m < 4; ++m) {
      const int row = m0 + wr * 64 + m * 16 + fr;
      const int rowc = row < NTOK ? row : NTOK - 1;
      const float rsc = srs[rowc - m0];
      const int b = tok_b(rowc), j = tok_j(rowc);
#pragma unroll
      for (int q = 0; q < 2; ++q) {
        const int col = n0 + wc * 64 + q * 32 + 8 * fq;
        const int h = col / 96, dd = col % 96;
        float v[8] = {acc[m][2 * q][0], acc[m][2 * q][1], acc[m][2 * q][2], acc[m][2 * q][3], acc[m][2 * q + 1][0], acc[m][2 * q + 1][1], acc[m][2 * q + 1][2], acc[m][2 * q + 1][3]};
        float vp[8];
#pragma unroll
        for (int k = 0; k < 8; ++k) vp[k] = shfl_xor_(v[k], 16);
        if (dd >= 64 && j >= CTXL) {
          const int tl = j - CTXL, pos = ((dd - 64) < 16) ? (tl / GRID_W) : (tl % GRID_W);
          const bool lo = ((dd & 8) == 0);
#pragma unroll
          for (int k = 0; k < 8; ++k) {
            float c, sn; rope_cs(ropetab, pos, k, c, sn);
            v[k] = lo ? (v[k] * c - vp[k] * sn) : (v[k] * c + vp[k] * sn);
          }
        }
#pragma unroll
        for (int k = 0; k < 8; ++k) v[k] *= rsc;
        if (row < NTOK) st8bf(Q + (((size_t)b * 4 + h) * TOK + j) * 96 + dd, v);
      }
    }
  }
}
DI void mlakv_tile(const Params& p, const LP& L, int t, char* smem) {
  const int mt = t % TP_MT, h = t / TP_MT, m0 = mt * 256, n0 = h * 128;
  const bf16* P1 = (const bf16*)(p.ws + OFF_P1);
  float* srs = (float*)(smem + SRS_OFF);
  GA g = make_ga(P1 + C_CKV, P1W, (const bf16*)(L.we + WE_UKV), 128, 128, NTOK);
  f32x4 acc[4][4];
  gemm_s<4>(g, m0, n0, smem, acc);
  rowscale_256(P1, m0, C_CKV, 128, srs);
  __syncthreads();
  bf16* K = (bf16*)(p.ws + OFF_MIX + MX_K);
  bf16* VT = (bf16*)(p.ws + OFF_MIX + MX_VTM);
  const float* ropetab = (const float*)(p.ws + OFF_ROPE);
  EPI_BEGIN(4, acc, m0, n0, NTOK)
    const float rsc = srs[row - m0];
    const int b = tok_b(row), j = tok_j(row), dd = col - n0;
#pragma unroll
    for (int k = 0; k < 8; ++k) v[k] *= rsc;
    if (dd < 64) st8bf(K + (((size_t)b * 4 + h) * TOK + j) * 96 + dd, v);
    else {
#pragma unroll
      for (int k = 0; k < 8; ++k) VT[(((size_t)b * 4 + h) * 64 + (dd - 64 + k)) * TOK + j] = f2bf(v[k]);
    }
  EPI_END
  for (int i = tid_(); i < 256 * 16; i += NTHREADS) {
    int r = i >> 4, q = i & 15;
    int row = m0 + r;
    if (row < NTOK) {
      int b = tok_b(row), j = tok_j(row);
      int blk = q >> 3, i8 = q & 7;
      float x1 = bf2f(P1[(size_t)row * P1W + C_KR + blk * 16 + i8]), x2 = bf2f(P1[(size_t)row * P1W + C_KR + blk * 16 + i8 + 8]);
      float o1 = x1, o2 = x2;
      if (j >= CTXL) {
        int tl = j - CTXL, pos = blk == 0 ? (tl / GRID_W) : (tl % GRID_W);
        float c, sn; rope_cs(ropetab, pos, i8, c, sn);
        o1 = x1 * c - x2 * sn; o2 = x2 * c + x1 * sn;
      }
      bf16* kd = K + (((size_t)b * 4 + h) * TOK + j) * 96 + 64 + blk * 16 + i8;
      kd[0] = f2bf(o1); kd[8] = f2bf(o2);
    }
  }
}
DI void navt_item(const Params& p, int it, char* smem) {
  bf16* s = (bf16*)smem;
  const bf16* P1 = (const bf16*)(p.ws + OFF_P1);
  bf16* VT = (bf16*)(p.ws + OFF_MIX + MX_VTN);
  const int tok0 = it * 64, tid = tid_();
  const int b = tok_b(tok0), j0 = tok_j(tok0);
  __syncthreads();
  for (int i = tid; i < 64 * 32; i += NTHREADS) {
    int r = i >> 5, c8 = i & 31;
    *(uint4*)(s + r * 264 + c8 * 8) = *(const uint4*)(P1 + (size_t)(tok0 + r) * P1W + C_NA + 512 + c8 * 8);
  }
  __syncthreads();
  for (int i = tid; i < 256 * 8; i += NTHREADS) {
    int ch = i >> 3, t8 = i & 7;
    unsigned w[4];
#pragma unroll
    for (int q = 0; q < 4; ++q) w[q] = (unsigned)s[(t8 * 8 + 2 * q) * 264 + ch] | ((unsigned)s[(t8 * 8 + 2 * q + 1) * 264 + ch] << 16);
    *(uint4*)(VT + ((size_t)b * 256 + ch) * TOK + j0 + t8 * 8) = make_uint4(w[0], w[1], w[2], w[3]);
  }
}
constexpr int M2C_TOK = 128, M2C_ITEMS = NTOK / M2C_TOK;
DI void m2conv_item(const Params& p, const LP& L, int it) {
  const bf16* P1 = (const bf16*)(p.ws + OFF_P1);
  bf16* XB = (bf16*)(p.ws + OFF_MIX + MX_XBC);
  const int tok0 = it * M2C_TOK;
  const float* cw = p.in[I_M2CONVW] + (size_t)L.l * 4 * 768;
  const float* cb = p.in[I_M2CONVB] + (size_t)L.l * 768;
  for (int task = tid_(); task < 96 * (M2C_TOK / 8); task += NTHREADS) {
    const int cg = task % 96, tb = task / 96, c0 = cg * 8;
    const int tokb = tok0 + tb * 8, jt = tok_j(tokb), base = tokb - jt;
    const int slo = (jt < CTXL) ? 0 : CTXL, shi = (jt < CTXL) ? CTXL : TOK;
    float w[4][8], bias[8];
#pragma unroll
    for (int k = 0; k < 4; ++k) { float4 a = *(const float4*)(cw + k * 768 + c0), b4 = *(const float4*)(cw + k * 768 + c0 + 4);
      w[k][0] = a.x; w[k][1] = a.y; w[k][2] = a.z; w[k][3] = a.w; w[k][4] = b4.x; w[k][5] = b4.y; w[k][6] = b4.z; w[k][7] = b4.w; }
    { float4 a = *(const float4*)(cb + c0), b4 = *(const float4*)(cb + c0 + 4);
      bias[0] = a.x; bias[1] = a.y; bias[2] = a.z; bias[3] = a.w; bias[4] = b4.x; bias[5] = b4.y; bias[6] = b4.z; bias[7] = b4.w; }
    float xin[11][8];
#pragma unroll
    for (int r = 0; r < 11; ++r) {
      const int j = jt - 2 + r;
      if (j >= slo && j < shi) ld8bf(P1 + (size_t)(base + j) * P1W + C_XBC + c0, xin[r]);
      else {
#pragma unroll
        for (int c = 0; c < 8; ++c) xin[r][c] = 0.f;
      }
    }
    float y[8][8];
#pragma unroll
    for (int t = 0; t < 8; ++t) {
#pragma unroll
      for (int c = 0; c < 8; ++c) y[t][c] = siluf_(bias[c] + w[0][c] * xin[t][c] + w[1][c] * xin[t + 1][c] + w[2][c] * xin[t + 2][c] + w[3][c] * xin[t + 3][c]);
      st8bf(XB + (size_t)(base + jt + t) * 768 + c0, y[t]);
    }
    if (c0 < 512) {
      bf16* XT = (bf16*)(p.ws + OFF_MIX + MX_XBT) + ((size_t)(base / TOK) * 512 + c0) * TOK + jt;
#pragma unroll
      for (int c = 0; c < 8; ++c) {
        float col[8];
#pragma unroll
        for (int t = 0; t < 8; ++t) col[t] = y[t][c];
        st8bf(XT + (size_t)c * TOK, col);
      }
    }
  }
}
DI int m2_seq2tok(int sq, int dir) { return (dir == 0) ? sq : (sq < CTXL ? (CTXL - 1 - sq) : (TOK - 1 - (sq - CTXL))); }
constexpr int M2S_ITEMS = BATCH * 8 * (TOK / 64) / NWAVES;
DI void m2scal_item(const Params& p, const LP& L, int it) {
  const int w = it * NWAVES + (tid_() >> 6), lane = tid_() & 63;
  const int ch = w % (TOK / 64), r = w / (TOK / 64), hd = r & 3, dir = (r >> 2) & 1, b = r >> 3;
  const float a = -expf(p.in[I_M2ALOG][(L.l * 2 + dir) * 4 + hd]);
  const int sq = ch * 64 + lane, j = m2_seq2tok(sq, dir);
  const float dt = ((const float*)(p.ws + OFF_DT))[((size_t)b * TOK + j) * 8 + dir * 4 + hd];
  float cs = dt * a;
#pragma unroll
  for (int d = 1; d < 64; d <<= 1) { float o = shfl_up_(cs, d); if (lane >= d) cs += o; }
  const float sl = shfl_(cs, 63);
  float* o = (float*)(p.ws + OFF_MIX + MX_M2S) + ((size_t)((b * 2 + dir) * 4 + hd) * TOK + sq) * 4;
  *(float4*)o = make_float4(cs, dt, dt * __expf(sl - cs), cs * 1.4426950408889634f - log2f(dt));
}
constexpr int S5_MT = (MCH + 255) / 256;
DI void s5a_tile(const Params& p, const LP& L, int t, char* smem) {
  const int g = t / (S5_MT * 2), r = t % (S5_MT * 2), mt = r / 2, nt = r % 2;
  const int m0 = mt * 256, n0 = nt * 128;
  GA ga = make_ga((const bf16*)(p.ws + OFF_MIX + MX_US5) + (size_t)g * NTOK * 16, 256, (const bf16*)(L.s5 + S5_WA) + (size_t)g * 65536, 256, 256, MCH);
  f32x4 acc[4][4];
  gemm_s<4>(ga, m0, n0, smem, acc);
  float* HE = (float*)(p.ws + OFF_MIX + MX_HEND) + (size_t)g * MCH * 256;
  EPI_BEGIN(4, acc, m0, n0, MCH)
    st8f(HE + (size_t)row * 256 + col, v);
  EPI_END
}
DI int s5_chunk_of(int i, int d) { return (d == 0) ? i : (i < NCC ? (NCC - 1 - i) : (NCH - 1 - (i - NCC))); }
DI void s5carry_item(const Params& p, const LP& L, int it) {
  const int w = it * NWAVES + (tid_() >> 6), lane = tid_() & 63;
  const int d = w / (16 * BATCH), g = (w / BATCH) & 15, b = w % BATCH;
  const float* lp = (const float*)(L.s5 + S5_LAMPOW) + ((size_t)((d * 16 + g) * 17 + 16) * 64 + lane) * 2;
  const float lre = lp[0], lim = lp[1];
  const float* HE = (const float*)(p.ws + OFF_MIX + MX_HEND) + ((size_t)g * MCH + (size_t)b * NCH) * 256 + d * 128;
  bf16* HI = (bf16*)(p.ws + OFF_MIX + MX_HIN) + ((size_t)g * MCH + (size_t)b * NCH) * 256 + d * 128;
  float cre = 0.f, cim = 0.f;
  static_assert(NCH % 4 == 0, "chunk count");
  for (int i0 = 0; i0 < NCH; i0 += 4) {
    float hre[4], him[4];
#pragma unroll
    for (int k = 0; k < 4; ++k) { const int ch = s5_chunk_of(i0 + k, d); hre[k] = HE[(size_t)ch * 256 + lane]; him[k] = HE[(size_t)ch * 256 + 64 + lane]; }
#pragma unroll
    for (int k = 0; k < 4; ++k) {
      const int ch = s5_chunk_of(i0 + k, d);
      HI[(size_t)ch * 256 + lane] = f2bf(cre); HI[(size_t)ch * 256 + 64 + lane] = f2bf(cim);
      const float nre = lre * cre - lim * cim + hre[k], nim = lre * cim + lim * cre + him[k];
      cre = nre; cim = nim;
    }
  }
}
DI void s5c_tile(const Params& p, const LP& L, int t, char* smem) {
  const int g = t / (S5_MT * 2), r = t % (S5_MT * 2), mt = r / 2, nt = r % 2;
  const int m0 = mt * 256, n0 = nt * 128;
  GA ga = make_ga((const bf16*)(p.ws + OFF_MIX + MX_US5) + (size_t)g * NTOK * 16, 256, (const bf16*)(L.s5 + S5_W2) + (size_t)g * 256 * 512, 512, 512, MCH);
  ga.A2 = (const bf16*)(p.ws + OFF_MIX + MX_HIN) + (size_t)g * MCH * 256; ga.lda2 = 256; ga.ksplit = 256;
  f32x4 acc[4][4];
  gemm_s<4>(ga, m0, n0, smem, acc);
  bf16* Z = (bf16*)(p.ws + OFF_MIX + MX_Z);
  EPI_BEGIN(4, acc, m0, n0, MCH)
#pragma unroll
    for (int k = 0; k < 8; ++k) v[k] = geluf_(v[k]);
    st8bf(Z + ((size_t)row * 16 + (col >> 4)) * 256 + g * 16 + (col & 15), v);
  EPI_END
}

DI float fmax_(float a, float b) { return a > b ? a : b; }
constexpr int AT_LDV = 76;
struct NaInfo { int r, qc, rs, cs; };
template <int DK, bool NA>
DI void attn_block(const bf16* qrow, bool active, const bf16* Kp, int kstride, const bf16* Vt,
                   int ka0, int ntile_a, int arow0, int kb0, int ntile_b,
                   const float* srpb, NaInfo ni, float scale, bf16* orow, char* smem) {
  constexpr int LDK = DK + 8, KCH = DK / 8;
  constexpr int KT_BYTES = 64 * LDK * 2, VT_BYTES = 64 * AT_LDV * 2;
  constexpr int NKL = (64 * KCH + NTHREADS - 1) / NTHREADS;
  const int tid = tid_(), lane = tid & 63, half = lane >> 5, r = lane & 31;
  bf16* sK = (bf16*)smem;
  bf16* sV = (bf16*)(smem + 2 * KT_BYTES);
  bf16x8 qf[DK / 16];
  f32x16 o0, o1;
  float m = -1e30f, l = 0.f;
  const float scale2 = scale * 1.4426950408889634f;
#pragma unroll
  for (int ks = 0; ks < DK / 16; ++ks) qf[ks] = active ? *(const bf16x8*)(qrow + ks * 16 + 8 * half) : bf16x8{0, 0, 0, 0, 0, 0, 0, 0};
#pragma unroll
  for (int i = 0; i < 16; ++i) { o0[i] = 0.f; o1[i] = 0.f; }
  const int NTL = ntile_a + ntile_b;
  u32x4 rk[NKL], rv[1];
#pragma unroll
  for (int i = 0; i < NKL; ++i) rk[i] = u32x4{0u, 0u, 0u, 0u};
  auto key0_of = [&](int t) { return t < ntile_a ? ka0 + 64 * t : kb0 + 64 * (t - ntile_a); };
#define AT_GLOAD(t_) { const int k0_ = key0_of(t_); \
    _Pragma("unroll") for (int i_ = 0; i_ < NKL; ++i_) { const int c_ = tid + i_ * NTHREADS; const int key_ = c_ / KCH, ch_ = c_ % KCH; \
      if (c_ < 64 * KCH) rk[i_] = *(const u32x4*)(Kp + (size_t)(k0_ + key_) * kstride + ch_ * 8); } \
    { const int d_ = tid >> 3, ch_ = tid & 7; rv[0] = *(const u32x4*)(Vt + (size_t)d_ * TOK + k0_ + ch_ * 8); } }
#define AT_SSTORE(buf_) { \
    _Pragma("unroll") for (int i_ = 0; i_ < NKL; ++i_) { const int c_ = tid + i_ * NTHREADS; const int key_ = c_ / KCH, ch_ = c_ % KCH; \
      if (c_ < 64 * KCH) *(u32x4*)(sK + (buf_) * (64 * LDK) + key_ * LDK + ch_ * 8) = rk[i_]; } \
    { const int d_ = tid >> 3, ch_ = tid & 7; \
      bf16* dst_ = sV + (buf_) * (64 * AT_LDV) + d_ * AT_LDV + ch_ * 8; \
      *(uint2*)dst_ = make_uint2(rv[0][0], rv[0][1]); *(uint2*)(dst_ + 4) = make_uint2(rv[0][2], rv[0][3]); } }
  __syncthreads();
  AT_GLOAD(0) AT_SSTORE(0)
  __syncthreads();
#pragma unroll 1
  for (int t = 0; t < NTL; ++t) {
    const int buf = t & 1;
    if (t + 1 < NTL) AT_GLOAD(t + 1)
    bool doit = active;
    int trow0 = 0;
    if (NA && t < ntile_a) {
      trow0 = arow0 + t * (64 / GRID_W);
      doit = active && (trow0 + (64 / GRID_W) > ni.rs) && (trow0 < ni.rs + WIN_R);
    }
    if (doit) {
      const bf16* kb = sK + buf * (64 * LDK);
      const bf16* vb = sV + buf * (64 * AT_LDV);
      f32x16 s0, s1;
#pragma unroll
      for (int i = 0; i < 16; ++i) { s0[i] = 0.f; s1[i] = 0.f; }
#pragma unroll
      for (int ks = 0; ks < DK / 16; ++ks) {
        bf16x8 a0 = *(const bf16x8*)(kb + r * LDK + ks * 16 + 8 * half);
        bf16x8 a1 = *(const bf16x8*)(kb + (32 + r) * LDK + ks * 16 + 8 * half);
        s0 = __builtin_amdgcn_mfma_f32_32x32x16_bf16(a0, qf[ks], s0, 0, 0, 0);
        s1 = __builtin_amdgcn_mfma_f32_32x32x16_bf16(a1, qf[ks], s1, 0, 0, 0);
      }
      float mx = -INFINITY;
      if (NA && t < ntile_a) {
#pragma unroll
        for (int i = 0; i < 16; ++i) {
          const int kk = (i & 3) + 8 * (i >> 2) + 4 * half;
#pragma unroll
          for (int hb = 0; hb < 2; ++hb) {
            const int kq = kk + 32 * hb;
            const int kr = trow0 + kq / GRID_W, kc = kq % GRID_W;
            const bool ok = (kr >= ni.rs) && (kr < ni.rs + WIN_R) && (kc >= ni.cs) && (kc < ni.cs + WIN_C);
            const float bias = ok ? srpb[(kr - ni.r + 7) * 31 + (kc - ni.qc + 15)] * 1.4426950408889634f : -INFINITY;
            if (hb == 0) { s0[i] = s0[i] * scale2 + bias; mx = fmax_(mx, s0[i]); }
            else { s1[i] = s1[i] * scale2 + bias; mx = fmax_(mx, s1[i]); }
          }
        }
      } else {
#pragma unroll
        for (int i = 0; i < 16; ++i) { s0[i] *= scale2; s1[i] *= scale2; mx = fmax_(mx, fmax_(s0[i], s1[i])); }
      }
      mx = fmax_(mx, shfl_xor_(mx, 32));
      const float mn = fmax_(m, mx);
      const float alpha = exp2f_(m - mn);
      const bool same = (mn == m);
      m = mn;
      float ps = 0.f;
#pragma unroll
      for (int i = 0; i < 16; ++i) { s0[i] = exp2f_(s0[i] - mn); s1[i] = exp2f_(s1[i] - mn); ps += s0[i] + s1[i]; }
      l = l * alpha + ps;
      if (!wave_all_(same)) {
#pragma unroll
        for (int i = 0; i < 16; ++i) { o0[i] *= alpha; o1[i] *= alpha; }
      }
#pragma unroll
      for (int kq = 0; kq < 4; ++kq) {
        u32x4 pw;
#pragma unroll
        for (int j = 0; j < 4; ++j) pw[j] = (kq < 2) ? pack2(s0[8 * (kq & 1) + 2 * j], s0[8 * (kq & 1) + 2 * j + 1]) : pack2(s1[8 * (kq & 1) + 2 * j], s1[8 * (kq & 1) + 2 * j + 1]);
        const bf16x8 pf = __builtin_bit_cast(bf16x8, pw);
        const bf16* v0 = vb + r * AT_LDV + 16 * kq + 4 * half;
        const bf16* v1 = vb + (r + 32) * AT_LDV + 16 * kq + 4 * half;
        uint2 a0 = *(const uint2*)v0, a1 = *(const uint2*)(v0 + 8), b0 = *(const uint2*)v1, b1 = *(const uint2*)(v1 + 8);
        bf16x8 va, vbb;
        va[0] = (short)(a0.x & 0xffff); va[1] = (short)(a0.x >> 16); va[2] = (short)(a0.y & 0xffff); va[3] = (short)(a0.y >> 16);
        va[4] = (short)(a1.x & 0xffff); va[5] = (short)(a1.x >> 16); va[6] = (short)(a1.y & 0xffff); va[7] = (short)(a1.y >> 16);
        vbb[0] = (short)(b0.x & 0xffff); vbb[1] = (short)(b0.x >> 16); vbb[2] = (short)(b0.y & 0xffff); vbb[3] = (short)(b0.y >> 16);
        vbb[4] = (short)(b1.x & 0xffff); vbb[5] = (short)(b1.x >> 16); vbb[6] = (short)(b1.y & 0xffff); vbb[7] = (short)(b1.y >> 16);
        o0 = __builtin_amdgcn_mfma_f32_32x32x16_bf16(va, pf, o0, 0, 0, 0);
        o1 = __builtin_amdgcn_mfma_f32_32x32x16_bf16(vbb, pf, o1, 0, 0, 0);
      }
    }
    if (t + 1 < NTL) AT_SSTORE(buf ^ 1)
    __syncthreads();
  }
  if (active) {
    const float lt = l + shfl_xor_(l, 32);
    const float inv = 1.0f / lt;
#pragma unroll
    for (int gI = 0; gI < 4; ++gI) {
      const int d0 = 8 * gI + 4 * half;
      *(uint2*)(orow + d0) = make_uint2(pack2(o0[4 * gI] * inv, o0[4 * gI + 1] * inv), pack2(o0[4 * gI + 2] * inv, o0[4 * gI + 3] * inv));
      *(uint2*)(orow + 32 + d0) = make_uint2(pack2(o1[4 * gI] * inv, o1[4 * gI + 1] * inv), pack2(o1[4 * gI + 2] * inv, o1[4 * gI + 3] * inv));
    }
  }
}
DI void mla_attn_item(const Params& p, int it, bool ctxq, char* smem) {
  const int nqb = ctxq ? (CTXL + 255) / 256 : SEQ / 256;
  const int b = it / (4 * nqb), h = (it / nqb) & 3, qb = it % nqb;
  const int lane = tid_() & 63, wid = tid_() >> 6;
  const int nq = ctxq ? CTXL : SEQ, q0 = qb * 256 + wid * 32;
  const bool active = q0 < nq;
  const int jq = (ctxq ? 0 : CTXL) + (active ? q0 : 0) + (lane & 31);
  const bf16* Q = (const bf16*)(p.ws + OFF_MIX + MX_Q) + ((size_t)b * 4 + h) * TOK * 96;
  const bf16* K = (const bf16*)(p.ws + OFF_MIX + MX_K) + ((size_t)b * 4 + h) * TOK * 96;
  const bf16* VT = (const bf16*)(p.ws + OFF_MIX + MX_VTM) + ((size_t)b * 4 + h) * 64 * TOK;
  bf16* O = (bf16*)(p.ws + OFF_O) + ((size_t)b * TOK + jq) * 1024 + 0 * 256 + h * 64;
  NaInfo ni; ni.r = 0; ni.qc = 0; ni.rs = 0; ni.cs = 0;
  attn_block<96, false>(Q + (size_t)jq * 96, active, K, 96, VT, 0, 0, 0, 0, (ctxq ? CTXL : TOK) / 64, nullptr, ni, 0.10206207261596577f, O, smem);
}
DI void na_attn_item(const Params& p, const LP& L, int it, bool ctxq, char* smem) {
  const int nqb = ctxq ? (CTXL + 255) / 256 : SEQ / 256;
  const int b = it / (4 * nqb), h = (it / nqb) & 3, qb = it % nqb;
  const int tid = tid_(), lane = tid & 63, wid = tid >> 6;
  const int nq = ctxq ? CTXL : SEQ, q0 = qb * 256 + wid * 32;
  const bool active = q0 < nq;
  const int jq = (ctxq ? 0 : CTXL) + (active ? q0 : 0) + (lane & 31);
  const bf16* P1 = (const bf16*)(p.ws + OFF_P1) + (size_t)b * TOK * P1W;
  const bf16* VT = (const bf16*)(p.ws + OFF_MIX + MX_VTN) + ((size_t)b * 4 + h) * 64 * TOK;
  const bf16* Kb = P1 + C_NA + 256 + h * 64;
  bf16* O = (bf16*)(p.ws + OFF_O) + ((size_t)b * TOK + jq) * 1024 + 1 * 256 + h * 64;
  constexpr int AT_END64 = 2 * (64 * 72 * 2) + 2 * (64 * AT_LDV * 2);
  float* srpb = (float*)(smem + AT_END64);
  NaInfo ni; ni.r = 0; ni.qc = 0; ni.rs = 0; ni.cs = 0;
  int ka0 = 0, nta = 0, arow0 = 0;
  if (!ctxq) {
    __syncthreads();
    const float* rpb = p.in[I_RPB] + ((size_t)L.l * 4 + h) * 15 * 31;
    for (int i = tid; i < 15 * 31; i += NTHREADS) srpb[i] = rpb[i];
    const int tl = q0 + (lane & 31);
    ni.r = tl / GRID_W; ni.qc = tl % GRID_W;
    int rs = ni.r - WIN_R / 2; rs = rs < 0 ? 0 : (rs > ROWS - WIN_R ? ROWS - WIN_R : rs);
    int cs = ni.qc - WIN_C / 2; cs = cs < 0 ? 0 : (cs > GRID_W - WIN_C ? GRID_W - WIN_C : cs);
    ni.rs = rs; ni.cs = cs;
    constexpr int RPT = 64 / GRID_W;
    const int rfirst = (qb * 256) / GRID_W, rlast = (qb * 256 + 255) / GRID_W;
    int rs_f = rfirst - WIN_R / 2; rs_f = rs_f < 0 ? 0 : (rs_f > ROWS - WIN_R ? ROWS - WIN_R : rs_f);
    int rs_l = rlast - WIN_R / 2; rs_l = rs_l < 0 ? 0 : (rs_l > ROWS - WIN_R ? ROWS - WIN_R : rs_l);
    arow0 = (rs_f / RPT) * RPT;
    const int row_hi = rs_l + WIN_R;
    nta = (row_hi - arow0 + RPT - 1) / RPT;
    ka0 = CTXL + arow0 * GRID_W;
  }
  attn_block<64, true>(P1 + (size_t)jq * P1W + C_NA + h * 64, active, Kb, P1W, VT, ka0, nta, arow0, 0, CTXL / 64, srpb, ni, 0.125f, O, smem);
}

constexpr int M2_LDB = 136, M2_LDX = 72;
constexpr int M2_OFF_B = 0;
constexpr int M2_OFF_C = M2_OFF_B + 64 * M2_LDB * 2;
constexpr int M2_OFF_HD = M2_OFF_C + 64 * M2_LDB * 2;
constexpr int M2H_H = 0;
constexpr int M2H_XT = M2H_H + 64 * M2_LDB * 2;
constexpr int M2H_BT = M2H_XT + 64 * M2_LDX * 2;
constexpr int M2H_S = M2H_BT + 128 * M2_LDX * 2;
constexpr int M2H_X = M2H_S + 3 * 64 * 4;
constexpr int M2H_SIZE = M2H_X + 64 * M2_LDX * 2;
constexpr int M2_SMEM = M2_OFF_HD + 2 * M2H_SIZE;
static_assert(M2_SMEM <= SMEM_BYTES, "m2 smem");
DI u32x4 rev8_(u32x4 v) {
  return u32x4{(v[3] >> 16) | (v[3] << 16), (v[2] >> 16) | (v[2] << 16), (v[1] >> 16) | (v[1] << 16), (v[0] >> 16) | (v[0] << 16)};
}
DI void m2scan_item(const Params& p, const LP& L, int it, char* smem) {
  const int b = it / 4, grp = (it >> 1) & 1, dir = it & 1;
  const int tid = tid_(), lane = tid & 63, wid = tid >> 6, half = lane >> 5, r = lane & 31;
  const int hsel = wid >> 2, wl = wid & 3, hd = grp * 2 + hsel;
  bf16* sB = (bf16*)(smem + M2_OFF_B);
  bf16* sC = (bf16*)(smem + M2_OFF_C);
  char* hb = smem + M2_OFF_HD + hsel * M2H_SIZE;
  bf16* sH = (bf16*)(hb + M2H_H);
  bf16* sXT = (bf16*)(hb + M2H_XT);
  bf16* sBT = (bf16*)(hb + M2H_BT);
  float* sS = (float*)(hb + M2H_S);
  float* sDt = sS + 64;
  float* sW = sS + 128;
  const bf16* XB = (const bf16*)(p.ws + OFF_MIX + MX_XBC) + (size_t)b * TOK * 768;
  const bf16* XT = (const bf16*)(p.ws + OFF_MIX + MX_XBT) + (size_t)b * 512 * TOK;
  const float* SC = (const float*)(p.ws + OFF_MIX + MX_M2S) + (size_t)((b * 2 + dir) * 4 + hd) * TOK * 4;
  float* YM = (float*)(p.ws + OFF_HA) + ((size_t)dir * NTOK + (size_t)b * TOK) * 256;
  const int pb = wl & 1, tb = wl >> 1, nb0 = 2 * (wl >> 1);
  f32x16 hst[2];
#pragma unroll
  for (int i = 0; i < 16; ++i) { hst[0][i] = 0.f; hst[1][i] = 0.f; }
  __syncthreads();
  for (int i = tid; i < 2 * M2H_SIZE / 4; i += NTHREADS) ((unsigned*)(smem + M2_OFF_HD))[i] = 0u;
  __syncthreads();
  u32x4 rxt[2], rbt[2], rb[2], rc[2];
  float4 rsc = make_float4(0.f, 0.f, 0.f, 0.f);
#define M2_TLOAD(rowptr_, sq0_) (*(const u32x4*)((rowptr_) + ((dir == 0) ? (sq0_) : m2_seq2tok((sq0_) + 7, 1))))
#define M2_GLOAD(c0_) { \
    _Pragma("unroll") for (int q_ = 0; q_ < 2; ++q_) { const int i_ = tid + q_ * NTHREADS; const int h2_ = i_ >> 9, t8_ = ((i_ >> 6) & 7) * 8, pp_ = i_ & 63; \
      rxt[q_] = M2_TLOAD(XT + (size_t)((grp * 2 + h2_) * 64 + pp_) * TOK, (c0_) + t8_); } \
    _Pragma("unroll") for (int q_ = 0; q_ < 2; ++q_) { const int i_ = tid + q_ * NTHREADS; const int t8_ = (i_ >> 7) * 8, nn_ = i_ & 127; \
      rbt[q_] = M2_TLOAD(XT + (size_t)(256 + grp * 128 + nn_) * TOK, (c0_) + t8_); } \
    _Pragma("unroll") for (int q_ = 0; q_ < 2; ++q_) { const int i_ = tid + q_ * NTHREADS; const int t_ = i_ >> 4, n8_ = (i_ & 15) * 8; \
      const bf16* src_ = XB + (size_t)m2_seq2tok((c0_) + t_, dir) * 768 + grp * 128 + n8_; \
      rb[q_] = *(const u32x4*)(src_ + 256); rc[q_] = *(const u32x4*)(src_ + 512); } \
    if (wl == 0) rsc = *(const float4*)(SC + (size_t)((c0_) + lane) * 4); }
  M2_GLOAD(0)
  for (int c0 = 0; c0 < TOK; c0 += 64) {
    if (wl == 0) { sS[lane] = rsc.x; sDt[lane] = rsc.w; sW[lane] = rsc.z; }
    __syncthreads();
#pragma unroll
    for (int q2 = 0; q2 < 2; ++q2) {
      const int i = tid + q2 * NTHREADS; const int h2 = i >> 9, t8 = ((i >> 6) & 7) * 8, pp = i & 63;
      *(u32x4*)((bf16*)(smem + M2_OFF_HD + h2 * M2H_SIZE + M2H_XT) + pp * M2_LDX + t8) = dir ? rev8_(rxt[q2]) : rxt[q2];
    }
#pragma unroll
    for (int q4 = 0; q4 < 2; ++q4) {
      const int i = tid + q4 * NTHREADS; const int t = i >> 4, n8 = (i & 15) * 8;
      *(u32x4*)(sB + t * M2_LDB + n8) = rb[q4];
      *(u32x4*)(sC + t * M2_LDB + n8) = rc[q4];
    }
#pragma unroll
    for (int q4 = 0; q4 < 2; ++q4) {
      const int i = tid + q4 * NTHREADS; const int t8 = (i >> 7) * 8, nn = i & 127;
      float bv[8];
      if (dir) rbt[q4] = rev8_(rbt[q4]);
      bv[0] = __uint_as_float(rbt[q4][0] << 16); bv[1] = __uint_as_float(rbt[q4][0] & 0xffff0000u);
      bv[2] = __uint_as_float(rbt[q4][1] << 16); bv[3] = __uint_as_float(rbt[q4][1] & 0xffff0000u);
      bv[4] = __uint_as_float(rbt[q4][2] << 16); bv[5] = __uint_as_float(rbt[q4][2] & 0xffff0000u);
      bv[6] = __uint_as_float(rbt[q4][3] << 16); bv[7] = __uint_as_float(rbt[q4][3] & 0xffff0000u);
#pragma unroll
      for (int h2 = 0; h2 < 2; ++h2) {
        const float* wv = (const float*)(smem + M2_OFF_HD + h2 * M2H_SIZE + M2H_S) + 128 + t8;
        float sv[8];
#pragma unroll
        for (int k = 0; k < 8; ++k) sv[k] = bv[k] * wv[k];
        st8bf((bf16*)(smem + M2_OFF_HD + h2 * M2H_SIZE + M2H_BT) + nn * M2_LDX + t8, sv);
      }
    }
    __syncthreads();
    if (c0 + 64 < TOK) M2_GLOAD(c0 + 64)
    {
      f32x16 yT, y2;
#pragma unroll
      for (int i = 0; i < 16; ++i) { yT[i] = 0.f; y2[i] = 0.f; }
      const int tv = 32 * tb + r;
      const float St = sS[tv];
      for (int sb = 0; sb <= tb; ++sb) {
        f32x16 gT;
#pragma unroll
        for (int i = 0; i < 16; ++i) gT[i] = 0.f;
#pragma unroll
        for (int ks = 0; ks < 8; ++ks) {
          bf16x8 av = *(const bf16x8*)(sB + (32 * sb + r) * M2_LDB + 16 * ks + 8 * half);
          bf16x8 bv = *(const bf16x8*)(sC + tv * M2_LDB + 16 * ks + 8 * half);
          gT = __builtin_amdgcn_mfma_f32_32x32x16_bf16(av, bv, gT, 0, 0, 0);
        }
        const float St2 = St * 1.4426950408889634f;
        if (sb == tb) {
#pragma unroll
          for (int i = 0; i < 16; ++i) {
            const int sv = 32 * sb + (i & 3) + 8 * (i >> 2) + 4 * half;
            gT[i] = (sv <= tv) ? gT[i] * exp2f_(St2 - sDt[sv]) : 0.f;
          }
        } else {
#pragma unroll
          for (int i = 0; i < 16; ++i) {
            const int sv = 32 * sb + (i & 3) + 8 * (i >> 2) + 4 * half;
            gT[i] *= exp2f_(St2 - sDt[sv]);
          }
        }
#pragma unroll
        for (int kq = 0; kq < 2; ++kq) {
          const u32x4 pw = u32x4{pack2(gT[8 * kq], gT[8 * kq + 1]), pack2(gT[8 * kq + 2], gT[8 * kq + 3]), pack2(gT[8 * kq + 4], gT[8 * kq + 5]), pack2(gT[8 * kq + 6], gT[8 * kq + 7])};
          const bf16x8 pf = __builtin_bit_cast(bf16x8, pw);
          const bf16* xr = sXT + (32 * pb + r) * M2_LDX + 32 * sb + 16 * kq + 4 * half;
          uint2 x0 = *(const uint2*)xr, x1 = *(const uint2*)(xr + 8);
          bf16x8 xa;
          xa[0] = (short)(x0.x & 0xffff); xa[1] = (short)(x0.x >> 16); xa[2] = (short)(x0.y & 0xffff); xa[3] = (short)(x0.y >> 16);
          xa[4] = (short)(x1.x & 0xffff); xa[5] = (short)(x1.x >> 16); xa[6] = (short)(x1.y & 0xffff); xa[7] = (short)(x1.y >> 16);
          yT = __builtin_amdgcn_mfma_f32_32x32x16_bf16(xa, pf, yT, 0, 0, 0);
        }
      }
#pragma unroll
      for (int ks = 0; ks < 8; ++ks) {
        bf16x8 av = *(const bf16x8*)(sH + (32 * pb + r) * M2_LDB + 16 * ks + 8 * half);
        bf16x8 bv = *(const bf16x8*)(sC + tv * M2_LDB + 16 * ks + 8 * half);
        y2 = __builtin_amdgcn_mfma_f32_32x32x16_bf16(av, bv, y2, 0, 0, 0);
      }
      const float eS = __expf(St);
      const int j = m2_seq2tok(c0 + tv, dir);
      float* yo = YM + (size_t)j * 256 + hd * 64 + 32 * pb + 4 * half;
#pragma unroll
      for (int gI = 0; gI < 4; ++gI)
        *(float4*)(yo + 8 * gI) = make_float4(yT[4 * gI] + eS * y2[4 * gI], yT[4 * gI + 1] + eS * y2[4 * gI + 1], yT[4 * gI + 2] + eS * y2[4 * gI + 2], yT[4 * gI + 3] + eS * y2[4 * gI + 3]);
    }
    __syncthreads();
    {
      const float eL = __expf(sS[63]);
#pragma unroll
      for (int q = 0; q < 2; ++q) {
#pragma unroll
        for (int i = 0; i < 16; ++i) hst[q][i] *= eL;
#pragma unroll
        for (int ks = 0; ks < 4; ++ks) {
          bf16x8 av = *(const bf16x8*)(sXT + (32 * pb + r) * M2_LDX + 16 * ks + 8 * half);
          bf16x8 bv = *(const bf16x8*)(sBT + (32 * (nb0 + q) + r) * M2_LDX + 16 * ks + 8 * half);
          hst[q] = __builtin_amdgcn_mfma_f32_32x32x16_bf16(av, bv, hst[q], 0, 0, 0);
        }
#pragma unroll
        for (int i = 0; i < 16; ++i) {
          const int pv = 32 * pb + (i & 3) + 8 * (i >> 2) + 4 * half;
          sH[pv * M2_LDB + 32 * (nb0 + q) + r] = f2bf(hst[q][i]);
        }
      }
    }
    __syncthreads();
  }
}
DI void m2gate_item(const Params& p, const LP& L, int it) {
  const int tok = it * NWAVES + (tid_() >> 6), lane = tid_() & 63;
  const float* Y0 = (const float*)(p.ws + OFF_HA) + (size_t)tok * 256;
  const float* Y1 = Y0 + (size_t)NTOK * 256;
  const bf16* XB = (const bf16*)(p.ws + OFF_MIX + MX_XBC) + (size_t)tok * 768;
  const bf16* P1 = (const bf16*)(p.ws + OFF_P1) + (size_t)tok * P1W + C_Z;
  const int c = lane * 4, hd = c >> 6;
  const float dsk = p.in[I_M2D][L.l * 4 + hd];
  float4 y0 = *(const float4*)(Y0 + c), y1 = *(const float4*)(Y1 + c);
  uint2 xw = *(const uint2*)(XB + c), zw = *(const uint2*)(P1 + c);
  float xs[4] = {__uint_as_float(xw.x << 16), __uint_as_float(xw.x & 0xffff0000u), __uint_as_float(xw.y << 16), __uint_as_float(xw.y & 0xffff0000u)};
  float zs[4] = {__uint_as_float(zw.x << 16), __uint_as_float(zw.x & 0xffff0000u), __uint_as_float(zw.y << 16), __uint_as_float(zw.y & 0xffff0000u)};
  float ys[4] = {y0.x + y1.x, y0.y + y1.y, y0.z + y1.z, y0.w + y1.w};
  float v[4], ss = 0.f;
#pragma unroll
  for (int i = 0; i < 4; ++i) { v[i] = (ys[i] + dsk * xs[i]) * siluf_(zs[i]); ss += v[i] * v[i]; }
  ss = wave_sum(ss);
  const float rs = rsqrtf(ss * (1.f / 256.f) + EPS);
  float4 gn = *(const float4*)(p.in[I_M2GNORM] + L.l * 256 + c);
  bf16* O = (bf16*)(p.ws + OFF_O) + (size_t)tok * 1024 + 768 + c;
  *(uint2*)O = make_uint2(pack2(v[0] * rs * gn.x, v[1] * rs * gn.y), pack2(v[2] * rs * gn.z, v[3] * rs * gn.w));
}
constexpr int GLU_MT = (NTOK + 255) / 256;
DI void glu_tile(const Params& p, const LP& L, int t, char* smem) {
  const int mt = t % GLU_MT, nt = t / GLU_MT, m0 = mt * 256, n0 = nt * 128;
  const bf16* Z = (const bf16*)(p.ws + OFF_MIX + MX_Z);
  GA g = make_ga(Z, 256, (const bf16*)(L.we + WE_GLU), 256, 256, NTOK);
  f32x4 acc[4][4];
  gemm_s<4>(g, m0, n0, smem, acc);
  bf16* O = (bf16*)(p.ws + OFF_O);
  const float* bg = p.in[I_S5BGLU] + L.l * 256;
  EPI_BEGIN(4, acc, m0, n0, NTOK)
    float z[8]; ld8bf(Z + (size_t)row * 256 + col, z);
#pragma unroll
    for (int k = 0; k < 8; ++k) v[k] = z[k] * sigmoidf_(v[k] + bg[col + k]);
    st8bf(O + (size_t)row * 1024 + 512 + col, v);
  EPI_END
}
DI void merge_tile(const Params& p, const LP& L, int t, char* smem) {
  constexpr int MT_L = BATCH * (SEQ / 256), MT_A = (NTOK + 255) / 256;
  const int mt = L.last ? t % MT_L : t % MT_A, nt = L.last ? t / MT_L : t / MT_A, m0 = mtile_row0(mt, L.last, 256), n0 = nt * 128;
  const bf16* O = (const bf16*)(p.ws + OFF_O);
  const bf16* PG = (const bf16*)(p.ws + OFF_PG);
  float tot[4][2][8];
#pragma unroll
  for (int a = 0; a < 4; ++a)
#pragma unroll
    for (int q = 0; q < 2; ++q)
#pragma unroll
      for (int k = 0; k < 8; ++k) tot[a][q][k] = 0.f;
  for (int j = 0; j < 4; ++j) {
    GA g = make_ga(O + j * 256, 1024, (const bf16*)(L.we + WE_WB) + (size_t)j * 1024 * 256, 256, 256, NTOK);
    f32x4 acc[4][4];
    gemm_s<4>(g, m0, n0, smem, acc);
    EPI_BEGIN(4, acc, m0, n0, NTOK)
      float gt[8]; ld8bf(PG + (size_t)row * 4096 + j * 1024 + col, gt);
#pragma unroll
      for (int k = 0; k < 8; ++k) tot[_m][_q][k] += gt[k] * v[k];
    EPI_END
  }
  bf16* Y = (bf16*)(p.ws + OFF_P1);
  {
    const int l = tid_() & 63, w = tid_() >> 6, wr = w >> 1, wc = w & 1, fr = l & 15, fq = l >> 4;
#pragma unroll
    for (int m = 0; m < 4; ++m)
#pragma unroll
      for (int q = 0; q < 2; ++q) {
        const int row = m0 + wr * 64 + m * 16 + fr, col = n0 + wc * 64 + q * 32 + 8 * fq;
        if (row < NTOK) st8bf(Y + (size_t)row * 1024 + col, tot[m][q]);
      }
  }
}
DI void outproj_tile(const Params& p, const LP& L, int t, char* smem) {
  float* Y2 = (float*)(p.ws + OFF_HA);
  constexpr int MT_L = BATCH * (SEQ / 256), MT_A = (NTOK + 255) / 256;
  const int mt = L.last ? t % MT_L : t % MT_A, nt = L.last ? t / MT_L : t / MT_A, m0 = mtile_row0(mt, L.last, 256), n0 = nt * 256;
  GA g = make_ga((const bf16*)(p.ws + OFF_P1), 1024, (const bf16*)(L.we + WE_WOUT), 1024, 1024, NTOK);
  f32x4 acc[2][2][4][2];
  gemm_big(g, m0, n0, smem, acc);
  EPIB_BEGIN(acc, m0, n0, NTOK)
    st8f(Y2 + (size_t)row * 1024 + col, v);
  EPIB_END
}
DI int post_ntok(bool latonly) { return latonly ? BATCH * SEQ : NTOK; }
DI int post_tok(int i, bool latonly) { return latonly ? ((i / SEQ) * TOK + CTXL + (i % SEQ)) : i; }

DI const float* xsrc_row(const Params& p, int l, int tok) {
  if (l > 0) return (const float*)(p.ws + OFF_X) + (size_t)tok * 1024;
  const int b = tok_b(tok), j = tok_j(tok);
  return (j < CTXL) ? p.in[I_CTX] + ((size_t)b * CTXL + j) * 1024 : p.in[I_X] + ((size_t)b * SEQ + (j - CTXL)) * 1024;
}
DI void post_stage_router(const Params& p, const LP& L, char* smem) {
  const float* wr = p.in[I_WROUTER] + (size_t)L.l * 1024 * 16;
  float4* wl = (float4*)smem;
  __syncthreads();
  for (int i = tid_(); i < 4096; i += NTHREADS) {
    const int k = i >> 2, q = i & 3;
    const int pos = ((k >> 8) * 4 + (k & 3)) * 64 + ((k >> 2) & 63);
    wl[q * 1024 + pos] = *(const float4*)(wr + (size_t)k * 16 + q * 4);
  }
  __syncthreads();
}
DI void post_phase(const Params& p, const LP& L, char* smem) {
  const int lane = tid_() & 63, gw = (int)blockIdx.x * NWAVES + (tid_() >> 6), TW = (int)gridDim.x * NWAVES;
  const int n = post_ntok(L.last);
  if (gw >= n) return;
  const float* gpm = p.in[I_GPOSTMIX] + L.l * 1024;
  const float4* wl = (const float4*)smem;
  int i = gw, tok = post_tok(i, L.last);
  float4 yr[4], xr[4];
  {
    const float* X = xsrc_row(p, L.l, tok);
    const float* Y2 = (const float*)(p.ws + OFF_HA) + (size_t)tok * 1024;
#pragma unroll
    for (int q = 0; q < 4; ++q) { yr[q] = *(const float4*)(Y2 + lane * 4 + q * 256); xr[q] = *(const float4*)(X + lane * 4 + q * 256); }
  }
  for (;;) {
    const int inext = i + TW; const bool has = inext < n; const int tokn = has ? post_tok(inext, L.last) : tok;
    float4 yn[4], xn[4];
    {
      const float* Xn = xsrc_row(p, L.l, tokn);
      const float* Yn = (const float*)(p.ws + OFF_HA) + (size_t)tokn * 1024;
#pragma unroll
      for (int q = 0; q < 4; ++q) { yn[q] = *(const float4*)(Yn + lane * 4 + q * 256); xn[q] = *(const float4*)(Xn + lane * 4 + q * 256); }
    }
    float* X = (float*)(p.ws + OFF_X) + (size_t)tok * 1024;
    const float* mod = L.mod + (size_t)tok_modrow(tok) * 6144;
    float xv[16], h[16];
    float ss = 0.f;
#pragma unroll
    for (int q = 0; q < 4; ++q) ss += yr[q].x * yr[q].x + yr[q].y * yr[q].y + yr[q].z * yr[q].z + yr[q].w * yr[q].w;
    ss = wave_sum(ss);
    const float rs = rsqrtf(ss * (1.f / 1024.f) + EPS);
#pragma unroll
    for (int q = 0; q < 4; ++q) {
      const int c = lane * 4 + q * 256;
      float4 xo = xr[q], gv = *(const float4*)(gpm + c), gt = *(const float4*)(mod + 2048 + c);
      xo.x += gt.x * yr[q].x * rs * gv.x; xo.y += gt.y * yr[q].y * rs * gv.y; xo.z += gt.z * yr[q].z * rs * gv.z; xo.w += gt.w * yr[q].w * rs * gv.w;
      *(float4*)(X + c) = xo;
      xv[q * 4] = xo.x; xv[q * 4 + 1] = xo.y; xv[q * 4 + 2] = xo.z; xv[q * 4 + 3] = xo.w;
    }
    bf16* H2 = (bf16*)(p.ws + OFF_P1) + (size_t)NTOK * 1024 + (size_t)tok * 1024;
    normmod_row(xv, p.in[I_GPREFFN] + L.l * 1024, mod + 3072, mod + 4096, H2, h);
    float lg[16];
#pragma unroll
    for (int e = 0; e < 16; ++e) lg[e] = 0.f;
#pragma unroll
    for (int q = 0; q < 16; ++q) {
      const int pos = ((q >> 2) * 4 + (q & 3)) * 64 + lane;
      float4 a = wl[pos], b4 = wl[1024 + pos], c4 = wl[2048 + pos], d4 = wl[3072 + pos];
      float hv = h[q];
      lg[0] += hv * a.x; lg[1] += hv * a.y; lg[2] += hv * a.z; lg[3] += hv * a.w;
      lg[4] += hv * b4.x; lg[5] += hv * b4.y; lg[6] += hv * b4.z; lg[7] += hv * b4.w;
      lg[8] += hv * c4.x; lg[9] += hv * c4.y; lg[10] += hv * c4.z; lg[11] += hv * c4.w;
      lg[12] += hv * d4.x; lg[13] += hv * d4.y; lg[14] += hv * d4.z; lg[15] += hv * d4.w;
    }
    float mx = -INFINITY;
#pragma unroll
    for (int e = 0; e < 16; ++e) { lg[e] = wave_sum(lg[e]); mx = fmax_(mx, lg[e]); }
    float se = 0.f;
#pragma unroll
    for (int e = 0; e < 16; ++e) { lg[e] = expf(lg[e] - mx); se += lg[e]; }
    if (lane < 16) {
      float v = 0.f;
#pragma unroll
      for (int e = 0; e < 16; ++e) if (e == lane) v = lg[e];
      ((float*)(p.ws + OFF_AFF))[(size_t)lane * NTOK + tok] = v / se;
    }
    if (!has) break;
    i = inext; tok = tokn;
#pragma unroll
    for (int q = 0; q < 4; ++q) { yr[q] = yn[q]; xr[q] = xn[q]; }
  }
}
DI int block_sum_(int v, int* sred, int round) {
  const int tid = tid_(), lane = tid & 63, wid = tid >> 6;
  v += shfl_xor_(v, 32); v += shfl_xor_(v, 16); v += shfl_xor_(v, 8); v += shfl_xor_(v, 4); v += shfl_xor_(v, 2); v += shfl_xor_(v, 1);
  int* r = sred + (round & 1) * NWAVES;
  if (lane == 0) r[wid] = v;
  __syncthreads();
  int tsum = 0;
#pragma unroll
  for (int q = 0; q < NWAVES; ++q) tsum += r[q];
  return tsum;
}
DI void route_item(const Params& p, const LP& L, int it, char* smem) {
  const int nstream = L.last ? 1 : 2;
  const int b = it / (16 * nstream), e = (it / nstream) & 15, ctxs = (nstream == 2) ? (it & 1) : 0;
  const int T = ctxs ? CTXL : SEQ, cap = ctxs ? CAP_C : CAP_L;
  const int tok0 = b * TOK + (ctxs ? 0 : CTXL);
  const int slot0 = ctxs ? (BATCH * CAP_L + b * CAP_C) : (b * CAP_L);
  int* sred = (int*)smem;
  const float* AFF = (const float*)(p.ws + OFF_AFF) + (size_t)e * NTOK + tok0;
  int* SEL = (int*)(p.ws + OFF_SEL);
  int* IDX = (int*)(p.ws + OFF_IDX) + (size_t)e * ESLOTS;
  float* GW = (float*)(p.ws + OFF_GW) + (size_t)e * ESLOTS;
  const int tid = tid_(), lane = tid & 63, wid = tid >> 6;
  constexpr int MAXPER = (SEQ + NTHREADS - 1) / NTHREADS;
  const int per = (T + NTHREADS - 1) / NTHREADS;
  unsigned key[MAXPER];
  __syncthreads();
#pragma unroll
  for (int k = 0; k < MAXPER; ++k) {
    int i = tid * per + k;
    key[k] = (k < per && i < T) ? (__float_as_uint(AFF[i]) + 1u) : 0u;
  }
  unsigned thr = 0u;
  int round = 0;
  for (int bit = 30; bit >= 0; --bit) {
    const unsigned cand = thr | (1u << bit);
    int c = 0;
#pragma unroll
    for (int k = 0; k < MAXPER; ++k) c += (key[k] >= cand) ? 1 : 0;
    c = block_sum_(c, sred, round++);
    if (c >= cap) thr = cand;
  }
  int cg = 0, ce = 0;
#pragma unroll
  for (int k = 0; k < MAXPER; ++k) { cg += (key[k] > thr) ? 1 : 0; ce += (key[k] == thr) ? 1 : 0; }
  const int tot_gt = block_sum_(cg, sred, round++);
  const int need_eq = cap - tot_gt;
  int v = cg | (ce << 16), inc = v;
#pragma unroll
  for (int d = 1; d < 64; d <<= 1) { int o = shfl_up_(inc, d); if (lane >= d) inc += o; }
  int* soff = sred + 2 * NWAVES;
  __syncthreads();
  if (lane == 63) soff[wid] = inc;
  __syncthreads();
  int base = 0;
  for (int w = 0; w < wid; ++w) base += soff[w];
  int excl = base + inc - v;
  int gt_before = excl & 0xffff, eq_before = excl >> 16;
#pragma unroll
  for (int k = 0; k < MAXPER; ++k) {
    int i = tid * per + k;
    if (k < per && i < T) {
      const bool isgt = key[k] > thr, iseq = key[k] == thr;
      const bool sel = isgt || (iseq && eq_before < need_eq);
      const int slot = slot0 + gt_before + (eq_before < need_eq ? eq_before : need_eq);
      if (sel) { IDX[slot] = tok0 + i; GW[slot] = __uint_as_float(key[k] - 1u); SEL[(size_t)(tok0 + i) * 16 + e] = slot; }
      else SEL[(size_t)(tok0 + i) * 16 + e] = -1;
      gt_before += isgt ? 1 : 0; eq_before += iseq ? 1 : 0;
    }
  }
}
DI void moe1_tile(const Params& p, const LP& L, int t, char* smem) {
  const int nslots = L.last ? ESLOTS_L : ESLOTS;
  constexpr int MT_L = (ESLOTS_L + 255) / 256, MT_A = (ESLOTS + 255) / 256;
  const int nt = t & 7, sq = t >> 3;
  const int e = L.last ? sq / MT_L : sq / MT_A, mt = L.last ? sq % MT_L : sq % MT_A;
  const int m0 = mt * 256, n0 = nt * 256;
  GA g = make_ga((const bf16*)(p.ws + OFF_P1) + (size_t)NTOK * 1024, 1024, (const bf16*)(p.ws + OFF_MIX + WX_GU) + (size_t)e * 2048 * 1024, 1024, 1024, nslots);
  g.ridx = (const int*)(p.ws + OFF_IDX) + (size_t)e * ESLOTS;
  f32x4 acc[2][2][4][2];
  gemm_big(g, m0, n0, smem, acc);
  bf16* ACT = (bf16*)(p.ws + OFF_PG) + (size_t)e * ESLOTS * 1024;
  {
    const int l = tid_() & 63, w = tid_() >> 6, wr = w >> 2, wc = w & 3, fr = l & 15, fq = l >> 4;
#pragma unroll
    for (int ai = 0; ai < 2; ++ai)
#pragma unroll
      for (int m = 0; m < 4; ++m) {
        const int row = m0 + ai * 128 + wr * 64 + m * 16 + fr;
        float a[8];
#pragma unroll
        for (int k = 0; k < 4; ++k) { a[k] = siluf_(acc[ai][0][m][0][k]) * acc[ai][1][m][0][k]; a[4 + k] = siluf_(acc[ai][0][m][1][k]) * acc[ai][1][m][1][k]; }
        if (row < nslots) st8bf(ACT + (size_t)row * 1024 + nt * 128 + wc * 32 + 8 * fq, a);
      }
  }
}
DI void moe2_tile(const Params& p, const LP& L, int t, char* smem) {
  const int nslots = L.last ? ESLOTS_L : ESLOTS;
  constexpr int MT_L = (ESLOTS_L + 255) / 256, MT_A = (ESLOTS + 255) / 256;
  const int x = t & 7, nt = x & 3, sq = (t >> 3) * 2 + (x >> 2);
  const int e = L.last ? sq / MT_L : sq / MT_A, mt = L.last ? sq % MT_L : sq % MT_A;
  if (e >= NE) return;
  const int m0 = mt * 256, n0 = nt * 256;
  GA g = make_ga((const bf16*)(p.ws + OFF_PG) + (size_t)e * ESLOTS * 1024, 1024, (const bf16*)(p.ws + OFF_MIX + WX_DN) + (size_t)e * 1024 * 1024, 1024, 1024, nslots);
  f32x4 acc[2][2][4][2];
  gemm_big(g, m0, n0, smem, acc);
  bf16* YS = (bf16*)(p.ws + OFF_PG) + (size_t)NE * ESLOTS * 1024 + (size_t)e * ESLOTS * 1024;
  const float* GW = (const float*)(p.ws + OFF_GW) + (size_t)e * ESLOTS;
  EPIB_BEGIN(acc, m0, n0, nslots)
    const float gw = GW[row];
#pragma unroll
    for (int k = 0; k < 8; ++k) v[k] *= gw;
    st8bf(YS + (size_t)row * 1024 + col, v);
  EPIB_END
}
DI int uni_(int v) {
#ifdef EMU
  return v;
#else
  return __builtin_amdgcn_readfirstlane(v);
#endif
}
DI void comb_phase(const Params& p, const LP& L) {
  const int lane = tid_() & 63, gw = (int)blockIdx.x * NWAVES + (tid_() >> 6), TW = (int)gridDim.x * NWAVES;
  const int n = post_ntok(L.last);
  if (gw >= n) return;
  const bf16* YS = (const bf16*)(p.ws + OFF_PG) + (size_t)NE * ESLOTS * 1024;
  const float* gpf = p.in[I_GPOSTFFN] + L.l * 1024;
  int i = gw, tok = post_tok(i, L.last);
  uint4 sel[4]; float4 xr[4];
  {
    const uint4* sp = (const uint4*)((const int*)(p.ws + OFF_SEL) + (size_t)tok * 16);
    const float* X = (const float*)(p.ws + OFF_X) + (size_t)tok * 1024;
#pragma unroll
    for (int q = 0; q < 4; ++q) { sel[q] = sp[q]; xr[q] = *(const float4*)(X + lane * 4 + q * 256); }
  }
  for (;;) {
    const int inext = i + TW; const bool has = inext < n; const int tokn = has ? post_tok(inext, L.last) : tok;
    float s[16];
#pragma unroll
    for (int q = 0; q < 16; ++q) s[q] = 0.f;
#pragma unroll
    for (int e = 0; e < 16; ++e) {
      const unsigned sv = (e & 3) == 0 ? sel[e >> 2].x : (e & 3) == 1 ? sel[e >> 2].y : (e & 3) == 2 ? sel[e >> 2].z : sel[e >> 2].w;
      const int sl = uni_((int)sv);
      if (sl >= 0) {
        const bf16* yr = YS + ((size_t)e * ESLOTS + sl) * 1024;
#pragma unroll
        for (int q = 0; q < 4; ++q) {
          uint2 w = *(const uint2*)(yr + lane * 4 + q * 256);
          s[q * 4] += __uint_as_float(w.x << 16); s[q * 4 + 1] += __uint_as_float(w.x & 0xffff0000u);
          s[q * 4 + 2] += __uint_as_float(w.y << 16); s[q * 4 + 3] += __uint_as_float(w.y & 0xffff0000u);
        }
      }
    }
    uint4 seln[4]; float4 xn[4];
    {
      const uint4* sp = (const uint4*)((const int*)(p.ws + OFF_SEL) + (size_t)tokn * 16);
      const float* Xn = (const float*)(p.ws + OFF_X) + (size_t)tokn * 1024;
#pragma unroll
      for (int q = 0; q < 4; ++q) { seln[q] = sp[q]; xn[q] = *(const float4*)(Xn + lane * 4 + q * 256); }
    }
    float ss = 0.f;
#pragma unroll
    for (int q = 0; q < 16; ++q) ss += s[q] * s[q];
    ss = wave_sum(ss);
    const float rs = rsqrtf(ss * (1.f / 1024.f) + EPS);
    const float* mod = L.mod + (size_t)tok_modrow(tok) * 6144;
    float* dst = (float*)(p.ws + OFF_X) + (size_t)tok * 1024;
    if (L.last) { const int b = tok_b(tok), j = tok_j(tok); dst = p.out + ((size_t)b * SEQ + (j - CTXL)) * 1024; }
    float xv[16], h[16];
#pragma unroll
    for (int q = 0; q < 4; ++q) {
      const int c = lane * 4 + q * 256;
      float4 xo = xr[q], gv = *(const float4*)(gpf + c), gt = *(const float4*)(mod + 5120 + c);
      xo.x += gt.x * s[q * 4] * rs * gv.x; xo.y += gt.y * s[q * 4 + 1] * rs * gv.y; xo.z += gt.z * s[q * 4 + 2] * rs * gv.z; xo.w += gt.w * s[q * 4 + 3] * rs * gv.w;
      *(float4*)(dst + c) = xo;
      xv[q * 4] = xo.x; xv[q * 4 + 1] = xo.y; xv[q * 4 + 2] = xo.z; xv[q * 4 + 3] = xo.w;
    }
    if (!L.last) {
      const float* mod1 = (const float*)(p.ws + OFF_MOD) + ((size_t)(L.l + 1) * NB1 + tok_modrow(tok)) * 6144;
      normmod_row(xv, p.in[I_GPREMIX] + (L.l + 1) * 1024, mod1, mod1 + 1024, (bf16*)(p.ws + OFF_HA) + (size_t)tok * 1024, h);
    }
    if (!has) break;
    i = inext; tok = tokn;
#pragma unroll
    for (int q = 0; q < 4; ++q) { sel[q] = seln[q]; xr[q] = xn[q]; }
  }
}

enum { PH_PREP0 = 0, PH_PREP1, PH_L0 };
enum { LP_INPROJ = 0, LP_TOKPREP, LP_MIX1, LP_MIX2, LP_GLU, LP_MERGE, LP_OUT, LP_POST, LP_ROUTE, LP_MOE1, LP_MOE2, LP_COMB, LP_COUNT };
constexpr int NPHASES = PH_L0 + DEPTH * LP_COUNT;


DI void run_phase(const Params& p, int ph, char* smem) {
  const int G = gridDim.x;
  int start = blockIdx.x;
  auto seg = [&](int n, auto&& fn) {
    for (; start < n; start += G) fn(start);
    start -= n;
  };
#ifdef ONLY_PREP
  if (ph >= PH_L0) return;
#endif
  if (ph == PH_PREP0) {
    seg(DEPTH * 96, [&](int it) { mod_item(p, it, smem); });
    seg(DEPTH * 32, [&](int it) { s5_tab_item(p, it, smem); });
    seg(1, [&](int) { rope_tab_item(p); });
    seg(DEPTH * CT_EARLY, [&](int it) { conv_early_item(p, it / CT_EARLY, it % CT_EARLY, smem); });
    return;
  }
  if (ph == PH_PREP1) {
    seg(DEPTH * 256, [&](int it) { s5_mat_item(p, it); });
    seg(NTOK / NWAVES, [&](int it) { prep_row_item(p, it); });
    return;
  }
#ifdef ONLY_LPH
  if (ph < PH_L0) return;
#endif
  const int l = (ph - PH_L0) / LP_COUNT;
#ifdef ONLY_LPH
  const int lph = ONLY_LPH;
#else
  const int lph = (ph - PH_L0) % LP_COUNT;
#endif
  const LP L = make_lp(p, l);
  switch (lph) {
    case LP_INPROJ:
      seg(L.last ? IP_SLOTS_LAST : IP_SLOTS_ALL, [&](int it) { inproj_tile(p, L, it, smem); });
      break;
    case LP_TOKPREP:
      seg(16 * S5_MT * 2, [&](int it) { s5a_tile(p, L, it, smem); });
      seg(TP_MT * 3, [&](int it) { mlaq_tile(p, L, it, smem); });
      seg(TP_MT * 4, [&](int it) { mlakv_tile(p, L, it, smem); });
      seg(NTOK / 64, [&](int it) { navt_item(p, it, smem); });
      seg(M2C_ITEMS, [&](int it) { m2conv_item(p, L, it); });
      seg(M2S_ITEMS, [&](int it) { m2scal_item(p, L, it); });
      break;
    case LP_MIX1: {
      const int n0 = BATCH * 4, n1 = n0 + 2 * 16 * BATCH / NWAVES, n2 = n1 + BATCH * 4 * (SEQ / 256), n3 = n2 + BATCH * 4 * (SEQ / 256);
      const int n4 = n3 + (L.last ? 0 : BATCH * 4 * ((CTXL + 255) / 256)), n5 = n4 + (L.last ? 0 : BATCH * 4 * ((CTXL + 255) / 256));
      int* qhead = (int*)(p.ws + OFF_BAR) + Q_WORD0 + 64 * (l + 2 * p.probe_rep);
#ifdef EMU
      volatile int* bc = (volatile int*)(smem + SMEM_BYTES + 8);
#else
      volatile LAS int* bc = (volatile LAS int*)(smem + SMEM_BYTES + 8);
#endif
      for (;;) {
        __syncthreads();
        if (tid_() == 0) {
#ifdef EMU
          *bc = atomicAdd(qhead, 1);
#else
          *bc = __hip_atomic_fetch_add(qhead, 1, __ATOMIC_RELAXED, __HIP_MEMORY_SCOPE_AGENT);
#endif
        }
        __syncthreads();
        const int it = *bc;
        if (it >= n5) break;
        if (it < n0) m2scan_item(p, L, it, smem);
        else if (it < n1) s5carry_item(p, L, it - n0);
        else if (it < n2) mla_attn_item(p, it - n1, false, smem);
        else if (it < n3) na_attn_item(p, L, it - n2, false, smem);
        else if (it < n4) mla_attn_item(p, it - n3, true, smem);
        else na_attn_item(p, L, it - n4, true, smem);
      }
    } break;
    case LP_MIX2:
      seg(16 * S5_MT * 2, [&](int it) { s5c_tile(p, L, it, smem); });
      seg(NTOK / NWAVES, [&](int it) { m2gate_item(p, L, it); });
      break;
    case LP_GLU:
      seg(GLU_MT * 2, [&](int it) { glu_tile(p, L, it, smem); });
      break;
    case LP_MERGE:
      seg(mtiles(L.last, 256) * 8, [&](int it) { merge_tile(p, L, it, smem); });
      break;
    case LP_OUT:
      seg(mtiles(L.last, 256) * 4, [&](int it) { outproj_tile(p, L, it, smem); });
      break;
    case LP_POST:
      seg(CT_EXP, [&](int it) { conv_expert_item(p, l, it, smem); });
      post_stage_router(p, L, smem);
      post_phase(p, L, smem);
      break;
    case LP_ROUTE:
      seg(BATCH * 16 * (L.last ? 1 : 2), [&](int it) { route_item(p, L, it, smem); });
      break;
    case LP_MOE1:
      seg(NE * (((L.last ? ESLOTS_L : ESLOTS) + 255) / 256) * 8, [&](int it) { moe1_tile(p, L, it, smem); });
      break;
    case LP_MOE2:
      seg(((NE * (((L.last ? ESLOTS_L : ESLOTS) + 255) / 256) + 1) / 2) * 8, [&](int it) { moe2_tile(p, L, it, smem); });
      break;
    case LP_COMB:
      comb_phase(p, L);
      break;
  }
}

__global__ void __launch_bounds__(NTHREADS, 2) mega_kernel(Params p) {
#ifdef EMU
  char* smem = emu_cur_f->blk->smem;
  for (int ph = p.phase_lo; ph < p.phase_hi; ++ph) {
    run_phase(p, ph, smem);
    if (ph + 1 < p.phase_hi) emu_grid_sync();
  }
#else
  __shared__ __attribute__((aligned(16))) char smem[SMEM_BYTES + 16 + 256];
  {
    const unsigned hw = (unsigned)__builtin_amdgcn_s_getreg((5 << 11) | 4) & 0x3fu;
    if ((threadIdx.x & 63) == 0) *(volatile int*)(smem + WAVE_TAB_OFF + hw * 4u) = (int)(threadIdx.x >> 6);
    __syncthreads();
  }
  if (p.phase_hi - p.phase_lo > 1) {
    if (threadIdx.x == 0) *(uint4*)(smem + SMEM_BYTES) = make_uint4(0u, 0u, 0u, 0u);
    __syncthreads();
    XcdBarrier xb = xcd_barrier_post((unsigned*)(p.ws + OFF_BAR), (volatile LAS unsigned*)(smem + SMEM_BYTES));
    for (int ph = p.phase_lo; ph < p.phase_hi; ++ph) {
      int reps = 1;
#ifdef PROBE_PHASE
      if (ph == PROBE_PHASE || ph == PROBE_PHASE2) reps = 1 + PROBE_REP;
#endif
      for (int rep = 0; rep < reps; ++rep) {
        p.probe_rep = rep;
        run_phase(p, ph, smem);
        if (ph + 1 < p.phase_hi || rep + 1 < reps) {
          if (ph == p.phase_lo && rep == 0) cg::this_grid().sync();
          else xcd_barrier(xb);
        }
      }
    }
  } else {
    run_phase(p, p.phase_lo, smem);
  }
#endif
}

#ifndef EMU
extern "C" void kernel_launch(void* const* d_in, const int* in_sizes, int n_in, void* d_out, int out_size, void* d_ws, size_t ws_size,
                              hipStream_t stream) {
  static int grid_blocks = 0;
  if (!grid_blocks) {
    int dev = 0, cus = 0, per_cu = 0;
    hipGetDevice(&dev);
    hipDeviceGetAttribute(&cus, hipDeviceAttributeMultiprocessorCount, dev);
    hipOccupancyMaxActiveBlocksPerMultiprocessor(&per_cu, mega_kernel, NTHREADS, 0);
    if (per_cu > 1) per_cu = 1;
    if (per_cu < 1) per_cu = 1;
    grid_blocks = cus * per_cu;
    if (ws_size < WS_TOTAL) fprintf(stderr, "workspace too small: %zu < %zu\n", ws_size, (size_t)WS_TOTAL);
  }
  Params p{};
  for (int i = 0; i < N_INPUTS; ++i) p.in[i] = (const float*)d_in[i];
  p.out = (float*)d_out;
  p.ws = (char*)d_ws;
#if MK_MULTI
  for (int ph = 0; ph < NPHASES; ++ph) {
    p.phase_lo = ph; p.phase_hi = ph + 1;
    hipLaunchKernelGGL(mega_kernel, dim3(grid_blocks), dim3(NTHREADS), 0, stream, p);
  }
#else
  p.phase_lo = 0; p.phase_hi = NPHASES;
  hipMemsetAsync((char*)d_ws + OFF_BAR, 0, BAR_BYTES, stream);
  void* args[] = {&p};
  hipError_t e = hipLaunchCooperativeKernel((void*)mega_kernel, dim3(grid_blocks), dim3(NTHREADS), args, 0, stream);
  if (e != hipSuccess) fprintf(stderr, "cooperative launch failed: %s (grid %d)\n", hipGetErrorString(e), grid_blocks);
#endif
}
#endif
```

```cpp
#ifdef EMU
#include "emu.h"
#else
#include <hip/hip_runtime.h>
#include <hip/hip_cooperative_groups.h>
#include <cstdio>
namespace cg = cooperative_groups;
using bf16x8 = __attribute__((ext_vector_type(8))) short;
using f32x4 = __attribute__((ext_vector_type(4))) float;
using f32x16 = __attribute__((ext_vector_type(16))) float;
#endif
using u32x4 = __attribute__((ext_vector_type(4))) unsigned;
#ifndef MK_MULTI
#define MK_MULTI 0
#endif

#define DI __device__ __forceinline__
typedef unsigned short bf16;

#ifdef EMU_SMALL2
constexpr int BATCH = 2, SEQ = 1024, CTXL = 64, GRID_W = 32;
#elif defined(EMU_SMALL)
constexpr int BATCH = 2, SEQ = 512, CTXL = 64, GRID_W = 32;
#else
constexpr int BATCH = 8, SEQ = 2048, CTXL = 256, GRID_W = 64;
#endif
constexpr int D = 1024, DEPTH = 2;
constexpr int TOK = CTXL + SEQ, NTOK = BATCH * TOK;
constexpr int ROWS = SEQ / GRID_W;
constexpr int WIN_R = (ROWS < 8 ? ROWS : 8), WIN_C = 16;
constexpr int N_IN = 6568, N_INP = 6656;
constexpr int C_CQ = 0, C_CKV = 256, C_KR = 384, C_NA = 416, C_S5 = 1184, C_Z = 1440, C_XBC = 1696, C_DT = 2464, C_GATE = 2472;
constexpr int P1W = 2480;
constexpr int NCH = TOK / 16, NCC = CTXL / 16, MCH = BATCH * NCH;
constexpr int NE = 16;
constexpr int CAP_L = 2 * SEQ / NE, CAP_C = 2 * CTXL / NE;
constexpr int ESLOTS = BATCH * (CAP_L + CAP_C), ESLOTS_L = BATCH * CAP_L;
constexpr int NB1 = BATCH + 1;
constexpr float EPS = 1e-6f;
constexpr int SMEM_BYTES = 147456;
constexpr int NTHREADS = 512, NWAVES = NTHREADS / 64;

enum { I_X = 0, I_C, I_CTX, I_CCTX, I_WADA, I_BADA, I_GPREMIX, I_GPOSTMIX, I_GPREFFN, I_GPOSTFFN, I_WIN, I_GCQ, I_GCKV, I_WUQ, I_WUKV, I_RPB,
       I_S5ARE, I_S5AIM, I_S5LOGSTEP, I_S5BRE, I_S5BIM, I_S5CRE, I_S5CIM, I_S5D, I_S5WGLU, I_S5BGLU, I_M2CONVW, I_M2CONVB, I_M2ALOG, I_M2DTBIAS,
       I_M2D, I_M2GNORM, I_WBRANCH, I_WOUT, I_WROUTER, I_WGATE, I_WUP, I_WDOWN, N_INPUTS };

constexpr size_t al256(size_t x) { return (x + 255) & ~(size_t)255; }
constexpr size_t SZ_X = (size_t)NTOK * D * 4;
constexpr size_t SZ_ROWBF = (size_t)NTOK * D * 2;
constexpr size_t OFF_X = 0;
constexpr size_t OFF_MOD = OFF_X + al256(SZ_X);
constexpr size_t OFF_HA = OFF_MOD + al256((size_t)DEPTH * NB1 * 6144 * 4);
constexpr size_t OFF_O = OFF_HA + al256(SZ_ROWBF);
constexpr size_t OFF_P1 = OFF_O + al256(SZ_ROWBF);
constexpr size_t SZ_P1 = (size_t)NTOK * P1W * 2;
constexpr size_t OFF_PG = OFF_P1 + al256(SZ_P1);
constexpr size_t SZ_PG = (size_t)NTOK * 4096 * 2;
constexpr size_t OFF_DT = OFF_PG + al256(SZ_PG);
constexpr size_t OFF_AFF = OFF_DT + al256((size_t)NTOK * 8 * 4);
constexpr size_t OFF_SEL = OFF_AFF + al256((size_t)NTOK * 16 * 4);
constexpr size_t OFF_IDX = OFF_SEL + al256((size_t)NTOK * 16 * 4);
constexpr size_t OFF_GW = OFF_IDX + al256((size_t)NE * ESLOTS * 4);
constexpr size_t OFF_BAR = OFF_GW + al256((size_t)NE * ESLOTS * 4);
constexpr size_t BAR_BYTES = (3456 + 64 * 4) * 4;
constexpr int Q_WORD0 = 3456;
constexpr size_t OFF_ROPE = OFF_BAR + al256(BAR_BYTES);
constexpr size_t OFF_WEARLY = OFF_ROPE + al256(64 * 8 * 2 * 4);
constexpr size_t WE_WIN = 0;
constexpr size_t WE_UQ = WE_WIN + (size_t)N_INP * 1024 * 2;
constexpr size_t WE_UKV = WE_UQ + (size_t)384 * 256 * 2;
constexpr size_t WE_GLU = WE_UKV + (size_t)512 * 128 * 2;
constexpr size_t WE_WB = WE_GLU + (size_t)256 * 256 * 2;
constexpr size_t WE_WOUT = WE_WB + (size_t)4 * 1024 * 256 * 2;
constexpr size_t WE_SIZE = al256(WE_WOUT + (size_t)1024 * 1024 * 2);
constexpr size_t OFF_S5TAB = OFF_WEARLY + DEPTH * WE_SIZE;
constexpr size_t S5_LAMPOW = 0;
constexpr size_t S5_BBAR = S5_LAMPOW + (size_t)2 * 16 * 17 * 64 * 2 * 4;
constexpr size_t S5_KT = S5_BBAR + (size_t)2 * 16 * 64 * 16 * 2 * 4;
constexpr size_t S5_WA = S5_KT + (size_t)2 * 16 * 16 * 256 * 4;
constexpr size_t S5_W2 = S5_WA + (size_t)16 * 256 * 256 * 2;
constexpr size_t S5_SIZE = al256(S5_W2 + (size_t)16 * 256 * 512 * 2);
constexpr size_t OFF_MIX = OFF_S5TAB + DEPTH * S5_SIZE;
constexpr size_t MX_Q = 0;
constexpr size_t MX_K = MX_Q + al256((size_t)BATCH * 4 * TOK * 96 * 2);
constexpr size_t MX_VTM = MX_K + al256((size_t)BATCH * 4 * TOK * 96 * 2);
constexpr size_t MX_VTN = MX_VTM + al256((size_t)BATCH * 4 * 64 * TOK * 2);
constexpr size_t MX_XBC = MX_VTN + al256((size_t)BATCH * 4 * 64 * TOK * 2);
constexpr size_t MX_US5 = MX_XBC + al256((size_t)NTOK * 768 * 2);
constexpr size_t MX_HEND = MX_US5 + al256((size_t)NTOK * 256 * 2);
constexpr size_t MX_HIN = MX_HEND + al256((size_t)16 * MCH * 256 * 4);
constexpr size_t MX_Z = MX_HIN + al256((size_t)16 * MCH * 256 * 2);
constexpr size_t MX_XBT = MX_Z + al256((size_t)NTOK * 256 * 2);
constexpr size_t MX_M2S = MX_XBT + al256((size_t)NTOK * 512 * 2);
constexpr size_t MX_SIZE = MX_M2S + al256((size_t)BATCH * 8 * TOK * 4 * 4);
constexpr size_t WX_GU = 0;
constexpr size_t WX_DN = WX_GU + (size_t)NE * 2048 * 1024 * 2;
constexpr size_t WX_SIZE = WX_DN + (size_t)NE * 1024 * 1024 * 2;
constexpr size_t MIXREG = (MX_SIZE > WX_SIZE ? MX_SIZE : WX_SIZE);
constexpr size_t WS_TOTAL = OFF_MIX + al256(MIXREG);

struct Params {
  const float* in[N_INPUTS];
  float* out;
  char* ws;
  int phase_lo, phase_hi;
  int probe_rep, pad_;
};

constexpr int WAVE_TAB_OFF = SMEM_BYTES + 16;
DI int tid_() {
#ifdef EMU
  return (int)threadIdx.x;
#else
  const unsigned hw = (unsigned)__builtin_amdgcn_s_getreg((5 << 11) | 4) & 0x3fu;
  const int wave = *(volatile __attribute__((address_space(3))) int*)(unsigned long)(WAVE_TAB_OFF + hw * 4u);
  int lane;
  asm volatile("v_mbcnt_lo_u32_b32 %0, -1, 0\n\tv_mbcnt_hi_u32_b32 %0, -1, %0" : "=v"(lane));
  return wave * 64 + lane;
#endif
}
#ifdef EMU
template <class T> DI T shfl_xor_(T v, int m) { return __shfl_xor(v, m); }
template <class T> DI T shfl_up_(T v, int d) { return __shfl_up(v, d); }
template <class T> DI T shfl_(T v, int src) { return __shfl(v, src); }
#else
template <class T> DI T shfl_xor_(T v, int m) {
  const int idx = ((tid_() & 63) ^ m) << 2;
  return __builtin_bit_cast(T, __builtin_amdgcn_ds_bpermute(idx, __builtin_bit_cast(int, v)));
}
template <class T> DI T shfl_up_(T v, int d) {
  const int l = tid_() & 63; const int idx = (l >= d ? l - d : l) << 2;
  return __builtin_bit_cast(T, __builtin_amdgcn_ds_bpermute(idx, __builtin_bit_cast(int, v)));
}
template <class T> DI T shfl_(T v, int src) {
  int idx = src << 2; asm volatile("" : "+v"(idx));
  return __builtin_bit_cast(T, __builtin_amdgcn_ds_bpermute(idx, __builtin_bit_cast(int, v)));
}
#endif
DI float bf2f(bf16 h) { return __uint_as_float(((unsigned)h) << 16); }
DI bf16 f2bf(float f) { unsigned u = __float_as_uint(f); u += 0x7fffu + ((u >> 16) & 1u); return (bf16)(u >> 16); }
#ifdef EMU
DI unsigned pack2(float a, float b) { return (unsigned)f2bf(a) | ((unsigned)f2bf(b) << 16); }
DI float exp2f_(float x) { return exp2f(x); }
#else
typedef float f32x2_t_ __attribute__((ext_vector_type(2)));
typedef __bf16 bf16x2_t_ __attribute__((ext_vector_type(2)));
DI unsigned pack2(float a, float b) { const f32x2_t_ v = {a, b}; return __builtin_bit_cast(unsigned, __builtin_convertvector(v, bf16x2_t_)); }
DI float exp2f_(float x) { return __builtin_amdgcn_exp2f(x); }
#endif
DI float sigmoidf_(float x) { return 1.0f / (1.0f + __expf(-x)); }
DI float siluf_(float x) { return x / (1.0f + __expf(-x)); }
DI float softplusf_(float x) { const float ax = x < 0.f ? -x : x; return (x > 0.f ? x : 0.f) + __logf(1.0f + __expf(-ax)); }
DI float geluf_(float x) { const float u2 = 1.5957691216057308f * (x + 0.044715f * x * x * x); return x / (1.0f + __expf(-u2)); }
DI bool wave_all_(bool c) {
#ifdef EMU
  int v = c ? 0 : 1;
  v += shfl_xor_(v, 32); v += shfl_xor_(v, 16); v += shfl_xor_(v, 8); v += shfl_xor_(v, 4); v += shfl_xor_(v, 2); v += shfl_xor_(v, 1);
  return v == 0;
#else
  return __builtin_amdgcn_ballot_w64(!c) == 0ull;
#endif
}
DI float wave_sum(float v) {
#ifdef EMU
  v += shfl_xor_(v, 32); v += shfl_xor_(v, 16); v += shfl_xor_(v, 8); v += shfl_xor_(v, 4); v += shfl_xor_(v, 2); v += shfl_xor_(v, 1);
  return v;
#else
  int x = __float_as_int(v);
  x = __float_as_int(__int_as_float(x) + __int_as_float(__builtin_amdgcn_update_dpp(0, x, 0xB1, 0xF, 0xF, true)));
  x = __float_as_int(__int_as_float(x) + __int_as_float(__builtin_amdgcn_update_dpp(0, x, 0x4E, 0xF, 0xF, true)));
  x = __float_as_int(__int_as_float(x) + __int_as_float(__builtin_amdgcn_update_dpp(0, x, 0x141, 0xF, 0xF, true)));
  x = __float_as_int(__int_as_float(x) + __int_as_float(__builtin_amdgcn_update_dpp(0, x, 0x140, 0xF, 0xF, true)));
  const float r0 = __int_as_float(__builtin_amdgcn_readlane(x, 0)), r1 = __int_as_float(__builtin_amdgcn_readlane(x, 16));
  const float r2 = __int_as_float(__builtin_amdgcn_readlane(x, 32)), r3 = __int_as_float(__builtin_amdgcn_readlane(x, 48));
  return (r0 + r1) + (r2 + r3);
#endif
}
#ifndef EMU
#define XB_TMO      128
#define XB_XCNT(j)  (256  + 64 * (j))
#define XB_XSUB(j)  (1280 + 64 * (j))
#define XB_XGEN(j)  (2304 + 64 * (j))
#define XB_TOP      3328
#define XB_TOPGEN   3392
#define XB_SPIN_CAP (1u << 24)
#define LAS __attribute__((address_space(3)))
DI unsigned xb_ld(unsigned* p) { return __hip_atomic_load(p, __ATOMIC_RELAXED, __HIP_MEMORY_SCOPE_AGENT); }
DI unsigned xb_add(unsigned* p, unsigned v) { return __hip_atomic_fetch_add(p, v, __ATOMIC_RELAXED, __HIP_MEMORY_SCOPE_AGENT); }
DI unsigned xb_xcc_id() { return (unsigned)__builtin_amdgcn_s_getreg((3 << 11) | 20) & 0xFu; }
#define XB_SPIN(cond, bar) do { unsigned _sp = 0; while (cond) { __builtin_amdgcn_s_sleep(1); \
    if ((++_sp & 255u) == 0u) { if (xb_ld(&(bar)[XB_TMO])) break; if (_sp > XB_SPIN_CAP) { atomicAdd(&(bar)[XB_TMO], 1u); break; } } } } while (0)
struct XcdBarrier { unsigned* bar; unsigned x; volatile LAS unsigned* st; };
DI XcdBarrier xcd_barrier_post(unsigned* bar, volatile LAS unsigned* st) {
  XcdBarrier b; b.bar = bar; b.x = xb_xcc_id(); b.st = st;
  if (threadIdx.x == 0) (void)xb_add(&bar[XB_XCNT(b.x)], 1u);
  return b;
}
DI void xcd_barrier_complete(unsigned* bar, unsigned x, unsigned& nloc, unsigned& nx) {
  const unsigned G = gridDim.x * gridDim.y * gridDim.z;
  unsigned sum, cnt, mine, sp = 0u;
  for (;;) {
    sum = 0u; cnt = 0u; mine = 0u;
#pragma unroll
    for (unsigned j = 0; j < 16; ++j) { const unsigned c = xb_ld(&bar[XB_XCNT(j)]); sum += c; cnt += (c > 0u) ? 1u : 0u; mine = (j == x) ? c : mine; }
    if (sum == G) break;
    __builtin_amdgcn_s_sleep(1);
    if ((++sp & 255u) == 0u) { if (xb_ld(&bar[XB_TMO])) break; if (sp > XB_SPIN_CAP) { atomicAdd(&bar[XB_TMO], 1u); break; } }
  }
  nloc = mine > 0u ? mine : 1u; nx = cnt > 0u ? cnt : 1u;
}
DI void xcd_barrier(const XcdBarrier& b) {
  asm volatile("s_waitcnt vmcnt(0)" ::: "memory");
  __syncthreads();
  if (threadIdx.x == 0) {
    unsigned* bar = b.bar;
    __builtin_amdgcn_s_waitcnt(0);
    unsigned nloc = b.st[0], nx = b.st[1];
    if (nloc == 0u) { xcd_barrier_complete(bar, b.x, nloc, nx); b.st[0] = nloc; b.st[1] = nx; }
    const unsigned old = xb_add(&bar[XB_XSUB(b.x)], 1u);
    const unsigned gen = old / nloc;
    if (old + 1u == (gen + 1u) * nloc) {
      __builtin_amdgcn_fence(__ATOMIC_RELEASE, "agent");
      asm volatile("s_waitcnt vmcnt(0)" ::: "memory");
      const unsigned og = xb_add(&bar[XB_TOP], 1u);
      const unsigned tg = og / nx;
      if (og + 1u == (tg + 1u) * nx) xb_add(&bar[XB_TOPGEN], 1u);
      else XB_SPIN(xb_ld(&bar[XB_TOPGEN]) == tg, bar);
      __builtin_amdgcn_fence(__ATOMIC_ACQUIRE, "agent");
      xb_add(&bar[XB_XGEN(b.x)], 1u);
      asm volatile("s_waitcnt vmcnt(0)" ::: "memory");
    } else {
      XB_SPIN(xb_ld(&bar[XB_XGEN(b.x)]) == gen, bar);
      __builtin_amdgcn_fence(__ATOMIC_ACQUIRE, "agent");
      asm volatile("s_waitcnt vmcnt(0)" ::: "memory");
    }
  }
  __syncthreads();
}
#endif

struct GA {
  const bf16* A; const bf16* A2; int lda, lda2, ksplit;
  const int* ridx; int mvalid;
  const bf16* Bt; int ldb; int K;
  int kfix;
};
DI GA make_ga(const bf16* A, int lda, const bf16* Bt, int ldb, int K, int mvalid) {
  GA g; g.A = A; g.A2 = A; g.lda = lda; g.lda2 = lda; g.ksplit = K; g.ridx = nullptr; g.mvalid = mvalid; g.Bt = Bt; g.ldb = ldb; g.K = K; g.kfix = 0; return g;
}

#ifdef EMU
#define GLDS16(gptr_, lptr_) memcpy((void*)(lptr_), (const void*)(gptr_), 16)
#define BGLDS16(rsrc_, base_, voff_, soff_, lptr_) memcpy((void*)(lptr_), (const char*)(base_) + (voff_) + (soff_), 16)
#define GEMM_WAIT(N_)
#define RAW_BARRIER() __syncthreads()
#else
#define LASV __attribute__((address_space(3))) void
#define GLDS16(gptr_, lptr_) __builtin_amdgcn_global_load_lds((const void*)(gptr_), (LASV*)(lptr_), 16, 0, 0)
#define BGLDS16(rsrc_, base_, voff_, soff_, lptr_) __builtin_amdgcn_raw_ptr_buffer_load_lds(rsrc_, (LASV*)(lptr_), 16, (int)(voff_), (int)(soff_), 0, 0)
#define GEMM_WAIT(N_) asm volatile("s_waitcnt vmcnt(%0)" :: "n"(N_) : "memory")
#define RAW_BARRIER() { asm volatile("" ::: "memory"); __builtin_amdgcn_s_barrier(); asm volatile("" ::: "memory"); }
#endif
DI int perm32(int rho) { const int n = rho >> 4, i = rho & 15; return 8 * (i >> 2) + 4 * n + (i & 3); }
constexpr int SRS_OFF = 73728;
template <int NT>
DI void gemm_s(const GA& g, int m0, int n0, char* smem, f32x4 (&acc)[4][NT]) {
  constexpr int A_ELEMS = 256 * 32, B_ELEMS = 32 * NT * 32, STAGE = A_ELEMS + B_ELEMS;
  bf16* st = (bf16*)smem;
  const int tid = tid_(), lane = tid & 63, wid = tid >> 6, wr = wid >> 1, wc = wid & 1, fr = lane & 15, fq = lane >> 4;
  const int lrow = tid >> 2, pch = tid & 3;
  long aoff[2], aoff2[2], boff;
#pragma unroll
  for (int i = 0; i < 2; ++i) {
    const int row = lrow + 128 * i;
    const int lch = pch ^ ((-(row >> 2)) & 3);
    int gm = m0 + row; if (gm > g.mvalid - 1) gm = g.mvalid - 1;
    const int ar = g.ridx ? g.ridx[gm] : gm;
    aoff[i] = (long)ar * g.lda + lch * 8;
    aoff2[i] = (long)ar * g.lda2 + lch * 8;
  }
  const int cb = (NT == 4) ? tid : (tid & 255);
  {
    const int row = cb >> 2;
    const int lch = pch ^ ((-(row >> 2)) & 3);
    const int src = n0 + (row & ~31) + perm32(row & 31);
    boff = (long)src * g.ldb + lch * 8;
  }
#pragma unroll
  for (int m = 0; m < 4; ++m)
#pragma unroll
    for (int n = 0; n < NT; ++n) acc[m][n] = f32x4{0.f, 0.f, 0.f, 0.f};
  const int T = g.K / 32;
#define GEMM_DMA(t_, stg_) { const int k0_ = (t_) * 32; const bool seg2_ = (k0_ >= g.ksplit); bf16* sa_ = st + (stg_) * STAGE; \
    _Pragma("unroll") for (int i_ = 0; i_ < 2; ++i_) { \
      const bf16* ap_ = seg2_ ? (g.A2 + aoff2[i_] + (k0_ - g.ksplit)) : (g.A + aoff[i_] + k0_); \
      GLDS16(ap_, sa_ + (tid + i_ * 512) * 8); } \
    GLDS16(g.Bt + boff + k0_, sa_ + A_ELEMS + cb * 8); }
  __syncthreads();
  GEMM_DMA(0, 0)
  if (T > 1) GEMM_DMA(1, 1)
  int s_cur = 0, s_nxt = 2;
#pragma unroll 1
  for (int t = 0; t < T; ++t) {
    if (t + 1 < T) { GEMM_WAIT(3); } else { GEMM_WAIT(0); }
    RAW_BARRIER();
    if (t + 2 < T) GEMM_DMA(t + 2, s_nxt)
    const bf16* sa = st + s_cur * STAGE;
    const bf16* sb = sa + A_ELEMS;
    bf16x8 af[4], bfr[NT];
#pragma unroll
    for (int n = 0; n < NT; ++n) {
      const int row = wc * (16 * NT) + n * 16 + fr;
      bfr[n] = *(const bf16x8*)(sb + row * 32 + ((fq ^ ((-(row >> 2)) & 3)) << 3));
    }
#pragma unroll
    for (int m = 0; m < 4; ++m) {
      const int row = wr * 64 + m * 16 + fr;
      af[m] = *(const bf16x8*)(sa + row * 32 + ((fq ^ ((-(row >> 2)) & 3)) << 3));
    }
#pragma unroll
    for (int m = 0; m < 4; ++m)
#pragma unroll
      for (int n = 0; n < NT; ++n) acc[m][n] = __builtin_amdgcn_mfma_f32_16x16x32_bf16(bfr[n], af[m], acc[m][n], 0, 0, 0);
    s_cur = (s_cur == 2) ? 0 : s_cur + 1;
    s_nxt = (s_nxt == 2) ? 0 : s_nxt + 1;
  }
}
constexpr int BG_HT = 128 * 64;
DI int lds_byte(int r, int c) { const int stt = (r >> 4) * 2 + (c >> 5), rr = r & 15, cc = c & 31, ob = rr * 64 + cc * 2; return stt * 1024 + (ob ^ (((ob >> 9) & 1) << 5)); }
DI void stage_rc(int b, int& R, int& C) { const int stt = b / 1024, sb = b % 1024, swz = sb ^ (((sb >> 9) & 1) << 5); R = (stt >> 1) * 16 + swz / 64; C = (stt & 1) * 32 + (swz % 64) / 2; }
#ifdef EMU
#define BG_WAIT_V(n)
#define BG_WAIT_L(n)
#define BG_BAR __syncthreads()
#define BG_SCHED
#define BG_PRIO(x)
#else
#define BG_WAIT_V(n) asm volatile("s_waitcnt vmcnt(" #n ")" ::: "memory")
#define BG_WAIT_L(n) asm volatile("s_waitcnt lgkmcnt(" #n ")" ::: "memory")
#define BG_BAR __builtin_amdgcn_s_barrier()
#define BG_SCHED __builtin_amdgcn_sched_barrier(0)
#define BG_PRIO(x) __builtin_amdgcn_s_setprio(x)
#endif
DI void gemm_big(const GA& g, int m0, int n0, char* smem, f32x4 (&acc)[2][2][4][2]) {
  bf16* shm = (bf16*)smem;
  const int tid = tid_(), wid = tid >> 6, lane = tid & 63, wr = wid >> 2, wc = wid & 3, fr = lane & 15, fq = lane >> 4;
  unsigned aof[2][2], bof[2];
#ifdef EMU
  const int dma_lds = tid * 16;
#else
  const int dma_lds = __builtin_amdgcn_readfirstlane(tid >> 6) * 1024;
#endif
#ifndef EMU
  const __amdgpu_buffer_rsrc_t rsA = __builtin_amdgcn_make_buffer_rsrc((void*)g.A, 0, 0x7fffffff, 0x00020000);
  const __amdgpu_buffer_rsrc_t rsB = __builtin_amdgcn_make_buffer_rsrc((void*)g.Bt, 0, 0x7fffffff, 0x00020000);
#endif
#pragma unroll
  for (int i = 0; i < 2; ++i) {
    int R, C; stage_rc(tid * 16 + i * 8192, R, C);
    bof[i] = (unsigned)((n0 + (R & ~31) + perm32(R & 31)) * g.ldb + C) * 2u;
#pragma unroll
    for (int h = 0; h < 2; ++h) {
      int gm = m0 + h * 128 + R; if (gm > g.mvalid - 1) gm = g.mvalid - 1;
      const int ar = g.ridx ? g.ridx[gm] : gm;
      aof[h][i] = (unsigned)(ar * g.lda + C) * 2u;
    }
  }
#define BG_SA(b, h) (shm + ((b) * 2 + (h)) * BG_HT)
#define BG_SB(b, h) (shm + (4 + (b) * 2 + (h)) * BG_HT)
#define BG_STAGE_A(P, h, kt) { \
    _Pragma("unroll") for (int i_ = 0; i_ < 2; ++i_) BGLDS16(rsA, g.A, aof[h][i_], (kt) * 128, (char*)(P) + dma_lds + i_ * 8192); }
#define BG_STAGE_B(P, h, kt) { \
    _Pragma("unroll") for (int i_ = 0; i_ < 2; ++i_) BGLDS16(rsB, g.Bt, bof[i_], (kt) * 128 + (h) * 256 * g.ldb, (char*)(P) + dma_lds + i_ * 8192); }
#define BG_LDA(dst, b, h) _Pragma("unroll") for (int m_ = 0; m_ < 4; ++m_) _Pragma("unroll") for (int k_ = 0; k_ < 2; ++k_) \
    dst[m_][k_] = *(const bf16x8*)((const char*)BG_SA(b, h) + lds_byte(wr * 64 + m_ * 16 + fr, k_ * 32 + fq * 8))
#define BG_LDB(dst, b, h) _Pragma("unroll") for (int n_ = 0; n_ < 2; ++n_) _Pragma("unroll") for (int k_ = 0; k_ < 2; ++k_) \
    dst[n_][k_] = *(const bf16x8*)((const char*)BG_SB(b, h) + lds_byte(wc * 32 + n_ * 16 + fr, k_ * 32 + fq * 8))
#define BG_MMA(ai, bj, At_, Bt_) { BG_PRIO(1); \
    _Pragma("unroll") for (int m_ = 0; m_ < 4; ++m_) _Pragma("unroll") for (int n_ = 0; n_ < 2; ++n_) _Pragma("unroll") for (int k_ = 0; k_ < 2; ++k_) \
      acc[ai][bj][m_][n_] = __builtin_amdgcn_mfma_f32_16x16x32_bf16(Bt_[n_][k_], At_[m_][k_], acc[ai][bj][m_][n_], 0, 0, 0); \
    BG_PRIO(0); }
#pragma unroll
  for (int a_ = 0; a_ < 2; ++a_)
#pragma unroll
    for (int b_ = 0; b_ < 2; ++b_)
#pragma unroll
      for (int m_ = 0; m_ < 4; ++m_)
#pragma unroll
        for (int n_ = 0; n_ < 2; ++n_) acc[a_][b_][m_][n_] = f32x4{0.f, 0.f, 0.f, 0.f};
  bf16x8 At[4][2], B0[2][2], B1[2][2];
  const int nt = g.K / 64;
  __syncthreads();
  BG_STAGE_B(BG_SB(0, 0), 0, 0) BG_STAGE_A(BG_SA(0, 0), 0, 0)
  BG_STAGE_B(BG_SB(0, 1), 1, 0) BG_STAGE_A(BG_SA(0, 1), 1, 0)
  if (wr == 1) BG_BAR;
  BG_WAIT_V(4); BG_BAR;
  BG_STAGE_B(BG_SB(1, 0), 0, 1) BG_STAGE_A(BG_SA(1, 0), 0, 1) BG_STAGE_B(BG_SB(1, 1), 1, 1)
  BG_WAIT_V(6); BG_BAR;
#pragma unroll 1
  for (int t = 0; t < nt - 2; t += 2) {
    BG_LDB(B0, 0, 0); BG_SCHED; BG_LDA(At, 0, 0); BG_STAGE_A(BG_SA(1, 1), 1, t + 1)
    BG_WAIT_L(8); BG_BAR; BG_WAIT_L(0); BG_MMA(0, 0, At, B0) BG_BAR; BG_SCHED;
    BG_LDB(B1, 0, 1); BG_STAGE_B(BG_SB(0, 0), 0, t + 2)
    BG_BAR; BG_WAIT_L(0); BG_MMA(0, 1, At, B1) BG_BAR;
    BG_LDA(At, 0, 1); BG_STAGE_A(BG_SA(0, 0), 0, t + 2)
    BG_BAR; BG_WAIT_L(0); BG_MMA(1, 0, At, B0) BG_BAR; BG_SCHED;
    BG_STAGE_B(BG_SB(0, 1), 1, t + 2)
    BG_WAIT_V(6); BG_BAR; BG_MMA(1, 1, At, B1) BG_BAR;
    BG_LDB(B0, 1, 0); BG_SCHED; BG_LDA(At, 1, 0); BG_STAGE_A(BG_SA(0, 1), 1, t + 2)
    BG_WAIT_L(8); BG_BAR; BG_WAIT_L(0); BG_MMA(0, 0, At, B0) BG_BAR; BG_SCHED;
    BG_LDB(B1, 1, 1); BG_STAGE_B(BG_SB(1, 0), 0, t + 3)
    BG_BAR; BG_WAIT_L(0); BG_MMA(0, 1, At, B1) BG_BAR;
    BG_LDA(At, 1, 1); BG_STAGE_A(BG_SA(1, 0), 0, t + 3)
    BG_BAR; BG_WAIT_L(0); BG_MMA(1, 0, At, B0) BG_BAR; BG_SCHED;
    BG_STAGE_B(BG_SB(1, 1), 1, t + 3)
    BG_WAIT_V(6); BG_BAR; BG_MMA(1, 1, At, B1) BG_BAR;
  }
  { BG_LDB(B0, 0, 0); BG_LDA(At, 0, 0); BG_STAGE_A(BG_SA(1, 1), 1, nt - 1)
    BG_BAR; BG_WAIT_L(0); BG_MMA(0, 0, At, B0) BG_BAR;
    BG_LDB(B1, 0, 1); BG_BAR; BG_WAIT_L(0); BG_MMA(0, 1, At, B1) BG_BAR;
    BG_LDA(At, 0, 1); BG_WAIT_V(4); BG_BAR; BG_WAIT_L(0); BG_MMA(1, 0, At, B0) BG_MMA(1, 1, At, B1) BG_BAR; }
  { BG_LDB(B0, 1, 0); BG_LDA(At, 1, 0); BG_WAIT_V(2); BG_BAR; BG_WAIT_L(0); BG_MMA(0, 0, At, B0) BG_BAR;
    BG_LDB(B1, 1, 1); BG_WAIT_V(0); BG_BAR; BG_WAIT_L(0); BG_MMA(0, 1, At, B1) BG_BAR;
    BG_LDA(At, 1, 1); BG_BAR; BG_WAIT_L(0); BG_MMA(1, 0, At, B0) BG_MMA(1, 1, At, B1) BG_BAR; }
  if (wr == 0) BG_BAR;
}
#define EPIB_BEGIN(acc_, m0_, n0_, mvalid_) { const int _l = tid_() & 63, _w = tid_() >> 6, _wr = _w >> 2, _wc = _w & 3, _fr = _l & 15, _fq = _l >> 4; \
  _Pragma("unroll") for (int _ai = 0; _ai < 2; ++_ai) _Pragma("unroll") for (int _m = 0; _m < 4; ++_m) { const int row = (m0_) + _ai * 128 + _wr * 64 + _m * 16 + _fr; \
  _Pragma("unroll") for (int _bj = 0; _bj < 2; ++_bj) { const int col = (n0_) + _bj * 128 + _wc * 32 + 8 * _fq; (void)col; \
    float v[8] = {acc_[_ai][_bj][_m][0][0], acc_[_ai][_bj][_m][0][1], acc_[_ai][_bj][_m][0][2], acc_[_ai][_bj][_m][0][3], \
                  acc_[_ai][_bj][_m][1][0], acc_[_ai][_bj][_m][1][1], acc_[_ai][_bj][_m][1][2], acc_[_ai][_bj][_m][1][3]}; \
    if (row < (mvalid_)) {
#define EPIB_END }}}}

DI void ld8bf(const bf16* p, float (&v)[8]) {
  uint4 w = *(const uint4*)p;
  v[0] = __uint_as_float(w.x << 16); v[1] = __uint_as_float(w.x & 0xffff0000u); v[2] = __uint_as_float(w.y << 16); v[3] = __uint_as_float(w.y & 0xffff0000u);
  v[4] = __uint_as_float(w.z << 16); v[5] = __uint_as_float(w.z & 0xffff0000u); v[6] = __uint_as_float(w.w << 16); v[7] = __uint_as_float(w.w & 0xffff0000u);
}
DI void st8bf(bf16* p, const float (&v)[8]) { *(uint4*)p = make_uint4(pack2(v[0], v[1]), pack2(v[2], v[3]), pack2(v[4], v[5]), pack2(v[6], v[7])); }
DI void st8f(float* p, const float (&v)[8]) { *(float4*)p = make_float4(v[0], v[1], v[2], v[3]); *(float4*)(p + 4) = make_float4(v[4], v[5], v[6], v[7]); }
#define EPI_BEGIN(NT_, acc_, m0_, n0_, mvalid_) { const int _l = tid_() & 63, _w = tid_() >> 6, _wr = _w >> 1, _wc = _w & 1, _fr = _l & 15, _fq = _l >> 4; \
  _Pragma("unroll") for (int _m = 0; _m < 4; ++_m) { const int row = (m0_) + _wr * 64 + _m * 16 + _fr; \
  _Pragma("unroll") for (int _q = 0; _q < (NT_) / 2; ++_q) { const int col = (n0_) + _wc * (16 * (NT_)) + _q * 32 + 8 * _fq; (void)col; \
    float v[8] = {acc_[_m][2 * _q][0], acc_[_m][2 * _q][1], acc_[_m][2 * _q][2], acc_[_m][2 * _q][3], \
                  acc_[_m][2 * _q + 1][0], acc_[_m][2 * _q + 1][1], acc_[_m][2 * _q + 1][2], acc_[_m][2 * _q + 1][3]}; \
    if (row < (mvalid_)) {
#define EPI_END }}}}

DI int mtile_row0(int mt, bool latonly, int TH) {
  if (!latonly) return mt * TH;
  const int per = SEQ / TH, b = mt / per, r = mt % per;
  return b * TOK + CTXL + r * TH;
}
DI int mtiles(bool latonly, int TH) { return latonly ? BATCH * (SEQ / TH) : (NTOK + TH - 1) / TH; }

struct LP {
  int l; bool last;
  const float* mod;
  char* we;
  char* s5;
};
DI LP make_lp(const Params& p, int l) {
  LP q; q.l = l; q.last = (l == DEPTH - 1);
  q.mod = (const float*)(p.ws + OFF_MOD) + (size_t)l * NB1 * 6144;
  q.we = p.ws + OFF_WEARLY + (size_t)l * WE_SIZE;
  q.s5 = p.ws + OFF_S5TAB + (size_t)l * S5_SIZE;
  return q;
}

template <class RowMap>
DI void conv_tile(const float* src, int lds, int nsrc, const float* kscale, bf16* dst, int K, int k0, int n0, char* smem, RowMap rowmap, int ndst = 1 << 30) {
  (void)smem;
  const int tid = tid_(), n4 = (tid & 63) * 4, k8 = (tid >> 6) * 8;
  float4 v[8];
  const bool ok = (n0 + n4 < nsrc);
  const float* sp = src + (size_t)(k0 + k8) * lds + n0 + n4;
#pragma unroll
  for (int k = 0; k < 8; ++k) v[k] = ok ? *(const float4*)(sp + (size_t)k * lds) : make_float4(0.f, 0.f, 0.f, 0.f);
  if (kscale) {
#pragma unroll
    for (int k = 0; k < 8; ++k) { const float sc = kscale[k0 + k8 + k]; v[k].x *= sc; v[k].y *= sc; v[k].z *= sc; v[k].w *= sc; }
  }
  float o[8];
#pragma unroll
  for (int k = 0; k < 8; ++k) o[k] = v[k].x;
  if (n0 + n4 + 0 < ndst) st8bf(dst + (size_t)rowmap(n0 + n4 + 0) * K + k0 + k8, o);
#pragma unroll
  for (int k = 0; k < 8; ++k) o[k] = v[k].y;
  if (n0 + n4 + 1 < ndst) st8bf(dst + (size_t)rowmap(n0 + n4 + 1) * K + k0 + k8, o);
#pragma unroll
  for (int k = 0; k < 8; ++k) o[k] = v[k].z;
  if (n0 + n4 + 2 < ndst) st8bf(dst + (size_t)rowmap(n0 + n4 + 2) * K + k0 + k8, o);
#pragma unroll
  for (int k = 0; k < 8; ++k) o[k] = v[k].w;
  if (n0 + n4 + 3 < ndst) st8bf(dst + (size_t)rowmap(n0 + n4 + 3) * K + k0 + k8, o);
}
struct RowId { DI int operator()(int n) const { return n; } };
struct RowGU { int half; DI int operator()(int f) const { return (f >> 7) * 256 + half * 128 + (f & 127); } };

constexpr int CT_WIN = 16 * (N_INP / 256), CT_UQ = 4 * 2, CT_UKV = 2 * 2, CT_GLU = 4, CT_WB = 4 * 16, CT_WOUT = 64;
constexpr int CT_EARLY = CT_WIN + CT_UQ + CT_UKV + CT_GLU + CT_WB + CT_WOUT;
constexpr int CT_EXP = NE * 3 * 64;

DI void conv_early_item(const Params& p, int l, int it, char* smem) {
  char* we = p.ws + OFF_WEARLY + (size_t)l * WE_SIZE;
  if (it < CT_WIN) {
    int kt = it % 16, nt = it / 16;
    conv_tile(p.in[I_WIN] + (size_t)l * 1024 * N_IN, N_IN, N_IN, nullptr, (bf16*)(we + WE_WIN), 1024, kt * 64, nt * 256, smem, RowId());
    return;
  }
  it -= CT_WIN;
  if (it < CT_UQ) {
    int kt = it % 4, nt = it / 4;
    conv_tile(p.in[I_WUQ] + (size_t)l * 256 * 384, 384, 384, p.in[I_GCQ] + l * 256, (bf16*)(we + WE_UQ), 256, kt * 64, nt * 256, smem, RowId(), 384);
    return;
  }
  it -= CT_UQ;
  if (it < CT_UKV) {
    int kt = it % 2, nt = it / 2;
    conv_tile(p.in[I_WUKV] + (size_t)l * 128 * 512, 512, 512, p.in[I_GCKV] + l * 128, (bf16*)(we + WE_UKV), 128, kt * 64, nt * 256, smem, RowId());
    return;
  }
  it -= CT_UKV;
  if (it < CT_GLU) {
    int kt = it;
    conv_tile(p.in[I_S5WGLU] + (size_t)l * 256 * 256, 256, 256, nullptr, (bf16*)(we + WE_GLU), 256, kt * 64, 0, smem, RowId());
    return;
  }
  it -= CT_GLU;
  if (it < CT_WB) {
    int j = it / 16, r = it % 16, kt = r % 4, nt = r / 4;
    conv_tile(p.in[I_WBRANCH] + ((size_t)l * 4 + j) * 256 * 1024, 1024, 1024, nullptr, (bf16*)(we + WE_WB) + (size_t)j * 1024 * 256, 256, kt * 64, nt * 256, smem, RowId());
    return;
  }
  it -= CT_WB;
  {
    int kt = it % 16, nt = it / 16;
    conv_tile(p.in[I_WOUT] + (size_t)l * 1024 * 1024, 1024, 1024, nullptr, (bf16*)(we + WE_WOUT), 1024, kt * 64, nt * 256, smem, RowId());
  }
}
DI void conv_expert_item(const Params& p, int l, int it, char* smem) {
  char* wx = p.ws + OFF_MIX;
  int e = it / 192, r = it % 192, which = r / 64, t = r % 64, kt = t % 16, nt = t / 16;
  size_t eoff = ((size_t)l * NE + e) * 1024 * 1024;
  if (which == 0) { RowGU rm; rm.half = 0; conv_tile(p.in[I_WGATE] + eoff, 1024, 1024, nullptr, (bf16*)(wx + WX_GU) + (size_t)e * 2048 * 1024, 1024, kt * 64, nt * 256, smem, rm); }
  else if (which == 1) { RowGU rm; rm.half = 1; conv_tile(p.in[I_WUP] + eoff, 1024, 1024, nullptr, (bf16*)(wx + WX_GU) + (size_t)e * 2048 * 1024, 1024, kt * 64, nt * 256, smem, rm); }
  else conv_tile(p.in[I_WDOWN] + eoff, 1024, 1024, nullptr, (bf16*)(wx + WX_DN) + (size_t)e * 1024 * 1024, 1024, kt * 64, nt * 256, smem, RowId());
}

DI void mod_item(const Params& p, int it, char* smem) {
  const int l = it / 96, cg0 = (it % 96) * 64;
  float* sc = (float*)smem;
  float* red = sc + NB1 * 1024;
  const int tid = tid_();
  __syncthreads();
  for (int i = tid; i < NB1 * 1024; i += NTHREADS) {
    int r = i >> 10, k = i & 1023;
    float c = (r < BATCH) ? p.in[I_C][r * 1024 + k] : p.in[I_CCTX][k];
    sc[i] = siluf_(c);
  }
  __syncthreads();
  const int cl = tid & 63, kg = tid >> 6;
  float acc[NB1];
#pragma unroll
  for (int r = 0; r < NB1; ++r) acc[r] = 0.f;
  const float* w = p.in[I_WADA] + (size_t)l * 1024 * 6144 + cg0 + cl;
  for (int k0 = kg * (1024 / NWAVES); k0 < (kg + 1) * (1024 / NWAVES); k0 += 16) {
    float wv[16];
#pragma unroll
    for (int u = 0; u < 16; ++u) wv[u] = w[(size_t)(k0 + u) * 6144];
#pragma unroll
    for (int u = 0; u < 16; ++u)
#pragma unroll
      for (int r = 0; r < NB1; ++r) acc[r] += sc[r * 1024 + k0 + u] * wv[u];
  }
#pragma unroll
  for (int r = 0; r < NB1; ++r) red[(kg * NB1 + r) * 64 + cl] = acc[r];
  __syncthreads();
  for (int i = tid; i < NB1 * 64; i += NTHREADS) {
    int r = i >> 6, c = i & 63;
    float s = 0.f;
#pragma unroll
    for (int q = 0; q < NWAVES; ++q) s += red[(q * NB1 + r) * 64 + c];
    s += p.in[I_BADA][l * 6144 + cg0 + c];
    ((float*)(p.ws + OFF_MOD))[((size_t)l * NB1 + r) * 6144 + cg0 + c] = s;
  }
}

DI void s5_tab_item(const Params& p, int it, char* smem) {
  const int l = it / 32, d = (it / 16) & 1, g = it & 15;
  char* s5 = p.ws + OFF_S5TAB + (size_t)l * S5_SIZE;
  float* lampow = (float*)(s5 + S5_LAMPOW) + (size_t)(d * 16 + g) * 17 * 64 * 2;
  float* bbar = (float*)(s5 + S5_BBAR) + (size_t)(d * 16 + g) * 64 * 16 * 2;
  float* kt = (float*)(s5 + S5_KT) + (size_t)(d * 16 + g) * 16 * 256;
  float* slam = (float*)smem;
  float* sbb = slam + 17 * 64 * 2;
  const int tid = tid_();
  const size_t pg = ((size_t)(l * 2 + d) * 16 + g);
  const float step = expf(p.in[I_S5LOGSTEP][pg]);
  __syncthreads();
  for (int i = tid; i < 17 * 64; i += NTHREADS) {
    int j = i >> 6, pp = i & 63;
    float are = p.in[I_S5ARE][pg * 64 + pp], aim = p.in[I_S5AIM][pg * 64 + pp];
    float mag = expf((float)j * step * are), ang = (float)j * step * aim;
    float re = mag * cosf(ang), im = mag * sinf(ang);
    slam[i * 2] = re; slam[i * 2 + 1] = im; lampow[i * 2] = re; lampow[i * 2 + 1] = im;
  }
  __syncthreads();
  for (int i = tid; i < 64 * 16; i += NTHREADS) {
    int pp = i >> 4;
    float are = p.in[I_S5ARE][pg * 64 + pp], aim = p.in[I_S5AIM][pg * 64 + pp];
    float x = slam[(64 + pp) * 2] - 1.0f, y = slam[(64 + pp) * 2 + 1];
    float den = are * are + aim * aim;
    float qre = (x * are + y * aim) / den, qim = (y * are - x * aim) / den;
    float bre = p.in[I_S5BRE][pg * 1024 + i], bim = p.in[I_S5BIM][pg * 1024 + i];
    float re = qre * bre - qim * bim, im = qre * bim + qim * bre;
    sbb[i * 2] = re; sbb[i * 2 + 1] = im; bbar[i * 2] = re; bbar[i * 2 + 1] = im;
  }
  __syncthreads();
  for (int i = tid; i < 16 * 256; i += NTHREADS) {
    int j = i >> 8, c = (i >> 4) & 15, c2 = i & 15;
    float s = 0.f;
    for (int pp = 0; pp < 64; ++pp) {
      float cre = p.in[I_S5CRE][pg * 1024 + c * 64 + pp], cim = p.in[I_S5CIM][pg * 1024 + c * 64 + pp];
      float lre = slam[(j * 64 + pp) * 2], lim = slam[(j * 64 + pp) * 2 + 1];
      float tre = cre * lre - cim * lim, tim = cre * lim + cim * lre;
      float bre = sbb[(pp * 16 + c2) * 2], bim = sbb[(pp * 16 + c2) * 2 + 1];
      s += tre * bre - tim * bim;
    }
    kt[i] = s;
  }
}
DI void s5_mat_item(const Params& p, int it) {
  const int l = it / 256, g = (it / 16) & 15, q = it & 15;
  char* s5 = p.ws + OFF_S5TAB + (size_t)l * S5_SIZE;
  const float* lampow = (const float*)(s5 + S5_LAMPOW);
  const float* bbar = (const float*)(s5 + S5_BBAR);
  const float* ktab = (const float*)(s5 + S5_KT);
  bf16* WA = (bf16*)(s5 + S5_WA) + (size_t)g * 256 * 256;
  bf16* W2 = (bf16*)(s5 + S5_W2) + (size_t)g * 256 * 512;
  const int tid = tid_();
  for (int i = tid; i < 16 * 256; i += NTHREADS) {
    int n = q * 16 + (i >> 8), k = i & 255;
    int d = n >> 7, ri = (n >> 6) & 1, pp = n & 63, s = k >> 4, c2 = k & 15;
    int e = (d == 0) ? (15 - s) : s;
    const float* lp = lampow + ((size_t)((d * 16 + g) * 17 + e) * 64 + pp) * 2;
    const float* bp = bbar + ((size_t)((d * 16 + g) * 64 + pp) * 16 + c2) * 2;
    float re = lp[0] * bp[0] - lp[1] * bp[1], im = lp[0] * bp[1] + lp[1] * bp[0];
    WA[(size_t)n * 256 + k] = f2bf(ri == 0 ? re : im);
  }
  for (int i = tid; i < 16 * 512; i += NTHREADS) {
    int n = q * 16 + (i >> 9), k = i & 511;
    int lq = n >> 4, c = n & 15;
    float v;
    if (k < 256) {
      int s = k >> 4, c2 = k & 15;
      v = 0.f;
      if (s <= lq) v += ktab[((size_t)(0 * 16 + g) * 16 + (lq - s)) * 256 + c * 16 + c2];
      if (s >= lq) v += ktab[((size_t)(1 * 16 + g) * 16 + (s - lq)) * 256 + c * 16 + c2];
      if (s == lq && c == c2) v += p.in[I_S5D][l * 256 + g * 16 + c];
    } else {
      int kk = k - 256, d = kk >> 7, ri = (kk >> 6) & 1, pp = kk & 63;
      int e = (d == 0) ? (lq + 1) : (16 - lq);
      size_t pg = ((size_t)(l * 2 + d) * 16 + g);
      float cre = p.in[I_S5CRE][pg * 1024 + c * 64 + pp], cim = p.in[I_S5CIM][pg * 1024 + c * 64 + pp];
      const float* lp = lampow + ((size_t)((d * 16 + g) * 17 + e) * 64 + pp) * 2;
      float re = cre * lp[0] - cim * lp[1], im = cre * lp[1] + cim * lp[0];
      v = (ri == 0) ? re : -im;
    }
    W2[(size_t)n * 512 + k] = f2bf(v);
  }
}

DI int tok_b(int tok) { return tok / TOK; }
DI int tok_j(int tok) { return tok % TOK; }
DI int tok_modrow(int tok) { return (tok_j(tok) < CTXL) ? BATCH : tok_b(tok); }

DI void normmod_row(const float (&xv)[16], const float* g, const float* shift, const float* scale, bf16* dst, float (&hout)[16]) {
  const int lane = tid_() & 63;
  float ss = 0.f;
#pragma unroll
  for (int i = 0; i < 16; ++i) ss += xv[i] * xv[i];
  ss = wave_sum(ss);
  const float rs = rsqrtf(ss * (1.0f / 1024.f) + EPS);
#pragma unroll
  for (int i = 0; i < 4; ++i) {
    int c = lane * 4 + i * 256;
    float4 gv = *(const float4*)(g + c), sh = *(const float4*)(shift + c), sc = *(const float4*)(scale + c);
    float h0 = xv[i * 4 + 0] * rs * gv.x * (1.f + sc.x) + sh.x;
    float h1 = xv[i * 4 + 1] * rs * gv.y * (1.f + sc.y) + sh.y;
    float h2 = xv[i * 4 + 2] * rs * gv.z * (1.f + sc.z) + sh.z;
    float h3 = xv[i * 4 + 3] * rs * gv.w * (1.f + sc.w) + sh.w;
    hout[i * 4 + 0] = h0; hout[i * 4 + 1] = h1; hout[i * 4 + 2] = h2; hout[i * 4 + 3] = h3;
    *(uint2*)(dst + c) = make_uint2(pack2(h0, h1), pack2(h2, h3));
  }
}

DI void prep_row_item(const Params& p, int it) {
  const int tok = it * NWAVES + (tid_() >> 6), lane = tid_() & 63;
  const int b = tok_b(tok), j = tok_j(tok);
  const float* src = (j < CTXL) ? p.in[I_CTX] + ((size_t)b * CTXL + j) * 1024 : p.in[I_X] + ((size_t)b * SEQ + (j - CTXL)) * 1024;
  float xv[16], h[16];
#pragma unroll
  for (int i = 0; i < 4; ++i) {
    float4 v = *(const float4*)(src + lane * 4 + i * 256);
    xv[i * 4] = v.x; xv[i * 4 + 1] = v.y; xv[i * 4 + 2] = v.z; xv[i * 4 + 3] = v.w;
  }
  const float* mod = (const float*)(p.ws + OFF_MOD) + (size_t)tok_modrow(tok) * 6144;
  normmod_row(xv, p.in[I_GPREMIX], mod + 0, mod + 1024, (bf16*)(p.ws + OFF_HA) + (size_t)tok * 1024, h);
}

constexpr int IP_LT = BATCH * (SEQ / 256), IP_CT = BATCH * ((CTXL + 255) / 256), IP_MT = IP_LT + IP_CT, IP_NT = N_INP / 256;
constexpr int IP_RR = (IP_MT + 7) / 8, IP_RC = (IP_NT + 1) / 2;
constexpr int IP_RC_NOGATE = (((C_GATE + 255) / 256) + 1) / 2;
constexpr int IP_RR_LAT = IP_LT / 8;
constexpr bool IP_COMPACT = (IP_LT % 8 == 0);
constexpr int IP_RECTS_ALL = IP_RR * IP_RC, IP_RECTS_LAST = IP_COMPACT ? (IP_RR * IP_RC_NOGATE + IP_RR_LAT * (IP_RC - IP_RC_NOGATE)) : IP_RECTS_ALL;
constexpr int IP_SLOTS_ALL = ((IP_RECTS_ALL + 15) / 16) * 256, IP_SLOTS_LAST = ((IP_RECTS_LAST + 15) / 16) * 256;
DI void inproj_tile(const Params& p, const LP& L, int t, char* smem) {
  const int vb = t % 256, vround = t / 256, x = vb % 8, j = vb / 8;
  const int Rc = vround * 16 + x * 2 + (j >> 4), jj = j & 15;
  int rm, rn;
  if (!L.last || !IP_COMPACT || Rc < IP_RR * IP_RC_NOGATE) { rm = Rc % IP_RR; rn = Rc / IP_RR; }
  else { const int q = Rc - IP_RR * IP_RC_NOGATE; rm = q % IP_RR_LAT; rn = IP_RC_NOGATE + q / IP_RR_LAT; }
  const int mt = rm * 8 + (jj & 7), nt = rn * 2 + (jj >> 3);
  if (mt >= IP_MT || nt >= IP_NT || rn >= IP_RC) return;
  int m0;
  if (mt < IP_LT) m0 = (mt / (SEQ / 256)) * TOK + CTXL + (mt % (SEQ / 256)) * 256;
  else { const int c = mt - IP_LT; m0 = (c / ((CTXL + 255) / 256)) * TOK + (c % ((CTXL + 255) / 256)) * 256; }
  const int n0 = nt * 256;
  const int mv = (mt < IP_LT) ? NTOK : (m0 - (m0 % TOK) + CTXL);
  if (L.last && mt >= IP_LT && n0 >= ((C_GATE + 255) / 256) * 256) return;
  GA g = make_ga((const bf16*)(p.ws + OFF_HA), 1024, (const bf16*)(L.we + WE_WIN), 1024, 1024, mv);
  f32x4 acc[2][2][4][2];
  gemm_big(g, m0, n0, smem, acc);
  bf16* P1 = (bf16*)(p.ws + OFF_P1);
  bf16* PG = (bf16*)(p.ws + OFF_PG);
  bf16* US5 = (bf16*)(p.ws + OFF_MIX + MX_US5);
  float* DT = (float*)(p.ws + OFF_DT);
  const float* dtb = p.in[I_M2DTBIAS] + L.l * 8;
  EPIB_BEGIN(acc, m0, n0, mv)
    if (col < C_S5 || (col >= C_Z && col < C_DT)) st8bf(P1 + (size_t)row * P1W + col, v);
    else if (col < C_Z) st8bf(US5 + ((size_t)((col - C_S5) >> 4) * NTOK + row) * 16 + (col & 15), v);
    else if (col < C_GATE) {
#pragma unroll
      for (int k = 0; k < 8; ++k) v[k] = softplusf_(v[k] + dtb[k]);
      st8f(DT + (size_t)row * 8, v);
    } else if (col < N_IN) {
#pragma unroll
      for (int k = 0; k < 8; ++k) v[k] = sigmoidf_(v[k]);
      st8bf(PG + (size_t)row * 4096 + (col - C_GATE), v);
    }
  EPIB_END
}

DI void rowscale_256(const bf16* P1, int m0, int c0, int width, float* srs) {
  const int r = tid_() >> 1, hf = tid_() & 1;
  int gr = m0 + r; if (gr > NTOK - 1) gr = NTOK - 1;
  const bf16* src = P1 + (size_t)gr * P1W + c0 + hf * (width / 2);
  float ss = 0.f;
  for (int i = 0; i < width / 2; i += 8) {
    float v[8]; ld8bf(src + i, v);
#pragma unroll
    for (int k = 0; k < 8; ++k) ss += v[k] * v[k];
  }
  ss += shfl_xor_(ss, 1);
  if (hf == 0) srs[r] = rsqrtf(ss / (float)width + EPS);
}
DI void rope_tab_item(const Params& p) {
  float* tab = (float*)(p.ws + OFF_ROPE);
  for (int i = tid_(); i < 64 * 8; i += NTHREADS) {
    int pos = i >> 3, k = i & 7;
    float f = expf(-(float)k * (9.210340371976184f / 8.0f));
    float a = (float)pos * f;
    tab[i * 2] = cosf(a); tab[i * 2 + 1] = sinf(a);
  }
}
DI void rope_cs(const float* tab, int pos, int i, float& c, float& s) { c = tab[(pos * 8 + i) * 2]; s = tab[(pos * 8 + i) * 2 + 1]; }

constexpr int TP_MT = (NTOK + 255) / 256;
DI void mlaq_tile(const Params& p, const LP& L, int t, char* smem) {
  const int mt = t % TP_MT, nt = t / TP_MT, m0 = mt * 256, n0 = nt * 128;
  const bf16* P1 = (const bf16*)(p.ws + OFF_P1);
  float* srs = (float*)(smem + SRS_OFF);
  GA g = make_ga(P1 + C_CQ, P1W, (const bf16*)(L.we + WE_UQ), 256, 256, NTOK);
  f32x4 acc[4][4];
  gemm_s<4>(g, m0, n0, smem, acc);
  rowscale_256(P1, m0, C_CQ, 256, srs);
  __syncthreads();
  bf16* Q = (bf16*)(p.ws + OFF_MIX + MX_Q);
  const float* ropetab = (const float*)(p.ws + OFF_ROPE);
  {
    const int l = tid_() & 63, w = tid_() >> 6, wr = w >> 1, wc = w & 1, fr = l & 15, fq = l >> 4;
#pragma unroll
    for (int m = 0; m < 4; ++m) {
      const int row = m0 + wr * 64 + m * 16 + fr;
      const int rowc = row < NTOK ? row : NTOK - 1;
      const float rsc = srs[rowc - m0];
      const int b = tok_b(rowc), j = tok_j(rowc);
#pragma unroll
      for (int q = 0; q < 2; ++q) {
        const int col = n0 + wc * 64 + q * 32 + 8 * fq;
        const int h = col / 96, dd = col % 96;
        float v[8] = {acc[m][2 * q][0], acc[m][2 * q][1], acc[m][2 * q][2], acc[m][2 * q][3], acc[m][2 * q + 1][0], acc[m][2 * q + 1][1], acc[m][2 * q + 1][2], acc[m][2 * q + 1][3]};
        float vp[8];
#pragma unroll
        for (int k = 0; k < 8; ++k) vp[k] = shfl_xor_(v[k], 16);
        if (dd >= 64 && j >= CTXL) {
          const int tl = j - CTXL, pos = ((dd - 64) < 16) ? (tl / GRID_W) : (tl % GRID_W);
          const bool lo = ((dd & 8) == 0);
#pragma unroll
          for (int k = 0; k < 8; ++k) {
            float c, sn; rope_cs(ropetab, pos, k, c, sn);
            v[k] = lo ? (v[k] * c - vp[k] * sn) : (v[k] * c + vp[k] * sn);
          }
        }
#pragma unroll
        for (int k = 0; k < 8; ++k) v[k] *= rsc;
        if (row < NTOK) st8bf(Q + (((size_t)b * 4 + h) * TOK + j) * 96 + dd, v);
      }
    }
  }
}
DI void mlakv_tile(const Params& p, const LP& L, int t, char* smem) {
  const int mt = t % TP_MT, h = t / TP_MT, m0 = mt * 256, n0 = h * 128;
  const bf16* P1 = (const bf16*)(p.ws + OFF_P1);
  float* srs = (float*)(smem + SRS_OFF);
  GA g = make_ga(P1 + C_CKV, P1W, (const bf16*)(L.we + WE_UKV), 128, 128, NTOK);
  f32x4 acc[4][4];
  gemm_s<4>(g, m0, n0, smem, acc);
  rowscale_256(P1, m0, C_CKV, 128, srs);
  __syncthreads();
  bf16* K = (bf16*)(p.ws + OFF_MIX + MX_K);
  bf16* VT = (bf16*)(p.ws + OFF_MIX + MX_VTM);
  const float* ropetab = (const float*)(p.ws + OFF_ROPE);
  EPI_BEGIN(4, acc, m0, n0, NTOK)
    const float rsc = srs[row - m0];
    const int b = tok_b(row), j = tok_j(row), dd = col - n0;
#pragma unroll
    for (int k = 0; k < 8; ++k) v[k] *= rsc;
    if (dd < 64) st8bf(K + (((size_t)b * 4 + h) * TOK + j) * 96 + dd, v);
    else {
#pragma unroll
      for (int k = 0; k < 8; ++k) VT[(((size_t)b * 4 + h) * 64 + (dd - 64 + k)) * TOK + j] = f2bf(v[k]);
    }
  EPI_END
  for (int i = tid_(); i < 256 * 16; i += NTHREADS) {
    int r = i >> 4, q = i & 15;
    int row = m0 + r;
    if (row < NTOK) {
      int b = tok_b(row), j = tok_j(row);
      int blk = q >> 3, i8 = q & 7;
      float x1 = bf2f(P1[(size_t)row * P1W + C_KR + blk * 16 + i8]), x2 = bf2f(P1[(size_t)row * P1W + C_KR + blk * 16 + i8 + 8]);
      float o1 = x1, o2 = x2;
      if (j >= CTXL) {
        int tl = j - CTXL, pos = blk == 0 ? (tl / GRID_W) : (tl % GRID_W);
        float c, sn; rope_cs(ropetab, pos, i8, c, sn);
        o1 = x1 * c - x2 * sn; o2 = x2 * c + x1 * sn;
      }
      bf16* kd = K + (((size_t)b * 4 + h) * TOK + j) * 96 + 64 + blk * 16 + i8;
      kd[0] = f2bf(o1); kd[8] = f2bf(o2);
    }
  }
}
DI void navt_item(const Params& p, int it, char* smem) {
  bf16* s = (bf16*)smem;
  const bf16* P1 = (const bf16*)(p.ws + OFF_P1);
  bf16* VT = (bf16*)(p.ws + OFF_MIX + MX_VTN);
  const int tok0 = it * 64, tid = tid_();
  const int b = tok_b(tok0), j0 = tok_j(tok0);
  __syncthreads();
  for (int i = tid; i < 64 * 32; i += NTHREADS) {
    int r = i >> 5, c8 = i & 31;
    *(uint4*)(s + r * 264 + c8 * 8) = *(const uint4*)(P1 + (size_t)(tok0 + r) * P1W + C_NA + 512 + c8 * 8);
  }
  __syncthreads();
  for (int i = tid; i < 256 * 8; i += NTHREADS) {
    int ch = i >> 3, t8 = i & 7;
    unsigned w[4];
#pragma unroll
    for (int q = 0; q < 4; ++q) w[q] = (unsigned)s[(t8 * 8 + 2 * q) * 264 + ch] | ((unsigned)s[(t8 * 8 + 2 * q + 1) * 264 + ch] << 16);
    *(uint4*)(VT + ((size_t)b * 256 + ch) * TOK + j0 + t8 * 8) = make_uint4(w[0], w[1], w[2], w[3]);
  }
}
constexpr int M2C_TOK = 128, M2C_ITEMS = NTOK / M2C_TOK;
DI void m2conv_item(const Params& p, const LP& L, int it) {
  const bf16* P1 = (const bf16*)(p.ws + OFF_P1);
  bf16* XB = (bf16*)(p.ws + OFF_MIX + MX_XBC);
  const int tok0 = it * M2C_TOK;
  const float* cw = p.in[I_M2CONVW] + (size_t)L.l * 4 * 768;
  const float* cb = p.in[I_M2CONVB] + (size_t)L.l * 768;
  for (int task = tid_(); task < 96 * (M2C_TOK / 8); task += NTHREADS) {
    const int cg = task % 96, tb = task / 96, c0 = cg * 8;
    const int tokb = tok0 + tb * 8, jt = tok_j(tokb), base = tokb - jt;
    const int slo = (jt < CTXL) ? 0 : CTXL, shi = (jt < CTXL) ? CTXL : TOK;
    float w[4][8], bias[8];
#pragma unroll
    for (int k = 0; k < 4; ++k) { float4 a = *(const float4*)(cw + k * 768 + c0), b4 = *(const float4*)(cw + k * 768 + c0 + 4);
      w[k][0] = a.x; w[k][1] = a.y; w[k][2] = a.z; w[k][3] = a.w; w[k][4] = b4.x; w[k][5] = b4.y; w[k][6] = b4.z; w[k][7] = b4.w; }
    { float4 a = *(const float4*)(cb + c0), b4 = *(const float4*)(cb + c0 + 4);
      bias[0] = a.x; bias[1] = a.y; bias[2] = a.z; bias[3] = a.w; bias[4] = b4.x; bias[5] = b4.y; bias[6] = b4.z; bias[7] = b4.w; }
    float xin[11][8];
#pragma unroll
    for (int r = 0; r < 11; ++r) {
      const int j = jt - 2 + r;
      if (j >= slo && j < shi) ld8bf(P1 + (size_t)(base + j) * P1W + C_XBC + c0, xin[r]);
      else {
#pragma unroll
        for (int c = 0; c < 8; ++c) xin[r][c] = 0.f;
      }
    }
    float y[8][8];
#pragma unroll
    for (int t = 0; t < 8; ++t) {
#pragma unroll
      for (int c = 0; c < 8; ++c) y[t][c] = siluf_(bias[c] + w[0][c] * xin[t][c] + w[1][c] * xin[t + 1][c] + w[2][c] * xin[t + 2][c] + w[3][c] * xin[t + 3][c]);
      st8bf(XB + (size_t)(base + jt + t) * 768 + c0, y[t]);
    }
    if (c0 < 512) {
      bf16* XT = (bf16*)(p.ws + OFF_MIX + MX_XBT) + ((size_t)(base / TOK) * 512 + c0) * TOK + jt;
#pragma unroll
      for (int c = 0; c < 8; ++c) {
        float col[8];
#pragma unroll
        for (int t = 0; t < 8; ++t) col[t] = y[t][c];
        st8bf(XT + (size_t)c * TOK, col);
      }
    }
  }
}
DI int m2_seq2tok(int sq, int dir) { return (dir == 0) ? sq : (sq < CTXL ? (CTXL - 1 - sq) : (TOK - 1 - (sq - CTXL))); }
constexpr int M2S_ITEMS = BATCH * 8 * (TOK / 64) / NWAVES;
DI void m2scal_item(const Params& p, const LP& L, int it) {
  const int w = it * NWAVES + (tid_() >> 6), lane = tid_() & 63;
  const int ch = w % (TOK / 64), r = w / (TOK / 64), hd = r & 3, dir = (r >> 2) & 1, b = r >> 3;
  const float a = -expf(p.in[I_M2ALOG][(L.l * 2 + dir) * 4 + hd]);
  const int sq = ch * 64 + lane, j = m2_seq2tok(sq, dir);
  const float dt = ((const float*)(p.ws + OFF_DT))[((size_t)b * TOK + j) * 8 + dir * 4 + hd];
  float cs = dt * a;
#pragma unroll
  for (int d = 1; d < 64; d <<= 1) { float o = shfl_up_(cs, d); if (lane >= d) cs += o; }
  const float sl = shfl_(cs, 63);
  float* o = (float*)(p.ws + OFF_MIX + MX_M2S) + ((size_t)((b * 2 + dir) * 4 + hd) * TOK + sq) * 4;
  *(float4*)o = make_float4(cs, dt, dt * __expf(sl - cs), cs * 1.4426950408889634f - log2f(dt));
}
constexpr int S5_MT = (MCH + 255) / 256;
DI void s5a_tile(const Params& p, const LP& L, int t, char* smem) {
  const int g = t / (S5_MT * 2), r = t % (S5_MT * 2), mt = r / 2, nt = r % 2;
  const int m0 = mt * 256, n0 = nt * 128;
  GA ga = make_ga((const bf16*)(p.ws + OFF_MIX + MX_US5) + (size_t)g * NTOK * 16, 256, (const bf16*)(L.s5 + S5_WA) + (size_t)g * 65536, 256, 256, MCH);
  f32x4 acc[4][4];
  gemm_s<4>(ga, m0, n0, smem, acc);
  float* HE = (float*)(p.ws + OFF_MIX + MX_HEND) + (size_t)g * MCH * 256;
  EPI_BEGIN(4, acc, m0, n0, MCH)
    st8f(HE + (size_t)row * 256 + col, v);
  EPI_END
}
DI int s5_chunk_of(int i, int d) { return (d == 0) ? i : (i < NCC ? (NCC - 1 - i) : (NCH - 1 - (i - NCC))); }
DI void s5carry_item(const Params& p, const LP& L, int it) {
  const int w = it * NWAVES + (tid_() >> 6), lane = tid_() & 63;
  const int d = w / (16 * BATCH), g = (w / BATCH) & 15, b = w % BATCH;
  const float* lp = (const float*)(L.s5 + S5_LAMPOW) + ((size_t)((d * 16 + g) * 17 + 16) * 64 + lane) * 2;
  const float lre = lp[0], lim = lp[1];
  const float* HE = (const float*)(p.ws + OFF_MIX + MX_HEND) + ((size_t)g * MCH + (size_t)b * NCH) * 256 + d * 128;
  bf16* HI = (bf16*)(p.ws + OFF_MIX + MX_HIN) + ((size_t)g * MCH + (size_t)b * NCH) * 256 + d * 128;
  float cre = 0.f, cim = 0.f;
  static_assert(NCH % 4 == 0, "chunk count");
  for (int i0 = 0; i0 < NCH; i0 += 4) {
    float hre[4], him[4];
#pragma unroll
    for (int k = 0; k < 4; ++k) { const int ch = s5_chunk_of(i0 + k, d); hre[k] = HE[(size_t)ch * 256 + lane]; him[k] = HE[(size_t)ch * 256 + 64 + lane]; }
#pragma unroll
    for (int k = 0; k < 4; ++k) {
      const int ch = s5_chunk_of(i0 + k, d);
      HI[(size_t)ch * 256 + lane] = f2bf(cre); HI[(size_t)ch * 256 + 64 + lane] = f2bf(cim);
      const float nre = lre * cre - lim * cim + hre[k], nim = lre * cim + lim * cre + him[k];
      cre = nre; cim = nim;
    }
  }
}
DI void s5c_tile(const Params& p, const LP& L, int t, char* smem) {
  const int g = t / (S5_MT * 2), r = t % (S5_MT * 2), mt = r / 2, nt = r % 2;
  const int m0 = mt * 256, n0 = nt * 128;
  GA ga = make_ga((const bf16*)(p.ws + OFF_MIX + MX_US5) + (size_t)g * NTOK * 16, 256, (const bf16*)(L.s5 + S5_W2) + (size_t)g * 256 * 512, 512, 512, MCH);
  ga.A2 = (const bf16*)(p.ws + OFF_MIX + MX_HIN) + (size_t)g * MCH * 256; ga.lda2 = 256; ga.ksplit = 256;
  f32x4 acc[4][4];
  gemm_s<4>(ga, m0, n0, smem, acc);
  bf16* Z = (bf16*)(p.ws + OFF_MIX + MX_Z);
  EPI_BEGIN(4, acc, m0, n0, MCH)
#pragma unroll
    for (int k = 0; k < 8; ++k) v[k] = geluf_(v[k]);
    st8bf(Z + ((size_t)row * 16 + (col >> 4)) * 256 + g * 16 + (col & 15), v);
  EPI_END
}

DI float fmax_(float a, float b) { return a > b ? a : b; }
constexpr int AT_LDV = 76;
struct NaInfo { int r, qc, rs, cs; };
template <int DK, bool NA>
DI void attn_block(const bf16* qrow, bool active, const bf16* Kp, int kstride, const bf16* Vt,
                   int ka0, int ntile_a, int arow0, int kb0, int ntile_b,
                   const float* srpb, NaInfo ni, float scale, bf16* orow, char* smem) {
  constexpr int LDK = DK + 8, KCH = DK / 8;
  constexpr int KT_BYTES = 64 * LDK * 2, VT_BYTES = 64 * AT_LDV * 2;
  constexpr int NKL = (64 * KCH + NTHREADS - 1) / NTHREADS;
  const int tid = tid_(), lane = tid & 63, half = lane >> 5, r = lane & 31;
  bf16* sK = (bf16*)smem;
  bf16* sV = (bf16*)(smem + 2 * KT_BYTES);
  bf16x8 qf[DK / 16];
  f32x16 o0, o1;
  float m = -1e30f, l = 0.f;
  const float scale2 = scale * 1.4426950408889634f;
#pragma unroll
  for (int ks = 0; ks < DK / 16; ++ks) qf[ks] = active ? *(const bf16x8*)(qrow + ks * 16 + 8 * half) : bf16x8{0, 0, 0, 0, 0, 0, 0, 0};
#pragma unroll
  for (int i = 0; i < 16; ++i) { o0[i] = 0.f; o1[i] = 0.f; }
  const int NTL = ntile_a + ntile_b;
  u32x4 rk[NKL], rv[1];
#pragma unroll
  for (int i = 0; i < NKL; ++i) rk[i] = u32x4{0u, 0u, 0u, 0u};
  auto key0_of = [&](int t) { return t < ntile_a ? ka0 + 64 * t : kb0 + 64 * (t - ntile_a); };
#define AT_GLOAD(t_) { const int k0_ = key0_of(t_); \
    _Pragma("unroll") for (int i_ = 0; i_ < NKL; ++i_) { const int c_ = tid + i_ * NTHREADS; const int key_ = c_ / KCH, ch_ = c_ % KCH; \
      if (c_ < 64 * KCH) rk[i_] = *(const u32x4*)(Kp + (size_t)(k0_ + key_) * kstride + ch_ * 8); } \
    { const int d_ = tid >> 3, ch_ = tid & 7; rv[0] = *(const u32x4*)(Vt + (size_t)d_ * TOK + k0_ + ch_ * 8); } }
#define AT_SSTORE(buf_) { \
    _Pragma("unroll") for (int i_ = 0; i_ < NKL; ++i_) { const int c_ = tid + i_ * NTHREADS; const int key_ = c_ / KCH, ch_ = c_ % KCH; \
      if (c_ < 64 * KCH) *(u32x4*)(sK + (buf_) * (64 * LDK) + key_ * LDK + ch_ * 8) = rk[i_]; } \
    { const int d_ = tid >> 3, ch_ = tid & 7; \
      bf16* dst_ = sV + (buf_) * (64 * AT_LDV) + d_ * AT_LDV + ch_ * 8; \
      *(uint2*)dst_ = make_uint2(rv[0][0], rv[0][1]); *(uint2*)(dst_ + 4) = make_uint2(rv[0][2], rv[0][3]); } }
  __syncthreads();
  AT_GLOAD(0) AT_SSTORE(0)
  __syncthreads();
#pragma unroll 1
  for (int t = 0; t < NTL; ++t) {
    const int buf = t & 1;
    if (t + 1 < NTL) AT_GLOAD(t + 1)
    bool doit = active;
    int trow0 = 0;
    if (NA && t < ntile_a) {
      trow0 = arow0 + t * (64 / GRID_W);
      doit = active && (trow0 + (64 / GRID_W) > ni.rs) && (trow0 < ni.rs + WIN_R);
    }
    if (doit) {
      const bf16* kb = sK + buf * (64 * LDK);
      const bf16* vb = sV + buf * (64 * AT_LDV);
      f32x16 s0, s1;
#pragma unroll
      for (int i = 0; i < 16; ++i) { s0[i] = 0.f; s1[i] = 0.f; }
#pragma unroll
      for (int ks = 0; ks < DK / 16; ++ks) {
        bf16x8 a0 = *(const bf16x8*)(kb + r * LDK + ks * 16 + 8 * half);
        bf16x8 a1 = *(const bf16x8*)(kb + (32 + r) * LDK + ks * 16 + 8 * half);
        s0 = __builtin_amdgcn_mfma_f32_32x32x16_bf16(a0, qf[ks], s0, 0, 0, 0);
        s1 = __builtin_amdgcn_mfma_f32_32x32x16_bf16(a1, qf[ks], s1, 0, 0, 0);
      }
      float mx = -INFINITY;
      if (NA && t < ntile_a) {
#pragma unroll
        for (int i = 0; i < 16; ++i) {
          const int kk = (i & 3) + 8 * (i >> 2) + 4 * half;
#pragma unroll
          for (int hb = 0; hb < 2; ++hb) {
            const int kq = kk + 32 * hb;
            const int kr = trow0 + kq / GRID_W, kc = kq % GRID_W;
            const bool ok = (kr >= ni.rs) && (kr < ni.rs + WIN_R) && (kc >= ni.cs) && (kc < ni.cs + WIN_C);
            const float bias = ok ? srpb[(kr - ni.r + 7) * 31 + (kc - ni.qc + 15)] * 1.4426950408889634f : -INFINITY;
            if (hb == 0) { s0[i] = s0[i] * scale2 + bias; mx = fmax_(mx, s0[i]); }
            else { s1[i] = s1[i] * scale2 + bias; mx = fmax_(mx, s1[i]); }
          }
        }
      } else {
#pragma unroll
        for (int i = 0; i < 16; ++i) { s0[i] *= scale2; s1[i] *= scale2; mx = fmax_(mx, fmax_(s0[i], s1[i])); }
      }
      mx = fmax_(mx, shfl_xor_(mx, 32));
      const float mn = fmax_(m, mx);
      const float alpha = exp2f_(m - mn);
      const bool same = (mn == m);
      m = mn;
      float ps = 0.f;
#pragma unroll
      for (int i = 0; i < 16; ++i) { s0[i] = exp2f_(s0[i] - mn); s1[i] = exp2f_(s1[i] - mn); ps += s0[i] + s1[i]; }
      l = l * alpha + ps;
      if (!wave_all_(same)) {
#pragma unroll
        for (int i = 0; i < 16; ++i) { o0[i] *= alpha; o1[i] *= alpha; }
      }
#pragma unroll
      for (int kq = 0; kq < 4; ++kq) {
        u32x4 pw;
#pragma unroll
        for (int j = 0; j < 4; ++j) pw[j] = (kq < 2) ? pack2(s0[8 * (kq & 1) + 2 * j], s0[8 * (kq & 1) + 2 * j + 1]) : pack2(s1[8 * (kq & 1) + 2 * j], s1[8 * (kq & 1) + 2 * j + 1]);
        const bf16x8 pf = __builtin_bit_cast(bf16x8, pw);
        const bf16* v0 = vb + r * AT_LDV + 16 * kq + 4 * half;
        const bf16* v1 = vb + (r + 32) * AT_LDV + 16 * kq + 4 * half;
        uint2 a0 = *(const uint2*)v0, a1 = *(const uint2*)(v0 + 8), b0 = *(const uint2*)v1, b1 = *(const uint2*)(v1 + 8);
        bf16x8 va, vbb;
        va[0] = (short)(a0.x & 0xffff); va[1] = (short)(a0.x >> 16); va[2] = (short)(a0.y & 0xffff); va[3] = (short)(a0.y >> 16);
        va[4] = (short)(a1.x & 0xffff); va[5] = (short)(a1.x >> 16); va[6] = (short)(a1.y & 0xffff); va[7] = (short)(a1.y >> 16);
        vbb[0] = (short)(b0.x & 0xffff); vbb[1] = (short)(b0.x >> 16); vbb[2] = (short)(b0.y & 0xffff); vbb[3] = (short)(b0.y >> 16);
        vbb[4] = (short)(b1.x & 0xffff); vbb[5] = (short)(b1.x >> 16); vbb[6] = (short)(b1.y & 0xffff); vbb[7] = (short)(b1.y >> 16);
        o0 = __builtin_amdgcn_mfma_f32_32x32x16_bf16(va, pf, o0, 0, 0, 0);
        o1 = __builtin_amdgcn_mfma_f32_32x32x16_bf16(vbb, pf, o1, 0, 0, 0);
      }
    }
    if (t + 1 < NTL) AT_SSTORE(buf ^ 1)
    __syncthreads();
  }
  if (active) {
    const float lt = l + shfl_xor_(l, 32);
    const float inv = 1.0f / lt;
#pragma unroll
    for (int gI = 0; gI < 4; ++gI) {
      const int d0 = 8 * gI + 4 * half;
      *(uint2*)(orow + d0) = make_uint2(pack2(o0[4 * gI] * inv, o0[4 * gI + 1] * inv), pack2(o0[4 * gI + 2] * inv, o0[4 * gI + 3] * inv));
      *(uint2*)(orow + 32 + d0) = make_uint2(pack2(o1[4 * gI] * inv, o1[4 * gI + 1] * inv), pack2(o1[4 * gI + 2] * inv, o1[4 * gI + 3] * inv));
    }
  }
}
DI void mla_attn_item(const Params& p, int it, bool ctxq, char* smem) {
  const int nqb = ctxq ? (CTXL + 255) / 256 : SEQ / 256;
  const int b = it / (4 * nqb), h = (it / nqb) & 3, qb = it % nqb;
  const int lane = tid_() & 63, wid = tid_() >> 6;
  const int nq = ctxq ? CTXL : SEQ, q0 = qb * 256 + wid * 32;
  const bool active = q0 < nq;
  const int jq = (ctxq ? 0 : CTXL) + (active ? q0 : 0) + (lane & 31);
  const bf16* Q = (const bf16*)(p.ws + OFF_MIX + MX_Q) + ((size_t)b * 4 + h) * TOK * 96;
  const bf16* K = (const bf16*)(p.ws + OFF_MIX + MX_K) + ((size_t)b * 4 + h) * TOK * 96;
  const bf16* VT = (const bf16*)(p.ws + OFF_MIX + MX_VTM) + ((size_t)b * 4 + h) * 64 * TOK;
  bf16* O = (bf16*)(p.ws + OFF_O) + ((size_t)b * TOK + jq) * 1024 + 0 * 256 + h * 64;
  NaInfo ni; ni.r = 0; ni.qc = 0; ni.rs = 0; ni.cs = 0;
  attn_block<96, false>(Q + (size_t)jq * 96, active, K, 96, VT, 0, 0, 0, 0, (ctxq ? CTXL : TOK) / 64, nullptr, ni, 0.10206207261596577f, O, smem);
}
DI void na_attn_item(const Params& p, const LP& L, int it, bool ctxq, char* smem) {
  const int nqb = ctxq ? (CTXL + 255) / 256 : SEQ / 256;
  const int b = it / (4 * nqb), h = (it / nqb) & 3, qb = it % nqb;
  const int tid = tid_(), lane = tid & 63, wid = tid >> 6;
  const int nq = ctxq ? CTXL : SEQ, q0 = qb * 256 + wid * 32;
  const bool active = q0 < nq;
  const int jq = (ctxq ? 0 : CTXL) + (active ? q0 : 0) + (lane & 31);
  const bf16* P1 = (const bf16*)(p.ws + OFF_P1) + (size_t)b * TOK * P1W;
  const bf16* VT = (const bf16*)(p.ws + OFF_MIX + MX_VTN) + ((size_t)b * 4 + h) * 64 * TOK;
  const bf16* Kb = P1 + C_NA + 256 + h * 64;
  bf16* O = (bf16*)(p.ws + OFF_O) + ((size_t)b * TOK + jq) * 1024 + 1 * 256 + h * 64;
  constexpr int AT_END64 = 2 * (64 * 72 * 2) + 2 * (64 * AT_LDV * 2);
  float* srpb = (float*)(smem + AT_END64);
  NaInfo ni; ni.r = 0; ni.qc = 0; ni.rs = 0; ni.cs = 0;
  int ka0 = 0, nta = 0, arow0 = 0;
  if (!ctxq) {
    __syncthreads();
    const float* rpb = p.in[I_RPB] + ((size_t)L.l * 4 + h) * 15 * 31;
    for (int i = tid; i < 15 * 31; i += NTHREADS) srpb[i] = rpb[i];
    const int tl = q0 + (lane & 31);
    ni.r = tl / GRID_W; ni.qc = tl % GRID_W;
    int rs = ni.r - WIN_R / 2; rs = rs < 0 ? 0 : (rs > ROWS - WIN_R ? ROWS - WIN_R : rs);
    int cs = ni.qc - WIN_C / 2; cs = cs < 0 ? 0 : (cs > GRID_W - WIN_C ? GRID_W - WIN_C : cs);
    ni.rs = rs; ni.cs = cs;
    constexpr int RPT = 64 / GRID_W;
    const int rfirst = (qb * 256) / GRID_W, rlast = (qb * 256 + 255) / GRID_W;
    int rs_f = rfirst - WIN_R / 2; rs_f = rs_f < 0 ? 0 : (rs_f > ROWS - WIN_R ? ROWS - WIN_R : rs_f);
    int rs_l = rlast - WIN_R / 2; rs_l = rs_l < 0 ? 0 : (rs_l > ROWS - WIN_R ? ROWS - WIN_R : rs_l);
    arow0 = (rs_f / RPT) * RPT;
    const int row_hi = rs_l + WIN_R;
    nta = (row_hi - arow0 + RPT - 1) / RPT;
    ka0 = CTXL + arow0 * GRID_W;
  }
  attn_block<64, true>(P1 + (size_t)jq * P1W + C_NA + h * 64, active, Kb, P1W, VT, ka0, nta, arow0, 0, CTXL / 64, srpb, ni, 0.125f, O, smem);
}

constexpr int M2_LDB = 136, M2_LDX = 72;
constexpr int M2_OFF_B = 0;
constexpr int M2_OFF_C = M2_OFF_B + 64 * M2_LDB * 2;
constexpr int M2_OFF_HD = M2_OFF_C + 64 * M2_LDB * 2;
constexpr int M2H_H = 0;
constexpr int M2H_XT = M2H_H + 64 * M2_LDB * 2;
constexpr int M2H_BT = M2H_XT + 64 * M2_LDX * 2;
constexpr int M2H_S = M2H_BT + 128 * M2_LDX * 2;
constexpr int M2H_X = M2H_S + 3 * 64 * 4;
constexpr int M2H_SIZE = M2H_X + 64 * M2_LDX * 2;
constexpr int M2_SMEM = M2_OFF_HD + 2 * M2H_SIZE;
static_assert(M2_SMEM <= SMEM_BYTES, "m2 smem");
DI u32x4 rev8_(u32x4 v) {
  return u32x4{(v[3] >> 16) | (v[3] << 16), (v[2] >> 16) | (v[2] << 16), (v[1] >> 16) | (v[1] << 16), (v[0] >> 16) | (v[0] << 16)};
}
DI void m2scan_item(const Params& p, const LP& L, int it, char* smem) {
  const int b = it / 4, grp = (it >> 1) & 1, dir = it & 1;
  const int tid = tid_(), lane = tid & 63, wid = tid >> 6, half = lane >> 5, r = lane & 31;
  const int hsel = wid >> 2, wl = wid & 3, hd = grp * 2 + hsel;
  bf16* sB = (bf16*)(smem + M2_OFF_B);
  bf16* sC = (bf16*)(smem + M2_OFF_C);
  char* hb = smem + M2_OFF_HD + hsel * M2H_SIZE;
  bf16* sH = (bf16*)(hb + M2H_H);
  bf16* sXT = (bf16*)(hb + M2H_XT);
  bf16* sBT = (bf16*)(hb + M2H_BT);
  float* sS = (float*)(hb + M2H_S);
  float* sDt = sS + 64;
  float* sW = sS + 128;
  const bf16* XB = (const bf16*)(p.ws + OFF_MIX + MX_XBC) + (size_t)b * TOK * 768;
  const bf16* XT = (const bf16*)(p.ws + OFF_MIX + MX_XBT) + (size_t)b * 512 * TOK;
  const float* SC = (const float*)(p.ws + OFF_MIX + MX_M2S) + (size_t)((b * 2 + dir) * 4 + hd) * TOK * 4;
  float* YM = (float*)(p.ws + OFF_HA) + ((size_t)dir * NTOK + (size_t)b * TOK) * 256;
  const int pb = wl & 1, tb = wl >> 1, nb0 = 2 * (wl >> 1);
  f32x16 hst[2];
#pragma unroll
  for (int i = 0; i < 16; ++i) { hst[0][i] = 0.f; hst[1][i] = 0.f; }
  __syncthreads();
  for (int i = tid; i < 2 * M2H_SIZE / 4; i += NTHREADS) ((unsigned*)(smem + M2_OFF_HD))[i] = 0u;
  __syncthreads();
  u32x4 rxt[2], rbt[2], rb[2], rc[2];
  float4 rsc = make_float4(0.f, 0.f, 0.f, 0.f);
#define M2_TLOAD(rowptr_, sq0_) (*(const u32x4*)((rowptr_) + ((dir == 0) ? (sq0_) : m2_seq2tok((sq0_) + 7, 1))))
#define M2_GLOAD(c0_) { \
    _Pragma("unroll") for (int q_ = 0; q_ < 2; ++q_) { const int i_ = tid + q_ * NTHREADS; const int h2_ = i_ >> 9, t8_ = ((i_ >> 6) & 7) * 8, pp_ = i_ & 63; \
      rxt[q_] = M2_TLOAD(XT + (size_t)((grp * 2 + h2_) * 64 + pp_) * TOK, (c0_) + t8_); } \
    _Pragma("unroll") for (int q_ = 0; q_ < 2; ++q_) { const int i_ = tid + q_ * NTHREADS; const int t8_ = (i_ >> 7) * 8, nn_ = i_ & 127; \
      rbt[q_] = M2_TLOAD(XT + (size_t)(256 + grp * 128 + nn_) * TOK, (c0_) + t8_); } \
    _Pragma("unroll") for (int q_ = 0; q_ < 2; ++q_) { const int i_ = tid + q_ * NTHREADS; const int t_ = i_ >> 4, n8_ = (i_ & 15) * 8; \
      const bf16* src_ = XB + (size_t)m2_seq2tok((c0_) + t_, dir) * 768 + grp * 128 + n8_; \
      rb[q_] = *(const u32x4*)(src_ + 256); rc[q_] = *(const u32x4*)(src_ + 512); } \
    if (wl == 0) rsc = *(const float4*)(SC + (size_t)((c0_) + lane) * 4); }
  M2_GLOAD(0)
  for (int c0 = 0; c0 < TOK; c0 += 64) {
    if (wl == 0) { sS[lane] = rsc.x; sDt[lane] = rsc.w; sW[lane] = rsc.z; }
    __syncthreads();
#pragma unroll
    for (int q2 = 0; q2 < 2; ++q2) {
      const int i = tid + q2 * NTHREADS; const int h2 = i >> 9, t8 = ((i >> 6) & 7) * 8, pp = i & 63;
      *(u32x4*)((bf16*)(smem + M2_OFF_HD + h2 * M2H_SIZE + M2H_XT) + pp * M2_LDX + t8) = dir ? rev8_(rxt[q2]) : rxt[q2];
    }
#pragma unroll
    for (int q4 = 0; q4 < 2; ++q4) {
      const int i = tid + q4 * NTHREADS; const int t = i >> 4, n8 = (i & 15) * 8;
      *(u32x4*)(sB + t * M2_LDB + n8) = rb[q4];
      *(u32x4*)(sC + t * M2_LDB + n8) = rc[q4];
    }
#pragma unroll
    for (int q4 = 0; q4 < 2; ++q4) {
      const int i = tid + q4 * NTHREADS; const int t8 = (i >> 7) * 8, nn = i & 127;
      float bv[8];
      if (dir) rbt[q4] = rev8_(rbt[q4]);
      bv[0] = __uint_as_float(rbt[q4][0] << 16); bv[1] = __uint_as_float(rbt[q4][0] & 0xffff0000u);
      bv[2] = __uint_as_float(rbt[q4][1] << 16); bv[3] = __uint_as_float(rbt[q4][1] & 0xffff0000u);
      bv[4] = __uint_as_float(rbt[q4][2] << 16); bv[5] = __uint_as_float(rbt[q4][2] & 0xffff0000u);
      bv[6] = __uint_as_float(rbt[q4][3] << 16); bv[7] = __uint_as_float(rbt[q4][3] & 0xffff0000u);
#pragma unroll
      for (int h2 = 0; h2 < 2; ++h2) {
        const float* wv = (const float*)(smem + M2_OFF_HD + h2 * M2H_SIZE + M2H_S) + 128 + t8;
        float sv[8];
#pragma unroll
        for (int k = 0; k < 8; ++k) sv[k] = bv[k] * wv[k];
        st8bf((bf16*)(smem + M2_OFF_HD + h2 * M2H_SIZE + M2H_BT) + nn * M2_LDX + t8, sv);
      }
    }
    __syncthreads();
    if (c0 + 64 < TOK) M2_GLOAD(c0 + 64)
    {
      f32x16 yT, y2;
#pragma unroll
      for (int i = 0; i < 16; ++i) { yT[i] = 0.f; y2[i] = 0.f; }
      const int tv = 32 * tb + r;
      const float St = sS[tv];
      for (int sb = 0; sb <= tb; ++sb) {
        f32x16 gT;
#pragma unroll
        for (int i = 0; i < 16; ++i) gT[i] = 0.f;
#pragma unroll
        for (int ks = 0; ks < 8; ++ks) {
          bf16x8 av = *(const bf16x8*)(sB + (32 * sb + r) * M2_LDB + 16 * ks + 8 * half);
          bf16x8 bv = *(const bf16x8*)(sC + tv * M2_LDB + 16 * ks + 8 * half);
          gT = __builtin_amdgcn_mfma_f32_32x32x16_bf16(av, bv, gT, 0, 0, 0);
        }
        const float St2 = St * 1.4426950408889634f;
        if (sb == tb) {
#pragma unroll
          for (int i = 0; i < 16; ++i) {
            const int sv = 32 * sb + (i & 3) + 8 * (i >> 2) + 4 * half;
            gT[i] = (sv <= tv) ? gT[i] * exp2f_(St2 - sDt[sv]) : 0.f;
          }
        } else {
#pragma unroll
          for (int i = 0; i < 16; ++i) {
            const int sv = 32 * sb + (i & 3) + 8 * (i >> 2) + 4 * half;
            gT[i] *= exp2f_(St2 - sDt[sv]);
          }
        }
#pragma unroll
        for (int kq = 0; kq < 2; ++kq) {
          const u32x4 pw = u32x4{pack2(gT[8 * kq], gT[8 * kq + 1]), pack2(gT[8 * kq + 2], gT[8 * kq + 3]), pack2(gT[8 * kq + 4], gT[8 * kq + 5]), pack2(gT[8 * kq + 6], gT[8 * kq + 7])};
          const bf16x8 pf = __builtin_bit_cast(bf16x8, pw);
          const bf16* xr = sXT + (32 * pb + r) * M2_LDX + 32 * sb + 16 * kq + 4 * half;
          uint2 x0 = *(const uint2*)xr, x1 = *(const uint2*)(xr + 8);
          bf16x8 xa;
          xa[0] = (short)(x0.x & 0xffff); xa[1] = (short)(x0.x >> 16); xa[2] = (short)(x0.y & 0xffff); xa[3] = (short)(x0.y >> 16);
          xa[4] = (short)(x1.x & 0xffff); xa[5] = (short)(x1.x >> 16); xa[6] = (short)(x1.y & 0xffff); xa[7] = (short)(x1.y >> 16);
          yT = __builtin_amdgcn_mfma_f32_32x32x16_bf16(xa, pf, yT, 0, 0, 0);
        }
      }
#pragma unroll
      for (int ks = 0; ks < 8; ++ks) {
        bf16x8 av = *(const bf16x8*)(sH + (32 * pb + r) * M2_LDB + 16 * ks + 8 * half);
        bf16x8 bv = *(const bf16x8*)(sC + tv * M2_LDB + 16 * ks + 8 * half);
        y2 = __builtin_amdgcn_mfma_f32_32x32x16_bf16(av, bv, y2, 0, 0, 0);
      }
      const float eS = __expf(St);
      const int j = m2_seq2tok(c0 + tv, dir);
      float* yo = YM + (size_t)j * 256 + hd * 64 + 32 * pb + 4 * half;
#pragma unroll
      for (int gI = 0; gI < 4; ++gI)
        *(float4*)(yo + 8 * gI) = make_float4(yT[4 * gI] + eS * y2[4 * gI], yT[4 * gI + 1] + eS * y2[4 * gI + 1], yT[4 * gI + 2] + eS * y2[4 * gI + 2], yT[4 * gI + 3] + eS * y2[4 * gI + 3]);
    }
    __syncthreads();
    {
      const float eL = __expf(sS[63]);
#pragma unroll
      for (int q = 0; q < 2; ++q) {
#pragma unroll
        for (int i = 0; i < 16; ++i) hst[q][i] *= eL;
#pragma unroll
        for (int ks = 0; ks < 4; ++ks) {
          bf16x8 av = *(const bf16x8*)(sXT + (32 * pb + r) * M2_LDX + 16 * ks + 8 * half);
          bf16x8 bv = *(const bf16x8*)(sBT + (32 * (nb0 + q) + r) * M2_LDX + 16 * ks + 8 * half);
          hst[q] = __builtin_amdgcn_mfma_f32_32x32x16_bf16(av, bv, hst[q], 0, 0, 0);
        }
#pragma unroll
        for (int i = 0; i < 16; ++i) {
          const int pv = 32 * pb + (i & 3) + 8 * (i >> 2) + 4 * half;
          sH[pv * M2_LDB + 32 * (nb0 + q) + r] = f2bf(hst[q][i]);
        }
      }
    }
    __syncthreads();
  }
}
DI void m2gate_item(const Params& p, const LP& L, int it) {
  const int tok = it * NWAVES + (tid_() >> 6), lane = tid_() & 63;
  const float* Y0 = (const float*)(p.ws + OFF_HA) + (size_t)tok * 256;
  const float* Y1 = Y0 + (size_t)NTOK * 256;
  const bf16* XB = (const bf16*)(p.ws + OFF_MIX + MX_XBC) + (size_t)tok * 768;
  const bf16* P1 = (const bf16*)(p.ws + OFF_P1) + (size_t)tok * P1W + C_Z;
  const int c = lane * 4, hd = c >> 6;
  const float dsk = p.in[I_M2D][L.l * 4 + hd];
  float4 y0 = *(const float4*)(Y0 + c), y1 = *(const float4*)(Y1 + c);
  uint2 xw = *(const uint2*)(XB + c), zw = *(const uint2*)(P1 + c);
  float xs[4] = {__uint_as_float(xw.x << 16), __uint_as_float(xw.x & 0xffff0000u), __uint_as_float(xw.y << 16), __uint_as_float(xw.y & 0xffff0000u)};
  float zs[4] = {__uint_as_float(zw.x << 16), __uint_as_float(zw.x & 0xffff0000u), __uint_as_float(zw.y << 16), __uint_as_float(zw.y & 0xffff0000u)};
  float ys[4] = {y0.x + y1.x, y0.y + y1.y, y0.z + y1.z, y0.w + y1.w};
  float v[4], ss = 0.f;
#pragma unroll
  for (int i = 0; i < 4; ++i) { v[i] = (ys[i] + dsk * xs[i]) * siluf_(zs[i]); ss += v[i] * v[i]; }
  ss = wave_sum(ss);
  const float rs = rsqrtf(ss * (1.f / 256.f) + EPS);
  float4 gn = *(const float4*)(p.in[I_M2GNORM] + L.l * 256 + c);
  bf16* O = (bf16*)(p.ws + OFF_O) + (size_t)tok * 1024 + 768 + c;
  *(uint2*)O = make_uint2(pack2(v[0] * rs * gn.x, v[1] * rs * gn.y), pack2(v[2] * rs * gn.z, v[3] * rs * gn.w));
}
constexpr int GLU_MT = (NTOK + 255) / 256;
DI void glu_tile(const Params& p, const LP& L, int t, char* smem) {
  const int mt = t % GLU_MT, nt = t / GLU_MT, m0 = mt * 256, n0 = nt * 128;
  const bf16* Z = (const bf16*)(p.ws + OFF_MIX + MX_Z);
  GA g = make_ga(Z, 256, (const bf16*)(L.we + WE_GLU), 256, 256, NTOK);
  f32x4 acc[4][4];
  gemm_s<4>(g, m0, n0, smem, acc);
  bf16* O = (bf16*)(p.ws + OFF_O);
  const float* bg = p.in[I_S5BGLU] + L.l * 256;
  EPI_BEGIN(4, acc, m0, n0, NTOK)
    float z[8]; ld8bf(Z + (size_t)row * 256 + col, z);
#pragma unroll
    for (int k = 0; k < 8; ++k) v[k] = z[k] * sigmoidf_(v[k] + bg[col + k]);
    st8bf(O + (size_t)row * 1024 + 512 + col, v);
  EPI_END
}
DI void merge_tile(const Params& p, const LP& L, int t, char* smem) {
  constexpr int MT_L = BATCH * (SEQ / 256), MT_A = (NTOK + 255) / 256;
  const int mt = L.last ? t % MT_L : t % MT_A, nt = L.last ? t / MT_L : t / MT_A, m0 = mtile_row0(mt, L.last, 256), n0 = nt * 128;
  const bf16* O = (const bf16*)(p.ws + OFF_O);
  const bf16* PG = (const bf16*)(p.ws + OFF_PG);
  float tot[4][2][8];
#pragma unroll
  for (int a = 0; a < 4; ++a)
#pragma unroll
    for (int q = 0; q < 2; ++q)
#pragma unroll
      for (int k = 0; k < 8; ++k) tot[a][q][k] = 0.f;
  for (int j = 0; j < 4; ++j) {
    GA g = make_ga(O + j * 256, 1024, (const bf16*)(L.we + WE_WB) + (size_t)j * 1024 * 256, 256, 256, NTOK);
    f32x4 acc[4][4];
    gemm_s<4>(g, m0, n0, smem, acc);
    EPI_BEGIN(4, acc, m0, n0, NTOK)
      float gt[8]; ld8bf(PG + (size_t)row * 4096 + j * 1024 + col, gt);
#pragma unroll
      for (int k = 0; k < 8; ++k) tot[_m][_q][k] += gt[k] * v[k];
    EPI_END
  }
  bf16* Y = (bf16*)(p.ws + OFF_P1);
  {
    const int l = tid_() & 63, w = tid_() >> 6, wr = w >> 1, wc = w & 1, fr = l & 15, fq = l >> 4;
#pragma unroll
    for (int m = 0; m < 4; ++m)
#pragma unroll
      for (int q = 0; q < 2; ++q) {
        const int row = m0 + wr * 64 + m * 16 + fr, col = n0 + wc * 64 + q * 32 + 8 * fq;
        if (row < NTOK) st8bf(Y + (size_t)row * 1024 + col, tot[m][q]);
      }
  }
}
DI void outproj_tile(const Params& p, const LP& L, int t, char* smem) {
  float* Y2 = (float*)(p.ws + OFF_HA);
  constexpr int MT_L = BATCH * (SEQ / 256), MT_A = (NTOK + 255) / 256;
  const int mt = L.last ? t % MT_L : t % MT_A, nt = L.last ? t / MT_L : t / MT_A, m0 = mtile_row0(mt, L.last, 256), n0 = nt * 256;
  GA g = make_ga((const bf16*)(p.ws + OFF_P1), 1024, (const bf16*)(L.we + WE_WOUT), 1024, 1024, NTOK);
  f32x4 acc[2][2][4][2];
  gemm_big(g, m0, n0, smem, acc);
  EPIB_BEGIN(acc, m0, n0, NTOK)
    st8f(Y2 + (size_t)row * 1024 + col, v);
  EPIB_END
}
DI int post_ntok(bool latonly) { return latonly ? BATCH * SEQ : NTOK; }
DI int post_tok(int i, bool latonly) { return latonly ? ((i / SEQ) * TOK + CTXL + (i % SEQ)) : i; }

DI const float* xsrc_row(const Params& p, int l, int tok) {
  if (l > 0) return (const float*)(p.ws + OFF_X) + (size_t)tok * 1024;
  const int b = tok_b(tok), j = tok_j(tok);
  return (j < CTXL) ? p.in[I_CTX] + ((size_t)b * CTXL + j) * 1024 : p.in[I_X] + ((size_t)b * SEQ + (j - CTXL)) * 1024;
}
DI void post_stage_router(const Params& p, const LP& L, char* smem) {
  const float* wr = p.in[I_WROUTER] + (size_t)L.l * 1024 * 16;
  float4* wl = (float4*)smem;
  __syncthreads();
  for (int i = tid_(); i < 4096; i += NTHREADS) {
    const int k = i >> 2, q = i & 3;
    const int pos = ((k >> 8) * 4 + (k & 3)) * 64 + ((k >> 2) & 63);
    wl[q * 1024 + pos] = *(const float4*)(wr + (size_t)k * 16 + q * 4);
  }
  __syncthreads();
}
DI void post_phase(const Params& p, const LP& L, char* smem) {
  const int lane = tid_() & 63, gw = (int)blockIdx.x * NWAVES + (tid_() >> 6), TW = (int)gridDim.x * NWAVES;
  const int n = post_ntok(L.last);
  if (gw >= n) return;
  const float* gpm = p.in[I_GPOSTMIX] + L.l * 1024;
  const float4* wl = (const float4*)smem;
  int i = gw, tok = post_tok(i, L.last);
  float4 yr[4], xr[4];
  {
    const float* X = xsrc_row(p, L.l, tok);
    const float* Y2 = (const float*)(p.ws + OFF_HA) + (size_t)tok * 1024;
#pragma unroll
    for (int q = 0; q < 4; ++q) { yr[q] = *(const float4*)(Y2 + lane * 4 + q * 256); xr[q] = *(const float4*)(X + lane * 4 + q * 256); }
  }
  for (;;) {
    const int inext = i + TW; const bool has = inext < n; const int tokn = has ? post_tok(inext, L.last) : tok;
    float4 yn[4], xn[4];
    {
      const float* Xn = xsrc_row(p, L.l, tokn);
      const float* Yn = (const float*)(p.ws + OFF_HA) + (size_t)tokn * 1024;
#pragma unroll
      for (int q = 0; q < 4; ++q) { yn[q] = *(const float4*)(Yn + lane * 4 + q * 256); xn[q] = *(const float4*)(Xn + lane * 4 + q * 256); }
    }
    float* X = (float*)(p.ws + OFF_X) + (size_t)tok * 1024;
    const float* mod = L.mod + (size_t)tok_modrow(tok) * 6144;
    float xv[16], h[16];
    float ss = 0.f;
#pragma unroll
    for (int q = 0; q < 4; ++q) ss += yr[q].x * yr[q].x + yr[q].y * yr[q].y + yr[q].z * yr[q].z + yr[q].w * yr[q].w;
    ss = wave_sum(ss);
    const float rs = rsqrtf(ss * (1.f / 1024.f) + EPS);
#pragma unroll
    for (int q = 0; q < 4; ++q) {
      const int c = lane * 4 + q * 256;
      float4 xo = xr[q], gv = *(const float4*)(gpm + c), gt = *(const float4*)(mod + 2048 + c);
      xo.x += gt.x * yr[q].x * rs * gv.x; xo.y += gt.y * yr[q].y * rs * gv.y; xo.z += gt.z * yr[q].z * rs * gv.z; xo.w += gt.w * yr[q].w * rs * gv.w;
      *(float4*)(X + c) = xo;
      xv[q * 4] = xo.x; xv[q * 4 + 1] = xo.y; xv[q * 4 + 2] = xo.z; xv[q * 4 + 3] = xo.w;
    }
    bf16* H2 = (bf16*)(p.ws + OFF_P1) + (size_t)NTOK * 1024 + (size_t)tok * 1024;
    normmod_row(xv, p.in[I_GPREFFN] + L.l * 1024, mod + 3072, mod + 4096, H2, h);
    float lg[16];
#pragma unroll
    for (int e = 0; e < 16; ++e) lg[e] = 0.f;
#pragma unroll
    for (int q = 0; q < 16; ++q) {
      const int pos = ((q >> 2) * 4 + (q & 3)) * 64 + lane;
      float4 a = wl[pos], b4 = wl[1024 + pos], c4 = wl[2048 + pos], d4 = wl[3072 + pos];
      float hv = h[q];
      lg[0] += hv * a.x; lg[1] += hv * a.y; lg[2] += hv * a.z; lg[3] += hv * a.w;
      lg[4] += hv * b4.x; lg[5] += hv * b4.y; lg[6] += hv * b4.z; lg[7] += hv * b4.w;
      lg[8] += hv * c4.x; lg[9] += hv * c4.y; lg[10] += hv * c4.z; lg[11] += hv * c4.w;
      lg[12] += hv * d4.x; lg[13] += hv * d4.y; lg[14] += hv * d4.z; lg[15] += hv * d4.w;
    }
    float mx = -INFINITY;
#pragma unroll
    for (int e = 0; e < 16; ++e) { lg[e] = wave_sum(lg[e]); mx = fmax_(mx, lg[e]); }
    float se = 0.f;
#pragma unroll
    for (int e = 0; e < 16; ++e) { lg[e] = expf(lg[e] - mx); se += lg[e]; }
    if (lane < 16) {
      float v = 0.f;
#pragma unroll
      for (int e = 0; e < 16; ++e) if (e == lane) v = lg[e];
      ((float*)(p.ws + OFF_AFF))[(size_t)lane * NTOK + tok] = v / se;
    }
    if (!has) break;
    i = inext; tok = tokn;
#pragma unroll
    for (int q = 0; q < 4; ++q) { yr[q] = yn[q]; xr[q] = xn[q]; }
  }
}
DI int block_sum_(int v, int* sred, int round) {
  const int tid = tid_(), lane = tid & 63, wid = tid >> 6;
  v += shfl_xor_(v, 32); v += shfl_xor_(v, 16); v += shfl_xor_(v, 8); v += shfl_xor_(v, 4); v += shfl_xor_(v, 2); v += shfl_xor_(v, 1);
  int* r = sred + (round & 1) * NWAVES;
  if (lane == 0) r[wid] = v;
  __syncthreads();
  int tsum = 0;
#pragma unroll
  for (int q = 0; q < NWAVES; ++q) tsum += r[q];
  return tsum;
}
DI void route_item(const Params& p, const LP& L, int it, char* smem) {
  const int nstream = L.last ? 1 : 2;
  const int b = it / (16 * nstream), e = (it / nstream) & 15, ctxs = (nstream == 2) ? (it & 1) : 0;
  const int T = ctxs ? CTXL : SEQ, cap = ctxs ? CAP_C : CAP_L;
  const int tok0 = b * TOK + (ctxs ? 0 : CTXL);
  const int slot0 = ctxs ? (BATCH * CAP_L + b * CAP_C) : (b * CAP_L);
  int* sred = (int*)smem;
  const float* AFF = (const float*)(p.ws + OFF_AFF) + (size_t)e * NTOK + tok0;
  int* SEL = (int*)(p.ws + OFF_SEL);
  int* IDX = (int*)(p.ws + OFF_IDX) + (size_t)e * ESLOTS;
  float* GW = (float*)(p.ws + OFF_GW) + (size_t)e * ESLOTS;
  const int tid = tid_(), lane = tid & 63, wid = tid >> 6;
  constexpr int MAXPER = (SEQ + NTHREADS - 1) / NTHREADS;
  const int per = (T + NTHREADS - 1) / NTHREADS;
  unsigned key[MAXPER];
  __syncthreads();
#pragma unroll
  for (int k = 0; k < MAXPER; ++k) {
    int i = tid * per + k;
    key[k] = (k < per && i < T) ? (__float_as_uint(AFF[i]) + 1u) : 0u;
  }
  unsigned thr = 0u;
  int round = 0;
  for (int bit = 30; bit >= 0; --bit) {
    const unsigned cand = thr | (1u << bit);
    int c = 0;
#pragma unroll
    for (int k = 0; k < MAXPER; ++k) c += (key[k] >= cand) ? 1 : 0;
    c = block_sum_(c, sred, round++);
    if (c >= cap) thr = cand;
  }
  int cg = 0, ce = 0;
#pragma unroll
  for (int k = 0; k < MAXPER; ++k) { cg += (key[k] > thr) ? 1 : 0; ce += (key[k] == thr) ? 1 : 0; }
  const int tot_gt = block_sum_(cg, sred, round++);
  const int need_eq = cap - tot_gt;
  int v = cg | (ce << 16), inc = v;
#pragma unroll
  for (int d = 1; d < 64; d <<= 1) { int o = shfl_up_(inc, d); if (lane >= d) inc += o; }
  int* soff = sred + 2 * NWAVES;
  __syncthreads();
  if (lane == 63) soff[wid] = inc;
  __syncthreads();
  int base = 0;
  for (int w = 0; w < wid; ++w) base += soff[w];
  int excl = base + inc - v;
  int gt_before = excl & 0xffff, eq_before = excl >> 16;
#pragma unroll
  for (int k = 0; k < MAXPER; ++k) {
    int i = tid * per + k;
    if (k < per && i < T) {
      const bool isgt = key[k] > thr, iseq = key[k] == thr;
      const bool sel = isgt || (iseq && eq_before < need_eq);
      const int slot = slot0 + gt_before + (eq_before < need_eq ? eq_before : need_eq);
      if (sel) { IDX[slot] = tok0 + i; GW[slot] = __uint_as_float(key[k] - 1u); SEL[(size_t)(tok0 + i) * 16 + e] = slot; }
      else SEL[(size_t)(tok0 + i) * 16 + e] = -1;
      gt_before += isgt ? 1 : 0; eq_before += iseq ? 1 : 0;
    }
  }
}
DI void moe1_tile(const Params& p, const LP& L, int t, char* smem) {
  const int nslots = L.last ? ESLOTS_L : ESLOTS;
  constexpr int MT_L = (ESLOTS_L + 255) / 256, MT_A = (ESLOTS + 255) / 256;
  const int nt = t & 7, sq = t >> 3;
  const int e = L.last ? sq / MT_L : sq / MT_A, mt = L.last ? sq % MT_L : sq % MT_A;
  const int m0 = mt * 256, n0 = nt * 256;
  GA g = make_ga((const bf16*)(p.ws + OFF_P1) + (size_t)NTOK * 1024, 1024, (const bf16*)(p.ws + OFF_MIX + WX_GU) + (size_t)e * 2048 * 1024, 1024, 1024, nslots);
  g.ridx = (const int*)(p.ws + OFF_IDX) + (size_t)e * ESLOTS;
  f32x4 acc[2][2][4][2];
  gemm_big(g, m0, n0, smem, acc);
  bf16* ACT = (bf16*)(p.ws + OFF_PG) + (size_t)e * ESLOTS * 1024;
  {
    const int l = tid_() & 63, w = tid_() >> 6, wr = w >> 2, wc = w & 3, fr = l & 15, fq = l >> 4;
#pragma unroll
    for (int ai = 0; ai < 2; ++ai)
#pragma unroll
      for (int m = 0; m < 4; ++m) {
        const int row = m0 + ai * 128 + wr * 64 + m * 16 + fr;
        float a[8];
#pragma unroll
        for (int k = 0; k < 4; ++k) { a[k] = siluf_(acc[ai][0][m][0][k]) * acc[ai][1][m][0][k]; a[4 + k] = siluf_(acc[ai][0][m][1][k]) * acc[ai][1][m][1][k]; }
        if (row < nslots) st8bf(ACT + (size_t)row * 1024 + nt * 128 + wc * 32 + 8 * fq, a);
      }
  }
}
DI void moe2_tile(const Params& p, const LP& L, int t, char* smem) {
  const int nslots = L.last ? ESLOTS_L : ESLOTS;
  constexpr int MT_L = (ESLOTS_L + 255) / 256, MT_A = (ESLOTS + 255) / 256;
  const int x = t & 7, nt = x & 3, sq = (t >> 3) * 2 + (x >> 2);
  const int e = L.last ? sq / MT_L : sq / MT_A, mt = L.last ? sq % MT_L : sq % MT_A;
  if (e >= NE) return;
  const int m0 = mt * 256, n0 = nt * 256;
  GA g = make_ga((const bf16*)(p.ws + OFF_PG) + (size_t)e * ESLOTS * 1024, 1024, (const bf16*)(p.ws + OFF_MIX + WX_DN) + (size_t)e * 1024 * 1024, 1024, 1024, nslots);
  f32x4 acc[2][2][4][2];
  gemm_big(g, m0, n0, smem, acc);
  bf16* YS = (bf16*)(p.ws + OFF_PG) + (size_t)NE * ESLOTS * 1024 + (size_t)e * ESLOTS * 1024;
  const float* GW = (const float*)(p.ws + OFF_GW) + (size_t)e * ESLOTS;
  EPIB_BEGIN(acc, m0, n0, nslots)
    const float gw = GW[row];
#pragma unroll
    for (int k = 0; k < 8; ++k) v[k] *= gw;
    st8bf(YS + (size_t)row * 1024 + col, v);
  EPIB_END
}
DI int uni_(int v) {
#ifdef EMU
  return v;
#else
  return __builtin_amdgcn_readfirstlane(v);
#endif
}
DI void comb_phase(const Params& p, const LP& L) {
  const int lane = tid_() & 63, gw = (int)blockIdx.x * NWAVES + (tid_() >> 6), TW = (int)gridDim.x * NWAVES;
  const int n = post_ntok(L.last);
  if (gw >= n) return;
  const bf16* YS = (const bf16*)(p.ws + OFF_PG) + (size_t)NE * ESLOTS * 1024;
  const float* gpf = p.in[I_GPOSTFFN] + L.l * 1024;
  int i = gw, tok = post_tok(i, L.last);
  uint4 sel[4]; float4 xr[4];
  {
    const uint4* sp = (const uint4*)((const int*)(p.ws + OFF_SEL) + (size_t)tok * 16);
    const float* X = (const float*)(p.ws + OFF_X) + (size_t)tok * 1024;
#pragma unroll
    for (int q = 0; q < 4; ++q) { sel[q] = sp[q]; xr[q] = *(const float4*)(X + lane * 4 + q * 256); }
  }
  for (;;) {
    const int inext = i + TW; const bool has = inext < n; const int tokn = has ? post_tok(inext, L.last) : tok;
    float s[16];
#pragma unroll
    for (int q = 0; q < 16; ++q) s[q] = 0.f;
#pragma unroll
    for (int e = 0; e < 16; ++e) {
      const unsigned sv = (e & 3) == 0 ? sel[e >> 2].x : (e & 3) == 1 ? sel[e >> 2].y : (e & 3) == 2 ? sel[e >> 2].z : sel[e >> 2].w;
      const int sl = uni_((int)sv);
      if (sl >= 0) {
        const bf16* yr = YS + ((size_t)e * ESLOTS + sl) * 1024;
#pragma unroll
        for (int q = 0; q < 4; ++q) {
          uint2 w = *(const uint2*)(yr + lane * 4 + q * 256);
          s[q * 4] += __uint_as_float(w.x << 16); s[q * 4 + 1] += __uint_as_float(w.x & 0xffff0000u);
          s[q * 4 + 2] += __uint_as_float(w.y << 16); s[q * 4 + 3] += __uint_as_float(w.y & 0xffff0000u);
        }
      }
    }
    uint4 seln[4]; float4 xn[4];
    {
      const uint4* sp = (const uint4*)((const int*)(p.ws + OFF_SEL) + (size_t)tokn * 16);
      const float* Xn = (const float*)(p.ws + OFF_X) + (size_t)tokn * 1024;
#pragma unroll
      for (int q = 0; q < 4; ++q) { seln[q] = sp[q]; xn[q] = *(const float4*)(Xn + lane * 4 + q * 256); }
    }
    float ss = 0.f;
#pragma unroll
    for (int q = 0; q < 16; ++q) ss += s[q] * s[q];
    ss = wave_sum(ss);
    const float rs = rsqrtf(ss * (1.f / 1024.f) + EPS);
    const float* mod = L.mod + (size_t)tok_modrow(tok) * 6144;
    float* dst = (float*)(p.ws + OFF_X) + (size_t)tok * 1024;
    if (L.last) { const int b = tok_b(tok), j = tok_j(tok); dst = p.out + ((size_t)b * SEQ + (j - CTXL)) * 1024; }
    float xv[16], h[16];
#pragma unroll
    for (int q = 0; q < 4; ++q) {
      const int c = lane * 4 + q * 256;
      float4 xo = xr[q], gv = *(const float4*)(gpf + c), gt = *(const float4*)(mod + 5120 + c);
      xo.x += gt.x * s[q * 4] * rs * gv.x; xo.y += gt.y * s[q * 4 + 1] * rs * gv.y; xo.z += gt.z * s[q * 4 + 2] * rs * gv.z; xo.w += gt.w * s[q * 4 + 3] * rs * gv.w;
      *(float4*)(dst + c) = xo;
      xv[q * 4] = xo.x; xv[q * 4 + 1] = xo.y; xv[q * 4 + 2] = xo.z; xv[q * 4 + 3] = xo.w;
    }
    if (!L.last) {
      const float* mod1 = (const float*)(p.ws + OFF_MOD) + ((size_t)(L.l + 1) * NB1 + tok_modrow(tok)) * 6144;
      normmod_row(xv, p.in[I_GPREMIX] + (L.l + 1) * 1024, mod1, mod1 + 1024, (bf16*)(p.ws + OFF_HA) + (size_t)tok * 1024, h);
    }
    if (!has) break;
    i = inext; tok = tokn;
#pragma unroll
    for (int q = 0; q < 4; ++q) { sel[q] = seln[q]; xr[q] = xn[q]; }
  }
}

enum { PH_PREP0 = 0, PH_PREP1, PH_L0 };
enum { LP_INPROJ = 0, LP_TOKPREP, LP_MIX1, LP_MIX2, LP_GLU, LP_MERGE, LP_OUT, LP_POST, LP_ROUTE, LP_MOE1, LP_MOE2, LP_COMB, LP_COUNT };
constexpr int NPHASES = PH_L0 + DEPTH * LP_COUNT;


DI void run_phase(const Params& p, int ph, char* smem) {
  const int G = gridDim.x;
  int start = blockIdx.x;
  auto seg = [&](int n, auto&& fn) {
    for (; start < n; start += G) fn(start);
    start -= n;
  };
#ifdef ONLY_PREP
  if (ph >= PH_L0) return;
#endif
  if (ph == PH_PREP0) {
    seg(DEPTH * 96, [&](int it) { mod_item(p, it, smem); });
    seg(DEPTH * 32, [&](int it) { s5_tab_item(p, it, smem); });
    seg(1, [&](int) { rope_tab_item(p); });
    seg(DEPTH * CT_EARLY, [&](int it) { conv_early_item(p, it / CT_EARLY, it % CT_EARLY, smem); });
    return;
  }
  if (ph == PH_PREP1) {
    seg(DEPTH * 256, [&](int it) { s5_mat_item(p, it); });
    seg(NTOK / NWAVES, [&](int it) { prep_row_item(p, it); });
    return;
  }
#ifdef ONLY_LPH
  if (ph < PH_L0) return;
#endif
  const int l = (ph - PH_L0) / LP_COUNT;
#ifdef ONLY_LPH
  const int lph = ONLY_LPH;
#else
  const int lph = (ph - PH_L0) % LP_COUNT;
#endif
  const LP L = make_lp(p, l);
  switch (lph) {
    case LP_INPROJ:
      seg(L.last ? IP_SLOTS_LAST : IP_SLOTS_ALL, [&](int it) { inproj_tile(p, L, it, smem); });
      break;
    case LP_TOKPREP:
      seg(16 * S5_MT * 2, [&](int it) { s5a_tile(p, L, it, smem); });
      seg(TP_MT * 3, [&](int it) { mlaq_tile(p, L, it, smem); });
      seg(TP_MT * 4, [&](int it) { mlakv_tile(p, L, it, smem); });
      seg(NTOK / 64, [&](int it) { navt_item(p, it, smem); });
      seg(M2C_ITEMS, [&](int it) { m2conv_item(p, L, it); });
      seg(M2S_ITEMS, [&](int it) { m2scal_item(p, L, it); });
      break;
    case LP_MIX1: {
      const int n0 = BATCH * 4, n1 = n0 + 2 * 16 * BATCH / NWAVES, n2 = n1 + BATCH * 4 * (SEQ / 256), n3 = n2 + BATCH * 4 * (SEQ / 256);
      const int n4 = n3 + (L.last ? 0 : BATCH * 4 * ((CTXL + 255) / 256)), n5 = n4 + (L.last ? 0 : BATCH * 4 * ((CTXL + 255) / 256));
      int* qhead = (int*)(p.ws + OFF_BAR) + Q_WORD0 + 64 * (l + 2 * p.probe_rep);
#ifdef EMU
      volatile int* bc = (volatile int*)(smem + SMEM_BYTES + 8);
#else
      volatile LAS int* bc = (volatile LAS int*)(smem + SMEM_BYTES + 8);
#endif
      for (;;) {
        __syncthreads();
        if (tid_() == 0) {
#ifdef EMU
          *bc = atomicAdd(qhead, 1);
#else
          *bc = __hip_atomic_fetch_add(qhead, 1, __ATOMIC_RELAXED, __HIP_MEMORY_SCOPE_AGENT);
#endif
        }
        __syncthreads();
        const int it = *bc;
        if (it >= n5) break;
        if (it < n0) m2scan_item(p, L, it, smem);
        else if (it < n1) s5carry_item(p, L, it - n0);
        else if (it < n2) mla_attn_item(p, it - n1, false, smem);
        else if (it < n3) na_attn_item(p, L, it - n2, false, smem);
        else if (it < n4) mla_attn_item(p, it - n3, true, smem);
        else na_attn_item(p, L, it - n4, true, smem);
      }
    } break;
    case LP_MIX2:
      seg(16 * S5_MT * 2, [&](int it) { s5c_tile(p, L, it, smem); });
      seg(NTOK / NWAVES, [&](int it) { m2gate_item(p, L, it); });
      break;
    case LP_GLU:
      seg(GLU_MT * 2, [&](int it) { glu_tile(p, L, it, smem); });
      break;
    case LP_MERGE:
      seg(mtiles(L.last, 256) * 8, [&](int it) { merge_tile(p, L, it, smem); });
      break;
    case LP_OUT:
      seg(mtiles(L.last, 256) * 4, [&](int it) { outproj_tile(p, L, it, smem); });
      break;
    case LP_POST:
      seg(CT_EXP, [&](int it) { conv_expert_item(p, l, it, smem); });
      post_stage_router(p, L, smem);
      post_phase(p, L, smem);
      break;
    case LP_ROUTE:
      seg(BATCH * 16 * (L.last ? 1 : 2), [&](int it) { route_item(p, L, it, smem); });
      break;
    case LP_MOE1:
      seg(NE * (((L.last ? ESLOTS_L : ESLOTS) + 255) / 256) * 8, [&](int it) { moe1_tile(p, L, it, smem); });
      break;
    case LP_MOE2:
      seg(((NE * (((L.last ? ESLOTS_L : ESLOTS) + 255) / 256) + 1) / 2) * 8, [&](int it) { moe2_tile(p, L, it, smem); });
      break;
    case LP_COMB:
      comb_phase(p, L);
      break;
  }
}

__global__ void __launch_bounds__(NTHREADS, 2) mega_kernel(Params p) {
#ifdef EMU
  char* smem = emu_cur_f->blk->smem;
  for (int ph = p.phase_lo; ph < p.phase_hi; ++ph) {
    run_phase(p, ph, smem);
    if (ph + 1 < p.phase_hi) emu_grid_sync();
  }
#else
  __shared__ __attribute__((aligned(16))) char smem[SMEM_BYTES + 16 + 256];
  {
    const unsigned hw = (unsigned)__builtin_amdgcn_s_getreg((5 << 11) | 4) & 0x3fu;
    if ((threadIdx.x & 63) == 0) *(volatile int*)(smem + WAVE_TAB_OFF + hw * 4u) = (int)(threadIdx.x >> 6);
    __syncthreads();
  }
  if (p.phase_hi - p.phase_lo > 1) {
    if (threadIdx.x == 0) *(uint4*)(smem + SMEM_BYTES) = make_uint4(0u, 0u, 0u, 0u);
    __syncthreads();
    XcdBarrier xb = xcd_barrier_post((unsigned*)(p.ws + OFF_BAR), (volatile LAS unsigned*)(smem + SMEM_BYTES));
    for (int ph = p.phase_lo; ph < p.phase_hi; ++ph) {
      int reps = 1;
#ifdef PROBE_PHASE
      if (ph == PROBE_PHASE || ph == PROBE_PHASE2) reps = 1 + PROBE_REP;
#endif
      for (int rep = 0; rep < reps; ++rep) {
        p.probe_rep = rep;
        run_phase(p, ph, smem);
        if (ph + 1 < p.phase_hi || rep + 1 < reps) {
          if (ph == p.phase_lo && rep == 0) cg::this_grid().sync();
          else xcd_barrier(xb);
        }
      }
    }
  } else {
    run_phase(p, p.phase_lo, smem);
  }
#endif
}

#ifndef EMU
extern "C" void kernel_launch(void* const* d_in, const int* in_sizes, int n_in, void* d_out, int out_size, void* d_ws, size_t ws_size,
                              hipStream_t stream) {
  static int grid_blocks = 0;
  if (!grid_blocks) {
    int dev = 0, cus = 0, per_cu = 0;
    hipGetDevice(&dev);
    hipDeviceGetAttribute(&cus, hipDeviceAttributeMultiprocessorCount, dev);
    hipOccupancyMaxActiveBlocksPerMultiprocessor(&per_cu, mega_kernel, NTHREADS, 0);
    if (per_cu > 1) per_cu = 1;
    if (per_cu < 1) per_cu = 1;
    grid_blocks = cus * per_cu;
    if (ws_size < WS_TOTAL) fprintf(stderr, "workspace too small: %zu < %zu\n", ws_size, (size_t)WS_TOTAL);
  }
  Params p{};
  for (int i = 0; i < N_INPUTS; ++i) p.in[i] = (const float*)d_in[i];
  p.out = (float*)d_out;
  p.ws = (char*)d_ws;
#if MK_MULTI
  for (int ph = 0; ph < NPHASES; ++ph) {
    p.phase_lo = ph; p.phase_hi = ph + 1;
    hipLaunchKernelGGL(mega_kernel, dim3(grid_blocks), dim3(NTHREADS), 0, stream, p);
  }
#else
  p.phase_lo = 0; p.phase_hi = NPHASES;
  hipMemsetAsync((char*)d_ws + OFF_BAR, 0, BAR_BYTES, stream);
  void* args[] = {&p};
  hipError_t e = hipLaunchCooperativeKernel((void*)mega_kernel, dim3(grid_blocks), dim3(NTHREADS), args, 0, stream);
  if (e != hipSuccess) fprintf(stderr, "cooperative launch failed: %s (grid %d)\n", hipGetErrorString(e), grid_blocks);
#endif
}
#endif
```

```cpp
#ifdef EMU
#include "emu.h"
#else
#include <hip/hip_runtime.h>
#include <hip/hip_cooperative_groups.h>
#include <cstdio>
namespace cg = cooperative_groups;
using bf16x8 = __attribute__((ext_vector_type(8))) short;
using f32x4 = __attribute__((ext_vector_type(4))) float;
using f32x16 = __attribute__((ext_vector_type(16))) float;
#endif
using u32x4 = __attribute__((ext_vector_type(4))) unsigned;
#ifndef MK_MULTI
#define MK_MULTI 0
#endif

#define DI __device__ __forceinline__
typedef unsigned short bf16;

#ifdef EMU_SMALL2
constexpr int BATCH = 2, SEQ = 1024, CTXL = 64, GRID_W = 32;
#elif defined(EMU_SMALL)
constexpr int BATCH = 2, SEQ = 512, CTXL = 64, GRID_W = 32;
#else
constexpr int BATCH = 8, SEQ = 2048, CTXL = 256, GRID_W = 64;
#endif
constexpr int D = 1024, DEPTH = 2;
constexpr int TOK = CTXL + SEQ, NTOK = BATCH * TOK;
constexpr int ROWS = SEQ / GRID_W;
constexpr int WIN_R = (ROWS < 8 ? ROWS : 8), WIN_C = 16;
constexpr int N_IN = 6568, N_INP = 6656;
constexpr int C_CQ = 0, C_CKV = 256, C_KR = 384, C_NA = 416, C_S5 = 1184, C_Z = 1440, C_XBC = 1696, C_DT = 2464, C_GATE = 2472;
constexpr int P1W = 2480;
constexpr int NCH = TOK / 16, NCC = CTXL / 16, MCH = BATCH * NCH;
constexpr int NE = 16;
constexpr int CAP_L = 2 * SEQ / NE, CAP_C = 2 * CTXL / NE;
constexpr int ESLOTS = BATCH * (CAP_L + CAP_C), ESLOTS_L = BATCH * CAP_L;
constexpr int NB1 = BATCH + 1;
constexpr float EPS = 1e-6f;
constexpr int SMEM_BYTES = 147456;
constexpr int NTHREADS = 512, NWAVES = NTHREADS / 64;

enum { I_X = 0, I_C, I_CTX, I_CCTX, I_WADA, I_BADA, I_GPREMIX, I_GPOSTMIX, I_GPREFFN, I_GPOSTFFN, I_WIN, I_GCQ, I_GCKV, I_WUQ, I_WUKV, I_RPB,
       I_S5ARE, I_S5AIM, I_S5LOGSTEP, I_S5BRE, I_S5BIM, I_S5CRE, I_S5CIM, I_S5D, I_S5WGLU, I_S5BGLU, I_M2CONVW, I_M2CONVB, I_M2ALOG, I_M2DTBIAS,
       I_M2D, I_M2GNORM, I_WBRANCH, I_WOUT, I_WROUTER, I_WGATE, I_WUP, I_WDOWN, N_INPUTS };

constexpr size_t al256(size_t x) { return (x + 255) & ~(size_t)255; }
constexpr size_t SZ_X = (size_t)NTOK * D * 4;
constexpr size_t SZ_ROWBF = (size_t)NTOK * D * 2;
constexpr size_t OFF_X = 0;
constexpr size_t OFF_MOD = OFF_X + al256(SZ_X);
constexpr size_t OFF_HA = OFF_MOD + al256((size_t)DEPTH * NB1 * 6144 * 4);
constexpr size_t OFF_O = OFF_HA + al256(SZ_ROWBF);
constexpr size_t OFF_P1 = OFF_O + al256(SZ_ROWBF);
constexpr size_t SZ_P1 = (size_t)NTOK * P1W * 2;
constexpr size_t OFF_PG = OFF_P1 + al256(SZ_P1);
constexpr size_t SZ_PG = (size_t)NTOK * 4096 * 2;
constexpr size_t OFF_DT = OFF_PG + al256(SZ_PG);
constexpr size_t OFF_AFF = OFF_DT + al256((size_t)NTOK * 8 * 4);
constexpr size_t OFF_SEL = OFF_AFF + al256((size_t)NTOK * 16 * 4);
constexpr size_t OFF_IDX = OFF_SEL + al256((size_t)NTOK * 16 * 4);
constexpr size_t OFF_GW = OFF_IDX + al256((size_t)NE * ESLOTS * 4);
constexpr size_t OFF_BAR = OFF_GW + al256((size_t)NE * ESLOTS * 4);
constexpr size_t BAR_BYTES = (3456 + 64 * 4) * 4;
constexpr int Q_WORD0 = 3456;
constexpr size_t OFF_ROPE = OFF_BAR + al256(BAR_BYTES);
constexpr size_t OFF_WEARLY = OFF_ROPE + al256(64 * 8 * 2 * 4);
constexpr size_t WE_WIN = 0;
constexpr size_t WE_UQ = WE_WIN + (size_t)N_INP * 1024 * 2;
constexpr size_t WE_UKV = WE_UQ + (size_t)384 * 256 * 2;
constexpr size_t WE_GLU = WE_UKV + (size_t)512 * 128 * 2;
constexpr size_t WE_WB = WE_GLU + (size_t)256 * 256 * 2;
constexpr size_t WE_WOUT = WE_WB + (size_t)4 * 1024 * 256 * 2;
constexpr size_t WE_SIZE = al256(WE_WOUT + (size_t)1024 * 1024 * 2);
constexpr size_t OFF_S5TAB = OFF_WEARLY + DEPTH * WE_SIZE;
constexpr size_t S5_LAMPOW = 0;
constexpr size_t S5_BBAR = S5_LAMPOW + (size_t)2 * 16 * 17 * 64 * 2 * 4;
constexpr size_t S5_KT = S5_BBAR + (size_t)2 * 16 * 64 * 16 * 2 * 4;
constexpr size_t S5_WA = S5_KT + (size_t)2 * 16 * 16 * 256 * 4;
constexpr size_t S5_W2 = S5_WA + (size_t)16 * 256 * 256 * 2;
constexpr size_t S5_SIZE = al256(S5_W2 + (size_t)16 * 256 * 512 * 2);
constexpr size_t OFF_MIX = OFF_S5TAB + DEPTH * S5_SIZE;
constexpr size_t MX_Q = 0;
constexpr size_t MX_K = MX_Q + al256((size_t)BATCH * 4 * TOK * 96 * 2);
constexpr size_t MX_VTM = MX_K + al256((size_t)BATCH * 4 * TOK * 96 * 2);
constexpr size_t MX_VTN = MX_VTM + al256((size_t)BATCH * 4 * 64 * TOK * 2);
constexpr size_t MX_XBC = MX_VTN + al256((size_t)BATCH * 4 * 64 * TOK * 2);
constexpr size_t MX_US5 = MX_XBC + al256((size_t)NTOK * 768 * 2);
constexpr size_t MX_HEND = MX_US5 + al256((size_t)NTOK * 256 * 2);
constexpr size_t MX_HIN = MX_HEND + al256((size_t)16 * MCH * 256 * 4);
constexpr size_t MX_Z = MX_HIN + al256((size_t)16 * MCH * 256 * 2);
constexpr size_t MX_XBT = MX_Z + al256((size_t)NTOK * 256 * 2);
constexpr size_t MX_M2S = MX_XBT + al256((size_t)NTOK * 512 * 2);
constexpr size_t MX_SIZE = MX_M2S + al256((size_t)BATCH * 8 * TOK * 4 * 4);
constexpr size_t WX_GU = 0;
constexpr size_t WX_DN = WX_GU + (size_t)NE * 2048 * 1024 * 2;
constexpr size_t WX_SIZE = WX_DN + (size_t)NE * 1024 * 1024 * 2;
constexpr size_t MIXREG = (MX_SIZE > WX_SIZE ? MX_SIZE : WX_SIZE);
constexpr size_t WS_TOTAL = OFF_MIX + al256(MIXREG);

struct Params {
  const float* in[N_INPUTS];
  float* out;
  char* ws;
  int phase_lo, phase_hi;
  int probe_rep, pad_;
};

constexpr int WAVE_TAB_OFF = SMEM_BYTES + 16;
DI int tid_() {
#ifdef EMU
  return (int)threadIdx.x;
#else
  const unsigned hw = (unsigned)__builtin_amdgcn_s_getreg((5 << 11) | 4) & 0x3fu;
  const int wave = *(volatile __attribute__((address_space(3))) int*)(unsigned long)(WAVE_TAB_OFF + hw * 4u);
  int lane;
  asm volatile("v_mbcnt_lo_u32_b32 %0, -1, 0\n\tv_mbcnt_hi_u32_b32 %0, -1, %0" : "=v"(lane));
  return wave * 64 + lane;
#endif
}
#ifdef EMU
template <class T> DI T shfl_xor_(T v, int m) { return __shfl_xor(v, m); }
template <class T> DI T shfl_up_(T v, int d) { return __shfl_up(v, d); }
template <class T> DI T shfl_(T v, int src) { return __shfl(v, src); }
#else
template <class T> DI T shfl_xor_(T v, int m) {
  const int idx = ((tid_() & 63) ^ m) << 2;
  return __builtin_bit_cast(T, __builtin_amdgcn_ds_bpermute(idx, __builtin_bit_cast(int, v)));
}
template <class T> DI T shfl_up_(T v, int d) {
  const int l = tid_() & 63; const int idx = (l >= d ? l - d : l) << 2;
  return __builtin_bit_cast(T, __builtin_amdgcn_ds_bpermute(idx, __builtin_bit_cast(int, v)));
}
template <class T> DI T shfl_(T v, int src) {
  int idx = src << 2; asm volatile("" : "+v"(idx));
  return __builtin_bit_cast(T, __builtin_amdgcn_ds_bpermute(idx, __builtin_bit_cast(int, v)));
}
#endif
DI float bf2f(bf16 h) { return __uint_as_float(((unsigned)h) << 16); }
DI bf16 f2bf(float f) { unsigned u = __float_as_uint(f); u += 0x7fffu + ((u >> 16) & 1u); return (bf16)(u >> 16); }
#ifdef EMU
DI unsigned pack2(float a, float b) { return (unsigned)f2bf(a) | ((unsigned)f2bf(b) << 16); }
DI float exp2f_(float x) { return exp2f(x); }
#else
typedef float f32x2_t_ __attribute__((ext_vector_type(2)));
typedef __bf16 bf16x2_t_ __attribute__((ext_vector_type(2)));
DI unsigned pack2(float a, float b) { const f32x2_t_ v = {a, b}; return __builtin_bit_cast(unsigned, __builtin_convertvector(v, bf16x2_t_)); }
DI float exp2f_(float x) { return __builtin_amdgcn_exp2f(x); }
#endif
#ifdef EMU
DI float rcp_(float x) { return 1.0f / x; }
#else
DI float rcp_(float x) { return __builtin_amdgcn_rcpf(x); }
#endif
DI float sigmoidf_(float x) { return rcp_(1.0f + exp2f_(-1.4426950408889634f * x)); }
DI float siluf_(float x) { return x * rcp_(1.0f + exp2f_(-1.4426950408889634f * x)); }
DI float softplusf_(float x) { const float ax = x < 0.f ? -x : x; return (x > 0.f ? x : 0.f) + __logf(1.0f + __expf(-ax)); }
DI float geluf_(float x) { const float u2 = 1.5957691216057308f * (x + 0.044715f * x * x * x); return x * rcp_(1.0f + exp2f_(-1.4426950408889634f * u2)); }
DI bool wave_all_(bool c) {
#ifdef EMU
  int v = c ? 0 : 1;
  v += shfl_xor_(v, 32); v += shfl_xor_(v, 16); v += shfl_xor_(v, 8); v += shfl_xor_(v, 4); v += shfl_xor_(v, 2); v += shfl_xor_(v, 1);
  return v == 0;
#else
  return __builtin_amdgcn_ballot_w64(!c) == 0ull;
#endif
}
DI float wave_sum(float v) {
#ifdef EMU
  v += shfl_xor_(v, 32); v += shfl_xor_(v, 16); v += shfl_xor_(v, 8); v += shfl_xor_(v, 4); v += shfl_xor_(v, 2); v += shfl_xor_(v, 1);
  return v;
#else
  int x = __float_as_int(v);
  x = __float_as_int(__int_as_float(x) + __int_as_float(__builtin_amdgcn_update_dpp(0, x, 0xB1, 0xF, 0xF, true)));
  x = __float_as_int(__int_as_float(x) + __int_as_float(__builtin_amdgcn_update_dpp(0, x, 0x4E, 0xF, 0xF, true)));
  x = __float_as_int(__int_as_float(x) + __int_as_float(__builtin_amdgcn_update_dpp(0, x, 0x141, 0xF, 0xF, true)));
  x = __float_as_int(__int_as_float(x) + __int_as_float(__builtin_amdgcn_update_dpp(0, x, 0x140, 0xF, 0xF, true)));
  const float r0 = __int_as_float(__builtin_amdgcn_readlane(x, 0)), r1 = __int_as_float(__builtin_amdgcn_readlane(x, 16));
  const float r2 = __int_as_float(__builtin_amdgcn_readlane(x, 32)), r3 = __int_as_float(__builtin_amdgcn_readlane(x, 48));
  return (r0 + r1) + (r2 + r3);
#endif
}
#ifndef EMU
#define XB_TMO      128
#define XB_XCNT(j)  (256  + 64 * (j))
#define XB_XSUB(j)  (1280 + 64 * (j))
#define XB_XGEN(j)  (2304 + 64 * (j))
#define XB_TOP      3328
#define XB_TOPGEN   3392
#define XB_SPIN_CAP (1u << 24)
#define LAS __attribute__((address_space(3)))
DI unsigned xb_ld(unsigned* p) { return __hip_atomic_load(p, __ATOMIC_RELAXED, __HIP_MEMORY_SCOPE_AGENT); }
DI unsigned xb_add(unsigned* p, unsigned v) { return __hip_atomic_fetch_add(p, v, __ATOMIC_RELAXED, __HIP_MEMORY_SCOPE_AGENT); }
DI unsigned xb_xcc_id() { return (unsigned)__builtin_amdgcn_s_getreg((3 << 11) | 20) & 0xFu; }
#define XB_SPIN(cond, bar) do { unsigned _sp = 0; while (cond) { __builtin_amdgcn_s_sleep(1); \
    if ((++_sp & 255u) == 0u) { if (xb_ld(&(bar)[XB_TMO])) break; if (_sp > XB_SPIN_CAP) { atomicAdd(&(bar)[XB_TMO], 1u); break; } } } } while (0)
struct XcdBarrier { unsigned* bar; unsigned x; volatile LAS unsigned* st; };
DI XcdBarrier xcd_barrier_post(unsigned* bar, volatile LAS unsigned* st) {
  XcdBarrier b; b.bar = bar; b.x = xb_xcc_id(); b.st = st;
  if (threadIdx.x == 0) (void)xb_add(&bar[XB_XCNT(b.x)], 1u);
  return b;
}
DI void xcd_barrier_complete(unsigned* bar, unsigned x, unsigned& nloc, unsigned& nx) {
  const unsigned G = gridDim.x * gridDim.y * gridDim.z;
  unsigned sum, cnt, mine, sp = 0u;
  for (;;) {
    sum = 0u; cnt = 0u; mine = 0u;
#pragma unroll
    for (unsigned j = 0; j < 16; ++j) { const unsigned c = xb_ld(&bar[XB_XCNT(j)]); sum += c; cnt += (c > 0u) ? 1u : 0u; mine = (j == x) ? c : mine; }
    if (sum == G) break;
    __builtin_amdgcn_s_sleep(1);
    if ((++sp & 255u) == 0u) { if (xb_ld(&bar[XB_TMO])) break; if (sp > XB_SPIN_CAP) { atomicAdd(&bar[XB_TMO], 1u); break; } }
  }
  nloc = mine > 0u ? mine : 1u; nx = cnt > 0u ? cnt : 1u;
}
DI void xcd_barrier(const XcdBarrier& b) {
  asm volatile("s_waitcnt vmcnt(0)" ::: "memory");
  __syncthreads();
  if (threadIdx.x == 0) {
    unsigned* bar = b.bar;
    __builtin_amdgcn_s_waitcnt(0);
    unsigned nloc = b.st[0], nx = b.st[1];
    if (nloc == 0u) { xcd_barrier_complete(bar, b.x, nloc, nx); b.st[0] = nloc; b.st[1] = nx; }
    const unsigned old = xb_add(&bar[XB_XSUB(b.x)], 1u);
    const unsigned gen = old / nloc;
    if (old + 1u == (gen + 1u) * nloc) {
      __builtin_amdgcn_fence(__ATOMIC_RELEASE, "agent");
      asm volatile("s_waitcnt vmcnt(0)" ::: "memory");
      const unsigned og = xb_add(&bar[XB_TOP], 1u);
      const unsigned tg = og / nx;
      if (og + 1u == (tg + 1u) * nx) xb_add(&bar[XB_TOPGEN], 1u);
      else XB_SPIN(xb_ld(&bar[XB_TOPGEN]) == tg, bar);
      __builtin_amdgcn_fence(__ATOMIC_ACQUIRE, "agent");
      xb_add(&bar[XB_XGEN(b.x)], 1u);
      asm volatile("s_waitcnt vmcnt(0)" ::: "memory");
    } else {
      XB_SPIN(xb_ld(&bar[XB_XGEN(b.x)]) == gen, bar);
      __builtin_amdgcn_fence(__ATOMIC_ACQUIRE, "agent");
      asm volatile("s_waitcnt vmcnt(0)" ::: "memory");
    }
  }
  __syncthreads();
}
#endif

struct GA {
  const bf16* A; const bf16* A2; int lda, lda2, ksplit;
  const int* ridx; int mvalid;
  const bf16* Bt; int ldb; int K;
  int kfix;
};
DI GA make_ga(const bf16* A, int lda, const bf16* Bt, int ldb, int K, int mvalid) {
  GA g; g.A = A; g.A2 = A; g.lda = lda; g.lda2 = lda; g.ksplit = K; g.ridx = nullptr; g.mvalid = mvalid; g.Bt = Bt; g.ldb = ldb; g.K = K; g.kfix = 0; return g;
}

#ifdef EMU
#define GLDS16(gptr_, lptr_) memcpy((void*)(lptr_), (const void*)(gptr_), 16)
#define BGLDS16(rsrc_, base_, voff_, soff_, lptr_) memcpy((void*)(lptr_), (const char*)(base_) + (voff_) + (soff_), 16)
#define GEMM_WAIT(N_)
#define RAW_BARRIER() __syncthreads()
#else
#define LASV __attribute__((address_space(3))) void
#define GLDS16(gptr_, lptr_) __builtin_amdgcn_global_load_lds((const void*)(gptr_), (LASV*)(lptr_), 16, 0, 0)
#define BGLDS16(rsrc_, base_, voff_, soff_, lptr_) __builtin_amdgcn_raw_ptr_buffer_load_lds(rsrc_, (LASV*)(lptr_), 16, (int)(voff_), (int)(soff_), 0, 0)
#define GEMM_WAIT(N_) asm volatile("s_waitcnt vmcnt(%0)" :: "n"(N_) : "memory")
#define RAW_BARRIER() { asm volatile("" ::: "memory"); __builtin_amdgcn_s_barrier(); asm volatile("" ::: "memory"); }
#endif
DI int perm32(int rho) { const int n = rho >> 4, i = rho & 15; return 8 * (i >> 2) + 4 * n + (i & 3); }
constexpr int SRS_OFF = 73728;
template <int NT>
DI void gemm_s(const GA& g, int m0, int n0, char* smem, f32x4 (&acc)[4][NT]) {
  constexpr int A_ELEMS = 256 * 32, B_ELEMS = 32 * NT * 32, STAGE = A_ELEMS + B_ELEMS;
  bf16* st = (bf16*)smem;
  const int tid = tid_(), lane = tid & 63, wid = tid >> 6, wr = wid >> 1, wc = wid & 1, fr = lane & 15, fq = lane >> 4;
  const int lrow = tid >> 2, pch = tid & 3;
  long aoff[2], aoff2[2], boff;
#pragma unroll
  for (int i = 0; i < 2; ++i) {
    const int row = lrow + 128 * i;
    const int lch = pch ^ ((-(row >> 2)) & 3);
    int gm = m0 + row; if (gm > g.mvalid - 1) gm = g.mvalid - 1;
    const int ar = g.ridx ? g.ridx[gm] : gm;
    aoff[i] = (long)ar * g.lda + lch * 8;
    aoff2[i] = (long)ar * g.lda2 + lch * 8;
  }
  const int cb = (NT == 4) ? tid : (tid & 255);
  {
    const int row = cb >> 2;
    const int lch = pch ^ ((-(row >> 2)) & 3);
    const int src = n0 + (row & ~31) + perm32(row & 31);
    boff = (long)src * g.ldb + lch * 8;
  }
#pragma unroll
  for (int m = 0; m < 4; ++m)
#pragma unroll
    for (int n = 0; n < NT; ++n) acc[m][n] = f32x4{0.f, 0.f, 0.f, 0.f};
  const int T = g.K / 32;
#define GEMM_DMA(t_, stg_) { const int k0_ = (t_) * 32; const bool seg2_ = (k0_ >= g.ksplit); bf16* sa_ = st + (stg_) * STAGE; \
    _Pragma("unroll") for (int i_ = 0; i_ < 2; ++i_) { \
      const bf16* ap_ = seg2_ ? (g.A2 + aoff2[i_] + (k0_ - g.ksplit)) : (g.A + aoff[i_] + k0_); \
      GLDS16(ap_, sa_ + (tid + i_ * 512) * 8); } \
    GLDS16(g.Bt + boff + k0_, sa_ + A_ELEMS + cb * 8); }
  __syncthreads();
  GEMM_DMA(0, 0)
  if (T > 1) GEMM_DMA(1, 1)
  int s_cur = 0, s_nxt = 2;
#pragma unroll 1
  for (int t = 0; t < T; ++t) {
    if (t + 1 < T) { GEMM_WAIT(3); } else { GEMM_WAIT(0); }
    RAW_BARRIER();
    if (t + 2 < T) GEMM_DMA(t + 2, s_nxt)
    const bf16* sa = st + s_cur * STAGE;
    const bf16* sb = sa + A_ELEMS;
    bf16x8 af[4], bfr[NT];
#pragma unroll
    for (int n = 0; n < NT; ++n) {
      const int row = wc * (16 * NT) + n * 16 + fr;
      bfr[n] = *(const bf16x8*)(sb + row * 32 + ((fq ^ ((-(row >> 2)) & 3)) << 3));
    }
#pragma unroll
    for (int m = 0; m < 4; ++m) {
      const int row = wr * 64 + m * 16 + fr;
      af[m] = *(const bf16x8*)(sa + row * 32 + ((fq ^ ((-(row >> 2)) & 3)) << 3));
    }
#pragma unroll
    for (int m = 0; m < 4; ++m)
#pragma unroll
      for (int n = 0; n < NT; ++n) acc[m][n] = __builtin_amdgcn_mfma_f32_16x16x32_bf16(bfr[n], af[m], acc[m][n], 0, 0, 0);
    s_cur = (s_cur == 2) ? 0 : s_cur + 1;
    s_nxt = (s_nxt == 2) ? 0 : s_nxt + 1;
  }
}
constexpr int BG_HT = 128 * 64;
DI int lds_byte(int r, int c) { const int stt = (r >> 4) * 2 + (c >> 5), rr = r & 15, cc = c & 31, ob = rr * 64 + cc * 2; return stt * 1024 + (ob ^ (((ob >> 9) & 1) << 5)); }
DI void stage_rc(int b, int& R, int& C) { const int stt = b / 1024, sb = b % 1024, swz = sb ^ (((sb >> 9) & 1) << 5); R = (stt >> 1) * 16 + swz / 64; C = (stt & 1) * 32 + (swz % 64) / 2; }
#ifdef EMU
#define BG_WAIT_V(n)
#define BG_WAIT_L(n)
#define BG_BAR __syncthreads()
#define BG_SCHED
#define BG_PRIO(x)
#else
#define BG_WAIT_V(n) asm volatile("s_waitcnt vmcnt(" #n ")" ::: "memory")
#define BG_WAIT_L(n) asm volatile("s_waitcnt lgkmcnt(" #n ")" ::: "memory")
#define BG_BAR __builtin_amdgcn_s_barrier()
#define BG_SCHED __builtin_amdgcn_sched_barrier(0)
#define BG_PRIO(x) __builtin_amdgcn_s_setprio(x)
#endif
DI void gemm_big(const GA& g, int m0, int n0, char* smem, f32x4 (&acc)[2][2][4][2]) {
  bf16* shm = (bf16*)smem;
  const int tid = tid_(), wid = tid >> 6, lane = tid & 63, wr = wid >> 2, wc = wid & 3, fr = lane & 15, fq = lane >> 4;
  unsigned aof[2][2], bof[2];
#ifdef EMU
  const int dma_lds = tid * 16;
#else
  const int dma_lds = __builtin_amdgcn_readfirstlane(tid >> 6) * 1024;
#endif
#ifndef EMU
  const __amdgpu_buffer_rsrc_t rsA = __builtin_amdgcn_make_buffer_rsrc((void*)g.A, 0, 0x7fffffff, 0x00020000);
  const __amdgpu_buffer_rsrc_t rsB = __builtin_amdgcn_make_buffer_rsrc((void*)g.Bt, 0, 0x7fffffff, 0x00020000);
#endif
#pragma unroll
  for (int i = 0; i < 2; ++i) {
    int R, C; stage_rc(tid * 16 + i * 8192, R, C);
    bof[i] = (unsigned)((n0 + (R & ~31) + perm32(R & 31)) * g.ldb + C) * 2u;
#pragma unroll
    for (int h = 0; h < 2; ++h) {
      int gm = m0 + h * 128 + R; if (gm > g.mvalid - 1) gm = g.mvalid - 1;
      const int ar = g.ridx ? g.ridx[gm] : gm;
      aof[h][i] = (unsigned)(ar * g.lda + C) * 2u;
    }
  }
#define BG_SA(b, h) (shm + ((b) * 2 + (h)) * BG_HT)
#define BG_SB(b, h) (shm + (4 + (b) * 2 + (h)) * BG_HT)
#define BG_STAGE_A(P, h, kt) { \
    _Pragma("unroll") for (int i_ = 0; i_ < 2; ++i_) BGLDS16(rsA, g.A, aof[h][i_], (kt) * 128, (char*)(P) + dma_lds + i_ * 8192); }
#define BG_STAGE_B(P, h, kt) { \
    _Pragma("unroll") for (int i_ = 0; i_ < 2; ++i_) BGLDS16(rsB, g.Bt, bof[i_], (kt) * 128 + (h) * 256 * g.ldb, (char*)(P) + dma_lds + i_ * 8192); }
#define BG_LDA(dst, b, h) _Pragma("unroll") for (int m_ = 0; m_ < 4; ++m_) _Pragma("unroll") for (int k_ = 0; k_ < 2; ++k_) \
    dst[m_][k_] = *(const bf16x8*)((const char*)BG_SA(b, h) + lds_byte(wr * 64 + m_ * 16 + fr, k_ * 32 + fq * 8))
#define BG_LDB(dst, b, h) _Pragma("unroll") for (int n_ = 0; n_ < 2; ++n_) _Pragma("unroll") for (int k_ = 0; k_ < 2; ++k_) \
    dst[n_][k_] = *(const bf16x8*)((const char*)BG_SB(b, h) + lds_byte(wc * 32 + n_ * 16 + fr, k_ * 32 + fq * 8))
#define BG_MMA(ai, bj, At_, Bt_) { BG_PRIO(1); \
    _Pragma("unroll") for (int m_ = 0; m_ < 4; ++m_) _Pragma("unroll") for (int n_ = 0; n_ < 2; ++n_) _Pragma("unroll") for (int k_ = 0; k_ < 2; ++k_) \
      acc[ai][bj][m_][n_] = __builtin_amdgcn_mfma_f32_16x16x32_bf16(Bt_[n_][k_], At_[m_][k_], acc[ai][bj][m_][n_], 0, 0, 0); \
    BG_PRIO(0); }
#pragma unroll
  for (int a_ = 0; a_ < 2; ++a_)
#pragma unroll
    for (int b_ = 0; b_ < 2; ++b_)
#pragma unroll
      for (int m_ = 0; m_ < 4; ++m_)
#pragma unroll
        for (int n_ = 0; n_ < 2; ++n_) acc[a_][b_][m_][n_] = f32x4{0.f, 0.f, 0.f, 0.f};
  bf16x8 At[4][2], B0[2][2], B1[2][2];
  const int nt = g.K / 64;
  __syncthreads();
  BG_STAGE_B(BG_SB(0, 0), 0, 0) BG_STAGE_A(BG_SA(0, 0), 0, 0)
  BG_STAGE_B(BG_SB(0, 1), 1, 0) BG_STAGE_A(BG_SA(0, 1), 1, 0)
  if (wr == 1) BG_BAR;
  BG_WAIT_V(4); BG_BAR;
  BG_STAGE_B(BG_SB(1, 0), 0, 1) BG_STAGE_A(BG_SA(1, 0), 0, 1) BG_STAGE_B(BG_SB(1, 1), 1, 1)
  BG_WAIT_V(6); BG_BAR;
#pragma unroll 1
  for (int t = 0; t < nt - 2; t += 2) {
    BG_LDB(B0, 0, 0); BG_SCHED; BG_LDA(At, 0, 0); BG_STAGE_A(BG_SA(1, 1), 1, t + 1)
    BG_WAIT_L(8); BG_BAR; BG_WAIT_L(0); BG_MMA(0, 0, At, B0) BG_BAR; BG_SCHED;
    BG_LDB(B1, 0, 1); BG_STAGE_B(BG_SB(0, 0), 0, t + 2)
    BG_BAR; BG_WAIT_L(0); BG_MMA(0, 1, At, B1) BG_BAR;
    BG_LDA(At, 0, 1); BG_STAGE_A(BG_SA(0, 0), 0, t + 2)
    BG_BAR; BG_WAIT_L(0); BG_MMA(1, 0, At, B0) BG_BAR; BG_SCHED;
    BG_STAGE_B(BG_SB(0, 1), 1, t + 2)
    BG_WAIT_V(6); BG_BAR; BG_MMA(1, 1, At, B1) BG_BAR;
    BG_LDB(B0, 1, 0); BG_SCHED; BG_LDA(At, 1, 0); BG_STAGE_A(BG_SA(0, 1), 1, t + 2)
    BG_WAIT_L(8); BG_BAR; BG_WAIT_L(0); BG_MMA(0, 0, At, B0) BG_BAR; BG_SCHED;
    BG_LDB(B1, 1, 1); BG_STAGE_B(BG_SB(1, 0), 0, t + 3)
    BG_BAR; BG_WAIT_L(0); BG_MMA(0, 1, At, B1) BG_BAR;
    BG_LDA(At, 1, 1); BG_STAGE_A(BG_SA(1, 0), 0, t + 3)
    BG_BAR; BG_WAIT_L(0); BG_MMA(1, 0, At, B0) BG_BAR; BG_SCHED;
    BG_STAGE_B(BG_SB(1, 1), 1, t + 3)
    BG_WAIT_V(6); BG_BAR; BG_MMA(1, 1, At, B1) BG_BAR;
  }
  { BG_LDB(B0, 0, 0); BG_LDA(At, 0, 0); BG_STAGE_A(BG_SA(1, 1), 1, nt - 1)
    BG_BAR; BG_WAIT_L(0); BG_MMA(0, 0, At, B0) BG_BAR;
    BG_LDB(B1, 0, 1); BG_BAR; BG_WAIT_L(0); BG_MMA(0, 1, At, B1) BG_BAR;
    BG_LDA(At, 0, 1); BG_WAIT_V(4); BG_BAR; BG_WAIT_L(0); BG_MMA(1, 0, At, B0) BG_MMA(1, 1, At, B1) BG_BAR; }
  { BG_LDB(B0, 1, 0); BG_LDA(At, 1, 0); BG_WAIT_V(2); BG_BAR; BG_WAIT_L(0); BG_MMA(0, 0, At, B0) BG_BAR;
    BG_LDB(B1, 1, 1); BG_WAIT_V(0); BG_BAR; BG_WAIT_L(0); BG_MMA(0, 1, At, B1) BG_BAR;
    BG_LDA(At, 1, 1); BG_BAR; BG_WAIT_L(0); BG_MMA(1, 0, At, B0) BG_MMA(1, 1, At, B1) BG_BAR; }
  if (wr == 0) BG_BAR;
}
#define EPIB_BEGIN(acc_, m0_, n0_, mvalid_) { const int _l = tid_() & 63, _w = tid_() >> 6, _wr = _w >> 2, _wc = _w & 3, _fr = _l & 15, _fq = _l >> 4; \
  _Pragma("unroll") for (int _ai = 0; _ai < 2; ++_ai) _Pragma("unroll") for (int _m = 0; _m < 4; ++_m) { const int row = (m0_) + _ai * 128 + _wr * 64 + _m * 16 + _fr; \
  _Pragma("unroll") for (int _bj = 0; _bj < 2; ++_bj) { const int col = (n0_) + _bj * 128 + _wc * 32 + 8 * _fq; (void)col; \
    float v[8] = {acc_[_ai][_bj][_m][0][0], acc_[_ai][_bj][_m][0][1], acc_[_ai][_bj][_m][0][2], acc_[_ai][_bj][_m][0][3], \
                  acc_[_ai][_bj][_m][1][0], acc_[_ai][_bj][_m][1][1], acc_[_ai][_bj][_m][1][2], acc_[_ai][_bj][_m][1][3]}; \
    if (row < (mvalid_)) {
#define EPIB_END }}}}

DI void ld8bf(const bf16* p, float (&v)[8]) {
  uint4 w = *(const uint4*)p;
  v[0] = __uint_as_float(w.x << 16); v[1] = __uint_as_float(w.x & 0xffff0000u); v[2] = __uint_as_float(w.y << 16); v[3] = __uint_as_float(w.y & 0xffff0000u);
  v[4] = __uint_as_float(w.z << 16); v[5] = __uint_as_float(w.z & 0xffff0000u); v[6] = __uint_as_float(w.w << 16); v[7] = __uint_as_float(w.w & 0xffff0000u);
}
DI void st8bf(bf16* p, const float (&v)[8]) { *(uint4*)p = make_uint4(pack2(v[0], v[1]), pack2(v[2], v[3]), pack2(v[4], v[5]), pack2(v[6], v[7])); }
DI void st8f(float* p, const float (&v)[8]) { *(float4*)p = make_float4(v[0], v[1], v[2], v[3]); *(float4*)(p + 4) = make_float4(v[4], v[5], v[6], v[7]); }
#define EPI_BEGIN(NT_, acc_, m0_, n0_, mvalid_) { const int _l = tid_() & 63, _w = tid_() >> 6, _wr = _w >> 1, _wc = _w & 1, _fr = _l & 15, _fq = _l >> 4; \
  _Pragma("unroll") for (int _m = 0; _m < 4; ++_m) { const int row = (m0_) + _wr * 64 + _m * 16 + _fr; \
  _Pragma("unroll") for (int _q = 0; _q < (NT_) / 2; ++_q) { const int col = (n0_) + _wc * (16 * (NT_)) + _q * 32 + 8 * _fq; (void)col; \
    float v[8] = {acc_[_m][2 * _q][0], acc_[_m][2 * _q][1], acc_[_m][2 * _q][2], acc_[_m][2 * _q][3], \
                  acc_[_m][2 * _q + 1][0], acc_[_m][2 * _q + 1][1], acc_[_m][2 * _q + 1][2], acc_[_m][2 * _q + 1][3]}; \
    if (row < (mvalid_)) {
#define EPI_END }}}}

DI int mtile_row0(int mt, bool latonly, int TH) {
  if (!latonly) return mt * TH;
  const int per = SEQ / TH, b = mt / per, r = mt % per;
  return b * TOK + CTXL + r * TH;
}
DI int mtiles(bool latonly, int TH) { return latonly ? BATCH * (SEQ / TH) : (NTOK + TH - 1) / TH; }

struct LP {
  int l; bool last;
  const float* mod;
  char* we;
  char* s5;
};
DI LP make_lp(const Params& p, int l) {
  LP q; q.l = l; q.last = (l == DEPTH - 1);
  q.mod = (const float*)(p.ws + OFF_MOD) + (size_t)l * NB1 * 6144;
  q.we = p.ws + OFF_WEARLY + (size_t)l * WE_SIZE;
  q.s5 = p.ws + OFF_S5TAB + (size_t)l * S5_SIZE;
  return q;
}

template <class RowMap>
DI void conv_tile(const float* src, int lds, int nsrc, const float* kscale, bf16* dst, int K, int k0, int n0, char* smem, RowMap rowmap, int ndst = 1 << 30) {
  (void)smem;
  const int tid = tid_(), n4 = (tid & 63) * 4, k8 = (tid >> 6) * 8;
  float4 v[8];
  const bool ok = (n0 + n4 < nsrc);
  const float* sp = src + (size_t)(k0 + k8) * lds + n0 + n4;
#pragma unroll
  for (int k = 0; k < 8; ++k) v[k] = ok ? *(const float4*)(sp + (size_t)k * lds) : make_float4(0.f, 0.f, 0.f, 0.f);
  if (kscale) {
#pragma unroll
    for (int k = 0; k < 8; ++k) { const float sc = kscale[k0 + k8 + k]; v[k].x *= sc; v[k].y *= sc; v[k].z *= sc; v[k].w *= sc; }
  }
  float o[8];
#pragma unroll
  for (int k = 0; k < 8; ++k) o[k] = v[k].x;
  if (n0 + n4 + 0 < ndst) st8bf(dst + (size_t)rowmap(n0 + n4 + 0) * K + k0 + k8, o);
#pragma unroll
  for (int k = 0; k < 8; ++k) o[k] = v[k].y;
  if (n0 + n4 + 1 < ndst) st8bf(dst + (size_t)rowmap(n0 + n4 + 1) * K + k0 + k8, o);
#pragma unroll
  for (int k = 0; k < 8; ++k) o[k] = v[k].z;
  if (n0 + n4 + 2 < ndst) st8bf(dst + (size_t)rowmap(n0 + n4 + 2) * K + k0 + k8, o);
#pragma unroll
  for (int k = 0; k < 8; ++k) o[k] = v[k].w;
  if (n0 + n4 + 3 < ndst) st8bf(dst + (size_t)rowmap(n0 + n4 + 3) * K + k0 + k8, o);
}
struct RowId { DI int operator()(int n) const { return n; } };
struct RowGU { int half; DI int operator()(int f) const { return (f >> 7) * 256 + half * 128 + (f & 127); } };

constexpr int CT_WIN = 16 * (N_INP / 256), CT_UQ = 4 * 2, CT_UKV = 2 * 2, CT_GLU = 4, CT_WB = 4 * 16, CT_WOUT = 64;
constexpr int CT_EARLY = CT_WIN + CT_UQ + CT_UKV + CT_GLU + CT_WB + CT_WOUT;
constexpr int CT_EXP = NE * 3 * 64;

DI void conv_early_item(const Params& p, int l, int it, char* smem) {
  char* we = p.ws + OFF_WEARLY + (size_t)l * WE_SIZE;
  if (it < CT_WIN) {
    int kt = it % 16, nt = it / 16;
    conv_tile(p.in[I_WIN] + (size_t)l * 1024 * N_IN, N_IN, N_IN, nullptr, (bf16*)(we + WE_WIN), 1024, kt * 64, nt * 256, smem, RowId());
    return;
  }
  it -= CT_WIN;
  if (it < CT_UQ) {
    int kt = it % 4, nt = it / 4;
    conv_tile(p.in[I_WUQ] + (size_t)l * 256 * 384, 384, 384, p.in[I_GCQ] + l * 256, (bf16*)(we + WE_UQ), 256, kt * 64, nt * 256, smem, RowId(), 384);
    return;
  }
  it -= CT_UQ;
  if (it < CT_UKV) {
    int kt = it % 2, nt = it / 2;
    conv_tile(p.in[I_WUKV] + (size_t)l * 128 * 512, 512, 512, p.in[I_GCKV] + l * 128, (bf16*)(we + WE_UKV), 128, kt * 64, nt * 256, smem, RowId());
    return;
  }
  it -= CT_UKV;
  if (it < CT_GLU) {
    int kt = it;
    conv_tile(p.in[I_S5WGLU] + (size_t)l * 256 * 256, 256, 256, nullptr, (bf16*)(we + WE_GLU), 256, kt * 64, 0, smem, RowId());
    return;
  }
  it -= CT_GLU;
  if (it < CT_WB) {
    int j = it / 16, r = it % 16, kt = r % 4, nt = r / 4;
    conv_tile(p.in[I_WBRANCH] + ((size_t)l * 4 + j) * 256 * 1024, 1024, 1024, nullptr, (bf16*)(we + WE_WB) + (size_t)j * 1024 * 256, 256, kt * 64, nt * 256, smem, RowId());
    return;
  }
  it -= CT_WB;
  {
    int kt = it % 16, nt = it / 16;
    conv_tile(p.in[I_WOUT] + (size_t)l * 1024 * 1024, 1024, 1024, nullptr, (bf16*)(we + WE_WOUT), 1024, kt * 64, nt * 256, smem, RowId());
  }
}
DI void conv_expert_item(const Params& p, int l, int it, char* smem) {
  char* wx = p.ws + OFF_MIX;
  int e = it / 192, r = it % 192, which = r / 64, t = r % 64, kt = t % 16, nt = t / 16;
  size_t eoff = ((size_t)l * NE + e) * 1024 * 1024;
  if (which == 0) { RowGU rm; rm.half = 0; conv_tile(p.in[I_WGATE] + eoff, 1024, 1024, nullptr, (bf16*)(wx + WX_GU) + (size_t)e * 2048 * 1024, 1024, kt * 64, nt * 256, smem, rm); }
  else if (which == 1) { RowGU rm; rm.half = 1; conv_tile(p.in[I_WUP] + eoff, 1024, 1024, nullptr, (bf16*)(wx + WX_GU) + (size_t)e * 2048 * 1024, 1024, kt * 64, nt * 256, smem, rm); }
  else conv_tile(p.in[I_WDOWN] + eoff, 1024, 1024, nullptr, (bf16*)(wx + WX_DN) + (size_t)e * 1024 * 1024, 1024, kt * 64, nt * 256, smem, RowId());
}

DI void mod_item(const Params& p, int it, char* smem) {
  const int l = it / 96, cg0 = (it % 96) * 64;
  float* sc = (float*)smem;
  float* red = sc + NB1 * 1024;
  const int tid = tid_();
  __syncthreads();
  for (int i = tid; i < NB1 * 1024; i += NTHREADS) {
    int r = i >> 10, k = i & 1023;
    float c = (r < BATCH) ? p.in[I_C][r * 1024 + k] : p.in[I_CCTX][k];
    sc[i] = siluf_(c);
  }
  __syncthreads();
  const int cl = tid & 63, kg = tid >> 6;
  float acc[NB1];
#pragma unroll
  for (int r = 0; r < NB1; ++r) acc[r] = 0.f;
  const float* w = p.in[I_WADA] + (size_t)l * 1024 * 6144 + cg0 + cl;
  for (int k0 = kg * (1024 / NWAVES); k0 < (kg + 1) * (1024 / NWAVES); k0 += 16) {
    float wv[16];
#pragma unroll
    for (int u = 0; u < 16; ++u) wv[u] = w[(size_t)(k0 + u) * 6144];
#pragma unroll
    for (int u = 0; u < 16; ++u)
#pragma unroll
      for (int r = 0; r < NB1; ++r) acc[r] += sc[r * 1024 + k0 + u] * wv[u];
  }
#pragma unroll
  for (int r = 0; r < NB1; ++r) red[(kg * NB1 + r) * 64 + cl] = acc[r];
  __syncthreads();
  for (int i = tid; i < NB1 * 64; i += NTHREADS) {
    int r = i >> 6, c = i & 63;
    float s = 0.f;
#pragma unroll
    for (int q = 0; q < NWAVES; ++q) s += red[(q * NB1 + r) * 64 + c];
    s += p.in[I_BADA][l * 6144 + cg0 + c];
    ((float*)(p.ws + OFF_MOD))[((size_t)l * NB1 + r) * 6144 + cg0 + c] = s;
  }
}

DI void s5_tab_item(const Params& p, int it, char* smem) {
  const int l = it / 32, d = (it / 16) & 1, g = it & 15;
  char* s5 = p.ws + OFF_S5TAB + (size_t)l * S5_SIZE;
  float* lampow = (float*)(s5 + S5_LAMPOW) + (size_t)(d * 16 + g) * 17 * 64 * 2;
  float* bbar = (float*)(s5 + S5_BBAR) + (size_t)(d * 16 + g) * 64 * 16 * 2;
  float* kt = (float*)(s5 + S5_KT) + (size_t)(d * 16 + g) * 16 * 256;
  float* slam = (float*)smem;
  float* sbb = slam + 17 * 64 * 2;
  const int tid = tid_();
  const size_t pg = ((size_t)(l * 2 + d) * 16 + g);
  const float step = expf(p.in[I_S5LOGSTEP][pg]);
  __syncthreads();
  for (int i = tid; i < 17 * 64; i += NTHREADS) {
    int j = i >> 6, pp = i & 63;
    float are = p.in[I_S5ARE][pg * 64 + pp], aim = p.in[I_S5AIM][pg * 64 + pp];
    float mag = expf((float)j * step * are), ang = (float)j * step * aim;
    float re = mag * cosf(ang), im = mag * sinf(ang);
    slam[i * 2] = re; slam[i * 2 + 1] = im; lampow[i * 2] = re; lampow[i * 2 + 1] = im;
  }
  __syncthreads();
  for (int i = tid; i < 64 * 16; i += NTHREADS) {
    int pp = i >> 4;
    float are = p.in[I_S5ARE][pg * 64 + pp], aim = p.in[I_S5AIM][pg * 64 + pp];
    float x = slam[(64 + pp) * 2] - 1.0f, y = slam[(64 + pp) * 2 + 1];
    float den = are * are + aim * aim;
    float qre = (x * are + y * aim) / den, qim = (y * are - x * aim) / den;
    float bre = p.in[I_S5BRE][pg * 1024 + i], bim = p.in[I_S5BIM][pg * 1024 + i];
    float re = qre * bre - qim * bim, im = qre * bim + qim * bre;
    sbb[i * 2] = re; sbb[i * 2 + 1] = im; bbar[i * 2] = re; bbar[i * 2 + 1] = im;
  }
  __syncthreads();
  for (int i = tid; i < 16 * 256; i += NTHREADS) {
    int j = i >> 8, c = (i >> 4) & 15, c2 = i & 15;
    float s = 0.f;
    for (int pp = 0; pp < 64; ++pp) {
      float cre = p.in[I_S5CRE][pg * 1024 + c * 64 + pp], cim = p.in[I_S5CIM][pg * 1024 + c * 64 + pp];
      float lre = slam[(j * 64 + pp) * 2], lim = slam[(j * 64 + pp) * 2 + 1];
      float tre = cre * lre - cim * lim, tim = cre * lim + cim * lre;
      float bre = sbb[(pp * 16 + c2) * 2], bim = sbb[(pp * 16 + c2) * 2 + 1];
      s += tre * bre - tim * bim;
    }
    kt[i] = s;
  }
}
DI void s5_mat_item(const Params& p, int it) {
  const int l = it / 256, g = (it / 16) & 15, q = it & 15;
  char* s5 = p.ws + OFF_S5TAB + (size_t)l * S5_SIZE;
  const float* lampow = (const float*)(s5 + S5_LAMPOW);
  const float* bbar = (const float*)(s5 + S5_BBAR);
  const float* ktab = (const float*)(s5 + S5_KT);
  bf16* WA = (bf16*)(s5 + S5_WA) + (size_t)g * 256 * 256;
  bf16* W2 = (bf16*)(s5 + S5_W2) + (size_t)g * 256 * 512;
  const int tid = tid_();
  for (int i = tid; i < 16 * 256; i += NTHREADS) {
    int n = q * 16 + (i >> 8), k = i & 255;
    int d = n >> 7, ri = (n >> 6) & 1, pp = n & 63, s = k >> 4, c2 = k & 15;
    int e = (d == 0) ? (15 - s) : s;
    const float* lp = lampow + ((size_t)((d * 16 + g) * 17 + e) * 64 + pp) * 2;
    const float* bp = bbar + ((size_t)((d * 16 + g) * 64 + pp) * 16 + c2) * 2;
    float re = lp[0] * bp[0] - lp[1] * bp[1], im = lp[0] * bp[1] + lp[1] * bp[0];
    WA[(size_t)n * 256 + k] = f2bf(ri == 0 ? re : im);
  }
  for (int i = tid; i < 16 * 512; i += NTHREADS) {
    int n = q * 16 + (i >> 9), k = i & 511;
    int lq = n >> 4, c = n & 15;
    float v;
    if (k < 256) {
      int s = k >> 4, c2 = k & 15;
      v = 0.f;
      if (s <= lq) v += ktab[((size_t)(0 * 16 + g) * 16 + (lq - s)) * 256 + c * 16 + c2];
      if (s >= lq) v += ktab[((size_t)(1 * 16 + g) * 16 + (s - lq)) * 256 + c * 16 + c2];
      if (s == lq && c == c2) v += p.in[I_S5D][l * 256 + g * 16 + c];
    } else {
      int kk = k - 256, d = kk >> 7, ri = (kk >> 6) & 1, pp = kk & 63;
      int e = (d == 0) ? (lq + 1) : (16 - lq);
      size_t pg = ((size_t)(l * 2 + d) * 16 + g);
      float cre = p.in[I_S5CRE][pg * 1024 + c * 64 + pp], cim = p.in[I_S5CIM][pg * 1024 + c * 64 + pp];
      const float* lp = lampow + ((size_t)((d * 16 + g) * 17 + e) * 64 + pp) * 2;
      float re = cre * lp[0] - cim * lp[1], im = cre * lp[1] + cim * lp[0];
      v = (ri == 0) ? re : -im;
    }
    W2[(size_t)n * 512 + k] = f2bf(v);
  }
}

DI int tok_b(int tok) { return tok / TOK; }
DI int tok_j(int tok) { return tok % TOK; }
DI int tok_modrow(int tok) { return (tok_j(tok) < CTXL) ? BATCH : tok_b(tok); }

DI void normmod_row(const float (&xv)[16], const float* g, const float* shift, const float* scale, bf16* dst, float (&hout)[16]) {
  const int lane = tid_() & 63;
  float ss = 0.f;
#pragma unroll
  for (int i = 0; i < 16; ++i) ss += xv[i] * xv[i];
  ss = wave_sum(ss);
  const float rs = rsqrtf(ss * (1.0f / 1024.f) + EPS);
#pragma unroll
  for (int i = 0; i < 4; ++i) {
    int c = lane * 4 + i * 256;
    float4 gv = *(const float4*)(g + c), sh = *(const float4*)(shift + c), sc = *(const float4*)(scale + c);
    float h0 = xv[i * 4 + 0] * rs * gv.x * (1.f + sc.x) + sh.x;
    float h1 = xv[i * 4 + 1] * rs * gv.y * (1.f + sc.y) + sh.y;
    float h2 = xv[i * 4 + 2] * rs * gv.z * (1.f + sc.z) + sh.z;
    float h3 = xv[i * 4 + 3] * rs * gv.w * (1.f + sc.w) + sh.w;
    hout[i * 4 + 0] = h0; hout[i * 4 + 1] = h1; hout[i * 4 + 2] = h2; hout[i * 4 + 3] = h3;
    *(uint2*)(dst + c) = make_uint2(pack2(h0, h1), pack2(h2, h3));
  }
}

DI void prep_row_item(const Params& p, int it) {
  const int tok = it * NWAVES + (tid_() >> 6), lane = tid_() & 63;
  const int b = tok_b(tok), j = tok_j(tok);
  const float* src = (j < CTXL) ? p.in[I_CTX] + ((size_t)b * CTXL + j) * 1024 : p.in[I_X] + ((size_t)b * SEQ + (j - CTXL)) * 1024;
  float xv[16], h[16];
#pragma unroll
  for (int i = 0; i < 4; ++i) {
    float4 v = *(const float4*)(src + lane * 4 + i * 256);
    xv[i * 4] = v.x; xv[i * 4 + 1] = v.y; xv[i * 4 + 2] = v.z; xv[i * 4 + 3] = v.w;
  }
  const float* mod = (const float*)(p.ws + OFF_MOD) + (size_t)tok_modrow(tok) * 6144;
  normmod_row(xv, p.in[I_GPREMIX], mod + 0, mod + 1024, (bf16*)(p.ws + OFF_HA) + (size_t)tok * 1024, h);
}

constexpr int IP_LT = BATCH * (SEQ / 256), IP_CT = BATCH * ((CTXL + 255) / 256), IP_MT = IP_LT + IP_CT, IP_NT = N_INP / 256;
constexpr int IP_RR = (IP_MT + 7) / 8, IP_RC = (IP_NT + 1) / 2;
constexpr int IP_RC_NOGATE = (((C_GATE + 255) / 256) + 1) / 2;
constexpr int IP_RR_LAT = IP_LT / 8;
constexpr bool IP_COMPACT = (IP_LT % 8 == 0);
constexpr int IP_RECTS_ALL = IP_RR * IP_RC, IP_RECTS_LAST = IP_COMPACT ? (IP_RR * IP_RC_NOGATE + IP_RR_LAT * (IP_RC - IP_RC_NOGATE)) : IP_RECTS_ALL;
constexpr int IP_SLOTS_ALL = ((IP_RECTS_ALL + 15) / 16) * 256, IP_SLOTS_LAST = ((IP_RECTS_LAST + 15) / 16) * 256;
DI void inproj_tile(const Params& p, const LP& L, int t, char* smem) {
  const int vb = t % 256, vround = t / 256, x = vb % 8, j = vb / 8;
  const int Rc = vround * 16 + x * 2 + (j >> 4), jj = j & 15;
  int rm, rn;
  if (!L.last || !IP_COMPACT || Rc < IP_RR * IP_RC_NOGATE) { rm = Rc % IP_RR; rn = Rc / IP_RR; }
  else { const int q = Rc - IP_RR * IP_RC_NOGATE; rm = q % IP_RR_LAT; rn = IP_RC_NOGATE + q / IP_RR_LAT; }
  const int mt = rm * 8 + (jj & 7), nt = rn * 2 + (jj >> 3);
  if (mt >= IP_MT || nt >= IP_NT || rn >= IP_RC) return;
  int m0;
  if (mt < IP_LT) m0 = (mt / (SEQ / 256)) * TOK + CTXL + (mt % (SEQ / 256)) * 256;
  else { const int c = mt - IP_LT; m0 = (c / ((CTXL + 255) / 256)) * TOK + (c % ((CTXL + 255) / 256)) * 256; }
  const int n0 = nt * 256;
  const int mv = (mt < IP_LT) ? NTOK : (m0 - (m0 % TOK) + CTXL);
  if (L.last && mt >= IP_LT && n0 >= ((C_GATE + 255) / 256) * 256) return;
  GA g = make_ga((const bf16*)(p.ws + OFF_HA), 1024, (const bf16*)(L.we + WE_WIN), 1024, 1024, mv);
  f32x4 acc[2][2][4][2];
  gemm_big(g, m0, n0, smem, acc);
  bf16* P1 = (bf16*)(p.ws + OFF_P1);
  bf16* PG = (bf16*)(p.ws + OFF_PG);
  bf16* US5 = (bf16*)(p.ws + OFF_MIX + MX_US5);
  float* DT = (float*)(p.ws + OFF_DT);
  const float* dtb = p.in[I_M2DTBIAS] + L.l * 8;
  EPIB_BEGIN(acc, m0, n0, mv)
    if (col < C_S5 || (col >= C_Z && col < C_DT)) st8bf(P1 + (size_t)row * P1W + col, v);
    else if (col < C_Z) st8bf(US5 + ((size_t)((col - C_S5) >> 4) * NTOK + row) * 16 + (col & 15), v);
    else if (col < C_GATE) {
#pragma unroll
      for (int k = 0; k < 8; ++k) v[k] = softplusf_(v[k] + dtb[k]);
      st8f(DT + (size_t)row * 8, v);
    } else if (col < N_IN) {
#pragma unroll
      for (int k = 0; k < 8; ++k) v[k] = sigmoidf_(v[k]);
      st8bf(PG + (size_t)row * 4096 + (col - C_GATE), v);
    }
  EPIB_END
}

DI void rowscale_256(const bf16* P1, int m0, int c0, int width, float* srs) {
  const int r = tid_() >> 1, hf = tid_() & 1;
  int gr = m0 + r; if (gr > NTOK - 1) gr = NTOK - 1;
  const bf16* src = P1 + (size_t)gr * P1W + c0 + hf * (width / 2);
  float ss = 0.f;
  for (int i = 0; i < width / 2; i += 8) {
    float v[8]; ld8bf(src + i, v);
#pragma unroll
    for (int k = 0; k < 8; ++k) ss += v[k] * v[k];
  }
  ss += shfl_xor_(ss, 1);
  if (hf == 0) srs[r] = rsqrtf(ss / (float)width + EPS);
}
DI void rope_tab_item(const Params& p) {
  float* tab = (float*)(p.ws + OFF_ROPE);
  for (int i = tid_(); i < 64 * 8; i += NTHREADS) {
    int pos = i >> 3, k = i & 7;
    float f = expf(-(float)k * (9.210340371976184f / 8.0f));
    float a = (float)pos * f;
    tab[i * 2] = cosf(a); tab[i * 2 + 1] = sinf(a);
  }
}
DI void rope_cs(const float* tab, int pos, int i, float& c, float& s) { c = tab[(pos * 8 + i) * 2]; s = tab[(pos * 8 + i) * 2 + 1]; }

constexpr int TP_MT = (NTOK + 255) / 256;
DI void mlaq_tile(const Params& p, const LP& L, int t, char* smem) {
  const int mt = t % TP_MT, nt = t / TP_MT, m0 = mt * 256, n0 = nt * 128;
  const bf16* P1 = (const bf16*)(p.ws + OFF_P1);
  float* srs = (float*)(smem + SRS_OFF);
  GA g = make_ga(P1 + C_CQ, P1W, (const bf16*)(L.we + WE_UQ), 256, 256, NTOK);
  f32x4 acc[4][4];
  gemm_s<4>(g, m0, n0, smem, acc);
  rowscale_256(P1, m0, C_CQ, 256, srs);
  __syncthreads();
  bf16* Q = (bf16*)(p.ws + OFF_MIX + MX_Q);
  const float* ropetab = (const float*)(p.ws + OFF_ROPE);
  {
    const int l = tid_() & 63, w = tid_() >> 6, wr = w >> 1, wc = w & 1, fr = l & 15, fq = l >> 4;
#pragma unroll
    for (int m = 0; m < 4; ++m) {
      const int row = m0 + wr * 64 + m * 16 + fr;
      const int rowc = row < NTOK ? row : NTOK - 1;
      const float rsc = srs[rowc - m0];
      const int b = tok_b(rowc), j = tok_j(rowc);
#pragma unroll
      for (int q = 0; q < 2; ++q) {
        const int col = n0 + wc * 64 + q * 32 + 8 * fq;
        const int h = col / 96, dd = col % 96;
        float v[8] = {acc[m][2 * q][0], acc[m][2 * q][1], acc[m][2 * q][2], acc[m][2 * q][3], acc[m][2 * q + 1][0], acc[m][2 * q + 1][1], acc[m][2 * q + 1][2], acc[m][2 * q + 1][3]};
        float vp[8];
#pragma unroll
        for (int k = 0; k < 8; ++k) vp[k] = shfl_xor_(v[k], 16);
        if (dd >= 64 && j >= CTXL) {
          const int tl = j - CTXL, pos = ((dd - 64) < 16) ? (tl / GRID_W) : (tl % GRID_W);
          const bool lo = ((dd & 8) == 0);
#pragma unroll
          for (int k = 0; k < 8; ++k) {
            float c, sn; rope_cs(ropetab, pos, k, c, sn);
            v[k] = lo ? (v[k] * c - vp[k] * sn) : (v[k] * c + vp[k] * sn);
          }
        }
#pragma unroll
        for (int k = 0; k < 8; ++k) v[k] *= rsc;
        if (row < NTOK) st8bf(Q + (((size_t)b * 4 + h) * TOK + j) * 96 + dd, v);
      }
    }
  }
}
DI void mlakv_tile(const Params& p, const LP& L, int t, char* smem) {
  const int mt = t % TP_MT, h = t / TP_MT, m0 = mt * 256, n0 = h * 128;
  const bf16* P1 = (const bf16*)(p.ws + OFF_P1);
  float* srs = (float*)(smem + SRS_OFF);
  GA g = make_ga(P1 + C_CKV, P1W, (const bf16*)(L.we + WE_UKV), 128, 128, NTOK);
  f32x4 acc[4][4];
  gemm_s<4>(g, m0, n0, smem, acc);
  rowscale_256(P1, m0, C_CKV, 128, srs);
  __syncthreads();
  bf16* K = (bf16*)(p.ws + OFF_MIX + MX_K);
  bf16* VT = (bf16*)(p.ws + OFF_MIX + MX_VTM);
  const float* ropetab = (const float*)(p.ws + OFF_ROPE);
  EPI_BEGIN(4, acc, m0, n0, NTOK)
    const float rsc = srs[row - m0];
    const int b = tok_b(row), j = tok_j(row), dd = col - n0;
#pragma unroll
    for (int k = 0; k < 8; ++k) v[k] *= rsc;
    if (dd < 64) st8bf(K + (((size_t)b * 4 + h) * TOK + j) * 96 + dd, v);
    else {
#pragma unroll
      for (int k = 0; k < 8; ++k) VT[(((size_t)b * 4 + h) * 64 + (dd - 64 + k)) * TOK + j] = f2bf(v[k]);
    }
  EPI_END
  for (int i = tid_(); i < 256 * 16; i += NTHREADS) {
    int r = i >> 4, q = i & 15;
    int row = m0 + r;
    if (row < NTOK) {
      int b = tok_b(row), j = tok_j(row);
      int blk = q >> 3, i8 = q & 7;
      float x1 = bf2f(P1[(size_t)row * P1W + C_KR + blk * 16 + i8]), x2 = bf2f(P1[(size_t)row * P1W + C_KR + blk * 16 + i8 + 8]);
      float o1 = x1, o2 = x2;
      if (j >= CTXL) {
        int tl = j - CTXL, pos = blk == 0 ? (tl / GRID_W) : (tl % GRID_W);
        float c, sn; rope_cs(ropetab, pos, i8, c, sn);
        o1 = x1 * c - x2 * sn; o2 = x2 * c + x1 * sn;
      }
      bf16* kd = K + (((size_t)b * 4 + h) * TOK + j) * 96 + 64 + blk * 16 + i8;
      kd[0] = f2bf(o1); kd[8] = f2bf(o2);
    }
  }
}
DI void navt_item(const Params& p, int it, char* smem) {
  bf16* s = (bf16*)smem;
  const bf16* P1 = (const bf16*)(p.ws + OFF_P1);
  bf16* VT = (bf16*)(p.ws + OFF_MIX + MX_VTN);
  const int tok0 = it * 64, tid = tid_();
  const int b = tok_b(tok0), j0 = tok_j(tok0);
  __syncthreads();
  for (int i = tid; i < 64 * 32; i += NTHREADS) {
    int r = i >> 5, c8 = i & 31;
    *(uint4*)(s + r * 264 + c8 * 8) = *(const uint4*)(P1 + (size_t)(tok0 + r) * P1W + C_NA + 512 + c8 * 8);
  }
  __syncthreads();
  for (int i = tid; i < 256 * 8; i += NTHREADS) {
    int ch = i >> 3, t8 = i & 7;
    unsigned w[4];
#pragma unroll
    for (int q = 0; q < 4; ++q) w[q] = (unsigned)s[(t8 * 8 + 2 * q) * 264 + ch] | ((unsigned)s[(t8 * 8 + 2 * q + 1) * 264 + ch] << 16);
    *(uint4*)(VT + ((size_t)b * 256 + ch) * TOK + j0 + t8 * 8) = make_uint4(w[0], w[1], w[2], w[3]);
  }
}
constexpr int M2C_TOK = 128, M2C_ITEMS = NTOK / M2C_TOK;
DI void m2conv_item(const Params& p, const LP& L, int it) {
  const bf16* P1 = (const bf16*)(p.ws + OFF_P1);
  bf16* XB = (bf16*)(p.ws + OFF_MIX + MX_XBC);
  const int tok0 = it * M2C_TOK;
  const float* cw = p.in[I_M2CONVW] + (size_t)L.l * 4 * 768;
  const float* cb = p.in[I_M2CONVB] + (size_t)L.l * 768;
  for (int task = tid_(); task < 96 * (M2C_TOK / 8); task += NTHREADS) {
    const int cg = task % 96, tb = task / 96, c0 = cg * 8;
    const int tokb = tok0 + tb * 8, jt = tok_j(tokb), base = tokb - jt;
    const int slo = (jt < CTXL) ? 0 : CTXL, shi = (jt < CTXL) ? CTXL : TOK;
    float w[4][8], bias[8];
#pragma unroll
    for (int k = 0; k < 4; ++k) { float4 a = *(const float4*)(cw + k * 768 + c0), b4 = *(const float4*)(cw + k * 768 + c0 + 4);
      w[k][0] = a.x; w[k][1] = a.y; w[k][2] = a.z; w[k][3] = a.w; w[k][4] = b4.x; w[k][5] = b4.y; w[k][6] = b4.z; w[k][7] = b4.w; }
    { float4 a = *(const float4*)(cb + c0), b4 = *(const float4*)(cb + c0 + 4);
      bias[0] = a.x; bias[1] = a.y; bias[2] = a.z; bias[3] = a.w; bias[4] = b4.x; bias[5] = b4.y; bias[6] = b4.z; bias[7] = b4.w; }
    float xin[11][8];
#pragma unroll
    for (int r = 0; r < 11; ++r) {
      const int j = jt - 2 + r;
      if (j >= slo && j < shi) ld8bf(P1 + (size_t)(base + j) * P1W + C_XBC + c0, xin[r]);
      else {
#pragma unroll
        for (int c = 0; c < 8; ++c) xin[r][c] = 0.f;
      }
    }
    float y[8][8];
#pragma unroll
    for (int t = 0; t < 8; ++t) {
#pragma unroll
      for (int c = 0; c < 8; ++c) y[t][c] = siluf_(bias[c] + w[0][c] * xin[t][c] + w[1][c] * xin[t + 1][c] + w[2][c] * xin[t + 2][c] + w[3][c] * xin[t + 3][c]);
      st8bf(XB + (size_t)(base + jt + t) * 768 + c0, y[t]);
    }
    if (c0 < 512) {
      bf16* XT = (bf16*)(p.ws + OFF_MIX + MX_XBT) + ((size_t)(base / TOK) * 512 + c0) * TOK + jt;
#pragma unroll
      for (int c = 0; c < 8; ++c) {
        float col[8];
#pragma unroll
        for (int t = 0; t < 8; ++t) col[t] = y[t][c];
        st8bf(XT + (size_t)c * TOK, col);
      }
    }
  }
}
DI int m2_seq2tok(int sq, int dir) { return (dir == 0) ? sq : (sq < CTXL ? (CTXL - 1 - sq) : (TOK - 1 - (sq - CTXL))); }
constexpr int M2S_ITEMS = BATCH * 8 * (TOK / 64) / NWAVES;
DI void m2scal_item(const Params& p, const LP& L, int it) {
  const int w = it * NWAVES + (tid_() >> 6), lane = tid_() & 63;
  const int ch = w % (TOK / 64), r = w / (TOK / 64), hd = r & 3, dir = (r >> 2) & 1, b = r >> 3;
  const float a = -expf(p.in[I_M2ALOG][(L.l * 2 + dir) * 4 + hd]);
  const int sq = ch * 64 + lane, j = m2_seq2tok(sq, dir);
  const float dt = ((const float*)(p.ws + OFF_DT))[((size_t)b * TOK + j) * 8 + dir * 4 + hd];
  float cs = dt * a;
#pragma unroll
  for (int d = 1; d < 64; d <<= 1) { float o = shfl_up_(cs, d); if (lane >= d) cs += o; }
  const float sl = shfl_(cs, 63);
  float* o = (float*)(p.ws + OFF_MIX + MX_M2S) + ((size_t)((b * 2 + dir) * 4 + hd) * TOK + sq) * 4;
  *(float4*)o = make_float4(cs, dt, dt * __expf(sl - cs), cs * 1.4426950408889634f - log2f(dt));
}
constexpr int S5_MT = (MCH + 255) / 256;
DI void s5a_tile(const Params& p, const LP& L, int t, char* smem) {
  const int g = t / (S5_MT * 2), r = t % (S5_MT * 2), mt = r / 2, nt = r % 2;
  const int m0 = mt * 256, n0 = nt * 128;
  GA ga = make_ga((const bf16*)(p.ws + OFF_MIX + MX_US5) + (size_t)g * NTOK * 16, 256, (const bf16*)(L.s5 + S5_WA) + (size_t)g * 65536, 256, 256, MCH);
  f32x4 acc[4][4];
  gemm_s<4>(ga, m0, n0, smem, acc);
  float* HE = (float*)(p.ws + OFF_MIX + MX_HEND) + (size_t)g * MCH * 256;
  EPI_BEGIN(4, acc, m0, n0, MCH)
    st8f(HE + (size_t)row * 256 + col, v);
  EPI_END
}
DI int s5_chunk_of(int i, int d) { return (d == 0) ? i : (i < NCC ? (NCC - 1 - i) : (NCH - 1 - (i - NCC))); }
DI void s5carry_item(const Params& p, const LP& L, int it) {
  const int w = it * NWAVES + (tid_() >> 6), lane = tid_() & 63;
  const int d = w / (16 * BATCH), g = (w / BATCH) & 15, b = w % BATCH;
  const float* lp = (const float*)(L.s5 + S5_LAMPOW) + ((size_t)((d * 16 + g) * 17 + 16) * 64 + lane) * 2;
  const float lre = lp[0], lim = lp[1];
  const float* HE = (const float*)(p.ws + OFF_MIX + MX_HEND) + ((size_t)g * MCH + (size_t)b * NCH) * 256 + d * 128;
  bf16* HI = (bf16*)(p.ws + OFF_MIX + MX_HIN) + ((size_t)g * MCH + (size_t)b * NCH) * 256 + d * 128;
  float cre = 0.f, cim = 0.f;
  static_assert(NCH % 4 == 0, "chunk count");
  for (int i0 = 0; i0 < NCH; i0 += 4) {
    float hre[4], him[4];
#pragma unroll
    for (int k = 0; k < 4; ++k) { const int ch = s5_chunk_of(i0 + k, d); hre[k] = HE[(size_t)ch * 256 + lane]; him[k] = HE[(size_t)ch * 256 + 64 + lane]; }
#pragma unroll
    for (int k = 0; k < 4; ++k) {
      const int ch = s5_chunk_of(i0 + k, d);
      HI[(size_t)ch * 256 + lane] = f2bf(cre); HI[(size_t)ch * 256 + 64 + lane] = f2bf(cim);
      const float nre = lre * cre - lim * cim + hre[k], nim = lre * cim + lim * cre + him[k];
      cre = nre; cim = nim;
    }
  }
}
DI void s5c_tile(const Params& p, const LP& L, int t, char* smem) {
  const int g = t / (S5_MT * 2), r = t % (S5_MT * 2), mt = r / 2, nt = r % 2;
  const int m0 = mt * 256, n0 = nt * 128;
  GA ga = make_ga((const bf16*)(p.ws + OFF_MIX + MX_US5) + (size_t)g * NTOK * 16, 256, (const bf16*)(L.s5 + S5_W2) + (size_t)g * 256 * 512, 512, 512, MCH);
  ga.A2 = (const bf16*)(p.ws + OFF_MIX + MX_HIN) + (size_t)g * MCH * 256; ga.lda2 = 256; ga.ksplit = 256;
  f32x4 acc[4][4];
  gemm_s<4>(ga, m0, n0, smem, acc);
  bf16* Z = (bf16*)(p.ws + OFF_MIX + MX_Z);
  EPI_BEGIN(4, acc, m0, n0, MCH)
#pragma unroll
    for (int k = 0; k < 8; ++k) v[k] = geluf_(v[k]);
    st8bf(Z + ((size_t)row * 16 + (col >> 4)) * 256 + g * 16 + (col & 15), v);
  EPI_END
}

DI float fmax_(float a, float b) { return a > b ? a : b; }
constexpr int AT_LDV = 76;
struct NaInfo { int r, qc, rs, cs; };
template <int DK, bool NA>
DI void attn_block(const bf16* qrow, bool active, const bf16* Kp, int kstride, const bf16* Vt,
                   int ka0, int ntile_a, int arow0, int kb0, int ntile_b,
                   const float* srpb, NaInfo ni, float scale, bf16* orow, char* smem) {
  constexpr int LDK = DK + 8, KCH = DK / 8;
  constexpr int KT_BYTES = 64 * LDK * 2, VT_BYTES = 64 * AT_LDV * 2;
  constexpr int NKL = (64 * KCH + NTHREADS - 1) / NTHREADS;
  const int tid = tid_(), lane = tid & 63, half = lane >> 5, r = lane & 31;
  bf16* sK = (bf16*)smem;
  bf16* sV = (bf16*)(smem + 2 * KT_BYTES);
  bf16x8 qf[DK / 16];
  f32x16 o0, o1;
  float m = -1e30f, l = 0.f;
  const float scale2 = scale * 1.4426950408889634f;
#pragma unroll
  for (int ks = 0; ks < DK / 16; ++ks) qf[ks] = active ? *(const bf16x8*)(qrow + ks * 16 + 8 * half) : bf16x8{0, 0, 0, 0, 0, 0, 0, 0};
#pragma unroll
  for (int i = 0; i < 16; ++i) { o0[i] = 0.f; o1[i] = 0.f; }
  const int NTL = ntile_a + ntile_b;
  u32x4 rk[NKL], rv[1];
#pragma unroll
  for (int i = 0; i < NKL; ++i) rk[i] = u32x4{0u, 0u, 0u, 0u};
  auto key0_of = [&](int t) { return t < ntile_a ? ka0 + 64 * t : kb0 + 64 * (t - ntile_a); };
#define AT_GLOAD(t_) { const int k0_ = key0_of(t_); \
    _Pragma("unroll") for (int i_ = 0; i_ < NKL; ++i_) { const int c_ = tid + i_ * NTHREADS; const int key_ = c_ / KCH, ch_ = c_ % KCH; \
      if (c_ < 64 * KCH) rk[i_] = *(const u32x4*)(Kp + (size_t)(k0_ + key_) * kstride + ch_ * 8); } \
    { const int d_ = tid >> 3, ch_ = tid & 7; rv[0] = *(const u32x4*)(Vt + (size_t)d_ * TOK + k0_ + ch_ * 8); } }
#define AT_SSTORE(buf_) { \
    _Pragma("unroll") for (int i_ = 0; i_ < NKL; ++i_) { const int c_ = tid + i_ * NTHREADS; const int key_ = c_ / KCH, ch_ = c_ % KCH; \
      if (c_ < 64 * KCH) *(u32x4*)(sK + (buf_) * (64 * LDK) + key_ * LDK + ch_ * 8) = rk[i_]; } \
    { const int d_ = tid >> 3, ch_ = tid & 7; \
      bf16* dst_ = sV + (buf_) * (64 * AT_LDV) + d_ * AT_LDV + ch_ * 8; \
      *(uint2*)dst_ = make_uint2(rv[0][0], rv[0][1]); *(uint2*)(dst_ + 4) = make_uint2(rv[0][2], rv[0][3]); } }
  __syncthreads();
  AT_GLOAD(0) AT_SSTORE(0)
  __syncthreads();
#pragma unroll 1
  for (int t = 0; t < NTL; ++t) {
    const int buf = t & 1;
    if (t + 1 < NTL) AT_GLOAD(t + 1)
    bool doit = active;
    int trow0 = 0;
    if (NA && t < ntile_a) {
      trow0 = arow0 + t * (64 / GRID_W);
      doit = active && (trow0 + (64 / GRID_W) > ni.rs) && (trow0 < ni.rs + WIN_R);
    }
    if (doit) {
      const bf16* kb = sK + buf * (64 * LDK);
      const bf16* vb = sV + buf * (64 * AT_LDV);
      f32x16 s0, s1;
#pragma unroll
      for (int i = 0; i < 16; ++i) { s0[i] = 0.f; s1[i] = 0.f; }
#pragma unroll
      for (int ks = 0; ks < DK / 16; ++ks) {
        bf16x8 a0 = *(const bf16x8*)(kb + r * LDK + ks * 16 + 8 * half);
        bf16x8 a1 = *(const bf16x8*)(kb + (32 + r) * LDK + ks * 16 + 8 * half);
        s0 = __builtin_amdgcn_mfma_f32_32x32x16_bf16(a0, qf[ks], s0, 0, 0, 0);
        s1 = __builtin_amdgcn_mfma_f32_32x32x16_bf16(a1, qf[ks], s1, 0, 0, 0);
      }
      float mx = -INFINITY;
      if (NA && t < ntile_a) {
#pragma unroll
        for (int i = 0; i < 16; ++i) {
          const int kk = (i & 3) + 8 * (i >> 2) + 4 * half;
#pragma unroll
          for (int hb = 0; hb < 2; ++hb) {
            const int kq = kk + 32 * hb;
            const int kr = trow0 + kq / GRID_W, kc = kq % GRID_W;
            const bool ok = (kr >= ni.rs) && (kr < ni.rs + WIN_R) && (kc >= ni.cs) && (kc < ni.cs + WIN_C);
            const float bias = ok ? srpb[(kr - ni.r + 7) * 31 + (kc - ni.qc + 15)] * 1.4426950408889634f : -INFINITY;
            if (hb == 0) { s0[i] = s0[i] * scale2 + bias; mx = fmax_(mx, s0[i]); }
            else { s1[i] = s1[i] * scale2 + bias; mx = fmax_(mx, s1[i]); }
          }
        }
      } else {
#pragma unroll
        for (int i = 0; i < 16; ++i) { s0[i] *= scale2; s1[i] *= scale2; mx = fmax_(mx, fmax_(s0[i], s1[i])); }
      }
      mx = fmax_(mx, shfl_xor_(mx, 32));
      const float mn = fmax_(m, mx);
      const float alpha = exp2f_(m - mn);
      const bool same = (mn == m);
      m = mn;
      float ps = 0.f;
#pragma unroll
      for (int i = 0; i < 16; ++i) { s0[i] = exp2f_(s0[i] - mn); s1[i] = exp2f_(s1[i] - mn); ps += s0[i] + s1[i]; }
      l = l * alpha + ps;
      if (!wave_all_(same)) {
#pragma unroll
        for (int i = 0; i < 16; ++i) { o0[i] *= alpha; o1[i] *= alpha; }
      }
#pragma unroll
      for (int kq = 0; kq < 4; ++kq) {
        u32x4 pw;
#pragma unroll
        for (int j = 0; j < 4; ++j) pw[j] = (kq < 2) ? pack2(s0[8 * (kq & 1) + 2 * j], s0[8 * (kq & 1) + 2 * j + 1]) : pack2(s1[8 * (kq & 1) + 2 * j], s1[8 * (kq & 1) + 2 * j + 1]);
        const bf16x8 pf = __builtin_bit_cast(bf16x8, pw);
        const bf16* v0 = vb + r * AT_LDV + 16 * kq + 4 * half;
        const bf16* v1 = vb + (r + 32) * AT_LDV + 16 * kq + 4 * half;
        uint2 a0 = *(const uint2*)v0, a1 = *(const uint2*)(v0 + 8), b0 = *(const uint2*)v1, b1 = *(const uint2*)(v1 + 8);
        bf16x8 va, vbb;
        va[0] = (short)(a0.x & 0xffff); va[1] = (short)(a0.x >> 16); va[2] = (short)(a0.y & 0xffff); va[3] = (short)(a0.y >> 16);
        va[4] = (short)(a1.x & 0xffff); va[5] = (short)(a1.x >> 16); va[6] = (short)(a1.y & 0xffff); va[7] = (short)(a1.y >> 16);
        vbb[0] = (short)(b0.x & 0xffff); vbb[1] = (short)(b0.x >> 16); vbb[2] = (short)(b0.y & 0xffff); vbb[3] = (short)(b0.y >> 16);
        vbb[4] = (short)(b1.x & 0xffff); vbb[5] = (short)(b1.x >> 16); vbb[6] = (short)(b1.y & 0xffff); vbb[7] = (short)(b1.y >> 16);
        o0 = __builtin_amdgcn_mfma_f32_32x32x16_bf16(va, pf, o0, 0, 0, 0);
        o1 = __builtin_amdgcn_mfma_f32_32x32x16_bf16(vbb, pf, o1, 0, 0, 0);
      }
    }
    if (t + 1 < NTL) AT_SSTORE(buf ^ 1)
    __syncthreads();
  }
  if (active) {
    const float lt = l + shfl_xor_(l, 32);
    const float inv = rcp_(lt);
#pragma unroll
    for (int gI = 0; gI < 4; ++gI) {
      const int d0 = 8 * gI + 4 * half;
      *(uint2*)(orow + d0) = make_uint2(pack2(o0[4 * gI] * inv, o0[4 * gI + 1] * inv), pack2(o0[4 * gI + 2] * inv, o0[4 * gI + 3] * inv));
      *(uint2*)(orow + 32 + d0) = make_uint2(pack2(o1[4 * gI] * inv, o1[4 * gI + 1] * inv), pack2(o1[4 * gI + 2] * inv, o1[4 * gI + 3] * inv));
    }
  }
}
DI void mla_attn_item(const Params& p, int it, bool ctxq, char* smem) {
  const int nqb = ctxq ? (CTXL + 255) / 256 : SEQ / 256;
  const int b = it / (4 * nqb), h = (it / nqb) & 3, qb = it % nqb;
  const int lane = tid_() & 63, wid = tid_() >> 6;
  const int nq = ctxq ? CTXL : SEQ, q0 = qb * 256 + wid * 32;
  const bool active = q0 < nq;
  const int jq = (ctxq ? 0 : CTXL) + (active ? q0 : 0) + (lane & 31);
  const bf16* Q = (const bf16*)(p.ws + OFF_MIX + MX_Q) + ((size_t)b * 4 + h) * TOK * 96;
  const bf16* K = (const bf16*)(p.ws + OFF_MIX + MX_K) + ((size_t)b * 4 + h) * TOK * 96;
  const bf16* VT = (const bf16*)(p.ws + OFF_MIX + MX_VTM) + ((size_t)b * 4 + h) * 64 * TOK;
  bf16* O = (bf16*)(p.ws + OFF_O) + ((size_t)b * TOK + jq) * 1024 + 0 * 256 + h * 64;
  NaInfo ni; ni.r = 0; ni.qc = 0; ni.rs = 0; ni.cs = 0;
  attn_block<96, false>(Q + (size_t)jq * 96, active, K, 96, VT, 0, 0, 0, 0, (ctxq ? CTXL : TOK) / 64, nullptr, ni, 0.10206207261596577f, O, smem);
}
DI void na_attn_item(const Params& p, const LP& L, int it, bool ctxq, char* smem) {
  const int nqb = ctxq ? (CTXL + 255) / 256 : SEQ / 256;
  const int b = it / (4 * nqb), h = (it / nqb) & 3, qb = it % nqb;
  const int tid = tid_(), lane = tid & 63, wid = tid >> 6;
  const int nq = ctxq ? CTXL : SEQ, q0 = qb * 256 + wid * 32;
  const bool active = q0 < nq;
  const int jq = (ctxq ? 0 : CTXL) + (active ? q0 : 0) + (lane & 31);
  const bf16* P1 = (const bf16*)(p.ws + OFF_P1) + (size_t)b * TOK * P1W;
  const bf16* VT = (const bf16*)(p.ws + OFF_MIX + MX_VTN) + ((size_t)b * 4 + h) * 64 * TOK;
  const bf16* Kb = P1 + C_NA + 256 + h * 64;
  bf16* O = (bf16*)(p.ws + OFF_O) + ((size_t)b * TOK + jq) * 1024 + 1 * 256 + h * 64;
  constexpr int AT_END64 = 2 * (64 * 72 * 2) + 2 * (64 * AT_LDV * 2);
  float* srpb = (float*)(smem + AT_END64);
  NaInfo ni; ni.r = 0; ni.qc = 0; ni.rs = 0; ni.cs = 0;
  int ka0 = 0, nta = 0, arow0 = 0;
  if (!ctxq) {
    __syncthreads();
    const float* rpb = p.in[I_RPB] + ((size_t)L.l * 4 + h) * 15 * 31;
    for (int i = tid; i < 15 * 31; i += NTHREADS) srpb[i] = rpb[i];
    const int tl = q0 + (lane & 31);
    ni.r = tl / GRID_W; ni.qc = tl % GRID_W;
    int rs = ni.r - WIN_R / 2; rs = rs < 0 ? 0 : (rs > ROWS - WIN_R ? ROWS - WIN_R : rs);
    int cs = ni.qc - WIN_C / 2; cs = cs < 0 ? 0 : (cs > GRID_W - WIN_C ? GRID_W - WIN_C : cs);
    ni.rs = rs; ni.cs = cs;
    constexpr int RPT = 64 / GRID_W;
    const int rfirst = (qb * 256) / GRID_W, rlast = (qb * 256 + 255) / GRID_W;
    int rs_f = rfirst - WIN_R / 2; rs_f = rs_f < 0 ? 0 : (rs_f > ROWS - WIN_R ? ROWS - WIN_R : rs_f);
    int rs_l = rlast - WIN_R / 2; rs_l = rs_l < 0 ? 0 : (rs_l > ROWS - WIN_R ? ROWS - WIN_R : rs_l);
    arow0 = (rs_f / RPT) * RPT;
    const int row_hi = rs_l + WIN_R;
    nta = (row_hi - arow0 + RPT - 1) / RPT;
    ka0 = CTXL + arow0 * GRID_W;
  }
  attn_block<64, true>(P1 + (size_t)jq * P1W + C_NA + h * 64, active, Kb, P1W, VT, ka0, nta, arow0, 0, CTXL / 64, srpb, ni, 0.125f, O, smem);
}

constexpr int M2_LDB = 136, M2_LDX = 72;
constexpr int M2_OFF_B = 0;
constexpr int M2_OFF_C = M2_OFF_B + 64 * M2_LDB * 2;
constexpr int M2_OFF_HD = M2_OFF_C + 64 * M2_LDB * 2;
constexpr int M2H_H = 0;
constexpr int M2H_XT = M2H_H + 64 * M2_LDB * 2;
constexpr int M2H_BT = M2H_XT + 64 * M2_LDX * 2;
constexpr int M2H_S = M2H_BT + 128 * M2_LDX * 2;
constexpr int M2H_X = M2H_S + 3 * 64 * 4;
constexpr int M2H_SIZE = M2H_X + 64 * M2_LDX * 2;
constexpr int M2_SMEM = M2_OFF_HD + 2 * M2H_SIZE;
static_assert(M2_SMEM <= SMEM_BYTES, "m2 smem");
DI u32x4 rev8_(u32x4 v) {
  return u32x4{(v[3] >> 16) | (v[3] << 16), (v[2] >> 16) | (v[2] << 16), (v[1] >> 16) | (v[1] << 16), (v[0] >> 16) | (v[0] << 16)};
}
DI void m2scan_item(const Params& p, const LP& L, int it, char* smem) {
  const int b = it / 4, grp = (it >> 1) & 1, dir = it & 1;
  const int tid = tid_(), lane = tid & 63, wid = tid >> 6, half = lane >> 5, r = lane & 31;
  const int hsel = wid >> 2, wl = wid & 3, hd = grp * 2 + hsel;
  bf16* sB = (bf16*)(smem + M2_OFF_B);
  bf16* sC = (bf16*)(smem + M2_OFF_C);
  char* hb = smem + M2_OFF_HD + hsel * M2H_SIZE;
  bf16* sH = (bf16*)(hb + M2H_H);
  bf16* sXT = (bf16*)(hb + M2H_XT);
  bf16* sBT = (bf16*)(hb + M2H_BT);
  float* sS = (float*)(hb + M2H_S);
  float* sDt = sS + 64;
  float* sW = sS + 128;
  const bf16* XB = (const bf16*)(p.ws + OFF_MIX + MX_XBC) + (size_t)b * TOK * 768;
  const bf16* XT = (const bf16*)(p.ws + OFF_MIX + MX_XBT) + (size_t)b * 512 * TOK;
  const float* SC = (const float*)(p.ws + OFF_MIX + MX_M2S) + (size_t)((b * 2 + dir) * 4 + hd) * TOK * 4;
  float* YM = (float*)(p.ws + OFF_HA) + ((size_t)dir * NTOK + (size_t)b * TOK) * 256;
  const int pb = wl & 1, tb = wl >> 1, nb0 = 2 * (wl >> 1);
  f32x16 hst[2];
#pragma unroll
  for (int i = 0; i < 16; ++i) { hst[0][i] = 0.f; hst[1][i] = 0.f; }
  __syncthreads();
  for (int i = tid; i < 2 * M2H_SIZE / 4; i += NTHREADS) ((unsigned*)(smem + M2_OFF_HD))[i] = 0u;
  __syncthreads();
  u32x4 rxt[2], rbt[2], rb[2], rc[2];
  float4 rsc = make_float4(0.f, 0.f, 0.f, 0.f);
#define M2_TLOAD(rowptr_, sq0_) (*(const u32x4*)((rowptr_) + ((dir == 0) ? (sq0_) : m2_seq2tok((sq0_) + 7, 1))))
#define M2_GLOAD(c0_) { \
    _Pragma("unroll") for (int q_ = 0; q_ < 2; ++q_) { const int i_ = tid + q_ * NTHREADS; const int h2_ = i_ >> 9, t8_ = ((i_ >> 6) & 7) * 8, pp_ = i_ & 63; \
      rxt[q_] = M2_TLOAD(XT + (size_t)((grp * 2 + h2_) * 64 + pp_) * TOK, (c0_) + t8_); } \
    _Pragma("unroll") for (int q_ = 0; q_ < 2; ++q_) { const int i_ = tid + q_ * NTHREADS; const int t8_ = (i_ >> 7) * 8, nn_ = i_ & 127; \
      rbt[q_] = M2_TLOAD(XT + (size_t)(256 + grp * 128 + nn_) * TOK, (c0_) + t8_); } \
    _Pragma("unroll") for (int q_ = 0; q_ < 2; ++q_) { const int i_ = tid + q_ * NTHREADS; const int t_ = i_ >> 4, n8_ = (i_ & 15) * 8; \
      const bf16* src_ = XB + (size_t)m2_seq2tok((c0_) + t_, dir) * 768 + grp * 128 + n8_; \
      rb[q_] = *(const u32x4*)(src_ + 256); rc[q_] = *(const u32x4*)(src_ + 512); } \
    if (wl == 0) rsc = *(const float4*)(SC + (size_t)((c0_) + lane) * 4); }
  M2_GLOAD(0)
  for (int c0 = 0; c0 < TOK; c0 += 64) {
    if (wl == 0) { sS[lane] = rsc.x; sDt[lane] = rsc.w; sW[lane] = rsc.z; }
    __syncthreads();
#pragma unroll
    for (int q2 = 0; q2 < 2; ++q2) {
      const int i = tid + q2 * NTHREADS; const int h2 = i >> 9, t8 = ((i >> 6) & 7) * 8, pp = i & 63;
      *(u32x4*)((bf16*)(smem + M2_OFF_HD + h2 * M2H_SIZE + M2H_XT) + pp * M2_LDX + t8) = dir ? rev8_(rxt[q2]) : rxt[q2];
    }
#pragma unroll
    for (int q4 = 0; q4 < 2; ++q4) {
      const int i = tid + q4 * NTHREADS; const int t = i >> 4, n8 = (i & 15) * 8;
      *(u32x4*)(sB + t * M2_LDB + n8) = rb[q4];
      *(u32x4*)(sC + t * M2_LDB + n8) = rc[q4];
    }
#pragma unroll
    for (int q4 = 0; q4 < 2; ++q4) {
      const int i = tid + q4 * NTHREADS; const int t8 = (i >> 7) * 8, nn = i & 127;
      float bv[8];
      if (dir) rbt[q4] = rev8_(rbt[q4]);
      bv[0] = __uint_as_float(rbt[q4][0] << 16); bv[1] = __uint_as_float(rbt[q4][0] & 0xffff0000u);
      bv[2] = __uint_as_float(rbt[q4][1] << 16); bv[3] = __uint_as_float(rbt[q4][1] & 0xffff0000u);
      bv[4] = __uint_as_float(rbt[q4][2] << 16); bv[5] = __uint_as_float(rbt[q4][2] & 0xffff0000u);
      bv[6] = __uint_as_float(rbt[q4][3] << 16); bv[7] = __uint_as_float(rbt[q4][3] & 0xffff0000u);
#pragma unroll
      for (int h2 = 0; h2 < 2; ++h2) {
        const float* wv = (const float*)(smem + M2_OFF_HD + h2 * M2H_SIZE + M2H_S) + 128 + t8;
        float sv[8];
#pragma unroll
        for (int k = 0; k < 8; ++k) sv[k] = bv[k] * wv[k];
        st8bf((bf16*)(smem + M2_OFF_HD + h2 * M2H_SIZE + M2H_BT) + nn * M2_LDX + t8, sv);
      }
    }
    __syncthreads();
    if (c0 + 64 < TOK) M2_GLOAD(c0 + 64)
    {
      f32x16 yT, y2;
#pragma unroll
      for (int i = 0; i < 16; ++i) { yT[i] = 0.f; y2[i] = 0.f; }
      const int tv = 32 * tb + r;
      const float St = sS[tv];
      for (int sb = 0; sb <= tb; ++sb) {
        f32x16 gT;
#pragma unroll
        for (int i = 0; i < 16; ++i) gT[i] = 0.f;
#pragma unroll
        for (int ks = 0; ks < 8; ++ks) {
          bf16x8 av = *(const bf16x8*)(sB + (32 * sb + r) * M2_LDB + 16 * ks + 8 * half);
          bf16x8 bv = *(const bf16x8*)(sC + tv * M2_LDB + 16 * ks + 8 * half);
          gT = __builtin_amdgcn_mfma_f32_32x32x16_bf16(av, bv, gT, 0, 0, 0);
        }
        const float St2 = St * 1.4426950408889634f;
        if (sb == tb) {
#pragma unroll
          for (int i = 0; i < 16; ++i) {
            const int sv = 32 * sb + (i & 3) + 8 * (i >> 2) + 4 * half;
            gT[i] = (sv <= tv) ? gT[i] * exp2f_(St2 - sDt[sv]) : 0.f;
          }
        } else {
#pragma unroll
          for (int i = 0; i < 16; ++i) {
            const int sv = 32 * sb + (i & 3) + 8 * (i >> 2) + 4 * half;
            gT[i] *= exp2f_(St2 - sDt[sv]);
          }
        }
#pragma unroll
        for (int kq = 0; kq < 2; ++kq) {
          const u32x4 pw = u32x4{pack2(gT[8 * kq], gT[8 * kq + 1]), pack2(gT[8 * kq + 2], gT[8 * kq + 3]), pack2(gT[8 * kq + 4], gT[8 * kq + 5]), pack2(gT[8 * kq + 6], gT[8 * kq + 7])};
          const bf16x8 pf = __builtin_bit_cast(bf16x8, pw);
          const bf16* xr = sXT + (32 * pb + r) * M2_LDX + 32 * sb + 16 * kq + 4 * half;
          uint2 x0 = *(const uint2*)xr, x1 = *(const uint2*)(xr + 8);
          bf16x8 xa;
          xa[0] = (short)(x0.x & 0xffff); xa[1] = (short)(x0.x >> 16); xa[2] = (short)(x0.y & 0xffff); xa[3] = (short)(x0.y >> 16);
          xa[4] = (short)(x1.x & 0xffff); xa[5] = (short)(x1.x >> 16); xa[6] = (short)(x1.y & 0xffff); xa[7] = (short)(x1.y >> 16);
          yT = __builtin_amdgcn_mfma_f32_32x32x16_bf16(xa, pf, yT, 0, 0, 0);
        }
      }
#pragma unroll
      for (int ks = 0; ks < 8; ++ks) {
        bf16x8 av = *(const bf16x8*)(sH + (32 * pb + r) * M2_LDB + 16 * ks + 8 * half);
        bf16x8 bv = *(const bf16x8*)(sC + tv * M2_LDB + 16 * ks + 8 * half);
        y2 = __builtin_amdgcn_mfma_f32_32x32x16_bf16(av, bv, y2, 0, 0, 0);
      }
      const float eS = __expf(St);
      const int j = m2_seq2tok(c0 + tv, dir);
      float* yo = YM + (size_t)j * 256 + hd * 64 + 32 * pb + 4 * half;
#pragma unroll
      for (int gI = 0; gI < 4; ++gI)
        *(float4*)(yo + 8 * gI) = make_float4(yT[4 * gI] + eS * y2[4 * gI], yT[4 * gI + 1] + eS * y2[4 * gI + 1], yT[4 * gI + 2] + eS * y2[4 * gI + 2], yT[4 * gI + 3] + eS * y2[4 * gI + 3]);
    }
    __syncthreads();
    {
      const float eL = __expf(sS[63]);
#pragma unroll
      for (int q = 0; q < 2; ++q) {
#pragma unroll
        for (int i = 0; i < 16; ++i) hst[q][i] *= eL;
#pragma unroll
        for (int ks = 0; ks < 4; ++ks) {
          bf16x8 av = *(const bf16x8*)(sXT + (32 * pb + r) * M2_LDX + 16 * ks + 8 * half);
          bf16x8 bv = *(const bf16x8*)(sBT + (32 * (nb0 + q) + r) * M2_LDX + 16 * ks + 8 * half);
          hst[q] = __builtin_amdgcn_mfma_f32_32x32x16_bf16(av, bv, hst[q], 0, 0, 0);
        }
#pragma unroll
        for (int i = 0; i < 16; ++i) {
          const int pv = 32 * pb + (i & 3) + 8 * (i >> 2) + 4 * half;
          sH[pv * M2_LDB + 32 * (nb0 + q) + r] = f2bf(hst[q][i]);
        }
      }
    }
    __syncthreads();
  }
}
DI void m2gate_item(const Params& p, const LP& L, int it) {
  const int tok = it * NWAVES + (tid_() >> 6), lane = tid_() & 63;
  const float* Y0 = (const float*)(p.ws + OFF_HA) + (size_t)tok * 256;
  const float* Y1 = Y0 + (size_t)NTOK * 256;
  const bf16* XB = (const bf16*)(p.ws + OFF_MIX + MX_XBC) + (size_t)tok * 768;
  const bf16* P1 = (const bf16*)(p.ws + OFF_P1) + (size_t)tok * P1W + C_Z;
  const int c = lane * 4, hd = c >> 6;
  const float dsk = p.in[I_M2D][L.l * 4 + hd];
  float4 y0 = *(const float4*)(Y0 + c), y1 = *(const float4*)(Y1 + c);
  uint2 xw = *(const uint2*)(XB + c), zw = *(const uint2*)(P1 + c);
  float xs[4] = {__uint_as_float(xw.x << 16), __uint_as_float(xw.x & 0xffff0000u), __uint_as_float(xw.y << 16), __uint_as_float(xw.y & 0xffff0000u)};
  float zs[4] = {__uint_as_float(zw.x << 16), __uint_as_float(zw.x & 0xffff0000u), __uint_as_float(zw.y << 16), __uint_as_float(zw.y & 0xffff0000u)};
  float ys[4] = {y0.x + y1.x, y0.y + y1.y, y0.z + y1.z, y0.w + y1.w};
  float v[4], ss = 0.f;
#pragma unroll
  for (int i = 0; i < 4; ++i) { v[i] = (ys[i] + dsk * xs[i]) * siluf_(zs[i]); ss += v[i] * v[i]; }
  ss = wave_sum(ss);
  const float rs = rsqrtf(ss * (1.f / 256.f) + EPS);
  float4 gn = *(const float4*)(p.in[I_M2GNORM] + L.l * 256 + c);
  bf16* O = (bf16*)(p.ws + OFF_O) + (size_t)tok * 1024 + 768 + c;
  *(uint2*)O = make_uint2(pack2(v[0] * rs * gn.x, v[1] * rs * gn.y), pack2(v[2] * rs * gn.z, v[3] * rs * gn.w));
}
constexpr int GLU_MT = (NTOK + 255) / 256;
DI void glu_tile(const Params& p, const LP& L, int t, char* smem) {
  const int mt = t % GLU_MT, nt = t / GLU_MT, m0 = mt * 256, n0 = nt * 128;
  const bf16* Z = (const bf16*)(p.ws + OFF_MIX + MX_Z);
  GA g = make_ga(Z, 256, (const bf16*)(L.we + WE_GLU), 256, 256, NTOK);
  f32x4 acc[4][4];
  gemm_s<4>(g, m0, n0, smem, acc);
  bf16* O = (bf16*)(p.ws + OFF_O);
  const float* bg = p.in[I_S5BGLU] + L.l * 256;
  EPI_BEGIN(4, acc, m0, n0, NTOK)
    float z[8]; ld8bf(Z + (size_t)row * 256 + col, z);
#pragma unroll
    for (int k = 0; k < 8; ++k) v[k] = z[k] * sigmoidf_(v[k] + bg[col + k]);
    st8bf(O + (size_t)row * 1024 + 512 + col, v);
  EPI_END
}
DI void merge_tile(const Params& p, const LP& L, int t, char* smem) {
  constexpr int MT_L = BATCH * (SEQ / 256), MT_A = (NTOK + 255) / 256;
  const int mt = L.last ? t % MT_L : t % MT_A, nt = L.last ? t / MT_L : t / MT_A, m0 = mtile_row0(mt, L.last, 256), n0 = nt * 128;
  const bf16* O = (const bf16*)(p.ws + OFF_O);
  const bf16* PG = (const bf16*)(p.ws + OFF_PG);
  float tot[4][2][8];
#pragma unroll
  for (int a = 0; a < 4; ++a)
#pragma unroll
    for (int q = 0; q < 2; ++q)
#pragma unroll
      for (int k = 0; k < 8; ++k) tot[a][q][k] = 0.f;
  for (int j = 0; j < 4; ++j) {
    GA g = make_ga(O + j * 256, 1024, (const bf16*)(L.we + WE_WB) + (size_t)j * 1024 * 256, 256, 256, NTOK);
    f32x4 acc[4][4];
    gemm_s<4>(g, m0, n0, smem, acc);
    EPI_BEGIN(4, acc, m0, n0, NTOK)
      float gt[8]; ld8bf(PG + (size_t)row * 4096 + j * 1024 + col, gt);
#pragma unroll
      for (int k = 0; k < 8; ++k) tot[_m][_q][k] += gt[k] * v[k];
    EPI_END
  }
  bf16* Y = (bf16*)(p.ws + OFF_P1);
  {
    const int l = tid_() & 63, w = tid_() >> 6, wr = w >> 1, wc = w & 1, fr = l & 15, fq = l >> 4;
#pragma unroll
    for (int m = 0; m < 4; ++m)
#pragma unroll
      for (int q = 0; q < 2; ++q) {
        const int row = m0 + wr * 64 + m * 16 + fr, col = n0 + wc * 64 + q * 32 + 8 * fq;
        if (row < NTOK) st8bf(Y + (size_t)row * 1024 + col, tot[m][q]);
      }
  }
}
DI void outproj_tile(const Params& p, const LP& L, int t, char* smem) {
  float* Y2 = (float*)(p.ws + OFF_HA);
  constexpr int MT_L = BATCH * (SEQ / 256), MT_A = (NTOK + 255) / 256;
  const int mt = L.last ? t % MT_L : t % MT_A, nt = L.last ? t / MT_L : t / MT_A, m0 = mtile_row0(mt, L.last, 256), n0 = nt * 256;
  GA g = make_ga((const bf16*)(p.ws + OFF_P1), 1024, (const bf16*)(L.we + WE_WOUT), 1024, 1024, NTOK);
  f32x4 acc[2][2][4][2];
  gemm_big(g, m0, n0, smem, acc);
  EPIB_BEGIN(acc, m0, n0, NTOK)
    st8f(Y2 + (size_t)row * 1024 + col, v);
  EPIB_END
}
DI int post_ntok(bool latonly) { return latonly ? BATCH * SEQ : NTOK; }
DI int post_tok(int i, bool latonly) { return latonly ? ((i / SEQ) * TOK + CTXL + (i % SEQ)) : i; }

DI const float* xsrc_row(const Params& p, int l, int tok) {
  if (l > 0) return (const float*)(p.ws + OFF_X) + (size_t)tok * 1024;
  const int b = tok_b(tok), j = tok_j(tok);
  return (j < CTXL) ? p.in[I_CTX] + ((size_t)b * CTXL + j) * 1024 : p.in[I_X] + ((size_t)b * SEQ + (j - CTXL)) * 1024;
}
DI void post_stage_router(const Params& p, const LP& L, char* smem) {
  const float* wr = p.in[I_WROUTER] + (size_t)L.l * 1024 * 16;
  float4* wl = (float4*)smem;
  __syncthreads();
  for (int i = tid_(); i < 4096; i += NTHREADS) {
    const int k = i >> 2, q = i & 3;
    const int pos = ((k >> 8) * 4 + (k & 3)) * 64 + ((k >> 2) & 63);
    wl[q * 1024 + pos] = *(const float4*)(wr + (size_t)k * 16 + q * 4);
  }
  __syncthreads();
}
DI void post_phase(const Params& p, const LP& L, char* smem) {
  const int lane = tid_() & 63, gw = (int)blockIdx.x * NWAVES + (tid_() >> 6), TW = (int)gridDim.x * NWAVES;
  const int n = post_ntok(L.last);
  if (gw >= n) return;
  const float* gpm = p.in[I_GPOSTMIX] + L.l * 1024;
  const float4* wl = (const float4*)smem;
  int i = gw, tok = post_tok(i, L.last);
  float4 yr[4], xr[4];
  {
    const float* X = xsrc_row(p, L.l, tok);
    const float* Y2 = (const float*)(p.ws + OFF_HA) + (size_t)tok * 1024;
#pragma unroll
    for (int q = 0; q < 4; ++q) { yr[q] = *(const float4*)(Y2 + lane * 4 + q * 256); xr[q] = *(const float4*)(X + lane * 4 + q * 256); }
  }
  for (;;) {
    const int inext = i + TW; const bool has = inext < n; const int tokn = has ? post_tok(inext, L.last) : tok;
    float4 yn[4], xn[4];
    {
      const float* Xn = xsrc_row(p, L.l, tokn);
      const float* Yn = (const float*)(p.ws + OFF_HA) + (size_t)tokn * 1024;
#pragma unroll
      for (int q = 0; q < 4; ++q) { yn[q] = *(const float4*)(Yn + lane * 4 + q * 256); xn[q] = *(const float4*)(Xn + lane * 4 + q * 256); }
    }
    float* X = (float*)(p.ws + OFF_X) + (size_t)tok * 1024;
    const float* mod = L.mod + (size_t)tok_modrow(tok) * 6144;
    float xv[16], h[16];
    float ss = 0.f;
#pragma unroll
    for (int q = 0; q < 4; ++q) ss += yr[q].x * yr[q].x + yr[q].y * yr[q].y + yr[q].z * yr[q].z + yr[q].w * yr[q].w;
    ss = wave_sum(ss);
    const float rs = rsqrtf(ss * (1.f / 1024.f) + EPS);
#pragma unroll
    for (int q = 0; q < 4; ++q) {
      const int c = lane * 4 + q * 256;
      float4 xo = xr[q], gv = *(const float4*)(gpm + c), gt = *(const float4*)(mod + 2048 + c);
      xo.x += gt.x * yr[q].x * rs * gv.x; xo.y += gt.y * yr[q].y * rs * gv.y; xo.z += gt.z * yr[q].z * rs * gv.z; xo.w += gt.w * yr[q].w * rs * gv.w;
      *(float4*)(X + c) = xo;
      xv[q * 4] = xo.x; xv[q * 4 + 1] = xo.y; xv[q * 4 + 2] = xo.z; xv[q * 4 + 3] = xo.w;
    }
    bf16* H2 = (bf16*)(p.ws + OFF_P1) + (size_t)NTOK * 1024 + (size_t)tok * 1024;
    normmod_row(xv, p.in[I_GPREFFN] + L.l * 1024, mod + 3072, mod + 4096, H2, h);
    float lg[16];
#pragma unroll
    for (int e = 0; e < 16; ++e) lg[e] = 0.f;
#pragma unroll
    for (int q = 0; q < 16; ++q) {
      const int pos = ((q >> 2) * 4 + (q & 3)) * 64 + lane;
      float4 a = wl[pos], b4 = wl[1024 + pos], c4 = wl[2048 + pos], d4 = wl[3072 + pos];
      float hv = h[q];
      lg[0] += hv * a.x; lg[1] += hv * a.y; lg[2] += hv * a.z; lg[3] += hv * a.w;
      lg[4] += hv * b4.x; lg[5] += hv * b4.y; lg[6] += hv * b4.z; lg[7] += hv * b4.w;
      lg[8] += hv * c4.x; lg[9] += hv * c4.y; lg[10] += hv * c4.z; lg[11] += hv * c4.w;
      lg[12] += hv * d4.x; lg[13] += hv * d4.y; lg[14] += hv * d4.z; lg[15] += hv * d4.w;
    }
    float mx = -INFINITY;
#pragma unroll
    for (int e = 0; e < 16; ++e) { lg[e] = wave_sum(lg[e]); mx = fmax_(mx, lg[e]); }
    float se = 0.f;
#pragma unroll
    for (int e = 0; e < 16; ++e) { lg[e] = expf(lg[e] - mx); se += lg[e]; }
    if (lane < 16) {
      float v = 0.f;
#pragma unroll
      for (int e = 0; e < 16; ++e) if (e == lane) v = lg[e];
      ((float*)(p.ws + OFF_AFF))[(size_t)lane * NTOK + tok] = v * rcp_(se);
    }
    if (!has) break;
    i = inext; tok = tokn;
#pragma unroll
    for (int q = 0; q < 4; ++q) { yr[q] = yn[q]; xr[q] = xn[q]; }
  }
}
DI int block_sum_(int v, int* sred, int round) {
  const int tid = tid_(), lane = tid & 63, wid = tid >> 6;
  v += shfl_xor_(v, 32); v += shfl_xor_(v, 16); v += shfl_xor_(v, 8); v += shfl_xor_(v, 4); v += shfl_xor_(v, 2); v += shfl_xor_(v, 1);
  int* r = sred + (round & 1) * NWAVES;
  if (lane == 0) r[wid] = v;
  __syncthreads();
  int tsum = 0;
#pragma unroll
  for (int q = 0; q < NWAVES; ++q) tsum += r[q];
  return tsum;
}
DI void route_item(const Params& p, const LP& L, int it, char* smem) {
  const int nstream = L.last ? 1 : 2;
  const int b = it / (16 * nstream), e = (it / nstream) & 15, ctxs = (nstream == 2) ? (it & 1) : 0;
  const int T = ctxs ? CTXL : SEQ, cap = ctxs ? CAP_C : CAP_L;
  const int tok0 = b * TOK + (ctxs ? 0 : CTXL);
  const int slot0 = ctxs ? (BATCH * CAP_L + b * CAP_C) : (b * CAP_L);
  int* sred = (int*)smem;
  const float* AFF = (const float*)(p.ws + OFF_AFF) + (size_t)e * NTOK + tok0;
  int* SEL = (int*)(p.ws + OFF_SEL);
  int* IDX = (int*)(p.ws + OFF_IDX) + (size_t)e * ESLOTS;
  float* GW = (float*)(p.ws + OFF_GW) + (size_t)e * ESLOTS;
  const int tid = tid_(), lane = tid & 63, wid = tid >> 6;
  constexpr int MAXPER = (SEQ + NTHREADS - 1) / NTHREADS;
  const int per = (T + NTHREADS - 1) / NTHREADS;
  unsigned key[MAXPER];
  __syncthreads();
#pragma unroll
  for (int k = 0; k < MAXPER; ++k) {
    int i = tid * per + k;
    key[k] = (k < per && i < T) ? (__float_as_uint(AFF[i]) + 1u) : 0u;
  }
  unsigned thr = 0u;
  int round = 0;
  for (int bit = 30; bit >= 0; --bit) {
    const unsigned cand = thr | (1u << bit);
    int c = 0;
#pragma unroll
    for (int k = 0; k < MAXPER; ++k) c += (key[k] >= cand) ? 1 : 0;
    c = block_sum_(c, sred, round++);
    if (c >= cap) thr = cand;
  }
  int cg = 0, ce = 0;
#pragma unroll
  for (int k = 0; k < MAXPER; ++k) { cg += (key[k] > thr) ? 1 : 0; ce += (key[k] == thr) ? 1 : 0; }
  const int tot_gt = block_sum_(cg, sred, round++);
  const int need_eq = cap - tot_gt;
  int v = cg | (ce << 16), inc = v;
#pragma unroll
  for (int d = 1; d < 64; d <<= 1) { int o = shfl_up_(inc, d); if (lane >= d) inc += o; }
  int* soff = sred + 2 * NWAVES;
  __syncthreads();
  if (lane == 63) soff[wid] = inc;
  __syncthreads();
  int base = 0;
  for (int w = 0; w < wid; ++w) base += soff[w];
  int excl = base + inc - v;
  int gt_before = excl & 0xffff, eq_before = excl >> 16;
#pragma unroll
  for (int k = 0; k < MAXPER; ++k) {
    int i = tid * per + k;
    if (k < per && i < T) {
      const bool isgt = key[k] > thr, iseq = key[k] == thr;
      const bool sel = isgt || (iseq && eq_before < need_eq);
      const int slot = slot0 + gt_before + (eq_before < need_eq ? eq_before : need_eq);
      if (sel) { IDX[slot] = tok0 + i; GW[slot] = __uint_as_float(key[k] - 1u); SEL[(size_t)(tok0 + i) * 16 + e] = slot; }
      else SEL[(size_t)(tok0 + i) * 16 + e] = -1;
      gt_before += isgt ? 1 : 0; eq_before += iseq ? 1 : 0;
    }
  }
}
DI void moe1_tile(const Params& p, const LP& L, int t, char* smem) {
  const int nslots = L.last ? ESLOTS_L : ESLOTS;
  constexpr int MT_L = (ESLOTS_L + 255) / 256, MT_A = (ESLOTS + 255) / 256;
  const int nt = t & 7, sq = t >> 3;
  const int e = L.last ? sq / MT_L : sq / MT_A, mt = L.last ? sq % MT_L : sq % MT_A;
  const int m0 = mt * 256, n0 = nt * 256;
  GA g = make_ga((const bf16*)(p.ws + OFF_P1) + (size_t)NTOK * 1024, 1024, (const bf16*)(p.ws + OFF_MIX + WX_GU) + (size_t)e * 2048 * 1024, 1024, 1024, nslots);
  g.ridx = (const int*)(p.ws + OFF_IDX) + (size_t)e * ESLOTS;
  f32x4 acc[2][2][4][2];
  gemm_big(g, m0, n0, smem, acc);
  bf16* ACT = (bf16*)(p.ws + OFF_PG) + (size_t)e * ESLOTS * 1024;
  {
    const int l = tid_() & 63, w = tid_() >> 6, wr = w >> 2, wc = w & 3, fr = l & 15, fq = l >> 4;
#pragma unroll
    for (int ai = 0; ai < 2; ++ai)
#pragma unroll
      for (int m = 0; m < 4; ++m) {
        const int row = m0 + ai * 128 + wr * 64 + m * 16 + fr;
        float a[8];
#pragma unroll
        for (int k = 0; k < 4; ++k) { a[k] = siluf_(acc[ai][0][m][0][k]) * acc[ai][1][m][0][k]; a[4 + k] = siluf_(acc[ai][0][m][1][k]) * acc[ai][1][m][1][k]; }
        if (row < nslots) st8bf(ACT + (size_t)row * 1024 + nt * 128 + wc * 32 + 8 * fq, a);
      }
  }
}
DI void moe2_tile(const Params& p, const LP& L, int t, char* smem) {
  const int nslots = L.last ? ESLOTS_L : ESLOTS;
  constexpr int MT_L = (ESLOTS_L + 255) / 256, MT_A = (ESLOTS + 255) / 256;
  const int x = t & 7, nt = x & 3, sq = (t >> 3) * 2 + (x >> 2);
  const int e = L.last ? sq / MT_L : sq / MT_A, mt = L.last ? sq % MT_L : sq % MT_A;
  if (e >= NE) return;
  const int m0 = mt * 256, n0 = nt * 256;
  GA g = make_ga((const bf16*)(p.ws + OFF_PG) + (size_t)e * ESLOTS * 1024, 1024, (const bf16*)(p.ws + OFF_MIX + WX_DN) + (size_t)e * 1024 * 1024, 1024, 1024, nslots);
  f32x4 acc[2][2][4][2];
  gemm_big(g, m0, n0, smem, acc);
  bf16* YS = (bf16*)(p.ws + OFF_PG) + (size_t)NE * ESLOTS * 1024 + (size_t)e * ESLOTS * 1024;
  const float* GW = (const float*)(p.ws + OFF_GW) + (size_t)e * ESLOTS;
  EPIB_BEGIN(acc, m0, n0, nslots)
    const float gw = GW[row];
#pragma unroll
    for (int k = 0; k < 8; ++k) v[k] *= gw;
    st8bf(YS + (size_t)row * 1024 + col, v);
  EPIB_END
}
DI int uni_(int v) {
#ifdef EMU
  return v;
#else
  return __builtin_amdgcn_readfirstlane(v);
#endif
}
DI void comb_phase(const Params& p, const LP& L) {
  const int lane = tid_() & 63, gw = (int)blockIdx.x * NWAVES + (tid_() >> 6), TW = (int)gridDim.x * NWAVES;
  const int n = post_ntok(L.last);
  if (gw >= n) return;
  const bf16* YS = (const bf16*)(p.ws + OFF_PG) + (size_t)NE * ESLOTS * 1024;
  const float* gpf = p.in[I_GPOSTFFN] + L.l * 1024;
  int i = gw, tok = post_tok(i, L.last);
  uint4 sel[4]; float4 xr[4];
  {
    const uint4* sp = (const uint4*)((const int*)(p.ws + OFF_SEL) + (size_t)tok * 16);
    const float* X = (const float*)(p.ws + OFF_X) + (size_t)tok * 1024;
#pragma unroll
    for (int q = 0; q < 4; ++q) { sel[q] = sp[q]; xr[q] = *(const float4*)(X + lane * 4 + q * 256); }
  }
  for (;;) {
    const int inext = i + TW; const bool has = inext < n; const int tokn = has ? post_tok(inext, L.last) : tok;
    float s[16];
#pragma unroll
    for (int q = 0; q < 16; ++q) s[q] = 0.f;
#pragma unroll
    for (int e = 0; e < 16; ++e) {
      const unsigned sv = (e & 3) == 0 ? sel[e >> 2].x : (e & 3) == 1 ? sel[e >> 2].y : (e & 3) == 2 ? sel[e >> 2].z : sel[e >> 2].w;
      const int sl = uni_((int)sv);
      if (sl >= 0) {
        const bf16* yr = YS + ((size_t)e * ESLOTS + sl) * 1024;
#pragma unroll
        for (int q = 0; q < 4; ++q) {
          uint2 w = *(const uint2*)(yr + lane * 4 + q * 256);
          s[q * 4] += __uint_as_float(w.x << 16); s[q * 4 + 1] += __uint_as_float(w.x & 0xffff0000u);
          s[q * 4 + 2] += __uint_as_float(w.y << 16); s[q * 4 + 3] += __uint_as_float(w.y & 0xffff0000u);
        }
      }
    }
    uint4 seln[4]; float4 xn[4];
    {
      const uint4* sp = (const uint4*)((const int*)(p.ws + OFF_SEL) + (size_t)tokn * 16);
      const float* Xn = (const float*)(p.ws + OFF_X) + (size_t)tokn * 1024;
#pragma unroll
      for (int q = 0; q < 4; ++q) { seln[q] = sp[q]; xn[q] = *(const float4*)(Xn + lane * 4 + q * 256); }
    }
    float ss = 0.f;
#pragma unroll
    for (int q = 0; q < 16; ++q) ss += s[q] * s[q];
    ss = wave_sum(ss);
    const float rs = rsqrtf(ss * (1.f / 1024.f) + EPS);
    const float* mod = L.mod + (size_t)tok_modrow(tok) * 6144;
    float* dst = (float*)(p.ws + OFF_X) + (size_t)tok * 1024;
    if (L.last) { const int b = tok_b(tok), j = tok_j(tok); dst = p.out + ((size_t)b * SEQ + (j - CTXL)) * 1024; }
    float xv[16], h[16];
#pragma unroll
    for (int q = 0; q < 4; ++q) {
      const int c = lane * 4 + q * 256;
      float4 xo = xr[q], gv = *(const float4*)(gpf + c), gt = *(const float4*)(mod + 5120 + c);
      xo.x += gt.x * s[q * 4] * rs * gv.x; xo.y += gt.y * s[q * 4 + 1] * rs * gv.y; xo.z += gt.z * s[q * 4 + 2] * rs * gv.z; xo.w += gt.w * s[q * 4 + 3] * rs * gv.w;
      *(float4*)(dst + c) = xo;
      xv[q * 4] = xo.x; xv[q * 4 + 1] = xo.y; xv[q * 4 + 2] = xo.z; xv[q * 4 + 3] = xo.w;
    }
    if (!L.last) {
      const float* mod1 = (const float*)(p.ws + OFF_MOD) + ((size_t)(L.l + 1) * NB1 + tok_modrow(tok)) * 6144;
      normmod_row(xv, p.in[I_GPREMIX] + (L.l + 1) * 1024, mod1, mod1 + 1024, (bf16*)(p.ws + OFF_HA) + (size_t)tok * 1024, h);
    }
    if (!has) break;
    i = inext; tok = tokn;
#pragma unroll
    for (int q = 0; q < 4; ++q) { sel[q] = seln[q]; xr[q] = xn[q]; }
  }
}

enum { PH_PREP0 = 0, PH_PREP1, PH_L0 };
enum { LP_INPROJ = 0, LP_TOKPREP, LP_MIX1, LP_MIX2, LP_GLU, LP_MERGE, LP_OUT, LP_POST, LP_ROUTE, LP_MOE1, LP_MOE2, LP_COMB, LP_COUNT };
constexpr int NPHASES = PH_L0 + DEPTH * LP_COUNT;


DI void run_phase(const Params& p, int ph, char* smem) {
  const int G = gridDim.x;
  int start = blockIdx.x;
  auto seg = [&](int n, auto&& fn) {
    for (; start < n; start += G) fn(start);
    start -= n;
  };
#ifdef ONLY_PREP
  if (ph >= PH_L0) return;
#endif
  if (ph == PH_PREP0) {
    seg(DEPTH * 96, [&](int it) { mod_item(p, it, smem); });
    seg(DEPTH * 32, [&](int it) { s5_tab_item(p, it, smem); });
    seg(1, [&](int) { rope_tab_item(p); });
    seg(DEPTH * CT_EARLY, [&](int it) { conv_early_item(p, it / CT_EARLY, it % CT_EARLY, smem); });
    return;
  }
  if (ph == PH_PREP1) {
    seg(DEPTH * 256, [&](int it) { s5_mat_item(p, it); });
    seg(NTOK / NWAVES, [&](int it) { prep_row_item(p, it); });
    return;
  }
#ifdef ONLY_LPH
  if (ph < PH_L0) return;
#endif
  const int l = (ph - PH_L0) / LP_COUNT;
#ifdef ONLY_LPH
  const int lph = ONLY_LPH;
#else
  const int lph = (ph - PH_L0) % LP_COUNT;
#endif
  const LP L = make_lp(p, l);
  switch (lph) {
    case LP_INPROJ:
      seg(L.last ? IP_SLOTS_LAST : IP_SLOTS_ALL, [&](int it) { inproj_tile(p, L, it, smem); });
      break;
    case LP_TOKPREP:
      seg(16 * S5_MT * 2, [&](int it) { s5a_tile(p, L, it, smem); });
      seg(TP_MT * 3, [&](int it) { mlaq_tile(p, L, it, smem); });
      seg(TP_MT * 4, [&](int it) { mlakv_tile(p, L, it, smem); });
      seg(NTOK / 64, [&](int it) { navt_item(p, it, smem); });
      seg(M2C_ITEMS, [&](int it) { m2conv_item(p, L, it); });
      seg(M2S_ITEMS, [&](int it) { m2scal_item(p, L, it); });
      break;
    case LP_MIX1: {
      const int n0 = BATCH * 4, n1 = n0 + 2 * 16 * BATCH / NWAVES, n2 = n1 + BATCH * 4 * (SEQ / 256), n3 = n2 + BATCH * 4 * (SEQ / 256);
      const int n4 = n3 + (L.last ? 0 : BATCH * 4 * ((CTXL + 255) / 256)), n5 = n4 + (L.last ? 0 : BATCH * 4 * ((CTXL + 255) / 256));
      int* qhead = (int*)(p.ws + OFF_BAR) + Q_WORD0 + 64 * (l + 2 * p.probe_rep);
#ifdef EMU
      volatile int* bc = (volatile int*)(smem + SMEM_BYTES + 8);
#else
      volatile LAS int* bc = (volatile LAS int*)(smem + SMEM_BYTES + 8);
#endif
      for (;;) {
        __syncthreads();
        if (tid_() == 0) {
#ifdef EMU
          *bc = atomicAdd(qhead, 1);
#else
          *bc = __hip_atomic_fetch_add(qhead, 1, __ATOMIC_RELAXED, __HIP_MEMORY_SCOPE_AGENT);
#endif
        }
        __syncthreads();
        const int it = *bc;
        if (it >= n5) break;
        if (it < n0) m2scan_item(p, L, it, smem);
        else if (it < n1) s5carry_item(p, L, it - n0);
        else if (it < n2) mla_attn_item(p, it - n1, false, smem);
        else if (it < n3) na_attn_item(p, L, it - n2, false, smem);
        else if (it < n4) mla_attn_item(p, it - n3, true, smem);
        else na_attn_item(p, L, it - n4, true, smem);
      }
    } break;
    case LP_MIX2:
      seg(16 * S5_MT * 2, [&](int it) { s5c_tile(p, L, it, smem); });
      seg(NTOK / NWAVES, [&](int it) { m2gate_item(p, L, it); });
      break;
    case LP_GLU:
      seg(GLU_MT * 2, [&](int it) { glu_tile(p, L, it, smem); });
      break;
    case LP_MERGE:
      seg(mtiles(L.last, 256) * 8, [&](int it) { merge_tile(p, L, it, smem); });
      break;
    case LP_OUT:
      seg(mtiles(L.last, 256) * 4, [&](int it) { outproj_tile(p, L, it, smem); });
      break;
    case LP_POST:
      seg(CT_EXP, [&](int it) { conv_expert_item(p, l, it, smem); });
      post_stage_router(p, L, smem);
      post_phase(p, L, smem);
      break;
    case LP_ROUTE:
      seg(BATCH * 16 * (L.last ? 1 : 2), [&](int it) { route_item(p, L, it, smem); });
      break;
    case LP_MOE1:
      seg(NE * (((L.last ? ESLOTS_L : ESLOTS) + 255) / 256) * 8, [&](int it) { moe1_tile(p, L, it, smem); });
      break;
    case LP_MOE2:
      seg(((NE * (((L.last ? ESLOTS_L : ESLOTS) + 255) / 256) + 1) / 2) * 8, [&](int it) { moe2_tile(p, L, it, smem); });
      break;
    case LP_COMB:
      comb_phase(p, L);
      break;
  }
}

__global__ void __launch_bounds__(NTHREADS, 2) mega_kernel(Params p) {
#ifdef EMU
  char* smem = emu_cur_f->blk->smem;
  for (int ph = p.phase_lo; ph < p.phase_hi; ++ph) {
    run_phase(p, ph, smem);
    if (ph + 1 < p.phase_hi) emu_grid_sync();
  }
#else
  __shared__ __attribute__((aligned(16))) char smem[SMEM_BYTES + 16 + 256];
  {
    const unsigned hw = (unsigned)__builtin_amdgcn_s_getreg((5 << 11) | 4) & 0x3fu;
    if ((threadIdx.x & 63) == 0) *(volatile int*)(smem + WAVE_TAB_OFF + hw * 4u) = (int)(threadIdx.x >> 6);
    __syncthreads();
  }
  if (p.phase_hi - p.phase_lo > 1) {
    if (threadIdx.x == 0) *(uint4*)(smem + SMEM_BYTES) = make_uint4(0u, 0u, 0u, 0u);
    __syncthreads();
    XcdBarrier xb = xcd_barrier_post((unsigned*)(p.ws + OFF_BAR), (volatile LAS unsigned*)(smem + SMEM_BYTES));
    for (int ph = p.phase_lo; ph < p.phase_hi; ++ph) {
      int reps = 1;
#ifdef PROBE_PHASE
      if (ph == PROBE_PHASE || ph == PROBE_PHASE2) reps = 1 + PROBE_REP;
#endif
      for (int rep = 0; rep < reps; ++rep) {
        p.probe_rep = rep;
        run_phase(p, ph, smem);
        if (ph + 1 < p.phase_hi || rep + 1 < reps) {
          if (ph == p.phase_lo && rep == 0) cg::this_grid().sync();
          else xcd_barrier(xb);
        }
      }
    }
  } else {
    run_phase(p, p.phase_lo, smem);
  }
#endif
}

#ifndef EMU
extern "C" void kernel_launch(void* const* d_in, const int* in_sizes, int n_in, void* d_out, int out_size, void* d_ws, size_t ws_size,
                              hipStream_t stream) {
  static int grid_blocks = 0;
  if (!grid_blocks) {
    int dev = 0, cus = 0, per_cu = 0;
    hipGetDevice(&dev);
    hipDeviceGetAttribute(&cus, hipDeviceAttributeMultiprocessorCount, dev);
    hipOccupancyMaxActiveBlocksPerMultiprocessor(&per_cu, mega_kernel, NTHREADS, 0);
    if (per_cu > 1) per_cu = 1;
    if (per_cu < 1) per_cu = 1;
    grid_blocks = cus * per_cu;
    if (ws_size < WS_TOTAL) fprintf(stderr, "workspace too small: %zu < %zu\n", ws_size, (size_t)WS_TOTAL);
  }
  Params p{};
  for (int i = 0; i < N_INPUTS; ++i) p.in[i] = (const float*)d_in[i];
  p.out = (float*)d_out;
  p.ws = (char*)d_ws;
#if MK_MULTI
  for (int ph = 0; ph < NPHASES; ++ph) {
    p.phase_lo = ph; p.phase_hi = ph + 1;
    hipLaunchKernelGGL(mega_kernel, dim3(grid_blocks), dim3(NTHREADS), 0, stream, p);
  }
#else
  p.phase_lo = 0; p.phase_hi = NPHASES;
  hipMemsetAsync((char*)d_ws + OFF_BAR, 0, BAR_BYTES, stream);
  void* args[] = {&p};
  hipError_t e = hipLaunchCooperativeKernel((void*)mega_kernel, dim3(grid_blocks), dim3(NTHREADS), args, 0, stream);
  if (e != hipSuccess) fprintf(stderr, "cooperative launch failed: %s (grid %d)\n", hipGetErrorString(e), grid_blocks);
#endif
}
#endif
```

```cpp
#ifdef EMU
#include "emu.h"
#else
#include <hip/hip_runtime.h>
#include <hip/hip_cooperative_groups.h>
#include <cstdio>
namespace cg = cooperative_groups;
using bf16x8 = __attribute__((ext_vector_type(8))) short;
using f32x4 = __attribute__((ext_vector_type(4))) float;
using f32x16 = __attribute__((ext_vector_type(16))) float;
#endif
using u32x4 = __attribute__((ext_vector_type(4))) unsigned;
#ifndef MK_MULTI
#define MK_MULTI 0
#endif

#define DI __device__ __forceinline__
typedef unsigned short bf16;

#ifdef EMU_SMALL2
constexpr int BATCH = 2, SEQ = 1024, CTXL = 64, GRID_W = 32;
#elif defined(EMU_SMALL)
constexpr int BATCH = 2, SEQ = 512, CTXL = 64, GRID_W = 32;
#else
constexpr int BATCH = 8, SEQ = 2048, CTXL = 256, GRID_W = 64;
#endif
constexpr int D = 1024, DEPTH = 2;
constexpr int TOK = CTXL + SEQ, NTOK = BATCH * TOK;
constexpr int ROWS = SEQ / GRID_W;
constexpr int WIN_R = (ROWS < 8 ? ROWS : 8), WIN_C = 16;
constexpr int N_IN = 6568, N_INP = 6656;
constexpr int C_CQ = 0, C_CKV = 256, C_KR = 384, C_NA = 416, C_S5 = 1184, C_Z = 1440, C_XBC = 1696, C_DT = 2464, C_GATE = 2472;
constexpr int P1W = 2480;
constexpr int NCH = TOK / 16, NCC = CTXL / 16, MCH = BATCH * NCH;
constexpr int NE = 16;
constexpr int CAP_L = 2 * SEQ / NE, CAP_C = 2 * CTXL / NE;
constexpr int ESLOTS = BATCH * (CAP_L + CAP_C), ESLOTS_L = BATCH * CAP_L;
constexpr int NB1 = BATCH + 1;
constexpr float EPS = 1e-6f;
constexpr int SMEM_BYTES = 147456;
constexpr int NTHREADS = 512, NWAVES = NTHREADS / 64;

enum { I_X = 0, I_C, I_CTX, I_CCTX, I_WADA, I_BADA, I_GPREMIX, I_GPOSTMIX, I_GPREFFN, I_GPOSTFFN, I_WIN, I_GCQ, I_GCKV, I_WUQ, I_WUKV, I_RPB,
       I_S5ARE, I_S5AIM, I_S5LOGSTEP, I_S5BRE, I_S5BIM, I_S5CRE, I_S5CIM, I_S5D, I_S5WGLU, I_S5BGLU, I_M2CONVW, I_M2CONVB, I_M2ALOG, I_M2DTBIAS,
       I_M2D, I_M2GNORM, I_WBRANCH, I_WOUT, I_WROUTER, I_WGATE, I_WUP, I_WDOWN, N_INPUTS };

constexpr size_t al256(size_t x) { return (x + 255) & ~(size_t)255; }
constexpr size_t SZ_X = (size_t)NTOK * D * 4;
constexpr size_t SZ_ROWBF = (size_t)NTOK * D * 2;
constexpr size_t OFF_X = 0;
constexpr size_t OFF_MOD = OFF_X + al256(SZ_X);
constexpr size_t OFF_HA = OFF_MOD + al256((size_t)DEPTH * NB1 * 6144 * 4);
constexpr size_t OFF_O = OFF_HA + al256(SZ_ROWBF);
constexpr size_t OFF_P1 = OFF_O + al256(SZ_ROWBF);
constexpr size_t SZ_P1 = (size_t)NTOK * P1W * 2;
constexpr size_t OFF_PG = OFF_P1 + al256(SZ_P1);
constexpr size_t SZ_PG = (size_t)NTOK * 4096 * 2;
constexpr size_t OFF_DT = OFF_PG + al256(SZ_PG);
constexpr size_t OFF_AFF = OFF_DT + al256((size_t)NTOK * 8 * 4);
constexpr size_t OFF_SEL = OFF_AFF + al256((size_t)NTOK * 16 * 4);
constexpr size_t OFF_IDX = OFF_SEL + al256((size_t)NTOK * 16 * 4);
constexpr size_t OFF_GW = OFF_IDX + al256((size_t)NE * ESLOTS * 4);
constexpr size_t OFF_BAR = OFF_GW + al256((size_t)NE * ESLOTS * 4);
constexpr size_t BAR_BYTES = (3456 + 64 * 4) * 4;
constexpr int Q_WORD0 = 3456;
constexpr size_t OFF_ROPE = OFF_BAR + al256(BAR_BYTES);
constexpr size_t OFF_WEARLY = OFF_ROPE + al256(64 * 8 * 2 * 4);
constexpr size_t WE_WIN = 0;
constexpr size_t WE_UQ = WE_WIN + (size_t)N_INP * 1024 * 2;
constexpr size_t WE_UKV = WE_UQ + (size_t)384 * 256 * 2;
constexpr size_t WE_GLU = WE_UKV + (size_t)512 * 128 * 2;
constexpr size_t WE_WB = WE_GLU + (size_t)256 * 256 * 2;
constexpr size_t WE_WOUT = WE_WB + (size_t)4 * 1024 * 256 * 2;
constexpr size_t WE_SIZE = al256(WE_WOUT + (size_t)1024 * 1024 * 2);
constexpr size_t OFF_S5TAB = OFF_WEARLY + DEPTH * WE_SIZE;
constexpr size_t S5_LAMPOW = 0;
constexpr size_t S5_BBAR = S5_LAMPOW + (size_t)2 * 16 * 17 * 64 * 2 * 4;
constexpr size_t S5_KT = S5_BBAR + (size_t)2 * 16 * 64 * 16 * 2 * 4;
constexpr size_t S5_WA = S5_KT + (size_t)2 * 16 * 16 * 256 * 4;
constexpr size_t S5_W2 = S5_WA + (size_t)16 * 256 * 256 * 2;
constexpr size_t S5_SIZE = al256(S5_W2 + (size_t)16 * 256 * 512 * 2);
constexpr size_t OFF_MIX = OFF_S5TAB + DEPTH * S5_SIZE;
constexpr size_t MX_Q = 0;
constexpr size_t MX_K = MX_Q + al256((size_t)BATCH * 4 * TOK * 96 * 2);
constexpr size_t MX_VTM = MX_K + al256((size_t)BATCH * 4 * TOK * 96 * 2);
constexpr size_t MX_VTN = MX_VTM + al256((size_t)BATCH * 4 * 64 * TOK * 2);
constexpr size_t MX_XBC = MX_VTN + al256((size_t)BATCH * 4 * 64 * TOK * 2);
constexpr size_t MX_US5 = MX_XBC + al256((size_t)NTOK * 768 * 2);
constexpr size_t MX_HEND = MX_US5 + al256((size_t)NTOK * 256 * 2);
constexpr size_t MX_HIN = MX_HEND + al256((size_t)16 * MCH * 256 * 4);
constexpr size_t MX_Z = MX_HIN + al256((size_t)16 * MCH * 256 * 2);
constexpr size_t MX_XBT = MX_Z + al256((size_t)NTOK * 256 * 2);
constexpr size_t MX_M2S = MX_XBT + al256((size_t)NTOK * 512 * 2);
constexpr size_t MX_SIZE = MX_M2S + al256((size_t)BATCH * 8 * TOK * 4 * 4);
constexpr size_t WX_GU = 0;
constexpr size_t WX_DN = WX_GU + (size_t)NE * 2048 * 1024 * 2;
constexpr size_t WX_SIZE = WX_DN + (size_t)NE * 1024 * 1024 * 2;
constexpr size_t MIXREG = (MX_SIZE > WX_SIZE ? MX_SIZE : WX_SIZE);
constexpr size_t WS_TOTAL = OFF_MIX + al256(MIXREG);

struct Params {
  const float* in[N_INPUTS];
  float* out;
  char* ws;
  int phase_lo, phase_hi;
  int probe_rep, pad_;
};

constexpr int WAVE_TAB_OFF = SMEM_BYTES + 16;
DI int tid_() {
#ifdef EMU
  return (int)threadIdx.x;
#else
  const unsigned hw = (unsigned)__builtin_amdgcn_s_getreg((5 << 11) | 4) & 0x3fu;
  const int wave = *(volatile __attribute__((address_space(3))) int*)(unsigned long)(WAVE_TAB_OFF + hw * 4u);
  int lane;
  asm volatile("v_mbcnt_lo_u32_b32 %0, -1, 0\n\tv_mbcnt_hi_u32_b32 %0, -1, %0" : "=v"(lane));
  return wave * 64 + lane;
#endif
}
#ifdef EMU
template <class T> DI T shfl_xor_(T v, int m) { return __shfl_xor(v, m); }
template <class T> DI T shfl_up_(T v, int d) { return __shfl_up(v, d); }
template <class T> DI T shfl_(T v, int src) { return __shfl(v, src); }
#else
template <class T> DI T shfl_xor_(T v, int m) {
  const int idx = ((tid_() & 63) ^ m) << 2;
  return __builtin_bit_cast(T, __builtin_amdgcn_ds_bpermute(idx, __builtin_bit_cast(int, v)));
}
template <class T> DI T shfl_up_(T v, int d) {
  const int l = tid_() & 63; const int idx = (l >= d ? l - d : l) << 2;
  return __builtin_bit_cast(T, __builtin_amdgcn_ds_bpermute(idx, __builtin_bit_cast(int, v)));
}
template <class T> DI T shfl_(T v, int src) {
  int idx = src << 2; asm volatile("" : "+v"(idx));
  return __builtin_bit_cast(T, __builtin_amdgcn_ds_bpermute(idx, __builtin_bit_cast(int, v)));
}
#endif
DI float bf2f(bf16 h) { return __uint_as_float(((unsigned)h) << 16); }
#ifdef EMU
DI bf16 f2bf(float f) { unsigned u = __float_as_uint(f); u += 0x7fffu + ((u >> 16) & 1u); return (bf16)(u >> 16); }
DI unsigned pack2(float a, float b) { return (unsigned)f2bf(a) | ((unsigned)f2bf(b) << 16); }
DI float exp2f_(float x) { return exp2f(x); }
#else
typedef float f32x2_t_ __attribute__((ext_vector_type(2)));
typedef __bf16 bf16x2_t_ __attribute__((ext_vector_type(2)));
DI unsigned pack2(float a, float b) { const f32x2_t_ v = {a, b}; return __builtin_bit_cast(unsigned, __builtin_convertvector(v, bf16x2_t_)); }
DI bf16 f2bf(float f) { return (bf16)(pack2(f, 0.f) & 0xffffu); }
DI float exp2f_(float x) { return __builtin_amdgcn_exp2f(x); }
#endif
#ifdef EMU
DI float rcp_(float x) { return 1.0f / x; }
#else
DI float rcp_(float x) { return __builtin_amdgcn_rcpf(x); }
#endif
DI float sigmoidf_(float x) { return rcp_(1.0f + exp2f_(-1.4426950408889634f * x)); }
DI float siluf_(float x) { return x * rcp_(1.0f + exp2f_(-1.4426950408889634f * x)); }
DI float softplusf_(float x) { const float ax = x < 0.f ? -x : x; return (x > 0.f ? x : 0.f) + __logf(1.0f + __expf(-ax)); }
DI float geluf_(float x) { const float u2 = 1.5957691216057308f * (x + 0.044715f * x * x * x); return x * rcp_(1.0f + exp2f_(-1.4426950408889634f * u2)); }
DI bool wave_all_(bool c) {
#ifdef EMU
  int v = c ? 0 : 1;
  v += shfl_xor_(v, 32); v += shfl_xor_(v, 16); v += shfl_xor_(v, 8); v += shfl_xor_(v, 4); v += shfl_xor_(v, 2); v += shfl_xor_(v, 1);
  return v == 0;
#else
  return __builtin_amdgcn_ballot_w64(!c) == 0ull;
#endif
}
DI float wave_sum(float v) {
#ifdef EMU
  v += shfl_xor_(v, 32); v += shfl_xor_(v, 16); v += shfl_xor_(v, 8); v += shfl_xor_(v, 4); v += shfl_xor_(v, 2); v += shfl_xor_(v, 1);
  return v;
#else
  int x = __float_as_int(v);
  x = __float_as_int(__int_as_float(x) + __int_as_float(__builtin_amdgcn_update_dpp(0, x, 0xB1, 0xF, 0xF, true)));
  x = __float_as_int(__int_as_float(x) + __int_as_float(__builtin_amdgcn_update_dpp(0, x, 0x4E, 0xF, 0xF, true)));
  x = __float_as_int(__int_as_float(x) + __int_as_float(__builtin_amdgcn_update_dpp(0, x, 0x141, 0xF, 0xF, true)));
  x = __float_as_int(__int_as_float(x) + __int_as_float(__builtin_amdgcn_update_dpp(0, x, 0x140, 0xF, 0xF, true)));
  const float r0 = __int_as_float(__builtin_amdgcn_readlane(x, 0)), r1 = __int_as_float(__builtin_amdgcn_readlane(x, 16));
  const float r2 = __int_as_float(__builtin_amdgcn_readlane(x, 32)), r3 = __int_as_float(__builtin_amdgcn_readlane(x, 48));
  return (r0 + r1) + (r2 + r3);
#endif
}
#ifndef EMU
#define XB_TMO      128
#define XB_XCNT(j)  (256  + 64 * (j))
#define XB_XSUB(j)  (1280 + 64 * (j))
#define XB_XGEN(j)  (2304 + 64 * (j))
#define XB_TOP      3328
#define XB_TOPGEN   3392
#define XB_SPIN_CAP (1u << 24)
#define LAS __attribute__((address_space(3)))
DI unsigned xb_ld(unsigned* p) { return __hip_atomic_load(p, __ATOMIC_RELAXED, __HIP_MEMORY_SCOPE_AGENT); }
DI unsigned xb_add(unsigned* p, unsigned v) { return __hip_atomic_fetch_add(p, v, __ATOMIC_RELAXED, __HIP_MEMORY_SCOPE_AGENT); }
DI unsigned xb_xcc_id() { return (unsigned)__builtin_amdgcn_s_getreg((3 << 11) | 20) & 0xFu; }
#define XB_SPIN(cond, bar) do { unsigned _sp = 0; while (cond) { __builtin_amdgcn_s_sleep(1); \
    if ((++_sp & 255u) == 0u) { if (xb_ld(&(bar)[XB_TMO])) break; if (_sp > XB_SPIN_CAP) { atomicAdd(&(bar)[XB_TMO], 1u); break; } } } } while (0)
struct XcdBarrier { unsigned* bar; unsigned x; volatile LAS unsigned* st; };
DI XcdBarrier xcd_barrier_post(unsigned* bar, volatile LAS unsigned* st) {
  XcdBarrier b; b.bar = bar; b.x = xb_xcc_id(); b.st = st;
  if (threadIdx.x == 0) (void)xb_add(&bar[XB_XCNT(b.x)], 1u);
  return b;
}
DI void xcd_barrier_complete(unsigned* bar, unsigned x, unsigned& nloc, unsigned& nx) {
  const unsigned G = gridDim.x * gridDim.y * gridDim.z;
  unsigned sum, cnt, mine, sp = 0u;
  for (;;) {
    sum = 0u; cnt = 0u; mine = 0u;
#pragma unroll
    for (unsigned j = 0; j < 16; ++j) { const unsigned c = xb_ld(&bar[XB_XCNT(j)]); sum += c; cnt += (c > 0u) ? 1u : 0u; mine = (j == x) ? c : mine; }
    if (sum == G) break;
    __builtin_amdgcn_s_sleep(1);
    if ((++sp & 255u) == 0u) { if (xb_ld(&bar[XB_TMO])) break; if (sp > XB_SPIN_CAP) { atomicAdd(&bar[XB_TMO], 1u); break; } }
  }
  nloc = mine > 0u ? mine : 1u; nx = cnt > 0u ? cnt : 1u;
}
DI void xcd_barrier(const XcdBarrier& b) {
  asm volatile("s_waitcnt vmcnt(0)" ::: "memory");
  __syncthreads();
  if (threadIdx.x == 0) {
    unsigned* bar = b.bar;
    __builtin_amdgcn_s_waitcnt(0);
    unsigned nloc = b.st[0], nx = b.st[1];
    if (nloc == 0u) { xcd_barrier_complete(bar, b.x, nloc, nx); b.st[0] = nloc; b.st[1] = nx; }
    const unsigned old = xb_add(&bar[XB_XSUB(b.x)], 1u);
    const unsigned gen = old / nloc;
    if (old + 1u == (gen + 1u) * nloc) {
      __builtin_amdgcn_fence(__ATOMIC_RELEASE, "agent");
      asm volatile("s_waitcnt vmcnt(0)" ::: "memory");
      const unsigned og = xb_add(&bar[XB_TOP], 1u);
      const unsigned tg = og / nx;
      if (og + 1u == (tg + 1u) * nx) xb_add(&bar[XB_TOPGEN], 1u);
      else XB_SPIN(xb_ld(&bar[XB_TOPGEN]) == tg, bar);
      __builtin_amdgcn_fence(__ATOMIC_ACQUIRE, "agent");
      xb_add(&bar[XB_XGEN(b.x)], 1u);
      asm volatile("s_waitcnt vmcnt(0)" ::: "memory");
    } else {
      XB_SPIN(xb_ld(&bar[XB_XGEN(b.x)]) == gen, bar);
      __builtin_amdgcn_fence(__ATOMIC_ACQUIRE, "agent");
      asm volatile("s_waitcnt vmcnt(0)" ::: "memory");
    }
  }
  __syncthreads();
}
#endif

struct GA {
  const bf16* A; const bf16* A2; int lda, lda2, ksplit;
  const int* ridx; int mvalid;
  const bf16* Bt; int ldb; int K;
  int kfix;
};
DI GA make_ga(const bf16* A, int lda, const bf16* Bt, int ldb, int K, int mvalid) {
  GA g; g.A = A; g.A2 = A; g.lda = lda; g.lda2 = lda; g.ksplit = K; g.ridx = nullptr; g.mvalid = mvalid; g.Bt = Bt; g.ldb = ldb; g.K = K; g.kfix = 0; return g;
}

#ifdef EMU
#define GLDS16(gptr_, lptr_) memcpy((void*)(lptr_), (const void*)(gptr_), 16)
#define BGLDS16(rsrc_, base_, voff_, soff_, lptr_) memcpy((void*)(lptr_), (const char*)(base_) + (voff_) + (soff_), 16)
#define GEMM_WAIT(N_)
#define RAW_BARRIER() __syncthreads()
#else
#define LASV __attribute__((address_space(3))) void
#define GLDS16(gptr_, lptr_) __builtin_amdgcn_global_load_lds((const void*)(gptr_), (LASV*)(lptr_), 16, 0, 0)
#define BGLDS16(rsrc_, base_, voff_, soff_, lptr_) __builtin_amdgcn_raw_ptr_buffer_load_lds(rsrc_, (LASV*)(lptr_), 16, (int)(voff_), (int)(soff_), 0, 0)
#define GEMM_WAIT(N_) asm volatile("s_waitcnt vmcnt(%0)" :: "n"(N_) : "memory")
#define RAW_BARRIER() { asm volatile("" ::: "memory"); __builtin_amdgcn_s_barrier(); asm volatile("" ::: "memory"); }
#endif
DI int perm32(int rho) { const int n = rho >> 4, i = rho & 15; return 8 * (i >> 2) + 4 * n + (i & 3); }
constexpr int SRS_OFF = 73728;
template <int NT>
DI void gemm_s(const GA& g, int m0, int n0, char* smem, f32x4 (&acc)[4][NT]) {
  constexpr int A_ELEMS = 256 * 32, B_ELEMS = 32 * NT * 32, STAGE = A_ELEMS + B_ELEMS;
  bf16* st = (bf16*)smem;
  const int tid = tid_(), lane = tid & 63, wid = tid >> 6, wr = wid >> 1, wc = wid & 1, fr = lane & 15, fq = lane >> 4;
  const int lrow = tid >> 2, pch = tid & 3;
  long aoff[2], aoff2[2], boff;
#pragma unroll
  for (int i = 0; i < 2; ++i) {
    const int row = lrow + 128 * i;
    const int lch = pch ^ ((-(row >> 2)) & 3);
    int gm = m0 + row; if (gm > g.mvalid - 1) gm = g.mvalid - 1;
    const int ar = g.ridx ? g.ridx[gm] : gm;
    aoff[i] = (long)ar * g.lda + lch * 8;
    aoff2[i] = (long)ar * g.lda2 + lch * 8;
  }
  const int cb = (NT == 4) ? tid : (tid & 255);
  {
    const int row = cb >> 2;
    const int lch = pch ^ ((-(row >> 2)) & 3);
    const int src = n0 + (row & ~31) + perm32(row & 31);
    boff = (long)src * g.ldb + lch * 8;
  }
#pragma unroll
  for (int m = 0; m < 4; ++m)
#pragma unroll
    for (int n = 0; n < NT; ++n) acc[m][n] = f32x4{0.f, 0.f, 0.f, 0.f};
  const int T = g.K / 32;
#define GEMM_DMA(t_, stg_) { const int k0_ = (t_) * 32; const bool seg2_ = (k0_ >= g.ksplit); bf16* sa_ = st + (stg_) * STAGE; \
    _Pragma("unroll") for (int i_ = 0; i_ < 2; ++i_) { \
      const bf16* ap_ = seg2_ ? (g.A2 + aoff2[i_] + (k0_ - g.ksplit)) : (g.A + aoff[i_] + k0_); \
      GLDS16(ap_, sa_ + (tid + i_ * 512) * 8); } \
    GLDS16(g.Bt + boff + k0_, sa_ + A_ELEMS + cb * 8); }
  __syncthreads();
  GEMM_DMA(0, 0)
  if (T > 1) GEMM_DMA(1, 1)
  int s_cur = 0, s_nxt = 2;
#pragma unroll 1
  for (int t = 0; t < T; ++t) {
    if (t + 1 < T) { GEMM_WAIT(3); } else { GEMM_WAIT(0); }
    RAW_BARRIER();
    if (t + 2 < T) GEMM_DMA(t + 2, s_nxt)
    const bf16* sa = st + s_cur * STAGE;
    const bf16* sb = sa + A_ELEMS;
    bf16x8 af[4], bfr[NT];
#pragma unroll
    for (int n = 0; n < NT; ++n) {
      const int row = wc * (16 * NT) + n * 16 + fr;
      bfr[n] = *(const bf16x8*)(sb + row * 32 + ((fq ^ ((-(row >> 2)) & 3)) << 3));
    }
#pragma unroll
    for (int m = 0; m < 4; ++m) {
      const int row = wr * 64 + m * 16 + fr;
      af[m] = *(const bf16x8*)(sa + row * 32 + ((fq ^ ((-(row >> 2)) & 3)) << 3));
    }
#pragma unroll
    for (int m = 0; m < 4; ++m)
#pragma unroll
      for (int n = 0; n < NT; ++n) acc[m][n] = __builtin_amdgcn_mfma_f32_16x16x32_bf16(bfr[n], af[m], acc[m][n], 0, 0, 0);
    s_cur = (s_cur == 2) ? 0 : s_cur + 1;
    s_nxt = (s_nxt == 2) ? 0 : s_nxt + 1;
  }
}
constexpr int BG_HT = 128 * 64;
DI int lds_byte(int r, int c) { const int stt = (r >> 4) * 2 + (c >> 5), rr = r & 15, cc = c & 31, ob = rr * 64 + cc * 2; return stt * 1024 + (ob ^ (((ob >> 9) & 1) << 5)); }
DI void stage_rc(int b, int& R, int& C) { const int stt = b / 1024, sb = b % 1024, swz = sb ^ (((sb >> 9) & 1) << 5); R = (stt >> 1) * 16 + swz / 64; C = (stt & 1) * 32 + (swz % 64) / 2; }
#ifdef EMU
#define BG_WAIT_V(n)
#define BG_WAIT_L(n)
#define BG_BAR __syncthreads()
#define BG_SCHED
#define BG_PRIO(x)
#else
#define BG_WAIT_V(n) asm volatile("s_waitcnt vmcnt(" #n ")" ::: "memory")
#define BG_WAIT_L(n) asm volatile("s_waitcnt lgkmcnt(" #n ")" ::: "memory")
#define BG_BAR __builtin_amdgcn_s_barrier()
#define BG_SCHED __builtin_amdgcn_sched_barrier(0)
#define BG_PRIO(x) __builtin_amdgcn_s_setprio(x)
#endif
DI void gemm_big(const GA& g, int m0, int n0, char* smem, f32x4 (&acc)[2][2][4][2]) {
  bf16* shm = (bf16*)smem;
  const int tid = tid_(), wid = tid >> 6, lane = tid & 63, wr = wid >> 2, wc = wid & 3, fr = lane & 15, fq = lane >> 4;
  unsigned aof[2][2], bof[2];
#ifdef EMU
  const int dma_lds = tid * 16;
#else
  const int dma_lds = __builtin_amdgcn_readfirstlane(tid >> 6) * 1024;
#endif
#ifndef EMU
  const __amdgpu_buffer_rsrc_t rsA = __builtin_amdgcn_make_buffer_rsrc((void*)g.A, 0, 0x7fffffff, 0x00020000);
  const __amdgpu_buffer_rsrc_t rsB = __builtin_amdgcn_make_buffer_rsrc((void*)g.Bt, 0, 0x7fffffff, 0x00020000);
#endif
#pragma unroll
  for (int i = 0; i < 2; ++i) {
    int R, C; stage_rc(tid * 16 + i * 8192, R, C);
    bof[i] = (unsigned)((n0 + (R & ~31) + perm32(R & 31)) * g.ldb + C) * 2u;
#pragma unroll
    for (int h = 0; h < 2; ++h) {
      int gm = m0 + h * 128 + R; if (gm > g.mvalid - 1) gm = g.mvalid - 1;
      const int ar = g.ridx ? g.ridx[gm] : gm;
      aof[h][i] = (unsigned)(ar * g.lda + C) * 2u;
    }
  }
#define BG_SA(b, h) (shm + ((b) * 2 + (h)) * BG_HT)
#define BG_SB(b, h) (shm + (4 + (b) * 2 + (h)) * BG_HT)
#define BG_STAGE_A(P, h, kt) { \
    _Pragma("unroll") for (int i_ = 0; i_ < 2; ++i_) BGLDS16(rsA, g.A, aof[h][i_], (kt) * 128, (char*)(P) + dma_lds + i_ * 8192); }
#define BG_STAGE_B(P, h, kt) { \
    _Pragma("unroll") for (int i_ = 0; i_ < 2; ++i_) BGLDS16(rsB, g.Bt, bof[i_], (kt) * 128 + (h) * 256 * g.ldb, (char*)(P) + dma_lds + i_ * 8192); }
#define BG_LDA(dst, b, h) _Pragma("unroll") for (int m_ = 0; m_ < 4; ++m_) _Pragma("unroll") for (int k_ = 0; k_ < 2; ++k_) \
    dst[m_][k_] = *(const bf16x8*)((const char*)BG_SA(b, h) + lds_byte(wr * 64 + m_ * 16 + fr, k_ * 32 + fq * 8))
#define BG_LDB(dst, b, h) _Pragma("unroll") for (int n_ = 0; n_ < 2; ++n_) _Pragma("unroll") for (int k_ = 0; k_ < 2; ++k_) \
    dst[n_][k_] = *(const bf16x8*)((const char*)BG_SB(b, h) + lds_byte(wc * 32 + n_ * 16 + fr, k_ * 32 + fq * 8))
#define BG_MMA(ai, bj, At_, Bt_) { BG_PRIO(1); \
    _Pragma("unroll") for (int m_ = 0; m_ < 4; ++m_) _Pragma("unroll") for (int n_ = 0; n_ < 2; ++n_) _Pragma("unroll") for (int k_ = 0; k_ < 2; ++k_) \
      acc[ai][bj][m_][n_] = __builtin_amdgcn_mfma_f32_16x16x32_bf16(Bt_[n_][k_], At_[m_][k_], acc[ai][bj][m_][n_], 0, 0, 0); \
    BG_PRIO(0); }
#pragma unroll
  for (int a_ = 0; a_ < 2; ++a_)
#pragma unroll
    for (int b_ = 0; b_ < 2; ++b_)
#pragma unroll
      for (int m_ = 0; m_ < 4; ++m_)
#pragma unroll
        for (int n_ = 0; n_ < 2; ++n_) acc[a_][b_][m_][n_] = f32x4{0.f, 0.f, 0.f, 0.f};
  bf16x8 At[4][2], B0[2][2], B1[2][2];
  const int nt = g.K / 64;
  __syncthreads();
  BG_STAGE_B(BG_SB(0, 0), 0, 0) BG_STAGE_A(BG_SA(0, 0), 0, 0)
  BG_STAGE_B(BG_SB(0, 1), 1, 0) BG_STAGE_A(BG_SA(0, 1), 1, 0)
  if (wr == 1) BG_BAR;
  BG_WAIT_V(4); BG_BAR;
  BG_STAGE_B(BG_SB(1, 0), 0, 1) BG_STAGE_A(BG_SA(1, 0), 0, 1) BG_STAGE_B(BG_SB(1, 1), 1, 1)
  BG_WAIT_V(6); BG_BAR;
#pragma unroll 1
  for (int t = 0; t < nt - 2; t += 2) {
    BG_LDB(B0, 0, 0); BG_SCHED; BG_LDA(At, 0, 0); BG_STAGE_A(BG_SA(1, 1), 1, t + 1)
    BG_WAIT_L(8); BG_BAR; BG_WAIT_L(0); BG_MMA(0, 0, At, B0) BG_BAR; BG_SCHED;
    BG_LDB(B1, 0, 1); BG_STAGE_B(BG_SB(0, 0), 0, t + 2)
    BG_BAR; BG_WAIT_L(0); BG_MMA(0, 1, At, B1) BG_BAR;
    BG_LDA(At, 0, 1); BG_STAGE_A(BG_SA(0, 0), 0, t + 2)
    BG_BAR; BG_WAIT_L(0); BG_MMA(1, 0, At, B0) BG_BAR; BG_SCHED;
    BG_STAGE_B(BG_SB(0, 1), 1, t + 2)
    BG_WAIT_V(6); BG_BAR; BG_MMA(1, 1, At, B1) BG_BAR;
    BG_LDB(B0, 1, 0); BG_SCHED; BG_LDA(At, 1, 0); BG_STAGE_A(BG_SA(0, 1), 1, t + 2)
    BG_WAIT_L(8); BG_BAR; BG_WAIT_L(0); BG_MMA(0, 0, At, B0) BG_BAR; BG_SCHED;
    BG_LDB(B1, 1, 1); BG_STAGE_B(BG_SB(1, 0), 0, t + 3)
    BG_BAR; BG_WAIT_L(0); BG_MMA(0, 1, At, B1) BG_BAR;
    BG_LDA(At, 1, 1); BG_STAGE_A(BG_SA(1, 0), 0, t + 3)
    BG_BAR; BG_WAIT_L(0); BG_MMA(1, 0, At, B0) BG_BAR; BG_SCHED;
    BG_STAGE_B(BG_SB(1, 1), 1, t + 3)
    BG_WAIT_V(6); BG_BAR; BG_MMA(1, 1, At, B1) BG_BAR;
  }
  { BG_LDB(B0, 0, 0); BG_LDA(At, 0, 0); BG_STAGE_A(BG_SA(1, 1), 1, nt - 1)
    BG_BAR; BG_WAIT_L(0); BG_MMA(0, 0, At, B0) BG_BAR;
    BG_LDB(B1, 0, 1); BG_BAR; BG_WAIT_L(0); BG_MMA(0, 1, At, B1) BG_BAR;
    BG_LDA(At, 0, 1); BG_WAIT_V(4); BG_BAR; BG_WAIT_L(0); BG_MMA(1, 0, At, B0) BG_MMA(1, 1, At, B1) BG_BAR; }
  { BG_LDB(B0, 1, 0); BG_LDA(At, 1, 0); BG_WAIT_V(2); BG_BAR; BG_WAIT_L(0); BG_MMA(0, 0, At, B0) BG_BAR;
    BG_LDB(B1, 1, 1); BG_WAIT_V(0); BG_BAR; BG_WAIT_L(0); BG_MMA(0, 1, At, B1) BG_BAR;
    BG_LDA(At, 1, 1); BG_BAR; BG_WAIT_L(0); BG_MMA(1, 0, At, B0) BG_MMA(1, 1, At, B1) BG_BAR; }
  if (wr == 0) BG_BAR;
}
#define EPIB_BEGIN(acc_, m0_, n0_, mvalid_) { const int _l = tid_() & 63, _w = tid_() >> 6, _wr = _w >> 2, _wc = _w & 3, _fr = _l & 15, _fq = _l >> 4; \
  _Pragma("unroll") for (int _ai = 0; _ai < 2; ++_ai) _Pragma("unroll") for (int _m = 0; _m < 4; ++_m) { const int row = (m0_) + _ai * 128 + _wr * 64 + _m * 16 + _fr; \
  _Pragma("unroll") for (int _bj = 0; _bj < 2; ++_bj) { const int col = (n0_) + _bj * 128 + _wc * 32 + 8 * _fq; (void)col; \
    float v[8] = {acc_[_ai][_bj][_m][0][0], acc_[_ai][_bj][_m][0][1], acc_[_ai][_bj][_m][0][2], acc_[_ai][_bj][_m][0][3], \
                  acc_[_ai][_bj][_m][1][0], acc_[_ai][_bj][_m][1][1], acc_[_ai][_bj][_m][1][2], acc_[_ai][_bj][_m][1][3]}; \
    if (row < (mvalid_)) {
#define EPIB_END }}}}

DI void ld8bf(const bf16* p, float (&v)[8]) {
  uint4 w = *(const uint4*)p;
  v[0] = __uint_as_float(w.x << 16); v[1] = __uint_as_float(w.x & 0xffff0000u); v[2] = __uint_as_float(w.y << 16); v[3] = __uint_as_float(w.y & 0xffff0000u);
  v[4] = __uint_as_float(w.z << 16); v[5] = __uint_as_float(w.z & 0xffff0000u); v[6] = __uint_as_float(w.w << 16); v[7] = __uint_as_float(w.w & 0xffff0000u);
}
DI void st8bf(bf16* p, const float (&v)[8]) { *(uint4*)p = make_uint4(pack2(v[0], v[1]), pack2(v[2], v[3]), pack2(v[4], v[5]), pack2(v[6], v[7])); }
DI void st8f(float* p, const float (&v)[8]) { *(float4*)p = make_float4(v[0], v[1], v[2], v[3]); *(float4*)(p + 4) = make_float4(v[4], v[5], v[6], v[7]); }
#define EPI_BEGIN(NT_, acc_, m0_, n0_, mvalid_) { const int _l = tid_() & 63, _w = tid_() >> 6, _wr = _w >> 1, _wc = _w & 1, _fr = _l & 15, _fq = _l >> 4; \
  _Pragma("unroll") for (int _m = 0; _m < 4; ++_m) { const int row = (m0_) + _wr * 64 + _m * 16 + _fr; \
  _Pragma("unroll") for (int _q = 0; _q < (NT_) / 2; ++_q) { const int col = (n0_) + _wc * (16 * (NT_)) + _q * 32 + 8 * _fq; (void)col; \
    float v[8] = {acc_[_m][2 * _q][0], acc_[_m][2 * _q][1], acc_[_m][2 * _q][2], acc_[_m][2 * _q][3], \
                  acc_[_m][2 * _q + 1][0], acc_[_m][2 * _q + 1][1], acc_[_m][2 * _q + 1][2], acc_[_m][2 * _q + 1][3]}; \
    if (row < (mvalid_)) {
#define EPI_END }}}}

DI int mtile_row0(int mt, bool latonly, int TH) {
  if (!latonly) return mt * TH;
  const int per = SEQ / TH, b = mt / per, r = mt % per;
  return b * TOK + CTXL + r * TH;
}
DI int mtiles(bool latonly, int TH) { return latonly ? BATCH * (SEQ / TH) : (NTOK + TH - 1) / TH; }

struct LP {
  int l; bool last;
  const float* mod;
  char* we;
  char* s5;
};
DI LP make_lp(const Params& p, int l) {
  LP q; q.l = l; q.last = (l == DEPTH - 1);
  q.mod = (const float*)(p.ws + OFF_MOD) + (size_t)l * NB1 * 6144;
  q.we = p.ws + OFF_WEARLY + (size_t)l * WE_SIZE;
  q.s5 = p.ws + OFF_S5TAB + (size_t)l * S5_SIZE;
  return q;
}

template <class RowMap>
DI void conv_tile(const float* src, int lds, int nsrc, const float* kscale, bf16* dst, int K, int k0, int n0, char* smem, RowMap rowmap, int ndst = 1 << 30) {
  (void)smem;
  const int tid = tid_(), n4 = (tid & 63) * 4, k8 = (tid >> 6) * 8;
  float4 v[8];
  const bool ok = (n0 + n4 < nsrc);
  const float* sp = src + (size_t)(k0 + k8) * lds + n0 + n4;
#pragma unroll
  for (int k = 0; k < 8; ++k) v[k] = ok ? *(const float4*)(sp + (size_t)k * lds) : make_float4(0.f, 0.f, 0.f, 0.f);
  if (kscale) {
#pragma unroll
    for (int k = 0; k < 8; ++k) { const float sc = kscale[k0 + k8 + k]; v[k].x *= sc; v[k].y *= sc; v[k].z *= sc; v[k].w *= sc; }
  }
  float o[8];
#pragma unroll
  for (int k = 0; k < 8; ++k) o[k] = v[k].x;
  if (n0 + n4 + 0 < ndst) st8bf(dst + (size_t)rowmap(n0 + n4 + 0) * K + k0 + k8, o);
#pragma unroll
  for (int k = 0; k < 8; ++k) o[k] = v[k].y;
  if (n0 + n4 + 1 < ndst) st8bf(dst + (size_t)rowmap(n0 + n4 + 1) * K + k0 + k8, o);
#pragma unroll
  for (int k = 0; k < 8; ++k) o[k] = v[k].z;
  if (n0 + n4 + 2 < ndst) st8bf(dst + (size_t)rowmap(n0 + n4 + 2) * K + k0 + k8, o);
#pragma unroll
  for (int k = 0; k < 8; ++k) o[k] = v[k].w;
  if (n0 + n4 + 3 < ndst) st8bf(dst + (size_t)rowmap(n0 + n4 + 3) * K + k0 + k8, o);
}
struct RowId { DI int operator()(int n) const { return n; } };
struct RowGU { int half; DI int operator()(int f) const { return (f >> 7) * 256 + half * 128 + (f & 127); } };

constexpr int CT_WIN = 16 * (N_INP / 256), CT_UQ = 4 * 2, CT_UKV = 2 * 2, CT_GLU = 4, CT_WB = 4 * 16, CT_WOUT = 64;
constexpr int CT_EARLY = CT_WIN + CT_UQ + CT_UKV + CT_GLU + CT_WB + CT_WOUT;
constexpr int CT_EXP = NE * 3 * 64;

DI void conv_early_item(const Params& p, int l, int it, char* smem) {
  char* we = p.ws + OFF_WEARLY + (size_t)l * WE_SIZE;
  if (it < CT_WIN) {
    int kt = it % 16, nt = it / 16;
    conv_tile(p.in[I_WIN] + (size_t)l * 1024 * N_IN, N_IN, N_IN, nullptr, (bf16*)(we + WE_WIN), 1024, kt * 64, nt * 256, smem, RowId());
    return;
  }
  it -= CT_WIN;
  if (it < CT_UQ) {
    int kt = it % 4, nt = it / 4;
    conv_tile(p.in[I_WUQ] + (size_t)l * 256 * 384, 384, 384, p.in[I_GCQ] + l * 256, (bf16*)(we + WE_UQ), 256, kt * 64, nt * 256, smem, RowId(), 384);
    return;
  }
  it -= CT_UQ;
  if (it < CT_UKV) {
    int kt = it % 2, nt = it / 2;
    conv_tile(p.in[I_WUKV] + (size_t)l * 128 * 512, 512, 512, p.in[I_GCKV] + l * 128, (bf16*)(we + WE_UKV), 128, kt * 64, nt * 256, smem, RowId());
    return;
  }
  it -= CT_UKV;
  if (it < CT_GLU) {
    int kt = it;
    conv_tile(p.in[I_S5WGLU] + (size_t)l * 256 * 256, 256, 256, nullptr, (bf16*)(we + WE_GLU), 256, kt * 64, 0, smem, RowId());
    return;
  }
  it -= CT_GLU;
  if (it < CT_WB) {
    int j = it / 16, r = it % 16, kt = r % 4, nt = r / 4;
    conv_tile(p.in[I_WBRANCH] + ((size_t)l * 4 + j) * 256 * 1024, 1024, 1024, nullptr, (bf16*)(we + WE_WB) + (size_t)j * 1024 * 256, 256, kt * 64, nt * 256, smem, RowId());
    return;
  }
  it -= CT_WB;
  {
    int kt = it % 16, nt = it / 16;
    conv_tile(p.in[I_WOUT] + (size_t)l * 1024 * 1024, 1024, 1024, nullptr, (bf16*)(we + WE_WOUT), 1024, kt * 64, nt * 256, smem, RowId());
  }
}
DI void conv_expert_item(const Params& p, int l, int it, char* smem) {
  char* wx = p.ws + OFF_MIX;
  int e = it / 192, r = it % 192, which = r / 64, t = r % 64, kt = t % 16, nt = t / 16;
  size_t eoff = ((size_t)l * NE + e) * 1024 * 1024;
  if (which == 0) { RowGU rm; rm.half = 0; conv_tile(p.in[I_WGATE] + eoff, 1024, 1024, nullptr, (bf16*)(wx + WX_GU) + (size_t)e * 2048 * 1024, 1024, kt * 64, nt * 256, smem, rm); }
  else if (which == 1) { RowGU rm; rm.half = 1; conv_tile(p.in[I_WUP] + eoff, 1024, 1024, nullptr, (bf16*)(wx + WX_GU) + (size_t)e * 2048 * 1024, 1024, kt * 64, nt * 256, smem, rm); }
  else conv_tile(p.in[I_WDOWN] + eoff, 1024, 1024, nullptr, (bf16*)(wx + WX_DN) + (size_t)e * 1024 * 1024, 1024, kt * 64, nt * 256, smem, RowId());
}

DI void mod_item(const Params& p, int it, char* smem) {
  const int l = it / 96, cg0 = (it % 96) * 64;
  float* sc = (float*)smem;
  float* red = sc + NB1 * 1024;
  const int tid = tid_();
  __syncthreads();
  for (int i = tid; i < NB1 * 1024; i += NTHREADS) {
    int r = i >> 10, k = i & 1023;
    float c = (r < BATCH) ? p.in[I_C][r * 1024 + k] : p.in[I_CCTX][k];
    sc[i] = siluf_(c);
  }
  __syncthreads();
  const int cl = tid & 63, kg = tid >> 6;
  float acc[NB1];
#pragma unroll
  for (int r = 0; r < NB1; ++r) acc[r] = 0.f;
  const float* w = p.in[I_WADA] + (size_t)l * 1024 * 6144 + cg0 + cl;
  for (int k0 = kg * (1024 / NWAVES); k0 < (kg + 1) * (1024 / NWAVES); k0 += 16) {
    float wv[16];
#pragma unroll
    for (int u = 0; u < 16; ++u) wv[u] = w[(size_t)(k0 + u) * 6144];
#pragma unroll
    for (int u = 0; u < 16; ++u)
#pragma unroll
      for (int r = 0; r < NB1; ++r) acc[r] += sc[r * 1024 + k0 + u] * wv[u];
  }
#pragma unroll
  for (int r = 0; r < NB1; ++r) red[(kg * NB1 + r) * 64 + cl] = acc[r];
  __syncthreads();
  for (int i = tid; i < NB1 * 64; i += NTHREADS) {
    int r = i >> 6, c = i & 63;
    float s = 0.f;
#pragma unroll
    for (int q = 0; q < NWAVES; ++q) s += red[(q * NB1 + r) * 64 + c];
    s += p.in[I_BADA][l * 6144 + cg0 + c];
    ((float*)(p.ws + OFF_MOD))[((size_t)l * NB1 + r) * 6144 + cg0 + c] = s;
  }
}

DI void s5_tab_item(const Params& p, int it, char* smem) {
  const int l = it / 32, d = (it / 16) & 1, g = it & 15;
  char* s5 = p.ws + OFF_S5TAB + (size_t)l * S5_SIZE;
  float* lampow = (float*)(s5 + S5_LAMPOW) + (size_t)(d * 16 + g) * 17 * 64 * 2;
  float* bbar = (float*)(s5 + S5_BBAR) + (size_t)(d * 16 + g) * 64 * 16 * 2;
  float* kt = (float*)(s5 + S5_KT) + (size_t)(d * 16 + g) * 16 * 256;
  float* slam = (float*)smem;
  float* sbb = slam + 17 * 64 * 2;
  const int tid = tid_();
  const size_t pg = ((size_t)(l * 2 + d) * 16 + g);
  const float step = expf(p.in[I_S5LOGSTEP][pg]);
  __syncthreads();
  for (int i = tid; i < 17 * 64; i += NTHREADS) {
    int j = i >> 6, pp = i & 63;
    float are = p.in[I_S5ARE][pg * 64 + pp], aim = p.in[I_S5AIM][pg * 64 + pp];
    float mag = expf((float)j * step * are), ang = (float)j * step * aim;
    float re = mag * cosf(ang), im = mag * sinf(ang);
    slam[i * 2] = re; slam[i * 2 + 1] = im; lampow[i * 2] = re; lampow[i * 2 + 1] = im;
  }
  __syncthreads();
  for (int i = tid; i < 64 * 16; i += NTHREADS) {
    int pp = i >> 4;
    float are = p.in[I_S5ARE][pg * 64 + pp], aim = p.in[I_S5AIM][pg * 64 + pp];
    float x = slam[(64 + pp) * 2] - 1.0f, y = slam[(64 + pp) * 2 + 1];
    float den = are * are + aim * aim;
    float qre = (x * are + y * aim) / den, qim = (y * are - x * aim) / den;
    float bre = p.in[I_S5BRE][pg * 1024 + i], bim = p.in[I_S5BIM][pg * 1024 + i];
    float re = qre * bre - qim * bim, im = qre * bim + qim * bre;
    sbb[i * 2] = re; sbb[i * 2 + 1] = im; bbar[i * 2] = re; bbar[i * 2 + 1] = im;
  }
  __syncthreads();
  for (int i = tid; i < 16 * 256; i += NTHREADS) {
    int j = i >> 8, c = (i >> 4) & 15, c2 = i & 15;
    float s = 0.f;
    for (int pp = 0; pp < 64; ++pp) {
      float cre = p.in[I_S5CRE][pg * 1024 + c * 64 + pp], cim = p.in[I_S5CIM][pg * 1024 + c * 64 + pp];
      float lre = slam[(j * 64 + pp) * 2], lim = slam[(j * 64 + pp) * 2 + 1];
      float tre = cre * lre - cim * lim, tim = cre * lim + cim * lre;
      float bre = sbb[(pp * 16 + c2) * 2], bim = sbb[(pp * 16 + c2) * 2 + 1];
      s += tre * bre - tim * bim;
    }
    kt[i] = s;
  }
}
DI void s5_mat_item(const Params& p, int it) {
  const int l = it / 256, g = (it / 16) & 15, q = it & 15;
  char* s5 = p.ws + OFF_S5TAB + (size_t)l * S5_SIZE;
  const float* lampow = (const float*)(s5 + S5_LAMPOW);
  const float* bbar = (const float*)(s5 + S5_BBAR);
  const float* ktab = (const float*)(s5 + S5_KT);
  bf16* WA = (bf16*)(s5 + S5_WA) + (size_t)g * 256 * 256;
  bf16* W2 = (bf16*)(s5 + S5_W2) + (size_t)g * 256 * 512;
  const int tid = tid_();
  for (int i = tid; i < 16 * 256; i += NTHREADS) {
    int n = q * 16 + (i >> 8), k = i & 255;
    int d = n >> 7, ri = (n >> 6) & 1, pp = n & 63, s = k >> 4, c2 = k & 15;
    int e = (d == 0) ? (15 - s) : s;
    const float* lp = lampow + ((size_t)((d * 16 + g) * 17 + e) * 64 + pp) * 2;
    const float* bp = bbar + ((size_t)((d * 16 + g) * 64 + pp) * 16 + c2) * 2;
    float re = lp[0] * bp[0] - lp[1] * bp[1], im = lp[0] * bp[1] + lp[1] * bp[0];
    WA[(size_t)n * 256 + k] = f2bf(ri == 0 ? re : im);
  }
  for (int i = tid; i < 16 * 512; i += NTHREADS) {
    int n = q * 16 + (i >> 9), k = i & 511;
    int lq = n >> 4, c = n & 15;
    float v;
    if (k < 256) {
      int s = k >> 4, c2 = k & 15;
      v = 0.f;
      if (s <= lq) v += ktab[((size_t)(0 * 16 + g) * 16 + (lq - s)) * 256 + c * 16 + c2];
      if (s >= lq) v += ktab[((size_t)(1 * 16 + g) * 16 + (s - lq)) * 256 + c * 16 + c2];
      if (s == lq && c == c2) v += p.in[I_S5D][l * 256 + g * 16 + c];
    } else {
      int kk = k - 256, d = kk >> 7, ri = (kk >> 6) & 1, pp = kk & 63;
      int e = (d == 0) ? (lq + 1) : (16 - lq);
      size_t pg = ((size_t)(l * 2 + d) * 16 + g);
      float cre = p.in[I_S5CRE][pg * 1024 + c * 64 + pp], cim = p.in[I_S5CIM][pg * 1024 + c * 64 + pp];
      const float* lp = lampow + ((size_t)((d * 16 + g) * 17 + e) * 64 + pp) * 2;
      float re = cre * lp[0] - cim * lp[1], im = cre * lp[1] + cim * lp[0];
      v = (ri == 0) ? re : -im;
    }
    W2[(size_t)n * 512 + k] = f2bf(v);
  }
}

DI int tok_b(int tok) { return tok / TOK; }
DI int tok_j(int tok) { return tok % TOK; }
DI int tok_modrow(int tok) { return (tok_j(tok) < CTXL) ? BATCH : tok_b(tok); }

DI void normmod_row(const float (&xv)[16], const float* g, const float* shift, const float* scale, bf16* dst, float (&hout)[16]) {
  const int lane = tid_() & 63;
  float ss = 0.f;
#pragma unroll
  for (int i = 0; i < 16; ++i) ss += xv[i] * xv[i];
  ss = wave_sum(ss);
  const float rs = rsqrtf(ss * (1.0f / 1024.f) + EPS);
#pragma unroll
  for (int i = 0; i < 4; ++i) {
    int c = lane * 4 + i * 256;
    float4 gv = *(const float4*)(g + c), sh = *(const float4*)(shift + c), sc = *(const float4*)(scale + c);
    float h0 = xv[i * 4 + 0] * rs * gv.x * (1.f + sc.x) + sh.x;
    float h1 = xv[i * 4 + 1] * rs * gv.y * (1.f + sc.y) + sh.y;
    float h2 = xv[i * 4 + 2] * rs * gv.z * (1.f + sc.z) + sh.z;
    float h3 = xv[i * 4 + 3] * rs * gv.w * (1.f + sc.w) + sh.w;
    hout[i * 4 + 0] = h0; hout[i * 4 + 1] = h1; hout[i * 4 + 2] = h2; hout[i * 4 + 3] = h3;
    *(uint2*)(dst + c) = make_uint2(pack2(h0, h1), pack2(h2, h3));
  }
}

DI void prep_row_item(const Params& p, int it) {
  const int tok = it * NWAVES + (tid_() >> 6), lane = tid_() & 63;
  const int b = tok_b(tok), j = tok_j(tok);
  const float* src = (j < CTXL) ? p.in[I_CTX] + ((size_t)b * CTXL + j) * 1024 : p.in[I_X] + ((size_t)b * SEQ + (j - CTXL)) * 1024;
  float xv[16], h[16];
#pragma unroll
  for (int i = 0; i < 4; ++i) {
    float4 v = *(const float4*)(src + lane * 4 + i * 256);
    xv[i * 4] = v.x; xv[i * 4 + 1] = v.y; xv[i * 4 + 2] = v.z; xv[i * 4 + 3] = v.w;
  }
  const float* mod = (const float*)(p.ws + OFF_MOD) + (size_t)tok_modrow(tok) * 6144;
  normmod_row(xv, p.in[I_GPREMIX], mod + 0, mod + 1024, (bf16*)(p.ws + OFF_HA) + (size_t)tok * 1024, h);
}

constexpr int IP_LT = BATCH * (SEQ / 256), IP_CT = BATCH * ((CTXL + 255) / 256), IP_MT = IP_LT + IP_CT, IP_NT = N_INP / 256;
constexpr int IP_RR = (IP_MT + 7) / 8, IP_RC = (IP_NT + 1) / 2;
constexpr int IP_RC_NOGATE = (((C_GATE + 255) / 256) + 1) / 2;
constexpr int IP_RR_LAT = IP_LT / 8;
constexpr bool IP_COMPACT = (IP_LT % 8 == 0);
constexpr int IP_RECTS_ALL = IP_RR * IP_RC, IP_RECTS_LAST = IP_COMPACT ? (IP_RR * IP_RC_NOGATE + IP_RR_LAT * (IP_RC - IP_RC_NOGATE)) : IP_RECTS_ALL;
constexpr int IP_SLOTS_ALL = ((IP_RECTS_ALL + 15) / 16) * 256, IP_SLOTS_LAST = ((IP_RECTS_LAST + 15) / 16) * 256;
DI void inproj_tile(const Params& p, const LP& L, int t, char* smem) {
  const int vb = t % 256, vround = t / 256, x = vb % 8, j = vb / 8;
  const int Rc = vround * 16 + x * 2 + (j >> 4), jj = j & 15;
  int rm, rn;
  if (!L.last || !IP_COMPACT || Rc < IP_RR * IP_RC_NOGATE) { rm = Rc % IP_RR; rn = Rc / IP_RR; }
  else { const int q = Rc - IP_RR * IP_RC_NOGATE; rm = q % IP_RR_LAT; rn = IP_RC_NOGATE + q / IP_RR_LAT; }
  const int mt = rm * 8 + (jj & 7), nt = rn * 2 + (jj >> 3);
  if (mt >= IP_MT || nt >= IP_NT || rn >= IP_RC) return;
  int m0;
  if (mt < IP_LT) m0 = (mt / (SEQ / 256)) * TOK + CTXL + (mt % (SEQ / 256)) * 256;
  else { const int c = mt - IP_LT; m0 = (c / ((CTXL + 255) / 256)) * TOK + (c % ((CTXL + 255) / 256)) * 256; }
  const int n0 = nt * 256;
  const int mv = (mt < IP_LT) ? NTOK : (m0 - (m0 % TOK) + CTXL);
  if (L.last && mt >= IP_LT && n0 >= ((C_GATE + 255) / 256) * 256) return;
  GA g = make_ga((const bf16*)(p.ws + OFF_HA), 1024, (const bf16*)(L.we + WE_WIN), 1024, 1024, mv);
  f32x4 acc[2][2][4][2];
  gemm_big(g, m0, n0, smem, acc);
  bf16* P1 = (bf16*)(p.ws + OFF_P1);
  bf16* PG = (bf16*)(p.ws + OFF_PG);
  bf16* US5 = (bf16*)(p.ws + OFF_MIX + MX_US5);
  float* DT = (float*)(p.ws + OFF_DT);
  const float* dtb = p.in[I_M2DTBIAS] + L.l * 8;
  EPIB_BEGIN(acc, m0, n0, mv)
    if (col < C_S5 || (col >= C_Z && col < C_DT)) st8bf(P1 + (size_t)row * P1W + col, v);
    else if (col < C_Z) st8bf(US5 + ((size_t)((col - C_S5) >> 4) * NTOK + row) * 16 + (col & 15), v);
    else if (col < C_GATE) {
#pragma unroll
      for (int k = 0; k < 8; ++k) v[k] = softplusf_(v[k] + dtb[k]);
      st8f(DT + (size_t)row * 8, v);
    } else if (col < N_IN) {
#pragma unroll
      for (int k = 0; k < 8; ++k) v[k] = sigmoidf_(v[k]);
      st8bf(PG + (size_t)row * 4096 + (col - C_GATE), v);
    }
  EPIB_END
}

DI void rowscale_256(const bf16* P1, int m0, int c0, int width, float* srs) {
  const int r = tid_() >> 1, hf = tid_() & 1;
  int gr = m0 + r; if (gr > NTOK - 1) gr = NTOK - 1;
  const bf16* src = P1 + (size_t)gr * P1W + c0 + hf * (width / 2);
  float ss = 0.f;
  for (int i = 0; i < width / 2; i += 8) {
    float v[8]; ld8bf(src + i, v);
#pragma unroll
    for (int k = 0; k < 8; ++k) ss += v[k] * v[k];
  }
  ss += shfl_xor_(ss, 1);
  if (hf == 0) srs[r] = rsqrtf(ss / (float)width + EPS);
}
DI void rope_tab_item(const Params& p) {
  float* tab = (float*)(p.ws + OFF_ROPE);
  for (int i = tid_(); i < 64 * 8; i += NTHREADS) {
    int pos = i >> 3, k = i & 7;
    float f = expf(-(float)k * (9.210340371976184f / 8.0f));
    float a = (float)pos * f;
    tab[i * 2] = cosf(a); tab[i * 2 + 1] = sinf(a);
  }
}
DI void rope_cs(const float* tab, int pos, int i, float& c, float& s) { c = tab[(pos * 8 + i) * 2]; s = tab[(pos * 8 + i) * 2 + 1]; }

constexpr int TP_MT = (NTOK + 255) / 256;
DI void mlaq_tile(const Params& p, const LP& L, int t, char* smem) {
  const int mt = t % TP_MT, nt = t / TP_MT, m0 = mt * 256, n0 = nt * 128;
  const bf16* P1 = (const bf16*)(p.ws + OFF_P1);
  float* srs = (float*)(smem + SRS_OFF);
  GA g = make_ga(P1 + C_CQ, P1W, (const bf16*)(L.we + WE_UQ), 256, 256, NTOK);
  f32x4 acc[4][4];
  gemm_s<4>(g, m0, n0, smem, acc);
  rowscale_256(P1, m0, C_CQ, 256, srs);
  __syncthreads();
  bf16* Q = (bf16*)(p.ws + OFF_MIX + MX_Q);
  const float* ropetab = (const float*)(p.ws + OFF_ROPE);
  {
    const int l = tid_() & 63, w = tid_() >> 6, wr = w >> 1, wc = w & 1, fr = l & 15, fq = l >> 4;
#pragma unroll
    for (int m = 0; m < 4; ++m) {
      const int row = m0 + wr * 64 + m * 16 + fr;
      const int rowc = row < NTOK ? row : NTOK - 1;
      const float rsc = srs[rowc - m0];
      const int b = tok_b(rowc), j = tok_j(rowc);
#pragma unroll
      for (int q = 0; q < 2; ++q) {
        const int col = n0 + wc * 64 + q * 32 + 8 * fq;
        const int h = col / 96, dd = col % 96;
        float v[8] = {acc[m][2 * q][0], acc[m][2 * q][1], acc[m][2 * q][2], acc[m][2 * q][3], acc[m][2 * q + 1][0], acc[m][2 * q + 1][1], acc[m][2 * q + 1][2], acc[m][2 * q + 1][3]};
        float vp[8];
#pragma unroll
        for (int k = 0; k < 8; ++k) vp[k] = shfl_xor_(v[k], 16);
        if (dd >= 64 && j >= CTXL) {
          const int tl = j - CTXL, pos = ((dd - 64) < 16) ? (tl / GRID_W) : (tl % GRID_W);
          const bool lo = ((dd & 8) == 0);
#pragma unroll
          for (int k = 0; k < 8; ++k) {
            float c, sn; rope_cs(ropetab, pos, k, c, sn);
            v[k] = lo ? (v[k] * c - vp[k] * sn) : (v[k] * c + vp[k] * sn);
          }
        }
#pragma unroll
        for (int k = 0; k < 8; ++k) v[k] *= rsc;
        if (row < NTOK) st8bf(Q + (((size_t)b * 4 + h) * TOK + j) * 96 + dd, v);
      }
    }
  }
}
DI void mlakv_tile(const Params& p, const LP& L, int t, char* smem) {
  const int mt = t % TP_MT, h = t / TP_MT, m0 = mt * 256, n0 = h * 128;
  const bf16* P1 = (const bf16*)(p.ws + OFF_P1);
  float* srs = (float*)(smem + SRS_OFF);
  GA g = make_ga(P1 + C_CKV, P1W, (const bf16*)(L.we + WE_UKV), 128, 128, NTOK);
  f32x4 acc[4][4];
  gemm_s<4>(g, m0, n0, smem, acc);
  rowscale_256(P1, m0, C_CKV, 128, srs);
  __syncthreads();
  bf16* K = (bf16*)(p.ws + OFF_MIX + MX_K);
  bf16* VT = (bf16*)(p.ws + OFF_MIX + MX_VTM);
  const float* ropetab = (const float*)(p.ws + OFF_ROPE);
  EPI_BEGIN(4, acc, m0, n0, NTOK)
    const float rsc = srs[row - m0];
    const int b = tok_b(row), j = tok_j(row), dd = col - n0;
#pragma unroll
    for (int k = 0; k < 8; ++k) v[k] *= rsc;
    if (dd < 64) st8bf(K + (((size_t)b * 4 + h) * TOK + j) * 96 + dd, v);
    else {
#pragma unroll
      for (int k = 0; k < 8; ++k) VT[(((size_t)b * 4 + h) * 64 + (dd - 64 + k)) * TOK + j] = f2bf(v[k]);
    }
  EPI_END
  for (int i = tid_(); i < 256 * 16; i += NTHREADS) {
    int r = i >> 4, q = i & 15;
    int row = m0 + r;
    if (row < NTOK) {
      int b = tok_b(row), j = tok_j(row);
      int blk = q >> 3, i8 = q & 7;
      float x1 = bf2f(P1[(size_t)row * P1W + C_KR + blk * 16 + i8]), x2 = bf2f(P1[(size_t)row * P1W + C_KR + blk * 16 + i8 + 8]);
      float o1 = x1, o2 = x2;
      if (j >= CTXL) {
        int tl = j - CTXL, pos = blk == 0 ? (tl / GRID_W) : (tl % GRID_W);
        float c, sn; rope_cs(ropetab, pos, i8, c, sn);
        o1 = x1 * c - x2 * sn; o2 = x2 * c + x1 * sn;
      }
      bf16* kd = K + (((size_t)b * 4 + h) * TOK + j) * 96 + 64 + blk * 16 + i8;
      kd[0] = f2bf(o1); kd[8] = f2bf(o2);
    }
  }
}
DI void navt_item(const Params& p, int it, char* smem) {
  bf16* s = (bf16*)smem;
  const bf16* P1 = (const bf16*)(p.ws + OFF_P1);
  bf16* VT = (bf16*)(p.ws + OFF_MIX + MX_VTN);
  const int tok0 = it * 64, tid = tid_();
  const int b = tok_b(tok0), j0 = tok_j(tok0);
  __syncthreads();
  for (int i = tid; i < 64 * 32; i += NTHREADS) {
    int r = i >> 5, c8 = i & 31;
    *(uint4*)(s + r * 264 + c8 * 8) = *(const uint4*)(P1 + (size_t)(tok0 + r) * P1W + C_NA + 512 + c8 * 8);
  }
  __syncthreads();
  for (int i = tid; i < 256 * 8; i += NTHREADS) {
    int ch = i >> 3, t8 = i & 7;
    unsigned w[4];
#pragma unroll
    for (int q = 0; q < 4; ++q) w[q] = (unsigned)s[(t8 * 8 + 2 * q) * 264 + ch] | ((unsigned)s[(t8 * 8 + 2 * q + 1) * 264 + ch] << 16);
    *(uint4*)(VT + ((size_t)b * 256 + ch) * TOK + j0 + t8 * 8) = make_uint4(w[0], w[1], w[2], w[3]);
  }
}
constexpr int M2C_TOK = 128, M2C_ITEMS = NTOK / M2C_TOK;
DI void m2conv_item(const Params& p, const LP& L, int it) {
  const bf16* P1 = (const bf16*)(p.ws + OFF_P1);
  bf16* XB = (bf16*)(p.ws + OFF_MIX + MX_XBC);
  const int tok0 = it * M2C_TOK;
  const float* cw = p.in[I_M2CONVW] + (size_t)L.l * 4 * 768;
  const float* cb = p.in[I_M2CONVB] + (size_t)L.l * 768;
  for (int task = tid_(); task < 96 * (M2C_TOK / 8); task += NTHREADS) {
    const int cg = task % 96, tb = task / 96, c0 = cg * 8;
    const int tokb = tok0 + tb * 8, jt = tok_j(tokb), base = tokb - jt;
    const int slo = (jt < CTXL) ? 0 : CTXL, shi = (jt < CTXL) ? CTXL : TOK;
    float w[4][8], bias[8];
#pragma unroll
    for (int k = 0; k < 4; ++k) { float4 a = *(const float4*)(cw + k * 768 + c0), b4 = *(const float4*)(cw + k * 768 + c0 + 4);
      w[k][0] = a.x; w[k][1] = a.y; w[k][2] = a.z; w[k][3] = a.w; w[k][4] = b4.x; w[k][5] = b4.y; w[k][6] = b4.z; w[k][7] = b4.w; }
    { float4 a = *(const float4*)(cb + c0), b4 = *(const float4*)(cb + c0 + 4);
      bias[0] = a.x; bias[1] = a.y; bias[2] = a.z; bias[3] = a.w; bias[4] = b4.x; bias[5] = b4.y; bias[6] = b4.z; bias[7] = b4.w; }
    float xin[11][8];
#pragma unroll
    for (int r = 0; r < 11; ++r) {
      const int j = jt - 2 + r;
      if (j >= slo && j < shi) ld8bf(P1 + (size_t)(base + j) * P1W + C_XBC + c0, xin[r]);
      else {
#pragma unroll
        for (int c = 0; c < 8; ++c) xin[r][c] = 0.f;
      }
    }
    float y[8][8];
#pragma unroll
    for (int t = 0; t < 8; ++t) {
#pragma unroll
      for (int c = 0; c < 8; ++c) y[t][c] = siluf_(bias[c] + w[0][c] * xin[t][c] + w[1][c] * xin[t + 1][c] + w[2][c] * xin[t + 2][c] + w[3][c] * xin[t + 3][c]);
      st8bf(XB + (size_t)(base + jt + t) * 768 + c0, y[t]);
    }
    if (c0 < 512) {
      bf16* XT = (bf16*)(p.ws + OFF_MIX + MX_XBT) + ((size_t)(base / TOK) * 512 + c0) * TOK + jt;
#pragma unroll
      for (int c = 0; c < 8; ++c) {
        float col[8];
#pragma unroll
        for (int t = 0; t < 8; ++t) col[t] = y[t][c];
        st8bf(XT + (size_t)c * TOK, col);
      }
    }
  }
}
DI int m2_seq2tok(int sq, int dir) { return (dir == 0) ? sq : (sq < CTXL ? (CTXL - 1 - sq) : (TOK - 1 - (sq - CTXL))); }
constexpr int M2S_ITEMS = BATCH * 8 * (TOK / 64) / NWAVES;
DI void m2scal_item(const Params& p, const LP& L, int it) {
  const int w = it * NWAVES + (tid_() >> 6), lane = tid_() & 63;
  const int ch = w % (TOK / 64), r = w / (TOK / 64), hd = r & 3, dir = (r >> 2) & 1, b = r >> 3;
  const float a = -expf(p.in[I_M2ALOG][(L.l * 2 + dir) * 4 + hd]);
  const int sq = ch * 64 + lane, j = m2_seq2tok(sq, dir);
  const float dt = ((const float*)(p.ws + OFF_DT))[((size_t)b * TOK + j) * 8 + dir * 4 + hd];
  float cs = dt * a;
#pragma unroll
  for (int d = 1; d < 64; d <<= 1) { float o = shfl_up_(cs, d); if (lane >= d) cs += o; }
  const float sl = shfl_(cs, 63);
  float* o = (float*)(p.ws + OFF_MIX + MX_M2S) + ((size_t)((b * 2 + dir) * 4 + hd) * TOK + sq) * 4;
  *(float4*)o = make_float4(cs, dt, dt * __expf(sl - cs), cs * 1.4426950408889634f - log2f(dt));
}
constexpr int S5_MT = (MCH + 255) / 256;
DI void s5a_tile(const Params& p, const LP& L, int t, char* smem) {
  const int g = t / (S5_MT * 2), r = t % (S5_MT * 2), mt = r / 2, nt = r % 2;
  const int m0 = mt * 256, n0 = nt * 128;
  GA ga = make_ga((const bf16*)(p.ws + OFF_MIX + MX_US5) + (size_t)g * NTOK * 16, 256, (const bf16*)(L.s5 + S5_WA) + (size_t)g * 65536, 256, 256, MCH);
  f32x4 acc[4][4];
  gemm_s<4>(ga, m0, n0, smem, acc);
  float* HE = (float*)(p.ws + OFF_MIX + MX_HEND) + (size_t)g * MCH * 256;
  EPI_BEGIN(4, acc, m0, n0, MCH)
    st8f(HE + (size_t)row * 256 + col, v);
  EPI_END
}
DI int s5_chunk_of(int i, int d) { return (d == 0) ? i : (i < NCC ? (NCC - 1 - i) : (NCH - 1 - (i - NCC))); }
DI void s5carry_item(const Params& p, const LP& L, int it) {
  const int w = it * NWAVES + (tid_() >> 6), lane = tid_() & 63;
  const int d = w / (16 * BATCH), g = (w / BATCH) & 15, b = w % BATCH;
  const float* lp = (const float*)(L.s5 + S5_LAMPOW) + ((size_t)((d * 16 + g) * 17 + 16) * 64 + lane) * 2;
  const float lre = lp[0], lim = lp[1];
  const float* HE = (const float*)(p.ws + OFF_MIX + MX_HEND) + ((size_t)g * MCH + (size_t)b * NCH) * 256 + d * 128;
  bf16* HI = (bf16*)(p.ws + OFF_MIX + MX_HIN) + ((size_t)g * MCH + (size_t)b * NCH) * 256 + d * 128;
  float cre = 0.f, cim = 0.f;
  static_assert(NCH % 4 == 0, "chunk count");
  for (int i0 = 0; i0 < NCH; i0 += 4) {
    float hre[4], him[4];
#pragma unroll
    for (int k = 0; k < 4; ++k) { const int ch = s5_chunk_of(i0 + k, d); hre[k] = HE[(size_t)ch * 256 + lane]; him[k] = HE[(size_t)ch * 256 + 64 + lane]; }
#pragma unroll
    for (int k = 0; k < 4; ++k) {
      const int ch = s5_chunk_of(i0 + k, d);
      HI[(size_t)ch * 256 + lane] = f2bf(cre); HI[(size_t)ch * 256 + 64 + lane] = f2bf(cim);
      const float nre = lre * cre - lim * cim + hre[k], nim = lre * cim + lim * cre + him[k];
      cre = nre; cim = nim;
    }
  }
}
DI void s5c_tile(const Params& p, const LP& L, int t, char* smem) {
  const int g = t / (S5_MT * 2), r = t % (S5_MT * 2), mt = r / 2, nt = r % 2;
  const int m0 = mt * 256, n0 = nt * 128;
  GA ga = make_ga((const bf16*)(p.ws + OFF_MIX + MX_US5) + (size_t)g * NTOK * 16, 256, (const bf16*)(L.s5 + S5_W2) + (size_t)g * 256 * 512, 512, 512, MCH);
  ga.A2 = (const bf16*)(p.ws + OFF_MIX + MX_HIN) + (size_t)g * MCH * 256; ga.lda2 = 256; ga.ksplit = 256;
  f32x4 acc[4][4];
  gemm_s<4>(ga, m0, n0, smem, acc);
  bf16* Z = (bf16*)(p.ws + OFF_MIX + MX_Z);
  EPI_BEGIN(4, acc, m0, n0, MCH)
#pragma unroll
    for (int k = 0; k < 8; ++k) v[k] = geluf_(v[k]);
    st8bf(Z + ((size_t)row * 16 + (col >> 4)) * 256 + g * 16 + (col & 15), v);
  EPI_END
}

#ifdef EMU
DI float fmax_(float a, float b) { return a > b ? a : b; }
#else
DI float fmax_(float a, float b) { return __builtin_fmaxf(a, b); }
#endif
constexpr int AT_LDV = 76;
struct NaInfo { int r, qc, rs, cs; };
template <int DK, bool NA>
DI void attn_block(const bf16* qrow, bool active, const bf16* Kp, int kstride, const bf16* Vt,
                   int ka0, int ntile_a, int arow0, int kb0, int ntile_b,
                   const float* srpb, NaInfo ni, float scale, bf16* orow, char* smem) {
  constexpr int LDK = DK + 8, KCH = DK / 8;
  constexpr int KT_BYTES = 64 * LDK * 2, VT_BYTES = 64 * AT_LDV * 2;
  constexpr int NKL = (64 * KCH + NTHREADS - 1) / NTHREADS;
  const int tid = tid_(), lane = tid & 63, half = lane >> 5, r = lane & 31;
  bf16* sK = (bf16*)smem;
  bf16* sV = (bf16*)(smem + 2 * KT_BYTES);
  bf16x8 qf[DK / 16];
  f32x16 o0, o1;
  float m = -1e30f, l = 0.f;
  const float scale2 = scale * 1.4426950408889634f;
#pragma unroll
  for (int ks = 0; ks < DK / 16; ++ks) qf[ks] = active ? *(const bf16x8*)(qrow + ks * 16 + 8 * half) : bf16x8{0, 0, 0, 0, 0, 0, 0, 0};
#pragma unroll
  for (int i = 0; i < 16; ++i) { o0[i] = 0.f; o1[i] = 0.f; }
  const int NTL = ntile_a + ntile_b;
  u32x4 rk[NKL], rv[1];
#pragma unroll
  for (int i = 0; i < NKL; ++i) rk[i] = u32x4{0u, 0u, 0u, 0u};
  auto key0_of = [&](int t) { return t < ntile_a ? ka0 + 64 * t : kb0 + 64 * (t - ntile_a); };
#define AT_GLOAD(t_) { const int k0_ = key0_of(t_); \
    _Pragma("unroll") for (int i_ = 0; i_ < NKL; ++i_) { const int c_ = tid + i_ * NTHREADS; const int key_ = c_ / KCH, ch_ = c_ % KCH; \
      if (c_ < 64 * KCH) rk[i_] = *(const u32x4*)(Kp + (size_t)(k0_ + key_) * kstride + ch_ * 8); } \
    { const int d_ = tid >> 3, ch_ = tid & 7; rv[0] = *(const u32x4*)(Vt + (size_t)d_ * TOK + k0_ + ch_ * 8); } }
#define AT_SSTORE(buf_) { \
    _Pragma("unroll") for (int i_ = 0; i_ < NKL; ++i_) { const int c_ = tid + i_ * NTHREADS; const int key_ = c_ / KCH, ch_ = c_ % KCH; \
      if (c_ < 64 * KCH) *(u32x4*)(sK + (buf_) * (64 * LDK) + key_ * LDK + ch_ * 8) = rk[i_]; } \
    { const int d_ = tid >> 3, ch_ = tid & 7; \
      bf16* dst_ = sV + (buf_) * (64 * AT_LDV) + d_ * AT_LDV + ch_ * 8; \
      *(uint2*)dst_ = make_uint2(rv[0][0], rv[0][1]); *(uint2*)(dst_ + 4) = make_uint2(rv[0][2], rv[0][3]); } }
  __syncthreads();
  AT_GLOAD(0) AT_SSTORE(0)
  __syncthreads();
#pragma unroll 1
  for (int t = 0; t < NTL; ++t) {
    const int buf = t & 1;
    if (t + 1 < NTL) AT_GLOAD(t + 1)
    bool doit = active;
    int trow0 = 0;
    if (NA && t < ntile_a) {
      trow0 = arow0 + t * (64 / GRID_W);
      doit = active && (trow0 + (64 / GRID_W) > ni.rs) && (trow0 < ni.rs + WIN_R);
    }
    if (doit) {
      const bf16* kb = sK + buf * (64 * LDK);
      const bf16* vb = sV + buf * (64 * AT_LDV);
      f32x16 s0, s1;
#pragma unroll
      for (int i = 0; i < 16; ++i) { s0[i] = 0.f; s1[i] = 0.f; }
#pragma unroll
      for (int ks = 0; ks < DK / 16; ++ks) {
        bf16x8 a0 = *(const bf16x8*)(kb + r * LDK + ks * 16 + 8 * half);
        bf16x8 a1 = *(const bf16x8*)(kb + (32 + r) * LDK + ks * 16 + 8 * half);
        s0 = __builtin_amdgcn_mfma_f32_32x32x16_bf16(a0, qf[ks], s0, 0, 0, 0);
        s1 = __builtin_amdgcn_mfma_f32_32x32x16_bf16(a1, qf[ks], s1, 0, 0, 0);
      }
      float mx = -INFINITY;
      if (NA && t < ntile_a) {
#pragma unroll
        for (int i = 0; i < 16; ++i) {
          const int kk = (i & 3) + 8 * (i >> 2) + 4 * half;
#pragma unroll
          for (int hb = 0; hb < 2; ++hb) {
            const int kq = kk + 32 * hb;
            const int kr = trow0 + kq / GRID_W, kc = kq % GRID_W;
            const bool ok = (kr >= ni.rs) && (kr < ni.rs + WIN_R) && (kc >= ni.cs) && (kc < ni.cs + WIN_C);
            const float bias = ok ? srpb[(kr - ni.r + 7) * 31 + (kc - ni.qc + 15)] * 1.4426950408889634f : -INFINITY;
            if (hb == 0) { s0[i] = s0[i] * scale2 + bias; mx = fmax_(mx, s0[i]); }
            else { s1[i] = s1[i] * scale2 + bias; mx = fmax_(mx, s1[i]); }
          }
        }
      } else {
        s0 = s0 * scale2; s1 = s1 * scale2;
#pragma unroll
        for (int i = 0; i < 16; ++i) mx = fmax_(mx, fmax_(s0[i], s1[i]));
      }
      mx = fmax_(mx, shfl_xor_(mx, 32));
      const float mn = fmax_(m, mx);
      const float alpha = exp2f_(m - mn);
      const bool same = (mn == m);
      m = mn;
      float ps = 0.f;
      { const float nmn = -mn; s0 = s0 + nmn; s1 = s1 + nmn; }
#pragma unroll
      for (int i = 0; i < 16; ++i) { s0[i] = exp2f_(s0[i]); s1[i] = exp2f_(s1[i]); }
      { const f32x16 st = s0 + s1;
        ps = ((st[0] + st[1]) + (st[2] + st[3])) + ((st[4] + st[5]) + (st[6] + st[7])) + (((st[8] + st[9]) + (st[10] + st[11])) + ((st[12] + st[13]) + (st[14] + st[15]))); }
      l = l * alpha + ps;
      if (!wave_all_(same)) {
#pragma unroll
        for (int i = 0; i < 16; ++i) { o0[i] *= alpha; o1[i] *= alpha; }
      }
#pragma unroll
      for (int kq = 0; kq < 4; ++kq) {
        u32x4 pw;
#pragma unroll
        for (int j = 0; j < 4; ++j) pw[j] = (kq < 2) ? pack2(s0[8 * (kq & 1) + 2 * j], s0[8 * (kq & 1) + 2 * j + 1]) : pack2(s1[8 * (kq & 1) + 2 * j], s1[8 * (kq & 1) + 2 * j + 1]);
        const bf16x8 pf = __builtin_bit_cast(bf16x8, pw);
        const bf16* v0 = vb + r * AT_LDV + 16 * kq + 4 * half;
        const bf16* v1 = vb + (r + 32) * AT_LDV + 16 * kq + 4 * half;
        uint2 a0 = *(const uint2*)v0, a1 = *(const uint2*)(v0 + 8), b0 = *(const uint2*)v1, b1 = *(const uint2*)(v1 + 8);
        bf16x8 va, vbb;
        va[0] = (short)(a0.x & 0xffff); va[1] = (short)(a0.x >> 16); va[2] = (short)(a0.y & 0xffff); va[3] = (short)(a0.y >> 16);
        va[4] = (short)(a1.x & 0xffff); va[5] = (short)(a1.x >> 16); va[6] = (short)(a1.y & 0xffff); va[7] = (short)(a1.y >> 16);
        vbb[0] = (short)(b0.x & 0xffff); vbb[1] = (short)(b0.x >> 16); vbb[2] = (short)(b0.y & 0xffff); vbb[3] = (short)(b0.y >> 16);
        vbb[4] = (short)(b1.x & 0xffff); vbb[5] = (short)(b1.x >> 16); vbb[6] = (short)(b1.y & 0xffff); vbb[7] = (short)(b1.y >> 16);
        o0 = __builtin_amdgcn_mfma_f32_32x32x16_bf16(va, pf, o0, 0, 0, 0);
        o1 = __builtin_amdgcn_mfma_f32_32x32x16_bf16(vbb, pf, o1, 0, 0, 0);
      }
    }
    if (t + 1 < NTL) AT_SSTORE(buf ^ 1)
    __syncthreads();
  }
  if (active) {
    const float lt = l + shfl_xor_(l, 32);
    const float inv = rcp_(lt);
#pragma unroll
    for (int gI = 0; gI < 4; ++gI) {
      const int d0 = 8 * gI + 4 * half;
      *(uint2*)(orow + d0) = make_uint2(pack2(o0[4 * gI] * inv, o0[4 * gI + 1] * inv), pack2(o0[4 * gI + 2] * inv, o0[4 * gI + 3] * inv));
      *(uint2*)(orow + 32 + d0) = make_uint2(pack2(o1[4 * gI] * inv, o1[4 * gI + 1] * inv), pack2(o1[4 * gI + 2] * inv, o1[4 * gI + 3] * inv));
    }
  }
}
DI void mla_attn_item(const Params& p, int it, bool ctxq, char* smem) {
  const int nqb = ctxq ? (CTXL + 255) / 256 : SEQ / 256;
  const int b = it / (4 * nqb), h = (it / nqb) & 3, qb = it % nqb;
  const int lane = tid_() & 63, wid = tid_() >> 6;
  const int nq = ctxq ? CTXL : SEQ, q0 = qb * 256 + wid * 32;
  const bool active = q0 < nq;
  const int jq = (ctxq ? 0 : CTXL) + (active ? q0 : 0) + (lane & 31);
  const bf16* Q = (const bf16*)(p.ws + OFF_MIX + MX_Q) + ((size_t)b * 4 + h) * TOK * 96;
  const bf16* K = (const bf16*)(p.ws + OFF_MIX + MX_K) + ((size_t)b * 4 + h) * TOK * 96;
  const bf16* VT = (const bf16*)(p.ws + OFF_MIX + MX_VTM) + ((size_t)b * 4 + h) * 64 * TOK;
  bf16* O = (bf16*)(p.ws + OFF_O) + ((size_t)b * TOK + jq) * 1024 + 0 * 256 + h * 64;
  NaInfo ni; ni.r = 0; ni.qc = 0; ni.rs = 0; ni.cs = 0;
  attn_block<96, false>(Q + (size_t)jq * 96, active, K, 96, VT, 0, 0, 0, 0, (ctxq ? CTXL : TOK) / 64, nullptr, ni, 0.10206207261596577f, O, smem);
}
DI void na_attn_item(const Params& p, const LP& L, int it, bool ctxq, char* smem) {
  const int nqb = ctxq ? (CTXL + 255) / 256 : SEQ / 256;
  const int b = it / (4 * nqb), h = (it / nqb) & 3, qb = it % nqb;
  const int tid = tid_(), lane = tid & 63, wid = tid >> 6;
  const int nq = ctxq ? CTXL : SEQ, q0 = qb * 256 + wid * 32;
  const bool active = q0 < nq;
  const int jq = (ctxq ? 0 : CTXL) + (active ? q0 : 0) + (lane & 31);
  const bf16* P1 = (const bf16*)(p.ws + OFF_P1) + (size_t)b * TOK * P1W;
  const bf16* VT = (const bf16*)(p.ws + OFF_MIX + MX_VTN) + ((size_t)b * 4 + h) * 64 * TOK;
  const bf16* Kb = P1 + C_NA + 256 + h * 64;
  bf16* O = (bf16*)(p.ws + OFF_O) + ((size_t)b * TOK + jq) * 1024 + 1 * 256 + h * 64;
  constexpr int AT_END64 = 2 * (64 * 72 * 2) + 2 * (64 * AT_LDV * 2);
  float* srpb = (float*)(smem + AT_END64);
  NaInfo ni; ni.r = 0; ni.qc = 0; ni.rs = 0; ni.cs = 0;
  int ka0 = 0, nta = 0, arow0 = 0;
  if (!ctxq) {
    __syncthreads();
    const float* rpb = p.in[I_RPB] + ((size_t)L.l * 4 + h) * 15 * 31;
    for (int i = tid; i < 15 * 31; i += NTHREADS) srpb[i] = rpb[i];
    const int tl = q0 + (lane & 31);
    ni.r = tl / GRID_W; ni.qc = tl % GRID_W;
    int rs = ni.r - WIN_R / 2; rs = rs < 0 ? 0 : (rs > ROWS - WIN_R ? ROWS - WIN_R : rs);
    int cs = ni.qc - WIN_C / 2; cs = cs < 0 ? 0 : (cs > GRID_W - WIN_C ? GRID_W - WIN_C : cs);
    ni.rs = rs; ni.cs = cs;
    constexpr int RPT = 64 / GRID_W;
    const int rfirst = (qb * 256) / GRID_W, rlast = (qb * 256 + 255) / GRID_W;
    int rs_f = rfirst - WIN_R / 2; rs_f = rs_f < 0 ? 0 : (rs_f > ROWS - WIN_R ? ROWS - WIN_R : rs_f);
    int rs_l = rlast - WIN_R / 2; rs_l = rs_l < 0 ? 0 : (rs_l > ROWS - WIN_R ? ROWS - WIN_R : rs_l);
    arow0 = (rs_f / RPT) * RPT;
    const int row_hi = rs_l + WIN_R;
    nta = (row_hi - arow0 + RPT - 1) / RPT;
    ka0 = CTXL + arow0 * GRID_W;
  }
  attn_block<64, true>(P1 + (size_t)jq * P1W + C_NA + h * 64, active, Kb, P1W, VT, ka0, nta, arow0, 0, CTXL / 64, srpb, ni, 0.125f, O, smem);
}

constexpr int M2_LDB = 136, M2_LDX = 72;
constexpr int M2_OFF_B = 0;
constexpr int M2_OFF_C = M2_OFF_B + 64 * M2_LDB * 2;
constexpr int M2_OFF_HD = M2_OFF_C + 64 * M2_LDB * 2;
constexpr int M2H_H = 0;
constexpr int M2H_XT = M2H_H + 64 * M2_LDB * 2;
constexpr int M2H_BT = M2H_XT + 64 * M2_LDX * 2;
constexpr int M2H_S = M2H_BT + 128 * M2_LDX * 2;
constexpr int M2H_X = M2H_S + 3 * 64 * 4;
constexpr int M2H_SIZE = M2H_X + 64 * M2_LDX * 2;
constexpr int M2_SMEM = M2_OFF_HD + 2 * M2H_SIZE;
static_assert(M2_SMEM <= SMEM_BYTES, "m2 smem");
DI u32x4 rev8_(u32x4 v) {
  return u32x4{(v[3] >> 16) | (v[3] << 16), (v[2] >> 16) | (v[2] << 16), (v[1] >> 16) | (v[1] << 16), (v[0] >> 16) | (v[0] << 16)};
}
DI void m2scan_item(const Params& p, const LP& L, int it, char* smem) {
  const int b = it / 4, grp = (it >> 1) & 1, dir = it & 1;
  const int tid = tid_(), lane = tid & 63, wid = tid >> 6, half = lane >> 5, r = lane & 31;
  const int hsel = wid >> 2, wl = wid & 3, hd = grp * 2 + hsel;
  bf16* sB = (bf16*)(smem + M2_OFF_B);
  bf16* sC = (bf16*)(smem + M2_OFF_C);
  char* hb = smem + M2_OFF_HD + hsel * M2H_SIZE;
  bf16* sH = (bf16*)(hb + M2H_H);
  bf16* sXT = (bf16*)(hb + M2H_XT);
  bf16* sBT = (bf16*)(hb + M2H_BT);
  float* sS = (float*)(hb + M2H_S);
  float* sDt = sS + 64;
  float* sW = sS + 128;
  const bf16* XB = (const bf16*)(p.ws + OFF_MIX + MX_XBC) + (size_t)b * TOK * 768;
  const bf16* XT = (const bf16*)(p.ws + OFF_MIX + MX_XBT) + (size_t)b * 512 * TOK;
  const float* SC = (const float*)(p.ws + OFF_MIX + MX_M2S) + (size_t)((b * 2 + dir) * 4 + hd) * TOK * 4;
  float* YM = (float*)(p.ws + OFF_HA) + ((size_t)dir * NTOK + (size_t)b * TOK) * 256;
  const int pb = wl & 1, tb = wl >> 1, nb0 = 2 * (wl >> 1);
  f32x16 hst[2];
#pragma unroll
  for (int i = 0; i < 16; ++i) { hst[0][i] = 0.f; hst[1][i] = 0.f; }
  __syncthreads();
  for (int i = tid; i < 2 * M2H_SIZE / 4; i += NTHREADS) ((unsigned*)(smem + M2_OFF_HD))[i] = 0u;
  __syncthreads();
  u32x4 rxt[2], rbt[2], rb[2], rc[2];
  float4 rsc = make_float4(0.f, 0.f, 0.f, 0.f);
#define M2_TLOAD(rowptr_, sq0_) (*(const u32x4*)((rowptr_) + ((dir == 0) ? (sq0_) : m2_seq2tok((sq0_) + 7, 1))))
#define M2_GLOAD(c0_) { \
    _Pragma("unroll") for (int q_ = 0; q_ < 2; ++q_) { const int i_ = tid + q_ * NTHREADS; const int h2_ = i_ >> 9, t8_ = ((i_ >> 6) & 7) * 8, pp_ = i_ & 63; \
      rxt[q_] = M2_TLOAD(XT + (size_t)((grp * 2 + h2_) * 64 + pp_) * TOK, (c0_) + t8_); } \
    _Pragma("unroll") for (int q_ = 0; q_ < 2; ++q_) { const int i_ = tid + q_ * NTHREADS; const int t8_ = (i_ >> 7) * 8, nn_ = i_ & 127; \
      rbt[q_] = M2_TLOAD(XT + (size_t)(256 + grp * 128 + nn_) * TOK, (c0_) + t8_); } \
    _Pragma("unroll") for (int q_ = 0; q_ < 2; ++q_) { const int i_ = tid + q_ * NTHREADS; const int t_ = i_ >> 4, n8_ = (i_ & 15) * 8; \
      const bf16* src_ = XB + (size_t)m2_seq2tok((c0_) + t_, dir) * 768 + grp * 128 + n8_; \
      rb[q_] = *(const u32x4*)(src_ + 256); rc[q_] = *(const u32x4*)(src_ + 512); } \
    if (wl == 0) rsc = *(const float4*)(SC + (size_t)((c0_) + lane) * 4); }
  M2_GLOAD(0)
  for (int c0 = 0; c0 < TOK; c0 += 64) {
    if (wl == 0) { sS[lane] = rsc.x; sDt[lane] = rsc.w; sW[lane] = rsc.z; }
    __syncthreads();
#pragma unroll
    for (int q2 = 0; q2 < 2; ++q2) {
      const int i = tid + q2 * NTHREADS; const int h2 = i >> 9, t8 = ((i >> 6) & 7) * 8, pp = i & 63;
      *(u32x4*)((bf16*)(smem + M2_OFF_HD + h2 * M2H_SIZE + M2H_XT) + pp * M2_LDX + t8) = dir ? rev8_(rxt[q2]) : rxt[q2];
    }
#pragma unroll
    for (int q4 = 0; q4 < 2; ++q4) {
      const int i = tid + q4 * NTHREADS; const int t = i >> 4, n8 = (i & 15) * 8;
      *(u32x4*)(sB + t * M2_LDB + n8) = rb[q4];
      *(u32x4*)(sC + t * M2_LDB + n8) = rc[q4];
    }
#pragma unroll
    for (int q4 = 0; q4 < 2; ++q4) {
      const int i = tid + q4 * NTHREADS; const int t8 = (i >> 7) * 8, nn = i & 127;
      float bv[8];
      if (dir) rbt[q4] = rev8_(rbt[q4]);
      bv[0] = __uint_as_float(rbt[q4][0] << 16); bv[1] = __uint_as_float(rbt[q4][0] & 0xffff0000u);
      bv[2] = __uint_as_float(rbt[q4][1] << 16); bv[3] = __uint_as_float(rbt[q4][1] & 0xffff0000u);
      bv[4] = __uint_as_float(rbt[q4][2] << 16); bv[5] = __uint_as_float(rbt[q4][2] & 0xffff0000u);
      bv[6] = __uint_as_float(rbt[q4][3] << 16); bv[7] = __uint_as_float(rbt[q4][3] & 0xffff0000u);
#pragma unroll
      for (int h2 = 0; h2 < 2; ++h2) {
        const float* wv = (const float*)(smem + M2_OFF_HD + h2 * M2H_SIZE + M2H_S) + 128 + t8;
        float sv[8];
#pragma unroll
        for (int k = 0; k < 8; ++k) sv[k] = bv[k] * wv[k];
        st8bf((bf16*)(smem + M2_OFF_HD + h2 * M2H_SIZE + M2H_BT) + nn * M2_LDX + t8, sv);
      }
    }
    __syncthreads();
    if (c0 + 64 < TOK) M2_GLOAD(c0 + 64)
    {
      f32x16 yT, y2;
#pragma unroll
      for (int i = 0; i < 16; ++i) { yT[i] = 0.f; y2[i] = 0.f; }
      const int tv = 32 * tb + r;
      const float St = sS[tv];
      for (int sb = 0; sb <= tb; ++sb) {
        f32x16 gT;
#pragma unroll
        for (int i = 0; i < 16; ++i) gT[i] = 0.f;
#pragma unroll
        for (int ks = 0; ks < 8; ++ks) {
          bf16x8 av = *(const bf16x8*)(sB + (32 * sb + r) * M2_LDB + 16 * ks + 8 * half);
          bf16x8 bv = *(const bf16x8*)(sC + tv * M2_LDB + 16 * ks + 8 * half);
          gT = __builtin_amdgcn_mfma_f32_32x32x16_bf16(av, bv, gT, 0, 0, 0);
        }
        const float St2 = St * 1.4426950408889634f;
        if (sb == tb) {
#pragma unroll
          for (int i = 0; i < 16; ++i) {
            const int sv = 32 * sb + (i & 3) + 8 * (i >> 2) + 4 * half;
            gT[i] = (sv <= tv) ? gT[i] * exp2f_(St2 - sDt[sv]) : 0.f;
          }
        } else {
#pragma unroll
          for (int i = 0; i < 16; ++i) {
            const int sv = 32 * sb + (i & 3) + 8 * (i >> 2) + 4 * half;
            gT[i] *= exp2f_(St2 - sDt[sv]);
          }
        }
#pragma unroll
        for (int kq = 0; kq < 2; ++kq) {
          const u32x4 pw = u32x4{pack2(gT[8 * kq], gT[8 * kq + 1]), pack2(gT[8 * kq + 2], gT[8 * kq + 3]), pack2(gT[8 * kq + 4], gT[8 * kq + 5]), pack2(gT[8 * kq + 6], gT[8 * kq + 7])};
          const bf16x8 pf = __builtin_bit_cast(bf16x8, pw);
          const bf16* xr = sXT + (32 * pb + r) * M2_LDX + 32 * sb + 16 * kq + 4 * half;
          uint2 x0 = *(const uint2*)xr, x1 = *(const uint2*)(xr + 8);
          bf16x8 xa;
          xa[0] = (short)(x0.x & 0xffff); xa[1] = (short)(x0.x >> 16); xa[2] = (short)(x0.y & 0xffff); xa[3] = (short)(x0.y >> 16);
          xa[4] = (short)(x1.x & 0xffff); xa[5] = (short)(x1.x >> 16); xa[6] = (short)(x1.y & 0xffff); xa[7] = (short)(x1.y >> 16);
          yT = __builtin_amdgcn_mfma_f32_32x32x16_bf16(xa, pf, yT, 0, 0, 0);
        }
      }
#pragma unroll
      for (int ks = 0; ks < 8; ++ks) {
        bf16x8 av = *(const bf16x8*)(sH + (32 * pb + r) * M2_LDB + 16 * ks + 8 * half);
        bf16x8 bv = *(const bf16x8*)(sC + tv * M2_LDB + 16 * ks + 8 * half);
        y2 = __builtin_amdgcn_mfma_f32_32x32x16_bf16(av, bv, y2, 0, 0, 0);
      }
      const float eS = __expf(St);
      const int j = m2_seq2tok(c0 + tv, dir);
      float* yo = YM + (size_t)j * 256 + hd * 64 + 32 * pb + 4 * half;
#pragma unroll
      for (int gI = 0; gI < 4; ++gI)
        *(float4*)(yo + 8 * gI) = make_float4(yT[4 * gI] + eS * y2[4 * gI], yT[4 * gI + 1] + eS * y2[4 * gI + 1], yT[4 * gI + 2] + eS * y2[4 * gI + 2], yT[4 * gI + 3] + eS * y2[4 * gI + 3]);
    }
    __syncthreads();
    {
      const float eL = __expf(sS[63]);
#pragma unroll
      for (int q = 0; q < 2; ++q) {
#pragma unroll
        for (int i = 0; i < 16; ++i) hst[q][i] *= eL;
#pragma unroll
        for (int ks = 0; ks < 4; ++ks) {
          bf16x8 av = *(const bf16x8*)(sXT + (32 * pb + r) * M2_LDX + 16 * ks + 8 * half);
          bf16x8 bv = *(const bf16x8*)(sBT + (32 * (nb0 + q) + r) * M2_LDX + 16 * ks + 8 * half);
          hst[q] = __builtin_amdgcn_mfma_f32_32x32x16_bf16(av, bv, hst[q], 0, 0, 0);
        }
#pragma unroll
        for (int i = 0; i < 16; ++i) {
          const int pv = 32 * pb + (i & 3) + 8 * (i >> 2) + 4 * half;
          sH[pv * M2_LDB + 32 * (nb0 + q) + r] = f2bf(hst[q][i]);
        }
      }
    }
    __syncthreads();
  }
}
DI void m2gate_item(const Params& p, const LP& L, int it) {
  const int tok = it * NWAVES + (tid_() >> 6), lane = tid_() & 63;
  const float* Y0 = (const float*)(p.ws + OFF_HA) + (size_t)tok * 256;
  const float* Y1 = Y0 + (size_t)NTOK * 256;
  const bf16* XB = (const bf16*)(p.ws + OFF_MIX + MX_XBC) + (size_t)tok * 768;
  const bf16* P1 = (const bf16*)(p.ws + OFF_P1) + (size_t)tok * P1W + C_Z;
  const int c = lane * 4, hd = c >> 6;
  const float dsk = p.in[I_M2D][L.l * 4 + hd];
  float4 y0 = *(const float4*)(Y0 + c), y1 = *(const float4*)(Y1 + c);
  uint2 xw = *(const uint2*)(XB + c), zw = *(const uint2*)(P1 + c);
  float xs[4] = {__uint_as_float(xw.x << 16), __uint_as_float(xw.x & 0xffff0000u), __uint_as_float(xw.y << 16), __uint_as_float(xw.y & 0xffff0000u)};
  float zs[4] = {__uint_as_float(zw.x << 16), __uint_as_float(zw.x & 0xffff0000u), __uint_as_float(zw.y << 16), __uint_as_float(zw.y & 0xffff0000u)};
  float ys[4] = {y0.x + y1.x, y0.y + y1.y, y0.z + y1.z, y0.w + y1.w};
  float v[4], ss = 0.f;
#pragma unroll
  for (int i = 0; i < 4; ++i) { v[i] = (ys[i] + dsk * xs[i]) * siluf_(zs[i]); ss += v[i] * v[i]; }
  ss = wave_sum(ss);
  const float rs = rsqrtf(ss * (1.f / 256.f) + EPS);
  float4 gn = *(const float4*)(p.in[I_M2GNORM] + L.l * 256 + c);
  bf16* O = (bf16*)(p.ws + OFF_O) + (size_t)tok * 1024 + 768 + c;
  *(uint2*)O = make_uint2(pack2(v[0] * rs * gn.x, v[1] * rs * gn.y), pack2(v[2] * rs * gn.z, v[3] * rs * gn.w));
}
constexpr int GLU_MT = (NTOK + 255) / 256;
DI void glu_tile(const Params& p, const LP& L, int t, char* smem) {
  const int mt = t % GLU_MT, nt = t / GLU_MT, m0 = mt * 256, n0 = nt * 128;
  const bf16* Z = (const bf16*)(p.ws + OFF_MIX + MX_Z);
  GA g = make_ga(Z, 256, (const bf16*)(L.we + WE_GLU), 256, 256, NTOK);
  f32x4 acc[4][4];
  gemm_s<4>(g, m0, n0, smem, acc);
  bf16* O = (bf16*)(p.ws + OFF_O);
  const float* bg = p.in[I_S5BGLU] + L.l * 256;
  EPI_BEGIN(4, acc, m0, n0, NTOK)
    float z[8]; ld8bf(Z + (size_t)row * 256 + col, z);
#pragma unroll
    for (int k = 0; k < 8; ++k) v[k] = z[k] * sigmoidf_(v[k] + bg[col + k]);
    st8bf(O + (size_t)row * 1024 + 512 + col, v);
  EPI_END
}
DI void merge_tile(const Params& p, const LP& L, int t, char* smem) {
  constexpr int MT_L = BATCH * (SEQ / 256), MT_A = (NTOK + 255) / 256;
  const int mt = L.last ? t % MT_L : t % MT_A, nt = L.last ? t / MT_L : t / MT_A, m0 = mtile_row0(mt, L.last, 256), n0 = nt * 128;
  const bf16* O = (const bf16*)(p.ws + OFF_O);
  const bf16* PG = (const bf16*)(p.ws + OFF_PG);
  float tot[4][2][8];
#pragma unroll
  for (int a = 0; a < 4; ++a)
#pragma unroll
    for (int q = 0; q < 2; ++q)
#pragma unroll
      for (int k = 0; k < 8; ++k) tot[a][q][k] = 0.f;
  for (int j = 0; j < 4; ++j) {
    GA g = make_ga(O + j * 256, 1024, (const bf16*)(L.we + WE_WB) + (size_t)j * 1024 * 256, 256, 256, NTOK);
    f32x4 acc[4][4];
    gemm_s<4>(g, m0, n0, smem, acc);
    EPI_BEGIN(4, acc, m0, n0, NTOK)
      float gt[8]; ld8bf(PG + (size_t)row * 4096 + j * 1024 + col, gt);
#pragma unroll
      for (int k = 0; k < 8; ++k) tot[_m][_q][k] += gt[k] * v[k];
    EPI_END
  }
  bf16* Y = (bf16*)(p.ws + OFF_P1);
  {
    const int l = tid_() & 63, w = tid_() >> 6, wr = w >> 1, wc = w & 1, fr = l & 15, fq = l >> 4;
#pragma unroll
    for (int m = 0; m < 4; ++m)
#pragma unroll
      for (int q = 0; q < 2; ++q) {
        const int row = m0 + wr * 64 + m * 16 + fr, col = n0 + wc * 64 + q * 32 + 8 * fq;
        if (row < NTOK) st8bf(Y + (size_t)row * 1024 + col, tot[m][q]);
      }
  }
}
DI void outproj_tile(const Params& p, const LP& L, int t, char* smem) {
  float* Y2 = (float*)(p.ws + OFF_HA);
  constexpr int MT_L = BATCH * (SEQ / 256), MT_A = (NTOK + 255) / 256;
  const int mt = L.last ? t % MT_L : t % MT_A, nt = L.last ? t / MT_L : t / MT_A, m0 = mtile_row0(mt, L.last, 256), n0 = nt * 256;
  GA g = make_ga((const bf16*)(p.ws + OFF_P1), 1024, (const bf16*)(L.we + WE_WOUT), 1024, 1024, NTOK);
  f32x4 acc[2][2][4][2];
  gemm_big(g, m0, n0, smem, acc);
  EPIB_BEGIN(acc, m0, n0, NTOK)
    st8f(Y2 + (size_t)row * 1024 + col, v);
  EPIB_END
}
DI int post_ntok(bool latonly) { return latonly ? BATCH * SEQ : NTOK; }
DI int post_tok(int i, bool latonly) { return latonly ? ((i / SEQ) * TOK + CTXL + (i % SEQ)) : i; }

DI const float* xsrc_row(const Params& p, int l, int tok) {
  if (l > 0) return (const float*)(p.ws + OFF_X) + (size_t)tok * 1024;
  const int b = tok_b(tok), j = tok_j(tok);
  return (j < CTXL) ? p.in[I_CTX] + ((size_t)b * CTXL + j) * 1024 : p.in[I_X] + ((size_t)b * SEQ + (j - CTXL)) * 1024;
}
DI void post_stage_router(const Params& p, const LP& L, char* smem) {
  const float* wr = p.in[I_WROUTER] + (size_t)L.l * 1024 * 16;
  float4* wl = (float4*)smem;
  __syncthreads();
  for (int i = tid_(); i < 4096; i += NTHREADS) {
    const int k = i >> 2, q = i & 3;
    const int pos = ((k >> 8) * 4 + (k & 3)) * 64 + ((k >> 2) & 63);
    wl[q * 1024 + pos] = *(const float4*)(wr + (size_t)k * 16 + q * 4);
  }
  __syncthreads();
}
DI void post_phase(const Params& p, const LP& L, char* smem) {
  const int lane = tid_() & 63, gw = (int)blockIdx.x * NWAVES + (tid_() >> 6), TW = (int)gridDim.x * NWAVES;
  const int n = post_ntok(L.last);
  if (gw >= n) return;
  const float* gpm = p.in[I_GPOSTMIX] + L.l * 1024;
  const float4* wl = (const float4*)smem;
  int i = gw, tok = post_tok(i, L.last);
  float4 yr[4], xr[4];
  {
    const float* X = xsrc_row(p, L.l, tok);
    const float* Y2 = (const float*)(p.ws + OFF_HA) + (size_t)tok * 1024;
#pragma unroll
    for (int q = 0; q < 4; ++q) { yr[q] = *(const float4*)(Y2 + lane * 4 + q * 256); xr[q] = *(const float4*)(X + lane * 4 + q * 256); }
  }
  for (;;) {
    const int inext = i + TW; const bool has = inext < n; const int tokn = has ? post_tok(inext, L.last) : tok;
    float4 yn[4], xn[4];
    {
      const float* Xn = xsrc_row(p, L.l, tokn);
      const float* Yn = (const float*)(p.ws + OFF_HA) + (size_t)tokn * 1024;
#pragma unroll
      for (int q = 0; q < 4; ++q) { yn[q] = *(const float4*)(Yn + lane * 4 + q * 256); xn[q] = *(const float4*)(Xn + lane * 4 + q * 256); }
    }
    float* X = (float*)(p.ws + OFF_X) + (size_t)tok * 1024;
    const float* mod = L.mod + (size_t)tok_modrow(tok) * 6144;
    float xv[16], h[16];
    float ss = 0.f;
#pragma unroll
    for (int q = 0; q < 4; ++q) ss += yr[q].x * yr[q].x + yr[q].y * yr[q].y + yr[q].z * yr[q].z + yr[q].w * yr[q].w;
    ss = wave_sum(ss);
    const float rs = rsqrtf(ss * (1.f / 1024.f) + EPS);
#pragma unroll
    for (int q = 0; q < 4; ++q) {
      const int c = lane * 4 + q * 256;
      float4 xo = xr[q], gv = *(const float4*)(gpm + c), gt = *(const float4*)(mod + 2048 + c);
      xo.x += gt.x * yr[q].x * rs * gv.x; xo.y += gt.y * yr[q].y * rs * gv.y; xo.z += gt.z * yr[q].z * rs * gv.z; xo.w += gt.w * yr[q].w * rs * gv.w;
      *(float4*)(X + c) = xo;
      xv[q * 4] = xo.x; xv[q * 4 + 1] = xo.y; xv[q * 4 + 2] = xo.z; xv[q * 4 + 3] = xo.w;
    }
    bf16* H2 = (bf16*)(p.ws + OFF_P1) + (size_t)NTOK * 1024 + (size_t)tok * 1024;
    normmod_row(xv, p.in[I_GPREFFN] + L.l * 1024, mod + 3072, mod + 4096, H2, h);
    float lg[16];
#pragma unroll
    for (int e = 0; e < 16; ++e) lg[e] = 0.f;
#pragma unroll
    for (int q = 0; q < 16; ++q) {
      const int pos = ((q >> 2) * 4 + (q & 3)) * 64 + lane;
      float4 a = wl[pos], b4 = wl[1024 + pos], c4 = wl[2048 + pos], d4 = wl[3072 + pos];
      float hv = h[q];
      lg[0] += hv * a.x; lg[1] += hv * a.y; lg[2] += hv * a.z; lg[3] += hv * a.w;
      lg[4] += hv * b4.x; lg[5] += hv * b4.y; lg[6] += hv * b4.z; lg[7] += hv * b4.w;
      lg[8] += hv * c4.x; lg[9] += hv * c4.y; lg[10] += hv * c4.z; lg[11] += hv * c4.w;
      lg[12] += hv * d4.x; lg[13] += hv * d4.y; lg[14] += hv * d4.z; lg[15] += hv * d4.w;
    }
    float mx = -INFINITY;
#pragma unroll
    for (int e = 0; e < 16; ++e) { lg[e] = wave_sum(lg[e]); mx = fmax_(mx, lg[e]); }
    float se = 0.f;
#pragma unroll
    for (int e = 0; e < 16; ++e) { lg[e] = expf(lg[e] - mx); se += lg[e]; }
    if (lane < 16) {
      float v = 0.f;
#pragma unroll
      for (int e = 0; e < 16; ++e) if (e == lane) v = lg[e];
      ((float*)(p.ws + OFF_AFF))[(size_t)lane * NTOK + tok] = v * rcp_(se);
    }
    if (!has) break;
    i = inext; tok = tokn;
#pragma unroll
    for (int q = 0; q < 4; ++q) { yr[q] = yn[q]; xr[q] = xn[q]; }
  }
}
DI int block_sum_(int v, int* sred, int round) {
  const int tid = tid_(), lane = tid & 63, wid = tid >> 6;
  v += shfl_xor_(v, 32); v += shfl_xor_(v, 16); v += shfl_xor_(v, 8); v += shfl_xor_(v, 4); v += shfl_xor_(v, 2); v += shfl_xor_(v, 1);
  int* r = sred + (round & 1) * NWAVES;
  if (lane == 0) r[wid] = v;
  __syncthreads();
  int tsum = 0;
#pragma unroll
  for (int q = 0; q < NWAVES; ++q) tsum += r[q];
  return tsum;
}
DI void route_item(const Params& p, const LP& L, int it, char* smem) {
  const int nstream = L.last ? 1 : 2;
  const int b = it / (16 * nstream), e = (it / nstream) & 15, ctxs = (nstream == 2) ? (it & 1) : 0;
  const int T = ctxs ? CTXL : SEQ, cap = ctxs ? CAP_C : CAP_L;
  const int tok0 = b * TOK + (ctxs ? 0 : CTXL);
  const int slot0 = ctxs ? (BATCH * CAP_L + b * CAP_C) : (b * CAP_L);
  int* sred = (int*)smem;
  const float* AFF = (const float*)(p.ws + OFF_AFF) + (size_t)e * NTOK + tok0;
  int* SEL = (int*)(p.ws + OFF_SEL);
  int* IDX = (int*)(p.ws + OFF_IDX) + (size_t)e * ESLOTS;
  float* GW = (float*)(p.ws + OFF_GW) + (size_t)e * ESLOTS;
  const int tid = tid_(), lane = tid & 63, wid = tid >> 6;
  constexpr int MAXPER = (SEQ + NTHREADS - 1) / NTHREADS;
  const int per = (T + NTHREADS - 1) / NTHREADS;
  unsigned key[MAXPER];
  __syncthreads();
#pragma unroll
  for (int k = 0; k < MAXPER; ++k) {
    int i = tid * per + k;
    key[k] = (k < per && i < T) ? (__float_as_uint(AFF[i]) + 1u) : 0u;
  }
  unsigned thr = 0u;
  int round = 0;
  for (int bit = 30; bit >= 0; --bit) {
    const unsigned cand = thr | (1u << bit);
    int c = 0;
#pragma unroll
    for (int k = 0; k < MAXPER; ++k) c += (key[k] >= cand) ? 1 : 0;
    c = block_sum_(c, sred, round++);
    if (c >= cap) thr = cand;
  }
  int cg = 0, ce = 0;
#pragma unroll
  for (int k = 0; k < MAXPER; ++k) { cg += (key[k] > thr) ? 1 : 0; ce += (key[k] == thr) ? 1 : 0; }
  const int tot_gt = block_sum_(cg, sred, round++);
  const int need_eq = cap - tot_gt;
  int v = cg | (ce << 16), inc = v;
#pragma unroll
  for (int d = 1; d < 64; d <<= 1) { int o = shfl_up_(inc, d); if (lane >= d) inc += o; }
  int* soff = sred + 2 * NWAVES;
  __syncthreads();
  if (lane == 63) soff[wid] = inc;
  __syncthreads();
  int base = 0;
  for (int w = 0; w < wid; ++w) base += soff[w];
  int excl = base + inc - v;
  int gt_before = excl & 0xffff, eq_before = excl >> 16;
#pragma unroll
  for (int k = 0; k < MAXPER; ++k) {
    int i = tid * per + k;
    if (k < per && i < T) {
      const bool isgt = key[k] > thr, iseq = key[k] == thr;
      const bool sel = isgt || (iseq && eq_before < need_eq);
      const int slot = slot0 + gt_before + (eq_before < need_eq ? eq_before : need_eq);
      if (sel) { IDX[slot] = tok0 + i; GW[slot] = __uint_as_float(key[k] - 1u); SEL[(size_t)(tok0 + i) * 16 + e] = slot; }
      else SEL[(size_t)(tok0 + i) * 16 + e] = -1;
      gt_before += isgt ? 1 : 0; eq_before += iseq ? 1 : 0;
    }
  }
}
DI void moe1_tile(const Params& p, const LP& L, int t, char* smem) {
  const int nslots = L.last ? ESLOTS_L : ESLOTS;
  constexpr int MT_L = (ESLOTS_L + 255) / 256, MT_A = (ESLOTS + 255) / 256;
  const int nt = t & 7, sq = t >> 3;
  const int e = L.last ? sq / MT_L : sq / MT_A, mt = L.last ? sq % MT_L : sq % MT_A;
  const int m0 = mt * 256, n0 = nt * 256;
  GA g = make_ga((const bf16*)(p.ws + OFF_P1) + (size_t)NTOK * 1024, 1024, (const bf16*)(p.ws + OFF_MIX + WX_GU) + (size_t)e * 2048 * 1024, 1024, 1024, nslots);
  g.ridx = (const int*)(p.ws + OFF_IDX) + (size_t)e * ESLOTS;
  f32x4 acc[2][2][4][2];
  gemm_big(g, m0, n0, smem, acc);
  bf16* ACT = (bf16*)(p.ws + OFF_PG) + (size_t)e * ESLOTS * 1024;
  {
    const int l = tid_() & 63, w = tid_() >> 6, wr = w >> 2, wc = w & 3, fr = l & 15, fq = l >> 4;
#pragma unroll
    for (int ai = 0; ai < 2; ++ai)
#pragma unroll
      for (int m = 0; m < 4; ++m) {
        const int row = m0 + ai * 128 + wr * 64 + m * 16 + fr;
        float a[8];
#pragma unroll
        for (int k = 0; k < 4; ++k) { a[k] = siluf_(acc[ai][0][m][0][k]) * acc[ai][1][m][0][k]; a[4 + k] = siluf_(acc[ai][0][m][1][k]) * acc[ai][1][m][1][k]; }
        if (row < nslots) st8bf(ACT + (size_t)row * 1024 + nt * 128 + wc * 32 + 8 * fq, a);
      }
  }
}
DI void moe2_tile(const Params& p, const LP& L, int t, char* smem) {
  const int nslots = L.last ? ESLOTS_L : ESLOTS;
  constexpr int MT_L = (ESLOTS_L + 255) / 256, MT_A = (ESLOTS + 255) / 256;
  const int x = t & 7, nt = x & 3, sq = (t >> 3) * 2 + (x >> 2);
  const int e = L.last ? sq / MT_L : sq / MT_A, mt = L.last ? sq % MT_L : sq % MT_A;
  if (e >= NE) return;
  const int m0 = mt * 256, n0 = nt * 256;
  GA g = make_ga((const bf16*)(p.ws + OFF_PG) + (size_t)e * ESLOTS * 1024, 1024, (const bf16*)(p.ws + OFF_MIX + WX_DN) + (size_t)e * 1024 * 1024, 1024, 1024, nslots);
  f32x4 acc[2][2][4][2];
  gemm_big(g, m0, n0, smem, acc);
  bf16* YS = (bf16*)(p.ws + OFF_PG) + (size_t)NE * ESLOTS * 1024 + (size_t)e * ESLOTS * 1024;
  const float* GW = (const float*)(p.ws + OFF_GW) + (size_t)e * ESLOTS;
  EPIB_BEGIN(acc, m0, n0, nslots)
    const float gw = GW[row];
#pragma unroll
    for (int k = 0; k < 8; ++k) v[k] *= gw;
    st8bf(YS + (size_t)row * 1024 + col, v);
  EPIB_END
}
DI int uni_(int v) {
#ifdef EMU
  return v;
#else
  return __builtin_amdgcn_readfirstlane(v);
#endif
}
DI void comb_phase(const Params& p, const LP& L) {
  const int lane = tid_() & 63, gw = (int)blockIdx.x * NWAVES + (tid_() >> 6), TW = (int)gridDim.x * NWAVES;
  const int n = post_ntok(L.last);
  if (gw >= n) return;
  const bf16* YS = (const bf16*)(p.ws + OFF_PG) + (size_t)NE * ESLOTS * 1024;
  const float* gpf = p.in[I_GPOSTFFN] + L.l * 1024;
  int i = gw, tok = post_tok(i, L.last);
  uint4 sel[4]; float4 xr[4];
  {
    const uint4* sp = (const uint4*)((const int*)(p.ws + OFF_SEL) + (size_t)tok * 16);
    const float* X = (const float*)(p.ws + OFF_X) + (size_t)tok * 1024;
#pragma unroll
    for (int q = 0; q < 4; ++q) { sel[q] = sp[q]; xr[q] = *(const float4*)(X + lane * 4 + q * 256); }
  }
  for (;;) {
    const int inext = i + TW; const bool has = inext < n; const int tokn = has ? post_tok(inext, L.last) : tok;
    float s[16];
#pragma unroll
    for (int q = 0; q < 16; ++q) s[q] = 0.f;
#pragma unroll
    for (int e = 0; e < 16; ++e) {
      const unsigned sv = (e & 3) == 0 ? sel[e >> 2].x : (e & 3) == 1 ? sel[e >> 2].y : (e & 3) == 2 ? sel[e >> 2].z : sel[e >> 2].w;
      const int sl = uni_((int)sv);
      if (sl >= 0) {
        const bf16* yr = YS + ((size_t)e * ESLOTS + sl) * 1024;
#pragma unroll
        for (int q = 0; q < 4; ++q) {
          uint2 w = *(const uint2*)(yr + lane * 4 + q * 256);
          s[q * 4] += __uint_as_float(w.x << 16); s[q * 4 + 1] += __uint_as_float(w.x & 0xffff0000u);
          s[q * 4 + 2] += __uint_as_float(w.y << 16); s[q * 4 + 3] += __uint_as_float(w.y & 0xffff0000u);
        }
      }
    }
    uint4 seln[4]; float4 xn[4];
    {
      const uint4* sp = (const uint4*)((const int*)(p.ws + OFF_SEL) + (size_t)tokn * 16);
      const float* Xn = (const float*)(p.ws + OFF_X) + (size_t)tokn * 1024;
#pragma unroll
      for (int q = 0; q < 4; ++q) { seln[q] = sp[q]; xn[q] = *(const float4*)(Xn + lane * 4 + q * 256); }
    }
    float ss = 0.f;
#pragma unroll
    for (int q = 0; q < 16; ++q) ss += s[q] * s[q];
    ss = wave_sum(ss);
    const float rs = rsqrtf(ss * (1.f / 1024.f) + EPS);
    const float* mod = L.mod + (size_t)tok_modrow(tok) * 6144;
    float* dst = (float*)(p.ws + OFF_X) + (size_t)tok * 1024;
    if (L.last) { const int b = tok_b(tok), j = tok_j(tok); dst = p.out + ((size_t)b * SEQ + (j - CTXL)) * 1024; }
    float xv[16], h[16];
#pragma unroll
    for (int q = 0; q < 4; ++q) {
      const int c = lane * 4 + q * 256;
      float4 xo = xr[q], gv = *(const float4*)(gpf + c), gt = *(const float4*)(mod + 5120 + c);
      xo.x += gt.x * s[q * 4] * rs * gv.x; xo.y += gt.y * s[q * 4 + 1] * rs * gv.y; xo.z += gt.z * s[q * 4 + 2] * rs * gv.z; xo.w += gt.w * s[q * 4 + 3] * rs * gv.w;
      *(float4*)(dst + c) = xo;
      xv[q * 4] = xo.x; xv[q * 4 + 1] = xo.y; xv[q * 4 + 2] = xo.z; xv[q * 4 + 3] = xo.w;
    }
    if (!L.last) {
      const float* mod1 = (const float*)(p.ws + OFF_MOD) + ((size_t)(L.l + 1) * NB1 + tok_modrow(tok)) * 6144;
      normmod_row(xv, p.in[I_GPREMIX] + (L.l + 1) * 1024, mod1, mod1 + 1024, (bf16*)(p.ws + OFF_HA) + (size_t)tok * 1024, h);
    }
    if (!has) break;
    i = inext; tok = tokn;
#pragma unroll
    for (int q = 0; q < 4; ++q) { sel[q] = seln[q]; xr[q] = xn[q]; }
  }
}

enum { PH_PREP0 = 0, PH_PREP1, PH_L0 };
enum { LP_INPROJ = 0, LP_TOKPREP, LP_MIX1, LP_MIX2, LP_GLU, LP_MERGE, LP_OUT, LP_POST, LP_ROUTE, LP_MOE1, LP_MOE2, LP_COMB, LP_COUNT };
constexpr int NPHASES = PH_L0 + DEPTH * LP_COUNT;


DI void run_phase(const Params& p, int ph, char* smem) {
  const int G = gridDim.x;
  int start = blockIdx.x;
  auto seg = [&](int n, auto&& fn) {
    for (; start < n; start += G) fn(start);
    start -= n;
  };
#ifdef ONLY_PREP
  if (ph >= PH_L0) return;
#endif
  if (ph == PH_PREP0) {
    seg(DEPTH * 96, [&](int it) { mod_item(p, it, smem); });
    seg(DEPTH * 32, [&](int it) { s5_tab_item(p, it, smem); });
    seg(1, [&](int) { rope_tab_item(p); });
    seg(DEPTH * CT_EARLY, [&](int it) { conv_early_item(p, it / CT_EARLY, it % CT_EARLY, smem); });
    return;
  }
  if (ph == PH_PREP1) {
    seg(DEPTH * 256, [&](int it) { s5_mat_item(p, it); });
    seg(NTOK / NWAVES, [&](int it) { prep_row_item(p, it); });
    return;
  }
#ifdef ONLY_LPH
  if (ph < PH_L0) return;
#endif
  const int l = (ph - PH_L0) / LP_COUNT;
#ifdef ONLY_LPH
  const int lph = ONLY_LPH;
#else
  const int lph = (ph - PH_L0) % LP_COUNT;
#endif
  const LP L = make_lp(p, l);
  switch (lph) {
    case LP_INPROJ:
      seg(L.last ? IP_SLOTS_LAST : IP_SLOTS_ALL, [&](int it) { inproj_tile(p, L, it, smem); });
      break;
    case LP_TOKPREP:
      seg(16 * S5_MT * 2, [&](int it) { s5a_tile(p, L, it, smem); });
      seg(TP_MT * 3, [&](int it) { mlaq_tile(p, L, it, smem); });
      seg(TP_MT * 4, [&](int it) { mlakv_tile(p, L, it, smem); });
      seg(NTOK / 64, [&](int it) { navt_item(p, it, smem); });
      seg(M2C_ITEMS, [&](int it) { m2conv_item(p, L, it); });
      seg(M2S_ITEMS, [&](int it) { m2scal_item(p, L, it); });
      break;
    case LP_MIX1: {
      const int n0 = BATCH * 4, n1 = n0 + 2 * 16 * BATCH / NWAVES, n2 = n1 + BATCH * 4 * (SEQ / 256), n3 = n2 + BATCH * 4 * (SEQ / 256);
      const int n4 = n3 + (L.last ? 0 : BATCH * 4 * ((CTXL + 255) / 256)), n5 = n4 + (L.last ? 0 : BATCH * 4 * ((CTXL + 255) / 256));
      int* qhead = (int*)(p.ws + OFF_BAR) + Q_WORD0 + 64 * (l + 2 * p.probe_rep);
#ifdef EMU
      volatile int* bc = (volatile int*)(smem + SMEM_BYTES + 8);
#else
      volatile LAS int* bc = (volatile LAS int*)(smem + SMEM_BYTES + 8);
#endif
      for (;;) {
        __syncthreads();
        if (tid_() == 0) {
#ifdef EMU
          *bc = atomicAdd(qhead, 1);
#else
          *bc = __hip_atomic_fetch_add(qhead, 1, __ATOMIC_RELAXED, __HIP_MEMORY_SCOPE_AGENT);
#endif
        }
        __syncthreads();
        const int it = *bc;
        if (it >= n5) break;
        if (it < n0) m2scan_item(p, L, it, smem);
        else if (it < n1) s5carry_item(p, L, it - n0);
        else if (it < n2) mla_attn_item(p, it - n1, false, smem);
        else if (it < n3) na_attn_item(p, L, it - n2, false, smem);
        else if (it < n4) mla_attn_item(p, it - n3, true, smem);
        else na_attn_item(p, L, it - n4, true, smem);
      }
    } break;
    case LP_MIX2:
      seg(16 * S5_MT * 2, [&](int it) { s5c_tile(p, L, it, smem); });
      seg(NTOK / NWAVES, [&](int it) { m2gate_item(p, L, it); });
      break;
    case LP_GLU:
      seg(GLU_MT * 2, [&](int it) { glu_tile(p, L, it, smem); });
      break;
    case LP_MERGE:
      seg(mtiles(L.last, 256) * 8, [&](int it) { merge_tile(p, L, it, smem); });
      break;
    case LP_OUT:
      seg(mtiles(L.last, 256) * 4, [&](int it) { outproj_tile(p, L, it, smem); });
      break;
    case LP_POST:
      seg(CT_EXP, [&](int it) { conv_expert_item(p, l, it, smem); });
      post_stage_router(p, L, smem);
      post_phase(p, L, smem);
      break;
    case LP_ROUTE:
      seg(BATCH * 16 * (L.last ? 1 : 2), [&](int it) { route_item(p, L, it, smem); });
      break;
    case LP_MOE1:
      seg(NE * (((L.last ? ESLOTS_L : ESLOTS) + 255) / 256) * 8, [&](int it) { moe1_tile(p, L, it, smem); });
      break;
    case LP_MOE2:
      seg(((NE * (((L.last ? ESLOTS_L : ESLOTS) + 255) / 256) + 1) / 2) * 8, [&](int it) { moe2_tile(p, L, it, smem); });
      break;
    case LP_COMB:
      comb_phase(p, L);
      break;
  }
}

__global__ void __launch_bounds__(NTHREADS, 2) mega_kernel(Params p) {
#ifdef EMU
  char* smem = emu_cur_f->blk->smem;
  for (int ph = p.phase_lo; ph < p.phase_hi; ++ph) {
    run_phase(p, ph, smem);
    if (ph + 1 < p.phase_hi) emu_grid_sync();
  }
#else
  __shared__ __attribute__((aligned(16))) char smem[SMEM_BYTES + 16 + 256];
  {
    const unsigned hw = (unsigned)__builtin_amdgcn_s_getreg((5 << 11) | 4) & 0x3fu;
    if ((threadIdx.x & 63) == 0) *(volatile int*)(smem + WAVE_TAB_OFF + hw * 4u) = (int)(threadIdx.x >> 6);
    __syncthreads();
  }
  if (p.phase_hi - p.phase_lo > 1) {
    if (threadIdx.x == 0) *(uint4*)(smem + SMEM_BYTES) = make_uint4(0u, 0u, 0u, 0u);
    __syncthreads();
    XcdBarrier xb = xcd_barrier_post((unsigned*)(p.ws + OFF_BAR), (volatile LAS unsigned*)(smem + SMEM_BYTES));
    for (int ph = p.phase_lo; ph < p.phase_hi; ++ph) {
      int reps = 1;
#ifdef PROBE_PHASE
      if (ph == PROBE_PHASE || ph == PROBE_PHASE2) reps = 1 + PROBE_REP;
#endif
      for (int rep = 0; rep < reps; ++rep) {
        p.probe_rep = rep;
        run_phase(p, ph, smem);
        if (ph + 1 < p.phase_hi || rep + 1 < reps) {
          if (ph == p.phase_lo && rep == 0) cg::this_grid().sync();
          else xcd_barrier(xb);
        }
      }
    }
  } else {
    run_phase(p, p.phase_lo, smem);
  }
#endif
}

#ifndef EMU
extern "C" void kernel_launch(void* const* d_in, const int* in_sizes, int n_in, void* d_out, int out_size, void* d_ws, size_t ws_size,
                              hipStream_t stream) {
  static int grid_blocks = 0;
  if (!grid_blocks) {
    int dev = 0, cus = 0, per_cu = 0;
    hipGetDevice(&dev);
    hipDeviceGetAttribute(&cus, hipDeviceAttributeMultiprocessorCount, dev);
    hipOccupancyMaxActiveBlocksPerMultiprocessor(&per_cu, mega_kernel, NTHREADS, 0);
    if (per_cu > 1) per_cu = 1;
    if (per_cu < 1) per_cu = 1;
    grid_blocks = cus * per_cu;
    if (ws_size < WS_TOTAL) fprintf(stderr, "workspace too small: %zu < %zu\n", ws_size, (size_t)WS_TOTAL);
  }
  Params p{};
  for (int i = 0; i < N_INPUTS; ++i) p.in[i] = (const float*)d_in[i];
  p.out = (float*)d_out;
  p.ws = (char*)d_ws;
#if MK_MULTI
  for (int ph = 0; ph < NPHASES; ++ph) {
    p.phase_lo = ph; p.phase_hi = ph + 1;
    hipLaunchKernelGGL(mega_kernel, dim3(grid_blocks), dim3(NTHREADS), 0, stream, p);
  }
#else
  p.phase_lo = 0; p.phase_hi = NPHASES;
  hipMemsetAsync((char*)d_ws + OFF_BAR, 0, BAR_BYTES, stream);
  void* args[] = {&p};
  hipError_t e = hipLaunchCooperativeKernel((void*)mega_kernel, dim3(grid_blocks), dim3(NTHREADS), args, 0, stream);
  if (e != hipSuccess) fprintf(stderr, "cooperative launch failed: %s (grid %d)\n", hipGetErrorString(e), grid_blocks);
#endif
}
#endif
```

```cpp
#ifdef EMU
#include "emu.h"
#else
#include <hip/hip_runtime.h>
#include <hip/hip_cooperative_groups.h>
#include <cstdio>
namespace cg = cooperative_groups;
using bf16x8 = __attribute__((ext_vector_type(8))) short;
using f32x4 = __attribute__((ext_vector_type(4))) float;
using f32x16 = __attribute__((ext_vector_type(16))) float;
#endif
using u32x4 = __attribute__((ext_vector_type(4))) unsigned;
#ifndef MK_MULTI
#define MK_MULTI 0
#endif

#define DI __device__ __forceinline__
typedef unsigned short bf16;

#ifdef EMU_SMALL2
constexpr int BATCH = 2, SEQ = 1024, CTXL = 64, GRID_W = 32;
#elif defined(EMU_SMALL)
constexpr int BATCH = 2, SEQ = 512, CTXL = 64, GRID_W = 32;
#else
constexpr int BATCH = 8, SEQ = 2048, CTXL = 256, GRID_W = 64;
#endif
constexpr int D = 1024, DEPTH = 2;
constexpr int TOK = CTXL + SEQ, NTOK = BATCH * TOK;
constexpr int ROWS = SEQ / GRID_W;
constexpr int WIN_R = (ROWS < 8 ? ROWS : 8), WIN_C = 16;
constexpr int N_IN = 6568, N_INP = 6656;
constexpr int C_CQ = 0, C_CKV = 256, C_KR = 384, C_NA = 416, C_S5 = 1184, C_Z = 1440, C_XBC = 1696, C_DT = 2464, C_GATE = 2472;
constexpr int P1W = 2480;
constexpr int NCH = TOK / 16, NCC = CTXL / 16, MCH = BATCH * NCH;
constexpr int NE = 16;
constexpr int CAP_L = 2 * SEQ / NE, CAP_C = 2 * CTXL / NE;
constexpr int ESLOTS = BATCH * (CAP_L + CAP_C), ESLOTS_L = BATCH * CAP_L;
constexpr int NB1 = BATCH + 1;
constexpr float EPS = 1e-6f;
constexpr int SMEM_BYTES = 147456;
constexpr int NTHREADS = 512, NWAVES = NTHREADS / 64;

enum { I_X = 0, I_C, I_CTX, I_CCTX, I_WADA, I_BADA, I_GPREMIX, I_GPOSTMIX, I_GPREFFN, I_GPOSTFFN, I_WIN, I_GCQ, I_GCKV, I_WUQ, I_WUKV, I_RPB,
       I_S5ARE, I_S5AIM, I_S5LOGSTEP, I_S5BRE, I_S5BIM, I_S5CRE, I_S5CIM, I_S5D, I_S5WGLU, I_S5BGLU, I_M2CONVW, I_M2CONVB, I_M2ALOG, I_M2DTBIAS,
       I_M2D, I_M2GNORM, I_WBRANCH, I_WOUT, I_WROUTER, I_WGATE, I_WUP, I_WDOWN, N_INPUTS };

constexpr size_t al256(size_t x) { return (x + 255) & ~(size_t)255; }
constexpr size_t SZ_X = (size_t)NTOK * D * 4;
constexpr size_t SZ_ROWBF = (size_t)NTOK * D * 2;
constexpr size_t OFF_X = 0;
constexpr size_t OFF_MOD = OFF_X + al256(SZ_X);
constexpr size_t OFF_HA = OFF_MOD + al256((size_t)DEPTH * NB1 * 6144 * 4);
constexpr size_t OFF_O = OFF_HA + al256(SZ_ROWBF);
constexpr size_t OFF_P1 = OFF_O + al256(SZ_ROWBF);
constexpr size_t SZ_P1 = (size_t)NTOK * P1W * 2;
constexpr size_t OFF_PG = OFF_P1 + al256(SZ_P1);
constexpr size_t SZ_PG = (size_t)NTOK * 4096 * 2;
constexpr size_t OFF_DT = OFF_PG + al256(SZ_PG);
constexpr size_t OFF_AFF = OFF_DT + al256((size_t)NTOK * 8 * 4);
constexpr size_t OFF_SEL = OFF_AFF + al256((size_t)NTOK * 16 * 4);
constexpr size_t OFF_IDX = OFF_SEL + al256((size_t)NTOK * 16 * 4);
constexpr size_t OFF_GW = OFF_IDX + al256((size_t)NE * ESLOTS * 4);
constexpr size_t OFF_BAR = OFF_GW + al256((size_t)NE * ESLOTS * 4);
constexpr size_t BAR_BYTES = (3456 + 64 * 4) * 4;
constexpr int Q_WORD0 = 3456;
constexpr size_t OFF_ROPE = OFF_BAR + al256(BAR_BYTES);
constexpr size_t OFF_WEARLY = OFF_ROPE + al256(64 * 8 * 2 * 4);
constexpr size_t WE_WIN = 0;
constexpr size_t WE_UQ = WE_WIN + (size_t)N_INP * 1024 * 2;
constexpr size_t WE_UKV = WE_UQ + (size_t)384 * 256 * 2;
constexpr size_t WE_GLU = WE_UKV + (size_t)512 * 128 * 2;
constexpr size_t WE_WB = WE_GLU + (size_t)256 * 256 * 2;
constexpr size_t WE_WOUT = WE_WB + (size_t)4 * 1024 * 256 * 2;
constexpr size_t WE_SIZE = al256(WE_WOUT + (size_t)1024 * 1024 * 2);
constexpr size_t OFF_S5TAB = OFF_WEARLY + DEPTH * WE_SIZE;
constexpr size_t S5_LAMPOW = 0;
constexpr size_t S5_BBAR = S5_LAMPOW + (size_t)2 * 16 * 17 * 64 * 2 * 4;
constexpr size_t S5_KT = S5_BBAR + (size_t)2 * 16 * 64 * 16 * 2 * 4;
constexpr size_t S5_WA = S5_KT + (size_t)2 * 16 * 16 * 256 * 4;
constexpr size_t S5_W2 = S5_WA + (size_t)16 * 256 * 256 * 2;
constexpr size_t S5_SIZE = al256(S5_W2 + (size_t)16 * 256 * 512 * 2);
constexpr size_t OFF_MIX = OFF_S5TAB + DEPTH * S5_SIZE;
constexpr size_t MX_Q = 0;
constexpr size_t MX_K = MX_Q + al256((size_t)BATCH * 4 * TOK * 96 * 2);
constexpr size_t MX_VTM = MX_K + al256((size_t)BATCH * 4 * TOK * 96 * 2);
constexpr size_t MX_VTN = MX_VTM + al256((size_t)BATCH * 4 * 64 * TOK * 2);
constexpr size_t MX_XBC = MX_VTN + al256((size_t)BATCH * 4 * 64 * TOK * 2);
constexpr size_t MX_US5 = MX_XBC + al256((size_t)NTOK * 768 * 2);
constexpr size_t MX_HEND = MX_US5 + al256((size_t)NTOK * 256 * 2);
constexpr size_t MX_HIN = MX_HEND + al256((size_t)16 * MCH * 256 * 4);
constexpr size_t MX_Z = MX_HIN + al256((size_t)16 * MCH * 256 * 2);
constexpr size_t MX_XBT = MX_Z + al256((size_t)NTOK * 256 * 2);
constexpr size_t MX_M2S = MX_XBT + al256((size_t)NTOK * 512 * 2);
constexpr int M2_SPLIT = ((TOK / 64 + 1) / 2) * 64, M2_REST = TOK - M2_SPLIT;
constexpr size_t MX_HM = MX_M2S + al256((size_t)BATCH * 8 * TOK * 4 * 4);
constexpr size_t MX_GT = MX_HM + al256((size_t)BATCH * 4 * 128 * 128 * 2);
constexpr size_t MX_SIZE = MX_GT + al256((size_t)BATCH * 8 * M2_REST * 4);
constexpr size_t WX_GU = 0;
constexpr size_t WX_DN = WX_GU + (size_t)NE * 2048 * 1024 * 2;
constexpr size_t WX_SIZE = WX_DN + (size_t)NE * 1024 * 1024 * 2;
constexpr size_t MIXREG = (MX_SIZE > WX_SIZE ? MX_SIZE : WX_SIZE);
constexpr size_t WS_TOTAL = OFF_MIX + al256(MIXREG);

struct Params {
  const float* in[N_INPUTS];
  float* out;
  char* ws;
  int phase_lo, phase_hi;
  int probe_rep, pad_;
};

constexpr int WAVE_TAB_OFF = SMEM_BYTES + 16;
DI int tid_() {
#ifdef EMU
  return (int)threadIdx.x;
#else
  const unsigned hw = (unsigned)__builtin_amdgcn_s_getreg((5 << 11) | 4) & 0x3fu;
  const int wave = *(volatile __attribute__((address_space(3))) int*)(unsigned long)(WAVE_TAB_OFF + hw * 4u);
  int lane;
  asm volatile("v_mbcnt_lo_u32_b32 %0, -1, 0\n\tv_mbcnt_hi_u32_b32 %0, -1, %0" : "=v"(lane));
  return wave * 64 + lane;
#endif
}
#ifdef EMU
template <class T> DI T shfl_xor_(T v, int m) { return __shfl_xor(v, m); }
template <class T> DI T shfl_up_(T v, int d) { return __shfl_up(v, d); }
template <class T> DI T shfl_(T v, int src) { return __shfl(v, src); }
#else
template <class T> DI T shfl_xor_(T v, int m) {
  const int idx = ((tid_() & 63) ^ m) << 2;
  return __builtin_bit_cast(T, __builtin_amdgcn_ds_bpermute(idx, __builtin_bit_cast(int, v)));
}
template <class T> DI T shfl_up_(T v, int d) {
  const int l = tid_() & 63; const int idx = (l >= d ? l - d : l) << 2;
  return __builtin_bit_cast(T, __builtin_amdgcn_ds_bpermute(idx, __builtin_bit_cast(int, v)));
}
template <class T> DI T shfl_(T v, int src) {
  int idx = src << 2; asm volatile("" : "+v"(idx));
  return __builtin_bit_cast(T, __builtin_amdgcn_ds_bpermute(idx, __builtin_bit_cast(int, v)));
}
#endif
DI float bf2f(bf16 h) { return __uint_as_float(((unsigned)h) << 16); }
#ifdef EMU
DI bf16 f2bf(float f) { unsigned u = __float_as_uint(f); u += 0x7fffu + ((u >> 16) & 1u); return (bf16)(u >> 16); }
DI unsigned pack2(float a, float b) { return (unsigned)f2bf(a) | ((unsigned)f2bf(b) << 16); }
DI float exp2f_(float x) { return exp2f(x); }
#else
typedef float f32x2_t_ __attribute__((ext_vector_type(2)));
typedef __bf16 bf16x2_t_ __attribute__((ext_vector_type(2)));
DI unsigned pack2(float a, float b) { const f32x2_t_ v = {a, b}; return __builtin_bit_cast(unsigned, __builtin_convertvector(v, bf16x2_t_)); }
DI bf16 f2bf(float f) { return (bf16)(pack2(f, 0.f) & 0xffffu); }
DI float exp2f_(float x) { return __builtin_amdgcn_exp2f(x); }
#endif
#ifdef EMU
DI float rcp_(float x) { return 1.0f / x; }
#else
DI float rcp_(float x) { return __builtin_amdgcn_rcpf(x); }
#endif
DI float sigmoidf_(float x) { return rcp_(1.0f + exp2f_(-1.4426950408889634f * x)); }
DI float siluf_(float x) { return x * rcp_(1.0f + exp2f_(-1.4426950408889634f * x)); }
DI float softplusf_(float x) { const float ax = x < 0.f ? -x : x; return (x > 0.f ? x : 0.f) + __logf(1.0f + __expf(-ax)); }
DI float geluf_(float x) { const float u2 = 1.5957691216057308f * (x + 0.044715f * x * x * x); return x * rcp_(1.0f + exp2f_(-1.4426950408889634f * u2)); }
DI bool wave_all_(bool c) {
#ifdef EMU
  int v = c ? 0 : 1;
  v += shfl_xor_(v, 32); v += shfl_xor_(v, 16); v += shfl_xor_(v, 8); v += shfl_xor_(v, 4); v += shfl_xor_(v, 2); v += shfl_xor_(v, 1);
  return v == 0;
#else
  return __builtin_amdgcn_ballot_w64(!c) == 0ull;
#endif
}
DI float wave_sum(float v) {
#ifdef EMU
  v += shfl_xor_(v, 32); v += shfl_xor_(v, 16); v += shfl_xor_(v, 8); v += shfl_xor_(v, 4); v += shfl_xor_(v, 2); v += shfl_xor_(v, 1);
  return v;
#else
  int x = __float_as_int(v);
  x = __float_as_int(__int_as_float(x) + __int_as_float(__builtin_amdgcn_update_dpp(0, x, 0xB1, 0xF, 0xF, true)));
  x = __float_as_int(__int_as_float(x) + __int_as_float(__builtin_amdgcn_update_dpp(0, x, 0x4E, 0xF, 0xF, true)));
  x = __float_as_int(__int_as_float(x) + __int_as_float(__builtin_amdgcn_update_dpp(0, x, 0x141, 0xF, 0xF, true)));
  x = __float_as_int(__int_as_float(x) + __int_as_float(__builtin_amdgcn_update_dpp(0, x, 0x140, 0xF, 0xF, true)));
  const float r0 = __int_as_float(__builtin_amdgcn_readlane(x, 0)), r1 = __int_as_float(__builtin_amdgcn_readlane(x, 16));
  const float r2 = __int_as_float(__builtin_amdgcn_readlane(x, 32)), r3 = __int_as_float(__builtin_amdgcn_readlane(x, 48));
  return (r0 + r1) + (r2 + r3);
#endif
}
#ifndef EMU
#define XB_TMO      128
#define XB_XCNT(j)  (256  + 64 * (j))
#define XB_XSUB(j)  (1280 + 64 * (j))
#define XB_XGEN(j)  (2304 + 64 * (j))
#define XB_TOP      3328
#define XB_TOPGEN   3392
#define XB_SPIN_CAP (1u << 24)
#define LAS __attribute__((address_space(3)))
DI unsigned xb_ld(unsigned* p) { return __hip_atomic_load(p, __ATOMIC_RELAXED, __HIP_MEMORY_SCOPE_AGENT); }
DI unsigned xb_add(unsigned* p, unsigned v) { return __hip_atomic_fetch_add(p, v, __ATOMIC_RELAXED, __HIP_MEMORY_SCOPE_AGENT); }
DI unsigned xb_xcc_id() { return (unsigned)__builtin_amdgcn_s_getreg((3 << 11) | 20) & 0xFu; }
#define XB_SPIN(cond, bar) do { unsigned _sp = 0; while (cond) { __builtin_amdgcn_s_sleep(1); \
    if ((++_sp & 255u) == 0u) { if (xb_ld(&(bar)[XB_TMO])) break; if (_sp > XB_SPIN_CAP) { atomicAdd(&(bar)[XB_TMO], 1u); break; } } } } while (0)
struct XcdBarrier { unsigned* bar; unsigned x; volatile LAS unsigned* st; };
DI XcdBarrier xcd_barrier_post(unsigned* bar, volatile LAS unsigned* st) {
  XcdBarrier b; b.bar = bar; b.x = xb_xcc_id(); b.st = st;
  if (threadIdx.x == 0) (void)xb_add(&bar[XB_XCNT(b.x)], 1u);
  return b;
}
DI void xcd_barrier_complete(unsigned* bar, unsigned x, unsigned& nloc, unsigned& nx) {
  const unsigned G = gridDim.x * gridDim.y * gridDim.z;
  unsigned sum, cnt, mine, sp = 0u;
  for (;;) {
    sum = 0u; cnt = 0u; mine = 0u;
#pragma unroll
    for (unsigned j = 0; j < 16; ++j) { const unsigned c = xb_ld(&bar[XB_XCNT(j)]); sum += c; cnt += (c > 0u) ? 1u : 0u; mine = (j == x) ? c : mine; }
    if (sum == G) break;
    __builtin_amdgcn_s_sleep(1);
    if ((++sp & 255u) == 0u) { if (xb_ld(&bar[XB_TMO])) break; if (sp > XB_SPIN_CAP) { atomicAdd(&bar[XB_TMO], 1u); break; } }
  }
  nloc = mine > 0u ? mine : 1u; nx = cnt > 0u ? cnt : 1u;
}
DI void xcd_barrier(const XcdBarrier& b) {
  asm volatile("s_waitcnt vmcnt(0)" ::: "memory");
  __syncthreads();
  if (threadIdx.x == 0) {
    unsigned* bar = b.bar;
    __builtin_amdgcn_s_waitcnt(0);
    unsigned nloc = b.st[0], nx = b.st[1];
    if (nloc == 0u) { xcd_barrier_complete(bar, b.x, nloc, nx); b.st[0] = nloc; b.st[1] = nx; }
    const unsigned old = xb_add(&bar[XB_XSUB(b.x)], 1u);
    const unsigned gen = old / nloc;
    if (old + 1u == (gen + 1u) * nloc) {
      __builtin_amdgcn_fence(__ATOMIC_RELEASE, "agent");
      asm volatile("s_waitcnt vmcnt(0)" ::: "memory");
      const unsigned og = xb_add(&bar[XB_TOP], 1u);
      const unsigned tg = og / nx;
      if (og + 1u == (tg + 1u) * nx) xb_add(&bar[XB_TOPGEN], 1u);
      else XB_SPIN(xb_ld(&bar[XB_TOPGEN]) == tg, bar);
      __builtin_amdgcn_fence(__ATOMIC_ACQUIRE, "agent");
      xb_add(&bar[XB_XGEN(b.x)], 1u);
      asm volatile("s_waitcnt vmcnt(0)" ::: "memory");
    } else {
      XB_SPIN(xb_ld(&bar[XB_XGEN(b.x)]) == gen, bar);
      __builtin_amdgcn_fence(__ATOMIC_ACQUIRE, "agent");
      asm volatile("s_waitcnt vmcnt(0)" ::: "memory");
    }
  }
  __syncthreads();
}
#endif

struct GA {
  const bf16* A; const bf16* A2; int lda, lda2, ksplit;
  const int* ridx; int mvalid;
  const bf16* Bt; int ldb; int K;
  int kfix;
};
DI GA make_ga(const bf16* A, int lda, const bf16* Bt, int ldb, int K, int mvalid) {
  GA g; g.A = A; g.A2 = A; g.lda = lda; g.lda2 = lda; g.ksplit = K; g.ridx = nullptr; g.mvalid = mvalid; g.Bt = Bt; g.ldb = ldb; g.K = K; g.kfix = 0; return g;
}

#ifdef EMU
#define GLDS16(gptr_, lptr_) memcpy((void*)(lptr_), (const void*)(gptr_), 16)
#define BGLDS16(rsrc_, base_, voff_, soff_, lptr_) memcpy((void*)(lptr_), (const char*)(base_) + (voff_) + (soff_), 16)
#define GEMM_WAIT(N_)
#define RAW_BARRIER() __syncthreads()
#else
#define LASV __attribute__((address_space(3))) void
#define GLDS16(gptr_, lptr_) __builtin_amdgcn_global_load_lds((const void*)(gptr_), (LASV*)(lptr_), 16, 0, 0)
#define BGLDS16(rsrc_, base_, voff_, soff_, lptr_) __builtin_amdgcn_raw_ptr_buffer_load_lds(rsrc_, (LASV*)(lptr_), 16, (int)(voff_), (int)(soff_), 0, 0)
#define GEMM_WAIT(N_) asm volatile("s_waitcnt vmcnt(%0)" :: "n"(N_) : "memory")
#define RAW_BARRIER() { asm volatile("" ::: "memory"); __builtin_amdgcn_s_barrier(); asm volatile("" ::: "memory"); }
#endif
DI int perm32(int rho) { const int n = rho >> 4, i = rho & 15; return 8 * (i >> 2) + 4 * n + (i & 3); }
constexpr int SRS_OFF = 73728;
template <int NT>
DI void gemm_s(const GA& g, int m0, int n0, char* smem, f32x4 (&acc)[4][NT]) {
  constexpr int A_ELEMS = 256 * 32, B_ELEMS = 32 * NT * 32, STAGE = A_ELEMS + B_ELEMS;
  bf16* st = (bf16*)smem;
  const int tid = tid_(), lane = tid & 63, wid = tid >> 6, wr = wid >> 1, wc = wid & 1, fr = lane & 15, fq = lane >> 4;
  const int lrow = tid >> 2, pch = tid & 3;
  long aoff[2], aoff2[2], boff;
#pragma unroll
  for (int i = 0; i < 2; ++i) {
    const int row = lrow + 128 * i;
    const int lch = pch ^ ((-(row >> 2)) & 3);
    int gm = m0 + row; if (gm > g.mvalid - 1) gm = g.mvalid - 1;
    const int ar = g.ridx ? g.ridx[gm] : gm;
    aoff[i] = (long)ar * g.lda + lch * 8;
    aoff2[i] = (long)ar * g.lda2 + lch * 8;
  }
  const int cb = (NT == 4) ? tid : (tid & 255);
  {
    const int row = cb >> 2;
    const int lch = pch ^ ((-(row >> 2)) & 3);
    const int src = n0 + (row & ~31) + perm32(row & 31);
    boff = (long)src * g.ldb + lch * 8;
  }
#pragma unroll
  for (int m = 0; m < 4; ++m)
#pragma unroll
    for (int n = 0; n < NT; ++n) acc[m][n] = f32x4{0.f, 0.f, 0.f, 0.f};
  const int T = g.K / 32;
#define GEMM_DMA(t_, stg_) { const int k0_ = (t_) * 32; const bool seg2_ = (k0_ >= g.ksplit); bf16* sa_ = st + (stg_) * STAGE; \
    _Pragma("unroll") for (int i_ = 0; i_ < 2; ++i_) { \
      const bf16* ap_ = seg2_ ? (g.A2 + aoff2[i_] + (k0_ - g.ksplit)) : (g.A + aoff[i_] + k0_); \
      GLDS16(ap_, sa_ + (tid + i_ * 512) * 8); } \
    GLDS16(g.Bt + boff + k0_, sa_ + A_ELEMS + cb * 8); }
  __syncthreads();
  GEMM_DMA(0, 0)
  if (T > 1) GEMM_DMA(1, 1)
  int s_cur = 0, s_nxt = 2;
#pragma unroll 1
  for (int t = 0; t < T; ++t) {
    if (t + 1 < T) { GEMM_WAIT(3); } else { GEMM_WAIT(0); }
    RAW_BARRIER();
    if (t + 2 < T) GEMM_DMA(t + 2, s_nxt)
    const bf16* sa = st + s_cur * STAGE;
    const bf16* sb = sa + A_ELEMS;
    bf16x8 af[4], bfr[NT];
#pragma unroll
    for (int n = 0; n < NT; ++n) {
      const int row = wc * (16 * NT) + n * 16 + fr;
      bfr[n] = *(const bf16x8*)(sb + row * 32 + ((fq ^ ((-(row >> 2)) & 3)) << 3));
    }
#pragma unroll
    for (int m = 0; m < 4; ++m) {
      const int row = wr * 64 + m * 16 + fr;
      af[m] = *(const bf16x8*)(sa + row * 32 + ((fq ^ ((-(row >> 2)) & 3)) << 3));
    }
#pragma unroll
    for (int m = 0; m < 4; ++m)
#pragma unroll
      for (int n = 0; n < NT; ++n) acc[m][n] = __builtin_amdgcn_mfma_f32_16x16x32_bf16(bfr[n], af[m], acc[m][n], 0, 0, 0);
    s_cur = (s_cur == 2) ? 0 : s_cur + 1;
    s_nxt = (s_nxt == 2) ? 0 : s_nxt + 1;
  }
}
constexpr int BG_HT = 128 * 64;
DI int lds_byte(int r, int c) { const int stt = (r >> 4) * 2 + (c >> 5), rr = r & 15, cc = c & 31, ob = rr * 64 + cc * 2; return stt * 1024 + (ob ^ (((ob >> 9) & 1) << 5)); }
DI void stage_rc(int b, int& R, int& C) { const int stt = b / 1024, sb = b % 1024, swz = sb ^ (((sb >> 9) & 1) << 5); R = (stt >> 1) * 16 + swz / 64; C = (stt & 1) * 32 + (swz % 64) / 2; }
#ifdef EMU
#define BG_WAIT_V(n)
#define BG_WAIT_L(n)
#define BG_BAR __syncthreads()
#define BG_SCHED
#define BG_PRIO(x)
#else
#define BG_WAIT_V(n) asm volatile("s_waitcnt vmcnt(" #n ")" ::: "memory")
#define BG_WAIT_L(n) asm volatile("s_waitcnt lgkmcnt(" #n ")" ::: "memory")
#define BG_BAR __builtin_amdgcn_s_barrier()
#define BG_SCHED __builtin_amdgcn_sched_barrier(0)
#define BG_PRIO(x) __builtin_amdgcn_s_setprio(x)
#endif
DI void gemm_big(const GA& g, int m0, int n0, char* smem, f32x4 (&acc)[2][2][4][2]) {
  bf16* shm = (bf16*)smem;
  const int tid = tid_(), wid = tid >> 6, lane = tid & 63, wr = wid >> 2, wc = wid & 3, fr = lane & 15, fq = lane >> 4;
  unsigned aof[2][2], bof[2];
#ifdef EMU
  const int dma_lds = tid * 16;
#else
  const int dma_lds = __builtin_amdgcn_readfirstlane(tid >> 6) * 1024;
#endif
#ifndef EMU
  const __amdgpu_buffer_rsrc_t rsA = __builtin_amdgcn_make_buffer_rsrc((void*)g.A, 0, 0x7fffffff, 0x00020000);
  const __amdgpu_buffer_rsrc_t rsB = __builtin_amdgcn_make_buffer_rsrc((void*)g.Bt, 0, 0x7fffffff, 0x00020000);
#endif
#pragma unroll
  for (int i = 0; i < 2; ++i) {
    int R, C; stage_rc(tid * 16 + i * 8192, R, C);
    bof[i] = (unsigned)((n0 + (R & ~31) + perm32(R & 31)) * g.ldb + C) * 2u;
#pragma unroll
    for (int h = 0; h < 2; ++h) {
      int gm = m0 + h * 128 + R; if (gm > g.mvalid - 1) gm = g.mvalid - 1;
      const int ar = g.ridx ? g.ridx[gm] : gm;
      aof[h][i] = (unsigned)(ar * g.lda + C) * 2u;
    }
  }
#define BG_SA(b, h) (shm + ((b) * 2 + (h)) * BG_HT)
#define BG_SB(b, h) (shm + (4 + (b) * 2 + (h)) * BG_HT)
#define BG_STAGE_A(P, h, kt) { \
    _Pragma("unroll") for (int i_ = 0; i_ < 2; ++i_) BGLDS16(rsA, g.A, aof[h][i_], (kt) * 128, (char*)(P) + dma_lds + i_ * 8192); }
#define BG_STAGE_B(P, h, kt) { \
    _Pragma("unroll") for (int i_ = 0; i_ < 2; ++i_) BGLDS16(rsB, g.Bt, bof[i_], (kt) * 128 + (h) * 256 * g.ldb, (char*)(P) + dma_lds + i_ * 8192); }
#define BG_LDA(dst, b, h) _Pragma("unroll") for (int m_ = 0; m_ < 4; ++m_) _Pragma("unroll") for (int k_ = 0; k_ < 2; ++k_) \
    dst[m_][k_] = *(const bf16x8*)((const char*)BG_SA(b, h) + lds_byte(wr * 64 + m_ * 16 + fr, k_ * 32 + fq * 8))
#define BG_LDB(dst, b, h) _Pragma("unroll") for (int n_ = 0; n_ < 2; ++n_) _Pragma("unroll") for (int k_ = 0; k_ < 2; ++k_) \
    dst[n_][k_] = *(const bf16x8*)((const char*)BG_SB(b, h) + lds_byte(wc * 32 + n_ * 16 + fr, k_ * 32 + fq * 8))
#define BG_MMA(ai, bj, At_, Bt_) { BG_PRIO(1); \
    _Pragma("unroll") for (int m_ = 0; m_ < 4; ++m_) _Pragma("unroll") for (int n_ = 0; n_ < 2; ++n_) _Pragma("unroll") for (int k_ = 0; k_ < 2; ++k_) \
      acc[ai][bj][m_][n_] = __builtin_amdgcn_mfma_f32_16x16x32_bf16(Bt_[n_][k_], At_[m_][k_], acc[ai][bj][m_][n_], 0, 0, 0); \
    BG_PRIO(0); }
#pragma unroll
  for (int a_ = 0; a_ < 2; ++a_)
#pragma unroll
    for (int b_ = 0; b_ < 2; ++b_)
#pragma unroll
      for (int m_ = 0; m_ < 4; ++m_)
#pragma unroll
        for (int n_ = 0; n_ < 2; ++n_) acc[a_][b_][m_][n_] = f32x4{0.f, 0.f, 0.f, 0.f};
  bf16x8 At[4][2], B0[2][2], B1[2][2];
  const int nt = g.K / 64;
  __syncthreads();
  BG_STAGE_B(BG_SB(0, 0), 0, 0) BG_STAGE_A(BG_SA(0, 0), 0, 0)
  BG_STAGE_B(BG_SB(0, 1), 1, 0) BG_STAGE_A(BG_SA(0, 1), 1, 0)
  if (wr == 1) BG_BAR;
  BG_WAIT_V(4); BG_BAR;
  BG_STAGE_B(BG_SB(1, 0), 0, 1) BG_STAGE_A(BG_SA(1, 0), 0, 1) BG_STAGE_B(BG_SB(1, 1), 1, 1)
  BG_WAIT_V(6); BG_BAR;
#pragma unroll 1
  for (int t = 0; t < nt - 2; t += 2) {
    BG_LDB(B0, 0, 0); BG_SCHED; BG_LDA(At, 0, 0); BG_STAGE_A(BG_SA(1, 1), 1, t + 1)
    BG_WAIT_L(8); BG_BAR; BG_WAIT_L(0); BG_MMA(0, 0, At, B0) BG_BAR; BG_SCHED;
    BG_LDB(B1, 0, 1); BG_STAGE_B(BG_SB(0, 0), 0, t + 2)
    BG_BAR; BG_WAIT_L(0); BG_MMA(0, 1, At, B1) BG_BAR;
    BG_LDA(At, 0, 1); BG_STAGE_A(BG_SA(0, 0), 0, t + 2)
    BG_BAR; BG_WAIT_L(0); BG_MMA(1, 0, At, B0) BG_BAR; BG_SCHED;
    BG_STAGE_B(BG_SB(0, 1), 1, t + 2)
    BG_WAIT_V(6); BG_BAR; BG_MMA(1, 1, At, B1) BG_BAR;
    BG_LDB(B0, 1, 0); BG_SCHED; BG_LDA(At, 1, 0); BG_STAGE_A(BG_SA(0, 1), 1, t + 2)
    BG_WAIT_L(8); BG_BAR; BG_WAIT_L(0); BG_MMA(0, 0, At, B0) BG_BAR; BG_SCHED;
    BG_LDB(B1, 1, 1); BG_STAGE_B(BG_SB(1, 0), 0, t + 3)
    BG_BAR; BG_WAIT_L(0); BG_MMA(0, 1, At, B1) BG_BAR;
    BG_LDA(At, 1, 1); BG_STAGE_A(BG_SA(1, 0), 0, t + 3)
    BG_BAR; BG_WAIT_L(0); BG_MMA(1, 0, At, B0) BG_BAR; BG_SCHED;
    BG_STAGE_B(BG_SB(1, 1), 1, t + 3)
    BG_WAIT_V(6); BG_BAR; BG_MMA(1, 1, At, B1) BG_BAR;
  }
  { BG_LDB(B0, 0, 0); BG_LDA(At, 0, 0); BG_STAGE_A(BG_SA(1, 1), 1, nt - 1)
    BG_BAR; BG_WAIT_L(0); BG_MMA(0, 0, At, B0) BG_BAR;
    BG_LDB(B1, 0, 1); BG_BAR; BG_WAIT_L(0); BG_MMA(0, 1, At, B1) BG_BAR;
    BG_LDA(At, 0, 1); BG_WAIT_V(4); BG_BAR; BG_WAIT_L(0); BG_MMA(1, 0, At, B0) BG_MMA(1, 1, At, B1) BG_BAR; }
  { BG_LDB(B0, 1, 0); BG_LDA(At, 1, 0); BG_WAIT_V(2); BG_BAR; BG_WAIT_L(0); BG_MMA(0, 0, At, B0) BG_BAR;
    BG_LDB(B1, 1, 1); BG_WAIT_V(0); BG_BAR; BG_WAIT_L(0); BG_MMA(0, 1, At, B1) BG_BAR;
    BG_LDA(At, 1, 1); BG_BAR; BG_WAIT_L(0); BG_MMA(1, 0, At, B0) BG_MMA(1, 1, At, B1) BG_BAR; }
  if (wr == 0) BG_BAR;
}
#define EPIB_BEGIN(acc_, m0_, n0_, mvalid_) { const int _l = tid_() & 63, _w = tid_() >> 6, _wr = _w >> 2, _wc = _w & 3, _fr = _l & 15, _fq = _l >> 4; \
  _Pragma("unroll") for (int _ai = 0; _ai < 2; ++_ai) _Pragma("unroll") for (int _m = 0; _m < 4; ++_m) { const int row = (m0_) + _ai * 128 + _wr * 64 + _m * 16 + _fr; \
  _Pragma("unroll") for (int _bj = 0; _bj < 2; ++_bj) { const int col = (n0_) + _bj * 128 + _wc * 32 + 8 * _fq; (void)col; \
    float v[8] = {acc_[_ai][_bj][_m][0][0], acc_[_ai][_bj][_m][0][1], acc_[_ai][_bj][_m][0][2], acc_[_ai][_bj][_m][0][3], \
                  acc_[_ai][_bj][_m][1][0], acc_[_ai][_bj][_m][1][1], acc_[_ai][_bj][_m][1][2], acc_[_ai][_bj][_m][1][3]}; \
    if (row < (mvalid_)) {
#define EPIB_END }}}}

DI void ld8bf(const bf16* p, float (&v)[8]) {
  uint4 w = *(const uint4*)p;
  v[0] = __uint_as_float(w.x << 16); v[1] = __uint_as_float(w.x & 0xffff0000u); v[2] = __uint_as_float(w.y << 16); v[3] = __uint_as_float(w.y & 0xffff0000u);
  v[4] = __uint_as_float(w.z << 16); v[5] = __uint_as_float(w.z & 0xffff0000u); v[6] = __uint_as_float(w.w << 16); v[7] = __uint_as_float(w.w & 0xffff0000u);
}
DI void st8bf(bf16* p, const float (&v)[8]) { *(uint4*)p = make_uint4(pack2(v[0], v[1]), pack2(v[2], v[3]), pack2(v[4], v[5]), pack2(v[6], v[7])); }
DI void st8f(float* p, const float (&v)[8]) { *(float4*)p = make_float4(v[0], v[1], v[2], v[3]); *(float4*)(p + 4) = make_float4(v[4], v[5], v[6], v[7]); }
#define EPI_BEGIN(NT_, acc_, m0_, n0_, mvalid_) { const int _l = tid_() & 63, _w = tid_() >> 6, _wr = _w >> 1, _wc = _w & 1, _fr = _l & 15, _fq = _l >> 4; \
  _Pragma("unroll") for (int _m = 0; _m < 4; ++_m) { const int row = (m0_) + _wr * 64 + _m * 16 + _fr; \
  _Pragma("unroll") for (int _q = 0; _q < (NT_) / 2; ++_q) { const int col = (n0_) + _wc * (16 * (NT_)) + _q * 32 + 8 * _fq; (void)col; \
    float v[8] = {acc_[_m][2 * _q][0], acc_[_m][2 * _q][1], acc_[_m][2 * _q][2], acc_[_m][2 * _q][3], \
                  acc_[_m][2 * _q + 1][0], acc_[_m][2 * _q + 1][1], acc_[_m][2 * _q + 1][2], acc_[_m][2 * _q + 1][3]}; \
    if (row < (mvalid_)) {
#define EPI_END }}}}

DI int mtile_row0(int mt, bool latonly, int TH) {
  if (!latonly) return mt * TH;
  const int per = SEQ / TH, b = mt / per, r = mt % per;
  return b * TOK + CTXL + r * TH;
}
DI int mtiles(bool latonly, int TH) { return latonly ? BATCH * (SEQ / TH) : (NTOK + TH - 1) / TH; }

struct LP {
  int l; bool last;
  const float* mod;
  char* we;
  char* s5;
};
DI LP make_lp(const Params& p, int l) {
  LP q; q.l = l; q.last = (l == DEPTH - 1);
  q.mod = (const float*)(p.ws + OFF_MOD) + (size_t)l * NB1 * 6144;
  q.we = p.ws + OFF_WEARLY + (size_t)l * WE_SIZE;
  q.s5 = p.ws + OFF_S5TAB + (size_t)l * S5_SIZE;
  return q;
}

template <class RowMap>
DI void conv_tile(const float* src, int lds, int nsrc, const float* kscale, bf16* dst, int K, int k0, int n0, char* smem, RowMap rowmap, int ndst = 1 << 30) {
  (void)smem;
  const int tid = tid_(), n4 = (tid & 63) * 4, k8 = (tid >> 6) * 8;
  float4 v[8];
  const bool ok = (n0 + n4 < nsrc);
  const float* sp = src + (size_t)(k0 + k8) * lds + n0 + n4;
#pragma unroll
  for (int k = 0; k < 8; ++k) v[k] = ok ? *(const float4*)(sp + (size_t)k * lds) : make_float4(0.f, 0.f, 0.f, 0.f);
  if (kscale) {
#pragma unroll
    for (int k = 0; k < 8; ++k) { const float sc = kscale[k0 + k8 + k]; v[k].x *= sc; v[k].y *= sc; v[k].z *= sc; v[k].w *= sc; }
  }
  float o[8];
#pragma unroll
  for (int k = 0; k < 8; ++k) o[k] = v[k].x;
  if (n0 + n4 + 0 < ndst) st8bf(dst + (size_t)rowmap(n0 + n4 + 0) * K + k0 + k8, o);
#pragma unroll
  for (int k = 0; k < 8; ++k) o[k] = v[k].y;
  if (n0 + n4 + 1 < ndst) st8bf(dst + (size_t)rowmap(n0 + n4 + 1) * K + k0 + k8, o);
#pragma unroll
  for (int k = 0; k < 8; ++k) o[k] = v[k].z;
  if (n0 + n4 + 2 < ndst) st8bf(dst + (size_t)rowmap(n0 + n4 + 2) * K + k0 + k8, o);
#pragma unroll
  for (int k = 0; k < 8; ++k) o[k] = v[k].w;
  if (n0 + n4 + 3 < ndst) st8bf(dst + (size_t)rowmap(n0 + n4 + 3) * K + k0 + k8, o);
}
struct RowId { DI int operator()(int n) const { return n; } };
struct RowGU { int half; DI int operator()(int f) const { return (f >> 7) * 256 + half * 128 + (f & 127); } };

constexpr int CT_WIN = 16 * (N_INP / 256), CT_UQ = 4 * 2, CT_UKV = 2 * 2, CT_GLU = 4, CT_WB = 4 * 16, CT_WOUT = 64;
constexpr int CT_EARLY = CT_WIN + CT_UQ + CT_UKV + CT_GLU + CT_WB + CT_WOUT;
constexpr int CT_EXP = NE * 3 * 64;

DI void conv_early_item(const Params& p, int l, int it, char* smem) {
  char* we = p.ws + OFF_WEARLY + (size_t)l * WE_SIZE;
  if (it < CT_WIN) {
    int kt = it % 16, nt = it / 16;
    conv_tile(p.in[I_WIN] + (size_t)l * 1024 * N_IN, N_IN, N_IN, nullptr, (bf16*)(we + WE_WIN), 1024, kt * 64, nt * 256, smem, RowId());
    return;
  }
  it -= CT_WIN;
  if (it < CT_UQ) {
    int kt = it % 4, nt = it / 4;
    conv_tile(p.in[I_WUQ] + (size_t)l * 256 * 384, 384, 384, p.in[I_GCQ] + l * 256, (bf16*)(we + WE_UQ), 256, kt * 64, nt * 256, smem, RowId(), 384);
    return;
  }
  it -= CT_UQ;
  if (it < CT_UKV) {
    int kt = it % 2, nt = it / 2;
    conv_tile(p.in[I_WUKV] + (size_t)l * 128 * 512, 512, 512, p.in[I_GCKV] + l * 128, (bf16*)(we + WE_UKV), 128, kt * 64, nt * 256, smem, RowId());
    return;
  }
  it -= CT_UKV;
  if (it < CT_GLU) {
    int kt = it;
    conv_tile(p.in[I_S5WGLU] + (size_t)l * 256 * 256, 256, 256, nullptr, (bf16*)(we + WE_GLU), 256, kt * 64, 0, smem, RowId());
    return;
  }
  it -= CT_GLU;
  if (it < CT_WB) {
    int j = it / 16, r = it % 16, kt = r % 4, nt = r / 4;
    conv_tile(p.in[I_WBRANCH] + ((size_t)l * 4 + j) * 256 * 1024, 1024, 1024, nullptr, (bf16*)(we + WE_WB) + (size_t)j * 1024 * 256, 256, kt * 64, nt * 256, smem, RowId());
    return;
  }
  it -= CT_WB;
  {
    int kt = it % 16, nt = it / 16;
    conv_tile(p.in[I_WOUT] + (size_t)l * 1024 * 1024, 1024, 1024, nullptr, (bf16*)(we + WE_WOUT), 1024, kt * 64, nt * 256, smem, RowId());
  }
}
DI void conv_expert_item(const Params& p, int l, int it, char* smem) {
  char* wx = p.ws + OFF_MIX;
  int e = it / 192, r = it % 192, which = r / 64, t = r % 64, kt = t % 16, nt = t / 16;
  size_t eoff = ((size_t)l * NE + e) * 1024 * 1024;
  if (which == 0) { RowGU rm; rm.half = 0; conv_tile(p.in[I_WGATE] + eoff, 1024, 1024, nullptr, (bf16*)(wx + WX_GU) + (size_t)e * 2048 * 1024, 1024, kt * 64, nt * 256, smem, rm); }
  else if (which == 1) { RowGU rm; rm.half = 1; conv_tile(p.in[I_WUP] + eoff, 1024, 1024, nullptr, (bf16*)(wx + WX_GU) + (size_t)e * 2048 * 1024, 1024, kt * 64, nt * 256, smem, rm); }
  else conv_tile(p.in[I_WDOWN] + eoff, 1024, 1024, nullptr, (bf16*)(wx + WX_DN) + (size_t)e * 1024 * 1024, 1024, kt * 64, nt * 256, smem, RowId());
}

DI void mod_item(const Params& p, int it, char* smem) {
  const int l = it / 96, cg0 = (it % 96) * 64;
  float* sc = (float*)smem;
  float* red = sc + NB1 * 1024;
  const int tid = tid_();
  __syncthreads();
  for (int i = tid; i < NB1 * 1024; i += NTHREADS) {
    int r = i >> 10, k = i & 1023;
    float c = (r < BATCH) ? p.in[I_C][r * 1024 + k] : p.in[I_CCTX][k];
    sc[i] = siluf_(c);
  }
  __syncthreads();
  const int cl = tid & 63, kg = tid >> 6;
  float acc[NB1];
#pragma unroll
  for (int r = 0; r < NB1; ++r) acc[r] = 0.f;
  const float* w = p.in[I_WADA] + (size_t)l * 1024 * 6144 + cg0 + cl;
  for (int k0 = kg * (1024 / NWAVES); k0 < (kg + 1) * (1024 / NWAVES); k0 += 16) {
    float wv[16];
#pragma unroll
    for (int u = 0; u < 16; ++u) wv[u] = w[(size_t)(k0 + u) * 6144];
#pragma unroll
    for (int u = 0; u < 16; ++u)
#pragma unroll
      for (int r = 0; r < NB1; ++r) acc[r] += sc[r * 1024 + k0 + u] * wv[u];
  }
#pragma unroll
  for (int r = 0; r < NB1; ++r) red[(kg * NB1 + r) * 64 + cl] = acc[r];
  __syncthreads();
  for (int i = tid; i < NB1 * 64; i += NTHREADS) {
    int r = i >> 6, c = i & 63;
    float s = 0.f;
#pragma unroll
    for (int q = 0; q < NWAVES; ++q) s += red[(q * NB1 + r) * 64 + c];
    s += p.in[I_BADA][l * 6144 + cg0 + c];
    ((float*)(p.ws + OFF_MOD))[((size_t)l * NB1 + r) * 6144 + cg0 + c] = s;
  }
}

DI void s5_tab_item(const Params& p, int it, char* smem) {
  const int l = it / 32, d = (it / 16) & 1, g = it & 15;
  char* s5 = p.ws + OFF_S5TAB + (size_t)l * S5_SIZE;
  float* lampow = (float*)(s5 + S5_LAMPOW) + (size_t)(d * 16 + g) * 17 * 64 * 2;
  float* bbar = (float*)(s5 + S5_BBAR) + (size_t)(d * 16 + g) * 64 * 16 * 2;
  float* kt = (float*)(s5 + S5_KT) + (size_t)(d * 16 + g) * 16 * 256;
  float* slam = (float*)smem;
  float* sbb = slam + 17 * 64 * 2;
  const int tid = tid_();
  const size_t pg = ((size_t)(l * 2 + d) * 16 + g);
  const float step = expf(p.in[I_S5LOGSTEP][pg]);
  __syncthreads();
  for (int i = tid; i < 17 * 64; i += NTHREADS) {
    int j = i >> 6, pp = i & 63;
    float are = p.in[I_S5ARE][pg * 64 + pp], aim = p.in[I_S5AIM][pg * 64 + pp];
    float mag = expf((float)j * step * are), ang = (float)j * step * aim;
    float re = mag * cosf(ang), im = mag * sinf(ang);
    slam[i * 2] = re; slam[i * 2 + 1] = im; lampow[i * 2] = re; lampow[i * 2 + 1] = im;
  }
  __syncthreads();
  for (int i = tid; i < 64 * 16; i += NTHREADS) {
    int pp = i >> 4;
    float are = p.in[I_S5ARE][pg * 64 + pp], aim = p.in[I_S5AIM][pg * 64 + pp];
    float x = slam[(64 + pp) * 2] - 1.0f, y = slam[(64 + pp) * 2 + 1];
    float den = are * are + aim * aim;
    float qre = (x * are + y * aim) / den, qim = (y * are - x * aim) / den;
    float bre = p.in[I_S5BRE][pg * 1024 + i], bim = p.in[I_S5BIM][pg * 1024 + i];
    float re = qre * bre - qim * bim, im = qre * bim + qim * bre;
    sbb[i * 2] = re; sbb[i * 2 + 1] = im; bbar[i * 2] = re; bbar[i * 2 + 1] = im;
  }
  __syncthreads();
  for (int i = tid; i < 16 * 256; i += NTHREADS) {
    int j = i >> 8, c = (i >> 4) & 15, c2 = i & 15;
    float s = 0.f;
    for (int pp = 0; pp < 64; ++pp) {
      float cre = p.in[I_S5CRE][pg * 1024 + c * 64 + pp], cim = p.in[I_S5CIM][pg * 1024 + c * 64 + pp];
      float lre = slam[(j * 64 + pp) * 2], lim = slam[(j * 64 + pp) * 2 + 1];
      float tre = cre * lre - cim * lim, tim = cre * lim + cim * lre;
      float bre = sbb[(pp * 16 + c2) * 2], bim = sbb[(pp * 16 + c2) * 2 + 1];
      s += tre * bre - tim * bim;
    }
    kt[i] = s;
  }
}
DI void s5_mat_item(const Params& p, int it) {
  const int l = it / 256, g = (it / 16) & 15, q = it & 15;
  char* s5 = p.ws + OFF_S5TAB + (size_t)l * S5_SIZE;
  const float* lampow = (const float*)(s5 + S5_LAMPOW);
  const float* bbar = (const float*)(s5 + S5_BBAR);
  const float* ktab = (const float*)(s5 + S5_KT);
  bf16* WA = (bf16*)(s5 + S5_WA) + (size_t)g * 256 * 256;
  bf16* W2 = (bf16*)(s5 + S5_W2) + (size_t)g * 256 * 512;
  const int tid = tid_();
  for (int i = tid; i < 16 * 256; i += NTHREADS) {
    int n = q * 16 + (i >> 8), k = i & 255;
    int d = n >> 7, ri = (n >> 6) & 1, pp = n & 63, s = k >> 4, c2 = k & 15;
    int e = (d == 0) ? (15 - s) : s;
    const float* lp = lampow + ((size_t)((d * 16 + g) * 17 + e) * 64 + pp) * 2;
    const float* bp = bbar + ((size_t)((d * 16 + g) * 64 + pp) * 16 + c2) * 2;
    float re = lp[0] * bp[0] - lp[1] * bp[1], im = lp[0] * bp[1] + lp[1] * bp[0];
    WA[(size_t)n * 256 + k] = f2bf(ri == 0 ? re : im);
  }
  for (int i = tid; i < 16 * 512; i += NTHREADS) {
    int n = q * 16 + (i >> 9), k = i & 511;
    int lq = n >> 4, c = n & 15;
    float v;
    if (k < 256) {
      int s = k >> 4, c2 = k & 15;
      v = 0.f;
      if (s <= lq) v += ktab[((size_t)(0 * 16 + g) * 16 + (lq - s)) * 256 + c * 16 + c2];
      if (s >= lq) v += ktab[((size_t)(1 * 16 + g) * 16 + (s - lq)) * 256 + c * 16 + c2];
      if (s == lq && c == c2) v += p.in[I_S5D][l * 256 + g * 16 + c];
    } else {
      int kk = k - 256, d = kk >> 7, ri = (kk >> 6) & 1, pp = kk & 63;
      int e = (d == 0) ? (lq + 1) : (16 - lq);
      size_t pg = ((size_t)(l * 2 + d) * 16 + g);
      float cre = p.in[I_S5CRE][pg * 1024 + c * 64 + pp], cim = p.in[I_S5CIM][pg * 1024 + c * 64 + pp];
      const float* lp = lampow + ((size_t)((d * 16 + g) * 17 + e) * 64 + pp) * 2;
      float re = cre * lp[0] - cim * lp[1], im = cre * lp[1] + cim * lp[0];
      v = (ri == 0) ? re : -im;
    }
    W2[(size_t)n * 512 + k] = f2bf(v);
  }
}

DI int tok_b(int tok) { return tok / TOK; }
DI int tok_j(int tok) { return tok % TOK; }
DI int tok_modrow(int tok) { return (tok_j(tok) < CTXL) ? BATCH : tok_b(tok); }

DI void normmod_row(const float (&xv)[16], const float* g, const float* shift, const float* scale, bf16* dst, float (&hout)[16]) {
  const int lane = tid_() & 63;
  float ss = 0.f;
#pragma unroll
  for (int i = 0; i < 16; ++i) ss += xv[i] * xv[i];
  ss = wave_sum(ss);
  const float rs = rsqrtf(ss * (1.0f / 1024.f) + EPS);
#pragma unroll
  for (int i = 0; i < 4; ++i) {
    int c = lane * 4 + i * 256;
    float4 gv = *(const float4*)(g + c), sh = *(const float4*)(shift + c), sc = *(const float4*)(scale + c);
    float h0 = xv[i * 4 + 0] * rs * gv.x * (1.f + sc.x) + sh.x;
    float h1 = xv[i * 4 + 1] * rs * gv.y * (1.f + sc.y) + sh.y;
    float h2 = xv[i * 4 + 2] * rs * gv.z * (1.f + sc.z) + sh.z;
    float h3 = xv[i * 4 + 3] * rs * gv.w * (1.f + sc.w) + sh.w;
    hout[i * 4 + 0] = h0; hout[i * 4 + 1] = h1; hout[i * 4 + 2] = h2; hout[i * 4 + 3] = h3;
    *(uint2*)(dst + c) = make_uint2(pack2(h0, h1), pack2(h2, h3));
  }
}

DI void prep_row_item(const Params& p, int it) {
  const int tok = it * NWAVES + (tid_() >> 6), lane = tid_() & 63;
  const int b = tok_b(tok), j = tok_j(tok);
  const float* src = (j < CTXL) ? p.in[I_CTX] + ((size_t)b * CTXL + j) * 1024 : p.in[I_X] + ((size_t)b * SEQ + (j - CTXL)) * 1024;
  float xv[16], h[16];
#pragma unroll
  for (int i = 0; i < 4; ++i) {
    float4 v = *(const float4*)(src + lane * 4 + i * 256);
    xv[i * 4] = v.x; xv[i * 4 + 1] = v.y; xv[i * 4 + 2] = v.z; xv[i * 4 + 3] = v.w;
  }
  const float* mod = (const float*)(p.ws + OFF_MOD) + (size_t)tok_modrow(tok) * 6144;
  normmod_row(xv, p.in[I_GPREMIX], mod + 0, mod + 1024, (bf16*)(p.ws + OFF_HA) + (size_t)tok * 1024, h);
}

constexpr int IP_LT = BATCH * (SEQ / 256), IP_CT = BATCH * ((CTXL + 255) / 256), IP_MT = IP_LT + IP_CT, IP_NT = N_INP / 256;
constexpr int IP_RR = (IP_MT + 7) / 8, IP_RC = (IP_NT + 1) / 2;
constexpr int IP_RC_NOGATE = (((C_GATE + 255) / 256) + 1) / 2;
constexpr int IP_RR_LAT = IP_LT / 8;
constexpr bool IP_COMPACT = (IP_LT % 8 == 0);
constexpr int IP_RECTS_ALL = IP_RR * IP_RC, IP_RECTS_LAST = IP_COMPACT ? (IP_RR * IP_RC_NOGATE + IP_RR_LAT * (IP_RC - IP_RC_NOGATE)) : IP_RECTS_ALL;
constexpr int IP_SLOTS_ALL = ((IP_RECTS_ALL + 15) / 16) * 256, IP_SLOTS_LAST = ((IP_RECTS_LAST + 15) / 16) * 256;
DI void inproj_tile(const Params& p, const LP& L, int t, char* smem) {
  const int vb = t % 256, vround = t / 256, x = vb % 8, j = vb / 8;
  const int Rc = vround * 16 + x * 2 + (j >> 4), jj = j & 15;
  int rm, rn;
  if (!L.last || !IP_COMPACT || Rc < IP_RR * IP_RC_NOGATE) { rm = Rc % IP_RR; rn = Rc / IP_RR; }
  else { const int q = Rc - IP_RR * IP_RC_NOGATE; rm = q % IP_RR_LAT; rn = IP_RC_NOGATE + q / IP_RR_LAT; }
  const int mt = rm * 8 + (jj & 7), nt = rn * 2 + (jj >> 3);
  if (mt >= IP_MT || nt >= IP_NT || rn >= IP_RC) return;
  int m0;
  if (mt < IP_LT) m0 = (mt / (SEQ / 256)) * TOK + CTXL + (mt % (SEQ / 256)) * 256;
  else { const int c = mt - IP_LT; m0 = (c / ((CTXL + 255) / 256)) * TOK + (c % ((CTXL + 255) / 256)) * 256; }
  const int n0 = nt * 256;
  const int mv = (mt < IP_LT) ? NTOK : (m0 - (m0 % TOK) + CTXL);
  if (L.last && mt >= IP_LT && n0 >= ((C_GATE + 255) / 256) * 256) return;
  GA g = make_ga((const bf16*)(p.ws + OFF_HA), 1024, (const bf16*)(L.we + WE_WIN), 1024, 1024, mv);
  f32x4 acc[2][2][4][2];
  gemm_big(g, m0, n0, smem, acc);
  bf16* P1 = (bf16*)(p.ws + OFF_P1);
  bf16* PG = (bf16*)(p.ws + OFF_PG);
  bf16* US5 = (bf16*)(p.ws + OFF_MIX + MX_US5);
  float* DT = (float*)(p.ws + OFF_DT);
  const float* dtb = p.in[I_M2DTBIAS] + L.l * 8;
  EPIB_BEGIN(acc, m0, n0, mv)
    if (col < C_S5 || (col >= C_Z && col < C_DT)) st8bf(P1 + (size_t)row * P1W + col, v);
    else if (col < C_Z) st8bf(US5 + ((size_t)((col - C_S5) >> 4) * NTOK + row) * 16 + (col & 15), v);
    else if (col < C_GATE) {
#pragma unroll
      for (int k = 0; k < 8; ++k) v[k] = softplusf_(v[k] + dtb[k]);
      st8f(DT + (size_t)row * 8, v);
    } else if (col < N_IN) {
#pragma unroll
      for (int k = 0; k < 8; ++k) v[k] = sigmoidf_(v[k]);
      st8bf(PG + (size_t)row * 4096 + (col - C_GATE), v);
    }
  EPIB_END
}

DI void rowscale_256(const bf16* P1, int m0, int c0, int width, float* srs) {
  const int r = tid_() >> 1, hf = tid_() & 1;
  int gr = m0 + r; if (gr > NTOK - 1) gr = NTOK - 1;
  const bf16* src = P1 + (size_t)gr * P1W + c0 + hf * (width / 2);
  float ss = 0.f;
  for (int i = 0; i < width / 2; i += 8) {
    float v[8]; ld8bf(src + i, v);
#pragma unroll
    for (int k = 0; k < 8; ++k) ss += v[k] * v[k];
  }
  ss += shfl_xor_(ss, 1);
  if (hf == 0) srs[r] = rsqrtf(ss / (float)width + EPS);
}
DI void rope_tab_item(const Params& p) {
  float* tab = (float*)(p.ws + OFF_ROPE);
  for (int i = tid_(); i < 64 * 8; i += NTHREADS) {
    int pos = i >> 3, k = i & 7;
    float f = expf(-(float)k * (9.210340371976184f / 8.0f));
    float a = (float)pos * f;
    tab[i * 2] = cosf(a); tab[i * 2 + 1] = sinf(a);
  }
}
DI void rope_cs(const float* tab, int pos, int i, float& c, float& s) { c = tab[(pos * 8 + i) * 2]; s = tab[(pos * 8 + i) * 2 + 1]; }

constexpr int TP_MT = (NTOK + 255) / 256;
DI void mlaq_tile(const Params& p, const LP& L, int t, char* smem) {
  const int mt = t % TP_MT, nt = t / TP_MT, m0 = mt * 256, n0 = nt * 128;
  const bf16* P1 = (const bf16*)(p.ws + OFF_P1);
  float* srs = (float*)(smem + SRS_OFF);
  GA g = make_ga(P1 + C_CQ, P1W, (const bf16*)(L.we + WE_UQ), 256, 256, NTOK);
  f32x4 acc[4][4];
  gemm_s<4>(g, m0, n0, smem, acc);
  rowscale_256(P1, m0, C_CQ, 256, srs);
  __syncthreads();
  bf16* Q = (bf16*)(p.ws + OFF_MIX + MX_Q);
  const float* ropetab = (const float*)(p.ws + OFF_ROPE);
  {
    const int l = tid_() & 63, w = tid_() >> 6, wr = w >> 1, wc = w & 1, fr = l & 15, fq = l >> 4;
#pragma unroll
    for (int m = 0; m < 4; ++m) {
      const int row = m0 + wr * 64 + m * 16 + fr;
      const int rowc = row < NTOK ? row : NTOK - 1;
      const float rsc = srs[rowc - m0];
      const int b = tok_b(rowc), j = tok_j(rowc);
#pragma unroll
      for (int q = 0; q < 2; ++q) {
        const int col = n0 + wc * 64 + q * 32 + 8 * fq;
        const int h = col / 96, dd = col % 96;
        float v[8] = {acc[m][2 * q][0], acc[m][2 * q][1], acc[m][2 * q][2], acc[m][2 * q][3], acc[m][2 * q + 1][0], acc[m][2 * q + 1][1], acc[m][2 * q + 1][2], acc[m][2 * q + 1][3]};
        float vp[8];
#pragma unroll
        for (int k = 0; k < 8; ++k) vp[k] = shfl_xor_(v[k], 16);
        if (dd >= 64 && j >= CTXL) {
          const int tl = j - CTXL, pos = ((dd - 64) < 16) ? (tl / GRID_W) : (tl % GRID_W);
          const bool lo = ((dd & 8) == 0);
#pragma unroll
          for (int k = 0; k < 8; ++k) {
            float c, sn; rope_cs(ropetab, pos, k, c, sn);
            v[k] = lo ? (v[k] * c - vp[k] * sn) : (v[k] * c + vp[k] * sn);
          }
        }
#pragma unroll
        for (int k = 0; k < 8; ++k) v[k] *= rsc;
        if (row < NTOK) st8bf(Q + (((size_t)b * 4 + h) * TOK + j) * 96 + dd, v);
      }
    }
  }
}
DI void mlakv_tile(const Params& p, const LP& L, int t, char* smem) {
  const int mt = t % TP_MT, h = t / TP_MT, m0 = mt * 256, n0 = h * 128;
  const bf16* P1 = (const bf16*)(p.ws + OFF_P1);
  float* srs = (float*)(smem + SRS_OFF);
  GA g = make_ga(P1 + C_CKV, P1W, (const bf16*)(L.we + WE_UKV), 128, 128, NTOK);
  f32x4 acc[4][4];
  gemm_s<4>(g, m0, n0, smem, acc);
  rowscale_256(P1, m0, C_CKV, 128, srs);
  __syncthreads();
  bf16* K = (bf16*)(p.ws + OFF_MIX + MX_K);
  bf16* VT = (bf16*)(p.ws + OFF_MIX + MX_VTM);
  const float* ropetab = (const float*)(p.ws + OFF_ROPE);
  EPI_BEGIN(4, acc, m0, n0, NTOK)
    const float rsc = srs[row - m0];
    const int b = tok_b(row), j = tok_j(row), dd = col - n0;
#pragma unroll
    for (int k = 0; k < 8; ++k) v[k] *= rsc;
    if (dd < 64) st8bf(K + (((size_t)b * 4 + h) * TOK + j) * 96 + dd, v);
    else {
#pragma unroll
      for (int k = 0; k < 8; ++k) VT[(((size_t)b * 4 + h) * 64 + (dd - 64 + k)) * TOK + j] = f2bf(v[k]);
    }
  EPI_END
  for (int i = tid_(); i < 256 * 16; i += NTHREADS) {
    int r = i >> 4, q = i & 15;
    int row = m0 + r;
    if (row < NTOK) {
      int b = tok_b(row), j = tok_j(row);
      int blk = q >> 3, i8 = q & 7;
      float x1 = bf2f(P1[(size_t)row * P1W + C_KR + blk * 16 + i8]), x2 = bf2f(P1[(size_t)row * P1W + C_KR + blk * 16 + i8 + 8]);
      float o1 = x1, o2 = x2;
      if (j >= CTXL) {
        int tl = j - CTXL, pos = blk == 0 ? (tl / GRID_W) : (tl % GRID_W);
        float c, sn; rope_cs(ropetab, pos, i8, c, sn);
        o1 = x1 * c - x2 * sn; o2 = x2 * c + x1 * sn;
      }
      bf16* kd = K + (((size_t)b * 4 + h) * TOK + j) * 96 + 64 + blk * 16 + i8;
      kd[0] = f2bf(o1); kd[8] = f2bf(o2);
    }
  }
}
DI void navt_item(const Params& p, int it, char* smem) {
  bf16* s = (bf16*)smem;
  const bf16* P1 = (const bf16*)(p.ws + OFF_P1);
  bf16* VT = (bf16*)(p.ws + OFF_MIX + MX_VTN);
  const int tok0 = it * 64, tid = tid_();
  const int b = tok_b(tok0), j0 = tok_j(tok0);
  __syncthreads();
  for (int i = tid; i < 64 * 32; i += NTHREADS) {
    int r = i >> 5, c8 = i & 31;
    *(uint4*)(s + r * 264 + c8 * 8) = *(const uint4*)(P1 + (size_t)(tok0 + r) * P1W + C_NA + 512 + c8 * 8);
  }
  __syncthreads();
  for (int i = tid; i < 256 * 8; i += NTHREADS) {
    int ch = i >> 3, t8 = i & 7;
    unsigned w[4];
#pragma unroll
    for (int q = 0; q < 4; ++q) w[q] = (unsigned)s[(t8 * 8 + 2 * q) * 264 + ch] | ((unsigned)s[(t8 * 8 + 2 * q + 1) * 264 + ch] << 16);
    *(uint4*)(VT + ((size_t)b * 256 + ch) * TOK + j0 + t8 * 8) = make_uint4(w[0], w[1], w[2], w[3]);
  }
}
constexpr int M2C_TOK = 128, M2C_ITEMS = NTOK / M2C_TOK;
DI void m2conv_item(const Params& p, const LP& L, int it) {
  const bf16* P1 = (const bf16*)(p.ws + OFF_P1);
  bf16* XB = (bf16*)(p.ws + OFF_MIX + MX_XBC);
  const int tok0 = it * M2C_TOK;
  const float* cw = p.in[I_M2CONVW] + (size_t)L.l * 4 * 768;
  const float* cb = p.in[I_M2CONVB] + (size_t)L.l * 768;
  for (int task = tid_(); task < 96 * (M2C_TOK / 8); task += NTHREADS) {
    const int cg = task % 96, tb = task / 96, c0 = cg * 8;
    const int tokb = tok0 + tb * 8, jt = tok_j(tokb), base = tokb - jt;
    const int slo = (jt < CTXL) ? 0 : CTXL, shi = (jt < CTXL) ? CTXL : TOK;
    float w[4][8], bias[8];
#pragma unroll
    for (int k = 0; k < 4; ++k) { float4 a = *(const float4*)(cw + k * 768 + c0), b4 = *(const float4*)(cw + k * 768 + c0 + 4);
      w[k][0] = a.x; w[k][1] = a.y; w[k][2] = a.z; w[k][3] = a.w; w[k][4] = b4.x; w[k][5] = b4.y; w[k][6] = b4.z; w[k][7] = b4.w; }
    { float4 a = *(const float4*)(cb + c0), b4 = *(const float4*)(cb + c0 + 4);
      bias[0] = a.x; bias[1] = a.y; bias[2] = a.z; bias[3] = a.w; bias[4] = b4.x; bias[5] = b4.y; bias[6] = b4.z; bias[7] = b4.w; }
    float xin[11][8];
#pragma unroll
    for (int r = 0; r < 11; ++r) {
      const int j = jt - 2 + r;
      if (j >= slo && j < shi) ld8bf(P1 + (size_t)(base + j) * P1W + C_XBC + c0, xin[r]);
      else {
#pragma unroll
        for (int c = 0; c < 8; ++c) xin[r][c] = 0.f;
      }
    }
    float y[8][8];
#pragma unroll
    for (int t = 0; t < 8; ++t) {
#pragma unroll
      for (int c = 0; c < 8; ++c) y[t][c] = siluf_(bias[c] + w[0][c] * xin[t][c] + w[1][c] * xin[t + 1][c] + w[2][c] * xin[t + 2][c] + w[3][c] * xin[t + 3][c]);
      st8bf(XB + (size_t)(base + jt + t) * 768 + c0, y[t]);
    }
    if (c0 < 512) {
      bf16* XT = (bf16*)(p.ws + OFF_MIX + MX_XBT) + ((size_t)(base / TOK) * 512 + c0) * TOK + jt;
#pragma unroll
      for (int c = 0; c < 8; ++c) {
        float col[8];
#pragma unroll
        for (int t = 0; t < 8; ++t) col[t] = y[t][c];
        st8bf(XT + (size_t)c * TOK, col);
      }
    }
  }
}
DI int m2_seq2tok(int sq, int dir) { return (dir == 0) ? sq : (sq < CTXL ? (CTXL - 1 - sq) : (TOK - 1 - (sq - CTXL))); }
constexpr int M2S_ITEMS = BATCH * 8 * (TOK / 64) / NWAVES;
DI void m2scal_item(const Params& p, const LP& L, int it) {
  const int w = it * NWAVES + (tid_() >> 6), lane = tid_() & 63;
  const int ch = w % (TOK / 64), r = w / (TOK / 64), hd = r & 3, dir = (r >> 2) & 1, b = r >> 3;
  const float a = -expf(p.in[I_M2ALOG][(L.l * 2 + dir) * 4 + hd]);
  const int sq = ch * 64 + lane, j = m2_seq2tok(sq, dir);
  const float dt = ((const float*)(p.ws + OFF_DT))[((size_t)b * TOK + j) * 8 + dir * 4 + hd];
  float cs = dt * a;
#pragma unroll
  for (int d = 1; d < 64; d <<= 1) { float o = shfl_up_(cs, d); if (lane >= d) cs += o; }
  const float sl = shfl_(cs, 63);
  float* o = (float*)(p.ws + OFF_MIX + MX_M2S) + ((size_t)((b * 2 + dir) * 4 + hd) * TOK + sq) * 4;
  *(float4*)o = make_float4(cs, dt, dt * __expf(sl - cs), cs * 1.4426950408889634f - log2f(dt));
}
constexpr int S5_MT = (MCH + 255) / 256;
DI void s5a_tile(const Params& p, const LP& L, int t, char* smem) {
  const int g = t / (S5_MT * 2), r = t % (S5_MT * 2), mt = r / 2, nt = r % 2;
  const int m0 = mt * 256, n0 = nt * 128;
  GA ga = make_ga((const bf16*)(p.ws + OFF_MIX + MX_US5) + (size_t)g * NTOK * 16, 256, (const bf16*)(L.s5 + S5_WA) + (size_t)g * 65536, 256, 256, MCH);
  f32x4 acc[4][4];
  gemm_s<4>(ga, m0, n0, smem, acc);
  float* HE = (float*)(p.ws + OFF_MIX + MX_HEND) + (size_t)g * MCH * 256;
  EPI_BEGIN(4, acc, m0, n0, MCH)
    st8f(HE + (size_t)row * 256 + col, v);
  EPI_END
}
DI int s5_chunk_of(int i, int d) { return (d == 0) ? i : (i < NCC ? (NCC - 1 - i) : (NCH - 1 - (i - NCC))); }
DI void s5carry_item(const Params& p, const LP& L, int it) {
  const int w = it * NWAVES + (tid_() >> 6), lane = tid_() & 63;
  const int d = w / (16 * BATCH), g = (w / BATCH) & 15, b = w % BATCH;
  const float* lp = (const float*)(L.s5 + S5_LAMPOW) + ((size_t)((d * 16 + g) * 17 + 16) * 64 + lane) * 2;
  const float lre = lp[0], lim = lp[1];
  const float* HE = (const float*)(p.ws + OFF_MIX + MX_HEND) + ((size_t)g * MCH + (size_t)b * NCH) * 256 + d * 128;
  bf16* HI = (bf16*)(p.ws + OFF_MIX + MX_HIN) + ((size_t)g * MCH + (size_t)b * NCH) * 256 + d * 128;
  float cre = 0.f, cim = 0.f;
  static_assert(NCH % 4 == 0, "chunk count");
  for (int i0 = 0; i0 < NCH; i0 += 4) {
    float hre[4], him[4];
#pragma unroll
    for (int k = 0; k < 4; ++k) { const int ch = s5_chunk_of(i0 + k, d); hre[k] = HE[(size_t)ch * 256 + lane]; him[k] = HE[(size_t)ch * 256 + 64 + lane]; }
#pragma unroll
    for (int k = 0; k < 4; ++k) {
      const int ch = s5_chunk_of(i0 + k, d);
      HI[(size_t)ch * 256 + lane] = f2bf(cre); HI[(size_t)ch * 256 + 64 + lane] = f2bf(cim);
      const float nre = lre * cre - lim * cim + hre[k], nim = lre * cim + lim * cre + him[k];
      cre = nre; cim = nim;
    }
  }
}
DI void s5c_tile(const Params& p, const LP& L, int t, char* smem) {
  const int g = t / (S5_MT * 2), r = t % (S5_MT * 2), mt = r / 2, nt = r % 2;
  const int m0 = mt * 256, n0 = nt * 128;
  GA ga = make_ga((const bf16*)(p.ws + OFF_MIX + MX_US5) + (size_t)g * NTOK * 16, 256, (const bf16*)(L.s5 + S5_W2) + (size_t)g * 256 * 512, 512, 512, MCH);
  ga.A2 = (const bf16*)(p.ws + OFF_MIX + MX_HIN) + (size_t)g * MCH * 256; ga.lda2 = 256; ga.ksplit = 256;
  f32x4 acc[4][4];
  gemm_s<4>(ga, m0, n0, smem, acc);
  bf16* Z = (bf16*)(p.ws + OFF_MIX + MX_Z);
  EPI_BEGIN(4, acc, m0, n0, MCH)
#pragma unroll
    for (int k = 0; k < 8; ++k) v[k] = geluf_(v[k]);
    st8bf(Z + ((size_t)row * 16 + (col >> 4)) * 256 + g * 16 + (col & 15), v);
  EPI_END
}

#ifdef EMU
DI float fmax_(float a, float b) { return a > b ? a : b; }
#else
DI float fmax_(float a, float b) { return __builtin_fmaxf(a, b); }
#endif
constexpr int AT_LDV = 76;
struct NaInfo { int r, qc, rs, cs; };
template <int DK, bool NA>
DI void attn_block(const bf16* qrow, bool active, const bf16* Kp, int kstride, const bf16* Vt,
                   int ka0, int ntile_a, int arow0, int kb0, int ntile_b,
                   const float* srpb, NaInfo ni, float scale, bf16* orow, char* smem) {
  constexpr int LDK = DK + 8, KCH = DK / 8;
  constexpr int KT_BYTES = 64 * LDK * 2, VT_BYTES = 64 * AT_LDV * 2;
  constexpr int NKL = (64 * KCH + NTHREADS - 1) / NTHREADS;
  const int tid = tid_(), lane = tid & 63, half = lane >> 5, r = lane & 31;
  bf16* sK = (bf16*)smem;
  bf16* sV = (bf16*)(smem + 2 * KT_BYTES);
  bf16x8 qf[DK / 16];
  f32x16 o0, o1;
  float m = -1e30f, l = 0.f;
  const float scale2 = scale * 1.4426950408889634f;
#pragma unroll
  for (int ks = 0; ks < DK / 16; ++ks) qf[ks] = active ? *(const bf16x8*)(qrow + ks * 16 + 8 * half) : bf16x8{0, 0, 0, 0, 0, 0, 0, 0};
#pragma unroll
  for (int i = 0; i < 16; ++i) { o0[i] = 0.f; o1[i] = 0.f; }
  const int NTL = ntile_a + ntile_b;
  u32x4 rk[NKL], rv[1];
#pragma unroll
  for (int i = 0; i < NKL; ++i) rk[i] = u32x4{0u, 0u, 0u, 0u};
  auto key0_of = [&](int t) { return t < ntile_a ? ka0 + 64 * t : kb0 + 64 * (t - ntile_a); };
#define AT_GLOAD(t_) { const int k0_ = key0_of(t_); \
    _Pragma("unroll") for (int i_ = 0; i_ < NKL; ++i_) { const int c_ = tid + i_ * NTHREADS; const int key_ = c_ / KCH, ch_ = c_ % KCH; \
      if (c_ < 64 * KCH) rk[i_] = *(const u32x4*)(Kp + (size_t)(k0_ + key_) * kstride + ch_ * 8); } \
    { const int d_ = tid >> 3, ch_ = tid & 7; rv[0] = *(const u32x4*)(Vt + (size_t)d_ * TOK + k0_ + ch_ * 8); } }
#define AT_SSTORE(buf_) { \
    _Pragma("unroll") for (int i_ = 0; i_ < NKL; ++i_) { const int c_ = tid + i_ * NTHREADS; const int key_ = c_ / KCH, ch_ = c_ % KCH; \
      if (c_ < 64 * KCH) *(u32x4*)(sK + (buf_) * (64 * LDK) + key_ * LDK + ch_ * 8) = rk[i_]; } \
    { const int d_ = tid >> 3, ch_ = tid & 7; \
      bf16* dst_ = sV + (buf_) * (64 * AT_LDV) + d_ * AT_LDV + ch_ * 8; \
      *(uint2*)dst_ = make_uint2(rv[0][0], rv[0][1]); *(uint2*)(dst_ + 4) = make_uint2(rv[0][2], rv[0][3]); } }
  __syncthreads();
  AT_GLOAD(0) AT_SSTORE(0)
  __syncthreads();
#pragma unroll 1
  for (int t = 0; t < NTL; ++t) {
    const int buf = t & 1;
    if (t + 1 < NTL) AT_GLOAD(t + 1)
    bool doit = active;
    int trow0 = 0;
    if (NA && t < ntile_a) {
      trow0 = arow0 + t * (64 / GRID_W);
      doit = active && (trow0 + (64 / GRID_W) > ni.rs) && (trow0 < ni.rs + WIN_R);
    }
    if (doit) {
      const bf16* kb = sK + buf * (64 * LDK);
      const bf16* vb = sV + buf * (64 * AT_LDV);
      f32x16 s0, s1;
#pragma unroll
      for (int i = 0; i < 16; ++i) { s0[i] = 0.f; s1[i] = 0.f; }
#pragma unroll
      for (int ks = 0; ks < DK / 16; ++ks) {
        bf16x8 a0 = *(const bf16x8*)(kb + r * LDK + ks * 16 + 8 * half);
        bf16x8 a1 = *(const bf16x8*)(kb + (32 + r) * LDK + ks * 16 + 8 * half);
        s0 = __builtin_amdgcn_mfma_f32_32x32x16_bf16(a0, qf[ks], s0, 0, 0, 0);
        s1 = __builtin_amdgcn_mfma_f32_32x32x16_bf16(a1, qf[ks], s1, 0, 0, 0);
      }
      float mx = -INFINITY;
      if (NA && t < ntile_a) {
#pragma unroll
        for (int i = 0; i < 16; ++i) {
          const int kk = (i & 3) + 8 * (i >> 2) + 4 * half;
#pragma unroll
          for (int hb = 0; hb < 2; ++hb) {
            const int kq = kk + 32 * hb;
            const int kr = trow0 + kq / GRID_W, kc = kq % GRID_W;
            const bool ok = (kr >= ni.rs) && (kr < ni.rs + WIN_R) && (kc >= ni.cs) && (kc < ni.cs + WIN_C);
            const float bias = ok ? srpb[(kr - ni.r + 7) * 31 + (kc - ni.qc + 15)] * 1.4426950408889634f : -INFINITY;
            if (hb == 0) { s0[i] = s0[i] * scale2 + bias; mx = fmax_(mx, s0[i]); }
            else { s1[i] = s1[i] * scale2 + bias; mx = fmax_(mx, s1[i]); }
          }
        }
      } else {
        s0 = s0 * scale2; s1 = s1 * scale2;
#pragma unroll
        for (int i = 0; i < 16; ++i) mx = fmax_(mx, fmax_(s0[i], s1[i]));
      }
      mx = fmax_(mx, shfl_xor_(mx, 32));
      const float mn = fmax_(m, mx);
      const float alpha = exp2f_(m - mn);
      const bool same = (mn == m);
      m = mn;
      float ps = 0.f;
      { const float nmn = -mn; s0 = s0 + nmn; s1 = s1 + nmn; }
#pragma unroll
      for (int i = 0; i < 16; ++i) { s0[i] = exp2f_(s0[i]); s1[i] = exp2f_(s1[i]); }
      { const f32x16 st = s0 + s1;
        ps = ((st[0] + st[1]) + (st[2] + st[3])) + ((st[4] + st[5]) + (st[6] + st[7])) + (((st[8] + st[9]) + (st[10] + st[11])) + ((st[12] + st[13]) + (st[14] + st[15]))); }
      l = l * alpha + ps;
      if (!wave_all_(same)) {
#pragma unroll
        for (int i = 0; i < 16; ++i) { o0[i] *= alpha; o1[i] *= alpha; }
      }
#pragma unroll
      for (int kq = 0; kq < 4; ++kq) {
        u32x4 pw;
#pragma unroll
        for (int j = 0; j < 4; ++j) pw[j] = (kq < 2) ? pack2(s0[8 * (kq & 1) + 2 * j], s0[8 * (kq & 1) + 2 * j + 1]) : pack2(s1[8 * (kq & 1) + 2 * j], s1[8 * (kq & 1) + 2 * j + 1]);
        const bf16x8 pf = __builtin_bit_cast(bf16x8, pw);
        const bf16* v0 = vb + r * AT_LDV + 16 * kq + 4 * half;
        const bf16* v1 = vb + (r + 32) * AT_LDV + 16 * kq + 4 * half;
        uint2 a0 = *(const uint2*)v0, a1 = *(const uint2*)(v0 + 8), b0 = *(const uint2*)v1, b1 = *(const uint2*)(v1 + 8);
        bf16x8 va, vbb;
        va[0] = (short)(a0.x & 0xffff); va[1] = (short)(a0.x >> 16); va[2] = (short)(a0.y & 0xffff); va[3] = (short)(a0.y >> 16);
        va[4] = (short)(a1.x & 0xffff); va[5] = (short)(a1.x >> 16); va[6] = (short)(a1.y & 0xffff); va[7] = (short)(a1.y >> 16);
        vbb[0] = (short)(b0.x & 0xffff); vbb[1] = (short)(b0.x >> 16); vbb[2] = (short)(b0.y & 0xffff); vbb[3] = (short)(b0.y >> 16);
        vbb[4] = (short)(b1.x & 0xffff); vbb[5] = (short)(b1.x >> 16); vbb[6] = (short)(b1.y & 0xffff); vbb[7] = (short)(b1.y >> 16);
        o0 = __builtin_amdgcn_mfma_f32_32x32x16_bf16(va, pf, o0, 0, 0, 0);
        o1 = __builtin_amdgcn_mfma_f32_32x32x16_bf16(vbb, pf, o1, 0, 0, 0);
      }
    }
    if (t + 1 < NTL) AT_SSTORE(buf ^ 1)
    __syncthreads();
  }
  if (active) {
    const float lt = l + shfl_xor_(l, 32);
    const float inv = rcp_(lt);
#pragma unroll
    for (int gI = 0; gI < 4; ++gI) {
      const int d0 = 8 * gI + 4 * half;
      *(uint2*)(orow + d0) = make_uint2(pack2(o0[4 * gI] * inv, o0[4 * gI + 1] * inv), pack2(o0[4 * gI + 2] * inv, o0[4 * gI + 3] * inv));
      *(uint2*)(orow + 32 + d0) = make_uint2(pack2(o1[4 * gI] * inv, o1[4 * gI + 1] * inv), pack2(o1[4 * gI + 2] * inv, o1[4 * gI + 3] * inv));
    }
  }
}
DI void mla_attn_item(const Params& p, int it, bool ctxq, char* smem) {
  const int nqb = ctxq ? (CTXL + 255) / 256 : SEQ / 256;
  const int b = it / (4 * nqb), h = (it / nqb) & 3, qb = it % nqb;
  const int lane = tid_() & 63, wid = tid_() >> 6;
  const int nq = ctxq ? CTXL : SEQ, q0 = qb * 256 + wid * 32;
  const bool active = q0 < nq;
  const int jq = (ctxq ? 0 : CTXL) + (active ? q0 : 0) + (lane & 31);
  const bf16* Q = (const bf16*)(p.ws + OFF_MIX + MX_Q) + ((size_t)b * 4 + h) * TOK * 96;
  const bf16* K = (const bf16*)(p.ws + OFF_MIX + MX_K) + ((size_t)b * 4 + h) * TOK * 96;
  const bf16* VT = (const bf16*)(p.ws + OFF_MIX + MX_VTM) + ((size_t)b * 4 + h) * 64 * TOK;
  bf16* O = (bf16*)(p.ws + OFF_O) + ((size_t)b * TOK + jq) * 1024 + 0 * 256 + h * 64;
  NaInfo ni; ni.r = 0; ni.qc = 0; ni.rs = 0; ni.cs = 0;
  attn_block<96, false>(Q + (size_t)jq * 96, active, K, 96, VT, 0, 0, 0, 0, (ctxq ? CTXL : TOK) / 64, nullptr, ni, 0.10206207261596577f, O, smem);
}
DI void na_attn_item(const Params& p, const LP& L, int it, bool ctxq, char* smem) {
  const int nqb = ctxq ? (CTXL + 255) / 256 : SEQ / 256;
  const int b = it / (4 * nqb), h = (it / nqb) & 3, qb = it % nqb;
  const int tid = tid_(), lane = tid & 63, wid = tid >> 6;
  const int nq = ctxq ? CTXL : SEQ, q0 = qb * 256 + wid * 32;
  const bool active = q0 < nq;
  const int jq = (ctxq ? 0 : CTXL) + (active ? q0 : 0) + (lane & 31);
  const bf16* P1 = (const bf16*)(p.ws + OFF_P1) + (size_t)b * TOK * P1W;
  const bf16* VT = (const bf16*)(p.ws + OFF_MIX + MX_VTN) + ((size_t)b * 4 + h) * 64 * TOK;
  const bf16* Kb = P1 + C_NA + 256 + h * 64;
  bf16* O = (bf16*)(p.ws + OFF_O) + ((size_t)b * TOK + jq) * 1024 + 1 * 256 + h * 64;
  constexpr int AT_END64 = 2 * (64 * 72 * 2) + 2 * (64 * AT_LDV * 2);
  float* srpb = (float*)(smem + AT_END64);
  NaInfo ni; ni.r = 0; ni.qc = 0; ni.rs = 0; ni.cs = 0;
  int ka0 = 0, nta = 0, arow0 = 0;
  if (!ctxq) {
    __syncthreads();
    const float* rpb = p.in[I_RPB] + ((size_t)L.l * 4 + h) * 15 * 31;
    for (int i = tid; i < 15 * 31; i += NTHREADS) srpb[i] = rpb[i];
    const int tl = q0 + (lane & 31);
    ni.r = tl / GRID_W; ni.qc = tl % GRID_W;
    int rs = ni.r - WIN_R / 2; rs = rs < 0 ? 0 : (rs > ROWS - WIN_R ? ROWS - WIN_R : rs);
    int cs = ni.qc - WIN_C / 2; cs = cs < 0 ? 0 : (cs > GRID_W - WIN_C ? GRID_W - WIN_C : cs);
    ni.rs = rs; ni.cs = cs;
    constexpr int RPT = 64 / GRID_W;
    const int rfirst = (qb * 256) / GRID_W, rlast = (qb * 256 + 255) / GRID_W;
    int rs_f = rfirst - WIN_R / 2; rs_f = rs_f < 0 ? 0 : (rs_f > ROWS - WIN_R ? ROWS - WIN_R : rs_f);
    int rs_l = rlast - WIN_R / 2; rs_l = rs_l < 0 ? 0 : (rs_l > ROWS - WIN_R ? ROWS - WIN_R : rs_l);
    arow0 = (rs_f / RPT) * RPT;
    const int row_hi = rs_l + WIN_R;
    nta = (row_hi - arow0 + RPT - 1) / RPT;
    ka0 = CTXL + arow0 * GRID_W;
  }
  attn_block<64, true>(P1 + (size_t)jq * P1W + C_NA + h * 64, active, Kb, P1W, VT, ka0, nta, arow0, 0, CTXL / 64, srpb, ni, 0.125f, O, smem);
}

constexpr int M2_LDB = 136, M2_LDX = 72;
constexpr int M2_OFF_B = 0;
constexpr int M2_OFF_C = M2_OFF_B + 64 * M2_LDB * 2;
constexpr int M2_OFF_HD = M2_OFF_C + 64 * M2_LDB * 2;
constexpr int M2H_H = 0;
constexpr int M2H_XT = M2H_H + 64 * M2_LDB * 2;
constexpr int M2H_BT = M2H_XT + 64 * M2_LDX * 2;
constexpr int M2H_S = M2H_BT + 128 * M2_LDX * 2;
constexpr int M2H_X = M2H_S + 3 * 64 * 4;
constexpr int M2H_SIZE = M2H_X + 64 * M2_LDX * 2;
constexpr int M2_SMEM = M2_OFF_HD + 2 * M2H_SIZE;
static_assert(M2_SMEM <= SMEM_BYTES, "m2 smem");
DI u32x4 rev8_(u32x4 v) {
  return u32x4{(v[3] >> 16) | (v[3] << 16), (v[2] >> 16) | (v[2] << 16), (v[1] >> 16) | (v[1] << 16), (v[0] >> 16) | (v[0] << 16)};
}
DI void m2scan_item(const Params& p, const LP& L, int it, char* smem) {
  const int b = it / 8, grp = (it >> 2) & 1, dir = (it >> 1) & 1, seg1 = it & 1;
  const int cbeg = seg1 ? M2_SPLIT : 0, cend = seg1 ? TOK : M2_SPLIT;
  const int tid = tid_(), lane = tid & 63, wid = tid >> 6, half = lane >> 5, r = lane & 31;
  const int hsel = wid >> 2, wl = wid & 3, hd = grp * 2 + hsel;
  bf16* sB = (bf16*)(smem + M2_OFF_B);
  bf16* sC = (bf16*)(smem + M2_OFF_C);
  char* hb = smem + M2_OFF_HD + hsel * M2H_SIZE;
  bf16* sH = (bf16*)(hb + M2H_H);
  bf16* sXT = (bf16*)(hb + M2H_XT);
  bf16* sBT = (bf16*)(hb + M2H_BT);
  float* sS = (float*)(hb + M2H_S);
  float* sDt = sS + 64;
  float* sW = sS + 128;
  const bf16* XB = (const bf16*)(p.ws + OFF_MIX + MX_XBC) + (size_t)b * TOK * 768;
  const bf16* XT = (const bf16*)(p.ws + OFF_MIX + MX_XBT) + (size_t)b * 512 * TOK;
  const float* SC = (const float*)(p.ws + OFF_MIX + MX_M2S) + (size_t)((b * 2 + dir) * 4 + hd) * TOK * 4;
  float* YM = (float*)(p.ws + OFF_HA) + ((size_t)dir * NTOK + (size_t)b * TOK) * 256;
  const int pb = wl & 1, tb = wl >> 1, nb0 = 2 * (wl >> 1);
  f32x16 hst[2];
#pragma unroll
  for (int i = 0; i < 16; ++i) { hst[0][i] = 0.f; hst[1][i] = 0.f; }
  __syncthreads();
  for (int i = tid; i < 2 * M2H_SIZE / 4; i += NTHREADS) ((unsigned*)(smem + M2_OFF_HD))[i] = 0u;
  __syncthreads();
  u32x4 rxt[2], rbt[2], rb[2], rc[2];
  float4 rsc = make_float4(0.f, 0.f, 0.f, 0.f);
#define M2_TLOAD(rowptr_, sq0_) (*(const u32x4*)((rowptr_) + ((dir == 0) ? (sq0_) : m2_seq2tok((sq0_) + 7, 1))))
#define M2_GLOAD(c0_) { \
    _Pragma("unroll") for (int q_ = 0; q_ < 2; ++q_) { const int i_ = tid + q_ * NTHREADS; const int h2_ = i_ >> 9, t8_ = ((i_ >> 6) & 7) * 8, pp_ = i_ & 63; \
      rxt[q_] = M2_TLOAD(XT + (size_t)((grp * 2 + h2_) * 64 + pp_) * TOK, (c0_) + t8_); } \
    _Pragma("unroll") for (int q_ = 0; q_ < 2; ++q_) { const int i_ = tid + q_ * NTHREADS; const int t8_ = (i_ >> 7) * 8, nn_ = i_ & 127; \
      rbt[q_] = M2_TLOAD(XT + (size_t)(256 + grp * 128 + nn_) * TOK, (c0_) + t8_); } \
    _Pragma("unroll") for (int q_ = 0; q_ < 2; ++q_) { const int i_ = tid + q_ * NTHREADS; const int t_ = i_ >> 4, n8_ = (i_ & 15) * 8; \
      const bf16* src_ = XB + (size_t)m2_seq2tok((c0_) + t_, dir) * 768 + grp * 128 + n8_; \
      rb[q_] = *(const u32x4*)(src_ + 256); rc[q_] = *(const u32x4*)(src_ + 512); } \
    if (wl == 0) rsc = *(const float4*)(SC + (size_t)((c0_) + lane) * 4); }
  M2_GLOAD(cbeg)
  float* GT = (float*)(p.ws + OFF_MIX + MX_GT) + (size_t)((b * 2 + dir) * 4 + hd) * M2_REST;
  float lcum = 0.f;
  for (int c0 = cbeg; c0 < cend; c0 += 64) {
    if (wl == 0) {
      sS[lane] = rsc.x; sDt[lane] = rsc.w; sW[lane] = rsc.z;
      if (seg1) { GT[c0 - M2_SPLIT + lane] = rsc.x + lcum; lcum += shfl_(rsc.x, 63); }
    }
    __syncthreads();
#pragma unroll
    for (int q2 = 0; q2 < 2; ++q2) {
      const int i = tid + q2 * NTHREADS; const int h2 = i >> 9, t8 = ((i >> 6) & 7) * 8, pp = i & 63;
      *(u32x4*)((bf16*)(smem + M2_OFF_HD + h2 * M2H_SIZE + M2H_XT) + pp * M2_LDX + t8) = dir ? rev8_(rxt[q2]) : rxt[q2];
    }
#pragma unroll
    for (int q4 = 0; q4 < 2; ++q4) {
      const int i = tid + q4 * NTHREADS; const int t = i >> 4, n8 = (i & 15) * 8;
      *(u32x4*)(sB + t * M2_LDB + n8) = rb[q4];
      *(u32x4*)(sC + t * M2_LDB + n8) = rc[q4];
    }
#pragma unroll
    for (int q4 = 0; q4 < 2; ++q4) {
      const int i = tid + q4 * NTHREADS; const int t8 = (i >> 7) * 8, nn = i & 127;
      float bv[8];
      if (dir) rbt[q4] = rev8_(rbt[q4]);
      bv[0] = __uint_as_float(rbt[q4][0] << 16); bv[1] = __uint_as_float(rbt[q4][0] & 0xffff0000u);
      bv[2] = __uint_as_float(rbt[q4][1] << 16); bv[3] = __uint_as_float(rbt[q4][1] & 0xffff0000u);
      bv[4] = __uint_as_float(rbt[q4][2] << 16); bv[5] = __uint_as_float(rbt[q4][2] & 0xffff0000u);
      bv[6] = __uint_as_float(rbt[q4][3] << 16); bv[7] = __uint_as_float(rbt[q4][3] & 0xffff0000u);
#pragma unroll
      for (int h2 = 0; h2 < 2; ++h2) {
        const float* wv = (const float*)(smem + M2_OFF_HD + h2 * M2H_SIZE + M2H_S) + 128 + t8;
        float sv[8];
#pragma unroll
        for (int k = 0; k < 8; ++k) sv[k] = bv[k] * wv[k];
        st8bf((bf16*)(smem + M2_OFF_HD + h2 * M2H_SIZE + M2H_BT) + nn * M2_LDX + t8, sv);
      }
    }
    __syncthreads();
    if (c0 + 64 < cend) M2_GLOAD(c0 + 64)
    {
      f32x16 yT, y2;
#pragma unroll
      for (int i = 0; i < 16; ++i) { yT[i] = 0.f; y2[i] = 0.f; }
      const int tv = 32 * tb + r;
      const float St = sS[tv];
      for (int sb = 0; sb <= tb; ++sb) {
        f32x16 gT;
#pragma unroll
        for (int i = 0; i < 16; ++i) gT[i] = 0.f;
#pragma unroll
        for (int ks = 0; ks < 8; ++ks) {
          bf16x8 av = *(const bf16x8*)(sB + (32 * sb + r) * M2_LDB + 16 * ks + 8 * half);
          bf16x8 bv = *(const bf16x8*)(sC + tv * M2_LDB + 16 * ks + 8 * half);
          gT = __builtin_amdgcn_mfma_f32_32x32x16_bf16(av, bv, gT, 0, 0, 0);
        }
        const float St2 = St * 1.4426950408889634f;
        if (sb == tb) {
#pragma unroll
          for (int i = 0; i < 16; ++i) {
            const int sv = 32 * sb + (i & 3) + 8 * (i >> 2) + 4 * half;
            gT[i] = (sv <= tv) ? gT[i] * exp2f_(St2 - sDt[sv]) : 0.f;
          }
        } else {
#pragma unroll
          for (int i = 0; i < 16; ++i) {
            const int sv = 32 * sb + (i & 3) + 8 * (i >> 2) + 4 * half;
            gT[i] *= exp2f_(St2 - sDt[sv]);
          }
        }
#pragma unroll
        for (int kq = 0; kq < 2; ++kq) {
          const u32x4 pw = u32x4{pack2(gT[8 * kq], gT[8 * kq + 1]), pack2(gT[8 * kq + 2], gT[8 * kq + 3]), pack2(gT[8 * kq + 4], gT[8 * kq + 5]), pack2(gT[8 * kq + 6], gT[8 * kq + 7])};
          const bf16x8 pf = __builtin_bit_cast(bf16x8, pw);
          const bf16* xr = sXT + (32 * pb + r) * M2_LDX + 32 * sb + 16 * kq + 4 * half;
          uint2 x0 = *(const uint2*)xr, x1 = *(const uint2*)(xr + 8);
          bf16x8 xa;
          xa[0] = (short)(x0.x & 0xffff); xa[1] = (short)(x0.x >> 16); xa[2] = (short)(x0.y & 0xffff); xa[3] = (short)(x0.y >> 16);
          xa[4] = (short)(x1.x & 0xffff); xa[5] = (short)(x1.x >> 16); xa[6] = (short)(x1.y & 0xffff); xa[7] = (short)(x1.y >> 16);
          yT = __builtin_amdgcn_mfma_f32_32x32x16_bf16(xa, pf, yT, 0, 0, 0);
        }
      }
#pragma unroll
      for (int ks = 0; ks < 8; ++ks) {
        bf16x8 av = *(const bf16x8*)(sH + (32 * pb + r) * M2_LDB + 16 * ks + 8 * half);
        bf16x8 bv = *(const bf16x8*)(sC + tv * M2_LDB + 16 * ks + 8 * half);
        y2 = __builtin_amdgcn_mfma_f32_32x32x16_bf16(av, bv, y2, 0, 0, 0);
      }
      const float eS = __expf(St);
      const int j = m2_seq2tok(c0 + tv, dir);
      float* yo = YM + (size_t)j * 256 + hd * 64 + 32 * pb + 4 * half;
#pragma unroll
      for (int gI = 0; gI < 4; ++gI)
        *(float4*)(yo + 8 * gI) = make_float4(yT[4 * gI] + eS * y2[4 * gI], yT[4 * gI + 1] + eS * y2[4 * gI + 1], yT[4 * gI + 2] + eS * y2[4 * gI + 2], yT[4 * gI + 3] + eS * y2[4 * gI + 3]);
    }
    __syncthreads();
    {
      const float eL = __expf(sS[63]);
#pragma unroll
      for (int q = 0; q < 2; ++q) {
#pragma unroll
        for (int i = 0; i < 16; ++i) hst[q][i] *= eL;
#pragma unroll
        for (int ks = 0; ks < 4; ++ks) {
          bf16x8 av = *(const bf16x8*)(sXT + (32 * pb + r) * M2_LDX + 16 * ks + 8 * half);
          bf16x8 bv = *(const bf16x8*)(sBT + (32 * (nb0 + q) + r) * M2_LDX + 16 * ks + 8 * half);
          hst[q] = __builtin_amdgcn_mfma_f32_32x32x16_bf16(av, bv, hst[q], 0, 0, 0);
        }
#pragma unroll
        for (int i = 0; i < 16; ++i) {
          const int pv = 32 * pb + (i & 3) + 8 * (i >> 2) + 4 * half;
          sH[pv * M2_LDB + 32 * (nb0 + q) + r] = f2bf(hst[q][i]);
        }
      }
    }
    __syncthreads();
  }
  if (!seg1) {
    bf16* HM = (bf16*)(p.ws + OFF_MIX + MX_HM) + (size_t)((b * 2 + dir) * 2 + grp) * 128 * 128;
#pragma unroll
    for (int q = 0; q < 4; ++q) {
      const int i = tid + q * NTHREADS, pr = i >> 4, n8 = (i & 15) * 8;
      *(u32x4*)(HM + pr * 128 + n8) = *(const u32x4*)((const bf16*)(smem + M2_OFF_HD + (pr >> 6) * M2H_SIZE + M2H_H) + (pr & 63) * M2_LDB + n8);
    }
  }
}
constexpr int M2C_MT = (M2_REST + 255) / 256;
DI void m2corr_tile(const Params& p, const LP& L, int t, char* smem) {
  const int mt = t % M2C_MT, r = t / M2C_MT, grp = r & 1, dir = (r >> 1) & 1, b = r >> 2;
  const int tok0 = dir ? CTXL : M2_SPLIT;
  const bf16* A = (const bf16*)(p.ws + OFF_MIX + MX_XBC) + ((size_t)b * TOK + tok0) * 768 + 512 + grp * 128;
  const bf16* HM = (const bf16*)(p.ws + OFF_MIX + MX_HM) + (size_t)((b * 2 + dir) * 2 + grp) * 128 * 128;
  GA g = make_ga(A, 768, HM, 128, 128, M2_REST);
  f32x4 acc[4][4];
  const int m0 = mt * 256;
  gemm_s<4>(g, m0, 0, smem, acc);
  float* YM = (float*)(p.ws + OFF_HA) + ((size_t)dir * NTOK + (size_t)b * TOK + tok0) * 256;
  const float* GT = (const float*)(p.ws + OFF_MIX + MX_GT) + (size_t)((b * 2 + dir) * 4 + grp * 2) * M2_REST;
  EPI_BEGIN(4, acc, m0, 0, M2_REST)
    const int hs = col >> 6;
    const int sidx = dir ? (M2_REST - 1 - row) : row;
    const float f = __expf(GT[(size_t)hs * M2_REST + sidx]);
    float* yo = YM + (size_t)row * 256 + (grp * 2 + hs) * 64 + (col & 63);
    float4 y0 = *(const float4*)yo, y1 = *(const float4*)(yo + 4);
    y0.x += f * v[0]; y0.y += f * v[1]; y0.z += f * v[2]; y0.w += f * v[3];
    y1.x += f * v[4]; y1.y += f * v[5]; y1.z += f * v[6]; y1.w += f * v[7];
    *(float4*)yo = y0; *(float4*)(yo + 4) = y1;
  EPI_END
}
DI void m2gate_item(const Params& p, const LP& L, int it) {
  const int tok = it * NWAVES + (tid_() >> 6), lane = tid_() & 63;
  const float* Y0 = (const float*)(p.ws + OFF_HA) + (size_t)tok * 256;
  const float* Y1 = Y0 + (size_t)NTOK * 256;
  const bf16* XB = (const bf16*)(p.ws + OFF_MIX + MX_XBC) + (size_t)tok * 768;
  const bf16* P1 = (const bf16*)(p.ws + OFF_P1) + (size_t)tok * P1W + C_Z;
  const int c = lane * 4, hd = c >> 6;
  const float dsk = p.in[I_M2D][L.l * 4 + hd];
  float4 y0 = *(const float4*)(Y0 + c), y1 = *(const float4*)(Y1 + c);
  uint2 xw = *(const uint2*)(XB + c), zw = *(const uint2*)(P1 + c);
  float xs[4] = {__uint_as_float(xw.x << 16), __uint_as_float(xw.x & 0xffff0000u), __uint_as_float(xw.y << 16), __uint_as_float(xw.y & 0xffff0000u)};
  float zs[4] = {__uint_as_float(zw.x << 16), __uint_as_float(zw.x & 0xffff0000u), __uint_as_float(zw.y << 16), __uint_as_float(zw.y & 0xffff0000u)};
  float ys[4] = {y0.x + y1.x, y0.y + y1.y, y0.z + y1.z, y0.w + y1.w};
  float v[4], ss = 0.f;
#pragma unroll
  for (int i = 0; i < 4; ++i) { v[i] = (ys[i] + dsk * xs[i]) * siluf_(zs[i]); ss += v[i] * v[i]; }
  ss = wave_sum(ss);
  const float rs = rsqrtf(ss * (1.f / 256.f) + EPS);
  float4 gn = *(const float4*)(p.in[I_M2GNORM] + L.l * 256 + c);
  bf16* O = (bf16*)(p.ws + OFF_O) + (size_t)tok * 1024 + 768 + c;
  *(uint2*)O = make_uint2(pack2(v[0] * rs * gn.x, v[1] * rs * gn.y), pack2(v[2] * rs * gn.z, v[3] * rs * gn.w));
}
constexpr int GLU_MT = (NTOK + 255) / 256;
DI void glu_tile(const Params& p, const LP& L, int t, char* smem) {
  const int mt = t % GLU_MT, nt = t / GLU_MT, m0 = mt * 256, n0 = nt * 128;
  const bf16* Z = (const bf16*)(p.ws + OFF_MIX + MX_Z);
  GA g = make_ga(Z, 256, (const bf16*)(L.we + WE_GLU), 256, 256, NTOK);
  f32x4 acc[4][4];
  gemm_s<4>(g, m0, n0, smem, acc);
  bf16* O = (bf16*)(p.ws + OFF_O);
  const float* bg = p.in[I_S5BGLU] + L.l * 256;
  EPI_BEGIN(4, acc, m0, n0, NTOK)
    float z[8]; ld8bf(Z + (size_t)row * 256 + col, z);
#pragma unroll
    for (int k = 0; k < 8; ++k) v[k] = z[k] * sigmoidf_(v[k] + bg[col + k]);
    st8bf(O + (size_t)row * 1024 + 512 + col, v);
  EPI_END
}
DI void merge_tile(const Params& p, const LP& L, int t, char* smem) {
  constexpr int MT_L = BATCH * (SEQ / 256), MT_A = (NTOK + 255) / 256;
  const int mt = L.last ? t % MT_L : t % MT_A, nt = L.last ? t / MT_L : t / MT_A, m0 = mtile_row0(mt, L.last, 256), n0 = nt * 128;
  const bf16* O = (const bf16*)(p.ws + OFF_O);
  const bf16* PG = (const bf16*)(p.ws + OFF_PG);
  float tot[4][2][8];
#pragma unroll
  for (int a = 0; a < 4; ++a)
#pragma unroll
    for (int q = 0; q < 2; ++q)
#pragma unroll
      for (int k = 0; k < 8; ++k) tot[a][q][k] = 0.f;
  for (int j = 0; j < 4; ++j) {
    GA g = make_ga(O + j * 256, 1024, (const bf16*)(L.we + WE_WB) + (size_t)j * 1024 * 256, 256, 256, NTOK);
    f32x4 acc[4][4];
    gemm_s<4>(g, m0, n0, smem, acc);
    EPI_BEGIN(4, acc, m0, n0, NTOK)
      float gt[8]; ld8bf(PG + (size_t)row * 4096 + j * 1024 + col, gt);
#pragma unroll
      for (int k = 0; k < 8; ++k) tot[_m][_q][k] += gt[k] * v[k];
    EPI_END
  }
  bf16* Y = (bf16*)(p.ws + OFF_P1);
  {
    const int l = tid_() & 63, w = tid_() >> 6, wr = w >> 1, wc = w & 1, fr = l & 15, fq = l >> 4;
#pragma unroll
    for (int m = 0; m < 4; ++m)
#pragma unroll
      for (int q = 0; q < 2; ++q) {
        const int row = m0 + wr * 64 + m * 16 + fr, col = n0 + wc * 64 + q * 32 + 8 * fq;
        if (row < NTOK) st8bf(Y + (size_t)row * 1024 + col, tot[m][q]);
      }
  }
}
DI void outproj_tile(const Params& p, const LP& L, int t, char* smem) {
  float* Y2 = (float*)(p.ws + OFF_HA);
  constexpr int MT_L = BATCH * (SEQ / 256), MT_A = (NTOK + 255) / 256;
  const int mt = L.last ? t % MT_L : t % MT_A, nt = L.last ? t / MT_L : t / MT_A, m0 = mtile_row0(mt, L.last, 256), n0 = nt * 256;
  GA g = make_ga((const bf16*)(p.ws + OFF_P1), 1024, (const bf16*)(L.we + WE_WOUT), 1024, 1024, NTOK);
  f32x4 acc[2][2][4][2];
  gemm_big(g, m0, n0, smem, acc);
  EPIB_BEGIN(acc, m0, n0, NTOK)
    st8f(Y2 + (size_t)row * 1024 + col, v);
  EPIB_END
}
DI int post_ntok(bool latonly) { return latonly ? BATCH * SEQ : NTOK; }
DI int post_tok(int i, bool latonly) { return latonly ? ((i / SEQ) * TOK + CTXL + (i % SEQ)) : i; }

DI const float* xsrc_row(const Params& p, int l, int tok) {
  if (l > 0) return (const float*)(p.ws + OFF_X) + (size_t)tok * 1024;
  const int b = tok_b(tok), j = tok_j(tok);
  return (j < CTXL) ? p.in[I_CTX] + ((size_t)b * CTXL + j) * 1024 : p.in[I_X] + ((size_t)b * SEQ + (j - CTXL)) * 1024;
}
DI void post_stage_router(const Params& p, const LP& L, char* smem) {
  const float* wr = p.in[I_WROUTER] + (size_t)L.l * 1024 * 16;
  float4* wl = (float4*)smem;
  __syncthreads();
  for (int i = tid_(); i < 4096; i += NTHREADS) {
    const int k = i >> 2, q = i & 3;
    const int pos = ((k >> 8) * 4 + (k & 3)) * 64 + ((k >> 2) & 63);
    wl[q * 1024 + pos] = *(const float4*)(wr + (size_t)k * 16 + q * 4);
  }
  __syncthreads();
}
DI void post_phase(const Params& p, const LP& L, char* smem) {
  const int lane = tid_() & 63, gw = (int)blockIdx.x * NWAVES + (tid_() >> 6), TW = (int)gridDim.x * NWAVES;
  const int n = post_ntok(L.last);
  if (gw >= n) return;
  const float* gpm = p.in[I_GPOSTMIX] + L.l * 1024;
  const float4* wl = (const float4*)smem;
  int i = gw, tok = post_tok(i, L.last);
  float4 yr[4], xr[4];
  {
    const float* X = xsrc_row(p, L.l, tok);
    const float* Y2 = (const float*)(p.ws + OFF_HA) + (size_t)tok * 1024;
#pragma unroll
    for (int q = 0; q < 4; ++q) { yr[q] = *(const float4*)(Y2 + lane * 4 + q * 256); xr[q] = *(const float4*)(X + lane * 4 + q * 256); }
  }
  for (;;) {
    const int inext = i + TW; const bool has = inext < n; const int tokn = has ? post_tok(inext, L.last) : tok;
    float4 yn[4], xn[4];
    {
      const float* Xn = xsrc_row(p, L.l, tokn);
      const float* Yn = (const float*)(p.ws + OFF_HA) + (size_t)tokn * 1024;
#pragma unroll
      for (int q = 0; q < 4; ++q) { yn[q] = *(const float4*)(Yn + lane * 4 + q * 256); xn[q] = *(const float4*)(Xn + lane * 4 + q * 256); }
    }
    float* X = (float*)(p.ws + OFF_X) + (size_t)tok * 1024;
    const float* mod = L.mod + (size_t)tok_modrow(tok) * 6144;
    float xv[16], h[16];
    float ss = 0.f;
#pragma unroll
    for (int q = 0; q < 4; ++q) ss += yr[q].x * yr[q].x + yr[q].y * yr[q].y + yr[q].z * yr[q].z + yr[q].w * yr[q].w;
    ss = wave_sum(ss);
    const float rs = rsqrtf(ss * (1.f / 1024.f) + EPS);
#pragma unroll
    for (int q = 0; q < 4; ++q) {
      const int c = lane * 4 + q * 256;
      float4 xo = xr[q], gv = *(const float4*)(gpm + c), gt = *(const float4*)(mod + 2048 + c);
      xo.x += gt.x * yr[q].x * rs * gv.x; xo.y += gt.y * yr[q].y * rs * gv.y; xo.z += gt.z * yr[q].z * rs * gv.z; xo.w += gt.w * yr[q].w * rs * gv.w;
      *(float4*)(X + c) = xo;
      xv[q * 4] = xo.x; xv[q * 4 + 1] = xo.y; xv[q * 4 + 2] = xo.z; xv[q * 4 + 3] = xo.w;
    }
    bf16* H2 = (bf16*)(p.ws + OFF_P1) + (size_t)NTOK * 1024 + (size_t)tok * 1024;
    normmod_row(xv, p.in[I_GPREFFN] + L.l * 1024, mod + 3072, mod + 4096, H2, h);
    float lg[16];
#pragma unroll
    for (int e = 0; e < 16; ++e) lg[e] = 0.f;
#pragma unroll
    for (int q = 0; q < 16; ++q) {
      const int pos = ((q >> 2) * 4 + (q & 3)) * 64 + lane;
      float4 a = wl[pos], b4 = wl[1024 + pos], c4 = wl[2048 + pos], d4 = wl[3072 + pos];
      float hv = h[q];
      lg[0] += hv * a.x; lg[1] += hv * a.y; lg[2] += hv * a.z; lg[3] += hv * a.w;
      lg[4] += hv * b4.x; lg[5] += hv * b4.y; lg[6] += hv * b4.z; lg[7] += hv * b4.w;
      lg[8] += hv * c4.x; lg[9] += hv * c4.y; lg[10] += hv * c4.z; lg[11] += hv * c4.w;
      lg[12] += hv * d4.x; lg[13] += hv * d4.y; lg[14] += hv * d4.z; lg[15] += hv * d4.w;
    }
    float mx = -INFINITY;
#pragma unroll
    for (int e = 0; e < 16; ++e) { lg[e] = wave_sum(lg[e]); mx = fmax_(mx, lg[e]); }
    float se = 0.f;
#pragma unroll
    for (int e = 0; e < 16; ++e) { lg[e] = expf(lg[e] - mx); se += lg[e]; }
    if (lane < 16) {
      float v = 0.f;
#pragma unroll
      for (int e = 0; e < 16; ++e) if (e == lane) v = lg[e];
      ((float*)(p.ws + OFF_AFF))[(size_t)lane * NTOK + tok] = v * rcp_(se);
    }
    if (!has) break;
    i = inext; tok = tokn;
#pragma unroll
    for (int q = 0; q < 4; ++q) { yr[q] = yn[q]; xr[q] = xn[q]; }
  }
}
DI int block_sum_(int v, int* sred, int round) {
  const int tid = tid_(), lane = tid & 63, wid = tid >> 6;
  v += shfl_xor_(v, 32); v += shfl_xor_(v, 16); v += shfl_xor_(v, 8); v += shfl_xor_(v, 4); v += shfl_xor_(v, 2); v += shfl_xor_(v, 1);
  int* r = sred + (round & 1) * NWAVES;
  if (lane == 0) r[wid] = v;
  __syncthreads();
  int tsum = 0;
#pragma unroll
  for (int q = 0; q < NWAVES; ++q) tsum += r[q];
  return tsum;
}
DI void route_item(const Params& p, const LP& L, int it, char* smem) {
  const int nstream = L.last ? 1 : 2;
  const int b = it / (16 * nstream), e = (it / nstream) & 15, ctxs = (nstream == 2) ? (it & 1) : 0;
  const int T = ctxs ? CTXL : SEQ, cap = ctxs ? CAP_C : CAP_L;
  const int tok0 = b * TOK + (ctxs ? 0 : CTXL);
  const int slot0 = ctxs ? (BATCH * CAP_L + b * CAP_C) : (b * CAP_L);
  int* sred = (int*)smem;
  const float* AFF = (const float*)(p.ws + OFF_AFF) + (size_t)e * NTOK + tok0;
  int* SEL = (int*)(p.ws + OFF_SEL);
  int* IDX = (int*)(p.ws + OFF_IDX) + (size_t)e * ESLOTS;
  float* GW = (float*)(p.ws + OFF_GW) + (size_t)e * ESLOTS;
  const int tid = tid_(), lane = tid & 63, wid = tid >> 6;
  constexpr int MAXPER = (SEQ + NTHREADS - 1) / NTHREADS;
  const int per = (T + NTHREADS - 1) / NTHREADS;
  unsigned key[MAXPER];
  __syncthreads();
#pragma unroll
  for (int k = 0; k < MAXPER; ++k) {
    int i = tid * per + k;
    key[k] = (k < per && i < T) ? (__float_as_uint(AFF[i]) + 1u) : 0u;
  }
  unsigned thr = 0u;
  int round = 0;
  for (int bit = 30; bit >= 0; --bit) {
    const unsigned cand = thr | (1u << bit);
    int c = 0;
#pragma unroll
    for (int k = 0; k < MAXPER; ++k) c += (key[k] >= cand) ? 1 : 0;
    c = block_sum_(c, sred, round++);
    if (c >= cap) thr = cand;
  }
  int cg = 0, ce = 0;
#pragma unroll
  for (int k = 0; k < MAXPER; ++k) { cg += (key[k] > thr) ? 1 : 0; ce += (key[k] == thr) ? 1 : 0; }
  const int tot_gt = block_sum_(cg, sred, round++);
  const int need_eq = cap - tot_gt;
  int v = cg | (ce << 16), inc = v;
#pragma unroll
  for (int d = 1; d < 64; d <<= 1) { int o = shfl_up_(inc, d); if (lane >= d) inc += o; }
  int* soff = sred + 2 * NWAVES;
  __syncthreads();
  if (lane == 63) soff[wid] = inc;
  __syncthreads();
  int base = 0;
  for (int w = 0; w < wid; ++w) base += soff[w];
  int excl = base + inc - v;
  int gt_before = excl & 0xffff, eq_before = excl >> 16;
#pragma unroll
  for (int k = 0; k < MAXPER; ++k) {
    int i = tid * per + k;
    if (k < per && i < T) {
      const bool isgt = key[k] > thr, iseq = key[k] == thr;
      const bool sel = isgt || (iseq && eq_before < need_eq);
      const int slot = slot0 + gt_before + (eq_before < need_eq ? eq_before : need_eq);
      if (sel) { IDX[slot] = tok0 + i; GW[slot] = __uint_as_float(key[k] - 1u); SEL[(size_t)(tok0 + i) * 16 + e] = slot; }
      else SEL[(size_t)(tok0 + i) * 16 + e] = -1;
      gt_before += isgt ? 1 : 0; eq_before += iseq ? 1 : 0;
    }
  }
}
DI void moe1_tile(const Params& p, const LP& L, int t, char* smem) {
  const int nslots = L.last ? ESLOTS_L : ESLOTS;
  constexpr int MT_L = (ESLOTS_L + 255) / 256, MT_A = (ESLOTS + 255) / 256;
  const int nt = t & 7, sq = t >> 3;
  const int e = L.last ? sq / MT_L : sq / MT_A, mt = L.last ? sq % MT_L : sq % MT_A;
  const int m0 = mt * 256, n0 = nt * 256;
  GA g = make_ga((const bf16*)(p.ws + OFF_P1) + (size_t)NTOK * 1024, 1024, (const bf16*)(p.ws + OFF_MIX + WX_GU) + (size_t)e * 2048 * 1024, 1024, 1024, nslots);
  g.ridx = (const int*)(p.ws + OFF_IDX) + (size_t)e * ESLOTS;
  f32x4 acc[2][2][4][2];
  gemm_big(g, m0, n0, smem, acc);
  bf16* ACT = (bf16*)(p.ws + OFF_PG) + (size_t)e * ESLOTS * 1024;
  {
    const int l = tid_() & 63, w = tid_() >> 6, wr = w >> 2, wc = w & 3, fr = l & 15, fq = l >> 4;
#pragma unroll
    for (int ai = 0; ai < 2; ++ai)
#pragma unroll
      for (int m = 0; m < 4; ++m) {
        const int row = m0 + ai * 128 + wr * 64 + m * 16 + fr;
        float a[8];
#pragma unroll
        for (int k = 0; k < 4; ++k) { a[k] = siluf_(acc[ai][0][m][0][k]) * acc[ai][1][m][0][k]; a[4 + k] = siluf_(acc[ai][0][m][1][k]) * acc[ai][1][m][1][k]; }
        if (row < nslots) st8bf(ACT + (size_t)row * 1024 + nt * 128 + wc * 32 + 8 * fq, a);
      }
  }
}
DI void moe2_tile(const Params& p, const LP& L, int t, char* smem) {
  const int nslots = L.last ? ESLOTS_L : ESLOTS;
  constexpr int MT_L = (ESLOTS_L + 255) / 256, MT_A = (ESLOTS + 255) / 256;
  const int x = t & 7, nt = x & 3, sq = (t >> 3) * 2 + (x >> 2);
  const int e = L.last ? sq / MT_L : sq / MT_A, mt = L.last ? sq % MT_L : sq % MT_A;
  if (e >= NE) return;
  const int m0 = mt * 256, n0 = nt * 256;
  GA g = make_ga((const bf16*)(p.ws + OFF_PG) + (size_t)e * ESLOTS * 1024, 1024, (const bf16*)(p.ws + OFF_MIX + WX_DN) + (size_t)e * 1024 * 1024, 1024, 1024, nslots);
  f32x4 acc[2][2][4][2];
  gemm_big(g, m0, n0, smem, acc);
  bf16* YS = (bf16*)(p.ws + OFF_PG) + (size_t)NE * ESLOTS * 1024 + (size_t)e * ESLOTS * 1024;
  const float* GW = (const float*)(p.ws + OFF_GW) + (size_t)e * ESLOTS;
  EPIB_BEGIN(acc, m0, n0, nslots)
    const float gw = GW[row];
#pragma unroll
    for (int k = 0; k < 8; ++k) v[k] *= gw;
    st8bf(YS + (size_t)row * 1024 + col, v);
  EPIB_END
}
DI int uni_(int v) {
#ifdef EMU
  return v;
#else
  return __builtin_amdgcn_readfirstlane(v);
#endif
}
DI void comb_phase(const Params& p, const LP& L) {
  const int lane = tid_() & 63, gw = (int)blockIdx.x * NWAVES + (tid_() >> 6), TW = (int)gridDim.x * NWAVES;
  const int n = post_ntok(L.last);
  if (gw >= n) return;
  const bf16* YS = (const bf16*)(p.ws + OFF_PG) + (size_t)NE * ESLOTS * 1024;
  const float* gpf = p.in[I_GPOSTFFN] + L.l * 1024;
  int i = gw, tok = post_tok(i, L.last);
  uint4 sel[4]; float4 xr[4];
  {
    const uint4* sp = (const uint4*)((const int*)(p.ws + OFF_SEL) + (size_t)tok * 16);
    const float* X = (const float*)(p.ws + OFF_X) + (size_t)tok * 1024;
#pragma unroll
    for (int q = 0; q < 4; ++q) { sel[q] = sp[q]; xr[q] = *(const float4*)(X + lane * 4 + q * 256); }
  }
  for (;;) {
    const int inext = i + TW; const bool has = inext < n; const int tokn = has ? post_tok(inext, L.last) : tok;
    float s[16];
#pragma unroll
    for (int q = 0; q < 16; ++q) s[q] = 0.f;
#pragma unroll
    for (int e = 0; e < 16; ++e) {
      const unsigned sv = (e & 3) == 0 ? sel[e >> 2].x : (e & 3) == 1 ? sel[e >> 2].y : (e & 3) == 2 ? sel[e >> 2].z : sel[e >> 2].w;
      const int sl = uni_((int)sv);
      if (sl >= 0) {
        const bf16* yr = YS + ((size_t)e * ESLOTS + sl) * 1024;
#pragma unroll
        for (int q = 0; q < 4; ++q) {
          uint2 w = *(const uint2*)(yr + lane * 4 + q * 256);
          s[q * 4] += __uint_as_float(w.x << 16); s[q * 4 + 1] += __uint_as_float(w.x & 0xffff0000u);
          s[q * 4 + 2] += __uint_as_float(w.y << 16); s[q * 4 + 3] += __uint_as_float(w.y & 0xffff0000u);
        }
      }
    }
    uint4 seln[4]; float4 xn[4];
    {
      const uint4* sp = (const uint4*)((const int*)(p.ws + OFF_SEL) + (size_t)tokn * 16);
      const float* Xn = (const float*)(p.ws + OFF_X) + (size_t)tokn * 1024;
#pragma unroll
      for (int q = 0; q < 4; ++q) { seln[q] = sp[q]; xn[q] = *(const float4*)(Xn + lane * 4 + q * 256); }
    }
    float ss = 0.f;
#pragma unroll
    for (int q = 0; q < 16; ++q) ss += s[q] * s[q];
    ss = wave_sum(ss);
    const float rs = rsqrtf(ss * (1.f / 1024.f) + EPS);
    const float* mod = L.mod + (size_t)tok_modrow(tok) * 6144;
    float* dst = (float*)(p.ws + OFF_X) + (size_t)tok * 1024;
    if (L.last) { const int b = tok_b(tok), j = tok_j(tok); dst = p.out + ((size_t)b * SEQ + (j - CTXL)) * 1024; }
    float xv[16], h[16];
#pragma unroll
    for (int q = 0; q < 4; ++q) {
      const int c = lane * 4 + q * 256;
      float4 xo = xr[q], gv = *(const float4*)(gpf + c), gt = *(const float4*)(mod + 5120 + c);
      xo.x += gt.x * s[q * 4] * rs * gv.x; xo.y += gt.y * s[q * 4 + 1] * rs * gv.y; xo.z += gt.z * s[q * 4 + 2] * rs * gv.z; xo.w += gt.w * s[q * 4 + 3] * rs * gv.w;
      *(float4*)(dst + c) = xo;
      xv[q * 4] = xo.x; xv[q * 4 + 1] = xo.y; xv[q * 4 + 2] = xo.z; xv[q * 4 + 3] = xo.w;
    }
    if (!L.last) {
      const float* mod1 = (const float*)(p.ws + OFF_MOD) + ((size_t)(L.l + 1) * NB1 + tok_modrow(tok)) * 6144;
      normmod_row(xv, p.in[I_GPREMIX] + (L.l + 1) * 1024, mod1, mod1 + 1024, (bf16*)(p.ws + OFF_HA) + (size_t)tok * 1024, h);
    }
    if (!has) break;
    i = inext; tok = tokn;
#pragma unroll
    for (int q = 0; q < 4; ++q) { sel[q] = seln[q]; xr[q] = xn[q]; }
  }
}

enum { PH_PREP0 = 0, PH_PREP1, PH_L0 };
enum { LP_INPROJ = 0, LP_TOKPREP, LP_MIX1, LP_MIX2, LP_GLU, LP_MERGE, LP_OUT, LP_POST, LP_ROUTE, LP_MOE1, LP_MOE2, LP_COMB, LP_COUNT };
constexpr int NPHASES = PH_L0 + DEPTH * LP_COUNT;


DI void run_phase(const Params& p, int ph, char* smem) {
  const int G = gridDim.x;
  int start = blockIdx.x;
  auto seg = [&](int n, auto&& fn) {
    for (; start < n; start += G) fn(start);
    start -= n;
  };
#ifdef ONLY_PREP
  if (ph >= PH_L0) return;
#endif
  if (ph == PH_PREP0) {
    seg(DEPTH * 96, [&](int it) { mod_item(p, it, smem); });
    seg(DEPTH * 32, [&](int it) { s5_tab_item(p, it, smem); });
    seg(1, [&](int) { rope_tab_item(p); });
    seg(DEPTH * CT_EARLY, [&](int it) { conv_early_item(p, it / CT_EARLY, it % CT_EARLY, smem); });
    return;
  }
  if (ph == PH_PREP1) {
    seg(DEPTH * 256, [&](int it) { s5_mat_item(p, it); });
    seg(NTOK / NWAVES, [&](int it) { prep_row_item(p, it); });
    return;
  }
#ifdef ONLY_LPH
  if (ph < PH_L0) return;
#endif
  const int l = (ph - PH_L0) / LP_COUNT;
#ifdef ONLY_LPH
  const int lph = ONLY_LPH;
#else
  const int lph = (ph - PH_L0) % LP_COUNT;
#endif
  const LP L = make_lp(p, l);
  switch (lph) {
    case LP_INPROJ:
      seg(L.last ? IP_SLOTS_LAST : IP_SLOTS_ALL, [&](int it) { inproj_tile(p, L, it, smem); });
      break;
    case LP_TOKPREP:
      seg(16 * S5_MT * 2, [&](int it) { s5a_tile(p, L, it, smem); });
      seg(TP_MT * 3, [&](int it) { mlaq_tile(p, L, it, smem); });
      seg(TP_MT * 4, [&](int it) { mlakv_tile(p, L, it, smem); });
      seg(NTOK / 64, [&](int it) { navt_item(p, it, smem); });
      seg(M2C_ITEMS, [&](int it) { m2conv_item(p, L, it); });
      seg(M2S_ITEMS, [&](int it) { m2scal_item(p, L, it); });
      break;
    case LP_MIX1: {
      const int n0 = BATCH * 8, n1 = n0 + 2 * 16 * BATCH / NWAVES, n2 = n1 + BATCH * 4 * (SEQ / 256), n3 = n2 + BATCH * 4 * (SEQ / 256);
      const int n4 = n3 + (L.last ? 0 : BATCH * 4 * ((CTXL + 255) / 256)), n5 = n4 + (L.last ? 0 : BATCH * 4 * ((CTXL + 255) / 256));
      int* qhead = (int*)(p.ws + OFF_BAR) + Q_WORD0 + 64 * (l + 2 * p.probe_rep);
#ifdef EMU
      volatile int* bc = (volatile int*)(smem + SMEM_BYTES + 8);
#else
      volatile LAS int* bc = (volatile LAS int*)(smem + SMEM_BYTES + 8);
#endif
      for (;;) {
        __syncthreads();
        if (tid_() == 0) {
#ifdef EMU
          *bc = atomicAdd(qhead, 1);
#else
          *bc = __hip_atomic_fetch_add(qhead, 1, __ATOMIC_RELAXED, __HIP_MEMORY_SCOPE_AGENT);
#endif
        }
        __syncthreads();
        const int it = *bc;
        if (it >= n5) break;
#ifdef PROBE_SKIPM2
        if (it < n0) { if (p.probe_rep == 0) m2scan_item(p, L, it, smem); }
#else
        if (it < n0) m2scan_item(p, L, it, smem);
#endif
        else if (it < n1) s5carry_item(p, L, it - n0);
        else if (it < n2) mla_attn_item(p, it - n1, false, smem);
        else if (it < n3) na_attn_item(p, L, it - n2, false, smem);
        else if (it < n4) mla_attn_item(p, it - n3, true, smem);
        else na_attn_item(p, L, it - n4, true, smem);
      }
    } break;
    case LP_MIX2:
      seg(16 * S5_MT * 2, [&](int it) { s5c_tile(p, L, it, smem); });
      seg(BATCH * 4 * M2C_MT, [&](int it) { m2corr_tile(p, L, it, smem); });
      break;
    case LP_GLU:
      seg(GLU_MT * 2, [&](int it) { glu_tile(p, L, it, smem); });
      seg(NTOK / NWAVES, [&](int it) { m2gate_item(p, L, it); });
      break;
    case LP_MERGE:
      seg(mtiles(L.last, 256) * 8, [&](int it) { merge_tile(p, L, it, smem); });
      break;
    case LP_OUT:
      seg(mtiles(L.last, 256) * 4, [&](int it) { outproj_tile(p, L, it, smem); });
      break;
    case LP_POST:
      seg(CT_EXP, [&](int it) { conv_expert_item(p, l, it, smem); });
      post_stage_router(p, L, smem);
      post_phase(p, L, smem);
      break;
    case LP_ROUTE:
      seg(BATCH * 16 * (L.last ? 1 : 2), [&](int it) { route_item(p, L, it, smem); });
      break;
    case LP_MOE1:
      seg(NE * (((L.last ? ESLOTS_L : ESLOTS) + 255) / 256) * 8, [&](int it) { moe1_tile(p, L, it, smem); });
      break;
    case LP_MOE2:
      seg(((NE * (((L.last ? ESLOTS_L : ESLOTS) + 255) / 256) + 1) / 2) * 8, [&](int it) { moe2_tile(p, L, it, smem); });
      break;
    case LP_COMB:
      comb_phase(p, L);
      break;
  }
}

__global__ void __launch_bounds__(NTHREADS, 2) mega_kernel(Params p) {
#ifdef EMU
  char* smem = emu_cur_f->blk->smem;
  for (int ph = p.phase_lo; ph < p.phase_hi; ++ph) {
    run_phase(p, ph, smem);
    if (ph + 1 < p.phase_hi) emu_grid_sync();
  }
#else
  __shared__ __attribute__((aligned(16))) char smem[SMEM_BYTES + 16 + 256];
  {
    const unsigned hw = (unsigned)__builtin_amdgcn_s_getreg((5 << 11) | 4) & 0x3fu;
    if ((threadIdx.x & 63) == 0) *(volatile int*)(smem + WAVE_TAB_OFF + hw * 4u) = (int)(threadIdx.x >> 6);
    __syncthreads();
  }
  if (p.phase_hi - p.phase_lo > 1) {
    if (threadIdx.x == 0) *(uint4*)(smem + SMEM_BYTES) = make_uint4(0u, 0u, 0u, 0u);
    __syncthreads();
    XcdBarrier xb = xcd_barrier_post((unsigned*)(p.ws + OFF_BAR), (volatile LAS unsigned*)(smem + SMEM_BYTES));
    for (int ph = p.phase_lo; ph < p.phase_hi; ++ph) {
      int reps = 1;
#ifdef PROBE_PHASE
      if (ph == PROBE_PHASE || ph == PROBE_PHASE2) reps = 1 + PROBE_REP;
#endif
      for (int rep = 0; rep < reps; ++rep) {
        p.probe_rep = rep;
        run_phase(p, ph, smem);
        if (ph + 1 < p.phase_hi || rep + 1 < reps) {
          if (ph == p.phase_lo && rep == 0) cg::this_grid().sync();
          else xcd_barrier(xb);
        }
      }
    }
  } else {
    run_phase(p, p.phase_lo, smem);
  }
#endif
}

#ifndef EMU
extern "C" void kernel_launch(void* const* d_in, const int* in_sizes, int n_in, void* d_out, int out_size, void* d_ws, size_t ws_size,
                              hipStream_t stream) {
  static int grid_blocks = 0;
  if (!grid_blocks) {
    int dev = 0, cus = 0, per_cu = 0;
    hipGetDevice(&dev);
    hipDeviceGetAttribute(&cus, hipDeviceAttributeMultiprocessorCount, dev);
    hipOccupancyMaxActiveBlocksPerMultiprocessor(&per_cu, mega_kernel, NTHREADS, 0);
    if (per_cu > 1) per_cu = 1;
    if (per_cu < 1) per_cu = 1;
    grid_blocks = cus * per_cu;
    if (ws_size < WS_TOTAL) fprintf(stderr, "workspace too small: %zu < %zu\n", ws_size, (size_t)WS_TOTAL);
  }
  Params p{};
  for (int i = 0; i < N_INPUTS; ++i) p.in[i] = (const float*)d_in[i];
  p.out = (float*)d_out;
  p.ws = (char*)d_ws;
#if MK_MULTI
  for (int ph = 0; ph < NPHASES; ++ph) {
    p.phase_lo = ph; p.phase_hi = ph + 1;
    hipLaunchKernelGGL(mega_kernel, dim3(grid_blocks), dim3(NTHREADS), 0, stream, p);
  }
#else
  p.phase_lo = 0; p.phase_hi = NPHASES;
  hipMemsetAsync((char*)d_ws + OFF_BAR, 0, BAR_BYTES, stream);
  void* args[] = {&p};
  hipError_t e = hipLaunchCooperativeKernel((void*)mega_kernel, dim3(grid_blocks), dim3(NTHREADS), args, 0, stream);
  if (e != hipSuccess) fprintf(stderr, "cooperative launch failed: %s (grid %d)\n", hipGetErrorString(e), grid_blocks);
#endif
}
#endif
```

```cpp
#ifdef EMU
#include "emu.h"
#else
#include <hip/hip_runtime.h>
#include <hip/hip_cooperative_groups.h>
#include <cstdio>
namespace cg = cooperative_groups;
using bf16x8 = __attribute__((ext_vector_type(8))) short;
using f32x4 = __attribute__((ext_vector_type(4))) float;
using f32x16 = __attribute__((ext_vector_type(16))) float;
#endif
using u32x4 = __attribute__((ext_vector_type(4))) unsigned;
#ifndef MK_MULTI
#define MK_MULTI 0
#endif

#define DI __device__ __forceinline__
typedef unsigned short bf16;

#ifdef EMU_SMALL2
constexpr int BATCH = 2, SEQ = 1024, CTXL = 64, GRID_W = 32;
#elif defined(EMU_SMALL)
constexpr int BATCH = 2, SEQ = 512, CTXL = 64, GRID_W = 32;
#else
constexpr int BATCH = 8, SEQ = 2048, CTXL = 256, GRID_W = 64;
#endif
constexpr int D = 1024, DEPTH = 2;
constexpr int TOK = CTXL + SEQ, NTOK = BATCH * TOK;
constexpr int ROWS = SEQ / GRID_W;
constexpr int WIN_R = (ROWS < 8 ? ROWS : 8), WIN_C = 16;
constexpr int N_IN = 6568, N_INP = 6656;
constexpr int C_CQ = 0, C_CKV = 256, C_KR = 384, C_NA = 416, C_S5 = 1184, C_Z = 1440, C_XBC = 1696, C_DT = 2464, C_GATE = 2472;
constexpr int P1W = 2480;
constexpr int NCH = TOK / 16, NCC = CTXL / 16, MCH = BATCH * NCH;
constexpr int NE = 16;
constexpr int CAP_L = 2 * SEQ / NE, CAP_C = 2 * CTXL / NE;
constexpr int ESLOTS = BATCH * (CAP_L + CAP_C), ESLOTS_L = BATCH * CAP_L;
constexpr int NB1 = BATCH + 1;
constexpr float EPS = 1e-6f;
constexpr int SMEM_BYTES = 147456;
constexpr int NTHREADS = 512, NWAVES = NTHREADS / 64;

enum { I_X = 0, I_C, I_CTX, I_CCTX, I_WADA, I_BADA, I_GPREMIX, I_GPOSTMIX, I_GPREFFN, I_GPOSTFFN, I_WIN, I_GCQ, I_GCKV, I_WUQ, I_WUKV, I_RPB,
       I_S5ARE, I_S5AIM, I_S5LOGSTEP, I_S5BRE, I_S5BIM, I_S5CRE, I_S5CIM, I_S5D, I_S5WGLU, I_S5BGLU, I_M2CONVW, I_M2CONVB, I_M2ALOG, I_M2DTBIAS,
       I_M2D, I_M2GNORM, I_WBRANCH, I_WOUT, I_WROUTER, I_WGATE, I_WUP, I_WDOWN, N_INPUTS };

constexpr size_t al256(size_t x) { return (x + 255) & ~(size_t)255; }
constexpr size_t SZ_X = (size_t)NTOK * D * 4;
constexpr size_t SZ_ROWBF = (size_t)NTOK * D * 2;
constexpr size_t OFF_X = 0;
constexpr size_t OFF_MOD = OFF_X + al256(SZ_X);
constexpr size_t OFF_HA = OFF_MOD + al256((size_t)DEPTH * NB1 * 6144 * 4);
constexpr size_t OFF_O = OFF_HA + al256(SZ_ROWBF);
constexpr size_t OFF_P1 = OFF_O + al256(SZ_ROWBF);
constexpr size_t SZ_P1 = (size_t)NTOK * P1W * 2;
constexpr size_t OFF_PG = OFF_P1 + al256(SZ_P1);
constexpr size_t SZ_PG = (size_t)NTOK * 4096 * 2;
constexpr size_t OFF_DT = OFF_PG + al256(SZ_PG);
constexpr size_t OFF_AFF = OFF_DT + al256((size_t)NTOK * 8 * 4);
constexpr size_t OFF_SEL = OFF_AFF + al256((size_t)NTOK * 16 * 4);
constexpr size_t OFF_IDX = OFF_SEL + al256((size_t)NTOK * 16 * 4);
constexpr size_t OFF_GW = OFF_IDX + al256((size_t)NE * ESLOTS * 4);
constexpr size_t OFF_BAR = OFF_GW + al256((size_t)NE * ESLOTS * 4);
constexpr size_t BAR_BYTES = (3456 + 64 * 4) * 4;
constexpr int Q_WORD0 = 3456;
constexpr size_t OFF_ROPE = OFF_BAR + al256(BAR_BYTES);
constexpr size_t OFF_WEARLY = OFF_ROPE + al256(64 * 8 * 2 * 4);
constexpr size_t WE_WIN = 0;
constexpr size_t WE_UQ = WE_WIN + (size_t)N_INP * 1024 * 2;
constexpr size_t WE_UKV = WE_UQ + (size_t)384 * 256 * 2;
constexpr size_t WE_GLU = WE_UKV + (size_t)512 * 128 * 2;
constexpr size_t WE_WB = WE_GLU + (size_t)256 * 256 * 2;
constexpr size_t WE_WOUT = WE_WB + (size_t)4 * 1024 * 256 * 2;
constexpr size_t WE_SIZE = al256(WE_WOUT + (size_t)1024 * 1024 * 2);
constexpr size_t OFF_S5TAB = OFF_WEARLY + DEPTH * WE_SIZE;
constexpr size_t S5_LAMPOW = 0;
constexpr size_t S5_BBAR = S5_LAMPOW + (size_t)2 * 16 * 17 * 64 * 2 * 4;
constexpr size_t S5_KT = S5_BBAR + (size_t)2 * 16 * 64 * 16 * 2 * 4;
constexpr size_t S5_WA = S5_KT + (size_t)2 * 16 * 16 * 256 * 4;
constexpr size_t S5_W2 = S5_WA + (size_t)16 * 256 * 256 * 2;
constexpr size_t S5_SIZE = al256(S5_W2 + (size_t)16 * 256 * 512 * 2);
constexpr size_t OFF_MIX = OFF_S5TAB + DEPTH * S5_SIZE;
constexpr size_t MX_Q = 0;
constexpr size_t MX_K = MX_Q + al256((size_t)BATCH * 4 * TOK * 96 * 2);
constexpr size_t MX_VTM = MX_K + al256((size_t)BATCH * 4 * TOK * 96 * 2);
constexpr size_t MX_VTN = MX_VTM + al256((size_t)BATCH * 4 * 64 * TOK * 2);
constexpr size_t MX_XBC = MX_VTN + al256((size_t)BATCH * 4 * 64 * TOK * 2);
constexpr size_t MX_US5 = MX_XBC + al256((size_t)NTOK * 768 * 2);
constexpr size_t MX_HEND = MX_US5 + al256((size_t)NTOK * 256 * 2);
constexpr size_t MX_HIN = MX_HEND + al256((size_t)16 * MCH * 256 * 4);
constexpr size_t MX_Z = MX_HIN + al256((size_t)16 * MCH * 256 * 2);
constexpr size_t MX_XBT = MX_Z + al256((size_t)NTOK * 256 * 2);
constexpr size_t MX_M2S = MX_XBT + al256((size_t)NTOK * 512 * 2);
constexpr int M2_SPLIT = ((TOK / 64 + 1) / 2) * 64, M2_REST = TOK - M2_SPLIT;
constexpr size_t MX_HM = MX_M2S + al256((size_t)BATCH * 8 * TOK * 4 * 4);
constexpr size_t MX_GT = MX_HM + al256((size_t)BATCH * 4 * 128 * 128 * 2);
constexpr size_t MX_SIZE = MX_GT + al256((size_t)BATCH * 8 * M2_REST * 4);
constexpr size_t WX_GU = 0;
constexpr size_t WX_DN = WX_GU + (size_t)NE * 2048 * 1024 * 2;
constexpr size_t WX_SIZE = WX_DN + (size_t)NE * 1024 * 1024 * 2;
constexpr size_t MIXREG = (MX_SIZE > WX_SIZE ? MX_SIZE : WX_SIZE);
constexpr size_t WS_TOTAL = OFF_MIX + al256(MIXREG);

struct Params {
  const float* in[N_INPUTS];
  float* out;
  char* ws;
  int phase_lo, phase_hi;
  int probe_rep, pad_;
};

constexpr int WAVE_TAB_OFF = SMEM_BYTES + 16;
DI int tid_() {
#ifdef EMU
  return (int)threadIdx.x;
#else
  const unsigned hw = (unsigned)__builtin_amdgcn_s_getreg((5 << 11) | 4) & 0x3fu;
  const int wave = *(volatile __attribute__((address_space(3))) int*)(unsigned long)(WAVE_TAB_OFF + hw * 4u);
  int lane;
  asm volatile("v_mbcnt_lo_u32_b32 %0, -1, 0\n\tv_mbcnt_hi_u32_b32 %0, -1, %0" : "=v"(lane));
  return wave * 64 + lane;
#endif
}
#ifdef EMU
template <class T> DI T shfl_xor_(T v, int m) { return __shfl_xor(v, m); }
template <class T> DI T shfl_up_(T v, int d) { return __shfl_up(v, d); }
template <class T> DI T shfl_(T v, int src) { return __shfl(v, src); }
#else
template <class T> DI T shfl_xor_(T v, int m) {
  const int idx = ((tid_() & 63) ^ m) << 2;
  return __builtin_bit_cast(T, __builtin_amdgcn_ds_bpermute(idx, __builtin_bit_cast(int, v)));
}
template <class T> DI T shfl_up_(T v, int d) {
  const int l = tid_() & 63; const int idx = (l >= d ? l - d : l) << 2;
  return __builtin_bit_cast(T, __builtin_amdgcn_ds_bpermute(idx, __builtin_bit_cast(int, v)));
}
template <class T> DI T shfl_(T v, int src) {
  int idx = src << 2; asm volatile("" : "+v"(idx));
  return __builtin_bit_cast(T, __builtin_amdgcn_ds_bpermute(idx, __builtin_bit_cast(int, v)));
}
#endif
DI float bf2f(bf16 h) { return __uint_as_float(((unsigned)h) << 16); }
#ifdef EMU
DI bf16 f2bf(float f) { unsigned u = __float_as_uint(f); u += 0x7fffu + ((u >> 16) & 1u); return (bf16)(u >> 16); }
DI unsigned pack2(float a, float b) { return (unsigned)f2bf(a) | ((unsigned)f2bf(b) << 16); }
DI float exp2f_(float x) { return exp2f(x); }
#else
typedef float f32x2_t_ __attribute__((ext_vector_type(2)));
typedef __bf16 bf16x2_t_ __attribute__((ext_vector_type(2)));
DI unsigned pack2(float a, float b) { const f32x2_t_ v = {a, b}; return __builtin_bit_cast(unsigned, __builtin_convertvector(v, bf16x2_t_)); }
DI bf16 f2bf(float f) { return (bf16)(pack2(f, 0.f) & 0xffffu); }
DI float exp2f_(float x) { return __builtin_amdgcn_exp2f(x); }
#endif
#ifdef EMU
DI float rcp_(float x) { return 1.0f / x; }
#else
DI float rcp_(float x) { return __builtin_amdgcn_rcpf(x); }
#endif
DI float sigmoidf_(float x) { return rcp_(1.0f + exp2f_(-1.4426950408889634f * x)); }
DI float siluf_(float x) { return x * rcp_(1.0f + exp2f_(-1.4426950408889634f * x)); }
DI float softplusf_(float x) { const float ax = x < 0.f ? -x : x; return (x > 0.f ? x : 0.f) + __logf(1.0f + __expf(-ax)); }
DI float geluf_(float x) { const float u2 = 1.5957691216057308f * (x + 0.044715f * x * x * x); return x * rcp_(1.0f + exp2f_(-1.4426950408889634f * u2)); }
DI bool wave_all_(bool c) {
#ifdef EMU
  int v = c ? 0 : 1;
  v += shfl_xor_(v, 32); v += shfl_xor_(v, 16); v += shfl_xor_(v, 8); v += shfl_xor_(v, 4); v += shfl_xor_(v, 2); v += shfl_xor_(v, 1);
  return v == 0;
#else
  return __builtin_amdgcn_ballot_w64(!c) == 0ull;
#endif
}
DI float wave_sum(float v) {
#ifdef EMU
  v += shfl_xor_(v, 32); v += shfl_xor_(v, 16); v += shfl_xor_(v, 8); v += shfl_xor_(v, 4); v += shfl_xor_(v, 2); v += shfl_xor_(v, 1);
  return v;
#else
  int x = __float_as_int(v);
  x = __float_as_int(__int_as_float(x) + __int_as_float(__builtin_amdgcn_update_dpp(0, x, 0xB1, 0xF, 0xF, true)));
  x = __float_as_int(__int_as_float(x) + __int_as_float(__builtin_amdgcn_update_dpp(0, x, 0x4E, 0xF, 0xF, true)));
  x = __float_as_int(__int_as_float(x) + __int_as_float(__builtin_amdgcn_update_dpp(0, x, 0x141, 0xF, 0xF, true)));
  x = __float_as_int(__int_as_float(x) + __int_as_float(__builtin_amdgcn_update_dpp(0, x, 0x140, 0xF, 0xF, true)));
  const float r0 = __int_as_float(__builtin_amdgcn_readlane(x, 0)), r1 = __int_as_float(__builtin_amdgcn_readlane(x, 16));
  const float r2 = __int_as_float(__builtin_amdgcn_readlane(x, 32)), r3 = __int_as_float(__builtin_amdgcn_readlane(x, 48));
  return (r0 + r1) + (r2 + r3);
#endif
}
#ifndef EMU
#define XB_TMO      128
#define XB_XCNT(j)  (256  + 64 * (j))
#define XB_XSUB(j)  (1280 + 64 * (j))
#define XB_XGEN(j)  (2304 + 64 * (j))
#define XB_TOP      3328
#define XB_TOPGEN   3392
#define XB_SPIN_CAP (1u << 24)
#define LAS __attribute__((address_space(3)))
DI unsigned xb_ld(unsigned* p) { return __hip_atomic_load(p, __ATOMIC_RELAXED, __HIP_MEMORY_SCOPE_AGENT); }
DI unsigned xb_add(unsigned* p, unsigned v) { return __hip_atomic_fetch_add(p, v, __ATOMIC_RELAXED, __HIP_MEMORY_SCOPE_AGENT); }
DI unsigned xb_xcc_id() { return (unsigned)__builtin_amdgcn_s_getreg((3 << 11) | 20) & 0xFu; }
#define XB_SPIN(cond, bar) do { unsigned _sp = 0; while (cond) { __builtin_amdgcn_s_sleep(1); \
    if ((++_sp & 255u) == 0u) { if (xb_ld(&(bar)[XB_TMO])) break; if (_sp > XB_SPIN_CAP) { atomicAdd(&(bar)[XB_TMO], 1u); break; } } } } while (0)
struct XcdBarrier { unsigned* bar; unsigned x; volatile LAS unsigned* st; };
DI XcdBarrier xcd_barrier_post(unsigned* bar, volatile LAS unsigned* st) {
  XcdBarrier b; b.bar = bar; b.x = xb_xcc_id(); b.st = st;
  if (threadIdx.x == 0) (void)xb_add(&bar[XB_XCNT(b.x)], 1u);
  return b;
}
DI void xcd_barrier_complete(unsigned* bar, unsigned x, unsigned& nloc, unsigned& nx) {
  const unsigned G = gridDim.x * gridDim.y * gridDim.z;
  unsigned sum, cnt, mine, sp = 0u;
  for (;;) {
    sum = 0u; cnt = 0u; mine = 0u;
#pragma unroll
    for (unsigned j = 0; j < 16; ++j) { const unsigned c = xb_ld(&bar[XB_XCNT(j)]); sum += c; cnt += (c > 0u) ? 1u : 0u; mine = (j == x) ? c : mine; }
    if (sum == G) break;
    __builtin_amdgcn_s_sleep(1);
    if ((++sp & 255u) == 0u) { if (xb_ld(&bar[XB_TMO])) break; if (sp > XB_SPIN_CAP) { atomicAdd(&bar[XB_TMO], 1u); break; } }
  }
  nloc = mine > 0u ? mine : 1u; nx = cnt > 0u ? cnt : 1u;
}
DI void xcd_barrier(const XcdBarrier& b) {
  asm volatile("s_waitcnt vmcnt(0)" ::: "memory");
  __syncthreads();
  if (threadIdx.x == 0) {
    unsigned* bar = b.bar;
    __builtin_amdgcn_s_waitcnt(0);
    unsigned nloc = b.st[0], nx = b.st[1];
    if (nloc == 0u) { xcd_barrier_complete(bar, b.x, nloc, nx); b.st[0] = nloc; b.st[1] = nx; }
    const unsigned old = xb_add(&bar[XB_XSUB(b.x)], 1u);
    const unsigned gen = old / nloc;
    if (old + 1u == (gen + 1u) * nloc) {
      __builtin_amdgcn_fence(__ATOMIC_RELEASE, "agent");
      asm volatile("s_waitcnt vmcnt(0)" ::: "memory");
      const unsigned og = xb_add(&bar[XB_TOP], 1u);
      const unsigned tg = og / nx;
      if (og + 1u == (tg + 1u) * nx) xb_add(&bar[XB_TOPGEN], 1u);
      else XB_SPIN(xb_ld(&bar[XB_TOPGEN]) == tg, bar);
      __builtin_amdgcn_fence(__ATOMIC_ACQUIRE, "agent");
      xb_add(&bar[XB_XGEN(b.x)], 1u);
      asm volatile("s_waitcnt vmcnt(0)" ::: "memory");
    } else {
      XB_SPIN(xb_ld(&bar[XB_XGEN(b.x)]) == gen, bar);
      __builtin_amdgcn_fence(__ATOMIC_ACQUIRE, "agent");
      asm volatile("s_waitcnt vmcnt(0)" ::: "memory");
    }
  }
  __syncthreads();
}
#endif

struct GA {
  const bf16* A; const bf16* A2; int lda, lda2, ksplit;
  const int* ridx; int mvalid;
  const bf16* Bt; int ldb; int K;
  int kfix;
};
DI GA make_ga(const bf16* A, int lda, const bf16* Bt, int ldb, int K, int mvalid) {
  GA g; g.A = A; g.A2 = A; g.lda = lda; g.lda2 = lda; g.ksplit = K; g.ridx = nullptr; g.mvalid = mvalid; g.Bt = Bt; g.ldb = ldb; g.K = K; g.kfix = 0; return g;
}

#ifdef EMU
#define GLDS16(gptr_, lptr_) memcpy((void*)(lptr_), (const void*)(gptr_), 16)
#define BGLDS16(rsrc_, base_, voff_, soff_, lptr_) memcpy((void*)(lptr_), (const char*)(base_) + (voff_) + (soff_), 16)
#define GEMM_WAIT(N_)
#define RAW_BARRIER() __syncthreads()
#else
#define LASV __attribute__((address_space(3))) void
#define GLDS16(gptr_, lptr_) __builtin_amdgcn_global_load_lds((const void*)(gptr_), (LASV*)(lptr_), 16, 0, 0)
#define BGLDS16(rsrc_, base_, voff_, soff_, lptr_) __builtin_amdgcn_raw_ptr_buffer_load_lds(rsrc_, (LASV*)(lptr_), 16, (int)(voff_), (int)(soff_), 0, 0)
#define GEMM_WAIT(N_) asm volatile("s_waitcnt vmcnt(%0)" :: "n"(N_) : "memory")
#define RAW_BARRIER() { asm volatile("" ::: "memory"); __builtin_amdgcn_s_barrier(); asm volatile("" ::: "memory"); }
#endif
DI int perm32(int rho) { const int n = rho >> 4, i = rho & 15; return 8 * (i >> 2) + 4 * n + (i & 3); }
constexpr int SRS_OFF = 73728;
template <int NT>
DI void gemm_s(const GA& g, int m0, int n0, char* smem, f32x4 (&acc)[4][NT]) {
  constexpr int A_ELEMS = 256 * 32, B_ELEMS = 32 * NT * 32, STAGE = A_ELEMS + B_ELEMS;
  bf16* st = (bf16*)smem;
  const int tid = tid_(), lane = tid & 63, wid = tid >> 6, wr = wid >> 1, wc = wid & 1, fr = lane & 15, fq = lane >> 4;
  const int lrow = tid >> 2, pch = tid & 3;
  long aoff[2], aoff2[2], boff;
#pragma unroll
  for (int i = 0; i < 2; ++i) {
    const int row = lrow + 128 * i;
    const int lch = pch ^ ((-(row >> 2)) & 3);
    int gm = m0 + row; if (gm > g.mvalid - 1) gm = g.mvalid - 1;
    const int ar = g.ridx ? g.ridx[gm] : gm;
    aoff[i] = (long)ar * g.lda + lch * 8;
    aoff2[i] = (long)ar * g.lda2 + lch * 8;
  }
  const int cb = (NT == 4) ? tid : (tid & 255);
  {
    const int row = cb >> 2;
    const int lch = pch ^ ((-(row >> 2)) & 3);
    const int src = n0 + (row & ~31) + perm32(row & 31);
    boff = (long)src * g.ldb + lch * 8;
  }
#pragma unroll
  for (int m = 0; m < 4; ++m)
#pragma unroll
    for (int n = 0; n < NT; ++n) acc[m][n] = f32x4{0.f, 0.f, 0.f, 0.f};
  const int T = g.K / 32;
#define GEMM_DMA(t_, stg_) { const int k0_ = (t_) * 32; const bool seg2_ = (k0_ >= g.ksplit); bf16* sa_ = st + (stg_) * STAGE; \
    _Pragma("unroll") for (int i_ = 0; i_ < 2; ++i_) { \
      const bf16* ap_ = seg2_ ? (g.A2 + aoff2[i_] + (k0_ - g.ksplit)) : (g.A + aoff[i_] + k0_); \
      GLDS16(ap_, sa_ + (tid + i_ * 512) * 8); } \
    GLDS16(g.Bt + boff + k0_, sa_ + A_ELEMS + cb * 8); }
  __syncthreads();
  GEMM_DMA(0, 0)
  if (T > 1) GEMM_DMA(1, 1)
  int s_cur = 0, s_nxt = 2;
#pragma unroll 1
  for (int t = 0; t < T; ++t) {
    if (t + 1 < T) { GEMM_WAIT(3); } else { GEMM_WAIT(0); }
    RAW_BARRIER();
    if (t + 2 < T) GEMM_DMA(t + 2, s_nxt)
    const bf16* sa = st + s_cur * STAGE;
    const bf16* sb = sa + A_ELEMS;
    bf16x8 af[4], bfr[NT];
#pragma unroll
    for (int n = 0; n < NT; ++n) {
      const int row = wc * (16 * NT) + n * 16 + fr;
      bfr[n] = *(const bf16x8*)(sb + row * 32 + ((fq ^ ((-(row >> 2)) & 3)) << 3));
    }
#pragma unroll
    for (int m = 0; m < 4; ++m) {
      const int row = wr * 64 + m * 16 + fr;
      af[m] = *(const bf16x8*)(sa + row * 32 + ((fq ^ ((-(row >> 2)) & 3)) << 3));
    }
#pragma unroll
    for (int m = 0; m < 4; ++m)
#pragma unroll
      for (int n = 0; n < NT; ++n) acc[m][n] = __builtin_amdgcn_mfma_f32_16x16x32_bf16(bfr[n], af[m], acc[m][n], 0, 0, 0);
    s_cur = (s_cur == 2) ? 0 : s_cur + 1;
    s_nxt = (s_nxt == 2) ? 0 : s_nxt + 1;
  }
}
constexpr int BG_HT = 128 * 64;
DI int lds_byte(int r, int c) { const int stt = (r >> 4) * 2 + (c >> 5), rr = r & 15, cc = c & 31, ob = rr * 64 + cc * 2; return stt * 1024 + (ob ^ (((ob >> 9) & 1) << 5)); }
DI void stage_rc(int b, int& R, int& C) { const int stt = b / 1024, sb = b % 1024, swz = sb ^ (((sb >> 9) & 1) << 5); R = (stt >> 1) * 16 + swz / 64; C = (stt & 1) * 32 + (swz % 64) / 2; }
#ifdef EMU
#define BG_WAIT_V(n)
#define BG_WAIT_L(n)
#define BG_BAR __syncthreads()
#define BG_SCHED
#define BG_PRIO(x)
#else
#define BG_WAIT_V(n) asm volatile("s_waitcnt vmcnt(" #n ")" ::: "memory")
#define BG_WAIT_L(n) asm volatile("s_waitcnt lgkmcnt(" #n ")" ::: "memory")
#define BG_BAR __builtin_amdgcn_s_barrier()
#define BG_SCHED __builtin_amdgcn_sched_barrier(0)
#define BG_PRIO(x) __builtin_amdgcn_s_setprio(x)
#endif
DI void gemm_big(const GA& g, int m0, int n0, char* smem, f32x4 (&acc)[2][2][4][2]) {
  bf16* shm = (bf16*)smem;
  const int tid = tid_(), wid = tid >> 6, lane = tid & 63, wr = wid >> 2, wc = wid & 3, fr = lane & 15, fq = lane >> 4;
  unsigned aof[2][2], bof[2];
#ifdef EMU
  const int dma_lds = tid * 16;
#else
  const int dma_lds = __builtin_amdgcn_readfirstlane(tid >> 6) * 1024;
#endif
#ifndef EMU
  const __amdgpu_buffer_rsrc_t rsA = __builtin_amdgcn_make_buffer_rsrc((void*)g.A, 0, 0x7fffffff, 0x00020000);
  const __amdgpu_buffer_rsrc_t rsB = __builtin_amdgcn_make_buffer_rsrc((void*)g.Bt, 0, 0x7fffffff, 0x00020000);
#endif
#pragma unroll
  for (int i = 0; i < 2; ++i) {
    int R, C; stage_rc(tid * 16 + i * 8192, R, C);
    bof[i] = (unsigned)((n0 + (R & ~31) + perm32(R & 31)) * g.ldb + C) * 2u;
#pragma unroll
    for (int h = 0; h < 2; ++h) {
      int gm = m0 + h * 128 + R; if (gm > g.mvalid - 1) gm = g.mvalid - 1;
      const int ar = g.ridx ? g.ridx[gm] : gm;
      aof[h][i] = (unsigned)(ar * g.lda + C) * 2u;
    }
  }
#define BG_SA(b, h) (shm + ((b) * 2 + (h)) * BG_HT)
#define BG_SB(b, h) (shm + (4 + (b) * 2 + (h)) * BG_HT)
#define BG_STAGE_A(P, h, kt) { \
    _Pragma("unroll") for (int i_ = 0; i_ < 2; ++i_) BGLDS16(rsA, g.A, aof[h][i_], (kt) * 128, (char*)(P) + dma_lds + i_ * 8192); }
#define BG_STAGE_B(P, h, kt) { \
    _Pragma("unroll") for (int i_ = 0; i_ < 2; ++i_) BGLDS16(rsB, g.Bt, bof[i_], (kt) * 128 + (h) * 256 * g.ldb, (char*)(P) + dma_lds + i_ * 8192); }
#define BG_LDA(dst, b, h) _Pragma("unroll") for (int m_ = 0; m_ < 4; ++m_) _Pragma("unroll") for (int k_ = 0; k_ < 2; ++k_) \
    dst[m_][k_] = *(const bf16x8*)((const char*)BG_SA(b, h) + lds_byte(wr * 64 + m_ * 16 + fr, k_ * 32 + fq * 8))
#define BG_LDB(dst, b, h) _Pragma("unroll") for (int n_ = 0; n_ < 2; ++n_) _Pragma("unroll") for (int k_ = 0; k_ < 2; ++k_) \
    dst[n_][k_] = *(const bf16x8*)((const char*)BG_SB(b, h) + lds_byte(wc * 32 + n_ * 16 + fr, k_ * 32 + fq * 8))
#define BG_MMA(ai, bj, At_, Bt_) { BG_PRIO(1); \
    _Pragma("unroll") for (int m_ = 0; m_ < 4; ++m_) _Pragma("unroll") for (int n_ = 0; n_ < 2; ++n_) _Pragma("unroll") for (int k_ = 0; k_ < 2; ++k_) \
      acc[ai][bj][m_][n_] = __builtin_amdgcn_mfma_f32_16x16x32_bf16(Bt_[n_][k_], At_[m_][k_], acc[ai][bj][m_][n_], 0, 0, 0); \
    BG_PRIO(0); }
#pragma unroll
  for (int a_ = 0; a_ < 2; ++a_)
#pragma unroll
    for (int b_ = 0; b_ < 2; ++b_)
#pragma unroll
      for (int m_ = 0; m_ < 4; ++m_)
#pragma unroll
        for (int n_ = 0; n_ < 2; ++n_) acc[a_][b_][m_][n_] = f32x4{0.f, 0.f, 0.f, 0.f};
  bf16x8 At[4][2], B0[2][2], B1[2][2];
  const int nt = g.K / 64;
  __syncthreads();
  BG_STAGE_B(BG_SB(0, 0), 0, 0) BG_STAGE_A(BG_SA(0, 0), 0, 0)
  BG_STAGE_B(BG_SB(0, 1), 1, 0) BG_STAGE_A(BG_SA(0, 1), 1, 0)
  if (wr == 1) BG_BAR;
  BG_WAIT_V(4); BG_BAR;
  BG_STAGE_B(BG_SB(1, 0), 0, 1) BG_STAGE_A(BG_SA(1, 0), 0, 1) BG_STAGE_B(BG_SB(1, 1), 1, 1)
  BG_WAIT_V(6); BG_BAR;
#pragma unroll 1
  for (int t = 0; t < nt - 2; t += 2) {
    BG_LDB(B0, 0, 0); BG_SCHED; BG_LDA(At, 0, 0); BG_STAGE_A(BG_SA(1, 1), 1, t + 1)
    BG_WAIT_L(8); BG_BAR; BG_WAIT_L(0); BG_MMA(0, 0, At, B0) BG_BAR; BG_SCHED;
    BG_LDB(B1, 0, 1); BG_STAGE_B(BG_SB(0, 0), 0, t + 2)
    BG_BAR; BG_WAIT_L(0); BG_MMA(0, 1, At, B1) BG_BAR;
    BG_LDA(At, 0, 1); BG_STAGE_A(BG_SA(0, 0), 0, t + 2)
    BG_BAR; BG_WAIT_L(0); BG_MMA(1, 0, At, B0) BG_BAR; BG_SCHED;
    BG_STAGE_B(BG_SB(0, 1), 1, t + 2)
    BG_WAIT_V(6); BG_BAR; BG_MMA(1, 1, At, B1) BG_BAR;
    BG_LDB(B0, 1, 0); BG_SCHED; BG_LDA(At, 1, 0); BG_STAGE_A(BG_SA(0, 1), 1, t + 2)
    BG_WAIT_L(8); BG_BAR; BG_WAIT_L(0); BG_MMA(0, 0, At, B0) BG_BAR; BG_SCHED;
    BG_LDB(B1, 1, 1); BG_STAGE_B(BG_SB(1, 0), 0, t + 3)
    BG_BAR; BG_WAIT_L(0); BG_MMA(0, 1, At, B1) BG_BAR;
    BG_LDA(At, 1, 1); BG_STAGE_A(BG_SA(1, 0), 0, t + 3)
    BG_BAR; BG_WAIT_L(0); BG_MMA(1, 0, At, B0) BG_BAR; BG_SCHED;
    BG_STAGE_B(BG_SB(1, 1), 1, t + 3)
    BG_WAIT_V(6); BG_BAR; BG_MMA(1, 1, At, B1) BG_BAR;
  }
  { BG_LDB(B0, 0, 0); BG_LDA(At, 0, 0); BG_STAGE_A(BG_SA(1, 1), 1, nt - 1)
    BG_BAR; BG_WAIT_L(0); BG_MMA(0, 0, At, B0) BG_BAR;
    BG_LDB(B1, 0, 1); BG_BAR; BG_WAIT_L(0); BG_MMA(0, 1, At, B1) BG_BAR;
    BG_LDA(At, 0, 1); BG_WAIT_V(4); BG_BAR; BG_WAIT_L(0); BG_MMA(1, 0, At, B0) BG_MMA(1, 1, At, B1) BG_BAR; }
  { BG_LDB(B0, 1, 0); BG_LDA(At, 1, 0); BG_WAIT_V(2); BG_BAR; BG_WAIT_L(0); BG_MMA(0, 0, At, B0) BG_BAR;
    BG_LDB(B1, 1, 1); BG_WAIT_V(0); BG_BAR; BG_WAIT_L(0); BG_MMA(0, 1, At, B1) BG_BAR;
    BG_LDA(At, 1, 1); BG_BAR; BG_WAIT_L(0); BG_MMA(1, 0, At, B0) BG_MMA(1, 1, At, B1) BG_BAR; }
  if (wr == 0) BG_BAR;
}
#define EPIB_BEGIN(acc_, m0_, n0_, mvalid_) { const int _l = tid_() & 63, _w = tid_() >> 6, _wr = _w >> 2, _wc = _w & 3, _fr = _l & 15, _fq = _l >> 4; \
  _Pragma("unroll") for (int _ai = 0; _ai < 2; ++_ai) _Pragma("unroll") for (int _m = 0; _m < 4; ++_m) { const int row = (m0_) + _ai * 128 + _wr * 64 + _m * 16 + _fr; \
  _Pragma("unroll") for (int _bj = 0; _bj < 2; ++_bj) { const int col = (n0_) + _bj * 128 + _wc * 32 + 8 * _fq; (void)col; \
    float v[8] = {acc_[_ai][_bj][_m][0][0], acc_[_ai][_bj][_m][0][1], acc_[_ai][_bj][_m][0][2], acc_[_ai][_bj][_m][0][3], \
                  acc_[_ai][_bj][_m][1][0], acc_[_ai][_bj][_m][1][1], acc_[_ai][_bj][_m][1][2], acc_[_ai][_bj][_m][1][3]}; \
    if (row < (mvalid_)) {
#define EPIB_END }}}}

DI void ld8bf(const bf16* p, float (&v)[8]) {
  uint4 w = *(const uint4*)p;
  v[0] = __uint_as_float(w.x << 16); v[1] = __uint_as_float(w.x & 0xffff0000u); v[2] = __uint_as_float(w.y << 16); v[3] = __uint_as_float(w.y & 0xffff0000u);
  v[4] = __uint_as_float(w.z << 16); v[5] = __uint_as_float(w.z & 0xffff0000u); v[6] = __uint_as_float(w.w << 16); v[7] = __uint_as_float(w.w & 0xffff0000u);
}
DI void st8bf(bf16* p, const float (&v)[8]) { *(uint4*)p = make_uint4(pack2(v[0], v[1]), pack2(v[2], v[3]), pack2(v[4], v[5]), pack2(v[6], v[7])); }
DI void st8f(float* p, const float (&v)[8]) { *(float4*)p = make_float4(v[0], v[1], v[2], v[3]); *(float4*)(p + 4) = make_float4(v[4], v[5], v[6], v[7]); }
#define EPI_BEGIN(NT_, acc_, m0_, n0_, mvalid_) { const int _l = tid_() & 63, _w = tid_() >> 6, _wr = _w >> 1, _wc = _w & 1, _fr = _l & 15, _fq = _l >> 4; \
  _Pragma("unroll") for (int _m = 0; _m < 4; ++_m) { const int row = (m0_) + _wr * 64 + _m * 16 + _fr; \
  _Pragma("unroll") for (int _q = 0; _q < (NT_) / 2; ++_q) { const int col = (n0_) + _wc * (16 * (NT_)) + _q * 32 + 8 * _fq; (void)col; \
    float v[8] = {acc_[_m][2 * _q][0], acc_[_m][2 * _q][1], acc_[_m][2 * _q][2], acc_[_m][2 * _q][3], \
                  acc_[_m][2 * _q + 1][0], acc_[_m][2 * _q + 1][1], acc_[_m][2 * _q + 1][2], acc_[_m][2 * _q + 1][3]}; \
    if (row < (mvalid_)) {
#define EPI_END }}}}

DI int mtile_row0(int mt, bool latonly, int TH) {
  if (!latonly) return mt * TH;
  const int per = SEQ / TH, b = mt / per, r = mt % per;
  return b * TOK + CTXL + r * TH;
}
DI int mtiles(bool latonly, int TH) { return latonly ? BATCH * (SEQ / TH) : (NTOK + TH - 1) / TH; }

struct LP {
  int l; bool last;
  const float* mod;
  char* we;
  char* s5;
};
DI LP make_lp(const Params& p, int l) {
  LP q; q.l = l; q.last = (l == DEPTH - 1);
  q.mod = (const float*)(p.ws + OFF_MOD) + (size_t)l * NB1 * 6144;
  q.we = p.ws + OFF_WEARLY + (size_t)l * WE_SIZE;
  q.s5 = p.ws + OFF_S5TAB + (size_t)l * S5_SIZE;
  return q;
}

template <class RowMap>
DI void conv_tile(const float* src, int lds, int nsrc, const float* kscale, bf16* dst, int K, int k0, int n0, char* smem, RowMap rowmap, int ndst = 1 << 30) {
  (void)smem;
  const int tid = tid_(), n4 = (tid & 63) * 4, k8 = (tid >> 6) * 8;
  float4 v[8];
  const bool ok = (n0 + n4 < nsrc);
  const float* sp = src + (size_t)(k0 + k8) * lds + n0 + n4;
#pragma unroll
  for (int k = 0; k < 8; ++k) v[k] = ok ? *(const float4*)(sp + (size_t)k * lds) : make_float4(0.f, 0.f, 0.f, 0.f);
  if (kscale) {
#pragma unroll
    for (int k = 0; k < 8; ++k) { const float sc = kscale[k0 + k8 + k]; v[k].x *= sc; v[k].y *= sc; v[k].z *= sc; v[k].w *= sc; }
  }
  float o[8];
#pragma unroll
  for (int k = 0; k < 8; ++k) o[k] = v[k].x;
  if (n0 + n4 + 0 < ndst) st8bf(dst + (size_t)rowmap(n0 + n4 + 0) * K + k0 + k8, o);
#pragma unroll
  for (int k = 0; k < 8; ++k) o[k] = v[k].y;
  if (n0 + n4 + 1 < ndst) st8bf(dst + (size_t)rowmap(n0 + n4 + 1) * K + k0 + k8, o);
#pragma unroll
  for (int k = 0; k < 8; ++k) o[k] = v[k].z;
  if (n0 + n4 + 2 < ndst) st8bf(dst + (size_t)rowmap(n0 + n4 + 2) * K + k0 + k8, o);
#pragma unroll
  for (int k = 0; k < 8; ++k) o[k] = v[k].w;
  if (n0 + n4 + 3 < ndst) st8bf(dst + (size_t)rowmap(n0 + n4 + 3) * K + k0 + k8, o);
}
struct RowId { DI int operator()(int n) const { return n; } };
struct RowGU { int half; DI int operator()(int f) const { return (f >> 7) * 256 + half * 128 + (f & 127); } };

constexpr int CT_WIN = 16 * (N_INP / 256), CT_UQ = 4 * 2, CT_UKV = 2 * 2, CT_GLU = 4, CT_WB = 4 * 16, CT_WOUT = 64;
constexpr int CT_EARLY = CT_WIN + CT_UQ + CT_UKV + CT_GLU + CT_WB + CT_WOUT;
constexpr int CT_EXP = NE * 3 * 64;

DI void conv_early_item(const Params& p, int l, int it, char* smem) {
  char* we = p.ws + OFF_WEARLY + (size_t)l * WE_SIZE;
  if (it < CT_WIN) {
    int kt = it % 16, nt = it / 16;
    conv_tile(p.in[I_WIN] + (size_t)l * 1024 * N_IN, N_IN, N_IN, nullptr, (bf16*)(we + WE_WIN), 1024, kt * 64, nt * 256, smem, RowId());
    return;
  }
  it -= CT_WIN;
  if (it < CT_UQ) {
    int kt = it % 4, nt = it / 4;
    conv_tile(p.in[I_WUQ] + (size_t)l * 256 * 384, 384, 384, p.in[I_GCQ] + l * 256, (bf16*)(we + WE_UQ), 256, kt * 64, nt * 256, smem, RowId(), 384);
    return;
  }
  it -= CT_UQ;
  if (it < CT_UKV) {
    int kt = it % 2, nt = it / 2;
    conv_tile(p.in[I_WUKV] + (size_t)l * 128 * 512, 512, 512, p.in[I_GCKV] + l * 128, (bf16*)(we + WE_UKV), 128, kt * 64, nt * 256, smem, RowId());
    return;
  }
  it -= CT_UKV;
  if (it < CT_GLU) {
    int kt = it;
    conv_tile(p.in[I_S5WGLU] + (size_t)l * 256 * 256, 256, 256, nullptr, (bf16*)(we + WE_GLU), 256, kt * 64, 0, smem, RowId());
    return;
  }
  it -= CT_GLU;
  if (it < CT_WB) {
    int j = it / 16, r = it % 16, kt = r % 4, nt = r / 4;
    conv_tile(p.in[I_WBRANCH] + ((size_t)l * 4 + j) * 256 * 1024, 1024, 1024, nullptr, (bf16*)(we + WE_WB) + (size_t)j * 1024 * 256, 256, kt * 64, nt * 256, smem, RowId());
    return;
  }
  it -= CT_WB;
  {
    int kt = it % 16, nt = it / 16;
    conv_tile(p.in[I_WOUT] + (size_t)l * 1024 * 1024, 1024, 1024, nullptr, (bf16*)(we + WE_WOUT), 1024, kt * 64, nt * 256, smem, RowId());
  }
}
DI void conv_expert_item(const Params& p, int l, int it, char* smem) {
  char* wx = p.ws + OFF_MIX;
  int e = it / 192, r = it % 192, which = r / 64, t = r % 64, kt = t % 16, nt = t / 16;
  size_t eoff = ((size_t)l * NE + e) * 1024 * 1024;
  if (which == 0) { RowGU rm; rm.half = 0; conv_tile(p.in[I_WGATE] + eoff, 1024, 1024, nullptr, (bf16*)(wx + WX_GU) + (size_t)e * 2048 * 1024, 1024, kt * 64, nt * 256, smem, rm); }
  else if (which == 1) { RowGU rm; rm.half = 1; conv_tile(p.in[I_WUP] + eoff, 1024, 1024, nullptr, (bf16*)(wx + WX_GU) + (size_t)e * 2048 * 1024, 1024, kt * 64, nt * 256, smem, rm); }
  else conv_tile(p.in[I_WDOWN] + eoff, 1024, 1024, nullptr, (bf16*)(wx + WX_DN) + (size_t)e * 1024 * 1024, 1024, kt * 64, nt * 256, smem, RowId());
}

DI void mod_item(const Params& p, int it, char* smem) {
  const int l = it / 96, cg0 = (it % 96) * 64;
  float* sc = (float*)smem;
  float* red = sc + NB1 * 1024;
  const int tid = tid_();
  __syncthreads();
  for (int i = tid; i < NB1 * 1024; i += NTHREADS) {
    int r = i >> 10, k = i & 1023;
    float c = (r < BATCH) ? p.in[I_C][r * 1024 + k] : p.in[I_CCTX][k];
    sc[i] = siluf_(c);
  }
  __syncthreads();
  const int cl = tid & 63, kg = tid >> 6;
  float acc[NB1];
#pragma unroll
  for (int r = 0; r < NB1; ++r) acc[r] = 0.f;
  const float* w = p.in[I_WADA] + (size_t)l * 1024 * 6144 + cg0 + cl;
  for (int k0 = kg * (1024 / NWAVES); k0 < (kg + 1) * (1024 / NWAVES); k0 += 16) {
    float wv[16];
#pragma unroll
    for (int u = 0; u < 16; ++u) wv[u] = w[(size_t)(k0 + u) * 6144];
#pragma unroll
    for (int u = 0; u < 16; ++u)
#pragma unroll
      for (int r = 0; r < NB1; ++r) acc[r] += sc[r * 1024 + k0 + u] * wv[u];
  }
#pragma unroll
  for (int r = 0; r < NB1; ++r) red[(kg * NB1 + r) * 64 + cl] = acc[r];
  __syncthreads();
  for (int i = tid; i < NB1 * 64; i += NTHREADS) {
    int r = i >> 6, c = i & 63;
    float s = 0.f;
#pragma unroll
    for (int q = 0; q < NWAVES; ++q) s += red[(q * NB1 + r) * 64 + c];
    s += p.in[I_BADA][l * 6144 + cg0 + c];
    ((float*)(p.ws + OFF_MOD))[((size_t)l * NB1 + r) * 6144 + cg0 + c] = s;
  }
}

DI void s5_tab_item(const Params& p, int it, char* smem) {
  const int l = it / 32, d = (it / 16) & 1, g = it & 15;
  char* s5 = p.ws + OFF_S5TAB + (size_t)l * S5_SIZE;
  float* lampow = (float*)(s5 + S5_LAMPOW) + (size_t)(d * 16 + g) * 17 * 64 * 2;
  float* bbar = (float*)(s5 + S5_BBAR) + (size_t)(d * 16 + g) * 64 * 16 * 2;
  float* kt = (float*)(s5 + S5_KT) + (size_t)(d * 16 + g) * 16 * 256;
  float* slam = (float*)smem;
  float* sbb = slam + 17 * 64 * 2;
  const int tid = tid_();
  const size_t pg = ((size_t)(l * 2 + d) * 16 + g);
  const float step = expf(p.in[I_S5LOGSTEP][pg]);
  __syncthreads();
  for (int i = tid; i < 17 * 64; i += NTHREADS) {
    int j = i >> 6, pp = i & 63;
    float are = p.in[I_S5ARE][pg * 64 + pp], aim = p.in[I_S5AIM][pg * 64 + pp];
    float mag = expf((float)j * step * are), ang = (float)j * step * aim;
    float re = mag * cosf(ang), im = mag * sinf(ang);
    slam[i * 2] = re; slam[i * 2 + 1] = im; lampow[i * 2] = re; lampow[i * 2 + 1] = im;
  }
  __syncthreads();
  for (int i = tid; i < 64 * 16; i += NTHREADS) {
    int pp = i >> 4;
    float are = p.in[I_S5ARE][pg * 64 + pp], aim = p.in[I_S5AIM][pg * 64 + pp];
    float x = slam[(64 + pp) * 2] - 1.0f, y = slam[(64 + pp) * 2 + 1];
    float den = are * are + aim * aim;
    float qre = (x * are + y * aim) / den, qim = (y * are - x * aim) / den;
    float bre = p.in[I_S5BRE][pg * 1024 + i], bim = p.in[I_S5BIM][pg * 1024 + i];
    float re = qre * bre - qim * bim, im = qre * bim + qim * bre;
    sbb[i * 2] = re; sbb[i * 2 + 1] = im; bbar[i * 2] = re; bbar[i * 2 + 1] = im;
  }
  __syncthreads();
  for (int i = tid; i < 16 * 256; i += NTHREADS) {
    int j = i >> 8, c = (i >> 4) & 15, c2 = i & 15;
    float s = 0.f;
    for (int pp = 0; pp < 64; ++pp) {
      float cre = p.in[I_S5CRE][pg * 1024 + c * 64 + pp], cim = p.in[I_S5CIM][pg * 1024 + c * 64 + pp];
      float lre = slam[(j * 64 + pp) * 2], lim = slam[(j * 64 + pp) * 2 + 1];
      float tre = cre * lre - cim * lim, tim = cre * lim + cim * lre;
      float bre = sbb[(pp * 16 + c2) * 2], bim = sbb[(pp * 16 + c2) * 2 + 1];
      s += tre * bre - tim * bim;
    }
    kt[i] = s;
  }
}
DI void s5_mat_item(const Params& p, int it) {
  const int l = it / 256, g = (it / 16) & 15, q = it & 15;
  char* s5 = p.ws + OFF_S5TAB + (size_t)l * S5_SIZE;
  const float* lampow = (const float*)(s5 + S5_LAMPOW);
  const float* bbar = (const float*)(s5 + S5_BBAR);
  const float* ktab = (const float*)(s5 + S5_KT);
  bf16* WA = (bf16*)(s5 + S5_WA) + (size_t)g * 256 * 256;
  bf16* W2 = (bf16*)(s5 + S5_W2) + (size_t)g * 256 * 512;
  const int tid = tid_();
  for (int i = tid; i < 16 * 256; i += NTHREADS) {
    int n = q * 16 + (i >> 8), k = i & 255;
    int d = n >> 7, ri = (n >> 6) & 1, pp = n & 63, s = k >> 4, c2 = k & 15;
    int e = (d == 0) ? (15 - s) : s;
    const float* lp = lampow + ((size_t)((d * 16 + g) * 17 + e) * 64 + pp) * 2;
    const float* bp = bbar + ((size_t)((d * 16 + g) * 64 + pp) * 16 + c2) * 2;
    float re = lp[0] * bp[0] - lp[1] * bp[1], im = lp[0] * bp[1] + lp[1] * bp[0];
    WA[(size_t)n * 256 + k] = f2bf(ri == 0 ? re : im);
  }
  for (int i = tid; i < 16 * 512; i += NTHREADS) {
    int n = q * 16 + (i >> 9), k = i & 511;
    int lq = n >> 4, c = n & 15;
    float v;
    if (k < 256) {
      int s = k >> 4, c2 = k & 15;
      v = 0.f;
      if (s <= lq) v += ktab[((size_t)(0 * 16 + g) * 16 + (lq - s)) * 256 + c * 16 + c2];
      if (s >= lq) v += ktab[((size_t)(1 * 16 + g) * 16 + (s - lq)) * 256 + c * 16 + c2];
      if (s == lq && c == c2) v += p.in[I_S5D][l * 256 + g * 16 + c];
    } else {
      int kk = k - 256, d = kk >> 7, ri = (kk >> 6) & 1, pp = kk & 63;
      int e = (d == 0) ? (lq + 1) : (16 - lq);
      size_t pg = ((size_t)(l * 2 + d) * 16 + g);
      float cre = p.in[I_S5CRE][pg * 1024 + c * 64 + pp], cim = p.in[I_S5CIM][pg * 1024 + c * 64 + pp];
      const float* lp = lampow + ((size_t)((d * 16 + g) * 17 + e) * 64 + pp) * 2;
      float re = cre * lp[0] - cim * lp[1], im = cre * lp[1] + cim * lp[0];
      v = (ri == 0) ? re : -im;
    }
    W2[(size_t)n * 512 + k] = f2bf(v);
  }
}

DI int tok_b(int tok) { return tok / TOK; }
DI int tok_j(int tok) { return tok % TOK; }
DI int tok_modrow(int tok) { return (tok_j(tok) < CTXL) ? BATCH : tok_b(tok); }

DI void normmod_row(const float (&xv)[16], const float* g, const float* shift, const float* scale, bf16* dst, float (&hout)[16]) {
  const int lane = tid_() & 63;
  float ss = 0.f;
#pragma unroll
  for (int i = 0; i < 16; ++i) ss += xv[i] * xv[i];
  ss = wave_sum(ss);
  const float rs = rsqrtf(ss * (1.0f / 1024.f) + EPS);
#pragma unroll
  for (int i = 0; i < 4; ++i) {
    int c = lane * 4 + i * 256;
    float4 gv = *(const float4*)(g + c), sh = *(const float4*)(shift + c), sc = *(const float4*)(scale + c);
    float h0 = xv[i * 4 + 0] * rs * gv.x * (1.f + sc.x) + sh.x;
    float h1 = xv[i * 4 + 1] * rs * gv.y * (1.f + sc.y) + sh.y;
    float h2 = xv[i * 4 + 2] * rs * gv.z * (1.f + sc.z) + sh.z;
    float h3 = xv[i * 4 + 3] * rs * gv.w * (1.f + sc.w) + sh.w;
    hout[i * 4 + 0] = h0; hout[i * 4 + 1] = h1; hout[i * 4 + 2] = h2; hout[i * 4 + 3] = h3;
    *(uint2*)(dst + c) = make_uint2(pack2(h0, h1), pack2(h2, h3));
  }
}

DI void prep_row_item(const Params& p, int it) {
  const int tok = it * NWAVES + (tid_() >> 6), lane = tid_() & 63;
  const int b = tok_b(tok), j = tok_j(tok);
  const float* src = (j < CTXL) ? p.in[I_CTX] + ((size_t)b * CTXL + j) * 1024 : p.in[I_X] + ((size_t)b * SEQ + (j - CTXL)) * 1024;
  float xv[16], h[16];
#pragma unroll
  for (int i = 0; i < 4; ++i) {
    float4 v = *(const float4*)(src + lane * 4 + i * 256);
    xv[i * 4] = v.x; xv[i * 4 + 1] = v.y; xv[i * 4 + 2] = v.z; xv[i * 4 + 3] = v.w;
  }
  const float* mod = (const float*)(p.ws + OFF_MOD) + (size_t)tok_modrow(tok) * 6144;
  normmod_row(xv, p.in[I_GPREMIX], mod + 0, mod + 1024, (bf16*)(p.ws + OFF_HA) + (size_t)tok * 1024, h);
}

constexpr int IP_LT = BATCH * (SEQ / 256), IP_CT = BATCH * ((CTXL + 255) / 256), IP_MT = IP_LT + IP_CT, IP_NT = N_INP / 256;
constexpr int IP_RR = (IP_MT + 7) / 8, IP_RC = (IP_NT + 1) / 2;
constexpr int IP_RC_NOGATE = (((C_GATE + 255) / 256) + 1) / 2;
constexpr int IP_RR_LAT = IP_LT / 8;
constexpr bool IP_COMPACT = (IP_LT % 8 == 0);
constexpr int IP_RECTS_ALL = IP_RR * IP_RC, IP_RECTS_LAST = IP_COMPACT ? (IP_RR * IP_RC_NOGATE + IP_RR_LAT * (IP_RC - IP_RC_NOGATE)) : IP_RECTS_ALL;
constexpr int IP_SLOTS_ALL = ((IP_RECTS_ALL + 15) / 16) * 256, IP_SLOTS_LAST = ((IP_RECTS_LAST + 15) / 16) * 256;
DI void inproj_tile(const Params& p, const LP& L, int t, char* smem) {
  const int vb = t % 256, vround = t / 256, x = vb % 8, j = vb / 8;
  const int Rc = vround * 16 + x * 2 + (j >> 4), jj = j & 15;
  int rm, rn;
  if (!L.last || !IP_COMPACT || Rc < IP_RR * IP_RC_NOGATE) { rm = Rc % IP_RR; rn = Rc / IP_RR; }
  else { const int q = Rc - IP_RR * IP_RC_NOGATE; rm = q % IP_RR_LAT; rn = IP_RC_NOGATE + q / IP_RR_LAT; }
  const int mt = rm * 8 + (jj & 7), nt = rn * 2 + (jj >> 3);
  if (mt >= IP_MT || nt >= IP_NT || rn >= IP_RC) return;
  int m0;
  if (mt < IP_LT) m0 = (mt / (SEQ / 256)) * TOK + CTXL + (mt % (SEQ / 256)) * 256;
  else { const int c = mt - IP_LT; m0 = (c / ((CTXL + 255) / 256)) * TOK + (c % ((CTXL + 255) / 256)) * 256; }
  const int n0 = nt * 256;
  const int mv = (mt < IP_LT) ? NTOK : (m0 - (m0 % TOK) + CTXL);
  if (L.last && mt >= IP_LT && n0 >= ((C_GATE + 255) / 256) * 256) return;
  GA g = make_ga((const bf16*)(p.ws + OFF_HA), 1024, (const bf16*)(L.we + WE_WIN), 1024, 1024, mv);
  f32x4 acc[2][2][4][2];
  gemm_big(g, m0, n0, smem, acc);
  bf16* P1 = (bf16*)(p.ws + OFF_P1);
  bf16* PG = (bf16*)(p.ws + OFF_PG);
  bf16* US5 = (bf16*)(p.ws + OFF_MIX + MX_US5);
  float* DT = (float*)(p.ws + OFF_DT);
  const float* dtb = p.in[I_M2DTBIAS] + L.l * 8;
  EPIB_BEGIN(acc, m0, n0, mv)
    if (col < C_S5 || (col >= C_Z && col < C_DT)) st8bf(P1 + (size_t)row * P1W + col, v);
    else if (col < C_Z) st8bf(US5 + ((size_t)((col - C_S5) >> 4) * NTOK + row) * 16 + (col & 15), v);
    else if (col < C_GATE) {
#pragma unroll
      for (int k = 0; k < 8; ++k) v[k] = softplusf_(v[k] + dtb[k]);
      st8f(DT + (size_t)row * 8, v);
    } else if (col < N_IN) {
#pragma unroll
      for (int k = 0; k < 8; ++k) v[k] = sigmoidf_(v[k]);
      st8bf(PG + (size_t)row * 4096 + (col - C_GATE), v);
    }
  EPIB_END
}

DI void rowscale_256(const bf16* P1, int m0, int c0, int width, float* srs) {
  const int r = tid_() >> 1, hf = tid_() & 1;
  int gr = m0 + r; if (gr > NTOK - 1) gr = NTOK - 1;
  const bf16* src = P1 + (size_t)gr * P1W + c0 + hf * (width / 2);
  float ss = 0.f;
  for (int i = 0; i < width / 2; i += 8) {
    float v[8]; ld8bf(src + i, v);
#pragma unroll
    for (int k = 0; k < 8; ++k) ss += v[k] * v[k];
  }
  ss += shfl_xor_(ss, 1);
  if (hf == 0) srs[r] = rsqrtf(ss / (float)width + EPS);
}
DI void rope_tab_item(const Params& p) {
  float* tab = (float*)(p.ws + OFF_ROPE);
  for (int i = tid_(); i < 64 * 8; i += NTHREADS) {
    int pos = i >> 3, k = i & 7;
    float f = expf(-(float)k * (9.210340371976184f / 8.0f));
    float a = (float)pos * f;
    tab[i * 2] = cosf(a); tab[i * 2 + 1] = sinf(a);
  }
}
DI void rope_cs(const float* tab, int pos, int i, float& c, float& s) { c = tab[(pos * 8 + i) * 2]; s = tab[(pos * 8 + i) * 2 + 1]; }

constexpr int TP_MT = (NTOK + 255) / 256;
DI void mlaq_tile(const Params& p, const LP& L, int t, char* smem) {
  const int mt = t % TP_MT, nt = t / TP_MT, m0 = mt * 256, n0 = nt * 128;
  const bf16* P1 = (const bf16*)(p.ws + OFF_P1);
  float* srs = (float*)(smem + SRS_OFF);
  GA g = make_ga(P1 + C_CQ, P1W, (const bf16*)(L.we + WE_UQ), 256, 256, NTOK);
  f32x4 acc[4][4];
  gemm_s<4>(g, m0, n0, smem, acc);
  rowscale_256(P1, m0, C_CQ, 256, srs);
  __syncthreads();
  bf16* Q = (bf16*)(p.ws + OFF_MIX + MX_Q);
  const float* ropetab = (const float*)(p.ws + OFF_ROPE);
  {
    const int l = tid_() & 63, w = tid_() >> 6, wr = w >> 1, wc = w & 1, fr = l & 15, fq = l >> 4;
#pragma unroll
    for (int m = 0; m < 4; ++m) {
      const int row = m0 + wr * 64 + m * 16 + fr;
      const int rowc = row < NTOK ? row : NTOK - 1;
      const float rsc = srs[rowc - m0];
      const int b = tok_b(rowc), j = tok_j(rowc);
#pragma unroll
      for (int q = 0; q < 2; ++q) {
        const int col = n0 + wc * 64 + q * 32 + 8 * fq;
        const int h = col / 96, dd = col % 96;
        float v[8] = {acc[m][2 * q][0], acc[m][2 * q][1], acc[m][2 * q][2], acc[m][2 * q][3], acc[m][2 * q + 1][0], acc[m][2 * q + 1][1], acc[m][2 * q + 1][2], acc[m][2 * q + 1][3]};
        float vp[8];
#pragma unroll
        for (int k = 0; k < 8; ++k) vp[k] = shfl_xor_(v[k], 16);
        if (dd >= 64 && j >= CTXL) {
          const int tl = j - CTXL, pos = ((dd - 64) < 16) ? (tl / GRID_W) : (tl % GRID_W);
          const bool lo = ((dd & 8) == 0);
#pragma unroll
          for (int k = 0; k < 8; ++k) {
            float c, sn; rope_cs(ropetab, pos, k, c, sn);
            v[k] = lo ? (v[k] * c - vp[k] * sn) : (v[k] * c + vp[k] * sn);
          }
        }
#pragma unroll
        for (int k = 0; k < 8; ++k) v[k] *= rsc;
        if (row < NTOK) st8bf(Q + (((size_t)b * 4 + h) * TOK + j) * 96 + dd, v);
      }
    }
  }
}
DI void mlakv_tile(const Params& p, const LP& L, int t, char* smem) {
  const int mt = t % TP_MT, h = t / TP_MT, m0 = mt * 256, n0 = h * 128;
  const bf16* P1 = (const bf16*)(p.ws + OFF_P1);
  float* srs = (float*)(smem + SRS_OFF);
  GA g = make_ga(P1 + C_CKV, P1W, (const bf16*)(L.we + WE_UKV), 128, 128, NTOK);
  f32x4 acc[4][4];
  gemm_s<4>(g, m0, n0, smem, acc);
  rowscale_256(P1, m0, C_CKV, 128, srs);
  __syncthreads();
  bf16* K = (bf16*)(p.ws + OFF_MIX + MX_K);
  bf16* VT = (bf16*)(p.ws + OFF_MIX + MX_VTM);
  const float* ropetab = (const float*)(p.ws + OFF_ROPE);
  EPI_BEGIN(4, acc, m0, n0, NTOK)
    const float rsc = srs[row - m0];
    const int b = tok_b(row), j = tok_j(row), dd = col - n0;
#pragma unroll
    for (int k = 0; k < 8; ++k) v[k] *= rsc;
    if (dd < 64) st8bf(K + (((size_t)b * 4 + h) * TOK + j) * 96 + dd, v);
    else {
#pragma unroll
      for (int k = 0; k < 8; ++k) VT[(((size_t)b * 4 + h) * 64 + (dd - 64 + k)) * TOK + j] = f2bf(v[k]);
    }
  EPI_END
  for (int i = tid_(); i < 256 * 16; i += NTHREADS) {
    int r = i >> 4, q = i & 15;
    int row = m0 + r;
    if (row < NTOK) {
      int b = tok_b(row), j = tok_j(row);
      int blk = q >> 3, i8 = q & 7;
      float x1 = bf2f(P1[(size_t)row * P1W + C_KR + blk * 16 + i8]), x2 = bf2f(P1[(size_t)row * P1W + C_KR + blk * 16 + i8 + 8]);
      float o1 = x1, o2 = x2;
      if (j >= CTXL) {
        int tl = j - CTXL, pos = blk == 0 ? (tl / GRID_W) : (tl % GRID_W);
        float c, sn; rope_cs(ropetab, pos, i8, c, sn);
        o1 = x1 * c - x2 * sn; o2 = x2 * c + x1 * sn;
      }
      bf16* kd = K + (((size_t)b * 4 + h) * TOK + j) * 96 + 64 + blk * 16 + i8;
      kd[0] = f2bf(o1); kd[8] = f2bf(o2);
    }
  }
}
DI void navt_item(const Params& p, int it, char* smem) {
  bf16* s = (bf16*)smem;
  const bf16* P1 = (const bf16*)(p.ws + OFF_P1);
  bf16* VT = (bf16*)(p.ws + OFF_MIX + MX_VTN);
  const int tok0 = it * 64, tid = tid_();
  const int b = tok_b(tok0), j0 = tok_j(tok0);
  __syncthreads();
  for (int i = tid; i < 64 * 32; i += NTHREADS) {
    int r = i >> 5, c8 = i & 31;
    *(uint4*)(s + r * 264 + c8 * 8) = *(const uint4*)(P1 + (size_t)(tok0 + r) * P1W + C_NA + 512 + c8 * 8);
  }
  __syncthreads();
  for (int i = tid; i < 256 * 8; i += NTHREADS) {
    int ch = i >> 3, t8 = i & 7;
    unsigned w[4];
#pragma unroll
    for (int q = 0; q < 4; ++q) w[q] = (unsigned)s[(t8 * 8 + 2 * q) * 264 + ch] | ((unsigned)s[(t8 * 8 + 2 * q + 1) * 264 + ch] << 16);
    *(uint4*)(VT + ((size_t)b * 256 + ch) * TOK + j0 + t8 * 8) = make_uint4(w[0], w[1], w[2], w[3]);
  }
}
constexpr int M2C_TOK = 128, M2C_ITEMS = NTOK / M2C_TOK;
DI void m2conv_item(const Params& p, const LP& L, int it) {
  const bf16* P1 = (const bf16*)(p.ws + OFF_P1);
  bf16* XB = (bf16*)(p.ws + OFF_MIX + MX_XBC);
  const int tok0 = it * M2C_TOK;
  const float* cw = p.in[I_M2CONVW] + (size_t)L.l * 4 * 768;
  const float* cb = p.in[I_M2CONVB] + (size_t)L.l * 768;
  for (int task = tid_(); task < 96 * (M2C_TOK / 8); task += NTHREADS) {
    const int cg = task % 96, tb = task / 96, c0 = cg * 8;
    const int tokb = tok0 + tb * 8, jt = tok_j(tokb), base = tokb - jt;
    const int slo = (jt < CTXL) ? 0 : CTXL, shi = (jt < CTXL) ? CTXL : TOK;
    float w[4][8], bias[8];
#pragma unroll
    for (int k = 0; k < 4; ++k) { float4 a = *(const float4*)(cw + k * 768 + c0), b4 = *(const float4*)(cw + k * 768 + c0 + 4);
      w[k][0] = a.x; w[k][1] = a.y; w[k][2] = a.z; w[k][3] = a.w; w[k][4] = b4.x; w[k][5] = b4.y; w[k][6] = b4.z; w[k][7] = b4.w; }
    { float4 a = *(const float4*)(cb + c0), b4 = *(const float4*)(cb + c0 + 4);
      bias[0] = a.x; bias[1] = a.y; bias[2] = a.z; bias[3] = a.w; bias[4] = b4.x; bias[5] = b4.y; bias[6] = b4.z; bias[7] = b4.w; }
    float xin[11][8];
#pragma unroll
    for (int r = 0; r < 11; ++r) {
      const int j = jt - 2 + r;
      if (j >= slo && j < shi) ld8bf(P1 + (size_t)(base + j) * P1W + C_XBC + c0, xin[r]);
      else {
#pragma unroll
        for (int c = 0; c < 8; ++c) xin[r][c] = 0.f;
      }
    }
    float y[8][8];
#pragma unroll
    for (int t = 0; t < 8; ++t) {
#pragma unroll
      for (int c = 0; c < 8; ++c) y[t][c] = siluf_(bias[c] + w[0][c] * xin[t][c] + w[1][c] * xin[t + 1][c] + w[2][c] * xin[t + 2][c] + w[3][c] * xin[t + 3][c]);
      st8bf(XB + (size_t)(base + jt + t) * 768 + c0, y[t]);
    }
    if (c0 < 512) {
      bf16* XT = (bf16*)(p.ws + OFF_MIX + MX_XBT) + ((size_t)(base / TOK) * 512 + c0) * TOK + jt;
#pragma unroll
      for (int c = 0; c < 8; ++c) {
        float col[8];
#pragma unroll
        for (int t = 0; t < 8; ++t) col[t] = y[t][c];
        st8bf(XT + (size_t)c * TOK, col);
      }
    }
  }
}
DI int m2_seq2tok(int sq, int dir) { return (dir == 0) ? sq : (sq < CTXL ? (CTXL - 1 - sq) : (TOK - 1 - (sq - CTXL))); }
constexpr int M2S_ITEMS = BATCH * 8 * (TOK / 64) / NWAVES;
DI void m2scal_item(const Params& p, const LP& L, int it) {
  const int w = it * NWAVES + (tid_() >> 6), lane = tid_() & 63;
  const int ch = w % (TOK / 64), r = w / (TOK / 64), hd = r & 3, dir = (r >> 2) & 1, b = r >> 3;
  const float a = -expf(p.in[I_M2ALOG][(L.l * 2 + dir) * 4 + hd]);
  const int sq = ch * 64 + lane, j = m2_seq2tok(sq, dir);
  const float dt = ((const float*)(p.ws + OFF_DT))[((size_t)b * TOK + j) * 8 + dir * 4 + hd];
  float cs = dt * a;
#pragma unroll
  for (int d = 1; d < 64; d <<= 1) { float o = shfl_up_(cs, d); if (lane >= d) cs += o; }
  const float sl = shfl_(cs, 63);
  float* o = (float*)(p.ws + OFF_MIX + MX_M2S) + ((size_t)((b * 2 + dir) * 4 + hd) * TOK + sq) * 4;
  *(float4*)o = make_float4(cs, dt, dt * __expf(sl - cs), cs * 1.4426950408889634f - log2f(dt));
}
constexpr int S5_MT = (MCH + 255) / 256;
DI void s5a_tile(const Params& p, const LP& L, int t, char* smem) {
  const int g = t / (S5_MT * 2), r = t % (S5_MT * 2), mt = r / 2, nt = r % 2;
  const int m0 = mt * 256, n0 = nt * 128;
  GA ga = make_ga((const bf16*)(p.ws + OFF_MIX + MX_US5) + (size_t)g * NTOK * 16, 256, (const bf16*)(L.s5 + S5_WA) + (size_t)g * 65536, 256, 256, MCH);
  f32x4 acc[4][4];
  gemm_s<4>(ga, m0, n0, smem, acc);
  float* HE = (float*)(p.ws + OFF_MIX + MX_HEND) + (size_t)g * MCH * 256;
  EPI_BEGIN(4, acc, m0, n0, MCH)
    st8f(HE + (size_t)row * 256 + col, v);
  EPI_END
}
DI int s5_chunk_of(int i, int d) { return (d == 0) ? i : (i < NCC ? (NCC - 1 - i) : (NCH - 1 - (i - NCC))); }
DI void s5carry_item(const Params& p, const LP& L, int it) {
  const int w = it * NWAVES + (tid_() >> 6), lane = tid_() & 63;
  const int d = w / (16 * BATCH), g = (w / BATCH) & 15, b = w % BATCH;
  const float* lp = (const float*)(L.s5 + S5_LAMPOW) + ((size_t)((d * 16 + g) * 17 + 16) * 64 + lane) * 2;
  const float lre = lp[0], lim = lp[1];
  const float* HE = (const float*)(p.ws + OFF_MIX + MX_HEND) + ((size_t)g * MCH + (size_t)b * NCH) * 256 + d * 128;
  bf16* HI = (bf16*)(p.ws + OFF_MIX + MX_HIN) + ((size_t)g * MCH + (size_t)b * NCH) * 256 + d * 128;
  float cre = 0.f, cim = 0.f;
  static_assert(NCH % 4 == 0, "chunk count");
  for (int i0 = 0; i0 < NCH; i0 += 4) {
    float hre[4], him[4];
#pragma unroll
    for (int k = 0; k < 4; ++k) { const int ch = s5_chunk_of(i0 + k, d); hre[k] = HE[(size_t)ch * 256 + lane]; him[k] = HE[(size_t)ch * 256 + 64 + lane]; }
#pragma unroll
    for (int k = 0; k < 4; ++k) {
      const int ch = s5_chunk_of(i0 + k, d);
      HI[(size_t)ch * 256 + lane] = f2bf(cre); HI[(size_t)ch * 256 + 64 + lane] = f2bf(cim);
      const float nre = lre * cre - lim * cim + hre[k], nim = lre * cim + lim * cre + him[k];
      cre = nre; cim = nim;
    }
  }
}
DI void s5c_tile(const Params& p, const LP& L, int t, char* smem) {
  const int g = t / (S5_MT * 2), r = t % (S5_MT * 2), mt = r / 2, nt = r % 2;
  const int m0 = mt * 256, n0 = nt * 128;
  GA ga = make_ga((const bf16*)(p.ws + OFF_MIX + MX_US5) + (size_t)g * NTOK * 16, 256, (const bf16*)(L.s5 + S5_W2) + (size_t)g * 256 * 512, 512, 512, MCH);
  ga.A2 = (const bf16*)(p.ws + OFF_MIX + MX_HIN) + (size_t)g * MCH * 256; ga.lda2 = 256; ga.ksplit = 256;
  f32x4 acc[4][4];
  gemm_s<4>(ga, m0, n0, smem, acc);
  bf16* Z = (bf16*)(p.ws + OFF_MIX + MX_Z);
  EPI_BEGIN(4, acc, m0, n0, MCH)
#pragma unroll
    for (int k = 0; k < 8; ++k) v[k] = geluf_(v[k]);
    st8bf(Z + ((size_t)row * 16 + (col >> 4)) * 256 + g * 16 + (col & 15), v);
  EPI_END
}

#ifdef EMU
DI float fmax_(float a, float b) { return a > b ? a : b; }
#else
DI float fmax_(float a, float b) { return __builtin_fmaxf(a, b); }
#endif
constexpr int AT_LDV = 76;
struct NaInfo { int r, qc, rs, cs; };
template <int DK, bool NA>
DI void attn_block(const bf16* qrow, bool active, const bf16* Kp, int kstride, const bf16* Vt,
                   int ka0, int ntile_a, int arow0, int kb0, int ntile_b,
                   const float* srpb, NaInfo ni, float scale, bf16* orow, char* smem) {
  constexpr int LDK = DK + 8, KCH = DK / 8;
  constexpr int KT_BYTES = 64 * LDK * 2, VT_BYTES = 64 * AT_LDV * 2;
  constexpr int NKL = (64 * KCH + NTHREADS - 1) / NTHREADS;
  const int tid = tid_(), lane = tid & 63, half = lane >> 5, r = lane & 31;
  bf16* sK = (bf16*)smem;
  bf16* sV = (bf16*)(smem + 2 * KT_BYTES);
  bf16x8 qf[DK / 16];
  f32x16 o0, o1;
  float m = -1e30f, l = 0.f;
  const float scale2 = scale * 1.4426950408889634f;
#pragma unroll
  for (int ks = 0; ks < DK / 16; ++ks) qf[ks] = active ? *(const bf16x8*)(qrow + ks * 16 + 8 * half) : bf16x8{0, 0, 0, 0, 0, 0, 0, 0};
#pragma unroll
  for (int i = 0; i < 16; ++i) { o0[i] = 0.f; o1[i] = 0.f; }
  const int NTL = ntile_a + ntile_b;
  u32x4 rk[NKL], rv[1];
#pragma unroll
  for (int i = 0; i < NKL; ++i) rk[i] = u32x4{0u, 0u, 0u, 0u};
  auto key0_of = [&](int t) { return t < ntile_a ? ka0 + 64 * t : kb0 + 64 * (t - ntile_a); };
#define AT_GLOAD(t_) { const int k0_ = key0_of(t_); \
    _Pragma("unroll") for (int i_ = 0; i_ < NKL; ++i_) { const int c_ = tid + i_ * NTHREADS; const int key_ = c_ / KCH, ch_ = c_ % KCH; \
      if (c_ < 64 * KCH) rk[i_] = *(const u32x4*)(Kp + (size_t)(k0_ + key_) * kstride + ch_ * 8); } \
    { const int d_ = tid >> 3, ch_ = tid & 7; rv[0] = *(const u32x4*)(Vt + (size_t)d_ * TOK + k0_ + ch_ * 8); } }
#define AT_SSTORE(buf_) { \
    _Pragma("unroll") for (int i_ = 0; i_ < NKL; ++i_) { const int c_ = tid + i_ * NTHREADS; const int key_ = c_ / KCH, ch_ = c_ % KCH; \
      if (c_ < 64 * KCH) *(u32x4*)(sK + (buf_) * (64 * LDK) + key_ * LDK + ch_ * 8) = rk[i_]; } \
    { const int d_ = tid >> 3, ch_ = tid & 7; \
      bf16* dst_ = sV + (buf_) * (64 * AT_LDV) + d_ * AT_LDV + ch_ * 8; \
      *(uint2*)dst_ = make_uint2(rv[0][0], rv[0][1]); *(uint2*)(dst_ + 4) = make_uint2(rv[0][2], rv[0][3]); } }
  __syncthreads();
  AT_GLOAD(0) AT_SSTORE(0)
  __syncthreads();
#pragma unroll 1
  for (int t = 0; t < NTL; ++t) {
    const int buf = t & 1;
    if (t + 1 < NTL) AT_GLOAD(t + 1)
    bool doit = active;
    int trow0 = 0;
    if (NA && t < ntile_a) {
      trow0 = arow0 + t * (64 / GRID_W);
      doit = active && (trow0 + (64 / GRID_W) > ni.rs) && (trow0 < ni.rs + WIN_R);
    }
    if (doit) {
      const bf16* kb = sK + buf * (64 * LDK);
      const bf16* vb = sV + buf * (64 * AT_LDV);
      f32x16 s0, s1;
#pragma unroll
      for (int i = 0; i < 16; ++i) { s0[i] = 0.f; s1[i] = 0.f; }
      bf16x8 ka0[DK / 16], ka1[DK / 16];
#pragma unroll
      for (int ks = 0; ks < DK / 16; ++ks) {
        ka0[ks] = *(const bf16x8*)(kb + r * LDK + ks * 16 + 8 * half);
        ka1[ks] = *(const bf16x8*)(kb + (32 + r) * LDK + ks * 16 + 8 * half);
      }
      BG_SCHED;
#pragma unroll
      for (int ks = 0; ks < DK / 16; ++ks) {
        s0 = __builtin_amdgcn_mfma_f32_32x32x16_bf16(ka0[ks], qf[ks], s0, 0, 0, 0);
        s1 = __builtin_amdgcn_mfma_f32_32x32x16_bf16(ka1[ks], qf[ks], s1, 0, 0, 0);
      }
      uint2 va0[4], va1[4], vb0[4], vb1[4];
#pragma unroll
      for (int kq = 0; kq < 4; ++kq) {
        const bf16* v0 = vb + r * AT_LDV + 16 * kq + 4 * half;
        const bf16* v1 = vb + (r + 32) * AT_LDV + 16 * kq + 4 * half;
        va0[kq] = *(const uint2*)v0; va1[kq] = *(const uint2*)(v0 + 8); vb0[kq] = *(const uint2*)v1; vb1[kq] = *(const uint2*)(v1 + 8);
      }
      BG_SCHED;
      float mx = -INFINITY;
      if (NA && t < ntile_a) {
#pragma unroll
        for (int i = 0; i < 16; ++i) {
          const int kk = (i & 3) + 8 * (i >> 2) + 4 * half;
#pragma unroll
          for (int hb = 0; hb < 2; ++hb) {
            const int kq = kk + 32 * hb;
            const int kr = trow0 + kq / GRID_W, kc = kq % GRID_W;
            const bool ok = (kr >= ni.rs) && (kr < ni.rs + WIN_R) && (kc >= ni.cs) && (kc < ni.cs + WIN_C);
            const float bias = ok ? srpb[(kr - ni.r + 7) * 31 + (kc - ni.qc + 15)] * 1.4426950408889634f : -INFINITY;
            if (hb == 0) { s0[i] = s0[i] * scale2 + bias; mx = fmax_(mx, s0[i]); }
            else { s1[i] = s1[i] * scale2 + bias; mx = fmax_(mx, s1[i]); }
          }
        }
      } else {
        s0 = s0 * scale2; s1 = s1 * scale2;
#pragma unroll
        for (int i = 0; i < 16; ++i) mx = fmax_(mx, fmax_(s0[i], s1[i]));
      }
      mx = fmax_(mx, shfl_xor_(mx, 32));
      const float mn = fmax_(m, mx);
      const float alpha = exp2f_(m - mn);
      const bool same = (mn == m);
      m = mn;
      float ps = 0.f;
      { const float nmn = -mn; s0 = s0 + nmn; s1 = s1 + nmn; }
#pragma unroll
      for (int i = 0; i < 16; ++i) { s0[i] = exp2f_(s0[i]); s1[i] = exp2f_(s1[i]); }
      { const f32x16 st = s0 + s1;
        ps = ((st[0] + st[1]) + (st[2] + st[3])) + ((st[4] + st[5]) + (st[6] + st[7])) + (((st[8] + st[9]) + (st[10] + st[11])) + ((st[12] + st[13]) + (st[14] + st[15]))); }
      l = l * alpha + ps;
      if (!wave_all_(same)) {
#pragma unroll
        for (int i = 0; i < 16; ++i) { o0[i] *= alpha; o1[i] *= alpha; }
      }
#pragma unroll
      for (int kq = 0; kq < 4; ++kq) {
        u32x4 pw;
#pragma unroll
        for (int j = 0; j < 4; ++j) pw[j] = (kq < 2) ? pack2(s0[8 * (kq & 1) + 2 * j], s0[8 * (kq & 1) + 2 * j + 1]) : pack2(s1[8 * (kq & 1) + 2 * j], s1[8 * (kq & 1) + 2 * j + 1]);
        const bf16x8 pf = __builtin_bit_cast(bf16x8, pw);
        const uint2 a0 = va0[kq], a1 = va1[kq], b0 = vb0[kq], b1 = vb1[kq];
        bf16x8 va, vbb;
        va[0] = (short)(a0.x & 0xffff); va[1] = (short)(a0.x >> 16); va[2] = (short)(a0.y & 0xffff); va[3] = (short)(a0.y >> 16);
        va[4] = (short)(a1.x & 0xffff); va[5] = (short)(a1.x >> 16); va[6] = (short)(a1.y & 0xffff); va[7] = (short)(a1.y >> 16);
        vbb[0] = (short)(b0.x & 0xffff); vbb[1] = (short)(b0.x >> 16); vbb[2] = (short)(b0.y & 0xffff); vbb[3] = (short)(b0.y >> 16);
        vbb[4] = (short)(b1.x & 0xffff); vbb[5] = (short)(b1.x >> 16); vbb[6] = (short)(b1.y & 0xffff); vbb[7] = (short)(b1.y >> 16);
        o0 = __builtin_amdgcn_mfma_f32_32x32x16_bf16(va, pf, o0, 0, 0, 0);
        o1 = __builtin_amdgcn_mfma_f32_32x32x16_bf16(vbb, pf, o1, 0, 0, 0);
      }
    }
    if (t + 1 < NTL) AT_SSTORE(buf ^ 1)
    __syncthreads();
  }
  if (active) {
    const float lt = l + shfl_xor_(l, 32);
    const float inv = rcp_(lt);
#pragma unroll
    for (int gI = 0; gI < 4; ++gI) {
      const int d0 = 8 * gI + 4 * half;
      *(uint2*)(orow + d0) = make_uint2(pack2(o0[4 * gI] * inv, o0[4 * gI + 1] * inv), pack2(o0[4 * gI + 2] * inv, o0[4 * gI + 3] * inv));
      *(uint2*)(orow + 32 + d0) = make_uint2(pack2(o1[4 * gI] * inv, o1[4 * gI + 1] * inv), pack2(o1[4 * gI + 2] * inv, o1[4 * gI + 3] * inv));
    }
  }
}
DI void mla_attn_item(const Params& p, int it, bool ctxq, char* smem) {
  const int nqb = ctxq ? (CTXL + 255) / 256 : SEQ / 256;
  const int b = it / (4 * nqb), h = (it / nqb) & 3, qb = it % nqb;
  const int lane = tid_() & 63, wid = tid_() >> 6;
  const int nq = ctxq ? CTXL : SEQ, q0 = qb * 256 + wid * 32;
  const bool active = q0 < nq;
  const int jq = (ctxq ? 0 : CTXL) + (active ? q0 : 0) + (lane & 31);
  const bf16* Q = (const bf16*)(p.ws + OFF_MIX + MX_Q) + ((size_t)b * 4 + h) * TOK * 96;
  const bf16* K = (const bf16*)(p.ws + OFF_MIX + MX_K) + ((size_t)b * 4 + h) * TOK * 96;
  const bf16* VT = (const bf16*)(p.ws + OFF_MIX + MX_VTM) + ((size_t)b * 4 + h) * 64 * TOK;
  bf16* O = (bf16*)(p.ws + OFF_O) + ((size_t)b * TOK + jq) * 1024 + 0 * 256 + h * 64;
  NaInfo ni; ni.r = 0; ni.qc = 0; ni.rs = 0; ni.cs = 0;
  attn_block<96, false>(Q + (size_t)jq * 96, active, K, 96, VT, 0, 0, 0, 0, (ctxq ? CTXL : TOK) / 64, nullptr, ni, 0.10206207261596577f, O, smem);
}
DI void na_attn_item(const Params& p, const LP& L, int it, bool ctxq, char* smem) {
  const int nqb = ctxq ? (CTXL + 255) / 256 : SEQ / 256;
  const int b = it / (4 * nqb), h = (it / nqb) & 3, qb = it % nqb;
  const int tid = tid_(), lane = tid & 63, wid = tid >> 6;
  const int nq = ctxq ? CTXL : SEQ, q0 = qb * 256 + wid * 32;
  const bool active = q0 < nq;
  const int jq = (ctxq ? 0 : CTXL) + (active ? q0 : 0) + (lane & 31);
  const bf16* P1 = (const bf16*)(p.ws + OFF_P1) + (size_t)b * TOK * P1W;
  const bf16* VT = (const bf16*)(p.ws + OFF_MIX + MX_VTN) + ((size_t)b * 4 + h) * 64 * TOK;
  const bf16* Kb = P1 + C_NA + 256 + h * 64;
  bf16* O = (bf16*)(p.ws + OFF_O) + ((size_t)b * TOK + jq) * 1024 + 1 * 256 + h * 64;
  constexpr int AT_END64 = 2 * (64 * 72 * 2) + 2 * (64 * AT_LDV * 2);
  float* srpb = (float*)(smem + AT_END64);
  NaInfo ni; ni.r = 0; ni.qc = 0; ni.rs = 0; ni.cs = 0;
  int ka0 = 0, nta = 0, arow0 = 0;
  if (!ctxq) {
    __syncthreads();
    const float* rpb = p.in[I_RPB] + ((size_t)L.l * 4 + h) * 15 * 31;
    for (int i = tid; i < 15 * 31; i += NTHREADS) srpb[i] = rpb[i];
    const int tl = q0 + (lane & 31);
    ni.r = tl / GRID_W; ni.qc = tl % GRID_W;
    int rs = ni.r - WIN_R / 2; rs = rs < 0 ? 0 : (rs > ROWS - WIN_R ? ROWS - WIN_R : rs);
    int cs = ni.qc - WIN_C / 2; cs = cs < 0 ? 0 : (cs > GRID_W - WIN_C ? GRID_W - WIN_C : cs);
    ni.rs = rs; ni.cs = cs;
    constexpr int RPT = 64 / GRID_W;
    const int rfirst = (qb * 256) / GRID_W, rlast = (qb * 256 + 255) / GRID_W;
    int rs_f = rfirst - WIN_R / 2; rs_f = rs_f < 0 ? 0 : (rs_f > ROWS - WIN_R ? ROWS - WIN_R : rs_f);
    int rs_l = rlast - WIN_R / 2; rs_l = rs_l < 0 ? 0 : (rs_l > ROWS - WIN_R ? ROWS - WIN_R : rs_l);
    arow0 = (rs_f / RPT) * RPT;
    const int row_hi = rs_l + WIN_R;
    nta = (row_hi - arow0 + RPT - 1) / RPT;
    ka0 = CTXL + arow0 * GRID_W;
  }
  attn_block<64, true>(P1 + (size_t)jq * P1W + C_NA + h * 64, active, Kb, P1W, VT, ka0, nta, arow0, 0, CTXL / 64, srpb, ni, 0.125f, O, smem);
}

constexpr int M2_LDB = 136, M2_LDX = 72;
constexpr int M2_OFF_B = 0;
constexpr int M2_OFF_C = M2_OFF_B + 64 * M2_LDB * 2;
constexpr int M2_OFF_HD = M2_OFF_C + 64 * M2_LDB * 2;
constexpr int M2H_H = 0;
constexpr int M2H_XT = M2H_H + 64 * M2_LDB * 2;
constexpr int M2H_BT = M2H_XT + 64 * M2_LDX * 2;
constexpr int M2H_S = M2H_BT + 128 * M2_LDX * 2;
constexpr int M2H_X = M2H_S + 3 * 64 * 4;
constexpr int M2H_SIZE = M2H_X + 64 * M2_LDX * 2;
constexpr int M2_SMEM = M2_OFF_HD + 2 * M2H_SIZE;
static_assert(M2_SMEM <= SMEM_BYTES, "m2 smem");
DI u32x4 rev8_(u32x4 v) {
  return u32x4{(v[3] >> 16) | (v[3] << 16), (v[2] >> 16) | (v[2] << 16), (v[1] >> 16) | (v[1] << 16), (v[0] >> 16) | (v[0] << 16)};
}
DI void m2scan_item(const Params& p, const LP& L, int it, char* smem) {
  const int b = it / 8, grp = (it >> 2) & 1, dir = (it >> 1) & 1, seg1 = it & 1;
  const int cbeg = seg1 ? M2_SPLIT : 0, cend = seg1 ? TOK : M2_SPLIT;
  const int tid = tid_(), lane = tid & 63, wid = tid >> 6, half = lane >> 5, r = lane & 31;
  const int hsel = wid >> 2, wl = wid & 3, hd = grp * 2 + hsel;
  bf16* sB = (bf16*)(smem + M2_OFF_B);
  bf16* sC = (bf16*)(smem + M2_OFF_C);
  char* hb = smem + M2_OFF_HD + hsel * M2H_SIZE;
  bf16* sH = (bf16*)(hb + M2H_H);
  bf16* sXT = (bf16*)(hb + M2H_XT);
  bf16* sBT = (bf16*)(hb + M2H_BT);
  float* sS = (float*)(hb + M2H_S);
  float* sDt = sS + 64;
  float* sW = sS + 128;
  const bf16* XB = (const bf16*)(p.ws + OFF_MIX + MX_XBC) + (size_t)b * TOK * 768;
  const bf16* XT = (const bf16*)(p.ws + OFF_MIX + MX_XBT) + (size_t)b * 512 * TOK;
  const float* SC = (const float*)(p.ws + OFF_MIX + MX_M2S) + (size_t)((b * 2 + dir) * 4 + hd) * TOK * 4;
  float* YM = (float*)(p.ws + OFF_HA) + ((size_t)dir * NTOK + (size_t)b * TOK) * 256;
  const int pb = wl & 1, tb = wl >> 1, nb0 = 2 * (wl >> 1);
  f32x16 hst[2];
#pragma unroll
  for (int i = 0; i < 16; ++i) { hst[0][i] = 0.f; hst[1][i] = 0.f; }
  __syncthreads();
  for (int i = tid; i < 2 * M2H_SIZE / 4; i += NTHREADS) ((unsigned*)(smem + M2_OFF_HD))[i] = 0u;
  __syncthreads();
  u32x4 rxt[2], rbt[2], rb[2], rc[2];
  float4 rsc = make_float4(0.f, 0.f, 0.f, 0.f);
#define M2_TLOAD(rowptr_, sq0_) (*(const u32x4*)((rowptr_) + ((dir == 0) ? (sq0_) : m2_seq2tok((sq0_) + 7, 1))))
#define M2_GLOAD(c0_) { \
    _Pragma("unroll") for (int q_ = 0; q_ < 2; ++q_) { const int i_ = tid + q_ * NTHREADS; const int h2_ = i_ >> 9, t8_ = ((i_ >> 6) & 7) * 8, pp_ = i_ & 63; \
      rxt[q_] = M2_TLOAD(XT + (size_t)((grp * 2 + h2_) * 64 + pp_) * TOK, (c0_) + t8_); } \
    _Pragma("unroll") for (int q_ = 0; q_ < 2; ++q_) { const int i_ = tid + q_ * NTHREADS; const int t8_ = (i_ >> 7) * 8, nn_ = i_ & 127; \
      rbt[q_] = M2_TLOAD(XT + (size_t)(256 + grp * 128 + nn_) * TOK, (c0_) + t8_); } \
    _Pragma("unroll") for (int q_ = 0; q_ < 2; ++q_) { const int i_ = tid + q_ * NTHREADS; const int t_ = i_ >> 4, n8_ = (i_ & 15) * 8; \
      const bf16* src_ = XB + (size_t)m2_seq2tok((c0_) + t_, dir) * 768 + grp * 128 + n8_; \
      rb[q_] = *(const u32x4*)(src_ + 256); rc[q_] = *(const u32x4*)(src_ + 512); } \
    if (wl == 0) rsc = *(const float4*)(SC + (size_t)((c0_) + lane) * 4); }
  M2_GLOAD(cbeg)
  float* GT = (float*)(p.ws + OFF_MIX + MX_GT) + (size_t)((b * 2 + dir) * 4 + hd) * M2_REST;
  float lcum = 0.f;
  for (int c0 = cbeg; c0 < cend; c0 += 64) {
    if (wl == 0) {
      sS[lane] = rsc.x; sDt[lane] = rsc.w; sW[lane] = rsc.z;
      if (seg1) { GT[c0 - M2_SPLIT + lane] = rsc.x + lcum; lcum += shfl_(rsc.x, 63); }
    }
    __syncthreads();
#pragma unroll
    for (int q2 = 0; q2 < 2; ++q2) {
      const int i = tid + q2 * NTHREADS; const int h2 = i >> 9, t8 = ((i >> 6) & 7) * 8, pp = i & 63;
      *(u32x4*)((bf16*)(smem + M2_OFF_HD + h2 * M2H_SIZE + M2H_XT) + pp * M2_LDX + t8) = dir ? rev8_(rxt[q2]) : rxt[q2];
    }
#pragma unroll
    for (int q4 = 0; q4 < 2; ++q4) {
      const int i = tid + q4 * NTHREADS; const int t = i >> 4, n8 = (i & 15) * 8;
      *(u32x4*)(sB + t * M2_LDB + n8) = rb[q4];
      *(u32x4*)(sC + t * M2_LDB + n8) = rc[q4];
    }
#pragma unroll
    for (int q4 = 0; q4 < 2; ++q4) {
      const int i = tid + q4 * NTHREADS; const int t8 = (i >> 7) * 8, nn = i & 127;
      float bv[8];
      if (dir) rbt[q4] = rev8_(rbt[q4]);
      bv[0] = __uint_as_float(rbt[q4][0] << 16); bv[1] = __uint_as_float(rbt[q4][0] & 0xffff0000u);
      bv[2] = __uint_as_float(rbt[q4][1] << 16); bv[3] = __uint_as_float(rbt[q4][1] & 0xffff0000u);
      bv[4] = __uint_as_float(rbt[q4][2] << 16); bv[5] = __uint_as_float(rbt[q4][2] & 0xffff0000u);
      bv[6] = __uint_as_float(rbt[q4][3] << 16); bv[7] = __uint_as_float(rbt[q4][3] & 0xffff0000u);
#pragma unroll
      for (int h2 = 0; h2 < 2; ++h2) {
        const float* wv = (const float*)(smem + M2_OFF_HD + h2 * M2H_SIZE + M2H_S) + 128 + t8;
        float sv[8];
#pragma unroll
        for (int k = 0; k < 8; ++k) sv[k] = bv[k] * wv[k];
        st8bf((bf16*)(smem + M2_OFF_HD + h2 * M2H_SIZE + M2H_BT) + nn * M2_LDX + t8, sv);
      }
    }
    __syncthreads();
    if (c0 + 64 < cend) M2_GLOAD(c0 + 64)
    {
      f32x16 yT, y2;
#pragma unroll
      for (int i = 0; i < 16; ++i) { yT[i] = 0.f; y2[i] = 0.f; }
      const int tv = 32 * tb + r;
      const float St = sS[tv];
      for (int sb = 0; sb <= tb; ++sb) {
        f32x16 gT;
#pragma unroll
        for (int i = 0; i < 16; ++i) gT[i] = 0.f;
#pragma unroll
        for (int ks = 0; ks < 8; ++ks) {
          bf16x8 av = *(const bf16x8*)(sB + (32 * sb + r) * M2_LDB + 16 * ks + 8 * half);
          bf16x8 bv = *(const bf16x8*)(sC + tv * M2_LDB + 16 * ks + 8 * half);
          gT = __builtin_amdgcn_mfma_f32_32x32x16_bf16(av, bv, gT, 0, 0, 0);
        }
        const float St2 = St * 1.4426950408889634f;
        if (sb == tb) {
#pragma unroll
          for (int i = 0; i < 16; ++i) {
            const int sv = 32 * sb + (i & 3) + 8 * (i >> 2) + 4 * half;
            gT[i] = (sv <= tv) ? gT[i] * exp2f_(St2 - sDt[sv]) : 0.f;
          }
        } else {
#pragma unroll
          for (int i = 0; i < 16; ++i) {
            const int sv = 32 * sb + (i & 3) + 8 * (i >> 2) + 4 * half;
            gT[i] *= exp2f_(St2 - sDt[sv]);
          }
        }
#pragma unroll
        for (int kq = 0; kq < 2; ++kq) {
          const u32x4 pw = u32x4{pack2(gT[8 * kq], gT[8 * kq + 1]), pack2(gT[8 * kq + 2], gT[8 * kq + 3]), pack2(gT[8 * kq + 4], gT[8 * kq + 5]), pack2(gT[8 * kq + 6], gT[8 * kq + 7])};
          const bf16x8 pf = __builtin_bit_cast(bf16x8, pw);
          const bf16* xr = sXT + (32 * pb + r) * M2_LDX + 32 * sb + 16 * kq + 4 * half;
          uint2 x0 = *(const uint2*)xr, x1 = *(const uint2*)(xr + 8);
          bf16x8 xa;
          xa[0] = (short)(x0.x & 0xffff); xa[1] = (short)(x0.x >> 16); xa[2] = (short)(x0.y & 0xffff); xa[3] = (short)(x0.y >> 16);
          xa[4] = (short)(x1.x & 0xffff); xa[5] = (short)(x1.x >> 16); xa[6] = (short)(x1.y & 0xffff); xa[7] = (short)(x1.y >> 16);
          yT = __builtin_amdgcn_mfma_f32_32x32x16_bf16(xa, pf, yT, 0, 0, 0);
        }
      }
#pragma unroll
      for (int ks = 0; ks < 8; ++ks) {
        bf16x8 av = *(const bf16x8*)(sH + (32 * pb + r) * M2_LDB + 16 * ks + 8 * half);
        bf16x8 bv = *(const bf16x8*)(sC + tv * M2_LDB + 16 * ks + 8 * half);
        y2 = __builtin_amdgcn_mfma_f32_32x32x16_bf16(av, bv, y2, 0, 0, 0);
      }
      const float eS = __expf(St);
      const int j = m2_seq2tok(c0 + tv, dir);
      float* yo = YM + (size_t)j * 256 + hd * 64 + 32 * pb + 4 * half;
#pragma unroll
      for (int gI = 0; gI < 4; ++gI)
        *(float4*)(yo + 8 * gI) = make_float4(yT[4 * gI] + eS * y2[4 * gI], yT[4 * gI + 1] + eS * y2[4 * gI + 1], yT[4 * gI + 2] + eS * y2[4 * gI + 2], yT[4 * gI + 3] + eS * y2[4 * gI + 3]);
    }
    __syncthreads();
    {
      const float eL = __expf(sS[63]);
#pragma unroll
      for (int q = 0; q < 2; ++q) {
#pragma unroll
        for (int i = 0; i < 16; ++i) hst[q][i] *= eL;
#pragma unroll
        for (int ks = 0; ks < 4; ++ks) {
          bf16x8 av = *(const bf16x8*)(sXT + (32 * pb + r) * M2_LDX + 16 * ks + 8 * half);
          bf16x8 bv = *(const bf16x8*)(sBT + (32 * (nb0 + q) + r) * M2_LDX + 16 * ks + 8 * half);
          hst[q] = __builtin_amdgcn_mfma_f32_32x32x16_bf16(av, bv, hst[q], 0, 0, 0);
        }
#pragma unroll
        for (int i = 0; i < 16; ++i) {
          const int pv = 32 * pb + (i & 3) + 8 * (i >> 2) + 4 * half;
          sH[pv * M2_LDB + 32 * (nb0 + q) + r] = f2bf(hst[q][i]);
        }
      }
    }
    __syncthreads();
  }
  if (!seg1) {
    bf16* HM = (bf16*)(p.ws + OFF_MIX + MX_HM) + (size_t)((b * 2 + dir) * 2 + grp) * 128 * 128;
#pragma unroll
    for (int q = 0; q < 4; ++q) {
      const int i = tid + q * NTHREADS, pr = i >> 4, n8 = (i & 15) * 8;
      *(u32x4*)(HM + pr * 128 + n8) = *(const u32x4*)((const bf16*)(smem + M2_OFF_HD + (pr >> 6) * M2H_SIZE + M2H_H) + (pr & 63) * M2_LDB + n8);
    }
  }
}
constexpr int M2C_MT = (M2_REST + 255) / 256;
DI void m2corr_tile(const Params& p, const LP& L, int t, char* smem) {
  const int mt = t % M2C_MT, r = t / M2C_MT, grp = r & 1, dir = (r >> 1) & 1, b = r >> 2;
  const int tok0 = dir ? CTXL : M2_SPLIT;
  const bf16* A = (const bf16*)(p.ws + OFF_MIX + MX_XBC) + ((size_t)b * TOK + tok0) * 768 + 512 + grp * 128;
  const bf16* HM = (const bf16*)(p.ws + OFF_MIX + MX_HM) + (size_t)((b * 2 + dir) * 2 + grp) * 128 * 128;
  GA g = make_ga(A, 768, HM, 128, 128, M2_REST);
  f32x4 acc[4][4];
  const int m0 = mt * 256;
  gemm_s<4>(g, m0, 0, smem, acc);
  float* YM = (float*)(p.ws + OFF_HA) + ((size_t)dir * NTOK + (size_t)b * TOK + tok0) * 256;
  const float* GT = (const float*)(p.ws + OFF_MIX + MX_GT) + (size_t)((b * 2 + dir) * 4 + grp * 2) * M2_REST;
  EPI_BEGIN(4, acc, m0, 0, M2_REST)
    const int hs = col >> 6;
    const int sidx = dir ? (M2_REST - 1 - row) : row;
    const float f = __expf(GT[(size_t)hs * M2_REST + sidx]);
    float* yo = YM + (size_t)row * 256 + (grp * 2 + hs) * 64 + (col & 63);
    float4 y0 = *(const float4*)yo, y1 = *(const float4*)(yo + 4);
    y0.x += f * v[0]; y0.y += f * v[1]; y0.z += f * v[2]; y0.w += f * v[3];
    y1.x += f * v[4]; y1.y += f * v[5]; y1.z += f * v[6]; y1.w += f * v[7];
    *(float4*)yo = y0; *(float4*)(yo + 4) = y1;
  EPI_END
}
DI void m2gate_item(const Params& p, const LP& L, int it) {
  const int tok = it * NWAVES + (tid_() >> 6), lane = tid_() & 63;
  const float* Y0 = (const float*)(p.ws + OFF_HA) + (size_t)tok * 256;
  const float* Y1 = Y0 + (size_t)NTOK * 256;
  const bf16* XB = (const bf16*)(p.ws + OFF_MIX + MX_XBC) + (size_t)tok * 768;
  const bf16* P1 = (const bf16*)(p.ws + OFF_P1) + (size_t)tok * P1W + C_Z;
  const int c = lane * 4, hd = c >> 6;
  const float dsk = p.in[I_M2D][L.l * 4 + hd];
  float4 y0 = *(const float4*)(Y0 + c), y1 = *(const float4*)(Y1 + c);
  uint2 xw = *(const uint2*)(XB + c), zw = *(const uint2*)(P1 + c);
  float xs[4] = {__uint_as_float(xw.x << 16), __uint_as_float(xw.x & 0xffff0000u), __uint_as_float(xw.y << 16), __uint_as_float(xw.y & 0xffff0000u)};
  float zs[4] = {__uint_as_float(zw.x << 16), __uint_as_float(zw.x & 0xffff0000u), __uint_as_float(zw.y << 16), __uint_as_float(zw.y & 0xffff0000u)};
  float ys[4] = {y0.x + y1.x, y0.y + y1.y, y0.z + y1.z, y0.w + y1.w};
  float v[4], ss = 0.f;
#pragma unroll
  for (int i = 0; i < 4; ++i) { v[i] = (ys[i] + dsk * xs[i]) * siluf_(zs[i]); ss += v[i] * v[i]; }
  ss = wave_sum(ss);
  const float rs = rsqrtf(ss * (1.f / 256.f) + EPS);
  float4 gn = *(const float4*)(p.in[I_M2GNORM] + L.l * 256 + c);
  bf16* O = (bf16*)(p.ws + OFF_O) + (size_t)tok * 1024 + 768 + c;
  *(uint2*)O = make_uint2(pack2(v[0] * rs * gn.x, v[1] * rs * gn.y), pack2(v[2] * rs * gn.z, v[3] * rs * gn.w));
}
constexpr int GLU_MT = (NTOK + 255) / 256;
DI void glu_tile(const Params& p, const LP& L, int t, char* smem) {
  const int mt = t % GLU_MT, nt = t / GLU_MT, m0 = mt * 256, n0 = nt * 128;
  const bf16* Z = (const bf16*)(p.ws + OFF_MIX + MX_Z);
  GA g = make_ga(Z, 256, (const bf16*)(L.we + WE_GLU), 256, 256, NTOK);
  f32x4 acc[4][4];
  gemm_s<4>(g, m0, n0, smem, acc);
  bf16* O = (bf16*)(p.ws + OFF_O);
  const float* bg = p.in[I_S5BGLU] + L.l * 256;
  EPI_BEGIN(4, acc, m0, n0, NTOK)
    float z[8]; ld8bf(Z + (size_t)row * 256 + col, z);
#pragma unroll
    for (int k = 0; k < 8; ++k) v[k] = z[k] * sigmoidf_(v[k] + bg[col + k]);
    st8bf(O + (size_t)row * 1024 + 512 + col, v);
  EPI_END
}
DI void merge_tile(const Params& p, const LP& L, int t, char* smem) {
  constexpr int MT_L = BATCH * (SEQ / 256), MT_A = (NTOK + 255) / 256;
  const int mt = L.last ? t % MT_L : t % MT_A, nt = L.last ? t / MT_L : t / MT_A, m0 = mtile_row0(mt, L.last, 256), n0 = nt * 128;
  const bf16* O = (const bf16*)(p.ws + OFF_O);
  const bf16* PG = (const bf16*)(p.ws + OFF_PG);
  float tot[4][2][8];
#pragma unroll
  for (int a = 0; a < 4; ++a)
#pragma unroll
    for (int q = 0; q < 2; ++q)
#pragma unroll
      for (int k = 0; k < 8; ++k) tot[a][q][k] = 0.f;
  for (int j = 0; j < 4; ++j) {
    GA g = make_ga(O + j * 256, 1024, (const bf16*)(L.we + WE_WB) + (size_t)j * 1024 * 256, 256, 256, NTOK);
    f32x4 acc[4][4];
    gemm_s<4>(g, m0, n0, smem, acc);
    EPI_BEGIN(4, acc, m0, n0, NTOK)
      float gt[8]; ld8bf(PG + (size_t)row * 4096 + j * 1024 + col, gt);
#pragma unroll
      for (int k = 0; k < 8; ++k) tot[_m][_q][k] += gt[k] * v[k];
    EPI_END
  }
  bf16* Y = (bf16*)(p.ws + OFF_P1);
  {
    const int l = tid_() & 63, w = tid_() >> 6, wr = w >> 1, wc = w & 1, fr = l & 15, fq = l >> 4;
#pragma unroll
    for (int m = 0; m < 4; ++m)
#pragma unroll
      for (int q = 0; q < 2; ++q) {
        const int row = m0 + wr * 64 + m * 16 + fr, col = n0 + wc * 64 + q * 32 + 8 * fq;
        if (row < NTOK) st8bf(Y + (size_t)row * 1024 + col, tot[m][q]);
      }
  }
}
DI void outproj_tile(const Params& p, const LP& L, int t, char* smem) {
  float* Y2 = (float*)(p.ws + OFF_HA);
  constexpr int MT_L = BATCH * (SEQ / 256), MT_A = (NTOK + 255) / 256;
  const int mt = L.last ? t % MT_L : t % MT_A, nt = L.last ? t / MT_L : t / MT_A, m0 = mtile_row0(mt, L.last, 256), n0 = nt * 256;
  GA g = make_ga((const bf16*)(p.ws + OFF_P1), 1024, (const bf16*)(L.we + WE_WOUT), 1024, 1024, NTOK);
  f32x4 acc[2][2][4][2];
  gemm_big(g, m0, n0, smem, acc);
  EPIB_BEGIN(acc, m0, n0, NTOK)
    st8f(Y2 + (size_t)row * 1024 + col, v);
  EPIB_END
}
DI int post_ntok(bool latonly) { return latonly ? BATCH * SEQ : NTOK; }
DI int post_tok(int i, bool latonly) { return latonly ? ((i / SEQ) * TOK + CTXL + (i % SEQ)) : i; }

DI const float* xsrc_row(const Params& p, int l, int tok) {
  if (l > 0) return (const float*)(p.ws + OFF_X) + (size_t)tok * 1024;
  const int b = tok_b(tok), j = tok_j(tok);
  return (j < CTXL) ? p.in[I_CTX] + ((size_t)b * CTXL + j) * 1024 : p.in[I_X] + ((size_t)b * SEQ + (j - CTXL)) * 1024;
}
DI void post_stage_router(const Params& p, const LP& L, char* smem) {
  const float* wr = p.in[I_WROUTER] + (size_t)L.l * 1024 * 16;
  float4* wl = (float4*)smem;
  __syncthreads();
  for (int i = tid_(); i < 4096; i += NTHREADS) {
    const int k = i >> 2, q = i & 3;
    const int pos = ((k >> 8) * 4 + (k & 3)) * 64 + ((k >> 2) & 63);
    wl[q * 1024 + pos] = *(const float4*)(wr + (size_t)k * 16 + q * 4);
  }
  __syncthreads();
}
DI void post_phase(const Params& p, const LP& L, char* smem) {
  const int lane = tid_() & 63, gw = (int)blockIdx.x * NWAVES + (tid_() >> 6), TW = (int)gridDim.x * NWAVES;
  const int n = post_ntok(L.last);
  if (gw >= n) return;
  const float* gpm = p.in[I_GPOSTMIX] + L.l * 1024;
  const float4* wl = (const float4*)smem;
  int i = gw, tok = post_tok(i, L.last);
  float4 yr[4], xr[4];
  {
    const float* X = xsrc_row(p, L.l, tok);
    const float* Y2 = (const float*)(p.ws + OFF_HA) + (size_t)tok * 1024;
#pragma unroll
    for (int q = 0; q < 4; ++q) { yr[q] = *(const float4*)(Y2 + lane * 4 + q * 256); xr[q] = *(const float4*)(X + lane * 4 + q * 256); }
  }
  for (;;) {
    const int inext = i + TW; const bool has = inext < n; const int tokn = has ? post_tok(inext, L.last) : tok;
    float4 yn[4], xn[4];
    {
      const float* Xn = xsrc_row(p, L.l, tokn);
      const float* Yn = (const float*)(p.ws + OFF_HA) + (size_t)tokn * 1024;
#pragma unroll
      for (int q = 0; q < 4; ++q) { yn[q] = *(const float4*)(Yn + lane * 4 + q * 256); xn[q] = *(const float4*)(Xn + lane * 4 + q * 256); }
    }
    float* X = (float*)(p.ws + OFF_X) + (size_t)tok * 1024;
    const float* mod = L.mod + (size_t)tok_modrow(tok) * 6144;
    float xv[16], h[16];
    float ss = 0.f;
#pragma unroll
    for (int q = 0; q < 4; ++q) ss += yr[q].x * yr[q].x + yr[q].y * yr[q].y + yr[q].z * yr[q].z + yr[q].w * yr[q].w;
    ss = wave_sum(ss);
    const float rs = rsqrtf(ss * (1.f / 1024.f) + EPS);
#pragma unroll
    for (int q = 0; q < 4; ++q) {
      const int c = lane * 4 + q * 256;
      float4 xo = xr[q], gv = *(const float4*)(gpm + c), gt = *(const float4*)(mod + 2048 + c);
      xo.x += gt.x * yr[q].x * rs * gv.x; xo.y += gt.y * yr[q].y * rs * gv.y; xo.z += gt.z * yr[q].z * rs * gv.z; xo.w += gt.w * yr[q].w * rs * gv.w;
      *(float4*)(X + c) = xo;
      xv[q * 4] = xo.x; xv[q * 4 + 1] = xo.y; xv[q * 4 + 2] = xo.z; xv[q * 4 + 3] = xo.w;
    }
    bf16* H2 = (bf16*)(p.ws + OFF_P1) + (size_t)NTOK * 1024 + (size_t)tok * 1024;
    normmod_row(xv, p.in[I_GPREFFN] + L.l * 1024, mod + 3072, mod + 4096, H2, h);
    float lg[16];
#pragma unroll
    for (int e = 0; e < 16; ++e) lg[e] = 0.f;
#pragma unroll
    for (int q = 0; q < 16; ++q) {
      const int pos = ((q >> 2) * 4 + (q & 3)) * 64 + lane;
      float4 a = wl[pos], b4 = wl[1024 + pos], c4 = wl[2048 + pos], d4 = wl[3072 + pos];
      float hv = h[q];
      lg[0] += hv * a.x; lg[1] += hv * a.y; lg[2] += hv * a.z; lg[3] += hv * a.w;
      lg[4] += hv * b4.x; lg[5] += hv * b4.y; lg[6] += hv * b4.z; lg[7] += hv * b4.w;
      lg[8] += hv * c4.x; lg[9] += hv * c4.y; lg[10] += hv * c4.z; lg[11] += hv * c4.w;
      lg[12] += hv * d4.x; lg[13] += hv * d4.y; lg[14] += hv * d4.z; lg[15] += hv * d4.w;
    }
    float mx = -INFINITY;
#pragma unroll
    for (int e = 0; e < 16; ++e) { lg[e] = wave_sum(lg[e]); mx = fmax_(mx, lg[e]); }
    float se = 0.f;
#pragma unroll
    for (int e = 0; e < 16; ++e) { lg[e] = expf(lg[e] - mx); se += lg[e]; }
    if (lane < 16) {
      float v = 0.f;
#pragma unroll
      for (int e = 0; e < 16; ++e) if (e == lane) v = lg[e];
      ((float*)(p.ws + OFF_AFF))[(size_t)lane * NTOK + tok] = v * rcp_(se);
    }
    if (!has) break;
    i = inext; tok = tokn;
#pragma unroll
    for (int q = 0; q < 4; ++q) { yr[q] = yn[q]; xr[q] = xn[q]; }
  }
}
DI int block_sum_(int v, int* sred, int round) {
  const int tid = tid_(), lane = tid & 63, wid = tid >> 6;
  v += shfl_xor_(v, 32); v += shfl_xor_(v, 16); v += shfl_xor_(v, 8); v += shfl_xor_(v, 4); v += shfl_xor_(v, 2); v += shfl_xor_(v, 1);
  int* r = sred + (round & 1) * NWAVES;
  if (lane == 0) r[wid] = v;
  __syncthreads();
  int tsum = 0;
#pragma unroll
  for (int q = 0; q < NWAVES; ++q) tsum += r[q];
  return tsum;
}
DI void route_item(const Params& p, const LP& L, int it, char* smem) {
  const int nstream = L.last ? 1 : 2;
  const int b = it / (16 * nstream), e = (it / nstream) & 15, ctxs = (nstream == 2) ? (it & 1) : 0;
  const int T = ctxs ? CTXL : SEQ, cap = ctxs ? CAP_C : CAP_L;
  const int tok0 = b * TOK + (ctxs ? 0 : CTXL);
  const int slot0 = ctxs ? (BATCH * CAP_L + b * CAP_C) : (b * CAP_L);
  int* sred = (int*)smem;
  const float* AFF = (const float*)(p.ws + OFF_AFF) + (size_t)e * NTOK + tok0;
  int* SEL = (int*)(p.ws + OFF_SEL);
  int* IDX = (int*)(p.ws + OFF_IDX) + (size_t)e * ESLOTS;
  float* GW = (float*)(p.ws + OFF_GW) + (size_t)e * ESLOTS;
  const int tid = tid_(), lane = tid & 63, wid = tid >> 6;
  constexpr int MAXPER = (SEQ + NTHREADS - 1) / NTHREADS;
  const int per = (T + NTHREADS - 1) / NTHREADS;
  unsigned key[MAXPER];
  __syncthreads();
#pragma unroll
  for (int k = 0; k < MAXPER; ++k) {
    int i = tid * per + k;
    key[k] = (k < per && i < T) ? (__float_as_uint(AFF[i]) + 1u) : 0u;
  }
  unsigned thr = 0u;
  int round = 0;
  for (int bit = 30; bit >= 0; --bit) {
    const unsigned cand = thr | (1u << bit);
    int c = 0;
#pragma unroll
    for (int k = 0; k < MAXPER; ++k) c += (key[k] >= cand) ? 1 : 0;
    c = block_sum_(c, sred, round++);
    if (c >= cap) thr = cand;
  }
  int cg = 0, ce = 0;
#pragma unroll
  for (int k = 0; k < MAXPER; ++k) { cg += (key[k] > thr) ? 1 : 0; ce += (key[k] == thr) ? 1 : 0; }
  const int tot_gt = block_sum_(cg, sred, round++);
  const int need_eq = cap - tot_gt;
  int v = cg | (ce << 16), inc = v;
#pragma unroll
  for (int d = 1; d < 64; d <<= 1) { int o = shfl_up_(inc, d); if (lane >= d) inc += o; }
  int* soff = sred + 2 * NWAVES;
  __syncthreads();
  if (lane == 63) soff[wid] = inc;
  __syncthreads();
  int base = 0;
  for (int w = 0; w < wid; ++w) base += soff[w];
  int excl = base + inc - v;
  int gt_before = excl & 0xffff, eq_before = excl >> 16;
#pragma unroll
  for (int k = 0; k < MAXPER; ++k) {
    int i = tid * per + k;
    if (k < per && i < T) {
      const bool isgt = key[k] > thr, iseq = key[k] == thr;
      const bool sel = isgt || (iseq && eq_before < need_eq);
      const int slot = slot0 + gt_before + (eq_before < need_eq ? eq_before : need_eq);
      if (sel) { IDX[slot] = tok0 + i; GW[slot] = __uint_as_float(key[k] - 1u); SEL[(size_t)(tok0 + i) * 16 + e] = slot; }
      else SEL[(size_t)(tok0 + i) * 16 + e] = -1;
      gt_before += isgt ? 1 : 0; eq_before += iseq ? 1 : 0;
    }
  }
}
DI void moe1_tile(const Params& p, const LP& L, int t, char* smem) {
  const int nslots = L.last ? ESLOTS_L : ESLOTS;
  constexpr int MT_L = (ESLOTS_L + 255) / 256, MT_A = (ESLOTS + 255) / 256;
  const int nt = t & 7, sq = t >> 3;
  const int e = L.last ? sq / MT_L : sq / MT_A, mt = L.last ? sq % MT_L : sq % MT_A;
  const int m0 = mt * 256, n0 = nt * 256;
  GA g = make_ga((const bf16*)(p.ws + OFF_P1) + (size_t)NTOK * 1024, 1024, (const bf16*)(p.ws + OFF_MIX + WX_GU) + (size_t)e * 2048 * 1024, 1024, 1024, nslots);
  g.ridx = (const int*)(p.ws + OFF_IDX) + (size_t)e * ESLOTS;
  f32x4 acc[2][2][4][2];
  gemm_big(g, m0, n0, smem, acc);
  bf16* ACT = (bf16*)(p.ws + OFF_PG) + (size_t)e * ESLOTS * 1024;
  {
    const int l = tid_() & 63, w = tid_() >> 6, wr = w >> 2, wc = w & 3, fr = l & 15, fq = l >> 4;
#pragma unroll
    for (int ai = 0; ai < 2; ++ai)
#pragma unroll
      for (int m = 0; m < 4; ++m) {
        const int row = m0 + ai * 128 + wr * 64 + m * 16 + fr;
        float a[8];
#pragma unroll
        for (int k = 0; k < 4; ++k) { a[k] = siluf_(acc[ai][0][m][0][k]) * acc[ai][1][m][0][k]; a[4 + k] = siluf_(acc[ai][0][m][1][k]) * acc[ai][1][m][1][k]; }
        if (row < nslots) st8bf(ACT + (size_t)row * 1024 + nt * 128 + wc * 32 + 8 * fq, a);
      }
  }
}
DI void moe2_tile(const Params& p, const LP& L, int t, char* smem) {
  const int nslots = L.last ? ESLOTS_L : ESLOTS;
  constexpr int MT_L = (ESLOTS_L + 255) / 256, MT_A = (ESLOTS + 255) / 256;
  const int x = t & 7, nt = x & 3, sq = (t >> 3) * 2 + (x >> 2);
  const int e = L.last ? sq / MT_L : sq / MT_A, mt = L.last ? sq % MT_L : sq % MT_A;
  if (e >= NE) return;
  const int m0 = mt * 256, n0 = nt * 256;
  GA g = make_ga((const bf16*)(p.ws + OFF_PG) + (size_t)e * ESLOTS * 1024, 1024, (const bf16*)(p.ws + OFF_MIX + WX_DN) + (size_t)e * 1024 * 1024, 1024, 1024, nslots);
  f32x4 acc[2][2][4][2];
  gemm_big(g, m0, n0, smem, acc);
  bf16* YS = (bf16*)(p.ws + OFF_PG) + (size_t)NE * ESLOTS * 1024 + (size_t)e * ESLOTS * 1024;
  const float* GW = (const float*)(p.ws + OFF_GW) + (size_t)e * ESLOTS;
  EPIB_BEGIN(acc, m0, n0, nslots)
    const float gw = GW[row];
#pragma unroll
    for (int k = 0; k < 8; ++k) v[k] *= gw;
    st8bf(YS + (size_t)row * 1024 + col, v);
  EPIB_END
}
DI int uni_(int v) {
#ifdef EMU
  return v;
#else
  return __builtin_amdgcn_readfirstlane(v);
#endif
}
DI void comb_phase(const Params& p, const LP& L) {
  const int lane = tid_() & 63, gw = (int)blockIdx.x * NWAVES + (tid_() >> 6), TW = (int)gridDim.x * NWAVES;
  const int n = post_ntok(L.last);
  if (gw >= n) return;
  const bf16* YS = (const bf16*)(p.ws + OFF_PG) + (size_t)NE * ESLOTS * 1024;
  const float* gpf = p.in[I_GPOSTFFN] + L.l * 1024;
  int i = gw, tok = post_tok(i, L.last);
  uint4 sel[4]; float4 xr[4];
  {
    const uint4* sp = (const uint4*)((const int*)(p.ws + OFF_SEL) + (size_t)tok * 16);
    const float* X = (const float*)(p.ws + OFF_X) + (size_t)tok * 1024;
#pragma unroll
    for (int q = 0; q < 4; ++q) { sel[q] = sp[q]; xr[q] = *(const float4*)(X + lane * 4 + q * 256); }
  }
  for (;;) {
    const int inext = i + TW; const bool has = inext < n; const int tokn = has ? post_tok(inext, L.last) : tok;
    float s[16];
#pragma unroll
    for (int q = 0; q < 16; ++q) s[q] = 0.f;
#pragma unroll
    for (int e = 0; e < 16; ++e) {
      const unsigned sv = (e & 3) == 0 ? sel[e >> 2].x : (e & 3) == 1 ? sel[e >> 2].y : (e & 3) == 2 ? sel[e >> 2].z : sel[e >> 2].w;
      const int sl = uni_((int)sv);
      if (sl >= 0) {
        const bf16* yr = YS + ((size_t)e * ESLOTS + sl) * 1024;
#pragma unroll
        for (int q = 0; q < 4; ++q) {
          uint2 w = *(const uint2*)(yr + lane * 4 + q * 256);
          s[q * 4] += __uint_as_float(w.x << 16); s[q * 4 + 1] += __uint_as_float(w.x & 0xffff0000u);
          s[q * 4 + 2] += __uint_as_float(w.y << 16); s[q * 4 + 3] += __uint_as_float(w.y & 0xffff0000u);
        }
      }
    }
    uint4 seln[4]; float4 xn[4];
    {
      const uint4* sp = (const uint4*)((const int*)(p.ws + OFF_SEL) + (size_t)tokn * 16);
      const float* Xn = (const float*)(p.ws + OFF_X) + (size_t)tokn * 1024;
#pragma unroll
      for (int q = 0; q < 4; ++q) { seln[q] = sp[q]; xn[q] = *(const float4*)(Xn + lane * 4 + q * 256); }
    }
    float ss = 0.f;
#pragma unroll
    for (int q = 0; q < 16; ++q) ss += s[q] * s[q];
    ss = wave_sum(ss);
    const float rs = rsqrtf(ss * (1.f / 1024.f) + EPS);
    const float* mod = L.mod + (size_t)tok_modrow(tok) * 6144;
    float* dst = (float*)(p.ws + OFF_X) + (size_t)tok * 1024;
    if (L.last) { const int b = tok_b(tok), j = tok_j(tok); dst = p.out + ((size_t)b * SEQ + (j - CTXL)) * 1024; }
    float xv[16], h[16];
#pragma unroll
    for (int q = 0; q < 4; ++q) {
      const int c = lane * 4 + q * 256;
      float4 xo = xr[q], gv = *(const float4*)(gpf + c), gt = *(const float4*)(mod + 5120 + c);
      xo.x += gt.x * s[q * 4] * rs * gv.x; xo.y += gt.y * s[q * 4 + 1] * rs * gv.y; xo.z += gt.z * s[q * 4 + 2] * rs * gv.z; xo.w += gt.w * s[q * 4 + 3] * rs * gv.w;
      *(float4*)(dst + c) = xo;
      xv[q * 4] = xo.x; xv[q * 4 + 1] = xo.y; xv[q * 4 + 2] = xo.z; xv[q * 4 + 3] = xo.w;
    }
    if (!L.last) {
      const float* mod1 = (const float*)(p.ws + OFF_MOD) + ((size_t)(L.l + 1) * NB1 + tok_modrow(tok)) * 6144;
      normmod_row(xv, p.in[I_GPREMIX] + (L.l + 1) * 1024, mod1, mod1 + 1024, (bf16*)(p.ws + OFF_HA) + (size_t)tok * 1024, h);
    }
    if (!has) break;
    i = inext; tok = tokn;
#pragma unroll
    for (int q = 0; q < 4; ++q) { sel[q] = seln[q]; xr[q] = xn[q]; }
  }
}

enum { PH_PREP0 = 0, PH_PREP1, PH_L0 };
enum { LP_INPROJ = 0, LP_TOKPREP, LP_MIX1, LP_MIX2, LP_GLU, LP_MERGE, LP_OUT, LP_POST, LP_ROUTE, LP_MOE1, LP_MOE2, LP_COMB, LP_COUNT };
constexpr int NPHASES = PH_L0 + DEPTH * LP_COUNT;


DI void run_phase(const Params& p, int ph, char* smem) {
  const int G = gridDim.x;
  int start = blockIdx.x;
  auto seg = [&](int n, auto&& fn) {
    for (; start < n; start += G) fn(start);
    start -= n;
  };
#ifdef ONLY_PREP
  if (ph >= PH_L0) return;
#endif
  if (ph == PH_PREP0) {
    seg(DEPTH * 96, [&](int it) { mod_item(p, it, smem); });
    seg(DEPTH * 32, [&](int it) { s5_tab_item(p, it, smem); });
    seg(1, [&](int) { rope_tab_item(p); });
    seg(DEPTH * CT_EARLY, [&](int it) { conv_early_item(p, it / CT_EARLY, it % CT_EARLY, smem); });
    return;
  }
  if (ph == PH_PREP1) {
    seg(DEPTH * 256, [&](int it) { s5_mat_item(p, it); });
    seg(NTOK / NWAVES, [&](int it) { prep_row_item(p, it); });
    return;
  }
#ifdef ONLY_LPH
  if (ph < PH_L0) return;
#endif
  const int l = (ph - PH_L0) / LP_COUNT;
#ifdef ONLY_LPH
  const int lph = ONLY_LPH;
#else
  const int lph = (ph - PH_L0) % LP_COUNT;
#endif
  const LP L = make_lp(p, l);
  switch (lph) {
    case LP_INPROJ:
      seg(L.last ? IP_SLOTS_LAST : IP_SLOTS_ALL, [&](int it) { inproj_tile(p, L, it, smem); });
      break;
    case LP_TOKPREP:
      seg(16 * S5_MT * 2, [&](int it) { s5a_tile(p, L, it, smem); });
      seg(TP_MT * 3, [&](int it) { mlaq_tile(p, L, it, smem); });
      seg(TP_MT * 4, [&](int it) { mlakv_tile(p, L, it, smem); });
      seg(NTOK / 64, [&](int it) { navt_item(p, it, smem); });
      seg(M2C_ITEMS, [&](int it) { m2conv_item(p, L, it); });
      seg(M2S_ITEMS, [&](int it) { m2scal_item(p, L, it); });
      break;
    case LP_MIX1: {
      const int n0 = BATCH * 8, n1 = n0 + 2 * 16 * BATCH / NWAVES, n2 = n1 + BATCH * 4 * (SEQ / 256), n3 = n2 + BATCH * 4 * (SEQ / 256);
      const int n4 = n3 + (L.last ? 0 : BATCH * 4 * ((CTXL + 255) / 256)), n5 = n4 + (L.last ? 0 : BATCH * 4 * ((CTXL + 255) / 256));
      int* qhead = (int*)(p.ws + OFF_BAR) + Q_WORD0 + 64 * (l + 2 * p.probe_rep);
#ifdef EMU
      volatile int* bc = (volatile int*)(smem + SMEM_BYTES + 8);
#else
      volatile LAS int* bc = (volatile LAS int*)(smem + SMEM_BYTES + 8);
#endif
      for (;;) {
        __syncthreads();
        if (tid_() == 0) {
#ifdef EMU
          *bc = atomicAdd(qhead, 1);
#else
          *bc = __hip_atomic_fetch_add(qhead, 1, __ATOMIC_RELAXED, __HIP_MEMORY_SCOPE_AGENT);
#endif
        }
        __syncthreads();
        const int it = *bc;
        if (it >= n5) break;
#ifdef PROBE_SKIPM2
        if (it < n0) { if (p.probe_rep == 0) m2scan_item(p, L, it, smem); }
#else
        if (it < n0) m2scan_item(p, L, it, smem);
#endif
        else if (it < n1) s5carry_item(p, L, it - n0);
        else if (it < n2) mla_attn_item(p, it - n1, false, smem);
        else if (it < n3) na_attn_item(p, L, it - n2, false, smem);
        else if (it < n4) mla_attn_item(p, it - n3, true, smem);
        else na_attn_item(p, L, it - n4, true, smem);
      }
    } break;
    case LP_MIX2:
      seg(16 * S5_MT * 2, [&](int it) { s5c_tile(p, L, it, smem); });
      seg(BATCH * 4 * M2C_MT, [&](int it) { m2corr_tile(p, L, it, smem); });
      break;
    case LP_GLU:
      seg(GLU_MT * 2, [&](int it) { glu_tile(p, L, it, smem); });
      seg(NTOK / NWAVES, [&](int it) { m2gate_item(p, L, it); });
      break;
    case LP_MERGE:
      seg(mtiles(L.last, 256) * 8, [&](int it) { merge_tile(p, L, it, smem); });
      break;
    case LP_OUT:
      seg(mtiles(L.last, 256) * 4, [&](int it) { outproj_tile(p, L, it, smem); });
      break;
    case LP_POST:
      seg(CT_EXP, [&](int it) { conv_expert_item(p, l, it, smem); });
      post_stage_router(p, L, smem);
      post_phase(p, L, smem);
      break;
    case LP_ROUTE:
      seg(BATCH * 16 * (L.last ? 1 : 2), [&](int it) { route_item(p, L, it, smem); });
      break;
    case LP_MOE1:
      seg(NE * (((L.last ? ESLOTS_L : ESLOTS) + 255) / 256) * 8, [&](int it) { moe1_tile(p, L, it, smem); });
      break;
    case LP_MOE2:
      seg(((NE * (((L.last ? ESLOTS_L : ESLOTS) + 255) / 256) + 1) / 2) * 8, [&](int it) { moe2_tile(p, L, it, smem); });
      break;
    case LP_COMB:
      comb_phase(p, L);
      break;
  }
}

__global__ void __launch_bounds__(NTHREADS, 2) mega_kernel(Params p) {
#ifdef EMU
  char* smem = emu_cur_f->blk->smem;
  for (int ph = p.phase_lo; ph < p.phase_hi; ++ph) {
    run_phase(p, ph, smem);
    if (ph + 1 < p.phase_hi) emu_grid_sync();
  }
#else
  __shared__ __attribute__((aligned(16))) char smem[SMEM_BYTES + 16 + 256];
  {
    const unsigned hw = (unsigned)__builtin_amdgcn_s_getreg((5 << 11) | 4) & 0x3fu;
    if ((threadIdx.x & 63) == 0) *(volatile int*)(smem + WAVE_TAB_OFF + hw * 4u) = (int)(threadIdx.x >> 6);
    __syncthreads();
  }
  if (p.phase_hi - p.phase_lo > 1) {
    if (threadIdx.x == 0) *(uint4*)(smem + SMEM_BYTES) = make_uint4(0u, 0u, 0u, 0u);
    __syncthreads();
    XcdBarrier xb = xcd_barrier_post((unsigned*)(p.ws + OFF_BAR), (volatile LAS unsigned*)(smem + SMEM_BYTES));
    for (int ph = p.phase_lo; ph < p.phase_hi; ++ph) {
      int reps = 1;
#ifdef PROBE_PHASE
      if (ph == PROBE_PHASE || ph == PROBE_PHASE2) reps = 1 + PROBE_REP;
#endif
      for (int rep = 0; rep < reps; ++rep) {
        p.probe_rep = rep;
        run_phase(p, ph, smem);
        if (ph + 1 < p.phase_hi || rep + 1 < reps) {
          if (ph == p.phase_lo && rep == 0) cg::this_grid().sync();
          else xcd_barrier(xb);
        }
      }
    }
  } else {
    run_phase(p, p.phase_lo, smem);
  }
#endif
}

#ifndef EMU
extern "C" void kernel_launch(void* const* d_in, const int* in_sizes, int n_in, void* d_out, int out_size, void* d_ws, size_t ws_size,
                              hipStream_t stream) {
  static int grid_blocks = 0;
  if (!grid_blocks) {
    int dev = 0, cus = 0, per_cu = 0;
    hipGetDevice(&dev);
    hipDeviceGetAttribute(&cus, hipDeviceAttributeMultiprocessorCount, dev);
    hipOccupancyMaxActiveBlocksPerMultiprocessor(&per_cu, mega_kernel, NTHREADS, 0);
    if (per_cu > 1) per_cu = 1;
    if (per_cu < 1) per_cu = 1;
    grid_blocks = cus * per_cu;
    if (ws_size < WS_TOTAL) fprintf(stderr, "workspace too small: %zu < %zu\n", ws_size, (size_t)WS_TOTAL);
  }
  Params p{};
  for (int i = 0; i < N_INPUTS; ++i) p.in[i] = (const float*)d_in[i];
  p.out = (float*)d_out;
  p.ws = (char*)d_ws;
#if MK_MULTI
  for (int ph = 0; ph < NPHASES; ++ph) {
    p.phase_lo = ph; p.phase_hi = ph + 1;
    hipLaunchKernelGGL(mega_kernel, dim3(grid_blocks), dim3(NTHREADS), 0, stream, p);
  }
#else
  p.phase_lo = 0; p.phase_hi = NPHASES;
  hipMemsetAsync((char*)d_ws + OFF_BAR, 0, BAR_BYTES, stream);
  void* args[] = {&p};
  hipError_t e = hipLaunchCooperativeKernel((void*)mega_kernel, dim3(grid_blocks), dim3(NTHREADS), args, 0, stream);
  if (e != hipSuccess) fprintf(stderr, "cooperative launch failed: %s (grid %d)\n", hipGetErrorString(e), grid_blocks);
#endif
}
#endif
```

```cpp
#ifdef EMU
#include "emu.h"
#else
#include <hip/hip_runtime.h>
#include <hip/hip_cooperative_groups.h>
#include <cstdio>
namespace cg = cooperative_groups;
using bf16x8 = __attribute__((ext_vector_type(8))) short;
using f32x4 = __attribute__((ext_vector_type(4))) float;
using f32x16 = __attribute__((ext_vector_type(16))) float;
#endif
using u32x4 = __attribute__((ext_vector_type(4))) unsigned;
#ifndef MK_MULTI
#define MK_MULTI 0
#endif

#define DI __device__ __forceinline__
typedef unsigned short bf16;

#ifdef EMU_SMALL2
constexpr int BATCH = 2, SEQ = 1024, CTXL = 64, GRID_W = 32;
#elif defined(EMU_SMALL)
constexpr int BATCH = 2, SEQ = 512, CTXL = 64, GRID_W = 32;
#else
constexpr int BATCH = 8, SEQ = 2048, CTXL = 256, GRID_W = 64;
#endif
constexpr int D = 1024, DEPTH = 2;
constexpr int TOK = CTXL + SEQ, NTOK = BATCH * TOK;
constexpr int ROWS = SEQ / GRID_W;
constexpr int WIN_R = (ROWS < 8 ? ROWS : 8), WIN_C = 16;
constexpr int N_IN = 6568, N_INP = 6656;
constexpr int C_CQ = 0, C_CKV = 256, C_KR = 384, C_NA = 416, C_S5 = 1184, C_Z = 1440, C_XBC = 1696, C_DT = 2464, C_GATE = 2472;
constexpr int P1W = 2480;
constexpr int NCH = TOK / 16, NCC = CTXL / 16, MCH = BATCH * NCH;
constexpr int NE = 16;
constexpr int CAP_L = 2 * SEQ / NE, CAP_C = 2 * CTXL / NE;
constexpr int ESLOTS = BATCH * (CAP_L + CAP_C), ESLOTS_L = BATCH * CAP_L;
constexpr int NB1 = BATCH + 1;
constexpr float EPS = 1e-6f;
constexpr int SMEM_BYTES = 147456;
constexpr int NTHREADS = 512, NWAVES = NTHREADS / 64;

enum { I_X = 0, I_C, I_CTX, I_CCTX, I_WADA, I_BADA, I_GPREMIX, I_GPOSTMIX, I_GPREFFN, I_GPOSTFFN, I_WIN, I_GCQ, I_GCKV, I_WUQ, I_WUKV, I_RPB,
       I_S5ARE, I_S5AIM, I_S5LOGSTEP, I_S5BRE, I_S5BIM, I_S5CRE, I_S5CIM, I_S5D, I_S5WGLU, I_S5BGLU, I_M2CONVW, I_M2CONVB, I_M2ALOG, I_M2DTBIAS,
       I_M2D, I_M2GNORM, I_WBRANCH, I_WOUT, I_WROUTER, I_WGATE, I_WUP, I_WDOWN, N_INPUTS };

constexpr size_t al256(size_t x) { return (x + 255) & ~(size_t)255; }
constexpr size_t SZ_X = (size_t)NTOK * D * 4;
constexpr size_t SZ_ROWBF = (size_t)NTOK * D * 2;
constexpr size_t OFF_X = 0;
constexpr size_t OFF_MOD = OFF_X + al256(SZ_X);
constexpr size_t OFF_HA = OFF_MOD + al256((size_t)DEPTH * NB1 * 6144 * 4);
constexpr size_t OFF_O = OFF_HA + al256(SZ_ROWBF);
constexpr size_t OFF_P1 = OFF_O + al256(SZ_ROWBF);
constexpr size_t SZ_P1 = (size_t)NTOK * P1W * 2;
constexpr size_t OFF_PG = OFF_P1 + al256(SZ_P1);
constexpr size_t SZ_PG = (size_t)NTOK * 4096 * 2;
constexpr size_t OFF_DT = OFF_PG + al256(SZ_PG);
constexpr size_t OFF_AFF = OFF_DT + al256((size_t)NTOK * 8 * 4);
constexpr size_t OFF_SEL = OFF_AFF + al256((size_t)NTOK * 16 * 4);
constexpr size_t OFF_IDX = OFF_SEL + al256((size_t)NTOK * 16 * 4);
constexpr size_t OFF_GW = OFF_IDX + al256((size_t)NE * ESLOTS * 4);
constexpr size_t OFF_BAR = OFF_GW + al256((size_t)NE * ESLOTS * 4);
constexpr size_t BAR_BYTES = (3456 + 64 * 4) * 4;
constexpr int Q_WORD0 = 3456;
constexpr size_t OFF_ROPE = OFF_BAR + al256(BAR_BYTES);
constexpr size_t OFF_WEARLY = OFF_ROPE + al256(64 * 8 * 2 * 4);
constexpr size_t WE_WIN = 0;
constexpr size_t WE_UQ = WE_WIN + (size_t)N_INP * 1024 * 2;
constexpr size_t WE_UKV = WE_UQ + (size_t)384 * 256 * 2;
constexpr size_t WE_GLU = WE_UKV + (size_t)512 * 128 * 2;
constexpr size_t WE_WB = WE_GLU + (size_t)256 * 256 * 2;
constexpr size_t WE_WOUT = WE_WB + (size_t)4 * 1024 * 256 * 2;
constexpr size_t WE_SIZE = al256(WE_WOUT + (size_t)1024 * 1024 * 2);
constexpr size_t OFF_S5TAB = OFF_WEARLY + DEPTH * WE_SIZE;
constexpr size_t S5_LAMPOW = 0;
constexpr size_t S5_BBAR = S5_LAMPOW + (size_t)2 * 16 * 17 * 64 * 2 * 4;
constexpr size_t S5_KT = S5_BBAR + (size_t)2 * 16 * 64 * 16 * 2 * 4;
constexpr size_t S5_WA = S5_KT + (size_t)2 * 16 * 16 * 256 * 4;
constexpr size_t S5_W2 = S5_WA + (size_t)16 * 256 * 256 * 2;
constexpr size_t S5_SIZE = al256(S5_W2 + (size_t)16 * 256 * 512 * 2);
constexpr size_t OFF_MIX = OFF_S5TAB + DEPTH * S5_SIZE;
constexpr size_t MX_Q = 0;
constexpr size_t MX_K = MX_Q + al256((size_t)BATCH * 4 * TOK * 96 * 2);
constexpr size_t MX_VTM = MX_K + al256((size_t)BATCH * 4 * TOK * 96 * 2);
constexpr size_t MX_VTN = MX_VTM + al256((size_t)BATCH * 4 * 64 * TOK * 2);
constexpr size_t MX_XBC = MX_VTN + al256((size_t)BATCH * 4 * 64 * TOK * 2);
constexpr size_t MX_US5 = MX_XBC + al256((size_t)NTOK * 768 * 2);
constexpr size_t MX_HEND = MX_US5 + al256((size_t)NTOK * 256 * 2);
constexpr size_t MX_HIN = MX_HEND + al256((size_t)16 * MCH * 256 * 4);
constexpr size_t MX_Z = MX_HIN + al256((size_t)16 * MCH * 256 * 2);
constexpr size_t MX_XBT = MX_Z + al256((size_t)NTOK * 256 * 2);
constexpr size_t MX_M2S = MX_XBT + al256((size_t)NTOK * 512 * 2);
constexpr int M2_SPLIT = ((TOK / 64 + 1) / 2) * 64, M2_REST = TOK - M2_SPLIT;
constexpr size_t MX_HM = MX_M2S + al256((size_t)BATCH * 8 * TOK * 4 * 4);
constexpr size_t MX_GT = MX_HM + al256((size_t)BATCH * 4 * 128 * 128 * 2);
constexpr size_t MX_SIZE = MX_GT + al256((size_t)BATCH * 8 * M2_REST * 4);
constexpr size_t WX_GU = 0;
constexpr size_t WX_DN = WX_GU + (size_t)NE * 2048 * 1024 * 2;
constexpr size_t WX_SIZE = WX_DN + (size_t)NE * 1024 * 1024 * 2;
constexpr size_t MIXREG = (MX_SIZE > WX_SIZE ? MX_SIZE : WX_SIZE);
constexpr size_t WS_TOTAL = OFF_MIX + al256(MIXREG);

struct Params {
  const float* in[N_INPUTS];
  float* out;
  char* ws;
  int phase_lo, phase_hi;
  int probe_rep, pad_;
};

constexpr int WAVE_TAB_OFF = SMEM_BYTES + 16;
DI int tid_() {
#ifdef EMU
  return (int)threadIdx.x;
#else
  const unsigned hw = (unsigned)__builtin_amdgcn_s_getreg((5 << 11) | 4) & 0x3fu;
  const int wave = *(volatile __attribute__((address_space(3))) int*)(unsigned long)(WAVE_TAB_OFF + hw * 4u);
  int lane;
  asm volatile("v_mbcnt_lo_u32_b32 %0, -1, 0\n\tv_mbcnt_hi_u32_b32 %0, -1, %0" : "=v"(lane));
  return wave * 64 + lane;
#endif
}
#ifdef EMU
template <class T> DI T shfl_xor_(T v, int m) { return __shfl_xor(v, m); }
template <class T> DI T shfl_up_(T v, int d) { return __shfl_up(v, d); }
template <class T> DI T shfl_(T v, int src) { return __shfl(v, src); }
#else
template <class T> DI T shfl_xor_(T v, int m) {
  const int idx = ((tid_() & 63) ^ m) << 2;
  return __builtin_bit_cast(T, __builtin_amdgcn_ds_bpermute(idx, __builtin_bit_cast(int, v)));
}
template <class T> DI T shfl_up_(T v, int d) {
  const int l = tid_() & 63; const int idx = (l >= d ? l - d : l) << 2;
  return __builtin_bit_cast(T, __builtin_amdgcn_ds_bpermute(idx, __builtin_bit_cast(int, v)));
}
template <class T> DI T shfl_(T v, int src) {
  int idx = src << 2; asm volatile("" : "+v"(idx));
  return __builtin_bit_cast(T, __builtin_amdgcn_ds_bpermute(idx, __builtin_bit_cast(int, v)));
}
#endif
DI float bf2f(bf16 h) { return __uint_as_float(((unsigned)h) << 16); }
#ifdef EMU
DI bf16 f2bf(float f) { unsigned u = __float_as_uint(f); u += 0x7fffu + ((u >> 16) & 1u); return (bf16)(u >> 16); }
DI unsigned pack2(float a, float b) { return (unsigned)f2bf(a) | ((unsigned)f2bf(b) << 16); }
DI float exp2f_(float x) { return exp2f(x); }
#else
typedef float f32x2_t_ __attribute__((ext_vector_type(2)));
typedef __bf16 bf16x2_t_ __attribute__((ext_vector_type(2)));
DI unsigned pack2(float a, float b) { const f32x2_t_ v = {a, b}; return __builtin_bit_cast(unsigned, __builtin_convertvector(v, bf16x2_t_)); }
DI bf16 f2bf(float f) { return (bf16)(pack2(f, 0.f) & 0xffffu); }
DI float exp2f_(float x) { return __builtin_amdgcn_exp2f(x); }
#endif
#ifdef EMU
DI float rcp_(float x) { return 1.0f / x; }
#else
DI float rcp_(float x) { return __builtin_amdgcn_rcpf(x); }
#endif
DI float sigmoidf_(float x) { return rcp_(1.0f + exp2f_(-1.4426950408889634f * x)); }
DI float siluf_(float x) { return x * rcp_(1.0f + exp2f_(-1.4426950408889634f * x)); }
DI float softplusf_(float x) { const float ax = x < 0.f ? -x : x; return (x > 0.f ? x : 0.f) + __logf(1.0f + __expf(-ax)); }
DI float geluf_(float x) { const float u2 = 1.5957691216057308f * (x + 0.044715f * x * x * x); return x * rcp_(1.0f + exp2f_(-1.4426950408889634f * u2)); }
DI bool wave_all_(bool c) {
#ifdef EMU
  int v = c ? 0 : 1;
  v += shfl_xor_(v, 32); v += shfl_xor_(v, 16); v += shfl_xor_(v, 8); v += shfl_xor_(v, 4); v += shfl_xor_(v, 2); v += shfl_xor_(v, 1);
  return v == 0;
#else
  return __builtin_amdgcn_ballot_w64(!c) == 0ull;
#endif
}
DI float wave_sum(float v) {
#ifdef EMU
  v += shfl_xor_(v, 32); v += shfl_xor_(v, 16); v += shfl_xor_(v, 8); v += shfl_xor_(v, 4); v += shfl_xor_(v, 2); v += shfl_xor_(v, 1);
  return v;
#else
  int x = __float_as_int(v);
  x = __float_as_int(__int_as_float(x) + __int_as_float(__builtin_amdgcn_update_dpp(0, x, 0xB1, 0xF, 0xF, true)));
  x = __float_as_int(__int_as_float(x) + __int_as_float(__builtin_amdgcn_update_dpp(0, x, 0x4E, 0xF, 0xF, true)));
  x = __float_as_int(__int_as_float(x) + __int_as_float(__builtin_amdgcn_update_dpp(0, x, 0x141, 0xF, 0xF, true)));
  x = __float_as_int(__int_as_float(x) + __int_as_float(__builtin_amdgcn_update_dpp(0, x, 0x140, 0xF, 0xF, true)));
  const float r0 = __int_as_float(__builtin_amdgcn_readlane(x, 0)), r1 = __int_as_float(__builtin_amdgcn_readlane(x, 16));
  const float r2 = __int_as_float(__builtin_amdgcn_readlane(x, 32)), r3 = __int_as_float(__builtin_amdgcn_readlane(x, 48));
  return (r0 + r1) + (r2 + r3);
#endif
}
#ifndef EMU
#define XB_TMO      128
#define XB_XCNT(j)  (256  + 64 * (j))
#define XB_XSUB(j)  (1280 + 64 * (j))
#define XB_XGEN(j)  (2304 + 64 * (j))
#define XB_TOP      3328
#define XB_TOPGEN   3392
#define XB_SPIN_CAP (1u << 24)
#define LAS __attribute__((address_space(3)))
DI unsigned xb_ld(unsigned* p) { return __hip_atomic_load(p, __ATOMIC_RELAXED, __HIP_MEMORY_SCOPE_AGENT); }
DI unsigned xb_add(unsigned* p, unsigned v) { return __hip_atomic_fetch_add(p, v, __ATOMIC_RELAXED, __HIP_MEMORY_SCOPE_AGENT); }
DI unsigned xb_xcc_id() { return (unsigned)__builtin_amdgcn_s_getreg((3 << 11) | 20) & 0xFu; }
#define XB_SPIN(cond, bar) do { unsigned _sp = 0; while (cond) { __builtin_amdgcn_s_sleep(1); \
    if ((++_sp & 255u) == 0u) { if (xb_ld(&(bar)[XB_TMO])) break; if (_sp > XB_SPIN_CAP) { atomicAdd(&(bar)[XB_TMO], 1u); break; } } } } while (0)
struct XcdBarrier { unsigned* bar; unsigned x; volatile LAS unsigned* st; };
DI XcdBarrier xcd_barrier_post(unsigned* bar, volatile LAS unsigned* st) {
  XcdBarrier b; b.bar = bar; b.x = xb_xcc_id(); b.st = st;
  if (threadIdx.x == 0) (void)xb_add(&bar[XB_XCNT(b.x)], 1u);
  return b;
}
DI void xcd_barrier_complete(unsigned* bar, unsigned x, unsigned& nloc, unsigned& nx) {
  const unsigned G = gridDim.x * gridDim.y * gridDim.z;
  unsigned sum, cnt, mine, sp = 0u;
  for (;;) {
    sum = 0u; cnt = 0u; mine = 0u;
#pragma unroll
    for (unsigned j = 0; j < 16; ++j) { const unsigned c = xb_ld(&bar[XB_XCNT(j)]); sum += c; cnt += (c > 0u) ? 1u : 0u; mine = (j == x) ? c : mine; }
    if (sum == G) break;
    __builtin_amdgcn_s_sleep(1);
    if ((++sp & 255u) == 0u) { if (xb_ld(&bar[XB_TMO])) break; if (sp > XB_SPIN_CAP) { atomicAdd(&bar[XB_TMO], 1u); break; } }
  }
  nloc = mine > 0u ? mine : 1u; nx = cnt > 0u ? cnt : 1u;
}
DI void xcd_barrier(const XcdBarrier& b) {
  asm volatile("s_waitcnt vmcnt(0)" ::: "memory");
  __syncthreads();
  if (threadIdx.x == 0) {
    unsigned* bar = b.bar;
    __builtin_amdgcn_s_waitcnt(0);
    unsigned nloc = b.st[0], nx = b.st[1];
    if (nloc == 0u) { xcd_barrier_complete(bar, b.x, nloc, nx); b.st[0] = nloc; b.st[1] = nx; }
    const unsigned old = xb_add(&bar[XB_XSUB(b.x)], 1u);
    const unsigned gen = old / nloc;
    if (old + 1u == (gen + 1u) * nloc) {
      __builtin_amdgcn_fence(__ATOMIC_RELEASE, "agent");
      asm volatile("s_waitcnt vmcnt(0)" ::: "memory");
      const unsigned og = xb_add(&bar[XB_TOP], 1u);
      const unsigned tg = og / nx;
      if (og + 1u == (tg + 1u) * nx) xb_add(&bar[XB_TOPGEN], 1u);
      else XB_SPIN(xb_ld(&bar[XB_TOPGEN]) == tg, bar);
      __builtin_amdgcn_fence(__ATOMIC_ACQUIRE, "agent");
      xb_add(&bar[XB_XGEN(b.x)], 1u);
      asm volatile("s_waitcnt vmcnt(0)" ::: "memory");
    } else {
      XB_SPIN(xb_ld(&bar[XB_XGEN(b.x)]) == gen, bar);
      __builtin_amdgcn_fence(__ATOMIC_ACQUIRE, "agent");
      asm volatile("s_waitcnt vmcnt(0)" ::: "memory");
    }
  }
  __syncthreads();
}
#endif

struct GA {
  const bf16* A; const bf16* A2; int lda, lda2, ksplit;
  const int* ridx; int mvalid;
  const bf16* Bt; int ldb; int K;
  int kfix;
};
DI GA make_ga(const bf16* A, int lda, const bf16* Bt, int ldb, int K, int mvalid) {
  GA g; g.A = A; g.A2 = A; g.lda = lda; g.lda2 = lda; g.ksplit = K; g.ridx = nullptr; g.mvalid = mvalid; g.Bt = Bt; g.ldb = ldb; g.K = K; g.kfix = 0; return g;
}

#ifdef EMU
#define GLDS16(gptr_, lptr_) memcpy((void*)(lptr_), (const void*)(gptr_), 16)
#define BGLDS16(rsrc_, base_, voff_, soff_, lptr_) memcpy((void*)(lptr_), (const char*)(base_) + (voff_) + (soff_), 16)
#define GEMM_WAIT(N_)
#define RAW_BARRIER() __syncthreads()
#else
#define LASV __attribute__((address_space(3))) void
#define GLDS16(gptr_, lptr_) __builtin_amdgcn_global_load_lds((const void*)(gptr_), (LASV*)(lptr_), 16, 0, 0)
#define BGLDS16(rsrc_, base_, voff_, soff_, lptr_) __builtin_amdgcn_raw_ptr_buffer_load_lds(rsrc_, (LASV*)(lptr_), 16, (int)(voff_), (int)(soff_), 0, 0)
#define GEMM_WAIT(N_) asm volatile("s_waitcnt vmcnt(%0)" :: "n"(N_) : "memory")
#define RAW_BARRIER() { asm volatile("" ::: "memory"); __builtin_amdgcn_s_barrier(); asm volatile("" ::: "memory"); }
#endif
DI int perm32(int rho) { const int n = rho >> 4, i = rho & 15; return 8 * (i >> 2) + 4 * n + (i & 3); }
constexpr int SRS_OFF = 73728;
template <int NT>
DI void gemm_s(const GA& g, int m0, int n0, char* smem, f32x4 (&acc)[4][NT]) {
  constexpr int A_ELEMS = 256 * 32, B_ELEMS = 32 * NT * 32, STAGE = A_ELEMS + B_ELEMS;
  bf16* st = (bf16*)smem;
  const int tid = tid_(), lane = tid & 63, wid = tid >> 6, wr = wid >> 1, wc = wid & 1, fr = lane & 15, fq = lane >> 4;
  const int lrow = tid >> 2, pch = tid & 3;
  long aoff[2], aoff2[2], boff;
#pragma unroll
  for (int i = 0; i < 2; ++i) {
    const int row = lrow + 128 * i;
    const int lch = pch ^ ((-(row >> 2)) & 3);
    int gm = m0 + row; if (gm > g.mvalid - 1) gm = g.mvalid - 1;
    const int ar = g.ridx ? g.ridx[gm] : gm;
    aoff[i] = (long)ar * g.lda + lch * 8;
    aoff2[i] = (long)ar * g.lda2 + lch * 8;
  }
  const int cb = (NT == 4) ? tid : (tid & 255);
  {
    const int row = cb >> 2;
    const int lch = pch ^ ((-(row >> 2)) & 3);
    const int src = n0 + (row & ~31) + perm32(row & 31);
    boff = (long)src * g.ldb + lch * 8;
  }
#pragma unroll
  for (int m = 0; m < 4; ++m)
#pragma unroll
    for (int n = 0; n < NT; ++n) acc[m][n] = f32x4{0.f, 0.f, 0.f, 0.f};
  const int T = g.K / 32;
#define GEMM_DMA(t_, stg_) { const int k0_ = (t_) * 32; const bool seg2_ = (k0_ >= g.ksplit); bf16* sa_ = st + (stg_) * STAGE; \
    _Pragma("unroll") for (int i_ = 0; i_ < 2; ++i_) { \
      const bf16* ap_ = seg2_ ? (g.A2 + aoff2[i_] + (k0_ - g.ksplit)) : (g.A + aoff[i_] + k0_); \
      GLDS16(ap_, sa_ + (tid + i_ * 512) * 8); } \
    GLDS16(g.Bt + boff + k0_, sa_ + A_ELEMS + cb * 8); }
  __syncthreads();
  GEMM_DMA(0, 0)
  if (T > 1) GEMM_DMA(1, 1)
  int s_cur = 0, s_nxt = 2;
#pragma unroll 1
  for (int t = 0; t < T; ++t) {
    if (t + 1 < T) { GEMM_WAIT(3); } else { GEMM_WAIT(0); }
    RAW_BARRIER();
    if (t + 2 < T) GEMM_DMA(t + 2, s_nxt)
    const bf16* sa = st + s_cur * STAGE;
    const bf16* sb = sa + A_ELEMS;
    bf16x8 af[4], bfr[NT];
#pragma unroll
    for (int n = 0; n < NT; ++n) {
      const int row = wc * (16 * NT) + n * 16 + fr;
      bfr[n] = *(const bf16x8*)(sb + row * 32 + ((fq ^ ((-(row >> 2)) & 3)) << 3));
    }
#pragma unroll
    for (int m = 0; m < 4; ++m) {
      const int row = wr * 64 + m * 16 + fr;
      af[m] = *(const bf16x8*)(sa + row * 32 + ((fq ^ ((-(row >> 2)) & 3)) << 3));
    }
#pragma unroll
    for (int m = 0; m < 4; ++m)
#pragma unroll
      for (int n = 0; n < NT; ++n) acc[m][n] = __builtin_amdgcn_mfma_f32_16x16x32_bf16(bfr[n], af[m], acc[m][n], 0, 0, 0);
    s_cur = (s_cur == 2) ? 0 : s_cur + 1;
    s_nxt = (s_nxt == 2) ? 0 : s_nxt + 1;
  }
}
constexpr int BG_HT = 128 * 64;
DI int lds_byte(int r, int c) { const int stt = (r >> 4) * 2 + (c >> 5), rr = r & 15, cc = c & 31, ob = rr * 64 + cc * 2; return stt * 1024 + (ob ^ (((ob >> 9) & 1) << 5)); }
DI void stage_rc(int b, int& R, int& C) { const int stt = b / 1024, sb = b % 1024, swz = sb ^ (((sb >> 9) & 1) << 5); R = (stt >> 1) * 16 + swz / 64; C = (stt & 1) * 32 + (swz % 64) / 2; }
#ifdef EMU
#define BG_WAIT_V(n)
#define BG_WAIT_L(n)
#define BG_BAR __syncthreads()
#define BG_SCHED
#define BG_PRIO(x)
#else
#define BG_WAIT_V(n) asm volatile("s_waitcnt vmcnt(" #n ")" ::: "memory")
#define BG_WAIT_L(n) asm volatile("s_waitcnt lgkmcnt(" #n ")" ::: "memory")
#define BG_BAR __builtin_amdgcn_s_barrier()
#define BG_SCHED __builtin_amdgcn_sched_barrier(0)
#define BG_PRIO(x) __builtin_amdgcn_s_setprio(x)
#endif
DI void gemm_big(const GA& g, int m0, int n0, char* smem, f32x4 (&acc)[2][2][4][2]) {
  bf16* shm = (bf16*)smem;
  const int tid = tid_(), wid = tid >> 6, lane = tid & 63, wr = wid >> 2, wc = wid & 3, fr = lane & 15, fq = lane >> 4;
  unsigned aof[2][2], bof[2];
#ifdef EMU
  const int dma_lds = tid * 16;
#else
  const int dma_lds = __builtin_amdgcn_readfirstlane(tid >> 6) * 1024;
#endif
#ifndef EMU
  const __amdgpu_buffer_rsrc_t rsA = __builtin_amdgcn_make_buffer_rsrc((void*)g.A, 0, 0x7fffffff, 0x00020000);
  const __amdgpu_buffer_rsrc_t rsB = __builtin_amdgcn_make_buffer_rsrc((void*)g.Bt, 0, 0x7fffffff, 0x00020000);
#endif
#pragma unroll
  for (int i = 0; i < 2; ++i) {
    int R, C; stage_rc(tid * 16 + i * 8192, R, C);
    bof[i] = (unsigned)((n0 + (R & ~31) + perm32(R & 31)) * g.ldb + C) * 2u;
#pragma unroll
    for (int h = 0; h < 2; ++h) {
      int gm = m0 + h * 128 + R; if (gm > g.mvalid - 1) gm = g.mvalid - 1;
      const int ar = g.ridx ? g.ridx[gm] : gm;
      aof[h][i] = (unsigned)(ar * g.lda + C) * 2u;
    }
  }
#define BG_SA(b, h) (shm + ((b) * 2 + (h)) * BG_HT)
#define BG_SB(b, h) (shm + (4 + (b) * 2 + (h)) * BG_HT)
#define BG_STAGE_A(P, h, kt) { \
    _Pragma("unroll") for (int i_ = 0; i_ < 2; ++i_) BGLDS16(rsA, g.A, aof[h][i_], (kt) * 128, (char*)(P) + dma_lds + i_ * 8192); }
#define BG_STAGE_B(P, h, kt) { \
    _Pragma("unroll") for (int i_ = 0; i_ < 2; ++i_) BGLDS16(rsB, g.Bt, bof[i_], (kt) * 128 + (h) * 256 * g.ldb, (char*)(P) + dma_lds + i_ * 8192); }
#define BG_LDA(dst, b, h) _Pragma("unroll") for (int m_ = 0; m_ < 4; ++m_) _Pragma("unroll") for (int k_ = 0; k_ < 2; ++k_) \
    dst[m_][k_] = *(const bf16x8*)((const char*)BG_SA(b, h) + lds_byte(wr * 64 + m_ * 16 + fr, k_ * 32 + fq * 8))
#define BG_LDB(dst, b, h) _Pragma("unroll") for (int n_ = 0; n_ < 2; ++n_) _Pragma("unroll") for (int k_ = 0; k_ < 2; ++k_) \
    dst[n_][k_] = *(const bf16x8*)((const char*)BG_SB(b, h) + lds_byte(wc * 32 + n_ * 16 + fr, k_ * 32 + fq * 8))
#define BG_MMA(ai, bj, At_, Bt_) { BG_PRIO(1); \
    _Pragma("unroll") for (int m_ = 0; m_ < 4; ++m_) _Pragma("unroll") for (int n_ = 0; n_ < 2; ++n_) _Pragma("unroll") for (int k_ = 0; k_ < 2; ++k_) \
      acc[ai][bj][m_][n_] = __builtin_amdgcn_mfma_f32_16x16x32_bf16(Bt_[n_][k_], At_[m_][k_], acc[ai][bj][m_][n_], 0, 0, 0); \
    BG_PRIO(0); }
#pragma unroll
  for (int a_ = 0; a_ < 2; ++a_)
#pragma unroll
    for (int b_ = 0; b_ < 2; ++b_)
#pragma unroll
      for (int m_ = 0; m_ < 4; ++m_)
#pragma unroll
        for (int n_ = 0; n_ < 2; ++n_) acc[a_][b_][m_][n_] = f32x4{0.f, 0.f, 0.f, 0.f};
  bf16x8 At[4][2], B0[2][2], B1[2][2];
  const int nt = g.K / 64;
  __syncthreads();
  BG_STAGE_B(BG_SB(0, 0), 0, 0) BG_STAGE_A(BG_SA(0, 0), 0, 0)
  BG_STAGE_B(BG_SB(0, 1), 1, 0) BG_STAGE_A(BG_SA(0, 1), 1, 0)
  if (wr == 1) BG_BAR;
  BG_WAIT_V(4); BG_BAR;
  BG_STAGE_B(BG_SB(1, 0), 0, 1) BG_STAGE_A(BG_SA(1, 0), 0, 1) BG_STAGE_B(BG_SB(1, 1), 1, 1)
  BG_WAIT_V(6); BG_BAR;
#pragma unroll 1
  for (int t = 0; t < nt - 2; t += 2) {
    BG_LDB(B0, 0, 0); BG_SCHED; BG_LDA(At, 0, 0); BG_STAGE_A(BG_SA(1, 1), 1, t + 1)
    BG_WAIT_L(8); BG_BAR; BG_WAIT_L(0); BG_MMA(0, 0, At, B0) BG_BAR; BG_SCHED;
    BG_LDB(B1, 0, 1); BG_STAGE_B(BG_SB(0, 0), 0, t + 2)
    BG_BAR; BG_WAIT_L(0); BG_MMA(0, 1, At, B1) BG_BAR;
    BG_LDA(At, 0, 1); BG_STAGE_A(BG_SA(0, 0), 0, t + 2)
    BG_BAR; BG_WAIT_L(0); BG_MMA(1, 0, At, B0) BG_BAR; BG_SCHED;
    BG_STAGE_B(BG_SB(0, 1), 1, t + 2)
    BG_WAIT_V(6); BG_BAR; BG_MMA(1, 1, At, B1) BG_BAR;
    BG_LDB(B0, 1, 0); BG_SCHED; BG_LDA(At, 1, 0); BG_STAGE_A(BG_SA(0, 1), 1, t + 2)
    BG_WAIT_L(8); BG_BAR; BG_WAIT_L(0); BG_MMA(0, 0, At, B0) BG_BAR; BG_SCHED;
    BG_LDB(B1, 1, 1); BG_STAGE_B(BG_SB(1, 0), 0, t + 3)
    BG_BAR; BG_WAIT_L(0); BG_MMA(0, 1, At, B1) BG_BAR;
    BG_LDA(At, 1, 1); BG_STAGE_A(BG_SA(1, 0), 0, t + 3)
    BG_BAR; BG_WAIT_L(0); BG_MMA(1, 0, At, B0) BG_BAR; BG_SCHED;
    BG_STAGE_B(BG_SB(1, 1), 1, t + 3)
    BG_WAIT_V(6); BG_BAR; BG_MMA(1, 1, At, B1) BG_BAR;
  }
  { BG_LDB(B0, 0, 0); BG_LDA(At, 0, 0); BG_STAGE_A(BG_SA(1, 1), 1, nt - 1)
    BG_BAR; BG_WAIT_L(0); BG_MMA(0, 0, At, B0) BG_BAR;
    BG_LDB(B1, 0, 1); BG_BAR; BG_WAIT_L(0); BG_MMA(0, 1, At, B1) BG_BAR;
    BG_LDA(At, 0, 1); BG_WAIT_V(4); BG_BAR; BG_WAIT_L(0); BG_MMA(1, 0, At, B0) BG_MMA(1, 1, At, B1) BG_BAR; }
  { BG_LDB(B0, 1, 0); BG_LDA(At, 1, 0); BG_WAIT_V(2); BG_BAR; BG_WAIT_L(0); BG_MMA(0, 0, At, B0) BG_BAR;
    BG_LDB(B1, 1, 1); BG_WAIT_V(0); BG_BAR; BG_WAIT_L(0); BG_MMA(0, 1, At, B1) BG_BAR;
    BG_LDA(At, 1, 1); BG_BAR; BG_WAIT_L(0); BG_MMA(1, 0, At, B0) BG_MMA(1, 1, At, B1) BG_BAR; }
  if (wr == 0) BG_BAR;
}
#define EPIB_BEGIN(acc_, m0_, n0_, mvalid_) { const int _l = tid_() & 63, _w = tid_() >> 6, _wr = _w >> 2, _wc = _w & 3, _fr = _l & 15, _fq = _l >> 4; \
  _Pragma("unroll") for (int _ai = 0; _ai < 2; ++_ai) _Pragma("unroll") for (int _m = 0; _m < 4; ++_m) { const int row = (m0_) + _ai * 128 + _wr * 64 + _m * 16 + _fr; \
  _Pragma("unroll") for (int _bj = 0; _bj < 2; ++_bj) { const int col = (n0_) + _bj * 128 + _wc * 32 + 8 * _fq; (void)col; \
    float v[8] = {acc_[_ai][_bj][_m][0][0], acc_[_ai][_bj][_m][0][1], acc_[_ai][_bj][_m][0][2], acc_[_ai][_bj][_m][0][3], \
                  acc_[_ai][_bj][_m][1][0], acc_[_ai][_bj][_m][1][1], acc_[_ai][_bj][_m][1][2], acc_[_ai][_bj][_m][1][3]}; \
    if (row < (mvalid_)) {
#define EPIB_END }}}}

DI void ld8bf(const bf16* p, float (&v)[8]) {
  uint4 w = *(const uint4*)p;
  v[0] = __uint_as_float(w.x << 16); v[1] = __uint_as_float(w.x & 0xffff0000u); v[2] = __uint_as_float(w.y << 16); v[3] = __uint_as_float(w.y & 0xffff0000u);
  v[4] = __uint_as_float(w.z << 16); v[5] = __uint_as_float(w.z & 0xffff0000u); v[6] = __uint_as_float(w.w << 16); v[7] = __uint_as_float(w.w & 0xffff0000u);
}
DI void st8bf(bf16* p, const float (&v)[8]) { *(uint4*)p = make_uint4(pack2(v[0], v[1]), pack2(v[2], v[3]), pack2(v[4], v[5]), pack2(v[6], v[7])); }
DI void st8f(float* p, const float (&v)[8]) { *(float4*)p = make_float4(v[0], v[1], v[2], v[3]); *(float4*)(p + 4) = make_float4(v[4], v[5], v[6], v[7]); }
#define EPI_BEGIN(NT_, acc_, m0_, n0_, mvalid_) { const int _l = tid_() & 63, _w = tid_() >> 6, _wr = _w >> 1, _wc = _w & 1, _fr = _l & 15, _fq = _l >> 4; \
  _Pragma("unroll") for (int _m = 0; _m < 4; ++_m) { const int row = (m0_) + _wr * 64 + _m * 16 + _fr; \
  _Pragma("unroll") for (int _q = 0; _q < (NT_) / 2; ++_q) { const int col = (n0_) + _wc * (16 * (NT_)) + _q * 32 + 8 * _fq; (void)col; \
    float v[8] = {acc_[_m][2 * _q][0], acc_[_m][2 * _q][1], acc_[_m][2 * _q][2], acc_[_m][2 * _q][3], \
                  acc_[_m][2 * _q + 1][0], acc_[_m][2 * _q + 1][1], acc_[_m][2 * _q + 1][2], acc_[_m][2 * _q + 1][3]}; \
    if (row < (mvalid_)) {
#define EPI_END }}}}

DI int mtile_row0(int mt, bool latonly, int TH) {
  if (!latonly) return mt * TH;
  const int per = SEQ / TH, b = mt / per, r = mt % per;
  return b * TOK + CTXL + r * TH;
}
DI int mtiles(bool latonly, int TH) { return latonly ? BATCH * (SEQ / TH) : (NTOK + TH - 1) / TH; }

struct LP {
  int l; bool last;
  const float* mod;
  char* we;
  char* s5;
};
DI LP make_lp(const Params& p, int l) {
  LP q; q.l = l; q.last = (l == DEPTH - 1);
  q.mod = (const float*)(p.ws + OFF_MOD) + (size_t)l * NB1 * 6144;
  q.we = p.ws + OFF_WEARLY + (size_t)l * WE_SIZE;
  q.s5 = p.ws + OFF_S5TAB + (size_t)l * S5_SIZE;
  return q;
}

template <class RowMap>
DI void conv_tile(const float* src, int lds, int nsrc, const float* kscale, bf16* dst, int K, int k0, int n0, char* smem, RowMap rowmap, int ndst = 1 << 30) {
  (void)smem;
  const int tid = tid_(), n4 = (tid >> 6) * 32 + (tid & 7) * 4, k8 = ((tid >> 3) & 7) * 8;
  float4 v[8];
  const bool ok = (n0 + n4 < nsrc);
  const float* sp = src + (size_t)(k0 + k8) * lds + n0 + n4;
#pragma unroll
  for (int k = 0; k < 8; ++k) v[k] = ok ? *(const float4*)(sp + (size_t)k * lds) : make_float4(0.f, 0.f, 0.f, 0.f);
  if (kscale) {
#pragma unroll
    for (int k = 0; k < 8; ++k) { const float sc = kscale[k0 + k8 + k]; v[k].x *= sc; v[k].y *= sc; v[k].z *= sc; v[k].w *= sc; }
  }
  float o[8];
#pragma unroll
  for (int k = 0; k < 8; ++k) o[k] = v[k].x;
  if (n0 + n4 + 0 < ndst) st8bf(dst + (size_t)rowmap(n0 + n4 + 0) * K + k0 + k8, o);
#pragma unroll
  for (int k = 0; k < 8; ++k) o[k] = v[k].y;
  if (n0 + n4 + 1 < ndst) st8bf(dst + (size_t)rowmap(n0 + n4 + 1) * K + k0 + k8, o);
#pragma unroll
  for (int k = 0; k < 8; ++k) o[k] = v[k].z;
  if (n0 + n4 + 2 < ndst) st8bf(dst + (size_t)rowmap(n0 + n4 + 2) * K + k0 + k8, o);
#pragma unroll
  for (int k = 0; k < 8; ++k) o[k] = v[k].w;
  if (n0 + n4 + 3 < ndst) st8bf(dst + (size_t)rowmap(n0 + n4 + 3) * K + k0 + k8, o);
}
struct RowId { DI int operator()(int n) const { return n; } };
struct RowGU { int half; DI int operator()(int f) const { return (f >> 7) * 256 + half * 128 + (f & 127); } };

constexpr int CT_WIN = 16 * (N_INP / 256), CT_UQ = 4 * 2, CT_UKV = 2 * 2, CT_GLU = 4, CT_WB = 4 * 16, CT_WOUT = 64;
constexpr int CT_EARLY = CT_WIN + CT_UQ + CT_UKV + CT_GLU + CT_WB + CT_WOUT;
constexpr int CT_EXP = NE * 3 * 64;

DI void conv_early_item(const Params& p, int l, int it, char* smem) {
  char* we = p.ws + OFF_WEARLY + (size_t)l * WE_SIZE;
  if (it < CT_WIN) {
    int kt = it % 16, nt = it / 16;
    conv_tile(p.in[I_WIN] + (size_t)l * 1024 * N_IN, N_IN, N_IN, nullptr, (bf16*)(we + WE_WIN), 1024, kt * 64, nt * 256, smem, RowId());
    return;
  }
  it -= CT_WIN;
  if (it < CT_UQ) {
    int kt = it % 4, nt = it / 4;
    conv_tile(p.in[I_WUQ] + (size_t)l * 256 * 384, 384, 384, p.in[I_GCQ] + l * 256, (bf16*)(we + WE_UQ), 256, kt * 64, nt * 256, smem, RowId(), 384);
    return;
  }
  it -= CT_UQ;
  if (it < CT_UKV) {
    int kt = it % 2, nt = it / 2;
    conv_tile(p.in[I_WUKV] + (size_t)l * 128 * 512, 512, 512, p.in[I_GCKV] + l * 128, (bf16*)(we + WE_UKV), 128, kt * 64, nt * 256, smem, RowId());
    return;
  }
  it -= CT_UKV;
  if (it < CT_GLU) {
    int kt = it;
    conv_tile(p.in[I_S5WGLU] + (size_t)l * 256 * 256, 256, 256, nullptr, (bf16*)(we + WE_GLU), 256, kt * 64, 0, smem, RowId());
    return;
  }
  it -= CT_GLU;
  if (it < CT_WB) {
    int j = it / 16, r = it % 16, kt = r % 4, nt = r / 4;
    conv_tile(p.in[I_WBRANCH] + ((size_t)l * 4 + j) * 256 * 1024, 1024, 1024, nullptr, (bf16*)(we + WE_WB) + (size_t)j * 1024 * 256, 256, kt * 64, nt * 256, smem, RowId());
    return;
  }
  it -= CT_WB;
  {
    int kt = it % 16, nt = it / 16;
    conv_tile(p.in[I_WOUT] + (size_t)l * 1024 * 1024, 1024, 1024, nullptr, (bf16*)(we + WE_WOUT), 1024, kt * 64, nt * 256, smem, RowId());
  }
}
DI void conv_expert_item(const Params& p, int l, int it, char* smem) {
  char* wx = p.ws + OFF_MIX;
  int e = it / 192, r = it % 192, which = r / 64, t = r % 64, kt = t % 16, nt = t / 16;
  size_t eoff = ((size_t)l * NE + e) * 1024 * 1024;
  if (which == 0) { RowGU rm; rm.half = 0; conv_tile(p.in[I_WGATE] + eoff, 1024, 1024, nullptr, (bf16*)(wx + WX_GU) + (size_t)e * 2048 * 1024, 1024, kt * 64, nt * 256, smem, rm); }
  else if (which == 1) { RowGU rm; rm.half = 1; conv_tile(p.in[I_WUP] + eoff, 1024, 1024, nullptr, (bf16*)(wx + WX_GU) + (size_t)e * 2048 * 1024, 1024, kt * 64, nt * 256, smem, rm); }
  else conv_tile(p.in[I_WDOWN] + eoff, 1024, 1024, nullptr, (bf16*)(wx + WX_DN) + (size_t)e * 1024 * 1024, 1024, kt * 64, nt * 256, smem, RowId());
}

DI void mod_item(const Params& p, int it, char* smem) {
  const int l = it / 96, cg0 = (it % 96) * 64;
  float* sc = (float*)smem;
  float* red = sc + NB1 * 1024;
  const int tid = tid_();
  __syncthreads();
  for (int i = tid; i < NB1 * 1024; i += NTHREADS) {
    int r = i >> 10, k = i & 1023;
    float c = (r < BATCH) ? p.in[I_C][r * 1024 + k] : p.in[I_CCTX][k];
    sc[i] = siluf_(c);
  }
  __syncthreads();
  const int cl = tid & 63, kg = tid >> 6;
  float acc[NB1];
#pragma unroll
  for (int r = 0; r < NB1; ++r) acc[r] = 0.f;
  const float* w = p.in[I_WADA] + (size_t)l * 1024 * 6144 + cg0 + cl;
  for (int k0 = kg * (1024 / NWAVES); k0 < (kg + 1) * (1024 / NWAVES); k0 += 16) {
    float wv[16];
#pragma unroll
    for (int u = 0; u < 16; ++u) wv[u] = w[(size_t)(k0 + u) * 6144];
#pragma unroll
    for (int u = 0; u < 16; ++u)
#pragma unroll
      for (int r = 0; r < NB1; ++r) acc[r] += sc[r * 1024 + k0 + u] * wv[u];
  }
#pragma unroll
  for (int r = 0; r < NB1; ++r) red[(kg * NB1 + r) * 64 + cl] = acc[r];
  __syncthreads();
  for (int i = tid; i < NB1 * 64; i += NTHREADS) {
    int r = i >> 6, c = i & 63;
    float s = 0.f;
#pragma unroll
    for (int q = 0; q < NWAVES; ++q) s += red[(q * NB1 + r) * 64 + c];
    s += p.in[I_BADA][l * 6144 + cg0 + c];
    ((float*)(p.ws + OFF_MOD))[((size_t)l * NB1 + r) * 6144 + cg0 + c] = s;
  }
}

DI void s5_tab_item(const Params& p, int it, char* smem) {
  const int l = it / 32, d = (it / 16) & 1, g = it & 15;
  char* s5 = p.ws + OFF_S5TAB + (size_t)l * S5_SIZE;
  float* lampow = (float*)(s5 + S5_LAMPOW) + (size_t)(d * 16 + g) * 17 * 64 * 2;
  float* bbar = (float*)(s5 + S5_BBAR) + (size_t)(d * 16 + g) * 64 * 16 * 2;
  float* kt = (float*)(s5 + S5_KT) + (size_t)(d * 16 + g) * 16 * 256;
  float* slam = (float*)smem;
  float* sbb = slam + 17 * 64 * 2;
  const int tid = tid_();
  const size_t pg = ((size_t)(l * 2 + d) * 16 + g);
  const float step = expf(p.in[I_S5LOGSTEP][pg]);
  __syncthreads();
  for (int i = tid; i < 17 * 64; i += NTHREADS) {
    int j = i >> 6, pp = i & 63;
    float are = p.in[I_S5ARE][pg * 64 + pp], aim = p.in[I_S5AIM][pg * 64 + pp];
    float mag = expf((float)j * step * are), ang = (float)j * step * aim;
    float re = mag * cosf(ang), im = mag * sinf(ang);
    slam[i * 2] = re; slam[i * 2 + 1] = im; lampow[i * 2] = re; lampow[i * 2 + 1] = im;
  }
  __syncthreads();
  for (int i = tid; i < 64 * 16; i += NTHREADS) {
    int pp = i >> 4;
    float are = p.in[I_S5ARE][pg * 64 + pp], aim = p.in[I_S5AIM][pg * 64 + pp];
    float x = slam[(64 + pp) * 2] - 1.0f, y = slam[(64 + pp) * 2 + 1];
    float den = are * are + aim * aim;
    float qre = (x * are + y * aim) / den, qim = (y * are - x * aim) / den;
    float bre = p.in[I_S5BRE][pg * 1024 + i], bim = p.in[I_S5BIM][pg * 1024 + i];
    float re = qre * bre - qim * bim, im = qre * bim + qim * bre;
    sbb[i * 2] = re; sbb[i * 2 + 1] = im; bbar[i * 2] = re; bbar[i * 2 + 1] = im;
  }
  __syncthreads();
  for (int i = tid; i < 16 * 256; i += NTHREADS) {
    int j = i >> 8, c = (i >> 4) & 15, c2 = i & 15;
    float s = 0.f;
    for (int pp = 0; pp < 64; ++pp) {
      float cre = p.in[I_S5CRE][pg * 1024 + c * 64 + pp], cim = p.in[I_S5CIM][pg * 1024 + c * 64 + pp];
      float lre = slam[(j * 64 + pp) * 2], lim = slam[(j * 64 + pp) * 2 + 1];
      float tre = cre * lre - cim * lim, tim = cre * lim + cim * lre;
      float bre = sbb[(pp * 16 + c2) * 2], bim = sbb[(pp * 16 + c2) * 2 + 1];
      s += tre * bre - tim * bim;
    }
    kt[i] = s;
  }
}
DI void s5_mat_item(const Params& p, int it) {
  const int l = it / 256, g = (it / 16) & 15, q = it & 15;
  char* s5 = p.ws + OFF_S5TAB + (size_t)l * S5_SIZE;
  const float* lampow = (const float*)(s5 + S5_LAMPOW);
  const float* bbar = (const float*)(s5 + S5_BBAR);
  const float* ktab = (const float*)(s5 + S5_KT);
  bf16* WA = (bf16*)(s5 + S5_WA) + (size_t)g * 256 * 256;
  bf16* W2 = (bf16*)(s5 + S5_W2) + (size_t)g * 256 * 512;
  const int tid = tid_();
  for (int i = tid; i < 16 * 256; i += NTHREADS) {
    int n = q * 16 + (i >> 8), k = i & 255;
    int d = n >> 7, ri = (n >> 6) & 1, pp = n & 63, s = k >> 4, c2 = k & 15;
    int e = (d == 0) ? (15 - s) : s;
    const float* lp = lampow + ((size_t)((d * 16 + g) * 17 + e) * 64 + pp) * 2;
    const float* bp = bbar + ((size_t)((d * 16 + g) * 64 + pp) * 16 + c2) * 2;
    float re = lp[0] * bp[0] - lp[1] * bp[1], im = lp[0] * bp[1] + lp[1] * bp[0];
    WA[(size_t)n * 256 + k] = f2bf(ri == 0 ? re : im);
  }
  for (int i = tid; i < 16 * 512; i += NTHREADS) {
    int n = q * 16 + (i >> 9), k = i & 511;
    int lq = n >> 4, c = n & 15;
    float v;
    if (k < 256) {
      int s = k >> 4, c2 = k & 15;
      v = 0.f;
      if (s <= lq) v += ktab[((size_t)(0 * 16 + g) * 16 + (lq - s)) * 256 + c * 16 + c2];
      if (s >= lq) v += ktab[((size_t)(1 * 16 + g) * 16 + (s - lq)) * 256 + c * 16 + c2];
      if (s == lq && c == c2) v += p.in[I_S5D][l * 256 + g * 16 + c];
    } else {
      int kk = k - 256, d = kk >> 7, ri = (kk >> 6) & 1, pp = kk & 63;
      int e = (d == 0) ? (lq + 1) : (16 - lq);
      size_t pg = ((size_t)(l * 2 + d) * 16 + g);
      float cre = p.in[I_S5CRE][pg * 1024 + c * 64 + pp], cim = p.in[I_S5CIM][pg * 1024 + c * 64 + pp];
      const float* lp = lampow + ((size_t)((d * 16 + g) * 17 + e) * 64 + pp) * 2;
      float re = cre * lp[0] - cim * lp[1], im = cre * lp[1] + cim * lp[0];
      v = (ri == 0) ? re : -im;
    }
    W2[(size_t)n * 512 + k] = f2bf(v);
  }
}

DI int tok_b(int tok) { return tok / TOK; }
DI int tok_j(int tok) { return tok % TOK; }
DI int tok_modrow(int tok) { return (tok_j(tok) < CTXL) ? BATCH : tok_b(tok); }

DI void normmod_row(const float (&xv)[16], const float* g, const float* shift, const float* scale, bf16* dst, float (&hout)[16]) {
  const int lane = tid_() & 63;
  float ss = 0.f;
#pragma unroll
  for (int i = 0; i < 16; ++i) ss += xv[i] * xv[i];
  ss = wave_sum(ss);
  const float rs = rsqrtf(ss * (1.0f / 1024.f) + EPS);
#pragma unroll
  for (int i = 0; i < 4; ++i) {
    int c = lane * 4 + i * 256;
    float4 gv = *(const float4*)(g + c), sh = *(const float4*)(shift + c), sc = *(const float4*)(scale + c);
    float h0 = xv[i * 4 + 0] * rs * gv.x * (1.f + sc.x) + sh.x;
    float h1 = xv[i * 4 + 1] * rs * gv.y * (1.f + sc.y) + sh.y;
    float h2 = xv[i * 4 + 2] * rs * gv.z * (1.f + sc.z) + sh.z;
    float h3 = xv[i * 4 + 3] * rs * gv.w * (1.f + sc.w) + sh.w;
    hout[i * 4 + 0] = h0; hout[i * 4 + 1] = h1; hout[i * 4 + 2] = h2; hout[i * 4 + 3] = h3;
    *(uint2*)(dst + c) = make_uint2(pack2(h0, h1), pack2(h2, h3));
  }
}

DI void prep_row_item(const Params& p, int it) {
  const int tok = it * NWAVES + (tid_() >> 6), lane = tid_() & 63;
  const int b = tok_b(tok), j = tok_j(tok);
  const float* src = (j < CTXL) ? p.in[I_CTX] + ((size_t)b * CTXL + j) * 1024 : p.in[I_X] + ((size_t)b * SEQ + (j - CTXL)) * 1024;
  float xv[16], h[16];
#pragma unroll
  for (int i = 0; i < 4; ++i) {
    float4 v = *(const float4*)(src + lane * 4 + i * 256);
    xv[i * 4] = v.x; xv[i * 4 + 1] = v.y; xv[i * 4 + 2] = v.z; xv[i * 4 + 3] = v.w;
  }
  const float* mod = (const float*)(p.ws + OFF_MOD) + (size_t)tok_modrow(tok) * 6144;
  normmod_row(xv, p.in[I_GPREMIX], mod + 0, mod + 1024, (bf16*)(p.ws + OFF_HA) + (size_t)tok * 1024, h);
}

constexpr int IP_LT = BATCH * (SEQ / 256), IP_CT = BATCH * ((CTXL + 255) / 256), IP_MT = IP_LT + IP_CT, IP_NT = N_INP / 256;
constexpr int IP_RR = (IP_MT + 7) / 8, IP_RC = (IP_NT + 1) / 2;
constexpr int IP_RC_NOGATE = (((C_GATE + 255) / 256) + 1) / 2;
constexpr int IP_RR_LAT = IP_LT / 8;
constexpr bool IP_COMPACT = (IP_LT % 8 == 0);
constexpr int IP_RECTS_ALL = IP_RR * IP_RC, IP_RECTS_LAST = IP_COMPACT ? (IP_RR * IP_RC_NOGATE + IP_RR_LAT * (IP_RC - IP_RC_NOGATE)) : IP_RECTS_ALL;
constexpr int IP_SLOTS_ALL = ((IP_RECTS_ALL + 15) / 16) * 256, IP_SLOTS_LAST = ((IP_RECTS_LAST + 15) / 16) * 256;
DI void inproj_tile(const Params& p, const LP& L, int t, char* smem) {
  const int vb = t % 256, vround = t / 256, x = vb % 8, j = vb / 8;
  const int Rc = vround * 16 + x * 2 + (j >> 4), jj = j & 15;
  int rm, rn;
  if (!L.last || !IP_COMPACT || Rc < IP_RR * IP_RC_NOGATE) { rm = Rc % IP_RR; rn = Rc / IP_RR; }
  else { const int q = Rc - IP_RR * IP_RC_NOGATE; rm = q % IP_RR_LAT; rn = IP_RC_NOGATE + q / IP_RR_LAT; }
  const int mt = rm * 8 + (jj & 7), nt = rn * 2 + (jj >> 3);
  if (mt >= IP_MT || nt >= IP_NT || rn >= IP_RC) return;
  int m0;
  if (mt < IP_LT) m0 = (mt / (SEQ / 256)) * TOK + CTXL + (mt % (SEQ / 256)) * 256;
  else { const int c = mt - IP_LT; m0 = (c / ((CTXL + 255) / 256)) * TOK + (c % ((CTXL + 255) / 256)) * 256; }
  const int n0 = nt * 256;
  const int mv = (mt < IP_LT) ? NTOK : (m0 - (m0 % TOK) + CTXL);
  if (L.last && mt >= IP_LT && n0 >= ((C_GATE + 255) / 256) * 256) return;
  GA g = make_ga((const bf16*)(p.ws + OFF_HA), 1024, (const bf16*)(L.we + WE_WIN), 1024, 1024, mv);
  f32x4 acc[2][2][4][2];
  gemm_big(g, m0, n0, smem, acc);
  bf16* P1 = (bf16*)(p.ws + OFF_P1);
  bf16* PG = (bf16*)(p.ws + OFF_PG);
  bf16* US5 = (bf16*)(p.ws + OFF_MIX + MX_US5);
  float* DT = (float*)(p.ws + OFF_DT);
  const float* dtb = p.in[I_M2DTBIAS] + L.l * 8;
  EPIB_BEGIN(acc, m0, n0, mv)
    if (col < C_S5 || (col >= C_Z && col < C_DT)) st8bf(P1 + (size_t)row * P1W + col, v);
    else if (col < C_Z) st8bf(US5 + ((size_t)((col - C_S5) >> 4) * NTOK + row) * 16 + (col & 15), v);
    else if (col < C_GATE) {
#pragma unroll
      for (int k = 0; k < 8; ++k) v[k] = softplusf_(v[k] + dtb[k]);
      st8f(DT + (size_t)row * 8, v);
    } else if (col < N_IN) {
#pragma unroll
      for (int k = 0; k < 8; ++k) v[k] = sigmoidf_(v[k]);
      st8bf(PG + (size_t)row * 4096 + (col - C_GATE), v);
    }
  EPIB_END
}

DI void rowscale_256(const bf16* P1, int m0, int c0, int width, float* srs) {
  const int r = tid_() >> 1, hf = tid_() & 1;
  int gr = m0 + r; if (gr > NTOK - 1) gr = NTOK - 1;
  const bf16* src = P1 + (size_t)gr * P1W + c0 + hf * (width / 2);
  float ss = 0.f;
  for (int i = 0; i < width / 2; i += 8) {
    float v[8]; ld8bf(src + i, v);
#pragma unroll
    for (int k = 0; k < 8; ++k) ss += v[k] * v[k];
  }
  ss += shfl_xor_(ss, 1);
  if (hf == 0) srs[r] = rsqrtf(ss / (float)width + EPS);
}
DI void rope_tab_item(const Params& p) {
  float* tab = (float*)(p.ws + OFF_ROPE);
  for (int i = tid_(); i < 64 * 8; i += NTHREADS) {
    int pos = i >> 3, k = i & 7;
    float f = expf(-(float)k * (9.210340371976184f / 8.0f));
    float a = (float)pos * f;
    tab[i * 2] = cosf(a); tab[i * 2 + 1] = sinf(a);
  }
}
DI void rope_cs(const float* tab, int pos, int i, float& c, float& s) { c = tab[(pos * 8 + i) * 2]; s = tab[(pos * 8 + i) * 2 + 1]; }

constexpr int TP_MT = (NTOK + 255) / 256;
DI void mlaq_tile(const Params& p, const LP& L, int t, char* smem) {
  const int mt = t % TP_MT, nt = t / TP_MT, m0 = mt * 256, n0 = nt * 128;
  const bf16* P1 = (const bf16*)(p.ws + OFF_P1);
  float* srs = (float*)(smem + SRS_OFF);
  GA g = make_ga(P1 + C_CQ, P1W, (const bf16*)(L.we + WE_UQ), 256, 256, NTOK);
  f32x4 acc[4][4];
  gemm_s<4>(g, m0, n0, smem, acc);
  rowscale_256(P1, m0, C_CQ, 256, srs);
  __syncthreads();
  bf16* Q = (bf16*)(p.ws + OFF_MIX + MX_Q);
  const float* ropetab = (const float*)(p.ws + OFF_ROPE);
  {
    const int l = tid_() & 63, w = tid_() >> 6, wr = w >> 1, wc = w & 1, fr = l & 15, fq = l >> 4;
#pragma unroll
    for (int m = 0; m < 4; ++m) {
      const int row = m0 + wr * 64 + m * 16 + fr;
      const int rowc = row < NTOK ? row : NTOK - 1;
      const float rsc = srs[rowc - m0];
      const int b = tok_b(rowc), j = tok_j(rowc);
#pragma unroll
      for (int q = 0; q < 2; ++q) {
        const int col = n0 + wc * 64 + q * 32 + 8 * fq;
        const int h = col / 96, dd = col % 96;
        float v[8] = {acc[m][2 * q][0], acc[m][2 * q][1], acc[m][2 * q][2], acc[m][2 * q][3], acc[m][2 * q + 1][0], acc[m][2 * q + 1][1], acc[m][2 * q + 1][2], acc[m][2 * q + 1][3]};
        float vp[8];
#pragma unroll
        for (int k = 0; k < 8; ++k) vp[k] = shfl_xor_(v[k], 16);
        if (dd >= 64 && j >= CTXL) {
          const int tl = j - CTXL, pos = ((dd - 64) < 16) ? (tl / GRID_W) : (tl % GRID_W);
          const bool lo = ((dd & 8) == 0);
#pragma unroll
          for (int k = 0; k < 8; ++k) {
            float c, sn; rope_cs(ropetab, pos, k, c, sn);
            v[k] = lo ? (v[k] * c - vp[k] * sn) : (v[k] * c + vp[k] * sn);
          }
        }
#pragma unroll
        for (int k = 0; k < 8; ++k) v[k] *= rsc;
        if (row < NTOK) st8bf(Q + (((size_t)b * 4 + h) * TOK + j) * 96 + dd, v);
      }
    }
  }
}
DI void mlakv_tile(const Params& p, const LP& L, int t, char* smem) {
  const int mt = t % TP_MT, h = t / TP_MT, m0 = mt * 256, n0 = h * 128;
  const bf16* P1 = (const bf16*)(p.ws + OFF_P1);
  float* srs = (float*)(smem + SRS_OFF);
  GA g = make_ga(P1 + C_CKV, P1W, (const bf16*)(L.we + WE_UKV), 128, 128, NTOK);
  f32x4 acc[4][4];
  gemm_s<4>(g, m0, n0, smem, acc);
  rowscale_256(P1, m0, C_CKV, 128, srs);
  __syncthreads();
  bf16* K = (bf16*)(p.ws + OFF_MIX + MX_K);
  bf16* VT = (bf16*)(p.ws + OFF_MIX + MX_VTM);
  const float* ropetab = (const float*)(p.ws + OFF_ROPE);
  EPI_BEGIN(4, acc, m0, n0, NTOK)
    const float rsc = srs[row - m0];
    const int b = tok_b(row), j = tok_j(row), dd = col - n0;
#pragma unroll
    for (int k = 0; k < 8; ++k) v[k] *= rsc;
    if (dd < 64) st8bf(K + (((size_t)b * 4 + h) * TOK + j) * 96 + dd, v);
    else {
#pragma unroll
      for (int k = 0; k < 8; ++k) VT[(((size_t)b * 4 + h) * 64 + (dd - 64 + k)) * TOK + j] = f2bf(v[k]);
    }
  EPI_END
  for (int i = tid_(); i < 256 * 16; i += NTHREADS) {
    int r = i >> 4, q = i & 15;
    int row = m0 + r;
    if (row < NTOK) {
      int b = tok_b(row), j = tok_j(row);
      int blk = q >> 3, i8 = q & 7;
      float x1 = bf2f(P1[(size_t)row * P1W + C_KR + blk * 16 + i8]), x2 = bf2f(P1[(size_t)row * P1W + C_KR + blk * 16 + i8 + 8]);
      float o1 = x1, o2 = x2;
      if (j >= CTXL) {
        int tl = j - CTXL, pos = blk == 0 ? (tl / GRID_W) : (tl % GRID_W);
        float c, sn; rope_cs(ropetab, pos, i8, c, sn);
        o1 = x1 * c - x2 * sn; o2 = x2 * c + x1 * sn;
      }
      bf16* kd = K + (((size_t)b * 4 + h) * TOK + j) * 96 + 64 + blk * 16 + i8;
      kd[0] = f2bf(o1); kd[8] = f2bf(o2);
    }
  }
}
DI void navt_item(const Params& p, int it, char* smem) {
  bf16* s = (bf16*)smem;
  const bf16* P1 = (const bf16*)(p.ws + OFF_P1);
  bf16* VT = (bf16*)(p.ws + OFF_MIX + MX_VTN);
  const int tok0 = it * 64, tid = tid_();
  const int b = tok_b(tok0), j0 = tok_j(tok0);
  __syncthreads();
  for (int i = tid; i < 64 * 32; i += NTHREADS) {
    int r = i >> 5, c8 = i & 31;
    *(uint4*)(s + r * 264 + c8 * 8) = *(const uint4*)(P1 + (size_t)(tok0 + r) * P1W + C_NA + 512 + c8 * 8);
  }
  __syncthreads();
  for (int i = tid; i < 256 * 8; i += NTHREADS) {
    int ch = i >> 3, t8 = i & 7;
    unsigned w[4];
#pragma unroll
    for (int q = 0; q < 4; ++q) w[q] = (unsigned)s[(t8 * 8 + 2 * q) * 264 + ch] | ((unsigned)s[(t8 * 8 + 2 * q + 1) * 264 + ch] << 16);
    *(uint4*)(VT + ((size_t)b * 256 + ch) * TOK + j0 + t8 * 8) = make_uint4(w[0], w[1], w[2], w[3]);
  }
}
constexpr int M2C_TOK = 128, M2C_ITEMS = NTOK / M2C_TOK;
DI void m2conv_item(const Params& p, const LP& L, int it) {
  const bf16* P1 = (const bf16*)(p.ws + OFF_P1);
  bf16* XB = (bf16*)(p.ws + OFF_MIX + MX_XBC);
  const int tok0 = it * M2C_TOK;
  const float* cw = p.in[I_M2CONVW] + (size_t)L.l * 4 * 768;
  const float* cb = p.in[I_M2CONVB] + (size_t)L.l * 768;
  for (int task = tid_(); task < 96 * (M2C_TOK / 8); task += NTHREADS) {
    const int cg = task % 96, tb = task / 96, c0 = cg * 8;
    const int tokb = tok0 + tb * 8, jt = tok_j(tokb), base = tokb - jt;
    const int slo = (jt < CTXL) ? 0 : CTXL, shi = (jt < CTXL) ? CTXL : TOK;
    float w[4][8], bias[8];
#pragma unroll
    for (int k = 0; k < 4; ++k) { float4 a = *(const float4*)(cw + k * 768 + c0), b4 = *(const float4*)(cw + k * 768 + c0 + 4);
      w[k][0] = a.x; w[k][1] = a.y; w[k][2] = a.z; w[k][3] = a.w; w[k][4] = b4.x; w[k][5] = b4.y; w[k][6] = b4.z; w[k][7] = b4.w; }
    { float4 a = *(const float4*)(cb + c0), b4 = *(const float4*)(cb + c0 + 4);
      bias[0] = a.x; bias[1] = a.y; bias[2] = a.z; bias[3] = a.w; bias[4] = b4.x; bias[5] = b4.y; bias[6] = b4.z; bias[7] = b4.w; }
    float xin[11][8];
#pragma unroll
    for (int r = 0; r < 11; ++r) {
      const int j = jt - 2 + r;
      if (j >= slo && j < shi) ld8bf(P1 + (size_t)(base + j) * P1W + C_XBC + c0, xin[r]);
      else {
#pragma unroll
        for (int c = 0; c < 8; ++c) xin[r][c] = 0.f;
      }
    }
    float y[8][8];
#pragma unroll
    for (int t = 0; t < 8; ++t) {
#pragma unroll
      for (int c = 0; c < 8; ++c) y[t][c] = siluf_(bias[c] + w[0][c] * xin[t][c] + w[1][c] * xin[t + 1][c] + w[2][c] * xin[t + 2][c] + w[3][c] * xin[t + 3][c]);
      st8bf(XB + (size_t)(base + jt + t) * 768 + c0, y[t]);
    }
    if (c0 < 512) {
      bf16* XT = (bf16*)(p.ws + OFF_MIX + MX_XBT) + ((size_t)(base / TOK) * 512 + c0) * TOK + jt;
#pragma unroll
      for (int c = 0; c < 8; ++c) {
        float col[8];
#pragma unroll
        for (int t = 0; t < 8; ++t) col[t] = y[t][c];
        st8bf(XT + (size_t)c * TOK, col);
      }
    }
  }
}
DI int m2_seq2tok(int sq, int dir) { return (dir == 0) ? sq : (sq < CTXL ? (CTXL - 1 - sq) : (TOK - 1 - (sq - CTXL))); }
constexpr int M2S_ITEMS = BATCH * 8 * (TOK / 64) / NWAVES;
DI void m2scal_item(const Params& p, const LP& L, int it) {
  const int w = it * NWAVES + (tid_() >> 6), lane = tid_() & 63;
  const int ch = w % (TOK / 64), r = w / (TOK / 64), hd = r & 3, dir = (r >> 2) & 1, b = r >> 3;
  const float a = -expf(p.in[I_M2ALOG][(L.l * 2 + dir) * 4 + hd]);
  const int sq = ch * 64 + lane, j = m2_seq2tok(sq, dir);
  const float dt = ((const float*)(p.ws + OFF_DT))[((size_t)b * TOK + j) * 8 + dir * 4 + hd];
  float cs = dt * a;
#pragma unroll
  for (int d = 1; d < 64; d <<= 1) { float o = shfl_up_(cs, d); if (lane >= d) cs += o; }
  const float sl = shfl_(cs, 63);
  float* o = (float*)(p.ws + OFF_MIX + MX_M2S) + ((size_t)((b * 2 + dir) * 4 + hd) * TOK + sq) * 4;
  *(float4*)o = make_float4(cs, dt, dt * __expf(sl - cs), cs * 1.4426950408889634f - log2f(dt));
}
constexpr int S5_MT = (MCH + 255) / 256;
DI void s5a_tile(const Params& p, const LP& L, int t, char* smem) {
  const int g = t / (S5_MT * 2), r = t % (S5_MT * 2), mt = r / 2, nt = r % 2;
  const int m0 = mt * 256, n0 = nt * 128;
  GA ga = make_ga((const bf16*)(p.ws + OFF_MIX + MX_US5) + (size_t)g * NTOK * 16, 256, (const bf16*)(L.s5 + S5_WA) + (size_t)g * 65536, 256, 256, MCH);
  f32x4 acc[4][4];
  gemm_s<4>(ga, m0, n0, smem, acc);
  float* HE = (float*)(p.ws + OFF_MIX + MX_HEND) + (size_t)g * MCH * 256;
  EPI_BEGIN(4, acc, m0, n0, MCH)
    st8f(HE + (size_t)row * 256 + col, v);
  EPI_END
}
DI int s5_chunk_of(int i, int d) { return (d == 0) ? i : (i < NCC ? (NCC - 1 - i) : (NCH - 1 - (i - NCC))); }
DI void s5carry_item(const Params& p, const LP& L, int it) {
  const int w = it * NWAVES + (tid_() >> 6), lane = tid_() & 63;
  const int d = w / (16 * BATCH), g = (w / BATCH) & 15, b = w % BATCH;
  const float* lp = (const float*)(L.s5 + S5_LAMPOW) + ((size_t)((d * 16 + g) * 17 + 16) * 64 + lane) * 2;
  const float lre = lp[0], lim = lp[1];
  const float* HE = (const float*)(p.ws + OFF_MIX + MX_HEND) + ((size_t)g * MCH + (size_t)b * NCH) * 256 + d * 128;
  bf16* HI = (bf16*)(p.ws + OFF_MIX + MX_HIN) + ((size_t)g * MCH + (size_t)b * NCH) * 256 + d * 128;
  float cre = 0.f, cim = 0.f;
  constexpr int SB = 16;
  float are[SB], aim[SB], bre[SB], bim[SB];
#define S5_LOAD(RE_, IM_, I0_) { _Pragma("unroll") for (int k_ = 0; k_ < SB; ++k_) { const int ii_ = (I0_) + k_; \
    if (ii_ < NCH) { const int ch_ = s5_chunk_of(ii_, d); RE_[k_] = HE[(size_t)ch_ * 256 + lane]; IM_[k_] = HE[(size_t)ch_ * 256 + 64 + lane]; } } }
#define S5_STEP(RE_, IM_, I0_) { _Pragma("unroll") for (int k_ = 0; k_ < SB; ++k_) { const int ii_ = (I0_) + k_; \
    if (ii_ < NCH) { const int ch_ = s5_chunk_of(ii_, d); \
      HI[(size_t)ch_ * 256 + lane] = f2bf(cre); HI[(size_t)ch_ * 256 + 64 + lane] = f2bf(cim); \
      const float nre_ = lre * cre - lim * cim + RE_[k_], nim_ = lre * cim + lim * cre + IM_[k_]; \
      cre = nre_; cim = nim_; } } }
#pragma unroll
  for (int k = 0; k < SB; ++k) { are[k] = 0.f; aim[k] = 0.f; bre[k] = 0.f; bim[k] = 0.f; }
  S5_LOAD(are, aim, 0)
  for (int i0 = 0; i0 < NCH; i0 += 2 * SB) {
    S5_LOAD(bre, bim, i0 + SB)
    S5_STEP(are, aim, i0)
    S5_LOAD(are, aim, i0 + 2 * SB)
    S5_STEP(bre, bim, i0 + SB)
  }
#undef S5_LOAD
#undef S5_STEP
}
DI void s5c_tile(const Params& p, const LP& L, int t, char* smem) {
  const int g = t / (S5_MT * 2), r = t % (S5_MT * 2), mt = r / 2, nt = r % 2;
  const int m0 = mt * 256, n0 = nt * 128;
  GA ga = make_ga((const bf16*)(p.ws + OFF_MIX + MX_US5) + (size_t)g * NTOK * 16, 256, (const bf16*)(L.s5 + S5_W2) + (size_t)g * 256 * 512, 512, 512, MCH);
  ga.A2 = (const bf16*)(p.ws + OFF_MIX + MX_HIN) + (size_t)g * MCH * 256; ga.lda2 = 256; ga.ksplit = 256;
  f32x4 acc[4][4];
  gemm_s<4>(ga, m0, n0, smem, acc);
  bf16* Z = (bf16*)(p.ws + OFF_MIX + MX_Z);
  EPI_BEGIN(4, acc, m0, n0, MCH)
#pragma unroll
    for (int k = 0; k < 8; ++k) v[k] = geluf_(v[k]);
    st8bf(Z + ((size_t)row * 16 + (col >> 4)) * 256 + g * 16 + (col & 15), v);
  EPI_END
}

#ifdef EMU
DI float fmax_(float a, float b) { return a > b ? a : b; }
#else
DI float fmax_(float a, float b) { return __builtin_fmaxf(a, b); }
#endif
constexpr int AT_LDV = 76;
struct NaInfo { int r, qc, rs, cs; };
template <int DK, bool NA>
DI void attn_block(const bf16* qrow, bool active, const bf16* Kp, int kstride, const bf16* Vt,
                   int ka0, int ntile_a, int arow0, int kb0, int ntile_b,
                   const float* srpb, NaInfo ni, float scale, bf16* orow, char* smem) {
  constexpr int LDK = DK + 8, KCH = DK / 8;
  constexpr int KT_BYTES = 64 * LDK * 2, VT_BYTES = 64 * AT_LDV * 2;
  constexpr int NKL = (64 * KCH + NTHREADS - 1) / NTHREADS;
  const int tid = tid_(), lane = tid & 63, half = lane >> 5, r = lane & 31;
  bf16* sK = (bf16*)smem;
  bf16* sV = (bf16*)(smem + 2 * KT_BYTES);
  bf16x8 qf[DK / 16];
  f32x16 o0, o1;
  float m = -1e30f, l = 0.f;
  const float scale2 = scale * 1.4426950408889634f;
#pragma unroll
  for (int ks = 0; ks < DK / 16; ++ks) qf[ks] = active ? *(const bf16x8*)(qrow + ks * 16 + 8 * half) : bf16x8{0, 0, 0, 0, 0, 0, 0, 0};
#pragma unroll
  for (int i = 0; i < 16; ++i) { o0[i] = 0.f; o1[i] = 0.f; }
  const int NTL = ntile_a + ntile_b;
  u32x4 rk[NKL], rv[1];
#pragma unroll
  for (int i = 0; i < NKL; ++i) rk[i] = u32x4{0u, 0u, 0u, 0u};
  auto key0_of = [&](int t) { return t < ntile_a ? ka0 + 64 * t : kb0 + 64 * (t - ntile_a); };
#define AT_GLOAD(t_) { const int k0_ = key0_of(t_); \
    _Pragma("unroll") for (int i_ = 0; i_ < NKL; ++i_) { const int c_ = tid + i_ * NTHREADS; const int key_ = c_ / KCH, ch_ = c_ % KCH; \
      if (c_ < 64 * KCH) rk[i_] = *(const u32x4*)(Kp + (size_t)(k0_ + key_) * kstride + ch_ * 8); } \
    { const int d_ = tid >> 3, ch_ = tid & 7; rv[0] = *(const u32x4*)(Vt + (size_t)d_ * TOK + k0_ + ch_ * 8); } }
#define AT_SSTORE(buf_) { \
    _Pragma("unroll") for (int i_ = 0; i_ < NKL; ++i_) { const int c_ = tid + i_ * NTHREADS; const int key_ = c_ / KCH, ch_ = c_ % KCH; \
      if (c_ < 64 * KCH) *(u32x4*)(sK + (buf_) * (64 * LDK) + key_ * LDK + ch_ * 8) = rk[i_]; } \
    { const int d_ = tid >> 3, ch_ = tid & 7; \
      bf16* dst_ = sV + (buf_) * (64 * AT_LDV) + d_ * AT_LDV + ch_ * 8; \
      *(uint2*)dst_ = make_uint2(rv[0][0], rv[0][1]); *(uint2*)(dst_ + 4) = make_uint2(rv[0][2], rv[0][3]); } }
  __syncthreads();
  AT_GLOAD(0) AT_SSTORE(0)
  __syncthreads();
#pragma unroll 1
  for (int t = 0; t < NTL; ++t) {
    const int buf = t & 1;
    if (t + 1 < NTL) AT_GLOAD(t + 1)
    bool doit = active;
    int trow0 = 0;
    if (NA && t < ntile_a) {
      trow0 = arow0 + t * (64 / GRID_W);
      doit = active && (trow0 + (64 / GRID_W) > ni.rs) && (trow0 < ni.rs + WIN_R);
    }
    if (doit) {
      const bf16* kb = sK + buf * (64 * LDK);
      const bf16* vb = sV + buf * (64 * AT_LDV);
      f32x16 s0, s1;
#pragma unroll
      for (int i = 0; i < 16; ++i) { s0[i] = 0.f; s1[i] = 0.f; }
      bf16x8 ka0[DK / 16], ka1[DK / 16];
#pragma unroll
      for (int ks = 0; ks < DK / 16; ++ks) {
        ka0[ks] = *(const bf16x8*)(kb + r * LDK + ks * 16 + 8 * half);
        ka1[ks] = *(const bf16x8*)(kb + (32 + r) * LDK + ks * 16 + 8 * half);
      }
      BG_SCHED;
#pragma unroll
      for (int ks = 0; ks < DK / 16; ++ks) {
        s0 = __builtin_amdgcn_mfma_f32_32x32x16_bf16(ka0[ks], qf[ks], s0, 0, 0, 0);
        s1 = __builtin_amdgcn_mfma_f32_32x32x16_bf16(ka1[ks], qf[ks], s1, 0, 0, 0);
      }
      uint2 va0[4], va1[4], vb0[4], vb1[4];
#pragma unroll
      for (int kq = 0; kq < 4; ++kq) {
        const bf16* v0 = vb + r * AT_LDV + 16 * kq + 4 * half;
        const bf16* v1 = vb + (r + 32) * AT_LDV + 16 * kq + 4 * half;
        va0[kq] = *(const uint2*)v0; va1[kq] = *(const uint2*)(v0 + 8); vb0[kq] = *(const uint2*)v1; vb1[kq] = *(const uint2*)(v1 + 8);
      }
      BG_SCHED;
      float mx = -INFINITY;
      if (NA && t < ntile_a) {
#pragma unroll
        for (int i = 0; i < 16; ++i) {
          const int kk = (i & 3) + 8 * (i >> 2) + 4 * half;
#pragma unroll
          for (int hb = 0; hb < 2; ++hb) {
            const int kq = kk + 32 * hb;
            const int kr = trow0 + kq / GRID_W, kc = kq % GRID_W;
            const bool ok = (kr >= ni.rs) && (kr < ni.rs + WIN_R) && (kc >= ni.cs) && (kc < ni.cs + WIN_C);
            const float bias = ok ? srpb[(kr - ni.r + 7) * 31 + (kc - ni.qc + 15)] * 1.4426950408889634f : -INFINITY;
            if (hb == 0) { s0[i] = s0[i] * scale2 + bias; mx = fmax_(mx, s0[i]); }
            else { s1[i] = s1[i] * scale2 + bias; mx = fmax_(mx, s1[i]); }
          }
        }
      } else {
        s0 = s0 * scale2; s1 = s1 * scale2;
#pragma unroll
        for (int i = 0; i < 16; ++i) mx = fmax_(mx, fmax_(s0[i], s1[i]));
      }
      mx = fmax_(mx, shfl_xor_(mx, 32));
      const float mn = fmax_(m, mx);
      const float alpha = exp2f_(m - mn);
      const bool same = (mn == m);
      m = mn;
      float ps = 0.f;
      { const float nmn = -mn; s0 = s0 + nmn; s1 = s1 + nmn; }
#pragma unroll
      for (int i = 0; i < 16; ++i) { s0[i] = exp2f_(s0[i]); s1[i] = exp2f_(s1[i]); }
      { const f32x16 st = s0 + s1;
        ps = ((st[0] + st[1]) + (st[2] + st[3])) + ((st[4] + st[5]) + (st[6] + st[7])) + (((st[8] + st[9]) + (st[10] + st[11])) + ((st[12] + st[13]) + (st[14] + st[15]))); }
      l = l * alpha + ps;
      if (!wave_all_(same)) {
#pragma unroll
        for (int i = 0; i < 16; ++i) { o0[i] *= alpha; o1[i] *= alpha; }
      }
#pragma unroll
      for (int kq = 0; kq < 4; ++kq) {
        u32x4 pw;
#pragma unroll
        for (int j = 0; j < 4; ++j) pw[j] = (kq < 2) ? pack2(s0[8 * (kq & 1) + 2 * j], s0[8 * (kq & 1) + 2 * j + 1]) : pack2(s1[8 * (kq & 1) + 2 * j], s1[8 * (kq & 1) + 2 * j + 1]);
        const bf16x8 pf = __builtin_bit_cast(bf16x8, pw);
        const uint2 a0 = va0[kq], a1 = va1[kq], b0 = vb0[kq], b1 = vb1[kq];
        bf16x8 va, vbb;
        va[0] = (short)(a0.x & 0xffff); va[1] = (short)(a0.x >> 16); va[2] = (short)(a0.y & 0xffff); va[3] = (short)(a0.y >> 16);
        va[4] = (short)(a1.x & 0xffff); va[5] = (short)(a1.x >> 16); va[6] = (short)(a1.y & 0xffff); va[7] = (short)(a1.y >> 16);
        vbb[0] = (short)(b0.x & 0xffff); vbb[1] = (short)(b0.x >> 16); vbb[2] = (short)(b0.y & 0xffff); vbb[3] = (short)(b0.y >> 16);
        vbb[4] = (short)(b1.x & 0xffff); vbb[5] = (short)(b1.x >> 16); vbb[6] = (short)(b1.y & 0xffff); vbb[7] = (short)(b1.y >> 16);
        o0 = __builtin_amdgcn_mfma_f32_32x32x16_bf16(va, pf, o0, 0, 0, 0);
        o1 = __builtin_amdgcn_mfma_f32_32x32x16_bf16(vbb, pf, o1, 0, 0, 0);
      }
    }
    if (t + 1 < NTL) AT_SSTORE(buf ^ 1)
    __syncthreads();
  }
  if (active) {
    const float lt = l + shfl_xor_(l, 32);
    const float inv = rcp_(lt);
#pragma unroll
    for (int gI = 0; gI < 4; ++gI) {
      const int d0 = 8 * gI + 4 * half;
      *(uint2*)(orow + d0) = make_uint2(pack2(o0[4 * gI] * inv, o0[4 * gI + 1] * inv), pack2(o0[4 * gI + 2] * inv, o0[4 * gI + 3] * inv));
      *(uint2*)(orow + 32 + d0) = make_uint2(pack2(o1[4 * gI] * inv, o1[4 * gI + 1] * inv), pack2(o1[4 * gI + 2] * inv, o1[4 * gI + 3] * inv));
    }
  }
}
DI void mla_attn_item(const Params& p, int it, bool ctxq, char* smem) {
  const int nqb = ctxq ? (CTXL + 255) / 256 : SEQ / 256;
  const int b = it / (4 * nqb), h = (it / nqb) & 3, qb = it % nqb;
  const int lane = tid_() & 63, wid = tid_() >> 6;
  const int nq = ctxq ? CTXL : SEQ, q0 = qb * 256 + wid * 32;
  const bool active = q0 < nq;
  const int jq = (ctxq ? 0 : CTXL) + (active ? q0 : 0) + (lane & 31);
  const bf16* Q = (const bf16*)(p.ws + OFF_MIX + MX_Q) + ((size_t)b * 4 + h) * TOK * 96;
  const bf16* K = (const bf16*)(p.ws + OFF_MIX + MX_K) + ((size_t)b * 4 + h) * TOK * 96;
  const bf16* VT = (const bf16*)(p.ws + OFF_MIX + MX_VTM) + ((size_t)b * 4 + h) * 64 * TOK;
  bf16* O = (bf16*)(p.ws + OFF_O) + ((size_t)b * TOK + jq) * 1024 + 0 * 256 + h * 64;
  NaInfo ni; ni.r = 0; ni.qc = 0; ni.rs = 0; ni.cs = 0;
  attn_block<96, false>(Q + (size_t)jq * 96, active, K, 96, VT, 0, 0, 0, 0, (ctxq ? CTXL : TOK) / 64, nullptr, ni, 0.10206207261596577f, O, smem);
}
DI void na_attn_item(const Params& p, const LP& L, int it, bool ctxq, char* smem) {
  const int nqb = ctxq ? (CTXL + 255) / 256 : SEQ / 256;
  const int b = it / (4 * nqb), h = (it / nqb) & 3, qb = it % nqb;
  const int tid = tid_(), lane = tid & 63, wid = tid >> 6;
  const int nq = ctxq ? CTXL : SEQ, q0 = qb * 256 + wid * 32;
  const bool active = q0 < nq;
  const int jq = (ctxq ? 0 : CTXL) + (active ? q0 : 0) + (lane & 31);
  const bf16* P1 = (const bf16*)(p.ws + OFF_P1) + (size_t)b * TOK * P1W;
  const bf16* VT = (const bf16*)(p.ws + OFF_MIX + MX_VTN) + ((size_t)b * 4 + h) * 64 * TOK;
  const bf16* Kb = P1 + C_NA + 256 + h * 64;
  bf16* O = (bf16*)(p.ws + OFF_O) + ((size_t)b * TOK + jq) * 1024 + 1 * 256 + h * 64;
  constexpr int AT_END64 = 2 * (64 * 72 * 2) + 2 * (64 * AT_LDV * 2);
  float* srpb = (float*)(smem + AT_END64);
  NaInfo ni; ni.r = 0; ni.qc = 0; ni.rs = 0; ni.cs = 0;
  int ka0 = 0, nta = 0, arow0 = 0;
  if (!ctxq) {
    __syncthreads();
    const float* rpb = p.in[I_RPB] + ((size_t)L.l * 4 + h) * 15 * 31;
    for (int i = tid; i < 15 * 31; i += NTHREADS) srpb[i] = rpb[i];
    const int tl = q0 + (lane & 31);
    ni.r = tl / GRID_W; ni.qc = tl % GRID_W;
    int rs = ni.r - WIN_R / 2; rs = rs < 0 ? 0 : (rs > ROWS - WIN_R ? ROWS - WIN_R : rs);
    int cs = ni.qc - WIN_C / 2; cs = cs < 0 ? 0 : (cs > GRID_W - WIN_C ? GRID_W - WIN_C : cs);
    ni.rs = rs; ni.cs = cs;
    constexpr int RPT = 64 / GRID_W;
    const int rfirst = (qb * 256) / GRID_W, rlast = (qb * 256 + 255) / GRID_W;
    int rs_f = rfirst - WIN_R / 2; rs_f = rs_f < 0 ? 0 : (rs_f > ROWS - WIN_R ? ROWS - WIN_R : rs_f);
    int rs_l = rlast - WIN_R / 2; rs_l = rs_l < 0 ? 0 : (rs_l > ROWS - WIN_R ? ROWS - WIN_R : rs_l);
    arow0 = (rs_f / RPT) * RPT;
    const int row_hi = rs_l + WIN_R;
    nta = (row_hi - arow0 + RPT - 1) / RPT;
    ka0 = CTXL + arow0 * GRID_W;
  }
  attn_block<64, true>(P1 + (size_t)jq * P1W + C_NA + h * 64, active, Kb, P1W, VT, ka0, nta, arow0, 0, CTXL / 64, srpb, ni, 0.125f, O, smem);
}

constexpr int M2_LDB = 136, M2_LDX = 72;
constexpr int M2_OFF_B = 0;
constexpr int M2_OFF_C = M2_OFF_B + 64 * M2_LDB * 2;
constexpr int M2_OFF_HD = M2_OFF_C + 64 * M2_LDB * 2;
constexpr int M2H_H = 0;
constexpr int M2H_XT = M2H_H + 64 * M2_LDB * 2;
constexpr int M2H_BT = M2H_XT + 64 * M2_LDX * 2;
constexpr int M2H_S = M2H_BT + 128 * M2_LDX * 2;
constexpr int M2H_X = M2H_S + 3 * 64 * 4;
constexpr int M2H_SIZE = M2H_X + 64 * M2_LDX * 2;
constexpr int M2_SMEM = M2_OFF_HD + 2 * M2H_SIZE;
static_assert(M2_SMEM <= SMEM_BYTES, "m2 smem");
DI u32x4 rev8_(u32x4 v) {
  return u32x4{(v[3] >> 16) | (v[3] << 16), (v[2] >> 16) | (v[2] << 16), (v[1] >> 16) | (v[1] << 16), (v[0] >> 16) | (v[0] << 16)};
}
DI void m2scan_item(const Params& p, const LP& L, int it, char* smem) {
  const int b = it / 8, grp = (it >> 2) & 1, dir = (it >> 1) & 1, seg1 = it & 1;
  const int cbeg = seg1 ? M2_SPLIT : 0, cend = seg1 ? TOK : M2_SPLIT;
  const int tid = tid_(), lane = tid & 63, wid = tid >> 6, half = lane >> 5, r = lane & 31;
  const int hsel = wid >> 2, wl = wid & 3, hd = grp * 2 + hsel;
  bf16* sB = (bf16*)(smem + M2_OFF_B);
  bf16* sC = (bf16*)(smem + M2_OFF_C);
  char* hb = smem + M2_OFF_HD + hsel * M2H_SIZE;
  bf16* sH = (bf16*)(hb + M2H_H);
  bf16* sXT = (bf16*)(hb + M2H_XT);
  bf16* sBT = (bf16*)(hb + M2H_BT);
  float* sS = (float*)(hb + M2H_S);
  float* sDt = sS + 64;
  float* sW = sS + 128;
  const bf16* XB = (const bf16*)(p.ws + OFF_MIX + MX_XBC) + (size_t)b * TOK * 768;
  const bf16* XT = (const bf16*)(p.ws + OFF_MIX + MX_XBT) + (size_t)b * 512 * TOK;
  const float* SC = (const float*)(p.ws + OFF_MIX + MX_M2S) + (size_t)((b * 2 + dir) * 4 + hd) * TOK * 4;
  float* YM = (float*)(p.ws + OFF_HA) + ((size_t)dir * NTOK + (size_t)b * TOK) * 256;
  const int pb = wl & 1, tb = wl >> 1, nb0 = 2 * (wl >> 1);
  f32x16 hst[2];
#pragma unroll
  for (int i = 0; i < 16; ++i) { hst[0][i] = 0.f; hst[1][i] = 0.f; }
  __syncthreads();
  for (int i = tid; i < 2 * M2H_SIZE / 4; i += NTHREADS) ((unsigned*)(smem + M2_OFF_HD))[i] = 0u;
  __syncthreads();
  u32x4 rxt[2], rbt[2], rb[2], rc[2];
  float4 rsc = make_float4(0.f, 0.f, 0.f, 0.f);
#define M2_TLOAD(rowptr_, sq0_) (*(const u32x4*)((rowptr_) + ((dir == 0) ? (sq0_) : m2_seq2tok((sq0_) + 7, 1))))
#define M2_GLOAD(c0_) { \
    _Pragma("unroll") for (int q_ = 0; q_ < 2; ++q_) { const int i_ = tid + q_ * NTHREADS; const int h2_ = i_ >> 9, t8_ = ((i_ >> 6) & 7) * 8, pp_ = i_ & 63; \
      rxt[q_] = M2_TLOAD(XT + (size_t)((grp * 2 + h2_) * 64 + pp_) * TOK, (c0_) + t8_); } \
    _Pragma("unroll") for (int q_ = 0; q_ < 2; ++q_) { const int i_ = tid + q_ * NTHREADS; const int t8_ = (i_ >> 7) * 8, nn_ = i_ & 127; \
      rbt[q_] = M2_TLOAD(XT + (size_t)(256 + grp * 128 + nn_) * TOK, (c0_) + t8_); } \
    _Pragma("unroll") for (int q_ = 0; q_ < 2; ++q_) { const int i_ = tid + q_ * NTHREADS; const int t_ = i_ >> 4, n8_ = (i_ & 15) * 8; \
      const bf16* src_ = XB + (size_t)m2_seq2tok((c0_) + t_, dir) * 768 + grp * 128 + n8_; \
      rb[q_] = *(const u32x4*)(src_ + 256); rc[q_] = *(const u32x4*)(src_ + 512); } \
    if (wl == 0) rsc = *(const float4*)(SC + (size_t)((c0_) + lane) * 4); }
  M2_GLOAD(cbeg)
  float* GT = (float*)(p.ws + OFF_MIX + MX_GT) + (size_t)((b * 2 + dir) * 4 + hd) * M2_REST;
  float lcum = 0.f;
  for (int c0 = cbeg; c0 < cend; c0 += 64) {
    if (wl == 0) {
      sS[lane] = rsc.x; sDt[lane] = rsc.w; sW[lane] = rsc.z;
      if (seg1) { GT[c0 - M2_SPLIT + lane] = rsc.x + lcum; lcum += shfl_(rsc.x, 63); }
    }
    __syncthreads();
#pragma unroll
    for (int q2 = 0; q2 < 2; ++q2) {
      const int i = tid + q2 * NTHREADS; const int h2 = i >> 9, t8 = ((i >> 6) & 7) * 8, pp = i & 63;
      *(u32x4*)((bf16*)(smem + M2_OFF_HD + h2 * M2H_SIZE + M2H_XT) + pp * M2_LDX + t8) = dir ? rev8_(rxt[q2]) : rxt[q2];
    }
#pragma unroll
    for (int q4 = 0; q4 < 2; ++q4) {
      const int i = tid + q4 * NTHREADS; const int t = i >> 4, n8 = (i & 15) * 8;
      *(u32x4*)(sB + t * M2_LDB + n8) = rb[q4];
      *(u32x4*)(sC + t * M2_LDB + n8) = rc[q4];
    }
#pragma unroll
    for (int q4 = 0; q4 < 2; ++q4) {
      const int i = tid + q4 * NTHREADS; const int t8 = (i >> 7) * 8, nn = i & 127;
      float bv[8];
      if (dir) rbt[q4] = rev8_(rbt[q4]);
      bv[0] = __uint_as_float(rbt[q4][0] << 16); bv[1] = __uint_as_float(rbt[q4][0] & 0xffff0000u);
      bv[2] = __uint_as_float(rbt[q4][1] << 16); bv[3] = __uint_as_float(rbt[q4][1] & 0xffff0000u);
      bv[4] = __uint_as_float(rbt[q4][2] << 16); bv[5] = __uint_as_float(rbt[q4][2] & 0xffff0000u);
      bv[6] = __uint_as_float(rbt[q4][3] << 16); bv[7] = __uint_as_float(rbt[q4][3] & 0xffff0000u);
#pragma unroll
      for (int h2 = 0; h2 < 2; ++h2) {
        const float* wv = (const float*)(smem + M2_OFF_HD + h2 * M2H_SIZE + M2H_S) + 128 + t8;
        float sv[8];
#pragma unroll
        for (int k = 0; k < 8; ++k) sv[k] = bv[k] * wv[k];
        st8bf((bf16*)(smem + M2_OFF_HD + h2 * M2H_SIZE + M2H_BT) + nn * M2_LDX + t8, sv);
      }
    }
    __syncthreads();
    if (c0 + 64 < cend) M2_GLOAD(c0 + 64)
    {
      f32x16 yT, y2;
#pragma unroll
      for (int i = 0; i < 16; ++i) { yT[i] = 0.f; y2[i] = 0.f; }
      const int tv = 32 * tb + r;
      const float St = sS[tv];
      for (int sb = 0; sb <= tb; ++sb) {
        f32x16 gT;
#pragma unroll
        for (int i = 0; i < 16; ++i) gT[i] = 0.f;
#pragma unroll
        for (int ks = 0; ks < 8; ++ks) {
          bf16x8 av = *(const bf16x8*)(sB + (32 * sb + r) * M2_LDB + 16 * ks + 8 * half);
          bf16x8 bv = *(const bf16x8*)(sC + tv * M2_LDB + 16 * ks + 8 * half);
          gT = __builtin_amdgcn_mfma_f32_32x32x16_bf16(av, bv, gT, 0, 0, 0);
        }
        const float St2 = St * 1.4426950408889634f;
        if (sb == tb) {
#pragma unroll
          for (int i = 0; i < 16; ++i) {
            const int sv = 32 * sb + (i & 3) + 8 * (i >> 2) + 4 * half;
            gT[i] = (sv <= tv) ? gT[i] * exp2f_(St2 - sDt[sv]) : 0.f;
          }
        } else {
#pragma unroll
          for (int i = 0; i < 16; ++i) {
            const int sv = 32 * sb + (i & 3) + 8 * (i >> 2) + 4 * half;
            gT[i] *= exp2f_(St2 - sDt[sv]);
          }
        }
#pragma unroll
        for (int kq = 0; kq < 2; ++kq) {
          const u32x4 pw = u32x4{pack2(gT[8 * kq], gT[8 * kq + 1]), pack2(gT[8 * kq + 2], gT[8 * kq + 3]), pack2(gT[8 * kq + 4], gT[8 * kq + 5]), pack2(gT[8 * kq + 6], gT[8 * kq + 7])};
          const bf16x8 pf = __builtin_bit_cast(bf16x8, pw);
          const bf16* xr = sXT + (32 * pb + r) * M2_LDX + 32 * sb + 16 * kq + 4 * half;
          uint2 x0 = *(const uint2*)xr, x1 = *(const uint2*)(xr + 8);
          bf16x8 xa;
          xa[0] = (short)(x0.x & 0xffff); xa[1] = (short)(x0.x >> 16); xa[2] = (short)(x0.y & 0xffff); xa[3] = (short)(x0.y >> 16);
          xa[4] = (short)(x1.x & 0xffff); xa[5] = (short)(x1.x >> 16); xa[6] = (short)(x1.y & 0xffff); xa[7] = (short)(x1.y >> 16);
          yT = __builtin_amdgcn_mfma_f32_32x32x16_bf16(xa, pf, yT, 0, 0, 0);
        }
      }
#pragma unroll
      for (int ks = 0; ks < 8; ++ks) {
        bf16x8 av = *(const bf16x8*)(sH + (32 * pb + r) * M2_LDB + 16 * ks + 8 * half);
        bf16x8 bv = *(const bf16x8*)(sC + tv * M2_LDB + 16 * ks + 8 * half);
        y2 = __builtin_amdgcn_mfma_f32_32x32x16_bf16(av, bv, y2, 0, 0, 0);
      }
      const float eS = __expf(St);
      const int j = m2_seq2tok(c0 + tv, dir);
      float* yo = YM + (size_t)j * 256 + hd * 64 + 32 * pb + 4 * half;
#pragma unroll
      for (int gI = 0; gI < 4; ++gI)
        *(float4*)(yo + 8 * gI) = make_float4(yT[4 * gI] + eS * y2[4 * gI], yT[4 * gI + 1] + eS * y2[4 * gI + 1], yT[4 * gI + 2] + eS * y2[4 * gI + 2], yT[4 * gI + 3] + eS * y2[4 * gI + 3]);
    }
    __syncthreads();
    {
      const float eL = __expf(sS[63]);
#pragma unroll
      for (int q = 0; q < 2; ++q) {
#pragma unroll
        for (int i = 0; i < 16; ++i) hst[q][i] *= eL;
#pragma unroll
        for (int ks = 0; ks < 4; ++ks) {
          bf16x8 av = *(const bf16x8*)(sXT + (32 * pb + r) * M2_LDX + 16 * ks + 8 * half);
          bf16x8 bv = *(const bf16x8*)(sBT + (32 * (nb0 + q) + r) * M2_LDX + 16 * ks + 8 * half);
          hst[q] = __builtin_amdgcn_mfma_f32_32x32x16_bf16(av, bv, hst[q], 0, 0, 0);
        }
#pragma unroll
        for (int i = 0; i < 16; ++i) {
          const int pv = 32 * pb + (i & 3) + 8 * (i >> 2) + 4 * half;
          sH[pv * M2_LDB + 32 * (nb0 + q) + r] = f2bf(hst[q][i]);
        }
      }
    }
    __syncthreads();
  }
  if (!seg1) {
    bf16* HM = (bf16*)(p.ws + OFF_MIX + MX_HM) + (size_t)((b * 2 + dir) * 2 + grp) * 128 * 128;
#pragma unroll
    for (int q = 0; q < 4; ++q) {
      const int i = tid + q * NTHREADS, pr = i >> 4, n8 = (i & 15) * 8;
      *(u32x4*)(HM + pr * 128 + n8) = *(const u32x4*)((const bf16*)(smem + M2_OFF_HD + (pr >> 6) * M2H_SIZE + M2H_H) + (pr & 63) * M2_LDB + n8);
    }
  }
}
constexpr int M2C_MT = (M2_REST + 255) / 256;
DI void m2corr_tile(const Params& p, const LP& L, int t, char* smem) {
  const int mt = t % M2C_MT, r = t / M2C_MT, grp = r & 1, dir = (r >> 1) & 1, b = r >> 2;
  const int tok0 = dir ? CTXL : M2_SPLIT;
  const bf16* A = (const bf16*)(p.ws + OFF_MIX + MX_XBC) + ((size_t)b * TOK + tok0) * 768 + 512 + grp * 128;
  const bf16* HM = (const bf16*)(p.ws + OFF_MIX + MX_HM) + (size_t)((b * 2 + dir) * 2 + grp) * 128 * 128;
  GA g = make_ga(A, 768, HM, 128, 128, M2_REST);
  f32x4 acc[4][4];
  const int m0 = mt * 256;
  gemm_s<4>(g, m0, 0, smem, acc);
  float* YM = (float*)(p.ws + OFF_HA) + ((size_t)dir * NTOK + (size_t)b * TOK + tok0) * 256;
  const float* GT = (const float*)(p.ws + OFF_MIX + MX_GT) + (size_t)((b * 2 + dir) * 4 + grp * 2) * M2_REST;
  EPI_BEGIN(4, acc, m0, 0, M2_REST)
    const int hs = col >> 6;
    const int sidx = dir ? (M2_REST - 1 - row) : row;
    const float f = __expf(GT[(size_t)hs * M2_REST + sidx]);
    float* yo = YM + (size_t)row * 256 + (grp * 2 + hs) * 64 + (col & 63);
    float4 y0 = *(const float4*)yo, y1 = *(const float4*)(yo + 4);
    y0.x += f * v[0]; y0.y += f * v[1]; y0.z += f * v[2]; y0.w += f * v[3];
    y1.x += f * v[4]; y1.y += f * v[5]; y1.z += f * v[6]; y1.w += f * v[7];
    *(float4*)yo = y0; *(float4*)(yo + 4) = y1;
  EPI_END
}
DI void m2gate_item(const Params& p, const LP& L, int it) {
  const int tok = it * NWAVES + (tid_() >> 6), lane = tid_() & 63;
  const float* Y0 = (const float*)(p.ws + OFF_HA) + (size_t)tok * 256;
  const float* Y1 = Y0 + (size_t)NTOK * 256;
  const bf16* XB = (const bf16*)(p.ws + OFF_MIX + MX_XBC) + (size_t)tok * 768;
  const bf16* P1 = (const bf16*)(p.ws + OFF_P1) + (size_t)tok * P1W + C_Z;
  const int c = lane * 4, hd = c >> 6;
  const float dsk = p.in[I_M2D][L.l * 4 + hd];
  float4 y0 = *(const float4*)(Y0 + c), y1 = *(const float4*)(Y1 + c);
  uint2 xw = *(const uint2*)(XB + c), zw = *(const uint2*)(P1 + c);
  float xs[4] = {__uint_as_float(xw.x << 16), __uint_as_float(xw.x & 0xffff0000u), __uint_as_float(xw.y << 16), __uint_as_float(xw.y & 0xffff0000u)};
  float zs[4] = {__uint_as_float(zw.x << 16), __uint_as_float(zw.x & 0xffff0000u), __uint_as_float(zw.y << 16), __uint_as_float(zw.y & 0xffff0000u)};
  float ys[4] = {y0.x + y1.x, y0.y + y1.y, y0.z + y1.z, y0.w + y1.w};
  float v[4], ss = 0.f;
#pragma unroll
  for (int i = 0; i < 4; ++i) { v[i] = (ys[i] + dsk * xs[i]) * siluf_(zs[i]); ss += v[i] * v[i]; }
  ss = wave_sum(ss);
  const float rs = rsqrtf(ss * (1.f / 256.f) + EPS);
  float4 gn = *(const float4*)(p.in[I_M2GNORM] + L.l * 256 + c);
  bf16* O = (bf16*)(p.ws + OFF_O) + (size_t)tok * 1024 + 768 + c;
  *(uint2*)O = make_uint2(pack2(v[0] * rs * gn.x, v[1] * rs * gn.y), pack2(v[2] * rs * gn.z, v[3] * rs * gn.w));
}
constexpr int GLU_MT = (NTOK + 255) / 256;
DI void glu_tile(const Params& p, const LP& L, int t, char* smem) {
  const int mt = t % GLU_MT, nt = t / GLU_MT, m0 = mt * 256, n0 = nt * 128;
  const bf16* Z = (const bf16*)(p.ws + OFF_MIX + MX_Z);
  GA g = make_ga(Z, 256, (const bf16*)(L.we + WE_GLU), 256, 256, NTOK);
  f32x4 acc[4][4];
  gemm_s<4>(g, m0, n0, smem, acc);
  bf16* O = (bf16*)(p.ws + OFF_O);
  const float* bg = p.in[I_S5BGLU] + L.l * 256;
  EPI_BEGIN(4, acc, m0, n0, NTOK)
    float z[8]; ld8bf(Z + (size_t)row * 256 + col, z);
#pragma unroll
    for (int k = 0; k < 8; ++k) v[k] = z[k] * sigmoidf_(v[k] + bg[col + k]);
    st8bf(O + (size_t)row * 1024 + 512 + col, v);
  EPI_END
}
DI void merge_tile(const Params& p, const LP& L, int t, char* smem) {
  constexpr int MT_L = BATCH * (SEQ / 256), MT_A = (NTOK + 255) / 256;
  const int mt = L.last ? t % MT_L : t % MT_A, nt = L.last ? t / MT_L : t / MT_A, m0 = mtile_row0(mt, L.last, 256), n0 = nt * 128;
  const bf16* O = (const bf16*)(p.ws + OFF_O);
  const bf16* PG = (const bf16*)(p.ws + OFF_PG);
  float tot[4][2][8];
#pragma unroll
  for (int a = 0; a < 4; ++a)
#pragma unroll
    for (int q = 0; q < 2; ++q)
#pragma unroll
      for (int k = 0; k < 8; ++k) tot[a][q][k] = 0.f;
  for (int j = 0; j < 4; ++j) {
    GA g = make_ga(O + j * 256, 1024, (const bf16*)(L.we + WE_WB) + (size_t)j * 1024 * 256, 256, 256, NTOK);
    f32x4 acc[4][4];
    gemm_s<4>(g, m0, n0, smem, acc);
    EPI_BEGIN(4, acc, m0, n0, NTOK)
      float gt[8]; ld8bf(PG + (size_t)row * 4096 + j * 1024 + col, gt);
#pragma unroll
      for (int k = 0; k < 8; ++k) tot[_m][_q][k] += gt[k] * v[k];
    EPI_END
  }
  bf16* Y = (bf16*)(p.ws + OFF_P1);
  {
    const int l = tid_() & 63, w = tid_() >> 6, wr = w >> 1, wc = w & 1, fr = l & 15, fq = l >> 4;
#pragma unroll
    for (int m = 0; m < 4; ++m)
#pragma unroll
      for (int q = 0; q < 2; ++q) {
        const int row = m0 + wr * 64 + m * 16 + fr, col = n0 + wc * 64 + q * 32 + 8 * fq;
        if (row < NTOK) st8bf(Y + (size_t)row * 1024 + col, tot[m][q]);
      }
  }
}
DI void outproj_tile(const Params& p, const LP& L, int t, char* smem) {
  float* Y2 = (float*)(p.ws + OFF_HA);
  constexpr int MT_L = BATCH * (SEQ / 256), MT_A = (NTOK + 255) / 256;
  const int mt = L.last ? t % MT_L : t % MT_A, nt = L.last ? t / MT_L : t / MT_A, m0 = mtile_row0(mt, L.last, 256), n0 = nt * 256;
  GA g = make_ga((const bf16*)(p.ws + OFF_P1), 1024, (const bf16*)(L.we + WE_WOUT), 1024, 1024, NTOK);
  f32x4 acc[2][2][4][2];
  gemm_big(g, m0, n0, smem, acc);
  EPIB_BEGIN(acc, m0, n0, NTOK)
    st8f(Y2 + (size_t)row * 1024 + col, v);
  EPIB_END
}
DI int post_ntok(bool latonly) { return latonly ? BATCH * SEQ : NTOK; }
DI int post_tok(int i, bool latonly) { return latonly ? ((i / SEQ) * TOK + CTXL + (i % SEQ)) : i; }

DI const float* xsrc_row(const Params& p, int l, int tok) {
  if (l > 0) return (const float*)(p.ws + OFF_X) + (size_t)tok * 1024;
  const int b = tok_b(tok), j = tok_j(tok);
  return (j < CTXL) ? p.in[I_CTX] + ((size_t)b * CTXL + j) * 1024 : p.in[I_X] + ((size_t)b * SEQ + (j - CTXL)) * 1024;
}
DI void post_stage_router(const Params& p, const LP& L, char* smem) {
  const float* wr = p.in[I_WROUTER] + (size_t)L.l * 1024 * 16;
  float4* wl = (float4*)smem;
  __syncthreads();
  for (int i = tid_(); i < 4096; i += NTHREADS) {
    const int k = i >> 2, q = i & 3;
    const int pos = ((k >> 8) * 4 + (k & 3)) * 64 + ((k >> 2) & 63);
    wl[q * 1024 + pos] = *(const float4*)(wr + (size_t)k * 16 + q * 4);
  }
  __syncthreads();
}
DI void post_phase(const Params& p, const LP& L, char* smem) {
  const int lane = tid_() & 63, gw = (int)blockIdx.x * NWAVES + (tid_() >> 6), TW = (int)gridDim.x * NWAVES;
  const int n = post_ntok(L.last);
  if (gw >= n) return;
  const float* gpm = p.in[I_GPOSTMIX] + L.l * 1024;
  const float4* wl = (const float4*)smem;
  int i = gw, tok = post_tok(i, L.last);
  float4 yr[4], xr[4];
  {
    const float* X = xsrc_row(p, L.l, tok);
    const float* Y2 = (const float*)(p.ws + OFF_HA) + (size_t)tok * 1024;
#pragma unroll
    for (int q = 0; q < 4; ++q) { yr[q] = *(const float4*)(Y2 + lane * 4 + q * 256); xr[q] = *(const float4*)(X + lane * 4 + q * 256); }
  }
  for (;;) {
    const int inext = i + TW; const bool has = inext < n; const int tokn = has ? post_tok(inext, L.last) : tok;
    float4 yn[4], xn[4];
    {
      const float* Xn = xsrc_row(p, L.l, tokn);
      const float* Yn = (const float*)(p.ws + OFF_HA) + (size_t)tokn * 1024;
#pragma unroll
      for (int q = 0; q < 4; ++q) { yn[q] = *(const float4*)(Yn + lane * 4 + q * 256); xn[q] = *(const float4*)(Xn + lane * 4 + q * 256); }
    }
    float* X = (float*)(p.ws + OFF_X) + (size_t)tok * 1024;
    const float* mod = L.mod + (size_t)tok_modrow(tok) * 6144;
    float xv[16], h[16];
    float ss = 0.f;
#pragma unroll
    for (int q = 0; q < 4; ++q) ss += yr[q].x * yr[q].x + yr[q].y * yr[q].y + yr[q].z * yr[q].z + yr[q].w * yr[q].w;
    ss = wave_sum(ss);
    const float rs = rsqrtf(ss * (1.f / 1024.f) + EPS);
#pragma unroll
    for (int q = 0; q < 4; ++q) {
      const int c = lane * 4 + q * 256;
      float4 xo = xr[q], gv = *(const float4*)(gpm + c), gt = *(const float4*)(mod + 2048 + c);
      xo.x += gt.x * yr[q].x * rs * gv.x; xo.y += gt.y * yr[q].y * rs * gv.y; xo.z += gt.z * yr[q].z * rs * gv.z; xo.w += gt.w * yr[q].w * rs * gv.w;
      *(float4*)(X + c) = xo;
      xv[q * 4] = xo.x; xv[q * 4 + 1] = xo.y; xv[q * 4 + 2] = xo.z; xv[q * 4 + 3] = xo.w;
    }
    bf16* H2 = (bf16*)(p.ws + OFF_P1) + (size_t)NTOK * 1024 + (size_t)tok * 1024;
    normmod_row(xv, p.in[I_GPREFFN] + L.l * 1024, mod + 3072, mod + 4096, H2, h);
    float lg[16];
#pragma unroll
    for (int e = 0; e < 16; ++e) lg[e] = 0.f;
#pragma unroll
    for (int q = 0; q < 16; ++q) {
      const int pos = ((q >> 2) * 4 + (q & 3)) * 64 + lane;
      float4 a = wl[pos], b4 = wl[1024 + pos], c4 = wl[2048 + pos], d4 = wl[3072 + pos];
      float hv = h[q];
      lg[0] += hv * a.x; lg[1] += hv * a.y; lg[2] += hv * a.z; lg[3] += hv * a.w;
      lg[4] += hv * b4.x; lg[5] += hv * b4.y; lg[6] += hv * b4.z; lg[7] += hv * b4.w;
      lg[8] += hv * c4.x; lg[9] += hv * c4.y; lg[10] += hv * c4.z; lg[11] += hv * c4.w;
      lg[12] += hv * d4.x; lg[13] += hv * d4.y; lg[14] += hv * d4.z; lg[15] += hv * d4.w;
    }
    float mx = -INFINITY;
#pragma unroll
    for (int e = 0; e < 16; ++e) { lg[e] = wave_sum(lg[e]); mx = fmax_(mx, lg[e]); }
    float se = 0.f;
#pragma unroll
    for (int e = 0; e < 16; ++e) { lg[e] = expf(lg[e] - mx); se += lg[e]; }
    if (lane < 16) {
      float v = 0.f;
#pragma unroll
      for (int e = 0; e < 16; ++e) if (e == lane) v = lg[e];
      ((float*)(p.ws + OFF_AFF))[(size_t)lane * NTOK + tok] = v * rcp_(se);
    }
    if (!has) break;
    i = inext; tok = tokn;
#pragma unroll
    for (int q = 0; q < 4; ++q) { yr[q] = yn[q]; xr[q] = xn[q]; }
  }
}
DI int block_sum_(int v, int* sred, int round) {
  const int tid = tid_(), lane = tid & 63, wid = tid >> 6;
  v += shfl_xor_(v, 32); v += shfl_xor_(v, 16); v += shfl_xor_(v, 8); v += shfl_xor_(v, 4); v += shfl_xor_(v, 2); v += shfl_xor_(v, 1);
  int* r = sred + (round & 1) * NWAVES;
  if (lane == 0) r[wid] = v;
  __syncthreads();
  int tsum = 0;
#pragma unroll
  for (int q = 0; q < NWAVES; ++q) tsum += r[q];
  return tsum;
}
DI void route_item(const Params& p, const LP& L, int it, char* smem) {
  const int nstream = L.last ? 1 : 2;
  const int b = it / (16 * nstream), e = (it / nstream) & 15, ctxs = (nstream == 2) ? (it & 1) : 0;
  const int T = ctxs ? CTXL : SEQ, cap = ctxs ? CAP_C : CAP_L;
  const int tok0 = b * TOK + (ctxs ? 0 : CTXL);
  const int slot0 = ctxs ? (BATCH * CAP_L + b * CAP_C) : (b * CAP_L);
  int* sred = (int*)smem;
  const float* AFF = (const float*)(p.ws + OFF_AFF) + (size_t)e * NTOK + tok0;
  int* SEL = (int*)(p.ws + OFF_SEL);
  int* IDX = (int*)(p.ws + OFF_IDX) + (size_t)e * ESLOTS;
  float* GW = (float*)(p.ws + OFF_GW) + (size_t)e * ESLOTS;
  const int tid = tid_(), lane = tid & 63, wid = tid >> 6;
  constexpr int MAXPER = (SEQ + NTHREADS - 1) / NTHREADS;
  const int per = (T + NTHREADS - 1) / NTHREADS;
  unsigned key[MAXPER];
  __syncthreads();
#pragma unroll
  for (int k = 0; k < MAXPER; ++k) {
    int i = tid * per + k;
    key[k] = (k < per && i < T) ? (__float_as_uint(AFF[i]) + 1u) : 0u;
  }
  unsigned thr = 0u;
  int round = 0;
  for (int bit = 30; bit >= 0; --bit) {
    const unsigned cand = thr | (1u << bit);
    int c = 0;
#pragma unroll
    for (int k = 0; k < MAXPER; ++k) c += (key[k] >= cand) ? 1 : 0;
    c = block_sum_(c, sred, round++);
    if (c >= cap) thr = cand;
  }
  int cg = 0, ce = 0;
#pragma unroll
  for (int k = 0; k < MAXPER; ++k) { cg += (key[k] > thr) ? 1 : 0; ce += (key[k] == thr) ? 1 : 0; }
  const int tot_gt = block_sum_(cg, sred, round++);
  const int need_eq = cap - tot_gt;
  int v = cg | (ce << 16), inc = v;
#pragma unroll
  for (int d = 1; d < 64; d <<= 1) { int o = shfl_up_(inc, d); if (lane >= d) inc += o; }
  int* soff = sred + 2 * NWAVES;
  __syncthreads();
  if (lane == 63) soff[wid] = inc;
  __syncthreads();
  int base = 0;
  for (int w = 0; w < wid; ++w) base += soff[w];
  int excl = base + inc - v;
  int gt_before = excl & 0xffff, eq_before = excl >> 16;
#pragma unroll
  for (int k = 0; k < MAXPER; ++k) {
    int i = tid * per + k;
    if (k < per && i < T) {
      const bool isgt = key[k] > thr, iseq = key[k] == thr;
      const bool sel = isgt || (iseq && eq_before < need_eq);
      const int slot = slot0 + gt_before + (eq_before < need_eq ? eq_before : need_eq);
      if (sel) { IDX[slot] = tok0 + i; GW[slot] = __uint_as_float(key[k] - 1u); SEL[(size_t)(tok0 + i) * 16 + e] = slot; }
      else SEL[(size_t)(tok0 + i) * 16 + e] = -1;
      gt_before += isgt ? 1 : 0; eq_before += iseq ? 1 : 0;
    }
  }
}
DI void moe1_tile(const Params& p, const LP& L, int t, char* smem) {
  const int nslots = L.last ? ESLOTS_L : ESLOTS;
  constexpr int MT_L = (ESLOTS_L + 255) / 256, MT_A = (ESLOTS + 255) / 256;
  const int nt = t & 7, sq = t >> 3;
  const int e = L.last ? sq / MT_L : sq / MT_A, mt = L.last ? sq % MT_L : sq % MT_A;
  const int m0 = mt * 256, n0 = nt * 256;
  GA g = make_ga((const bf16*)(p.ws + OFF_P1) + (size_t)NTOK * 1024, 1024, (const bf16*)(p.ws + OFF_MIX + WX_GU) + (size_t)e * 2048 * 1024, 1024, 1024, nslots);
  g.ridx = (const int*)(p.ws + OFF_IDX) + (size_t)e * ESLOTS;
  f32x4 acc[2][2][4][2];
  gemm_big(g, m0, n0, smem, acc);
  bf16* ACT = (bf16*)(p.ws + OFF_PG) + (size_t)e * ESLOTS * 1024;
  {
    const int l = tid_() & 63, w = tid_() >> 6, wr = w >> 2, wc = w & 3, fr = l & 15, fq = l >> 4;
#pragma unroll
    for (int ai = 0; ai < 2; ++ai)
#pragma unroll
      for (int m = 0; m < 4; ++m) {
        const int row = m0 + ai * 128 + wr * 64 + m * 16 + fr;
        float a[8];
#pragma unroll
        for (int k = 0; k < 4; ++k) { a[k] = siluf_(acc[ai][0][m][0][k]) * acc[ai][1][m][0][k]; a[4 + k] = siluf_(acc[ai][0][m][1][k]) * acc[ai][1][m][1][k]; }
        if (row < nslots) st8bf(ACT + (size_t)row * 1024 + nt * 128 + wc * 32 + 8 * fq, a);
      }
  }
}
DI void moe2_tile(const Params& p, const LP& L, int t, char* smem) {
  const int nslots = L.last ? ESLOTS_L : ESLOTS;
  constexpr int MT_L = (ESLOTS_L + 255) / 256, MT_A = (ESLOTS + 255) / 256;
  const int x = t & 7, nt = x & 3, sq = (t >> 3) * 2 + (x >> 2);
  const int e = L.last ? sq / MT_L : sq / MT_A, mt = L.last ? sq % MT_L : sq % MT_A;
  if (e >= NE) return;
  const int m0 = mt * 256, n0 = nt * 256;
  GA g = make_ga((const bf16*)(p.ws + OFF_PG) + (size_t)e * ESLOTS * 1024, 1024, (const bf16*)(p.ws + OFF_MIX + WX_DN) + (size_t)e * 1024 * 1024, 1024, 1024, nslots);
  f32x4 acc[2][2][4][2];
  gemm_big(g, m0, n0, smem, acc);
  bf16* YS = (bf16*)(p.ws + OFF_PG) + (size_t)NE * ESLOTS * 1024 + (size_t)e * ESLOTS * 1024;
  const float* GW = (const float*)(p.ws + OFF_GW) + (size_t)e * ESLOTS;
  EPIB_BEGIN(acc, m0, n0, nslots)
    const float gw = GW[row];
#pragma unroll
    for (int k = 0; k < 8; ++k) v[k] *= gw;
    st8bf(YS + (size_t)row * 1024 + col, v);
  EPIB_END
}
DI int uni_(int v) {
#ifdef EMU
  return v;
#else
  return __builtin_amdgcn_readfirstlane(v);
#endif
}
DI void comb_phase(const Params& p, const LP& L) {
  const int lane = tid_() & 63, gw = (int)blockIdx.x * NWAVES + (tid_() >> 6), TW = (int)gridDim.x * NWAVES;
  const int n = post_ntok(L.last);
  if (gw >= n) return;
  const bf16* YS = (const bf16*)(p.ws + OFF_PG) + (size_t)NE * ESLOTS * 1024;
  const float* gpf = p.in[I_GPOSTFFN] + L.l * 1024;
  int i = gw, tok = post_tok(i, L.last);
  uint4 sel[4]; float4 xr[4];
  {
    const uint4* sp = (const uint4*)((const int*)(p.ws + OFF_SEL) + (size_t)tok * 16);
    const float* X = (const float*)(p.ws + OFF_X) + (size_t)tok * 1024;
#pragma unroll
    for (int q = 0; q < 4; ++q) { sel[q] = sp[q]; xr[q] = *(const float4*)(X + lane * 4 + q * 256); }
  }
  for (;;) {
    const int inext = i + TW; const bool has = inext < n; const int tokn = has ? post_tok(inext, L.last) : tok;
    float s[16];
#pragma unroll
    for (int q = 0; q < 16; ++q) s[q] = 0.f;
#pragma unroll
    for (int e = 0; e < 16; ++e) {
      const unsigned sv = (e & 3) == 0 ? sel[e >> 2].x : (e & 3) == 1 ? sel[e >> 2].y : (e & 3) == 2 ? sel[e >> 2].z : sel[e >> 2].w;
      const int sl = uni_((int)sv);
      if (sl >= 0) {
        const bf16* yr = YS + ((size_t)e * ESLOTS + sl) * 1024;
#pragma unroll
        for (int q = 0; q < 4; ++q) {
          uint2 w = *(const uint2*)(yr + lane * 4 + q * 256);
          s[q * 4] += __uint_as_float(w.x << 16); s[q * 4 + 1] += __uint_as_float(w.x & 0xffff0000u);
          s[q * 4 + 2] += __uint_as_float(w.y << 16); s[q * 4 + 3] += __uint_as_float(w.y & 0xffff0000u);
        }
      }
    }
    uint4 seln[4]; float4 xn[4];
    {
      const uint4* sp = (const uint4*)((const int*)(p.ws + OFF_SEL) + (size_t)tokn * 16);
      const float* Xn = (const float*)(p.ws + OFF_X) + (size_t)tokn * 1024;
#pragma unroll
      for (int q = 0; q < 4; ++q) { seln[q] = sp[q]; xn[q] = *(const float4*)(Xn + lane * 4 + q * 256); }
    }
    float ss = 0.f;
#pragma unroll
    for (int q = 0; q < 16; ++q) ss += s[q] * s[q];
    ss = wave_sum(ss);
    const float rs = rsqrtf(ss * (1.f / 1024.f) + EPS);
    const float* mod = L.mod + (size_t)tok_modrow(tok) * 6144;
    float* dst = (float*)(p.ws + OFF_X) + (size_t)tok * 1024;
    if (L.last) { const int b = tok_b(tok), j = tok_j(tok); dst = p.out + ((size_t)b * SEQ + (j - CTXL)) * 1024; }
    float xv[16], h[16];
#pragma unroll
    for (int q = 0; q < 4; ++q) {
      const int c = lane * 4 + q * 256;
      float4 xo = xr[q], gv = *(const float4*)(gpf + c), gt = *(const float4*)(mod + 5120 + c);
      xo.x += gt.x * s[q * 4] * rs * gv.x; xo.y += gt.y * s[q * 4 + 1] * rs * gv.y; xo.z += gt.z * s[q * 4 + 2] * rs * gv.z; xo.w += gt.w * s[q * 4 + 3] * rs * gv.w;
      *(float4*)(dst + c) = xo;
      xv[q * 4] = xo.x; xv[q * 4 + 1] = xo.y; xv[q * 4 + 2] = xo.z; xv[q * 4 + 3] = xo.w;
    }
    if (!L.last) {
      const float* mod1 = (const float*)(p.ws + OFF_MOD) + ((size_t)(L.l + 1) * NB1 + tok_modrow(tok)) * 6144;
      normmod_row(xv, p.in[I_GPREMIX] + (L.l + 1) * 1024, mod1, mod1 + 1024, (bf16*)(p.ws + OFF_HA) + (size_t)tok * 1024, h);
    }
    if (!has) break;
    i = inext; tok = tokn;
#pragma unroll
    for (int q = 0; q < 4; ++q) { sel[q] = seln[q]; xr[q] = xn[q]; }
  }
}

enum { PH_PREP0 = 0, PH_PREP1, PH_L0 };
enum { LP_INPROJ = 0, LP_TOKPREP, LP_MIX1, LP_MIX2, LP_GLU, LP_MERGE, LP_OUT, LP_POST, LP_ROUTE, LP_MOE1, LP_MOE2, LP_COMB, LP_COUNT };
constexpr int NPHASES = PH_L0 + DEPTH * LP_COUNT;


DI void run_phase(const Params& p, int ph, char* smem) {
  const int G = gridDim.x;
  int start = blockIdx.x;
  auto seg = [&](int n, auto&& fn) {
    for (; start < n; start += G) fn(start);
    start -= n;
  };
#ifdef ONLY_PREP
  if (ph >= PH_L0) return;
#endif
  if (ph == PH_PREP0) {
    seg(DEPTH * 96, [&](int it) { mod_item(p, it, smem); });
    seg(DEPTH * 32, [&](int it) { s5_tab_item(p, it, smem); });
    seg(1, [&](int) { rope_tab_item(p); });
    seg(DEPTH * CT_EARLY, [&](int it) { conv_early_item(p, it / CT_EARLY, it % CT_EARLY, smem); });
    return;
  }
  if (ph == PH_PREP1) {
    seg(DEPTH * 256, [&](int it) { s5_mat_item(p, it); });
    seg(NTOK / NWAVES, [&](int it) { prep_row_item(p, it); });
    return;
  }
#ifdef ONLY_LPH
  if (ph < PH_L0) return;
#endif
  const int l = (ph - PH_L0) / LP_COUNT;
#ifdef ONLY_LPH
  const int lph = ONLY_LPH;
#else
  const int lph = (ph - PH_L0) % LP_COUNT;
#endif
  const LP L = make_lp(p, l);
  switch (lph) {
    case LP_INPROJ:
      seg(L.last ? IP_SLOTS_LAST : IP_SLOTS_ALL, [&](int it) { inproj_tile(p, L, it, smem); });
      break;
    case LP_TOKPREP:
      seg(16 * S5_MT * 2, [&](int it) { s5a_tile(p, L, it, smem); });
      seg(TP_MT * 3, [&](int it) { mlaq_tile(p, L, it, smem); });
      seg(TP_MT * 4, [&](int it) { mlakv_tile(p, L, it, smem); });
      seg(NTOK / 64, [&](int it) { navt_item(p, it, smem); });
      seg(M2C_ITEMS, [&](int it) { m2conv_item(p, L, it); });
      seg(M2S_ITEMS, [&](int it) { m2scal_item(p, L, it); });
      break;
    case LP_MIX1: {
      const int n0 = BATCH * 8, n1 = n0 + 2 * 16 * BATCH / NWAVES, n2 = n1 + BATCH * 4 * (SEQ / 256), n3 = n2 + BATCH * 4 * (SEQ / 256);
      const int n4 = n3 + (L.last ? 0 : BATCH * 4 * ((CTXL + 255) / 256)), n5 = n4 + (L.last ? 0 : BATCH * 4 * ((CTXL + 255) / 256));
      int* qhead = (int*)(p.ws + OFF_BAR) + Q_WORD0 + 64 * (l + 2 * p.probe_rep);
#ifdef EMU
      volatile int* bc = (volatile int*)(smem + SMEM_BYTES + 8);
#else
      volatile LAS int* bc = (volatile LAS int*)(smem + SMEM_BYTES + 8);
#endif
      for (;;) {
        __syncthreads();
        if (tid_() == 0) {
#ifdef EMU
          *bc = atomicAdd(qhead, 1);
#else
          *bc = __hip_atomic_fetch_add(qhead, 1, __ATOMIC_RELAXED, __HIP_MEMORY_SCOPE_AGENT);
#endif
        }
        __syncthreads();
        const int it = *bc;
        if (it >= n5) break;
#ifdef PROBE_SKIPM2
        if (it < n0) { if (p.probe_rep == 0) m2scan_item(p, L, it, smem); }
#else
        if (it < n0) m2scan_item(p, L, it, smem);
#endif
        else if (it < n1) s5carry_item(p, L, it - n0);
        else if (it < n2) mla_attn_item(p, it - n1, false, smem);
        else if (it < n3) na_attn_item(p, L, it - n2, false, smem);
        else if (it < n4) mla_attn_item(p, it - n3, true, smem);
        else na_attn_item(p, L, it - n4, true, smem);
      }
    } break;
    case LP_MIX2:
      seg(16 * S5_MT * 2, [&](int it) { s5c_tile(p, L, it, smem); });
      seg(BATCH * 4 * M2C_MT, [&](int it) { m2corr_tile(p, L, it, smem); });
      break;
    case LP_GLU:
      seg(GLU_MT * 2, [&](int it) { glu_tile(p, L, it, smem); });
      seg(NTOK / NWAVES, [&](int it) { m2gate_item(p, L, it); });
      break;
    case LP_MERGE:
      seg(mtiles(L.last, 256) * 8, [&](int it) { merge_tile(p, L, it, smem); });
      break;
    case LP_OUT:
      seg(mtiles(L.last, 256) * 4, [&](int it) { outproj_tile(p, L, it, smem); });
      break;
    case LP_POST:
      seg(CT_EXP, [&](int it) { conv_expert_item(p, l, it, smem); });
      post_stage_router(p, L, smem);
      post_phase(p, L, smem);
      break;
    case LP_ROUTE:
      seg(BATCH * 16 * (L.last ? 1 : 2), [&](int it) { route_item(p, L, it, smem); });
      break;
    case LP_MOE1:
      seg(NE * (((L.last ? ESLOTS_L : ESLOTS) + 255) / 256) * 8, [&](int it) { moe1_tile(p, L, it, smem); });
      break;
    case LP_MOE2:
      seg(((NE * (((L.last ? ESLOTS_L : ESLOTS) + 255) / 256) + 1) / 2) * 8, [&](int it) { moe2_tile(p, L, it, smem); });
      break;
    case LP_COMB:
      comb_phase(p, L);
      break;
  }
}

__global__ void __launch_bounds__(NTHREADS, 2) mega_kernel(Params p) {
#ifdef EMU
  char* smem = emu_cur_f->blk->smem;
  for (int ph = p.phase_lo; ph < p.phase_hi; ++ph) {
    run_phase(p, ph, smem);
    if (ph + 1 < p.phase_hi) emu_grid_sync();
  }
#else
  __shared__ __attribute__((aligned(16))) char smem[SMEM_BYTES + 16 + 256];
  {
    const unsigned hw = (unsigned)__builtin_amdgcn_s_getreg((5 << 11) | 4) & 0x3fu;
    if ((threadIdx.x & 63) == 0) *(volatile int*)(smem + WAVE_TAB_OFF + hw * 4u) = (int)(threadIdx.x >> 6);
    __syncthreads();
  }
  if (p.phase_hi - p.phase_lo > 1) {
    if (threadIdx.x == 0) *(uint4*)(smem + SMEM_BYTES) = make_uint4(0u, 0u, 0u, 0u);
    __syncthreads();
    XcdBarrier xb = xcd_barrier_post((unsigned*)(p.ws + OFF_BAR), (volatile LAS unsigned*)(smem + SMEM_BYTES));
    for (int ph = p.phase_lo; ph < p.phase_hi; ++ph) {
      int reps = 1;
#ifdef PROBE_PHASE
      if (ph == PROBE_PHASE || ph == PROBE_PHASE2) reps = 1 + PROBE_REP;
#endif
      for (int rep = 0; rep < reps; ++rep) {
        p.probe_rep = rep;
        run_phase(p, ph, smem);
        if (ph + 1 < p.phase_hi || rep + 1 < reps) {
          if (ph == p.phase_lo && rep == 0) cg::this_grid().sync();
          else xcd_barrier(xb);
        }
      }
    }
  } else {
    run_phase(p, p.phase_lo, smem);
  }
#endif
}

#ifndef EMU
extern "C" void kernel_launch(void* const* d_in, const int* in_sizes, int n_in, void* d_out, int out_size, void* d_ws, size_t ws_size,
                              hipStream_t stream) {
  static int grid_blocks = 0;
  if (!grid_blocks) {
    int dev = 0, cus = 0, per_cu = 0;
    hipGetDevice(&dev);
    hipDeviceGetAttribute(&cus, hipDeviceAttributeMultiprocessorCount, dev);
    hipOccupancyMaxActiveBlocksPerMultiprocessor(&per_cu, mega_kernel, NTHREADS, 0);
    if (per_cu > 1) per_cu = 1;
    if (per_cu < 1) per_cu = 1;
    grid_blocks = cus * per_cu;
    if (ws_size < WS_TOTAL) fprintf(stderr, "workspace too small: %zu < %zu\n", ws_size, (size_t)WS_TOTAL);
  }
  Params p{};
  for (int i = 0; i < N_INPUTS; ++i) p.in[i] = (const float*)d_in[i];
  p.out = (float*)d_out;
  p.ws = (char*)d_ws;
#if MK_MULTI
  for (int ph = 0; ph < NPHASES; ++ph) {
    p.phase_lo = ph; p.phase_hi = ph + 1;
    hipLaunchKernelGGL(mega_kernel, dim3(grid_blocks), dim3(NTHREADS), 0, stream, p);
  }
#else
  p.phase_lo = 0; p.phase_hi = NPHASES;
  hipMemsetAsync((char*)d_ws + OFF_BAR, 0, BAR_BYTES, stream);
  void* args[] = {&p};
  hipError_t e = hipLaunchCooperativeKernel((void*)mega_kernel, dim3(grid_blocks), dim3(NTHREADS), args, 0, stream);
  if (e != hipSuccess) fprintf(stderr, "cooperative launch failed: %s (grid %d)\n", hipGetErrorString(e), grid_blocks);
#endif
}
#endif
```

```cpp
#ifdef EMU
#include "emu.h"
#else
#include <hip/hip_runtime.h>
#include <hip/hip_cooperative_groups.h>
#include <cstdio>
namespace cg = cooperative_groups;
using bf16x8 = __attribute__((ext_vector_type(8))) short;
using f32x4 = __attribute__((ext_vector_type(4))) float;
using f32x16 = __attribute__((ext_vector_type(16))) float;
#endif
using u32x4 = __attribute__((ext_vector_type(4))) unsigned;
#ifndef MK_MULTI
#define MK_MULTI 0
#endif

#define DI __device__ __forceinline__
typedef unsigned short bf16;

#ifdef EMU_SMALL2
constexpr int BATCH = 2, SEQ = 1024, CTXL = 64, GRID_W = 32;
#elif defined(EMU_SMALL)
constexpr int BATCH = 2, SEQ = 512, CTXL = 64, GRID_W = 32;
#else
constexpr int BATCH = 8, SEQ = 2048, CTXL = 256, GRID_W = 64;
#endif
constexpr int D = 1024, DEPTH = 2;
constexpr int TOK = CTXL + SEQ, NTOK = BATCH * TOK;
constexpr int ROWS = SEQ / GRID_W;
constexpr int WIN_R = (ROWS < 8 ? ROWS : 8), WIN_C = 16;
constexpr int N_IN = 6568, N_INP = 6656;
constexpr int C_CQ = 0, C_CKV = 256, C_KR = 384, C_NA = 416, C_S5 = 1184, C_Z = 1440, C_XBC = 1696, C_DT = 2464, C_GATE = 2472;
constexpr int P1W = 2480;
constexpr int NCH = TOK / 16, NCC = CTXL / 16, MCH = BATCH * NCH;
constexpr int NE = 16;
constexpr int CAP_L = 2 * SEQ / NE, CAP_C = 2 * CTXL / NE;
constexpr int ESLOTS = BATCH * (CAP_L + CAP_C), ESLOTS_L = BATCH * CAP_L;
constexpr int NB1 = BATCH + 1;
constexpr float EPS = 1e-6f;
constexpr int SMEM_BYTES = 147456;
constexpr int NTHREADS = 512, NWAVES = NTHREADS / 64;

enum { I_X = 0, I_C, I_CTX, I_CCTX, I_WADA, I_BADA, I_GPREMIX, I_GPOSTMIX, I_GPREFFN, I_GPOSTFFN, I_WIN, I_GCQ, I_GCKV, I_WUQ, I_WUKV, I_RPB,
       I_S5ARE, I_S5AIM, I_S5LOGSTEP, I_S5BRE, I_S5BIM, I_S5CRE, I_S5CIM, I_S5D, I_S5WGLU, I_S5BGLU, I_M2CONVW, I_M2CONVB, I_M2ALOG, I_M2DTBIAS,
       I_M2D, I_M2GNORM, I_WBRANCH, I_WOUT, I_WROUTER, I_WGATE, I_WUP, I_WDOWN, N_INPUTS };

constexpr size_t al256(size_t x) { return (x + 255) & ~(size_t)255; }
constexpr size_t SZ_X = (size_t)NTOK * D * 4;
constexpr size_t SZ_ROWBF = (size_t)NTOK * D * 2;
constexpr size_t OFF_X = 0;
constexpr size_t OFF_MOD = OFF_X + al256(SZ_X);
constexpr size_t OFF_HA = OFF_MOD + al256((size_t)DEPTH * NB1 * 6144 * 4);
constexpr size_t OFF_O = OFF_HA + al256(SZ_ROWBF);
constexpr size_t OFF_P1 = OFF_O + al256(SZ_ROWBF);
constexpr size_t SZ_P1 = (size_t)NTOK * P1W * 2;
constexpr size_t OFF_PG = OFF_P1 + al256(SZ_P1);
constexpr size_t SZ_PG = (size_t)NTOK * 4096 * 2;
constexpr size_t OFF_DT = OFF_PG + al256(SZ_PG);
constexpr size_t OFF_AFF = OFF_DT + al256((size_t)NTOK * 8 * 4);
constexpr size_t OFF_SEL = OFF_AFF + al256((size_t)NTOK * 16 * 4);
constexpr size_t OFF_IDX = OFF_SEL + al256((size_t)NTOK * 16 * 4);
constexpr size_t OFF_GW = OFF_IDX + al256((size_t)NE * ESLOTS * 4);
constexpr size_t OFF_BAR = OFF_GW + al256((size_t)NE * ESLOTS * 4);
constexpr size_t BAR_BYTES = (3456 + 64 * 4) * 4;
constexpr int Q_WORD0 = 3456;
constexpr size_t OFF_ROPE = OFF_BAR + al256(BAR_BYTES);
constexpr size_t OFF_WEARLY = OFF_ROPE + al256(64 * 8 * 2 * 4);
constexpr size_t WE_WIN = 0;
constexpr size_t WE_UQ = WE_WIN + (size_t)N_INP * 1024 * 2;
constexpr size_t WE_UKV = WE_UQ + (size_t)384 * 256 * 2;
constexpr size_t WE_GLU = WE_UKV + (size_t)512 * 128 * 2;
constexpr size_t WE_WB = WE_GLU + (size_t)256 * 256 * 2;
constexpr size_t WE_WOUT = WE_WB + (size_t)4 * 1024 * 256 * 2;
constexpr size_t WE_SIZE = al256(WE_WOUT + (size_t)1024 * 1024 * 2);
constexpr size_t OFF_S5TAB = OFF_WEARLY + DEPTH * WE_SIZE;
constexpr size_t S5_LAMPOW = 0;
constexpr size_t S5_BBAR = S5_LAMPOW + (size_t)2 * 16 * 17 * 64 * 2 * 4;
constexpr size_t S5_KT = S5_BBAR + (size_t)2 * 16 * 64 * 16 * 2 * 4;
constexpr size_t S5_WA = S5_KT + (size_t)2 * 16 * 16 * 256 * 4;
constexpr size_t S5_W2 = S5_WA + (size_t)16 * 256 * 256 * 2;
constexpr size_t S5_SIZE = al256(S5_W2 + (size_t)16 * 256 * 512 * 2);
constexpr size_t OFF_MIX = OFF_S5TAB + DEPTH * S5_SIZE;
constexpr size_t MX_Q = 0;
constexpr size_t MX_K = MX_Q + al256((size_t)BATCH * 4 * TOK * 96 * 2);
constexpr size_t MX_VTM = MX_K + al256((size_t)BATCH * 4 * TOK * 96 * 2);
constexpr size_t MX_VTN = MX_VTM + al256((size_t)BATCH * 4 * 64 * TOK * 2);
constexpr size_t MX_XBC = MX_VTN + al256((size_t)BATCH * 4 * 64 * TOK * 2);
constexpr size_t MX_US5 = MX_XBC + al256((size_t)NTOK * 768 * 2);
constexpr size_t MX_HEND = MX_US5 + al256((size_t)NTOK * 256 * 2);
constexpr size_t MX_HIN = MX_HEND + al256((size_t)16 * MCH * 256 * 4);
constexpr size_t MX_Z = MX_HIN + al256((size_t)16 * MCH * 256 * 2);
constexpr size_t MX_XBT = MX_Z + al256((size_t)NTOK * 256 * 2);
constexpr size_t MX_M2S = MX_XBT + al256((size_t)NTOK * 512 * 2);
constexpr int M2_SPLIT = ((TOK / 64 + 1) / 2) * 64, M2_REST = TOK - M2_SPLIT;
constexpr size_t MX_HM = MX_M2S + al256((size_t)BATCH * 8 * TOK * 4 * 4);
constexpr size_t MX_GT = MX_HM + al256((size_t)BATCH * 4 * 128 * 128 * 2);
constexpr size_t MX_SIZE = MX_GT + al256((size_t)BATCH * 8 * M2_REST * 4);
constexpr size_t WX_GU = 0;
constexpr size_t WX_DN = WX_GU + (size_t)NE * 2048 * 1024 * 2;
constexpr size_t WX_SIZE = WX_DN + (size_t)NE * 1024 * 1024 * 2;
constexpr size_t MIXREG = (MX_SIZE > WX_SIZE ? MX_SIZE : WX_SIZE);
constexpr size_t WS_TOTAL = OFF_MIX + al256(MIXREG);

struct Params {
  const float* in[N_INPUTS];
  float* out;
  char* ws;
  int phase_lo, phase_hi;
  int probe_rep, pad_;
};

constexpr int WAVE_TAB_OFF = SMEM_BYTES + 16;
DI int tid_() {
#ifdef EMU
  return (int)threadIdx.x;
#else
  const unsigned hw = (unsigned)__builtin_amdgcn_s_getreg((5 << 11) | 4) & 0x3fu;
  const int wave = *(volatile __attribute__((address_space(3))) int*)(unsigned long)(WAVE_TAB_OFF + hw * 4u);
  int lane;
  asm volatile("v_mbcnt_lo_u32_b32 %0, -1, 0\n\tv_mbcnt_hi_u32_b32 %0, -1, %0" : "=v"(lane));
  return wave * 64 + lane;
#endif
}
#ifdef EMU
template <class T> DI T shfl_xor_(T v, int m) { return __shfl_xor(v, m); }
template <class T> DI T shfl_up_(T v, int d) { return __shfl_up(v, d); }
template <class T> DI T shfl_(T v, int src) { return __shfl(v, src); }
#else
template <class T> DI T shfl_xor_(T v, int m) {
  const int idx = ((tid_() & 63) ^ m) << 2;
  return __builtin_bit_cast(T, __builtin_amdgcn_ds_bpermute(idx, __builtin_bit_cast(int, v)));
}
template <class T> DI T shfl_up_(T v, int d) {
  const int l = tid_() & 63; const int idx = (l >= d ? l - d : l) << 2;
  return __builtin_bit_cast(T, __builtin_amdgcn_ds_bpermute(idx, __builtin_bit_cast(int, v)));
}
template <class T> DI T shfl_(T v, int src) {
  int idx = src << 2; asm volatile("" : "+v"(idx));
  return __builtin_bit_cast(T, __builtin_amdgcn_ds_bpermute(idx, __builtin_bit_cast(int, v)));
}
#endif
DI float bf2f(bf16 h) { return __uint_as_float(((unsigned)h) << 16); }
#ifdef EMU
DI bf16 f2bf(float f) { unsigned u = __float_as_uint(f); u += 0x7fffu + ((u >> 16) & 1u); return (bf16)(u >> 16); }
DI unsigned pack2(float a, float b) { return (unsigned)f2bf(a) | ((unsigned)f2bf(b) << 16); }
DI float exp2f_(float x) { return exp2f(x); }
#else
typedef float f32x2_t_ __attribute__((ext_vector_type(2)));
typedef __bf16 bf16x2_t_ __attribute__((ext_vector_type(2)));
DI unsigned pack2(float a, float b) { const f32x2_t_ v = {a, b}; return __builtin_bit_cast(unsigned, __builtin_convertvector(v, bf16x2_t_)); }
DI bf16 f2bf(float f) { return (bf16)(pack2(f, 0.f) & 0xffffu); }
DI float exp2f_(float x) { return __builtin_amdgcn_exp2f(x); }
#endif
#ifdef EMU
DI float rcp_(float x) { return 1.0f / x; }
#else
DI float rcp_(float x) { return __builtin_amdgcn_rcpf(x); }
#endif
DI float sigmoidf_(float x) { return rcp_(1.0f + exp2f_(-1.4426950408889634f * x)); }
DI float siluf_(float x) { return x * rcp_(1.0f + exp2f_(-1.4426950408889634f * x)); }
DI float softplusf_(float x) { const float ax = x < 0.f ? -x : x; return (x > 0.f ? x : 0.f) + __logf(1.0f + __expf(-ax)); }
DI float geluf_(float x) { const float u2 = 1.5957691216057308f * (x + 0.044715f * x * x * x); return x * rcp_(1.0f + exp2f_(-1.4426950408889634f * u2)); }
DI bool wave_all_(bool c) {
#ifdef EMU
  int v = c ? 0 : 1;
  v += shfl_xor_(v, 32); v += shfl_xor_(v, 16); v += shfl_xor_(v, 8); v += shfl_xor_(v, 4); v += shfl_xor_(v, 2); v += shfl_xor_(v, 1);
  return v == 0;
#else
  return __builtin_amdgcn_ballot_w64(!c) == 0ull;
#endif
}
DI float wave_sum(float v) {
#ifdef EMU
  v += shfl_xor_(v, 32); v += shfl_xor_(v, 16); v += shfl_xor_(v, 8); v += shfl_xor_(v, 4); v += shfl_xor_(v, 2); v += shfl_xor_(v, 1);
  return v;
#else
  int x = __float_as_int(v);
  x = __float_as_int(__int_as_float(x) + __int_as_float(__builtin_amdgcn_update_dpp(0, x, 0xB1, 0xF, 0xF, true)));
  x = __float_as_int(__int_as_float(x) + __int_as_float(__builtin_amdgcn_update_dpp(0, x, 0x4E, 0xF, 0xF, true)));
  x = __float_as_int(__int_as_float(x) + __int_as_float(__builtin_amdgcn_update_dpp(0, x, 0x141, 0xF, 0xF, true)));
  x = __float_as_int(__int_as_float(x) + __int_as_float(__builtin_amdgcn_update_dpp(0, x, 0x140, 0xF, 0xF, true)));
  const float r0 = __int_as_float(__builtin_amdgcn_readlane(x, 0)), r1 = __int_as_float(__builtin_amdgcn_readlane(x, 16));
  const float r2 = __int_as_float(__builtin_amdgcn_readlane(x, 32)), r3 = __int_as_float(__builtin_amdgcn_readlane(x, 48));
  return (r0 + r1) + (r2 + r3);
#endif
}
#ifndef EMU
#define XB_TMO      128
#define XB_XCNT(j)  (256  + 64 * (j))
#define XB_XSUB(j)  (1280 + 64 * (j))
#define XB_XGEN(j)  (2304 + 64 * (j))
#define XB_TOP      3328
#define XB_TOPGEN   3392
#define XB_SPIN_CAP (1u << 24)
#define LAS __attribute__((address_space(3)))
DI unsigned xb_ld(unsigned* p) { return __hip_atomic_load(p, __ATOMIC_RELAXED, __HIP_MEMORY_SCOPE_AGENT); }
DI unsigned xb_add(unsigned* p, unsigned v) { return __hip_atomic_fetch_add(p, v, __ATOMIC_RELAXED, __HIP_MEMORY_SCOPE_AGENT); }
DI unsigned xb_xcc_id() { return (unsigned)__builtin_amdgcn_s_getreg((3 << 11) | 20) & 0xFu; }
#define XB_SPIN(cond, bar) do { unsigned _sp = 0; while (cond) { __builtin_amdgcn_s_sleep(1); \
    if ((++_sp & 255u) == 0u) { if (xb_ld(&(bar)[XB_TMO])) break; if (_sp > XB_SPIN_CAP) { atomicAdd(&(bar)[XB_TMO], 1u); break; } } } } while (0)
struct XcdBarrier { unsigned* bar; unsigned x; volatile LAS unsigned* st; };
DI XcdBarrier xcd_barrier_post(unsigned* bar, volatile LAS unsigned* st) {
  XcdBarrier b; b.bar = bar; b.x = xb_xcc_id(); b.st = st;
  if (threadIdx.x == 0) (void)xb_add(&bar[XB_XCNT(b.x)], 1u);
  return b;
}
DI void xcd_barrier_complete(unsigned* bar, unsigned x, unsigned& nloc, unsigned& nx) {
  const unsigned G = gridDim.x * gridDim.y * gridDim.z;
  unsigned sum, cnt, mine, sp = 0u;
  for (;;) {
    sum = 0u; cnt = 0u; mine = 0u;
#pragma unroll
    for (unsigned j = 0; j < 16; ++j) { const unsigned c = xb_ld(&bar[XB_XCNT(j)]); sum += c; cnt += (c > 0u) ? 1u : 0u; mine = (j == x) ? c : mine; }
    if (sum == G) break;
    __builtin_amdgcn_s_sleep(1);
    if ((++sp & 255u) == 0u) { if (xb_ld(&bar[XB_TMO])) break; if (sp > XB_SPIN_CAP) { atomicAdd(&bar[XB_TMO], 1u); break; } }
  }
  nloc = mine > 0u ? mine : 1u; nx = cnt > 0u ? cnt : 1u;
}
DI void xcd_barrier(const XcdBarrier& b) {
  asm volatile("s_waitcnt vmcnt(0)" ::: "memory");
  __syncthreads();
  if (threadIdx.x == 0) {
    unsigned* bar = b.bar;
    __builtin_amdgcn_s_waitcnt(0);
    unsigned nloc = b.st[0], nx = b.st[1];
    if (nloc == 0u) { xcd_barrier_complete(bar, b.x, nloc, nx); b.st[0] = nloc; b.st[1] = nx; }
    const unsigned old = xb_add(&bar[XB_XSUB(b.x)], 1u);
    const unsigned gen = old / nloc;
    if (old + 1u == (gen + 1u) * nloc) {
      __builtin_amdgcn_fence(__ATOMIC_RELEASE, "agent");
      asm volatile("s_waitcnt vmcnt(0)" ::: "memory");
      const unsigned og = xb_add(&bar[XB_TOP], 1u);
      const unsigned tg = og / nx;
      if (og + 1u == (tg + 1u) * nx) xb_add(&bar[XB_TOPGEN], 1u);
      else XB_SPIN(xb_ld(&bar[XB_TOPGEN]) == tg, bar);
      __builtin_amdgcn_fence(__ATOMIC_ACQUIRE, "agent");
      xb_add(&bar[XB_XGEN(b.x)], 1u);
      asm volatile("s_waitcnt vmcnt(0)" ::: "memory");
    } else {
      XB_SPIN(xb_ld(&bar[XB_XGEN(b.x)]) == gen, bar);
      __builtin_amdgcn_fence(__ATOMIC_ACQUIRE, "agent");
      asm volatile("s_waitcnt vmcnt(0)" ::: "memory");
    }
  }
  __syncthreads();
}
#endif

struct GA {
  const bf16* A; const bf16* A2; int lda, lda2, ksplit;
  const int* ridx; int mvalid;
  const bf16* Bt; int ldb; int K;
  int kfix;
};
DI GA make_ga(const bf16* A, int lda, const bf16* Bt, int ldb, int K, int mvalid) {
  GA g; g.A = A; g.A2 = A; g.lda = lda; g.lda2 = lda; g.ksplit = K; g.ridx = nullptr; g.mvalid = mvalid; g.Bt = Bt; g.ldb = ldb; g.K = K; g.kfix = 0; return g;
}

#ifdef EMU
#define GLDS16(gptr_, lptr_) memcpy((void*)(lptr_), (const void*)(gptr_), 16)
#define BGLDS16(rsrc_, base_, voff_, soff_, lptr_) memcpy((void*)(lptr_), (const char*)(base_) + (voff_) + (soff_), 16)
#define GEMM_WAIT(N_)
#define RAW_BARRIER() __syncthreads()
#else
#define LASV __attribute__((address_space(3))) void
#define GLDS16(gptr_, lptr_) __builtin_amdgcn_global_load_lds((const void*)(gptr_), (LASV*)(lptr_), 16, 0, 0)
#define BGLDS16(rsrc_, base_, voff_, soff_, lptr_) __builtin_amdgcn_raw_ptr_buffer_load_lds(rsrc_, (LASV*)(lptr_), 16, (int)(voff_), (int)(soff_), 0, 0)
#define GEMM_WAIT(N_) asm volatile("s_waitcnt vmcnt(%0)" :: "n"(N_) : "memory")
#define RAW_BARRIER() { asm volatile("" ::: "memory"); __builtin_amdgcn_s_barrier(); asm volatile("" ::: "memory"); }
#endif
DI int perm32(int rho) { const int n = rho >> 4, i = rho & 15; return 8 * (i >> 2) + 4 * n + (i & 3); }
constexpr int SRS_OFF = 73728;
template <int NT>
DI void gemm_s(const GA& g, int m0, int n0, char* smem, f32x4 (&acc)[4][NT]) {
  constexpr int A_ELEMS = 256 * 32, B_ELEMS = 32 * NT * 32, STAGE = A_ELEMS + B_ELEMS;
  bf16* st = (bf16*)smem;
  const int tid = tid_(), lane = tid & 63, wid = tid >> 6, wr = wid >> 1, wc = wid & 1, fr = lane & 15, fq = lane >> 4;
  const int lrow = tid >> 2, pch = tid & 3;
  long aoff[2], aoff2[2], boff;
#pragma unroll
  for (int i = 0; i < 2; ++i) {
    const int row = lrow + 128 * i;
    const int lch = pch ^ ((-(row >> 2)) & 3);
    int gm = m0 + row; if (gm > g.mvalid - 1) gm = g.mvalid - 1;
    const int ar = g.ridx ? g.ridx[gm] : gm;
    aoff[i] = (long)ar * g.lda + lch * 8;
    aoff2[i] = (long)ar * g.lda2 + lch * 8;
  }
  const int cb = (NT == 4) ? tid : (tid & 255);
  {
    const int row = cb >> 2;
    const int lch = pch ^ ((-(row >> 2)) & 3);
    const int src = n0 + (row & ~31) + perm32(row & 31);
    boff = (long)src * g.ldb + lch * 8;
  }
#pragma unroll
  for (int m = 0; m < 4; ++m)
#pragma unroll
    for (int n = 0; n < NT; ++n) acc[m][n] = f32x4{0.f, 0.f, 0.f, 0.f};
  const int T = g.K / 32;
#define GEMM_DMA(t_, stg_) { const int k0_ = (t_) * 32; const bool seg2_ = (k0_ >= g.ksplit); bf16* sa_ = st + (stg_) * STAGE; \
    _Pragma("unroll") for (int i_ = 0; i_ < 2; ++i_) { \
      const bf16* ap_ = seg2_ ? (g.A2 + aoff2[i_] + (k0_ - g.ksplit)) : (g.A + aoff[i_] + k0_); \
      GLDS16(ap_, sa_ + (tid + i_ * 512) * 8); } \
    GLDS16(g.Bt + boff + k0_, sa_ + A_ELEMS + cb * 8); }
  __syncthreads();
  GEMM_DMA(0, 0)
  if (T > 1) GEMM_DMA(1, 1)
  int s_cur = 0, s_nxt = 2;
#pragma unroll 1
  for (int t = 0; t < T; ++t) {
    if (t + 1 < T) { GEMM_WAIT(3); } else { GEMM_WAIT(0); }
    RAW_BARRIER();
    if (t + 2 < T) GEMM_DMA(t + 2, s_nxt)
    const bf16* sa = st + s_cur * STAGE;
    const bf16* sb = sa + A_ELEMS;
    bf16x8 af[4], bfr[NT];
#pragma unroll
    for (int n = 0; n < NT; ++n) {
      const int row = wc * (16 * NT) + n * 16 + fr;
      bfr[n] = *(const bf16x8*)(sb + row * 32 + ((fq ^ ((-(row >> 2)) & 3)) << 3));
    }
#pragma unroll
    for (int m = 0; m < 4; ++m) {
      const int row = wr * 64 + m * 16 + fr;
      af[m] = *(const bf16x8*)(sa + row * 32 + ((fq ^ ((-(row >> 2)) & 3)) << 3));
    }
#pragma unroll
    for (int m = 0; m < 4; ++m)
#pragma unroll
      for (int n = 0; n < NT; ++n) acc[m][n] = __builtin_amdgcn_mfma_f32_16x16x32_bf16(bfr[n], af[m], acc[m][n], 0, 0, 0);
    s_cur = (s_cur == 2) ? 0 : s_cur + 1;
    s_nxt = (s_nxt == 2) ? 0 : s_nxt + 1;
  }
}
constexpr int BG_HT = 128 * 64;
DI int lds_byte(int r, int c) { const int stt = (r >> 4) * 2 + (c >> 5), rr = r & 15, cc = c & 31, ob = rr * 64 + cc * 2; return stt * 1024 + (ob ^ (((ob >> 9) & 1) << 5)); }
DI void stage_rc(int b, int& R, int& C) { const int stt = b / 1024, sb = b % 1024, swz = sb ^ (((sb >> 9) & 1) << 5); R = (stt >> 1) * 16 + swz / 64; C = (stt & 1) * 32 + (swz % 64) / 2; }
#ifdef EMU
#define BG_WAIT_V(n)
#define BG_WAIT_L(n)
#define BG_BAR __syncthreads()
#define BG_SCHED
#define BG_PRIO(x)
#else
#define BG_WAIT_V(n) asm volatile("s_waitcnt vmcnt(" #n ")" ::: "memory")
#define BG_WAIT_L(n) asm volatile("s_waitcnt lgkmcnt(" #n ")" ::: "memory")
#define BG_BAR __builtin_amdgcn_s_barrier()
#define BG_SCHED __builtin_amdgcn_sched_barrier(0)
#define BG_PRIO(x) __builtin_amdgcn_s_setprio(x)
#endif
DI void gemm_big(const GA& g, int m0, int n0, char* smem, f32x4 (&acc)[2][2][4][2]) {
  bf16* shm = (bf16*)smem;
  const int tid = tid_(), wid = tid >> 6, lane = tid & 63, wr = wid >> 2, wc = wid & 3, fr = lane & 15, fq = lane >> 4;
  unsigned aof[2][2], bof[2];
#ifdef EMU
  const int dma_lds = tid * 16;
#else
  const int dma_lds = __builtin_amdgcn_readfirstlane(tid >> 6) * 1024;
#endif
#ifndef EMU
  const __amdgpu_buffer_rsrc_t rsA = __builtin_amdgcn_make_buffer_rsrc((void*)g.A, 0, 0x7fffffff, 0x00020000);
  const __amdgpu_buffer_rsrc_t rsB = __builtin_amdgcn_make_buffer_rsrc((void*)g.Bt, 0, 0x7fffffff, 0x00020000);
#endif
#pragma unroll
  for (int i = 0; i < 2; ++i) {
    int R, C; stage_rc(tid * 16 + i * 8192, R, C);
    bof[i] = (unsigned)((n0 + (R & ~31) + perm32(R & 31)) * g.ldb + C) * 2u;
#pragma unroll
    for (int h = 0; h < 2; ++h) {
      int gm = m0 + h * 128 + R; if (gm > g.mvalid - 1) gm = g.mvalid - 1;
      const int ar = g.ridx ? g.ridx[gm] : gm;
      aof[h][i] = (unsigned)(ar * g.lda + C) * 2u;
    }
  }
#define BG_SA(b, h) (shm + ((b) * 2 + (h)) * BG_HT)
#define BG_SB(b, h) (shm + (4 + (b) * 2 + (h)) * BG_HT)
#define BG_STAGE_A(P, h, kt) { \
    _Pragma("unroll") for (int i_ = 0; i_ < 2; ++i_) BGLDS16(rsA, g.A, aof[h][i_], (kt) * 128, (char*)(P) + dma_lds + i_ * 8192); }
#define BG_STAGE_B(P, h, kt) { \
    _Pragma("unroll") for (int i_ = 0; i_ < 2; ++i_) BGLDS16(rsB, g.Bt, bof[i_], (kt) * 128 + (h) * 256 * g.ldb, (char*)(P) + dma_lds + i_ * 8192); }
#define BG_LDA(dst, b, h) _Pragma("unroll") for (int m_ = 0; m_ < 4; ++m_) _Pragma("unroll") for (int k_ = 0; k_ < 2; ++k_) \
    dst[m_][k_] = *(const bf16x8*)((const char*)BG_SA(b, h) + lds_byte(wr * 64 + m_ * 16 + fr, k_ * 32 + fq * 8))
#define BG_LDB(dst, b, h) _Pragma("unroll") for (int n_ = 0; n_ < 2; ++n_) _Pragma("unroll") for (int k_ = 0; k_ < 2; ++k_) \
    dst[n_][k_] = *(const bf16x8*)((const char*)BG_SB(b, h) + lds_byte(wc * 32 + n_ * 16 + fr, k_ * 32 + fq * 8))
#define BG_MMA(ai, bj, At_, Bt_) { BG_PRIO(1); \
    _Pragma("unroll") for (int m_ = 0; m_ < 4; ++m_) _Pragma("unroll") for (int n_ = 0; n_ < 2; ++n_) _Pragma("unroll") for (int k_ = 0; k_ < 2; ++k_) \
      acc[ai][bj][m_][n_] = __builtin_amdgcn_mfma_f32_16x16x32_bf16(Bt_[n_][k_], At_[m_][k_], acc[ai][bj][m_][n_], 0, 0, 0); \
    BG_PRIO(0); }
#pragma unroll
  for (int a_ = 0; a_ < 2; ++a_)
#pragma unroll
    for (int b_ = 0; b_ < 2; ++b_)
#pragma unroll
      for (int m_ = 0; m_ < 4; ++m_)
#pragma unroll
        for (int n_ = 0; n_ < 2; ++n_) acc[a_][b_][m_][n_] = f32x4{0.f, 0.f, 0.f, 0.f};
  bf16x8 At[4][2], B0[2][2], B1[2][2];
  const int nt = g.K / 64;
  __syncthreads();
  BG_STAGE_B(BG_SB(0, 0), 0, 0) BG_STAGE_A(BG_SA(0, 0), 0, 0)
  BG_STAGE_B(BG_SB(0, 1), 1, 0) BG_STAGE_A(BG_SA(0, 1), 1, 0)
  if (wr == 1) BG_BAR;
  BG_WAIT_V(4); BG_BAR;
  BG_STAGE_B(BG_SB(1, 0), 0, 1) BG_STAGE_A(BG_SA(1, 0), 0, 1) BG_STAGE_B(BG_SB(1, 1), 1, 1)
  BG_WAIT_V(6); BG_BAR;
#pragma unroll 1
  for (int t = 0; t < nt - 2; t += 2) {
    BG_LDB(B0, 0, 0); BG_SCHED; BG_LDA(At, 0, 0); BG_STAGE_A(BG_SA(1, 1), 1, t + 1)
    BG_WAIT_L(8); BG_BAR; BG_WAIT_L(0); BG_MMA(0, 0, At, B0) BG_BAR; BG_SCHED;
    BG_LDB(B1, 0, 1); BG_STAGE_B(BG_SB(0, 0), 0, t + 2)
    BG_BAR; BG_WAIT_L(0); BG_MMA(0, 1, At, B1) BG_BAR;
    BG_LDA(At, 0, 1); BG_STAGE_A(BG_SA(0, 0), 0, t + 2)
    BG_BAR; BG_WAIT_L(0); BG_MMA(1, 0, At, B0) BG_BAR; BG_SCHED;
    BG_STAGE_B(BG_SB(0, 1), 1, t + 2)
    BG_WAIT_V(6); BG_BAR; BG_MMA(1, 1, At, B1) BG_BAR;
    BG_LDB(B0, 1, 0); BG_SCHED; BG_LDA(At, 1, 0); BG_STAGE_A(BG_SA(0, 1), 1, t + 2)
    BG_WAIT_L(8); BG_BAR; BG_WAIT_L(0); BG_MMA(0, 0, At, B0) BG_BAR; BG_SCHED;
    BG_LDB(B1, 1, 1); BG_STAGE_B(BG_SB(1, 0), 0, t + 3)
    BG_BAR; BG_WAIT_L(0); BG_MMA(0, 1, At, B1) BG_BAR;
    BG_LDA(At, 1, 1); BG_STAGE_A(BG_SA(1, 0), 0, t + 3)
    BG_BAR; BG_WAIT_L(0); BG_MMA(1, 0, At, B0) BG_BAR; BG_SCHED;
    BG_STAGE_B(BG_SB(1, 1), 1, t + 3)
    BG_WAIT_V(6); BG_BAR; BG_MMA(1, 1, At, B1) BG_BAR;
  }
  { BG_LDB(B0, 0, 0); BG_LDA(At, 0, 0); BG_STAGE_A(BG_SA(1, 1), 1, nt - 1)
    BG_BAR; BG_WAIT_L(0); BG_MMA(0, 0, At, B0) BG_BAR;
    BG_LDB(B1, 0, 1); BG_BAR; BG_WAIT_L(0); BG_MMA(0, 1, At, B1) BG_BAR;
    BG_LDA(At, 0, 1); BG_WAIT_V(4); BG_BAR; BG_WAIT_L(0); BG_MMA(1, 0, At, B0) BG_MMA(1, 1, At, B1) BG_BAR; }
  { BG_LDB(B0, 1, 0); BG_LDA(At, 1, 0); BG_WAIT_V(2); BG_BAR; BG_WAIT_L(0); BG_MMA(0, 0, At, B0) BG_BAR;
    BG_LDB(B1, 1, 1); BG_WAIT_V(0); BG_BAR; BG_WAIT_L(0); BG_MMA(0, 1, At, B1) BG_BAR;
    BG_LDA(At, 1, 1); BG_BAR; BG_WAIT_L(0); BG_MMA(1, 0, At, B0) BG_MMA(1, 1, At, B1) BG_BAR; }
  if (wr == 0) BG_BAR;
}
#define EPIB_BEGIN(acc_, m0_, n0_, mvalid_) { const int _l = tid_() & 63, _w = tid_() >> 6, _wr = _w >> 2, _wc = _w & 3, _fr = _l & 15, _fq = _l >> 4; \
  _Pragma("unroll") for (int _ai = 0; _ai < 2; ++_ai) _Pragma("unroll") for (int _m = 0; _m < 4; ++_m) { const int row = (m0_) + _ai * 128 + _wr * 64 + _m * 16 + _fr; \
  _Pragma("unroll") for (int _bj = 0; _bj < 2; ++_bj) { const int col = (n0_) + _bj * 128 + _wc * 32 + 8 * _fq; (void)col; \
    float v[8] = {acc_[_ai][_bj][_m][0][0], acc_[_ai][_bj][_m][0][1], acc_[_ai][_bj][_m][0][2], acc_[_ai][_bj][_m][0][3], \
                  acc_[_ai][_bj][_m][1][0], acc_[_ai][_bj][_m][1][1], acc_[_ai][_bj][_m][1][2], acc_[_ai][_bj][_m][1][3]}; \
    if (row < (mvalid_)) {
#define EPIB_END }}}}

DI void ld8bf(const bf16* p, float (&v)[8]) {
  uint4 w = *(const uint4*)p;
  v[0] = __uint_as_float(w.x << 16); v[1] = __uint_as_float(w.x & 0xffff0000u); v[2] = __uint_as_float(w.y << 16); v[3] = __uint_as_float(w.y & 0xffff0000u);
  v[4] = __uint_as_float(w.z << 16); v[5] = __uint_as_float(w.z & 0xffff0000u); v[6] = __uint_as_float(w.w << 16); v[7] = __uint_as_float(w.w & 0xffff0000u);
}
DI void st8bf(bf16* p, const float (&v)[8]) { *(uint4*)p = make_uint4(pack2(v[0], v[1]), pack2(v[2], v[3]), pack2(v[4], v[5]), pack2(v[6], v[7])); }
#ifdef EMU
DI unsigned pk_u8_(float x, int sel, unsigned old) { float y = x < 0.f ? 0.f : (x > 255.f ? 255.f : x); return (old & ~(0xffu << (8 * sel))) | ((unsigned)lrintf(y) << (8 * sel)); }
#else
DI unsigned pk_u8_(float x, int sel, unsigned old) { return __builtin_amdgcn_cvt_pk_u8_f32(x, (unsigned)sel, old); }
#endif
DI void st8u8(unsigned char* p, const float (&v)[8]) {
  unsigned lo = 0u, hi = 0u;
#pragma unroll
  for (int k = 0; k < 4; ++k) { lo = pk_u8_(v[k] * 255.0f, k, lo); hi = pk_u8_(v[4 + k] * 255.0f, k, hi); }
  *(uint2*)p = make_uint2(lo, hi);
}
DI void ld8u8(const unsigned char* p, float (&v)[8]) {
  const uint2 w = *(const uint2*)p;
#pragma unroll
  for (int k = 0; k < 4; ++k) { v[k] = (float)((w.x >> (8 * k)) & 0xffu); v[4 + k] = (float)((w.y >> (8 * k)) & 0xffu); }
}
DI void st8f(float* p, const float (&v)[8]) { *(float4*)p = make_float4(v[0], v[1], v[2], v[3]); *(float4*)(p + 4) = make_float4(v[4], v[5], v[6], v[7]); }
#define EPI_BEGIN(NT_, acc_, m0_, n0_, mvalid_) { const int _l = tid_() & 63, _w = tid_() >> 6, _wr = _w >> 1, _wc = _w & 1, _fr = _l & 15, _fq = _l >> 4; \
  _Pragma("unroll") for (int _m = 0; _m < 4; ++_m) { const int row = (m0_) + _wr * 64 + _m * 16 + _fr; \
  _Pragma("unroll") for (int _q = 0; _q < (NT_) / 2; ++_q) { const int col = (n0_) + _wc * (16 * (NT_)) + _q * 32 + 8 * _fq; (void)col; \
    float v[8] = {acc_[_m][2 * _q][0], acc_[_m][2 * _q][1], acc_[_m][2 * _q][2], acc_[_m][2 * _q][3], \
                  acc_[_m][2 * _q + 1][0], acc_[_m][2 * _q + 1][1], acc_[_m][2 * _q + 1][2], acc_[_m][2 * _q + 1][3]}; \
    if (row < (mvalid_)) {
#define EPI_END }}}}

DI int mtile_row0(int mt, bool latonly, int TH) {
  if (!latonly) return mt * TH;
  const int per = SEQ / TH, b = mt / per, r = mt % per;
  return b * TOK + CTXL + r * TH;
}
DI int mtiles(bool latonly, int TH) { return latonly ? BATCH * (SEQ / TH) : (NTOK + TH - 1) / TH; }

struct LP {
  int l; bool last;
  const float* mod;
  char* we;
  char* s5;
};
DI LP make_lp(const Params& p, int l) {
  LP q; q.l = l; q.last = (l == DEPTH - 1);
  q.mod = (const float*)(p.ws + OFF_MOD) + (size_t)l * NB1 * 6144;
  q.we = p.ws + OFF_WEARLY + (size_t)l * WE_SIZE;
  q.s5 = p.ws + OFF_S5TAB + (size_t)l * S5_SIZE;
  return q;
}

template <class RowMap>
DI void conv_tile(const float* src, int lds, int nsrc, const float* kscale, bf16* dst, int K, int k0, int n0, char* smem, RowMap rowmap, int ndst = 1 << 30) {
  (void)smem;
  const int tid = tid_(), n4 = (tid >> 6) * 32 + (tid & 7) * 4, k8 = ((tid >> 3) & 7) * 8;
  float4 v[8];
  const bool ok = (n0 + n4 < nsrc);
  const float* sp = src + (size_t)(k0 + k8) * lds + n0 + n4;
#pragma unroll
  for (int k = 0; k < 8; ++k) v[k] = ok ? *(const float4*)(sp + (size_t)k * lds) : make_float4(0.f, 0.f, 0.f, 0.f);
  if (kscale) {
#pragma unroll
    for (int k = 0; k < 8; ++k) { const float sc = kscale[k0 + k8 + k]; v[k].x *= sc; v[k].y *= sc; v[k].z *= sc; v[k].w *= sc; }
  }
  float o[8];
#pragma unroll
  for (int k = 0; k < 8; ++k) o[k] = v[k].x;
  if (n0 + n4 + 0 < ndst) st8bf(dst + (size_t)rowmap(n0 + n4 + 0) * K + k0 + k8, o);
#pragma unroll
  for (int k = 0; k < 8; ++k) o[k] = v[k].y;
  if (n0 + n4 + 1 < ndst) st8bf(dst + (size_t)rowmap(n0 + n4 + 1) * K + k0 + k8, o);
#pragma unroll
  for (int k = 0; k < 8; ++k) o[k] = v[k].z;
  if (n0 + n4 + 2 < ndst) st8bf(dst + (size_t)rowmap(n0 + n4 + 2) * K + k0 + k8, o);
#pragma unroll
  for (int k = 0; k < 8; ++k) o[k] = v[k].w;
  if (n0 + n4 + 3 < ndst) st8bf(dst + (size_t)rowmap(n0 + n4 + 3) * K + k0 + k8, o);
}
struct RowId { DI int operator()(int n) const { return n; } };
struct RowGU { int half; DI int operator()(int f) const { return (f >> 7) * 256 + half * 128 + (f & 127); } };

constexpr int CT_WIN = 16 * (N_INP / 256), CT_UQ = 4 * 2, CT_UKV = 2 * 2, CT_GLU = 4, CT_WB = 4 * 16, CT_WOUT = 64;
constexpr int CT_EARLY = CT_WIN + CT_UQ + CT_UKV + CT_GLU + CT_WB + CT_WOUT;
constexpr int CT_EXP = NE * 3 * 64;

DI void conv_early_item(const Params& p, int l, int it, char* smem) {
  char* we = p.ws + OFF_WEARLY + (size_t)l * WE_SIZE;
  if (it < CT_WIN) {
    int kt = it % 16, nt = it / 16;
    conv_tile(p.in[I_WIN] + (size_t)l * 1024 * N_IN, N_IN, N_IN, nullptr, (bf16*)(we + WE_WIN), 1024, kt * 64, nt * 256, smem, RowId());
    return;
  }
  it -= CT_WIN;
  if (it < CT_UQ) {
    int kt = it % 4, nt = it / 4;
    conv_tile(p.in[I_WUQ] + (size_t)l * 256 * 384, 384, 384, p.in[I_GCQ] + l * 256, (bf16*)(we + WE_UQ), 256, kt * 64, nt * 256, smem, RowId(), 384);
    return;
  }
  it -= CT_UQ;
  if (it < CT_UKV) {
    int kt = it % 2, nt = it / 2;
    conv_tile(p.in[I_WUKV] + (size_t)l * 128 * 512, 512, 512, p.in[I_GCKV] + l * 128, (bf16*)(we + WE_UKV), 128, kt * 64, nt * 256, smem, RowId());
    return;
  }
  it -= CT_UKV;
  if (it < CT_GLU) {
    int kt = it;
    conv_tile(p.in[I_S5WGLU] + (size_t)l * 256 * 256, 256, 256, nullptr, (bf16*)(we + WE_GLU), 256, kt * 64, 0, smem, RowId());
    return;
  }
  it -= CT_GLU;
  if (it < CT_WB) {
    int j = it / 16, r = it % 16, kt = r % 4, nt = r / 4;
    conv_tile(p.in[I_WBRANCH] + ((size_t)l * 4 + j) * 256 * 1024, 1024, 1024, nullptr, (bf16*)(we + WE_WB) + (size_t)j * 1024 * 256, 256, kt * 64, nt * 256, smem, RowId());
    return;
  }
  it -= CT_WB;
  {
    int kt = it % 16, nt = it / 16;
    conv_tile(p.in[I_WOUT] + (size_t)l * 1024 * 1024, 1024, 1024, nullptr, (bf16*)(we + WE_WOUT), 1024, kt * 64, nt * 256, smem, RowId());
  }
}
DI void conv_expert_item(const Params& p, int l, int it, char* smem) {
  char* wx = p.ws + OFF_MIX;
  int e = it / 192, r = it % 192, which = r / 64, t = r % 64, kt = t % 16, nt = t / 16;
  size_t eoff = ((size_t)l * NE + e) * 1024 * 1024;
  if (which == 0) { RowGU rm; rm.half = 0; conv_tile(p.in[I_WGATE] + eoff, 1024, 1024, nullptr, (bf16*)(wx + WX_GU) + (size_t)e * 2048 * 1024, 1024, kt * 64, nt * 256, smem, rm); }
  else if (which == 1) { RowGU rm; rm.half = 1; conv_tile(p.in[I_WUP] + eoff, 1024, 1024, nullptr, (bf16*)(wx + WX_GU) + (size_t)e * 2048 * 1024, 1024, kt * 64, nt * 256, smem, rm); }
  else conv_tile(p.in[I_WDOWN] + eoff, 1024, 1024, nullptr, (bf16*)(wx + WX_DN) + (size_t)e * 1024 * 1024, 1024, kt * 64, nt * 256, smem, RowId());
}

DI void mod_item(const Params& p, int it, char* smem) {
  const int l = it / 96, cg0 = (it % 96) * 64;
  float* sc = (float*)smem;
  float* red = sc + NB1 * 1024;
  const int tid = tid_();
  __syncthreads();
  for (int i = tid; i < NB1 * 1024; i += NTHREADS) {
    int r = i >> 10, k = i & 1023;
    float c = (r < BATCH) ? p.in[I_C][r * 1024 + k] : p.in[I_CCTX][k];
    sc[i] = siluf_(c);
  }
  __syncthreads();
  const int cl = tid & 63, kg = tid >> 6;
  float acc[NB1];
#pragma unroll
  for (int r = 0; r < NB1; ++r) acc[r] = 0.f;
  const float* w = p.in[I_WADA] + (size_t)l * 1024 * 6144 + cg0 + cl;
  for (int k0 = kg * (1024 / NWAVES); k0 < (kg + 1) * (1024 / NWAVES); k0 += 16) {
    float wv[16];
#pragma unroll
    for (int u = 0; u < 16; ++u) wv[u] = w[(size_t)(k0 + u) * 6144];
#pragma unroll
    for (int u = 0; u < 16; ++u)
#pragma unroll
      for (int r = 0; r < NB1; ++r) acc[r] += sc[r * 1024 + k0 + u] * wv[u];
  }
#pragma unroll
  for (int r = 0; r < NB1; ++r) red[(kg * NB1 + r) * 64 + cl] = acc[r];
  __syncthreads();
  for (int i = tid; i < NB1 * 64; i += NTHREADS) {
    int r = i >> 6, c = i & 63;
    float s = 0.f;
#pragma unroll
    for (int q = 0; q < NWAVES; ++q) s += red[(q * NB1 + r) * 64 + c];
    s += p.in[I_BADA][l * 6144 + cg0 + c];
    ((float*)(p.ws + OFF_MOD))[((size_t)l * NB1 + r) * 6144 + cg0 + c] = s;
  }
}

DI void s5_tab_item(const Params& p, int it, char* smem) {
  const int l = it / 32, d = (it / 16) & 1, g = it & 15;
  char* s5 = p.ws + OFF_S5TAB + (size_t)l * S5_SIZE;
  float* lampow = (float*)(s5 + S5_LAMPOW) + (size_t)(d * 16 + g) * 17 * 64 * 2;
  float* bbar = (float*)(s5 + S5_BBAR) + (size_t)(d * 16 + g) * 64 * 16 * 2;
  float* kt = (float*)(s5 + S5_KT) + (size_t)(d * 16 + g) * 16 * 256;
  float* slam = (float*)smem;
  float* sbb = slam + 17 * 64 * 2;
  const int tid = tid_();
  const size_t pg = ((size_t)(l * 2 + d) * 16 + g);
  const float step = expf(p.in[I_S5LOGSTEP][pg]);
  __syncthreads();
  for (int i = tid; i < 17 * 64; i += NTHREADS) {
    int j = i >> 6, pp = i & 63;
    float are = p.in[I_S5ARE][pg * 64 + pp], aim = p.in[I_S5AIM][pg * 64 + pp];
    float mag = expf((float)j * step * are), ang = (float)j * step * aim;
    float re = mag * cosf(ang), im = mag * sinf(ang);
    slam[i * 2] = re; slam[i * 2 + 1] = im; lampow[i * 2] = re; lampow[i * 2 + 1] = im;
  }
  __syncthreads();
  for (int i = tid; i < 64 * 16; i += NTHREADS) {
    int pp = i >> 4;
    float are = p.in[I_S5ARE][pg * 64 + pp], aim = p.in[I_S5AIM][pg * 64 + pp];
    float x = slam[(64 + pp) * 2] - 1.0f, y = slam[(64 + pp) * 2 + 1];
    float den = are * are + aim * aim;
    float qre = (x * are + y * aim) / den, qim = (y * are - x * aim) / den;
    float bre = p.in[I_S5BRE][pg * 1024 + i], bim = p.in[I_S5BIM][pg * 1024 + i];
    float re = qre * bre - qim * bim, im = qre * bim + qim * bre;
    sbb[i * 2] = re; sbb[i * 2 + 1] = im; bbar[i * 2] = re; bbar[i * 2 + 1] = im;
  }
  __syncthreads();
  for (int i = tid; i < 16 * 256; i += NTHREADS) {
    int j = i >> 8, c = (i >> 4) & 15, c2 = i & 15;
    float s = 0.f;
    for (int pp = 0; pp < 64; ++pp) {
      float cre = p.in[I_S5CRE][pg * 1024 + c * 64 + pp], cim = p.in[I_S5CIM][pg * 1024 + c * 64 + pp];
      float lre = slam[(j * 64 + pp) * 2], lim = slam[(j * 64 + pp) * 2 + 1];
      float tre = cre * lre - cim * lim, tim = cre * lim + cim * lre;
      float bre = sbb[(pp * 16 + c2) * 2], bim = sbb[(pp * 16 + c2) * 2 + 1];
      s += tre * bre - tim * bim;
    }
    kt[i] = s;
  }
}
DI void s5_mat_item(const Params& p, int it) {
  const int l = it / 256, g = (it / 16) & 15, q = it & 15;
  char* s5 = p.ws + OFF_S5TAB + (size_t)l * S5_SIZE;
  const float* lampow = (const float*)(s5 + S5_LAMPOW);
  const float* bbar = (const float*)(s5 + S5_BBAR);
  const float* ktab = (const float*)(s5 + S5_KT);
  bf16* WA = (bf16*)(s5 + S5_WA) + (size_t)g * 256 * 256;
  bf16* W2 = (bf16*)(s5 + S5_W2) + (size_t)g * 256 * 512;
  const int tid = tid_();
  for (int i = tid; i < 16 * 256; i += NTHREADS) {
    int n = q * 16 + (i >> 8), k = i & 255;
    int d = n >> 7, ri = (n >> 6) & 1, pp = n & 63, s = k >> 4, c2 = k & 15;
    int e = (d == 0) ? (15 - s) : s;
    const float* lp = lampow + ((size_t)((d * 16 + g) * 17 + e) * 64 + pp) * 2;
    const float* bp = bbar + ((size_t)((d * 16 + g) * 64 + pp) * 16 + c2) * 2;
    float re = lp[0] * bp[0] - lp[1] * bp[1], im = lp[0] * bp[1] + lp[1] * bp[0];
    WA[(size_t)n * 256 + k] = f2bf(ri == 0 ? re : im);
  }
  for (int i = tid; i < 16 * 512; i += NTHREADS) {
    int n = q * 16 + (i >> 9), k = i & 511;
    int lq = n >> 4, c = n & 15;
    float v;
    if (k < 256) {
      int s = k >> 4, c2 = k & 15;
      v = 0.f;
      if (s <= lq) v += ktab[((size_t)(0 * 16 + g) * 16 + (lq - s)) * 256 + c * 16 + c2];
      if (s >= lq) v += ktab[((size_t)(1 * 16 + g) * 16 + (s - lq)) * 256 + c * 16 + c2];
      if (s == lq && c == c2) v += p.in[I_S5D][l * 256 + g * 16 + c];
    } else {
      int kk = k - 256, d = kk >> 7, ri = (kk >> 6) & 1, pp = kk & 63;
      int e = (d == 0) ? (lq + 1) : (16 - lq);
      size_t pg = ((size_t)(l * 2 + d) * 16 + g);
      float cre = p.in[I_S5CRE][pg * 1024 + c * 64 + pp], cim = p.in[I_S5CIM][pg * 1024 + c * 64 + pp];
      const float* lp = lampow + ((size_t)((d * 16 + g) * 17 + e) * 64 + pp) * 2;
      float re = cre * lp[0] - cim * lp[1], im = cre * lp[1] + cim * lp[0];
      v = (ri == 0) ? re : -im;
    }
    W2[(size_t)n * 512 + k] = f2bf(v);
  }
}

DI int tok_b(int tok) { return tok / TOK; }
DI int tok_j(int tok) { return tok % TOK; }
DI int tok_modrow(int tok) { return (tok_j(tok) < CTXL) ? BATCH : tok_b(tok); }

DI void normmod_row(const float (&xv)[16], const float* g, const float* shift, const float* scale, bf16* dst, float (&hout)[16]) {
  const int lane = tid_() & 63;
  float ss = 0.f;
#pragma unroll
  for (int i = 0; i < 16; ++i) ss += xv[i] * xv[i];
  ss = wave_sum(ss);
  const float rs = rsqrtf(ss * (1.0f / 1024.f) + EPS);
#pragma unroll
  for (int i = 0; i < 4; ++i) {
    int c = lane * 4 + i * 256;
    float4 gv = *(const float4*)(g + c), sh = *(const float4*)(shift + c), sc = *(const float4*)(scale + c);
    float h0 = xv[i * 4 + 0] * rs * gv.x * (1.f + sc.x) + sh.x;
    float h1 = xv[i * 4 + 1] * rs * gv.y * (1.f + sc.y) + sh.y;
    float h2 = xv[i * 4 + 2] * rs * gv.z * (1.f + sc.z) + sh.z;
    float h3 = xv[i * 4 + 3] * rs * gv.w * (1.f + sc.w) + sh.w;
    hout[i * 4 + 0] = h0; hout[i * 4 + 1] = h1; hout[i * 4 + 2] = h2; hout[i * 4 + 3] = h3;
    *(uint2*)(dst + c) = make_uint2(pack2(h0, h1), pack2(h2, h3));
  }
}

DI void prep_row_item(const Params& p, int it) {
  const int tok = it * NWAVES + (tid_() >> 6), lane = tid_() & 63;
  const int b = tok_b(tok), j = tok_j(tok);
  const float* src = (j < CTXL) ? p.in[I_CTX] + ((size_t)b * CTXL + j) * 1024 : p.in[I_X] + ((size_t)b * SEQ + (j - CTXL)) * 1024;
  float xv[16], h[16];
#pragma unroll
  for (int i = 0; i < 4; ++i) {
    float4 v = *(const float4*)(src + lane * 4 + i * 256);
    xv[i * 4] = v.x; xv[i * 4 + 1] = v.y; xv[i * 4 + 2] = v.z; xv[i * 4 + 3] = v.w;
  }
  const float* mod = (const float*)(p.ws + OFF_MOD) + (size_t)tok_modrow(tok) * 6144;
  normmod_row(xv, p.in[I_GPREMIX], mod + 0, mod + 1024, (bf16*)(p.ws + OFF_HA) + (size_t)tok * 1024, h);
}

constexpr int IP_LT = BATCH * (SEQ / 256), IP_CT = BATCH * ((CTXL + 255) / 256), IP_MT = IP_LT + IP_CT, IP_NT = N_INP / 256;
constexpr int IP_RR = (IP_MT + 7) / 8, IP_RC = (IP_NT + 1) / 2;
constexpr int IP_RC_NOGATE = (((C_GATE + 255) / 256) + 1) / 2;
constexpr int IP_RR_LAT = IP_LT / 8;
constexpr bool IP_COMPACT = (IP_LT % 8 == 0);
constexpr int IP_RECTS_ALL = IP_RR * IP_RC, IP_RECTS_LAST = IP_COMPACT ? (IP_RR * IP_RC_NOGATE + IP_RR_LAT * (IP_RC - IP_RC_NOGATE)) : IP_RECTS_ALL;
constexpr int IP_SLOTS_ALL = ((IP_RECTS_ALL + 15) / 16) * 256, IP_SLOTS_LAST = ((IP_RECTS_LAST + 15) / 16) * 256;
DI void inproj_tile(const Params& p, const LP& L, int t, char* smem) {
  const int vb = t % 256, vround = t / 256, x = vb % 8, j = vb / 8;
  const int Rc = vround * 16 + x * 2 + (j >> 4), jj = j & 15;
  int rm, rn;
  if (!L.last || !IP_COMPACT || Rc < IP_RR * IP_RC_NOGATE) { rm = Rc % IP_RR; rn = Rc / IP_RR; }
  else { const int q = Rc - IP_RR * IP_RC_NOGATE; rm = q % IP_RR_LAT; rn = IP_RC_NOGATE + q / IP_RR_LAT; }
  const int mt = rm * 8 + (jj & 7), nt = rn * 2 + (jj >> 3);
  if (mt >= IP_MT || nt >= IP_NT || rn >= IP_RC) return;
  int m0;
  if (mt < IP_LT) m0 = (mt / (SEQ / 256)) * TOK + CTXL + (mt % (SEQ / 256)) * 256;
  else { const int c = mt - IP_LT; m0 = (c / ((CTXL + 255) / 256)) * TOK + (c % ((CTXL + 255) / 256)) * 256; }
  const int n0 = nt * 256;
  const int mv = (mt < IP_LT) ? NTOK : (m0 - (m0 % TOK) + CTXL);
  if (L.last && mt >= IP_LT && n0 >= ((C_GATE + 255) / 256) * 256) return;
  GA g = make_ga((const bf16*)(p.ws + OFF_HA), 1024, (const bf16*)(L.we + WE_WIN), 1024, 1024, mv);
  f32x4 acc[2][2][4][2];
  gemm_big(g, m0, n0, smem, acc);
  bf16* P1 = (bf16*)(p.ws + OFF_P1);
  unsigned char* PG = (unsigned char*)(p.ws + OFF_PG);
  bf16* US5 = (bf16*)(p.ws + OFF_MIX + MX_US5);
  float* DT = (float*)(p.ws + OFF_DT);
  const float* dtb = p.in[I_M2DTBIAS] + L.l * 8;
  EPIB_BEGIN(acc, m0, n0, mv)
    if (col < C_S5 || (col >= C_Z && col < C_DT)) st8bf(P1 + (size_t)row * P1W + col, v);
    else if (col < C_Z) st8bf(US5 + ((size_t)((col - C_S5) >> 4) * NTOK + row) * 16 + (col & 15), v);
    else if (col < C_GATE) {
#pragma unroll
      for (int k = 0; k < 8; ++k) v[k] = softplusf_(v[k] + dtb[k]);
      st8f(DT + (size_t)row * 8, v);
    } else if (col < N_IN) {
#pragma unroll
      for (int k = 0; k < 8; ++k) v[k] = sigmoidf_(v[k]);
      st8u8(PG + (size_t)row * 4096 + (col - C_GATE), v);
    }
  EPIB_END
}

DI void rowscale_256(const bf16* P1, int m0, int c0, int width, float* srs) {
  const int r = tid_() >> 1, hf = tid_() & 1;
  int gr = m0 + r; if (gr > NTOK - 1) gr = NTOK - 1;
  const bf16* src = P1 + (size_t)gr * P1W + c0 + hf * (width / 2);
  float ss = 0.f;
  for (int i = 0; i < width / 2; i += 8) {
    float v[8]; ld8bf(src + i, v);
#pragma unroll
    for (int k = 0; k < 8; ++k) ss += v[k] * v[k];
  }
  ss += shfl_xor_(ss, 1);
  if (hf == 0) srs[r] = rsqrtf(ss / (float)width + EPS);
}
DI void rope_tab_item(const Params& p) {
  float* tab = (float*)(p.ws + OFF_ROPE);
  for (int i = tid_(); i < 64 * 8; i += NTHREADS) {
    int pos = i >> 3, k = i & 7;
    float f = expf(-(float)k * (9.210340371976184f / 8.0f));
    float a = (float)pos * f;
    tab[i * 2] = cosf(a); tab[i * 2 + 1] = sinf(a);
  }
}
DI void rope_cs(const float* tab, int pos, int i, float& c, float& s) { c = tab[(pos * 8 + i) * 2]; s = tab[(pos * 8 + i) * 2 + 1]; }

constexpr int TP_MT = (NTOK + 255) / 256;
DI void mlaq_tile(const Params& p, const LP& L, int t, char* smem) {
  const int mt = t % TP_MT, nt = t / TP_MT, m0 = mt * 256, n0 = nt * 128;
  const bf16* P1 = (const bf16*)(p.ws + OFF_P1);
  float* srs = (float*)(smem + SRS_OFF);
  GA g = make_ga(P1 + C_CQ, P1W, (const bf16*)(L.we + WE_UQ), 256, 256, NTOK);
  f32x4 acc[4][4];
  gemm_s<4>(g, m0, n0, smem, acc);
  rowscale_256(P1, m0, C_CQ, 256, srs);
  __syncthreads();
  bf16* Q = (bf16*)(p.ws + OFF_MIX + MX_Q);
  const float* ropetab = (const float*)(p.ws + OFF_ROPE);
  {
    const int l = tid_() & 63, w = tid_() >> 6, wr = w >> 1, wc = w & 1, fr = l & 15, fq = l >> 4;
#pragma unroll
    for (int m = 0; m < 4; ++m) {
      const int row = m0 + wr * 64 + m * 16 + fr;
      const int rowc = row < NTOK ? row : NTOK - 1;
      const float rsc = srs[rowc - m0];
      const int b = tok_b(rowc), j = tok_j(rowc);
#pragma unroll
      for (int q = 0; q < 2; ++q) {
        const int col = n0 + wc * 64 + q * 32 + 8 * fq;
        const int h = col / 96, dd = col % 96;
        float v[8] = {acc[m][2 * q][0], acc[m][2 * q][1], acc[m][2 * q][2], acc[m][2 * q][3], acc[m][2 * q + 1][0], acc[m][2 * q + 1][1], acc[m][2 * q + 1][2], acc[m][2 * q + 1][3]};
        float vp[8];
#pragma unroll
        for (int k = 0; k < 8; ++k) vp[k] = shfl_xor_(v[k], 16);
        if (dd >= 64 && j >= CTXL) {
          const int tl = j - CTXL, pos = ((dd - 64) < 16) ? (tl / GRID_W) : (tl % GRID_W);
          const bool lo = ((dd & 8) == 0);
#pragma unroll
          for (int k = 0; k < 8; ++k) {
            float c, sn; rope_cs(ropetab, pos, k, c, sn);
            v[k] = lo ? (v[k] * c - vp[k] * sn) : (v[k] * c + vp[k] * sn);
          }
        }
#pragma unroll
        for (int k = 0; k < 8; ++k) v[k] *= rsc;
        if (row < NTOK) st8bf(Q + (((size_t)b * 4 + h) * TOK + j) * 96 + dd, v);
      }
    }
  }
}
DI void mlakv_tile(const Params& p, const LP& L, int t, char* smem) {
  const int mt = t % TP_MT, h = t / TP_MT, m0 = mt * 256, n0 = h * 128;
  const bf16* P1 = (const bf16*)(p.ws + OFF_P1);
  float* srs = (float*)(smem + SRS_OFF);
  GA g = make_ga(P1 + C_CKV, P1W, (const bf16*)(L.we + WE_UKV), 128, 128, NTOK);
  f32x4 acc[4][4];
  gemm_s<4>(g, m0, n0, smem, acc);
  rowscale_256(P1, m0, C_CKV, 128, srs);
  __syncthreads();
  bf16* K = (bf16*)(p.ws + OFF_MIX + MX_K);
  bf16* VT = (bf16*)(p.ws + OFF_MIX + MX_VTM);
  const float* ropetab = (const float*)(p.ws + OFF_ROPE);
  EPI_BEGIN(4, acc, m0, n0, NTOK)
    const float rsc = srs[row - m0];
    const int b = tok_b(row), j = tok_j(row), dd = col - n0;
#pragma unroll
    for (int k = 0; k < 8; ++k) v[k] *= rsc;
    if (dd < 64) st8bf(K + (((size_t)b * 4 + h) * TOK + j) * 96 + dd, v);
    else {
#pragma unroll
      for (int k = 0; k < 8; ++k) VT[(((size_t)b * 4 + h) * 64 + (dd - 64 + k)) * TOK + j] = f2bf(v[k]);
    }
  EPI_END
  for (int i = tid_(); i < 256 * 16; i += NTHREADS) {
    int r = i >> 4, q = i & 15;
    int row = m0 + r;
    if (row < NTOK) {
      int b = tok_b(row), j = tok_j(row);
      int blk = q >> 3, i8 = q & 7;
      float x1 = bf2f(P1[(size_t)row * P1W + C_KR + blk * 16 + i8]), x2 = bf2f(P1[(size_t)row * P1W + C_KR + blk * 16 + i8 + 8]);
      float o1 = x1, o2 = x2;
      if (j >= CTXL) {
        int tl = j - CTXL, pos = blk == 0 ? (tl / GRID_W) : (tl % GRID_W);
        float c, sn; rope_cs(ropetab, pos, i8, c, sn);
        o1 = x1 * c - x2 * sn; o2 = x2 * c + x1 * sn;
      }
      bf16* kd = K + (((size_t)b * 4 + h) * TOK + j) * 96 + 64 + blk * 16 + i8;
      kd[0] = f2bf(o1); kd[8] = f2bf(o2);
    }
  }
}
DI void navt_item(const Params& p, int it, char* smem) {
  bf16* s = (bf16*)smem;
  const bf16* P1 = (const bf16*)(p.ws + OFF_P1);
  bf16* VT = (bf16*)(p.ws + OFF_MIX + MX_VTN);
  const int tok0 = it * 64, tid = tid_();
  const int b = tok_b(tok0), j0 = tok_j(tok0);
  __syncthreads();
  for (int i = tid; i < 64 * 32; i += NTHREADS) {
    int r = i >> 5, c8 = i & 31;
    *(uint4*)(s + r * 264 + c8 * 8) = *(const uint4*)(P1 + (size_t)(tok0 + r) * P1W + C_NA + 512 + c8 * 8);
  }
  __syncthreads();
  for (int i = tid; i < 256 * 8; i += NTHREADS) {
    int ch = i >> 3, t8 = i & 7;
    unsigned w[4];
#pragma unroll
    for (int q = 0; q < 4; ++q) w[q] = (unsigned)s[(t8 * 8 + 2 * q) * 264 + ch] | ((unsigned)s[(t8 * 8 + 2 * q + 1) * 264 + ch] << 16);
    *(uint4*)(VT + ((size_t)b * 256 + ch) * TOK + j0 + t8 * 8) = make_uint4(w[0], w[1], w[2], w[3]);
  }
}
constexpr int M2C_TOK = 128, M2C_ITEMS = NTOK / M2C_TOK;
DI void m2conv_item(const Params& p, const LP& L, int it) {
  const bf16* P1 = (const bf16*)(p.ws + OFF_P1);
  bf16* XB = (bf16*)(p.ws + OFF_MIX + MX_XBC);
  const int tok0 = it * M2C_TOK;
  const float* cw = p.in[I_M2CONVW] + (size_t)L.l * 4 * 768;
  const float* cb = p.in[I_M2CONVB] + (size_t)L.l * 768;
  for (int task = tid_(); task < 96 * (M2C_TOK / 8); task += NTHREADS) {
    const int cg = task % 96, tb = task / 96, c0 = cg * 8;
    const int tokb = tok0 + tb * 8, jt = tok_j(tokb), base = tokb - jt;
    const int slo = (jt < CTXL) ? 0 : CTXL, shi = (jt < CTXL) ? CTXL : TOK;
    float w[4][8], bias[8];
#pragma unroll
    for (int k = 0; k < 4; ++k) { float4 a = *(const float4*)(cw + k * 768 + c0), b4 = *(const float4*)(cw + k * 768 + c0 + 4);
      w[k][0] = a.x; w[k][1] = a.y; w[k][2] = a.z; w[k][3] = a.w; w[k][4] = b4.x; w[k][5] = b4.y; w[k][6] = b4.z; w[k][7] = b4.w; }
    { float4 a = *(const float4*)(cb + c0), b4 = *(const float4*)(cb + c0 + 4);
      bias[0] = a.x; bias[1] = a.y; bias[2] = a.z; bias[3] = a.w; bias[4] = b4.x; bias[5] = b4.y; bias[6] = b4.z; bias[7] = b4.w; }
    float xin[11][8];
#pragma unroll
    for (int r = 0; r < 11; ++r) {
      const int j = jt - 2 + r;
      if (j >= slo && j < shi) ld8bf(P1 + (size_t)(base + j) * P1W + C_XBC + c0, xin[r]);
      else {
#pragma unroll
        for (int c = 0; c < 8; ++c) xin[r][c] = 0.f;
      }
    }
    float y[8][8];
#pragma unroll
    for (int t = 0; t < 8; ++t) {
#pragma unroll
      for (int c = 0; c < 8; ++c) y[t][c] = siluf_(bias[c] + w[0][c] * xin[t][c] + w[1][c] * xin[t + 1][c] + w[2][c] * xin[t + 2][c] + w[3][c] * xin[t + 3][c]);
      st8bf(XB + (size_t)(base + jt + t) * 768 + c0, y[t]);
    }
    if (c0 < 512) {
      bf16* XT = (bf16*)(p.ws + OFF_MIX + MX_XBT) + ((size_t)(base / TOK) * 512 + c0) * TOK + jt;
#pragma unroll
      for (int c = 0; c < 8; ++c) {
        float col[8];
#pragma unroll
        for (int t = 0; t < 8; ++t) col[t] = y[t][c];
        st8bf(XT + (size_t)c * TOK, col);
      }
    }
  }
}
DI int m2_seq2tok(int sq, int dir) { return (dir == 0) ? sq : (sq < CTXL ? (CTXL - 1 - sq) : (TOK - 1 - (sq - CTXL))); }
constexpr int M2S_ITEMS = BATCH * 8 * (TOK / 64) / NWAVES;
DI void m2scal_item(const Params& p, const LP& L, int it) {
  const int w = it * NWAVES + (tid_() >> 6), lane = tid_() & 63;
  const int ch = w % (TOK / 64), r = w / (TOK / 64), hd = r & 3, dir = (r >> 2) & 1, b = r >> 3;
  const float a = -expf(p.in[I_M2ALOG][(L.l * 2 + dir) * 4 + hd]);
  const int sq = ch * 64 + lane, j = m2_seq2tok(sq, dir);
  const float dt = ((const float*)(p.ws + OFF_DT))[((size_t)b * TOK + j) * 8 + dir * 4 + hd];
  float cs = dt * a;
#pragma unroll
  for (int d = 1; d < 64; d <<= 1) { float o = shfl_up_(cs, d); if (lane >= d) cs += o; }
  const float sl = shfl_(cs, 63);
  float* o = (float*)(p.ws + OFF_MIX + MX_M2S) + ((size_t)((b * 2 + dir) * 4 + hd) * TOK + sq) * 4;
  *(float4*)o = make_float4(cs, dt, dt * __expf(sl - cs), cs * 1.4426950408889634f - log2f(dt));
}
constexpr int S5_MT = (MCH + 255) / 256;
DI void s5a_tile(const Params& p, const LP& L, int t, char* smem) {
  const int g = t / (S5_MT * 2), r = t % (S5_MT * 2), mt = r / 2, nt = r % 2;
  const int m0 = mt * 256, n0 = nt * 128;
  GA ga = make_ga((const bf16*)(p.ws + OFF_MIX + MX_US5) + (size_t)g * NTOK * 16, 256, (const bf16*)(L.s5 + S5_WA) + (size_t)g * 65536, 256, 256, MCH);
  f32x4 acc[4][4];
  gemm_s<4>(ga, m0, n0, smem, acc);
  float* HE = (float*)(p.ws + OFF_MIX + MX_HEND) + (size_t)g * MCH * 256;
  EPI_BEGIN(4, acc, m0, n0, MCH)
    st8f(HE + (size_t)row * 256 + col, v);
  EPI_END
}
DI int s5_chunk_of(int i, int d) { return (d == 0) ? i : (i < NCC ? (NCC - 1 - i) : (NCH - 1 - (i - NCC))); }
DI void s5carry_item(const Params& p, const LP& L, int it) {
  const int w = it * NWAVES + (tid_() >> 6), lane = tid_() & 63;
  const int d = w / (16 * BATCH), g = (w / BATCH) & 15, b = w % BATCH;
  const float* lp = (const float*)(L.s5 + S5_LAMPOW) + ((size_t)((d * 16 + g) * 17 + 16) * 64 + lane) * 2;
  const float lre = lp[0], lim = lp[1];
  const float* HE = (const float*)(p.ws + OFF_MIX + MX_HEND) + ((size_t)g * MCH + (size_t)b * NCH) * 256 + d * 128;
  bf16* HI = (bf16*)(p.ws + OFF_MIX + MX_HIN) + ((size_t)g * MCH + (size_t)b * NCH) * 256 + d * 128;
  float cre = 0.f, cim = 0.f;
  constexpr int SB = 16;
  float are[SB], aim[SB], bre[SB], bim[SB];
#define S5_LOAD(RE_, IM_, I0_) { _Pragma("unroll") for (int k_ = 0; k_ < SB; ++k_) { const int ii_ = (I0_) + k_; \
    if (ii_ < NCH) { const int ch_ = s5_chunk_of(ii_, d); RE_[k_] = HE[(size_t)ch_ * 256 + lane]; IM_[k_] = HE[(size_t)ch_ * 256 + 64 + lane]; } } }
#define S5_STEP(RE_, IM_, I0_) { _Pragma("unroll") for (int k_ = 0; k_ < SB; ++k_) { const int ii_ = (I0_) + k_; \
    if (ii_ < NCH) { const int ch_ = s5_chunk_of(ii_, d); \
      HI[(size_t)ch_ * 256 + lane] = f2bf(cre); HI[(size_t)ch_ * 256 + 64 + lane] = f2bf(cim); \
      const float nre_ = lre * cre - lim * cim + RE_[k_], nim_ = lre * cim + lim * cre + IM_[k_]; \
      cre = nre_; cim = nim_; } } }
#pragma unroll
  for (int k = 0; k < SB; ++k) { are[k] = 0.f; aim[k] = 0.f; bre[k] = 0.f; bim[k] = 0.f; }
  S5_LOAD(are, aim, 0)
  for (int i0 = 0; i0 < NCH; i0 += 2 * SB) {
    S5_LOAD(bre, bim, i0 + SB)
    S5_STEP(are, aim, i0)
    S5_LOAD(are, aim, i0 + 2 * SB)
    S5_STEP(bre, bim, i0 + SB)
  }
#undef S5_LOAD
#undef S5_STEP
}
DI void s5c_tile(const Params& p, const LP& L, int t, char* smem) {
  const int g = t / (S5_MT * 2), r = t % (S5_MT * 2), mt = r / 2, nt = r % 2;
  const int m0 = mt * 256, n0 = nt * 128;
  GA ga = make_ga((const bf16*)(p.ws + OFF_MIX + MX_US5) + (size_t)g * NTOK * 16, 256, (const bf16*)(L.s5 + S5_W2) + (size_t)g * 256 * 512, 512, 512, MCH);
  ga.A2 = (const bf16*)(p.ws + OFF_MIX + MX_HIN) + (size_t)g * MCH * 256; ga.lda2 = 256; ga.ksplit = 256;
  f32x4 acc[4][4];
  gemm_s<4>(ga, m0, n0, smem, acc);
  bf16* Z = (bf16*)(p.ws + OFF_MIX + MX_Z);
  EPI_BEGIN(4, acc, m0, n0, MCH)
#pragma unroll
    for (int k = 0; k < 8; ++k) v[k] = geluf_(v[k]);
    st8bf(Z + ((size_t)row * 16 + (col >> 4)) * 256 + g * 16 + (col & 15), v);
  EPI_END
}

#ifdef EMU
DI float fmax_(float a, float b) { return a > b ? a : b; }
#else
DI float fmax_(float a, float b) { return __builtin_fmaxf(a, b); }
#endif
constexpr int AT_LDV = 76;
struct NaInfo { int r, qc, rs, cs; };
template <int DK, bool NA>
DI void attn_block(const bf16* qrow, bool active, const bf16* Kp, int kstride, const bf16* Vt,
                   int ka0, int ntile_a, int arow0, int kb0, int ntile_b,
                   const float* srpb, NaInfo ni, float scale, bf16* orow, char* smem) {
  constexpr int LDK = DK + 8, KCH = DK / 8;
  constexpr int KT_BYTES = 64 * LDK * 2, VT_BYTES = 64 * AT_LDV * 2;
  constexpr int NKL = (64 * KCH + NTHREADS - 1) / NTHREADS;
  const int tid = tid_(), lane = tid & 63, half = lane >> 5, r = lane & 31;
  bf16* sK = (bf16*)smem;
  bf16* sV = (bf16*)(smem + 2 * KT_BYTES);
  bf16x8 qf[DK / 16];
  f32x16 o0, o1;
  float m = -1e30f, l = 0.f;
  const float scale2 = scale * 1.4426950408889634f;
#pragma unroll
  for (int ks = 0; ks < DK / 16; ++ks) qf[ks] = active ? *(const bf16x8*)(qrow + ks * 16 + 8 * half) : bf16x8{0, 0, 0, 0, 0, 0, 0, 0};
#pragma unroll
  for (int i = 0; i < 16; ++i) { o0[i] = 0.f; o1[i] = 0.f; }
  const int NTL = ntile_a + ntile_b;
  u32x4 rk[NKL], rv[1];
#pragma unroll
  for (int i = 0; i < NKL; ++i) rk[i] = u32x4{0u, 0u, 0u, 0u};
  auto key0_of = [&](int t) { return t < ntile_a ? ka0 + 64 * t : kb0 + 64 * (t - ntile_a); };
#define AT_GLOAD(t_) { const int k0_ = key0_of(t_); \
    _Pragma("unroll") for (int i_ = 0; i_ < NKL; ++i_) { const int c_ = tid + i_ * NTHREADS; const int key_ = c_ / KCH, ch_ = c_ % KCH; \
      if (c_ < 64 * KCH) rk[i_] = *(const u32x4*)(Kp + (size_t)(k0_ + key_) * kstride + ch_ * 8); } \
    { const int d_ = tid >> 3, ch_ = tid & 7; rv[0] = *(const u32x4*)(Vt + (size_t)d_ * TOK + k0_ + ch_ * 8); } }
#define AT_SSTORE(buf_) { \
    _Pragma("unroll") for (int i_ = 0; i_ < NKL; ++i_) { const int c_ = tid + i_ * NTHREADS; const int key_ = c_ / KCH, ch_ = c_ % KCH; \
      if (c_ < 64 * KCH) *(u32x4*)(sK + (buf_) * (64 * LDK) + key_ * LDK + ch_ * 8) = rk[i_]; } \
    { const int d_ = tid >> 3, ch_ = tid & 7; \
      bf16* dst_ = sV + (buf_) * (64 * AT_LDV) + d_ * AT_LDV + ch_ * 8; \
      *(uint2*)dst_ = make_uint2(rv[0][0], rv[0][1]); *(uint2*)(dst_ + 4) = make_uint2(rv[0][2], rv[0][3]); } }
  __syncthreads();
  AT_GLOAD(0) AT_SSTORE(0)
  __syncthreads();
#pragma unroll 1
  for (int t = 0; t < NTL; ++t) {
    const int buf = t & 1;
    if (t + 1 < NTL) AT_GLOAD(t + 1)
    bool doit = active;
    int trow0 = 0;
    if (NA && t < ntile_a) {
      trow0 = arow0 + t * (64 / GRID_W);
      doit = active && (trow0 + (64 / GRID_W) > ni.rs) && (trow0 < ni.rs + WIN_R);
    }
    if (doit) {
      const bf16* kb = sK + buf * (64 * LDK);
      const bf16* vb = sV + buf * (64 * AT_LDV);
      f32x16 s0, s1;
#pragma unroll
      for (int i = 0; i < 16; ++i) { s0[i] = 0.f; s1[i] = 0.f; }
      bf16x8 ka0[DK / 16], ka1[DK / 16];
#pragma unroll
      for (int ks = 0; ks < DK / 16; ++ks) {
        ka0[ks] = *(const bf16x8*)(kb + r * LDK + ks * 16 + 8 * half);
        ka1[ks] = *(const bf16x8*)(kb + (32 + r) * LDK + ks * 16 + 8 * half);
      }
      BG_SCHED;
#pragma unroll
      for (int ks = 0; ks < DK / 16; ++ks) {
        s0 = __builtin_amdgcn_mfma_f32_32x32x16_bf16(ka0[ks], qf[ks], s0, 0, 0, 0);
        s1 = __builtin_amdgcn_mfma_f32_32x32x16_bf16(ka1[ks], qf[ks], s1, 0, 0, 0);
      }
      uint2 va0[4], va1[4], vb0[4], vb1[4];
#pragma unroll
      for (int kq = 0; kq < 4; ++kq) {
        const bf16* v0 = vb + r * AT_LDV + 16 * kq + 4 * half;
        const bf16* v1 = vb + (r + 32) * AT_LDV + 16 * kq + 4 * half;
        va0[kq] = *(const uint2*)v0; va1[kq] = *(const uint2*)(v0 + 8); vb0[kq] = *(const uint2*)v1; vb1[kq] = *(const uint2*)(v1 + 8);
      }
      BG_SCHED;
      float mx = -INFINITY;
      if (NA && t < ntile_a) {
#pragma unroll
        for (int i = 0; i < 16; ++i) {
          const int kk = (i & 3) + 8 * (i >> 2) + 4 * half;
#pragma unroll
          for (int hb = 0; hb < 2; ++hb) {
            const int kq = kk + 32 * hb;
            const int kr = trow0 + kq / GRID_W, kc = kq % GRID_W;
            const bool ok = (kr >= ni.rs) && (kr < ni.rs + WIN_R) && (kc >= ni.cs) && (kc < ni.cs + WIN_C);
            const float bias = ok ? srpb[(kr - ni.r + 7) * 31 + (kc - ni.qc + 15)] * 1.4426950408889634f : -INFINITY;
            if (hb == 0) { s0[i] = s0[i] * scale2 + bias; mx = fmax_(mx, s0[i]); }
            else { s1[i] = s1[i] * scale2 + bias; mx = fmax_(mx, s1[i]); }
          }
        }
      } else {
        s0 = s0 * scale2; s1 = s1 * scale2;
#pragma unroll
        for (int i = 0; i < 16; ++i) mx = fmax_(mx, fmax_(s0[i], s1[i]));
      }
      mx = fmax_(mx, shfl_xor_(mx, 32));
      const float mn = fmax_(m, mx);
      const float alpha = exp2f_(m - mn);
      const bool same = (mn == m);
      m = mn;
      float ps = 0.f;
      { const float nmn = -mn; s0 = s0 + nmn; s1 = s1 + nmn; }
#pragma unroll
      for (int i = 0; i < 16; ++i) { s0[i] = exp2f_(s0[i]); s1[i] = exp2f_(s1[i]); }
      { const f32x16 st = s0 + s1;
        ps = ((st[0] + st[1]) + (st[2] + st[3])) + ((st[4] + st[5]) + (st[6] + st[7])) + (((st[8] + st[9]) + (st[10] + st[11])) + ((st[12] + st[13]) + (st[14] + st[15]))); }
      l = l * alpha + ps;
      if (!wave_all_(same)) {
#pragma unroll
        for (int i = 0; i < 16; ++i) { o0[i] *= alpha; o1[i] *= alpha; }
      }
#pragma unroll
      for (int kq = 0; kq < 4; ++kq) {
        u32x4 pw;
#pragma unroll
        for (int j = 0; j < 4; ++j) pw[j] = (kq < 2) ? pack2(s0[8 * (kq & 1) + 2 * j], s0[8 * (kq & 1) + 2 * j + 1]) : pack2(s1[8 * (kq & 1) + 2 * j], s1[8 * (kq & 1) + 2 * j + 1]);
        const bf16x8 pf = __builtin_bit_cast(bf16x8, pw);
        const uint2 a0 = va0[kq], a1 = va1[kq], b0 = vb0[kq], b1 = vb1[kq];
        bf16x8 va, vbb;
        va[0] = (short)(a0.x & 0xffff); va[1] = (short)(a0.x >> 16); va[2] = (short)(a0.y & 0xffff); va[3] = (short)(a0.y >> 16);
        va[4] = (short)(a1.x & 0xffff); va[5] = (short)(a1.x >> 16); va[6] = (short)(a1.y & 0xffff); va[7] = (short)(a1.y >> 16);
        vbb[0] = (short)(b0.x & 0xffff); vbb[1] = (short)(b0.x >> 16); vbb[2] = (short)(b0.y & 0xffff); vbb[3] = (short)(b0.y >> 16);
        vbb[4] = (short)(b1.x & 0xffff); vbb[5] = (short)(b1.x >> 16); vbb[6] = (short)(b1.y & 0xffff); vbb[7] = (short)(b1.y >> 16);
        o0 = __builtin_amdgcn_mfma_f32_32x32x16_bf16(va, pf, o0, 0, 0, 0);
        o1 = __builtin_amdgcn_mfma_f32_32x32x16_bf16(vbb, pf, o1, 0, 0, 0);
      }
    }
    if (t + 1 < NTL) AT_SSTORE(buf ^ 1)
    __syncthreads();
  }
  if (active) {
    const float lt = l + shfl_xor_(l, 32);
    const float inv = rcp_(lt);
#pragma unroll
    for (int gI = 0; gI < 4; ++gI) {
      const int d0 = 8 * gI + 4 * half;
      *(uint2*)(orow + d0) = make_uint2(pack2(o0[4 * gI] * inv, o0[4 * gI + 1] * inv), pack2(o0[4 * gI + 2] * inv, o0[4 * gI + 3] * inv));
      *(uint2*)(orow + 32 + d0) = make_uint2(pack2(o1[4 * gI] * inv, o1[4 * gI + 1] * inv), pack2(o1[4 * gI + 2] * inv, o1[4 * gI + 3] * inv));
    }
  }
}
DI void mla_attn_item(const Params& p, int it, bool ctxq, char* smem) {
  const int nqb = ctxq ? (CTXL + 255) / 256 : SEQ / 256;
  const int b = it / (4 * nqb), h = (it / nqb) & 3, qb = it % nqb;
  const int lane = tid_() & 63, wid = tid_() >> 6;
  const int nq = ctxq ? CTXL : SEQ, q0 = qb * 256 + wid * 32;
  const bool active = q0 < nq;
  const int jq = (ctxq ? 0 : CTXL) + (active ? q0 : 0) + (lane & 31);
  const bf16* Q = (const bf16*)(p.ws + OFF_MIX + MX_Q) + ((size_t)b * 4 + h) * TOK * 96;
  const bf16* K = (const bf16*)(p.ws + OFF_MIX + MX_K) + ((size_t)b * 4 + h) * TOK * 96;
  const bf16* VT = (const bf16*)(p.ws + OFF_MIX + MX_VTM) + ((size_t)b * 4 + h) * 64 * TOK;
  bf16* O = (bf16*)(p.ws + OFF_O) + ((size_t)b * TOK + jq) * 1024 + 0 * 256 + h * 64;
  NaInfo ni; ni.r = 0; ni.qc = 0; ni.rs = 0; ni.cs = 0;
  attn_block<96, false>(Q + (size_t)jq * 96, active, K, 96, VT, 0, 0, 0, 0, (ctxq ? CTXL : TOK) / 64, nullptr, ni, 0.10206207261596577f, O, smem);
}
DI void na_attn_item(const Params& p, const LP& L, int it, bool ctxq, char* smem) {
  const int nqb = ctxq ? (CTXL + 255) / 256 : SEQ / 256;
  const int b = it / (4 * nqb), h = (it / nqb) & 3, qb = it % nqb;
  const int tid = tid_(), lane = tid & 63, wid = tid >> 6;
  const int nq = ctxq ? CTXL : SEQ, q0 = qb * 256 + wid * 32;
  const bool active = q0 < nq;
  const int jq = (ctxq ? 0 : CTXL) + (active ? q0 : 0) + (lane & 31);
  const bf16* P1 = (const bf16*)(p.ws + OFF_P1) + (size_t)b * TOK * P1W;
  const bf16* VT = (const bf16*)(p.ws + OFF_MIX + MX_VTN) + ((size_t)b * 4 + h) * 64 * TOK;
  const bf16* Kb = P1 + C_NA + 256 + h * 64;
  bf16* O = (bf16*)(p.ws + OFF_O) + ((size_t)b * TOK + jq) * 1024 + 1 * 256 + h * 64;
  constexpr int AT_END64 = 2 * (64 * 72 * 2) + 2 * (64 * AT_LDV * 2);
  float* srpb = (float*)(smem + AT_END64);
  NaInfo ni; ni.r = 0; ni.qc = 0; ni.rs = 0; ni.cs = 0;
  int ka0 = 0, nta = 0, arow0 = 0;
  if (!ctxq) {
    __syncthreads();
    const float* rpb = p.in[I_RPB] + ((size_t)L.l * 4 + h) * 15 * 31;
    for (int i = tid; i < 15 * 31; i += NTHREADS) srpb[i] = rpb[i];
    const int tl = q0 + (lane & 31);
    ni.r = tl / GRID_W; ni.qc = tl % GRID_W;
    int rs = ni.r - WIN_R / 2; rs = rs < 0 ? 0 : (rs > ROWS - WIN_R ? ROWS - WIN_R : rs);
    int cs = ni.qc - WIN_C / 2; cs = cs < 0 ? 0 : (cs > GRID_W - WIN_C ? GRID_W - WIN_C : cs);
    ni.rs = rs; ni.cs = cs;
    constexpr int RPT = 64 / GRID_W;
    const int rfirst = (qb * 256) / GRID_W, rlast = (qb * 256 + 255) / GRID_W;
    int rs_f = rfirst - WIN_R / 2; rs_f = rs_f < 0 ? 0 : (rs_f > ROWS - WIN_R ? ROWS - WIN_R : rs_f);
    int rs_l = rlast - WIN_R / 2; rs_l = rs_l < 0 ? 0 : (rs_l > ROWS - WIN_R ? ROWS - WIN_R : rs_l);
    arow0 = (rs_f / RPT) * RPT;
    const int row_hi = rs_l + WIN_R;
    nta = (row_hi - arow0 + RPT - 1) / RPT;
    ka0 = CTXL + arow0 * GRID_W;
  }
  attn_block<64, true>(P1 + (size_t)jq * P1W + C_NA + h * 64, active, Kb, P1W, VT, ka0, nta, arow0, 0, CTXL / 64, srpb, ni, 0.125f, O, smem);
}

constexpr int M2_LDB = 136, M2_LDX = 72;
constexpr int M2_OFF_B = 0;
constexpr int M2_OFF_C = M2_OFF_B + 64 * M2_LDB * 2;
constexpr int M2_OFF_HD = M2_OFF_C + 64 * M2_LDB * 2;
constexpr int M2H_H = 0;
constexpr int M2H_XT = M2H_H + 64 * M2_LDB * 2;
constexpr int M2H_BT = M2H_XT + 64 * M2_LDX * 2;
constexpr int M2H_S = M2H_BT + 128 * M2_LDX * 2;
constexpr int M2H_X = M2H_S + 3 * 64 * 4;
constexpr int M2H_SIZE = M2H_X + 64 * M2_LDX * 2;
constexpr int M2_SMEM = M2_OFF_HD + 2 * M2H_SIZE;
static_assert(M2_SMEM <= SMEM_BYTES, "m2 smem");
DI u32x4 rev8_(u32x4 v) {
  return u32x4{(v[3] >> 16) | (v[3] << 16), (v[2] >> 16) | (v[2] << 16), (v[1] >> 16) | (v[1] << 16), (v[0] >> 16) | (v[0] << 16)};
}
DI void m2scan_item(const Params& p, const LP& L, int it, char* smem) {
  const int b = it / 8, grp = (it >> 2) & 1, dir = (it >> 1) & 1, seg1 = it & 1;
  const int cbeg = seg1 ? M2_SPLIT : 0, cend = seg1 ? TOK : M2_SPLIT;
  const int tid = tid_(), lane = tid & 63, wid = tid >> 6, half = lane >> 5, r = lane & 31;
  const int hsel = wid >> 2, wl = wid & 3, hd = grp * 2 + hsel;
  bf16* sB = (bf16*)(smem + M2_OFF_B);
  bf16* sC = (bf16*)(smem + M2_OFF_C);
  char* hb = smem + M2_OFF_HD + hsel * M2H_SIZE;
  bf16* sH = (bf16*)(hb + M2H_H);
  bf16* sXT = (bf16*)(hb + M2H_XT);
  bf16* sBT = (bf16*)(hb + M2H_BT);
  float* sS = (float*)(hb + M2H_S);
  float* sDt = sS + 64;
  float* sW = sS + 128;
  const bf16* XB = (const bf16*)(p.ws + OFF_MIX + MX_XBC) + (size_t)b * TOK * 768;
  const bf16* XT = (const bf16*)(p.ws + OFF_MIX + MX_XBT) + (size_t)b * 512 * TOK;
  const float* SC = (const float*)(p.ws + OFF_MIX + MX_M2S) + (size_t)((b * 2 + dir) * 4 + hd) * TOK * 4;
  float* YM = (float*)(p.ws + OFF_HA) + ((size_t)dir * NTOK + (size_t)b * TOK) * 256;
  const int pb = wl & 1, tb = wl >> 1, nb0 = 2 * (wl >> 1);
  f32x16 hst[2];
#pragma unroll
  for (int i = 0; i < 16; ++i) { hst[0][i] = 0.f; hst[1][i] = 0.f; }
  __syncthreads();
  for (int i = tid; i < 2 * M2H_SIZE / 4; i += NTHREADS) ((unsigned*)(smem + M2_OFF_HD))[i] = 0u;
  __syncthreads();
  u32x4 rxt[2], rbt[2], rb[2], rc[2];
  float4 rsc = make_float4(0.f, 0.f, 0.f, 0.f);
#define M2_TLOAD(rowptr_, sq0_) (*(const u32x4*)((rowptr_) + ((dir == 0) ? (sq0_) : m2_seq2tok((sq0_) + 7, 1))))
#define M2_GLOAD(c0_) { \
    _Pragma("unroll") for (int q_ = 0; q_ < 2; ++q_) { const int i_ = tid + q_ * NTHREADS; const int h2_ = i_ >> 9, t8_ = ((i_ >> 6) & 7) * 8, pp_ = i_ & 63; \
      rxt[q_] = M2_TLOAD(XT + (size_t)((grp * 2 + h2_) * 64 + pp_) * TOK, (c0_) + t8_); } \
    _Pragma("unroll") for (int q_ = 0; q_ < 2; ++q_) { const int i_ = tid + q_ * NTHREADS; const int t8_ = (i_ >> 7) * 8, nn_ = i_ & 127; \
      rbt[q_] = M2_TLOAD(XT + (size_t)(256 + grp * 128 + nn_) * TOK, (c0_) + t8_); } \
    _Pragma("unroll") for (int q_ = 0; q_ < 2; ++q_) { const int i_ = tid + q_ * NTHREADS; const int t_ = i_ >> 4, n8_ = (i_ & 15) * 8; \
      const bf16* src_ = XB + (size_t)m2_seq2tok((c0_) + t_, dir) * 768 + grp * 128 + n8_; \
      rb[q_] = *(const u32x4*)(src_ + 256); rc[q_] = *(const u32x4*)(src_ + 512); } \
    if (wl == 0) rsc = *(const float4*)(SC + (size_t)((c0_) + lane) * 4); }
  M2_GLOAD(cbeg)
  float* GT = (float*)(p.ws + OFF_MIX + MX_GT) + (size_t)((b * 2 + dir) * 4 + hd) * M2_REST;
  float lcum = 0.f;
  for (int c0 = cbeg; c0 < cend; c0 += 64) {
    if (wl == 0) {
      sS[lane] = rsc.x; sDt[lane] = rsc.w; sW[lane] = rsc.z;
      if (seg1) { GT[c0 - M2_SPLIT + lane] = rsc.x + lcum; lcum += shfl_(rsc.x, 63); }
    }
    __syncthreads();
#pragma unroll
    for (int q2 = 0; q2 < 2; ++q2) {
      const int i = tid + q2 * NTHREADS; const int h2 = i >> 9, t8 = ((i >> 6) & 7) * 8, pp = i & 63;
      *(u32x4*)((bf16*)(smem + M2_OFF_HD + h2 * M2H_SIZE + M2H_XT) + pp * M2_LDX + t8) = dir ? rev8_(rxt[q2]) : rxt[q2];
    }
#pragma unroll
    for (int q4 = 0; q4 < 2; ++q4) {
      const int i = tid + q4 * NTHREADS; const int t = i >> 4, n8 = (i & 15) * 8;
      *(u32x4*)(sB + t * M2_LDB + n8) = rb[q4];
      *(u32x4*)(sC + t * M2_LDB + n8) = rc[q4];
    }
#pragma unroll
    for (int q4 = 0; q4 < 2; ++q4) {
      const int i = tid + q4 * NTHREADS; const int t8 = (i >> 7) * 8, nn = i & 127;
      float bv[8];
      if (dir) rbt[q4] = rev8_(rbt[q4]);
      bv[0] = __uint_as_float(rbt[q4][0] << 16); bv[1] = __uint_as_float(rbt[q4][0] & 0xffff0000u);
      bv[2] = __uint_as_float(rbt[q4][1] << 16); bv[3] = __uint_as_float(rbt[q4][1] & 0xffff0000u);
      bv[4] = __uint_as_float(rbt[q4][2] << 16); bv[5] = __uint_as_float(rbt[q4][2] & 0xffff0000u);
      bv[6] = __uint_as_float(rbt[q4][3] << 16); bv[7] = __uint_as_float(rbt[q4][3] & 0xffff0000u);
#pragma unroll
      for (int h2 = 0; h2 < 2; ++h2) {
        const float* wv = (const float*)(smem + M2_OFF_HD + h2 * M2H_SIZE + M2H_S) + 128 + t8;
        float sv[8];
#pragma unroll
        for (int k = 0; k < 8; ++k) sv[k] = bv[k] * wv[k];
        st8bf((bf16*)(smem + M2_OFF_HD + h2 * M2H_SIZE + M2H_BT) + nn * M2_LDX + t8, sv);
      }
    }
    __syncthreads();
    if (c0 + 64 < cend) M2_GLOAD(c0 + 64)
    {
      f32x16 yT, y2;
#pragma unroll
      for (int i = 0; i < 16; ++i) { yT[i] = 0.f; y2[i] = 0.f; }
      const int tv = 32 * tb + r;
      const float St = sS[tv];
      for (int sb = 0; sb <= tb; ++sb) {
        f32x16 gT;
#pragma unroll
        for (int i = 0; i < 16; ++i) gT[i] = 0.f;
#pragma unroll
        for (int ks = 0; ks < 8; ++ks) {
          bf16x8 av = *(const bf16x8*)(sB + (32 * sb + r) * M2_LDB + 16 * ks + 8 * half);
          bf16x8 bv = *(const bf16x8*)(sC + tv * M2_LDB + 16 * ks + 8 * half);
          gT = __builtin_amdgcn_mfma_f32_32x32x16_bf16(av, bv, gT, 0, 0, 0);
        }
        const float St2 = St * 1.4426950408889634f;
        if (sb == tb) {
#pragma unroll
          for (int i = 0; i < 16; ++i) {
            const int sv = 32 * sb + (i & 3) + 8 * (i >> 2) + 4 * half;
            gT[i] = (sv <= tv) ? gT[i] * exp2f_(St2 - sDt[sv]) : 0.f;
          }
        } else {
#pragma unroll
          for (int i = 0; i < 16; ++i) {
            const int sv = 32 * sb + (i & 3) + 8 * (i >> 2) + 4 * half;
            gT[i] *= exp2f_(St2 - sDt[sv]);
          }
        }
#pragma unroll
        for (int kq = 0; kq < 2; ++kq) {
          const u32x4 pw = u32x4{pack2(gT[8 * kq], gT[8 * kq + 1]), pack2(gT[8 * kq + 2], gT[8 * kq + 3]), pack2(gT[8 * kq + 4], gT[8 * kq + 5]), pack2(gT[8 * kq + 6], gT[8 * kq + 7])};
          const bf16x8 pf = __builtin_bit_cast(bf16x8, pw);
          const bf16* xr = sXT + (32 * pb + r) * M2_LDX + 32 * sb + 16 * kq + 4 * half;
          uint2 x0 = *(const uint2*)xr, x1 = *(const uint2*)(xr + 8);
          bf16x8 xa;
          xa[0] = (short)(x0.x & 0xffff); xa[1] = (short)(x0.x >> 16); xa[2] = (short)(x0.y & 0xffff); xa[3] = (short)(x0.y >> 16);
          xa[4] = (short)(x1.x & 0xffff); xa[5] = (short)(x1.x >> 16); xa[6] = (short)(x1.y & 0xffff); xa[7] = (short)(x1.y >> 16);
          yT = __builtin_amdgcn_mfma_f32_32x32x16_bf16(xa, pf, yT, 0, 0, 0);
        }
      }
#pragma unroll
      for (int ks = 0; ks < 8; ++ks) {
        bf16x8 av = *(const bf16x8*)(sH + (32 * pb + r) * M2_LDB + 16 * ks + 8 * half);
        bf16x8 bv = *(const bf16x8*)(sC + tv * M2_LDB + 16 * ks + 8 * half);
        y2 = __builtin_amdgcn_mfma_f32_32x32x16_bf16(av, bv, y2, 0, 0, 0);
      }
      const float eS = __expf(St);
      const int j = m2_seq2tok(c0 + tv, dir);
      float* yo = YM + (size_t)j * 256 + hd * 64 + 32 * pb + 4 * half;
#pragma unroll
      for (int gI = 0; gI < 4; ++gI)
        *(float4*)(yo + 8 * gI) = make_float4(yT[4 * gI] + eS * y2[4 * gI], yT[4 * gI + 1] + eS * y2[4 * gI + 1], yT[4 * gI + 2] + eS * y2[4 * gI + 2], yT[4 * gI + 3] + eS * y2[4 * gI + 3]);
    }
    __syncthreads();
    {
      const float eL = __expf(sS[63]);
#pragma unroll
      for (int q = 0; q < 2; ++q) {
#pragma unroll
        for (int i = 0; i < 16; ++i) hst[q][i] *= eL;
#pragma unroll
        for (int ks = 0; ks < 4; ++ks) {
          bf16x8 av = *(const bf16x8*)(sXT + (32 * pb + r) * M2_LDX + 16 * ks + 8 * half);
          bf16x8 bv = *(const bf16x8*)(sBT + (32 * (nb0 + q) + r) * M2_LDX + 16 * ks + 8 * half);
          hst[q] = __builtin_amdgcn_mfma_f32_32x32x16_bf16(av, bv, hst[q], 0, 0, 0);
        }
#pragma unroll
        for (int i = 0; i < 16; ++i) {
          const int pv = 32 * pb + (i & 3) + 8 * (i >> 2) + 4 * half;
          sH[pv * M2_LDB + 32 * (nb0 + q) + r] = f2bf(hst[q][i]);
        }
      }
    }
    __syncthreads();
  }
  if (!seg1) {
    bf16* HM = (bf16*)(p.ws + OFF_MIX + MX_HM) + (size_t)((b * 2 + dir) * 2 + grp) * 128 * 128;
#pragma unroll
    for (int q = 0; q < 4; ++q) {
      const int i = tid + q * NTHREADS, pr = i >> 4, n8 = (i & 15) * 8;
      *(u32x4*)(HM + pr * 128 + n8) = *(const u32x4*)((const bf16*)(smem + M2_OFF_HD + (pr >> 6) * M2H_SIZE + M2H_H) + (pr & 63) * M2_LDB + n8);
    }
  }
}
constexpr int M2C_MT = (M2_REST + 255) / 256;
DI void m2corr_tile(const Params& p, const LP& L, int t, char* smem) {
  const int mt = t % M2C_MT, r = t / M2C_MT, grp = r & 1, dir = (r >> 1) & 1, b = r >> 2;
  const int tok0 = dir ? CTXL : M2_SPLIT;
  const bf16* A = (const bf16*)(p.ws + OFF_MIX + MX_XBC) + ((size_t)b * TOK + tok0) * 768 + 512 + grp * 128;
  const bf16* HM = (const bf16*)(p.ws + OFF_MIX + MX_HM) + (size_t)((b * 2 + dir) * 2 + grp) * 128 * 128;
  GA g = make_ga(A, 768, HM, 128, 128, M2_REST);
  f32x4 acc[4][4];
  const int m0 = mt * 256;
  gemm_s<4>(g, m0, 0, smem, acc);
  float* YM = (float*)(p.ws + OFF_HA) + ((size_t)dir * NTOK + (size_t)b * TOK + tok0) * 256;
  const float* GT = (const float*)(p.ws + OFF_MIX + MX_GT) + (size_t)((b * 2 + dir) * 4 + grp * 2) * M2_REST;
  EPI_BEGIN(4, acc, m0, 0, M2_REST)
    const int hs = col >> 6;
    const int sidx = dir ? (M2_REST - 1 - row) : row;
    const float f = __expf(GT[(size_t)hs * M2_REST + sidx]);
    float* yo = YM + (size_t)row * 256 + (grp * 2 + hs) * 64 + (col & 63);
    float4 y0 = *(const float4*)yo, y1 = *(const float4*)(yo + 4);
    y0.x += f * v[0]; y0.y += f * v[1]; y0.z += f * v[2]; y0.w += f * v[3];
    y1.x += f * v[4]; y1.y += f * v[5]; y1.z += f * v[6]; y1.w += f * v[7];
    *(float4*)yo = y0; *(float4*)(yo + 4) = y1;
  EPI_END
}
DI void m2gate_item(const Params& p, const LP& L, int it) {
  const int tok = it * NWAVES + (tid_() >> 6), lane = tid_() & 63;
  const float* Y0 = (const float*)(p.ws + OFF_HA) + (size_t)tok * 256;
  const float* Y1 = Y0 + (size_t)NTOK * 256;
  const bf16* XB = (const bf16*)(p.ws + OFF_MIX + MX_XBC) + (size_t)tok * 768;
  const bf16* P1 = (const bf16*)(p.ws + OFF_P1) + (size_t)tok * P1W + C_Z;
  const int c = lane * 4, hd = c >> 6;
  const float dsk = p.in[I_M2D][L.l * 4 + hd];
  float4 y0 = *(const float4*)(Y0 + c), y1 = *(const float4*)(Y1 + c);
  uint2 xw = *(const uint2*)(XB + c), zw = *(const uint2*)(P1 + c);
  float xs[4] = {__uint_as_float(xw.x << 16), __uint_as_float(xw.x & 0xffff0000u), __uint_as_float(xw.y << 16), __uint_as_float(xw.y & 0xffff0000u)};
  float zs[4] = {__uint_as_float(zw.x << 16), __uint_as_float(zw.x & 0xffff0000u), __uint_as_float(zw.y << 16), __uint_as_float(zw.y & 0xffff0000u)};
  float ys[4] = {y0.x + y1.x, y0.y + y1.y, y0.z + y1.z, y0.w + y1.w};
  float v[4], ss = 0.f;
#pragma unroll
  for (int i = 0; i < 4; ++i) { v[i] = (ys[i] + dsk * xs[i]) * siluf_(zs[i]); ss += v[i] * v[i]; }
  ss = wave_sum(ss);
  const float rs = rsqrtf(ss * (1.f / 256.f) + EPS);
  float4 gn = *(const float4*)(p.in[I_M2GNORM] + L.l * 256 + c);
  bf16* O = (bf16*)(p.ws + OFF_O) + (size_t)tok * 1024 + 768 + c;
  *(uint2*)O = make_uint2(pack2(v[0] * rs * gn.x, v[1] * rs * gn.y), pack2(v[2] * rs * gn.z, v[3] * rs * gn.w));
}
constexpr int GLU_MT = (NTOK + 255) / 256;
DI void glu_tile(const Params& p, const LP& L, int t, char* smem) {
  const int mt = t % GLU_MT, nt = t / GLU_MT, m0 = mt * 256, n0 = nt * 128;
  const bf16* Z = (const bf16*)(p.ws + OFF_MIX + MX_Z);
  GA g = make_ga(Z, 256, (const bf16*)(L.we + WE_GLU), 256, 256, NTOK);
  f32x4 acc[4][4];
  gemm_s<4>(g, m0, n0, smem, acc);
  bf16* O = (bf16*)(p.ws + OFF_O);
  const float* bg = p.in[I_S5BGLU] + L.l * 256;
  EPI_BEGIN(4, acc, m0, n0, NTOK)
    float z[8]; ld8bf(Z + (size_t)row * 256 + col, z);
#pragma unroll
    for (int k = 0; k < 8; ++k) v[k] = z[k] * sigmoidf_(v[k] + bg[col + k]);
    st8bf(O + (size_t)row * 1024 + 512 + col, v);
  EPI_END
}
DI void merge_tile(const Params& p, const LP& L, int t, char* smem) {
  constexpr int MT_L = BATCH * (SEQ / 256), MT_A = (NTOK + 255) / 256;
  const int mt = L.last ? t % MT_L : t % MT_A, nt = L.last ? t / MT_L : t / MT_A, m0 = mtile_row0(mt, L.last, 256), n0 = nt * 128;
  const bf16* O = (const bf16*)(p.ws + OFF_O);
  const unsigned char* PG = (const unsigned char*)(p.ws + OFF_PG);
  float tot[4][2][8];
#pragma unroll
  for (int a = 0; a < 4; ++a)
#pragma unroll
    for (int q = 0; q < 2; ++q)
#pragma unroll
      for (int k = 0; k < 8; ++k) tot[a][q][k] = 0.f;
  for (int j = 0; j < 4; ++j) {
    GA g = make_ga(O + j * 256, 1024, (const bf16*)(L.we + WE_WB) + (size_t)j * 1024 * 256, 256, 256, NTOK);
    f32x4 acc[4][4];
    gemm_s<4>(g, m0, n0, smem, acc);
    EPI_BEGIN(4, acc, m0, n0, NTOK)
      float gt[8]; ld8u8(PG + (size_t)row * 4096 + j * 1024 + col, gt);
#pragma unroll
      for (int k = 0; k < 8; ++k) tot[_m][_q][k] += gt[k] * v[k];
    EPI_END
  }
  bf16* Y = (bf16*)(p.ws + OFF_P1);
  {
    const int l = tid_() & 63, w = tid_() >> 6, wr = w >> 1, wc = w & 1, fr = l & 15, fq = l >> 4;
#pragma unroll
    for (int m = 0; m < 4; ++m)
#pragma unroll
      for (int q = 0; q < 2; ++q) {
        const int row = m0 + wr * 64 + m * 16 + fr, col = n0 + wc * 64 + q * 32 + 8 * fq;
        if (row < NTOK) {
#pragma unroll
          for (int k = 0; k < 8; ++k) tot[m][q][k] *= (1.0f / 255.0f);
          st8bf(Y + (size_t)row * 1024 + col, tot[m][q]);
        }
      }
  }
}
DI void outproj_tile(const Params& p, const LP& L, int t, char* smem) {
  float* Y2 = (float*)(p.ws + OFF_HA);
  constexpr int MT_L = BATCH * (SEQ / 256), MT_A = (NTOK + 255) / 256;
  const int mt = L.last ? t % MT_L : t % MT_A, nt = L.last ? t / MT_L : t / MT_A, m0 = mtile_row0(mt, L.last, 256), n0 = nt * 256;
  GA g = make_ga((const bf16*)(p.ws + OFF_P1), 1024, (const bf16*)(L.we + WE_WOUT), 1024, 1024, NTOK);
  f32x4 acc[2][2][4][2];
  gemm_big(g, m0, n0, smem, acc);
  EPIB_BEGIN(acc, m0, n0, NTOK)
    st8f(Y2 + (size_t)row * 1024 + col, v);
  EPIB_END
}
DI int post_ntok(bool latonly) { return latonly ? BATCH * SEQ : NTOK; }
DI int post_tok(int i, bool latonly) { return latonly ? ((i / SEQ) * TOK + CTXL + (i % SEQ)) : i; }

DI const float* xsrc_row(const Params& p, int l, int tok) {
  if (l > 0) return (const float*)(p.ws + OFF_X) + (size_t)tok * 1024;
  const int b = tok_b(tok), j = tok_j(tok);
  return (j < CTXL) ? p.in[I_CTX] + ((size_t)b * CTXL + j) * 1024 : p.in[I_X] + ((size_t)b * SEQ + (j - CTXL)) * 1024;
}
DI void post_stage_router(const Params& p, const LP& L, char* smem) {
  const float* wr = p.in[I_WROUTER] + (size_t)L.l * 1024 * 16;
  float4* wl = (float4*)smem;
  __syncthreads();
  for (int i = tid_(); i < 4096; i += NTHREADS) {
    const int k = i >> 2, q = i & 3;
    const int pos = ((k >> 8) * 4 + (k & 3)) * 64 + ((k >> 2) & 63);
    wl[q * 1024 + pos] = *(const float4*)(wr + (size_t)k * 16 + q * 4);
  }
  __syncthreads();
}
DI void post_phase(const Params& p, const LP& L, char* smem) {
  const int lane = tid_() & 63, gw = (int)blockIdx.x * NWAVES + (tid_() >> 6), TW = (int)gridDim.x * NWAVES;
  const int n = post_ntok(L.last);
  if (gw >= n) return;
  const float* gpm = p.in[I_GPOSTMIX] + L.l * 1024;
  const float4* wl = (const float4*)smem;
  int i = gw, tok = post_tok(i, L.last);
  float4 yr[4], xr[4];
  {
    const float* X = xsrc_row(p, L.l, tok);
    const float* Y2 = (const float*)(p.ws + OFF_HA) + (size_t)tok * 1024;
#pragma unroll
    for (int q = 0; q < 4; ++q) { yr[q] = *(const float4*)(Y2 + lane * 4 + q * 256); xr[q] = *(const float4*)(X + lane * 4 + q * 256); }
  }
  for (;;) {
    const int inext = i + TW; const bool has = inext < n; const int tokn = has ? post_tok(inext, L.last) : tok;
    float4 yn[4], xn[4];
    {
      const float* Xn = xsrc_row(p, L.l, tokn);
      const float* Yn = (const float*)(p.ws + OFF_HA) + (size_t)tokn * 1024;
#pragma unroll
      for (int q = 0; q < 4; ++q) { yn[q] = *(const float4*)(Yn + lane * 4 + q * 256); xn[q] = *(const float4*)(Xn + lane * 4 + q * 256); }
    }
    float* X = (float*)(p.ws + OFF_X) + (size_t)tok * 1024;
    const float* mod = L.mod + (size_t)tok_modrow(tok) * 6144;
    float xv[16], h[16];
    float ss = 0.f;
#pragma unroll
    for (int q = 0; q < 4; ++q) ss += yr[q].x * yr[q].x + yr[q].y * yr[q].y + yr[q].z * yr[q].z + yr[q].w * yr[q].w;
    ss = wave_sum(ss);
    const float rs = rsqrtf(ss * (1.f / 1024.f) + EPS);
#pragma unroll
    for (int q = 0; q < 4; ++q) {
      const int c = lane * 4 + q * 256;
      float4 xo = xr[q], gv = *(const float4*)(gpm + c), gt = *(const float4*)(mod + 2048 + c);
      xo.x += gt.x * yr[q].x * rs * gv.x; xo.y += gt.y * yr[q].y * rs * gv.y; xo.z += gt.z * yr[q].z * rs * gv.z; xo.w += gt.w * yr[q].w * rs * gv.w;
      *(float4*)(X + c) = xo;
      xv[q * 4] = xo.x; xv[q * 4 + 1] = xo.y; xv[q * 4 + 2] = xo.z; xv[q * 4 + 3] = xo.w;
    }
    bf16* H2 = (bf16*)(p.ws + OFF_P1) + (size_t)NTOK * 1024 + (size_t)tok * 1024;
    normmod_row(xv, p.in[I_GPREFFN] + L.l * 1024, mod + 3072, mod + 4096, H2, h);
    float lg[16];
#pragma unroll
    for (int e = 0; e < 16; ++e) lg[e] = 0.f;
#pragma unroll
    for (int q = 0; q < 16; ++q) {
      const int pos = ((q >> 2) * 4 + (q & 3)) * 64 + lane;
      float4 a = wl[pos], b4 = wl[1024 + pos], c4 = wl[2048 + pos], d4 = wl[3072 + pos];
      float hv = h[q];
      lg[0] += hv * a.x; lg[1] += hv * a.y; lg[2] += hv * a.z; lg[3] += hv * a.w;
      lg[4] += hv * b4.x; lg[5] += hv * b4.y; lg[6] += hv * b4.z; lg[7] += hv * b4.w;
      lg[8] += hv * c4.x; lg[9] += hv * c4.y; lg[10] += hv * c4.z; lg[11] += hv * c4.w;
      lg[12] += hv * d4.x; lg[13] += hv * d4.y; lg[14] += hv * d4.z; lg[15] += hv * d4.w;
    }
    float mx = -INFINITY;
#pragma unroll
    for (int e = 0; e < 16; ++e) { lg[e] = wave_sum(lg[e]); mx = fmax_(mx, lg[e]); }
    float se = 0.f;
#pragma unroll
    for (int e = 0; e < 16; ++e) { lg[e] = expf(lg[e] - mx); se += lg[e]; }
    if (lane < 16) {
      float v = 0.f;
#pragma unroll
      for (int e = 0; e < 16; ++e) if (e == lane) v = lg[e];
      ((float*)(p.ws + OFF_AFF))[(size_t)lane * NTOK + tok] = v * rcp_(se);
    }
    if (!has) break;
    i = inext; tok = tokn;
#pragma unroll
    for (int q = 0; q < 4; ++q) { yr[q] = yn[q]; xr[q] = xn[q]; }
  }
}
DI int block_sum_(int v, int* sred, int round) {
  const int tid = tid_(), lane = tid & 63, wid = tid >> 6;
  v += shfl_xor_(v, 32); v += shfl_xor_(v, 16); v += shfl_xor_(v, 8); v += shfl_xor_(v, 4); v += shfl_xor_(v, 2); v += shfl_xor_(v, 1);
  int* r = sred + (round & 1) * NWAVES;
  if (lane == 0) r[wid] = v;
  __syncthreads();
  int tsum = 0;
#pragma unroll
  for (int q = 0; q < NWAVES; ++q) tsum += r[q];
  return tsum;
}
DI void route_item(const Params& p, const LP& L, int it, char* smem) {
  const int nstream = L.last ? 1 : 2;
  const int b = it / (16 * nstream), e = (it / nstream) & 15, ctxs = (nstream == 2) ? (it & 1) : 0;
  const int T = ctxs ? CTXL : SEQ, cap = ctxs ? CAP_C : CAP_L;
  const int tok0 = b * TOK + (ctxs ? 0 : CTXL);
  const int slot0 = ctxs ? (BATCH * CAP_L + b * CAP_C) : (b * CAP_L);
  int* sred = (int*)smem;
  const float* AFF = (const float*)(p.ws + OFF_AFF) + (size_t)e * NTOK + tok0;
  int* SEL = (int*)(p.ws + OFF_SEL);
  int* IDX = (int*)(p.ws + OFF_IDX) + (size_t)e * ESLOTS;
  float* GW = (float*)(p.ws + OFF_GW) + (size_t)e * ESLOTS;
  const int tid = tid_(), lane = tid & 63, wid = tid >> 6;
  constexpr int MAXPER = (SEQ + NTHREADS - 1) / NTHREADS;
  const int per = (T + NTHREADS - 1) / NTHREADS;
  unsigned key[MAXPER];
  __syncthreads();
#pragma unroll
  for (int k = 0; k < MAXPER; ++k) {
    int i = tid * per + k;
    key[k] = (k < per && i < T) ? (__float_as_uint(AFF[i]) + 1u) : 0u;
  }
  unsigned thr = 0u;
  int round = 0;
  for (int bit = 30; bit >= 0; --bit) {
    const unsigned cand = thr | (1u << bit);
    int c = 0;
#pragma unroll
    for (int k = 0; k < MAXPER; ++k) c += (key[k] >= cand) ? 1 : 0;
    c = block_sum_(c, sred, round++);
    if (c >= cap) thr = cand;
  }
  int cg = 0, ce = 0;
#pragma unroll
  for (int k = 0; k < MAXPER; ++k) { cg += (key[k] > thr) ? 1 : 0; ce += (key[k] == thr) ? 1 : 0; }
  const int tot_gt = block_sum_(cg, sred, round++);
  const int need_eq = cap - tot_gt;
  int v = cg | (ce << 16), inc = v;
#pragma unroll
  for (int d = 1; d < 64; d <<= 1) { int o = shfl_up_(inc, d); if (lane >= d) inc += o; }
  int* soff = sred + 2 * NWAVES;
  __syncthreads();
  if (lane == 63) soff[wid] = inc;
  __syncthreads();
  int base = 0;
  for (int w = 0; w < wid; ++w) base += soff[w];
  int excl = base + inc - v;
  int gt_before = excl & 0xffff, eq_before = excl >> 16;
#pragma unroll
  for (int k = 0; k < MAXPER; ++k) {
    int i = tid * per + k;
    if (k < per && i < T) {
      const bool isgt = key[k] > thr, iseq = key[k] == thr;
      const bool sel = isgt || (iseq && eq_before < need_eq);
      const int slot = slot0 + gt_before + (eq_before < need_eq ? eq_before : need_eq);
      if (sel) { IDX[slot] = tok0 + i; GW[slot] = __uint_as_float(key[k] - 1u); SEL[(size_t)(tok0 + i) * 16 + e] = slot; }
      else SEL[(size_t)(tok0 + i) * 16 + e] = -1;
      gt_before += isgt ? 1 : 0; eq_before += iseq ? 1 : 0;
    }
  }
}
DI void moe1_tile(const Params& p, const LP& L, int t, char* smem) {
  const int nslots = L.last ? ESLOTS_L : ESLOTS;
  constexpr int MT_L = (ESLOTS_L + 255) / 256, MT_A = (ESLOTS + 255) / 256;
  const int nt = t & 7, sq = t >> 3;
  const int e = L.last ? sq / MT_L : sq / MT_A, mt = L.last ? sq % MT_L : sq % MT_A;
  const int m0 = mt * 256, n0 = nt * 256;
  GA g = make_ga((const bf16*)(p.ws + OFF_P1) + (size_t)NTOK * 1024, 1024, (const bf16*)(p.ws + OFF_MIX + WX_GU) + (size_t)e * 2048 * 1024, 1024, 1024, nslots);
  g.ridx = (const int*)(p.ws + OFF_IDX) + (size_t)e * ESLOTS;
  f32x4 acc[2][2][4][2];
  gemm_big(g, m0, n0, smem, acc);
  bf16* ACT = (bf16*)(p.ws + OFF_PG) + (size_t)e * ESLOTS * 1024;
  {
    const int l = tid_() & 63, w = tid_() >> 6, wr = w >> 2, wc = w & 3, fr = l & 15, fq = l >> 4;
#pragma unroll
    for (int ai = 0; ai < 2; ++ai)
#pragma unroll
      for (int m = 0; m < 4; ++m) {
        const int row = m0 + ai * 128 + wr * 64 + m * 16 + fr;
        float a[8];
#pragma unroll
        for (int k = 0; k < 4; ++k) { a[k] = siluf_(acc[ai][0][m][0][k]) * acc[ai][1][m][0][k]; a[4 + k] = siluf_(acc[ai][0][m][1][k]) * acc[ai][1][m][1][k]; }
        if (row < nslots) st8bf(ACT + (size_t)row * 1024 + nt * 128 + wc * 32 + 8 * fq, a);
      }
  }
}
DI void moe2_tile(const Params& p, const LP& L, int t, char* smem) {
  const int nslots = L.last ? ESLOTS_L : ESLOTS;
  constexpr int MT_L = (ESLOTS_L + 255) / 256, MT_A = (ESLOTS + 255) / 256;
  const int x = t & 7, nt = x & 3, sq = (t >> 3) * 2 + (x >> 2);
  const int e = L.last ? sq / MT_L : sq / MT_A, mt = L.last ? sq % MT_L : sq % MT_A;
  if (e >= NE) return;
  const int m0 = mt * 256, n0 = nt * 256;
  GA g = make_ga((const bf16*)(p.ws + OFF_PG) + (size_t)e * ESLOTS * 1024, 1024, (const bf16*)(p.ws + OFF_MIX + WX_DN) + (size_t)e * 1024 * 1024, 1024, 1024, nslots);
  f32x4 acc[2][2][4][2];
  gemm_big(g, m0, n0, smem, acc);
  bf16* YS = (bf16*)(p.ws + OFF_PG) + (size_t)NE * ESLOTS * 1024 + (size_t)e * ESLOTS * 1024;
  const float* GW = (const float*)(p.ws + OFF_GW) + (size_t)e * ESLOTS;
  EPIB_BEGIN(acc, m0, n0, nslots)
    const float gw = GW[row];
#pragma unroll
    for (int k = 0; k < 8; ++k) v[k] *= gw;
    st8bf(YS + (size_t)row * 1024 + col, v);
  EPIB_END
}
DI int uni_(int v) {
#ifdef EMU
  return v;
#else
  return __builtin_amdgcn_readfirstlane(v);
#endif
}
DI void comb_phase(const Params& p, const LP& L) {
  const int lane = tid_() & 63, gw = (int)blockIdx.x * NWAVES + (tid_() >> 6), TW = (int)gridDim.x * NWAVES;
  const int n = post_ntok(L.last);
  if (gw >= n) return;
  const bf16* YS = (const bf16*)(p.ws + OFF_PG) + (size_t)NE * ESLOTS * 1024;
  const float* gpf = p.in[I_GPOSTFFN] + L.l * 1024;
  int i = gw, tok = post_tok(i, L.last);
  uint4 sel[4]; float4 xr[4];
  {
    const uint4* sp = (const uint4*)((const int*)(p.ws + OFF_SEL) + (size_t)tok * 16);
    const float* X = (const float*)(p.ws + OFF_X) + (size_t)tok * 1024;
#pragma unroll
    for (int q = 0; q < 4; ++q) { sel[q] = sp[q]; xr[q] = *(const float4*)(X + lane * 4 + q * 256); }
  }
  for (;;) {
    const int inext = i + TW; const bool has = inext < n; const int tokn = has ? post_tok(inext, L.last) : tok;
    float s[16];
#pragma unroll
    for (int q = 0; q < 16; ++q) s[q] = 0.f;
#pragma unroll
    for (int e = 0; e < 16; ++e) {
      const unsigned sv = (e & 3) == 0 ? sel[e >> 2].x : (e & 3) == 1 ? sel[e >> 2].y : (e & 3) == 2 ? sel[e >> 2].z : sel[e >> 2].w;
      const int sl = uni_((int)sv);
      if (sl >= 0) {
        const bf16* yr = YS + ((size_t)e * ESLOTS + sl) * 1024;
#pragma unroll
        for (int q = 0; q < 4; ++q) {
          uint2 w = *(const uint2*)(yr + lane * 4 + q * 256);
          s[q * 4] += __uint_as_float(w.x << 16); s[q * 4 + 1] += __uint_as_float(w.x & 0xffff0000u);
          s[q * 4 + 2] += __uint_as_float(w.y << 16); s[q * 4 + 3] += __uint_as_float(w.y & 0xffff0000u);
        }
      }
    }
    uint4 seln[4]; float4 xn[4];
    {
      const uint4* sp = (const uint4*)((const int*)(p.ws + OFF_SEL) + (size_t)tokn * 16);
      const float* Xn = (const float*)(p.ws + OFF_X) + (size_t)tokn * 1024;
#pragma unroll
      for (int q = 0; q < 4; ++q) { seln[q] = sp[q]; xn[q] = *(const float4*)(Xn + lane * 4 + q * 256); }
    }
    float ss = 0.f;
#pragma unroll
    for (int q = 0; q < 16; ++q) ss += s[q] * s[q];
    ss = wave_sum(ss);
    const float rs = rsqrtf(ss * (1.f / 1024.f) + EPS);
    const float* mod = L.mod + (size_t)tok_modrow(tok) * 6144;
    float* dst = (float*)(p.ws + OFF_X) + (size_t)tok * 1024;
    if (L.last) { const int b = tok_b(tok), j = tok_j(tok); dst = p.out + ((size_t)b * SEQ + (j - CTXL)) * 1024; }
    float xv[16], h[16];
#pragma unroll
    for (int q = 0; q < 4; ++q) {
      const int c = lane * 4 + q * 256;
      float4 xo = xr[q], gv = *(const float4*)(gpf + c), gt = *(const float4*)(mod + 5120 + c);
      xo.x += gt.x * s[q * 4] * rs * gv.x; xo.y += gt.y * s[q * 4 + 1] * rs * gv.y; xo.z += gt.z * s[q * 4 + 2] * rs * gv.z; xo.w += gt.w * s[q * 4 + 3] * rs * gv.w;
      *(float4*)(dst + c) = xo;
      xv[q * 4] = xo.x; xv[q * 4 + 1] = xo.y; xv[q * 4 + 2] = xo.z; xv[q * 4 + 3] = xo.w;
    }
    if (!L.last) {
      const float* mod1 = (const float*)(p.ws + OFF_MOD) + ((size_t)(L.l + 1) * NB1 + tok_modrow(tok)) * 6144;
      normmod_row(xv, p.in[I_GPREMIX] + (L.l + 1) * 1024, mod1, mod1 + 1024, (bf16*)(p.ws + OFF_HA) + (size_t)tok * 1024, h);
    }
    if (!has) break;
    i = inext; tok = tokn;
#pragma unroll
    for (int q = 0; q < 4; ++q) { sel[q] = seln[q]; xr[q] = xn[q]; }
  }
}

enum { PH_PREP0 = 0, PH_PREP1, PH_L0 };
enum { LP_INPROJ = 0, LP_TOKPREP, LP_MIX1, LP_MIX2, LP_GLU, LP_MERGE, LP_OUT, LP_POST, LP_ROUTE, LP_MOE1, LP_MOE2, LP_COMB, LP_COUNT };
constexpr int NPHASES = PH_L0 + DEPTH * LP_COUNT;


DI void run_phase(const Params& p, int ph, char* smem) {
  const int G = gridDim.x;
  int start = blockIdx.x;
  auto seg = [&](int n, auto&& fn) {
    for (; start < n; start += G) fn(start);
    start -= n;
  };
#ifdef ONLY_PREP
  if (ph >= PH_L0) return;
#endif
  if (ph == PH_PREP0) {
    seg(DEPTH * 96, [&](int it) { mod_item(p, it, smem); });
    seg(DEPTH * 32, [&](int it) { s5_tab_item(p, it, smem); });
    seg(1, [&](int) { rope_tab_item(p); });
    seg(DEPTH * CT_EARLY, [&](int it) { conv_early_item(p, it / CT_EARLY, it % CT_EARLY, smem); });
    return;
  }
  if (ph == PH_PREP1) {
    seg(DEPTH * 256, [&](int it) { s5_mat_item(p, it); });
    seg(NTOK / NWAVES, [&](int it) { prep_row_item(p, it); });
    return;
  }
#ifdef ONLY_LPH
  if (ph < PH_L0) return;
#endif
  const int l = (ph - PH_L0) / LP_COUNT;
#ifdef ONLY_LPH
  const int lph = ONLY_LPH;
#else
  const int lph = (ph - PH_L0) % LP_COUNT;
#endif
  const LP L = make_lp(p, l);
  switch (lph) {
    case LP_INPROJ:
      seg(L.last ? IP_SLOTS_LAST : IP_SLOTS_ALL, [&](int it) { inproj_tile(p, L, it, smem); });
      break;
    case LP_TOKPREP:
      seg(16 * S5_MT * 2, [&](int it) { s5a_tile(p, L, it, smem); });
      seg(TP_MT * 3, [&](int it) { mlaq_tile(p, L, it, smem); });
      seg(TP_MT * 4, [&](int it) { mlakv_tile(p, L, it, smem); });
      seg(NTOK / 64, [&](int it) { navt_item(p, it, smem); });
      seg(M2C_ITEMS, [&](int it) { m2conv_item(p, L, it); });
      seg(M2S_ITEMS, [&](int it) { m2scal_item(p, L, it); });
      break;
    case LP_MIX1: {
      const int n0 = BATCH * 8, n1 = n0 + 2 * 16 * BATCH / NWAVES, n2 = n1 + BATCH * 4 * (SEQ / 256), n3 = n2 + BATCH * 4 * (SEQ / 256);
      const int n4 = n3 + (L.last ? 0 : BATCH * 4 * ((CTXL + 255) / 256)), n5 = n4 + (L.last ? 0 : BATCH * 4 * ((CTXL + 255) / 256));
      int* qhead = (int*)(p.ws + OFF_BAR) + Q_WORD0 + 64 * (l + 2 * p.probe_rep);
#ifdef EMU
      volatile int* bc = (volatile int*)(smem + SMEM_BYTES + 8);
#else
      volatile LAS int* bc = (volatile LAS int*)(smem + SMEM_BYTES + 8);
#endif
      for (;;) {
        __syncthreads();
        if (tid_() == 0) {
#ifdef EMU
          *bc = atomicAdd(qhead, 1);
#else
          *bc = __hip_atomic_fetch_add(qhead, 1, __ATOMIC_RELAXED, __HIP_MEMORY_SCOPE_AGENT);
#endif
        }
        __syncthreads();
        const int it = *bc;
        if (it >= n5) break;
#ifdef PROBE_SKIPM2
        if (it < n0) { if (p.probe_rep == 0) m2scan_item(p, L, it, smem); }
#else
        if (it < n0) m2scan_item(p, L, it, smem);
#endif
        else if (it < n1) s5carry_item(p, L, it - n0);
        else if (it < n2) mla_attn_item(p, it - n1, false, smem);
        else if (it < n3) na_attn_item(p, L, it - n2, false, smem);
        else if (it < n4) mla_attn_item(p, it - n3, true, smem);
        else na_attn_item(p, L, it - n4, true, smem);
      }
    } break;
    case LP_MIX2:
      seg(16 * S5_MT * 2, [&](int it) { s5c_tile(p, L, it, smem); });
      seg(BATCH * 4 * M2C_MT, [&](int it) { m2corr_tile(p, L, it, smem); });
      break;
    case LP_GLU:
      seg(GLU_MT * 2, [&](int it) { glu_tile(p, L, it, smem); });
      seg(NTOK / NWAVES, [&](int it) { m2gate_item(p, L, it); });
      break;
    case LP_MERGE:
      seg(mtiles(L.last, 256) * 8, [&](int it) { merge_tile(p, L, it, smem); });
      break;
    case LP_OUT:
      seg(mtiles(L.last, 256) * 4, [&](int it) { outproj_tile(p, L, it, smem); });
      break;
    case LP_POST:
      seg(CT_EXP, [&](int it) { conv_expert_item(p, l, it, smem); });
      post_stage_router(p, L, smem);
      post_phase(p, L, smem);
      break;
    case LP_ROUTE:
      seg(BATCH * 16 * (L.last ? 1 : 2), [&](int it) { route_item(p, L, it, smem); });
      break;
    case LP_MOE1:
      seg(NE * (((L.last ? ESLOTS_L : ESLOTS) + 255) / 256) * 8, [&](int it) { moe1_tile(p, L, it, smem); });
      break;
    case LP_MOE2:
      seg(((NE * (((L.last ? ESLOTS_L : ESLOTS) + 255) / 256) + 1) / 2) * 8, [&](int it) { moe2_tile(p, L, it, smem); });
      break;
    case LP_COMB:
      comb_phase(p, L);
      break;
  }
}

__global__ void __launch_bounds__(NTHREADS, 2) mega_kernel(Params p) {
#ifdef EMU
  char* smem = emu_cur_f->blk->smem;
  for (int ph = p.phase_lo; ph < p.phase_hi; ++ph) {
    run_phase(p, ph, smem);
    if (ph + 1 < p.phase_hi) emu_grid_sync();
  }
#else
  __shared__ __attribute__((aligned(16))) char smem[SMEM_BYTES + 16 + 256];
  {
    const unsigned hw = (unsigned)__builtin_amdgcn_s_getreg((5 << 11) | 4) & 0x3fu;
    if ((threadIdx.x & 63) == 0) *(volatile int*)(smem + WAVE_TAB_OFF + hw * 4u) = (int)(threadIdx.x >> 6);
    __syncthreads();
  }
  if (p.phase_hi - p.phase_lo > 1) {
    if (threadIdx.x == 0) *(uint4*)(smem + SMEM_BYTES) = make_uint4(0u, 0u, 0u, 0u);
    __syncthreads();
    XcdBarrier xb = xcd_barrier_post((unsigned*)(p.ws + OFF_BAR), (volatile LAS unsigned*)(smem + SMEM_BYTES));
    for (int ph = p.phase_lo; ph < p.phase_hi; ++ph) {
      int reps = 1;
#ifdef PROBE_PHASE
      if (ph == PROBE_PHASE || ph == PROBE_PHASE2) reps = 1 + PROBE_REP;
#endif
      for (int rep = 0; rep < reps; ++rep) {
        p.probe_rep = rep;
        run_phase(p, ph, smem);
        if (ph + 1 < p.phase_hi || rep + 1 < reps) {
          if (ph == p.phase_lo && rep == 0) cg::this_grid().sync();
          else xcd_barrier(xb);
        }
      }
    }
  } else {
    run_phase(p, p.phase_lo, smem);
  }
#endif
}

#ifndef EMU
extern "C" void kernel_launch(void* const* d_in, const int* in_sizes, int n_in, void* d_out, int out_size, void* d_ws, size_t ws_size,
                              hipStream_t stream) {
  static int grid_blocks = 0;
  if (!grid_blocks) {
    int dev = 0, cus = 0, per_cu = 0;
    hipGetDevice(&dev);
    hipDeviceGetAttribute(&cus, hipDeviceAttributeMultiprocessorCount, dev);
    hipOccupancyMaxActiveBlocksPerMultiprocessor(&per_cu, mega_kernel, NTHREADS, 0);
    if (per_cu > 1) per_cu = 1;
    if (per_cu < 1) per_cu = 1;
    grid_blocks = cus * per_cu;
    if (ws_size < WS_TOTAL) fprintf(stderr, "workspace too small: %zu < %zu\n", ws_size, (size_t)WS_TOTAL);
  }
  Params p{};
  for (int i = 0; i < N_INPUTS; ++i) p.in[i] = (const float*)d_in[i];
  p.out = (float*)d_out;
  p.ws = (char*)d_ws;
#if MK_MULTI
  for (int ph = 0; ph < NPHASES; ++ph) {
    p.phase_lo = ph; p.phase_hi = ph + 1;
    hipLaunchKernelGGL(mega_kernel, dim3(grid_blocks), dim3(NTHREADS), 0, stream, p);
  }
#else
  p.phase_lo = 0; p.phase_hi = NPHASES;
  hipMemsetAsync((char*)d_ws + OFF_BAR, 0, BAR_BYTES, stream);
  void* args[] = {&p};
  hipError_t e = hipLaunchCooperativeKernel((void*)mega_kernel, dim3(grid_blocks), dim3(NTHREADS), args, 0, stream);
  if (e != hipSuccess) fprintf(stderr, "cooperative launch failed: %s (grid %d)\n", hipGetErrorString(e), grid_blocks);
#endif
}
#endif
```

```cpp
#ifdef EMU
#include "emu.h"
#else
#include <hip/hip_runtime.h>
#include <hip/hip_cooperative_groups.h>
#include <cstdio>
namespace cg = cooperative_groups;
using bf16x8 = __attribute__((ext_vector_type(8))) short;
using f32x4 = __attribute__((ext_vector_type(4))) float;
using f32x16 = __attribute__((ext_vector_type(16))) float;
#endif
using u32x4 = __attribute__((ext_vector_type(4))) unsigned;
#ifndef MK_MULTI
#define MK_MULTI 0
#endif

#define DI __device__ __forceinline__
typedef unsigned short bf16;

#ifdef EMU_SMALL2
constexpr int BATCH = 2, SEQ = 1024, CTXL = 64, GRID_W = 32;
#elif defined(EMU_SMALL)
constexpr int BATCH = 2, SEQ = 512, CTXL = 64, GRID_W = 32;
#else
constexpr int BATCH = 8, SEQ = 2048, CTXL = 256, GRID_W = 64;
#endif
constexpr int D = 1024, DEPTH = 2;
constexpr int TOK = CTXL + SEQ, NTOK = BATCH * TOK;
constexpr int ROWS = SEQ / GRID_W;
constexpr int WIN_R = (ROWS < 8 ? ROWS : 8), WIN_C = 16;
constexpr int N_IN = 6568, N_INP = 6656;
constexpr int C_CQ = 0, C_CKV = 256, C_KR = 384, C_NA = 416, C_S5 = 1184, C_Z = 1440, C_XBC = 1696, C_DT = 2464, C_GATE = 2472;
constexpr int P1W = 2480;
constexpr int NCH = TOK / 16, NCC = CTXL / 16, MCH = BATCH * NCH;
constexpr int NE = 16;
constexpr int CAP_L = 2 * SEQ / NE, CAP_C = 2 * CTXL / NE;
constexpr int ESLOTS = BATCH * (CAP_L + CAP_C), ESLOTS_L = BATCH * CAP_L;
constexpr int NB1 = BATCH + 1;
constexpr float EPS = 1e-6f;
constexpr int SMEM_BYTES = 147456;
constexpr int NTHREADS = 512, NWAVES = NTHREADS / 64;

enum { I_X = 0, I_C, I_CTX, I_CCTX, I_WADA, I_BADA, I_GPREMIX, I_GPOSTMIX, I_GPREFFN, I_GPOSTFFN, I_WIN, I_GCQ, I_GCKV, I_WUQ, I_WUKV, I_RPB,
       I_S5ARE, I_S5AIM, I_S5LOGSTEP, I_S5BRE, I_S5BIM, I_S5CRE, I_S5CIM, I_S5D, I_S5WGLU, I_S5BGLU, I_M2CONVW, I_M2CONVB, I_M2ALOG, I_M2DTBIAS,
       I_M2D, I_M2GNORM, I_WBRANCH, I_WOUT, I_WROUTER, I_WGATE, I_WUP, I_WDOWN, N_INPUTS };

constexpr size_t al256(size_t x) { return (x + 255) & ~(size_t)255; }
constexpr size_t SZ_X = (size_t)NTOK * D * 4;
constexpr size_t SZ_ROWBF = (size_t)NTOK * D * 2;
constexpr size_t OFF_X = 0;
constexpr size_t OFF_MOD = OFF_X + al256(SZ_X);
constexpr size_t OFF_HA = OFF_MOD + al256((size_t)DEPTH * NB1 * 6144 * 4);
constexpr size_t OFF_O = OFF_HA + al256(SZ_ROWBF);
constexpr size_t OFF_P1 = OFF_O + al256(SZ_ROWBF);
constexpr size_t SZ_P1 = (size_t)NTOK * P1W * 2;
constexpr size_t OFF_PG = OFF_P1 + al256(SZ_P1);
constexpr size_t SZ_PG = (size_t)NTOK * 4096 * 2;
constexpr size_t OFF_DT = OFF_PG + al256(SZ_PG);
constexpr size_t OFF_AFF = OFF_DT + al256((size_t)NTOK * 8 * 4);
constexpr size_t OFF_SEL = OFF_AFF + al256((size_t)NTOK * 16 * 4);
constexpr size_t OFF_IDX = OFF_SEL + al256((size_t)NTOK * 16 * 4);
constexpr size_t OFF_GW = OFF_IDX + al256((size_t)NE * ESLOTS * 4);
constexpr size_t OFF_BAR = OFF_GW + al256((size_t)NE * ESLOTS * 4);
constexpr size_t BAR_BYTES = (3456 + 64 * 4) * 4;
constexpr int Q_WORD0 = 3456;
constexpr size_t OFF_ROPE = OFF_BAR + al256(BAR_BYTES);
constexpr size_t OFF_WEARLY = OFF_ROPE + al256(64 * 8 * 2 * 4);
constexpr size_t WE_WIN = 0;
constexpr size_t WE_UQ = WE_WIN + (size_t)N_INP * 1024 * 2;
constexpr size_t WE_UKV = WE_UQ + (size_t)384 * 256 * 2;
constexpr size_t WE_GLU = WE_UKV + (size_t)512 * 128 * 2;
constexpr size_t WE_WB = WE_GLU + (size_t)256 * 256 * 2;
constexpr size_t WE_WOUT = WE_WB + (size_t)4 * 1024 * 256 * 2;
constexpr size_t WE_SIZE = al256(WE_WOUT + (size_t)1024 * 1024 * 2);
constexpr size_t OFF_S5TAB = OFF_WEARLY + DEPTH * WE_SIZE;
constexpr size_t S5_LAMPOW = 0;
constexpr size_t S5_BBAR = S5_LAMPOW + (size_t)2 * 16 * 17 * 64 * 2 * 4;
constexpr size_t S5_KT = S5_BBAR + (size_t)2 * 16 * 64 * 16 * 2 * 4;
constexpr size_t S5_WA = S5_KT + (size_t)2 * 16 * 16 * 256 * 4;
constexpr size_t S5_W2 = S5_WA + (size_t)16 * 256 * 256 * 2;
constexpr size_t S5_SIZE = al256(S5_W2 + (size_t)16 * 256 * 512 * 2);
constexpr size_t OFF_MIX = OFF_S5TAB + DEPTH * S5_SIZE;
constexpr size_t MX_Q = 0;
constexpr size_t MX_K = MX_Q + al256((size_t)BATCH * 4 * TOK * 96 * 2);
constexpr size_t MX_VTM = MX_K + al256((size_t)BATCH * 4 * TOK * 96 * 2);
constexpr size_t MX_VTN = MX_VTM + al256((size_t)BATCH * 4 * 64 * TOK * 2);
constexpr size_t MX_XBC = MX_VTN + al256((size_t)BATCH * 4 * 64 * TOK * 2);
constexpr size_t MX_US5 = MX_XBC + al256((size_t)NTOK * 768 * 2);
constexpr size_t MX_HEND = MX_US5 + al256((size_t)NTOK * 256 * 2);
constexpr size_t MX_HIN = MX_HEND + al256((size_t)16 * MCH * 256 * 4);
constexpr size_t MX_Z = MX_HIN + al256((size_t)16 * MCH * 256 * 2);
constexpr size_t MX_XBT = MX_Z + al256((size_t)NTOK * 256 * 2);
constexpr size_t MX_M2S = MX_XBT + al256((size_t)NTOK * 512 * 2);
constexpr int M2_SPLIT = ((TOK / 64 + 1) / 2) * 64, M2_REST = TOK - M2_SPLIT;
constexpr size_t MX_HM = MX_M2S + al256((size_t)BATCH * 8 * TOK * 4 * 4);
constexpr size_t MX_GT = MX_HM + al256((size_t)BATCH * 4 * 128 * 128 * 2);
constexpr size_t MX_SIZE = MX_GT + al256((size_t)BATCH * 8 * M2_REST * 4);
constexpr size_t WX_GU = 0;
constexpr size_t WX_DN = WX_GU + (size_t)NE * 2048 * 1024 * 2;
constexpr size_t WX_SIZE = WX_DN + (size_t)NE * 1024 * 1024 * 2;
constexpr size_t MIXREG = (MX_SIZE > WX_SIZE ? MX_SIZE : WX_SIZE);
constexpr size_t WS_TOTAL = OFF_MIX + al256(MIXREG);

struct Params {
  const float* in[N_INPUTS];
  float* out;
  char* ws;
  int phase_lo, phase_hi;
  int probe_rep, pad_;
};

constexpr int WAVE_TAB_OFF = SMEM_BYTES + 16;
DI int tid_() {
#ifdef EMU
  return (int)threadIdx.x;
#else
  const unsigned hw = (unsigned)__builtin_amdgcn_s_getreg((5 << 11) | 4) & 0x3fu;
  const int wave = *(volatile __attribute__((address_space(3))) int*)(unsigned long)(WAVE_TAB_OFF + hw * 4u);
  int lane;
  asm volatile("v_mbcnt_lo_u32_b32 %0, -1, 0\n\tv_mbcnt_hi_u32_b32 %0, -1, %0" : "=v"(lane));
  return wave * 64 + lane;
#endif
}
#ifdef EMU
template <class T> DI T shfl_xor_(T v, int m) { return __shfl_xor(v, m); }
template <class T> DI T shfl_up_(T v, int d) { return __shfl_up(v, d); }
template <class T> DI T shfl_(T v, int src) { return __shfl(v, src); }
#else
template <class T> DI T shfl_xor_(T v, int m) {
  const int idx = ((tid_() & 63) ^ m) << 2;
  return __builtin_bit_cast(T, __builtin_amdgcn_ds_bpermute(idx, __builtin_bit_cast(int, v)));
}
template <class T> DI T shfl_up_(T v, int d) {
  const int l = tid_() & 63; const int idx = (l >= d ? l - d : l) << 2;
  return __builtin_bit_cast(T, __builtin_amdgcn_ds_bpermute(idx, __builtin_bit_cast(int, v)));
}
template <class T> DI T shfl_(T v, int src) {
  int idx = src << 2; asm volatile("" : "+v"(idx));
  return __builtin_bit_cast(T, __builtin_amdgcn_ds_bpermute(idx, __builtin_bit_cast(int, v)));
}
#endif
DI float bf2f(bf16 h) { return __uint_as_float(((unsigned)h) << 16); }
#ifdef EMU
DI bf16 f2bf(float f) { unsigned u = __float_as_uint(f); u += 0x7fffu + ((u >> 16) & 1u); return (bf16)(u >> 16); }
DI unsigned pack2(float a, float b) { return (unsigned)f2bf(a) | ((unsigned)f2bf(b) << 16); }
DI float exp2f_(float x) { return exp2f(x); }
#else
typedef float f32x2_t_ __attribute__((ext_vector_type(2)));
typedef __bf16 bf16x2_t_ __attribute__((ext_vector_type(2)));
DI unsigned pack2(float a, float b) { const f32x2_t_ v = {a, b}; return __builtin_bit_cast(unsigned, __builtin_convertvector(v, bf16x2_t_)); }
DI bf16 f2bf(float f) { return (bf16)(pack2(f, 0.f) & 0xffffu); }
DI float exp2f_(float x) { return __builtin_amdgcn_exp2f(x); }
#endif
#ifdef EMU
DI float rcp_(float x) { return 1.0f / x; }
#else
DI float rcp_(float x) { return __builtin_amdgcn_rcpf(x); }
#endif
DI float sigmoidf_(float x) { return rcp_(1.0f + exp2f_(-1.4426950408889634f * x)); }
DI float siluf_(float x) { return x * rcp_(1.0f + exp2f_(-1.4426950408889634f * x)); }
DI float softplusf_(float x) { const float ax = x < 0.f ? -x : x; return (x > 0.f ? x : 0.f) + __logf(1.0f + __expf(-ax)); }
DI float geluf_(float x) { const float u2 = 1.5957691216057308f * (x + 0.044715f * x * x * x); return x * rcp_(1.0f + exp2f_(-1.4426950408889634f * u2)); }
DI bool wave_all_(bool c) {
#ifdef EMU
  int v = c ? 0 : 1;
  v += shfl_xor_(v, 32); v += shfl_xor_(v, 16); v += shfl_xor_(v, 8); v += shfl_xor_(v, 4); v += shfl_xor_(v, 2); v += shfl_xor_(v, 1);
  return v == 0;
#else
  return __builtin_amdgcn_ballot_w64(!c) == 0ull;
#endif
}
DI float wave_sum(float v) {
#ifdef EMU
  v += shfl_xor_(v, 32); v += shfl_xor_(v, 16); v += shfl_xor_(v, 8); v += shfl_xor_(v, 4); v += shfl_xor_(v, 2); v += shfl_xor_(v, 1);
  return v;
#else
  int x = __float_as_int(v);
  x = __float_as_int(__int_as_float(x) + __int_as_float(__builtin_amdgcn_update_dpp(0, x, 0xB1, 0xF, 0xF, true)));
  x = __float_as_int(__int_as_float(x) + __int_as_float(__builtin_amdgcn_update_dpp(0, x, 0x4E, 0xF, 0xF, true)));
  x = __float_as_int(__int_as_float(x) + __int_as_float(__builtin_amdgcn_update_dpp(0, x, 0x141, 0xF, 0xF, true)));
  x = __float_as_int(__int_as_float(x) + __int_as_float(__builtin_amdgcn_update_dpp(0, x, 0x140, 0xF, 0xF, true)));
  const float r0 = __int_as_float(__builtin_amdgcn_readlane(x, 0)), r1 = __int_as_float(__builtin_amdgcn_readlane(x, 16));
  const float r2 = __int_as_float(__builtin_amdgcn_readlane(x, 32)), r3 = __int_as_float(__builtin_amdgcn_readlane(x, 48));
  return (r0 + r1) + (r2 + r3);
#endif
}
#ifndef EMU
#define XB_TMO      128
#define XB_XCNT(j)  (256  + 64 * (j))
#define XB_XSUB(j)  (1280 + 64 * (j))
#define XB_XGEN(j)  (2304 + 64 * (j))
#define XB_TOP      3328
#define XB_TOPGEN   3392
#define XB_SPIN_CAP (1u << 24)
#define LAS __attribute__((address_space(3)))
DI unsigned xb_ld(unsigned* p) { return __hip_atomic_load(p, __ATOMIC_RELAXED, __HIP_MEMORY_SCOPE_AGENT); }
DI unsigned xb_add(unsigned* p, unsigned v) { return __hip_atomic_fetch_add(p, v, __ATOMIC_RELAXED, __HIP_MEMORY_SCOPE_AGENT); }
DI unsigned xb_xcc_id() { return (unsigned)__builtin_amdgcn_s_getreg((3 << 11) | 20) & 0xFu; }
#define XB_SPIN(cond, bar) do { unsigned _sp = 0; while (cond) { __builtin_amdgcn_s_sleep(1); \
    if ((++_sp & 255u) == 0u) { if (xb_ld(&(bar)[XB_TMO])) break; if (_sp > XB_SPIN_CAP) { atomicAdd(&(bar)[XB_TMO], 1u); break; } } } } while (0)
struct XcdBarrier { unsigned* bar; unsigned x; volatile LAS unsigned* st; };
DI XcdBarrier xcd_barrier_post(unsigned* bar, volatile LAS unsigned* st) {
  XcdBarrier b; b.bar = bar; b.x = xb_xcc_id(); b.st = st;
  if (threadIdx.x == 0) (void)xb_add(&bar[XB_XCNT(b.x)], 1u);
  return b;
}
DI void xcd_barrier_complete(unsigned* bar, unsigned x, unsigned& nloc, unsigned& nx) {
  const unsigned G = gridDim.x * gridDim.y * gridDim.z;
  unsigned sum, cnt, mine, sp = 0u;
  for (;;) {
    sum = 0u; cnt = 0u; mine = 0u;
#pragma unroll
    for (unsigned j = 0; j < 16; ++j) { const unsigned c = xb_ld(&bar[XB_XCNT(j)]); sum += c; cnt += (c > 0u) ? 1u : 0u; mine = (j == x) ? c : mine; }
    if (sum == G) break;
    __builtin_amdgcn_s_sleep(1);
    if ((++sp & 255u) == 0u) { if (xb_ld(&bar[XB_TMO])) break; if (sp > XB_SPIN_CAP) { atomicAdd(&bar[XB_TMO], 1u); break; } }
  }
  nloc = mine > 0u ? mine : 1u; nx = cnt > 0u ? cnt : 1u;
}
DI void xcd_barrier(const XcdBarrier& b) {
  asm volatile("s_waitcnt vmcnt(0)" ::: "memory");
  __syncthreads();
  if (threadIdx.x == 0) {
    unsigned* bar = b.bar;
    __builtin_amdgcn_s_waitcnt(0);
    unsigned nloc = b.st[0], nx = b.st[1];
    if (nloc == 0u) { xcd_barrier_complete(bar, b.x, nloc, nx); b.st[0] = nloc; b.st[1] = nx; }
    const unsigned old = xb_add(&bar[XB_XSUB(b.x)], 1u);
    const unsigned gen = old / nloc;
    if (old + 1u == (gen + 1u) * nloc) {
      __builtin_amdgcn_fence(__ATOMIC_RELEASE, "agent");
      asm volatile("s_waitcnt vmcnt(0)" ::: "memory");
      const unsigned og = xb_add(&bar[XB_TOP], 1u);
      const unsigned tg = og / nx;
      if (og + 1u == (tg + 1u) * nx) xb_add(&bar[XB_TOPGEN], 1u);
      else XB_SPIN(xb_ld(&bar[XB_TOPGEN]) == tg, bar);
      __builtin_amdgcn_fence(__ATOMIC_ACQUIRE, "agent");
      xb_add(&bar[XB_XGEN(b.x)], 1u);
      asm volatile("s_waitcnt vmcnt(0)" ::: "memory");
    } else {
      XB_SPIN(xb_ld(&bar[XB_XGEN(b.x)]) == gen, bar);
      __builtin_amdgcn_fence(__ATOMIC_ACQUIRE, "agent");
      asm volatile("s_waitcnt vmcnt(0)" ::: "memory");
    }
  }
  __syncthreads();
}
#endif

struct GA {
  const bf16* A; const bf16* A2; int lda, lda2, ksplit;
  const int* ridx; int mvalid;
  const bf16* Bt; int ldb; int K;
  int kfix;
};
DI GA make_ga(const bf16* A, int lda, const bf16* Bt, int ldb, int K, int mvalid) {
  GA g; g.A = A; g.A2 = A; g.lda = lda; g.lda2 = lda; g.ksplit = K; g.ridx = nullptr; g.mvalid = mvalid; g.Bt = Bt; g.ldb = ldb; g.K = K; g.kfix = 0; return g;
}

#ifdef EMU
#define GLDS16(gptr_, lptr_) memcpy((void*)(lptr_), (const void*)(gptr_), 16)
#define BGLDS16(rsrc_, base_, voff_, soff_, lptr_) memcpy((void*)(lptr_), (const char*)(base_) + (voff_) + (soff_), 16)
#define GEMM_WAIT(N_)
#define RAW_BARRIER() __syncthreads()
#else
#define LASV __attribute__((address_space(3))) void
#define GLDS16(gptr_, lptr_) __builtin_amdgcn_global_load_lds((const void*)(gptr_), (LASV*)(lptr_), 16, 0, 0)
#define BGLDS16(rsrc_, base_, voff_, soff_, lptr_) __builtin_amdgcn_raw_ptr_buffer_load_lds(rsrc_, (LASV*)(lptr_), 16, (int)(voff_), (int)(soff_), 0, 0)
#define GEMM_WAIT(N_) asm volatile("s_waitcnt vmcnt(%0)" :: "n"(N_) : "memory")
#define RAW_BARRIER() { asm volatile("" ::: "memory"); __builtin_amdgcn_s_barrier(); asm volatile("" ::: "memory"); }
#endif
DI int perm32(int rho) { const int n = rho >> 4, i = rho & 15; return 8 * (i >> 2) + 4 * n + (i & 3); }
constexpr int SRS_OFF = 73728;
template <int NT>
DI void gemm_s(const GA& g, int m0, int n0, char* smem, f32x4 (&acc)[4][NT]) {
  constexpr int A_ELEMS = 256 * 32, B_ELEMS = 32 * NT * 32, STAGE = A_ELEMS + B_ELEMS;
  bf16* st = (bf16*)smem;
  const int tid = tid_(), lane = tid & 63, wid = tid >> 6, wr = wid >> 1, wc = wid & 1, fr = lane & 15, fq = lane >> 4;
  const int lrow = tid >> 2, pch = tid & 3;
  long aoff[2], aoff2[2], boff;
#pragma unroll
  for (int i = 0; i < 2; ++i) {
    const int row = lrow + 128 * i;
    const int lch = pch ^ ((-(row >> 2)) & 3);
    int gm = m0 + row; if (gm > g.mvalid - 1) gm = g.mvalid - 1;
    const int ar = g.ridx ? g.ridx[gm] : gm;
    aoff[i] = (long)ar * g.lda + lch * 8;
    aoff2[i] = (long)ar * g.lda2 + lch * 8;
  }
  const int cb = (NT == 4) ? tid : (tid & 255);
  {
    const int row = cb >> 2;
    const int lch = pch ^ ((-(row >> 2)) & 3);
    const int src = n0 + (row & ~31) + perm32(row & 31);
    boff = (long)src * g.ldb + lch * 8;
  }
#pragma unroll
  for (int m = 0; m < 4; ++m)
#pragma unroll
    for (int n = 0; n < NT; ++n) acc[m][n] = f32x4{0.f, 0.f, 0.f, 0.f};
  const int T = g.K / 32;
#define GEMM_DMA(t_, stg_) { const int k0_ = (t_) * 32; const bool seg2_ = (k0_ >= g.ksplit); bf16* sa_ = st + (stg_) * STAGE; \
    _Pragma("unroll") for (int i_ = 0; i_ < 2; ++i_) { \
      const bf16* ap_ = seg2_ ? (g.A2 + aoff2[i_] + (k0_ - g.ksplit)) : (g.A + aoff[i_] + k0_); \
      GLDS16(ap_, sa_ + (tid + i_ * 512) * 8); } \
    GLDS16(g.Bt + boff + k0_, sa_ + A_ELEMS + cb * 8); }
  __syncthreads();
  GEMM_DMA(0, 0)
  if (T > 1) GEMM_DMA(1, 1)
  int s_cur = 0, s_nxt = 2;
#pragma unroll 1
  for (int t = 0; t < T; ++t) {
    if (t + 1 < T) { GEMM_WAIT(3); } else { GEMM_WAIT(0); }
    RAW_BARRIER();
    if (t + 2 < T) GEMM_DMA(t + 2, s_nxt)
    const bf16* sa = st + s_cur * STAGE;
    const bf16* sb = sa + A_ELEMS;
    bf16x8 af[4], bfr[NT];
#pragma unroll
    for (int n = 0; n < NT; ++n) {
      const int row = wc * (16 * NT) + n * 16 + fr;
      bfr[n] = *(const bf16x8*)(sb + row * 32 + ((fq ^ ((-(row >> 2)) & 3)) << 3));
    }
#pragma unroll
    for (int m = 0; m < 4; ++m) {
      const int row = wr * 64 + m * 16 + fr;
      af[m] = *(const bf16x8*)(sa + row * 32 + ((fq ^ ((-(row >> 2)) & 3)) << 3));
    }
#pragma unroll
    for (int m = 0; m < 4; ++m)
#pragma unroll
      for (int n = 0; n < NT; ++n) acc[m][n] = __builtin_amdgcn_mfma_f32_16x16x32_bf16(bfr[n], af[m], acc[m][n], 0, 0, 0);
    s_cur = (s_cur == 2) ? 0 : s_cur + 1;
    s_nxt = (s_nxt == 2) ? 0 : s_nxt + 1;
  }
}
constexpr int BG_HT = 128 * 64;
DI int lds_byte(int r, int c) { const int stt = (r >> 4) * 2 + (c >> 5), rr = r & 15, cc = c & 31, ob = rr * 64 + cc * 2; return stt * 1024 + (ob ^ (((ob >> 9) & 1) << 5)); }
DI void stage_rc(int b, int& R, int& C) { const int stt = b / 1024, sb = b % 1024, swz = sb ^ (((sb >> 9) & 1) << 5); R = (stt >> 1) * 16 + swz / 64; C = (stt & 1) * 32 + (swz % 64) / 2; }
#ifdef EMU
#define BG_WAIT_V(n)
#define BG_WAIT_L(n)
#define BG_BAR __syncthreads()
#define BG_SCHED
#define BG_PRIO(x)
#else
#define BG_WAIT_V(n) asm volatile("s_waitcnt vmcnt(" #n ")" ::: "memory")
#define BG_WAIT_L(n) asm volatile("s_waitcnt lgkmcnt(" #n ")" ::: "memory")
#define BG_BAR __builtin_amdgcn_s_barrier()
#define BG_SCHED __builtin_amdgcn_sched_barrier(0)
#define BG_PRIO(x) __builtin_amdgcn_s_setprio(x)
#endif
DI void gemm_big(const GA& g, int m0, int n0, char* smem, f32x4 (&acc)[2][2][4][2]) {
  bf16* shm = (bf16*)smem;
  const int tid = tid_(), wid = tid >> 6, lane = tid & 63, wr = wid >> 2, wc = wid & 3, fr = lane & 15, fq = lane >> 4;
  unsigned aof[2][2], bof[2];
#ifdef EMU
  const int dma_lds = tid * 16;
#else
  const int dma_lds = __builtin_amdgcn_readfirstlane(tid >> 6) * 1024;
#endif
#ifndef EMU
  const __amdgpu_buffer_rsrc_t rsA = __builtin_amdgcn_make_buffer_rsrc((void*)g.A, 0, 0x7fffffff, 0x00020000);
  const __amdgpu_buffer_rsrc_t rsB = __builtin_amdgcn_make_buffer_rsrc((void*)g.Bt, 0, 0x7fffffff, 0x00020000);
#endif
#pragma unroll
  for (int i = 0; i < 2; ++i) {
    int R, C; stage_rc(tid * 16 + i * 8192, R, C);
    bof[i] = (unsigned)((n0 + (R & ~31) + perm32(R & 31)) * g.ldb + C) * 2u;
#pragma unroll
    for (int h = 0; h < 2; ++h) {
      int gm = m0 + h * 128 + R; if (gm > g.mvalid - 1) gm = g.mvalid - 1;
      const int ar = g.ridx ? g.ridx[gm] : gm;
      aof[h][i] = (unsigned)(ar * g.lda + C) * 2u;
    }
  }
#define BG_SA(b, h) (shm + ((b) * 2 + (h)) * BG_HT)
#define BG_SB(b, h) (shm + (4 + (b) * 2 + (h)) * BG_HT)
#define BG_STAGE_A(P, h, kt) { \
    _Pragma("unroll") for (int i_ = 0; i_ < 2; ++i_) BGLDS16(rsA, g.A, aof[h][i_], (kt) * 128, (char*)(P) + dma_lds + i_ * 8192); }
#define BG_STAGE_B(P, h, kt) { \
    _Pragma("unroll") for (int i_ = 0; i_ < 2; ++i_) BGLDS16(rsB, g.Bt, bof[i_], (kt) * 128 + (h) * 256 * g.ldb, (char*)(P) + dma_lds + i_ * 8192); }
#define BG_LDA(dst, b, h) _Pragma("unroll") for (int m_ = 0; m_ < 4; ++m_) _Pragma("unroll") for (int k_ = 0; k_ < 2; ++k_) \
    dst[m_][k_] = *(const bf16x8*)((const char*)BG_SA(b, h) + lds_byte(wr * 64 + m_ * 16 + fr, k_ * 32 + fq * 8))
#define BG_LDB(dst, b, h) _Pragma("unroll") for (int n_ = 0; n_ < 2; ++n_) _Pragma("unroll") for (int k_ = 0; k_ < 2; ++k_) \
    dst[n_][k_] = *(const bf16x8*)((const char*)BG_SB(b, h) + lds_byte(wc * 32 + n_ * 16 + fr, k_ * 32 + fq * 8))
#define BG_MMA(ai, bj, At_, Bt_) { BG_PRIO(1); \
    _Pragma("unroll") for (int m_ = 0; m_ < 4; ++m_) _Pragma("unroll") for (int n_ = 0; n_ < 2; ++n_) _Pragma("unroll") for (int k_ = 0; k_ < 2; ++k_) \
      acc[ai][bj][m_][n_] = __builtin_amdgcn_mfma_f32_16x16x32_bf16(Bt_[n_][k_], At_[m_][k_], acc[ai][bj][m_][n_], 0, 0, 0); \
    BG_PRIO(0); }
#pragma unroll
  for (int a_ = 0; a_ < 2; ++a_)
#pragma unroll
    for (int b_ = 0; b_ < 2; ++b_)
#pragma unroll
      for (int m_ = 0; m_ < 4; ++m_)
#pragma unroll
        for (int n_ = 0; n_ < 2; ++n_) acc[a_][b_][m_][n_] = f32x4{0.f, 0.f, 0.f, 0.f};
  bf16x8 At[4][2], B0[2][2], B1[2][2];
  const int nt = g.K / 64;
  __syncthreads();
  BG_STAGE_B(BG_SB(0, 0), 0, 0) BG_STAGE_A(BG_SA(0, 0), 0, 0)
  BG_STAGE_B(BG_SB(0, 1), 1, 0) BG_STAGE_A(BG_SA(0, 1), 1, 0)
  if (wr == 1) BG_BAR;
  BG_WAIT_V(4); BG_BAR;
  BG_STAGE_B(BG_SB(1, 0), 0, 1) BG_STAGE_A(BG_SA(1, 0), 0, 1) BG_STAGE_B(BG_SB(1, 1), 1, 1)
  BG_WAIT_V(6); BG_BAR;
#pragma unroll 1
  for (int t = 0; t < nt - 2; t += 2) {
    BG_LDB(B0, 0, 0); BG_SCHED; BG_LDA(At, 0, 0); BG_STAGE_A(BG_SA(1, 1), 1, t + 1)
    BG_WAIT_L(8); BG_BAR; BG_WAIT_L(0); BG_MMA(0, 0, At, B0) BG_BAR; BG_SCHED;
    BG_LDB(B1, 0, 1); BG_STAGE_B(BG_SB(0, 0), 0, t + 2)
    BG_BAR; BG_WAIT_L(0); BG_MMA(0, 1, At, B1) BG_BAR;
    BG_LDA(At, 0, 1); BG_STAGE_A(BG_SA(0, 0), 0, t + 2)
    BG_BAR; BG_WAIT_L(0); BG_MMA(1, 0, At, B0) BG_BAR; BG_SCHED;
    BG_STAGE_B(BG_SB(0, 1), 1, t + 2)
    BG_WAIT_V(6); BG_BAR; BG_MMA(1, 1, At, B1) BG_BAR;
    BG_LDB(B0, 1, 0); BG_SCHED; BG_LDA(At, 1, 0); BG_STAGE_A(BG_SA(0, 1), 1, t + 2)
    BG_WAIT_L(8); BG_BAR; BG_WAIT_L(0); BG_MMA(0, 0, At, B0) BG_BAR; BG_SCHED;
    BG_LDB(B1, 1, 1); BG_STAGE_B(BG_SB(1, 0), 0, t + 3)
    BG_BAR; BG_WAIT_L(0); BG_MMA(0, 1, At, B1) BG_BAR;
    BG_LDA(At, 1, 1); BG_STAGE_A(BG_SA(1, 0), 0, t + 3)
    BG_BAR; BG_WAIT_L(0); BG_MMA(1, 0, At, B0) BG_BAR; BG_SCHED;
    BG_STAGE_B(BG_SB(1, 1), 1, t + 3)
    BG_WAIT_V(6); BG_BAR; BG_MMA(1, 1, At, B1) BG_BAR;
  }
  { BG_LDB(B0, 0, 0); BG_LDA(At, 0, 0); BG_STAGE_A(BG_SA(1, 1), 1, nt - 1)
    BG_BAR; BG_WAIT_L(0); BG_MMA(0, 0, At, B0) BG_BAR;
    BG_LDB(B1, 0, 1); BG_BAR; BG_WAIT_L(0); BG_MMA(0, 1, At, B1) BG_BAR;
    BG_LDA(At, 0, 1); BG_WAIT_V(4); BG_BAR; BG_WAIT_L(0); BG_MMA(1, 0, At, B0) BG_MMA(1, 1, At, B1) BG_BAR; }
  { BG_LDB(B0, 1, 0); BG_LDA(At, 1, 0); BG_WAIT_V(2); BG_BAR; BG_WAIT_L(0); BG_MMA(0, 0, At, B0) BG_BAR;
    BG_LDB(B1, 1, 1); BG_WAIT_V(0); BG_BAR; BG_WAIT_L(0); BG_MMA(0, 1, At, B1) BG_BAR;
    BG_LDA(At, 1, 1); BG_BAR; BG_WAIT_L(0); BG_MMA(1, 0, At, B0) BG_MMA(1, 1, At, B1) BG_BAR; }
  if (wr == 0) BG_BAR;
}
#define EPIB_BEGIN(acc_, m0_, n0_, mvalid_) { const int _l = tid_() & 63, _w = tid_() >> 6, _wr = _w >> 2, _wc = _w & 3, _fr = _l & 15, _fq = _l >> 4; \
  _Pragma("unroll") for (int _ai = 0; _ai < 2; ++_ai) _Pragma("unroll") for (int _m = 0; _m < 4; ++_m) { const int row = (m0_) + _ai * 128 + _wr * 64 + _m * 16 + _fr; \
  _Pragma("unroll") for (int _bj = 0; _bj < 2; ++_bj) { const int col = (n0_) + _bj * 128 + _wc * 32 + 8 * _fq; (void)col; \
    float v[8] = {acc_[_ai][_bj][_m][0][0], acc_[_ai][_bj][_m][0][1], acc_[_ai][_bj][_m][0][2], acc_[_ai][_bj][_m][0][3], \
                  acc_[_ai][_bj][_m][1][0], acc_[_ai][_bj][_m][1][1], acc_[_ai][_bj][_m][1][2], acc_[_ai][_bj][_m][1][3]}; \
    if (row < (mvalid_)) {
#define EPIB_END }}}}

DI void ld8bf(const bf16* p, float (&v)[8]) {
  uint4 w = *(const uint4*)p;
  v[0] = __uint_as_float(w.x << 16); v[1] = __uint_as_float(w.x & 0xffff0000u); v[2] = __uint_as_float(w.y << 16); v[3] = __uint_as_float(w.y & 0xffff0000u);
  v[4] = __uint_as_float(w.z << 16); v[5] = __uint_as_float(w.z & 0xffff0000u); v[6] = __uint_as_float(w.w << 16); v[7] = __uint_as_float(w.w & 0xffff0000u);
}
DI void st8bf(bf16* p, const float (&v)[8]) { *(uint4*)p = make_uint4(pack2(v[0], v[1]), pack2(v[2], v[3]), pack2(v[4], v[5]), pack2(v[6], v[7])); }
#ifdef EMU
DI unsigned pk_u8_(float x, int sel, unsigned old) { float y = x < 0.f ? 0.f : (x > 255.f ? 255.f : x); return (old & ~(0xffu << (8 * sel))) | ((unsigned)lrintf(y) << (8 * sel)); }
#else
DI unsigned pk_u8_(float x, int sel, unsigned old) { return __builtin_amdgcn_cvt_pk_u8_f32(x, (unsigned)sel, old); }
#endif
DI void st8u8(unsigned char* p, const float (&v)[8]) {
  unsigned lo = 0u, hi = 0u;
#pragma unroll
  for (int k = 0; k < 4; ++k) { lo = pk_u8_(v[k] * 255.0f, k, lo); hi = pk_u8_(v[4 + k] * 255.0f, k, hi); }
  *(uint2*)p = make_uint2(lo, hi);
}
DI void ld8u8(const unsigned char* p, float (&v)[8]) {
  const uint2 w = *(const uint2*)p;
#pragma unroll
  for (int k = 0; k < 4; ++k) { v[k] = (float)((w.x >> (8 * k)) & 0xffu); v[4 + k] = (float)((w.y >> (8 * k)) & 0xffu); }
}
DI float4 bf4_(uint2 w) { return make_float4(__uint_as_float(w.x << 16), __uint_as_float(w.x & 0xffff0000u), __uint_as_float(w.y << 16), __uint_as_float(w.y & 0xffff0000u)); }
DI float4 bf4_(float4 v) { return v; }
DI uint2 pk4_(float4 v) { return make_uint2(pack2(v.x, v.y), pack2(v.z, v.w)); }
DI void st8f(float* p, const float (&v)[8]) { *(float4*)p = make_float4(v[0], v[1], v[2], v[3]); *(float4*)(p + 4) = make_float4(v[4], v[5], v[6], v[7]); }
#define EPI_BEGIN(NT_, acc_, m0_, n0_, mvalid_) { const int _l = tid_() & 63, _w = tid_() >> 6, _wr = _w >> 1, _wc = _w & 1, _fr = _l & 15, _fq = _l >> 4; \
  _Pragma("unroll") for (int _m = 0; _m < 4; ++_m) { const int row = (m0_) + _wr * 64 + _m * 16 + _fr; \
  _Pragma("unroll") for (int _q = 0; _q < (NT_) / 2; ++_q) { const int col = (n0_) + _wc * (16 * (NT_)) + _q * 32 + 8 * _fq; (void)col; \
    float v[8] = {acc_[_m][2 * _q][0], acc_[_m][2 * _q][1], acc_[_m][2 * _q][2], acc_[_m][2 * _q][3], \
                  acc_[_m][2 * _q + 1][0], acc_[_m][2 * _q + 1][1], acc_[_m][2 * _q + 1][2], acc_[_m][2 * _q + 1][3]}; \
    if (row < (mvalid_)) {
#define EPI_END }}}}

DI int mtile_row0(int mt, bool latonly, int TH) {
  if (!latonly) return mt * TH;
  const int per = SEQ / TH, b = mt / per, r = mt % per;
  return b * TOK + CTXL + r * TH;
}
DI int mtiles(bool latonly, int TH) { return latonly ? BATCH * (SEQ / TH) : (NTOK + TH - 1) / TH; }

struct LP {
  int l; bool last;
  const float* mod;
  char* we;
  char* s5;
};
DI LP make_lp(const Params& p, int l) {
  LP q; q.l = l; q.last = (l == DEPTH - 1);
  q.mod = (const float*)(p.ws + OFF_MOD) + (size_t)l * NB1 * 6144;
  q.we = p.ws + OFF_WEARLY + (size_t)l * WE_SIZE;
  q.s5 = p.ws + OFF_S5TAB + (size_t)l * S5_SIZE;
  return q;
}

template <class RowMap>
DI void conv_tile(const float* src, int lds, int nsrc, const float* kscale, bf16* dst, int K, int k0, int n0, char* smem, RowMap rowmap, int ndst = 1 << 30) {
  (void)smem;
  const int tid = tid_(), n4 = (tid >> 6) * 32 + (tid & 7) * 4, k8 = ((tid >> 3) & 7) * 8;
  float4 v[8];
  const bool ok = (n0 + n4 < nsrc);
  const float* sp = src + (size_t)(k0 + k8) * lds + n0 + n4;
#pragma unroll
  for (int k = 0; k < 8; ++k) v[k] = ok ? *(const float4*)(sp + (size_t)k * lds) : make_float4(0.f, 0.f, 0.f, 0.f);
  if (kscale) {
#pragma unroll
    for (int k = 0; k < 8; ++k) { const float sc = kscale[k0 + k8 + k]; v[k].x *= sc; v[k].y *= sc; v[k].z *= sc; v[k].w *= sc; }
  }
  float o[8];
#pragma unroll
  for (int k = 0; k < 8; ++k) o[k] = v[k].x;
  if (n0 + n4 + 0 < ndst) st8bf(dst + (size_t)rowmap(n0 + n4 + 0) * K + k0 + k8, o);
#pragma unroll
  for (int k = 0; k < 8; ++k) o[k] = v[k].y;
  if (n0 + n4 + 1 < ndst) st8bf(dst + (size_t)rowmap(n0 + n4 + 1) * K + k0 + k8, o);
#pragma unroll
  for (int k = 0; k < 8; ++k) o[k] = v[k].z;
  if (n0 + n4 + 2 < ndst) st8bf(dst + (size_t)rowmap(n0 + n4 + 2) * K + k0 + k8, o);
#pragma unroll
  for (int k = 0; k < 8; ++k) o[k] = v[k].w;
  if (n0 + n4 + 3 < ndst) st8bf(dst + (size_t)rowmap(n0 + n4 + 3) * K + k0 + k8, o);
}
struct RowId { DI int operator()(int n) const { return n; } };
struct RowGU { int half; DI int operator()(int f) const { return (f >> 7) * 256 + half * 128 + (f & 127); } };

constexpr int CT_WIN = 16 * (N_INP / 256), CT_UQ = 4 * 2, CT_UKV = 2 * 2, CT_GLU = 4, CT_WB = 4 * 16, CT_WOUT = 64;
constexpr int CT_EARLY = CT_WIN + CT_UQ + CT_UKV + CT_GLU + CT_WB + CT_WOUT;
constexpr int CT_EXP = NE * 3 * 64;

DI void conv_early_item(const Params& p, int l, int it, char* smem) {
  char* we = p.ws + OFF_WEARLY + (size_t)l * WE_SIZE;
  if (it < CT_WIN) {
    int kt = it % 16, nt = it / 16;
    conv_tile(p.in[I_WIN] + (size_t)l * 1024 * N_IN, N_IN, N_IN, nullptr, (bf16*)(we + WE_WIN), 1024, kt * 64, nt * 256, smem, RowId());
    return;
  }
  it -= CT_WIN;
  if (it < CT_UQ) {
    int kt = it % 4, nt = it / 4;
    conv_tile(p.in[I_WUQ] + (size_t)l * 256 * 384, 384, 384, p.in[I_GCQ] + l * 256, (bf16*)(we + WE_UQ), 256, kt * 64, nt * 256, smem, RowId(), 384);
    return;
  }
  it -= CT_UQ;
  if (it < CT_UKV) {
    int kt = it % 2, nt = it / 2;
    conv_tile(p.in[I_WUKV] + (size_t)l * 128 * 512, 512, 512, p.in[I_GCKV] + l * 128, (bf16*)(we + WE_UKV), 128, kt * 64, nt * 256, smem, RowId());
    return;
  }
  it -= CT_UKV;
  if (it < CT_GLU) {
    int kt = it;
    conv_tile(p.in[I_S5WGLU] + (size_t)l * 256 * 256, 256, 256, nullptr, (bf16*)(we + WE_GLU), 256, kt * 64, 0, smem, RowId());
    return;
  }
  it -= CT_GLU;
  if (it < CT_WB) {
    int j = it / 16, r = it % 16, kt = r % 4, nt = r / 4;
    conv_tile(p.in[I_WBRANCH] + ((size_t)l * 4 + j) * 256 * 1024, 1024, 1024, nullptr, (bf16*)(we + WE_WB) + (size_t)j * 1024 * 256, 256, kt * 64, nt * 256, smem, RowId());
    return;
  }
  it -= CT_WB;
  {
    int kt = it % 16, nt = it / 16;
    conv_tile(p.in[I_WOUT] + (size_t)l * 1024 * 1024, 1024, 1024, nullptr, (bf16*)(we + WE_WOUT), 1024, kt * 64, nt * 256, smem, RowId());
  }
}
DI void conv_expert_item(const Params& p, int l, int it, char* smem) {
  char* wx = p.ws + OFF_MIX;
  int e = it / 192, r = it % 192, which = r / 64, t = r % 64, kt = t % 16, nt = t / 16;
  size_t eoff = ((size_t)l * NE + e) * 1024 * 1024;
  if (which == 0) { RowGU rm; rm.half = 0; conv_tile(p.in[I_WGATE] + eoff, 1024, 1024, nullptr, (bf16*)(wx + WX_GU) + (size_t)e * 2048 * 1024, 1024, kt * 64, nt * 256, smem, rm); }
  else if (which == 1) { RowGU rm; rm.half = 1; conv_tile(p.in[I_WUP] + eoff, 1024, 1024, nullptr, (bf16*)(wx + WX_GU) + (size_t)e * 2048 * 1024, 1024, kt * 64, nt * 256, smem, rm); }
  else conv_tile(p.in[I_WDOWN] + eoff, 1024, 1024, nullptr, (bf16*)(wx + WX_DN) + (size_t)e * 1024 * 1024, 1024, kt * 64, nt * 256, smem, RowId());
}

DI void mod_item(const Params& p, int it, char* smem) {
  const int l = it / 96, cg0 = (it % 96) * 64;
  float* sc = (float*)smem;
  float* red = sc + NB1 * 1024;
  const int tid = tid_();
  __syncthreads();
  for (int i = tid; i < NB1 * 1024; i += NTHREADS) {
    int r = i >> 10, k = i & 1023;
    float c = (r < BATCH) ? p.in[I_C][r * 1024 + k] : p.in[I_CCTX][k];
    sc[i] = siluf_(c);
  }
  __syncthreads();
  const int cl = tid & 63, kg = tid >> 6;
  float acc[NB1];
#pragma unroll
  for (int r = 0; r < NB1; ++r) acc[r] = 0.f;
  const float* w = p.in[I_WADA] + (size_t)l * 1024 * 6144 + cg0 + cl;
  for (int k0 = kg * (1024 / NWAVES); k0 < (kg + 1) * (1024 / NWAVES); k0 += 16) {
    float wv[16];
#pragma unroll
    for (int u = 0; u < 16; ++u) wv[u] = w[(size_t)(k0 + u) * 6144];
#pragma unroll
    for (int u = 0; u < 16; ++u)
#pragma unroll
      for (int r = 0; r < NB1; ++r) acc[r] += sc[r * 1024 + k0 + u] * wv[u];
  }
#pragma unroll
  for (int r = 0; r < NB1; ++r) red[(kg * NB1 + r) * 64 + cl] = acc[r];
  __syncthreads();
  for (int i = tid; i < NB1 * 64; i += NTHREADS) {
    int r = i >> 6, c = i & 63;
    float s = 0.f;
#pragma unroll
    for (int q = 0; q < NWAVES; ++q) s += red[(q * NB1 + r) * 64 + c];
    s += p.in[I_BADA][l * 6144 + cg0 + c];
    ((float*)(p.ws + OFF_MOD))[((size_t)l * NB1 + r) * 6144 + cg0 + c] = s;
  }
}

DI void s5_tab_item(const Params& p, int it, char* smem) {
  const int l = it / 32, d = (it / 16) & 1, g = it & 15;
  char* s5 = p.ws + OFF_S5TAB + (size_t)l * S5_SIZE;
  float* lampow = (float*)(s5 + S5_LAMPOW) + (size_t)(d * 16 + g) * 17 * 64 * 2;
  float* bbar = (float*)(s5 + S5_BBAR) + (size_t)(d * 16 + g) * 64 * 16 * 2;
  float* kt = (float*)(s5 + S5_KT) + (size_t)(d * 16 + g) * 16 * 256;
  float* slam = (float*)smem;
  float* sbb = slam + 17 * 64 * 2;
  const int tid = tid_();
  const size_t pg = ((size_t)(l * 2 + d) * 16 + g);
  const float step = expf(p.in[I_S5LOGSTEP][pg]);
  __syncthreads();
  for (int i = tid; i < 17 * 64; i += NTHREADS) {
    int j = i >> 6, pp = i & 63;
    float are = p.in[I_S5ARE][pg * 64 + pp], aim = p.in[I_S5AIM][pg * 64 + pp];
    float mag = expf((float)j * step * are), ang = (float)j * step * aim;
    float re = mag * cosf(ang), im = mag * sinf(ang);
    slam[i * 2] = re; slam[i * 2 + 1] = im; lampow[i * 2] = re; lampow[i * 2 + 1] = im;
  }
  __syncthreads();
  for (int i = tid; i < 64 * 16; i += NTHREADS) {
    int pp = i >> 4;
    float are = p.in[I_S5ARE][pg * 64 + pp], aim = p.in[I_S5AIM][pg * 64 + pp];
    float x = slam[(64 + pp) * 2] - 1.0f, y = slam[(64 + pp) * 2 + 1];
    float den = are * are + aim * aim;
    float qre = (x * are + y * aim) / den, qim = (y * are - x * aim) / den;
    float bre = p.in[I_S5BRE][pg * 1024 + i], bim = p.in[I_S5BIM][pg * 1024 + i];
    float re = qre * bre - qim * bim, im = qre * bim + qim * bre;
    sbb[i * 2] = re; sbb[i * 2 + 1] = im; bbar[i * 2] = re; bbar[i * 2 + 1] = im;
  }
  __syncthreads();
  for (int i = tid; i < 16 * 256; i += NTHREADS) {
    int j = i >> 8, c = (i >> 4) & 15, c2 = i & 15;
    float s = 0.f;
    for (int pp = 0; pp < 64; ++pp) {
      float cre = p.in[I_S5CRE][pg * 1024 + c * 64 + pp], cim = p.in[I_S5CIM][pg * 1024 + c * 64 + pp];
      float lre = slam[(j * 64 + pp) * 2], lim = slam[(j * 64 + pp) * 2 + 1];
      float tre = cre * lre - cim * lim, tim = cre * lim + cim * lre;
      float bre = sbb[(pp * 16 + c2) * 2], bim = sbb[(pp * 16 + c2) * 2 + 1];
      s += tre * bre - tim * bim;
    }
    kt[i] = s;
  }
}
DI void s5_mat_item(const Params& p, int it) {
  const int l = it / 256, g = (it / 16) & 15, q = it & 15;
  char* s5 = p.ws + OFF_S5TAB + (size_t)l * S5_SIZE;
  const float* lampow = (const float*)(s5 + S5_LAMPOW);
  const float* bbar = (const float*)(s5 + S5_BBAR);
  const float* ktab = (const float*)(s5 + S5_KT);
  bf16* WA = (bf16*)(s5 + S5_WA) + (size_t)g * 256 * 256;
  bf16* W2 = (bf16*)(s5 + S5_W2) + (size_t)g * 256 * 512;
  const int tid = tid_();
  for (int i = tid; i < 16 * 256; i += NTHREADS) {
    int n = q * 16 + (i >> 8), k = i & 255;
    int d = n >> 7, ri = (n >> 6) & 1, pp = n & 63, s = k >> 4, c2 = k & 15;
    int e = (d == 0) ? (15 - s) : s;
    const float* lp = lampow + ((size_t)((d * 16 + g) * 17 + e) * 64 + pp) * 2;
    const float* bp = bbar + ((size_t)((d * 16 + g) * 64 + pp) * 16 + c2) * 2;
    float re = lp[0] * bp[0] - lp[1] * bp[1], im = lp[0] * bp[1] + lp[1] * bp[0];
    WA[(size_t)n * 256 + k] = f2bf(ri == 0 ? re : im);
  }
  for (int i = tid; i < 16 * 512; i += NTHREADS) {
    int n = q * 16 + (i >> 9), k = i & 511;
    int lq = n >> 4, c = n & 15;
    float v;
    if (k < 256) {
      int s = k >> 4, c2 = k & 15;
      v = 0.f;
      if (s <= lq) v += ktab[((size_t)(0 * 16 + g) * 16 + (lq - s)) * 256 + c * 16 + c2];
      if (s >= lq) v += ktab[((size_t)(1 * 16 + g) * 16 + (s - lq)) * 256 + c * 16 + c2];
      if (s == lq && c == c2) v += p.in[I_S5D][l * 256 + g * 16 + c];
    } else {
      int kk = k - 256, d = kk >> 7, ri = (kk >> 6) & 1, pp = kk & 63;
      int e = (d == 0) ? (lq + 1) : (16 - lq);
      size_t pg = ((size_t)(l * 2 + d) * 16 + g);
      float cre = p.in[I_S5CRE][pg * 1024 + c * 64 + pp], cim = p.in[I_S5CIM][pg * 1024 + c * 64 + pp];
      const float* lp = lampow + ((size_t)((d * 16 + g) * 17 + e) * 64 + pp) * 2;
      float re = cre * lp[0] - cim * lp[1], im = cre * lp[1] + cim * lp[0];
      v = (ri == 0) ? re : -im;
    }
    W2[(size_t)n * 512 + k] = f2bf(v);
  }
}

DI int tok_b(int tok) { return tok / TOK; }
DI int tok_j(int tok) { return tok % TOK; }
DI int tok_modrow(int tok) { return (tok_j(tok) < CTXL) ? BATCH : tok_b(tok); }

DI void normmod_row(const float (&xv)[16], const float* g, const float* shift, const float* scale, bf16* dst, float (&hout)[16]) {
  const int lane = tid_() & 63;
  float ss = 0.f;
#pragma unroll
  for (int i = 0; i < 16; ++i) ss += xv[i] * xv[i];
  ss = wave_sum(ss);
  const float rs = rsqrtf(ss * (1.0f / 1024.f) + EPS);
#pragma unroll
  for (int i = 0; i < 4; ++i) {
    int c = lane * 4 + i * 256;
    float4 gv = *(const float4*)(g + c), sh = *(const float4*)(shift + c), sc = *(const float4*)(scale + c);
    float h0 = xv[i * 4 + 0] * rs * gv.x * (1.f + sc.x) + sh.x;
    float h1 = xv[i * 4 + 1] * rs * gv.y * (1.f + sc.y) + sh.y;
    float h2 = xv[i * 4 + 2] * rs * gv.z * (1.f + sc.z) + sh.z;
    float h3 = xv[i * 4 + 3] * rs * gv.w * (1.f + sc.w) + sh.w;
    hout[i * 4 + 0] = h0; hout[i * 4 + 1] = h1; hout[i * 4 + 2] = h2; hout[i * 4 + 3] = h3;
    *(uint2*)(dst + c) = make_uint2(pack2(h0, h1), pack2(h2, h3));
  }
}

DI void prep_row_item(const Params& p, int it) {
  const int tok = it * NWAVES + (tid_() >> 6), lane = tid_() & 63;
  const int b = tok_b(tok), j = tok_j(tok);
  const float* src = (j < CTXL) ? p.in[I_CTX] + ((size_t)b * CTXL + j) * 1024 : p.in[I_X] + ((size_t)b * SEQ + (j - CTXL)) * 1024;
  float xv[16], h[16];
#pragma unroll
  for (int i = 0; i < 4; ++i) {
    float4 v = *(const float4*)(src + lane * 4 + i * 256);
    xv[i * 4] = v.x; xv[i * 4 + 1] = v.y; xv[i * 4 + 2] = v.z; xv[i * 4 + 3] = v.w;
  }
  const float* mod = (const float*)(p.ws + OFF_MOD) + (size_t)tok_modrow(tok) * 6144;
  normmod_row(xv, p.in[I_GPREMIX], mod + 0, mod + 1024, (bf16*)(p.ws + OFF_HA) + (size_t)tok * 1024, h);
}

constexpr int IP_LT = BATCH * (SEQ / 256), IP_CT = BATCH * ((CTXL + 255) / 256), IP_MT = IP_LT + IP_CT, IP_NT = N_INP / 256;
constexpr int IP_RR = (IP_MT + 7) / 8, IP_RC = (IP_NT + 1) / 2;
constexpr int IP_RC_NOGATE = (((C_GATE + 255) / 256) + 1) / 2;
constexpr int IP_RR_LAT = IP_LT / 8;
constexpr bool IP_COMPACT = (IP_LT % 8 == 0);
constexpr int IP_RECTS_ALL = IP_RR * IP_RC, IP_RECTS_LAST = IP_COMPACT ? (IP_RR * IP_RC_NOGATE + IP_RR_LAT * (IP_RC - IP_RC_NOGATE)) : IP_RECTS_ALL;
constexpr int IP_SLOTS_ALL = ((IP_RECTS_ALL + 15) / 16) * 256, IP_SLOTS_LAST = ((IP_RECTS_LAST + 15) / 16) * 256;
DI void inproj_tile(const Params& p, const LP& L, int t, char* smem) {
  const int vb = t % 256, vround = t / 256, x = vb % 8, j = vb / 8;
  const int Rc = vround * 16 + x * 2 + (j >> 4), jj = j & 15;
  int rm, rn;
  if (!L.last || !IP_COMPACT || Rc < IP_RR * IP_RC_NOGATE) { rm = Rc % IP_RR; rn = Rc / IP_RR; }
  else { const int q = Rc - IP_RR * IP_RC_NOGATE; rm = q % IP_RR_LAT; rn = IP_RC_NOGATE + q / IP_RR_LAT; }
  const int mt = rm * 8 + (jj & 7), nt = rn * 2 + (jj >> 3);
  if (mt >= IP_MT || nt >= IP_NT || rn >= IP_RC) return;
  int m0;
  if (mt < IP_LT) m0 = (mt / (SEQ / 256)) * TOK + CTXL + (mt % (SEQ / 256)) * 256;
  else { const int c = mt - IP_LT; m0 = (c / ((CTXL + 255) / 256)) * TOK + (c % ((CTXL + 255) / 256)) * 256; }
  const int n0 = nt * 256;
  const int mv = (mt < IP_LT) ? NTOK : (m0 - (m0 % TOK) + CTXL);
  if (L.last && mt >= IP_LT && n0 >= ((C_GATE + 255) / 256) * 256) return;
  GA g = make_ga((const bf16*)(p.ws + OFF_HA), 1024, (const bf16*)(L.we + WE_WIN), 1024, 1024, mv);
  f32x4 acc[2][2][4][2];
  gemm_big(g, m0, n0, smem, acc);
  bf16* P1 = (bf16*)(p.ws + OFF_P1);
  unsigned char* PG = (unsigned char*)(p.ws + OFF_PG);
  bf16* US5 = (bf16*)(p.ws + OFF_MIX + MX_US5);
  float* DT = (float*)(p.ws + OFF_DT);
  const float* dtb = p.in[I_M2DTBIAS] + L.l * 8;
  EPIB_BEGIN(acc, m0, n0, mv)
    if (col < C_S5 || (col >= C_Z && col < C_DT)) st8bf(P1 + (size_t)row * P1W + col, v);
    else if (col < C_Z) st8bf(US5 + ((size_t)((col - C_S5) >> 4) * NTOK + row) * 16 + (col & 15), v);
    else if (col < C_GATE) {
#pragma unroll
      for (int k = 0; k < 8; ++k) v[k] = softplusf_(v[k] + dtb[k]);
      st8f(DT + (size_t)row * 8, v);
    } else if (col < N_IN) {
#pragma unroll
      for (int k = 0; k < 8; ++k) v[k] = sigmoidf_(v[k]);
      st8u8(PG + (size_t)row * 4096 + (col - C_GATE), v);
    }
  EPIB_END
}

DI void rowscale_256(const bf16* P1, int m0, int c0, int width, float* srs) {
  const int r = tid_() >> 1, hf = tid_() & 1;
  int gr = m0 + r; if (gr > NTOK - 1) gr = NTOK - 1;
  const bf16* src = P1 + (size_t)gr * P1W + c0 + hf * (width / 2);
  float ss = 0.f;
  for (int i = 0; i < width / 2; i += 8) {
    float v[8]; ld8bf(src + i, v);
#pragma unroll
    for (int k = 0; k < 8; ++k) ss += v[k] * v[k];
  }
  ss += shfl_xor_(ss, 1);
  if (hf == 0) srs[r] = rsqrtf(ss / (float)width + EPS);
}
DI void rope_tab_item(const Params& p) {
  float* tab = (float*)(p.ws + OFF_ROPE);
  for (int i = tid_(); i < 64 * 8; i += NTHREADS) {
    int pos = i >> 3, k = i & 7;
    float f = expf(-(float)k * (9.210340371976184f / 8.0f));
    float a = (float)pos * f;
    tab[i * 2] = cosf(a); tab[i * 2 + 1] = sinf(a);
  }
}
DI void rope_cs(const float* tab, int pos, int i, float& c, float& s) { c = tab[(pos * 8 + i) * 2]; s = tab[(pos * 8 + i) * 2 + 1]; }

constexpr int TP_MT = (NTOK + 255) / 256;
DI void mlaq_tile(const Params& p, const LP& L, int t, char* smem) {
  const int mt = t % TP_MT, nt = t / TP_MT, m0 = mt * 256, n0 = nt * 128;
  const bf16* P1 = (const bf16*)(p.ws + OFF_P1);
  float* srs = (float*)(smem + SRS_OFF);
  GA g = make_ga(P1 + C_CQ, P1W, (const bf16*)(L.we + WE_UQ), 256, 256, NTOK);
  f32x4 acc[4][4];
  gemm_s<4>(g, m0, n0, smem, acc);
  rowscale_256(P1, m0, C_CQ, 256, srs);
  __syncthreads();
  bf16* Q = (bf16*)(p.ws + OFF_MIX + MX_Q);
  const float* ropetab = (const float*)(p.ws + OFF_ROPE);
  {
    const int l = tid_() & 63, w = tid_() >> 6, wr = w >> 1, wc = w & 1, fr = l & 15, fq = l >> 4;
#pragma unroll
    for (int m = 0; m < 4; ++m) {
      const int row = m0 + wr * 64 + m * 16 + fr;
      const int rowc = row < NTOK ? row : NTOK - 1;
      const float rsc = srs[rowc - m0];
      const int b = tok_b(rowc), j = tok_j(rowc);
#pragma unroll
      for (int q = 0; q < 2; ++q) {
        const int col = n0 + wc * 64 + q * 32 + 8 * fq;
        const int h = col / 96, dd = col % 96;
        float v[8] = {acc[m][2 * q][0], acc[m][2 * q][1], acc[m][2 * q][2], acc[m][2 * q][3], acc[m][2 * q + 1][0], acc[m][2 * q + 1][1], acc[m][2 * q + 1][2], acc[m][2 * q + 1][3]};
        float vp[8];
#pragma unroll
        for (int k = 0; k < 8; ++k) vp[k] = shfl_xor_(v[k], 16);
        if (dd >= 64 && j >= CTXL) {
          const int tl = j - CTXL, pos = ((dd - 64) < 16) ? (tl / GRID_W) : (tl % GRID_W);
          const bool lo = ((dd & 8) == 0);
#pragma unroll
          for (int k = 0; k < 8; ++k) {
            float c, sn; rope_cs(ropetab, pos, k, c, sn);
            v[k] = lo ? (v[k] * c - vp[k] * sn) : (v[k] * c + vp[k] * sn);
          }
        }
#pragma unroll
        for (int k = 0; k < 8; ++k) v[k] *= rsc;
        if (row < NTOK) st8bf(Q + (((size_t)b * 4 + h) * TOK + j) * 96 + dd, v);
      }
    }
  }
}
DI void mlakv_tile(const Params& p, const LP& L, int t, char* smem) {
  const int mt = t % TP_MT, h = t / TP_MT, m0 = mt * 256, n0 = h * 128;
  const bf16* P1 = (const bf16*)(p.ws + OFF_P1);
  float* srs = (float*)(smem + SRS_OFF);
  GA g = make_ga(P1 + C_CKV, P1W, (const bf16*)(L.we + WE_UKV), 128, 128, NTOK);
  f32x4 acc[4][4];
  gemm_s<4>(g, m0, n0, smem, acc);
  rowscale_256(P1, m0, C_CKV, 128, srs);
  __syncthreads();
  bf16* K = (bf16*)(p.ws + OFF_MIX + MX_K);
  bf16* VT = (bf16*)(p.ws + OFF_MIX + MX_VTM);
  const float* ropetab = (const float*)(p.ws + OFF_ROPE);
  EPI_BEGIN(4, acc, m0, n0, NTOK)
    const float rsc = srs[row - m0];
    const int b = tok_b(row), j = tok_j(row), dd = col - n0;
#pragma unroll
    for (int k = 0; k < 8; ++k) v[k] *= rsc;
    if (dd < 64) st8bf(K + (((size_t)b * 4 + h) * TOK + j) * 96 + dd, v);
    else {
#pragma unroll
      for (int k = 0; k < 8; ++k) VT[(((size_t)b * 4 + h) * 64 + (dd - 64 + k)) * TOK + j] = f2bf(v[k]);
    }
  EPI_END
  for (int i = tid_(); i < 256 * 16; i += NTHREADS) {
    int r = i >> 4, q = i & 15;
    int row = m0 + r;
    if (row < NTOK) {
      int b = tok_b(row), j = tok_j(row);
      int blk = q >> 3, i8 = q & 7;
      float x1 = bf2f(P1[(size_t)row * P1W + C_KR + blk * 16 + i8]), x2 = bf2f(P1[(size_t)row * P1W + C_KR + blk * 16 + i8 + 8]);
      float o1 = x1, o2 = x2;
      if (j >= CTXL) {
        int tl = j - CTXL, pos = blk == 0 ? (tl / GRID_W) : (tl % GRID_W);
        float c, sn; rope_cs(ropetab, pos, i8, c, sn);
        o1 = x1 * c - x2 * sn; o2 = x2 * c + x1 * sn;
      }
      bf16* kd = K + (((size_t)b * 4 + h) * TOK + j) * 96 + 64 + blk * 16 + i8;
      kd[0] = f2bf(o1); kd[8] = f2bf(o2);
    }
  }
}
DI void navt_item(const Params& p, int it, char* smem) {
  bf16* s = (bf16*)smem;
  const bf16* P1 = (const bf16*)(p.ws + OFF_P1);
  bf16* VT = (bf16*)(p.ws + OFF_MIX + MX_VTN);
  const int tok0 = it * 64, tid = tid_();
  const int b = tok_b(tok0), j0 = tok_j(tok0);
  __syncthreads();
  for (int i = tid; i < 64 * 32; i += NTHREADS) {
    int r = i >> 5, c8 = i & 31;
    *(uint4*)(s + r * 264 + c8 * 8) = *(const uint4*)(P1 + (size_t)(tok0 + r) * P1W + C_NA + 512 + c8 * 8);
  }
  __syncthreads();
  for (int i = tid; i < 256 * 8; i += NTHREADS) {
    int ch = i >> 3, t8 = i & 7;
    unsigned w[4];
#pragma unroll
    for (int q = 0; q < 4; ++q) w[q] = (unsigned)s[(t8 * 8 + 2 * q) * 264 + ch] | ((unsigned)s[(t8 * 8 + 2 * q + 1) * 264 + ch] << 16);
    *(uint4*)(VT + ((size_t)b * 256 + ch) * TOK + j0 + t8 * 8) = make_uint4(w[0], w[1], w[2], w[3]);
  }
}
constexpr int M2C_TOK = 128, M2C_ITEMS = NTOK / M2C_TOK;
DI void m2conv_item(const Params& p, const LP& L, int it) {
  const bf16* P1 = (const bf16*)(p.ws + OFF_P1);
  bf16* XB = (bf16*)(p.ws + OFF_MIX + MX_XBC);
  const int tok0 = it * M2C_TOK;
  const float* cw = p.in[I_M2CONVW] + (size_t)L.l * 4 * 768;
  const float* cb = p.in[I_M2CONVB] + (size_t)L.l * 768;
  for (int task = tid_(); task < 96 * (M2C_TOK / 8); task += NTHREADS) {
    const int cg = task % 96, tb = task / 96, c0 = cg * 8;
    const int tokb = tok0 + tb * 8, jt = tok_j(tokb), base = tokb - jt;
    const int slo = (jt < CTXL) ? 0 : CTXL, shi = (jt < CTXL) ? CTXL : TOK;
    float w[4][8], bias[8];
#pragma unroll
    for (int k = 0; k < 4; ++k) { float4 a = *(const float4*)(cw + k * 768 + c0), b4 = *(const float4*)(cw + k * 768 + c0 + 4);
      w[k][0] = a.x; w[k][1] = a.y; w[k][2] = a.z; w[k][3] = a.w; w[k][4] = b4.x; w[k][5] = b4.y; w[k][6] = b4.z; w[k][7] = b4.w; }
    { float4 a = *(const float4*)(cb + c0), b4 = *(const float4*)(cb + c0 + 4);
      bias[0] = a.x; bias[1] = a.y; bias[2] = a.z; bias[3] = a.w; bias[4] = b4.x; bias[5] = b4.y; bias[6] = b4.z; bias[7] = b4.w; }
    float xin[11][8];
#pragma unroll
    for (int r = 0; r < 11; ++r) {
      const int j = jt - 2 + r;
      if (j >= slo && j < shi) ld8bf(P1 + (size_t)(base + j) * P1W + C_XBC + c0, xin[r]);
      else {
#pragma unroll
        for (int c = 0; c < 8; ++c) xin[r][c] = 0.f;
      }
    }
    float y[8][8];
#pragma unroll
    for (int t = 0; t < 8; ++t) {
#pragma unroll
      for (int c = 0; c < 8; ++c) y[t][c] = siluf_(bias[c] + w[0][c] * xin[t][c] + w[1][c] * xin[t + 1][c] + w[2][c] * xin[t + 2][c] + w[3][c] * xin[t + 3][c]);
      st8bf(XB + (size_t)(base + jt + t) * 768 + c0, y[t]);
    }
    if (c0 < 512) {
      bf16* XT = (bf16*)(p.ws + OFF_MIX + MX_XBT) + ((size_t)(base / TOK) * 512 + c0) * TOK + jt;
#pragma unroll
      for (int c = 0; c < 8; ++c) {
        float col[8];
#pragma unroll
        for (int t = 0; t < 8; ++t) col[t] = y[t][c];
        st8bf(XT + (size_t)c * TOK, col);
      }
    }
  }
}
DI int m2_seq2tok(int sq, int dir) { return (dir == 0) ? sq : (sq < CTXL ? (CTXL - 1 - sq) : (TOK - 1 - (sq - CTXL))); }
constexpr int M2S_ITEMS = BATCH * 8 * (TOK / 64) / NWAVES;
DI void m2scal_item(const Params& p, const LP& L, int it) {
  const int w = it * NWAVES + (tid_() >> 6), lane = tid_() & 63;
  const int ch = w % (TOK / 64), r = w / (TOK / 64), hd = r & 3, dir = (r >> 2) & 1, b = r >> 3;
  const float a = -expf(p.in[I_M2ALOG][(L.l * 2 + dir) * 4 + hd]);
  const int sq = ch * 64 + lane, j = m2_seq2tok(sq, dir);
  const float dt = ((const float*)(p.ws + OFF_DT))[((size_t)b * TOK + j) * 8 + dir * 4 + hd];
  float cs = dt * a;
#pragma unroll
  for (int d = 1; d < 64; d <<= 1) { float o = shfl_up_(cs, d); if (lane >= d) cs += o; }
  const float sl = shfl_(cs, 63);
  float* o = (float*)(p.ws + OFF_MIX + MX_M2S) + ((size_t)((b * 2 + dir) * 4 + hd) * TOK + sq) * 4;
  *(float4*)o = make_float4(cs, dt, dt * __expf(sl - cs), cs * 1.4426950408889634f - log2f(dt));
}
constexpr int S5_MT = (MCH + 255) / 256;
DI void s5a_tile(const Params& p, const LP& L, int t, char* smem) {
  const int g = t / (S5_MT * 2), r = t % (S5_MT * 2), mt = r / 2, nt = r % 2;
  const int m0 = mt * 256, n0 = nt * 128;
  GA ga = make_ga((const bf16*)(p.ws + OFF_MIX + MX_US5) + (size_t)g * NTOK * 16, 256, (const bf16*)(L.s5 + S5_WA) + (size_t)g * 65536, 256, 256, MCH);
  f32x4 acc[4][4];
  gemm_s<4>(ga, m0, n0, smem, acc);
  float* HE = (float*)(p.ws + OFF_MIX + MX_HEND) + (size_t)g * MCH * 256;
  EPI_BEGIN(4, acc, m0, n0, MCH)
    st8f(HE + (size_t)row * 256 + col, v);
  EPI_END
}
DI int s5_chunk_of(int i, int d) { return (d == 0) ? i : (i < NCC ? (NCC - 1 - i) : (NCH - 1 - (i - NCC))); }
DI void s5carry_item(const Params& p, const LP& L, int it) {
  const int w = it * NWAVES + (tid_() >> 6), lane = tid_() & 63;
  const int d = w / (16 * BATCH), g = (w / BATCH) & 15, b = w % BATCH;
  const float* lp = (const float*)(L.s5 + S5_LAMPOW) + ((size_t)((d * 16 + g) * 17 + 16) * 64 + lane) * 2;
  const float lre = lp[0], lim = lp[1];
  const float* HE = (const float*)(p.ws + OFF_MIX + MX_HEND) + ((size_t)g * MCH + (size_t)b * NCH) * 256 + d * 128;
  bf16* HI = (bf16*)(p.ws + OFF_MIX + MX_HIN) + ((size_t)g * MCH + (size_t)b * NCH) * 256 + d * 128;
  float cre = 0.f, cim = 0.f;
  constexpr int SB = 16;
  float are[SB], aim[SB], bre[SB], bim[SB];
#define S5_LOAD(RE_, IM_, I0_) { _Pragma("unroll") for (int k_ = 0; k_ < SB; ++k_) { const int ii_ = (I0_) + k_; \
    if (ii_ < NCH) { const int ch_ = s5_chunk_of(ii_, d); RE_[k_] = HE[(size_t)ch_ * 256 + lane]; IM_[k_] = HE[(size_t)ch_ * 256 + 64 + lane]; } } }
#define S5_STEP(RE_, IM_, I0_) { _Pragma("unroll") for (int k_ = 0; k_ < SB; ++k_) { const int ii_ = (I0_) + k_; \
    if (ii_ < NCH) { const int ch_ = s5_chunk_of(ii_, d); \
      HI[(size_t)ch_ * 256 + lane] = f2bf(cre); HI[(size_t)ch_ * 256 + 64 + lane] = f2bf(cim); \
      const float nre_ = lre * cre - lim * cim + RE_[k_], nim_ = lre * cim + lim * cre + IM_[k_]; \
      cre = nre_; cim = nim_; } } }
#pragma unroll
  for (int k = 0; k < SB; ++k) { are[k] = 0.f; aim[k] = 0.f; bre[k] = 0.f; bim[k] = 0.f; }
  S5_LOAD(are, aim, 0)
  for (int i0 = 0; i0 < NCH; i0 += 2 * SB) {
    S5_LOAD(bre, bim, i0 + SB)
    S5_STEP(are, aim, i0)
    S5_LOAD(are, aim, i0 + 2 * SB)
    S5_STEP(bre, bim, i0 + SB)
  }
#undef S5_LOAD
#undef S5_STEP
}
DI void s5c_tile(const Params& p, const LP& L, int t, char* smem) {
  const int g = t / (S5_MT * 2), r = t % (S5_MT * 2), mt = r / 2, nt = r % 2;
  const int m0 = mt * 256, n0 = nt * 128;
  GA ga = make_ga((const bf16*)(p.ws + OFF_MIX + MX_US5) + (size_t)g * NTOK * 16, 256, (const bf16*)(L.s5 + S5_W2) + (size_t)g * 256 * 512, 512, 512, MCH);
  ga.A2 = (const bf16*)(p.ws + OFF_MIX + MX_HIN) + (size_t)g * MCH * 256; ga.lda2 = 256; ga.ksplit = 256;
  f32x4 acc[4][4];
  gemm_s<4>(ga, m0, n0, smem, acc);
  bf16* Z = (bf16*)(p.ws + OFF_MIX + MX_Z);
  EPI_BEGIN(4, acc, m0, n0, MCH)
#pragma unroll
    for (int k = 0; k < 8; ++k) v[k] = geluf_(v[k]);
    st8bf(Z + ((size_t)row * 16 + (col >> 4)) * 256 + g * 16 + (col & 15), v);
  EPI_END
}

#ifdef EMU
DI float fmax_(float a, float b) { return a > b ? a : b; }
#else
DI float fmax_(float a, float b) { return __builtin_fmaxf(a, b); }
#endif
constexpr int AT_LDV = 76;
struct NaInfo { int r, qc, rs, cs; };
template <int DK, bool NA>
DI void attn_block(const bf16* qrow, bool active, const bf16* Kp, int kstride, const bf16* Vt,
                   int ka0, int ntile_a, int arow0, int kb0, int ntile_b,
                   const float* srpb, NaInfo ni, float scale, bf16* orow, char* smem) {
  constexpr int LDK = DK + 8, KCH = DK / 8;
  constexpr int KT_BYTES = 64 * LDK * 2, VT_BYTES = 64 * AT_LDV * 2;
  constexpr int NKL = (64 * KCH + NTHREADS - 1) / NTHREADS;
  const int tid = tid_(), lane = tid & 63, half = lane >> 5, r = lane & 31;
  bf16* sK = (bf16*)smem;
  bf16* sV = (bf16*)(smem + 2 * KT_BYTES);
  bf16x8 qf[DK / 16];
  f32x16 o0, o1;
  float m = -1e30f, l = 0.f;
  const float scale2 = scale * 1.4426950408889634f;
#pragma unroll
  for (int ks = 0; ks < DK / 16; ++ks) qf[ks] = active ? *(const bf16x8*)(qrow + ks * 16 + 8 * half) : bf16x8{0, 0, 0, 0, 0, 0, 0, 0};
#pragma unroll
  for (int i = 0; i < 16; ++i) { o0[i] = 0.f; o1[i] = 0.f; }
  const int NTL = ntile_a + ntile_b;
  u32x4 rk[NKL], rv[1];
#pragma unroll
  for (int i = 0; i < NKL; ++i) rk[i] = u32x4{0u, 0u, 0u, 0u};
  auto key0_of = [&](int t) { return t < ntile_a ? ka0 + 64 * t : kb0 + 64 * (t - ntile_a); };
#define AT_GLOAD(t_) { const int k0_ = key0_of(t_); \
    _Pragma("unroll") for (int i_ = 0; i_ < NKL; ++i_) { const int c_ = tid + i_ * NTHREADS; const int key_ = c_ / KCH, ch_ = c_ % KCH; \
      if (c_ < 64 * KCH) rk[i_] = *(const u32x4*)(Kp + (size_t)(k0_ + key_) * kstride + ch_ * 8); } \
    { const int d_ = tid >> 3, ch_ = tid & 7; rv[0] = *(const u32x4*)(Vt + (size_t)d_ * TOK + k0_ + ch_ * 8); } }
#define AT_SSTORE(buf_) { \
    _Pragma("unroll") for (int i_ = 0; i_ < NKL; ++i_) { const int c_ = tid + i_ * NTHREADS; const int key_ = c_ / KCH, ch_ = c_ % KCH; \
      if (c_ < 64 * KCH) *(u32x4*)(sK + (buf_) * (64 * LDK) + key_ * LDK + ch_ * 8) = rk[i_]; } \
    { const int d_ = tid >> 3, ch_ = tid & 7; \
      bf16* dst_ = sV + (buf_) * (64 * AT_LDV) + d_ * AT_LDV + ch_ * 8; \
      *(uint2*)dst_ = make_uint2(rv[0][0], rv[0][1]); *(uint2*)(dst_ + 4) = make_uint2(rv[0][2], rv[0][3]); } }
  __syncthreads();
  AT_GLOAD(0) AT_SSTORE(0)
  __syncthreads();
#pragma unroll 1
  for (int t = 0; t < NTL; ++t) {
    const int buf = t & 1;
    if (t + 1 < NTL) AT_GLOAD(t + 1)
    bool doit = active;
    int trow0 = 0;
    if (NA && t < ntile_a) {
      trow0 = arow0 + t * (64 / GRID_W);
      doit = active && (trow0 + (64 / GRID_W) > ni.rs) && (trow0 < ni.rs + WIN_R);
    }
    if (doit) {
      const bf16* kb = sK + buf * (64 * LDK);
      const bf16* vb = sV + buf * (64 * AT_LDV);
      f32x16 s0, s1;
#pragma unroll
      for (int i = 0; i < 16; ++i) { s0[i] = 0.f; s1[i] = 0.f; }
      bf16x8 ka0[DK / 16], ka1[DK / 16];
#pragma unroll
      for (int ks = 0; ks < DK / 16; ++ks) {
        ka0[ks] = *(const bf16x8*)(kb + r * LDK + ks * 16 + 8 * half);
        ka1[ks] = *(const bf16x8*)(kb + (32 + r) * LDK + ks * 16 + 8 * half);
      }
      BG_SCHED;
#pragma unroll
      for (int ks = 0; ks < DK / 16; ++ks) {
        s0 = __builtin_amdgcn_mfma_f32_32x32x16_bf16(ka0[ks], qf[ks], s0, 0, 0, 0);
        s1 = __builtin_amdgcn_mfma_f32_32x32x16_bf16(ka1[ks], qf[ks], s1, 0, 0, 0);
      }
      uint2 va0[4], va1[4], vb0[4], vb1[4];
#pragma unroll
      for (int kq = 0; kq < 4; ++kq) {
        const bf16* v0 = vb + r * AT_LDV + 16 * kq + 4 * half;
        const bf16* v1 = vb + (r + 32) * AT_LDV + 16 * kq + 4 * half;
        va0[kq] = *(const uint2*)v0; va1[kq] = *(const uint2*)(v0 + 8); vb0[kq] = *(const uint2*)v1; vb1[kq] = *(const uint2*)(v1 + 8);
      }
      BG_SCHED;
      float mx = -INFINITY;
      if (NA && t < ntile_a) {
#pragma unroll
        for (int i = 0; i < 16; ++i) {
          const int kk = (i & 3) + 8 * (i >> 2) + 4 * half;
#pragma unroll
          for (int hb = 0; hb < 2; ++hb) {
            const int kq = kk + 32 * hb;
            const int kr = trow0 + kq / GRID_W, kc = kq % GRID_W;
            const bool ok = (kr >= ni.rs) && (kr < ni.rs + WIN_R) && (kc >= ni.cs) && (kc < ni.cs + WIN_C);
            const float bias = ok ? srpb[(kr - ni.r + 7) * 31 + (kc - ni.qc + 15)] * 1.4426950408889634f : -INFINITY;
            if (hb == 0) { s0[i] = s0[i] * scale2 + bias; mx = fmax_(mx, s0[i]); }
            else { s1[i] = s1[i] * scale2 + bias; mx = fmax_(mx, s1[i]); }
          }
        }
      } else {
        s0 = s0 * scale2; s1 = s1 * scale2;
#pragma unroll
        for (int i = 0; i < 16; ++i) mx = fmax_(mx, fmax_(s0[i], s1[i]));
      }
      mx = fmax_(mx, shfl_xor_(mx, 32));
      const float mn = fmax_(m, mx);
      const float alpha = exp2f_(m - mn);
      const bool same = (mn == m);
      m = mn;
      float ps = 0.f;
      { const float nmn = -mn; s0 = s0 + nmn; s1 = s1 + nmn; }
#pragma unroll
      for (int i = 0; i < 16; ++i) { s0[i] = exp2f_(s0[i]); s1[i] = exp2f_(s1[i]); }
      { const f32x16 st = s0 + s1;
        ps = ((st[0] + st[1]) + (st[2] + st[3])) + ((st[4] + st[5]) + (st[6] + st[7])) + (((st[8] + st[9]) + (st[10] + st[11])) + ((st[12] + st[13]) + (st[14] + st[15]))); }
      l = l * alpha + ps;
      if (!wave_all_(same)) {
#pragma unroll
        for (int i = 0; i < 16; ++i) { o0[i] *= alpha; o1[i] *= alpha; }
      }
#pragma unroll
      for (int kq = 0; kq < 4; ++kq) {
        u32x4 pw;
#pragma unroll
        for (int j = 0; j < 4; ++j) pw[j] = (kq < 2) ? pack2(s0[8 * (kq & 1) + 2 * j], s0[8 * (kq & 1) + 2 * j + 1]) : pack2(s1[8 * (kq & 1) + 2 * j], s1[8 * (kq & 1) + 2 * j + 1]);
        const bf16x8 pf = __builtin_bit_cast(bf16x8, pw);
        const uint2 a0 = va0[kq], a1 = va1[kq], b0 = vb0[kq], b1 = vb1[kq];
        bf16x8 va, vbb;
        va[0] = (short)(a0.x & 0xffff); va[1] = (short)(a0.x >> 16); va[2] = (short)(a0.y & 0xffff); va[3] = (short)(a0.y >> 16);
        va[4] = (short)(a1.x & 0xffff); va[5] = (short)(a1.x >> 16); va[6] = (short)(a1.y & 0xffff); va[7] = (short)(a1.y >> 16);
        vbb[0] = (short)(b0.x & 0xffff); vbb[1] = (short)(b0.x >> 16); vbb[2] = (short)(b0.y & 0xffff); vbb[3] = (short)(b0.y >> 16);
        vbb[4] = (short)(b1.x & 0xffff); vbb[5] = (short)(b1.x >> 16); vbb[6] = (short)(b1.y & 0xffff); vbb[7] = (short)(b1.y >> 16);
        o0 = __builtin_amdgcn_mfma_f32_32x32x16_bf16(va, pf, o0, 0, 0, 0);
        o1 = __builtin_amdgcn_mfma_f32_32x32x16_bf16(vbb, pf, o1, 0, 0, 0);
      }
    }
    if (t + 1 < NTL) AT_SSTORE(buf ^ 1)
    __syncthreads();
  }
  if (active) {
    const float lt = l + shfl_xor_(l, 32);
    const float inv = rcp_(lt);
#pragma unroll
    for (int gI = 0; gI < 4; ++gI) {
      const int d0 = 8 * gI + 4 * half;
      *(uint2*)(orow + d0) = make_uint2(pack2(o0[4 * gI] * inv, o0[4 * gI + 1] * inv), pack2(o0[4 * gI + 2] * inv, o0[4 * gI + 3] * inv));
      *(uint2*)(orow + 32 + d0) = make_uint2(pack2(o1[4 * gI] * inv, o1[4 * gI + 1] * inv), pack2(o1[4 * gI + 2] * inv, o1[4 * gI + 3] * inv));
    }
  }
}
DI void mla_attn_item(const Params& p, int it, bool ctxq, char* smem) {
  const int nqb = ctxq ? (CTXL + 255) / 256 : SEQ / 256;
  const int b = it / (4 * nqb), h = (it / nqb) & 3, qb = it % nqb;
  const int lane = tid_() & 63, wid = tid_() >> 6;
  const int nq = ctxq ? CTXL : SEQ, q0 = qb * 256 + wid * 32;
  const bool active = q0 < nq;
  const int jq = (ctxq ? 0 : CTXL) + (active ? q0 : 0) + (lane & 31);
  const bf16* Q = (const bf16*)(p.ws + OFF_MIX + MX_Q) + ((size_t)b * 4 + h) * TOK * 96;
  const bf16* K = (const bf16*)(p.ws + OFF_MIX + MX_K) + ((size_t)b * 4 + h) * TOK * 96;
  const bf16* VT = (const bf16*)(p.ws + OFF_MIX + MX_VTM) + ((size_t)b * 4 + h) * 64 * TOK;
  bf16* O = (bf16*)(p.ws + OFF_O) + ((size_t)b * TOK + jq) * 1024 + 0 * 256 + h * 64;
  NaInfo ni; ni.r = 0; ni.qc = 0; ni.rs = 0; ni.cs = 0;
  attn_block<96, false>(Q + (size_t)jq * 96, active, K, 96, VT, 0, 0, 0, 0, (ctxq ? CTXL : TOK) / 64, nullptr, ni, 0.10206207261596577f, O, smem);
}
DI void na_attn_item(const Params& p, const LP& L, int it, bool ctxq, char* smem) {
  const int nqb = ctxq ? (CTXL + 255) / 256 : SEQ / 256;
  const int b = it / (4 * nqb), h = (it / nqb) & 3, qb = it % nqb;
  const int tid = tid_(), lane = tid & 63, wid = tid >> 6;
  const int nq = ctxq ? CTXL : SEQ, q0 = qb * 256 + wid * 32;
  const bool active = q0 < nq;
  const int jq = (ctxq ? 0 : CTXL) + (active ? q0 : 0) + (lane & 31);
  const bf16* P1 = (const bf16*)(p.ws + OFF_P1) + (size_t)b * TOK * P1W;
  const bf16* VT = (const bf16*)(p.ws + OFF_MIX + MX_VTN) + ((size_t)b * 4 + h) * 64 * TOK;
  const bf16* Kb = P1 + C_NA + 256 + h * 64;
  bf16* O = (bf16*)(p.ws + OFF_O) + ((size_t)b * TOK + jq) * 1024 + 1 * 256 + h * 64;
  constexpr int AT_END64 = 2 * (64 * 72 * 2) + 2 * (64 * AT_LDV * 2);
  float* srpb = (float*)(smem + AT_END64);
  NaInfo ni; ni.r = 0; ni.qc = 0; ni.rs = 0; ni.cs = 0;
  int ka0 = 0, nta = 0, arow0 = 0;
  if (!ctxq) {
    __syncthreads();
    const float* rpb = p.in[I_RPB] + ((size_t)L.l * 4 + h) * 15 * 31;
    for (int i = tid; i < 15 * 31; i += NTHREADS) srpb[i] = rpb[i];
    const int tl = q0 + (lane & 31);
    ni.r = tl / GRID_W; ni.qc = tl % GRID_W;
    int rs = ni.r - WIN_R / 2; rs = rs < 0 ? 0 : (rs > ROWS - WIN_R ? ROWS - WIN_R : rs);
    int cs = ni.qc - WIN_C / 2; cs = cs < 0 ? 0 : (cs > GRID_W - WIN_C ? GRID_W - WIN_C : cs);
    ni.rs = rs; ni.cs = cs;
    constexpr int RPT = 64 / GRID_W;
    const int rfirst = (qb * 256) / GRID_W, rlast = (qb * 256 + 255) / GRID_W;
    int rs_f = rfirst - WIN_R / 2; rs_f = rs_f < 0 ? 0 : (rs_f > ROWS - WIN_R ? ROWS - WIN_R : rs_f);
    int rs_l = rlast - WIN_R / 2; rs_l = rs_l < 0 ? 0 : (rs_l > ROWS - WIN_R ? ROWS - WIN_R : rs_l);
    arow0 = (rs_f / RPT) * RPT;
    const int row_hi = rs_l + WIN_R;
    nta = (row_hi - arow0 + RPT - 1) / RPT;
    ka0 = CTXL + arow0 * GRID_W;
  }
  attn_block<64, true>(P1 + (size_t)jq * P1W + C_NA + h * 64, active, Kb, P1W, VT, ka0, nta, arow0, 0, CTXL / 64, srpb, ni, 0.125f, O, smem);
}

constexpr int M2_LDB = 136, M2_LDX = 72;
constexpr int M2_OFF_B = 0;
constexpr int M2_OFF_C = M2_OFF_B + 64 * M2_LDB * 2;
constexpr int M2_OFF_HD = M2_OFF_C + 64 * M2_LDB * 2;
constexpr int M2H_H = 0;
constexpr int M2H_XT = M2H_H + 64 * M2_LDB * 2;
constexpr int M2H_BT = M2H_XT + 64 * M2_LDX * 2;
constexpr int M2H_S = M2H_BT + 128 * M2_LDX * 2;
constexpr int M2H_X = M2H_S + 3 * 64 * 4;
constexpr int M2H_SIZE = M2H_X + 64 * M2_LDX * 2;
constexpr int M2_SMEM = M2_OFF_HD + 2 * M2H_SIZE;
static_assert(M2_SMEM <= SMEM_BYTES, "m2 smem");
DI u32x4 rev8_(u32x4 v) {
  return u32x4{(v[3] >> 16) | (v[3] << 16), (v[2] >> 16) | (v[2] << 16), (v[1] >> 16) | (v[1] << 16), (v[0] >> 16) | (v[0] << 16)};
}
DI void m2scan_item(const Params& p, const LP& L, int it, char* smem) {
  const int b = it / 8, grp = (it >> 2) & 1, dir = (it >> 1) & 1, seg1 = it & 1;
  const int cbeg = seg1 ? M2_SPLIT : 0, cend = seg1 ? TOK : M2_SPLIT;
  const int tid = tid_(), lane = tid & 63, wid = tid >> 6, half = lane >> 5, r = lane & 31;
  const int hsel = wid >> 2, wl = wid & 3, hd = grp * 2 + hsel;
  bf16* sB = (bf16*)(smem + M2_OFF_B);
  bf16* sC = (bf16*)(smem + M2_OFF_C);
  char* hb = smem + M2_OFF_HD + hsel * M2H_SIZE;
  bf16* sH = (bf16*)(hb + M2H_H);
  bf16* sXT = (bf16*)(hb + M2H_XT);
  bf16* sBT = (bf16*)(hb + M2H_BT);
  float* sS = (float*)(hb + M2H_S);
  float* sDt = sS + 64;
  float* sW = sS + 128;
  const bf16* XB = (const bf16*)(p.ws + OFF_MIX + MX_XBC) + (size_t)b * TOK * 768;
  const bf16* XT = (const bf16*)(p.ws + OFF_MIX + MX_XBT) + (size_t)b * 512 * TOK;
  const float* SC = (const float*)(p.ws + OFF_MIX + MX_M2S) + (size_t)((b * 2 + dir) * 4 + hd) * TOK * 4;
  float* YM = (float*)(p.ws + OFF_HA) + ((size_t)dir * NTOK + (size_t)b * TOK) * 256;
  const int pb = wl & 1, tb = wl >> 1, nb0 = 2 * (wl >> 1);
  f32x16 hst[2];
#pragma unroll
  for (int i = 0; i < 16; ++i) { hst[0][i] = 0.f; hst[1][i] = 0.f; }
  __syncthreads();
  for (int i = tid; i < 2 * M2H_SIZE / 4; i += NTHREADS) ((unsigned*)(smem + M2_OFF_HD))[i] = 0u;
  __syncthreads();
  u32x4 rxt[2], rbt[2], rb[2], rc[2];
  float4 rsc = make_float4(0.f, 0.f, 0.f, 0.f);
#define M2_TLOAD(rowptr_, sq0_) (*(const u32x4*)((rowptr_) + ((dir == 0) ? (sq0_) : m2_seq2tok((sq0_) + 7, 1))))
#define M2_GLOAD(c0_) { \
    _Pragma("unroll") for (int q_ = 0; q_ < 2; ++q_) { const int i_ = tid + q_ * NTHREADS; const int h2_ = i_ >> 9, t8_ = ((i_ >> 6) & 7) * 8, pp_ = i_ & 63; \
      rxt[q_] = M2_TLOAD(XT + (size_t)((grp * 2 + h2_) * 64 + pp_) * TOK, (c0_) + t8_); } \
    _Pragma("unroll") for (int q_ = 0; q_ < 2; ++q_) { const int i_ = tid + q_ * NTHREADS; const int t8_ = (i_ >> 7) * 8, nn_ = i_ & 127; \
      rbt[q_] = M2_TLOAD(XT + (size_t)(256 + grp * 128 + nn_) * TOK, (c0_) + t8_); } \
    _Pragma("unroll") for (int q_ = 0; q_ < 2; ++q_) { const int i_ = tid + q_ * NTHREADS; const int t_ = i_ >> 4, n8_ = (i_ & 15) * 8; \
      const bf16* src_ = XB + (size_t)m2_seq2tok((c0_) + t_, dir) * 768 + grp * 128 + n8_; \
      rb[q_] = *(const u32x4*)(src_ + 256); rc[q_] = *(const u32x4*)(src_ + 512); } \
    if (wl == 0) rsc = *(const float4*)(SC + (size_t)((c0_) + lane) * 4); }
  M2_GLOAD(cbeg)
  float* GT = (float*)(p.ws + OFF_MIX + MX_GT) + (size_t)((b * 2 + dir) * 4 + hd) * M2_REST;
  float lcum = 0.f;
  for (int c0 = cbeg; c0 < cend; c0 += 64) {
    if (wl == 0) {
      sS[lane] = rsc.x; sDt[lane] = rsc.w; sW[lane] = rsc.z;
      if (seg1) { GT[c0 - M2_SPLIT + lane] = rsc.x + lcum; lcum += shfl_(rsc.x, 63); }
    }
    __syncthreads();
#pragma unroll
    for (int q2 = 0; q2 < 2; ++q2) {
      const int i = tid + q2 * NTHREADS; const int h2 = i >> 9, t8 = ((i >> 6) & 7) * 8, pp = i & 63;
      *(u32x4*)((bf16*)(smem + M2_OFF_HD + h2 * M2H_SIZE + M2H_XT) + pp * M2_LDX + t8) = dir ? rev8_(rxt[q2]) : rxt[q2];
    }
#pragma unroll
    for (int q4 = 0; q4 < 2; ++q4) {
      const int i = tid + q4 * NTHREADS; const int t = i >> 4, n8 = (i & 15) * 8;
      *(u32x4*)(sB + t * M2_LDB + n8) = rb[q4];
      *(u32x4*)(sC + t * M2_LDB + n8) = rc[q4];
    }
#pragma unroll
    for (int q4 = 0; q4 < 2; ++q4) {
      const int i = tid + q4 * NTHREADS; const int t8 = (i >> 7) * 8, nn = i & 127;
      float bv[8];
      if (dir) rbt[q4] = rev8_(rbt[q4]);
      bv[0] = __uint_as_float(rbt[q4][0] << 16); bv[1] = __uint_as_float(rbt[q4][0] & 0xffff0000u);
      bv[2] = __uint_as_float(rbt[q4][1] << 16); bv[3] = __uint_as_float(rbt[q4][1] & 0xffff0000u);
      bv[4] = __uint_as_float(rbt[q4][2] << 16); bv[5] = __uint_as_float(rbt[q4][2] & 0xffff0000u);
      bv[6] = __uint_as_float(rbt[q4][3] << 16); bv[7] = __uint_as_float(rbt[q4][3] & 0xffff0000u);
#pragma unroll
      for (int h2 = 0; h2 < 2; ++h2) {
        const float* wv = (const float*)(smem + M2_OFF_HD + h2 * M2H_SIZE + M2H_S) + 128 + t8;
        float sv[8];
#pragma unroll
        for (int k = 0; k < 8; ++k) sv[k] = bv[k] * wv[k];
        st8bf((bf16*)(smem + M2_OFF_HD + h2 * M2H_SIZE + M2H_BT) + nn * M2_LDX + t8, sv);
      }
    }
    __syncthreads();
    if (c0 + 64 < cend) M2_GLOAD(c0 + 64)
    {
      f32x16 yT, y2;
#pragma unroll
      for (int i = 0; i < 16; ++i) { yT[i] = 0.f; y2[i] = 0.f; }
      const int tv = 32 * tb + r;
      const float St = sS[tv];
      for (int sb = 0; sb <= tb; ++sb) {
        f32x16 gT;
#pragma unroll
        for (int i = 0; i < 16; ++i) gT[i] = 0.f;
#pragma unroll
        for (int ks = 0; ks < 8; ++ks) {
          bf16x8 av = *(const bf16x8*)(sB + (32 * sb + r) * M2_LDB + 16 * ks + 8 * half);
          bf16x8 bv = *(const bf16x8*)(sC + tv * M2_LDB + 16 * ks + 8 * half);
          gT = __builtin_amdgcn_mfma_f32_32x32x16_bf16(av, bv, gT, 0, 0, 0);
        }
        const float St2 = St * 1.4426950408889634f;
        if (sb == tb) {
#pragma unroll
          for (int i = 0; i < 16; ++i) {
            const int sv = 32 * sb + (i & 3) + 8 * (i >> 2) + 4 * half;
            gT[i] = (sv <= tv) ? gT[i] * exp2f_(St2 - sDt[sv]) : 0.f;
          }
        } else {
#pragma unroll
          for (int i = 0; i < 16; ++i) {
            const int sv = 32 * sb + (i & 3) + 8 * (i >> 2) + 4 * half;
            gT[i] *= exp2f_(St2 - sDt[sv]);
          }
        }
#pragma unroll
        for (int kq = 0; kq < 2; ++kq) {
          const u32x4 pw = u32x4{pack2(gT[8 * kq], gT[8 * kq + 1]), pack2(gT[8 * kq + 2], gT[8 * kq + 3]), pack2(gT[8 * kq + 4], gT[8 * kq + 5]), pack2(gT[8 * kq + 6], gT[8 * kq + 7])};
          const bf16x8 pf = __builtin_bit_cast(bf16x8, pw);
          const bf16* xr = sXT + (32 * pb + r) * M2_LDX + 32 * sb + 16 * kq + 4 * half;
          uint2 x0 = *(const uint2*)xr, x1 = *(const uint2*)(xr + 8);
          bf16x8 xa;
          xa[0] = (short)(x0.x & 0xffff); xa[1] = (short)(x0.x >> 16); xa[2] = (short)(x0.y & 0xffff); xa[3] = (short)(x0.y >> 16);
          xa[4] = (short)(x1.x & 0xffff); xa[5] = (short)(x1.x >> 16); xa[6] = (short)(x1.y & 0xffff); xa[7] = (short)(x1.y >> 16);
          yT = __builtin_amdgcn_mfma_f32_32x32x16_bf16(xa, pf, yT, 0, 0, 0);
        }
      }
#pragma unroll
      for (int ks = 0; ks < 8; ++ks) {
        bf16x8 av = *(const bf16x8*)(sH + (32 * pb + r) * M2_LDB + 16 * ks + 8 * half);
        bf16x8 bv = *(const bf16x8*)(sC + tv * M2_LDB + 16 * ks + 8 * half);
        y2 = __builtin_amdgcn_mfma_f32_32x32x16_bf16(av, bv, y2, 0, 0, 0);
      }
      const float eS = __expf(St);
      const int j = m2_seq2tok(c0 + tv, dir);
      float* yo = YM + (size_t)j * 256 + hd * 64 + 32 * pb + 4 * half;
#pragma unroll
      for (int gI = 0; gI < 4; ++gI)
        *(float4*)(yo + 8 * gI) = make_float4(yT[4 * gI] + eS * y2[4 * gI], yT[4 * gI + 1] + eS * y2[4 * gI + 1], yT[4 * gI + 2] + eS * y2[4 * gI + 2], yT[4 * gI + 3] + eS * y2[4 * gI + 3]);
    }
    __syncthreads();
    {
      const float eL = __expf(sS[63]);
#pragma unroll
      for (int q = 0; q < 2; ++q) {
#pragma unroll
        for (int i = 0; i < 16; ++i) hst[q][i] *= eL;
#pragma unroll
        for (int ks = 0; ks < 4; ++ks) {
          bf16x8 av = *(const bf16x8*)(sXT + (32 * pb + r) * M2_LDX + 16 * ks + 8 * half);
          bf16x8 bv = *(const bf16x8*)(sBT + (32 * (nb0 + q) + r) * M2_LDX + 16 * ks + 8 * half);
          hst[q] = __builtin_amdgcn_mfma_f32_32x32x16_bf16(av, bv, hst[q], 0, 0, 0);
        }
#pragma unroll
        for (int i = 0; i < 16; ++i) {
          const int pv = 32 * pb + (i & 3) + 8 * (i >> 2) + 4 * half;
          sH[pv * M2_LDB + 32 * (nb0 + q) + r] = f2bf(hst[q][i]);
        }
      }
    }
    __syncthreads();
  }
  if (!seg1) {
    bf16* HM = (bf16*)(p.ws + OFF_MIX + MX_HM) + (size_t)((b * 2 + dir) * 2 + grp) * 128 * 128;
#pragma unroll
    for (int q = 0; q < 4; ++q) {
      const int i = tid + q * NTHREADS, pr = i >> 4, n8 = (i & 15) * 8;
      *(u32x4*)(HM + pr * 128 + n8) = *(const u32x4*)((const bf16*)(smem + M2_OFF_HD + (pr >> 6) * M2H_SIZE + M2H_H) + (pr & 63) * M2_LDB + n8);
    }
  }
}
constexpr int M2C_MT = (M2_REST + 255) / 256;
DI void m2corr_tile(const Params& p, const LP& L, int t, char* smem) {
  const int mt = t % M2C_MT, r = t / M2C_MT, grp = r & 1, dir = (r >> 1) & 1, b = r >> 2;
  const int tok0 = dir ? CTXL : M2_SPLIT;
  const bf16* A = (const bf16*)(p.ws + OFF_MIX + MX_XBC) + ((size_t)b * TOK + tok0) * 768 + 512 + grp * 128;
  const bf16* HM = (const bf16*)(p.ws + OFF_MIX + MX_HM) + (size_t)((b * 2 + dir) * 2 + grp) * 128 * 128;
  GA g = make_ga(A, 768, HM, 128, 128, M2_REST);
  f32x4 acc[4][4];
  const int m0 = mt * 256;
  gemm_s<4>(g, m0, 0, smem, acc);
  float* YM = (float*)(p.ws + OFF_HA) + ((size_t)dir * NTOK + (size_t)b * TOK + tok0) * 256;
  const float* GT = (const float*)(p.ws + OFF_MIX + MX_GT) + (size_t)((b * 2 + dir) * 4 + grp * 2) * M2_REST;
  EPI_BEGIN(4, acc, m0, 0, M2_REST)
    const int hs = col >> 6;
    const int sidx = dir ? (M2_REST - 1 - row) : row;
    const float f = __expf(GT[(size_t)hs * M2_REST + sidx]);
    float* yo = YM + (size_t)row * 256 + (grp * 2 + hs) * 64 + (col & 63);
    float4 y0 = *(const float4*)yo, y1 = *(const float4*)(yo + 4);
    y0.x += f * v[0]; y0.y += f * v[1]; y0.z += f * v[2]; y0.w += f * v[3];
    y1.x += f * v[4]; y1.y += f * v[5]; y1.z += f * v[6]; y1.w += f * v[7];
    *(float4*)yo = y0; *(float4*)(yo + 4) = y1;
  EPI_END
}
DI void m2gate_item(const Params& p, const LP& L, int it) {
  const int tok = it * NWAVES + (tid_() >> 6), lane = tid_() & 63;
  const float* Y0 = (const float*)(p.ws + OFF_HA) + (size_t)tok * 256;
  const float* Y1 = Y0 + (size_t)NTOK * 256;
  const bf16* XB = (const bf16*)(p.ws + OFF_MIX + MX_XBC) + (size_t)tok * 768;
  const bf16* P1 = (const bf16*)(p.ws + OFF_P1) + (size_t)tok * P1W + C_Z;
  const int c = lane * 4, hd = c >> 6;
  const float dsk = p.in[I_M2D][L.l * 4 + hd];
  float4 y0 = *(const float4*)(Y0 + c), y1 = *(const float4*)(Y1 + c);
  uint2 xw = *(const uint2*)(XB + c), zw = *(const uint2*)(P1 + c);
  float xs[4] = {__uint_as_float(xw.x << 16), __uint_as_float(xw.x & 0xffff0000u), __uint_as_float(xw.y << 16), __uint_as_float(xw.y & 0xffff0000u)};
  float zs[4] = {__uint_as_float(zw.x << 16), __uint_as_float(zw.x & 0xffff0000u), __uint_as_float(zw.y << 16), __uint_as_float(zw.y & 0xffff0000u)};
  float ys[4] = {y0.x + y1.x, y0.y + y1.y, y0.z + y1.z, y0.w + y1.w};
  float v[4], ss = 0.f;
#pragma unroll
  for (int i = 0; i < 4; ++i) { v[i] = (ys[i] + dsk * xs[i]) * siluf_(zs[i]); ss += v[i] * v[i]; }
  ss = wave_sum(ss);
  const float rs = rsqrtf(ss * (1.f / 256.f) + EPS);
  float4 gn = *(const float4*)(p.in[I_M2GNORM] + L.l * 256 + c);
  bf16* O = (bf16*)(p.ws + OFF_O) + (size_t)tok * 1024 + 768 + c;
  *(uint2*)O = make_uint2(pack2(v[0] * rs * gn.x, v[1] * rs * gn.y), pack2(v[2] * rs * gn.z, v[3] * rs * gn.w));
}
constexpr int GLU_MT = (NTOK + 255) / 256;
DI void glu_tile(const Params& p, const LP& L, int t, char* smem) {
  const int mt = t % GLU_MT, nt = t / GLU_MT, m0 = mt * 256, n0 = nt * 128;
  const bf16* Z = (const bf16*)(p.ws + OFF_MIX + MX_Z);
  GA g = make_ga(Z, 256, (const bf16*)(L.we + WE_GLU), 256, 256, NTOK);
  f32x4 acc[4][4];
  gemm_s<4>(g, m0, n0, smem, acc);
  bf16* O = (bf16*)(p.ws + OFF_O);
  const float* bg = p.in[I_S5BGLU] + L.l * 256;
  EPI_BEGIN(4, acc, m0, n0, NTOK)
    float z[8]; ld8bf(Z + (size_t)row * 256 + col, z);
#pragma unroll
    for (int k = 0; k < 8; ++k) v[k] = z[k] * sigmoidf_(v[k] + bg[col + k]);
    st8bf(O + (size_t)row * 1024 + 512 + col, v);
  EPI_END
}
DI void merge_tile(const Params& p, const LP& L, int t, char* smem) {
  constexpr int MT_L = BATCH * (SEQ / 256), MT_A = (NTOK + 255) / 256;
  const int mt = L.last ? t % MT_L : t % MT_A, nt = L.last ? t / MT_L : t / MT_A, m0 = mtile_row0(mt, L.last, 256), n0 = nt * 128;
  const bf16* O = (const bf16*)(p.ws + OFF_O);
  const unsigned char* PG = (const unsigned char*)(p.ws + OFF_PG);
  float tot[4][2][8];
#pragma unroll
  for (int a = 0; a < 4; ++a)
#pragma unroll
    for (int q = 0; q < 2; ++q)
#pragma unroll
      for (int k = 0; k < 8; ++k) tot[a][q][k] = 0.f;
  for (int j = 0; j < 4; ++j) {
    GA g = make_ga(O + j * 256, 1024, (const bf16*)(L.we + WE_WB) + (size_t)j * 1024 * 256, 256, 256, NTOK);
    f32x4 acc[4][4];
    gemm_s<4>(g, m0, n0, smem, acc);
    EPI_BEGIN(4, acc, m0, n0, NTOK)
      float gt[8]; ld8u8(PG + (size_t)row * 4096 + j * 1024 + col, gt);
#pragma unroll
      for (int k = 0; k < 8; ++k) tot[_m][_q][k] += gt[k] * v[k];
    EPI_END
  }
  bf16* Y = (bf16*)(p.ws + OFF_P1);
  {
    const int l = tid_() & 63, w = tid_() >> 6, wr = w >> 1, wc = w & 1, fr = l & 15, fq = l >> 4;
#pragma unroll
    for (int m = 0; m < 4; ++m)
#pragma unroll
      for (int q = 0; q < 2; ++q) {
        const int row = m0 + wr * 64 + m * 16 + fr, col = n0 + wc * 64 + q * 32 + 8 * fq;
        if (row < NTOK) {
#pragma unroll
          for (int k = 0; k < 8; ++k) tot[m][q][k] *= (1.0f / 255.0f);
          st8bf(Y + (size_t)row * 1024 + col, tot[m][q]);
        }
      }
  }
}
DI void outproj_tile(const Params& p, const LP& L, int t, char* smem) {
  bf16* Y2 = (bf16*)(p.ws + OFF_HA);
  constexpr int MT_L = BATCH * (SEQ / 256), MT_A = (NTOK + 255) / 256;
  const int mt = L.last ? t % MT_L : t % MT_A, nt = L.last ? t / MT_L : t / MT_A, m0 = mtile_row0(mt, L.last, 256), n0 = nt * 256;
  GA g = make_ga((const bf16*)(p.ws + OFF_P1), 1024, (const bf16*)(L.we + WE_WOUT), 1024, 1024, NTOK);
  f32x4 acc[2][2][4][2];
  gemm_big(g, m0, n0, smem, acc);
  EPIB_BEGIN(acc, m0, n0, NTOK)
    st8bf(Y2 + (size_t)row * 1024 + col, v);
  EPIB_END
}
DI int post_ntok(bool latonly) { return latonly ? BATCH * SEQ : NTOK; }
DI int post_tok(int i, bool latonly) { return latonly ? ((i / SEQ) * TOK + CTXL + (i % SEQ)) : i; }

DI const float* xsrc_row(const Params& p, int l, int tok) {
  (void)l;
  const int b = tok_b(tok), j = tok_j(tok);
  return (j < CTXL) ? p.in[I_CTX] + ((size_t)b * CTXL + j) * 1024 : p.in[I_X] + ((size_t)b * SEQ + (j - CTXL)) * 1024;
}
DI void post_stage_router(const Params& p, const LP& L, char* smem) {
  const float* wr = p.in[I_WROUTER] + (size_t)L.l * 1024 * 16;
  float4* wl = (float4*)smem;
  __syncthreads();
  for (int i = tid_(); i < 4096; i += NTHREADS) {
    const int k = i >> 2, q = i & 3;
    const int pos = ((k >> 8) * 4 + (k & 3)) * 64 + ((k >> 2) & 63);
    wl[q * 1024 + pos] = *(const float4*)(wr + (size_t)k * 16 + q * 4);
  }
  __syncthreads();
}
template <bool FIRST> struct XRow { typedef uint2 T; };
template <> struct XRow<true> { typedef float4 T; };
template <bool FIRST>
DI void post_phase_t(const Params& p, const LP& L, char* smem) {
  typedef typename XRow<FIRST>::T XT;
  const int lane = tid_() & 63, gw = (int)blockIdx.x * NWAVES + (tid_() >> 6), TW = (int)gridDim.x * NWAVES;
  const int n = post_ntok(L.last);
  if (gw >= n) return;
  const float* gpm = p.in[I_GPOSTMIX] + L.l * 1024;
  const float4* wl = (const float4*)smem;
  int i = gw, tok = post_tok(i, L.last);
  uint2 yr[4]; XT xr[4];
  {
    const bf16* Y2 = (const bf16*)(p.ws + OFF_HA) + (size_t)tok * 1024;
#pragma unroll
    for (int q = 0; q < 4; ++q) yr[q] = *(const uint2*)(Y2 + lane * 4 + q * 256);
    if constexpr (FIRST) { const float* X = xsrc_row(p, 0, tok);
#pragma unroll
      for (int q = 0; q < 4; ++q) xr[q] = *(const XT*)(X + lane * 4 + q * 256); }
    else { const bf16* X = (const bf16*)(p.ws + OFF_X) + (size_t)tok * 1024;
#pragma unroll
      for (int q = 0; q < 4; ++q) xr[q] = *(const XT*)(X + lane * 4 + q * 256); }
  }
  for (;;) {
    const int inext = i + TW; const bool has = inext < n; const int tokn = has ? post_tok(inext, L.last) : tok;
    uint2 yn[4]; XT xn[4];
    {
      const bf16* Yn = (const bf16*)(p.ws + OFF_HA) + (size_t)tokn * 1024;
#pragma unroll
      for (int q = 0; q < 4; ++q) yn[q] = *(const uint2*)(Yn + lane * 4 + q * 256);
      if constexpr (FIRST) { const float* Xn = xsrc_row(p, 0, tokn);
#pragma unroll
        for (int q = 0; q < 4; ++q) xn[q] = *(const XT*)(Xn + lane * 4 + q * 256); }
      else { const bf16* Xn = (const bf16*)(p.ws + OFF_X) + (size_t)tokn * 1024;
#pragma unroll
        for (int q = 0; q < 4; ++q) xn[q] = *(const XT*)(Xn + lane * 4 + q * 256); }
    }
    bf16* X = (bf16*)(p.ws + OFF_X) + (size_t)tok * 1024;
    const float* mod = L.mod + (size_t)tok_modrow(tok) * 6144;
    float xv[16], h[16];
    float ss = 0.f;
#pragma unroll
    for (int q = 0; q < 4; ++q) { const float4 y4 = bf4_(yr[q]); ss += y4.x * y4.x + y4.y * y4.y + y4.z * y4.z + y4.w * y4.w; }
    ss = wave_sum(ss);
    const float rs = rsqrtf(ss * (1.f / 1024.f) + EPS);
#pragma unroll
    for (int q = 0; q < 4; ++q) {
      const int c = lane * 4 + q * 256;
      const float4 y4 = bf4_(yr[q]);
      float4 xo = bf4_(xr[q]), gv = *(const float4*)(gpm + c), gt = *(const float4*)(mod + 2048 + c);
      xo.x += gt.x * y4.x * rs * gv.x; xo.y += gt.y * y4.y * rs * gv.y; xo.z += gt.z * y4.z * rs * gv.z; xo.w += gt.w * y4.w * rs * gv.w;
      *(uint2*)(X + c) = pk4_(xo);
      xv[q * 4] = xo.x; xv[q * 4 + 1] = xo.y; xv[q * 4 + 2] = xo.z; xv[q * 4 + 3] = xo.w;
    }
    bf16* H2 = (bf16*)(p.ws + OFF_P1) + (size_t)NTOK * 1024 + (size_t)tok * 1024;
    normmod_row(xv, p.in[I_GPREFFN] + L.l * 1024, mod + 3072, mod + 4096, H2, h);
    float lg[16];
#pragma unroll
    for (int e = 0; e < 16; ++e) lg[e] = 0.f;
#pragma unroll
    for (int q = 0; q < 16; ++q) {
      const int pos = ((q >> 2) * 4 + (q & 3)) * 64 + lane;
      float4 a = wl[pos], b4 = wl[1024 + pos], c4 = wl[2048 + pos], d4 = wl[3072 + pos];
      float hv = h[q];
      lg[0] += hv * a.x; lg[1] += hv * a.y; lg[2] += hv * a.z; lg[3] += hv * a.w;
      lg[4] += hv * b4.x; lg[5] += hv * b4.y; lg[6] += hv * b4.z; lg[7] += hv * b4.w;
      lg[8] += hv * c4.x; lg[9] += hv * c4.y; lg[10] += hv * c4.z; lg[11] += hv * c4.w;
      lg[12] += hv * d4.x; lg[13] += hv * d4.y; lg[14] += hv * d4.z; lg[15] += hv * d4.w;
    }
    float mx = -INFINITY;
#pragma unroll
    for (int e = 0; e < 16; ++e) { lg[e] = wave_sum(lg[e]); mx = fmax_(mx, lg[e]); }
    float se = 0.f;
#pragma unroll
    for (int e = 0; e < 16; ++e) { lg[e] = expf(lg[e] - mx); se += lg[e]; }
    if (lane < 16) {
      float v = 0.f;
#pragma unroll
      for (int e = 0; e < 16; ++e) if (e == lane) v = lg[e];
      ((float*)(p.ws + OFF_AFF))[(size_t)lane * NTOK + tok] = v * rcp_(se);
    }
    if (!has) break;
    i = inext; tok = tokn;
#pragma unroll
    for (int q = 0; q < 4; ++q) { yr[q] = yn[q]; xr[q] = xn[q]; }
  }
}
DI void post_phase(const Params& p, const LP& L, char* smem) { if (L.l == 0) post_phase_t<true>(p, L, smem); else post_phase_t<false>(p, L, smem); }
DI int block_sum_(int v, int* sred, int round) {
  const int tid = tid_(), lane = tid & 63, wid = tid >> 6;
  v += shfl_xor_(v, 32); v += shfl_xor_(v, 16); v += shfl_xor_(v, 8); v += shfl_xor_(v, 4); v += shfl_xor_(v, 2); v += shfl_xor_(v, 1);
  int* r = sred + (round & 1) * NWAVES;
  if (lane == 0) r[wid] = v;
  __syncthreads();
  int tsum = 0;
#pragma unroll
  for (int q = 0; q < NWAVES; ++q) tsum += r[q];
  return tsum;
}
DI void route_item(const Params& p, const LP& L, int it, char* smem) {
  const int nstream = L.last ? 1 : 2;
  const int b = it / (16 * nstream), e = (it / nstream) & 15, ctxs = (nstream == 2) ? (it & 1) : 0;
  const int T = ctxs ? CTXL : SEQ, cap = ctxs ? CAP_C : CAP_L;
  const int tok0 = b * TOK + (ctxs ? 0 : CTXL);
  const int slot0 = ctxs ? (BATCH * CAP_L + b * CAP_C) : (b * CAP_L);
  int* sred = (int*)smem;
  const float* AFF = (const float*)(p.ws + OFF_AFF) + (size_t)e * NTOK + tok0;
  int* SEL = (int*)(p.ws + OFF_SEL);
  int* IDX = (int*)(p.ws + OFF_IDX) + (size_t)e * ESLOTS;
  float* GW = (float*)(p.ws + OFF_GW) + (size_t)e * ESLOTS;
  const int tid = tid_(), lane = tid & 63, wid = tid >> 6;
  constexpr int MAXPER = (SEQ + NTHREADS - 1) / NTHREADS;
  const int per = (T + NTHREADS - 1) / NTHREADS;
  unsigned key[MAXPER];
  __syncthreads();
#pragma unroll
  for (int k = 0; k < MAXPER; ++k) {
    int i = tid * per + k;
    key[k] = (k < per && i < T) ? (__float_as_uint(AFF[i]) + 1u) : 0u;
  }
  unsigned thr = 0u;
  int round = 0;
  for (int bit = 30; bit >= 0; --bit) {
    const unsigned cand = thr | (1u << bit);
    int c = 0;
#pragma unroll
    for (int k = 0; k < MAXPER; ++k) c += (key[k] >= cand) ? 1 : 0;
    c = block_sum_(c, sred, round++);
    if (c >= cap) thr = cand;
  }
  int cg = 0, ce = 0;
#pragma unroll
  for (int k = 0; k < MAXPER; ++k) { cg += (key[k] > thr) ? 1 : 0; ce += (key[k] == thr) ? 1 : 0; }
  const int tot_gt = block_sum_(cg, sred, round++);
  const int need_eq = cap - tot_gt;
  int v = cg | (ce << 16), inc = v;
#pragma unroll
  for (int d = 1; d < 64; d <<= 1) { int o = shfl_up_(inc, d); if (lane >= d) inc += o; }
  int* soff = sred + 2 * NWAVES;
  __syncthreads();
  if (lane == 63) soff[wid] = inc;
  __syncthreads();
  int base = 0;
  for (int w = 0; w < wid; ++w) base += soff[w];
  int excl = base + inc - v;
  int gt_before = excl & 0xffff, eq_before = excl >> 16;
#pragma unroll
  for (int k = 0; k < MAXPER; ++k) {
    int i = tid * per + k;
    if (k < per && i < T) {
      const bool isgt = key[k] > thr, iseq = key[k] == thr;
      const bool sel = isgt || (iseq && eq_before < need_eq);
      const int slot = slot0 + gt_before + (eq_before < need_eq ? eq_before : need_eq);
      if (sel) { IDX[slot] = tok0 + i; GW[slot] = __uint_as_float(key[k] - 1u); SEL[(size_t)(tok0 + i) * 16 + e] = slot; }
      else SEL[(size_t)(tok0 + i) * 16 + e] = -1;
      gt_before += isgt ? 1 : 0; eq_before += iseq ? 1 : 0;
    }
  }
}
DI void moe1_tile(const Params& p, const LP& L, int t, char* smem) {
  const int nslots = L.last ? ESLOTS_L : ESLOTS;
  constexpr int MT_L = (ESLOTS_L + 255) / 256, MT_A = (ESLOTS + 255) / 256;
  const int nt = t & 7, sq = t >> 3;
  const int e = L.last ? sq / MT_L : sq / MT_A, mt = L.last ? sq % MT_L : sq % MT_A;
  const int m0 = mt * 256, n0 = nt * 256;
  GA g = make_ga((const bf16*)(p.ws + OFF_P1) + (size_t)NTOK * 1024, 1024, (const bf16*)(p.ws + OFF_MIX + WX_GU) + (size_t)e * 2048 * 1024, 1024, 1024, nslots);
  g.ridx = (const int*)(p.ws + OFF_IDX) + (size_t)e * ESLOTS;
  f32x4 acc[2][2][4][2];
  gemm_big(g, m0, n0, smem, acc);
  bf16* ACT = (bf16*)(p.ws + OFF_PG) + (size_t)e * ESLOTS * 1024;
  {
    const int l = tid_() & 63, w = tid_() >> 6, wr = w >> 2, wc = w & 3, fr = l & 15, fq = l >> 4;
#pragma unroll
    for (int ai = 0; ai < 2; ++ai)
#pragma unroll
      for (int m = 0; m < 4; ++m) {
        const int row = m0 + ai * 128 + wr * 64 + m * 16 + fr;
        float a[8];
#pragma unroll
        for (int k = 0; k < 4; ++k) { a[k] = siluf_(acc[ai][0][m][0][k]) * acc[ai][1][m][0][k]; a[4 + k] = siluf_(acc[ai][0][m][1][k]) * acc[ai][1][m][1][k]; }
        if (row < nslots) st8bf(ACT + (size_t)row * 1024 + nt * 128 + wc * 32 + 8 * fq, a);
      }
  }
}
DI void moe2_tile(const Params& p, const LP& L, int t, char* smem) {
  const int nslots = L.last ? ESLOTS_L : ESLOTS;
  constexpr int MT_L = (ESLOTS_L + 255) / 256, MT_A = (ESLOTS + 255) / 256;
  const int x = t & 7, nt = x & 3, sq = (t >> 3) * 2 + (x >> 2);
  const int e = L.last ? sq / MT_L : sq / MT_A, mt = L.last ? sq % MT_L : sq % MT_A;
  if (e >= NE) return;
  const int m0 = mt * 256, n0 = nt * 256;
  GA g = make_ga((const bf16*)(p.ws + OFF_PG) + (size_t)e * ESLOTS * 1024, 1024, (const bf16*)(p.ws + OFF_MIX + WX_DN) + (size_t)e * 1024 * 1024, 1024, 1024, nslots);
  f32x4 acc[2][2][4][2];
  gemm_big(g, m0, n0, smem, acc);
  bf16* YS = (bf16*)(p.ws + OFF_PG) + (size_t)NE * ESLOTS * 1024 + (size_t)e * ESLOTS * 1024;
  const float* GW = (const float*)(p.ws + OFF_GW) + (size_t)e * ESLOTS;
  EPIB_BEGIN(acc, m0, n0, nslots)
    const float gw = GW[row];
#pragma unroll
    for (int k = 0; k < 8; ++k) v[k] *= gw;
    st8bf(YS + (size_t)row * 1024 + col, v);
  EPIB_END
}
DI int uni_(int v) {
#ifdef EMU
  return v;
#else
  return __builtin_amdgcn_readfirstlane(v);
#endif
}
DI void comb_phase(const Params& p, const LP& L) {
  const int lane = tid_() & 63, gw = (int)blockIdx.x * NWAVES + (tid_() >> 6), TW = (int)gridDim.x * NWAVES;
  const int n = post_ntok(L.last);
  if (gw >= n) return;
  const bf16* YS = (const bf16*)(p.ws + OFF_PG) + (size_t)NE * ESLOTS * 1024;
  const float* gpf = p.in[I_GPOSTFFN] + L.l * 1024;
  int i = gw, tok = post_tok(i, L.last);
  uint4 sel[4]; uint2 xr[4];
  {
    const uint4* sp = (const uint4*)((const int*)(p.ws + OFF_SEL) + (size_t)tok * 16);
    const bf16* X = (const bf16*)(p.ws + OFF_X) + (size_t)tok * 1024;
#pragma unroll
    for (int q = 0; q < 4; ++q) { sel[q] = sp[q]; xr[q] = *(const uint2*)(X + lane * 4 + q * 256); }
  }
  for (;;) {
    const int inext = i + TW; const bool has = inext < n; const int tokn = has ? post_tok(inext, L.last) : tok;
    float s[16];
#pragma unroll
    for (int q = 0; q < 16; ++q) s[q] = 0.f;
#pragma unroll
    for (int e = 0; e < 16; ++e) {
      const unsigned sv = (e & 3) == 0 ? sel[e >> 2].x : (e & 3) == 1 ? sel[e >> 2].y : (e & 3) == 2 ? sel[e >> 2].z : sel[e >> 2].w;
      const int sl = uni_((int)sv);
      if (sl >= 0) {
        const bf16* yr = YS + ((size_t)e * ESLOTS + sl) * 1024;
#pragma unroll
        for (int q = 0; q < 4; ++q) {
          uint2 w = *(const uint2*)(yr + lane * 4 + q * 256);
          s[q * 4] += __uint_as_float(w.x << 16); s[q * 4 + 1] += __uint_as_float(w.x & 0xffff0000u);
          s[q * 4 + 2] += __uint_as_float(w.y << 16); s[q * 4 + 3] += __uint_as_float(w.y & 0xffff0000u);
        }
      }
    }
    uint4 seln[4]; uint2 xn[4];
    {
      const uint4* sp = (const uint4*)((const int*)(p.ws + OFF_SEL) + (size_t)tokn * 16);
      const bf16* Xn = (const bf16*)(p.ws + OFF_X) + (size_t)tokn * 1024;
#pragma unroll
      for (int q = 0; q < 4; ++q) { seln[q] = sp[q]; xn[q] = *(const uint2*)(Xn + lane * 4 + q * 256); }
    }
    float ss = 0.f;
#pragma unroll
    for (int q = 0; q < 16; ++q) ss += s[q] * s[q];
    ss = wave_sum(ss);
    const float rs = rsqrtf(ss * (1.f / 1024.f) + EPS);
    const float* mod = L.mod + (size_t)tok_modrow(tok) * 6144;
    bf16* dstx = (bf16*)(p.ws + OFF_X) + (size_t)tok * 1024;
    float* dst = p.out;
    if (L.last) { const int b = tok_b(tok), j = tok_j(tok); dst = p.out + ((size_t)b * SEQ + (j - CTXL)) * 1024; }
    float xv[16], h[16];
#pragma unroll
    for (int q = 0; q < 4; ++q) {
      const int c = lane * 4 + q * 256;
      float4 xo = bf4_(xr[q]), gv = *(const float4*)(gpf + c), gt = *(const float4*)(mod + 5120 + c);
      xo.x += gt.x * s[q * 4] * rs * gv.x; xo.y += gt.y * s[q * 4 + 1] * rs * gv.y; xo.z += gt.z * s[q * 4 + 2] * rs * gv.z; xo.w += gt.w * s[q * 4 + 3] * rs * gv.w;
      if (L.last) *(float4*)(dst + c) = xo; else *(uint2*)(dstx + c) = pk4_(xo);
      xv[q * 4] = xo.x; xv[q * 4 + 1] = xo.y; xv[q * 4 + 2] = xo.z; xv[q * 4 + 3] = xo.w;
    }
    if (!L.last) {
      const float* mod1 = (const float*)(p.ws + OFF_MOD) + ((size_t)(L.l + 1) * NB1 + tok_modrow(tok)) * 6144;
      normmod_row(xv, p.in[I_GPREMIX] + (L.l + 1) * 1024, mod1, mod1 + 1024, (bf16*)(p.ws + OFF_HA) + (size_t)tok * 1024, h);
    }
    if (!has) break;
    i = inext; tok = tokn;
#pragma unroll
    for (int q = 0; q < 4; ++q) { sel[q] = seln[q]; xr[q] = xn[q]; }
  }
}

enum { PH_PREP0 = 0, PH_PREP1, PH_L0 };
enum { LP_INPROJ = 0, LP_TOKPREP, LP_MIX1, LP_MIX2, LP_GLU, LP_MERGE, LP_OUT, LP_POST, LP_ROUTE, LP_MOE1, LP_MOE2, LP_COMB, LP_COUNT };
constexpr int NPHASES = PH_L0 + DEPTH * LP_COUNT;


DI void run_phase(const Params& p, int ph, char* smem) {
  const int G = gridDim.x;
  int start = blockIdx.x;
  auto seg = [&](int n, auto&& fn) {
    for (; start < n; start += G) fn(start);
    start -= n;
  };
#ifdef ONLY_PREP
  if (ph >= PH_L0) return;
#endif
  if (ph == PH_PREP0) {
    seg(DEPTH * 96, [&](int it) { mod_item(p, it, smem); });
    seg(DEPTH * 32, [&](int it) { s5_tab_item(p, it, smem); });
    seg(1, [&](int) { rope_tab_item(p); });
    seg(DEPTH * CT_EARLY, [&](int it) { conv_early_item(p, it / CT_EARLY, it % CT_EARLY, smem); });
    return;
  }
  if (ph == PH_PREP1) {
    seg(DEPTH * 256, [&](int it) { s5_mat_item(p, it); });
    seg(NTOK / NWAVES, [&](int it) { prep_row_item(p, it); });
    return;
  }
#ifdef ONLY_LPH
  if (ph < PH_L0) return;
#endif
  const int l = (ph - PH_L0) / LP_COUNT;
#ifdef ONLY_LPH
  const int lph = ONLY_LPH;
#else
  const int lph = (ph - PH_L0) % LP_COUNT;
#endif
  const LP L = make_lp(p, l);
  switch (lph) {
    case LP_INPROJ:
      seg(L.last ? IP_SLOTS_LAST : IP_SLOTS_ALL, [&](int it) { inproj_tile(p, L, it, smem); });
      break;
    case LP_TOKPREP:
      seg(16 * S5_MT * 2, [&](int it) { s5a_tile(p, L, it, smem); });
      seg(TP_MT * 3, [&](int it) { mlaq_tile(p, L, it, smem); });
      seg(TP_MT * 4, [&](int it) { mlakv_tile(p, L, it, smem); });
      seg(NTOK / 64, [&](int it) { navt_item(p, it, smem); });
      seg(M2C_ITEMS, [&](int it) { m2conv_item(p, L, it); });
      seg(M2S_ITEMS, [&](int it) { m2scal_item(p, L, it); });
      break;
    case LP_MIX1: {
      const int n0 = BATCH * 8, n1 = n0 + 2 * 16 * BATCH / NWAVES, n2 = n1 + BATCH * 4 * (SEQ / 256), n3 = n2 + BATCH * 4 * (SEQ / 256);
      const int n4 = n3 + (L.last ? 0 : BATCH * 4 * ((CTXL + 255) / 256)), n5 = n4 + (L.last ? 0 : BATCH * 4 * ((CTXL + 255) / 256));
      int* qhead = (int*)(p.ws + OFF_BAR) + Q_WORD0 + 64 * (l + 2 * p.probe_rep);
#ifdef EMU
      volatile int* bc = (volatile int*)(smem + SMEM_BYTES + 8);
#else
      volatile LAS int* bc = (volatile LAS int*)(smem + SMEM_BYTES + 8);
#endif
      for (;;) {
        __syncthreads();
        if (tid_() == 0) {
#ifdef EMU
          *bc = atomicAdd(qhead, 1);
#else
          *bc = __hip_atomic_fetch_add(qhead, 1, __ATOMIC_RELAXED, __HIP_MEMORY_SCOPE_AGENT);
#endif
        }
        __syncthreads();
        const int it = *bc;
        if (it >= n5) break;
#ifdef PROBE_SKIPM2
        if (it < n0) { if (p.probe_rep == 0) m2scan_item(p, L, it, smem); }
#else
        if (it < n0) m2scan_item(p, L, it, smem);
#endif
        else if (it < n1) s5carry_item(p, L, it - n0);
        else if (it < n2) mla_attn_item(p, it - n1, false, smem);
        else if (it < n3) na_attn_item(p, L, it - n2, false, smem);
        else if (it < n4) mla_attn_item(p, it - n3, true, smem);
        else na_attn_item(p, L, it - n4, true, smem);
      }
    } break;
    case LP_MIX2:
      seg(16 * S5_MT * 2, [&](int it) { s5c_tile(p, L, it, smem); });
      seg(BATCH * 4 * M2C_MT, [&](int it) { m2corr_tile(p, L, it, smem); });
      break;
    case LP_GLU:
      seg(GLU_MT * 2, [&](int it) { glu_tile(p, L, it, smem); });
      seg(NTOK / NWAVES, [&](int it) { m2gate_item(p, L, it); });
      break;
    case LP_MERGE:
      seg(mtiles(L.last, 256) * 8, [&](int it) { merge_tile(p, L, it, smem); });
      break;
    case LP_OUT:
      seg(mtiles(L.last, 256) * 4, [&](int it) { outproj_tile(p, L, it, smem); });
      break;
    case LP_POST:
      seg(CT_EXP, [&](int it) { conv_expert_item(p, l, it, smem); });
      post_stage_router(p, L, smem);
      post_phase(p, L, smem);
      break;
    case LP_ROUTE:
      seg(BATCH * 16 * (L.last ? 1 : 2), [&](int it) { route_item(p, L, it, smem); });
      break;
    case LP_MOE1:
      seg(NE * (((L.last ? ESLOTS_L : ESLOTS) + 255) / 256) * 8, [&](int it) { moe1_tile(p, L, it, smem); });
      break;
    case LP_MOE2:
      seg(((NE * (((L.last ? ESLOTS_L : ESLOTS) + 255) / 256) + 1) / 2) * 8, [&](int it) { moe2_tile(p, L, it, smem); });
      break;
    case LP_COMB:
      comb_phase(p, L);
      break;
  }
}

__global__ void __launch_bounds__(NTHREADS, 2) mega_kernel(Params p) {
#ifdef EMU
  char* smem = emu_cur_f->blk->smem;
  for (int ph = p.phase_lo; ph < p.phase_hi; ++ph) {
    run_phase(p, ph, smem);
    if (ph + 1 < p.phase_hi) emu_grid_sync();
  }
#else
  __shared__ __attribute__((aligned(16))) char smem[SMEM_BYTES + 16 + 256];
  {
    const unsigned hw = (unsigned)__builtin_amdgcn_s_getreg((5 << 11) | 4) & 0x3fu;
    if ((threadIdx.x & 63) == 0) *(volatile int*)(smem + WAVE_TAB_OFF + hw * 4u) = (int)(threadIdx.x >> 6);
    __syncthreads();
  }
  if (p.phase_hi - p.phase_lo > 1) {
    if (threadIdx.x == 0) *(uint4*)(smem + SMEM_BYTES) = make_uint4(0u, 0u, 0u, 0u);
    __syncthreads();
    XcdBarrier xb = xcd_barrier_post((unsigned*)(p.ws + OFF_BAR), (volatile LAS unsigned*)(smem + SMEM_BYTES));
    for (int ph = p.phase_lo; ph < p.phase_hi; ++ph) {
      int reps = 1;
#ifdef PROBE_PHASE
      if (ph == PROBE_PHASE || ph == PROBE_PHASE2) reps = 1 + PROBE_REP;
#endif
      for (int rep = 0; rep < reps; ++rep) {
        p.probe_rep = rep;
        run_phase(p, ph, smem);
        if (ph + 1 < p.phase_hi || rep + 1 < reps) {
          if (ph == p.phase_lo && rep == 0) cg::this_grid().sync();
          else xcd_barrier(xb);
        }
      }
    }
  } else {
    run_phase(p, p.phase_lo, smem);
  }
#endif
}

#ifndef EMU
extern "C" void kernel_launch(void* const* d_in, const int* in_sizes, int n_in, void* d_out, int out_size, void* d_ws, size_t ws_size,
                              hipStream_t stream) {
  static int grid_blocks = 0;
  if (!grid_blocks) {
    int dev = 0, cus = 0, per_cu = 0;
    hipGetDevice(&dev);
    hipDeviceGetAttribute(&cus, hipDeviceAttributeMultiprocessorCount, dev);
    hipOccupancyMaxActiveBlocksPerMultiprocessor(&per_cu, mega_kernel, NTHREADS, 0);
    if (per_cu > 1) per_cu = 1;
    if (per_cu < 1) per_cu = 1;
    grid_blocks = cus * per_cu;
    if (ws_size < WS_TOTAL) fprintf(stderr, "workspace too small: %zu < %zu\n", ws_size, (size_t)WS_TOTAL);
  }
  Params p{};
  for (int i = 0; i < N_INPUTS; ++i) p.in[i] = (const float*)d_in[i];
  p.out = (float*)d_out;
  p.ws = (char*)d_ws;
#if MK_MULTI
  for (int ph = 0; ph < NPHASES; ++ph) {
    p.phase_lo = ph; p.phase_hi = ph + 1;
    hipLaunchKernelGGL(mega_kernel, dim3(grid_blocks), dim3(NTHREADS), 0, stream, p);
  }
#else
  p.phase_lo = 0; p.phase_hi = NPHASES;
  hipMemsetAsync((char*)d_ws + OFF_BAR, 0, BAR_BYTES, stream);
  void* args[] = {&p};
  hipError_t e = hipLaunchCooperativeKernel((void*)mega_kernel, dim3(grid_blocks), dim3(NTHREADS), args, 0, stream);
  if (e != hipSuccess) fprintf(stderr, "cooperative launch failed: %s (grid %d)\n", hipGetErrorString(e), grid_blocks);
#endif
}
#endif
```

```cpp
#ifdef EMU
#include "emu.h"
#else
#include <hip/hip_runtime.h>
#include <hip/hip_cooperative_groups.h>
#include <cstdio>
namespace cg = cooperative_groups;
using bf16x8 = __attribute__((ext_vector_type(8))) short;
using f32x4 = __attribute__((ext_vector_type(4))) float;
using f32x16 = __attribute__((ext_vector_type(16))) float;
#endif
using u32x4 = __attribute__((ext_vector_type(4))) unsigned;
#ifndef MK_MULTI
#define MK_MULTI 0
#endif

#define DI __device__ __forceinline__
typedef unsigned short bf16;

#ifdef EMU_SMALL2
constexpr int BATCH = 2, SEQ = 1024, CTXL = 64, GRID_W = 32;
#elif defined(EMU_SMALL)
constexpr int BATCH = 2, SEQ = 512, CTXL = 64, GRID_W = 32;
#else
constexpr int BATCH = 8, SEQ = 2048, CTXL = 256, GRID_W = 64;
#endif
constexpr int D = 1024, DEPTH = 2;
constexpr int TOK = CTXL + SEQ, NTOK = BATCH * TOK;
constexpr int ROWS = SEQ / GRID_W;
constexpr int WIN_R = (ROWS < 8 ? ROWS : 8), WIN_C = 16;
constexpr int N_IN = 6568, N_INP = 6656;
constexpr int C_CQ = 0, C_CKV = 256, C_KR = 384, C_NA = 416, C_S5 = 1184, C_Z = 1440, C_XBC = 1696, C_DT = 2464, C_GATE = 2472;
constexpr int P1W = 2480;
constexpr int NCH = TOK / 16, NCC = CTXL / 16, MCH = BATCH * NCH;
constexpr int NE = 16;
constexpr int CAP_L = 2 * SEQ / NE, CAP_C = 2 * CTXL / NE;
constexpr int ESLOTS = BATCH * (CAP_L + CAP_C), ESLOTS_L = BATCH * CAP_L;
constexpr int NB1 = BATCH + 1;
constexpr float EPS = 1e-6f;
constexpr int SMEM_BYTES = 147456;
constexpr int NTHREADS = 512, NWAVES = NTHREADS / 64;

enum { I_X = 0, I_C, I_CTX, I_CCTX, I_WADA, I_BADA, I_GPREMIX, I_GPOSTMIX, I_GPREFFN, I_GPOSTFFN, I_WIN, I_GCQ, I_GCKV, I_WUQ, I_WUKV, I_RPB,
       I_S5ARE, I_S5AIM, I_S5LOGSTEP, I_S5BRE, I_S5BIM, I_S5CRE, I_S5CIM, I_S5D, I_S5WGLU, I_S5BGLU, I_M2CONVW, I_M2CONVB, I_M2ALOG, I_M2DTBIAS,
       I_M2D, I_M2GNORM, I_WBRANCH, I_WOUT, I_WROUTER, I_WGATE, I_WUP, I_WDOWN, N_INPUTS };

constexpr size_t al256(size_t x) { return (x + 255) & ~(size_t)255; }
constexpr size_t SZ_X = (size_t)NTOK * D * 4;
constexpr size_t SZ_ROWBF = (size_t)NTOK * D * 2;
constexpr size_t OFF_X = 0;
constexpr size_t OFF_MOD = OFF_X + al256(SZ_X);
constexpr size_t OFF_HA = OFF_MOD + al256((size_t)DEPTH * NB1 * 6144 * 4);
constexpr size_t OFF_O = OFF_HA + al256(SZ_ROWBF);
constexpr size_t OFF_P1 = OFF_O + al256(SZ_ROWBF);
constexpr size_t SZ_P1 = (size_t)NTOK * P1W * 2;
constexpr size_t OFF_PG = OFF_P1 + al256(SZ_P1);
constexpr size_t SZ_PG = (size_t)NTOK * 4096 * 2;
constexpr size_t OFF_DT = OFF_PG + al256(SZ_PG);
constexpr size_t OFF_AFF = OFF_DT + al256((size_t)NTOK * 8 * 4);
constexpr size_t OFF_SEL = OFF_AFF + al256((size_t)NTOK * 16 * 4);
constexpr size_t OFF_IDX = OFF_SEL + al256((size_t)NTOK * 16 * 4);
constexpr size_t OFF_GW = OFF_IDX + al256((size_t)NE * ESLOTS * 4);
constexpr size_t OFF_BAR = OFF_GW + al256((size_t)NE * ESLOTS * 4);
constexpr int Q_WORD0 = 3456;
constexpr int CNT_WORD0 = Q_WORD0 + 64 * 4;
constexpr int CNT_MT = (NTOK + 255) / 256, CNT_ET = (ESLOTS + 255) / 256, CNT_LAYER = CNT_MT + NE * CNT_ET;
constexpr size_t BAR_BYTES = (size_t)(CNT_WORD0 + DEPTH * CNT_LAYER) * 4;
constexpr size_t OFF_ROPE = OFF_BAR + al256(BAR_BYTES);
constexpr size_t OFF_WEARLY = OFF_ROPE + al256(64 * 8 * 2 * 4);
constexpr size_t WE_WIN = 0;
constexpr size_t WE_UQ = WE_WIN + (size_t)N_INP * 1024 * 2;
constexpr size_t WE_UKV = WE_UQ + (size_t)384 * 256 * 2;
constexpr size_t WE_GLU = WE_UKV + (size_t)512 * 128 * 2;
constexpr size_t WE_WB = WE_GLU + (size_t)256 * 256 * 2;
constexpr size_t WE_WOUT = WE_WB + (size_t)4 * 1024 * 256 * 2;
constexpr size_t WE_SIZE = al256(WE_WOUT + (size_t)1024 * 1024 * 2);
constexpr size_t OFF_S5TAB = OFF_WEARLY + DEPTH * WE_SIZE;
constexpr size_t S5_LAMPOW = 0;
constexpr size_t S5_BBAR = S5_LAMPOW + (size_t)2 * 16 * 17 * 64 * 2 * 4;
constexpr size_t S5_KT = S5_BBAR + (size_t)2 * 16 * 64 * 16 * 2 * 4;
constexpr size_t S5_WA = S5_KT + (size_t)2 * 16 * 16 * 256 * 4;
constexpr size_t S5_W2 = S5_WA + (size_t)16 * 256 * 256 * 2;
constexpr size_t S5_SIZE = al256(S5_W2 + (size_t)16 * 256 * 512 * 2);
constexpr size_t OFF_MIX = OFF_S5TAB + DEPTH * S5_SIZE;
constexpr size_t MX_Q = 0;
constexpr size_t MX_K = MX_Q + al256((size_t)BATCH * 4 * TOK * 96 * 2);
constexpr size_t MX_VTM = MX_K + al256((size_t)BATCH * 4 * TOK * 96 * 2);
constexpr size_t MX_VTN = MX_VTM + al256((size_t)BATCH * 4 * 64 * TOK * 2);
constexpr size_t MX_XBC = MX_VTN + al256((size_t)BATCH * 4 * 64 * TOK * 2);
constexpr size_t MX_US5 = MX_XBC + al256((size_t)NTOK * 768 * 2);
constexpr size_t MX_HEND = MX_US5 + al256((size_t)NTOK * 256 * 2);
constexpr size_t MX_HIN = MX_HEND + al256((size_t)16 * MCH * 256 * 4);
constexpr size_t MX_Z = MX_HIN + al256((size_t)16 * MCH * 256 * 2);
constexpr size_t MX_XBT = MX_Z + al256((size_t)NTOK * 256 * 2);
constexpr size_t MX_M2S = MX_XBT + al256((size_t)NTOK * 512 * 2);
constexpr int M2_SPLIT = ((TOK / 64 + 1) / 2) * 64, M2_REST = TOK - M2_SPLIT;
constexpr size_t MX_HM = MX_M2S + al256((size_t)BATCH * 8 * TOK * 4 * 4);
constexpr size_t MX_GT = MX_HM + al256((size_t)BATCH * 4 * 128 * 128 * 2);
constexpr size_t MX_SIZE = MX_GT + al256((size_t)BATCH * 8 * M2_REST * 4);
constexpr size_t WX_GU = 0;
constexpr size_t WX_DN = WX_GU + (size_t)NE * 2048 * 1024 * 2;
constexpr size_t WX_SIZE = WX_DN + (size_t)NE * 1024 * 1024 * 2;
constexpr size_t MIXREG = (MX_SIZE > WX_SIZE ? MX_SIZE : WX_SIZE);
constexpr size_t WS_TOTAL = OFF_MIX + al256(MIXREG);

struct Params {
  const float* in[N_INPUTS];
  float* out;
  char* ws;
  int phase_lo, phase_hi;
  int probe_rep, pad_;
};

constexpr int WAVE_TAB_OFF = SMEM_BYTES + 16;
DI int tid_() {
#ifdef EMU
  return (int)threadIdx.x;
#else
  const unsigned hw = (unsigned)__builtin_amdgcn_s_getreg((5 << 11) | 4) & 0x3fu;
  const int wave = *(volatile __attribute__((address_space(3))) int*)(unsigned long)(WAVE_TAB_OFF + hw * 4u);
  int lane;
  asm volatile("v_mbcnt_lo_u32_b32 %0, -1, 0\n\tv_mbcnt_hi_u32_b32 %0, -1, %0" : "=v"(lane));
  return wave * 64 + lane;
#endif
}
#ifdef EMU
template <class T> DI T shfl_xor_(T v, int m) { return __shfl_xor(v, m); }
template <class T> DI T shfl_up_(T v, int d) { return __shfl_up(v, d); }
template <class T> DI T shfl_(T v, int src) { return __shfl(v, src); }
#else
template <class T> DI T shfl_xor_(T v, int m) {
  const int idx = ((tid_() & 63) ^ m) << 2;
  return __builtin_bit_cast(T, __builtin_amdgcn_ds_bpermute(idx, __builtin_bit_cast(int, v)));
}
template <class T> DI T shfl_up_(T v, int d) {
  const int l = tid_() & 63; const int idx = (l >= d ? l - d : l) << 2;
  return __builtin_bit_cast(T, __builtin_amdgcn_ds_bpermute(idx, __builtin_bit_cast(int, v)));
}
template <class T> DI T shfl_(T v, int src) {
  int idx = src << 2; asm volatile("" : "+v"(idx));
  return __builtin_bit_cast(T, __builtin_amdgcn_ds_bpermute(idx, __builtin_bit_cast(int, v)));
}
#endif
DI float bf2f(bf16 h) { return __uint_as_float(((unsigned)h) << 16); }
#ifdef EMU
DI bf16 f2bf(float f) { unsigned u = __float_as_uint(f); u += 0x7fffu + ((u >> 16) & 1u); return (bf16)(u >> 16); }
DI unsigned pack2(float a, float b) { return (unsigned)f2bf(a) | ((unsigned)f2bf(b) << 16); }
DI float exp2f_(float x) { return exp2f(x); }
#else
typedef float f32x2_t_ __attribute__((ext_vector_type(2)));
typedef __bf16 bf16x2_t_ __attribute__((ext_vector_type(2)));
DI unsigned pack2(float a, float b) { const f32x2_t_ v = {a, b}; return __builtin_bit_cast(unsigned, __builtin_convertvector(v, bf16x2_t_)); }
DI bf16 f2bf(float f) { return (bf16)(pack2(f, 0.f) & 0xffffu); }
DI float exp2f_(float x) { return __builtin_amdgcn_exp2f(x); }
#endif
#ifdef EMU
DI float rcp_(float x) { return 1.0f / x; }
#else
DI float rcp_(float x) { return __builtin_amdgcn_rcpf(x); }
#endif
DI float sigmoidf_(float x) { return rcp_(1.0f + exp2f_(-1.4426950408889634f * x)); }
DI float siluf_(float x) { return x * rcp_(1.0f + exp2f_(-1.4426950408889634f * x)); }
DI float softplusf_(float x) { const float ax = x < 0.f ? -x : x; return (x > 0.f ? x : 0.f) + __logf(1.0f + __expf(-ax)); }
DI float geluf_(float x) { const float u2 = 1.5957691216057308f * (x + 0.044715f * x * x * x); return x * rcp_(1.0f + exp2f_(-1.4426950408889634f * u2)); }
DI bool wave_all_(bool c) {
#ifdef EMU
  int v = c ? 0 : 1;
  v += shfl_xor_(v, 32); v += shfl_xor_(v, 16); v += shfl_xor_(v, 8); v += shfl_xor_(v, 4); v += shfl_xor_(v, 2); v += shfl_xor_(v, 1);
  return v == 0;
#else
  return __builtin_amdgcn_ballot_w64(!c) == 0ull;
#endif
}
DI float wave_sum(float v) {
#ifdef EMU
  v += shfl_xor_(v, 32); v += shfl_xor_(v, 16); v += shfl_xor_(v, 8); v += shfl_xor_(v, 4); v += shfl_xor_(v, 2); v += shfl_xor_(v, 1);
  return v;
#else
  int x = __float_as_int(v);
  x = __float_as_int(__int_as_float(x) + __int_as_float(__builtin_amdgcn_update_dpp(0, x, 0xB1, 0xF, 0xF, true)));
  x = __float_as_int(__int_as_float(x) + __int_as_float(__builtin_amdgcn_update_dpp(0, x, 0x4E, 0xF, 0xF, true)));
  x = __float_as_int(__int_as_float(x) + __int_as_float(__builtin_amdgcn_update_dpp(0, x, 0x141, 0xF, 0xF, true)));
  x = __float_as_int(__int_as_float(x) + __int_as_float(__builtin_amdgcn_update_dpp(0, x, 0x140, 0xF, 0xF, true)));
  const float r0 = __int_as_float(__builtin_amdgcn_readlane(x, 0)), r1 = __int_as_float(__builtin_amdgcn_readlane(x, 16));
  const float r2 = __int_as_float(__builtin_amdgcn_readlane(x, 32)), r3 = __int_as_float(__builtin_amdgcn_readlane(x, 48));
  return (r0 + r1) + (r2 + r3);
#endif
}
#ifndef EMU
#define XB_TMO      128
#define XB_XCNT(j)  (256  + 64 * (j))
#define XB_XSUB(j)  (1280 + 64 * (j))
#define XB_XGEN(j)  (2304 + 64 * (j))
#define XB_TOP      3328
#define XB_TOPGEN   3392
#define XB_SPIN_CAP (1u << 24)
#define LAS __attribute__((address_space(3)))
DI unsigned xb_ld(unsigned* p) { return __hip_atomic_load(p, __ATOMIC_RELAXED, __HIP_MEMORY_SCOPE_AGENT); }
DI unsigned xb_add(unsigned* p, unsigned v) { return __hip_atomic_fetch_add(p, v, __ATOMIC_RELAXED, __HIP_MEMORY_SCOPE_AGENT); }
DI unsigned xb_xcc_id() { return (unsigned)__builtin_amdgcn_s_getreg((3 << 11) | 20) & 0xFu; }
#define XB_SPIN(cond, bar) do { unsigned _sp = 0; while (cond) { __builtin_amdgcn_s_sleep(1); \
    if ((++_sp & 255u) == 0u) { if (xb_ld(&(bar)[XB_TMO])) break; if (_sp > XB_SPIN_CAP) { atomicAdd(&(bar)[XB_TMO], 1u); break; } } } } while (0)
struct XcdBarrier { unsigned* bar; unsigned x; volatile LAS unsigned* st; };
DI XcdBarrier xcd_barrier_post(unsigned* bar, volatile LAS unsigned* st) {
  XcdBarrier b; b.bar = bar; b.x = xb_xcc_id(); b.st = st;
  if (threadIdx.x == 0) (void)xb_add(&bar[XB_XCNT(b.x)], 1u);
  return b;
}
DI void xcd_barrier_complete(unsigned* bar, unsigned x, unsigned& nloc, unsigned& nx) {
  const unsigned G = gridDim.x * gridDim.y * gridDim.z;
  unsigned sum, cnt, mine, sp = 0u;
  for (;;) {
    sum = 0u; cnt = 0u; mine = 0u;
#pragma unroll
    for (unsigned j = 0; j < 16; ++j) { const unsigned c = xb_ld(&bar[XB_XCNT(j)]); sum += c; cnt += (c > 0u) ? 1u : 0u; mine = (j == x) ? c : mine; }
    if (sum == G) break;
    __builtin_amdgcn_s_sleep(1);
    if ((++sp & 255u) == 0u) { if (xb_ld(&bar[XB_TMO])) break; if (sp > XB_SPIN_CAP) { atomicAdd(&bar[XB_TMO], 1u); break; } }
  }
  nloc = mine > 0u ? mine : 1u; nx = cnt > 0u ? cnt : 1u;
}
DI void xcd_barrier(const XcdBarrier& b) {
  asm volatile("s_waitcnt vmcnt(0)" ::: "memory");
  __syncthreads();
  if (threadIdx.x == 0) {
    unsigned* bar = b.bar;
    __builtin_amdgcn_s_waitcnt(0);
    unsigned nloc = b.st[0], nx = b.st[1];
    if (nloc == 0u) { xcd_barrier_complete(bar, b.x, nloc, nx); b.st[0] = nloc; b.st[1] = nx; }
    const unsigned old = xb_add(&bar[XB_XSUB(b.x)], 1u);
    const unsigned gen = old / nloc;
    if (old + 1u == (gen + 1u) * nloc) {
      __builtin_amdgcn_fence(__ATOMIC_RELEASE, "agent");
      asm volatile("s_waitcnt vmcnt(0)" ::: "memory");
      const unsigned og = xb_add(&bar[XB_TOP], 1u);
      const unsigned tg = og / nx;
      if (og + 1u == (tg + 1u) * nx) xb_add(&bar[XB_TOPGEN], 1u);
      else XB_SPIN(xb_ld(&bar[XB_TOPGEN]) == tg, bar);
      __builtin_amdgcn_fence(__ATOMIC_ACQUIRE, "agent");
      xb_add(&bar[XB_XGEN(b.x)], 1u);
      asm volatile("s_waitcnt vmcnt(0)" ::: "memory");
    } else {
      XB_SPIN(xb_ld(&bar[XB_XGEN(b.x)]) == gen, bar);
      __builtin_amdgcn_fence(__ATOMIC_ACQUIRE, "agent");
      asm volatile("s_waitcnt vmcnt(0)" ::: "memory");
    }
  }
  __syncthreads();
}
#endif

struct GA {
  const bf16* A; const bf16* A2; int lda, lda2, ksplit;
  const int* ridx; int mvalid;
  const bf16* Bt; int ldb; int K;
  int kfix;
};
DI GA make_ga(const bf16* A, int lda, const bf16* Bt, int ldb, int K, int mvalid) {
  GA g; g.A = A; g.A2 = A; g.lda = lda; g.lda2 = lda; g.ksplit = K; g.ridx = nullptr; g.mvalid = mvalid; g.Bt = Bt; g.ldb = ldb; g.K = K; g.kfix = 0; return g;
}

#ifdef EMU
#define GLDS16(gptr_, lptr_) memcpy((void*)(lptr_), (const void*)(gptr_), 16)
#define BGLDS16(rsrc_, base_, voff_, soff_, lptr_) memcpy((void*)(lptr_), (const char*)(base_) + (voff_) + (soff_), 16)
#define GEMM_WAIT(N_)
#define RAW_BARRIER() __syncthreads()
#else
#define LASV __attribute__((address_space(3))) void
#define GLDS16(gptr_, lptr_) __builtin_amdgcn_global_load_lds((const void*)(gptr_), (LASV*)(lptr_), 16, 0, 0)
#define BGLDS16(rsrc_, base_, voff_, soff_, lptr_) __builtin_amdgcn_raw_ptr_buffer_load_lds(rsrc_, (LASV*)(lptr_), 16, (int)(voff_), (int)(soff_), 0, 0)
#define GEMM_WAIT(N_) asm volatile("s_waitcnt vmcnt(%0)" :: "n"(N_) : "memory")
#define RAW_BARRIER() { asm volatile("" ::: "memory"); __builtin_amdgcn_s_barrier(); asm volatile("" ::: "memory"); }
#endif
DI int perm32(int rho) { const int n = rho >> 4, i = rho & 15; return 8 * (i >> 2) + 4 * n + (i & 3); }
constexpr int SRS_OFF = 73728;
template <int NT>
DI void gemm_s(const GA& g, int m0, int n0, char* smem, f32x4 (&acc)[4][NT]) {
  constexpr int A_ELEMS = 256 * 32, B_ELEMS = 32 * NT * 32, STAGE = A_ELEMS + B_ELEMS;
  bf16* st = (bf16*)smem;
  const int tid = tid_(), lane = tid & 63, wid = tid >> 6, wr = wid >> 1, wc = wid & 1, fr = lane & 15, fq = lane >> 4;
  const int lrow = tid >> 2, pch = tid & 3;
  long aoff[2], aoff2[2], boff;
#pragma unroll
  for (int i = 0; i < 2; ++i) {
    const int row = lrow + 128 * i;
    const int lch = pch ^ ((-(row >> 2)) & 3);
    int gm = m0 + row; if (gm > g.mvalid - 1) gm = g.mvalid - 1;
    const int ar = g.ridx ? g.ridx[gm] : gm;
    aoff[i] = (long)ar * g.lda + lch * 8;
    aoff2[i] = (long)ar * g.lda2 + lch * 8;
  }
  const int cb = (NT == 4) ? tid : (tid & 255);
  {
    const int row = cb >> 2;
    const int lch = pch ^ ((-(row >> 2)) & 3);
    const int src = n0 + (row & ~31) + perm32(row & 31);
    boff = (long)src * g.ldb + lch * 8;
  }
#pragma unroll
  for (int m = 0; m < 4; ++m)
#pragma unroll
    for (int n = 0; n < NT; ++n) acc[m][n] = f32x4{0.f, 0.f, 0.f, 0.f};
  const int T = g.K / 32;
#define GEMM_DMA(t_, stg_) { const int k0_ = (t_) * 32; const bool seg2_ = (k0_ >= g.ksplit); bf16* sa_ = st + (stg_) * STAGE; \
    _Pragma("unroll") for (int i_ = 0; i_ < 2; ++i_) { \
      const bf16* ap_ = seg2_ ? (g.A2 + aoff2[i_] + (k0_ - g.ksplit)) : (g.A + aoff[i_] + k0_); \
      GLDS16(ap_, sa_ + (tid + i_ * 512) * 8); } \
    GLDS16(g.Bt + boff + k0_, sa_ + A_ELEMS + cb * 8); }
  __syncthreads();
  GEMM_DMA(0, 0)
  if (T > 1) GEMM_DMA(1, 1)
  int s_cur = 0, s_nxt = 2;
#pragma unroll 1
  for (int t = 0; t < T; ++t) {
    if (t + 1 < T) { GEMM_WAIT(3); } else { GEMM_WAIT(0); }
    RAW_BARRIER();
    if (t + 2 < T) GEMM_DMA(t + 2, s_nxt)
    const bf16* sa = st + s_cur * STAGE;
    const bf16* sb = sa + A_ELEMS;
    bf16x8 af[4], bfr[NT];
#pragma unroll
    for (int n = 0; n < NT; ++n) {
      const int row = wc * (16 * NT) + n * 16 + fr;
      bfr[n] = *(const bf16x8*)(sb + row * 32 + ((fq ^ ((-(row >> 2)) & 3)) << 3));
    }
#pragma unroll
    for (int m = 0; m < 4; ++m) {
      const int row = wr * 64 + m * 16 + fr;
      af[m] = *(const bf16x8*)(sa + row * 32 + ((fq ^ ((-(row >> 2)) & 3)) << 3));
    }
#pragma unroll
    for (int m = 0; m < 4; ++m)
#pragma unroll
      for (int n = 0; n < NT; ++n) acc[m][n] = __builtin_amdgcn_mfma_f32_16x16x32_bf16(bfr[n], af[m], acc[m][n], 0, 0, 0);
    s_cur = (s_cur == 2) ? 0 : s_cur + 1;
    s_nxt = (s_nxt == 2) ? 0 : s_nxt + 1;
  }
}
constexpr int BG_HT = 128 * 64;
DI int lds_byte(int r, int c) { const int stt = (r >> 4) * 2 + (c >> 5), rr = r & 15, cc = c & 31, ob = rr * 64 + cc * 2; return stt * 1024 + (ob ^ (((ob >> 9) & 1) << 5)); }
DI void stage_rc(int b, int& R, int& C) { const int stt = b / 1024, sb = b % 1024, swz = sb ^ (((sb >> 9) & 1) << 5); R = (stt >> 1) * 16 + swz / 64; C = (stt & 1) * 32 + (swz % 64) / 2; }
#ifdef EMU
#define BG_WAIT_V(n)
#define BG_WAIT_L(n)
#define BG_BAR __syncthreads()
#define BG_SCHED
#define BG_PRIO(x)
#else
#define BG_WAIT_V(n) asm volatile("s_waitcnt vmcnt(" #n ")" ::: "memory")
#define BG_WAIT_L(n) asm volatile("s_waitcnt lgkmcnt(" #n ")" ::: "memory")
#define BG_BAR __builtin_amdgcn_s_barrier()
#define BG_SCHED __builtin_amdgcn_sched_barrier(0)
#define BG_PRIO(x) __builtin_amdgcn_s_setprio(x)
#endif
DI void gemm_big(const GA& g, int m0, int n0, char* smem, f32x4 (&acc)[2][2][4][2]) {
  bf16* shm = (bf16*)smem;
  const int tid = tid_(), wid = tid >> 6, lane = tid & 63, wr = wid >> 2, wc = wid & 3, fr = lane & 15, fq = lane >> 4;
  unsigned aof[2][2], bof[2];
#ifdef EMU
  const int dma_lds = tid * 16;
#else
  const int dma_lds = __builtin_amdgcn_readfirstlane(tid >> 6) * 1024;
#endif
#ifndef EMU
  const __amdgpu_buffer_rsrc_t rsA = __builtin_amdgcn_make_buffer_rsrc((void*)g.A, 0, 0x7fffffff, 0x00020000);
  const __amdgpu_buffer_rsrc_t rsB = __builtin_amdgcn_make_buffer_rsrc((void*)g.Bt, 0, 0x7fffffff, 0x00020000);
#endif
#pragma unroll
  for (int i = 0; i < 2; ++i) {
    int R, C; stage_rc(tid * 16 + i * 8192, R, C);
    bof[i] = (unsigned)((n0 + (R & ~31) + perm32(R & 31)) * g.ldb + C) * 2u;
#pragma unroll
    for (int h = 0; h < 2; ++h) {
      int gm = m0 + h * 128 + R; if (gm > g.mvalid - 1) gm = g.mvalid - 1;
      const int ar = g.ridx ? g.ridx[gm] : gm;
      aof[h][i] = (unsigned)(ar * g.lda + C) * 2u;
    }
  }
#define BG_SA(b, h) (shm + ((b) * 2 + (h)) * BG_HT)
#define BG_SB(b, h) (shm + (4 + (b) * 2 + (h)) * BG_HT)
#define BG_STAGE_A(P, h, kt) { \
    _Pragma("unroll") for (int i_ = 0; i_ < 2; ++i_) BGLDS16(rsA, g.A, aof[h][i_], (kt) * 128, (char*)(P) + dma_lds + i_ * 8192); }
#define BG_STAGE_B(P, h, kt) { \
    _Pragma("unroll") for (int i_ = 0; i_ < 2; ++i_) BGLDS16(rsB, g.Bt, bof[i_], (kt) * 128 + (h) * 256 * g.ldb, (char*)(P) + dma_lds + i_ * 8192); }
#define BG_LDA(dst, b, h) _Pragma("unroll") for (int m_ = 0; m_ < 4; ++m_) _Pragma("unroll") for (int k_ = 0; k_ < 2; ++k_) \
    dst[m_][k_] = *(const bf16x8*)((const char*)BG_SA(b, h) + lds_byte(wr * 64 + m_ * 16 + fr, k_ * 32 + fq * 8))
#define BG_LDB(dst, b, h) _Pragma("unroll") for (int n_ = 0; n_ < 2; ++n_) _Pragma("unroll") for (int k_ = 0; k_ < 2; ++k_) \
    dst[n_][k_] = *(const bf16x8*)((const char*)BG_SB(b, h) + lds_byte(wc * 32 + n_ * 16 + fr, k_ * 32 + fq * 8))
#define BG_MMA(ai, bj, At_, Bt_) { BG_PRIO(1); \
    _Pragma("unroll") for (int m_ = 0; m_ < 4; ++m_) _Pragma("unroll") for (int n_ = 0; n_ < 2; ++n_) _Pragma("unroll") for (int k_ = 0; k_ < 2; ++k_) \
      acc[ai][bj][m_][n_] = __builtin_amdgcn_mfma_f32_16x16x32_bf16(Bt_[n_][k_], At_[m_][k_], acc[ai][bj][m_][n_], 0, 0, 0); \
    BG_PRIO(0); }
#pragma unroll
  for (int a_ = 0; a_ < 2; ++a_)
#pragma unroll
    for (int b_ = 0; b_ < 2; ++b_)
#pragma unroll
      for (int m_ = 0; m_ < 4; ++m_)
#pragma unroll
        for (int n_ = 0; n_ < 2; ++n_) acc[a_][b_][m_][n_] = f32x4{0.f, 0.f, 0.f, 0.f};
  bf16x8 At[4][2], B0[2][2], B1[2][2];
  const int nt = g.K / 64;
  __syncthreads();
  BG_STAGE_B(BG_SB(0, 0), 0, 0) BG_STAGE_A(BG_SA(0, 0), 0, 0)
  BG_STAGE_B(BG_SB(0, 1), 1, 0) BG_STAGE_A(BG_SA(0, 1), 1, 0)
  if (wr == 1) BG_BAR;
  BG_WAIT_V(4); BG_BAR;
  BG_STAGE_B(BG_SB(1, 0), 0, 1) BG_STAGE_A(BG_SA(1, 0), 0, 1) BG_STAGE_B(BG_SB(1, 1), 1, 1)
  BG_WAIT_V(6); BG_BAR;
#pragma unroll 1
  for (int t = 0; t < nt - 2; t += 2) {
    BG_LDB(B0, 0, 0); BG_SCHED; BG_LDA(At, 0, 0); BG_STAGE_A(BG_SA(1, 1), 1, t + 1)
    BG_WAIT_L(8); BG_BAR; BG_WAIT_L(0); BG_MMA(0, 0, At, B0) BG_BAR; BG_SCHED;
    BG_LDB(B1, 0, 1); BG_STAGE_B(BG_SB(0, 0), 0, t + 2)
    BG_BAR; BG_WAIT_L(0); BG_MMA(0, 1, At, B1) BG_BAR;
    BG_LDA(At, 0, 1); BG_STAGE_A(BG_SA(0, 0), 0, t + 2)
    BG_BAR; BG_WAIT_L(0); BG_MMA(1, 0, At, B0) BG_BAR; BG_SCHED;
    BG_STAGE_B(BG_SB(0, 1), 1, t + 2)
    BG_WAIT_V(6); BG_BAR; BG_MMA(1, 1, At, B1) BG_BAR;
    BG_LDB(B0, 1, 0); BG_SCHED; BG_LDA(At, 1, 0); BG_STAGE_A(BG_SA(0, 1), 1, t + 2)
    BG_WAIT_L(8); BG_BAR; BG_WAIT_L(0); BG_MMA(0, 0, At, B0) BG_BAR; BG_SCHED;
    BG_LDB(B1, 1, 1); BG_STAGE_B(BG_SB(1, 0), 0, t + 3)
    BG_BAR; BG_WAIT_L(0); BG_MMA(0, 1, At, B1) BG_BAR;
    BG_LDA(At, 1, 1); BG_STAGE_A(BG_SA(1, 0), 0, t + 3)
    BG_BAR; BG_WAIT_L(0); BG_MMA(1, 0, At, B0) BG_BAR; BG_SCHED;
    BG_STAGE_B(BG_SB(1, 1), 1, t + 3)
    BG_WAIT_V(6); BG_BAR; BG_MMA(1, 1, At, B1) BG_BAR;
  }
  { BG_LDB(B0, 0, 0); BG_LDA(At, 0, 0); BG_STAGE_A(BG_SA(1, 1), 1, nt - 1)
    BG_BAR; BG_WAIT_L(0); BG_MMA(0, 0, At, B0) BG_BAR;
    BG_LDB(B1, 0, 1); BG_BAR; BG_WAIT_L(0); BG_MMA(0, 1, At, B1) BG_BAR;
    BG_LDA(At, 0, 1); BG_WAIT_V(4); BG_BAR; BG_WAIT_L(0); BG_MMA(1, 0, At, B0) BG_MMA(1, 1, At, B1) BG_BAR; }
  { BG_LDB(B0, 1, 0); BG_LDA(At, 1, 0); BG_WAIT_V(2); BG_BAR; BG_WAIT_L(0); BG_MMA(0, 0, At, B0) BG_BAR;
    BG_LDB(B1, 1, 1); BG_WAIT_V(0); BG_BAR; BG_WAIT_L(0); BG_MMA(0, 1, At, B1) BG_BAR;
    BG_LDA(At, 1, 1); BG_BAR; BG_WAIT_L(0); BG_MMA(1, 0, At, B0) BG_MMA(1, 1, At, B1) BG_BAR; }
  if (wr == 0) BG_BAR;
}
#define EPIB_BEGIN(acc_, m0_, n0_, mvalid_) { const int _l = tid_() & 63, _w = tid_() >> 6, _wr = _w >> 2, _wc = _w & 3, _fr = _l & 15, _fq = _l >> 4; \
  _Pragma("unroll") for (int _ai = 0; _ai < 2; ++_ai) _Pragma("unroll") for (int _m = 0; _m < 4; ++_m) { const int row = (m0_) + _ai * 128 + _wr * 64 + _m * 16 + _fr; \
  _Pragma("unroll") for (int _bj = 0; _bj < 2; ++_bj) { const int col = (n0_) + _bj * 128 + _wc * 32 + 8 * _fq; (void)col; \
    float v[8] = {acc_[_ai][_bj][_m][0][0], acc_[_ai][_bj][_m][0][1], acc_[_ai][_bj][_m][0][2], acc_[_ai][_bj][_m][0][3], \
                  acc_[_ai][_bj][_m][1][0], acc_[_ai][_bj][_m][1][1], acc_[_ai][_bj][_m][1][2], acc_[_ai][_bj][_m][1][3]}; \
    if (row < (mvalid_)) {
#define EPIB_END }}}}

DI void ld8bf(const bf16* p, float (&v)[8]) {
  uint4 w = *(const uint4*)p;
  v[0] = __uint_as_float(w.x << 16); v[1] = __uint_as_float(w.x & 0xffff0000u); v[2] = __uint_as_float(w.y << 16); v[3] = __uint_as_float(w.y & 0xffff0000u);
  v[4] = __uint_as_float(w.z << 16); v[5] = __uint_as_float(w.z & 0xffff0000u); v[6] = __uint_as_float(w.w << 16); v[7] = __uint_as_float(w.w & 0xffff0000u);
}
DI void st8bf(bf16* p, const float (&v)[8]) { *(uint4*)p = make_uint4(pack2(v[0], v[1]), pack2(v[2], v[3]), pack2(v[4], v[5]), pack2(v[6], v[7])); }
#ifdef EMU
DI unsigned pk_u8_(float x, int sel, unsigned old) { float y = x < 0.f ? 0.f : (x > 255.f ? 255.f : x); return (old & ~(0xffu << (8 * sel))) | ((unsigned)lrintf(y) << (8 * sel)); }
#else
DI unsigned pk_u8_(float x, int sel, unsigned old) { return __builtin_amdgcn_cvt_pk_u8_f32(x, (unsigned)sel, old); }
#endif
DI void st8u8(unsigned char* p, const float (&v)[8]) {
  unsigned lo = 0u, hi = 0u;
#pragma unroll
  for (int k = 0; k < 4; ++k) { lo = pk_u8_(v[k] * 255.0f, k, lo); hi = pk_u8_(v[4 + k] * 255.0f, k, hi); }
  *(uint2*)p = make_uint2(lo, hi);
}
DI void ld8u8(const unsigned char* p, float (&v)[8]) {
  const uint2 w = *(const uint2*)p;
#pragma unroll
  for (int k = 0; k < 4; ++k) { v[k] = (float)((w.x >> (8 * k)) & 0xffu); v[4 + k] = (float)((w.y >> (8 * k)) & 0xffu); }
}
DI float4 bf4_(uint2 w) { return make_float4(__uint_as_float(w.x << 16), __uint_as_float(w.x & 0xffff0000u), __uint_as_float(w.y << 16), __uint_as_float(w.y & 0xffff0000u)); }
DI float4 bf4_(float4 v) { return v; }
DI uint2 pk4_(float4 v) { return make_uint2(pack2(v.x, v.y), pack2(v.z, v.w)); }
DI void st8f(float* p, const float (&v)[8]) { *(float4*)p = make_float4(v[0], v[1], v[2], v[3]); *(float4*)(p + 4) = make_float4(v[4], v[5], v[6], v[7]); }
#define EPI_BEGIN(NT_, acc_, m0_, n0_, mvalid_) { const int _l = tid_() & 63, _w = tid_() >> 6, _wr = _w >> 1, _wc = _w & 1, _fr = _l & 15, _fq = _l >> 4; \
  _Pragma("unroll") for (int _m = 0; _m < 4; ++_m) { const int row = (m0_) + _wr * 64 + _m * 16 + _fr; \
  _Pragma("unroll") for (int _q = 0; _q < (NT_) / 2; ++_q) { const int col = (n0_) + _wc * (16 * (NT_)) + _q * 32 + 8 * _fq; (void)col; \
    float v[8] = {acc_[_m][2 * _q][0], acc_[_m][2 * _q][1], acc_[_m][2 * _q][2], acc_[_m][2 * _q][3], \
                  acc_[_m][2 * _q + 1][0], acc_[_m][2 * _q + 1][1], acc_[_m][2 * _q + 1][2], acc_[_m][2 * _q + 1][3]}; \
    if (row < (mvalid_)) {
#define EPI_END }}}}

DI int mtile_row0(int mt, bool latonly, int TH) {
  if (!latonly) return mt * TH;
  const int per = SEQ / TH, b = mt / per, r = mt % per;
  return b * TOK + CTXL + r * TH;
}
DI int mtiles(bool latonly, int TH) { return latonly ? BATCH * (SEQ / TH) : (NTOK + TH - 1) / TH; }

struct LP {
  int l; bool last;
  const float* mod;
  char* we;
  char* s5;
};
DI LP make_lp(const Params& p, int l) {
  LP q; q.l = l; q.last = (l == DEPTH - 1);
  q.mod = (const float*)(p.ws + OFF_MOD) + (size_t)l * NB1 * 6144;
  q.we = p.ws + OFF_WEARLY + (size_t)l * WE_SIZE;
  q.s5 = p.ws + OFF_S5TAB + (size_t)l * S5_SIZE;
  return q;
}

template <class RowMap>
DI void conv_tile(const float* src, int lds, int nsrc, const float* kscale, bf16* dst, int K, int k0, int n0, char* smem, RowMap rowmap, int ndst = 1 << 30) {
  (void)smem;
  const int tid = tid_(), n4 = (tid >> 6) * 32 + (tid & 7) * 4, k8 = ((tid >> 3) & 7) * 8;
  float4 v[8];
  const bool ok = (n0 + n4 < nsrc);
  const float* sp = src + (size_t)(k0 + k8) * lds + n0 + n4;
#pragma unroll
  for (int k = 0; k < 8; ++k) v[k] = ok ? *(const float4*)(sp + (size_t)k * lds) : make_float4(0.f, 0.f, 0.f, 0.f);
  if (kscale) {
#pragma unroll
    for (int k = 0; k < 8; ++k) { const float sc = kscale[k0 + k8 + k]; v[k].x *= sc; v[k].y *= sc; v[k].z *= sc; v[k].w *= sc; }
  }
  float o[8];
#pragma unroll
  for (int k = 0; k < 8; ++k) o[k] = v[k].x;
  if (n0 + n4 + 0 < ndst) st8bf(dst + (size_t)rowmap(n0 + n4 + 0) * K + k0 + k8, o);
#pragma unroll
  for (int k = 0; k < 8; ++k) o[k] = v[k].y;
  if (n0 + n4 + 1 < ndst) st8bf(dst + (size_t)rowmap(n0 + n4 + 1) * K + k0 + k8, o);
#pragma unroll
  for (int k = 0; k < 8; ++k) o[k] = v[k].z;
  if (n0 + n4 + 2 < ndst) st8bf(dst + (size_t)rowmap(n0 + n4 + 2) * K + k0 + k8, o);
#pragma unroll
  for (int k = 0; k < 8; ++k) o[k] = v[k].w;
  if (n0 + n4 + 3 < ndst) st8bf(dst + (size_t)rowmap(n0 + n4 + 3) * K + k0 + k8, o);
}
struct RowId { DI int operator()(int n) const { return n; } };
struct RowGU { int half; DI int operator()(int f) const { return (f >> 7) * 256 + half * 128 + (f & 127); } };

constexpr int CT_WIN = 16 * (N_INP / 256), CT_UQ = 4 * 2, CT_UKV = 2 * 2, CT_GLU = 4, CT_WB = 4 * 16, CT_WOUT = 64;
constexpr int CT_EARLY = CT_WIN + CT_UQ + CT_UKV + CT_GLU + CT_WB + CT_WOUT;
constexpr int CT_EXP = NE * 3 * 64;

DI void conv_early_item(const Params& p, int l, int it, char* smem) {
  char* we = p.ws + OFF_WEARLY + (size_t)l * WE_SIZE;
  if (it < CT_WIN) {
    int kt = it % 16, nt = it / 16;
    conv_tile(p.in[I_WIN] + (size_t)l * 1024 * N_IN, N_IN, N_IN, nullptr, (bf16*)(we + WE_WIN), 1024, kt * 64, nt * 256, smem, RowId());
    return;
  }
  it -= CT_WIN;
  if (it < CT_UQ) {
    int kt = it % 4, nt = it / 4;
    conv_tile(p.in[I_WUQ] + (size_t)l * 256 * 384, 384, 384, p.in[I_GCQ] + l * 256, (bf16*)(we + WE_UQ), 256, kt * 64, nt * 256, smem, RowId(), 384);
    return;
  }
  it -= CT_UQ;
  if (it < CT_UKV) {
    int kt = it % 2, nt = it / 2;
    conv_tile(p.in[I_WUKV] + (size_t)l * 128 * 512, 512, 512, p.in[I_GCKV] + l * 128, (bf16*)(we + WE_UKV), 128, kt * 64, nt * 256, smem, RowId());
    return;
  }
  it -= CT_UKV;
  if (it < CT_GLU) {
    int kt = it;
    conv_tile(p.in[I_S5WGLU] + (size_t)l * 256 * 256, 256, 256, nullptr, (bf16*)(we + WE_GLU), 256, kt * 64, 0, smem, RowId());
    return;
  }
  it -= CT_GLU;
  if (it < CT_WB) {
    int j = it / 16, r = it % 16, kt = r % 4, nt = r / 4;
    conv_tile(p.in[I_WBRANCH] + ((size_t)l * 4 + j) * 256 * 1024, 1024, 1024, nullptr, (bf16*)(we + WE_WB) + (size_t)j * 1024 * 256, 256, kt * 64, nt * 256, smem, RowId());
    return;
  }
  it -= CT_WB;
  {
    int kt = it % 16, nt = it / 16;
    conv_tile(p.in[I_WOUT] + (size_t)l * 1024 * 1024, 1024, 1024, nullptr, (bf16*)(we + WE_WOUT), 1024, kt * 64, nt * 256, smem, RowId());
  }
}
DI void conv_expert_item(const Params& p, int l, int it, char* smem) {
  char* wx = p.ws + OFF_MIX;
  int e = it / 192, r = it % 192, which = r / 64, t = r % 64, kt = t % 16, nt = t / 16;
  size_t eoff = ((size_t)l * NE + e) * 1024 * 1024;
  if (which == 0) { RowGU rm; rm.half = 0; conv_tile(p.in[I_WGATE] + eoff, 1024, 1024, nullptr, (bf16*)(wx + WX_GU) + (size_t)e * 2048 * 1024, 1024, kt * 64, nt * 256, smem, rm); }
  else if (which == 1) { RowGU rm; rm.half = 1; conv_tile(p.in[I_WUP] + eoff, 1024, 1024, nullptr, (bf16*)(wx + WX_GU) + (size_t)e * 2048 * 1024, 1024, kt * 64, nt * 256, smem, rm); }
  else conv_tile(p.in[I_WDOWN] + eoff, 1024, 1024, nullptr, (bf16*)(wx + WX_DN) + (size_t)e * 1024 * 1024, 1024, kt * 64, nt * 256, smem, RowId());
}

DI void mod_item(const Params& p, int it, char* smem) {
  const int l = it / 96, cg0 = (it % 96) * 64;
  float* sc = (float*)smem;
  float* red = sc + NB1 * 1024;
  const int tid = tid_();
  __syncthreads();
  for (int i = tid; i < NB1 * 1024; i += NTHREADS) {
    int r = i >> 10, k = i & 1023;
    float c = (r < BATCH) ? p.in[I_C][r * 1024 + k] : p.in[I_CCTX][k];
    sc[i] = siluf_(c);
  }
  __syncthreads();
  const int cl = tid & 63, kg = tid >> 6;
  float acc[NB1];
#pragma unroll
  for (int r = 0; r < NB1; ++r) acc[r] = 0.f;
  const float* w = p.in[I_WADA] + (size_t)l * 1024 * 6144 + cg0 + cl;
  for (int k0 = kg * (1024 / NWAVES); k0 < (kg + 1) * (1024 / NWAVES); k0 += 16) {
    float wv[16];
#pragma unroll
    for (int u = 0; u < 16; ++u) wv[u] = w[(size_t)(k0 + u) * 6144];
#pragma unroll
    for (int u = 0; u < 16; ++u)
#pragma unroll
      for (int r = 0; r < NB1; ++r) acc[r] += sc[r * 1024 + k0 + u] * wv[u];
  }
#pragma unroll
  for (int r = 0; r < NB1; ++r) red[(kg * NB1 + r) * 64 + cl] = acc[r];
  __syncthreads();
  for (int i = tid; i < NB1 * 64; i += NTHREADS) {
    int r = i >> 6, c = i & 63;
    float s = 0.f;
#pragma unroll
    for (int q = 0; q < NWAVES; ++q) s += red[(q * NB1 + r) * 64 + c];
    s += p.in[I_BADA][l * 6144 + cg0 + c];
    ((float*)(p.ws + OFF_MOD))[((size_t)l * NB1 + r) * 6144 + cg0 + c] = s;
  }
}

DI void s5_tab_item(const Params& p, int it, char* smem) {
  const int l = it / 32, d = (it / 16) & 1, g = it & 15;
  char* s5 = p.ws + OFF_S5TAB + (size_t)l * S5_SIZE;
  float* lampow = (float*)(s5 + S5_LAMPOW) + (size_t)(d * 16 + g) * 17 * 64 * 2;
  float* bbar = (float*)(s5 + S5_BBAR) + (size_t)(d * 16 + g) * 64 * 16 * 2;
  float* kt = (float*)(s5 + S5_KT) + (size_t)(d * 16 + g) * 16 * 256;
  float* slam = (float*)smem;
  float* sbb = slam + 17 * 64 * 2;
  const int tid = tid_();
  const size_t pg = ((size_t)(l * 2 + d) * 16 + g);
  const float step = expf(p.in[I_S5LOGSTEP][pg]);
  __syncthreads();
  for (int i = tid; i < 17 * 64; i += NTHREADS) {
    int j = i >> 6, pp = i & 63;
    float are = p.in[I_S5ARE][pg * 64 + pp], aim = p.in[I_S5AIM][pg * 64 + pp];
    float mag = expf((float)j * step * are), ang = (float)j * step * aim;
    float re = mag * cosf(ang), im = mag * sinf(ang);
    slam[i * 2] = re; slam[i * 2 + 1] = im; lampow[i * 2] = re; lampow[i * 2 + 1] = im;
  }
  __syncthreads();
  for (int i = tid; i < 64 * 16; i += NTHREADS) {
    int pp = i >> 4;
    float are = p.in[I_S5ARE][pg * 64 + pp], aim = p.in[I_S5AIM][pg * 64 + pp];
    float x = slam[(64 + pp) * 2] - 1.0f, y = slam[(64 + pp) * 2 + 1];
    float den = are * are + aim * aim;
    float qre = (x * are + y * aim) / den, qim = (y * are - x * aim) / den;
    float bre = p.in[I_S5BRE][pg * 1024 + i], bim = p.in[I_S5BIM][pg * 1024 + i];
    float re = qre * bre - qim * bim, im = qre * bim + qim * bre;
    sbb[i * 2] = re; sbb[i * 2 + 1] = im; bbar[i * 2] = re; bbar[i * 2 + 1] = im;
  }
  __syncthreads();
  for (int i = tid; i < 16 * 256; i += NTHREADS) {
    int j = i >> 8, c = (i >> 4) & 15, c2 = i & 15;
    float s = 0.f;
    for (int pp = 0; pp < 64; ++pp) {
      float cre = p.in[I_S5CRE][pg * 1024 + c * 64 + pp], cim = p.in[I_S5CIM][pg * 1024 + c * 64 + pp];
      float lre = slam[(j * 64 + pp) * 2], lim = slam[(j * 64 + pp) * 2 + 1];
      float tre = cre * lre - cim * lim, tim = cre * lim + cim * lre;
      float bre = sbb[(pp * 16 + c2) * 2], bim = sbb[(pp * 16 + c2) * 2 + 1];
      s += tre * bre - tim * bim;
    }
    kt[i] = s;
  }
}
DI void s5_mat_item(const Params& p, int it) {
  const int l = it / 256, g = (it / 16) & 15, q = it & 15;
  char* s5 = p.ws + OFF_S5TAB + (size_t)l * S5_SIZE;
  const float* lampow = (const float*)(s5 + S5_LAMPOW);
  const float* bbar = (const float*)(s5 + S5_BBAR);
  const float* ktab = (const float*)(s5 + S5_KT);
  bf16* WA = (bf16*)(s5 + S5_WA) + (size_t)g * 256 * 256;
  bf16* W2 = (bf16*)(s5 + S5_W2) + (size_t)g * 256 * 512;
  const int tid = tid_();
  for (int i = tid; i < 16 * 256; i += NTHREADS) {
    int n = q * 16 + (i >> 8), k = i & 255;
    int d = n >> 7, ri = (n >> 6) & 1, pp = n & 63, s = k >> 4, c2 = k & 15;
    int e = (d == 0) ? (15 - s) : s;
    const float* lp = lampow + ((size_t)((d * 16 + g) * 17 + e) * 64 + pp) * 2;
    const float* bp = bbar + ((size_t)((d * 16 + g) * 64 + pp) * 16 + c2) * 2;
    float re = lp[0] * bp[0] - lp[1] * bp[1], im = lp[0] * bp[1] + lp[1] * bp[0];
    WA[(size_t)n * 256 + k] = f2bf(ri == 0 ? re : im);
  }
  for (int i = tid; i < 16 * 512; i += NTHREADS) {
    int n = q * 16 + (i >> 9), k = i & 511;
    int lq = n >> 4, c = n & 15;
    float v;
    if (k < 256) {
      int s = k >> 4, c2 = k & 15;
      v = 0.f;
      if (s <= lq) v += ktab[((size_t)(0 * 16 + g) * 16 + (lq - s)) * 256 + c * 16 + c2];
      if (s >= lq) v += ktab[((size_t)(1 * 16 + g) * 16 + (s - lq)) * 256 + c * 16 + c2];
      if (s == lq && c == c2) v += p.in[I_S5D][l * 256 + g * 16 + c];
    } else {
      int kk = k - 256, d = kk >> 7, ri = (kk >> 6) & 1, pp = kk & 63;
      int e = (d == 0) ? (lq + 1) : (16 - lq);
      size_t pg = ((size_t)(l * 2 + d) * 16 + g);
      float cre = p.in[I_S5CRE][pg * 1024 + c * 64 + pp], cim = p.in[I_S5CIM][pg * 1024 + c * 64 + pp];
      const float* lp = lampow + ((size_t)((d * 16 + g) * 17 + e) * 64 + pp) * 2;
      float re = cre * lp[0] - cim * lp[1], im = cre * lp[1] + cim * lp[0];
      v = (ri == 0) ? re : -im;
    }
    W2[(size_t)n * 512 + k] = f2bf(v);
  }
}

DI int tok_b(int tok) { return tok / TOK; }
DI int tok_j(int tok) { return tok % TOK; }
DI int tok_modrow(int tok) { return (tok_j(tok) < CTXL) ? BATCH : tok_b(tok); }

DI void normmod_row(const float (&xv)[16], const float* g, const float* shift, const float* scale, bf16* dst, float (&hout)[16]) {
  const int lane = tid_() & 63;
  float ss = 0.f;
#pragma unroll
  for (int i = 0; i < 16; ++i) ss += xv[i] * xv[i];
  ss = wave_sum(ss);
  const float rs = rsqrtf(ss * (1.0f / 1024.f) + EPS);
#pragma unroll
  for (int i = 0; i < 4; ++i) {
    int c = lane * 4 + i * 256;
    float4 gv = *(const float4*)(g + c), sh = *(const float4*)(shift + c), sc = *(const float4*)(scale + c);
    float h0 = xv[i * 4 + 0] * rs * gv.x * (1.f + sc.x) + sh.x;
    float h1 = xv[i * 4 + 1] * rs * gv.y * (1.f + sc.y) + sh.y;
    float h2 = xv[i * 4 + 2] * rs * gv.z * (1.f + sc.z) + sh.z;
    float h3 = xv[i * 4 + 3] * rs * gv.w * (1.f + sc.w) + sh.w;
    hout[i * 4 + 0] = h0; hout[i * 4 + 1] = h1; hout[i * 4 + 2] = h2; hout[i * 4 + 3] = h3;
    *(uint2*)(dst + c) = make_uint2(pack2(h0, h1), pack2(h2, h3));
  }
}

DI void prep_row_item(const Params& p, int it) {
  const int tok = it * NWAVES + (tid_() >> 6), lane = tid_() & 63;
  const int b = tok_b(tok), j = tok_j(tok);
  const float* src = (j < CTXL) ? p.in[I_CTX] + ((size_t)b * CTXL + j) * 1024 : p.in[I_X] + ((size_t)b * SEQ + (j - CTXL)) * 1024;
  float xv[16], h[16];
#pragma unroll
  for (int i = 0; i < 4; ++i) {
    float4 v = *(const float4*)(src + lane * 4 + i * 256);
    xv[i * 4] = v.x; xv[i * 4 + 1] = v.y; xv[i * 4 + 2] = v.z; xv[i * 4 + 3] = v.w;
  }
  const float* mod = (const float*)(p.ws + OFF_MOD) + (size_t)tok_modrow(tok) * 6144;
  normmod_row(xv, p.in[I_GPREMIX], mod + 0, mod + 1024, (bf16*)(p.ws + OFF_HA) + (size_t)tok * 1024, h);
}

constexpr int IP_LT = BATCH * (SEQ / 256), IP_CT = BATCH * ((CTXL + 255) / 256), IP_MT = IP_LT + IP_CT, IP_NT = N_INP / 256;
constexpr int IP_RR = (IP_MT + 7) / 8, IP_RC = (IP_NT + 1) / 2;
constexpr int IP_RC_NOGATE = (((C_GATE + 255) / 256) + 1) / 2;
constexpr int IP_RR_LAT = IP_LT / 8;
constexpr bool IP_COMPACT = (IP_LT % 8 == 0);
constexpr int IP_RECTS_ALL = IP_RR * IP_RC, IP_RECTS_LAST = IP_COMPACT ? (IP_RR * IP_RC_NOGATE + IP_RR_LAT * (IP_RC - IP_RC_NOGATE)) : IP_RECTS_ALL;
constexpr int IP_SLOTS_ALL = ((IP_RECTS_ALL + 15) / 16) * 256, IP_SLOTS_LAST = ((IP_RECTS_LAST + 15) / 16) * 256;
DI void inproj_tile(const Params& p, const LP& L, int t, char* smem) {
  const int vb = t % 256, vround = t / 256, x = vb % 8, j = vb / 8;
  const int Rc = vround * 16 + x * 2 + (j >> 4), jj = j & 15;
  int rm, rn;
  if (!L.last || !IP_COMPACT || Rc < IP_RR * IP_RC_NOGATE) { rm = Rc % IP_RR; rn = Rc / IP_RR; }
  else { const int q = Rc - IP_RR * IP_RC_NOGATE; rm = q % IP_RR_LAT; rn = IP_RC_NOGATE + q / IP_RR_LAT; }
  const int mt = rm * 8 + (jj & 7), nt = rn * 2 + (jj >> 3);
  if (mt >= IP_MT || nt >= IP_NT || rn >= IP_RC) return;
  int m0;
  if (mt < IP_LT) m0 = (mt / (SEQ / 256)) * TOK + CTXL + (mt % (SEQ / 256)) * 256;
  else { const int c = mt - IP_LT; m0 = (c / ((CTXL + 255) / 256)) * TOK + (c % ((CTXL + 255) / 256)) * 256; }
  const int n0 = nt * 256;
  const int mv = (mt < IP_LT) ? NTOK : (m0 - (m0 % TOK) + CTXL);
  if (L.last && mt >= IP_LT && n0 >= ((C_GATE + 255) / 256) * 256) return;
  GA g = make_ga((const bf16*)(p.ws + OFF_HA), 1024, (const bf16*)(L.we + WE_WIN), 1024, 1024, mv);
  f32x4 acc[2][2][4][2];
  gemm_big(g, m0, n0, smem, acc);
  bf16* P1 = (bf16*)(p.ws + OFF_P1);
  unsigned char* PG = (unsigned char*)(p.ws + OFF_PG);
  bf16* US5 = (bf16*)(p.ws + OFF_MIX + MX_US5);
  float* DT = (float*)(p.ws + OFF_DT);
  const float* dtb = p.in[I_M2DTBIAS] + L.l * 8;
  EPIB_BEGIN(acc, m0, n0, mv)
    if (col < C_S5 || (col >= C_Z && col < C_DT)) st8bf(P1 + (size_t)row * P1W + col, v);
    else if (col < C_Z) st8bf(US5 + ((size_t)((col - C_S5) >> 4) * NTOK + row) * 16 + (col & 15), v);
    else if (col < C_GATE) {
#pragma unroll
      for (int k = 0; k < 8; ++k) v[k] = softplusf_(v[k] + dtb[k]);
      st8f(DT + (size_t)row * 8, v);
    } else if (col < N_IN) {
#pragma unroll
      for (int k = 0; k < 8; ++k) v[k] = sigmoidf_(v[k]);
      st8u8(PG + (size_t)row * 4096 + (col - C_GATE), v);
    }
  EPIB_END
}

DI void rowscale_256(const bf16* P1, int m0, int c0, int width, float* srs) {
  const int r = tid_() >> 1, hf = tid_() & 1;
  int gr = m0 + r; if (gr > NTOK - 1) gr = NTOK - 1;
  const bf16* src = P1 + (size_t)gr * P1W + c0 + hf * (width / 2);
  float ss = 0.f;
  for (int i = 0; i < width / 2; i += 8) {
    float v[8]; ld8bf(src + i, v);
#pragma unroll
    for (int k = 0; k < 8; ++k) ss += v[k] * v[k];
  }
  ss += shfl_xor_(ss, 1);
  if (hf == 0) srs[r] = rsqrtf(ss / (float)width + EPS);
}
DI void rope_tab_item(const Params& p) {
  float* tab = (float*)(p.ws + OFF_ROPE);
  for (int i = tid_(); i < 64 * 8; i += NTHREADS) {
    int pos = i >> 3, k = i & 7;
    float f = expf(-(float)k * (9.210340371976184f / 8.0f));
    float a = (float)pos * f;
    tab[i * 2] = cosf(a); tab[i * 2 + 1] = sinf(a);
  }
}
DI void rope_cs(const float* tab, int pos, int i, float& c, float& s) { c = tab[(pos * 8 + i) * 2]; s = tab[(pos * 8 + i) * 2 + 1]; }

constexpr int TP_MT = (NTOK + 255) / 256;
DI void mlaq_tile(const Params& p, const LP& L, int t, char* smem) {
  const int mt = t % TP_MT, nt = t / TP_MT, m0 = mt * 256, n0 = nt * 128;
  const bf16* P1 = (const bf16*)(p.ws + OFF_P1);
  float* srs = (float*)(smem + SRS_OFF);
  GA g = make_ga(P1 + C_CQ, P1W, (const bf16*)(L.we + WE_UQ), 256, 256, NTOK);
  f32x4 acc[4][4];
  gemm_s<4>(g, m0, n0, smem, acc);
  rowscale_256(P1, m0, C_CQ, 256, srs);
  __syncthreads();
  bf16* Q = (bf16*)(p.ws + OFF_MIX + MX_Q);
  const float* ropetab = (const float*)(p.ws + OFF_ROPE);
  {
    const int l = tid_() & 63, w = tid_() >> 6, wr = w >> 1, wc = w & 1, fr = l & 15, fq = l >> 4;
#pragma unroll
    for (int m = 0; m < 4; ++m) {
      const int row = m0 + wr * 64 + m * 16 + fr;
      const int rowc = row < NTOK ? row : NTOK - 1;
      const float rsc = srs[rowc - m0];
      const int b = tok_b(rowc), j = tok_j(rowc);
#pragma unroll
      for (int q = 0; q < 2; ++q) {
        const int col = n0 + wc * 64 + q * 32 + 8 * fq;
        const int h = col / 96, dd = col % 96;
        float v[8] = {acc[m][2 * q][0], acc[m][2 * q][1], acc[m][2 * q][2], acc[m][2 * q][3], acc[m][2 * q + 1][0], acc[m][2 * q + 1][1], acc[m][2 * q + 1][2], acc[m][2 * q + 1][3]};
        float vp[8];
#pragma unroll
        for (int k = 0; k < 8; ++k) vp[k] = shfl_xor_(v[k], 16);
        if (dd >= 64 && j >= CTXL) {
          const int tl = j - CTXL, pos = ((dd - 64) < 16) ? (tl / GRID_W) : (tl % GRID_W);
          const bool lo = ((dd & 8) == 0);
#pragma unroll
          for (int k = 0; k < 8; ++k) {
            float c, sn; rope_cs(ropetab, pos, k, c, sn);
            v[k] = lo ? (v[k] * c - vp[k] * sn) : (v[k] * c + vp[k] * sn);
          }
        }
#pragma unroll
        for (int k = 0; k < 8; ++k) v[k] *= rsc;
        if (row < NTOK) st8bf(Q + (((size_t)b * 4 + h) * TOK + j) * 96 + dd, v);
      }
    }
  }
}
DI void mlakv_tile(const Params& p, const LP& L, int t, char* smem) {
  const int mt = t % TP_MT, h = t / TP_MT, m0 = mt * 256, n0 = h * 128;
  const bf16* P1 = (const bf16*)(p.ws + OFF_P1);
  float* srs = (float*)(smem + SRS_OFF);
  GA g = make_ga(P1 + C_CKV, P1W, (const bf16*)(L.we + WE_UKV), 128, 128, NTOK);
  f32x4 acc[4][4];
  gemm_s<4>(g, m0, n0, smem, acc);
  rowscale_256(P1, m0, C_CKV, 128, srs);
  __syncthreads();
  bf16* K = (bf16*)(p.ws + OFF_MIX + MX_K);
  bf16* VT = (bf16*)(p.ws + OFF_MIX + MX_VTM);
  const float* ropetab = (const float*)(p.ws + OFF_ROPE);
  EPI_BEGIN(4, acc, m0, n0, NTOK)
    const float rsc = srs[row - m0];
    const int b = tok_b(row), j = tok_j(row), dd = col - n0;
#pragma unroll
    for (int k = 0; k < 8; ++k) v[k] *= rsc;
    if (dd < 64) st8bf(K + (((size_t)b * 4 + h) * TOK + j) * 96 + dd, v);
    else {
#pragma unroll
      for (int k = 0; k < 8; ++k) VT[(((size_t)b * 4 + h) * 64 + (dd - 64 + k)) * TOK + j] = f2bf(v[k]);
    }
  EPI_END
  for (int i = tid_(); i < 256 * 16; i += NTHREADS) {
    int r = i >> 4, q = i & 15;
    int row = m0 + r;
    if (row < NTOK) {
      int b = tok_b(row), j = tok_j(row);
      int blk = q >> 3, i8 = q & 7;
      float x1 = bf2f(P1[(size_t)row * P1W + C_KR + blk * 16 + i8]), x2 = bf2f(P1[(size_t)row * P1W + C_KR + blk * 16 + i8 + 8]);
      float o1 = x1, o2 = x2;
      if (j >= CTXL) {
        int tl = j - CTXL, pos = blk == 0 ? (tl / GRID_W) : (tl % GRID_W);
        float c, sn; rope_cs(ropetab, pos, i8, c, sn);
        o1 = x1 * c - x2 * sn; o2 = x2 * c + x1 * sn;
      }
      bf16* kd = K + (((size_t)b * 4 + h) * TOK + j) * 96 + 64 + blk * 16 + i8;
      kd[0] = f2bf(o1); kd[8] = f2bf(o2);
    }
  }
}
DI void navt_item(const Params& p, int it, char* smem) {
  bf16* s = (bf16*)smem;
  const bf16* P1 = (const bf16*)(p.ws + OFF_P1);
  bf16* VT = (bf16*)(p.ws + OFF_MIX + MX_VTN);
  const int tok0 = it * 64, tid = tid_();
  const int b = tok_b(tok0), j0 = tok_j(tok0);
  __syncthreads();
  for (int i = tid; i < 64 * 32; i += NTHREADS) {
    int r = i >> 5, c8 = i & 31;
    *(uint4*)(s + r * 264 + c8 * 8) = *(const uint4*)(P1 + (size_t)(tok0 + r) * P1W + C_NA + 512 + c8 * 8);
  }
  __syncthreads();
  for (int i = tid; i < 256 * 8; i += NTHREADS) {
    int ch = i >> 3, t8 = i & 7;
    unsigned w[4];
#pragma unroll
    for (int q = 0; q < 4; ++q) w[q] = (unsigned)s[(t8 * 8 + 2 * q) * 264 + ch] | ((unsigned)s[(t8 * 8 + 2 * q + 1) * 264 + ch] << 16);
    *(uint4*)(VT + ((size_t)b * 256 + ch) * TOK + j0 + t8 * 8) = make_uint4(w[0], w[1], w[2], w[3]);
  }
}
constexpr int M2C_TOK = 128, M2C_ITEMS = NTOK / M2C_TOK;
DI void m2conv_item(const Params& p, const LP& L, int it) {
  const bf16* P1 = (const bf16*)(p.ws + OFF_P1);
  bf16* XB = (bf16*)(p.ws + OFF_MIX + MX_XBC);
  const int tok0 = it * M2C_TOK;
  const float* cw = p.in[I_M2CONVW] + (size_t)L.l * 4 * 768;
  const float* cb = p.in[I_M2CONVB] + (size_t)L.l * 768;
  for (int task = tid_(); task < 96 * (M2C_TOK / 8); task += NTHREADS) {
    const int cg = task % 96, tb = task / 96, c0 = cg * 8;
    const int tokb = tok0 + tb * 8, jt = tok_j(tokb), base = tokb - jt;
    const int slo = (jt < CTXL) ? 0 : CTXL, shi = (jt < CTXL) ? CTXL : TOK;
    float w[4][8], bias[8];
#pragma unroll
    for (int k = 0; k < 4; ++k) { float4 a = *(const float4*)(cw + k * 768 + c0), b4 = *(const float4*)(cw + k * 768 + c0 + 4);
      w[k][0] = a.x; w[k][1] = a.y; w[k][2] = a.z; w[k][3] = a.w; w[k][4] = b4.x; w[k][5] = b4.y; w[k][6] = b4.z; w[k][7] = b4.w; }
    { float4 a = *(const float4*)(cb + c0), b4 = *(const float4*)(cb + c0 + 4);
      bias[0] = a.x; bias[1] = a.y; bias[2] = a.z; bias[3] = a.w; bias[4] = b4.x; bias[5] = b4.y; bias[6] = b4.z; bias[7] = b4.w; }
    float xin[11][8];
#pragma unroll
    for (int r = 0; r < 11; ++r) {
      const int j = jt - 2 + r;
      if (j >= slo && j < shi) ld8bf(P1 + (size_t)(base + j) * P1W + C_XBC + c0, xin[r]);
      else {
#pragma unroll
        for (int c = 0; c < 8; ++c) xin[r][c] = 0.f;
      }
    }
    float y[8][8];
#pragma unroll
    for (int t = 0; t < 8; ++t) {
#pragma unroll
      for (int c = 0; c < 8; ++c) y[t][c] = siluf_(bias[c] + w[0][c] * xin[t][c] + w[1][c] * xin[t + 1][c] + w[2][c] * xin[t + 2][c] + w[3][c] * xin[t + 3][c]);
      st8bf(XB + (size_t)(base + jt + t) * 768 + c0, y[t]);
    }
    if (c0 < 512) {
      bf16* XT = (bf16*)(p.ws + OFF_MIX + MX_XBT) + ((size_t)(base / TOK) * 512 + c0) * TOK + jt;
#pragma unroll
      for (int c = 0; c < 8; ++c) {
        float col[8];
#pragma unroll
        for (int t = 0; t < 8; ++t) col[t] = y[t][c];
        st8bf(XT + (size_t)c * TOK, col);
      }
    }
  }
}
DI int m2_seq2tok(int sq, int dir) { return (dir == 0) ? sq : (sq < CTXL ? (CTXL - 1 - sq) : (TOK - 1 - (sq - CTXL))); }
constexpr int M2S_ITEMS = BATCH * 8 * (TOK / 64) / NWAVES;
DI void m2scal_item(const Params& p, const LP& L, int it) {
  const int w = it * NWAVES + (tid_() >> 6), lane = tid_() & 63;
  const int ch = w % (TOK / 64), r = w / (TOK / 64), hd = r & 3, dir = (r >> 2) & 1, b = r >> 3;
  const float a = -expf(p.in[I_M2ALOG][(L.l * 2 + dir) * 4 + hd]);
  const int sq = ch * 64 + lane, j = m2_seq2tok(sq, dir);
  const float dt = ((const float*)(p.ws + OFF_DT))[((size_t)b * TOK + j) * 8 + dir * 4 + hd];
  float cs = dt * a;
#pragma unroll
  for (int d = 1; d < 64; d <<= 1) { float o = shfl_up_(cs, d); if (lane >= d) cs += o; }
  const float sl = shfl_(cs, 63);
  float* o = (float*)(p.ws + OFF_MIX + MX_M2S) + ((size_t)((b * 2 + dir) * 4 + hd) * TOK + sq) * 4;
  *(float4*)o = make_float4(cs, dt, dt * __expf(sl - cs), cs * 1.4426950408889634f - log2f(dt));
}
constexpr int S5_MT = (MCH + 255) / 256;
DI void s5a_tile(const Params& p, const LP& L, int t, char* smem) {
  const int g = t / (S5_MT * 2), r = t % (S5_MT * 2), mt = r / 2, nt = r % 2;
  const int m0 = mt * 256, n0 = nt * 128;
  GA ga = make_ga((const bf16*)(p.ws + OFF_MIX + MX_US5) + (size_t)g * NTOK * 16, 256, (const bf16*)(L.s5 + S5_WA) + (size_t)g * 65536, 256, 256, MCH);
  f32x4 acc[4][4];
  gemm_s<4>(ga, m0, n0, smem, acc);
  float* HE = (float*)(p.ws + OFF_MIX + MX_HEND) + (size_t)g * MCH * 256;
  EPI_BEGIN(4, acc, m0, n0, MCH)
    st8f(HE + (size_t)row * 256 + col, v);
  EPI_END
}
DI int s5_chunk_of(int i, int d) { return (d == 0) ? i : (i < NCC ? (NCC - 1 - i) : (NCH - 1 - (i - NCC))); }
DI void s5carry_item(const Params& p, const LP& L, int it) {
  const int w = it * NWAVES + (tid_() >> 6), lane = tid_() & 63;
  const int d = w / (16 * BATCH), g = (w / BATCH) & 15, b = w % BATCH;
  const float* lp = (const float*)(L.s5 + S5_LAMPOW) + ((size_t)((d * 16 + g) * 17 + 16) * 64 + lane) * 2;
  const float lre = lp[0], lim = lp[1];
  const float* HE = (const float*)(p.ws + OFF_MIX + MX_HEND) + ((size_t)g * MCH + (size_t)b * NCH) * 256 + d * 128;
  bf16* HI = (bf16*)(p.ws + OFF_MIX + MX_HIN) + ((size_t)g * MCH + (size_t)b * NCH) * 256 + d * 128;
  float cre = 0.f, cim = 0.f;
  constexpr int SB = 16;
  float are[SB], aim[SB], bre[SB], bim[SB];
#define S5_LOAD(RE_, IM_, I0_) { _Pragma("unroll") for (int k_ = 0; k_ < SB; ++k_) { const int ii_ = (I0_) + k_; \
    if (ii_ < NCH) { const int ch_ = s5_chunk_of(ii_, d); RE_[k_] = HE[(size_t)ch_ * 256 + lane]; IM_[k_] = HE[(size_t)ch_ * 256 + 64 + lane]; } } }
#define S5_STEP(RE_, IM_, I0_) { _Pragma("unroll") for (int k_ = 0; k_ < SB; ++k_) { const int ii_ = (I0_) + k_; \
    if (ii_ < NCH) { const int ch_ = s5_chunk_of(ii_, d); \
      HI[(size_t)ch_ * 256 + lane] = f2bf(cre); HI[(size_t)ch_ * 256 + 64 + lane] = f2bf(cim); \
      const float nre_ = lre * cre - lim * cim + RE_[k_], nim_ = lre * cim + lim * cre + IM_[k_]; \
      cre = nre_; cim = nim_; } } }
#pragma unroll
  for (int k = 0; k < SB; ++k) { are[k] = 0.f; aim[k] = 0.f; bre[k] = 0.f; bim[k] = 0.f; }
  S5_LOAD(are, aim, 0)
  for (int i0 = 0; i0 < NCH; i0 += 2 * SB) {
    S5_LOAD(bre, bim, i0 + SB)
    S5_STEP(are, aim, i0)
    S5_LOAD(are, aim, i0 + 2 * SB)
    S5_STEP(bre, bim, i0 + SB)
  }
#undef S5_LOAD
#undef S5_STEP
}
DI void s5c_tile(const Params& p, const LP& L, int t, char* smem) {
  const int g = t / (S5_MT * 2), r = t % (S5_MT * 2), mt = r / 2, nt = r % 2;
  const int m0 = mt * 256, n0 = nt * 128;
  GA ga = make_ga((const bf16*)(p.ws + OFF_MIX + MX_US5) + (size_t)g * NTOK * 16, 256, (const bf16*)(L.s5 + S5_W2) + (size_t)g * 256 * 512, 512, 512, MCH);
  ga.A2 = (const bf16*)(p.ws + OFF_MIX + MX_HIN) + (size_t)g * MCH * 256; ga.lda2 = 256; ga.ksplit = 256;
  f32x4 acc[4][4];
  gemm_s<4>(ga, m0, n0, smem, acc);
  bf16* Z = (bf16*)(p.ws + OFF_MIX + MX_Z);
  EPI_BEGIN(4, acc, m0, n0, MCH)
#pragma unroll
    for (int k = 0; k < 8; ++k) v[k] = geluf_(v[k]);
    st8bf(Z + ((size_t)row * 16 + (col >> 4)) * 256 + g * 16 + (col & 15), v);
  EPI_END
}

#ifdef EMU
DI float fmax_(float a, float b) { return a > b ? a : b; }
#else
DI float fmax_(float a, float b) { return __builtin_fmaxf(a, b); }
#endif
constexpr int AT_LDV = 76;
struct NaInfo { int r, qc, rs, cs; };
template <int DK, bool NA>
DI void attn_block(const bf16* qrow, bool active, const bf16* Kp, int kstride, const bf16* Vt,
                   int ka0, int ntile_a, int arow0, int kb0, int ntile_b,
                   const float* srpb, NaInfo ni, float scale, bf16* orow, char* smem) {
  constexpr int LDK = DK + 8, KCH = DK / 8;
  constexpr int KT_BYTES = 64 * LDK * 2, VT_BYTES = 64 * AT_LDV * 2;
  constexpr int NKL = (64 * KCH + NTHREADS - 1) / NTHREADS;
  const int tid = tid_(), lane = tid & 63, half = lane >> 5, r = lane & 31;
  bf16* sK = (bf16*)smem;
  bf16* sV = (bf16*)(smem + 2 * KT_BYTES);
  bf16x8 qf[DK / 16];
  f32x16 o0, o1;
  float m = -1e30f, l = 0.f;
  const float scale2 = scale * 1.4426950408889634f;
#pragma unroll
  for (int ks = 0; ks < DK / 16; ++ks) qf[ks] = active ? *(const bf16x8*)(qrow + ks * 16 + 8 * half) : bf16x8{0, 0, 0, 0, 0, 0, 0, 0};
#pragma unroll
  for (int i = 0; i < 16; ++i) { o0[i] = 0.f; o1[i] = 0.f; }
  const int NTL = ntile_a + ntile_b;
  u32x4 rk[NKL], rv[1];
#pragma unroll
  for (int i = 0; i < NKL; ++i) rk[i] = u32x4{0u, 0u, 0u, 0u};
  auto key0_of = [&](int t) { return t < ntile_a ? ka0 + 64 * t : kb0 + 64 * (t - ntile_a); };
#define AT_GLOAD(t_) { const int k0_ = key0_of(t_); \
    _Pragma("unroll") for (int i_ = 0; i_ < NKL; ++i_) { const int c_ = tid + i_ * NTHREADS; const int key_ = c_ / KCH, ch_ = c_ % KCH; \
      if (c_ < 64 * KCH) rk[i_] = *(const u32x4*)(Kp + (size_t)(k0_ + key_) * kstride + ch_ * 8); } \
    { const int d_ = tid >> 3, ch_ = tid & 7; rv[0] = *(const u32x4*)(Vt + (size_t)d_ * TOK + k0_ + ch_ * 8); } }
#define AT_SSTORE(buf_) { \
    _Pragma("unroll") for (int i_ = 0; i_ < NKL; ++i_) { const int c_ = tid + i_ * NTHREADS; const int key_ = c_ / KCH, ch_ = c_ % KCH; \
      if (c_ < 64 * KCH) *(u32x4*)(sK + (buf_) * (64 * LDK) + key_ * LDK + ch_ * 8) = rk[i_]; } \
    { const int d_ = tid >> 3, ch_ = tid & 7; \
      bf16* dst_ = sV + (buf_) * (64 * AT_LDV) + d_ * AT_LDV + ch_ * 8; \
      *(uint2*)dst_ = make_uint2(rv[0][0], rv[0][1]); *(uint2*)(dst_ + 4) = make_uint2(rv[0][2], rv[0][3]); } }
  __syncthreads();
  AT_GLOAD(0) AT_SSTORE(0)
  __syncthreads();
#pragma unroll 1
  for (int t = 0; t < NTL; ++t) {
    const int buf = t & 1;
    if (t + 1 < NTL) AT_GLOAD(t + 1)
    bool doit = active;
    int trow0 = 0;
    if (NA && t < ntile_a) {
      trow0 = arow0 + t * (64 / GRID_W);
      doit = active && (trow0 + (64 / GRID_W) > ni.rs) && (trow0 < ni.rs + WIN_R);
    }
    if (doit) {
      const bf16* kb = sK + buf * (64 * LDK);
      const bf16* vb = sV + buf * (64 * AT_LDV);
      f32x16 s0, s1;
#pragma unroll
      for (int i = 0; i < 16; ++i) { s0[i] = 0.f; s1[i] = 0.f; }
      bf16x8 ka0[DK / 16], ka1[DK / 16];
#pragma unroll
      for (int ks = 0; ks < DK / 16; ++ks) {
        ka0[ks] = *(const bf16x8*)(kb + r * LDK + ks * 16 + 8 * half);
        ka1[ks] = *(const bf16x8*)(kb + (32 + r) * LDK + ks * 16 + 8 * half);
      }
      BG_SCHED;
#pragma unroll
      for (int ks = 0; ks < DK / 16; ++ks) {
        s0 = __builtin_amdgcn_mfma_f32_32x32x16_bf16(ka0[ks], qf[ks], s0, 0, 0, 0);
        s1 = __builtin_amdgcn_mfma_f32_32x32x16_bf16(ka1[ks], qf[ks], s1, 0, 0, 0);
      }
      uint2 va0[4], va1[4], vb0[4], vb1[4];
#pragma unroll
      for (int kq = 0; kq < 4; ++kq) {
        const bf16* v0 = vb + r * AT_LDV + 16 * kq + 4 * half;
        const bf16* v1 = vb + (r + 32) * AT_LDV + 16 * kq + 4 * half;
        va0[kq] = *(const uint2*)v0; va1[kq] = *(const uint2*)(v0 + 8); vb0[kq] = *(const uint2*)v1; vb1[kq] = *(const uint2*)(v1 + 8);
      }
      BG_SCHED;
      float mx = -INFINITY;
      if (NA && t < ntile_a) {
#pragma unroll
        for (int i = 0; i < 16; ++i) {
          const int kk = (i & 3) + 8 * (i >> 2) + 4 * half;
#pragma unroll
          for (int hb = 0; hb < 2; ++hb) {
            const int kq = kk + 32 * hb;
            const int kr = trow0 + kq / GRID_W, kc = kq % GRID_W;
            const bool ok = (kr >= ni.rs) && (kr < ni.rs + WIN_R) && (kc >= ni.cs) && (kc < ni.cs + WIN_C);
            const float bias = ok ? srpb[(kr - ni.r + 7) * 31 + (kc - ni.qc + 15)] * 1.4426950408889634f : -INFINITY;
            if (hb == 0) { s0[i] = s0[i] * scale2 + bias; mx = fmax_(mx, s0[i]); }
            else { s1[i] = s1[i] * scale2 + bias; mx = fmax_(mx, s1[i]); }
          }
        }
      } else {
        s0 = s0 * scale2; s1 = s1 * scale2;
#pragma unroll
        for (int i = 0; i < 16; ++i) mx = fmax_(mx, fmax_(s0[i], s1[i]));
      }
      mx = fmax_(mx, shfl_xor_(mx, 32));
      const float mn = fmax_(m, mx);
      const float alpha = exp2f_(m - mn);
      const bool same = (mn == m);
      m = mn;
      float ps = 0.f;
      { const float nmn = -mn; s0 = s0 + nmn; s1 = s1 + nmn; }
#pragma unroll
      for (int i = 0; i < 16; ++i) { s0[i] = exp2f_(s0[i]); s1[i] = exp2f_(s1[i]); }
      { const f32x16 st = s0 + s1;
        ps = ((st[0] + st[1]) + (st[2] + st[3])) + ((st[4] + st[5]) + (st[6] + st[7])) + (((st[8] + st[9]) + (st[10] + st[11])) + ((st[12] + st[13]) + (st[14] + st[15]))); }
      l = l * alpha + ps;
      if (!wave_all_(same)) {
#pragma unroll
        for (int i = 0; i < 16; ++i) { o0[i] *= alpha; o1[i] *= alpha; }
      }
#pragma unroll
      for (int kq = 0; kq < 4; ++kq) {
        u32x4 pw;
#pragma unroll
        for (int j = 0; j < 4; ++j) pw[j] = (kq < 2) ? pack2(s0[8 * (kq & 1) + 2 * j], s0[8 * (kq & 1) + 2 * j + 1]) : pack2(s1[8 * (kq & 1) + 2 * j], s1[8 * (kq & 1) + 2 * j + 1]);
        const bf16x8 pf = __builtin_bit_cast(bf16x8, pw);
        const uint2 a0 = va0[kq], a1 = va1[kq], b0 = vb0[kq], b1 = vb1[kq];
        bf16x8 va, vbb;
        va[0] = (short)(a0.x & 0xffff); va[1] = (short)(a0.x >> 16); va[2] = (short)(a0.y & 0xffff); va[3] = (short)(a0.y >> 16);
        va[4] = (short)(a1.x & 0xffff); va[5] = (short)(a1.x >> 16); va[6] = (short)(a1.y & 0xffff); va[7] = (short)(a1.y >> 16);
        vbb[0] = (short)(b0.x & 0xffff); vbb[1] = (short)(b0.x >> 16); vbb[2] = (short)(b0.y & 0xffff); vbb[3] = (short)(b0.y >> 16);
        vbb[4] = (short)(b1.x & 0xffff); vbb[5] = (short)(b1.x >> 16); vbb[6] = (short)(b1.y & 0xffff); vbb[7] = (short)(b1.y >> 16);
        o0 = __builtin_amdgcn_mfma_f32_32x32x16_bf16(va, pf, o0, 0, 0, 0);
        o1 = __builtin_amdgcn_mfma_f32_32x32x16_bf16(vbb, pf, o1, 0, 0, 0);
      }
    }
    if (t + 1 < NTL) AT_SSTORE(buf ^ 1)
    __syncthreads();
  }
  if (active) {
    const float lt = l + shfl_xor_(l, 32);
    const float inv = rcp_(lt);
#pragma unroll
    for (int gI = 0; gI < 4; ++gI) {
      const int d0 = 8 * gI + 4 * half;
      *(uint2*)(orow + d0) = make_uint2(pack2(o0[4 * gI] * inv, o0[4 * gI + 1] * inv), pack2(o0[4 * gI + 2] * inv, o0[4 * gI + 3] * inv));
      *(uint2*)(orow + 32 + d0) = make_uint2(pack2(o1[4 * gI] * inv, o1[4 * gI + 1] * inv), pack2(o1[4 * gI + 2] * inv, o1[4 * gI + 3] * inv));
    }
  }
}
DI void mla_attn_item(const Params& p, int it, bool ctxq, char* smem) {
  const int nqb = ctxq ? (CTXL + 255) / 256 : SEQ / 256;
  const int b = it / (4 * nqb), h = (it / nqb) & 3, qb = it % nqb;
  const int lane = tid_() & 63, wid = tid_() >> 6;
  const int nq = ctxq ? CTXL : SEQ, q0 = qb * 256 + wid * 32;
  const bool active = q0 < nq;
  const int jq = (ctxq ? 0 : CTXL) + (active ? q0 : 0) + (lane & 31);
  const bf16* Q = (const bf16*)(p.ws + OFF_MIX + MX_Q) + ((size_t)b * 4 + h) * TOK * 96;
  const bf16* K = (const bf16*)(p.ws + OFF_MIX + MX_K) + ((size_t)b * 4 + h) * TOK * 96;
  const bf16* VT = (const bf16*)(p.ws + OFF_MIX + MX_VTM) + ((size_t)b * 4 + h) * 64 * TOK;
  bf16* O = (bf16*)(p.ws + OFF_O) + ((size_t)b * TOK + jq) * 1024 + 0 * 256 + h * 64;
  NaInfo ni; ni.r = 0; ni.qc = 0; ni.rs = 0; ni.cs = 0;
  attn_block<96, false>(Q + (size_t)jq * 96, active, K, 96, VT, 0, 0, 0, 0, (ctxq ? CTXL : TOK) / 64, nullptr, ni, 0.10206207261596577f, O, smem);
}
DI void na_attn_item(const Params& p, const LP& L, int it, bool ctxq, char* smem) {
  const int nqb = ctxq ? (CTXL + 255) / 256 : SEQ / 256;
  const int b = it / (4 * nqb), h = (it / nqb) & 3, qb = it % nqb;
  const int tid = tid_(), lane = tid & 63, wid = tid >> 6;
  const int nq = ctxq ? CTXL : SEQ, q0 = qb * 256 + wid * 32;
  const bool active = q0 < nq;
  const int jq = (ctxq ? 0 : CTXL) + (active ? q0 : 0) + (lane & 31);
  const bf16* P1 = (const bf16*)(p.ws + OFF_P1) + (size_t)b * TOK * P1W;
  const bf16* VT = (const bf16*)(p.ws + OFF_MIX + MX_VTN) + ((size_t)b * 4 + h) * 64 * TOK;
  const bf16* Kb = P1 + C_NA + 256 + h * 64;
  bf16* O = (bf16*)(p.ws + OFF_O) + ((size_t)b * TOK + jq) * 1024 + 1 * 256 + h * 64;
  constexpr int AT_END64 = 2 * (64 * 72 * 2) + 2 * (64 * AT_LDV * 2);
  float* srpb = (float*)(smem + AT_END64);
  NaInfo ni; ni.r = 0; ni.qc = 0; ni.rs = 0; ni.cs = 0;
  int ka0 = 0, nta = 0, arow0 = 0;
  if (!ctxq) {
    __syncthreads();
    const float* rpb = p.in[I_RPB] + ((size_t)L.l * 4 + h) * 15 * 31;
    for (int i = tid; i < 15 * 31; i += NTHREADS) srpb[i] = rpb[i];
    const int tl = q0 + (lane & 31);
    ni.r = tl / GRID_W; ni.qc = tl % GRID_W;
    int rs = ni.r - WIN_R / 2; rs = rs < 0 ? 0 : (rs > ROWS - WIN_R ? ROWS - WIN_R : rs);
    int cs = ni.qc - WIN_C / 2; cs = cs < 0 ? 0 : (cs > GRID_W - WIN_C ? GRID_W - WIN_C : cs);
    ni.rs = rs; ni.cs = cs;
    constexpr int RPT = 64 / GRID_W;
    const int rfirst = (qb * 256) / GRID_W, rlast = (qb * 256 + 255) / GRID_W;
    int rs_f = rfirst - WIN_R / 2; rs_f = rs_f < 0 ? 0 : (rs_f > ROWS - WIN_R ? ROWS - WIN_R : rs_f);
    int rs_l = rlast - WIN_R / 2; rs_l = rs_l < 0 ? 0 : (rs_l > ROWS - WIN_R ? ROWS - WIN_R : rs_l);
    arow0 = (rs_f / RPT) * RPT;
    const int row_hi = rs_l + WIN_R;
    nta = (row_hi - arow0 + RPT - 1) / RPT;
    ka0 = CTXL + arow0 * GRID_W;
  }
  attn_block<64, true>(P1 + (size_t)jq * P1W + C_NA + h * 64, active, Kb, P1W, VT, ka0, nta, arow0, 0, CTXL / 64, srpb, ni, 0.125f, O, smem);
}

constexpr int M2_LDB = 136, M2_LDX = 72;
constexpr int M2_OFF_B = 0;
constexpr int M2_OFF_C = M2_OFF_B + 64 * M2_LDB * 2;
constexpr int M2_OFF_HD = M2_OFF_C + 64 * M2_LDB * 2;
constexpr int M2H_H = 0;
constexpr int M2H_XT = M2H_H + 64 * M2_LDB * 2;
constexpr int M2H_BT = M2H_XT + 64 * M2_LDX * 2;
constexpr int M2H_S = M2H_BT + 128 * M2_LDX * 2;
constexpr int M2H_X = M2H_S + 3 * 64 * 4;
constexpr int M2H_SIZE = M2H_X + 64 * M2_LDX * 2;
constexpr int M2_SMEM = M2_OFF_HD + 2 * M2H_SIZE;
static_assert(M2_SMEM <= SMEM_BYTES, "m2 smem");
DI u32x4 rev8_(u32x4 v) {
  return u32x4{(v[3] >> 16) | (v[3] << 16), (v[2] >> 16) | (v[2] << 16), (v[1] >> 16) | (v[1] << 16), (v[0] >> 16) | (v[0] << 16)};
}
DI void m2scan_item(const Params& p, const LP& L, int it, char* smem) {
  const int b = it / 8, grp = (it >> 2) & 1, dir = (it >> 1) & 1, seg1 = it & 1;
  const int cbeg = seg1 ? M2_SPLIT : 0, cend = seg1 ? TOK : M2_SPLIT;
  const int tid = tid_(), lane = tid & 63, wid = tid >> 6, half = lane >> 5, r = lane & 31;
  const int hsel = wid >> 2, wl = wid & 3, hd = grp * 2 + hsel;
  bf16* sB = (bf16*)(smem + M2_OFF_B);
  bf16* sC = (bf16*)(smem + M2_OFF_C);
  char* hb = smem + M2_OFF_HD + hsel * M2H_SIZE;
  bf16* sH = (bf16*)(hb + M2H_H);
  bf16* sXT = (bf16*)(hb + M2H_XT);
  bf16* sBT = (bf16*)(hb + M2H_BT);
  float* sS = (float*)(hb + M2H_S);
  float* sDt = sS + 64;
  float* sW = sS + 128;
  const bf16* XB = (const bf16*)(p.ws + OFF_MIX + MX_XBC) + (size_t)b * TOK * 768;
  const bf16* XT = (const bf16*)(p.ws + OFF_MIX + MX_XBT) + (size_t)b * 512 * TOK;
  const float* SC = (const float*)(p.ws + OFF_MIX + MX_M2S) + (size_t)((b * 2 + dir) * 4 + hd) * TOK * 4;
  float* YM = (float*)(p.ws + OFF_HA) + ((size_t)dir * NTOK + (size_t)b * TOK) * 256;
  const int pb = wl & 1, tb = wl >> 1, nb0 = 2 * (wl >> 1);
  f32x16 hst[2];
#pragma unroll
  for (int i = 0; i < 16; ++i) { hst[0][i] = 0.f; hst[1][i] = 0.f; }
  __syncthreads();
  for (int i = tid; i < 2 * M2H_SIZE / 4; i += NTHREADS) ((unsigned*)(smem + M2_OFF_HD))[i] = 0u;
  __syncthreads();
  u32x4 rxt[2], rbt[2], rb[2], rc[2];
  float4 rsc = make_float4(0.f, 0.f, 0.f, 0.f);
#define M2_TLOAD(rowptr_, sq0_) (*(const u32x4*)((rowptr_) + ((dir == 0) ? (sq0_) : m2_seq2tok((sq0_) + 7, 1))))
#define M2_GLOAD(c0_) { \
    _Pragma("unroll") for (int q_ = 0; q_ < 2; ++q_) { const int i_ = tid + q_ * NTHREADS; const int h2_ = i_ >> 9, t8_ = ((i_ >> 6) & 7) * 8, pp_ = i_ & 63; \
      rxt[q_] = M2_TLOAD(XT + (size_t)((grp * 2 + h2_) * 64 + pp_) * TOK, (c0_) + t8_); } \
    _Pragma("unroll") for (int q_ = 0; q_ < 2; ++q_) { const int i_ = tid + q_ * NTHREADS; const int t8_ = (i_ >> 7) * 8, nn_ = i_ & 127; \
      rbt[q_] = M2_TLOAD(XT + (size_t)(256 + grp * 128 + nn_) * TOK, (c0_) + t8_); } \
    _Pragma("unroll") for (int q_ = 0; q_ < 2; ++q_) { const int i_ = tid + q_ * NTHREADS; const int t_ = i_ >> 4, n8_ = (i_ & 15) * 8; \
      const bf16* src_ = XB + (size_t)m2_seq2tok((c0_) + t_, dir) * 768 + grp * 128 + n8_; \
      rb[q_] = *(const u32x4*)(src_ + 256); rc[q_] = *(const u32x4*)(src_ + 512); } \
    if (wl == 0) rsc = *(const float4*)(SC + (size_t)((c0_) + lane) * 4); }
  M2_GLOAD(cbeg)
  float* GT = (float*)(p.ws + OFF_MIX + MX_GT) + (size_t)((b * 2 + dir) * 4 + hd) * M2_REST;
  float lcum = 0.f;
  for (int c0 = cbeg; c0 < cend; c0 += 64) {
    if (wl == 0) {
      sS[lane] = rsc.x; sDt[lane] = rsc.w; sW[lane] = rsc.z;
      if (seg1) { GT[c0 - M2_SPLIT + lane] = rsc.x + lcum; lcum += shfl_(rsc.x, 63); }
    }
    __syncthreads();
#pragma unroll
    for (int q2 = 0; q2 < 2; ++q2) {
      const int i = tid + q2 * NTHREADS; const int h2 = i >> 9, t8 = ((i >> 6) & 7) * 8, pp = i & 63;
      *(u32x4*)((bf16*)(smem + M2_OFF_HD + h2 * M2H_SIZE + M2H_XT) + pp * M2_LDX + t8) = dir ? rev8_(rxt[q2]) : rxt[q2];
    }
#pragma unroll
    for (int q4 = 0; q4 < 2; ++q4) {
      const int i = tid + q4 * NTHREADS; const int t = i >> 4, n8 = (i & 15) * 8;
      *(u32x4*)(sB + t * M2_LDB + n8) = rb[q4];
      *(u32x4*)(sC + t * M2_LDB + n8) = rc[q4];
    }
#pragma unroll
    for (int q4 = 0; q4 < 2; ++q4) {
      const int i = tid + q4 * NTHREADS; const int t8 = (i >> 7) * 8, nn = i & 127;
      float bv[8];
      if (dir) rbt[q4] = rev8_(rbt[q4]);
      bv[0] = __uint_as_float(rbt[q4][0] << 16); bv[1] = __uint_as_float(rbt[q4][0] & 0xffff0000u);
      bv[2] = __uint_as_float(rbt[q4][1] << 16); bv[3] = __uint_as_float(rbt[q4][1] & 0xffff0000u);
      bv[4] = __uint_as_float(rbt[q4][2] << 16); bv[5] = __uint_as_float(rbt[q4][2] & 0xffff0000u);
      bv[6] = __uint_as_float(rbt[q4][3] << 16); bv[7] = __uint_as_float(rbt[q4][3] & 0xffff0000u);
#pragma unroll
      for (int h2 = 0; h2 < 2; ++h2) {
        const float* wv = (const float*)(smem + M2_OFF_HD + h2 * M2H_SIZE + M2H_S) + 128 + t8;
        float sv[8];
#pragma unroll
        for (int k = 0; k < 8; ++k) sv[k] = bv[k] * wv[k];
        st8bf((bf16*)(smem + M2_OFF_HD + h2 * M2H_SIZE + M2H_BT) + nn * M2_LDX + t8, sv);
      }
    }
    __syncthreads();
    if (c0 + 64 < cend) M2_GLOAD(c0 + 64)
    {
      f32x16 yT, y2;
#pragma unroll
      for (int i = 0; i < 16; ++i) { yT[i] = 0.f; y2[i] = 0.f; }
      const int tv = 32 * tb + r;
      const float St = sS[tv];
      for (int sb = 0; sb <= tb; ++sb) {
        f32x16 gT;
#pragma unroll
        for (int i = 0; i < 16; ++i) gT[i] = 0.f;
#pragma unroll
        for (int ks = 0; ks < 8; ++ks) {
          bf16x8 av = *(const bf16x8*)(sB + (32 * sb + r) * M2_LDB + 16 * ks + 8 * half);
          bf16x8 bv = *(const bf16x8*)(sC + tv * M2_LDB + 16 * ks + 8 * half);
          gT = __builtin_amdgcn_mfma_f32_32x32x16_bf16(av, bv, gT, 0, 0, 0);
        }
        const float St2 = St * 1.4426950408889634f;
        if (sb == tb) {
#pragma unroll
          for (int i = 0; i < 16; ++i) {
            const int sv = 32 * sb + (i & 3) + 8 * (i >> 2) + 4 * half;
            gT[i] = (sv <= tv) ? gT[i] * exp2f_(St2 - sDt[sv]) : 0.f;
          }
        } else {
#pragma unroll
          for (int i = 0; i < 16; ++i) {
            const int sv = 32 * sb + (i & 3) + 8 * (i >> 2) + 4 * half;
            gT[i] *= exp2f_(St2 - sDt[sv]);
          }
        }
#pragma unroll
        for (int kq = 0; kq < 2; ++kq) {
          const u32x4 pw = u32x4{pack2(gT[8 * kq], gT[8 * kq + 1]), pack2(gT[8 * kq + 2], gT[8 * kq + 3]), pack2(gT[8 * kq + 4], gT[8 * kq + 5]), pack2(gT[8 * kq + 6], gT[8 * kq + 7])};
          const bf16x8 pf = __builtin_bit_cast(bf16x8, pw);
          const bf16* xr = sXT + (32 * pb + r) * M2_LDX + 32 * sb + 16 * kq + 4 * half;
          uint2 x0 = *(const uint2*)xr, x1 = *(const uint2*)(xr + 8);
          bf16x8 xa;
          xa[0] = (short)(x0.x & 0xffff); xa[1] = (short)(x0.x >> 16); xa[2] = (short)(x0.y & 0xffff); xa[3] = (short)(x0.y >> 16);
          xa[4] = (short)(x1.x & 0xffff); xa[5] = (short)(x1.x >> 16); xa[6] = (short)(x1.y & 0xffff); xa[7] = (short)(x1.y >> 16);
          yT = __builtin_amdgcn_mfma_f32_32x32x16_bf16(xa, pf, yT, 0, 0, 0);
        }
      }
#pragma unroll
      for (int ks = 0; ks < 8; ++ks) {
        bf16x8 av = *(const bf16x8*)(sH + (32 * pb + r) * M2_LDB + 16 * ks + 8 * half);
        bf16x8 bv = *(const bf16x8*)(sC + tv * M2_LDB + 16 * ks + 8 * half);
        y2 = __builtin_amdgcn_mfma_f32_32x32x16_bf16(av, bv, y2, 0, 0, 0);
      }
      const float eS = __expf(St);
      const int j = m2_seq2tok(c0 + tv, dir);
      float* yo = YM + (size_t)j * 256 + hd * 64 + 32 * pb + 4 * half;
#pragma unroll
      for (int gI = 0; gI < 4; ++gI)
        *(float4*)(yo + 8 * gI) = make_float4(yT[4 * gI] + eS * y2[4 * gI], yT[4 * gI + 1] + eS * y2[4 * gI + 1], yT[4 * gI + 2] + eS * y2[4 * gI + 2], yT[4 * gI + 3] + eS * y2[4 * gI + 3]);
    }
    __syncthreads();
    {
      const float eL = __expf(sS[63]);
#pragma unroll
      for (int q = 0; q < 2; ++q) {
#pragma unroll
        for (int i = 0; i < 16; ++i) hst[q][i] *= eL;
#pragma unroll
        for (int ks = 0; ks < 4; ++ks) {
          bf16x8 av = *(const bf16x8*)(sXT + (32 * pb + r) * M2_LDX + 16 * ks + 8 * half);
          bf16x8 bv = *(const bf16x8*)(sBT + (32 * (nb0 + q) + r) * M2_LDX + 16 * ks + 8 * half);
          hst[q] = __builtin_amdgcn_mfma_f32_32x32x16_bf16(av, bv, hst[q], 0, 0, 0);
        }
#pragma unroll
        for (int i = 0; i < 16; ++i) {
          const int pv = 32 * pb + (i & 3) + 8 * (i >> 2) + 4 * half;
          sH[pv * M2_LDB + 32 * (nb0 + q) + r] = f2bf(hst[q][i]);
        }
      }
    }
    __syncthreads();
  }
  if (!seg1) {
    bf16* HM = (bf16*)(p.ws + OFF_MIX + MX_HM) + (size_t)((b * 2 + dir) * 2 + grp) * 128 * 128;
#pragma unroll
    for (int q = 0; q < 4; ++q) {
      const int i = tid + q * NTHREADS, pr = i >> 4, n8 = (i & 15) * 8;
      *(u32x4*)(HM + pr * 128 + n8) = *(const u32x4*)((const bf16*)(smem + M2_OFF_HD + (pr >> 6) * M2H_SIZE + M2H_H) + (pr & 63) * M2_LDB + n8);
    }
  }
}
constexpr int M2C_MT = (M2_REST + 255) / 256;
DI void m2corr_tile(const Params& p, const LP& L, int t, char* smem) {
  const int mt = t % M2C_MT, r = t / M2C_MT, grp = r & 1, dir = (r >> 1) & 1, b = r >> 2;
  const int tok0 = dir ? CTXL : M2_SPLIT;
  const bf16* A = (const bf16*)(p.ws + OFF_MIX + MX_XBC) + ((size_t)b * TOK + tok0) * 768 + 512 + grp * 128;
  const bf16* HM = (const bf16*)(p.ws + OFF_MIX + MX_HM) + (size_t)((b * 2 + dir) * 2 + grp) * 128 * 128;
  GA g = make_ga(A, 768, HM, 128, 128, M2_REST);
  f32x4 acc[4][4];
  const int m0 = mt * 256;
  gemm_s<4>(g, m0, 0, smem, acc);
  float* YM = (float*)(p.ws + OFF_HA) + ((size_t)dir * NTOK + (size_t)b * TOK + tok0) * 256;
  const float* GT = (const float*)(p.ws + OFF_MIX + MX_GT) + (size_t)((b * 2 + dir) * 4 + grp * 2) * M2_REST;
  EPI_BEGIN(4, acc, m0, 0, M2_REST)
    const int hs = col >> 6;
    const int sidx = dir ? (M2_REST - 1 - row) : row;
    const float f = __expf(GT[(size_t)hs * M2_REST + sidx]);
    float* yo = YM + (size_t)row * 256 + (grp * 2 + hs) * 64 + (col & 63);
    float4 y0 = *(const float4*)yo, y1 = *(const float4*)(yo + 4);
    y0.x += f * v[0]; y0.y += f * v[1]; y0.z += f * v[2]; y0.w += f * v[3];
    y1.x += f * v[4]; y1.y += f * v[5]; y1.z += f * v[6]; y1.w += f * v[7];
    *(float4*)yo = y0; *(float4*)(yo + 4) = y1;
  EPI_END
}
DI void m2gate_item(const Params& p, const LP& L, int it) {
  const int tok = it * NWAVES + (tid_() >> 6), lane = tid_() & 63;
  const float* Y0 = (const float*)(p.ws + OFF_HA) + (size_t)tok * 256;
  const float* Y1 = Y0 + (size_t)NTOK * 256;
  const bf16* XB = (const bf16*)(p.ws + OFF_MIX + MX_XBC) + (size_t)tok * 768;
  const bf16* P1 = (const bf16*)(p.ws + OFF_P1) + (size_t)tok * P1W + C_Z;
  const int c = lane * 4, hd = c >> 6;
  const float dsk = p.in[I_M2D][L.l * 4 + hd];
  float4 y0 = *(const float4*)(Y0 + c), y1 = *(const float4*)(Y1 + c);
  uint2 xw = *(const uint2*)(XB + c), zw = *(const uint2*)(P1 + c);
  float xs[4] = {__uint_as_float(xw.x << 16), __uint_as_float(xw.x & 0xffff0000u), __uint_as_float(xw.y << 16), __uint_as_float(xw.y & 0xffff0000u)};
  float zs[4] = {__uint_as_float(zw.x << 16), __uint_as_float(zw.x & 0xffff0000u), __uint_as_float(zw.y << 16), __uint_as_float(zw.y & 0xffff0000u)};
  float ys[4] = {y0.x + y1.x, y0.y + y1.y, y0.z + y1.z, y0.w + y1.w};
  float v[4], ss = 0.f;
#pragma unroll
  for (int i = 0; i < 4; ++i) { v[i] = (ys[i] + dsk * xs[i]) * siluf_(zs[i]); ss += v[i] * v[i]; }
  ss = wave_sum(ss);
  const float rs = rsqrtf(ss * (1.f / 256.f) + EPS);
  float4 gn = *(const float4*)(p.in[I_M2GNORM] + L.l * 256 + c);
  bf16* O = (bf16*)(p.ws + OFF_O) + (size_t)tok * 1024 + 768 + c;
  *(uint2*)O = make_uint2(pack2(v[0] * rs * gn.x, v[1] * rs * gn.y), pack2(v[2] * rs * gn.z, v[3] * rs * gn.w));
}
constexpr int GLU_MT = (NTOK + 255) / 256;
DI void glu_tile(const Params& p, const LP& L, int t, char* smem) {
  const int mt = t % GLU_MT, nt = t / GLU_MT, m0 = mt * 256, n0 = nt * 128;
  const bf16* Z = (const bf16*)(p.ws + OFF_MIX + MX_Z);
  GA g = make_ga(Z, 256, (const bf16*)(L.we + WE_GLU), 256, 256, NTOK);
  f32x4 acc[4][4];
  gemm_s<4>(g, m0, n0, smem, acc);
  bf16* O = (bf16*)(p.ws + OFF_O);
  const float* bg = p.in[I_S5BGLU] + L.l * 256;
  EPI_BEGIN(4, acc, m0, n0, NTOK)
    float z[8]; ld8bf(Z + (size_t)row * 256 + col, z);
#pragma unroll
    for (int k = 0; k < 8; ++k) v[k] = z[k] * sigmoidf_(v[k] + bg[col + k]);
    st8bf(O + (size_t)row * 1024 + 512 + col, v);
  EPI_END
}
#ifdef EMU
DI void st16_wt(void* base, unsigned off, uint4 v) { *(uint4*)((char*)base + off) = v; }
#else
DI void st16_wt(void* base, unsigned off, uint4 v) {
  const __amdgpu_buffer_rsrc_t rs = __builtin_amdgcn_make_buffer_rsrc(base, 0, 0x7fffffff, 0x00020000);
  __builtin_amdgcn_raw_buffer_store_b128(u32x4{v.x, v.y, v.z, v.w}, rs, (int)off, 0, 16);
}
#endif
DI void st8bf_wt(bf16* base, unsigned eoff, const float (&v)[8]) { st16_wt(base, eoff * 2u, make_uint4(pack2(v[0], v[1]), pack2(v[2], v[3]), pack2(v[4], v[5]), pack2(v[6], v[7]))); }
DI void dep_signal(const Params& p, int idx) {
#ifndef EMU
  asm volatile("s_waitcnt vmcnt(0)" ::: "memory");
#endif
  __syncthreads();
  if (tid_() == 0) {
#ifdef EMU
    atomicAdd((int*)(p.ws + OFF_BAR) + CNT_WORD0 + idx, 1);
#else
    __hip_atomic_fetch_add((int*)(p.ws + OFF_BAR) + CNT_WORD0 + idx, 1, __ATOMIC_RELAXED, __HIP_MEMORY_SCOPE_AGENT);
#endif
  }
}
DI void dep_wait(const Params& p, int idx, int need) {
  if (tid_() == 0) {
    int* c = (int*)(p.ws + OFF_BAR) + CNT_WORD0 + idx;
#ifdef EMU
    while (__atomic_load_n(c, __ATOMIC_ACQUIRE) < need) emu_yield();
#else
    while (__hip_atomic_load(c, __ATOMIC_RELAXED, __HIP_MEMORY_SCOPE_AGENT) < need) __builtin_amdgcn_s_sleep(2);
    __builtin_amdgcn_fence(__ATOMIC_ACQUIRE, "agent");
#endif
  }
  __syncthreads();
}
DI void merge_tile(const Params& p, const LP& L, int t, char* smem) {
  const int mt = (t >> 6) * 8 + (t & 7), nt = (t >> 3) & 7;
  if (mt >= mtiles(L.last, 256)) return;
  const int m0 = mtile_row0(mt, L.last, 256), n0 = nt * 128;
  const bf16* O = (const bf16*)(p.ws + OFF_O);
  const unsigned char* PG = (const unsigned char*)(p.ws + OFF_PG);
  float tot[4][2][8];
#pragma unroll
  for (int a = 0; a < 4; ++a)
#pragma unroll
    for (int q = 0; q < 2; ++q)
#pragma unroll
      for (int k = 0; k < 8; ++k) tot[a][q][k] = 0.f;
  for (int j = 0; j < 4; ++j) {
    GA g = make_ga(O + j * 256, 1024, (const bf16*)(L.we + WE_WB) + (size_t)j * 1024 * 256, 256, 256, NTOK);
    f32x4 acc[4][4];
    gemm_s<4>(g, m0, n0, smem, acc);
    EPI_BEGIN(4, acc, m0, n0, NTOK)
      float gt[8]; ld8u8(PG + (size_t)row * 4096 + j * 1024 + col, gt);
#pragma unroll
      for (int k = 0; k < 8; ++k) tot[_m][_q][k] += gt[k] * v[k];
    EPI_END
  }
  bf16* Y = (bf16*)(p.ws + OFF_P1);
  {
    const int l = tid_() & 63, w = tid_() >> 6, wr = w >> 1, wc = w & 1, fr = l & 15, fq = l >> 4;
#pragma unroll
    for (int m = 0; m < 4; ++m)
#pragma unroll
      for (int q = 0; q < 2; ++q) {
        const int row = m0 + wr * 64 + m * 16 + fr, col = n0 + wc * 64 + q * 32 + 8 * fq;
        if (row < NTOK) {
#pragma unroll
          for (int k = 0; k < 8; ++k) tot[m][q][k] *= (1.0f / 255.0f);
          st8bf_wt(Y, (unsigned)row * 1024u + (unsigned)col, tot[m][q]);
        }
      }
  }
  dep_signal(p, L.l * CNT_LAYER + mt);
}
DI void outproj_tile(const Params& p, const LP& L, int t, char* smem) {
  bf16* Y2 = (bf16*)(p.ws + OFF_HA);
  constexpr int MT_L = BATCH * (SEQ / 256), MT_A = (NTOK + 255) / 256;
  const int mt = t >> 2, nt = t & 3, m0 = mtile_row0(mt, L.last, 256), n0 = nt * 256;
  (void)MT_L; (void)MT_A;
  GA g = make_ga((const bf16*)(p.ws + OFF_P1), 1024, (const bf16*)(L.we + WE_WOUT), 1024, 1024, NTOK);
  f32x4 acc[2][2][4][2];
  dep_wait(p, L.l * CNT_LAYER + mt, 8);
  gemm_big(g, m0, n0, smem, acc);
  EPIB_BEGIN(acc, m0, n0, NTOK)
    st8bf(Y2 + (size_t)row * 1024 + col, v);
  EPIB_END
}
DI int post_ntok(bool latonly) { return latonly ? BATCH * SEQ : NTOK; }
DI int post_tok(int i, bool latonly) { return latonly ? ((i / SEQ) * TOK + CTXL + (i % SEQ)) : i; }

DI const float* xsrc_row(const Params& p, int l, int tok) {
  (void)l;
  const int b = tok_b(tok), j = tok_j(tok);
  return (j < CTXL) ? p.in[I_CTX] + ((size_t)b * CTXL + j) * 1024 : p.in[I_X] + ((size_t)b * SEQ + (j - CTXL)) * 1024;
}
DI void post_stage_router(const Params& p, const LP& L, char* smem) {
  const float* wr = p.in[I_WROUTER] + (size_t)L.l * 1024 * 16;
  float4* wl = (float4*)smem;
  __syncthreads();
  for (int i = tid_(); i < 4096; i += NTHREADS) {
    const int k = i >> 2, q = i & 3;
    const int pos = ((k >> 8) * 4 + (k & 3)) * 64 + ((k >> 2) & 63);
    wl[q * 1024 + pos] = *(const float4*)(wr + (size_t)k * 16 + q * 4);
  }
  __syncthreads();
}
template <bool FIRST> struct XRow { typedef uint2 T; };
template <> struct XRow<true> { typedef float4 T; };
template <bool FIRST>
DI void post_phase_t(const Params& p, const LP& L, char* smem) {
  typedef typename XRow<FIRST>::T XT;
  const int lane = tid_() & 63, gw = (int)blockIdx.x * NWAVES + (tid_() >> 6), TW = (int)gridDim.x * NWAVES;
  const int n = post_ntok(L.last);
  if (gw >= n) return;
  const float* gpm = p.in[I_GPOSTMIX] + L.l * 1024;
  const float4* wl = (const float4*)smem;
  int i = gw, tok = post_tok(i, L.last);
  uint2 yr[4]; XT xr[4];
  {
    const bf16* Y2 = (const bf16*)(p.ws + OFF_HA) + (size_t)tok * 1024;
#pragma unroll
    for (int q = 0; q < 4; ++q) yr[q] = *(const uint2*)(Y2 + lane * 4 + q * 256);
    if constexpr (FIRST) { const float* X = xsrc_row(p, 0, tok);
#pragma unroll
      for (int q = 0; q < 4; ++q) xr[q] = *(const XT*)(X + lane * 4 + q * 256); }
    else { const bf16* X = (const bf16*)(p.ws + OFF_X) + (size_t)tok * 1024;
#pragma unroll
      for (int q = 0; q < 4; ++q) xr[q] = *(const XT*)(X + lane * 4 + q * 256); }
  }
  for (;;) {
    const int inext = i + TW; const bool has = inext < n; const int tokn = has ? post_tok(inext, L.last) : tok;
    uint2 yn[4]; XT xn[4];
    {
      const bf16* Yn = (const bf16*)(p.ws + OFF_HA) + (size_t)tokn * 1024;
#pragma unroll
      for (int q = 0; q < 4; ++q) yn[q] = *(const uint2*)(Yn + lane * 4 + q * 256);
      if constexpr (FIRST) { const float* Xn = xsrc_row(p, 0, tokn);
#pragma unroll
        for (int q = 0; q < 4; ++q) xn[q] = *(const XT*)(Xn + lane * 4 + q * 256); }
      else { const bf16* Xn = (const bf16*)(p.ws + OFF_X) + (size_t)tokn * 1024;
#pragma unroll
        for (int q = 0; q < 4; ++q) xn[q] = *(const XT*)(Xn + lane * 4 + q * 256); }
    }
    bf16* X = (bf16*)(p.ws + OFF_X) + (size_t)tok * 1024;
    const float* mod = L.mod + (size_t)tok_modrow(tok) * 6144;
    float xv[16], h[16];
    float ss = 0.f;
#pragma unroll
    for (int q = 0; q < 4; ++q) { const float4 y4 = bf4_(yr[q]); ss += y4.x * y4.x + y4.y * y4.y + y4.z * y4.z + y4.w * y4.w; }
    ss = wave_sum(ss);
    const float rs = rsqrtf(ss * (1.f / 1024.f) + EPS);
#pragma unroll
    for (int q = 0; q < 4; ++q) {
      const int c = lane * 4 + q * 256;
      const float4 y4 = bf4_(yr[q]);
      float4 xo = bf4_(xr[q]), gv = *(const float4*)(gpm + c), gt = *(const float4*)(mod + 2048 + c);
      xo.x += gt.x * y4.x * rs * gv.x; xo.y += gt.y * y4.y * rs * gv.y; xo.z += gt.z * y4.z * rs * gv.z; xo.w += gt.w * y4.w * rs * gv.w;
      *(uint2*)(X + c) = pk4_(xo);
      xv[q * 4] = xo.x; xv[q * 4 + 1] = xo.y; xv[q * 4 + 2] = xo.z; xv[q * 4 + 3] = xo.w;
    }
    bf16* H2 = (bf16*)(p.ws + OFF_P1) + (size_t)NTOK * 1024 + (size_t)tok * 1024;
    normmod_row(xv, p.in[I_GPREFFN] + L.l * 1024, mod + 3072, mod + 4096, H2, h);
    float lg[16];
#pragma unroll
    for (int e = 0; e < 16; ++e) lg[e] = 0.f;
#pragma unroll
    for (int q = 0; q < 16; ++q) {
      const int pos = ((q >> 2) * 4 + (q & 3)) * 64 + lane;
      float4 a = wl[pos], b4 = wl[1024 + pos], c4 = wl[2048 + pos], d4 = wl[3072 + pos];
      float hv = h[q];
      lg[0] += hv * a.x; lg[1] += hv * a.y; lg[2] += hv * a.z; lg[3] += hv * a.w;
      lg[4] += hv * b4.x; lg[5] += hv * b4.y; lg[6] += hv * b4.z; lg[7] += hv * b4.w;
      lg[8] += hv * c4.x; lg[9] += hv * c4.y; lg[10] += hv * c4.z; lg[11] += hv * c4.w;
      lg[12] += hv * d4.x; lg[13] += hv * d4.y; lg[14] += hv * d4.z; lg[15] += hv * d4.w;
    }
    float mx = -INFINITY;
#pragma unroll
    for (int e = 0; e < 16; ++e) { lg[e] = wave_sum(lg[e]); mx = fmax_(mx, lg[e]); }
    float se = 0.f;
#pragma unroll
    for (int e = 0; e < 16; ++e) { lg[e] = expf(lg[e] - mx); se += lg[e]; }
    if (lane < 16) {
      float v = 0.f;
#pragma unroll
      for (int e = 0; e < 16; ++e) if (e == lane) v = lg[e];
      ((float*)(p.ws + OFF_AFF))[(size_t)lane * NTOK + tok] = v * rcp_(se);
    }
    if (!has) break;
    i = inext; tok = tokn;
#pragma unroll
    for (int q = 0; q < 4; ++q) { yr[q] = yn[q]; xr[q] = xn[q]; }
  }
}
DI void post_phase(const Params& p, const LP& L, char* smem) { if (L.l == 0) post_phase_t<true>(p, L, smem); else post_phase_t<false>(p, L, smem); }
DI int block_sum_(int v, int* sred, int round) {
  const int tid = tid_(), lane = tid & 63, wid = tid >> 6;
  v += shfl_xor_(v, 32); v += shfl_xor_(v, 16); v += shfl_xor_(v, 8); v += shfl_xor_(v, 4); v += shfl_xor_(v, 2); v += shfl_xor_(v, 1);
  int* r = sred + (round & 1) * NWAVES;
  if (lane == 0) r[wid] = v;
  __syncthreads();
  int tsum = 0;
#pragma unroll
  for (int q = 0; q < NWAVES; ++q) tsum += r[q];
  return tsum;
}
DI void route_item(const Params& p, const LP& L, int it, char* smem) {
  const int nstream = L.last ? 1 : 2;
  const int b = it / (16 * nstream), e = (it / nstream) & 15, ctxs = (nstream == 2) ? (it & 1) : 0;
  const int T = ctxs ? CTXL : SEQ, cap = ctxs ? CAP_C : CAP_L;
  const int tok0 = b * TOK + (ctxs ? 0 : CTXL);
  const int slot0 = ctxs ? (BATCH * CAP_L + b * CAP_C) : (b * CAP_L);
  int* sred = (int*)smem;
  const float* AFF = (const float*)(p.ws + OFF_AFF) + (size_t)e * NTOK + tok0;
  int* SEL = (int*)(p.ws + OFF_SEL);
  int* IDX = (int*)(p.ws + OFF_IDX) + (size_t)e * ESLOTS;
  float* GW = (float*)(p.ws + OFF_GW) + (size_t)e * ESLOTS;
  const int tid = tid_(), lane = tid & 63, wid = tid >> 6;
  constexpr int MAXPER = (SEQ + NTHREADS - 1) / NTHREADS;
  const int per = (T + NTHREADS - 1) / NTHREADS;
  unsigned key[MAXPER];
  __syncthreads();
#pragma unroll
  for (int k = 0; k < MAXPER; ++k) {
    int i = tid * per + k;
    key[k] = (k < per && i < T) ? (__float_as_uint(AFF[i]) + 1u) : 0u;
  }
  unsigned thr = 0u;
  int round = 0;
  for (int bit = 30; bit >= 0; --bit) {
    const unsigned cand = thr | (1u << bit);
    int c = 0;
#pragma unroll
    for (int k = 0; k < MAXPER; ++k) c += (key[k] >= cand) ? 1 : 0;
    c = block_sum_(c, sred, round++);
    if (c >= cap) thr = cand;
  }
  int cg = 0, ce = 0;
#pragma unroll
  for (int k = 0; k < MAXPER; ++k) { cg += (key[k] > thr) ? 1 : 0; ce += (key[k] == thr) ? 1 : 0; }
  const int tot_gt = block_sum_(cg, sred, round++);
  const int need_eq = cap - tot_gt;
  int v = cg | (ce << 16), inc = v;
#pragma unroll
  for (int d = 1; d < 64; d <<= 1) { int o = shfl_up_(inc, d); if (lane >= d) inc += o; }
  int* soff = sred + 2 * NWAVES;
  __syncthreads();
  if (lane == 63) soff[wid] = inc;
  __syncthreads();
  int base = 0;
  for (int w = 0; w < wid; ++w) base += soff[w];
  int excl = base + inc - v;
  int gt_before = excl & 0xffff, eq_before = excl >> 16;
#pragma unroll
  for (int k = 0; k < MAXPER; ++k) {
    int i = tid * per + k;
    if (k < per && i < T) {
      const bool isgt = key[k] > thr, iseq = key[k] == thr;
      const bool sel = isgt || (iseq && eq_before < need_eq);
      const int slot = slot0 + gt_before + (eq_before < need_eq ? eq_before : need_eq);
      if (sel) { IDX[slot] = tok0 + i; GW[slot] = __uint_as_float(key[k] - 1u); SEL[(size_t)(tok0 + i) * 16 + e] = slot; }
      else SEL[(size_t)(tok0 + i) * 16 + e] = -1;
      gt_before += isgt ? 1 : 0; eq_before += iseq ? 1 : 0;
    }
  }
}
DI void moe1_tile(const Params& p, const LP& L, int t, char* smem) {
  const int nslots = L.last ? ESLOTS_L : ESLOTS;
  constexpr int MT_L = (ESLOTS_L + 255) / 256, MT_A = (ESLOTS + 255) / 256;
  const int nt = t & 7, sq = t >> 3;
  const int e = L.last ? sq / MT_L : sq / MT_A, mt = L.last ? sq % MT_L : sq % MT_A;
  const int m0 = mt * 256, n0 = nt * 256;
  GA g = make_ga((const bf16*)(p.ws + OFF_P1) + (size_t)NTOK * 1024, 1024, (const bf16*)(p.ws + OFF_MIX + WX_GU) + (size_t)e * 2048 * 1024, 1024, 1024, nslots);
  g.ridx = (const int*)(p.ws + OFF_IDX) + (size_t)e * ESLOTS;
  f32x4 acc[2][2][4][2];
  gemm_big(g, m0, n0, smem, acc);
  bf16* ACT = (bf16*)(p.ws + OFF_PG) + (size_t)e * ESLOTS * 1024;
  {
    const int l = tid_() & 63, w = tid_() >> 6, wr = w >> 2, wc = w & 3, fr = l & 15, fq = l >> 4;
#pragma unroll
    for (int ai = 0; ai < 2; ++ai)
#pragma unroll
      for (int m = 0; m < 4; ++m) {
        const int row = m0 + ai * 128 + wr * 64 + m * 16 + fr;
        float a[8];
#pragma unroll
        for (int k = 0; k < 4; ++k) { a[k] = siluf_(acc[ai][0][m][0][k]) * acc[ai][1][m][0][k]; a[4 + k] = siluf_(acc[ai][0][m][1][k]) * acc[ai][1][m][1][k]; }
        if (row < nslots) st8bf_wt(ACT, (unsigned)row * 1024u + (unsigned)(nt * 128 + wc * 32 + 8 * fq), a);
      }
  }
  dep_signal(p, L.l * CNT_LAYER + CNT_MT + e * CNT_ET + mt);
}
DI void moe2_tile(const Params& p, const LP& L, int t, char* smem) {
  const int nslots = L.last ? ESLOTS_L : ESLOTS;
  constexpr int MT_L = (ESLOTS_L + 255) / 256, MT_A = (ESLOTS + 255) / 256;
  const int x = t & 7, nt = x & 3, sq = (t >> 3) * 2 + (x >> 2);
  const int e = L.last ? sq / MT_L : sq / MT_A, mt = L.last ? sq % MT_L : sq % MT_A;
  if (e >= NE) return;
  const int m0 = mt * 256, n0 = nt * 256;
  GA g = make_ga((const bf16*)(p.ws + OFF_PG) + (size_t)e * ESLOTS * 1024, 1024, (const bf16*)(p.ws + OFF_MIX + WX_DN) + (size_t)e * 1024 * 1024, 1024, 1024, nslots);
  f32x4 acc[2][2][4][2];
  dep_wait(p, L.l * CNT_LAYER + CNT_MT + e * CNT_ET + mt, 8);
  gemm_big(g, m0, n0, smem, acc);
  bf16* YS = (bf16*)(p.ws + OFF_PG) + (size_t)NE * ESLOTS * 1024 + (size_t)e * ESLOTS * 1024;
  const float* GW = (const float*)(p.ws + OFF_GW) + (size_t)e * ESLOTS;
  EPIB_BEGIN(acc, m0, n0, nslots)
    const float gw = GW[row];
#pragma unroll
    for (int k = 0; k < 8; ++k) v[k] *= gw;
    st8bf(YS + (size_t)row * 1024 + col, v);
  EPIB_END
}
DI int uni_(int v) {
#ifdef EMU
  return v;
#else
  return __builtin_amdgcn_readfirstlane(v);
#endif
}
DI void comb_phase(const Params& p, const LP& L) {
  const int lane = tid_() & 63, gw = (int)blockIdx.x * NWAVES + (tid_() >> 6), TW = (int)gridDim.x * NWAVES;
  const int n = post_ntok(L.last);
  if (gw >= n) return;
  const bf16* YS = (const bf16*)(p.ws + OFF_PG) + (size_t)NE * ESLOTS * 1024;
  const float* gpf = p.in[I_GPOSTFFN] + L.l * 1024;
  int i = gw, tok = post_tok(i, L.last);
  uint4 sel[4]; uint2 xr[4];
  {
    const uint4* sp = (const uint4*)((const int*)(p.ws + OFF_SEL) + (size_t)tok * 16);
    const bf16* X = (const bf16*)(p.ws + OFF_X) + (size_t)tok * 1024;
#pragma unroll
    for (int q = 0; q < 4; ++q) { sel[q] = sp[q]; xr[q] = *(const uint2*)(X + lane * 4 + q * 256); }
  }
  for (;;) {
    const int inext = i + TW; const bool has = inext < n; const int tokn = has ? post_tok(inext, L.last) : tok;
    float s[16];
#pragma unroll
    for (int q = 0; q < 16; ++q) s[q] = 0.f;
#pragma unroll
    for (int e = 0; e < 16; ++e) {
      const unsigned sv = (e & 3) == 0 ? sel[e >> 2].x : (e & 3) == 1 ? sel[e >> 2].y : (e & 3) == 2 ? sel[e >> 2].z : sel[e >> 2].w;
      const int sl = uni_((int)sv);
      if (sl >= 0) {
        const bf16* yr = YS + ((size_t)e * ESLOTS + sl) * 1024;
#pragma unroll
        for (int q = 0; q < 4; ++q) {
          uint2 w = *(const uint2*)(yr + lane * 4 + q * 256);
          s[q * 4] += __uint_as_float(w.x << 16); s[q * 4 + 1] += __uint_as_float(w.x & 0xffff0000u);
          s[q * 4 + 2] += __uint_as_float(w.y << 16); s[q * 4 + 3] += __uint_as_float(w.y & 0xffff0000u);
        }
      }
    }
    uint4 seln[4]; uint2 xn[4];
    {
      const uint4* sp = (const uint4*)((const int*)(p.ws + OFF_SEL) + (size_t)tokn * 16);
      const bf16* Xn = (const bf16*)(p.ws + OFF_X) + (size_t)tokn * 1024;
#pragma unroll
      for (int q = 0; q < 4; ++q) { seln[q] = sp[q]; xn[q] = *(const uint2*)(Xn + lane * 4 + q * 256); }
    }
    float ss = 0.f;
#pragma unroll
    for (int q = 0; q < 16; ++q) ss += s[q] * s[q];
    ss = wave_sum(ss);
    const float rs = rsqrtf(ss * (1.f / 1024.f) + EPS);
    const float* mod = L.mod + (size_t)tok_modrow(tok) * 6144;
    bf16* dstx = (bf16*)(p.ws + OFF_X) + (size_t)tok * 1024;
    float* dst = p.out;
    if (L.last) { const int b = tok_b(tok), j = tok_j(tok); dst = p.out + ((size_t)b * SEQ + (j - CTXL)) * 1024; }
    float xv[16], h[16];
#pragma unroll
    for (int q = 0; q < 4; ++q) {
      const int c = lane * 4 + q * 256;
      float4 xo = bf4_(xr[q]), gv = *(const float4*)(gpf + c), gt = *(const float4*)(mod + 5120 + c);
      xo.x += gt.x * s[q * 4] * rs * gv.x; xo.y += gt.y * s[q * 4 + 1] * rs * gv.y; xo.z += gt.z * s[q * 4 + 2] * rs * gv.z; xo.w += gt.w * s[q * 4 + 3] * rs * gv.w;
      if (L.last) *(float4*)(dst + c) = xo; else *(uint2*)(dstx + c) = pk4_(xo);
      xv[q * 4] = xo.x; xv[q * 4 + 1] = xo.y; xv[q * 4 + 2] = xo.z; xv[q * 4 + 3] = xo.w;
    }
    if (!L.last) {
      const float* mod1 = (const float*)(p.ws + OFF_MOD) + ((size_t)(L.l + 1) * NB1 + tok_modrow(tok)) * 6144;
      normmod_row(xv, p.in[I_GPREMIX] + (L.l + 1) * 1024, mod1, mod1 + 1024, (bf16*)(p.ws + OFF_HA) + (size_t)tok * 1024, h);
    }
    if (!has) break;
    i = inext; tok = tokn;
#pragma unroll
    for (int q = 0; q < 4; ++q) { sel[q] = seln[q]; xr[q] = xn[q]; }
  }
}

enum { PH_PREP0 = 0, PH_PREP1, PH_L0 };
enum { LP_INPROJ = 0, LP_TOKPREP, LP_MIX1, LP_MIX2, LP_GLU, LP_MERGE, LP_POST, LP_ROUTE, LP_MOE, LP_COMB, LP_COUNT };
constexpr int NPHASES = PH_L0 + DEPTH * LP_COUNT;


DI void run_phase(const Params& p, int ph, char* smem) {
  const int G = gridDim.x;
  int start = blockIdx.x;
  auto seg = [&](int n, auto&& fn) {
    for (; start < n; start += G) fn(start);
    start -= n;
  };
#ifdef ONLY_PREP
  if (ph >= PH_L0) return;
#endif
  if (ph == PH_PREP0) {
    seg(DEPTH * 96, [&](int it) { mod_item(p, it, smem); });
    seg(DEPTH * 32, [&](int it) { s5_tab_item(p, it, smem); });
    seg(1, [&](int) { rope_tab_item(p); });
    seg(DEPTH * CT_EARLY, [&](int it) { conv_early_item(p, it / CT_EARLY, it % CT_EARLY, smem); });
    return;
  }
  if (ph == PH_PREP1) {
    seg(DEPTH * 256, [&](int it) { s5_mat_item(p, it); });
    seg(NTOK / NWAVES, [&](int it) { prep_row_item(p, it); });
    return;
  }
#ifdef ONLY_LPH
  if (ph < PH_L0) return;
#endif
  const int l = (ph - PH_L0) / LP_COUNT;
#ifdef ONLY_LPH
  const int lph = ONLY_LPH;
#else
  const int lph = (ph - PH_L0) % LP_COUNT;
#endif
  const LP L = make_lp(p, l);
  switch (lph) {
    case LP_INPROJ:
      seg(L.last ? IP_SLOTS_LAST : IP_SLOTS_ALL, [&](int it) { inproj_tile(p, L, it, smem); });
      break;
    case LP_TOKPREP:
      seg(16 * S5_MT * 2, [&](int it) { s5a_tile(p, L, it, smem); });
      seg(TP_MT * 3, [&](int it) { mlaq_tile(p, L, it, smem); });
      seg(TP_MT * 4, [&](int it) { mlakv_tile(p, L, it, smem); });
      seg(NTOK / 64, [&](int it) { navt_item(p, it, smem); });
      seg(M2C_ITEMS, [&](int it) { m2conv_item(p, L, it); });
      seg(M2S_ITEMS, [&](int it) { m2scal_item(p, L, it); });
      break;
    case LP_MIX1: {
      const int n0 = BATCH * 8, n1 = n0 + 2 * 16 * BATCH / NWAVES, n2 = n1 + BATCH * 4 * (SEQ / 256), n3 = n2 + BATCH * 4 * (SEQ / 256);
      const int n4 = n3 + (L.last ? 0 : BATCH * 4 * ((CTXL + 255) / 256)), n5 = n4 + (L.last ? 0 : BATCH * 4 * ((CTXL + 255) / 256));
      int* qhead = (int*)(p.ws + OFF_BAR) + Q_WORD0 + 64 * (l + 2 * p.probe_rep);
#ifdef EMU
      volatile int* bc = (volatile int*)(smem + SMEM_BYTES + 8);
#else
      volatile LAS int* bc = (volatile LAS int*)(smem + SMEM_BYTES + 8);
#endif
      for (;;) {
        __syncthreads();
        if (tid_() == 0) {
#ifdef EMU
          *bc = atomicAdd(qhead, 1);
#else
          *bc = __hip_atomic_fetch_add(qhead, 1, __ATOMIC_RELAXED, __HIP_MEMORY_SCOPE_AGENT);
#endif
        }
        __syncthreads();
        const int it = *bc;
        if (it >= n5) break;
#ifdef PROBE_SKIPM2
        if (it < n0) { if (p.probe_rep == 0) m2scan_item(p, L, it, smem); }
#else
        if (it < n0) m2scan_item(p, L, it, smem);
#endif
        else if (it < n1) s5carry_item(p, L, it - n0);
        else if (it < n2) mla_attn_item(p, it - n1, false, smem);
        else if (it < n3) na_attn_item(p, L, it - n2, false, smem);
        else if (it < n4) mla_attn_item(p, it - n3, true, smem);
        else na_attn_item(p, L, it - n4, true, smem);
      }
    } break;
    case LP_MIX2:
      seg(16 * S5_MT * 2, [&](int it) { s5c_tile(p, L, it, smem); });
      seg(BATCH * 4 * M2C_MT, [&](int it) { m2corr_tile(p, L, it, smem); });
      break;
    case LP_GLU:
      seg(GLU_MT * 2, [&](int it) { glu_tile(p, L, it, smem); });
      seg(NTOK / NWAVES, [&](int it) { m2gate_item(p, L, it); });
      break;
    case LP_MERGE:
      seg(((mtiles(L.last, 256) + 7) / 8) * 64, [&](int it) { merge_tile(p, L, it, smem); });
      seg(mtiles(L.last, 256) * 4, [&](int it) { outproj_tile(p, L, it, smem); });
      break;
    case LP_POST:
      seg(CT_EXP, [&](int it) { conv_expert_item(p, l, it, smem); });
      post_stage_router(p, L, smem);
      post_phase(p, L, smem);
      break;
    case LP_ROUTE:
      seg(BATCH * 16 * (L.last ? 1 : 2), [&](int it) { route_item(p, L, it, smem); });
      break;
    case LP_MOE:
      seg(NE * (((L.last ? ESLOTS_L : ESLOTS) + 255) / 256) * 8, [&](int it) { moe1_tile(p, L, it, smem); });
      seg(((NE * (((L.last ? ESLOTS_L : ESLOTS) + 255) / 256) + 1) / 2) * 8, [&](int it) { moe2_tile(p, L, it, smem); });
      break;
    case LP_COMB:
      comb_phase(p, L);
      break;
  }
}

__global__ void __launch_bounds__(NTHREADS, 2) mega_kernel(Params p) {
#ifdef EMU
  char* smem = emu_cur_f->blk->smem;
  for (int ph = p.phase_lo; ph < p.phase_hi; ++ph) {
    run_phase(p, ph, smem);
    if (ph + 1 < p.phase_hi) emu_grid_sync();
  }
#else
  __shared__ __attribute__((aligned(16))) char smem[SMEM_BYTES + 16 + 256];
  {
    const unsigned hw = (unsigned)__builtin_amdgcn_s_getreg((5 << 11) | 4) & 0x3fu;
    if ((threadIdx.x & 63) == 0) *(volatile int*)(smem + WAVE_TAB_OFF + hw * 4u) = (int)(threadIdx.x >> 6);
    __syncthreads();
  }
  if (p.phase_hi - p.phase_lo > 1) {
    if (threadIdx.x == 0) *(uint4*)(smem + SMEM_BYTES) = make_uint4(0u, 0u, 0u, 0u);
    __syncthreads();
    XcdBarrier xb = xcd_barrier_post((unsigned*)(p.ws + OFF_BAR), (volatile LAS unsigned*)(smem + SMEM_BYTES));
    for (int ph = p.phase_lo; ph < p.phase_hi; ++ph) {
      int reps = 1;
#ifdef PROBE_PHASE
      if (ph == PROBE_PHASE || ph == PROBE_PHASE2) reps = 1 + PROBE_REP;
#endif
      for (int rep = 0; rep < reps; ++rep) {
        p.probe_rep = rep;
        run_phase(p, ph, smem);
        if (ph + 1 < p.phase_hi || rep + 1 < reps) {
          if (ph == p.phase_lo && rep == 0) cg::this_grid().sync();
          else xcd_barrier(xb);
        }
      }
    }
  } else {
    run_phase(p, p.phase_lo, smem);
  }
#endif
}

#ifndef EMU
extern "C" void kernel_launch(void* const* d_in, const int* in_sizes, int n_in, void* d_out, int out_size, void* d_ws, size_t ws_size,
                              hipStream_t stream) {
  static int grid_blocks = 0;
  if (!grid_blocks) {
    int dev = 0, cus = 0, per_cu = 0;
    hipGetDevice(&dev);
    hipDeviceGetAttribute(&cus, hipDeviceAttributeMultiprocessorCount, dev);
    hipOccupancyMaxActiveBlocksPerMultiprocessor(&per_cu, mega_kernel, NTHREADS, 0);
    if (per_cu > 1) per_cu = 1;
    if (per_cu < 1) per_cu = 1;
    grid_blocks = cus * per_cu;
    if (ws_size < WS_TOTAL) fprintf(stderr, "workspace too small: %zu < %zu\n", ws_size, (size_t)WS_TOTAL);
  }
  Params p{};
  for (int i = 0; i < N_INPUTS; ++i) p.in[i] = (const float*)d_in[i];
  p.out = (float*)d_out;
  p.ws = (char*)d_ws;
#if MK_MULTI
  for (int ph = 0; ph < NPHASES; ++ph) {
    p.phase_lo = ph; p.phase_hi = ph + 1;
    hipLaunchKernelGGL(mega_kernel, dim3(grid_blocks), dim3(NTHREADS), 0, stream, p);
  }
#else
  p.phase_lo = 0; p.phase_hi = NPHASES;
  hipMemsetAsync((char*)d_ws + OFF_BAR, 0, BAR_BYTES, stream);
  void* args[] = {&p};
  hipError_t e = hipLaunchCooperativeKernel((void*)mega_kernel, dim3(grid_blocks), dim3(NTHREADS), args, 0, stream);
  if (e != hipSuccess) fprintf(stderr, "cooperative launch failed: %s (grid %d)\n", hipGetErrorString(e), grid_blocks);
#endif
}
#endif
```

```cpp
#ifdef EMU
#include "emu.h"
#else
#include <hip/hip_runtime.h>
#include <hip/hip_cooperative_groups.h>
#include <cstdio>
namespace cg = cooperative_groups;
using bf16x8 = __attribute__((ext_vector_type(8))) short;
using f32x4 = __attribute__((ext_vector_type(4))) float;
using f32x16 = __attribute__((ext_vector_type(16))) float;
#endif
using u32x4 = __attribute__((ext_vector_type(4))) unsigned;
#ifndef MK_MULTI
#define MK_MULTI 0
#endif

#define DI __device__ __forceinline__
typedef unsigned short bf16;

#ifdef EMU_SMALL2
constexpr int BATCH = 2, SEQ = 1024, CTXL = 64, GRID_W = 32;
#elif defined(EMU_SMALL)
constexpr int BATCH = 2, SEQ = 512, CTXL = 64, GRID_W = 32;
#else
constexpr int BATCH = 8, SEQ = 2048, CTXL = 256, GRID_W = 64;
#endif
constexpr int D = 1024, DEPTH = 2;
constexpr int TOK = CTXL + SEQ, NTOK = BATCH * TOK;
constexpr int ROWS = SEQ / GRID_W;
constexpr int WIN_R = (ROWS < 8 ? ROWS : 8), WIN_C = 16;
constexpr int N_IN = 6568, N_INP = 6656;
constexpr int C_CQ = 0, C_CKV = 256, C_KR = 384, C_NA = 416, C_S5 = 1184, C_Z = 1440, C_XBC = 1696, C_DT = 2464, C_GATE = 2472;
constexpr int P1W = 2480;
constexpr int NCH = TOK / 16, NCC = CTXL / 16, MCH = BATCH * NCH;
constexpr int NE = 16;
constexpr int CAP_L = 2 * SEQ / NE, CAP_C = 2 * CTXL / NE;
constexpr int ESLOTS = BATCH * (CAP_L + CAP_C), ESLOTS_L = BATCH * CAP_L;
constexpr int NB1 = BATCH + 1;
constexpr float EPS = 1e-6f;
constexpr int SMEM_BYTES = 147456;
constexpr int NTHREADS = 512, NWAVES = NTHREADS / 64;

enum { I_X = 0, I_C, I_CTX, I_CCTX, I_WADA, I_BADA, I_GPREMIX, I_GPOSTMIX, I_GPREFFN, I_GPOSTFFN, I_WIN, I_GCQ, I_GCKV, I_WUQ, I_WUKV, I_RPB,
       I_S5ARE, I_S5AIM, I_S5LOGSTEP, I_S5BRE, I_S5BIM, I_S5CRE, I_S5CIM, I_S5D, I_S5WGLU, I_S5BGLU, I_M2CONVW, I_M2CONVB, I_M2ALOG, I_M2DTBIAS,
       I_M2D, I_M2GNORM, I_WBRANCH, I_WOUT, I_WROUTER, I_WGATE, I_WUP, I_WDOWN, N_INPUTS };

constexpr size_t al256(size_t x) { return (x + 255) & ~(size_t)255; }
constexpr size_t SZ_X = (size_t)NTOK * D * 4;
constexpr size_t SZ_ROWBF = (size_t)NTOK * D * 2;
constexpr size_t OFF_X = 0;
constexpr size_t WDN_BYTES = (size_t)NE * 1024 * 1024 * 2;
constexpr bool WDN_IN_X = (al256(SZ_ROWBF) + WDN_BYTES <= al256(SZ_X));
constexpr size_t OFF_MOD = OFF_X + al256(SZ_X);
constexpr size_t OFF_HA = OFF_MOD + al256((size_t)DEPTH * NB1 * 6144 * 4);
constexpr size_t OFF_O = OFF_HA + al256(SZ_ROWBF);
constexpr size_t OFF_P1 = OFF_O + al256(SZ_ROWBF);
constexpr size_t SZ_P1 = (size_t)NTOK * P1W * 2;
constexpr size_t OFF_PG = OFF_P1 + al256(SZ_P1);
constexpr size_t SZ_PG = (size_t)NTOK * 4096 * 2;
constexpr size_t OFF_DT = OFF_PG + al256(SZ_PG);
constexpr size_t OFF_AFF = OFF_DT + al256((size_t)NTOK * 8 * 4);
constexpr size_t OFF_SEL = OFF_AFF + al256((size_t)NTOK * 16 * 4);
constexpr size_t OFF_IDX = OFF_SEL + al256((size_t)NTOK * 16 * 4);
constexpr size_t OFF_GW = OFF_IDX + al256((size_t)NE * ESLOTS * 4);
constexpr size_t OFF_BAR = OFF_GW + al256((size_t)NE * ESLOTS * 4);
constexpr int Q_WORD0 = 3456;
constexpr int CNT_WORD0 = Q_WORD0 + 64 * 4;
constexpr int CNT_MT = (NTOK + 255) / 256, CNT_ET = (ESLOTS + 255) / 256, CNT_LAYER = CNT_MT + NE * CNT_ET;
constexpr size_t BAR_BYTES = (size_t)(CNT_WORD0 + DEPTH * CNT_LAYER) * 4;
constexpr size_t OFF_ROPE = OFF_BAR + al256(BAR_BYTES);
constexpr size_t OFF_WEARLY = OFF_ROPE + al256(64 * 8 * 2 * 4);
constexpr size_t WE_WIN = 0;
constexpr size_t WE_UQ = WE_WIN + (size_t)N_INP * 1024 * 2;
constexpr size_t WE_UKV = WE_UQ + (size_t)384 * 256 * 2;
constexpr size_t WE_GLU = WE_UKV + (size_t)512 * 128 * 2;
constexpr size_t WE_WB = WE_GLU + (size_t)256 * 256 * 2;
constexpr size_t WE_WOUT = WE_WB + (size_t)4 * 1024 * 256 * 2;
constexpr size_t WE_SIZE = al256(WE_WOUT + (size_t)1024 * 1024 * 2);
constexpr size_t OFF_S5TAB = OFF_WEARLY + DEPTH * WE_SIZE;
constexpr size_t S5_LAMPOW = 0;
constexpr size_t S5_BBAR = S5_LAMPOW + (size_t)2 * 16 * 17 * 64 * 2 * 4;
constexpr size_t S5_KT = S5_BBAR + (size_t)2 * 16 * 64 * 16 * 2 * 4;
constexpr size_t S5_WA = S5_KT + (size_t)2 * 16 * 16 * 256 * 4;
constexpr size_t S5_W2 = S5_WA + (size_t)16 * 256 * 256 * 2;
constexpr size_t S5_SIZE = al256(S5_W2 + (size_t)16 * 256 * 512 * 2);
constexpr size_t OFF_MIX = OFF_S5TAB + DEPTH * S5_SIZE;
constexpr size_t MX_Q = 0;
constexpr size_t MX_K = MX_Q + al256((size_t)BATCH * 4 * TOK * 96 * 2);
constexpr size_t MX_VTM = MX_K + al256((size_t)BATCH * 4 * TOK * 96 * 2);
constexpr size_t MX_VTN = MX_VTM + al256((size_t)BATCH * 4 * 64 * TOK * 2);
constexpr size_t MX_XBC = MX_VTN + al256((size_t)BATCH * 4 * 64 * TOK * 2);
constexpr size_t MX_US5 = MX_XBC + al256((size_t)NTOK * 768 * 2);
constexpr size_t MX_HEND = MX_US5 + al256((size_t)NTOK * 256 * 2);
constexpr size_t MX_HIN = MX_HEND + al256((size_t)16 * MCH * 256 * 4);
constexpr size_t MX_Z = MX_HIN + al256((size_t)16 * MCH * 256 * 2);
constexpr size_t MX_XBT = MX_Z + al256((size_t)NTOK * 256 * 2);
constexpr size_t MX_M2S = MX_XBT + al256((size_t)NTOK * 512 * 2);
constexpr int M2_SPLIT = ((TOK / 64 + 1) / 2) * 64, M2_REST = TOK - M2_SPLIT;
constexpr size_t MX_HM = MX_M2S + al256((size_t)BATCH * 8 * TOK * 4 * 4);
constexpr size_t MX_GT = MX_HM + al256((size_t)BATCH * 4 * 128 * 128 * 2);
constexpr size_t MX_SIZE = MX_GT + al256((size_t)BATCH * 8 * M2_REST * 4);
constexpr size_t WX_GU = 0;
constexpr size_t WX_DN = WX_GU + (size_t)NE * 2048 * 1024 * 2;
constexpr size_t WX_SIZE = WX_DN + (size_t)NE * 1024 * 1024 * 2;
constexpr size_t MIXREG = (MX_SIZE > WX_SIZE ? MX_SIZE : WX_SIZE);
constexpr size_t OFF_WDN = WDN_IN_X ? OFF_X + al256(SZ_ROWBF) : OFF_MIX + al256(MIXREG);
constexpr size_t WS_TOTAL = OFF_MIX + al256(MIXREG) + (WDN_IN_X ? 0 : WDN_BYTES);

struct Params {
  const float* in[N_INPUTS];
  float* out;
  char* ws;
  int phase_lo, phase_hi;
  int probe_rep, pad_;
};

constexpr int WAVE_TAB_OFF = SMEM_BYTES + 16;
DI int tid_() {
#ifdef EMU
  return (int)threadIdx.x;
#else
  const unsigned hw = (unsigned)__builtin_amdgcn_s_getreg((5 << 11) | 4) & 0x3fu;
  const int wave = *(volatile __attribute__((address_space(3))) int*)(unsigned long)(WAVE_TAB_OFF + hw * 4u);
  int lane;
  asm volatile("v_mbcnt_lo_u32_b32 %0, -1, 0\n\tv_mbcnt_hi_u32_b32 %0, -1, %0" : "=v"(lane));
  return wave * 64 + lane;
#endif
}
#ifdef EMU
template <class T> DI T shfl_xor_(T v, int m) { return __shfl_xor(v, m); }
template <class T> DI T shfl_up_(T v, int d) { return __shfl_up(v, d); }
template <class T> DI T shfl_(T v, int src) { return __shfl(v, src); }
#else
template <class T> DI T shfl_xor_(T v, int m) {
  const int idx = ((tid_() & 63) ^ m) << 2;
  return __builtin_bit_cast(T, __builtin_amdgcn_ds_bpermute(idx, __builtin_bit_cast(int, v)));
}
template <class T> DI T shfl_up_(T v, int d) {
  const int l = tid_() & 63; const int idx = (l >= d ? l - d : l) << 2;
  return __builtin_bit_cast(T, __builtin_amdgcn_ds_bpermute(idx, __builtin_bit_cast(int, v)));
}
template <class T> DI T shfl_(T v, int src) {
  int idx = src << 2; asm volatile("" : "+v"(idx));
  return __builtin_bit_cast(T, __builtin_amdgcn_ds_bpermute(idx, __builtin_bit_cast(int, v)));
}
#endif
DI float bf2f(bf16 h) { return __uint_as_float(((unsigned)h) << 16); }
#ifdef EMU
DI bf16 f2bf(float f) { unsigned u = __float_as_uint(f); u += 0x7fffu + ((u >> 16) & 1u); return (bf16)(u >> 16); }
DI unsigned pack2(float a, float b) { return (unsigned)f2bf(a) | ((unsigned)f2bf(b) << 16); }
DI float exp2f_(float x) { return exp2f(x); }
#else
typedef float f32x2_t_ __attribute__((ext_vector_type(2)));
typedef __bf16 bf16x2_t_ __attribute__((ext_vector_type(2)));
DI unsigned pack2(float a, float b) { const f32x2_t_ v = {a, b}; return __builtin_bit_cast(unsigned, __builtin_convertvector(v, bf16x2_t_)); }
DI bf16 f2bf(float f) { return (bf16)(pack2(f, 0.f) & 0xffffu); }
DI float exp2f_(float x) { return __builtin_amdgcn_exp2f(x); }
#endif
#ifdef EMU
DI float rcp_(float x) { return 1.0f / x; }
#else
DI float rcp_(float x) { return __builtin_amdgcn_rcpf(x); }
#endif
DI float sigmoidf_(float x) { return rcp_(1.0f + exp2f_(-1.4426950408889634f * x)); }
DI float siluf_(float x) { return x * rcp_(1.0f + exp2f_(-1.4426950408889634f * x)); }
DI float softplusf_(float x) { const float ax = x < 0.f ? -x : x; return (x > 0.f ? x : 0.f) + __logf(1.0f + __expf(-ax)); }
DI float geluf_(float x) { const float u2 = 1.5957691216057308f * (x + 0.044715f * x * x * x); return x * rcp_(1.0f + exp2f_(-1.4426950408889634f * u2)); }
DI bool wave_all_(bool c) {
#ifdef EMU
  int v = c ? 0 : 1;
  v += shfl_xor_(v, 32); v += shfl_xor_(v, 16); v += shfl_xor_(v, 8); v += shfl_xor_(v, 4); v += shfl_xor_(v, 2); v += shfl_xor_(v, 1);
  return v == 0;
#else
  return __builtin_amdgcn_ballot_w64(!c) == 0ull;
#endif
}
DI float wave_sum(float v) {
#ifdef EMU
  v += shfl_xor_(v, 32); v += shfl_xor_(v, 16); v += shfl_xor_(v, 8); v += shfl_xor_(v, 4); v += shfl_xor_(v, 2); v += shfl_xor_(v, 1);
  return v;
#else
  int x = __float_as_int(v);
  x = __float_as_int(__int_as_float(x) + __int_as_float(__builtin_amdgcn_update_dpp(0, x, 0xB1, 0xF, 0xF, true)));
  x = __float_as_int(__int_as_float(x) + __int_as_float(__builtin_amdgcn_update_dpp(0, x, 0x4E, 0xF, 0xF, true)));
  x = __float_as_int(__int_as_float(x) + __int_as_float(__builtin_amdgcn_update_dpp(0, x, 0x141, 0xF, 0xF, true)));
  x = __float_as_int(__int_as_float(x) + __int_as_float(__builtin_amdgcn_update_dpp(0, x, 0x140, 0xF, 0xF, true)));
  const float r0 = __int_as_float(__builtin_amdgcn_readlane(x, 0)), r1 = __int_as_float(__builtin_amdgcn_readlane(x, 16));
  const float r2 = __int_as_float(__builtin_amdgcn_readlane(x, 32)), r3 = __int_as_float(__builtin_amdgcn_readlane(x, 48));
  return (r0 + r1) + (r2 + r3);
#endif
}
#ifndef EMU
#define XB_TMO      128
#define XB_XCNT(j)  (256  + 64 * (j))
#define XB_XSUB(j)  (1280 + 64 * (j))
#define XB_XGEN(j)  (2304 + 64 * (j))
#define XB_TOP      3328
#define XB_TOPGEN   3392
#define XB_SPIN_CAP (1u << 24)
#define LAS __attribute__((address_space(3)))
DI unsigned xb_ld(unsigned* p) { return __hip_atomic_load(p, __ATOMIC_RELAXED, __HIP_MEMORY_SCOPE_AGENT); }
DI unsigned xb_add(unsigned* p, unsigned v) { return __hip_atomic_fetch_add(p, v, __ATOMIC_RELAXED, __HIP_MEMORY_SCOPE_AGENT); }
DI unsigned xb_xcc_id() { return (unsigned)__builtin_amdgcn_s_getreg((3 << 11) | 20) & 0xFu; }
#define XB_SPIN(cond, bar) do { unsigned _sp = 0; while (cond) { __builtin_amdgcn_s_sleep(1); \
    if ((++_sp & 255u) == 0u) { if (xb_ld(&(bar)[XB_TMO])) break; if (_sp > XB_SPIN_CAP) { atomicAdd(&(bar)[XB_TMO], 1u); break; } } } } while (0)
struct XcdBarrier { unsigned* bar; unsigned x; volatile LAS unsigned* st; };
DI XcdBarrier xcd_barrier_post(unsigned* bar, volatile LAS unsigned* st) {
  XcdBarrier b; b.bar = bar; b.x = xb_xcc_id(); b.st = st;
  if (threadIdx.x == 0) (void)xb_add(&bar[XB_XCNT(b.x)], 1u);
  return b;
}
DI void xcd_barrier_complete(unsigned* bar, unsigned x, unsigned& nloc, unsigned& nx) {
  const unsigned G = gridDim.x * gridDim.y * gridDim.z;
  unsigned sum, cnt, mine, sp = 0u;
  for (;;) {
    sum = 0u; cnt = 0u; mine = 0u;
#pragma unroll
    for (unsigned j = 0; j < 16; ++j) { const unsigned c = xb_ld(&bar[XB_XCNT(j)]); sum += c; cnt += (c > 0u) ? 1u : 0u; mine = (j == x) ? c : mine; }
    if (sum == G) break;
    __builtin_amdgcn_s_sleep(1);
    if ((++sp & 255u) == 0u) { if (xb_ld(&bar[XB_TMO])) break; if (sp > XB_SPIN_CAP) { atomicAdd(&bar[XB_TMO], 1u); break; } }
  }
  nloc = mine > 0u ? mine : 1u; nx = cnt > 0u ? cnt : 1u;
}
DI void xcd_barrier(const XcdBarrier& b) {
  asm volatile("s_waitcnt vmcnt(0)" ::: "memory");
  __syncthreads();
  if (threadIdx.x == 0) {
    unsigned* bar = b.bar;
    __builtin_amdgcn_s_waitcnt(0);
    unsigned nloc = b.st[0], nx = b.st[1];
    if (nloc == 0u) { xcd_barrier_complete(bar, b.x, nloc, nx); b.st[0] = nloc; b.st[1] = nx; }
    const unsigned old = xb_add(&bar[XB_XSUB(b.x)], 1u);
    const unsigned gen = old / nloc;
    if (old + 1u == (gen + 1u) * nloc) {
      __builtin_amdgcn_fence(__ATOMIC_RELEASE, "agent");
      asm volatile("s_waitcnt vmcnt(0)" ::: "memory");
      const unsigned og = xb_add(&bar[XB_TOP], 1u);
      const unsigned tg = og / nx;
      if (og + 1u == (tg + 1u) * nx) xb_add(&bar[XB_TOPGEN], 1u);
      else XB_SPIN(xb_ld(&bar[XB_TOPGEN]) == tg, bar);
      __builtin_amdgcn_fence(__ATOMIC_ACQUIRE, "agent");
      xb_add(&bar[XB_XGEN(b.x)], 1u);
      asm volatile("s_waitcnt vmcnt(0)" ::: "memory");
    } else {
      XB_SPIN(xb_ld(&bar[XB_XGEN(b.x)]) == gen, bar);
      __builtin_amdgcn_fence(__ATOMIC_ACQUIRE, "agent");
      asm volatile("s_waitcnt vmcnt(0)" ::: "memory");
    }
  }
  __syncthreads();
}
#endif

struct GA {
  const bf16* A; const bf16* A2; int lda, lda2, ksplit;
  const int* ridx; int mvalid;
  const bf16* Bt; int ldb; int K;
  int kfix;
};
DI GA make_ga(const bf16* A, int lda, const bf16* Bt, int ldb, int K, int mvalid) {
  GA g; g.A = A; g.A2 = A; g.lda = lda; g.lda2 = lda; g.ksplit = K; g.ridx = nullptr; g.mvalid = mvalid; g.Bt = Bt; g.ldb = ldb; g.K = K; g.kfix = 0; return g;
}

#ifdef EMU
#define GLDS16(gptr_, lptr_) memcpy((void*)(lptr_), (const void*)(gptr_), 16)
#define BGLDS16(rsrc_, base_, voff_, soff_, lptr_) memcpy((void*)(lptr_), (const char*)(base_) + (voff_) + (soff_), 16)
#define GEMM_WAIT(N_)
#define RAW_BARRIER() __syncthreads()
#else
#define LASV __attribute__((address_space(3))) void
#define GLDS16(gptr_, lptr_) __builtin_amdgcn_global_load_lds((const void*)(gptr_), (LASV*)(lptr_), 16, 0, 0)
#define BGLDS16(rsrc_, base_, voff_, soff_, lptr_) __builtin_amdgcn_raw_ptr_buffer_load_lds(rsrc_, (LASV*)(lptr_), 16, (int)(voff_), (int)(soff_), 0, 0)
#define GEMM_WAIT(N_) asm volatile("s_waitcnt vmcnt(%0)" :: "n"(N_) : "memory")
#define RAW_BARRIER() { asm volatile("" ::: "memory"); __builtin_amdgcn_s_barrier(); asm volatile("" ::: "memory"); }
#endif
DI int perm32(int rho) { const int n = rho >> 4, i = rho & 15; return 8 * (i >> 2) + 4 * n + (i & 3); }
constexpr int SRS_OFF = 73728;
template <int NT>
DI void gemm_s(const GA& g, int m0, int n0, char* smem, f32x4 (&acc)[4][NT]) {
  constexpr int A_ELEMS = 256 * 32, B_ELEMS = 32 * NT * 32, STAGE = A_ELEMS + B_ELEMS;
  bf16* st = (bf16*)smem;
  const int tid = tid_(), lane = tid & 63, wid = tid >> 6, wr = wid >> 1, wc = wid & 1, fr = lane & 15, fq = lane >> 4;
  const int lrow = tid >> 2, pch = tid & 3;
  long aoff[2], aoff2[2], boff;
#pragma unroll
  for (int i = 0; i < 2; ++i) {
    const int row = lrow + 128 * i;
    const int lch = pch ^ ((-(row >> 2)) & 3);
    int gm = m0 + row; if (gm > g.mvalid - 1) gm = g.mvalid - 1;
    const int ar = g.ridx ? g.ridx[gm] : gm;
    aoff[i] = (long)ar * g.lda + lch * 8;
    aoff2[i] = (long)ar * g.lda2 + lch * 8;
  }
  const int cb = (NT == 4) ? tid : (tid & 255);
  {
    const int row = cb >> 2;
    const int lch = pch ^ ((-(row >> 2)) & 3);
    const int src = n0 + (row & ~31) + perm32(row & 31);
    boff = (long)src * g.ldb + lch * 8;
  }
#pragma unroll
  for (int m = 0; m < 4; ++m)
#pragma unroll
    for (int n = 0; n < NT; ++n) acc[m][n] = f32x4{0.f, 0.f, 0.f, 0.f};
  const int T = g.K / 32;
#define GEMM_DMA(t_, stg_) { const int k0_ = (t_) * 32; const bool seg2_ = (k0_ >= g.ksplit); bf16* sa_ = st + (stg_) * STAGE; \
    _Pragma("unroll") for (int i_ = 0; i_ < 2; ++i_) { \
      const bf16* ap_ = seg2_ ? (g.A2 + aoff2[i_] + (k0_ - g.ksplit)) : (g.A + aoff[i_] + k0_); \
      GLDS16(ap_, sa_ + (tid + i_ * 512) * 8); } \
    GLDS16(g.Bt + boff + k0_, sa_ + A_ELEMS + cb * 8); }
  __syncthreads();
  GEMM_DMA(0, 0)
  if (T > 1) GEMM_DMA(1, 1)
  int s_cur = 0, s_nxt = 2;
#pragma unroll 1
  for (int t = 0; t < T; ++t) {
    if (t + 1 < T) { GEMM_WAIT(3); } else { GEMM_WAIT(0); }
    RAW_BARRIER();
    if (t + 2 < T) GEMM_DMA(t + 2, s_nxt)
    const bf16* sa = st + s_cur * STAGE;
    const bf16* sb = sa + A_ELEMS;
    bf16x8 af[4], bfr[NT];
#pragma unroll
    for (int n = 0; n < NT; ++n) {
      const int row = wc * (16 * NT) + n * 16 + fr;
      bfr[n] = *(const bf16x8*)(sb + row * 32 + ((fq ^ ((-(row >> 2)) & 3)) << 3));
    }
#pragma unroll
    for (int m = 0; m < 4; ++m) {
      const int row = wr * 64 + m * 16 + fr;
      af[m] = *(const bf16x8*)(sa + row * 32 + ((fq ^ ((-(row >> 2)) & 3)) << 3));
    }
#pragma unroll
    for (int m = 0; m < 4; ++m)
#pragma unroll
      for (int n = 0; n < NT; ++n) acc[m][n] = __builtin_amdgcn_mfma_f32_16x16x32_bf16(bfr[n], af[m], acc[m][n], 0, 0, 0);
    s_cur = (s_cur == 2) ? 0 : s_cur + 1;
    s_nxt = (s_nxt == 2) ? 0 : s_nxt + 1;
  }
}
constexpr int BG_HT = 128 * 64;
DI int lds_byte(int r, int c) { const int stt = (r >> 4) * 2 + (c >> 5), rr = r & 15, cc = c & 31, ob = rr * 64 + cc * 2; return stt * 1024 + (ob ^ (((ob >> 9) & 1) << 5)); }
DI void stage_rc(int b, int& R, int& C) { const int stt = b / 1024, sb = b % 1024, swz = sb ^ (((sb >> 9) & 1) << 5); R = (stt >> 1) * 16 + swz / 64; C = (stt & 1) * 32 + (swz % 64) / 2; }
#ifdef EMU
#define BG_WAIT_V(n)
#define BG_WAIT_L(n)
#define BG_BAR __syncthreads()
#define BG_SCHED
#define BG_PRIO(x)
#else
#define BG_WAIT_V(n) asm volatile("s_waitcnt vmcnt(" #n ")" ::: "memory")
#define BG_WAIT_L(n) asm volatile("s_waitcnt lgkmcnt(" #n ")" ::: "memory")
#define BG_BAR __builtin_amdgcn_s_barrier()
#define BG_SCHED __builtin_amdgcn_sched_barrier(0)
#define BG_PRIO(x) __builtin_amdgcn_s_setprio(x)
#endif
DI void gemm_big(const GA& g, int m0, int n0, char* smem, f32x4 (&acc)[2][2][4][2]) {
  bf16* shm = (bf16*)smem;
  const int tid = tid_(), wid = tid >> 6, lane = tid & 63, wr = wid >> 2, wc = wid & 3, fr = lane & 15, fq = lane >> 4;
  unsigned aof[2][2], bof[2];
#ifdef EMU
  const int dma_lds = tid * 16;
#else
  const int dma_lds = __builtin_amdgcn_readfirstlane(tid >> 6) * 1024;
#endif
#ifndef EMU
  const __amdgpu_buffer_rsrc_t rsA = __builtin_amdgcn_make_buffer_rsrc((void*)g.A, 0, 0x7fffffff, 0x00020000);
  const __amdgpu_buffer_rsrc_t rsB = __builtin_amdgcn_make_buffer_rsrc((void*)g.Bt, 0, 0x7fffffff, 0x00020000);
#endif
#pragma unroll
  for (int i = 0; i < 2; ++i) {
    int R, C; stage_rc(tid * 16 + i * 8192, R, C);
    bof[i] = (unsigned)((n0 + (R & ~31) + perm32(R & 31)) * g.ldb + C) * 2u;
#pragma unroll
    for (int h = 0; h < 2; ++h) {
      int gm = m0 + h * 128 + R; if (gm > g.mvalid - 1) gm = g.mvalid - 1;
      const int ar = g.ridx ? g.ridx[gm] : gm;
      aof[h][i] = (unsigned)(ar * g.lda + C) * 2u;
    }
  }
#define BG_SA(b, h) (shm + ((b) * 2 + (h)) * BG_HT)
#define BG_SB(b, h) (shm + (4 + (b) * 2 + (h)) * BG_HT)
#define BG_STAGE_A(P, h, kt) { \
    _Pragma("unroll") for (int i_ = 0; i_ < 2; ++i_) BGLDS16(rsA, g.A, aof[h][i_], (kt) * 128, (char*)(P) + dma_lds + i_ * 8192); }
#define BG_STAGE_B(P, h, kt) { \
    _Pragma("unroll") for (int i_ = 0; i_ < 2; ++i_) BGLDS16(rsB, g.Bt, bof[i_], (kt) * 128 + (h) * 256 * g.ldb, (char*)(P) + dma_lds + i_ * 8192); }
#define BG_LDA(dst, b, h) _Pragma("unroll") for (int m_ = 0; m_ < 4; ++m_) _Pragma("unroll") for (int k_ = 0; k_ < 2; ++k_) \
    dst[m_][k_] = *(const bf16x8*)((const char*)BG_SA(b, h) + lds_byte(wr * 64 + m_ * 16 + fr, k_ * 32 + fq * 8))
#define BG_LDB(dst, b, h) _Pragma("unroll") for (int n_ = 0; n_ < 2; ++n_) _Pragma("unroll") for (int k_ = 0; k_ < 2; ++k_) \
    dst[n_][k_] = *(const bf16x8*)((const char*)BG_SB(b, h) + lds_byte(wc * 32 + n_ * 16 + fr, k_ * 32 + fq * 8))
#define BG_MMA(ai, bj, At_, Bt_) { BG_PRIO(1); \
    _Pragma("unroll") for (int m_ = 0; m_ < 4; ++m_) _Pragma("unroll") for (int n_ = 0; n_ < 2; ++n_) _Pragma("unroll") for (int k_ = 0; k_ < 2; ++k_) \
      acc[ai][bj][m_][n_] = __builtin_amdgcn_mfma_f32_16x16x32_bf16(Bt_[n_][k_], At_[m_][k_], acc[ai][bj][m_][n_], 0, 0, 0); \
    BG_PRIO(0); }
#pragma unroll
  for (int a_ = 0; a_ < 2; ++a_)
#pragma unroll
    for (int b_ = 0; b_ < 2; ++b_)
#pragma unroll
      for (int m_ = 0; m_ < 4; ++m_)
#pragma unroll
        for (int n_ = 0; n_ < 2; ++n_) acc[a_][b_][m_][n_] = f32x4{0.f, 0.f, 0.f, 0.f};
  bf16x8 At[4][2], B0[2][2], B1[2][2];
  const int nt = g.K / 64;
  __syncthreads();
  BG_STAGE_B(BG_SB(0, 0), 0, 0) BG_STAGE_A(BG_SA(0, 0), 0, 0)
  BG_STAGE_B(BG_SB(0, 1), 1, 0) BG_STAGE_A(BG_SA(0, 1), 1, 0)
  if (wr == 1) BG_BAR;
  BG_WAIT_V(4); BG_BAR;
  BG_STAGE_B(BG_SB(1, 0), 0, 1) BG_STAGE_A(BG_SA(1, 0), 0, 1) BG_STAGE_B(BG_SB(1, 1), 1, 1)
  BG_WAIT_V(6); BG_BAR;
#pragma unroll 1
  for (int t = 0; t < nt - 2; t += 2) {
    BG_LDB(B0, 0, 0); BG_SCHED; BG_LDA(At, 0, 0); BG_STAGE_A(BG_SA(1, 1), 1, t + 1)
    BG_WAIT_L(8); BG_BAR; BG_WAIT_L(0); BG_MMA(0, 0, At, B0) BG_BAR; BG_SCHED;
    BG_LDB(B1, 0, 1); BG_STAGE_B(BG_SB(0, 0), 0, t + 2)
    BG_BAR; BG_WAIT_L(0); BG_MMA(0, 1, At, B1) BG_BAR;
    BG_LDA(At, 0, 1); BG_STAGE_A(BG_SA(0, 0), 0, t + 2)
    BG_BAR; BG_WAIT_L(0); BG_MMA(1, 0, At, B0) BG_BAR; BG_SCHED;
    BG_STAGE_B(BG_SB(0, 1), 1, t + 2)
    BG_WAIT_V(6); BG_BAR; BG_MMA(1, 1, At, B1) BG_BAR;
    BG_LDB(B0, 1, 0); BG_SCHED; BG_LDA(At, 1, 0); BG_STAGE_A(BG_SA(0, 1), 1, t + 2)
    BG_WAIT_L(8); BG_BAR; BG_WAIT_L(0); BG_MMA(0, 0, At, B0) BG_BAR; BG_SCHED;
    BG_LDB(B1, 1, 1); BG_STAGE_B(BG_SB(1, 0), 0, t + 3)
    BG_BAR; BG_WAIT_L(0); BG_MMA(0, 1, At, B1) BG_BAR;
    BG_LDA(At, 1, 1); BG_STAGE_A(BG_SA(1, 0), 0, t + 3)
    BG_BAR; BG_WAIT_L(0); BG_MMA(1, 0, At, B0) BG_BAR; BG_SCHED;
    BG_STAGE_B(BG_SB(1, 1), 1, t + 3)
    BG_WAIT_V(6); BG_BAR; BG_MMA(1, 1, At, B1) BG_BAR;
  }
  { BG_LDB(B0, 0, 0); BG_LDA(At, 0, 0); BG_STAGE_A(BG_SA(1, 1), 1, nt - 1)
    BG_BAR; BG_WAIT_L(0); BG_MMA(0, 0, At, B0) BG_BAR;
    BG_LDB(B1, 0, 1); BG_BAR; BG_WAIT_L(0); BG_MMA(0, 1, At, B1) BG_BAR;
    BG_LDA(At, 0, 1); BG_WAIT_V(4); BG_BAR; BG_WAIT_L(0); BG_MMA(1, 0, At, B0) BG_MMA(1, 1, At, B1) BG_BAR; }
  { BG_LDB(B0, 1, 0); BG_LDA(At, 1, 0); BG_WAIT_V(2); BG_BAR; BG_WAIT_L(0); BG_MMA(0, 0, At, B0) BG_BAR;
    BG_LDB(B1, 1, 1); BG_WAIT_V(0); BG_BAR; BG_WAIT_L(0); BG_MMA(0, 1, At, B1) BG_BAR;
    BG_LDA(At, 1, 1); BG_BAR; BG_WAIT_L(0); BG_MMA(1, 0, At, B0) BG_MMA(1, 1, At, B1) BG_BAR; }
  if (wr == 0) BG_BAR;
}
#define EPIB_BEGIN(acc_, m0_, n0_, mvalid_) { const int _l = tid_() & 63, _w = tid_() >> 6, _wr = _w >> 2, _wc = _w & 3, _fr = _l & 15, _fq = _l >> 4; \
  _Pragma("unroll") for (int _ai = 0; _ai < 2; ++_ai) _Pragma("unroll") for (int _m = 0; _m < 4; ++_m) { const int row = (m0_) + _ai * 128 + _wr * 64 + _m * 16 + _fr; \
  _Pragma("unroll") for (int _bj = 0; _bj < 2; ++_bj) { const int col = (n0_) + _bj * 128 + _wc * 32 + 8 * _fq; (void)col; \
    float v[8] = {acc_[_ai][_bj][_m][0][0], acc_[_ai][_bj][_m][0][1], acc_[_ai][_bj][_m][0][2], acc_[_ai][_bj][_m][0][3], \
                  acc_[_ai][_bj][_m][1][0], acc_[_ai][_bj][_m][1][1], acc_[_ai][_bj][_m][1][2], acc_[_ai][_bj][_m][1][3]}; \
    if (row < (mvalid_)) {
#define EPIB_END }}}}

DI void ld8bf(const bf16* p, float (&v)[8]) {
  uint4 w = *(const uint4*)p;
  v[0] = __uint_as_float(w.x << 16); v[1] = __uint_as_float(w.x & 0xffff0000u); v[2] = __uint_as_float(w.y << 16); v[3] = __uint_as_float(w.y & 0xffff0000u);
  v[4] = __uint_as_float(w.z << 16); v[5] = __uint_as_float(w.z & 0xffff0000u); v[6] = __uint_as_float(w.w << 16); v[7] = __uint_as_float(w.w & 0xffff0000u);
}
DI void st8bf(bf16* p, const float (&v)[8]) { *(uint4*)p = make_uint4(pack2(v[0], v[1]), pack2(v[2], v[3]), pack2(v[4], v[5]), pack2(v[6], v[7])); }
#ifdef EMU
DI unsigned pk_u8_(float x, int sel, unsigned old) { float y = x < 0.f ? 0.f : (x > 255.f ? 255.f : x); return (old & ~(0xffu << (8 * sel))) | ((unsigned)lrintf(y) << (8 * sel)); }
#else
DI unsigned pk_u8_(float x, int sel, unsigned old) { return __builtin_amdgcn_cvt_pk_u8_f32(x, (unsigned)sel, old); }
#endif
DI void st8u8(unsigned char* p, const float (&v)[8]) {
  unsigned lo = 0u, hi = 0u;
#pragma unroll
  for (int k = 0; k < 4; ++k) { lo = pk_u8_(v[k] * 255.0f, k, lo); hi = pk_u8_(v[4 + k] * 255.0f, k, hi); }
  *(uint2*)p = make_uint2(lo, hi);
}
DI void ld8u8(const unsigned char* p, float (&v)[8]) {
  const uint2 w = *(const uint2*)p;
#pragma unroll
  for (int k = 0; k < 4; ++k) { v[k] = (float)((w.x >> (8 * k)) & 0xffu); v[4 + k] = (float)((w.y >> (8 * k)) & 0xffu); }
}
DI float4 bf4_(uint2 w) { return make_float4(__uint_as_float(w.x << 16), __uint_as_float(w.x & 0xffff0000u), __uint_as_float(w.y << 16), __uint_as_float(w.y & 0xffff0000u)); }
DI float4 bf4_(float4 v) { return v; }
DI uint2 pk4_(float4 v) { return make_uint2(pack2(v.x, v.y), pack2(v.z, v.w)); }
DI void st8f(float* p, const float (&v)[8]) { *(float4*)p = make_float4(v[0], v[1], v[2], v[3]); *(float4*)(p + 4) = make_float4(v[4], v[5], v[6], v[7]); }
#define EPI_BEGIN(NT_, acc_, m0_, n0_, mvalid_) { const int _l = tid_() & 63, _w = tid_() >> 6, _wr = _w >> 1, _wc = _w & 1, _fr = _l & 15, _fq = _l >> 4; \
  _Pragma("unroll") for (int _m = 0; _m < 4; ++_m) { const int row = (m0_) + _wr * 64 + _m * 16 + _fr; \
  _Pragma("unroll") for (int _q = 0; _q < (NT_) / 2; ++_q) { const int col = (n0_) + _wc * (16 * (NT_)) + _q * 32 + 8 * _fq; (void)col; \
    float v[8] = {acc_[_m][2 * _q][0], acc_[_m][2 * _q][1], acc_[_m][2 * _q][2], acc_[_m][2 * _q][3], \
                  acc_[_m][2 * _q + 1][0], acc_[_m][2 * _q + 1][1], acc_[_m][2 * _q + 1][2], acc_[_m][2 * _q + 1][3]}; \
    if (row < (mvalid_)) {
#define EPI_END }}}}

DI int mtile_row0(int mt, bool latonly, int TH) {
  if (!latonly) return mt * TH;
  const int per = SEQ / TH, b = mt / per, r = mt % per;
  return b * TOK + CTXL + r * TH;
}
DI int mtiles(bool latonly, int TH) { return latonly ? BATCH * (SEQ / TH) : (NTOK + TH - 1) / TH; }

struct LP {
  int l; bool last;
  const float* mod;
  char* we;
  char* s5;
};
DI LP make_lp(const Params& p, int l) {
  LP q; q.l = l; q.last = (l == DEPTH - 1);
  q.mod = (const float*)(p.ws + OFF_MOD) + (size_t)l * NB1 * 6144;
  q.we = p.ws + OFF_WEARLY + (size_t)l * WE_SIZE;
  q.s5 = p.ws + OFF_S5TAB + (size_t)l * S5_SIZE;
  return q;
}

template <class RowMap>
DI void conv_tile(const float* src, int lds, int nsrc, const float* kscale, bf16* dst, int K, int k0, int n0, char* smem, RowMap rowmap, int ndst = 1 << 30) {
  (void)smem;
  const int tid = tid_(), n4 = (tid >> 6) * 32 + (tid & 7) * 4, k8 = ((tid >> 3) & 7) * 8;
  float4 v[8];
  const bool ok = (n0 + n4 < nsrc);
  const float* sp = src + (size_t)(k0 + k8) * lds + n0 + n4;
#pragma unroll
  for (int k = 0; k < 8; ++k) v[k] = ok ? *(const float4*)(sp + (size_t)k * lds) : make_float4(0.f, 0.f, 0.f, 0.f);
  if (kscale) {
#pragma unroll
    for (int k = 0; k < 8; ++k) { const float sc = kscale[k0 + k8 + k]; v[k].x *= sc; v[k].y *= sc; v[k].z *= sc; v[k].w *= sc; }
  }
  float o[8];
#pragma unroll
  for (int k = 0; k < 8; ++k) o[k] = v[k].x;
  if (n0 + n4 + 0 < ndst) st8bf(dst + (size_t)rowmap(n0 + n4 + 0) * K + k0 + k8, o);
#pragma unroll
  for (int k = 0; k < 8; ++k) o[k] = v[k].y;
  if (n0 + n4 + 1 < ndst) st8bf(dst + (size_t)rowmap(n0 + n4 + 1) * K + k0 + k8, o);
#pragma unroll
  for (int k = 0; k < 8; ++k) o[k] = v[k].z;
  if (n0 + n4 + 2 < ndst) st8bf(dst + (size_t)rowmap(n0 + n4 + 2) * K + k0 + k8, o);
#pragma unroll
  for (int k = 0; k < 8; ++k) o[k] = v[k].w;
  if (n0 + n4 + 3 < ndst) st8bf(dst + (size_t)rowmap(n0 + n4 + 3) * K + k0 + k8, o);
}
struct RowId { DI int operator()(int n) const { return n; } };
struct RowGU { int half; DI int operator()(int f) const { return (f >> 7) * 256 + half * 128 + (f & 127); } };

constexpr int CT_WIN = 16 * (N_INP / 256), CT_UQ = 4 * 2, CT_UKV = 2 * 2, CT_GLU = 4, CT_WB = 4 * 16, CT_WOUT = 64;
constexpr int CT_EARLY = CT_WIN + CT_UQ + CT_UKV + CT_GLU + CT_WB + CT_WOUT;
constexpr int CT_EXP = NE * 2 * 64, CT_DN = NE * 64;

DI void conv_early_item(const Params& p, int l, int it, char* smem) {
  char* we = p.ws + OFF_WEARLY + (size_t)l * WE_SIZE;
  if (it < CT_WIN) {
    int kt = it % 16, nt = it / 16;
    conv_tile(p.in[I_WIN] + (size_t)l * 1024 * N_IN, N_IN, N_IN, nullptr, (bf16*)(we + WE_WIN), 1024, kt * 64, nt * 256, smem, RowId());
    return;
  }
  it -= CT_WIN;
  if (it < CT_UQ) {
    int kt = it % 4, nt = it / 4;
    conv_tile(p.in[I_WUQ] + (size_t)l * 256 * 384, 384, 384, p.in[I_GCQ] + l * 256, (bf16*)(we + WE_UQ), 256, kt * 64, nt * 256, smem, RowId(), 384);
    return;
  }
  it -= CT_UQ;
  if (it < CT_UKV) {
    int kt = it % 2, nt = it / 2;
    conv_tile(p.in[I_WUKV] + (size_t)l * 128 * 512, 512, 512, p.in[I_GCKV] + l * 128, (bf16*)(we + WE_UKV), 128, kt * 64, nt * 256, smem, RowId());
    return;
  }
  it -= CT_UKV;
  if (it < CT_GLU) {
    int kt = it;
    conv_tile(p.in[I_S5WGLU] + (size_t)l * 256 * 256, 256, 256, nullptr, (bf16*)(we + WE_GLU), 256, kt * 64, 0, smem, RowId());
    return;
  }
  it -= CT_GLU;
  if (it < CT_WB) {
    int j = it / 16, r = it % 16, kt = r % 4, nt = r / 4;
    conv_tile(p.in[I_WBRANCH] + ((size_t)l * 4 + j) * 256 * 1024, 1024, 1024, nullptr, (bf16*)(we + WE_WB) + (size_t)j * 1024 * 256, 256, kt * 64, nt * 256, smem, RowId());
    return;
  }
  it -= CT_WB;
  {
    int kt = it % 16, nt = it / 16;
    conv_tile(p.in[I_WOUT] + (size_t)l * 1024 * 1024, 1024, 1024, nullptr, (bf16*)(we + WE_WOUT), 1024, kt * 64, nt * 256, smem, RowId());
  }
}
DI void conv_dn_item(const Params& p, int l, int it, char* smem) {
  const int e = it / 64, t = it % 64, kt = t % 16, nt = t / 16;
  conv_tile(p.in[I_WDOWN] + ((size_t)l * NE + e) * 1024 * 1024, 1024, 1024, nullptr, (bf16*)(p.ws + OFF_WDN) + (size_t)e * 1024 * 1024, 1024, kt * 64, nt * 256, smem, RowId());
}
DI void conv_expert_item(const Params& p, int l, int it, char* smem) {
  char* wx = p.ws + OFF_MIX;
  int e = it / 128, r = it % 128, which = r / 64, t = r % 64, kt = t % 16, nt = t / 16;
  size_t eoff = ((size_t)l * NE + e) * 1024 * 1024;
  if (which == 0) { RowGU rm; rm.half = 0; conv_tile(p.in[I_WGATE] + eoff, 1024, 1024, nullptr, (bf16*)(wx + WX_GU) + (size_t)e * 2048 * 1024, 1024, kt * 64, nt * 256, smem, rm); }
  else { RowGU rm; rm.half = 1; conv_tile(p.in[I_WUP] + eoff, 1024, 1024, nullptr, (bf16*)(wx + WX_GU) + (size_t)e * 2048 * 1024, 1024, kt * 64, nt * 256, smem, rm); }
}

DI void mod_item(const Params& p, int it, char* smem) {
  const int l = it / 96, cg0 = (it % 96) * 64;
  float* sc = (float*)smem;
  float* red = sc + NB1 * 1024;
  const int tid = tid_();
  __syncthreads();
  for (int i = tid; i < NB1 * 1024; i += NTHREADS) {
    int r = i >> 10, k = i & 1023;
    float c = (r < BATCH) ? p.in[I_C][r * 1024 + k] : p.in[I_CCTX][k];
    sc[i] = siluf_(c);
  }
  __syncthreads();
  const int cl = tid & 63, kg = tid >> 6;
  float acc[NB1];
#pragma unroll
  for (int r = 0; r < NB1; ++r) acc[r] = 0.f;
  const float* w = p.in[I_WADA] + (size_t)l * 1024 * 6144 + cg0 + cl;
  for (int k0 = kg * (1024 / NWAVES); k0 < (kg + 1) * (1024 / NWAVES); k0 += 16) {
    float wv[16];
#pragma unroll
    for (int u = 0; u < 16; ++u) wv[u] = w[(size_t)(k0 + u) * 6144];
#pragma unroll
    for (int u = 0; u < 16; ++u)
#pragma unroll
      for (int r = 0; r < NB1; ++r) acc[r] += sc[r * 1024 + k0 + u] * wv[u];
  }
#pragma unroll
  for (int r = 0; r < NB1; ++r) red[(kg * NB1 + r) * 64 + cl] = acc[r];
  __syncthreads();
  for (int i = tid; i < NB1 * 64; i += NTHREADS) {
    int r = i >> 6, c = i & 63;
    float s = 0.f;
#pragma unroll
    for (int q = 0; q < NWAVES; ++q) s += red[(q * NB1 + r) * 64 + c];
    s += p.in[I_BADA][l * 6144 + cg0 + c];
    ((float*)(p.ws + OFF_MOD))[((size_t)l * NB1 + r) * 6144 + cg0 + c] = s;
  }
}

DI void s5_tab_item(const Params& p, int it, char* smem) {
  const int l = it / 32, d = (it / 16) & 1, g = it & 15;
  char* s5 = p.ws + OFF_S5TAB + (size_t)l * S5_SIZE;
  float* lampow = (float*)(s5 + S5_LAMPOW) + (size_t)(d * 16 + g) * 17 * 64 * 2;
  float* bbar = (float*)(s5 + S5_BBAR) + (size_t)(d * 16 + g) * 64 * 16 * 2;
  float* kt = (float*)(s5 + S5_KT) + (size_t)(d * 16 + g) * 16 * 256;
  float* slam = (float*)smem;
  float* sbb = slam + 17 * 64 * 2;
  const int tid = tid_();
  const size_t pg = ((size_t)(l * 2 + d) * 16 + g);
  const float step = expf(p.in[I_S5LOGSTEP][pg]);
  __syncthreads();
  for (int i = tid; i < 17 * 64; i += NTHREADS) {
    int j = i >> 6, pp = i & 63;
    float are = p.in[I_S5ARE][pg * 64 + pp], aim = p.in[I_S5AIM][pg * 64 + pp];
    float mag = expf((float)j * step * are), ang = (float)j * step * aim;
    float re = mag * cosf(ang), im = mag * sinf(ang);
    slam[i * 2] = re; slam[i * 2 + 1] = im; lampow[i * 2] = re; lampow[i * 2 + 1] = im;
  }
  __syncthreads();
  for (int i = tid; i < 64 * 16; i += NTHREADS) {
    int pp = i >> 4;
    float are = p.in[I_S5ARE][pg * 64 + pp], aim = p.in[I_S5AIM][pg * 64 + pp];
    float x = slam[(64 + pp) * 2] - 1.0f, y = slam[(64 + pp) * 2 + 1];
    float den = are * are + aim * aim;
    float qre = (x * are + y * aim) / den, qim = (y * are - x * aim) / den;
    float bre = p.in[I_S5BRE][pg * 1024 + i], bim = p.in[I_S5BIM][pg * 1024 + i];
    float re = qre * bre - qim * bim, im = qre * bim + qim * bre;
    sbb[i * 2] = re; sbb[i * 2 + 1] = im; bbar[i * 2] = re; bbar[i * 2 + 1] = im;
  }
  __syncthreads();
  for (int i = tid; i < 16 * 256; i += NTHREADS) {
    int j = i >> 8, c = (i >> 4) & 15, c2 = i & 15;
    float s = 0.f;
    for (int pp = 0; pp < 64; ++pp) {
      float cre = p.in[I_S5CRE][pg * 1024 + c * 64 + pp], cim = p.in[I_S5CIM][pg * 1024 + c * 64 + pp];
      float lre = slam[(j * 64 + pp) * 2], lim = slam[(j * 64 + pp) * 2 + 1];
      float tre = cre * lre - cim * lim, tim = cre * lim + cim * lre;
      float bre = sbb[(pp * 16 + c2) * 2], bim = sbb[(pp * 16 + c2) * 2 + 1];
      s += tre * bre - tim * bim;
    }
    kt[i] = s;
  }
}
DI void s5_mat_item(const Params& p, int it) {
  const int l = it / 256, g = (it / 16) & 15, q = it & 15;
  char* s5 = p.ws + OFF_S5TAB + (size_t)l * S5_SIZE;
  const float* lampow = (const float*)(s5 + S5_LAMPOW);
  const float* bbar = (const float*)(s5 + S5_BBAR);
  const float* ktab = (const float*)(s5 + S5_KT);
  bf16* WA = (bf16*)(s5 + S5_WA) + (size_t)g * 256 * 256;
  bf16* W2 = (bf16*)(s5 + S5_W2) + (size_t)g * 256 * 512;
  const int tid = tid_();
  for (int i = tid; i < 16 * 256; i += NTHREADS) {
    int n = q * 16 + (i >> 8), k = i & 255;
    int d = n >> 7, ri = (n >> 6) & 1, pp = n & 63, s = k >> 4, c2 = k & 15;
    int e = (d == 0) ? (15 - s) : s;
    const float* lp = lampow + ((size_t)((d * 16 + g) * 17 + e) * 64 + pp) * 2;
    const float* bp = bbar + ((size_t)((d * 16 + g) * 64 + pp) * 16 + c2) * 2;
    float re = lp[0] * bp[0] - lp[1] * bp[1], im = lp[0] * bp[1] + lp[1] * bp[0];
    WA[(size_t)n * 256 + k] = f2bf(ri == 0 ? re : im);
  }
  for (int i = tid; i < 16 * 512; i += NTHREADS) {
    int n = q * 16 + (i >> 9), k = i & 511;
    int lq = n >> 4, c = n & 15;
    float v;
    if (k < 256) {
      int s = k >> 4, c2 = k & 15;
      v = 0.f;
      if (s <= lq) v += ktab[((size_t)(0 * 16 + g) * 16 + (lq - s)) * 256 + c * 16 + c2];
      if (s >= lq) v += ktab[((size_t)(1 * 16 + g) * 16 + (s - lq)) * 256 + c * 16 + c2];
      if (s == lq && c == c2) v += p.in[I_S5D][l * 256 + g * 16 + c];
    } else {
      int kk = k - 256, d = kk >> 7, ri = (kk >> 6) & 1, pp = kk & 63;
      int e = (d == 0) ? (lq + 1) : (16 - lq);
      size_t pg = ((size_t)(l * 2 + d) * 16 + g);
      float cre = p.in[I_S5CRE][pg * 1024 + c * 64 + pp], cim = p.in[I_S5CIM][pg * 1024 + c * 64 + pp];
      const float* lp = lampow + ((size_t)((d * 16 + g) * 17 + e) * 64 + pp) * 2;
      float re = cre * lp[0] - cim * lp[1], im = cre * lp[1] + cim * lp[0];
      v = (ri == 0) ? re : -im;
    }
    W2[(size_t)n * 512 + k] = f2bf(v);
  }
}

DI int tok_b(int tok) { return tok / TOK; }
DI int tok_j(int tok) { return tok % TOK; }
DI int tok_modrow(int tok) { return (tok_j(tok) < CTXL) ? BATCH : tok_b(tok); }

DI void normmod_row(const float (&xv)[16], const float* g, const float* shift, const float* scale, bf16* dst, float (&hout)[16]) {
  const int lane = tid_() & 63;
  float4 gva[4], sha[4], sca[4];
#pragma unroll
  for (int i = 0; i < 4; ++i) { const int c = lane * 4 + i * 256; gva[i] = *(const float4*)(g + c); sha[i] = *(const float4*)(shift + c); sca[i] = *(const float4*)(scale + c); }
  float ss = 0.f;
#pragma unroll
  for (int i = 0; i < 16; ++i) ss += xv[i] * xv[i];
  ss = wave_sum(ss);
  const float rs = rsqrtf(ss * (1.0f / 1024.f) + EPS);
#pragma unroll
  for (int i = 0; i < 4; ++i) {
    int c = lane * 4 + i * 256;
    const float4 gv = gva[i], sh = sha[i], sc = sca[i];
    float h0 = xv[i * 4 + 0] * rs * gv.x * (1.f + sc.x) + sh.x;
    float h1 = xv[i * 4 + 1] * rs * gv.y * (1.f + sc.y) + sh.y;
    float h2 = xv[i * 4 + 2] * rs * gv.z * (1.f + sc.z) + sh.z;
    float h3 = xv[i * 4 + 3] * rs * gv.w * (1.f + sc.w) + sh.w;
    hout[i * 4 + 0] = h0; hout[i * 4 + 1] = h1; hout[i * 4 + 2] = h2; hout[i * 4 + 3] = h3;
    *(uint2*)(dst + c) = make_uint2(pack2(h0, h1), pack2(h2, h3));
  }
}

DI void prep_row_item(const Params& p, int it) {
  const int tok = it * NWAVES + (tid_() >> 6), lane = tid_() & 63;
  const int b = tok_b(tok), j = tok_j(tok);
  const float* src = (j < CTXL) ? p.in[I_CTX] + ((size_t)b * CTXL + j) * 1024 : p.in[I_X] + ((size_t)b * SEQ + (j - CTXL)) * 1024;
  float xv[16], h[16];
#pragma unroll
  for (int i = 0; i < 4; ++i) {
    float4 v = *(const float4*)(src + lane * 4 + i * 256);
    xv[i * 4] = v.x; xv[i * 4 + 1] = v.y; xv[i * 4 + 2] = v.z; xv[i * 4 + 3] = v.w;
  }
  const float* mod = (const float*)(p.ws + OFF_MOD) + (size_t)tok_modrow(tok) * 6144;
  normmod_row(xv, p.in[I_GPREMIX], mod + 0, mod + 1024, (bf16*)(p.ws + OFF_HA) + (size_t)tok * 1024, h);
}

constexpr int IP_LT = BATCH * (SEQ / 256), IP_CT = BATCH * ((CTXL + 255) / 256), IP_MT = IP_LT + IP_CT, IP_NT = N_INP / 256;
constexpr int IP_RR = (IP_MT + 7) / 8, IP_RC = (IP_NT + 1) / 2;
constexpr int IP_RC_NOGATE = (((C_GATE + 255) / 256) + 1) / 2;
constexpr int IP_RR_LAT = IP_LT / 8;
constexpr bool IP_COMPACT = (IP_LT % 8 == 0);
constexpr int IP_RECTS_ALL = IP_RR * IP_RC, IP_RECTS_LAST = IP_COMPACT ? (IP_RR * IP_RC_NOGATE + IP_RR_LAT * (IP_RC - IP_RC_NOGATE)) : IP_RECTS_ALL;
constexpr int IP_SLOTS_ALL = ((IP_RECTS_ALL + 15) / 16) * 256, IP_SLOTS_LAST = ((IP_RECTS_LAST + 15) / 16) * 256;
DI void inproj_tile(const Params& p, const LP& L, int t, char* smem) {
  const int vb = t % 256, vround = t / 256, x = vb % 8, j = vb / 8;
  const int Rc = vround * 16 + x * 2 + (j >> 4), jj = j & 15;
  int rm, rn;
  if (!L.last || !IP_COMPACT || Rc < IP_RR * IP_RC_NOGATE) { rm = Rc % IP_RR; rn = Rc / IP_RR; }
  else { const int q = Rc - IP_RR * IP_RC_NOGATE; rm = q % IP_RR_LAT; rn = IP_RC_NOGATE + q / IP_RR_LAT; }
  const int mt = rm * 8 + (jj & 7), nt = rn * 2 + (jj >> 3);
  if (mt >= IP_MT || nt >= IP_NT || rn >= IP_RC) return;
  int m0;
  if (mt < IP_LT) m0 = (mt / (SEQ / 256)) * TOK + CTXL + (mt % (SEQ / 256)) * 256;
  else { const int c = mt - IP_LT; m0 = (c / ((CTXL + 255) / 256)) * TOK + (c % ((CTXL + 255) / 256)) * 256; }
  const int n0 = nt * 256;
  const int mv = (mt < IP_LT) ? NTOK : (m0 - (m0 % TOK) + CTXL);
  if (L.last && mt >= IP_LT && n0 >= ((C_GATE + 255) / 256) * 256) return;
  GA g = make_ga((const bf16*)(p.ws + OFF_HA), 1024, (const bf16*)(L.we + WE_WIN), 1024, 1024, mv);
  f32x4 acc[2][2][4][2];
  gemm_big(g, m0, n0, smem, acc);
  bf16* P1 = (bf16*)(p.ws + OFF_P1);
  unsigned char* PG = (unsigned char*)(p.ws + OFF_PG);
  bf16* US5 = (bf16*)(p.ws + OFF_MIX + MX_US5);
  float* DT = (float*)(p.ws + OFF_DT);
  const float* dtb = p.in[I_M2DTBIAS] + L.l * 8;
  EPIB_BEGIN(acc, m0, n0, mv)
    if (col < C_S5 || (col >= C_Z && col < C_DT)) st8bf(P1 + (size_t)row * P1W + col, v);
    else if (col < C_Z) st8bf(US5 + ((size_t)((col - C_S5) >> 4) * NTOK + row) * 16 + (col & 15), v);
    else if (col < C_GATE) {
#pragma unroll
      for (int k = 0; k < 8; ++k) v[k] = softplusf_(v[k] + dtb[k]);
      st8f(DT + (size_t)row * 8, v);
    } else if (col < N_IN) {
#pragma unroll
      for (int k = 0; k < 8; ++k) v[k] = sigmoidf_(v[k]);
      st8u8(PG + (size_t)row * 4096 + (col - C_GATE), v);
    }
  EPIB_END
}

DI void rowscale_256(const bf16* P1, int m0, int c0, int width, float* srs) {
  const int r = tid_() >> 1, hf = tid_() & 1;
  int gr = m0 + r; if (gr > NTOK - 1) gr = NTOK - 1;
  const bf16* src = P1 + (size_t)gr * P1W + c0 + hf * (width / 2);
  float ss = 0.f;
  for (int i = 0; i < width / 2; i += 8) {
    float v[8]; ld8bf(src + i, v);
#pragma unroll
    for (int k = 0; k < 8; ++k) ss += v[k] * v[k];
  }
  ss += shfl_xor_(ss, 1);
  if (hf == 0) srs[r] = rsqrtf(ss / (float)width + EPS);
}
DI void rope_tab_item(const Params& p) {
  float* tab = (float*)(p.ws + OFF_ROPE);
  for (int i = tid_(); i < 64 * 8; i += NTHREADS) {
    int pos = i >> 3, k = i & 7;
    float f = expf(-(float)k * (9.210340371976184f / 8.0f));
    float a = (float)pos * f;
    tab[i * 2] = cosf(a); tab[i * 2 + 1] = sinf(a);
  }
}
DI void rope_cs(const float* tab, int pos, int i, float& c, float& s) { c = tab[(pos * 8 + i) * 2]; s = tab[(pos * 8 + i) * 2 + 1]; }

constexpr int TP_MT = (NTOK + 255) / 256;
DI void mlaq_tile(const Params& p, const LP& L, int t, char* smem) {
  const int mt = t % TP_MT, nt = t / TP_MT, m0 = mt * 256, n0 = nt * 128;
  const bf16* P1 = (const bf16*)(p.ws + OFF_P1);
  float* srs = (float*)(smem + SRS_OFF);
  GA g = make_ga(P1 + C_CQ, P1W, (const bf16*)(L.we + WE_UQ), 256, 256, NTOK);
  f32x4 acc[4][4];
  gemm_s<4>(g, m0, n0, smem, acc);
  rowscale_256(P1, m0, C_CQ, 256, srs);
  __syncthreads();
  bf16* Q = (bf16*)(p.ws + OFF_MIX + MX_Q);
  const float* ropetab = (const float*)(p.ws + OFF_ROPE);
  {
    const int l = tid_() & 63, w = tid_() >> 6, wr = w >> 1, wc = w & 1, fr = l & 15, fq = l >> 4;
#pragma unroll
    for (int m = 0; m < 4; ++m) {
      const int row = m0 + wr * 64 + m * 16 + fr;
      const int rowc = row < NTOK ? row : NTOK - 1;
      const float rsc = srs[rowc - m0];
      const int b = tok_b(rowc), j = tok_j(rowc);
#pragma unroll
      for (int q = 0; q < 2; ++q) {
        const int col = n0 + wc * 64 + q * 32 + 8 * fq;
        const int h = col / 96, dd = col % 96;
        float v[8] = {acc[m][2 * q][0], acc[m][2 * q][1], acc[m][2 * q][2], acc[m][2 * q][3], acc[m][2 * q + 1][0], acc[m][2 * q + 1][1], acc[m][2 * q + 1][2], acc[m][2 * q + 1][3]};
        float vp[8];
#pragma unroll
        for (int k = 0; k < 8; ++k) vp[k] = shfl_xor_(v[k], 16);
        if (dd >= 64 && j >= CTXL) {
          const int tl = j - CTXL, pos = ((dd - 64) < 16) ? (tl / GRID_W) : (tl % GRID_W);
          const bool lo = ((dd & 8) == 0);
#pragma unroll
          for (int k = 0; k < 8; ++k) {
            float c, sn; rope_cs(ropetab, pos, k, c, sn);
            v[k] = lo ? (v[k] * c - vp[k] * sn) : (v[k] * c + vp[k] * sn);
          }
        }
#pragma unroll
        for (int k = 0; k < 8; ++k) v[k] *= rsc;
        if (row < NTOK) st8bf(Q + (((size_t)b * 4 + h) * TOK + j) * 96 + dd, v);
      }
    }
  }
}
DI void mlakv_tile(const Params& p, const LP& L, int t, char* smem) {
  const int mt = t % TP_MT, h = t / TP_MT, m0 = mt * 256, n0 = h * 128;
  const bf16* P1 = (const bf16*)(p.ws + OFF_P1);
  float* srs = (float*)(smem + SRS_OFF);
  GA g = make_ga(P1 + C_CKV, P1W, (const bf16*)(L.we + WE_UKV), 128, 128, NTOK);
  f32x4 acc[4][4];
  gemm_s<4>(g, m0, n0, smem, acc);
  rowscale_256(P1, m0, C_CKV, 128, srs);
  __syncthreads();
  bf16* K = (bf16*)(p.ws + OFF_MIX + MX_K);
  bf16* VT = (bf16*)(p.ws + OFF_MIX + MX_VTM);
  const float* ropetab = (const float*)(p.ws + OFF_ROPE);
  constexpr bool VT_LDS = (TOK % 256 == 0) && (NTOK % 256 == 0);
  constexpr int VT_LD = 264;
  bf16* svt = (bf16*)smem;
  EPI_BEGIN(4, acc, m0, n0, NTOK)
    const float rsc = srs[row - m0];
    const int b = tok_b(row), j = tok_j(row), dd = col - n0;
#pragma unroll
    for (int k = 0; k < 8; ++k) v[k] *= rsc;
    if (dd < 64) st8bf(K + (((size_t)b * 4 + h) * TOK + j) * 96 + dd, v);
    else if (VT_LDS) {
#pragma unroll
      for (int k = 0; k < 8; ++k) svt[(dd - 64 + k) * VT_LD + (row - m0)] = f2bf(v[k]);
    } else {
#pragma unroll
      for (int k = 0; k < 8; ++k) VT[(((size_t)b * 4 + h) * 64 + (dd - 64 + k)) * TOK + j] = f2bf(v[k]);
    }
  EPI_END
  if (VT_LDS) {
    __syncthreads();
    const int b0 = tok_b(m0), j0 = tok_j(m0);
    for (int i = tid_(); i < 64 * 32; i += NTHREADS) {
      const int d = i >> 5, c8 = (i & 31) * 8;
      *(uint4*)(VT + (((size_t)b0 * 4 + h) * 64 + d) * TOK + j0 + c8) = *(const uint4*)(svt + d * VT_LD + c8);
    }
  }
  for (int i = tid_(); i < 256 * 16; i += NTHREADS) {
    int r = i >> 4, q = i & 15;
    int row = m0 + r;
    if (row < NTOK) {
      int b = tok_b(row), j = tok_j(row);
      int blk = q >> 3, i8 = q & 7;
      float x1 = bf2f(P1[(size_t)row * P1W + C_KR + blk * 16 + i8]), x2 = bf2f(P1[(size_t)row * P1W + C_KR + blk * 16 + i8 + 8]);
      float o1 = x1, o2 = x2;
      if (j >= CTXL) {
        int tl = j - CTXL, pos = blk == 0 ? (tl / GRID_W) : (tl % GRID_W);
        float c, sn; rope_cs(ropetab, pos, i8, c, sn);
        o1 = x1 * c - x2 * sn; o2 = x2 * c + x1 * sn;
      }
      bf16* kd = K + (((size_t)b * 4 + h) * TOK + j) * 96 + 64 + blk * 16 + i8;
      kd[0] = f2bf(o1); kd[8] = f2bf(o2);
    }
  }
}
DI void navt_item(const Params& p, int it, char* smem) {
  bf16* s = (bf16*)smem;
  const bf16* P1 = (const bf16*)(p.ws + OFF_P1);
  bf16* VT = (bf16*)(p.ws + OFF_MIX + MX_VTN);
  const int tok0 = it * 64, tid = tid_();
  const int b = tok_b(tok0), j0 = tok_j(tok0);
  __syncthreads();
  for (int i = tid; i < 64 * 32; i += NTHREADS) {
    int r = i >> 5, c8 = i & 31;
    *(uint4*)(s + r * 264 + c8 * 8) = *(const uint4*)(P1 + (size_t)(tok0 + r) * P1W + C_NA + 512 + c8 * 8);
  }
  __syncthreads();
  for (int i = tid; i < 256 * 8; i += NTHREADS) {
    int ch = i >> 3, t8 = i & 7;
    unsigned w[4];
#pragma unroll
    for (int q = 0; q < 4; ++q) w[q] = (unsigned)s[(t8 * 8 + 2 * q) * 264 + ch] | ((unsigned)s[(t8 * 8 + 2 * q + 1) * 264 + ch] << 16);
    *(uint4*)(VT + ((size_t)b * 256 + ch) * TOK + j0 + t8 * 8) = make_uint4(w[0], w[1], w[2], w[3]);
  }
}
constexpr int M2C_TASKS = (NTOK / 8) * 96, M2C_ITEMS = (M2C_TASKS + NTHREADS - 1) / NTHREADS;
DI void m2conv_item(const Params& p, const LP& L, int it) {
  const bf16* P1 = (const bf16*)(p.ws + OFF_P1);
  bf16* XB = (bf16*)(p.ws + OFF_MIX + MX_XBC);
  const float* cw = p.in[I_M2CONVW] + (size_t)L.l * 4 * 768;
  const float* cb = p.in[I_M2CONVB] + (size_t)L.l * 768;
  for (int task = it * NTHREADS + tid_(); task < M2C_TASKS && task < (it + 1) * NTHREADS; task += NTHREADS) {
    const int cg = task % 96, tb = task / 96, c0 = cg * 8;
    const int tokb = tb * 8, jt = tok_j(tokb), base = tokb - jt;
    const int slo = (jt < CTXL) ? 0 : CTXL, shi = (jt < CTXL) ? CTXL : TOK;
    float w[4][8], bias[8];
#pragma unroll
    for (int k = 0; k < 4; ++k) { float4 a = *(const float4*)(cw + k * 768 + c0), b4 = *(const float4*)(cw + k * 768 + c0 + 4);
      w[k][0] = a.x; w[k][1] = a.y; w[k][2] = a.z; w[k][3] = a.w; w[k][4] = b4.x; w[k][5] = b4.y; w[k][6] = b4.z; w[k][7] = b4.w; }
    { float4 a = *(const float4*)(cb + c0), b4 = *(const float4*)(cb + c0 + 4);
      bias[0] = a.x; bias[1] = a.y; bias[2] = a.z; bias[3] = a.w; bias[4] = b4.x; bias[5] = b4.y; bias[6] = b4.z; bias[7] = b4.w; }
    float xin[11][8];
#pragma unroll
    for (int r = 0; r < 11; ++r) {
      const int j = jt - 2 + r;
      const bool inside = (j >= slo && j < shi);
      const int jc = j < slo ? slo : (j > shi - 1 ? shi - 1 : j);
      ld8bf(P1 + (size_t)(base + jc) * P1W + C_XBC + c0, xin[r]);
#pragma unroll
      for (int c = 0; c < 8; ++c) xin[r][c] = inside ? xin[r][c] : 0.f;
    }
    float y[8][8];
#pragma unroll
    for (int t = 0; t < 8; ++t) {
#pragma unroll
      for (int c = 0; c < 8; ++c) y[t][c] = siluf_(bias[c] + w[0][c] * xin[t][c] + w[1][c] * xin[t + 1][c] + w[2][c] * xin[t + 2][c] + w[3][c] * xin[t + 3][c]);
      st8bf(XB + (size_t)(base + jt + t) * 768 + c0, y[t]);
    }
    if (c0 < 512) {
      bf16* XT = (bf16*)(p.ws + OFF_MIX + MX_XBT) + ((size_t)(base / TOK) * 512 + c0) * TOK + jt;
#pragma unroll
      for (int c = 0; c < 8; ++c) {
        float col[8];
#pragma unroll
        for (int t = 0; t < 8; ++t) col[t] = y[t][c];
        st8bf(XT + (size_t)c * TOK, col);
      }
    }
  }
}
DI int m2_seq2tok(int sq, int dir) { return (dir == 0) ? sq : (sq < CTXL ? (CTXL - 1 - sq) : (TOK - 1 - (sq - CTXL))); }
constexpr int M2S_ITEMS = BATCH * 8 * (TOK / 64) / NWAVES;
DI void m2scal_item(const Params& p, const LP& L, int it) {
  const int w = it * NWAVES + (tid_() >> 6), lane = tid_() & 63;
  const int ch = w % (TOK / 64), r = w / (TOK / 64), hd = r & 3, dir = (r >> 2) & 1, b = r >> 3;
  const float a = -expf(p.in[I_M2ALOG][(L.l * 2 + dir) * 4 + hd]);
  const int sq = ch * 64 + lane, j = m2_seq2tok(sq, dir);
  const float dt = ((const float*)(p.ws + OFF_DT))[((size_t)b * TOK + j) * 8 + dir * 4 + hd];
  float cs = dt * a;
#pragma unroll
  for (int d = 1; d < 64; d <<= 1) { float o = shfl_up_(cs, d); if (lane >= d) cs += o; }
  const float sl = shfl_(cs, 63);
  float* o = (float*)(p.ws + OFF_MIX + MX_M2S) + ((size_t)((b * 2 + dir) * 4 + hd) * TOK + sq) * 4;
  *(float4*)o = make_float4(cs, dt, dt * __expf(sl - cs), cs * 1.4426950408889634f - log2f(dt));
}
constexpr int S5_MT = (MCH + 255) / 256;
DI void s5a_tile(const Params& p, const LP& L, int t, char* smem) {
  const int g = t / (S5_MT * 2), r = t % (S5_MT * 2), mt = r / 2, nt = r % 2;
  const int m0 = mt * 256, n0 = nt * 128;
  GA ga = make_ga((const bf16*)(p.ws + OFF_MIX + MX_US5) + (size_t)g * NTOK * 16, 256, (const bf16*)(L.s5 + S5_WA) + (size_t)g * 65536, 256, 256, MCH);
  f32x4 acc[4][4];
  gemm_s<4>(ga, m0, n0, smem, acc);
  float* HE = (float*)(p.ws + OFF_MIX + MX_HEND) + (size_t)g * MCH * 256;
  EPI_BEGIN(4, acc, m0, n0, MCH)
    st8f(HE + (size_t)row * 256 + col, v);
  EPI_END
}
DI int s5_chunk_of(int i, int d) { return (d == 0) ? i : (i < NCC ? (NCC - 1 - i) : (NCH - 1 - (i - NCC))); }
DI void s5carry_item(const Params& p, const LP& L, int it) {
  const int w = it * NWAVES + (tid_() >> 6), lane = tid_() & 63;
  const int d = w / (16 * BATCH), g = (w / BATCH) & 15, b = w % BATCH;
  const float* lp = (const float*)(L.s5 + S5_LAMPOW) + ((size_t)((d * 16 + g) * 17 + 16) * 64 + lane) * 2;
  const float lre = lp[0], lim = lp[1];
  const float* HE = (const float*)(p.ws + OFF_MIX + MX_HEND) + ((size_t)g * MCH + (size_t)b * NCH) * 256 + d * 128;
  bf16* HI = (bf16*)(p.ws + OFF_MIX + MX_HIN) + ((size_t)g * MCH + (size_t)b * NCH) * 256 + d * 128;
  float cre = 0.f, cim = 0.f;
  constexpr int SB = 16;
  float are[SB], aim[SB], bre[SB], bim[SB];
#define S5_LOAD(RE_, IM_, I0_) { _Pragma("unroll") for (int k_ = 0; k_ < SB; ++k_) { const int ii_ = (I0_) + k_; \
    if (ii_ < NCH) { const int ch_ = s5_chunk_of(ii_, d); RE_[k_] = HE[(size_t)ch_ * 256 + lane]; IM_[k_] = HE[(size_t)ch_ * 256 + 64 + lane]; } } }
#define S5_STEP(RE_, IM_, I0_) { _Pragma("unroll") for (int k_ = 0; k_ < SB; ++k_) { const int ii_ = (I0_) + k_; \
    if (ii_ < NCH) { const int ch_ = s5_chunk_of(ii_, d); \
      HI[(size_t)ch_ * 256 + lane] = f2bf(cre); HI[(size_t)ch_ * 256 + 64 + lane] = f2bf(cim); \
      const float nre_ = lre * cre - lim * cim + RE_[k_], nim_ = lre * cim + lim * cre + IM_[k_]; \
      cre = nre_; cim = nim_; } } }
#pragma unroll
  for (int k = 0; k < SB; ++k) { are[k] = 0.f; aim[k] = 0.f; bre[k] = 0.f; bim[k] = 0.f; }
  S5_LOAD(are, aim, 0)
  for (int i0 = 0; i0 < NCH; i0 += 2 * SB) {
    S5_LOAD(bre, bim, i0 + SB)
    S5_STEP(are, aim, i0)
    S5_LOAD(are, aim, i0 + 2 * SB)
    S5_STEP(bre, bim, i0 + SB)
  }
#undef S5_LOAD
#undef S5_STEP
}
DI void s5c_tile(const Params& p, const LP& L, int t, char* smem) {
  const int g = t / (S5_MT * 2), r = t % (S5_MT * 2), mt = r / 2, nt = r % 2;
  const int m0 = mt * 256, n0 = nt * 128;
  GA ga = make_ga((const bf16*)(p.ws + OFF_MIX + MX_US5) + (size_t)g * NTOK * 16, 256, (const bf16*)(L.s5 + S5_W2) + (size_t)g * 256 * 512, 512, 512, MCH);
  ga.A2 = (const bf16*)(p.ws + OFF_MIX + MX_HIN) + (size_t)g * MCH * 256; ga.lda2 = 256; ga.ksplit = 256;
  f32x4 acc[4][4];
  gemm_s<4>(ga, m0, n0, smem, acc);
  bf16* Z = (bf16*)(p.ws + OFF_MIX + MX_Z);
  EPI_BEGIN(4, acc, m0, n0, MCH)
#pragma unroll
    for (int k = 0; k < 8; ++k) v[k] = geluf_(v[k]);
    st8bf(Z + ((size_t)row * 16 + (col >> 4)) * 256 + g * 16 + (col & 15), v);
  EPI_END
}

#ifdef EMU
DI float fmax_(float a, float b) { return a > b ? a : b; }
#else
DI float fmax_(float a, float b) { return __builtin_fmaxf(a, b); }
#endif
constexpr int AT_LDV = 76;
struct NaInfo { int r, qc, rs, cs; };
template <int DK, bool NA>
DI void attn_block(const bf16* qrow, bool active, const bf16* Kp, int kstride, const bf16* Vt,
                   int ka0, int ntile_a, int arow0, int kb0, int ntile_b,
                   const float* srpb, NaInfo ni, float scale, bf16* orow, char* smem) {
  constexpr int LDK = DK + 8, KCH = DK / 8;
  constexpr int KT_BYTES = 64 * LDK * 2, VT_BYTES = 64 * AT_LDV * 2;
  constexpr int NKL = (64 * KCH + NTHREADS - 1) / NTHREADS;
  const int tid = tid_(), lane = tid & 63, half = lane >> 5, r = lane & 31;
  bf16* sK = (bf16*)smem;
  bf16* sV = (bf16*)(smem + 2 * KT_BYTES);
  bf16x8 qf[DK / 16];
  f32x16 o0, o1;
  float m = -1e30f, l = 0.f;
  const float scale2 = scale * 1.4426950408889634f;
#pragma unroll
  for (int ks = 0; ks < DK / 16; ++ks) qf[ks] = active ? *(const bf16x8*)(qrow + ks * 16 + 8 * half) : bf16x8{0, 0, 0, 0, 0, 0, 0, 0};
#pragma unroll
  for (int i = 0; i < 16; ++i) { o0[i] = 0.f; o1[i] = 0.f; }
  const int NTL = ntile_a + ntile_b;
  u32x4 rk[NKL], rv[1];
#pragma unroll
  for (int i = 0; i < NKL; ++i) rk[i] = u32x4{0u, 0u, 0u, 0u};
  auto key0_of = [&](int t) { return t < ntile_a ? ka0 + 64 * t : kb0 + 64 * (t - ntile_a); };
#define AT_GLOAD(t_) { const int k0_ = key0_of(t_); \
    _Pragma("unroll") for (int i_ = 0; i_ < NKL; ++i_) { const int c_ = tid + i_ * NTHREADS; const int key_ = c_ / KCH, ch_ = c_ % KCH; \
      if (c_ < 64 * KCH) rk[i_] = *(const u32x4*)(Kp + (size_t)(k0_ + key_) * kstride + ch_ * 8); } \
    { const int d_ = tid >> 3, ch_ = tid & 7; rv[0] = *(const u32x4*)(Vt + (size_t)d_ * TOK + k0_ + ch_ * 8); } }
#define AT_SSTORE(buf_) { \
    _Pragma("unroll") for (int i_ = 0; i_ < NKL; ++i_) { const int c_ = tid + i_ * NTHREADS; const int key_ = c_ / KCH, ch_ = c_ % KCH; \
      if (c_ < 64 * KCH) *(u32x4*)(sK + (buf_) * (64 * LDK) + key_ * LDK + ch_ * 8) = rk[i_]; } \
    { const int d_ = tid >> 3, ch_ = tid & 7; \
      bf16* dst_ = sV + (buf_) * (64 * AT_LDV) + d_ * AT_LDV + ch_ * 8; \
      *(uint2*)dst_ = make_uint2(rv[0][0], rv[0][1]); *(uint2*)(dst_ + 4) = make_uint2(rv[0][2], rv[0][3]); } }
  __syncthreads();
  AT_GLOAD(0) AT_SSTORE(0)
  __syncthreads();
  if ((tid >> 6) >= 4) BG_PRIO(1);
#pragma unroll 1
  for (int t = 0; t < NTL; ++t) {
    const int buf = t & 1;
    if (t + 1 < NTL) AT_GLOAD(t + 1)
    bool doit = active;
    int trow0 = 0;
    if (NA && t < ntile_a) {
      trow0 = arow0 + t * (64 / GRID_W);
      doit = active && (trow0 + (64 / GRID_W) > ni.rs) && (trow0 < ni.rs + WIN_R);
    }
    if (doit) {
      const bf16* kb = sK + buf * (64 * LDK);
      const bf16* vb = sV + buf * (64 * AT_LDV);
      f32x16 s0, s1;
#pragma unroll
      for (int i = 0; i < 16; ++i) { s0[i] = 0.f; s1[i] = 0.f; }
      bf16x8 ka0[DK / 16], ka1[DK / 16];
#pragma unroll
      for (int ks = 0; ks < DK / 16; ++ks) {
        ka0[ks] = *(const bf16x8*)(kb + r * LDK + ks * 16 + 8 * half);
        ka1[ks] = *(const bf16x8*)(kb + (32 + r) * LDK + ks * 16 + 8 * half);
      }
      BG_SCHED;
#pragma unroll
      for (int ks = 0; ks < DK / 16; ++ks) {
        s0 = __builtin_amdgcn_mfma_f32_32x32x16_bf16(ka0[ks], qf[ks], s0, 0, 0, 0);
        s1 = __builtin_amdgcn_mfma_f32_32x32x16_bf16(ka1[ks], qf[ks], s1, 0, 0, 0);
      }
      uint2 va0[4], va1[4], vb0[4], vb1[4];
#pragma unroll
      for (int kq = 0; kq < 4; ++kq) {
        const bf16* v0 = vb + r * AT_LDV + 16 * kq + 4 * half;
        const bf16* v1 = vb + (r + 32) * AT_LDV + 16 * kq + 4 * half;
        va0[kq] = *(const uint2*)v0; va1[kq] = *(const uint2*)(v0 + 8); vb0[kq] = *(const uint2*)v1; vb1[kq] = *(const uint2*)(v1 + 8);
      }
      BG_SCHED;
      float mx = -INFINITY;
      if (NA && t < ntile_a) {
#pragma unroll
        for (int i = 0; i < 16; ++i) {
          const int kk = (i & 3) + 8 * (i >> 2) + 4 * half;
#pragma unroll
          for (int hb = 0; hb < 2; ++hb) {
            const int kq = kk + 32 * hb;
            const int kr = trow0 + kq / GRID_W, kc = kq % GRID_W;
            const bool ok = (kr >= ni.rs) && (kr < ni.rs + WIN_R) && (kc >= ni.cs) && (kc < ni.cs + WIN_C);
            const float bias = ok ? srpb[(kr - ni.r + 7) * 31 + (kc - ni.qc + 15)] * 1.4426950408889634f : -INFINITY;
            if (hb == 0) { s0[i] = s0[i] * scale2 + bias; mx = fmax_(mx, s0[i]); }
            else { s1[i] = s1[i] * scale2 + bias; mx = fmax_(mx, s1[i]); }
          }
        }
      } else {
        s0 = s0 * scale2; s1 = s1 * scale2;
#pragma unroll
        for (int i = 0; i < 16; ++i) mx = fmax_(mx, fmax_(s0[i], s1[i]));
      }
      mx = fmax_(mx, shfl_xor_(mx, 32));
      const float mn = fmax_(m, mx);
      const float alpha = exp2f_(m - mn);
      const bool same = (mn == m);
      m = mn;
      float ps = 0.f;
      { const float nmn = -mn; s0 = s0 + nmn; s1 = s1 + nmn; }
#pragma unroll
      for (int i = 0; i < 16; ++i) { s0[i] = exp2f_(s0[i]); s1[i] = exp2f_(s1[i]); }
      { const f32x16 st = s0 + s1;
        ps = ((st[0] + st[1]) + (st[2] + st[3])) + ((st[4] + st[5]) + (st[6] + st[7])) + (((st[8] + st[9]) + (st[10] + st[11])) + ((st[12] + st[13]) + (st[14] + st[15]))); }
      l = l * alpha + ps;
      if (!wave_all_(same)) {
#pragma unroll
        for (int i = 0; i < 16; ++i) { o0[i] *= alpha; o1[i] *= alpha; }
      }
#pragma unroll
      for (int kq = 0; kq < 4; ++kq) {
        u32x4 pw;
#pragma unroll
        for (int j = 0; j < 4; ++j) pw[j] = (kq < 2) ? pack2(s0[8 * (kq & 1) + 2 * j], s0[8 * (kq & 1) + 2 * j + 1]) : pack2(s1[8 * (kq & 1) + 2 * j], s1[8 * (kq & 1) + 2 * j + 1]);
        const bf16x8 pf = __builtin_bit_cast(bf16x8, pw);
        const uint2 a0 = va0[kq], a1 = va1[kq], b0 = vb0[kq], b1 = vb1[kq];
        bf16x8 va, vbb;
        va[0] = (short)(a0.x & 0xffff); va[1] = (short)(a0.x >> 16); va[2] = (short)(a0.y & 0xffff); va[3] = (short)(a0.y >> 16);
        va[4] = (short)(a1.x & 0xffff); va[5] = (short)(a1.x >> 16); va[6] = (short)(a1.y & 0xffff); va[7] = (short)(a1.y >> 16);
        vbb[0] = (short)(b0.x & 0xffff); vbb[1] = (short)(b0.x >> 16); vbb[2] = (short)(b0.y & 0xffff); vbb[3] = (short)(b0.y >> 16);
        vbb[4] = (short)(b1.x & 0xffff); vbb[5] = (short)(b1.x >> 16); vbb[6] = (short)(b1.y & 0xffff); vbb[7] = (short)(b1.y >> 16);
        o0 = __builtin_amdgcn_mfma_f32_32x32x16_bf16(va, pf, o0, 0, 0, 0);
        o1 = __builtin_amdgcn_mfma_f32_32x32x16_bf16(vbb, pf, o1, 0, 0, 0);
      }
    }
    if (t + 1 < NTL) AT_SSTORE(buf ^ 1)
    __syncthreads();
  }
  BG_PRIO(0);
  if (active) {
    const float lt = l + shfl_xor_(l, 32);
    const float inv = rcp_(lt);
#pragma unroll
    for (int gI = 0; gI < 4; ++gI) {
      const int d0 = 8 * gI + 4 * half;
      *(uint2*)(orow + d0) = make_uint2(pack2(o0[4 * gI] * inv, o0[4 * gI + 1] * inv), pack2(o0[4 * gI + 2] * inv, o0[4 * gI + 3] * inv));
      *(uint2*)(orow + 32 + d0) = make_uint2(pack2(o1[4 * gI] * inv, o1[4 * gI + 1] * inv), pack2(o1[4 * gI + 2] * inv, o1[4 * gI + 3] * inv));
    }
  }
}
DI void mla_attn_item(const Params& p, int it, bool ctxq, char* smem) {
  const int nqb = ctxq ? (CTXL + 255) / 256 : SEQ / 256;
  const int b = it / (4 * nqb), h = (it / nqb) & 3, qb = it % nqb;
  const int lane = tid_() & 63, wid = tid_() >> 6;
  const int nq = ctxq ? CTXL : SEQ, q0 = qb * 256 + wid * 32;
  const bool active = q0 < nq;
  const int jq = (ctxq ? 0 : CTXL) + (active ? q0 : 0) + (lane & 31);
  const bf16* Q = (const bf16*)(p.ws + OFF_MIX + MX_Q) + ((size_t)b * 4 + h) * TOK * 96;
  const bf16* K = (const bf16*)(p.ws + OFF_MIX + MX_K) + ((size_t)b * 4 + h) * TOK * 96;
  const bf16* VT = (const bf16*)(p.ws + OFF_MIX + MX_VTM) + ((size_t)b * 4 + h) * 64 * TOK;
  bf16* O = (bf16*)(p.ws + OFF_O) + ((size_t)b * TOK + jq) * 1024 + 0 * 256 + h * 64;
  NaInfo ni; ni.r = 0; ni.qc = 0; ni.rs = 0; ni.cs = 0;
  attn_block<96, false>(Q + (size_t)jq * 96, active, K, 96, VT, 0, 0, 0, 0, (ctxq ? CTXL : TOK) / 64, nullptr, ni, 0.10206207261596577f, O, smem);
}
DI void na_attn_item(const Params& p, const LP& L, int it, bool ctxq, char* smem) {
  const int nqb = ctxq ? (CTXL + 255) / 256 : SEQ / 256;
  const int b = it / (4 * nqb), h = (it / nqb) & 3, qb = it % nqb;
  const int tid = tid_(), lane = tid & 63, wid = tid >> 6;
  const int nq = ctxq ? CTXL : SEQ, q0 = qb * 256 + wid * 32;
  const bool active = q0 < nq;
  const int jq = (ctxq ? 0 : CTXL) + (active ? q0 : 0) + (lane & 31);
  const bf16* P1 = (const bf16*)(p.ws + OFF_P1) + (size_t)b * TOK * P1W;
  const bf16* VT = (const bf16*)(p.ws + OFF_MIX + MX_VTN) + ((size_t)b * 4 + h) * 64 * TOK;
  const bf16* Kb = P1 + C_NA + 256 + h * 64;
  bf16* O = (bf16*)(p.ws + OFF_O) + ((size_t)b * TOK + jq) * 1024 + 1 * 256 + h * 64;
  constexpr int AT_END64 = 2 * (64 * 72 * 2) + 2 * (64 * AT_LDV * 2);
  float* srpb = (float*)(smem + AT_END64);
  NaInfo ni; ni.r = 0; ni.qc = 0; ni.rs = 0; ni.cs = 0;
  int ka0 = 0, nta = 0, arow0 = 0;
  if (!ctxq) {
    __syncthreads();
    const float* rpb = p.in[I_RPB] + ((size_t)L.l * 4 + h) * 15 * 31;
    for (int i = tid; i < 15 * 31; i += NTHREADS) srpb[i] = rpb[i];
    const int tl = q0 + (lane & 31);
    ni.r = tl / GRID_W; ni.qc = tl % GRID_W;
    int rs = ni.r - WIN_R / 2; rs = rs < 0 ? 0 : (rs > ROWS - WIN_R ? ROWS - WIN_R : rs);
    int cs = ni.qc - WIN_C / 2; cs = cs < 0 ? 0 : (cs > GRID_W - WIN_C ? GRID_W - WIN_C : cs);
    ni.rs = rs; ni.cs = cs;
    constexpr int RPT = 64 / GRID_W;
    const int rfirst = (qb * 256) / GRID_W, rlast = (qb * 256 + 255) / GRID_W;
    int rs_f = rfirst - WIN_R / 2; rs_f = rs_f < 0 ? 0 : (rs_f > ROWS - WIN_R ? ROWS - WIN_R : rs_f);
    int rs_l = rlast - WIN_R / 2; rs_l = rs_l < 0 ? 0 : (rs_l > ROWS - WIN_R ? ROWS - WIN_R : rs_l);
    arow0 = (rs_f / RPT) * RPT;
    const int row_hi = rs_l + WIN_R;
    nta = (row_hi - arow0 + RPT - 1) / RPT;
    ka0 = CTXL + arow0 * GRID_W;
  }
  attn_block<64, true>(P1 + (size_t)jq * P1W + C_NA + h * 64, active, Kb, P1W, VT, ka0, nta, arow0, 0, CTXL / 64, srpb, ni, 0.125f, O, smem);
}

constexpr int M2_LDB = 136, M2_LDX = 72;
constexpr int M2_OFF_B = 0;
constexpr int M2_OFF_C = M2_OFF_B + 64 * M2_LDB * 2;
constexpr int M2_OFF_HD = M2_OFF_C + 64 * M2_LDB * 2;
constexpr int M2H_H = 0;
constexpr int M2H_XT = M2H_H + 64 * M2_LDB * 2;
constexpr int M2H_BT = M2H_XT + 64 * M2_LDX * 2;
constexpr int M2H_S = M2H_BT + 128 * M2_LDX * 2;
constexpr int M2H_X = M2H_S + 3 * 64 * 4;
constexpr int M2H_SIZE = M2H_X + 64 * M2_LDX * 2;
constexpr int M2_SMEM = M2_OFF_HD + 2 * M2H_SIZE;
static_assert(M2_SMEM <= SMEM_BYTES, "m2 smem");
DI u32x4 rev8_(u32x4 v) {
  return u32x4{(v[3] >> 16) | (v[3] << 16), (v[2] >> 16) | (v[2] << 16), (v[1] >> 16) | (v[1] << 16), (v[0] >> 16) | (v[0] << 16)};
}
DI void m2scan_item(const Params& p, const LP& L, int it, char* smem) {
  const int b = it / 8, grp = (it >> 2) & 1, dir = (it >> 1) & 1, seg1 = it & 1;
  const int cbeg = seg1 ? M2_SPLIT : 0, cend = seg1 ? TOK : M2_SPLIT;
  const int tid = tid_(), lane = tid & 63, wid = tid >> 6, half = lane >> 5, r = lane & 31;
  const int hsel = wid >> 2, wl = wid & 3, hd = grp * 2 + hsel;
  bf16* sB = (bf16*)(smem + M2_OFF_B);
  bf16* sC = (bf16*)(smem + M2_OFF_C);
  char* hb = smem + M2_OFF_HD + hsel * M2H_SIZE;
  bf16* sH = (bf16*)(hb + M2H_H);
  bf16* sXT = (bf16*)(hb + M2H_XT);
  bf16* sBT = (bf16*)(hb + M2H_BT);
  float* sS = (float*)(hb + M2H_S);
  float* sDt = sS + 64;
  float* sW = sS + 128;
  const bf16* XB = (const bf16*)(p.ws + OFF_MIX + MX_XBC) + (size_t)b * TOK * 768;
  const bf16* XT = (const bf16*)(p.ws + OFF_MIX + MX_XBT) + (size_t)b * 512 * TOK;
  const float* SC = (const float*)(p.ws + OFF_MIX + MX_M2S) + (size_t)((b * 2 + dir) * 4 + hd) * TOK * 4;
  float* YM = (float*)(p.ws + OFF_HA) + ((size_t)dir * NTOK + (size_t)b * TOK) * 256;
  const int pb = wl & 1, tb = wl >> 1, nb0 = 2 * (wl >> 1);
  f32x16 hst[2];
#pragma unroll
  for (int i = 0; i < 16; ++i) { hst[0][i] = 0.f; hst[1][i] = 0.f; }
  __syncthreads();
  for (int i = tid; i < 2 * M2H_SIZE / 4; i += NTHREADS) ((unsigned*)(smem + M2_OFF_HD))[i] = 0u;
  __syncthreads();
  u32x4 rxt[2], rbt[2], rb[2], rc[2];
  float4 rsc = make_float4(0.f, 0.f, 0.f, 0.f);
#define M2_TLOAD(rowptr_, sq0_) (*(const u32x4*)((rowptr_) + ((dir == 0) ? (sq0_) : m2_seq2tok((sq0_) + 7, 1))))
#define M2_GLOAD(c0_) { \
    _Pragma("unroll") for (int q_ = 0; q_ < 2; ++q_) { const int i_ = tid + q_ * NTHREADS; const int h2_ = i_ >> 9, t8_ = ((i_ >> 6) & 7) * 8, pp_ = i_ & 63; \
      rxt[q_] = M2_TLOAD(XT + (size_t)((grp * 2 + h2_) * 64 + pp_) * TOK, (c0_) + t8_); } \
    _Pragma("unroll") for (int q_ = 0; q_ < 2; ++q_) { const int i_ = tid + q_ * NTHREADS; const int t8_ = (i_ >> 7) * 8, nn_ = i_ & 127; \
      rbt[q_] = M2_TLOAD(XT + (size_t)(256 + grp * 128 + nn_) * TOK, (c0_) + t8_); } \
    _Pragma("unroll") for (int q_ = 0; q_ < 2; ++q_) { const int i_ = tid + q_ * NTHREADS; const int t_ = i_ >> 4, n8_ = (i_ & 15) * 8; \
      const bf16* src_ = XB + (size_t)m2_seq2tok((c0_) + t_, dir) * 768 + grp * 128 + n8_; \
      rb[q_] = *(const u32x4*)(src_ + 256); rc[q_] = *(const u32x4*)(src_ + 512); } \
    if (wl == 0) rsc = *(const float4*)(SC + (size_t)((c0_) + lane) * 4); }
  M2_GLOAD(cbeg)
  float* GT = (float*)(p.ws + OFF_MIX + MX_GT) + (size_t)((b * 2 + dir) * 4 + hd) * M2_REST;
  float lcum = 0.f;
  for (int c0 = cbeg; c0 < cend; c0 += 64) {
    if (wl == 0) {
      sS[lane] = rsc.x; sDt[lane] = rsc.w; sW[lane] = rsc.z;
      if (seg1) { GT[c0 - M2_SPLIT + lane] = rsc.x + lcum; lcum += shfl_(rsc.x, 63); }
    }
    __syncthreads();
#pragma unroll
    for (int q2 = 0; q2 < 2; ++q2) {
      const int i = tid + q2 * NTHREADS; const int h2 = i >> 9, t8 = ((i >> 6) & 7) * 8, pp = i & 63;
      *(u32x4*)((bf16*)(smem + M2_OFF_HD + h2 * M2H_SIZE + M2H_XT) + pp * M2_LDX + t8) = dir ? rev8_(rxt[q2]) : rxt[q2];
    }
#pragma unroll
    for (int q4 = 0; q4 < 2; ++q4) {
      const int i = tid + q4 * NTHREADS; const int t = i >> 4, n8 = (i & 15) * 8;
      *(u32x4*)(sB + t * M2_LDB + n8) = rb[q4];
      *(u32x4*)(sC + t * M2_LDB + n8) = rc[q4];
    }
#pragma unroll
    for (int q4 = 0; q4 < 2; ++q4) {
      const int i = tid + q4 * NTHREADS; const int t8 = (i >> 7) * 8, nn = i & 127;
      float bv[8];
      if (dir) rbt[q4] = rev8_(rbt[q4]);
      bv[0] = __uint_as_float(rbt[q4][0] << 16); bv[1] = __uint_as_float(rbt[q4][0] & 0xffff0000u);
      bv[2] = __uint_as_float(rbt[q4][1] << 16); bv[3] = __uint_as_float(rbt[q4][1] & 0xffff0000u);
      bv[4] = __uint_as_float(rbt[q4][2] << 16); bv[5] = __uint_as_float(rbt[q4][2] & 0xffff0000u);
      bv[6] = __uint_as_float(rbt[q4][3] << 16); bv[7] = __uint_as_float(rbt[q4][3] & 0xffff0000u);
#pragma unroll
      for (int h2 = 0; h2 < 2; ++h2) {
        const float* wv = (const float*)(smem + M2_OFF_HD + h2 * M2H_SIZE + M2H_S) + 128 + t8;
        float sv[8];
#pragma unroll
        for (int k = 0; k < 8; ++k) sv[k] = bv[k] * wv[k];
        st8bf((bf16*)(smem + M2_OFF_HD + h2 * M2H_SIZE + M2H_BT) + nn * M2_LDX + t8, sv);
      }
    }
    __syncthreads();
    if (c0 + 64 < cend) M2_GLOAD(c0 + 64)
    {
      f32x16 yT, y2;
#pragma unroll
      for (int i = 0; i < 16; ++i) { yT[i] = 0.f; y2[i] = 0.f; }
      const int tv = 32 * tb + r;
      const float St = sS[tv];
      for (int sb = 0; sb <= tb; ++sb) {
        f32x16 gT;
#pragma unroll
        for (int i = 0; i < 16; ++i) gT[i] = 0.f;
#pragma unroll
        for (int ks = 0; ks < 8; ++ks) {
          bf16x8 av = *(const bf16x8*)(sB + (32 * sb + r) * M2_LDB + 16 * ks + 8 * half);
          bf16x8 bv = *(const bf16x8*)(sC + tv * M2_LDB + 16 * ks + 8 * half);
          gT = __builtin_amdgcn_mfma_f32_32x32x16_bf16(av, bv, gT, 0, 0, 0);
        }
        const float St2 = St * 1.4426950408889634f;
        if (sb == tb) {
#pragma unroll
          for (int i = 0; i < 16; ++i) {
            const int sv = 32 * sb + (i & 3) + 8 * (i >> 2) + 4 * half;
            gT[i] = (sv <= tv) ? gT[i] * exp2f_(St2 - sDt[sv]) : 0.f;
          }
        } else {
#pragma unroll
          for (int i = 0; i < 16; ++i) {
            const int sv = 32 * sb + (i & 3) + 8 * (i >> 2) + 4 * half;
            gT[i] *= exp2f_(St2 - sDt[sv]);
          }
        }
#pragma unroll
        for (int kq = 0; kq < 2; ++kq) {
          const u32x4 pw = u32x4{pack2(gT[8 * kq], gT[8 * kq + 1]), pack2(gT[8 * kq + 2], gT[8 * kq + 3]), pack2(gT[8 * kq + 4], gT[8 * kq + 5]), pack2(gT[8 * kq + 6], gT[8 * kq + 7])};
          const bf16x8 pf = __builtin_bit_cast(bf16x8, pw);
          const bf16* xr = sXT + (32 * pb + r) * M2_LDX + 32 * sb + 16 * kq + 4 * half;
          uint2 x0 = *(const uint2*)xr, x1 = *(const uint2*)(xr + 8);
          bf16x8 xa;
          xa[0] = (short)(x0.x & 0xffff); xa[1] = (short)(x0.x >> 16); xa[2] = (short)(x0.y & 0xffff); xa[3] = (short)(x0.y >> 16);
          xa[4] = (short)(x1.x & 0xffff); xa[5] = (short)(x1.x >> 16); xa[6] = (short)(x1.y & 0xffff); xa[7] = (short)(x1.y >> 16);
          yT = __builtin_amdgcn_mfma_f32_32x32x16_bf16(xa, pf, yT, 0, 0, 0);
        }
      }
#pragma unroll
      for (int ks = 0; ks < 8; ++ks) {
        bf16x8 av = *(const bf16x8*)(sH + (32 * pb + r) * M2_LDB + 16 * ks + 8 * half);
        bf16x8 bv = *(const bf16x8*)(sC + tv * M2_LDB + 16 * ks + 8 * half);
        y2 = __builtin_amdgcn_mfma_f32_32x32x16_bf16(av, bv, y2, 0, 0, 0);
      }
      const float eS = __expf(St);
      const int j = m2_seq2tok(c0 + tv, dir);
      float* yo = YM + (size_t)j * 256 + hd * 64 + 32 * pb + 4 * half;
#pragma unroll
      for (int gI = 0; gI < 4; ++gI)
        *(float4*)(yo + 8 * gI) = make_float4(yT[4 * gI] + eS * y2[4 * gI], yT[4 * gI + 1] + eS * y2[4 * gI + 1], yT[4 * gI + 2] + eS * y2[4 * gI + 2], yT[4 * gI + 3] + eS * y2[4 * gI + 3]);
    }
    __syncthreads();
    {
      const float eL = __expf(sS[63]);
#pragma unroll
      for (int q = 0; q < 2; ++q) {
#pragma unroll
        for (int i = 0; i < 16; ++i) hst[q][i] *= eL;
#pragma unroll
        for (int ks = 0; ks < 4; ++ks) {
          bf16x8 av = *(const bf16x8*)(sXT + (32 * pb + r) * M2_LDX + 16 * ks + 8 * half);
          bf16x8 bv = *(const bf16x8*)(sBT + (32 * (nb0 + q) + r) * M2_LDX + 16 * ks + 8 * half);
          hst[q] = __builtin_amdgcn_mfma_f32_32x32x16_bf16(av, bv, hst[q], 0, 0, 0);
        }
#pragma unroll
        for (int i = 0; i < 16; ++i) {
          const int pv = 32 * pb + (i & 3) + 8 * (i >> 2) + 4 * half;
          sH[pv * M2_LDB + 32 * (nb0 + q) + r] = f2bf(hst[q][i]);
        }
      }
    }
    __syncthreads();
  }
  if (!seg1) {
    bf16* HM = (bf16*)(p.ws + OFF_MIX + MX_HM) + (size_t)((b * 2 + dir) * 2 + grp) * 128 * 128;
#pragma unroll
    for (int q = 0; q < 4; ++q) {
      const int i = tid + q * NTHREADS, pr = i >> 4, n8 = (i & 15) * 8;
      *(u32x4*)(HM + pr * 128 + n8) = *(const u32x4*)((const bf16*)(smem + M2_OFF_HD + (pr >> 6) * M2H_SIZE + M2H_H) + (pr & 63) * M2_LDB + n8);
    }
  }
}
constexpr int M2C_MT = (M2_REST + 255) / 256;
DI void m2corr_tile(const Params& p, const LP& L, int t, char* smem) {
  const int mt = t % M2C_MT, r = t / M2C_MT, grp = r & 1, dir = (r >> 1) & 1, b = r >> 2;
  const int tok0 = dir ? CTXL : M2_SPLIT;
  const bf16* A = (const bf16*)(p.ws + OFF_MIX + MX_XBC) + ((size_t)b * TOK + tok0) * 768 + 512 + grp * 128;
  const bf16* HM = (const bf16*)(p.ws + OFF_MIX + MX_HM) + (size_t)((b * 2 + dir) * 2 + grp) * 128 * 128;
  GA g = make_ga(A, 768, HM, 128, 128, M2_REST);
  f32x4 acc[4][4];
  const int m0 = mt * 256;
  gemm_s<4>(g, m0, 0, smem, acc);
  float* YM = (float*)(p.ws + OFF_HA) + ((size_t)dir * NTOK + (size_t)b * TOK + tok0) * 256;
  const float* GT = (const float*)(p.ws + OFF_MIX + MX_GT) + (size_t)((b * 2 + dir) * 4 + grp * 2) * M2_REST;
  EPI_BEGIN(4, acc, m0, 0, M2_REST)
    const int hs = col >> 6;
    const int sidx = dir ? (M2_REST - 1 - row) : row;
    const float f = __expf(GT[(size_t)hs * M2_REST + sidx]);
    float* yo = YM + (size_t)row * 256 + (grp * 2 + hs) * 64 + (col & 63);
    float4 y0 = *(const float4*)yo, y1 = *(const float4*)(yo + 4);
    y0.x += f * v[0]; y0.y += f * v[1]; y0.z += f * v[2]; y0.w += f * v[3];
    y1.x += f * v[4]; y1.y += f * v[5]; y1.z += f * v[6]; y1.w += f * v[7];
    *(float4*)yo = y0; *(float4*)(yo + 4) = y1;
  EPI_END
}
DI void m2gate_item(const Params& p, const LP& L, int it) {
  const int tok = it * NWAVES + (tid_() >> 6), lane = tid_() & 63;
  const float* Y0 = (const float*)(p.ws + OFF_HA) + (size_t)tok * 256;
  const float* Y1 = Y0 + (size_t)NTOK * 256;
  const bf16* XB = (const bf16*)(p.ws + OFF_MIX + MX_XBC) + (size_t)tok * 768;
  const bf16* P1 = (const bf16*)(p.ws + OFF_P1) + (size_t)tok * P1W + C_Z;
  const int c = lane * 4, hd = c >> 6;
  const float dsk = p.in[I_M2D][L.l * 4 + hd];
  float4 y0 = *(const float4*)(Y0 + c), y1 = *(const float4*)(Y1 + c);
  uint2 xw = *(const uint2*)(XB + c), zw = *(const uint2*)(P1 + c);
  float xs[4] = {__uint_as_float(xw.x << 16), __uint_as_float(xw.x & 0xffff0000u), __uint_as_float(xw.y << 16), __uint_as_float(xw.y & 0xffff0000u)};
  float zs[4] = {__uint_as_float(zw.x << 16), __uint_as_float(zw.x & 0xffff0000u), __uint_as_float(zw.y << 16), __uint_as_float(zw.y & 0xffff0000u)};
  float ys[4] = {y0.x + y1.x, y0.y + y1.y, y0.z + y1.z, y0.w + y1.w};
  float v[4], ss = 0.f;
#pragma unroll
  for (int i = 0; i < 4; ++i) { v[i] = (ys[i] + dsk * xs[i]) * siluf_(zs[i]); ss += v[i] * v[i]; }
  ss = wave_sum(ss);
  const float rs = rsqrtf(ss * (1.f / 256.f) + EPS);
  float4 gn = *(const float4*)(p.in[I_M2GNORM] + L.l * 256 + c);
  bf16* O = (bf16*)(p.ws + OFF_O) + (size_t)tok * 1024 + 768 + c;
  *(uint2*)O = make_uint2(pack2(v[0] * rs * gn.x, v[1] * rs * gn.y), pack2(v[2] * rs * gn.z, v[3] * rs * gn.w));
}
constexpr int GLU_MT = (NTOK + 255) / 256;
DI void glu_tile(const Params& p, const LP& L, int t, char* smem) {
  const int mt = t % GLU_MT, nt = t / GLU_MT, m0 = mt * 256, n0 = nt * 128;
  const bf16* Z = (const bf16*)(p.ws + OFF_MIX + MX_Z);
  GA g = make_ga(Z, 256, (const bf16*)(L.we + WE_GLU), 256, 256, NTOK);
  f32x4 acc[4][4];
  gemm_s<4>(g, m0, n0, smem, acc);
  bf16* O = (bf16*)(p.ws + OFF_O);
  const float* bg = p.in[I_S5BGLU] + L.l * 256;
  uint4 zraw[4][2]; float4 bga[2][2];
  {
    const int l_ = tid_() & 63, w_ = tid_() >> 6, wr_ = w_ >> 1, wc_ = w_ & 1, fr_ = l_ & 15, fq_ = l_ >> 4;
#pragma unroll
    for (int q_ = 0; q_ < 2; ++q_) {
      const int c_ = n0 + wc_ * 64 + q_ * 32 + 8 * fq_;
      bga[q_][0] = *(const float4*)(bg + c_); bga[q_][1] = *(const float4*)(bg + c_ + 4);
#pragma unroll
      for (int m_ = 0; m_ < 4; ++m_) { int r_ = m0 + wr_ * 64 + m_ * 16 + fr_; if (r_ > NTOK - 1) r_ = NTOK - 1; zraw[m_][q_] = *(const uint4*)(Z + (size_t)r_ * 256 + c_); }
    }
  }
  EPI_BEGIN(4, acc, m0, n0, NTOK)
    const uint4 zw = zraw[_m][_q];
    const float z[8] = {__uint_as_float(zw.x << 16), __uint_as_float(zw.x & 0xffff0000u), __uint_as_float(zw.y << 16), __uint_as_float(zw.y & 0xffff0000u),
                        __uint_as_float(zw.z << 16), __uint_as_float(zw.z & 0xffff0000u), __uint_as_float(zw.w << 16), __uint_as_float(zw.w & 0xffff0000u)};
    const float bgv[8] = {bga[_q][0].x, bga[_q][0].y, bga[_q][0].z, bga[_q][0].w, bga[_q][1].x, bga[_q][1].y, bga[_q][1].z, bga[_q][1].w};
#pragma unroll
    for (int k = 0; k < 8; ++k) v[k] = z[k] * sigmoidf_(v[k] + bgv[k]);
    st8bf(O + (size_t)row * 1024 + 512 + col, v);
  EPI_END
}
#ifdef EMU
DI void st16_wt(void* base, unsigned off, uint4 v) { *(uint4*)((char*)base + off) = v; }
#else
DI void st16_wt(void* base, unsigned off, uint4 v) {
  const __amdgpu_buffer_rsrc_t rs = __builtin_amdgcn_make_buffer_rsrc(base, 0, 0x7fffffff, 0x00020000);
  __builtin_amdgcn_raw_buffer_store_b128(u32x4{v.x, v.y, v.z, v.w}, rs, (int)off, 0, 16);
}
#endif
DI void st8bf_wt(bf16* base, unsigned eoff, const float (&v)[8]) { st16_wt(base, eoff * 2u, make_uint4(pack2(v[0], v[1]), pack2(v[2], v[3]), pack2(v[4], v[5]), pack2(v[6], v[7]))); }
DI void dep_signal(const Params& p, int idx) {
#ifndef EMU
  asm volatile("s_waitcnt vmcnt(0)" ::: "memory");
#endif
  __syncthreads();
  if (tid_() == 0) {
#ifdef EMU
    atomicAdd((int*)(p.ws + OFF_BAR) + CNT_WORD0 + idx, 1);
#else
    __hip_atomic_fetch_add((int*)(p.ws + OFF_BAR) + CNT_WORD0 + idx, 1, __ATOMIC_RELAXED, __HIP_MEMORY_SCOPE_AGENT);
#endif
  }
}
DI void dep_wait(const Params& p, int idx, int need) {
  if (tid_() == 0) {
    int* c = (int*)(p.ws + OFF_BAR) + CNT_WORD0 + idx;
#ifdef EMU
    while (__atomic_load_n(c, __ATOMIC_ACQUIRE) < need) emu_yield();
#else
    while (__hip_atomic_load(c, __ATOMIC_RELAXED, __HIP_MEMORY_SCOPE_AGENT) < need) __builtin_amdgcn_s_sleep(2);
    __builtin_amdgcn_fence(__ATOMIC_ACQUIRE, "agent");
#endif
  }
  __syncthreads();
}
DI void merge_tile(const Params& p, const LP& L, int t, char* smem) {
  const int mt = (t >> 6) * 8 + (t & 7), nt = (t >> 3) & 7;
  if (mt >= mtiles(L.last, 256)) return;
  const int m0 = mtile_row0(mt, L.last, 256), n0 = nt * 128;
  const bf16* O = (const bf16*)(p.ws + OFF_O);
  const unsigned char* PG = (const unsigned char*)(p.ws + OFF_PG);
  float tot[4][2][8];
#pragma unroll
  for (int a = 0; a < 4; ++a)
#pragma unroll
    for (int q = 0; q < 2; ++q)
#pragma unroll
      for (int k = 0; k < 8; ++k) tot[a][q][k] = 0.f;
  for (int j = 0; j < 4; ++j) {
    GA g = make_ga(O + j * 256, 1024, (const bf16*)(L.we + WE_WB) + (size_t)j * 1024 * 256, 256, 256, NTOK);
    f32x4 acc[4][4];
    gemm_s<4>(g, m0, n0, smem, acc);
    EPI_BEGIN(4, acc, m0, n0, NTOK)
      float gt[8]; ld8u8(PG + (size_t)row * 4096 + j * 1024 + col, gt);
#pragma unroll
      for (int k = 0; k < 8; ++k) tot[_m][_q][k] += gt[k] * v[k];
    EPI_END
  }
  bf16* Y = (bf16*)(p.ws + OFF_P1);
  {
    const int l = tid_() & 63, w = tid_() >> 6, wr = w >> 1, wc = w & 1, fr = l & 15, fq = l >> 4;
#pragma unroll
    for (int m = 0; m < 4; ++m)
#pragma unroll
      for (int q = 0; q < 2; ++q) {
        const int row = m0 + wr * 64 + m * 16 + fr, col = n0 + wc * 64 + q * 32 + 8 * fq;
        if (row < NTOK) {
#pragma unroll
          for (int k = 0; k < 8; ++k) tot[m][q][k] *= (1.0f / 255.0f);
          st8bf_wt(Y, (unsigned)row * 1024u + (unsigned)col, tot[m][q]);
        }
      }
  }
  dep_signal(p, L.l * CNT_LAYER + mt);
}
DI void outproj_tile(const Params& p, const LP& L, int t, char* smem) {
  bf16* Y2 = (bf16*)(p.ws + OFF_HA);
  constexpr int MT_L = BATCH * (SEQ / 256), MT_A = (NTOK + 255) / 256;
  const int mt = t >> 2, nt = t & 3, m0 = mtile_row0(mt, L.last, 256), n0 = nt * 256;
  (void)MT_L; (void)MT_A;
  GA g = make_ga((const bf16*)(p.ws + OFF_P1), 1024, (const bf16*)(L.we + WE_WOUT), 1024, 1024, NTOK);
  f32x4 acc[2][2][4][2];
  dep_wait(p, L.l * CNT_LAYER + mt, 8);
  gemm_big(g, m0, n0, smem, acc);
  EPIB_BEGIN(acc, m0, n0, NTOK)
    st8bf(Y2 + (size_t)row * 1024 + col, v);
  EPIB_END
}
DI int post_ntok(bool latonly) { return latonly ? BATCH * SEQ : NTOK; }
DI int post_tok(int i, bool latonly) { return latonly ? ((i / SEQ) * TOK + CTXL + (i % SEQ)) : i; }

DI const float* xsrc_row(const Params& p, int l, int tok) {
  (void)l;
  const int b = tok_b(tok), j = tok_j(tok);
  return (j < CTXL) ? p.in[I_CTX] + ((size_t)b * CTXL + j) * 1024 : p.in[I_X] + ((size_t)b * SEQ + (j - CTXL)) * 1024;
}
DI void post_stage_router(const Params& p, const LP& L, char* smem) {
  const float* wr = p.in[I_WROUTER] + (size_t)L.l * 1024 * 16;
  float4* wl = (float4*)smem;
  __syncthreads();
  for (int i = tid_(); i < 4096; i += NTHREADS) {
    const int k = i >> 2, q = i & 3;
    const int pos = ((k >> 8) * 4 + (k & 3)) * 64 + ((k >> 2) & 63);
    wl[q * 1024 + pos] = *(const float4*)(wr + (size_t)k * 16 + q * 4);
  }
  __syncthreads();
}
template <bool FIRST> struct XRow { typedef uint2 T; };
template <> struct XRow<true> { typedef float4 T; };
template <bool FIRST>
DI void post_phase_t(const Params& p, const LP& L, char* smem) {
  typedef typename XRow<FIRST>::T XT;
  const int lane = tid_() & 63, gw = (int)blockIdx.x * NWAVES + (tid_() >> 6), TW = (int)gridDim.x * NWAVES;
  const int n = post_ntok(L.last);
  if (gw >= n) return;
  const float* gpm = p.in[I_GPOSTMIX] + L.l * 1024;
  const float4* wl = (const float4*)smem;
  int i = gw, tok = post_tok(i, L.last);
  uint2 yr[4]; XT xr[4];
  {
    const bf16* Y2 = (const bf16*)(p.ws + OFF_HA) + (size_t)tok * 1024;
#pragma unroll
    for (int q = 0; q < 4; ++q) yr[q] = *(const uint2*)(Y2 + lane * 4 + q * 256);
    if constexpr (FIRST) { const float* X = xsrc_row(p, 0, tok);
#pragma unroll
      for (int q = 0; q < 4; ++q) xr[q] = *(const XT*)(X + lane * 4 + q * 256); }
    else { const bf16* X = (const bf16*)(p.ws + OFF_X) + (size_t)tok * 1024;
#pragma unroll
      for (int q = 0; q < 4; ++q) xr[q] = *(const XT*)(X + lane * 4 + q * 256); }
  }
  for (;;) {
    const int inext = i + TW; const bool has = inext < n; const int tokn = has ? post_tok(inext, L.last) : tok;
    uint2 yn[4]; XT xn[4];
    {
      const bf16* Yn = (const bf16*)(p.ws + OFF_HA) + (size_t)tokn * 1024;
#pragma unroll
      for (int q = 0; q < 4; ++q) yn[q] = *(const uint2*)(Yn + lane * 4 + q * 256);
      if constexpr (FIRST) { const float* Xn = xsrc_row(p, 0, tokn);
#pragma unroll
        for (int q = 0; q < 4; ++q) xn[q] = *(const XT*)(Xn + lane * 4 + q * 256); }
      else { const bf16* Xn = (const bf16*)(p.ws + OFF_X) + (size_t)tokn * 1024;
#pragma unroll
        for (int q = 0; q < 4; ++q) xn[q] = *(const XT*)(Xn + lane * 4 + q * 256); }
    }
    bf16* X = (bf16*)(p.ws + OFF_X) + (size_t)tok * 1024;
    const float* mod = L.mod + (size_t)tok_modrow(tok) * 6144;
    float xv[16], h[16];
    float4 gva[4], gta[4];
#pragma unroll
    for (int q = 0; q < 4; ++q) { const int c = lane * 4 + q * 256; gva[q] = *(const float4*)(gpm + c); gta[q] = *(const float4*)(mod + 2048 + c); }
    float ss = 0.f;
#pragma unroll
    for (int q = 0; q < 4; ++q) { const float4 y4 = bf4_(yr[q]); ss += y4.x * y4.x + y4.y * y4.y + y4.z * y4.z + y4.w * y4.w; }
    ss = wave_sum(ss);
    const float rs = rsqrtf(ss * (1.f / 1024.f) + EPS);
#pragma unroll
    for (int q = 0; q < 4; ++q) {
      const int c = lane * 4 + q * 256;
      const float4 y4 = bf4_(yr[q]);
      float4 xo = bf4_(xr[q]), gv = gva[q], gt = gta[q];
      xo.x += gt.x * y4.x * rs * gv.x; xo.y += gt.y * y4.y * rs * gv.y; xo.z += gt.z * y4.z * rs * gv.z; xo.w += gt.w * y4.w * rs * gv.w;
      *(uint2*)(X + c) = pk4_(xo);
      xv[q * 4] = xo.x; xv[q * 4 + 1] = xo.y; xv[q * 4 + 2] = xo.z; xv[q * 4 + 3] = xo.w;
    }
    bf16* H2 = (bf16*)(p.ws + OFF_P1) + (size_t)NTOK * 1024 + (size_t)tok * 1024;
    normmod_row(xv, p.in[I_GPREFFN] + L.l * 1024, mod + 3072, mod + 4096, H2, h);
    float lg[16];
#pragma unroll
    for (int e = 0; e < 16; ++e) lg[e] = 0.f;
#pragma unroll
    for (int q = 0; q < 16; ++q) {
      const int pos = ((q >> 2) * 4 + (q & 3)) * 64 + lane;
      float4 a = wl[pos], b4 = wl[1024 + pos], c4 = wl[2048 + pos], d4 = wl[3072 + pos];
      float hv = h[q];
      lg[0] += hv * a.x; lg[1] += hv * a.y; lg[2] += hv * a.z; lg[3] += hv * a.w;
      lg[4] += hv * b4.x; lg[5] += hv * b4.y; lg[6] += hv * b4.z; lg[7] += hv * b4.w;
      lg[8] += hv * c4.x; lg[9] += hv * c4.y; lg[10] += hv * c4.z; lg[11] += hv * c4.w;
      lg[12] += hv * d4.x; lg[13] += hv * d4.y; lg[14] += hv * d4.z; lg[15] += hv * d4.w;
    }
    float mx = -INFINITY;
#pragma unroll
    for (int e = 0; e < 16; ++e) { lg[e] = wave_sum(lg[e]); mx = fmax_(mx, lg[e]); }
    float se = 0.f;
#pragma unroll
    for (int e = 0; e < 16; ++e) { lg[e] = expf(lg[e] - mx); se += lg[e]; }
    if (lane < 16) {
      float v = 0.f;
#pragma unroll
      for (int e = 0; e < 16; ++e) if (e == lane) v = lg[e];
      ((float*)(p.ws + OFF_AFF))[(size_t)lane * NTOK + tok] = v * rcp_(se);
    }
    if (!has) break;
    i = inext; tok = tokn;
#pragma unroll
    for (int q = 0; q < 4; ++q) { yr[q] = yn[q]; xr[q] = xn[q]; }
  }
}
DI void post_phase(const Params& p, const LP& L, char* smem) { if (L.l == 0) post_phase_t<true>(p, L, smem); else post_phase_t<false>(p, L, smem); }
DI int block_sum_(int v, int* sred, int round) {
  const int tid = tid_(), lane = tid & 63, wid = tid >> 6;
  v += shfl_xor_(v, 32); v += shfl_xor_(v, 16); v += shfl_xor_(v, 8); v += shfl_xor_(v, 4); v += shfl_xor_(v, 2); v += shfl_xor_(v, 1);
  int* r = sred + (round & 1) * NWAVES;
  if (lane == 0) r[wid] = v;
  __syncthreads();
  int tsum = 0;
#pragma unroll
  for (int q = 0; q < NWAVES; ++q) tsum += r[q];
  return tsum;
}
DI void route_item(const Params& p, const LP& L, int it, char* smem) {
  const int nstream = L.last ? 1 : 2;
  const int b = it / (16 * nstream), e = (it / nstream) & 15, ctxs = (nstream == 2) ? (it & 1) : 0;
  const int T = ctxs ? CTXL : SEQ, cap = ctxs ? CAP_C : CAP_L;
  const int tok0 = b * TOK + (ctxs ? 0 : CTXL);
  const int slot0 = ctxs ? (BATCH * CAP_L + b * CAP_C) : (b * CAP_L);
  int* sred = (int*)smem;
  const float* AFF = (const float*)(p.ws + OFF_AFF) + (size_t)e * NTOK + tok0;
  int* SEL = (int*)(p.ws + OFF_SEL);
  int* IDX = (int*)(p.ws + OFF_IDX) + (size_t)e * ESLOTS;
  float* GW = (float*)(p.ws + OFF_GW) + (size_t)e * ESLOTS;
  const int tid = tid_(), lane = tid & 63, wid = tid >> 6;
  constexpr int MAXPER = (SEQ + NTHREADS - 1) / NTHREADS;
  const int per = (T + NTHREADS - 1) / NTHREADS;
  unsigned key[MAXPER];
  __syncthreads();
#pragma unroll
  for (int k = 0; k < MAXPER; ++k) {
    int i = tid * per + k;
    key[k] = (k < per && i < T) ? (__float_as_uint(AFF[i]) + 1u) : 0u;
  }
  unsigned thr = 0u;
  int round = 0;
  for (int bit = 30; bit >= 0; --bit) {
    const unsigned cand = thr | (1u << bit);
    int c = 0;
#pragma unroll
    for (int k = 0; k < MAXPER; ++k) c += (key[k] >= cand) ? 1 : 0;
    c = block_sum_(c, sred, round++);
    if (c >= cap) thr = cand;
  }
  int cg = 0, ce = 0;
#pragma unroll
  for (int k = 0; k < MAXPER; ++k) { cg += (key[k] > thr) ? 1 : 0; ce += (key[k] == thr) ? 1 : 0; }
  const int tot_gt = block_sum_(cg, sred, round++);
  const int need_eq = cap - tot_gt;
  int v = cg | (ce << 16), inc = v;
#pragma unroll
  for (int d = 1; d < 64; d <<= 1) { int o = shfl_up_(inc, d); if (lane >= d) inc += o; }
  int* soff = sred + 2 * NWAVES;
  __syncthreads();
  if (lane == 63) soff[wid] = inc;
  __syncthreads();
  int base = 0;
  for (int w = 0; w < wid; ++w) base += soff[w];
  int excl = base + inc - v;
  int gt_before = excl & 0xffff, eq_before = excl >> 16;
#pragma unroll
  for (int k = 0; k < MAXPER; ++k) {
    int i = tid * per + k;
    if (k < per && i < T) {
      const bool isgt = key[k] > thr, iseq = key[k] == thr;
      const bool sel = isgt || (iseq && eq_before < need_eq);
      const int slot = slot0 + gt_before + (eq_before < need_eq ? eq_before : need_eq);
      if (sel) { IDX[slot] = tok0 + i; GW[slot] = __uint_as_float(key[k] - 1u); SEL[(size_t)(tok0 + i) * 16 + e] = slot; }
      else SEL[(size_t)(tok0 + i) * 16 + e] = -1;
      gt_before += isgt ? 1 : 0; eq_before += iseq ? 1 : 0;
    }
  }
}
DI void moe1_tile(const Params& p, const LP& L, int t, char* smem) {
  const int nslots = L.last ? ESLOTS_L : ESLOTS;
  constexpr int MT_L = (ESLOTS_L + 255) / 256, MT_A = (ESLOTS + 255) / 256;
  const int nt = t & 7, sq = t >> 3;
  const int e = L.last ? sq / MT_L : sq / MT_A, mt = L.last ? sq % MT_L : sq % MT_A;
  const int m0 = mt * 256, n0 = nt * 256;
  GA g = make_ga((const bf16*)(p.ws + OFF_P1) + (size_t)NTOK * 1024, 1024, (const bf16*)(p.ws + OFF_MIX + WX_GU) + (size_t)e * 2048 * 1024, 1024, 1024, nslots);
  g.ridx = (const int*)(p.ws + OFF_IDX) + (size_t)e * ESLOTS;
  f32x4 acc[2][2][4][2];
  gemm_big(g, m0, n0, smem, acc);
  bf16* ACT = (bf16*)(p.ws + OFF_PG) + (size_t)e * ESLOTS * 1024;
  {
    const int l = tid_() & 63, w = tid_() >> 6, wr = w >> 2, wc = w & 3, fr = l & 15, fq = l >> 4;
#pragma unroll
    for (int ai = 0; ai < 2; ++ai)
#pragma unroll
      for (int m = 0; m < 4; ++m) {
        const int row = m0 + ai * 128 + wr * 64 + m * 16 + fr;
        float a[8];
#pragma unroll
        for (int k = 0; k < 4; ++k) { a[k] = siluf_(acc[ai][0][m][0][k]) * acc[ai][1][m][0][k]; a[4 + k] = siluf_(acc[ai][0][m][1][k]) * acc[ai][1][m][1][k]; }
        if (row < nslots) st8bf_wt(ACT, (unsigned)row * 1024u + (unsigned)(nt * 128 + wc * 32 + 8 * fq), a);
      }
  }
  dep_signal(p, L.l * CNT_LAYER + CNT_MT + e * CNT_ET + mt);
}
DI void moe2_tile(const Params& p, const LP& L, int t, char* smem) {
  const int nslots = L.last ? ESLOTS_L : ESLOTS;
  constexpr int MT_L = (ESLOTS_L + 255) / 256, MT_A = (ESLOTS + 255) / 256;
  const int x = t & 7, nt = x & 3, sq = (t >> 3) * 2 + (x >> 2);
  const int e = L.last ? sq / MT_L : sq / MT_A, mt = L.last ? sq % MT_L : sq % MT_A;
  if (e >= NE) return;
  const int m0 = mt * 256, n0 = nt * 256;
  GA g = make_ga((const bf16*)(p.ws + OFF_PG) + (size_t)e * ESLOTS * 1024, 1024, (const bf16*)(p.ws + OFF_WDN) + (size_t)e * 1024 * 1024, 1024, 1024, nslots);
  f32x4 acc[2][2][4][2];
  dep_wait(p, L.l * CNT_LAYER + CNT_MT + e * CNT_ET + mt, 8);
  gemm_big(g, m0, n0, smem, acc);
  bf16* YS = (bf16*)(p.ws + OFF_PG) + (size_t)NE * ESLOTS * 1024 + (size_t)e * ESLOTS * 1024;
  const float* GW = (const float*)(p.ws + OFF_GW) + (size_t)e * ESLOTS;
  float gwv[2][4];
  {
    const int l_ = tid_() & 63, w_ = tid_() >> 6;
#pragma unroll
    for (int a_ = 0; a_ < 2; ++a_)
#pragma unroll
      for (int m_ = 0; m_ < 4; ++m_) { int r_ = m0 + a_ * 128 + (w_ >> 2) * 64 + m_ * 16 + (l_ & 15); if (r_ > nslots - 1) r_ = nslots - 1; gwv[a_][m_] = GW[r_]; }
  }
  EPIB_BEGIN(acc, m0, n0, nslots)
    const float gw = gwv[_ai][_m];
#pragma unroll
    for (int k = 0; k < 8; ++k) v[k] *= gw;
    st8bf(YS + (size_t)row * 1024 + col, v);
  EPIB_END
}
DI int uni_(int v) {
#ifdef EMU
  return v;
#else
  return __builtin_amdgcn_readfirstlane(v);
#endif
}
DI void comb_phase(const Params& p, const LP& L) {
  const int lane = tid_() & 63, gw = (int)blockIdx.x * NWAVES + (tid_() >> 6), TW = (int)gridDim.x * NWAVES;
  const int n = post_ntok(L.last);
  if (gw >= n) return;
  const bf16* YS = (const bf16*)(p.ws + OFF_PG) + (size_t)NE * ESLOTS * 1024;
  const float* gpf = p.in[I_GPOSTFFN] + L.l * 1024;
  int i = gw, tok = post_tok(i, L.last);
  uint4 sel[4]; uint2 xr[4];
  {
    const uint4* sp = (const uint4*)((const int*)(p.ws + OFF_SEL) + (size_t)tok * 16);
    const bf16* X = (const bf16*)(p.ws + OFF_X) + (size_t)tok * 1024;
#pragma unroll
    for (int q = 0; q < 4; ++q) { sel[q] = sp[q]; xr[q] = *(const uint2*)(X + lane * 4 + q * 256); }
  }
  for (;;) {
    const int inext = i + TW; const bool has = inext < n; const int tokn = has ? post_tok(inext, L.last) : tok;
    float s[16];
#pragma unroll
    for (int q = 0; q < 16; ++q) s[q] = 0.f;
#pragma unroll
    for (int e = 0; e < 16; ++e) {
      const unsigned sv = (e & 3) == 0 ? sel[e >> 2].x : (e & 3) == 1 ? sel[e >> 2].y : (e & 3) == 2 ? sel[e >> 2].z : sel[e >> 2].w;
      const int sl = uni_((int)sv);
      if (sl >= 0) {
        const bf16* yr = YS + ((size_t)e * ESLOTS + sl) * 1024;
#pragma unroll
        for (int q = 0; q < 4; ++q) {
          uint2 w = *(const uint2*)(yr + lane * 4 + q * 256);
          s[q * 4] += __uint_as_float(w.x << 16); s[q * 4 + 1] += __uint_as_float(w.x & 0xffff0000u);
          s[q * 4 + 2] += __uint_as_float(w.y << 16); s[q * 4 + 3] += __uint_as_float(w.y & 0xffff0000u);
        }
      }
    }
    uint4 seln[4]; uint2 xn[4];
    {
      const uint4* sp = (const uint4*)((const int*)(p.ws + OFF_SEL) + (size_t)tokn * 16);
      const bf16* Xn = (const bf16*)(p.ws + OFF_X) + (size_t)tokn * 1024;
#pragma unroll
      for (int q = 0; q < 4; ++q) { seln[q] = sp[q]; xn[q] = *(const uint2*)(Xn + lane * 4 + q * 256); }
    }
    float ss = 0.f;
#pragma unroll
    for (int q = 0; q < 16; ++q) ss += s[q] * s[q];
    ss = wave_sum(ss);
    const float rs = rsqrtf(ss * (1.f / 1024.f) + EPS);
    const float* mod = L.mod + (size_t)tok_modrow(tok) * 6144;
    bf16* dstx = (bf16*)(p.ws + OFF_X) + (size_t)tok * 1024;
    float* dst = p.out;
    if (L.last) { const int b = tok_b(tok), j = tok_j(tok); dst = p.out + ((size_t)b * SEQ + (j - CTXL)) * 1024; }
    float xv[16], h[16];
    float4 gva[4], gta[4];
#pragma unroll
    for (int q = 0; q < 4; ++q) { const int c = lane * 4 + q * 256; gva[q] = *(const float4*)(gpf + c); gta[q] = *(const float4*)(mod + 5120 + c); }
#pragma unroll
    for (int q = 0; q < 4; ++q) {
      const int c = lane * 4 + q * 256;
      float4 xo = bf4_(xr[q]), gv = gva[q], gt = gta[q];
      xo.x += gt.x * s[q * 4] * rs * gv.x; xo.y += gt.y * s[q * 4 + 1] * rs * gv.y; xo.z += gt.z * s[q * 4 + 2] * rs * gv.z; xo.w += gt.w * s[q * 4 + 3] * rs * gv.w;
      if (L.last) *(float4*)(dst + c) = xo; else *(uint2*)(dstx + c) = pk4_(xo);
      xv[q * 4] = xo.x; xv[q * 4 + 1] = xo.y; xv[q * 4 + 2] = xo.z; xv[q * 4 + 3] = xo.w;
    }
    if (!L.last) {
      const float* mod1 = (const float*)(p.ws + OFF_MOD) + ((size_t)(L.l + 1) * NB1 + tok_modrow(tok)) * 6144;
      normmod_row(xv, p.in[I_GPREMIX] + (L.l + 1) * 1024, mod1, mod1 + 1024, (bf16*)(p.ws + OFF_HA) + (size_t)tok * 1024, h);
    }
    if (!has) break;
    i = inext; tok = tokn;
#pragma unroll
    for (int q = 0; q < 4; ++q) { sel[q] = seln[q]; xr[q] = xn[q]; }
  }
}

enum { PH_PREP0 = 0, PH_PREP1, PH_L0 };
enum { LP_INPROJ = 0, LP_TOKPREP, LP_MIX1, LP_MIX2, LP_GLU, LP_MERGE, LP_POST, LP_ROUTE, LP_MOE, LP_COMB, LP_COUNT };
constexpr int NPHASES = PH_L0 + DEPTH * LP_COUNT;


DI void run_phase(const Params& p, int ph, char* smem) {
  const int G = gridDim.x;
  int start = blockIdx.x;
  auto seg = [&](int n, auto&& fn) {
    for (; start < n; start += G) fn(start);
    start -= n;
  };
#ifdef ONLY_PREP
  if (ph >= PH_L0) return;
#endif
  if (ph == PH_PREP0) {
    seg(DEPTH * 96, [&](int it) { mod_item(p, it, smem); });
    seg(DEPTH * 32, [&](int it) { s5_tab_item(p, it, smem); });
    seg(1, [&](int) { rope_tab_item(p); });
    seg(CT_EARLY, [&](int it) { conv_early_item(p, 0, it, smem); });
    return;
  }
  if (ph == PH_PREP1) {
    seg(DEPTH * 256, [&](int it) { s5_mat_item(p, it); });
    seg(NTOK / NWAVES, [&](int it) { prep_row_item(p, it); });
    return;
  }
#ifdef ONLY_LPH
  if (ph < PH_L0) return;
#endif
  const int l = (ph - PH_L0) / LP_COUNT;
#ifdef ONLY_LPH
  const int lph = ONLY_LPH;
#else
  const int lph = (ph - PH_L0) % LP_COUNT;
#endif
  const LP L = make_lp(p, l);
  switch (lph) {
    case LP_INPROJ:
      seg(L.last ? IP_SLOTS_LAST : IP_SLOTS_ALL, [&](int it) { inproj_tile(p, L, it, smem); });
      break;
    case LP_TOKPREP:
      seg(16 * S5_MT * 2, [&](int it) { s5a_tile(p, L, it, smem); });
      seg(TP_MT * 3, [&](int it) { mlaq_tile(p, L, it, smem); });
      seg(TP_MT * 4, [&](int it) { mlakv_tile(p, L, it, smem); });
      seg(NTOK / 64, [&](int it) { navt_item(p, it, smem); });
      seg(M2C_ITEMS, [&](int it) { m2conv_item(p, L, it); });
      seg(M2S_ITEMS, [&](int it) { m2scal_item(p, L, it); });
      break;
    case LP_MIX1: {
      const int n0 = BATCH * 8, n1 = n0 + 2 * 16 * BATCH / NWAVES, n2 = n1 + BATCH * 4 * (SEQ / 256), n3 = n2 + BATCH * 4 * (SEQ / 256);
      const int n4 = n3 + (L.last ? 0 : BATCH * 4 * ((CTXL + 255) / 256)), n5 = n4 + (L.last ? 0 : BATCH * 4 * ((CTXL + 255) / 256));
      const int n6 = n5 + CT_DN / 4, n7 = n6 + (l + 1 < DEPTH ? (CT_EARLY + 3) / 4 : 0);
      int* qhead = (int*)(p.ws + OFF_BAR) + Q_WORD0 + 64 * (l + 2 * p.probe_rep);
#ifdef EMU
      volatile int* bc = (volatile int*)(smem + SMEM_BYTES + 8);
#else
      volatile LAS int* bc = (volatile LAS int*)(smem + SMEM_BYTES + 8);
#endif
      for (;;) {
        __syncthreads();
        if (tid_() == 0) {
#ifdef EMU
          *bc = atomicAdd(qhead, 1);
#else
          *bc = __hip_atomic_fetch_add(qhead, 1, __ATOMIC_RELAXED, __HIP_MEMORY_SCOPE_AGENT);
#endif
        }
        __syncthreads();
        const int it = *bc;
        if (it >= n7) break;
#ifdef PROBE_SKIPM2
        if (it < n0) { if (p.probe_rep == 0) m2scan_item(p, L, it, smem); }
#else
        if (it < n0) m2scan_item(p, L, it, smem);
#endif
        else if (it < n1) s5carry_item(p, L, it - n0);
        else if (it < n2) mla_attn_item(p, it - n1, false, smem);
        else if (it < n3) na_attn_item(p, L, it - n2, false, smem);
        else if (it < n4) mla_attn_item(p, it - n3, true, smem);
        else if (it < n5) na_attn_item(p, L, it - n4, true, smem);
        else if (it < n6) { for (int q = 0; q < 4; ++q) conv_dn_item(p, l, (it - n5) * 4 + q, smem); }
        else { for (int q = 0; q < 4; ++q) { const int ci = (it - n6) * 4 + q; if (ci < CT_EARLY) conv_early_item(p, l + 1, ci, smem); } }
      }
    } break;
    case LP_MIX2:
      seg(16 * S5_MT * 2, [&](int it) { s5c_tile(p, L, it, smem); });
      seg(BATCH * 4 * M2C_MT, [&](int it) { m2corr_tile(p, L, it, smem); });
      break;
    case LP_GLU:
      seg(GLU_MT * 2, [&](int it) { glu_tile(p, L, it, smem); });
      seg(NTOK / NWAVES, [&](int it) { m2gate_item(p, L, it); });
      break;
    case LP_MERGE:
      seg(((mtiles(L.last, 256) + 7) / 8) * 64, [&](int it) { merge_tile(p, L, it, smem); });
      seg(mtiles(L.last, 256) * 4, [&](int it) { outproj_tile(p, L, it, smem); });
      break;
    case LP_POST:
      seg(CT_EXP, [&](int it) { conv_expert_item(p, l, it, smem); });
      post_stage_router(p, L, smem);
      post_phase(p, L, smem);
      break;
    case LP_ROUTE:
      seg(BATCH * 16 * (L.last ? 1 : 2), [&](int it) { route_item(p, L, it, smem); });
      break;
    case LP_MOE:
      seg(NE * (((L.last ? ESLOTS_L : ESLOTS) + 255) / 256) * 8, [&](int it) { moe1_tile(p, L, it, smem); });
      seg(((NE * (((L.last ? ESLOTS_L : ESLOTS) + 255) / 256) + 1) / 2) * 8, [&](int it) { moe2_tile(p, L, it, smem); });
      break;
    case LP_COMB:
      comb_phase(p, L);
      break;
  }
}

__global__ void __launch_bounds__(NTHREADS, 2) mega_kernel(Params p) {
#ifdef EMU
  char* smem = emu_cur_f->blk->smem;
  for (int ph = p.phase_lo; ph < p.phase_hi; ++ph) {
    run_phase(p, ph, smem);
    if (ph + 1 < p.phase_hi) emu_grid_sync();
  }
#else
  __shared__ __attribute__((aligned(16))) char smem[SMEM_BYTES + 16 + 256];
  {
    const unsigned hw = (unsigned)__builtin_amdgcn_s_getreg((5 << 11) | 4) & 0x3fu;
    if ((threadIdx.x & 63) == 0) *(volatile int*)(smem + WAVE_TAB_OFF + hw * 4u) = (int)(threadIdx.x >> 6);
    __syncthreads();
  }
  if (p.phase_hi - p.phase_lo > 1) {
    if (threadIdx.x == 0) *(uint4*)(smem + SMEM_BYTES) = make_uint4(0u, 0u, 0u, 0u);
    __syncthreads();
    XcdBarrier xb = xcd_barrier_post((unsigned*)(p.ws + OFF_BAR), (volatile LAS unsigned*)(smem + SMEM_BYTES));
    for (int ph = p.phase_lo; ph < p.phase_hi; ++ph) {
      int reps = 1;
#ifdef PROBE_PHASE
      if (ph == PROBE_PHASE || ph == PROBE_PHASE2) reps = 1 + PROBE_REP;
#endif
      for (int rep = 0; rep < reps; ++rep) {
        p.probe_rep = rep;
        run_phase(p, ph, smem);
        if (ph + 1 < p.phase_hi || rep + 1 < reps) {
          if (p.pad_ != 0) cg::this_grid().sync();
          else xcd_barrier(xb);
        }
      }
    }
  } else {
    run_phase(p, p.phase_lo, smem);
  }
#endif
}

#ifndef EMU
extern "C" void kernel_launch(void* const* d_in, const int* in_sizes, int n_in, void* d_out, int out_size, void* d_ws, size_t ws_size,
                              hipStream_t stream) {
  static int grid_blocks = 0;
  if (!grid_blocks) {
    int dev = 0, cus = 0, per_cu = 0;
    hipGetDevice(&dev);
    hipDeviceGetAttribute(&cus, hipDeviceAttributeMultiprocessorCount, dev);
    hipOccupancyMaxActiveBlocksPerMultiprocessor(&per_cu, mega_kernel, NTHREADS, 0);
    if (per_cu > 1) per_cu = 1;
    if (per_cu < 1) per_cu = 1;
    grid_blocks = cus * per_cu;
    if (ws_size < WS_TOTAL) fprintf(stderr, "workspace too small: %zu < %zu\n", ws_size, (size_t)WS_TOTAL);
  }
  Params p{};
  for (int i = 0; i < N_INPUTS; ++i) p.in[i] = (const float*)d_in[i];
  p.out = (float*)d_out;
  p.ws = (char*)d_ws;
#if MK_MULTI
  for (int ph = 0; ph < NPHASES; ++ph) {
    p.phase_lo = ph; p.phase_hi = ph + 1;
    hipLaunchKernelGGL(mega_kernel, dim3(grid_blocks), dim3(NTHREADS), 0, stream, p);
  }
#else
  p.phase_lo = 0; p.phase_hi = NPHASES;
  hipMemsetAsync((char*)d_ws + OFF_BAR, 0, BAR_BYTES, stream);
  void* args[] = {&p};
  hipError_t e = hipLaunchCooperativeKernel((void*)mega_kernel, dim3(grid_blocks), dim3(NTHREADS), args, 0, stream);
  if (e != hipSuccess) fprintf(stderr, "cooperative launch failed: %s (grid %d)\n", hipGetErrorString(e), grid_blocks);
#endif
}
#endif
```
